# Optimizing an MI355X kernel written in HIP

```python
import math
import jax, jax.numpy as jnp
from jax import lax
import numpy as np


D_MODEL = 1024
BATCH = 8
SEQ = 8192
DEPTH = 1

SSM_GROUP = 16
D_SSM = D_MODEL // 2
SSM_GROUPS = D_SSM // SSM_GROUP
SSM_STATE = 64
STEP_MIN = 1e-3
STEP_MAX = 1e-1
HEAD_DIM = 64
D_ATTN = D_MODEL // 2
N_HEADS = D_ATTN // HEAD_DIM
MOBA_BLOCK = 256
MOBA_TOP_K = 3
Q_CHUNK = 32
NUM_BUCKETS = 32
MAX_DISTANCE = 128
N_GROUPS = 4
EXPERTS_PER_GROUP = 8
N_EXPERTS = N_GROUPS * EXPERTS_PER_GROUP
EXPERT_TOP_K = 2
D_EXPERT = D_MODEL // 2
RMS_EPS = 1e-6
NEG_INF = -1e30
D_IN = D_SSM + 3 * D_ATTN + 2 * D_MODEL

kernel_name = 'hybrid_s5_moba_hmoe_block'


def rms_norm(x, g):
    xf = x.astype(jnp.float32)
    y = xf * lax.rsqrt(jnp.mean(xf * xf, axis=-1, keepdims=True) + RMS_EPS)
    return (y * g.astype(jnp.float32)).astype(x.dtype)


def t5_bucket(dist):
    n = jnp.maximum(dist, 0)
    max_exact = NUM_BUCKETS // 2
    large = max_exact + (jnp.log(jnp.maximum(n, max_exact).astype(jnp.float32) / max_exact)
                         / math.log(MAX_DISTANCE / max_exact)
                         * (NUM_BUCKETS - max_exact)).astype(jnp.int32)
    return jnp.where(n < max_exact, n, jnp.minimum(large, NUM_BUCKETS - 1))


def _complex_affine_combine(e1, e2):
    a1r, a1i, b1r, b1i = e1
    a2r, a2i, b2r, b2i = e2
    return (a2r * a1r - a2i * a1i,
            a2r * a1i + a2i * a1r,
            a2r * b1r - a2i * b1i + b2r,
            a2r * b1i + a2i * b1r + b2i)


def s5_mixer(u, lam_re, lam_im, log_step, b_re, b_im, c_re, c_im, d):
    step = jnp.exp(log_step)[:, None]
    decay = jnp.exp(lam_re * step)
    a_re = decay * jnp.cos(lam_im * step)
    a_im = decay * jnp.sin(lam_im * step)
    denom = lam_re * lam_re + lam_im * lam_im
    nr, ni = a_re - 1.0, a_im
    coef_re = (nr * lam_re + ni * lam_im) / denom
    coef_im = (ni * lam_re - nr * lam_im) / denom
    bb_re = coef_re[..., None] * b_re - coef_im[..., None] * b_im
    bb_im = coef_re[..., None] * b_im + coef_im[..., None] * b_re
    bu_re = jnp.einsum('bsgh,gph->bsgp', u, bb_re)
    bu_im = jnp.einsum('bsgh,gph->bsgp', u, bb_im)
    a_re_full = jnp.broadcast_to(a_re, bu_re.shape)
    a_im_full = jnp.broadcast_to(a_im, bu_re.shape)
    _, _, h_re, h_im = lax.associative_scan(
        _complex_affine_combine, (a_re_full, a_im_full, bu_re, bu_im), axis=1)
    y = (jnp.einsum('bsgp,ghp->bsgh', h_re, c_re)
         - jnp.einsum('bsgp,ghp->bsgh', h_im, c_im)
         + d * u)
    return y


def moba_attention(q, k, v, rel_bias):
    B, H, S, Dh = q.shape
    nb = -(-S // MOBA_BLOCK)
    s_pad = nb * MOBA_BLOCK
    pad = ((0, 0), (0, 0), (0, s_pad - S), (0, 0))
    q, k, v = jnp.pad(q, pad), jnp.pad(k, pad), jnp.pad(v, pad)
    scale = HEAD_DIM ** -0.5
    rel_bias = rel_bias.astype(jnp.float32)
    k_blocks = k.reshape(B, H, nb, MOBA_BLOCK, Dh)
    v_blocks = v.reshape(B, H, nb, MOBA_BLOCK, Dh)
    k_mean = jnp.mean(k_blocks.astype(jnp.float32), axis=3)
    gate = jnp.einsum('bhsd,bhnd->bhsn', q.astype(jnp.float32), k_mean)
    q_blk = jnp.arange(s_pad) // MOBA_BLOCK
    gate = jnp.where(jnp.arange(nb)[None, :] < q_blk[:, None], gate, NEG_INF)
    k_top = min(MOBA_TOP_K, nb)
    _, idx = lax.top_k(gate, k_top)
    b_ix = jnp.arange(B)[:, None, None, None]
    h_ix = jnp.arange(H)[None, :, None, None]
    n_sel = k_top * MOBA_BLOCK

    def attend_chunk(c):
        start = c * Q_CHUNK
        own = start // MOBA_BLOCK
        q_c = lax.dynamic_slice_in_dim(q, start, Q_CHUNK, axis=2)
        idx_c = lax.dynamic_slice_in_dim(idx, start, Q_CHUNK, axis=2)
        q_pos = start + jnp.arange(Q_CHUNK)
        k_sel = k_blocks[b_ix, h_ix, idx_c].reshape(B, H, Q_CHUNK, n_sel, Dh)
        v_sel = v_blocks[b_ix, h_ix, idx_c].reshape(B, H, Q_CHUNK, n_sel, Dh)
        sel_pos = (idx_c[..., None] * MOBA_BLOCK + jnp.arange(MOBA_BLOCK)).reshape(B, H, Q_CHUNK, n_sel)
        sel_bias = rel_bias[h_ix, t5_bucket(q_pos[:, None] - sel_pos)]
        valid = jnp.repeat(idx_c < own, MOBA_BLOCK, axis=-1)
        logit_sel = jnp.einsum('bhqd,bhqnd->bhqn', q_c, k_sel).astype(jnp.float32) * scale + sel_bias
        logit_sel = jnp.where(valid, logit_sel, NEG_INF)
        k_own = lax.dynamic_slice_in_dim(k, own * MOBA_BLOCK, MOBA_BLOCK, axis=2)
        v_own = lax.dynamic_slice_in_dim(v, own * MOBA_BLOCK, MOBA_BLOCK, axis=2)
        d_own = q_pos[:, None] - (own * MOBA_BLOCK + jnp.arange(MOBA_BLOCK))[None, :]
        own_bias = rel_bias[:, t5_bucket(d_own)]
        logit_own = jnp.einsum('bhqd,bhkd->bhqk', q_c, k_own).astype(jnp.float32) * scale + own_bias[None]
        logit_own = jnp.where((d_own >= 0)[None, None], logit_own, NEG_INF)
        probs = jax.nn.softmax(jnp.concatenate([logit_sel, logit_own], axis=-1), axis=-1).astype(v.dtype)
        return (jnp.einsum('bhqn,bhqnd->bhqd', probs[..., :n_sel], v_sel)
                + jnp.einsum('bhqk,bhkd->bhqd', probs[..., n_sel:], v_own))

    out = lax.map(attend_chunk, jnp.arange(s_pad // Q_CHUNK))
    out = jnp.moveaxis(out, 0, 2).reshape(B, H, s_pad, Dh)
    return out[:, :, :S]


def hier_moe(h, w_rg, b_rg, w_re, b_re, w1, w3, w2):
    B, S, D = h.shape
    xf = h.reshape(B * S, D)
    g_prob = jax.nn.softmax((xf @ w_rg).astype(jnp.float32) + b_rg.astype(jnp.float32), axis=-1)
    g_val, g_idx = lax.top_k(g_prob, 1)
    e_logits = ((xf @ w_re).astype(jnp.float32) + b_re.astype(jnp.float32)).reshape(-1, N_GROUPS, EXPERTS_PER_GROUP)
    e_sel = jnp.take_along_axis(e_logits, g_idx[:, :, None], axis=1)[:, 0]
    e_val, e_idx = lax.top_k(jax.nn.softmax(e_sel, axis=-1), EXPERT_TOP_K)
    e_val = e_val / jnp.sum(e_val, axis=-1, keepdims=True)
    w_in_group = jnp.einsum('tk,tke->te', e_val, jax.nn.one_hot(e_idx, EXPERTS_PER_GROUP, dtype=jnp.float32))
    combine = (jax.nn.one_hot(g_idx[:, 0], N_GROUPS, dtype=jnp.float32) * g_val)[:, :, None] * w_in_group[:, None, :]
    combine = combine.reshape(-1, N_EXPERTS).astype(xf.dtype)
    y = jnp.zeros_like(xf)
    for e in range(N_EXPERTS):
        hid = jax.nn.silu(xf @ w1[e]) * (xf @ w3[e])
        y = y + combine[:, e:e + 1] * (hid @ w2[e])
    return y.reshape(B, S, D)


def setup_inputs(seed: int = 0) -> dict:
    key = jax.random.key(seed)
    ks = jax.random.split(key, 32)
    f32 = jnp.float32

    def nrm(k, shape, scale):
        return jax.random.normal(k, shape, f32) * scale

    L, G, P, Hc = DEPTH, SSM_GROUPS, SSM_STATE, SSM_GROUP
    return {
        'x': nrm(ks[0], (BATCH, SEQ, D_MODEL), 1.0),
        'ln1_g': 1.0 + nrm(ks[1], (L, D_MODEL), 0.02),
        'w_in': nrm(ks[2], (L, D_MODEL, D_IN), D_MODEL ** -0.5),
        'b_gate': nrm(ks[3], (L, 2 * D_MODEL), 0.1),
        'ssm_lambda_re': -0.5 + nrm(ks[4], (L, G, P), 0.01),
        'ssm_lambda_im': math.pi * jnp.arange(P, dtype=f32) + nrm(ks[5], (L, G, P), 0.01),
        'ssm_log_step': jax.random.uniform(ks[6], (L, G), f32, math.log(STEP_MIN), math.log(STEP_MAX)),
        'ssm_b_re': nrm(ks[7], (L, G, P, Hc), (2 * Hc) ** -0.5),
        'ssm_b_im': nrm(ks[8], (L, G, P, Hc), (2 * Hc) ** -0.5),
        'ssm_c_re': nrm(ks[9], (L, G, Hc, P), P ** -0.5),
        'ssm_c_im': nrm(ks[10], (L, G, Hc, P), P ** -0.5),
        'ssm_d': nrm(ks[11], (L, G, Hc), 1.0),
        'w_glu': nrm(ks[12], (L, D_SSM, D_SSM), D_SSM ** -0.5),
        'b_glu': nrm(ks[13], (L, D_SSM), 0.02),
        'w_up_ssm': nrm(ks[14], (L, D_SSM, D_MODEL), D_SSM ** -0.5),
        'w_up_attn': nrm(ks[15], (L, D_ATTN, D_MODEL), D_ATTN ** -0.5),
        'rel_bias': nrm(ks[16], (N_HEADS, NUM_BUCKETS), 0.5),
        'w_out': nrm(ks[17], (L, D_MODEL, D_MODEL), D_MODEL ** -0.5),
        'ln2_g': 1.0 + nrm(ks[18], (L, D_MODEL), 0.02),
        'w_router_group': nrm(ks[19], (L, D_MODEL, N_GROUPS), D_MODEL ** -0.5),
        'b_router_group': nrm(ks[20], (L, N_GROUPS), 0.01),
        'w_router_expert': nrm(ks[21], (L, D_MODEL, N_EXPERTS), D_MODEL ** -0.5),
        'b_router_expert': nrm(ks[22], (L, N_EXPERTS), 0.01),
        'w1': nrm(ks[23], (L, N_EXPERTS, D_MODEL, D_EXPERT), D_MODEL ** -0.5),
        'w3': nrm(ks[24], (L, N_EXPERTS, D_MODEL, D_EXPERT), D_MODEL ** -0.5),
        'w2': nrm(ks[25], (L, N_EXPERTS, D_EXPERT, D_MODEL), D_EXPERT ** -0.5),
        'ln_f_g': 1.0 + nrm(ks[26], (D_MODEL,), 0.02),
    }


def reference(x, ln1_g, w_in, b_gate, ssm_lambda_re, ssm_lambda_im, ssm_log_step,
              ssm_b_re, ssm_b_im, ssm_c_re, ssm_c_im, ssm_d, w_glu, b_glu,
              w_up_ssm, w_up_attn, rel_bias, w_out, ln2_g, w_router_group,
              b_router_group, w_router_expert, b_router_expert, w1, w3, w2, ln_f_g):
    B, S, D = x.shape
    for l in range(DEPTH):
        h = rms_norm(x, ln1_g[l])
        proj = h @ w_in[l]
        o1 = D_SSM
        o2 = o1 + D_ATTN
        o3 = o2 + D_ATTN
        o4 = o3 + D_ATTN
        u = proj[..., :o1].reshape(B, S, SSM_GROUPS, SSM_GROUP)
        q = proj[..., o1:o2].reshape(B, S, N_HEADS, HEAD_DIM).transpose(0, 2, 1, 3)
        k = proj[..., o2:o3].reshape(B, S, N_HEADS, HEAD_DIM).transpose(0, 2, 1, 3)
        v = proj[..., o3:o4].reshape(B, S, N_HEADS, HEAD_DIM).transpose(0, 2, 1, 3)
        gates = proj[..., o4:] + b_gate[l]
        gate_ssm, gate_attn = gates[..., :D_MODEL], gates[..., D_MODEL:]
        y_ssm = s5_mixer(u, ssm_lambda_re[l], ssm_lambda_im[l], ssm_log_step[l],
                         ssm_b_re[l], ssm_b_im[l], ssm_c_re[l], ssm_c_im[l], ssm_d[l]).reshape(B, S, D_SSM)
        g = jax.nn.gelu(y_ssm)
        y_ssm = g * jax.nn.sigmoid(g @ w_glu[l] + b_glu[l])
        y_attn = moba_attention(q, k, v, rel_bias).transpose(0, 2, 1, 3).reshape(B, S, D_ATTN)
        merged = (jax.nn.sigmoid(gate_ssm) * (y_ssm @ w_up_ssm[l])
                  + jax.nn.sigmoid(gate_attn) * (y_attn @ w_up_attn[l]))
        x = x + merged @ w_out[l]
        x = x + hier_moe(rms_norm(x, ln2_g[l]), w_router_group[l], b_router_group[l],
                         w_router_expert[l], b_router_expert[l], w1[l], w3[l], w2[l])
    return rms_norm(x, ln_f_g)
```

```cpp
#include <hip/hip_runtime.h>
#include <cstdio>
#include <cstdint>

#define LAS __attribute__((address_space(3)))
#define GAS __attribute__((address_space(1)))
typedef unsigned short bf16_t;
typedef short bf16x8 __attribute__((ext_vector_type(8)));
typedef float f32x2 __attribute__((ext_vector_type(2)));
typedef float f32x4 __attribute__((ext_vector_type(4)));
typedef float f32x16 __attribute__((ext_vector_type(16)));
typedef unsigned u32x2 __attribute__((ext_vector_type(2)));
typedef unsigned u32x4 __attribute__((ext_vector_type(4)));
typedef GAS unsigned gu32;
#define RLX_AGENT __ATOMIC_RELAXED, __HIP_MEMORY_SCOPE_AGENT
#define LDS_WAIT() asm volatile("s_waitcnt lgkmcnt(0)" ::: "memory")
#define VM_WAIT() asm volatile("s_waitcnt vmcnt(0)" ::: "memory")

__device__ __forceinline__ unsigned f2bf(float f) { unsigned u = __builtin_bit_cast(unsigned, f); return (u + 0x7fffu + ((u >> 16) & 1u)) >> 16; }
__device__ __forceinline__ unsigned pk2(float lo, float hi) { return f2bf(lo) | (f2bf(hi) << 16); }
__device__ __forceinline__ float bf2f(unsigned short b) { return __builtin_bit_cast(float, (unsigned)b << 16); }
__device__ __forceinline__ float bflo(unsigned w) { return __builtin_bit_cast(float, w << 16); }
__device__ __forceinline__ float bfhi(unsigned w) { return __builtin_bit_cast(float, w & 0xffff0000u); }
__device__ __forceinline__ unsigned cvt_pk_bf16(float lo, float hi) { unsigned r; asm volatile("v_cvt_pk_bf16_f32 %0, %1, %2" : "=v"(r) : "v"(lo), "v"(hi)); return r; }
__device__ __forceinline__ float fast_sigmoid(float x) { return __builtin_amdgcn_rcpf(1.f + __builtin_amdgcn_exp2f(-1.4426950408889634f * x)); }
__device__ __forceinline__ float wave_sum(float v) {
#pragma unroll
    for (int o = 1; o < 64; o <<= 1) v += __shfl_xor(v, o);
    return v;
}
__device__ __forceinline__ float wave_max(float v) {
#pragma unroll
    for (int o = 1; o < 64; o <<= 1) v = fmaxf(v, __shfl_xor(v, o));
    return v;
}

#define XB_TMO      128
#define XB_XCNT(j)  (256  + 64 * (j))
#define XB_XSUB(j)  (1280 + 64 * (j))
#define XB_XGEN(j)  (2304 + 64 * (j))
#define XB_TOP      3328
#define XB_TOPGEN   3392
#define XCD_BAR_WORDS 3456
#define XB_SPIN_CAP (1u << 20)

__device__ __forceinline__ unsigned xb_ld(unsigned* p)              { return __hip_atomic_load(p, __ATOMIC_RELAXED, __HIP_MEMORY_SCOPE_AGENT); }
__device__ __forceinline__ unsigned xb_add(unsigned* p, unsigned v) { return __hip_atomic_fetch_add(p, v, __ATOMIC_RELAXED, __HIP_MEMORY_SCOPE_AGENT); }
__device__ __forceinline__ unsigned xb_xcc_id() { return (unsigned)__builtin_amdgcn_s_getreg((3 << 11) | 20) & 0xFu; }
#define XB_SPIN(cond, bar) do { unsigned _sp = 0; while (cond) { __builtin_amdgcn_s_sleep(1); \
    if ((++_sp & 255u) == 0u) { if (xb_ld(&(bar)[XB_TMO])) break; if (_sp > XB_SPIN_CAP) { atomicAdd(&(bar)[XB_TMO], 1u); break; } } } } while (0)

struct XcdBarrier { unsigned* bar; unsigned x; volatile LAS unsigned* st; };

__device__ __forceinline__ XcdBarrier xcd_barrier_post(unsigned* bar, volatile LAS unsigned* st) {
    XcdBarrier b; b.bar = bar; b.x = xb_xcc_id(); b.st = st;
    if (threadIdx.x == 0) (void)xb_add(&bar[XB_XCNT(b.x)], 1u);
    return b;
}
__device__ __forceinline__ void xcd_barrier_complete(unsigned* bar, unsigned x, unsigned& nloc, unsigned& nx) {
    const unsigned G = gridDim.x * gridDim.y * gridDim.z;
    unsigned sum, cnt, mine, sp = 0u;
    for (;;) {
        sum = 0u; cnt = 0u; mine = 0u;
#pragma unroll
        for (unsigned j = 0; j < 16; ++j) { const unsigned c = xb_ld(&bar[XB_XCNT(j)]); sum += c; cnt += (c > 0u) ? 1u : 0u; mine = (j == x) ? c : mine; }
        if (sum == G) break;
        __builtin_amdgcn_s_sleep(1);
        if ((++sp & 255u) == 0u) { if (xb_ld(&bar[XB_TMO])) break; if (sp > XB_SPIN_CAP) { atomicAdd(&bar[XB_TMO], 1u); break; } }
    }
    nloc = mine > 0u ? mine : 1u; nx = cnt > 0u ? cnt : 1u;
}
__device__ __forceinline__ void xcd_barrier(const XcdBarrier& b) {
    asm volatile("s_waitcnt vmcnt(0)" ::: "memory");
    __syncthreads();
    if (threadIdx.x == 0) {
        unsigned* bar = b.bar;
        __builtin_amdgcn_s_waitcnt(0);
        unsigned nloc = b.st[0], nx = b.st[1];
        if (nloc == 0u) { xcd_barrier_complete(bar, b.x, nloc, nx); b.st[0] = nloc; b.st[1] = nx; }
        const unsigned old = xb_add(&bar[XB_XSUB(b.x)], 1u);
        const unsigned gen = old / nloc;
        if (old + 1u == (gen + 1u) * nloc) {
            __builtin_amdgcn_fence(__ATOMIC_RELEASE, "agent");
            asm volatile("s_waitcnt vmcnt(0)" ::: "memory");
            const unsigned og = xb_add(&bar[XB_TOP], 1u);
            const unsigned tg = og / nx;
            if (og + 1u == (tg + 1u) * nx) xb_add(&bar[XB_TOPGEN], 1u);
            else XB_SPIN(xb_ld(&bar[XB_TOPGEN]) == tg, bar);
            __builtin_amdgcn_fence(__ATOMIC_ACQUIRE, "agent");
            xb_add(&bar[XB_XGEN(b.x)], 1u);
            asm volatile("s_waitcnt vmcnt(0)" ::: "memory");
        } else {
            XB_SPIN(xb_ld(&bar[XB_XGEN(b.x)]) == gen, bar);
            __builtin_amdgcn_fence(__ATOMIC_ACQUIRE, "agent");
            asm volatile("s_waitcnt vmcnt(0)" ::: "memory");
        }
    }
    __syncthreads();
}

namespace pg8 {
constexpr int BM = 256, BK = 64, HALF = 128, HTB = HALF * BK * 2, STAGE_BYTES = 8 * HTB, NXCD = 8, WGM = 8;
__host__ __device__ __forceinline__ int lds_byte(int r, int c) { const int st = (r >> 4) * 2 + (c >> 5), rr = r & 15, cc = c & 31, ob = rr * 64 + cc * 2; return st * 1024 + (ob ^ (((ob >> 9) & 1) << 5)); }
__host__ __device__ __forceinline__ void stage_rc(int b, int& R, int& C) { const int st = b / 1024, sb = b % 1024, swz = sb ^ (((sb >> 9) & 1) << 5); R = (st >> 1) * 16 + swz / 64; C = (st & 1) * 32 + (swz % 64) / 2; }
__host__ __device__ __forceinline__ int perm32(int rho) { const int n = rho >> 4, i = rho & 15; return 8 * (i >> 2) + 4 * n + (i & 3); }

struct Unit { int pm, pn, pb, aux, aux2; };
struct Gemm { const bf16_t* A; const bf16_t* Bt; int lda, ldb, K; };

struct StaticOrder {
    int nM, nN, nwg, G, c;
    __device__ void init(int M, int N, int G_, int c_) { nM = M / BM; nN = N / BM; nwg = nM * nN; G = G_; c = c_; }
    __device__ bool next(int i, Unit& u) const {
        const long L = (long)i * G + c; if (L >= nwg) return false;
        int wgid = (int)L; { const int q = nwg / NXCD, r = nwg % NXCD, xcd = wgid % NXCD, off = wgid / NXCD; wgid = (xcd < r ? xcd * (q + 1) : r * (q + 1) + (xcd - r) * q) + off; }
        const int nig = WGM * nN, gid = wgid / nig, fm = gid * WGM, gsz = (nM - fm) < WGM ? (nM - fm) : WGM;
        u.pm = fm + ((wgid % nig) % gsz); u.pn = (wgid % nig) / gsz; u.pb = u.pn; u.aux = 0; u.aux2 = 0; return true;
    }
};
struct GroupedOrder {
    int nM, nN, rtpg, G, v;
    __device__ void init(int nM_, int nN_, int rtpg_, int G_, int v_) { nM = nM_; nN = nN_; rtpg = rtpg_; G = G_; v = v_; }
    __device__ bool next(int i, Unit& u) const {
        const int L = i * G + v; if (L >= nM * nN) return false;
        u.pm = L / nN; u.pn = L % nN; u.aux = u.pm / rtpg; u.pb = u.aux * nN + u.pn; u.aux2 = 0; return true;
    }
};

template <class Epi, class Sched, bool ALIGN_EPI, bool GATHER>
__device__ __forceinline__ void gemm_phase(LAS unsigned char* lds, const Gemm g, const Sched& S, const Epi& E, const LAS unsigned* rowtab  ) {
    const int tid = threadIdx.x, wid = __builtin_amdgcn_readfirstlane(tid >> 6), lane = tid & 63, wr = wid >> 2, wc = wid & 3, fr = lane & 15, fq = lane >> 4;
    const int K = g.K, nt = K / BK;
    int RA[2]; unsigned cA2[2]; unsigned voffB[2];
#pragma unroll
    for (int i = 0; i < 2; ++i) { int R, C; stage_rc(tid * 16 + i * 8192, R, C); const int Rb = (R & ~31) + perm32(R & 31);
        RA[i] = R; cA2[i] = (unsigned)C * 2u; voffB[i] = (unsigned)(Rb * g.ldb + C) * 2u; }
    const size_t kstep = (size_t)(BK * 2);
    const size_t hstepB = (size_t)HALF * g.ldb * 2, tstepB = 2 * hstepB;
    const size_t tstepA = (size_t)BM * g.lda * 2;
    const unsigned ldsw = (unsigned)wid * 1024u;
    const int aoff = lds_byte(wr * 64 + fr, fq * 8), boff = lds_byte(wc * 32 + fr, fq * 8);
    unsigned vAc[2][2], vAn[2][2];
#define PG8_SETVA(dst, ui_) do { _Pragma("unroll") for (int h_ = 0; h_ < 2; ++h_) _Pragma("unroll") for (int i_ = 0; i_ < 2; ++i_) \
        dst[h_][i_] = (GATHER ? rowtab[(ui_) * 256 + h_ * 128 + RA[i_]] : (unsigned)((h_ * 128 + RA[i_]) * g.lda) * 2u) + cA2[i_]; } while (0)
#define PG8_SA(b, h) (((b) * 2 + (h)) * HTB)
#define PG8_SB(b, h) ((4 + (b) * 2 + (h)) * HTB)
#define PG8_STAGE(bufoff, gbase, v0, v1) do { \
        __builtin_amdgcn_global_load_lds((const unsigned*)((const char*)(gbase) + (v0)), (LAS unsigned*)(lds + (bufoff) + ldsw), 16, 0, 0); \
        __builtin_amdgcn_global_load_lds((const unsigned*)((const char*)(gbase) + (v1)), (LAS unsigned*)(lds + (bufoff) + ldsw + 8192), 16, 0, 0); } while (0)
#define PG8_STB(bufoff, gbase) PG8_STAGE(bufoff, gbase, voffB[0], voffB[1])
#define PG8_LDA(dst, b, h) do { _Pragma("unroll") for (int m = 0; m < 4; ++m) _Pragma("unroll") for (int k = 0; k < 2; ++k) dst[m][k] = *(const LAS bf16x8*)(lds + PG8_SA(b, h) + aoff + m * 2048 + k * 1024); } while (0)
#define PG8_LDB(dst, b, h) do { _Pragma("unroll") for (int n = 0; n < 2; ++n) _Pragma("unroll") for (int k = 0; k < 2; ++k) dst[n][k] = *(const LAS bf16x8*)(lds + PG8_SB(b, h) + boff + n * 2048 + k * 1024); } while (0)
#define PG8_MMA(ai, bj, At, Bt) do { __builtin_amdgcn_s_setprio(1); _Pragma("unroll") for (int m = 0; m < 4; ++m) _Pragma("unroll") for (int n = 0; n < 2; ++n) _Pragma("unroll") for (int k = 0; k < 2; ++k) \
        acc[ai][bj][m][n] = __builtin_amdgcn_mfma_f32_16x16x32_bf16(Bt[n][k], At[m][k], acc[ai][bj][m][n], 0, 0, 0); __builtin_amdgcn_s_setprio(0); } while (0)
#define PG8_WAIT_V(n) asm volatile("s_waitcnt vmcnt(" #n ")" ::: "memory")
#define PG8_WAIT_L(n) asm volatile("s_waitcnt lgkmcnt(" #n ")" ::: "memory")
#define PG8_BAR __builtin_amdgcn_s_barrier()
#define PG8_SCHED __builtin_amdgcn_sched_barrier(0)
    Unit cur, nxt; int ui = 0;
    if (!S.next(0, cur)) return;
    f32x4 acc[2][2][4][2];
#pragma unroll
    for (int a = 0; a < 2; ++a)
#pragma unroll
        for (int b = 0; b < 2; ++b)
#pragma unroll
            for (int m = 0; m < 4; ++m)
#pragma unroll
                for (int n = 0; n < 2; ++n) acc[a][b][m][n] = (f32x4){0.f, 0.f, 0.f, 0.f};
    bf16x8 At[4][2], B0[2][2], B1[2][2];
    const char* cA = (const char*)g.A + (GATHER ? (size_t)0 : (size_t)cur.pm * tstepA); const char* cB = (const char*)g.Bt + (size_t)cur.pb * tstepB;
    PG8_SETVA(vAc, 0);
    PG8_STB(PG8_SB(0, 0), cB); PG8_STB(PG8_SB(0, 1), cB + hstepB); PG8_STAGE(PG8_SA(0, 0), cA, vAc[0][0], vAc[0][1]); PG8_STAGE(PG8_SA(0, 1), cA, vAc[1][0], vAc[1][1]);
    if (wr == 1) PG8_BAR;
    PG8_WAIT_V(2); PG8_BAR;
    PG8_STB(PG8_SB(1, 0), cB + kstep); PG8_STAGE(PG8_SA(1, 0), cA + kstep, vAc[0][0], vAc[0][1]); PG8_STB(PG8_SB(1, 1), cB + hstepB + kstep);
    PG8_WAIT_V(6); PG8_BAR;
    for (;;) {
        const bool has_next = S.next(ui + 1, nxt);
        const char* nA = GATHER ? cA : (has_next ? (const char*)g.A + (size_t)nxt.pm * tstepA : cA); const char* nB = has_next ? (const char*)g.Bt + (size_t)nxt.pb * tstepB : cB;
        if (GATHER) { if (has_next) { PG8_SETVA(vAn, ui + 1); } else {
#pragma unroll
            for (int h_ = 0; h_ < 2; ++h_) { vAn[h_][0] = vAc[h_][0]; vAn[h_][1] = vAc[h_][1]; } } }
        for (int t = 0; t < nt; t += 2) {
            const bool last = (t == nt - 2);
            const char* a1 = cA + (size_t)(t + 1) * kstep;
            const char* a2 = last ? nA : cA + (size_t)(t + 2) * kstep; const char* b2 = last ? nB : cB + (size_t)(t + 2) * kstep;
            const char* a3 = a2 + kstep; const char* b3 = b2 + kstep;
            unsigned x00, x01, x10, x11;
            if (GATHER) { x00 = last ? vAn[0][0] : vAc[0][0]; x01 = last ? vAn[0][1] : vAc[0][1]; x10 = last ? vAn[1][0] : vAc[1][0]; x11 = last ? vAn[1][1] : vAc[1][1]; }
            else { x00 = vAc[0][0]; x01 = vAc[0][1]; x10 = vAc[1][0]; x11 = vAc[1][1]; }
            PG8_LDB(B0, 0, 0); PG8_LDB(B1, 0, 1); PG8_SCHED; PG8_LDA(At, 0, 0); PG8_STAGE(PG8_SA(1, 1), a1, vAc[1][0], vAc[1][1]);
            PG8_WAIT_V(8); PG8_WAIT_L(0); PG8_BAR; PG8_MMA(0, 0, At, B0); PG8_MMA(0, 1, At, B1); PG8_BAR; PG8_SCHED;
            PG8_LDA(At, 0, 1); PG8_STB(PG8_SB(0, 0), b2); PG8_STB(PG8_SB(0, 1), b2 + hstepB); PG8_STAGE(PG8_SA(0, 0), a2, x00, x01);
            PG8_WAIT_V(8); PG8_WAIT_L(0); PG8_BAR; PG8_MMA(1, 0, At, B0); PG8_MMA(1, 1, At, B1); PG8_BAR; PG8_SCHED;
            PG8_LDB(B0, 1, 0); PG8_LDB(B1, 1, 1); PG8_SCHED; PG8_LDA(At, 1, 0); PG8_STAGE(PG8_SA(0, 1), a2, x10, x11);
            PG8_WAIT_V(8); PG8_WAIT_L(0); PG8_BAR; PG8_MMA(0, 0, At, B0); PG8_MMA(0, 1, At, B1); PG8_BAR; PG8_SCHED;
            PG8_LDA(At, 1, 1); PG8_STB(PG8_SB(1, 0), b3); PG8_STB(PG8_SB(1, 1), b3 + hstepB); PG8_STAGE(PG8_SA(1, 0), a3, x00, x01);
            PG8_WAIT_V(8); PG8_WAIT_L(0); PG8_BAR; PG8_MMA(1, 0, At, B0); PG8_MMA(1, 1, At, B1); PG8_BAR; PG8_SCHED;
        }
        if constexpr (ALIGN_EPI) { if (wr == 0) PG8_BAR; }
        E(acc, cur, wr, wc, fr, fq);
        if (!has_next) break;
#pragma unroll
        for (int a = 0; a < 2; ++a)
#pragma unroll
            for (int b = 0; b < 2; ++b)
#pragma unroll
                for (int m = 0; m < 4; ++m)
#pragma unroll
                    for (int n = 0; n < 2; ++n) acc[a][b][m][n] = (f32x4){0.f, 0.f, 0.f, 0.f};
        cur = nxt; cA = nA; cB = nB; ++ui;
        if (GATHER) {
#pragma unroll
            for (int h_ = 0; h_ < 2; ++h_) { vAc[h_][0] = vAn[h_][0]; vAc[h_][1] = vAn[h_][1]; } }
        if constexpr (ALIGN_EPI) { if (wr == 1) PG8_BAR; }
    }
    PG8_WAIT_V(0);
    if constexpr (!ALIGN_EPI) { if (wr == 0) PG8_BAR; }
    PG8_BAR;
#undef PG8_SETVA
#undef PG8_SA
#undef PG8_SB
#undef PG8_STAGE
#undef PG8_STB
#undef PG8_LDA
#undef PG8_LDB
#undef PG8_MMA
#undef PG8_WAIT_V
#undef PG8_WAIT_L
#undef PG8_BAR
#undef PG8_SCHED
}
}
constexpr int NWAVES = 8, NTHR = 512;
constexpr int BATCH = 8, SEQ = 8192, T = BATCH * SEQ, D = 1024, DIN = 4096;
constexpr int DS = 512, DA = 512, NH = 8, HD = 64, NBLK = SEQ / 256;
constexpr int SG = 32, SHC = 16, SP = 64, SL = 32, SKU = SL * SHC  , SKS = 2 * SP  , SKY = SKU + SKS  , SROWS = T / SL  ;
constexpr int NE = 32, DE = 512;
constexpr float RMS_EPS = 1e-6f;
constexpr float LOG2E = 1.4426950408889634f;
constexpr float QSCALE = 0.125f * LOG2E;
constexpr int ROWCAP = T;
constexpr int HID_ROWS = 2 * T + NE * 256;

constexpr size_t MiB = 1u << 20;
constexpr size_t WS_CTL = 0, CTL_ZERO_BYTES = 1 * MiB;
constexpr size_t WS_WIN = 1 * MiB;
constexpr size_t WS_WGLU = 9 * MiB;
constexpr size_t WS_WUS = 10 * MiB;
constexpr size_t WS_WUA = 11 * MiB;
constexpr size_t WS_WOUT = 12 * MiB;
constexpr size_t WS_WR = 14 * MiB;
constexpr size_t WS_KMEAN = 15 * MiB;
constexpr size_t WS_SSMW = 16 * MiB;
constexpr size_t WS_SSMT = 24 * MiB;
constexpr size_t WS_W13 = 44 * MiB;
constexpr size_t WS_W2 = 108 * MiB;
constexpr size_t WS_A0 = 140 * MiB;
constexpr size_t WS_UP = 276 * MiB;
constexpr size_t WS_Q = 356 * MiB;
constexpr size_t WS_SSQ = 404 * MiB;
constexpr size_t WS_RLOG = 408 * MiB;
constexpr size_t WS_K = 420 * MiB;
constexpr size_t WS_ROWTOK = 428 * MiB, WS_ROWCOEF = 436 * MiB, WS_ROWRSTD = 444 * MiB;
constexpr size_t WS_GACT = 420 * MiB;
constexpr size_t WS_V = 484 * MiB;
constexpr size_t WS_YSSM = 484 * MiB;
constexpr size_t WS_SGS = 548 * MiB;
constexpr size_t WS_SGA = 676 * MiB;
constexpr size_t WS_E = 804 * MiB;
constexpr size_t WS_YATT = 836 * MiB;
constexpr size_t WS_END = 932 * MiB;
constexpr size_t WS_KFRAG = WS_A0, WS_VFRAG = WS_A0 + 64 * MiB, WS_H1 = WS_A0, WS_MRG = WS_A0, WS_HID = WS_A0;
constexpr size_t WS_X1 = WS_SGS, WS_XG = WS_UP, WS_Y0 = WS_UP, WS_Y1 = WS_E;
static_assert(WS_GACT + 64 * MiB <= WS_YSSM && WS_YSSM + 64 * MiB <= WS_SGS, "map");
static_assert(WS_HID + (size_t)HID_ROWS * DE * 2 <= WS_UP, "hid fits");
static_assert(WS_RLOG + (size_t)T * 72 * 4 <= WS_ROWTOK, "rlog fits");

constexpr int CW_TMO = 0, CW_CODE = 1;
constexpr int CW_BAR = 4096;
constexpr int CW_ECNT = 8192;

constexpr int RING_BYTES = 131072;
constexpr int ROWTAB_OFF = RING_BYTES, ROWTAB_UNITS = 12, ROWTAB_BYTES = ROWTAB_UNITS * 1024;
constexpr int MOE_TST_OFF = ROWTAB_OFF + ROWTAB_BYTES;
constexpr int MISC_OFF = MOE_TST_OFF + 512;
constexpr int LDS_BYTES = MISC_OFF + 128;
static_assert(LDS_BYTES <= 163840, "LDS");

struct Frame {
    LAS unsigned char* lds;
    volatile LAS unsigned* MISC;
    gu32* ctl;
    unsigned char* ws;
    int tid, lane, wave, vcu, G;
    const float* in[27];
    float* out;
};

#define EPI_LOOP_BEGIN  _Pragma("unroll") for (int ai = 0; ai < 2; ++ai) _Pragma("unroll") for (int m = 0; m < 4; ++m) { const int rl = ai * 128 + wr * 64 + m * 16 + fr; _Pragma("unroll") for (int bj = 0; bj < 2; ++bj) { const int cl = bj * 128 + wc * 32 + 8 * fq; \
        const f32x4 a0 = acc[ai][bj][m][0], a1 = acc[ai][bj][m][1]; (void)rl; (void)cl; (void)a0; (void)a1;
#define EPI_LOOP_END } }
typedef const f32x4 (&AccRef)[2][2][4][2];
__device__ __forceinline__ u32x4 pack8(f32x4 a, f32x4 b) { u32x4 w; w.x = cvt_pk_bf16(a[0], a[1]); w.y = cvt_pk_bf16(a[2], a[3]); w.z = cvt_pk_bf16(b[0], b[1]); w.w = cvt_pk_bf16(b[2], b[3]); return w; }
__device__ __forceinline__ void unpack8(u32x4 w, f32x4& a, f32x4& b) { a = (f32x4){bflo(w.x), bfhi(w.x), bflo(w.y), bfhi(w.y)}; b = (f32x4){bflo(w.z), bfhi(w.z), bflo(w.w), bfhi(w.w)}; }

struct EpiProj {
    unsigned char* ws; const float* b_gate;
    __device__ __forceinline__ void operator()(AccRef acc, const pg8::Unit& u, int wr, int wc, int fr, int fq) const {
        const int pn = u.pn; const int row0 = u.pm * 256;
        if (pn < 2) {
            bf16_t* Uperm = (bf16_t*)(ws + WS_UP);
            EPI_LOOP_BEGIN
                const int row = row0 + rl, col = pn * 256 + cl;
                bf16_t* dst = Uperm + (size_t)(col >> 4) * ((size_t)SROWS * SKY) + (size_t)(row >> 5) * SKY + (row & 31) * 16 + (col & 15);
                *(u32x4*)dst = pack8(a0, a1);
            EPI_LOOP_END
        } else if (pn < 8) {
            const size_t boff = pn < 4 ? WS_Q : (pn < 6 ? WS_K : WS_V);
            bf16_t* base = (bf16_t*)(ws + boff); const float sc = pn < 4 ? QSCALE : 1.f; const int c0 = (pn & 1) * 256;
            EPI_LOOP_BEGIN
                const int row = row0 + rl, col = c0 + cl;
                *(u32x4*)(base + (size_t)row * 512 + col) = pack8(a0 * sc, a1 * sc);
            EPI_LOOP_END
        } else {
            const size_t boff = pn < 12 ? WS_SGS : WS_SGA;
            bf16_t* base = (bf16_t*)(ws + boff); const int c0 = ((pn - 8) & 3) * 256; const float* bg = b_gate + (pn - 8) * 256;
            EPI_LOOP_BEGIN
                const int row = row0 + rl, col = c0 + cl;
                const f32x4 b0 = *(const f32x4*)(bg + cl), b1 = *(const f32x4*)(bg + cl + 4);
                f32x4 s0, s1;
#pragma unroll
                for (int e = 0; e < 4; ++e) { s0[e] = fast_sigmoid(a0[e] + b0[e]); s1[e] = fast_sigmoid(a1[e] + b1[e]); }
                *(u32x4*)(base + (size_t)row * 1024 + col) = pack8(s0, s1);
            EPI_LOOP_END
        }
    }
};
struct EpiSsmE {
    float* E;
    __device__ __forceinline__ void operator()(AccRef acc, const pg8::Unit& u, int wr, int wc, int fr, int fq) const {
        EPI_LOOP_BEGIN
            if (bj == 0) { float* dst = E + (size_t)(u.pm * 256 + rl) * 128 + cl; *(f32x4*)dst = a0; *(f32x4*)(dst + 4) = a1; }
        EPI_LOOP_END
    }
};
__device__ __forceinline__ float gelu_tanh(float x) { const float z = 1.5957691216057308f * (x + 0.044715f * x * x * x); return x * fast_sigmoid(z); }
struct EpiSsmY {
    bf16_t* Gact;
    __device__ __forceinline__ void operator()(AccRef acc, const pg8::Unit& u, int wr, int wc, int fr, int fq) const {
        const int g = u.aux;
        EPI_LOOP_BEGIN
            const int rg = (u.pm & 7) * 256 + rl;
            const int colg = u.pn * 256 + cl;
            const int tok = (rg >> 8) * SEQ + (rg & 255) * SL + (colg >> 4);
            f32x4 y0, y1;
#pragma unroll
            for (int e = 0; e < 4; ++e) { y0[e] = gelu_tanh(a0[e]); y1[e] = gelu_tanh(a1[e]); }
            *(u32x4*)(Gact + (size_t)tok * DS + g * 16 + (colg & 15)) = pack8(y0, y1);
        EPI_LOOP_END
    }
};
struct EpiGlu {
    const bf16_t* Gact; bf16_t* Yssm; const float* b_glu;
    __device__ __forceinline__ void operator()(AccRef acc, const pg8::Unit& u, int wr, int wc, int fr, int fq) const {
        EPI_LOOP_BEGIN
            const int row = u.pm * 256 + rl, col = u.pn * 256 + cl;
            const f32x4 b0 = *(const f32x4*)(b_glu + col), b1 = *(const f32x4*)(b_glu + col + 4);
            f32x4 g0, g1; unpack8(*(const u32x4*)(Gact + (size_t)row * DS + col), g0, g1);
            f32x4 y0, y1;
#pragma unroll
            for (int e = 0; e < 4; ++e) { y0[e] = g0[e] * fast_sigmoid(a0[e] + b0[e]); y1[e] = g1[e] * fast_sigmoid(a1[e] + b1[e]); }
            *(u32x4*)(Yssm + (size_t)row * DS + col) = pack8(y0, y1);
        EPI_LOOP_END
    }
};
template <bool SECOND> struct EpiUp {
    const bf16_t* SG; bf16_t* Mrg;
    __device__ __forceinline__ void operator()(AccRef acc, const pg8::Unit& u, int wr, int wc, int fr, int fq) const {
        EPI_LOOP_BEGIN
            const size_t off = (size_t)(u.pm * 256 + rl) * D + u.pn * 256 + cl;
            f32x4 s0, s1; unpack8(*(const u32x4*)(SG + off), s0, s1);
            f32x4 y0 = s0 * a0, y1 = s1 * a1;
            if (SECOND) { f32x4 p0, p1; unpack8(*(const u32x4*)(Mrg + off), p0, p1); y0 += p0; y1 += p1; }
            *(u32x4*)(Mrg + off) = pack8(y0, y1);
        EPI_LOOP_END
    }
};
struct EpiOut {
    const float* x; float* X1; bf16_t* XG; const float* g2; float* SSQ;
    __device__ __forceinline__ void operator()(AccRef acc, const pg8::Unit& u, int wr, int wc, int fr, int fq) const {
#pragma unroll
        for (int ai = 0; ai < 2; ++ai)
#pragma unroll
            for (int m = 0; m < 4; ++m) { const int row = u.pm * 256 + ai * 128 + wr * 64 + m * 16 + fr; float ss = 0.f;
#pragma unroll
                for (int bj = 0; bj < 2; ++bj) { const int col = u.pn * 256 + bj * 128 + wc * 32 + 8 * fq; const size_t off = (size_t)row * D + col;
                    const f32x4 x0 = *(const f32x4*)(x + off) + acc[ai][bj][m][0], x1 = *(const f32x4*)(x + off + 4) + acc[ai][bj][m][1];
                    *(f32x4*)(X1 + off) = x0; *(f32x4*)(X1 + off + 4) = x1;
                    ss += (x0[0] * x0[0] + x0[1] * x0[1]) + (x0[2] * x0[2] + x0[3] * x0[3]) + (x1[0] * x1[0] + x1[1] * x1[1]) + (x1[2] * x1[2] + x1[3] * x1[3]);
                    const f32x4 w0 = *(const f32x4*)(g2 + col), w1 = *(const f32x4*)(g2 + col + 4);
                    *(u32x4*)(XG + off) = pack8(x0 * w0, x1 * w1); }
                ss += __shfl_xor(ss, 16); ss += __shfl_xor(ss, 32);
                if (fq == 0) SSQ[(size_t)row * 16 + u.pn * 4 + wc] = ss; }
    }
};
struct EpiRouter {
    float* Rlog;
    __device__ __forceinline__ void operator()(AccRef acc, const pg8::Unit& u, int wr, int wc, int fr, int fq) const {
        EPI_LOOP_BEGIN
            if (bj == 0 && cl < 72) { float* dst = Rlog + (size_t)(u.pm * 256 + rl) * 72 + cl; *(f32x4*)dst = a0; *(f32x4*)(dst + 4) = a1; }
        EPI_LOOP_END
    }
};
struct EpiMoe1 {
    bf16_t* Hid; const float* rowrstd; const unsigned* ecnt;
    __device__ __forceinline__ void operator()(AccRef acc, const pg8::Unit& u, int wr, int wc, int fr, int fq) const {
        const int e = u.aux, cnt = (int)ecnt[e];
#pragma unroll
        for (int ai = 0; ai < 2; ++ai)
#pragma unroll
            for (int m = 0; m < 4; ++m) { const int rl = ai * 128 + wr * 64 + m * 16 + fr; const int pos = u.aux2 + rl;
                if (pos < cnt) { const float rs = rowrstd[(size_t)e * ROWCAP + pos];
                    f32x4 h0, h1;
#pragma unroll
                    for (int k = 0; k < 4; ++k) { const float p = acc[ai][0][m][0][k] * rs, q = acc[ai][1][m][0][k] * rs; h0[k] = p * fast_sigmoid(p) * q;
                        const float p2 = acc[ai][0][m][1][k] * rs, q2 = acc[ai][1][m][1][k] * rs; h1[k] = p2 * fast_sigmoid(p2) * q2; }
                    *(u32x4*)(Hid + (size_t)(u.pm * 256 + rl) * DE + u.pn * 128 + wc * 32 + 8 * fq) = pack8(h0, h1); } }
    }
};
struct EpiMoe2 {
    bf16_t* Y0; size_t ydelta; const unsigned* rowtok; const float* rowcoef; const unsigned* ecnt;
    __device__ __forceinline__ void operator()(AccRef acc, const pg8::Unit& u, int wr, int wc, int fr, int fq) const {
        const int e = u.aux, cnt = (int)ecnt[e];
#pragma unroll
        for (int ai = 0; ai < 2; ++ai)
#pragma unroll
            for (int m = 0; m < 4; ++m) { const int rl = ai * 128 + wr * 64 + m * 16 + fr; const int pos = u.aux2 + rl;
                if (pos < cnt) { const unsigned tk = rowtok[(size_t)e * ROWCAP + pos]; const float cf = rowcoef[(size_t)e * ROWCAP + pos];
                    bf16_t* dst = (bf16_t*)((unsigned char*)Y0 + (size_t)(tk & 1u) * ydelta) + (size_t)(tk >> 1) * D + u.pn * 256 + wc * 32 + 8 * fq;
#pragma unroll
                    for (int bj = 0; bj < 2; ++bj) *(u32x4*)(dst + bj * 128) = pack8(acc[ai][bj][m][0] * cf, acc[ai][bj][m][1] * cf); } }
    }
};
__device__ __forceinline__ void transpose_item(const float* W, int N, int k0, int n0, bf16_t* WT, size_t drow0, int ldo, LAS float* scr, int lane) {
#pragma unroll 8
    for (int i = 0; i < 32; ++i) { const int kk = 2 * i + (lane >> 5); scr[kk * 33 + (lane & 31)] = W[(size_t)(k0 + kk) * N + n0 + (lane & 31)]; }
    LDS_WAIT(); asm volatile("" ::: "memory");
    const int c = lane & 7;
#pragma unroll
    for (int j = 0; j < 4; ++j) { const int n = (lane >> 3) + 8 * j; const LAS float* s = scr + (8 * c) * 33 + n;
        u32x4 o; o.x = pk2(s[0 * 33], s[1 * 33]); o.y = pk2(s[2 * 33], s[3 * 33]); o.z = pk2(s[4 * 33], s[5 * 33]); o.w = pk2(s[6 * 33], s[7 * 33]);
        *(u32x4*)(WT + (drow0 + n) * (size_t)ldo + k0 + 8 * c) = o; }
    LDS_WAIT(); asm volatile("" ::: "memory");
}
__device__ __forceinline__ void rms_row_to_bf16(int lane, const float* xrow, const float* g, bf16_t* orow) {
    const f32x4* xr = (const f32x4*)xrow + lane; const f32x4* gr = (const f32x4*)g + lane;
    f32x4 v[4]; float s = 0.f;
#pragma unroll
    for (int j = 0; j < 4; ++j) { v[j] = xr[64 * j]; s += (v[j].x * v[j].x + v[j].y * v[j].y) + (v[j].z * v[j].z + v[j].w * v[j].w); }
    const float rstd = 1.f / sqrtf(wave_sum(s) * (1.f / D) + RMS_EPS);
    unsigned long long* o8 = (unsigned long long*)orow + lane;
#pragma unroll
    for (int j = 0; j < 4; ++j) { const f32x4 w = gr[64 * j];
        o8[64 * j] = (unsigned long long)pk2(v[j].x * rstd * w.x, v[j].y * rstd * w.y) | ((unsigned long long)pk2(v[j].z * rstd * w.z, v[j].w * rstd * w.w) << 32); }
}
__device__ __forceinline__ void cpow(float lr, float li, float step, float dl, float& ar, float& ai) {
    const float mag = __expf(dl * lr * step); const float rev = dl * (li * step * 0.15915494309189535f); const float fr = rev - floorf(rev);
    ar = mag * __builtin_amdgcn_cosf(fr); ai = mag * __builtin_amdgcn_sinf(fr);
}
__device__ __forceinline__ void ssm_gen(Frame& F, int g) {
    LAS float* AP = (LAS float*)(F.lds); LAS float* BB = AP + 33 * 64 * 2; LAS float* CC = BB + 2048; LAS float* KT = CC + 2048;
    const float* lam_re = F.in[4] + g * SP; const float* lam_im = F.in[5] + g * SP; const float step = __expf(F.in[6][g]);
    const float* b_re = F.in[7] + g * SP * SHC; const float* b_im = F.in[8] + g * SP * SHC; const float* c_re = F.in[9] + g * SHC * SP; const float* c_im = F.in[10] + g * SHC * SP; const float* dd = F.in[11] + g * SHC;
    bf16_t* BT = (bf16_t*)(F.ws + WS_SSMT) + (size_t)g * 512 * SKY; bf16_t* BW = (bf16_t*)(F.ws + WS_SSMW) + (size_t)g * 256 * SKU;
    const int tid = F.tid;
    for (int idx = tid; idx < 33 * 64; idx += NTHR) { const int dl = idx >> 6, p = idx & 63; float ar, ai; cpow(lam_re[p], lam_im[p], step, (float)dl, ar, ai); AP[idx * 2] = ar; AP[idx * 2 + 1] = ai; }
    for (int idx = tid; idx < 1024; idx += NTHR) { const int ho = idx >> 6, p = idx & 63; CC[idx * 2] = c_re[ho * 64 + p]; CC[idx * 2 + 1] = c_im[ho * 64 + p]; }
    __syncthreads();
    for (int idx = tid; idx < 1024; idx += NTHR) { const int p = idx >> 4, h = idx & 15; const float ar = AP[(64 + p) * 2], ai = AP[(64 + p) * 2 + 1];
        const float lr = lam_re[p], li = lam_im[p], nr = ar - 1.f, ni = ai, den = lr * lr + li * li, cr = (nr * lr + ni * li) / den, ci = (ni * lr - nr * li) / den;
        const float br = b_re[p * 16 + h], bi = b_im[p * 16 + h]; BB[idx * 2] = cr * br - ci * bi; BB[idx * 2 + 1] = cr * bi + ci * br; }
    __syncthreads();
    for (int idx = tid; idx < 8192; idx += NTHR) { const int dl = idx >> 8, ho = (idx >> 4) & 15, hi = idx & 15; float s = 0.f;
        for (int p = 0; p < 64; ++p) { const float ar = AP[(dl * 64 + p) * 2], ai = AP[(dl * 64 + p) * 2 + 1], br = BB[(p * 16 + hi) * 2], bi = BB[(p * 16 + hi) * 2 + 1];
            const float zr = ar * br - ai * bi, zi = ar * bi + ai * br; s += CC[(ho * 64 + p) * 2] * zr - CC[(ho * 64 + p) * 2 + 1] * zi; }
        if (dl == 0 && ho == hi) s += dd[ho];
        KT[idx] = s; }
    __syncthreads();
    for (int v = tid; v < 512 * 80; v += NTHR) { const int n = v / 80, kv = (v % 80) * 8, tau = n >> 4, ho = n & 15; float val[8];
        if (kv < 512) { const int sg = kv >> 4, hi0 = kv & 15;
#pragma unroll
            for (int e = 0; e < 8; ++e) val[e] = (tau >= sg) ? KT[((tau - sg) * 16 + ho) * 16 + hi0 + e] : 0.f; }
        else { const int kk = kv - 512;
#pragma unroll
            for (int e = 0; e < 8; ++e) { const int p = (kk + e) >> 1, ri = (kk + e) & 1; const float ar = AP[((tau + 1) * 64 + p) * 2], ai = AP[((tau + 1) * 64 + p) * 2 + 1], cre = CC[(ho * 64 + p) * 2], cim = CC[(ho * 64 + p) * 2 + 1];
                val[e] = ri == 0 ? (cre * ar - cim * ai) : -(cre * ai + cim * ar); } }
        u32x4 o; o.x = pk2(val[0], val[1]); o.y = pk2(val[2], val[3]); o.z = pk2(val[4], val[5]); o.w = pk2(val[6], val[7]);
        *(u32x4*)(BT + (size_t)n * SKY + kv) = o; }
    for (int v = tid; v < 256 * 64; v += NTHR) { const int n = v >> 6, kv = (v & 63) * 8; float val[8];
        if (n < 128) { const int p = n >> 1, ri = n & 1, sg = kv >> 4, hi0 = kv & 15; const float ar = AP[((31 - sg) * 64 + p) * 2], ai = AP[((31 - sg) * 64 + p) * 2 + 1];
#pragma unroll
            for (int e = 0; e < 8; ++e) { const float br = BB[(p * 16 + hi0 + e) * 2], bi = BB[(p * 16 + hi0 + e) * 2 + 1]; val[e] = ri == 0 ? (ar * br - ai * bi) : (ar * bi + ai * br); } }
        else {
#pragma unroll
            for (int e = 0; e < 8; ++e) val[e] = 0.f; }
        u32x4 o; o.x = pk2(val[0], val[1]); o.y = pk2(val[2], val[3]); o.z = pk2(val[4], val[5]); o.w = pk2(val[6], val[7]);
        *(u32x4*)(BW + (size_t)n * SKU + kv) = o; }
    __syncthreads();
}
__device__ __forceinline__ void p0_prologue(Frame& F) {
    if (F.vcu < SG) { for (int g = F.vcu; g < SG; g += F.G) ssm_gen(F, g); }
    LAS float* scr = (LAS float*)(F.lds + F.wave * 16384);
    const int gw = F.vcu * NWAVES + F.wave, NGW = F.G * NWAVES, lane = F.lane;
    constexpr int I_IN = 16 * 128, I_GLU = 8 * 16, I_US = 8 * 32, I_UA = 8 * 32, I_OUT = 16 * 32, I_W1 = 32 * 256, I_W3 = 32 * 256, I_W2 = 32 * 256;
    constexpr int NITEMS = I_IN + I_GLU + I_US + I_UA + I_OUT + I_W1 + I_W3 + I_W2;
    unsigned char* ws = F.ws;
    for (int it = gw; it < NITEMS; it += NGW) {
        int r = it;
        if (r < I_IN) { transpose_item(F.in[2], DIN, 64 * (r / 128), 32 * (r % 128), (bf16_t*)(ws + WS_WIN), 32 * (r % 128), D, scr, lane); continue; } r -= I_IN;
        if (r < I_GLU) { transpose_item(F.in[12], DS, 64 * (r / 16), 32 * (r % 16), (bf16_t*)(ws + WS_WGLU), 32 * (r % 16), DS, scr, lane); continue; } r -= I_GLU;
        if (r < I_US) { transpose_item(F.in[14], D, 64 * (r / 32), 32 * (r % 32), (bf16_t*)(ws + WS_WUS), 32 * (r % 32), DS, scr, lane); continue; } r -= I_US;
        if (r < I_UA) { transpose_item(F.in[15], D, 64 * (r / 32), 32 * (r % 32), (bf16_t*)(ws + WS_WUA), 32 * (r % 32), DA, scr, lane); continue; } r -= I_UA;
        if (r < I_OUT) { transpose_item(F.in[17], D, 64 * (r / 32), 32 * (r % 32), (bf16_t*)(ws + WS_WOUT), 32 * (r % 32), D, scr, lane); continue; } r -= I_OUT;
        if (r < I_W1 + I_W3) { const int w3 = r >= I_W1; if (w3) r -= I_W1; const int e = r >> 8, q = r & 255, k0 = 64 * (q / 16), n0 = 32 * (q % 16);
            transpose_item((w3 ? F.in[24] : F.in[23]) + (size_t)e * D * DE, DE, k0, n0, (bf16_t*)(ws + WS_W13), (size_t)e * 1024 + 256 * (n0 >> 7) + (n0 & 127) + (w3 ? 128 : 0), D, scr, lane); continue; }
        r -= I_W1 + I_W3;
        { const int e = r >> 8, q = r & 255, k0 = 64 * (q / 32), n0 = 32 * (q % 32);
            transpose_item(F.in[25] + (size_t)e * DE * D, D, k0, n0, (bf16_t*)(ws + WS_W2), (size_t)e * 1024 + n0, DE, scr, lane); }
    }
    for (int m = gw; m < T; m += NGW) rms_row_to_bf16(lane, F.in[0] + (size_t)m * D, F.in[1], (bf16_t*)(ws + WS_H1) + (size_t)m * D);
    { bf16_t* WR = (bf16_t*)(ws + WS_WR); const float* wrg = F.in[19]; const float* wre = F.in[21];
      for (int idx = F.vcu * NTHR + F.tid; idx < 256 * D; idx += F.G * NTHR) { const int r = idx >> 10, k = idx & 1023; unsigned o = 0u;
          if (r < 72) { const int c = r < 36 ? r : r - 36; const float w = c < 4 ? wrg[k * 4 + c] : wre[k * 32 + (c - 4)]; const unsigned hb = f2bf(w);
              o = r < 36 ? hb : f2bf(w - __builtin_bit_cast(float, hb << 16)); }
          WR[idx] = (bf16_t)o; } }
}

__device__ __forceinline__ int crow(int r, int hi) { return (r & 3) + 8 * (r >> 2) + 4 * hi; }
constexpr int KVP = 72;
__device__ __forceinline__ void kv_prep_phase(Frame& F) {
    LAS bf16_t* KS = (LAS bf16_t*)(F.lds); LAS bf16_t* VS = KS + 256 * KVP; LAS float* PS = (LAS float*)(F.lds + 2 * 256 * KVP * 2); LAS float* WM = PS + 512;
    const bf16_t* Kb = (const bf16_t*)(F.ws + WS_K); const bf16_t* Vb = (const bf16_t*)(F.ws + WS_V);
    bf16_t* Kf = (bf16_t*)(F.ws + WS_KFRAG); bf16_t* Vf = (bf16_t*)(F.ws + WS_VFRAG); bf16_t* KM = (bf16_t*)(F.ws + WS_KMEAN); float* KN = (float*)(F.ws + WS_KMEAN + 512 * 1024);
    const int tid = F.tid;
    for (int item = F.vcu; item < BATCH * NH * NBLK; item += F.G) {
        const int n = item & 31, h = (item >> 5) & 7, b = item >> 8; const size_t tok0 = (size_t)b * SEQ + 256 * n;
#pragma unroll
        for (int j = 0; j < 4; ++j) { const int q = tid + NTHR * j, row = q >> 3, pc = q & 7; const size_t src = (tok0 + row) * DA + h * HD + pc * 8;
            *(LAS u32x4*)(KS + row * KVP + pc * 8) = *(const u32x4*)(Kb + src); *(LAS u32x4*)(VS + row * KVP + pc * 8) = *(const u32x4*)(Vb + src); }
        __syncthreads();
#pragma unroll
        for (int j = 0; j < 4; ++j) { const int P = tid + NTHR * j, st = P >> 8, ds = (P >> 6) & 3, l2 = P & 63, row = 32 * st + (l2 & 31), col = 16 * ds + 8 * (l2 >> 5);
            *(u32x4*)(Kf + ((size_t)item * 2048 + P) * 8) = *(const LAS u32x4*)(KS + row * KVP + col); }
#pragma unroll
        for (int j = 0; j < 4; ++j) { const int P = tid + NTHR * j, st = P >> 8, ks = (P >> 7) & 1, d0 = (P >> 6) & 1, l2 = P & 63, hi = l2 >> 5, jj = l2 & 31; unsigned w[4];
#pragma unroll
            for (int e = 0; e < 8; e += 2) { const unsigned lo = VS[(32 * st + 16 * ks + crow(e, hi)) * KVP + 32 * d0 + jj], hi16 = VS[(32 * st + 16 * ks + crow(e + 1, hi)) * KVP + 32 * d0 + jj]; w[e >> 1] = lo | (hi16 << 16); }
            *(u32x4*)(Vf + ((size_t)item * 2048 + P) * 8) = (u32x4){w[0], w[1], w[2], w[3]}; }
        { const int d = tid & 63, part = tid >> 6; float s = 0.f;
#pragma unroll 8
          for (int r = 0; r < 32; ++r) s += bf2f(KS[(part * 32 + r) * KVP + d]);
          PS[part * 64 + d] = s; }
        if (tid < 256) { float ss = 0.f;
#pragma unroll
            for (int c = 0; c < 8; ++c) { const u32x4 w = *(const LAS u32x4*)(KS + tid * KVP + c * 8);
                ss += bflo(w.x) * bflo(w.x) + bfhi(w.x) * bfhi(w.x) + bflo(w.y) * bflo(w.y) + bfhi(w.y) * bfhi(w.y) + bflo(w.z) * bflo(w.z) + bfhi(w.z) * bfhi(w.z) + bflo(w.w) * bflo(w.w) + bfhi(w.w) * bfhi(w.w); }
            ss = wave_max(ss); if (F.lane == 0) WM[F.wave] = ss; }
        __syncthreads();
        if (tid < 64) { float s = 0.f;
#pragma unroll
            for (int p = 0; p < 8; ++p) s += PS[p * 64 + tid];
            KM[(size_t)item * 64 + tid] = (bf16_t)f2bf(s * (1.f / 256.f)); }
        if (tid == 0) KN[item] = fmaxf(fmaxf(WM[0], WM[1]), fmaxf(WM[2], WM[3]));
        __syncthreads();
    }
}

__device__ __forceinline__ void ssm_scan_phase(Frame& F) {
    LAS float* FW = (LAS float*)(F.lds);
    const float* E = (const float*)(F.ws + WS_E); bf16_t* UP = (bf16_t*)(F.ws + WS_UP);
    const int w = F.wave, p = F.lane;
    for (int gb = F.vcu; gb < SG * BATCH; gb += F.G) {
        const int g = gb >> 3, b = gb & 7;
        const float lr = F.in[4][g * SP + p], li = F.in[5][g * SP + p], step = __expf(F.in[6][g]);
        float ar, ai; cpow(lr, li, step, 32.f, ar, ai);
        const size_t row0 = (size_t)g * SROWS + b * 256 + 32 * w;
        f32x2 e[32];
#pragma unroll
        for (int j = 0; j < 32; ++j) e[j] = *(const f32x2*)(E + (row0 + j) * 128 + 2 * p);
        float sr = 0.f, si = 0.f;
#pragma unroll
        for (int j = 0; j < 32; ++j) { const float nr = ar * sr - ai * si + e[j].x, ni = ar * si + ai * sr + e[j].y; sr = nr; si = ni; }
        FW[(w * 64 + p) * 2] = sr; FW[(w * 64 + p) * 2 + 1] = si;
        __syncthreads();
        float Ar = ar, Ai = ai;
#pragma unroll
        for (int q = 0; q < 5; ++q) { const float nr = Ar * Ar - Ai * Ai, ni = 2.f * Ar * Ai; Ar = nr; Ai = ni; }
        sr = 0.f; si = 0.f;
        for (int w2 = 0; w2 < w; ++w2) { const float fr = FW[(w2 * 64 + p) * 2], fi = FW[(w2 * 64 + p) * 2 + 1]; const float nr = Ar * sr - Ai * si + fr, ni = Ar * si + Ai * sr + fi; sr = nr; si = ni; }
#pragma unroll
        for (int j = 0; j < 32; ++j) { *(unsigned*)(UP + (row0 + j) * SKY + SKU + 2 * p) = pk2(sr, si);
            const float nr = ar * sr - ai * si + e[j].x, ni = ar * si + ai * sr + e[j].y; sr = nr; si = ni; }
        __syncthreads();
    }
}

constexpr int AQS = 0, AOACC = 36864, ALACC = 102400, AMQ = 103424, AKME = 104448, ALIST = 109056, ACNT = 117248, ATST = 117376, AMISC = 117632, ATAB = 117760;
static_assert(ATAB + 8 * 132 * 4 <= RING_BYTES, "attention LDS");
__device__ __forceinline__ void lds_add_f32(unsigned addr, float v) { asm volatile("ds_add_f32 %0, %1" :: "v"(addr), "v"(v) : "memory"); }
__device__ __forceinline__ int t5_bucket(int d) {
    if (d < 16) return d;
    return 16 + (d >= 19) + (d >= 21) + (d >= 24) + (d >= 27) + (d >= 31) + (d >= 35) + (d >= 40) + (d >= 46) + (d >= 52) + (d >= 59) + (d >= 67) + (d >= 77) + (d >= 87) + (d >= 99) + (d >= 113);
}
struct Top3 { float v0, v1, v2; int i0, i1, i2; };
__device__ __forceinline__ Top3 top3_insert(Top3 t, float x, int n) {
    const bool b0 = (x > t.v0) || (x == t.v0 && n < t.i0), b1 = (x > t.v1) || (x == t.v1 && n < t.i1), b2 = (x > t.v2) || (x == t.v2 && n < t.i2);
    Top3 r;
    r.v2 = b1 ? t.v1 : (b2 ? x : t.v2); r.i2 = b1 ? t.i1 : (b2 ? n : t.i2);
    r.v1 = b0 ? t.v0 : (b1 ? x : t.v1); r.i1 = b0 ? t.i0 : (b1 ? n : t.i1);
    r.v0 = b0 ? x : t.v0; r.i0 = b0 ? n : t.i0;
    return r;
}
__device__ __forceinline__ void attn_unit(Frame& F, int bh, int qb) {
    LAS unsigned char* L = F.lds;
    LAS bf16_t* QS = (LAS bf16_t*)(L + AQS); LAS float* OACC = (LAS float*)(L + AOACC); LAS float* LACC = (LAS float*)(L + ALACC); LAS float* MQ = (LAS float*)(L + AMQ);
    LAS bf16_t* KME = (LAS bf16_t*)(L + AKME); LAS unsigned char* LIST = L + ALIST; LAS int* CNT = (LAS int*)(L + ACNT); LAS int* TST = (LAS int*)(L + ATST);
    LAS int* NEXT = (LAS int*)(L + AMISC); LAS float* KNM = (LAS float*)(L + AMISC + 16); LAS float* TAB = (LAS float*)(L + ATAB);
    const int tid = F.tid, lane = F.lane, w = F.wave, j = lane & 31, hi = lane >> 5;
    const int b = bh >> 3, h = bh & 7; const size_t tok0 = (size_t)b * SEQ + 256 * qb;
    const bf16_t* Qb = (const bf16_t*)(F.ws + WS_Q); const bf16_t* KM = (const bf16_t*)(F.ws + WS_KMEAN); const float* KN = (const float*)(F.ws + WS_KMEAN + 512 * 1024);
    const bf16_t* Kfb = (const bf16_t*)(F.ws + WS_KFRAG) + (size_t)bh * 32 * 2048 * 8; const bf16_t* Vfb = (const bf16_t*)(F.ws + WS_VFRAG) + (size_t)bh * 32 * 2048 * 8;
    bf16_t* YA = (bf16_t*)(F.ws + WS_YATT);
    const LAS float* TABh = TAB + h * 132;
    for (int i = tid; i < 256 * 64 / 4; i += NTHR) ((LAS f32x4*)OACC)[i] = (f32x4){0.f, 0.f, 0.f, 0.f};
    if (tid < 256) LACC[tid] = 0.f;
#pragma unroll
    for (int jj = 0; jj < 4; ++jj) { const int q = tid + NTHR * jj, row = q >> 3, pc = q & 7; *(LAS u32x4*)(QS + row * KVP + pc * 8) = *(const u32x4*)(Qb + (tok0 + row) * DA + h * HD + pc * 8); }
    if (tid < 256) { const int n = tid >> 3, pc = tid & 7; *(LAS u32x4*)(KME + n * KVP + pc * 8) = *(const u32x4*)(KM + ((size_t)bh * 32 + n) * 64 + pc * 8); }
    if (tid < 32) CNT[tid] = 0;
    if (tid == 0) NEXT[0] = 0;
    if (w == 1) { float v = (lane <= qb && lane < 32) ? KN[bh * 32 + lane] : 0.f; v = wave_max(v); if (lane == 0) KNM[0] = v; }
    __syncthreads();
    {
        bf16x8 qf[4], kmf[4];
#pragma unroll
        for (int ds = 0; ds < 4; ++ds) { qf[ds] = *(const LAS bf16x8*)(QS + (32 * w + j) * KVP + 16 * ds + 8 * hi); kmf[ds] = *(const LAS bf16x8*)(KME + j * KVP + 16 * ds + 8 * hi); }
        f32x16 gt = {};
#pragma unroll
        for (int ds = 0; ds < 4; ++ds) gt = __builtin_amdgcn_mfma_f32_32x32x16_bf16(kmf[ds], qf[ds], gt, 0, 0, 0);
        float qn = 0.f;
#pragma unroll
        for (int ds = 0; ds < 4; ++ds)
#pragma unroll
            for (int e = 0; e < 8; ++e) { const float x = bf2f((unsigned short)qf[ds][e]); qn += x * x; }
        qn += __shfl_xor(qn, 32);
        const float m2 = sqrtf(qn * KNM[0]) + TABh[128];
        if (hi == 0) MQ[32 * w + j] = m2;
        Top3 t3; t3.v0 = t3.v1 = t3.v2 = -INFINITY; t3.i0 = t3.i1 = t3.i2 = -1;
#pragma unroll
        for (int r = 0; r < 16; ++r) { const int n = crow(r, hi); const float x = (n < qb) ? gt[r] : -INFINITY; t3 = top3_insert(t3, x, x > -INFINITY ? n : 0x7fffffff); }
        { const float p0 = __shfl_xor(t3.v0, 32), p1 = __shfl_xor(t3.v1, 32), p2 = __shfl_xor(t3.v2, 32); const int q0 = __shfl_xor(t3.i0, 32), q1 = __shfl_xor(t3.i1, 32), q2 = __shfl_xor(t3.i2, 32);
          t3 = top3_insert(t3, p0, q0 >= 0 ? q0 : 0x7fffffff); t3 = top3_insert(t3, p1, q1 >= 0 ? q1 : 0x7fffffff); t3 = top3_insert(t3, p2, q2 >= 0 ? q2 : 0x7fffffff); }
        const int i0 = t3.v0 > -INFINITY ? t3.i0 : -1, i1 = t3.v1 > -INFINITY ? t3.i1 : -1, i2 = t3.v2 > -INFINITY ? t3.i2 : -1;
        if (hi == 0) {
            if (i0 >= 0) { const int pos = __hip_atomic_fetch_add(CNT + i0, 1, __ATOMIC_RELAXED, __HIP_MEMORY_SCOPE_WORKGROUP); LIST[i0 * 256 + pos] = (unsigned char)(32 * w + j); }
            if (i1 >= 0) { const int pos = __hip_atomic_fetch_add(CNT + i1, 1, __ATOMIC_RELAXED, __HIP_MEMORY_SCOPE_WORKGROUP); LIST[i1 * 256 + pos] = (unsigned char)(32 * w + j); }
            if (i2 >= 0) { const int pos = __hip_atomic_fetch_add(CNT + i2, 1, __ATOMIC_RELAXED, __HIP_MEMORY_SCOPE_WORKGROUP); LIST[i2 * 256 + pos] = (unsigned char)(32 * w + j); }
        }
    }
    __syncthreads();
    if (w == 0) { int nt = (lane < qb && lane < 32) ? ((CNT[lane] + 31) >> 5) : 0; int inc = nt;
#pragma unroll
        for (int o = 1; o < 32; o <<= 1) { const int t = __shfl_up(inc, o); if (lane >= o) inc += t; }
        if (lane < 32) TST[lane + 1] = inc; if (lane == 0) TST[0] = 0; }
    __syncthreads();
    const int NTsel = TST[32], NI = NTsel + 8;
    const float b31 = TABh[129];
    for (;;) {
        int it = 0; if (lane == 0) it = __hip_atomic_fetch_add(NEXT, 1, __ATOMIC_RELAXED, __HIP_MEMORY_SCOPE_WORKGROUP);
        it = __builtin_amdgcn_readfirstlane(it);
        if (it >= NI) break;
        int kvblk, ste, ql, dq; bool nearm;
        if (it < NTsel) {
            const int e1 = (lane < 32) ? TST[lane + 1] : 0x7fffffff;
            const int n = __builtin_amdgcn_readfirstlane((int)__popcll(__ballot(e1 <= it)));
            const int chunk = it - __builtin_amdgcn_readfirstlane(TST[n]); const int cn = __builtin_amdgcn_readfirstlane(CNT[n]); const int idx = chunk * 32 + j;
            ql = idx < cn ? (int)LIST[n * 256 + idx] : -1; nearm = (n == qb - 1); dq = 256 + ql; ste = 8; kvblk = n;
        } else { const int w2 = 7 - (it - NTsel); ql = 32 * w2 + j; nearm = true; dq = ql; ste = w2 + 1; kvblk = qb; }
        const int qa = ql >= 0 ? ql : 0;
        bf16x8 qf[4];
#pragma unroll
        for (int ds = 0; ds < 4; ++ds) qf[ds] = *(const LAS bf16x8*)(QS + qa * KVP + 16 * ds + 8 * hi);
        const float m2 = ql >= 0 ? MQ[qa] : INFINITY; const float mfar = m2 - b31;
        const bf16_t* Kf = Kfb + ((size_t)kvblk * 2048 + lane) * 8; const bf16_t* Vf = Vfb + ((size_t)kvblk * 2048 + lane) * 8;
        f32x16 o0 = {}, o1 = {}; float lsum = 0.f;
        for (int st = 0; st < ste; ++st) {
            bf16x8 kf[4], vf[4];
#pragma unroll
            for (int ds = 0; ds < 4; ++ds) kf[ds] = *(const bf16x8*)(Kf + (st * 4 + ds) * 512);
#pragma unroll
            for (int q = 0; q < 4; ++q) vf[q] = *(const bf16x8*)(Vf + (st * 4 + q) * 512);
            f32x16 s = {};
#pragma unroll
            for (int ds = 0; ds < 4; ++ds) s = __builtin_amdgcn_mfma_f32_32x32x16_bf16(kf[ds], qf[ds], s, 0, 0, 0);
            float p[16];
            if (!nearm) {
#pragma unroll
                for (int r = 0; r < 16; ++r) p[r] = __builtin_amdgcn_exp2f(s[r] - mfar);
            } else {
#pragma unroll
                for (int r = 0; r < 16; ++r) { const int dist = dq - (32 * st + crow(r, hi)); const int di = dist < 0 ? 0 : (dist > 127 ? 127 : dist);
                    const float e = __builtin_amdgcn_exp2f(s[r] + TABh[di] - m2); p[r] = dist >= 0 ? e : 0.f; }
            }
#pragma unroll
            for (int r = 0; r < 16; ++r) lsum += p[r];
            u32x4 pa, pb; pa.x = cvt_pk_bf16(p[0], p[1]); pa.y = cvt_pk_bf16(p[2], p[3]); pa.z = cvt_pk_bf16(p[4], p[5]); pa.w = cvt_pk_bf16(p[6], p[7]);
            pb.x = cvt_pk_bf16(p[8], p[9]); pb.y = cvt_pk_bf16(p[10], p[11]); pb.z = cvt_pk_bf16(p[12], p[13]); pb.w = cvt_pk_bf16(p[14], p[15]);
            const bf16x8 A0 = __builtin_bit_cast(bf16x8, pa), A1 = __builtin_bit_cast(bf16x8, pb);
            o0 = __builtin_amdgcn_mfma_f32_32x32x16_bf16(A0, vf[0], o0, 0, 0, 0); o1 = __builtin_amdgcn_mfma_f32_32x32x16_bf16(A0, vf[1], o1, 0, 0, 0);
            o0 = __builtin_amdgcn_mfma_f32_32x32x16_bf16(A1, vf[2], o0, 0, 0, 0); o1 = __builtin_amdgcn_mfma_f32_32x32x16_bf16(A1, vf[3], o1, 0, 0, 0);
        }
        const float lt = lsum + __shfl_xor(lsum, 32);
        if (hi == 0 && ql >= 0) lds_add_f32((unsigned)(uintptr_t)(LACC + ql), lt);
#pragma unroll
        for (int r = 0; r < 16; ++r) { const int qrow = __shfl(ql, crow(r, hi));
            if (qrow >= 0) { const unsigned a = (unsigned)(uintptr_t)(OACC + qrow * 64 + j); lds_add_f32(a, o0[r]); lds_add_f32(a + 128u, o1[r]); } }
    }
    LDS_WAIT();
    __syncthreads();
    { const int ql = tid >> 1, half = tid & 1; const float inv = 1.f / LACC[ql]; const LAS f32x4* src = (const LAS f32x4*)(OACC + ql * 64 + 32 * half);
      bf16_t* dst = YA + (tok0 + ql) * DA + h * HD + 32 * half;
#pragma unroll
      for (int c = 0; c < 4; ++c) { const f32x4 a = src[2 * c] * inv, bq = src[2 * c + 1] * inv; *(u32x4*)(dst + 8 * c) = pack8(a, bq); } }
    __syncthreads();
}
__device__ __forceinline__ void attn_phase(Frame& F) {
    LAS float* TAB = (LAS float*)(F.lds + ATAB); const float* rb = F.in[16];
    for (int idx = F.tid; idx < 8 * 132; idx += NTHR) { const int h = idx / 132, d = idx % 132; float v = 0.f;
        if (d < 128) v = rb[h * 32 + t5_bucket(d)] * LOG2E;
        else if (d == 128) { float m = rb[h * 32]; for (int q = 1; q < 32; ++q) m = fmaxf(m, rb[h * 32 + q]); v = m * LOG2E; }
        else if (d == 129) v = rb[h * 32 + 31] * LOG2E;
        TAB[idx] = v; }
    __syncthreads();
    for (int quad = F.vcu; quad < 256; quad += F.G) { const int bh = quad >> 2, s = quad & 3;
        for (int i = 0; i < 8; ++i) { const int base = (i >> 1) * 8; const int qb = (i & 1) ? base + 7 - s : base + s; attn_unit(F, bh, qb); } }
}

__device__ __forceinline__ void routing_phase(Frame& F) {
    LAS int* lcnt = (LAS int*)(F.lds); LAS int* lbase = lcnt + 32;
    const float* SSQ = (const float*)(F.ws + WS_SSQ); const float* RL = (const float*)(F.ws + WS_RLOG);
    unsigned* rowtok = (unsigned*)(F.ws + WS_ROWTOK); float* rowcoef = (float*)(F.ws + WS_ROWCOEF); float* rowrstd = (float*)(F.ws + WS_ROWRSTD);
    unsigned* ecnt = (unsigned*)(F.ctl + CW_ECNT);
    const float* brg = F.in[20]; const float* bre = F.in[22];
    const int tid = F.tid;
    for (int base = F.vcu * 256; base < T; base += F.G * 256) {
        if (tid < 32) lcnt[tid] = 0;
        __syncthreads();
        int e0 = 0, e1 = 0, lp0 = 0, lp1 = 0; float c0 = 0.f, c1 = 0.f, rstd = 0.f; const int tok = base + tid;
        if (tid < 256) {
            float ss = 0.f;
#pragma unroll
            for (int q = 0; q < 4; ++q) { const f32x4 v = *(const f32x4*)(SSQ + (size_t)tok * 16 + 4 * q); ss += (v.x + v.y) + (v.z + v.w); }
            rstd = 1.f / sqrtf(ss * (1.f / D) + RMS_EPS);
            float r[72];
#pragma unroll
            for (int q = 0; q < 18; ++q) { const f32x4 v = *(const f32x4*)(RL + (size_t)tok * 72 + 4 * q); r[4 * q] = v.x; r[4 * q + 1] = v.y; r[4 * q + 2] = v.z; r[4 * q + 3] = v.w; }
            float gl[4], el[32];
#pragma unroll
            for (int c = 0; c < 4; ++c) gl[c] = rstd * (r[c] + r[36 + c]) + brg[c];
#pragma unroll
            for (int c = 0; c < 32; ++c) el[c] = rstd * (r[4 + c] + r[40 + c]) + bre[c];
            int gi = 0; float gm = gl[0];
#pragma unroll
            for (int c = 1; c < 4; ++c) if (gl[c] > gm) { gm = gl[c]; gi = c; }
            float Z = 0.f;
#pragma unroll
            for (int c = 0; c < 4; ++c) Z += __expf(gl[c] - gm);
            const float gval = 1.f / Z;
            float es[8];
#pragma unroll
            for (int q = 0; q < 8; ++q) es[q] = gi == 0 ? el[q] : (gi == 1 ? el[8 + q] : (gi == 2 ? el[16 + q] : el[24 + q]));
            int a0 = 0; float m0 = es[0];
#pragma unroll
            for (int q = 1; q < 8; ++q) if (es[q] > m0) { m0 = es[q]; a0 = q; }
            int a1 = -1; float m1 = -INFINITY;
#pragma unroll
            for (int q = 0; q < 8; ++q) if (q != a0 && es[q] > m1) { m1 = es[q]; a1 = q; }
            const float w0 = 1.f / (1.f + __expf(m1 - m0)), w1 = 1.f - w0;
            e0 = gi * 8 + a0; e1 = gi * 8 + a1; c0 = gval * w0; c1 = gval * w1;
            lp0 = __hip_atomic_fetch_add(lcnt + e0, 1, __ATOMIC_RELAXED, __HIP_MEMORY_SCOPE_WORKGROUP);
            lp1 = __hip_atomic_fetch_add(lcnt + e1, 1, __ATOMIC_RELAXED, __HIP_MEMORY_SCOPE_WORKGROUP);
        }
        __syncthreads();
        if (tid < 32) lbase[tid] = (int)__hip_atomic_fetch_add(ecnt + tid, (unsigned)lcnt[tid], __ATOMIC_RELAXED, __HIP_MEMORY_SCOPE_AGENT);
        __syncthreads();
        if (tid < 256) {
            const size_t i0 = (size_t)e0 * ROWCAP + lbase[e0] + lp0, i1 = (size_t)e1 * ROWCAP + lbase[e1] + lp1;
            rowtok[i0] = (unsigned)tok * 2u; rowcoef[i0] = c0; rowrstd[i0] = rstd;
            rowtok[i1] = (unsigned)tok * 2u + 1u; rowcoef[i1] = c1; rowrstd[i1] = rstd;
        }
        __syncthreads();
    }
}
struct MoeOrder {
    const LAS int* tst; int total, G, v;
    __device__ bool next(int i, pg8::Unit& u) const {
        const int L = i * G + v; if (L >= total) return false;
        const int rt = L >> 2; int e = 0;
#pragma unroll 8
        for (int q = 1; q <= 32; ++q) e += (tst[q] <= rt) ? 1 : 0;
        u.pm = rt; u.pn = L & 3; u.pb = e * 4 + u.pn; u.aux = e; u.aux2 = (rt - tst[e]) * 256; return true;
    }
};
__device__ __forceinline__ void moe_tables(Frame& F) {
    LAS int* tst = (LAS int*)(F.lds + MOE_TST_OFF); const unsigned* ecnt = (const unsigned*)(F.ctl + CW_ECNT);
    if (F.wave == 0) { const int lane = F.lane; int nt = lane < 32 ? (int)((ecnt[lane & 31] + 255u) >> 8) : 0; int inc = nt;
#pragma unroll
        for (int o = 1; o < 32; o <<= 1) { const int t = __shfl_up(inc, o); if (lane >= o) inc += t; }
        if (lane < 32) tst[lane + 1] = inc; if (lane == 0) tst[0] = 0; }
    __syncthreads();
}
__device__ __forceinline__ void final_phase(Frame& F) {
    const float* X1 = (const float*)(F.ws + WS_X1); const bf16_t* Y0 = (const bf16_t*)(F.ws + WS_Y0); const bf16_t* Y1 = (const bf16_t*)(F.ws + WS_Y1); const float* gf = F.in[26];
    const int gw = F.vcu * NWAVES + F.wave, NGW = F.G * NWAVES, lane = F.lane;
    for (int m = gw; m < T; m += NGW) {
        const f32x4* xr = (const f32x4*)(X1 + (size_t)m * D) + lane; const u32x2* y0 = (const u32x2*)(Y0 + (size_t)m * D) + lane; const u32x2* y1 = (const u32x2*)(Y1 + (size_t)m * D) + lane;
        f32x4 v[4]; float s = 0.f;
#pragma unroll
        for (int j = 0; j < 4; ++j) { v[j] = xr[64 * j]; const u32x2 a = y0[64 * j], c = y1[64 * j];
            v[j].x += bflo(a.x) + bflo(c.x); v[j].y += bfhi(a.x) + bfhi(c.x); v[j].z += bflo(a.y) + bflo(c.y); v[j].w += bfhi(a.y) + bfhi(c.y);
            s += (v[j].x * v[j].x + v[j].y * v[j].y) + (v[j].z * v[j].z + v[j].w * v[j].w); }
        const float rstd = 1.f / sqrtf(wave_sum(s) * (1.f / D) + RMS_EPS);
        f32x4* o = (f32x4*)(F.out + (size_t)m * D) + lane; const f32x4* gr = (const f32x4*)gf + lane;
#pragma unroll
        for (int j = 0; j < 4; ++j) o[64 * j] = v[j] * rstd * gr[64 * j];
    }
}
#ifndef MK_N_LAUNCHES
#define MK_N_LAUNCHES 13
#endif
constexpr int NPHASE = 13;
struct Args { const float* in[27]; float* out; unsigned char* ws; int ph_lo, ph_hi; };
static_assert(sizeof(Args) == 27 * 8 + 8 + 8 + 8, "Args has no padding");

__global__ void __launch_bounds__(NTHR, 2) fwd_kernel(Args args) {
    extern __shared__ __attribute__((aligned(16))) unsigned char lds_raw[];
    Frame F;
    F.lds = (LAS unsigned char*)lds_raw;
    F.MISC = (volatile LAS unsigned*)(F.lds + MISC_OFF);
    F.tid = threadIdx.x; F.lane = F.tid & 63; F.wave = __builtin_amdgcn_readfirstlane(F.tid >> 6);
    F.G = gridDim.x; { const int bx = blockIdx.x; F.vcu = (F.G % 8 == 0) ? (bx % 8) * (F.G / 8) + bx / 8 : bx; }
    F.ws = args.ws; F.ctl = (gu32*)(args.ws + WS_CTL); F.out = args.out;
#pragma unroll
    for (int i = 0; i < 27; ++i) F.in[i] = args.in[i];
    for (int u = F.tid; u < (LDS_BYTES - MOE_TST_OFF) / 4; u += NTHR) ((LAS unsigned*)(F.lds + MOE_TST_OFF))[u] = 0u;
    __syncthreads();
    XcdBarrier bar; bar.bar = (unsigned*)(F.ctl + CW_BAR); bar.x = 0; bar.st = nullptr;
    const int lo = args.ph_lo, hi = args.ph_hi;
    if (hi - lo > 1) bar = xcd_barrier_post((unsigned*)(F.ctl + CW_BAR), F.MISC + 8);
#define IN(k) (lo <= (k) && (k) < hi)
#define SEAM(k) do { if (IN(k) && IN((k) + 1)) xcd_barrier(bar); } while (0)
    unsigned char* ws = args.ws;
    LAS unsigned char* ring = F.lds;

    if (IN(0)) { p0_prologue(F); }
    SEAM(0);
    if (IN(1)) {
        pg8::Gemm g{(const bf16_t*)(ws + WS_H1), (const bf16_t*)(ws + WS_WIN), D, D, D}; pg8::StaticOrder S; S.init(T, DIN, F.G, (int)blockIdx.x);
        EpiProj E{ws, F.in[3]};
        pg8::gemm_phase<EpiProj, pg8::StaticOrder, true, false>(ring, g, S, E, nullptr);
    }
    SEAM(1);
    if (IN(2)) {
        { pg8::Gemm g{(const bf16_t*)(ws + WS_UP), (const bf16_t*)(ws + WS_SSMW), SKY, SKU, SKU}; pg8::GroupedOrder S; S.init(SG * 8, 1, 8, F.G, F.vcu);
          EpiSsmE E{(float*)(ws + WS_E)};
          pg8::gemm_phase<EpiSsmE, pg8::GroupedOrder, false, false>(ring, g, S, E, nullptr); }
        __syncthreads();
        kv_prep_phase(F);
    }
    SEAM(2);
    if (IN(3)) { ssm_scan_phase(F); attn_phase(F); }
    SEAM(3);
    if (IN(4)) {
        pg8::Gemm g{(const bf16_t*)(ws + WS_UP), (const bf16_t*)(ws + WS_SSMT), SKY, SKY, SKY}; pg8::GroupedOrder S; S.init(SG * 8, 2, 8, F.G, F.vcu);
        EpiSsmY E{(bf16_t*)(ws + WS_GACT)};
        pg8::gemm_phase<EpiSsmY, pg8::GroupedOrder, true, false>(ring, g, S, E, nullptr);
    }
    SEAM(4);
    if (IN(5)) {
        pg8::Gemm g{(const bf16_t*)(ws + WS_GACT), (const bf16_t*)(ws + WS_WGLU), DS, DS, DS}; pg8::StaticOrder S; S.init(T, DS, F.G, (int)blockIdx.x);
        EpiGlu E{(const bf16_t*)(ws + WS_GACT), (bf16_t*)(ws + WS_YSSM), F.in[13]};
        pg8::gemm_phase<EpiGlu, pg8::StaticOrder, true, false>(ring, g, S, E, nullptr);
    }
    SEAM(5);
    if (IN(6)) {
        { pg8::Gemm g{(const bf16_t*)(ws + WS_YSSM), (const bf16_t*)(ws + WS_WUS), DS, DS, DS}; pg8::StaticOrder S; S.init(T, D, F.G, (int)blockIdx.x);
          EpiUp<false> E{(const bf16_t*)(ws + WS_SGS), (bf16_t*)(ws + WS_MRG)};
          pg8::gemm_phase<EpiUp<false>, pg8::StaticOrder, true, false>(ring, g, S, E, nullptr); }
        VM_WAIT(); __syncthreads();
        { pg8::Gemm g{(const bf16_t*)(ws + WS_YATT), (const bf16_t*)(ws + WS_WUA), DA, DA, DA}; pg8::StaticOrder S; S.init(T, D, F.G, (int)blockIdx.x);
          EpiUp<true> E{(const bf16_t*)(ws + WS_SGA), (bf16_t*)(ws + WS_MRG)};
          pg8::gemm_phase<EpiUp<true>, pg8::StaticOrder, true, false>(ring, g, S, E, nullptr); }
    }
    SEAM(6);
    if (IN(7)) {
        pg8::Gemm g{(const bf16_t*)(ws + WS_MRG), (const bf16_t*)(ws + WS_WOUT), D, D, D}; pg8::StaticOrder S; S.init(T, D, F.G, (int)blockIdx.x);
        EpiOut E{F.in[0], (float*)(ws + WS_X1), (bf16_t*)(ws + WS_XG), F.in[18], (float*)(ws + WS_SSQ)};
        pg8::gemm_phase<EpiOut, pg8::StaticOrder, true, false>(ring, g, S, E, nullptr);
    }
    SEAM(7);
    if (IN(8)) {
        pg8::Gemm g{(const bf16_t*)(ws + WS_XG), (const bf16_t*)(ws + WS_WR), D, D, D}; pg8::StaticOrder S; S.init(T, 256, F.G, (int)blockIdx.x);
        EpiRouter E{(float*)(ws + WS_RLOG)};
        pg8::gemm_phase<EpiRouter, pg8::StaticOrder, false, false>(ring, g, S, E, nullptr);
    }
    SEAM(8);
    if (IN(9)) { routing_phase(F); }
    SEAM(9);
    if (IN(10)) {
        moe_tables(F);
        const LAS int* tst = (const LAS int*)(F.lds + MOE_TST_OFF);
        MoeOrder S{tst, tst[32] * 4, F.G, F.vcu};
        LAS unsigned* rowtab = (LAS unsigned*)(F.lds + ROWTAB_OFF);
        { const unsigned* rowtok = (const unsigned*)(ws + WS_ROWTOK); const unsigned* ecnt = (const unsigned*)(F.ctl + CW_ECNT); pg8::Unit u;
          for (int i = 0; i < ROWTAB_UNITS && S.next(i, u); ++i) { if (F.tid < 256) { const int pos = u.aux2 + F.tid; const unsigned tk = pos < (int)ecnt[u.aux] ? (rowtok[(size_t)u.aux * ROWCAP + pos] >> 1) : 0u; rowtab[i * 256 + F.tid] = tk * (unsigned)(D * 2); } } }
        __syncthreads();
        pg8::Gemm g{(const bf16_t*)(ws + WS_XG), (const bf16_t*)(ws + WS_W13), D, D, D};
        EpiMoe1 E{(bf16_t*)(ws + WS_HID), (const float*)(ws + WS_ROWRSTD), (const unsigned*)(F.ctl + CW_ECNT)};
        pg8::gemm_phase<EpiMoe1, MoeOrder, true, true>(ring, g, S, E, rowtab);
    }
    SEAM(10);
    if (IN(11)) {
        moe_tables(F);
        const LAS int* tst = (const LAS int*)(F.lds + MOE_TST_OFF);
        MoeOrder S{tst, tst[32] * 4, F.G, F.vcu};
        pg8::Gemm g{(const bf16_t*)(ws + WS_HID), (const bf16_t*)(ws + WS_W2), DE, DE, DE};
        EpiMoe2 E{(bf16_t*)(ws + WS_Y0), (size_t)(WS_Y1 - WS_Y0), (const unsigned*)(ws + WS_ROWTOK), (const float*)(ws + WS_ROWCOEF), (const unsigned*)(F.ctl + CW_ECNT)};
        pg8::gemm_phase<EpiMoe2, MoeOrder, true, false>(ring, g, S, E, nullptr);
    }
    SEAM(11);
    if (IN(12)) { final_phase(F); }
#undef IN
#undef SEAM
}

extern "C" void kernel_launch(void* const* d_in, const int* in_sizes, int n_in, void* d_out, int out_size, void* d_ws, size_t ws_size, hipStream_t stream) {
    static int grid = 0;
    if (grid == 0) {
        if (n_in != 27 || in_sizes[0] != T * D || out_size != T * D || ws_size < WS_END) { fprintf(stderr, "kernel_launch: unexpected shapes (n_in %d, in0 %d, out %d, ws %zu)\n", n_in, n_in > 0 ? in_sizes[0] : -1, out_size, ws_size); grid = -1; return; }
        int dev = 0, cus = 0;
        if (hipGetDevice(&dev) != hipSuccess || hipDeviceGetAttribute(&cus, hipDeviceAttributeMultiprocessorCount, dev) != hipSuccess) { grid = -1; return; }
        if (hipFuncSetAttribute((const void*)fwd_kernel, hipFuncAttributeMaxDynamicSharedMemorySize, LDS_BYTES) != hipSuccess) { fprintf(stderr, "kernel_launch: hipFuncSetAttribute failed\n"); grid = -1; return; }
        (void)hipGetLastError();
        grid = cus;
    }
    if (grid < 0) return;
    (void)hipMemsetAsync((char*)d_ws + WS_CTL, 0, CTL_ZERO_BYTES, stream);
    Args a{};
    for (int i = 0; i < 27; ++i) a.in[i] = (const float*)d_in[i];
    a.out = (float*)d_out; a.ws = (unsigned char*)d_ws;
    if (MK_N_LAUNCHES == 1) { a.ph_lo = 0; a.ph_hi = NPHASE; hipLaunchKernelGGL(fwd_kernel, dim3(grid), dim3(NTHR), LDS_BYTES, stream, a); }
    else { for (int p = 0; p < NPHASE; ++p) { a.ph_lo = p; a.ph_hi = p + 1; hipLaunchKernelGGL(fwd_kernel, dim3(grid), dim3(NTHR), LDS_BYTES, stream, a); } }
}
```

```cpp
#include <hip/hip_runtime.h>
#include <cstdio>
#include <cstdint>

#define LAS __attribute__((address_space(3)))
#define GAS __attribute__((address_space(1)))
typedef unsigned short bf16_t;
typedef short bf16x8 __attribute__((ext_vector_type(8)));
typedef float f32x2 __attribute__((ext_vector_type(2)));
typedef float f32x4 __attribute__((ext_vector_type(4)));
typedef float f32x16 __attribute__((ext_vector_type(16)));
typedef unsigned u32x2 __attribute__((ext_vector_type(2)));
typedef unsigned u32x4 __attribute__((ext_vector_type(4)));
typedef GAS unsigned gu32;
#define RLX_AGENT __ATOMIC_RELAXED, __HIP_MEMORY_SCOPE_AGENT
#define LDS_WAIT() asm volatile("s_waitcnt lgkmcnt(0)" ::: "memory")
#define VM_WAIT() asm volatile("s_waitcnt vmcnt(0)" ::: "memory")

__device__ __forceinline__ unsigned f2bf(float f) { unsigned u = __builtin_bit_cast(unsigned, f); return (u + 0x7fffu + ((u >> 16) & 1u)) >> 16; }
__device__ __forceinline__ unsigned pk2(float lo, float hi) { return f2bf(lo) | (f2bf(hi) << 16); }
__device__ __forceinline__ float bf2f(unsigned short b) { return __builtin_bit_cast(float, (unsigned)b << 16); }
__device__ __forceinline__ float bflo(unsigned w) { return __builtin_bit_cast(float, w << 16); }
__device__ __forceinline__ float bfhi(unsigned w) { return __builtin_bit_cast(float, w & 0xffff0000u); }
__device__ __forceinline__ unsigned cvt_pk_bf16(float lo, float hi) { unsigned r; asm volatile("v_cvt_pk_bf16_f32 %0, %1, %2" : "=v"(r) : "v"(lo), "v"(hi)); return r; }
__device__ __forceinline__ float fast_sigmoid(float x) { return __builtin_amdgcn_rcpf(1.f + __builtin_amdgcn_exp2f(-1.4426950408889634f * x)); }
__device__ __forceinline__ float wave_sum(float v) {
#pragma unroll
    for (int o = 1; o < 64; o <<= 1) v += __shfl_xor(v, o);
    return v;
}
__device__ __forceinline__ float wave_max(float v) {
#pragma unroll
    for (int o = 1; o < 64; o <<= 1) v = fmaxf(v, __shfl_xor(v, o));
    return v;
}

#define XB_TMO      128
#define XB_XCNT(j)  (256  + 64 * (j))
#define XB_XSUB(j)  (1280 + 64 * (j))
#define XB_XGEN(j)  (2304 + 64 * (j))
#define XB_TOP      3328
#define XB_TOPGEN   3392
#define XCD_BAR_WORDS 3456
#define XB_SPIN_CAP (1u << 20)

__device__ __forceinline__ unsigned xb_ld(unsigned* p)              { return __hip_atomic_load(p, __ATOMIC_RELAXED, __HIP_MEMORY_SCOPE_AGENT); }
__device__ __forceinline__ unsigned xb_add(unsigned* p, unsigned v) { return __hip_atomic_fetch_add(p, v, __ATOMIC_RELAXED, __HIP_MEMORY_SCOPE_AGENT); }
__device__ __forceinline__ unsigned xb_xcc_id() { return (unsigned)__builtin_amdgcn_s_getreg((3 << 11) | 20) & 0xFu; }
#define XB_SPIN(cond, bar) do { unsigned _sp = 0; while (cond) { __builtin_amdgcn_s_sleep(1); \
    if ((++_sp & 255u) == 0u) { if (xb_ld(&(bar)[XB_TMO])) break; if (_sp > XB_SPIN_CAP) { atomicAdd(&(bar)[XB_TMO], 1u); break; } } } } while (0)

struct XcdBarrier { unsigned* bar; unsigned x; volatile LAS unsigned* st; };

__device__ __forceinline__ XcdBarrier xcd_barrier_post(unsigned* bar, volatile LAS unsigned* st) {
    XcdBarrier b; b.bar = bar; b.x = xb_xcc_id(); b.st = st;
    if (threadIdx.x == 0) (void)xb_add(&bar[XB_XCNT(b.x)], 1u);
    return b;
}
__device__ __forceinline__ void xcd_barrier_complete(unsigned* bar, unsigned x, unsigned& nloc, unsigned& nx) {
    const unsigned G = gridDim.x * gridDim.y * gridDim.z;
    unsigned sum, cnt, mine, sp = 0u;
    for (;;) {
        sum = 0u; cnt = 0u; mine = 0u;
#pragma unroll
        for (unsigned j = 0; j < 16; ++j) { const unsigned c = xb_ld(&bar[XB_XCNT(j)]); sum += c; cnt += (c > 0u) ? 1u : 0u; mine = (j == x) ? c : mine; }
        if (sum == G) break;
        __builtin_amdgcn_s_sleep(1);
        if ((++sp & 255u) == 0u) { if (xb_ld(&bar[XB_TMO])) break; if (sp > XB_SPIN_CAP) { atomicAdd(&bar[XB_TMO], 1u); break; } }
    }
    nloc = mine > 0u ? mine : 1u; nx = cnt > 0u ? cnt : 1u;
}
__device__ __forceinline__ void xcd_barrier(const XcdBarrier& b) {
    asm volatile("s_waitcnt vmcnt(0)" ::: "memory");
    __syncthreads();
    if (threadIdx.x == 0) {
        unsigned* bar = b.bar;
        __builtin_amdgcn_s_waitcnt(0);
        unsigned nloc = b.st[0], nx = b.st[1];
        if (nloc == 0u) { xcd_barrier_complete(bar, b.x, nloc, nx); b.st[0] = nloc; b.st[1] = nx; }
        const unsigned old = xb_add(&bar[XB_XSUB(b.x)], 1u);
        const unsigned gen = old / nloc;
        if (old + 1u == (gen + 1u) * nloc) {
            __builtin_amdgcn_fence(__ATOMIC_RELEASE, "agent");
            asm volatile("s_waitcnt vmcnt(0)" ::: "memory");
            const unsigned og = xb_add(&bar[XB_TOP], 1u);
            const unsigned tg = og / nx;
            if (og + 1u == (tg + 1u) * nx) xb_add(&bar[XB_TOPGEN], 1u);
            else XB_SPIN(xb_ld(&bar[XB_TOPGEN]) == tg, bar);
            __builtin_amdgcn_fence(__ATOMIC_ACQUIRE, "agent");
            xb_add(&bar[XB_XGEN(b.x)], 1u);
            asm volatile("s_waitcnt vmcnt(0)" ::: "memory");
        } else {
            XB_SPIN(xb_ld(&bar[XB_XGEN(b.x)]) == gen, bar);
            __builtin_amdgcn_fence(__ATOMIC_ACQUIRE, "agent");
            asm volatile("s_waitcnt vmcnt(0)" ::: "memory");
        }
    }
    __syncthreads();
}

namespace pg8 {
constexpr int BM = 256, BK = 64, HALF = 128, HTB = HALF * BK * 2, STAGE_BYTES = 8 * HTB, NXCD = 8, WGM = 8;
__host__ __device__ __forceinline__ int lds_byte(int r, int c) { const int st = (r >> 4) * 2 + (c >> 5), rr = r & 15, cc = c & 31, ob = rr * 64 + cc * 2; return st * 1024 + (ob ^ (((ob >> 9) & 1) << 5)); }
__host__ __device__ __forceinline__ void stage_rc(int b, int& R, int& C) { const int st = b / 1024, sb = b % 1024, swz = sb ^ (((sb >> 9) & 1) << 5); R = (st >> 1) * 16 + swz / 64; C = (st & 1) * 32 + (swz % 64) / 2; }
__host__ __device__ __forceinline__ int perm32(int rho) { const int n = rho >> 4, i = rho & 15; return 8 * (i >> 2) + 4 * n + (i & 3); }

struct Unit { int pm, pn, pb, aux, aux2; };
struct Gemm { const bf16_t* A; const bf16_t* Bt; int lda, ldb, K; };

struct StaticOrder {
    int nM, nN, nwg, G, c;
    __device__ void init(int M, int N, int G_, int c_) { nM = M / BM; nN = N / BM; nwg = nM * nN; G = G_; c = c_; }
    __device__ bool next(int i, Unit& u) const {
        const long L = (long)i * G + c; if (L >= nwg) return false;
        int wgid = (int)L; { const int q = nwg / NXCD, r = nwg % NXCD, xcd = wgid % NXCD, off = wgid / NXCD; wgid = (xcd < r ? xcd * (q + 1) : r * (q + 1) + (xcd - r) * q) + off; }
        const int nig = WGM * nN, gid = wgid / nig, fm = gid * WGM, gsz = (nM - fm) < WGM ? (nM - fm) : WGM;
        u.pm = fm + ((wgid % nig) % gsz); u.pn = (wgid % nig) / gsz; u.pb = u.pn; u.aux = 0; u.aux2 = 0; return true;
    }
};
struct GroupedOrder {
    int nM, nN, rtpg, G, v;
    __device__ void init(int nM_, int nN_, int rtpg_, int G_, int v_) { nM = nM_; nN = nN_; rtpg = rtpg_; G = G_; v = v_; }
    __device__ bool next(int i, Unit& u) const {
        const int L = i * G + v; if (L >= nM * nN) return false;
        u.pm = L / nN; u.pn = L % nN; u.aux = u.pm / rtpg; u.pb = u.aux * nN + u.pn; u.aux2 = 0; return true;
    }
};

template <class Epi, class Sched, bool ALIGN_EPI, bool GATHER>
__device__ __forceinline__ void gemm_phase(LAS unsigned char* lds, const Gemm g, const Sched& S, const Epi& E, const LAS unsigned* rowtab  ) {
    const int tid = threadIdx.x, wid = __builtin_amdgcn_readfirstlane(tid >> 6), lane = tid & 63, wr = wid >> 2, wc = wid & 3, fr = lane & 15, fq = lane >> 4;
    const int K = g.K, nt = K / BK;
    int RA[2]; unsigned cA2[2]; unsigned voffB[2];
#pragma unroll
    for (int i = 0; i < 2; ++i) { int R, C; stage_rc(tid * 16 + i * 8192, R, C); const int Rb = (R & ~31) + perm32(R & 31);
        RA[i] = R; cA2[i] = (unsigned)C * 2u; voffB[i] = (unsigned)(Rb * g.ldb + C) * 2u; }
    const size_t kstep = (size_t)(BK * 2);
    const size_t hstepB = (size_t)HALF * g.ldb * 2, tstepB = 2 * hstepB;
    const size_t tstepA = (size_t)BM * g.lda * 2;
    const unsigned ldsw = (unsigned)wid * 1024u;
    const int aoff = lds_byte(wr * 64 + fr, fq * 8), boff = lds_byte(wc * 32 + fr, fq * 8);
    unsigned vAc[2][2], vAn[2][2];
#define PG8_SETVA(dst, ui_) do { _Pragma("unroll") for (int h_ = 0; h_ < 2; ++h_) _Pragma("unroll") for (int i_ = 0; i_ < 2; ++i_) \
        dst[h_][i_] = (GATHER ? rowtab[(ui_) * 256 + h_ * 128 + RA[i_]] : (unsigned)((h_ * 128 + RA[i_]) * g.lda) * 2u) + cA2[i_]; } while (0)
#define PG8_SA(b, h) (((b) * 2 + (h)) * HTB)
#define PG8_SB(b, h) ((4 + (b) * 2 + (h)) * HTB)
#define PG8_STAGE(bufoff, gbase, v0, v1) do { \
        __builtin_amdgcn_global_load_lds((const unsigned*)((const char*)(gbase) + (v0)), (LAS unsigned*)(lds + (bufoff) + ldsw), 16, 0, 0); \
        __builtin_amdgcn_global_load_lds((const unsigned*)((const char*)(gbase) + (v1)), (LAS unsigned*)(lds + (bufoff) + ldsw + 8192), 16, 0, 0); } while (0)
#define PG8_STB(bufoff, gbase) PG8_STAGE(bufoff, gbase, voffB[0], voffB[1])
#define PG8_LDA(dst, b, h) do { _Pragma("unroll") for (int m = 0; m < 4; ++m) _Pragma("unroll") for (int k = 0; k < 2; ++k) dst[m][k] = *(const LAS bf16x8*)(lds + PG8_SA(b, h) + aoff + m * 2048 + k * 1024); } while (0)
#define PG8_LDB(dst, b, h) do { _Pragma("unroll") for (int n = 0; n < 2; ++n) _Pragma("unroll") for (int k = 0; k < 2; ++k) dst[n][k] = *(const LAS bf16x8*)(lds + PG8_SB(b, h) + boff + n * 2048 + k * 1024); } while (0)
#define PG8_MMA(ai, bj, At, Bt) do { __builtin_amdgcn_s_setprio(1); _Pragma("unroll") for (int m = 0; m < 4; ++m) _Pragma("unroll") for (int n = 0; n < 2; ++n) _Pragma("unroll") for (int k = 0; k < 2; ++k) \
        acc[ai][bj][m][n] = __builtin_amdgcn_mfma_f32_16x16x32_bf16(Bt[n][k], At[m][k], acc[ai][bj][m][n], 0, 0, 0); __builtin_amdgcn_s_setprio(0); } while (0)
#define PG8_WAIT_V(n) asm volatile("s_waitcnt vmcnt(" #n ")" ::: "memory")
#define PG8_WAIT_L(n) asm volatile("s_waitcnt lgkmcnt(" #n ")" ::: "memory")
#define PG8_BAR __builtin_amdgcn_s_barrier()
#define PG8_SCHED __builtin_amdgcn_sched_barrier(0)
    Unit cur, nxt; int ui = 0;
    if (!S.next(0, cur)) return;
    f32x4 acc[2][2][4][2];
#pragma unroll
    for (int a = 0; a < 2; ++a)
#pragma unroll
        for (int b = 0; b < 2; ++b)
#pragma unroll
            for (int m = 0; m < 4; ++m)
#pragma unroll
                for (int n = 0; n < 2; ++n) acc[a][b][m][n] = (f32x4){0.f, 0.f, 0.f, 0.f};
    bf16x8 At[4][2], B0[2][2], B1[2][2];
    const char* cA = (const char*)g.A + (GATHER ? (size_t)0 : (size_t)cur.pm * tstepA); const char* cB = (const char*)g.Bt + (size_t)cur.pb * tstepB;
    PG8_SETVA(vAc, 0);
    PG8_STB(PG8_SB(0, 0), cB); PG8_STB(PG8_SB(0, 1), cB + hstepB); PG8_STAGE(PG8_SA(0, 0), cA, vAc[0][0], vAc[0][1]); PG8_STAGE(PG8_SA(0, 1), cA, vAc[1][0], vAc[1][1]);
    if (wr == 1) PG8_BAR;
    PG8_WAIT_V(2); PG8_BAR;
    PG8_STB(PG8_SB(1, 0), cB + kstep); PG8_STAGE(PG8_SA(1, 0), cA + kstep, vAc[0][0], vAc[0][1]); PG8_STB(PG8_SB(1, 1), cB + hstepB + kstep);
    PG8_WAIT_V(6); PG8_BAR;
    for (;;) {
        const bool has_next = S.next(ui + 1, nxt);
        const char* nA = GATHER ? cA : (has_next ? (const char*)g.A + (size_t)nxt.pm * tstepA : cA); const char* nB = has_next ? (const char*)g.Bt + (size_t)nxt.pb * tstepB : cB;
        if (GATHER) { if (has_next) { PG8_SETVA(vAn, ui + 1); } else {
#pragma unroll
            for (int h_ = 0; h_ < 2; ++h_) { vAn[h_][0] = vAc[h_][0]; vAn[h_][1] = vAc[h_][1]; } } }
        for (int t = 0; t < nt; t += 2) {
            const bool last = (t == nt - 2);
            const char* a1 = cA + (size_t)(t + 1) * kstep;
            const char* a2 = last ? nA : cA + (size_t)(t + 2) * kstep; const char* b2 = last ? nB : cB + (size_t)(t + 2) * kstep;
            const char* a3 = a2 + kstep; const char* b3 = b2 + kstep;
            unsigned x00, x01, x10, x11;
            if (GATHER) { x00 = last ? vAn[0][0] : vAc[0][0]; x01 = last ? vAn[0][1] : vAc[0][1]; x10 = last ? vAn[1][0] : vAc[1][0]; x11 = last ? vAn[1][1] : vAc[1][1]; }
            else { x00 = vAc[0][0]; x01 = vAc[0][1]; x10 = vAc[1][0]; x11 = vAc[1][1]; }
            PG8_LDB(B0, 0, 0); PG8_LDB(B1, 0, 1); PG8_SCHED; PG8_LDA(At, 0, 0); PG8_STAGE(PG8_SA(1, 1), a1, vAc[1][0], vAc[1][1]);
            PG8_WAIT_V(8); PG8_WAIT_L(0); PG8_BAR; PG8_MMA(0, 0, At, B0); PG8_MMA(0, 1, At, B1); PG8_BAR; PG8_SCHED;
            PG8_LDA(At, 0, 1); PG8_STB(PG8_SB(0, 0), b2); PG8_STB(PG8_SB(0, 1), b2 + hstepB); PG8_STAGE(PG8_SA(0, 0), a2, x00, x01);
            PG8_WAIT_V(8); PG8_WAIT_L(0); PG8_BAR; PG8_MMA(1, 0, At, B0); PG8_MMA(1, 1, At, B1); PG8_BAR; PG8_SCHED;
            PG8_LDB(B0, 1, 0); PG8_LDB(B1, 1, 1); PG8_SCHED; PG8_LDA(At, 1, 0); PG8_STAGE(PG8_SA(0, 1), a2, x10, x11);
            PG8_WAIT_V(8); PG8_WAIT_L(0); PG8_BAR; PG8_MMA(0, 0, At, B0); PG8_MMA(0, 1, At, B1); PG8_BAR; PG8_SCHED;
            PG8_LDA(At, 1, 1); PG8_STB(PG8_SB(1, 0), b3); PG8_STB(PG8_SB(1, 1), b3 + hstepB); PG8_STAGE(PG8_SA(1, 0), a3, x00, x01);
            PG8_WAIT_V(8); PG8_WAIT_L(0); PG8_BAR; PG8_MMA(1, 0, At, B0); PG8_MMA(1, 1, At, B1); PG8_BAR; PG8_SCHED;
        }
        if constexpr (ALIGN_EPI) { if (wr == 0) PG8_BAR; }
        E(acc, cur, wr, wc, fr, fq);
        if (!has_next) break;
#pragma unroll
        for (int a = 0; a < 2; ++a)
#pragma unroll
            for (int b = 0; b < 2; ++b)
#pragma unroll
                for (int m = 0; m < 4; ++m)
#pragma unroll
                    for (int n = 0; n < 2; ++n) acc[a][b][m][n] = (f32x4){0.f, 0.f, 0.f, 0.f};
        cur = nxt; cA = nA; cB = nB; ++ui;
        if (GATHER) {
#pragma unroll
            for (int h_ = 0; h_ < 2; ++h_) { vAc[h_][0] = vAn[h_][0]; vAc[h_][1] = vAn[h_][1]; } }
        if constexpr (ALIGN_EPI) { if (wr == 1) PG8_BAR; }
    }
    PG8_WAIT_V(0);
    if constexpr (!ALIGN_EPI) { if (wr == 0) PG8_BAR; }
    PG8_BAR;
#undef PG8_SETVA
#undef PG8_SA
#undef PG8_SB
#undef PG8_STAGE
#undef PG8_STB
#undef PG8_LDA
#undef PG8_LDB
#undef PG8_MMA
#undef PG8_WAIT_V
#undef PG8_WAIT_L
#undef PG8_BAR
#undef PG8_SCHED
}
}
constexpr int NWAVES = 8, NTHR = 512;
constexpr int BATCH = 8, SEQ = 8192, T = BATCH * SEQ, D = 1024, DIN = 4096;
constexpr int DS = 512, DA = 512, NH = 8, HD = 64, NBLK = SEQ / 256;
constexpr int SG = 32, SHC = 16, SP = 64, SL = 32, SKU = SL * SHC  , SKS = 2 * SP  , SKY = SKU + SKS  , SROWS = T / SL  ;
constexpr int NE = 32, DE = 512;
constexpr float RMS_EPS = 1e-6f;
constexpr float LOG2E = 1.4426950408889634f;
constexpr float QSCALE = 0.125f * LOG2E;
constexpr int ROWCAP = T;
constexpr int HID_ROWS = 2 * T + NE * 256;

constexpr size_t MiB = 1u << 20;
constexpr size_t WS_CTL = 0, CTL_ZERO_BYTES = 1 * MiB;
constexpr size_t WS_WIN = 1 * MiB;
constexpr size_t WS_WGLU = 9 * MiB;
constexpr size_t WS_WUS = 10 * MiB;
constexpr size_t WS_WUA = 11 * MiB;
constexpr size_t WS_WOUT = 12 * MiB;
constexpr size_t WS_WR = 14 * MiB;
constexpr size_t WS_KMEAN = 15 * MiB;
constexpr size_t WS_SSMW = 16 * MiB;
constexpr size_t WS_SSMT = 24 * MiB;
constexpr size_t WS_W13 = 44 * MiB;
constexpr size_t WS_W2 = 108 * MiB;
constexpr size_t WS_A0 = 140 * MiB;
constexpr size_t WS_UP = 276 * MiB;
constexpr size_t WS_Q = 356 * MiB;
constexpr size_t WS_SSQ = 404 * MiB;
constexpr size_t WS_RLOG = 408 * MiB;
constexpr size_t WS_K = 420 * MiB;
constexpr size_t WS_ROWTOK = 428 * MiB, WS_ROWCOEF = 436 * MiB, WS_ROWRSTD = 444 * MiB;
constexpr size_t WS_GACT = 420 * MiB;
constexpr size_t WS_V = 484 * MiB;
constexpr size_t WS_YSSM = 484 * MiB;
constexpr size_t WS_SGS = 548 * MiB;
constexpr size_t WS_SGA = 676 * MiB;
constexpr size_t WS_E = 804 * MiB;
constexpr size_t WS_YATT = 836 * MiB;
constexpr size_t WS_END = 932 * MiB;
constexpr size_t WS_KFRAG = WS_A0, WS_VFRAG = WS_A0 + 64 * MiB, WS_H1 = WS_A0, WS_MRG = WS_A0, WS_HID = WS_A0;
constexpr size_t WS_X1 = WS_SGS, WS_XG = WS_UP, WS_Y0 = WS_UP, WS_Y1 = WS_E;
static_assert(WS_GACT + 64 * MiB <= WS_YSSM && WS_YSSM + 64 * MiB <= WS_SGS, "map");
static_assert(WS_HID + (size_t)HID_ROWS * DE * 2 <= WS_UP, "hid fits");
static_assert(WS_RLOG + (size_t)T * 72 * 4 <= WS_ROWTOK, "rlog fits");

constexpr int CW_TMO = 0, CW_CODE = 1;
constexpr int CW_BAR = 4096;
constexpr int CW_ECNT = 8192;

constexpr int RING_BYTES = 131072;
constexpr int ROWTAB_OFF = RING_BYTES, ROWTAB_UNITS = 12, ROWTAB_BYTES = ROWTAB_UNITS * 1024;
constexpr int MOE_TST_OFF = ROWTAB_OFF + ROWTAB_BYTES;
constexpr int MISC_OFF = MOE_TST_OFF + 512;
constexpr int LDS_BYTES = MISC_OFF + 128;
static_assert(LDS_BYTES <= 163840, "LDS");

struct Frame {
    LAS unsigned char* lds;
    volatile LAS unsigned* MISC;
    gu32* ctl;
    unsigned char* ws;
    int tid, lane, wave, vcu, G;
    const float* in[27];
    float* out;
};

#define EPI_LOOP_BEGIN  _Pragma("unroll") for (int ai = 0; ai < 2; ++ai) _Pragma("unroll") for (int m = 0; m < 4; ++m) { const int rl = ai * 128 + wr * 64 + m * 16 + fr; _Pragma("unroll") for (int bj = 0; bj < 2; ++bj) { const int cl = bj * 128 + wc * 32 + 8 * fq; \
        const f32x4 a0 = acc[ai][bj][m][0], a1 = acc[ai][bj][m][1]; (void)rl; (void)cl; (void)a0; (void)a1;
#define EPI_LOOP_END } }
typedef const f32x4 (&AccRef)[2][2][4][2];
__device__ __forceinline__ u32x4 pack8(f32x4 a, f32x4 b) { u32x4 w; w.x = cvt_pk_bf16(a[0], a[1]); w.y = cvt_pk_bf16(a[2], a[3]); w.z = cvt_pk_bf16(b[0], b[1]); w.w = cvt_pk_bf16(b[2], b[3]); return w; }
__device__ __forceinline__ void unpack8(u32x4 w, f32x4& a, f32x4& b) { a = (f32x4){bflo(w.x), bfhi(w.x), bflo(w.y), bfhi(w.y)}; b = (f32x4){bflo(w.z), bfhi(w.z), bflo(w.w), bfhi(w.w)}; }

struct EpiProj {
    unsigned char* ws; const float* b_gate;
    __device__ __forceinline__ void operator()(AccRef acc, const pg8::Unit& u, int wr, int wc, int fr, int fq) const {
        const int pn = u.pn; const int row0 = u.pm * 256;
        if (pn < 2) {
            bf16_t* Uperm = (bf16_t*)(ws + WS_UP);
            EPI_LOOP_BEGIN
                const int row = row0 + rl, col = pn * 256 + cl;
                bf16_t* dst = Uperm + (size_t)(col >> 4) * ((size_t)SROWS * SKY) + (size_t)(row >> 5) * SKY + (row & 31) * 16 + (col & 15);
                *(u32x4*)dst = pack8(a0, a1);
            EPI_LOOP_END
        } else if (pn < 8) {
            const size_t boff = pn < 4 ? WS_Q : (pn < 6 ? WS_K : WS_V);
            bf16_t* base = (bf16_t*)(ws + boff); const float sc = pn < 4 ? QSCALE : 1.f; const int c0 = (pn & 1) * 256;
            EPI_LOOP_BEGIN
                const int row = row0 + rl, col = c0 + cl;
                *(u32x4*)(base + (size_t)row * 512 + col) = pack8(a0 * sc, a1 * sc);
            EPI_LOOP_END
        } else {
            const size_t boff = pn < 12 ? WS_SGS : WS_SGA;
            bf16_t* base = (bf16_t*)(ws + boff); const int c0 = ((pn - 8) & 3) * 256; const float* bg = b_gate + (pn - 8) * 256;
            EPI_LOOP_BEGIN
                const int row = row0 + rl, col = c0 + cl;
                const f32x4 b0 = *(const f32x4*)(bg + cl), b1 = *(const f32x4*)(bg + cl + 4);
                f32x4 s0, s1;
#pragma unroll
                for (int e = 0; e < 4; ++e) { s0[e] = fast_sigmoid(a0[e] + b0[e]); s1[e] = fast_sigmoid(a1[e] + b1[e]); }
                *(u32x4*)(base + (size_t)row * 1024 + col) = pack8(s0, s1);
            EPI_LOOP_END
        }
    }
};
struct EpiSsmE {
    float* E;
    __device__ __forceinline__ void operator()(AccRef acc, const pg8::Unit& u, int wr, int wc, int fr, int fq) const {
        EPI_LOOP_BEGIN
            if (bj == 0) { float* dst = E + (size_t)(u.pm * 256 + rl) * 128 + cl; *(f32x4*)dst = a0; *(f32x4*)(dst + 4) = a1; }
        EPI_LOOP_END
    }
};
__device__ __forceinline__ float gelu_tanh(float x) { const float z = 1.5957691216057308f * (x + 0.044715f * x * x * x); return x * fast_sigmoid(z); }
struct EpiSsmY {
    bf16_t* Gact;
    __device__ __forceinline__ void operator()(AccRef acc, const pg8::Unit& u, int wr, int wc, int fr, int fq) const {
        const int g = u.aux;
        EPI_LOOP_BEGIN
            const int rg = (u.pm & 7) * 256 + rl;
            const int colg = u.pn * 256 + cl;
            const int tok = (rg >> 8) * SEQ + (rg & 255) * SL + (colg >> 4);
            f32x4 y0, y1;
#pragma unroll
            for (int e = 0; e < 4; ++e) { y0[e] = gelu_tanh(a0[e]); y1[e] = gelu_tanh(a1[e]); }
            *(u32x4*)(Gact + (size_t)tok * DS + g * 16 + (colg & 15)) = pack8(y0, y1);
        EPI_LOOP_END
    }
};
struct EpiGlu {
    const bf16_t* Gact; bf16_t* Yssm; const float* b_glu;
    __device__ __forceinline__ void operator()(AccRef acc, const pg8::Unit& u, int wr, int wc, int fr, int fq) const {
        EPI_LOOP_BEGIN
            const int row = u.pm * 256 + rl, col = u.pn * 256 + cl;
            const f32x4 b0 = *(const f32x4*)(b_glu + col), b1 = *(const f32x4*)(b_glu + col + 4);
            f32x4 g0, g1; unpack8(*(const u32x4*)(Gact + (size_t)row * DS + col), g0, g1);
            f32x4 y0, y1;
#pragma unroll
            for (int e = 0; e < 4; ++e) { y0[e] = g0[e] * fast_sigmoid(a0[e] + b0[e]); y1[e] = g1[e] * fast_sigmoid(a1[e] + b1[e]); }
            *(u32x4*)(Yssm + (size_t)row * DS + col) = pack8(y0, y1);
        EPI_LOOP_END
    }
};
template <bool SECOND> struct EpiUp {
    const bf16_t* SG; bf16_t* Mrg;
    __device__ __forceinline__ void operator()(AccRef acc, const pg8::Unit& u, int wr, int wc, int fr, int fq) const {
        EPI_LOOP_BEGIN
            const size_t off = (size_t)(u.pm * 256 + rl) * D + u.pn * 256 + cl;
            f32x4 s0, s1; unpack8(*(const u32x4*)(SG + off), s0, s1);
            f32x4 y0 = s0 * a0, y1 = s1 * a1;
            if (SECOND) { f32x4 p0, p1; unpack8(*(const u32x4*)(Mrg + off), p0, p1); y0 += p0; y1 += p1; }
            *(u32x4*)(Mrg + off) = pack8(y0, y1);
        EPI_LOOP_END
    }
};
struct EpiOut {
    const float* x; float* X1; bf16_t* XG; const float* g2; float* SSQ;
    __device__ __forceinline__ void operator()(AccRef acc, const pg8::Unit& u, int wr, int wc, int fr, int fq) const {
#pragma unroll
        for (int ai = 0; ai < 2; ++ai)
#pragma unroll
            for (int m = 0; m < 4; ++m) { const int row = u.pm * 256 + ai * 128 + wr * 64 + m * 16 + fr; float ss = 0.f;
#pragma unroll
                for (int bj = 0; bj < 2; ++bj) { const int col = u.pn * 256 + bj * 128 + wc * 32 + 8 * fq; const size_t off = (size_t)row * D + col;
                    const f32x4 x0 = *(const f32x4*)(x + off) + acc[ai][bj][m][0], x1 = *(const f32x4*)(x + off + 4) + acc[ai][bj][m][1];
                    *(f32x4*)(X1 + off) = x0; *(f32x4*)(X1 + off + 4) = x1;
                    ss += (x0[0] * x0[0] + x0[1] * x0[1]) + (x0[2] * x0[2] + x0[3] * x0[3]) + (x1[0] * x1[0] + x1[1] * x1[1]) + (x1[2] * x1[2] + x1[3] * x1[3]);
                    const f32x4 w0 = *(const f32x4*)(g2 + col), w1 = *(const f32x4*)(g2 + col + 4);
                    *(u32x4*)(XG + off) = pack8(x0 * w0, x1 * w1); }
                ss += __shfl_xor(ss, 16); ss += __shfl_xor(ss, 32);
                if (fq == 0) SSQ[(size_t)row * 16 + u.pn * 4 + wc] = ss; }
    }
};
struct EpiRouter {
    float* Rlog;
    __device__ __forceinline__ void operator()(AccRef acc, const pg8::Unit& u, int wr, int wc, int fr, int fq) const {
        EPI_LOOP_BEGIN
            if (bj == 0 && cl < 72) { float* dst = Rlog + (size_t)(u.pm * 256 + rl) * 72 + cl; *(f32x4*)dst = a0; *(f32x4*)(dst + 4) = a1; }
        EPI_LOOP_END
    }
};
struct EpiMoe1 {
    bf16_t* Hid; const float* rowrstd; const unsigned* ecnt;
    __device__ __forceinline__ void operator()(AccRef acc, const pg8::Unit& u, int wr, int wc, int fr, int fq) const {
        const int e = u.aux, cnt = (int)ecnt[e];
#pragma unroll
        for (int ai = 0; ai < 2; ++ai)
#pragma unroll
            for (int m = 0; m < 4; ++m) { const int rl = ai * 128 + wr * 64 + m * 16 + fr; const int pos = u.aux2 + rl;
                if (pos < cnt) { const float rs = rowrstd[(size_t)e * ROWCAP + pos];
                    f32x4 h0, h1;
#pragma unroll
                    for (int k = 0; k < 4; ++k) { const float p = acc[ai][0][m][0][k] * rs, q = acc[ai][1][m][0][k] * rs; h0[k] = p * fast_sigmoid(p) * q;
                        const float p2 = acc[ai][0][m][1][k] * rs, q2 = acc[ai][1][m][1][k] * rs; h1[k] = p2 * fast_sigmoid(p2) * q2; }
                    *(u32x4*)(Hid + (size_t)(u.pm * 256 + rl) * DE + u.pn * 128 + wc * 32 + 8 * fq) = pack8(h0, h1); } }
    }
};
struct EpiMoe2 {
    bf16_t* Y0; size_t ydelta; const unsigned* rowtok; const float* rowcoef; const unsigned* ecnt;
    __device__ __forceinline__ void operator()(AccRef acc, const pg8::Unit& u, int wr, int wc, int fr, int fq) const {
        const int e = u.aux, cnt = (int)ecnt[e];
#pragma unroll
        for (int ai = 0; ai < 2; ++ai)
#pragma unroll
            for (int m = 0; m < 4; ++m) { const int rl = ai * 128 + wr * 64 + m * 16 + fr; const int pos = u.aux2 + rl;
                if (pos < cnt) { const unsigned tk = rowtok[(size_t)e * ROWCAP + pos]; const float cf = rowcoef[(size_t)e * ROWCAP + pos];
                    bf16_t* dst = (bf16_t*)((unsigned char*)Y0 + (size_t)(tk & 1u) * ydelta) + (size_t)(tk >> 1) * D + u.pn * 256 + wc * 32 + 8 * fq;
#pragma unroll
                    for (int bj = 0; bj < 2; ++bj) *(u32x4*)(dst + bj * 128) = pack8(acc[ai][bj][m][0] * cf, acc[ai][bj][m][1] * cf); } }
    }
};
__device__ __forceinline__ void transpose_item(const float* W, int N, int k0, int n0, bf16_t* WT, size_t drow0, int ldo, LAS float* scr, int lane) {
#pragma unroll 8
    for (int i = 0; i < 32; ++i) { const int kk = 2 * i + (lane >> 5); scr[kk * 33 + (lane & 31)] = W[(size_t)(k0 + kk) * N + n0 + (lane & 31)]; }
    LDS_WAIT(); asm volatile("" ::: "memory");
    const int c = lane & 7;
#pragma unroll
    for (int j = 0; j < 4; ++j) { const int n = (lane >> 3) + 8 * j; const LAS float* s = scr + (8 * c) * 33 + n;
        u32x4 o; o.x = pk2(s[0 * 33], s[1 * 33]); o.y = pk2(s[2 * 33], s[3 * 33]); o.z = pk2(s[4 * 33], s[5 * 33]); o.w = pk2(s[6 * 33], s[7 * 33]);
        *(u32x4*)(WT + (drow0 + n) * (size_t)ldo + k0 + 8 * c) = o; }
    LDS_WAIT(); asm volatile("" ::: "memory");
}
__device__ __forceinline__ void rms_row_to_bf16(int lane, const float* xrow, const float* g, bf16_t* orow) {
    const f32x4* xr = (const f32x4*)xrow + lane; const f32x4* gr = (const f32x4*)g + lane;
    f32x4 v[4]; float s = 0.f;
#pragma unroll
    for (int j = 0; j < 4; ++j) { v[j] = xr[64 * j]; s += (v[j].x * v[j].x + v[j].y * v[j].y) + (v[j].z * v[j].z + v[j].w * v[j].w); }
    const float rstd = 1.f / sqrtf(wave_sum(s) * (1.f / D) + RMS_EPS);
    unsigned long long* o8 = (unsigned long long*)orow + lane;
#pragma unroll
    for (int j = 0; j < 4; ++j) { const f32x4 w = gr[64 * j];
        o8[64 * j] = (unsigned long long)pk2(v[j].x * rstd * w.x, v[j].y * rstd * w.y) | ((unsigned long long)pk2(v[j].z * rstd * w.z, v[j].w * rstd * w.w) << 32); }
}
__device__ __forceinline__ void cpow(float lr, float li, float step, float dl, float& ar, float& ai) {
    const float mag = __expf(dl * lr * step); const float rev = dl * (li * step * 0.15915494309189535f); const float fr = rev - floorf(rev);
    ar = mag * __builtin_amdgcn_cosf(fr); ai = mag * __builtin_amdgcn_sinf(fr);
}
__device__ __forceinline__ void ssm_gen(Frame& F, int g) {
    LAS float* AP = (LAS float*)(F.lds); LAS float* BB = AP + 33 * 64 * 2; LAS float* CC = BB + 2048; LAS float* KT = CC + 2048;
    const float* lam_re = F.in[4] + g * SP; const float* lam_im = F.in[5] + g * SP; const float step = __expf(F.in[6][g]);
    const float* b_re = F.in[7] + g * SP * SHC; const float* b_im = F.in[8] + g * SP * SHC; const float* c_re = F.in[9] + g * SHC * SP; const float* c_im = F.in[10] + g * SHC * SP; const float* dd = F.in[11] + g * SHC;
    bf16_t* BT = (bf16_t*)(F.ws + WS_SSMT) + (size_t)g * 512 * SKY; bf16_t* BW = (bf16_t*)(F.ws + WS_SSMW) + (size_t)g * 256 * SKU;
    const int tid = F.tid;
    for (int idx = tid; idx < 33 * 64; idx += NTHR) { const int dl = idx >> 6, p = idx & 63; float ar, ai; cpow(lam_re[p], lam_im[p], step, (float)dl, ar, ai); AP[idx * 2] = ar; AP[idx * 2 + 1] = ai; }
    for (int idx = tid; idx < 1024; idx += NTHR) { const int ho = idx >> 6, p = idx & 63; CC[idx * 2] = c_re[ho * 64 + p]; CC[idx * 2 + 1] = c_im[ho * 64 + p]; }
    __syncthreads();
    for (int idx = tid; idx < 1024; idx += NTHR) { const int p = idx >> 4, h = idx & 15; const float ar = AP[(64 + p) * 2], ai = AP[(64 + p) * 2 + 1];
        const float lr = lam_re[p], li = lam_im[p], nr = ar - 1.f, ni = ai, den = lr * lr + li * li, cr = (nr * lr + ni * li) / den, ci = (ni * lr - nr * li) / den;
        const float br = b_re[p * 16 + h], bi = b_im[p * 16 + h]; BB[idx * 2] = cr * br - ci * bi; BB[idx * 2 + 1] = cr * bi + ci * br; }
    __syncthreads();
    for (int idx = tid; idx < 8192; idx += NTHR) { const int dl = idx >> 8, ho = (idx >> 4) & 15, hi = idx & 15; float s = 0.f;
        for (int p = 0; p < 64; ++p) { const float ar = AP[(dl * 64 + p) * 2], ai = AP[(dl * 64 + p) * 2 + 1], br = BB[(p * 16 + hi) * 2], bi = BB[(p * 16 + hi) * 2 + 1];
            const float zr = ar * br - ai * bi, zi = ar * bi + ai * br; s += CC[(ho * 64 + p) * 2] * zr - CC[(ho * 64 + p) * 2 + 1] * zi; }
        if (dl == 0 && ho == hi) s += dd[ho];
        KT[idx] = s; }
    __syncthreads();
    for (int v = tid; v < 512 * 80; v += NTHR) { const int n = v / 80, kv = (v % 80) * 8, tau = n >> 4, ho = n & 15; float val[8];
        if (kv < 512) { const int sg = kv >> 4, hi0 = kv & 15;
#pragma unroll
            for (int e = 0; e < 8; ++e) val[e] = (tau >= sg) ? KT[((tau - sg) * 16 + ho) * 16 + hi0 + e] : 0.f; }
        else { const int kk = kv - 512;
#pragma unroll
            for (int e = 0; e < 8; ++e) { const int p = (kk + e) >> 1, ri = (kk + e) & 1; const float ar = AP[((tau + 1) * 64 + p) * 2], ai = AP[((tau + 1) * 64 + p) * 2 + 1], cre = CC[(ho * 64 + p) * 2], cim = CC[(ho * 64 + p) * 2 + 1];
                val[e] = ri == 0 ? (cre * ar - cim * ai) : -(cre * ai + cim * ar); } }
        u32x4 o; o.x = pk2(val[0], val[1]); o.y = pk2(val[2], val[3]); o.z = pk2(val[4], val[5]); o.w = pk2(val[6], val[7]);
        *(u32x4*)(BT + (size_t)n * SKY + kv) = o; }
    for (int v = tid; v < 256 * 64; v += NTHR) { const int n = v >> 6, kv = (v & 63) * 8; float val[8];
        if (n < 128) { const int p = n >> 1, ri = n & 1, sg = kv >> 4, hi0 = kv & 15; const float ar = AP[((31 - sg) * 64 + p) * 2], ai = AP[((31 - sg) * 64 + p) * 2 + 1];
#pragma unroll
            for (int e = 0; e < 8; ++e) { const float br = BB[(p * 16 + hi0 + e) * 2], bi = BB[(p * 16 + hi0 + e) * 2 + 1]; val[e] = ri == 0 ? (ar * br - ai * bi) : (ar * bi + ai * br); } }
        else {
#pragma unroll
            for (int e = 0; e < 8; ++e) val[e] = 0.f; }
        u32x4 o; o.x = pk2(val[0], val[1]); o.y = pk2(val[2], val[3]); o.z = pk2(val[4], val[5]); o.w = pk2(val[6], val[7]);
        *(u32x4*)(BW + (size_t)n * SKU + kv) = o; }
    __syncthreads();
}
__device__ __forceinline__ void p0_prologue(Frame& F) {
    if (F.vcu < SG) { for (int g = F.vcu; g < SG; g += F.G) ssm_gen(F, g); }
    LAS float* scr = (LAS float*)(F.lds + F.wave * 16384);
    const int gw = F.vcu * NWAVES + F.wave, NGW = F.G * NWAVES, lane = F.lane;
    constexpr int I_IN = 16 * 128, I_GLU = 8 * 16, I_US = 8 * 32, I_UA = 8 * 32, I_OUT = 16 * 32, I_W1 = 32 * 256, I_W3 = 32 * 256, I_W2 = 32 * 256;
    constexpr int NITEMS = I_IN + I_GLU + I_US + I_UA + I_OUT + I_W1 + I_W3 + I_W2;
    unsigned char* ws = F.ws;
    for (int it = gw; it < NITEMS; it += NGW) {
        int r = it;
        if (r < I_IN) { transpose_item(F.in[2], DIN, 64 * (r / 128), 32 * (r % 128), (bf16_t*)(ws + WS_WIN), 32 * (r % 128), D, scr, lane); continue; } r -= I_IN;
        if (r < I_GLU) { transpose_item(F.in[12], DS, 64 * (r / 16), 32 * (r % 16), (bf16_t*)(ws + WS_WGLU), 32 * (r % 16), DS, scr, lane); continue; } r -= I_GLU;
        if (r < I_US) { transpose_item(F.in[14], D, 64 * (r / 32), 32 * (r % 32), (bf16_t*)(ws + WS_WUS), 32 * (r % 32), DS, scr, lane); continue; } r -= I_US;
        if (r < I_UA) { transpose_item(F.in[15], D, 64 * (r / 32), 32 * (r % 32), (bf16_t*)(ws + WS_WUA), 32 * (r % 32), DA, scr, lane); continue; } r -= I_UA;
        if (r < I_OUT) { transpose_item(F.in[17], D, 64 * (r / 32), 32 * (r % 32), (bf16_t*)(ws + WS_WOUT), 32 * (r % 32), D, scr, lane); continue; } r -= I_OUT;
        if (r < I_W1 + I_W3) { const int w3 = r >= I_W1; if (w3) r -= I_W1; const int e = r >> 8, q = r & 255, k0 = 64 * (q / 16), n0 = 32 * (q % 16);
            transpose_item((w3 ? F.in[24] : F.in[23]) + (size_t)e * D * DE, DE, k0, n0, (bf16_t*)(ws + WS_W13), (size_t)e * 1024 + 256 * (n0 >> 7) + (n0 & 127) + (w3 ? 128 : 0), D, scr, lane); continue; }
        r -= I_W1 + I_W3;
        { const int e = r >> 8, q = r & 255, k0 = 64 * (q / 32), n0 = 32 * (q % 32);
            transpose_item(F.in[25] + (size_t)e * DE * D, D, k0, n0, (bf16_t*)(ws + WS_W2), (size_t)e * 1024 + n0, DE, scr, lane); }
    }
    for (int m = gw; m < T; m += NGW) rms_row_to_bf16(lane, F.in[0] + (size_t)m * D, F.in[1], (bf16_t*)(ws + WS_H1) + (size_t)m * D);
    { bf16_t* WR = (bf16_t*)(ws + WS_WR); const float* wrg = F.in[19]; const float* wre = F.in[21];
      for (int idx = F.vcu * NTHR + F.tid; idx < 256 * D; idx += F.G * NTHR) { const int r = idx >> 10, k = idx & 1023; unsigned o = 0u;
          if (r < 72) { const int c = r < 36 ? r : r - 36; const float w = c < 4 ? wrg[k * 4 + c] : wre[k * 32 + (c - 4)]; const unsigned hb = f2bf(w);
              o = r < 36 ? hb : f2bf(w - __builtin_bit_cast(float, hb << 16)); }
          WR[idx] = (bf16_t)o; } }
}

__device__ __forceinline__ int crow(int r, int hi) { return (r & 3) + 8 * (r >> 2) + 4 * hi; }
constexpr int KVP = 72;
__device__ __forceinline__ void kv_prep_phase(Frame& F) {
    LAS bf16_t* KS = (LAS bf16_t*)(F.lds); LAS bf16_t* VS = KS + 256 * KVP; LAS float* PS = (LAS float*)(F.lds + 2 * 256 * KVP * 2); LAS float* WM = PS + 512;
    const bf16_t* Kb = (const bf16_t*)(F.ws + WS_K); const bf16_t* Vb = (const bf16_t*)(F.ws + WS_V);
    bf16_t* Kf = (bf16_t*)(F.ws + WS_KFRAG); bf16_t* Vf = (bf16_t*)(F.ws + WS_VFRAG); bf16_t* KM = (bf16_t*)(F.ws + WS_KMEAN); float* KN = (float*)(F.ws + WS_KMEAN + 512 * 1024);
    const int tid = F.tid;
    for (int item = F.vcu; item < BATCH * NH * NBLK; item += F.G) {
        const int n = item & 31, h = (item >> 5) & 7, b = item >> 8; const size_t tok0 = (size_t)b * SEQ + 256 * n;
#pragma unroll
        for (int j = 0; j < 4; ++j) { const int q = tid + NTHR * j, row = q >> 3, pc = q & 7; const size_t src = (tok0 + row) * DA + h * HD + pc * 8;
            *(LAS u32x4*)(KS + row * KVP + pc * 8) = *(const u32x4*)(Kb + src); *(LAS u32x4*)(VS + row * KVP + pc * 8) = *(const u32x4*)(Vb + src); }
        __syncthreads();
#pragma unroll
        for (int j = 0; j < 4; ++j) { const int P = tid + NTHR * j, st = P >> 8, ds = (P >> 6) & 3, l2 = P & 63, row = 32 * st + (l2 & 31), col = 16 * ds + 8 * (l2 >> 5);
            *(u32x4*)(Kf + ((size_t)item * 2048 + P) * 8) = *(const LAS u32x4*)(KS + row * KVP + col); }
#pragma unroll
        for (int j = 0; j < 4; ++j) { const int P = tid + NTHR * j, st = P >> 8, ks = (P >> 7) & 1, d0 = (P >> 6) & 1, l2 = P & 63, hi = l2 >> 5, jj = l2 & 31; unsigned w[4];
#pragma unroll
            for (int e = 0; e < 8; e += 2) { const unsigned lo = VS[(32 * st + 16 * ks + crow(e, hi)) * KVP + 32 * d0 + jj], hi16 = VS[(32 * st + 16 * ks + crow(e + 1, hi)) * KVP + 32 * d0 + jj]; w[e >> 1] = lo | (hi16 << 16); }
            *(u32x4*)(Vf + ((size_t)item * 2048 + P) * 8) = (u32x4){w[0], w[1], w[2], w[3]}; }
        { const int d = tid & 63, part = tid >> 6; float s = 0.f;
#pragma unroll 8
          for (int r = 0; r < 32; ++r) s += bf2f(KS[(part * 32 + r) * KVP + d]);
          PS[part * 64 + d] = s; }
        if (tid < 256) { float ss = 0.f;
#pragma unroll
            for (int c = 0; c < 8; ++c) { const u32x4 w = *(const LAS u32x4*)(KS + tid * KVP + c * 8);
                ss += bflo(w.x) * bflo(w.x) + bfhi(w.x) * bfhi(w.x) + bflo(w.y) * bflo(w.y) + bfhi(w.y) * bfhi(w.y) + bflo(w.z) * bflo(w.z) + bfhi(w.z) * bfhi(w.z) + bflo(w.w) * bflo(w.w) + bfhi(w.w) * bfhi(w.w); }
            ss = wave_max(ss); if (F.lane == 0) WM[F.wave] = ss; }
        __syncthreads();
        if (tid < 64) { float s = 0.f;
#pragma unroll
            for (int p = 0; p < 8; ++p) s += PS[p * 64 + tid];
            KM[(size_t)item * 64 + tid] = (bf16_t)f2bf(s * (1.f / 256.f)); }
        if (tid == 0) KN[item] = fmaxf(fmaxf(WM[0], WM[1]), fmaxf(WM[2], WM[3]));
        __syncthreads();
    }
}

__device__ __forceinline__ void ssm_scan_phase(Frame& F) {
    LAS float* FW = (LAS float*)(F.lds);
    const float* E = (const float*)(F.ws + WS_E); bf16_t* UP = (bf16_t*)(F.ws + WS_UP);
    const int w = F.wave, p = F.lane;
    for (int gb = F.vcu; gb < SG * BATCH; gb += F.G) {
        const int g = gb >> 3, b = gb & 7;
        const float lr = F.in[4][g * SP + p], li = F.in[5][g * SP + p], step = __expf(F.in[6][g]);
        float ar, ai; cpow(lr, li, step, 32.f, ar, ai);
        const size_t row0 = (size_t)g * SROWS + b * 256 + 32 * w;
        f32x2 e[32];
#pragma unroll
        for (int j = 0; j < 32; ++j) e[j] = *(const f32x2*)(E + (row0 + j) * 128 + 2 * p);
        float sr = 0.f, si = 0.f;
#pragma unroll
        for (int j = 0; j < 32; ++j) { const float nr = ar * sr - ai * si + e[j].x, ni = ar * si + ai * sr + e[j].y; sr = nr; si = ni; }
        FW[(w * 64 + p) * 2] = sr; FW[(w * 64 + p) * 2 + 1] = si;
        __syncthreads();
        float Ar = ar, Ai = ai;
#pragma unroll
        for (int q = 0; q < 5; ++q) { const float nr = Ar * Ar - Ai * Ai, ni = 2.f * Ar * Ai; Ar = nr; Ai = ni; }
        sr = 0.f; si = 0.f;
        for (int w2 = 0; w2 < w; ++w2) { const float fr = FW[(w2 * 64 + p) * 2], fi = FW[(w2 * 64 + p) * 2 + 1]; const float nr = Ar * sr - Ai * si + fr, ni = Ar * si + Ai * sr + fi; sr = nr; si = ni; }
#pragma unroll
        for (int j = 0; j < 32; ++j) { *(unsigned*)(UP + (row0 + j) * SKY + SKU + 2 * p) = pk2(sr, si);
            const float nr = ar * sr - ai * si + e[j].x, ni = ar * si + ai * sr + e[j].y; sr = nr; si = ni; }
        __syncthreads();
    }
}

constexpr int AQS = 0, AOACC = 36864, ALACC = 102400, AMQ = 103424, AKME = 104448, ALIST = 109056, ACNT = 117248, ATST = 117376, AMISC = 117632, ATAB = 117760;
static_assert(ATAB + 8 * 132 * 4 <= RING_BYTES, "attention LDS");
__device__ __forceinline__ void lds_add_f32(unsigned addr, float v) { asm volatile("ds_add_f32 %0, %1" :: "v"(addr), "v"(v) : "memory"); }
__device__ __forceinline__ int t5_bucket(int d) {
    if (d < 16) return d;
    return 16 + (d >= 19) + (d >= 21) + (d >= 24) + (d >= 27) + (d >= 31) + (d >= 35) + (d >= 40) + (d >= 46) + (d >= 52) + (d >= 59) + (d >= 67) + (d >= 77) + (d >= 87) + (d >= 99) + (d >= 113);
}
struct Top3 { float v0, v1, v2; int i0, i1, i2; };
__device__ __forceinline__ Top3 top3_insert(Top3 t, float x, int n) {
    const bool b0 = (x > t.v0) || (x == t.v0 && n < t.i0), b1 = (x > t.v1) || (x == t.v1 && n < t.i1), b2 = (x > t.v2) || (x == t.v2 && n < t.i2);
    Top3 r;
    r.v2 = b1 ? t.v1 : (b2 ? x : t.v2); r.i2 = b1 ? t.i1 : (b2 ? n : t.i2);
    r.v1 = b0 ? t.v0 : (b1 ? x : t.v1); r.i1 = b0 ? t.i0 : (b1 ? n : t.i1);
    r.v0 = b0 ? x : t.v0; r.i0 = b0 ? n : t.i0;
    return r;
}
__device__ __forceinline__ void attn_unit(Frame& F, int bh, int qb) {
    LAS unsigned char* L = F.lds;
    LAS bf16_t* QS = (LAS bf16_t*)(L + AQS); LAS float* OACC = (LAS float*)(L + AOACC); LAS float* LACC = (LAS float*)(L + ALACC); LAS float* MQ = (LAS float*)(L + AMQ);
    LAS bf16_t* KME = (LAS bf16_t*)(L + AKME); LAS unsigned char* LIST = L + ALIST; LAS int* CNT = (LAS int*)(L + ACNT); LAS int* TST = (LAS int*)(L + ATST);
    LAS int* NEXT = (LAS int*)(L + AMISC); LAS float* KNM = (LAS float*)(L + AMISC + 16); LAS float* TAB = (LAS float*)(L + ATAB);
    const int tid = F.tid, lane = F.lane, w = F.wave, j = lane & 31, hi = lane >> 5;
    const int b = bh >> 3, h = bh & 7; const size_t tok0 = (size_t)b * SEQ + 256 * qb;
    const bf16_t* Qb = (const bf16_t*)(F.ws + WS_Q); const bf16_t* KM = (const bf16_t*)(F.ws + WS_KMEAN); const float* KN = (const float*)(F.ws + WS_KMEAN + 512 * 1024);
    const bf16_t* Kfb = (const bf16_t*)(F.ws + WS_KFRAG) + (size_t)bh * 32 * 2048 * 8; const bf16_t* Vfb = (const bf16_t*)(F.ws + WS_VFRAG) + (size_t)bh * 32 * 2048 * 8;
    bf16_t* YA = (bf16_t*)(F.ws + WS_YATT);
    const LAS float* TABh = TAB + h * 132;
    for (int i = tid; i < 256 * 64 / 4; i += NTHR) ((LAS f32x4*)OACC)[i] = (f32x4){0.f, 0.f, 0.f, 0.f};
    if (tid < 256) LACC[tid] = 0.f;
#pragma unroll
    for (int jj = 0; jj < 4; ++jj) { const int q = tid + NTHR * jj, row = q >> 3, pc = q & 7; *(LAS u32x4*)(QS + row * KVP + pc * 8) = *(const u32x4*)(Qb + (tok0 + row) * DA + h * HD + pc * 8); }
    if (tid < 256) { const int n = tid >> 3, pc = tid & 7; *(LAS u32x4*)(KME + n * KVP + pc * 8) = *(const u32x4*)(KM + ((size_t)bh * 32 + n) * 64 + pc * 8); }
    if (tid < 32) CNT[tid] = 0;
    if (tid == 0) NEXT[0] = 0;
    if (w == 1) { float v = (lane <= qb && lane < 32) ? KN[bh * 32 + lane] : 0.f; v = wave_max(v); if (lane == 0) KNM[0] = v; }
    __syncthreads();
    {
        bf16x8 qf[4], kmf[4];
#pragma unroll
        for (int ds = 0; ds < 4; ++ds) { qf[ds] = *(const LAS bf16x8*)(QS + (32 * w + j) * KVP + 16 * ds + 8 * hi); kmf[ds] = *(const LAS bf16x8*)(KME + j * KVP + 16 * ds + 8 * hi); }
        f32x16 gt = {};
#pragma unroll
        for (int ds = 0; ds < 4; ++ds) gt = __builtin_amdgcn_mfma_f32_32x32x16_bf16(kmf[ds], qf[ds], gt, 0, 0, 0);
        float qn = 0.f;
#pragma unroll
        for (int ds = 0; ds < 4; ++ds)
#pragma unroll
            for (int e = 0; e < 8; ++e) { const float x = bf2f((unsigned short)qf[ds][e]); qn += x * x; }
        qn += __shfl_xor(qn, 32);
        const float m2 = sqrtf(qn * KNM[0]) + TABh[128];
        if (hi == 0) MQ[32 * w + j] = m2;
        Top3 t3; t3.v0 = t3.v1 = t3.v2 = -INFINITY; t3.i0 = t3.i1 = t3.i2 = -1;
#pragma unroll
        for (int r = 0; r < 16; ++r) { const int n = crow(r, hi); const float x = (n < qb) ? gt[r] : -INFINITY; t3 = top3_insert(t3, x, x > -INFINITY ? n : 0x7fffffff); }
        { const float p0 = __shfl_xor(t3.v0, 32), p1 = __shfl_xor(t3.v1, 32), p2 = __shfl_xor(t3.v2, 32); const int q0 = __shfl_xor(t3.i0, 32), q1 = __shfl_xor(t3.i1, 32), q2 = __shfl_xor(t3.i2, 32);
          t3 = top3_insert(t3, p0, q0 >= 0 ? q0 : 0x7fffffff); t3 = top3_insert(t3, p1, q1 >= 0 ? q1 : 0x7fffffff); t3 = top3_insert(t3, p2, q2 >= 0 ? q2 : 0x7fffffff); }
        const int i0 = t3.v0 > -INFINITY ? t3.i0 : -1, i1 = t3.v1 > -INFINITY ? t3.i1 : -1, i2 = t3.v2 > -INFINITY ? t3.i2 : -1;
        if (hi == 0) {
            if (i0 >= 0) { const int pos = __hip_atomic_fetch_add(CNT + i0, 1, __ATOMIC_RELAXED, __HIP_MEMORY_SCOPE_WORKGROUP); LIST[i0 * 256 + pos] = (unsigned char)(32 * w + j); }
            if (i1 >= 0) { const int pos = __hip_atomic_fetch_add(CNT + i1, 1, __ATOMIC_RELAXED, __HIP_MEMORY_SCOPE_WORKGROUP); LIST[i1 * 256 + pos] = (unsigned char)(32 * w + j); }
            if (i2 >= 0) { const int pos = __hip_atomic_fetch_add(CNT + i2, 1, __ATOMIC_RELAXED, __HIP_MEMORY_SCOPE_WORKGROUP); LIST[i2 * 256 + pos] = (unsigned char)(32 * w + j); }
        }
    }
    __syncthreads();
    if (w == 0) { int nt = (lane < qb && lane < 32) ? ((CNT[lane] + 31) >> 5) : 0; int inc = nt;
#pragma unroll
        for (int o = 1; o < 32; o <<= 1) { const int t = __shfl_up(inc, o); if (lane >= o) inc += t; }
        if (lane < 32) TST[lane + 1] = inc; if (lane == 0) TST[0] = 0; }
    __syncthreads();
    const int NTsel = TST[32], NI = NTsel + 8;
    const float b31 = TABh[129];
    for (;;) {
        int it = 0; if (lane == 0) it = __hip_atomic_fetch_add(NEXT, 1, __ATOMIC_RELAXED, __HIP_MEMORY_SCOPE_WORKGROUP);
        it = __builtin_amdgcn_readfirstlane(it);
        if (it >= NI) break;
        int kvblk, ste, ql, dq; bool nearm;
        if (it < NTsel) {
            const int e1 = (lane < 32) ? TST[lane + 1] : 0x7fffffff;
            const int n = __builtin_amdgcn_readfirstlane((int)__popcll(__ballot(e1 <= it)));
            const int chunk = it - __builtin_amdgcn_readfirstlane(TST[n]); const int cn = __builtin_amdgcn_readfirstlane(CNT[n]); const int idx = chunk * 32 + j;
            ql = idx < cn ? (int)LIST[n * 256 + idx] : -1; nearm = (n == qb - 1); dq = 256 + ql; ste = 8; kvblk = n;
        } else { const int w2 = 7 - (it - NTsel); ql = 32 * w2 + j; nearm = true; dq = ql; ste = w2 + 1; kvblk = qb; }
        const int qa = ql >= 0 ? ql : 0;
        bf16x8 qf[4];
#pragma unroll
        for (int ds = 0; ds < 4; ++ds) qf[ds] = *(const LAS bf16x8*)(QS + qa * KVP + 16 * ds + 8 * hi);
        const float m2 = ql >= 0 ? MQ[qa] : INFINITY; const float mfar = m2 - b31;
        const bf16_t* Kf = Kfb + ((size_t)kvblk * 2048 + lane) * 8; const bf16_t* Vf = Vfb + ((size_t)kvblk * 2048 + lane) * 8;
        f32x16 o0 = {}, o1 = {}; float lsum = 0.f;
        for (int st = 0; st < ste; ++st) {
            bf16x8 kf[4], vf[4];
#pragma unroll
            for (int ds = 0; ds < 4; ++ds) kf[ds] = *(const bf16x8*)(Kf + (st * 4 + ds) * 512);
#pragma unroll
            for (int q = 0; q < 4; ++q) vf[q] = *(const bf16x8*)(Vf + (st * 4 + q) * 512);
            f32x16 s = {};
#pragma unroll
            for (int ds = 0; ds < 4; ++ds) s = __builtin_amdgcn_mfma_f32_32x32x16_bf16(kf[ds], qf[ds], s, 0, 0, 0);
            float p[16];
            if (!nearm) {
#pragma unroll
                for (int r = 0; r < 16; ++r) p[r] = __builtin_amdgcn_exp2f(s[r] - mfar);
            } else {
#pragma unroll
                for (int r = 0; r < 16; ++r) { const int dist = dq - (32 * st + crow(r, hi)); const int di = dist < 0 ? 0 : (dist > 127 ? 127 : dist);
                    const float e = __builtin_amdgcn_exp2f(s[r] + TABh[di] - m2); p[r] = dist >= 0 ? e : 0.f; }
            }
#pragma unroll
            for (int r = 0; r < 16; ++r) lsum += p[r];
            u32x4 pa, pb; pa.x = cvt_pk_bf16(p[0], p[1]); pa.y = cvt_pk_bf16(p[2], p[3]); pa.z = cvt_pk_bf16(p[4], p[5]); pa.w = cvt_pk_bf16(p[6], p[7]);
            pb.x = cvt_pk_bf16(p[8], p[9]); pb.y = cvt_pk_bf16(p[10], p[11]); pb.z = cvt_pk_bf16(p[12], p[13]); pb.w = cvt_pk_bf16(p[14], p[15]);
            const bf16x8 A0 = __builtin_bit_cast(bf16x8, pa), A1 = __builtin_bit_cast(bf16x8, pb);
            o0 = __builtin_amdgcn_mfma_f32_32x32x16_bf16(A0, vf[0], o0, 0, 0, 0); o1 = __builtin_amdgcn_mfma_f32_32x32x16_bf16(A0, vf[1], o1, 0, 0, 0);
            o0 = __builtin_amdgcn_mfma_f32_32x32x16_bf16(A1, vf[2], o0, 0, 0, 0); o1 = __builtin_amdgcn_mfma_f32_32x32x16_bf16(A1, vf[3], o1, 0, 0, 0);
        }
        const float lt = lsum + __shfl_xor(lsum, 32);
        if (hi == 0 && ql >= 0) lds_add_f32((unsigned)(uintptr_t)(LACC + ql), lt);
#pragma unroll
        for (int r = 0; r < 16; ++r) { const int qrow = __shfl(ql, crow(r, hi));
            if (qrow >= 0) { const unsigned a = (unsigned)(uintptr_t)(OACC + qrow * 64 + j); lds_add_f32(a, o0[r]); lds_add_f32(a + 128u, o1[r]); } }
    }
    LDS_WAIT();
    __syncthreads();
    { const int ql = tid >> 1, half = tid & 1; const float inv = 1.f / LACC[ql]; const LAS f32x4* src = (const LAS f32x4*)(OACC + ql * 64 + 32 * half);
      bf16_t* dst = YA + (tok0 + ql) * DA + h * HD + 32 * half;
#pragma unroll
      for (int c = 0; c < 4; ++c) { const f32x4 a = src[2 * c] * inv, bq = src[2 * c + 1] * inv; *(u32x4*)(dst + 8 * c) = pack8(a, bq); } }
    __syncthreads();
}
__device__ __forceinline__ void attn_phase(Frame& F) {
    LAS float* TAB = (LAS float*)(F.lds + ATAB); const float* rb = F.in[16];
    for (int idx = F.tid; idx < 8 * 132; idx += NTHR) { const int h = idx / 132, d = idx % 132; float v = 0.f;
        if (d < 128) v = rb[h * 32 + t5_bucket(d)] * LOG2E;
        else if (d == 128) { float m = rb[h * 32]; for (int q = 1; q < 32; ++q) m = fmaxf(m, rb[h * 32 + q]); v = m * LOG2E; }
        else if (d == 129) v = rb[h * 32 + 31] * LOG2E;
        TAB[idx] = v; }
    __syncthreads();
    for (int quad = F.vcu; quad < 256; quad += F.G) { const int bh = quad >> 2, s = quad & 3;
        for (int i = 0; i < 8; ++i) { const int base = (i >> 1) * 8; const int qb = (i & 1) ? base + 7 - s : base + s; attn_unit(F, bh, qb); } }
}

__device__ __forceinline__ void routing_phase(Frame& F) {
    LAS int* lcnt = (LAS int*)(F.lds); LAS int* lbase = lcnt + 32;
    const float* SSQ = (const float*)(F.ws + WS_SSQ); const float* RL = (const float*)(F.ws + WS_RLOG);
    unsigned* rowtok = (unsigned*)(F.ws + WS_ROWTOK); float* rowcoef = (float*)(F.ws + WS_ROWCOEF); float* rowrstd = (float*)(F.ws + WS_ROWRSTD);
    unsigned* ecnt = (unsigned*)(F.ctl + CW_ECNT);
    const float* brg = F.in[20]; const float* bre = F.in[22];
    const int tid = F.tid;
    for (int base = F.vcu * 256; base < T; base += F.G * 256) {
        if (tid < 32) lcnt[tid] = 0;
        __syncthreads();
        int e0 = 0, e1 = 0, lp0 = 0, lp1 = 0; float c0 = 0.f, c1 = 0.f, rstd = 0.f; const int tok = base + tid;
        if (tid < 256) {
            float ss = 0.f;
#pragma unroll
            for (int q = 0; q < 4; ++q) { const f32x4 v = *(const f32x4*)(SSQ + (size_t)tok * 16 + 4 * q); ss += (v.x + v.y) + (v.z + v.w); }
            rstd = 1.f / sqrtf(ss * (1.f / D) + RMS_EPS);
            float r[72];
#pragma unroll
            for (int q = 0; q < 18; ++q) { const f32x4 v = *(const f32x4*)(RL + (size_t)tok * 72 + 4 * q); r[4 * q] = v.x; r[4 * q + 1] = v.y; r[4 * q + 2] = v.z; r[4 * q + 3] = v.w; }
            float gl[4], el[32];
#pragma unroll
            for (int c = 0; c < 4; ++c) gl[c] = rstd * (r[c] + r[36 + c]) + brg[c];
#pragma unroll
            for (int c = 0; c < 32; ++c) el[c] = rstd * (r[4 + c] + r[40 + c]) + bre[c];
            int gi = 0; float gm = gl[0];
#pragma unroll
            for (int c = 1; c < 4; ++c) if (gl[c] > gm) { gm = gl[c]; gi = c; }
            float Z = 0.f;
#pragma unroll
            for (int c = 0; c < 4; ++c) Z += __expf(gl[c] - gm);
            const float gval = 1.f / Z;
            float es[8];
#pragma unroll
            for (int q = 0; q < 8; ++q) es[q] = gi == 0 ? el[q] : (gi == 1 ? el[8 + q] : (gi == 2 ? el[16 + q] : el[24 + q]));
            int a0 = 0; float m0 = es[0];
#pragma unroll
            for (int q = 1; q < 8; ++q) if (es[q] > m0) { m0 = es[q]; a0 = q; }
            int a1 = -1; float m1 = -INFINITY;
#pragma unroll
            for (int q = 0; q < 8; ++q) if (q != a0 && es[q] > m1) { m1 = es[q]; a1 = q; }
            const float w0 = 1.f / (1.f + __expf(m1 - m0)), w1 = 1.f - w0;
            e0 = gi * 8 + a0; e1 = gi * 8 + a1; c0 = gval * w0; c1 = gval * w1;
            lp0 = __hip_atomic_fetch_add(lcnt + e0, 1, __ATOMIC_RELAXED, __HIP_MEMORY_SCOPE_WORKGROUP);
            lp1 = __hip_atomic_fetch_add(lcnt + e1, 1, __ATOMIC_RELAXED, __HIP_MEMORY_SCOPE_WORKGROUP);
        }
        __syncthreads();
        if (tid < 32) lbase[tid] = (int)__hip_atomic_fetch_add(ecnt + tid, (unsigned)lcnt[tid], __ATOMIC_RELAXED, __HIP_MEMORY_SCOPE_AGENT);
        __syncthreads();
        if (tid < 256) {
            const size_t i0 = (size_t)e0 * ROWCAP + lbase[e0] + lp0, i1 = (size_t)e1 * ROWCAP + lbase[e1] + lp1;
            rowtok[i0] = (unsigned)tok * 2u; rowcoef[i0] = c0; rowrstd[i0] = rstd;
            rowtok[i1] = (unsigned)tok * 2u + 1u; rowcoef[i1] = c1; rowrstd[i1] = rstd;
        }
        __syncthreads();
    }
}
struct MoeOrder {
    const LAS int* tst; int total, G, v;
    __device__ bool next(int i, pg8::Unit& u) const {
        const int L = i * G + v; if (L >= total) return false;
        const int rt = L >> 2; int e = 0;
#pragma unroll 8
        for (int q = 1; q <= 32; ++q) e += (tst[q] <= rt) ? 1 : 0;
        u.pm = rt; u.pn = L & 3; u.pb = e * 4 + u.pn; u.aux = e; u.aux2 = (rt - tst[e]) * 256; return true;
    }
};
__device__ __forceinline__ void moe_tables(Frame& F) {
    LAS int* tst = (LAS int*)(F.lds + MOE_TST_OFF); const unsigned* ecnt = (const unsigned*)(F.ctl + CW_ECNT);
    if (F.wave == 0) { const int lane = F.lane; int nt = lane < 32 ? (int)((ecnt[lane & 31] + 255u) >> 8) : 0; int inc = nt;
#pragma unroll
        for (int o = 1; o < 32; o <<= 1) { const int t = __shfl_up(inc, o); if (lane >= o) inc += t; }
        if (lane < 32) tst[lane + 1] = inc; if (lane == 0) tst[0] = 0; }
    __syncthreads();
}
__device__ __forceinline__ void final_phase(Frame& F) {
    const float* X1 = (const float*)(F.ws + WS_X1); const bf16_t* Y0 = (const bf16_t*)(F.ws + WS_Y0); const bf16_t* Y1 = (const bf16_t*)(F.ws + WS_Y1); const float* gf = F.in[26];
    const int gw = F.vcu * NWAVES + F.wave, NGW = F.G * NWAVES, lane = F.lane;
    for (int m = gw; m < T; m += NGW) {
        const f32x4* xr = (const f32x4*)(X1 + (size_t)m * D) + lane; const u32x2* y0 = (const u32x2*)(Y0 + (size_t)m * D) + lane; const u32x2* y1 = (const u32x2*)(Y1 + (size_t)m * D) + lane;
        f32x4 v[4]; float s = 0.f;
#pragma unroll
        for (int j = 0; j < 4; ++j) { v[j] = xr[64 * j]; const u32x2 a = y0[64 * j], c = y1[64 * j];
            v[j].x += bflo(a.x) + bflo(c.x); v[j].y += bfhi(a.x) + bfhi(c.x); v[j].z += bflo(a.y) + bflo(c.y); v[j].w += bfhi(a.y) + bfhi(c.y);
            s += (v[j].x * v[j].x + v[j].y * v[j].y) + (v[j].z * v[j].z + v[j].w * v[j].w); }
        const float rstd = 1.f / sqrtf(wave_sum(s) * (1.f / D) + RMS_EPS);
        f32x4* o = (f32x4*)(F.out + (size_t)m * D) + lane; const f32x4* gr = (const f32x4*)gf + lane;
#pragma unroll
        for (int j = 0; j < 4; ++j) o[64 * j] = v[j] * rstd * gr[64 * j];
    }
}
#ifndef MK_N_LAUNCHES
#define MK_N_LAUNCHES 1
#endif
constexpr int NPHASE = 13;
struct Args { const float* in[27]; float* out; unsigned char* ws; int ph_lo, ph_hi; };
static_assert(sizeof(Args) == 27 * 8 + 8 + 8 + 8, "Args has no padding");

__global__ void __launch_bounds__(NTHR, 2) fwd_kernel(Args args) {
    extern __shared__ __attribute__((aligned(16))) unsigned char lds_raw[];
    Frame F;
    F.lds = (LAS unsigned char*)lds_raw;
    F.MISC = (volatile LAS unsigned*)(F.lds + MISC_OFF);
    F.tid = threadIdx.x; F.lane = F.tid & 63; F.wave = __builtin_amdgcn_readfirstlane(F.tid >> 6);
    F.G = gridDim.x; { const int bx = blockIdx.x; F.vcu = (F.G % 8 == 0) ? (bx % 8) * (F.G / 8) + bx / 8 : bx; }
    F.ws = args.ws; F.ctl = (gu32*)(args.ws + WS_CTL); F.out = args.out;
#pragma unroll
    for (int i = 0; i < 27; ++i) F.in[i] = args.in[i];
    for (int u = F.tid; u < (LDS_BYTES - MOE_TST_OFF) / 4; u += NTHR) ((LAS unsigned*)(F.lds + MOE_TST_OFF))[u] = 0u;
    __syncthreads();
    XcdBarrier bar; bar.bar = (unsigned*)(F.ctl + CW_BAR); bar.x = 0; bar.st = nullptr;
    const int lo = args.ph_lo, hi = args.ph_hi;
    if (hi - lo > 1) bar = xcd_barrier_post((unsigned*)(F.ctl + CW_BAR), F.MISC + 8);
#define IN(k) (lo <= (k) && (k) < hi)
#define SEAM(k) do { if (IN(k) && IN((k) + 1)) xcd_barrier(bar); } while (0)
    unsigned char* ws = args.ws;
    LAS unsigned char* ring = F.lds;

    if (IN(0)) { p0_prologue(F); }
    SEAM(0);
    if (IN(1)) {
        pg8::Gemm g{(const bf16_t*)(ws + WS_H1), (const bf16_t*)(ws + WS_WIN), D, D, D}; pg8::StaticOrder S; S.init(T, DIN, F.G, (int)blockIdx.x);
        EpiProj E{ws, F.in[3]};
        pg8::gemm_phase<EpiProj, pg8::StaticOrder, true, false>(ring, g, S, E, nullptr);
    }
    SEAM(1);
    if (IN(2)) {
        { pg8::Gemm g{(const bf16_t*)(ws + WS_UP), (const bf16_t*)(ws + WS_SSMW), SKY, SKU, SKU}; pg8::GroupedOrder S; S.init(SG * 8, 1, 8, F.G, F.vcu);
          EpiSsmE E{(float*)(ws + WS_E)};
          pg8::gemm_phase<EpiSsmE, pg8::GroupedOrder, false, false>(ring, g, S, E, nullptr); }
        __syncthreads();
        kv_prep_phase(F);
    }
    SEAM(2);
    if (IN(3)) { ssm_scan_phase(F); attn_phase(F); }
    SEAM(3);
    if (IN(4)) {
        pg8::Gemm g{(const bf16_t*)(ws + WS_UP), (const bf16_t*)(ws + WS_SSMT), SKY, SKY, SKY}; pg8::GroupedOrder S; S.init(SG * 8, 2, 8, F.G, F.vcu);
        EpiSsmY E{(bf16_t*)(ws + WS_GACT)};
        pg8::gemm_phase<EpiSsmY, pg8::GroupedOrder, true, false>(ring, g, S, E, nullptr);
    }
    SEAM(4);
    if (IN(5)) {
        pg8::Gemm g{(const bf16_t*)(ws + WS_GACT), (const bf16_t*)(ws + WS_WGLU), DS, DS, DS}; pg8::StaticOrder S; S.init(T, DS, F.G, (int)blockIdx.x);
        EpiGlu E{(const bf16_t*)(ws + WS_GACT), (bf16_t*)(ws + WS_YSSM), F.in[13]};
        pg8::gemm_phase<EpiGlu, pg8::StaticOrder, true, false>(ring, g, S, E, nullptr);
    }
    SEAM(5);
    if (IN(6)) {
        { pg8::Gemm g{(const bf16_t*)(ws + WS_YSSM), (const bf16_t*)(ws + WS_WUS), DS, DS, DS}; pg8::StaticOrder S; S.init(T, D, F.G, (int)blockIdx.x);
          EpiUp<false> E{(const bf16_t*)(ws + WS_SGS), (bf16_t*)(ws + WS_MRG)};
          pg8::gemm_phase<EpiUp<false>, pg8::StaticOrder, true, false>(ring, g, S, E, nullptr); }
        VM_WAIT(); __syncthreads();
        { pg8::Gemm g{(const bf16_t*)(ws + WS_YATT), (const bf16_t*)(ws + WS_WUA), DA, DA, DA}; pg8::StaticOrder S; S.init(T, D, F.G, (int)blockIdx.x);
          EpiUp<true> E{(const bf16_t*)(ws + WS_SGA), (bf16_t*)(ws + WS_MRG)};
          pg8::gemm_phase<EpiUp<true>, pg8::StaticOrder, true, false>(ring, g, S, E, nullptr); }
    }
    SEAM(6);
    if (IN(7)) {
        pg8::Gemm g{(const bf16_t*)(ws + WS_MRG), (const bf16_t*)(ws + WS_WOUT), D, D, D}; pg8::StaticOrder S; S.init(T, D, F.G, (int)blockIdx.x);
        EpiOut E{F.in[0], (float*)(ws + WS_X1), (bf16_t*)(ws + WS_XG), F.in[18], (float*)(ws + WS_SSQ)};
        pg8::gemm_phase<EpiOut, pg8::StaticOrder, true, false>(ring, g, S, E, nullptr);
    }
    SEAM(7);
    if (IN(8)) {
        pg8::Gemm g{(const bf16_t*)(ws + WS_XG), (const bf16_t*)(ws + WS_WR), D, D, D}; pg8::StaticOrder S; S.init(T, 256, F.G, (int)blockIdx.x);
        EpiRouter E{(float*)(ws + WS_RLOG)};
        pg8::gemm_phase<EpiRouter, pg8::StaticOrder, false, false>(ring, g, S, E, nullptr);
    }
    SEAM(8);
    if (IN(9)) { routing_phase(F); }
    SEAM(9);
    if (IN(10)) {
        moe_tables(F);
        const LAS int* tst = (const LAS int*)(F.lds + MOE_TST_OFF);
        MoeOrder S{tst, tst[32] * 4, F.G, F.vcu};
        LAS unsigned* rowtab = (LAS unsigned*)(F.lds + ROWTAB_OFF);
        { const unsigned* rowtok = (const unsigned*)(ws + WS_ROWTOK); const unsigned* ecnt = (const unsigned*)(F.ctl + CW_ECNT); pg8::Unit u;
          for (int i = 0; i < ROWTAB_UNITS && S.next(i, u); ++i) { if (F.tid < 256) { const int pos = u.aux2 + F.tid; const unsigned tk = pos < (int)ecnt[u.aux] ? (rowtok[(size_t)u.aux * ROWCAP + pos] >> 1) : 0u; rowtab[i * 256 + F.tid] = tk * (unsigned)(D * 2); } } }
        __syncthreads();
        pg8::Gemm g{(const bf16_t*)(ws + WS_XG), (const bf16_t*)(ws + WS_W13), D, D, D};
        EpiMoe1 E{(bf16_t*)(ws + WS_HID), (const float*)(ws + WS_ROWRSTD), (const unsigned*)(F.ctl + CW_ECNT)};
        pg8::gemm_phase<EpiMoe1, MoeOrder, true, true>(ring, g, S, E, rowtab);
    }
    SEAM(10);
    if (IN(11)) {
        moe_tables(F);
        const LAS int* tst = (const LAS int*)(F.lds + MOE_TST_OFF);
        MoeOrder S{tst, tst[32] * 4, F.G, F.vcu};
        pg8::Gemm g{(const bf16_t*)(ws + WS_HID), (const bf16_t*)(ws + WS_W2), DE, DE, DE};
        EpiMoe2 E{(bf16_t*)(ws + WS_Y0), (size_t)(WS_Y1 - WS_Y0), (const unsigned*)(ws + WS_ROWTOK), (const float*)(ws + WS_ROWCOEF), (const unsigned*)(F.ctl + CW_ECNT)};
        pg8::gemm_phase<EpiMoe2, MoeOrder, true, false>(ring, g, S, E, nullptr);
    }
    SEAM(11);
    if (IN(12)) { final_phase(F); }
#undef IN
#undef SEAM
}

extern "C" void kernel_launch(void* const* d_in, const int* in_sizes, int n_in, void* d_out, int out_size, void* d_ws, size_t ws_size, hipStream_t stream) {
    static int grid = 0;
    if (grid == 0) {
        if (n_in != 27 || in_sizes[0] != T * D || out_size != T * D || ws_size < WS_END) { fprintf(stderr, "kernel_launch: unexpected shapes (n_in %d, in0 %d, out %d, ws %zu)\n", n_in, n_in > 0 ? in_sizes[0] : -1, out_size, ws_size); grid = -1; return; }
        int dev = 0, cus = 0;
        if (hipGetDevice(&dev) != hipSuccess || hipDeviceGetAttribute(&cus, hipDeviceAttributeMultiprocessorCount, dev) != hipSuccess) { grid = -1; return; }
        if (hipFuncSetAttribute((const void*)fwd_kernel, hipFuncAttributeMaxDynamicSharedMemorySize, LDS_BYTES) != hipSuccess) { fprintf(stderr, "kernel_launch: hipFuncSetAttribute failed\n"); grid = -1; return; }
        (void)hipGetLastError();
        grid = cus;
    }
    if (grid < 0) return;
    (void)hipMemsetAsync((char*)d_ws + WS_CTL, 0, CTL_ZERO_BYTES, stream);
    Args a{};
    for (int i = 0; i < 27; ++i) a.in[i] = (const float*)d_in[i];
    a.out = (float*)d_out; a.ws = (unsigned char*)d_ws;
    if (MK_N_LAUNCHES == 1) { a.ph_lo = 0; a.ph_hi = NPHASE; hipLaunchKernelGGL(fwd_kernel, dim3(grid), dim3(NTHR), LDS_BYTES, stream, a); }
    else { for (int p = 0; p < NPHASE; ++p) { a.ph_lo = p; a.ph_hi = p + 1; hipLaunchKernelGGL(fwd_kernel, dim3(grid), dim3(NTHR), LDS_BYTES, stream, a); } }
}
```

```cpp
#include <hip/hip_runtime.h>
#include <cstdio>
#include <cstdint>

#define LAS __attribute__((address_space(3)))
#define GAS __attribute__((address_space(1)))
typedef unsigned short bf16_t;
typedef short bf16x8 __attribute__((ext_vector_type(8)));
typedef float f32x2 __attribute__((ext_vector_type(2)));
typedef float f32x4 __attribute__((ext_vector_type(4)));
typedef float f32x16 __attribute__((ext_vector_type(16)));
typedef unsigned u32x2 __attribute__((ext_vector_type(2)));
typedef unsigned u32x4 __attribute__((ext_vector_type(4)));
typedef GAS unsigned gu32;
#define RLX_AGENT __ATOMIC_RELAXED, __HIP_MEMORY_SCOPE_AGENT
#define LDS_WAIT() asm volatile("s_waitcnt lgkmcnt(0)" ::: "memory")
#define VM_WAIT() asm volatile("s_waitcnt vmcnt(0)" ::: "memory")

__device__ __forceinline__ unsigned f2bf(float f) { unsigned u = __builtin_bit_cast(unsigned, f); return (u + 0x7fffu + ((u >> 16) & 1u)) >> 16; }
__device__ __forceinline__ unsigned pk2(float lo, float hi) { return f2bf(lo) | (f2bf(hi) << 16); }
__device__ __forceinline__ float bf2f(unsigned short b) { return __builtin_bit_cast(float, (unsigned)b << 16); }
__device__ __forceinline__ float bflo(unsigned w) { return __builtin_bit_cast(float, w << 16); }
__device__ __forceinline__ float bfhi(unsigned w) { return __builtin_bit_cast(float, w & 0xffff0000u); }
__device__ __forceinline__ unsigned cvt_pk_bf16(float lo, float hi) { unsigned r; asm volatile("v_cvt_pk_bf16_f32 %0, %1, %2" : "=v"(r) : "v"(lo), "v"(hi)); return r; }
__device__ __forceinline__ float fast_sigmoid(float x) { return __builtin_amdgcn_rcpf(1.f + __builtin_amdgcn_exp2f(-1.4426950408889634f * x)); }
__device__ __forceinline__ float wave_sum(float v) {
#pragma unroll
    for (int o = 1; o < 64; o <<= 1) v += __shfl_xor(v, o);
    return v;
}
__device__ __forceinline__ float wave_max(float v) {
#pragma unroll
    for (int o = 1; o < 64; o <<= 1) v = fmaxf(v, __shfl_xor(v, o));
    return v;
}

#define XB_TMO      128
#define XB_XCNT(j)  (256  + 64 * (j))
#define XB_XSUB(j)  (1280 + 64 * (j))
#define XB_XGEN(j)  (2304 + 64 * (j))
#define XB_TOP      3328
#define XB_TOPGEN   3392
#define XCD_BAR_WORDS 3456
#define XB_SPIN_CAP (1u << 20)

__device__ __forceinline__ unsigned xb_ld(unsigned* p)              { return __hip_atomic_load(p, __ATOMIC_RELAXED, __HIP_MEMORY_SCOPE_AGENT); }
__device__ __forceinline__ unsigned xb_add(unsigned* p, unsigned v) { return __hip_atomic_fetch_add(p, v, __ATOMIC_RELAXED, __HIP_MEMORY_SCOPE_AGENT); }
__device__ __forceinline__ unsigned xb_xcc_id() { return (unsigned)__builtin_amdgcn_s_getreg((3 << 11) | 20) & 0xFu; }
#define XB_SPIN(cond, bar) do { unsigned _sp = 0; while (cond) { __builtin_amdgcn_s_sleep(1); \
    if ((++_sp & 255u) == 0u) { if (xb_ld(&(bar)[XB_TMO])) break; if (_sp > XB_SPIN_CAP) { atomicAdd(&(bar)[XB_TMO], 1u); break; } } } } while (0)

struct XcdBarrier { unsigned* bar; unsigned x; volatile LAS unsigned* st; };

__device__ __forceinline__ XcdBarrier xcd_barrier_post(unsigned* bar, volatile LAS unsigned* st) {
    XcdBarrier b; b.bar = bar; b.x = xb_xcc_id(); b.st = st;
    if (threadIdx.x == 0) (void)xb_add(&bar[XB_XCNT(b.x)], 1u);
    return b;
}
__device__ __forceinline__ void xcd_barrier_complete(unsigned* bar, unsigned x, unsigned& nloc, unsigned& nx) {
    const unsigned G = gridDim.x * gridDim.y * gridDim.z;
    unsigned sum, cnt, mine, sp = 0u;
    for (;;) {
        sum = 0u; cnt = 0u; mine = 0u;
#pragma unroll
        for (unsigned j = 0; j < 16; ++j) { const unsigned c = xb_ld(&bar[XB_XCNT(j)]); sum += c; cnt += (c > 0u) ? 1u : 0u; mine = (j == x) ? c : mine; }
        if (sum == G) break;
        __builtin_amdgcn_s_sleep(1);
        if ((++sp & 255u) == 0u) { if (xb_ld(&bar[XB_TMO])) break; if (sp > XB_SPIN_CAP) { atomicAdd(&bar[XB_TMO], 1u); break; } }
    }
    nloc = mine > 0u ? mine : 1u; nx = cnt > 0u ? cnt : 1u;
}
__device__ __forceinline__ void xcd_barrier(const XcdBarrier& b) {
    asm volatile("s_waitcnt vmcnt(0)" ::: "memory");
    __syncthreads();
    if (threadIdx.x == 0) {
        unsigned* bar = b.bar;
        __builtin_amdgcn_s_waitcnt(0);
        unsigned nloc = b.st[0], nx = b.st[1];
        if (nloc == 0u) { xcd_barrier_complete(bar, b.x, nloc, nx); b.st[0] = nloc; b.st[1] = nx; }
        const unsigned old = xb_add(&bar[XB_XSUB(b.x)], 1u);
        const unsigned gen = old / nloc;
        if (old + 1u == (gen + 1u) * nloc) {
            __builtin_amdgcn_fence(__ATOMIC_RELEASE, "agent");
            asm volatile("s_waitcnt vmcnt(0)" ::: "memory");
            const unsigned og = xb_add(&bar[XB_TOP], 1u);
            const unsigned tg = og / nx;
            if (og + 1u == (tg + 1u) * nx) xb_add(&bar[XB_TOPGEN], 1u);
            else XB_SPIN(xb_ld(&bar[XB_TOPGEN]) == tg, bar);
            __builtin_amdgcn_fence(__ATOMIC_ACQUIRE, "agent");
            xb_add(&bar[XB_XGEN(b.x)], 1u);
            asm volatile("s_waitcnt vmcnt(0)" ::: "memory");
        } else {
            XB_SPIN(xb_ld(&bar[XB_XGEN(b.x)]) == gen, bar);
            __builtin_amdgcn_fence(__ATOMIC_ACQUIRE, "agent");
            asm volatile("s_waitcnt vmcnt(0)" ::: "memory");
        }
    }
    __syncthreads();
}

namespace pg8 {
constexpr int BM = 256, BK = 64, HALF = 128, HTB = HALF * BK * 2, STAGE_BYTES = 8 * HTB, NXCD = 8, WGM = 8;
__host__ __device__ __forceinline__ int lds_byte(int r, int c) { const int st = (r >> 4) * 2 + (c >> 5), rr = r & 15, cc = c & 31, ob = rr * 64 + cc * 2; return st * 1024 + (ob ^ (((ob >> 9) & 1) << 5)); }
__host__ __device__ __forceinline__ void stage_rc(int b, int& R, int& C) { const int st = b / 1024, sb = b % 1024, swz = sb ^ (((sb >> 9) & 1) << 5); R = (st >> 1) * 16 + swz / 64; C = (st & 1) * 32 + (swz % 64) / 2; }
__host__ __device__ __forceinline__ int perm32(int rho) { const int n = rho >> 4, i = rho & 15; return 8 * (i >> 2) + 4 * n + (i & 3); }

struct Unit { int pm, pn, pb, aux, aux2; };
struct Gemm { const bf16_t* A; const bf16_t* Bt; int lda, ldb, K; };

struct StaticOrder {
    int nM, nN, nwg, G, c;
    __device__ void init(int M, int N, int G_, int c_) { nM = M / BM; nN = N / BM; nwg = nM * nN; G = G_; c = c_; }
    __device__ bool next(int i, Unit& u) const {
        const long L = (long)i * G + c; if (L >= nwg) return false;
        int wgid = (int)L; { const int q = nwg / NXCD, r = nwg % NXCD, xcd = wgid % NXCD, off = wgid / NXCD; wgid = (xcd < r ? xcd * (q + 1) : r * (q + 1) + (xcd - r) * q) + off; }
        const int nig = WGM * nN, gid = wgid / nig, fm = gid * WGM, gsz = (nM - fm) < WGM ? (nM - fm) : WGM;
        u.pm = fm + ((wgid % nig) % gsz); u.pn = (wgid % nig) / gsz; u.pb = u.pn; u.aux = 0; u.aux2 = 0; return true;
    }
};
struct GroupedOrder {
    int nM, nN, rtpg, G, v;
    __device__ void init(int nM_, int nN_, int rtpg_, int G_, int v_) { nM = nM_; nN = nN_; rtpg = rtpg_; G = G_; v = v_; }
    __device__ bool next(int i, Unit& u) const {
        const int L = i * G + v; if (L >= nM * nN) return false;
        u.pm = L / nN; u.pn = L % nN; u.aux = u.pm / rtpg; u.pb = u.aux * nN + u.pn; u.aux2 = 0; return true;
    }
};

template <class Epi, class Sched, bool ALIGN_EPI, bool GATHER>
__device__ __forceinline__ void gemm_phase(LAS unsigned char* lds, const Gemm g, const Sched& S, const Epi& E, const LAS unsigned* rowtab  ) {
    const int tid = threadIdx.x, wid = __builtin_amdgcn_readfirstlane(tid >> 6), lane = tid & 63, wr = wid >> 2, wc = wid & 3, fr = lane & 15, fq = lane >> 4;
    const int K = g.K, nt = K / BK;
    int RA[2]; unsigned cA2[2]; unsigned voffB[2];
#pragma unroll
    for (int i = 0; i < 2; ++i) { int R, C; stage_rc(tid * 16 + i * 8192, R, C); const int Rb = (R & ~31) + perm32(R & 31);
        RA[i] = R; cA2[i] = (unsigned)C * 2u; voffB[i] = (unsigned)(Rb * g.ldb + C) * 2u; }
    const size_t kstep = (size_t)(BK * 2);
    const size_t hstepB = (size_t)HALF * g.ldb * 2, tstepB = 2 * hstepB;
    const size_t tstepA = (size_t)BM * g.lda * 2;
    const unsigned ldsw = (unsigned)wid * 1024u;
    const int aoff = lds_byte(wr * 64 + fr, fq * 8), boff = lds_byte(wc * 32 + fr, fq * 8);
    unsigned vAc[2][2], vAn[2][2];
#define PG8_SETVA(dst, ui_) do { _Pragma("unroll") for (int h_ = 0; h_ < 2; ++h_) _Pragma("unroll") for (int i_ = 0; i_ < 2; ++i_) \
        dst[h_][i_] = (GATHER ? rowtab[(ui_) * 256 + h_ * 128 + RA[i_]] : (unsigned)((h_ * 128 + RA[i_]) * g.lda) * 2u) + cA2[i_]; } while (0)
#define PG8_SA(b, h) (((b) * 2 + (h)) * HTB)
#define PG8_SB(b, h) ((4 + (b) * 2 + (h)) * HTB)
#define PG8_STAGE(bufoff, gbase, v0, v1) do { \
        __builtin_amdgcn_global_load_lds((const unsigned*)((const char*)(gbase) + (v0)), (LAS unsigned*)(lds + (bufoff) + ldsw), 16, 0, 0); \
        __builtin_amdgcn_global_load_lds((const unsigned*)((const char*)(gbase) + (v1)), (LAS unsigned*)(lds + (bufoff) + ldsw + 8192), 16, 0, 0); } while (0)
#define PG8_STB(bufoff, gbase) PG8_STAGE(bufoff, gbase, voffB[0], voffB[1])
#define PG8_LDA(dst, b, h) do { _Pragma("unroll") for (int m = 0; m < 4; ++m) _Pragma("unroll") for (int k = 0; k < 2; ++k) dst[m][k] = *(const LAS bf16x8*)(lds + PG8_SA(b, h) + aoff + m * 2048 + k * 1024); } while (0)
#define PG8_LDB(dst, b, h) do { _Pragma("unroll") for (int n = 0; n < 2; ++n) _Pragma("unroll") for (int k = 0; k < 2; ++k) dst[n][k] = *(const LAS bf16x8*)(lds + PG8_SB(b, h) + boff + n * 2048 + k * 1024); } while (0)
#define PG8_MMA(ai, bj, At, Bt) do { __builtin_amdgcn_s_setprio(1); _Pragma("unroll") for (int m = 0; m < 4; ++m) _Pragma("unroll") for (int n = 0; n < 2; ++n) _Pragma("unroll") for (int k = 0; k < 2; ++k) \
        acc[ai][bj][m][n] = __builtin_amdgcn_mfma_f32_16x16x32_bf16(Bt[n][k], At[m][k], acc[ai][bj][m][n], 0, 0, 0); __builtin_amdgcn_s_setprio(0); } while (0)
#define PG8_WAIT_V(n) asm volatile("s_waitcnt vmcnt(" #n ")" ::: "memory")
#define PG8_WAIT_L(n) asm volatile("s_waitcnt lgkmcnt(" #n ")" ::: "memory")
#define PG8_BAR __builtin_amdgcn_s_barrier()
#define PG8_SCHED __builtin_amdgcn_sched_barrier(0)
    Unit cur, nxt; int ui = 0;
    if (!S.next(0, cur)) return;
    f32x4 acc[2][2][4][2];
#pragma unroll
    for (int a = 0; a < 2; ++a)
#pragma unroll
        for (int b = 0; b < 2; ++b)
#pragma unroll
            for (int m = 0; m < 4; ++m)
#pragma unroll
                for (int n = 0; n < 2; ++n) acc[a][b][m][n] = (f32x4){0.f, 0.f, 0.f, 0.f};
    bf16x8 At[4][2], B0[2][2], B1[2][2];
    const char* cA = (const char*)g.A + (GATHER ? (size_t)0 : (size_t)cur.pm * tstepA); const char* cB = (const char*)g.Bt + (size_t)cur.pb * tstepB;
    PG8_SETVA(vAc, 0);
    PG8_STB(PG8_SB(0, 0), cB); PG8_STB(PG8_SB(0, 1), cB + hstepB); PG8_STAGE(PG8_SA(0, 0), cA, vAc[0][0], vAc[0][1]); PG8_STAGE(PG8_SA(0, 1), cA, vAc[1][0], vAc[1][1]);
    if (wr == 1) PG8_BAR;
    PG8_WAIT_V(2); PG8_BAR;
    PG8_STB(PG8_SB(1, 0), cB + kstep); PG8_STAGE(PG8_SA(1, 0), cA + kstep, vAc[0][0], vAc[0][1]); PG8_STB(PG8_SB(1, 1), cB + hstepB + kstep);
    PG8_WAIT_V(6); PG8_BAR;
    for (;;) {
        const bool has_next = S.next(ui + 1, nxt);
        const char* nA = GATHER ? cA : (has_next ? (const char*)g.A + (size_t)nxt.pm * tstepA : cA); const char* nB = has_next ? (const char*)g.Bt + (size_t)nxt.pb * tstepB : cB;
        if (GATHER) { if (has_next) { PG8_SETVA(vAn, ui + 1); } else {
#pragma unroll
            for (int h_ = 0; h_ < 2; ++h_) { vAn[h_][0] = vAc[h_][0]; vAn[h_][1] = vAc[h_][1]; } } }
        for (int t = 0; t < nt; t += 2) {
            const bool last = (t == nt - 2);
            const char* a1 = cA + (size_t)(t + 1) * kstep;
            const char* a2 = last ? nA : cA + (size_t)(t + 2) * kstep; const char* b2 = last ? nB : cB + (size_t)(t + 2) * kstep;
            const char* a3 = a2 + kstep; const char* b3 = b2 + kstep;
            unsigned x00, x01, x10, x11;
            if (GATHER) { x00 = last ? vAn[0][0] : vAc[0][0]; x01 = last ? vAn[0][1] : vAc[0][1]; x10 = last ? vAn[1][0] : vAc[1][0]; x11 = last ? vAn[1][1] : vAc[1][1]; }
            else { x00 = vAc[0][0]; x01 = vAc[0][1]; x10 = vAc[1][0]; x11 = vAc[1][1]; }
            PG8_LDB(B0, 0, 0); PG8_LDB(B1, 0, 1); PG8_SCHED; PG8_LDA(At, 0, 0); PG8_STAGE(PG8_SA(1, 1), a1, vAc[1][0], vAc[1][1]);
            PG8_WAIT_V(8); PG8_WAIT_L(0); PG8_BAR; PG8_MMA(0, 0, At, B0); PG8_MMA(0, 1, At, B1); PG8_BAR; PG8_SCHED;
            PG8_LDA(At, 0, 1); PG8_STB(PG8_SB(0, 0), b2); PG8_STB(PG8_SB(0, 1), b2 + hstepB); PG8_STAGE(PG8_SA(0, 0), a2, x00, x01);
            PG8_WAIT_V(8); PG8_WAIT_L(0); PG8_BAR; PG8_MMA(1, 0, At, B0); PG8_MMA(1, 1, At, B1); PG8_BAR; PG8_SCHED;
            PG8_LDB(B0, 1, 0); PG8_LDB(B1, 1, 1); PG8_SCHED; PG8_LDA(At, 1, 0); PG8_STAGE(PG8_SA(0, 1), a2, x10, x11);
            PG8_WAIT_V(8); PG8_WAIT_L(0); PG8_BAR; PG8_MMA(0, 0, At, B0); PG8_MMA(0, 1, At, B1); PG8_BAR; PG8_SCHED;
            PG8_LDA(At, 1, 1); PG8_STB(PG8_SB(1, 0), b3); PG8_STB(PG8_SB(1, 1), b3 + hstepB); PG8_STAGE(PG8_SA(1, 0), a3, x00, x01);
            PG8_WAIT_V(8); PG8_WAIT_L(0); PG8_BAR; PG8_MMA(1, 0, At, B0); PG8_MMA(1, 1, At, B1); PG8_BAR; PG8_SCHED;
        }
        if constexpr (ALIGN_EPI) { if (wr == 0) PG8_BAR; }
        E(acc, cur, wr, wc, fr, fq);
        if (!has_next) break;
#pragma unroll
        for (int a = 0; a < 2; ++a)
#pragma unroll
            for (int b = 0; b < 2; ++b)
#pragma unroll
                for (int m = 0; m < 4; ++m)
#pragma unroll
                    for (int n = 0; n < 2; ++n) acc[a][b][m][n] = (f32x4){0.f, 0.f, 0.f, 0.f};
        cur = nxt; cA = nA; cB = nB; ++ui;
        if (GATHER) {
#pragma unroll
            for (int h_ = 0; h_ < 2; ++h_) { vAc[h_][0] = vAn[h_][0]; vAc[h_][1] = vAn[h_][1]; } }
        if constexpr (ALIGN_EPI) { if (wr == 1) PG8_BAR; }
    }
    PG8_WAIT_V(0);
    if constexpr (!ALIGN_EPI) { if (wr == 0) PG8_BAR; }
    PG8_BAR;
#undef PG8_SETVA
#undef PG8_SA
#undef PG8_SB
#undef PG8_STAGE
#undef PG8_STB
#undef PG8_LDA
#undef PG8_LDB
#undef PG8_MMA
#undef PG8_WAIT_V
#undef PG8_WAIT_L
#undef PG8_BAR
#undef PG8_SCHED
}
}
constexpr int NWAVES = 8, NTHR = 512;
constexpr int BATCH = 8, SEQ = 8192, T = BATCH * SEQ, D = 1024, DIN = 4096;
constexpr int DS = 512, DA = 512, NH = 8, HD = 64, NBLK = SEQ / 256;
constexpr int SG = 32, SHC = 16, SP = 64, SL = 32, SKU = SL * SHC  , SKS = 2 * SP  , SKY = SKU + SKS  , SROWS = T / SL  ;
constexpr int NE = 32, DE = 512;
constexpr float RMS_EPS = 1e-6f;
constexpr float LOG2E = 1.4426950408889634f;
constexpr float QSCALE = 0.125f * LOG2E;
constexpr int ROWCAP = T;
constexpr int HID_ROWS = 2 * T + NE * 256;

constexpr size_t MiB = 1u << 20;
constexpr size_t WS_CTL = 0, CTL_ZERO_BYTES = 1 * MiB;
constexpr size_t WS_WIN = 1 * MiB;
constexpr size_t WS_WGLU = 9 * MiB;
constexpr size_t WS_WUS = 10 * MiB;
constexpr size_t WS_WUA = 11 * MiB;
constexpr size_t WS_WOUT = 12 * MiB;
constexpr size_t WS_WR = 14 * MiB;
constexpr size_t WS_KMEAN = 15 * MiB;
constexpr size_t WS_SSMW = 16 * MiB;
constexpr size_t WS_SSMT = 24 * MiB;
constexpr size_t WS_W13 = 44 * MiB;
constexpr size_t WS_W2 = 108 * MiB;
constexpr size_t WS_A0 = 140 * MiB;
constexpr size_t WS_UP = 276 * MiB;
constexpr size_t WS_Q = 356 * MiB;
constexpr size_t WS_SSQ = 404 * MiB;
constexpr size_t WS_RLOG = 408 * MiB;
constexpr size_t WS_K = 420 * MiB;
constexpr size_t WS_ROWTOK = 428 * MiB, WS_ROWCOEF = 436 * MiB, WS_ROWRSTD = 444 * MiB;
constexpr size_t WS_GACT = 420 * MiB;
constexpr size_t WS_V = 484 * MiB;
constexpr size_t WS_YSSM = 484 * MiB;
constexpr size_t WS_SGS = 548 * MiB;
constexpr size_t WS_SGA = 676 * MiB;
constexpr size_t WS_E = 804 * MiB;
constexpr size_t WS_YATT = 836 * MiB;
constexpr size_t WS_PART0 = 420 * MiB, WS_PART1 = 484 * MiB, WS_PART2 = 932 * MiB;
constexpr size_t WS_QLIST = 900 * MiB;
constexpr size_t WS_PL = 268 * MiB;
constexpr size_t WS_MQ = 996 * MiB;
constexpr size_t WS_END = 998 * MiB;
constexpr size_t WS_KFRAG = WS_A0, WS_VFRAG = WS_A0 + 64 * MiB, WS_H1 = WS_A0, WS_MRG = WS_A0, WS_HID = WS_A0;
constexpr size_t WS_X1 = WS_SGS, WS_XG = WS_UP, WS_Y0 = WS_UP, WS_Y1 = WS_E;
static_assert(WS_GACT + 64 * MiB <= WS_YSSM && WS_YSSM + 64 * MiB <= WS_SGS, "map");
static_assert(WS_HID + (size_t)HID_ROWS * DE * 2 <= WS_UP, "hid fits");
static_assert(WS_RLOG + (size_t)T * 72 * 4 <= WS_ROWTOK, "rlog fits");

constexpr int CW_TMO = 0, CW_CODE = 1;
constexpr int CW_BAR = 4096;
constexpr int CW_ECNT = 8192;
constexpr int CW_GCNT = 12288;

constexpr int RING_BYTES = 131072;
constexpr int ROWTAB_OFF = RING_BYTES, ROWTAB_UNITS = 12, ROWTAB_BYTES = 24 * 1024;
constexpr int MOE_TST_OFF = ROWTAB_OFF + ROWTAB_BYTES;
constexpr int MISC_OFF = MOE_TST_OFF + 512;
constexpr int LDS_BYTES = MISC_OFF + 128;
static_assert(LDS_BYTES <= 163840, "LDS");

struct Frame {
    LAS unsigned char* lds;
    volatile LAS unsigned* MISC;
    gu32* ctl;
    unsigned char* ws;
    int tid, lane, wave, vcu, G;
    const float* in[27];
    float* out;
};

#define EPI_LOOP_BEGIN  _Pragma("unroll") for (int ai = 0; ai < 2; ++ai) _Pragma("unroll") for (int m = 0; m < 4; ++m) { const int rl = ai * 128 + wr * 64 + m * 16 + fr; _Pragma("unroll") for (int bj = 0; bj < 2; ++bj) { const int cl = bj * 128 + wc * 32 + 8 * fq; \
        const f32x4 a0 = acc[ai][bj][m][0], a1 = acc[ai][bj][m][1]; (void)rl; (void)cl; (void)a0; (void)a1;
#define EPI_LOOP_END } }
typedef const f32x4 (&AccRef)[2][2][4][2];
__device__ __forceinline__ u32x4 pack8(f32x4 a, f32x4 b) { u32x4 w; w.x = cvt_pk_bf16(a[0], a[1]); w.y = cvt_pk_bf16(a[2], a[3]); w.z = cvt_pk_bf16(b[0], b[1]); w.w = cvt_pk_bf16(b[2], b[3]); return w; }
__device__ __forceinline__ void unpack8(u32x4 w, f32x4& a, f32x4& b) { a = (f32x4){bflo(w.x), bfhi(w.x), bflo(w.y), bfhi(w.y)}; b = (f32x4){bflo(w.z), bfhi(w.z), bflo(w.w), bfhi(w.w)}; }

struct EpiProj {
    unsigned char* ws; const float* b_gate;
    __device__ __forceinline__ void operator()(AccRef acc, const pg8::Unit& u, int wr, int wc, int fr, int fq) const {
        const int pn = u.pn; const int row0 = u.pm * 256;
        if (pn < 2) {
            bf16_t* Uperm = (bf16_t*)(ws + WS_UP);
            EPI_LOOP_BEGIN
                const int row = row0 + rl, col = pn * 256 + cl;
                bf16_t* dst = Uperm + (size_t)(col >> 4) * ((size_t)SROWS * SKY) + (size_t)(row >> 5) * SKY + (row & 31) * 16 + (col & 15);
                *(u32x4*)dst = pack8(a0, a1);
            EPI_LOOP_END
        } else if (pn < 8) {
            const size_t boff = pn < 4 ? WS_Q : (pn < 6 ? WS_K : WS_V);
            bf16_t* base = (bf16_t*)(ws + boff); const float sc = pn < 4 ? QSCALE : 1.f; const int c0 = (pn & 1) * 256;
            EPI_LOOP_BEGIN
                const int row = row0 + rl, col = c0 + cl;
                *(u32x4*)(base + (size_t)row * 512 + col) = pack8(a0 * sc, a1 * sc);
            EPI_LOOP_END
        } else {
            const size_t boff = pn < 12 ? WS_SGS : WS_SGA;
            bf16_t* base = (bf16_t*)(ws + boff); const int c0 = ((pn - 8) & 3) * 256; const float* bg = b_gate + (pn - 8) * 256;
            EPI_LOOP_BEGIN
                const int row = row0 + rl, col = c0 + cl;
                const f32x4 b0 = *(const f32x4*)(bg + cl), b1 = *(const f32x4*)(bg + cl + 4);
                f32x4 s0, s1;
#pragma unroll
                for (int e = 0; e < 4; ++e) { s0[e] = fast_sigmoid(a0[e] + b0[e]); s1[e] = fast_sigmoid(a1[e] + b1[e]); }
                *(u32x4*)(base + (size_t)row * 1024 + col) = pack8(s0, s1);
            EPI_LOOP_END
        }
    }
};
struct EpiSsmE {
    float* E;
    __device__ __forceinline__ void operator()(AccRef acc, const pg8::Unit& u, int wr, int wc, int fr, int fq) const {
        EPI_LOOP_BEGIN
            if (bj == 0) { float* dst = E + (size_t)(u.pm * 256 + rl) * 128 + cl; *(f32x4*)dst = a0; *(f32x4*)(dst + 4) = a1; }
        EPI_LOOP_END
    }
};
__device__ __forceinline__ float gelu_tanh(float x) { const float z = 1.5957691216057308f * (x + 0.044715f * x * x * x); return x * fast_sigmoid(z); }
struct EpiSsmY {
    bf16_t* Gact;
    __device__ __forceinline__ void operator()(AccRef acc, const pg8::Unit& u, int wr, int wc, int fr, int fq) const {
        const int g = u.aux;
        EPI_LOOP_BEGIN
            const int rg = (u.pm & 7) * 256 + rl;
            const int colg = u.pn * 256 + cl;
            const int tok = (rg >> 8) * SEQ + (rg & 255) * SL + (colg >> 4);
            f32x4 y0, y1;
#pragma unroll
            for (int e = 0; e < 4; ++e) { y0[e] = gelu_tanh(a0[e]); y1[e] = gelu_tanh(a1[e]); }
            *(u32x4*)(Gact + (size_t)tok * DS + g * 16 + (colg & 15)) = pack8(y0, y1);
        EPI_LOOP_END
    }
};
struct EpiGlu {
    const bf16_t* Gact; bf16_t* Yssm; const float* b_glu;
    __device__ __forceinline__ void operator()(AccRef acc, const pg8::Unit& u, int wr, int wc, int fr, int fq) const {
        EPI_LOOP_BEGIN
            const int row = u.pm * 256 + rl, col = u.pn * 256 + cl;
            const f32x4 b0 = *(const f32x4*)(b_glu + col), b1 = *(const f32x4*)(b_glu + col + 4);
            f32x4 g0, g1; unpack8(*(const u32x4*)(Gact + (size_t)row * DS + col), g0, g1);
            f32x4 y0, y1;
#pragma unroll
            for (int e = 0; e < 4; ++e) { y0[e] = g0[e] * fast_sigmoid(a0[e] + b0[e]); y1[e] = g1[e] * fast_sigmoid(a1[e] + b1[e]); }
            *(u32x4*)(Yssm + (size_t)row * DS + col) = pack8(y0, y1);
        EPI_LOOP_END
    }
};
template <bool SECOND> struct EpiUp {
    const bf16_t* SG; bf16_t* Mrg;
    __device__ __forceinline__ void operator()(AccRef acc, const pg8::Unit& u, int wr, int wc, int fr, int fq) const {
        EPI_LOOP_BEGIN
            const size_t off = (size_t)(u.pm * 256 + rl) * D + u.pn * 256 + cl;
            f32x4 s0, s1; unpack8(*(const u32x4*)(SG + off), s0, s1);
            f32x4 y0 = s0 * a0, y1 = s1 * a1;
            if (SECOND) { f32x4 p0, p1; unpack8(*(const u32x4*)(Mrg + off), p0, p1); y0 += p0; y1 += p1; }
            *(u32x4*)(Mrg + off) = pack8(y0, y1);
        EPI_LOOP_END
    }
};
struct EpiOut {
    const float* x; float* X1; bf16_t* XG; const float* g2; float* SSQ;
    __device__ __forceinline__ void operator()(AccRef acc, const pg8::Unit& u, int wr, int wc, int fr, int fq) const {
#pragma unroll
        for (int ai = 0; ai < 2; ++ai)
#pragma unroll
            for (int m = 0; m < 4; ++m) { const int row = u.pm * 256 + ai * 128 + wr * 64 + m * 16 + fr; float ss = 0.f;
#pragma unroll
                for (int bj = 0; bj < 2; ++bj) { const int col = u.pn * 256 + bj * 128 + wc * 32 + 8 * fq; const size_t off = (size_t)row * D + col;
                    const f32x4 x0 = *(const f32x4*)(x + off) + acc[ai][bj][m][0], x1 = *(const f32x4*)(x + off + 4) + acc[ai][bj][m][1];
                    *(f32x4*)(X1 + off) = x0; *(f32x4*)(X1 + off + 4) = x1;
                    ss += (x0[0] * x0[0] + x0[1] * x0[1]) + (x0[2] * x0[2] + x0[3] * x0[3]) + (x1[0] * x1[0] + x1[1] * x1[1]) + (x1[2] * x1[2] + x1[3] * x1[3]);
                    const f32x4 w0 = *(const f32x4*)(g2 + col), w1 = *(const f32x4*)(g2 + col + 4);
                    *(u32x4*)(XG + off) = pack8(x0 * w0, x1 * w1); }
                ss += __shfl_xor(ss, 16); ss += __shfl_xor(ss, 32);
                if (fq == 0) SSQ[(size_t)row * 16 + u.pn * 4 + wc] = ss; }
    }
};
struct EpiRouter {
    float* Rlog;
    __device__ __forceinline__ void operator()(AccRef acc, const pg8::Unit& u, int wr, int wc, int fr, int fq) const {
        EPI_LOOP_BEGIN
            if (bj == 0 && cl < 72) { float* dst = Rlog + (size_t)(u.pm * 256 + rl) * 72 + cl; *(f32x4*)dst = a0; *(f32x4*)(dst + 4) = a1; }
        EPI_LOOP_END
    }
};
struct EpiMoe1 {
    bf16_t* Hid; const float* rowrstd; const unsigned* ecnt;
    __device__ __forceinline__ void operator()(AccRef acc, const pg8::Unit& u, int wr, int wc, int fr, int fq) const {
        const int e = u.aux, cnt = (int)ecnt[e];
#pragma unroll
        for (int ai = 0; ai < 2; ++ai)
#pragma unroll
            for (int m = 0; m < 4; ++m) { const int rl = ai * 128 + wr * 64 + m * 16 + fr; const int pos = u.aux2 + rl;
                if (pos < cnt) { const float rs = rowrstd[(size_t)e * ROWCAP + pos];
                    f32x4 h0, h1;
#pragma unroll
                    for (int k = 0; k < 4; ++k) { const float p = acc[ai][0][m][0][k] * rs, q = acc[ai][1][m][0][k] * rs; h0[k] = p * fast_sigmoid(p) * q;
                        const float p2 = acc[ai][0][m][1][k] * rs, q2 = acc[ai][1][m][1][k] * rs; h1[k] = p2 * fast_sigmoid(p2) * q2; }
                    *(u32x4*)(Hid + (size_t)(u.pm * 256 + rl) * DE + u.pn * 128 + wc * 32 + 8 * fq) = pack8(h0, h1); } }
    }
};
struct EpiMoe2 {
    bf16_t* Y0; size_t ydelta; const unsigned* rowtok; const float* rowcoef; const unsigned* ecnt;
    __device__ __forceinline__ void operator()(AccRef acc, const pg8::Unit& u, int wr, int wc, int fr, int fq) const {
        const int e = u.aux, cnt = (int)ecnt[e];
#pragma unroll
        for (int ai = 0; ai < 2; ++ai)
#pragma unroll
            for (int m = 0; m < 4; ++m) { const int rl = ai * 128 + wr * 64 + m * 16 + fr; const int pos = u.aux2 + rl;
                if (pos < cnt) { const unsigned tk = rowtok[(size_t)e * ROWCAP + pos]; const float cf = rowcoef[(size_t)e * ROWCAP + pos];
                    bf16_t* dst = (bf16_t*)((unsigned char*)Y0 + (size_t)(tk & 1u) * ydelta) + (size_t)(tk >> 1) * D + u.pn * 256 + wc * 32 + 8 * fq;
#pragma unroll
                    for (int bj = 0; bj < 2; ++bj) *(u32x4*)(dst + bj * 128) = pack8(acc[ai][bj][m][0] * cf, acc[ai][bj][m][1] * cf); } }
    }
};
__device__ __forceinline__ void transpose_item(const float* W, int N, int k0, int n0, bf16_t* WT, size_t drow0, int ldo, LAS float* scr, int lane) {
#pragma unroll 8
    for (int i = 0; i < 32; ++i) { const int kk = 2 * i + (lane >> 5); scr[kk * 33 + (lane & 31)] = W[(size_t)(k0 + kk) * N + n0 + (lane & 31)]; }
    LDS_WAIT(); asm volatile("" ::: "memory");
    const int c = lane & 7;
#pragma unroll
    for (int j = 0; j < 4; ++j) { const int n = (lane >> 3) + 8 * j; const LAS float* s = scr + (8 * c) * 33 + n;
        u32x4 o; o.x = pk2(s[0 * 33], s[1 * 33]); o.y = pk2(s[2 * 33], s[3 * 33]); o.z = pk2(s[4 * 33], s[5 * 33]); o.w = pk2(s[6 * 33], s[7 * 33]);
        *(u32x4*)(WT + (drow0 + n) * (size_t)ldo + k0 + 8 * c) = o; }
    LDS_WAIT(); asm volatile("" ::: "memory");
}
__device__ __forceinline__ void rms_row_to_bf16(int lane, const float* xrow, const float* g, bf16_t* orow) {
    const f32x4* xr = (const f32x4*)xrow + lane; const f32x4* gr = (const f32x4*)g + lane;
    f32x4 v[4]; float s = 0.f;
#pragma unroll
    for (int j = 0; j < 4; ++j) { v[j] = xr[64 * j]; s += (v[j].x * v[j].x + v[j].y * v[j].y) + (v[j].z * v[j].z + v[j].w * v[j].w); }
    const float rstd = 1.f / sqrtf(wave_sum(s) * (1.f / D) + RMS_EPS);
    unsigned long long* o8 = (unsigned long long*)orow + lane;
#pragma unroll
    for (int j = 0; j < 4; ++j) { const f32x4 w = gr[64 * j];
        o8[64 * j] = (unsigned long long)pk2(v[j].x * rstd * w.x, v[j].y * rstd * w.y) | ((unsigned long long)pk2(v[j].z * rstd * w.z, v[j].w * rstd * w.w) << 32); }
}
__device__ __forceinline__ void cpow(float lr, float li, float step, float dl, float& ar, float& ai) {
    const float mag = __expf(dl * lr * step); const float rev = dl * (li * step * 0.15915494309189535f); const float fr = rev - floorf(rev);
    ar = mag * __builtin_amdgcn_cosf(fr); ai = mag * __builtin_amdgcn_sinf(fr);
}
__device__ __forceinline__ void ssm_gen(Frame& F, int g) {
    LAS float* AP = (LAS float*)(F.lds); LAS float* BB = AP + 33 * 64 * 2; LAS float* CC = BB + 2048; LAS float* KT = CC + 2048;
    const float* lam_re = F.in[4] + g * SP; const float* lam_im = F.in[5] + g * SP; const float step = __expf(F.in[6][g]);
    const float* b_re = F.in[7] + g * SP * SHC; const float* b_im = F.in[8] + g * SP * SHC; const float* c_re = F.in[9] + g * SHC * SP; const float* c_im = F.in[10] + g * SHC * SP; const float* dd = F.in[11] + g * SHC;
    bf16_t* BT = (bf16_t*)(F.ws + WS_SSMT) + (size_t)g * 512 * SKY; bf16_t* BW = (bf16_t*)(F.ws + WS_SSMW) + (size_t)g * 256 * SKU;
    const int tid = F.tid;
    for (int idx = tid; idx < 33 * 64; idx += NTHR) { const int dl = idx >> 6, p = idx & 63; float ar, ai; cpow(lam_re[p], lam_im[p], step, (float)dl, ar, ai); AP[idx * 2] = ar; AP[idx * 2 + 1] = ai; }
    for (int idx = tid; idx < 1024; idx += NTHR) { const int ho = idx >> 6, p = idx & 63; CC[idx * 2] = c_re[ho * 64 + p]; CC[idx * 2 + 1] = c_im[ho * 64 + p]; }
    __syncthreads();
    for (int idx = tid; idx < 1024; idx += NTHR) { const int p = idx >> 4, h = idx & 15; const float ar = AP[(64 + p) * 2], ai = AP[(64 + p) * 2 + 1];
        const float lr = lam_re[p], li = lam_im[p], nr = ar - 1.f, ni = ai, den = lr * lr + li * li, cr = (nr * lr + ni * li) / den, ci = (ni * lr - nr * li) / den;
        const float br = b_re[p * 16 + h], bi = b_im[p * 16 + h]; BB[idx * 2] = cr * br - ci * bi; BB[idx * 2 + 1] = cr * bi + ci * br; }
    __syncthreads();
    for (int idx = tid; idx < 8192; idx += NTHR) { const int dl = idx >> 8, ho = (idx >> 4) & 15, hi = idx & 15; float s = 0.f;
        for (int p = 0; p < 64; ++p) { const float ar = AP[(dl * 64 + p) * 2], ai = AP[(dl * 64 + p) * 2 + 1], br = BB[(p * 16 + hi) * 2], bi = BB[(p * 16 + hi) * 2 + 1];
            const float zr = ar * br - ai * bi, zi = ar * bi + ai * br; s += CC[(ho * 64 + p) * 2] * zr - CC[(ho * 64 + p) * 2 + 1] * zi; }
        if (dl == 0 && ho == hi) s += dd[ho];
        KT[idx] = s; }
    __syncthreads();
    for (int v = tid; v < 512 * 80; v += NTHR) { const int n = v / 80, kv = (v % 80) * 8, tau = n >> 4, ho = n & 15; float val[8];
        if (kv < 512) { const int sg = kv >> 4, hi0 = kv & 15;
#pragma unroll
            for (int e = 0; e < 8; ++e) val[e] = (tau >= sg) ? KT[((tau - sg) * 16 + ho) * 16 + hi0 + e] : 0.f; }
        else { const int kk = kv - 512;
#pragma unroll
            for (int e = 0; e < 8; ++e) { const int p = (kk + e) >> 1, ri = (kk + e) & 1; const float ar = AP[((tau + 1) * 64 + p) * 2], ai = AP[((tau + 1) * 64 + p) * 2 + 1], cre = CC[(ho * 64 + p) * 2], cim = CC[(ho * 64 + p) * 2 + 1];
                val[e] = ri == 0 ? (cre * ar - cim * ai) : -(cre * ai + cim * ar); } }
        u32x4 o; o.x = pk2(val[0], val[1]); o.y = pk2(val[2], val[3]); o.z = pk2(val[4], val[5]); o.w = pk2(val[6], val[7]);
        *(u32x4*)(BT + (size_t)n * SKY + kv) = o; }
    for (int v = tid; v < 256 * 64; v += NTHR) { const int n = v >> 6, kv = (v & 63) * 8; float val[8];
        if (n < 128) { const int p = n >> 1, ri = n & 1, sg = kv >> 4, hi0 = kv & 15; const float ar = AP[((31 - sg) * 64 + p) * 2], ai = AP[((31 - sg) * 64 + p) * 2 + 1];
#pragma unroll
            for (int e = 0; e < 8; ++e) { const float br = BB[(p * 16 + hi0 + e) * 2], bi = BB[(p * 16 + hi0 + e) * 2 + 1]; val[e] = ri == 0 ? (ar * br - ai * bi) : (ar * bi + ai * br); } }
        else {
#pragma unroll
            for (int e = 0; e < 8; ++e) val[e] = 0.f; }
        u32x4 o; o.x = pk2(val[0], val[1]); o.y = pk2(val[2], val[3]); o.z = pk2(val[4], val[5]); o.w = pk2(val[6], val[7]);
        *(u32x4*)(BW + (size_t)n * SKU + kv) = o; }
    __syncthreads();
}
__device__ __forceinline__ void p0_prologue(Frame& F) {
    if (F.vcu < SG) { for (int g = F.vcu; g < SG; g += F.G) ssm_gen(F, g); }
    LAS float* scr = (LAS float*)(F.lds + F.wave * 16384);
    const int gw = F.vcu * NWAVES + F.wave, NGW = F.G * NWAVES, lane = F.lane;
    constexpr int I_IN = 16 * 128, I_GLU = 8 * 16, I_US = 8 * 32, I_UA = 8 * 32, I_OUT = 16 * 32, I_W1 = 32 * 256, I_W3 = 32 * 256, I_W2 = 32 * 256;
    constexpr int NITEMS = I_IN + I_GLU + I_US + I_UA + I_OUT + I_W1 + I_W3 + I_W2;
    unsigned char* ws = F.ws;
    for (int it = gw; it < NITEMS; it += NGW) {
        int r = it;
        if (r < I_IN) { transpose_item(F.in[2], DIN, 64 * (r / 128), 32 * (r % 128), (bf16_t*)(ws + WS_WIN), 32 * (r % 128), D, scr, lane); continue; } r -= I_IN;
        if (r < I_GLU) { transpose_item(F.in[12], DS, 64 * (r / 16), 32 * (r % 16), (bf16_t*)(ws + WS_WGLU), 32 * (r % 16), DS, scr, lane); continue; } r -= I_GLU;
        if (r < I_US) { transpose_item(F.in[14], D, 64 * (r / 32), 32 * (r % 32), (bf16_t*)(ws + WS_WUS), 32 * (r % 32), DS, scr, lane); continue; } r -= I_US;
        if (r < I_UA) { transpose_item(F.in[15], D, 64 * (r / 32), 32 * (r % 32), (bf16_t*)(ws + WS_WUA), 32 * (r % 32), DA, scr, lane); continue; } r -= I_UA;
        if (r < I_OUT) { transpose_item(F.in[17], D, 64 * (r / 32), 32 * (r % 32), (bf16_t*)(ws + WS_WOUT), 32 * (r % 32), D, scr, lane); continue; } r -= I_OUT;
        if (r < I_W1 + I_W3) { const int w3 = r >= I_W1; if (w3) r -= I_W1; const int e = r >> 8, q = r & 255, k0 = 64 * (q / 16), n0 = 32 * (q % 16);
            transpose_item((w3 ? F.in[24] : F.in[23]) + (size_t)e * D * DE, DE, k0, n0, (bf16_t*)(ws + WS_W13), (size_t)e * 1024 + 256 * (n0 >> 7) + (n0 & 127) + (w3 ? 128 : 0), D, scr, lane); continue; }
        r -= I_W1 + I_W3;
        { const int e = r >> 8, q = r & 255, k0 = 64 * (q / 32), n0 = 32 * (q % 32);
            transpose_item(F.in[25] + (size_t)e * DE * D, D, k0, n0, (bf16_t*)(ws + WS_W2), (size_t)e * 1024 + n0, DE, scr, lane); }
    }
    for (int m = gw; m < T; m += NGW) rms_row_to_bf16(lane, F.in[0] + (size_t)m * D, F.in[1], (bf16_t*)(ws + WS_H1) + (size_t)m * D);
    { bf16_t* WR = (bf16_t*)(ws + WS_WR); const float* wrg = F.in[19]; const float* wre = F.in[21];
      for (int idx = F.vcu * NTHR + F.tid; idx < 256 * D; idx += F.G * NTHR) { const int r = idx >> 10, k = idx & 1023; unsigned o = 0u;
          if (r < 72) { const int c = r < 36 ? r : r - 36; const float w = c < 4 ? wrg[k * 4 + c] : wre[k * 32 + (c - 4)]; const unsigned hb = f2bf(w);
              o = r < 36 ? hb : f2bf(w - __builtin_bit_cast(float, hb << 16)); }
          WR[idx] = (bf16_t)o; } }
}

__device__ __forceinline__ int crow(int r, int hi) { return (r & 3) + 8 * (r >> 2) + 4 * hi; }
constexpr int KVP = 72;
__device__ __forceinline__ void kv_prep_phase(Frame& F) {
    LAS bf16_t* KS = (LAS bf16_t*)(F.lds); LAS bf16_t* VS = KS + 256 * KVP; LAS float* PS = (LAS float*)(F.lds + 2 * 256 * KVP * 2); LAS float* WM = PS + 512;
    const bf16_t* Kb = (const bf16_t*)(F.ws + WS_K); const bf16_t* Vb = (const bf16_t*)(F.ws + WS_V);
    bf16_t* Kf = (bf16_t*)(F.ws + WS_KFRAG); bf16_t* Vf = (bf16_t*)(F.ws + WS_VFRAG); bf16_t* KM = (bf16_t*)(F.ws + WS_KMEAN); float* KN = (float*)(F.ws + WS_KMEAN + 512 * 1024);
    const int tid = F.tid;
    for (int item = F.vcu; item < BATCH * NH * NBLK; item += F.G) {
        const int n = item & 31, h = (item >> 5) & 7, b = item >> 8; const size_t tok0 = (size_t)b * SEQ + 256 * n;
#pragma unroll
        for (int j = 0; j < 4; ++j) { const int q = tid + NTHR * j, row = q >> 3, pc = q & 7; const size_t src = (tok0 + row) * DA + h * HD + pc * 8;
            *(LAS u32x4*)(KS + row * KVP + pc * 8) = *(const u32x4*)(Kb + src); *(LAS u32x4*)(VS + row * KVP + pc * 8) = *(const u32x4*)(Vb + src); }
        __syncthreads();
#pragma unroll
        for (int j = 0; j < 4; ++j) { const int P = tid + NTHR * j, st = P >> 8, ds = (P >> 6) & 3, l2 = P & 63, row = 32 * st + (l2 & 31), col = 16 * ds + 8 * (l2 >> 5);
            *(u32x4*)(Kf + ((size_t)item * 2048 + P) * 8) = *(const LAS u32x4*)(KS + row * KVP + col); }
#pragma unroll
        for (int j = 0; j < 4; ++j) { const int P = tid + NTHR * j, st = P >> 8, ks = (P >> 7) & 1, d0 = (P >> 6) & 1, l2 = P & 63, hi = l2 >> 5, jj = l2 & 31; unsigned w[4];
#pragma unroll
            for (int e = 0; e < 8; e += 2) { const unsigned lo = VS[(32 * st + 16 * ks + crow(e, hi)) * KVP + 32 * d0 + jj], hi16 = VS[(32 * st + 16 * ks + crow(e + 1, hi)) * KVP + 32 * d0 + jj]; w[e >> 1] = lo | (hi16 << 16); }
            *(u32x4*)(Vf + ((size_t)item * 2048 + P) * 8) = (u32x4){w[0], w[1], w[2], w[3]}; }
        { const int d = tid & 63, part = tid >> 6; float s = 0.f;
#pragma unroll 8
          for (int r = 0; r < 32; ++r) s += bf2f(KS[(part * 32 + r) * KVP + d]);
          PS[part * 64 + d] = s; }
        if (tid < 256) { float ss = 0.f;
#pragma unroll
            for (int c = 0; c < 8; ++c) { const u32x4 w = *(const LAS u32x4*)(KS + tid * KVP + c * 8);
                ss += bflo(w.x) * bflo(w.x) + bfhi(w.x) * bfhi(w.x) + bflo(w.y) * bflo(w.y) + bfhi(w.y) * bfhi(w.y) + bflo(w.z) * bflo(w.z) + bfhi(w.z) * bfhi(w.z) + bflo(w.w) * bflo(w.w) + bfhi(w.w) * bfhi(w.w); }
            ss = wave_max(ss); if (F.lane == 0) WM[F.wave] = ss; }
        __syncthreads();
        if (tid < 64) { float s = 0.f;
#pragma unroll
            for (int p = 0; p < 8; ++p) s += PS[p * 64 + tid];
            KM[(size_t)item * 64 + tid] = (bf16_t)f2bf(s * (1.f / 256.f)); }
        if (tid == 0) KN[item] = fmaxf(fmaxf(WM[0], WM[1]), fmaxf(WM[2], WM[3]));
        __syncthreads();
    }
}

__device__ __forceinline__ void ssm_scan_phase(Frame& F) {
    LAS float* FW = (LAS float*)(F.lds);
    const float* E = (const float*)(F.ws + WS_E); bf16_t* UP = (bf16_t*)(F.ws + WS_UP);
    const int w = F.wave, p = F.lane;
    for (int gb = F.vcu; gb < SG * BATCH; gb += F.G) {
        const int g = gb >> 3, b = gb & 7;
        const float lr = F.in[4][g * SP + p], li = F.in[5][g * SP + p], step = __expf(F.in[6][g]);
        float ar, ai; cpow(lr, li, step, 32.f, ar, ai);
        const size_t row0 = (size_t)g * SROWS + b * 256 + 32 * w;
        f32x2 e[32];
#pragma unroll
        for (int j = 0; j < 32; ++j) e[j] = *(const f32x2*)(E + (row0 + j) * 128 + 2 * p);
        float sr = 0.f, si = 0.f;
#pragma unroll
        for (int j = 0; j < 32; ++j) { const float nr = ar * sr - ai * si + e[j].x, ni = ar * si + ai * sr + e[j].y; sr = nr; si = ni; }
        FW[(w * 64 + p) * 2] = sr; FW[(w * 64 + p) * 2 + 1] = si;
        __syncthreads();
        float Ar = ar, Ai = ai;
#pragma unroll
        for (int q = 0; q < 5; ++q) { const float nr = Ar * Ar - Ai * Ai, ni = 2.f * Ar * Ai; Ar = nr; Ai = ni; }
        sr = 0.f; si = 0.f;
        for (int w2 = 0; w2 < w; ++w2) { const float fr = FW[(w2 * 64 + p) * 2], fi = FW[(w2 * 64 + p) * 2 + 1]; const float nr = Ar * sr - Ai * si + fr, ni = Ar * si + Ai * sr + fi; sr = nr; si = ni; }
#pragma unroll
        for (int j = 0; j < 32; ++j) { *(unsigned*)(UP + (row0 + j) * SKY + SKU + 2 * p) = pk2(sr, si);
            const float nr = ar * sr - ai * si + e[j].x, ni = ar * si + ai * sr + e[j].y; sr = nr; si = ni; }
        __syncthreads();
    }
}

__device__ __forceinline__ int t5_bucket(int d) {
    if (d < 16) return d;
    return 16 + (d >= 19) + (d >= 21) + (d >= 24) + (d >= 27) + (d >= 31) + (d >= 35) + (d >= 40) + (d >= 46) + (d >= 52) + (d >= 59) + (d >= 67) + (d >= 77) + (d >= 87) + (d >= 99) + (d >= 113);
}
struct Top3 { float v0, v1, v2; int i0, i1, i2; };
__device__ __forceinline__ Top3 top3_insert(Top3 t, float x, int n) {
    const bool b0 = (x > t.v0) || (x == t.v0 && n < t.i0), b1 = (x > t.v1) || (x == t.v1 && n < t.i1), b2 = (x > t.v2) || (x == t.v2 && n < t.i2);
    Top3 r;
    r.v2 = b1 ? t.v1 : (b2 ? x : t.v2); r.i2 = b1 ? t.i1 : (b2 ? n : t.i2);
    r.v1 = b0 ? t.v0 : (b1 ? x : t.v1); r.i1 = b0 ? t.i0 : (b1 ? n : t.i1);
    r.v0 = b0 ? x : t.v0; r.i0 = b0 ? n : t.i0;
    return r;
}
constexpr int GQS = 0, GKME = 36864, GLIST = 41472, GCNTL = 57856, GBASE = 57984, GMISC = 58112;
__device__ __forceinline__ void attn_gate_unit(Frame& F, int bh, int qb) {
    LAS unsigned char* L = F.lds;
    LAS bf16_t* QS = (LAS bf16_t*)(L + GQS); LAS bf16_t* KME = (LAS bf16_t*)(L + GKME); LAS unsigned short* LIST = (LAS unsigned short*)(L + GLIST);
    LAS int* CNT = (LAS int*)(L + GCNTL); LAS int* BASE = (LAS int*)(L + GBASE); LAS float* KNM = (LAS float*)(L + GMISC);
    int tid = F.tid; asm volatile("" : "+v"(tid));
    const int lane = tid & 63, w = F.wave, j = lane & 31, hi = lane >> 5;
    const int b = bh >> 3, h = bh & 7; const size_t tok0 = (size_t)b * SEQ + 256 * qb;
    const bf16_t* Qb = (const bf16_t*)(F.ws + WS_Q); const bf16_t* KM = (const bf16_t*)(F.ws + WS_KMEAN); const float* KN = (const float*)(F.ws + WS_KMEAN + 512 * 1024);
    float* MQg = (float*)(F.ws + WS_MQ); unsigned short* QL = (unsigned short*)(F.ws + WS_QLIST); unsigned* GC = (unsigned*)(F.ctl + CW_GCNT);
#pragma unroll
    for (int jj = 0; jj < 4; ++jj) { const int q = tid + NTHR * jj, row = q >> 3, pc = q & 7; *(LAS u32x4*)(QS + row * KVP + pc * 8) = *(const u32x4*)(Qb + (tok0 + row) * DA + h * HD + pc * 8); }
    if (tid < 256) { const int n = tid >> 3, pc = tid & 7; *(LAS u32x4*)(KME + n * KVP + pc * 8) = *(const u32x4*)(KM + ((size_t)bh * 32 + n) * 64 + pc * 8); }
    if (tid < 32) CNT[tid] = 0;
    if (w == 1) { float v = (lane <= qb && lane < 32) ? KN[bh * 32 + lane] : 0.f; v = wave_max(v); if (lane == 0) KNM[0] = v; }
    if (w == 2) { float v = (lane < 32) ? F.in[16][h * 32 + (lane & 31)] : -INFINITY; v = wave_max(v); if (lane == 0) KNM[1] = v * LOG2E; }
    __syncthreads();
    {
        bf16x8 qf[4], kmf[4];
#pragma unroll
        for (int ds = 0; ds < 4; ++ds) { qf[ds] = *(const LAS bf16x8*)(QS + (32 * w + j) * KVP + 16 * ds + 8 * hi); kmf[ds] = *(const LAS bf16x8*)(KME + j * KVP + 16 * ds + 8 * hi); }
        f32x16 gt = {};
#pragma unroll
        for (int ds = 0; ds < 4; ++ds) gt = __builtin_amdgcn_mfma_f32_32x32x16_bf16(kmf[ds], qf[ds], gt, 0, 0, 0);
        float qn = 0.f;
#pragma unroll
        for (int ds = 0; ds < 4; ++ds)
#pragma unroll
            for (int e = 0; e < 8; ++e) { const float x = bf2f((unsigned short)qf[ds][e]); qn += x * x; }
        qn += __shfl_xor(qn, 32);
        const float m2 = sqrtf(qn * KNM[0]) + KNM[1];
        if (hi == 0) MQg[(size_t)bh * SEQ + 256 * qb + 32 * w + j] = m2;
        Top3 t3; t3.v0 = t3.v1 = t3.v2 = -INFINITY; t3.i0 = t3.i1 = t3.i2 = -1;
#pragma unroll
        for (int r = 0; r < 16; ++r) { const int n = crow(r, hi); const float x = (n < qb) ? gt[r] : -INFINITY; t3 = top3_insert(t3, x, x > -INFINITY ? n : 0x7fffffff); }
        { const float p0 = __shfl_xor(t3.v0, 32), p1 = __shfl_xor(t3.v1, 32), p2 = __shfl_xor(t3.v2, 32); const int q0 = __shfl_xor(t3.i0, 32), q1 = __shfl_xor(t3.i1, 32), q2 = __shfl_xor(t3.i2, 32);
          t3 = top3_insert(t3, p0, q0 >= 0 ? q0 : 0x7fffffff); t3 = top3_insert(t3, p1, q1 >= 0 ? q1 : 0x7fffffff); t3 = top3_insert(t3, p2, q2 >= 0 ? q2 : 0x7fffffff); }
        const int i0 = t3.v0 > -INFINITY ? t3.i0 : -1, i1 = t3.v1 > -INFINITY ? t3.i1 : -1, i2 = t3.v2 > -INFINITY ? t3.i2 : -1;
        if (hi == 0) { const int ql4 = (32 * w + j) << 2;
            if (i0 >= 0) { const int pos = __hip_atomic_fetch_add(CNT + i0, 1, __ATOMIC_RELAXED, __HIP_MEMORY_SCOPE_WORKGROUP); LIST[i0 * 256 + pos] = (unsigned short)(ql4 | 0); }
            if (i1 >= 0) { const int pos = __hip_atomic_fetch_add(CNT + i1, 1, __ATOMIC_RELAXED, __HIP_MEMORY_SCOPE_WORKGROUP); LIST[i1 * 256 + pos] = (unsigned short)(ql4 | 1); }
            if (i2 >= 0) { const int pos = __hip_atomic_fetch_add(CNT + i2, 1, __ATOMIC_RELAXED, __HIP_MEMORY_SCOPE_WORKGROUP); LIST[i2 * 256 + pos] = (unsigned short)(ql4 | 2); } }
    }
    __syncthreads();
    if (tid < 32 && tid < qb) BASE[tid] = (int)__hip_atomic_fetch_add(GC + bh * 32 + tid, (unsigned)CNT[tid], __ATOMIC_RELAXED, __HIP_MEMORY_SCOPE_AGENT);
    __syncthreads();
    for (int idx = tid; idx < qb * 256; idx += NTHR) { const int n = idx >> 8, i = idx & 255;
        if (i < CNT[n]) { const unsigned e = LIST[idx]; QL[((size_t)bh * 32 + n) * SEQ + BASE[n] + i] = (unsigned short)((((unsigned)(256 * qb) + (e >> 2)) << 2) | (e & 3u)); } }
    __syncthreads();
}
__device__ __forceinline__ void attn_gate_phase(Frame& F) {
    for (int u = F.vcu; u < BATCH * NH * NBLK; u += F.G) attn_gate_unit(F, u >> 5, u & 31);
}

#define ATTN_SUBTILE(KP, VP, st_, NEARM) do { \
        bf16x8 kf_[4], vf_[4]; \
        _Pragma("unroll") for (int ds_ = 0; ds_ < 4; ++ds_) kf_[ds_] = *(const LAS bf16x8*)((KP) + ((st_) * 4 + ds_) * 512 + lane8); \
        _Pragma("unroll") for (int q_ = 0; q_ < 4; ++q_) vf_[q_] = *(const LAS bf16x8*)((VP) + ((st_) * 4 + q_) * 512 + lane8); \
        f32x16 s_ = {}; \
        _Pragma("unroll") for (int ds_ = 0; ds_ < 4; ++ds_) s_ = __builtin_amdgcn_mfma_f32_32x32x16_bf16(kf_[ds_], qf[ds_], s_, 0, 0, 0); \
        float p_[16]; \
        if (!(NEARM)) { _Pragma("unroll") for (int r_ = 0; r_ < 16; ++r_) p_[r_] = __builtin_amdgcn_exp2f(s_[r_] - mfar); } \
        else { _Pragma("unroll") for (int r_ = 0; r_ < 16; ++r_) { const int dist_ = dq - (32 * (st_) + crow(r_, hi)); const int di_ = dist_ < 0 ? 0 : (dist_ > 127 ? 127 : dist_); \
                const float e_ = __builtin_amdgcn_exp2f(s_[r_] + TABh[di_] - m2); p_[r_] = dist_ >= 0 ? e_ : 0.f; } } \
        _Pragma("unroll") for (int r_ = 0; r_ < 16; ++r_) lsum += p_[r_]; \
        u32x4 pa_, pb_; pa_.x = cvt_pk_bf16(p_[0], p_[1]); pa_.y = cvt_pk_bf16(p_[2], p_[3]); pa_.z = cvt_pk_bf16(p_[4], p_[5]); pa_.w = cvt_pk_bf16(p_[6], p_[7]); \
        pb_.x = cvt_pk_bf16(p_[8], p_[9]); pb_.y = cvt_pk_bf16(p_[10], p_[11]); pb_.z = cvt_pk_bf16(p_[12], p_[13]); pb_.w = cvt_pk_bf16(p_[14], p_[15]); \
        const bf16x8 A0_ = __builtin_bit_cast(bf16x8, pa_), A1_ = __builtin_bit_cast(bf16x8, pb_); \
        o0 = __builtin_amdgcn_mfma_f32_32x32x16_bf16(vf_[0], A0_, o0, 0, 0, 0); o1 = __builtin_amdgcn_mfma_f32_32x32x16_bf16(vf_[1], A0_, o1, 0, 0, 0); \
        o0 = __builtin_amdgcn_mfma_f32_32x32x16_bf16(vf_[2], A1_, o0, 0, 0, 0); o1 = __builtin_amdgcn_mfma_f32_32x32x16_bf16(vf_[3], A1_, o1, 0, 0, 0); } while (0)

__device__ __forceinline__ void attn_fill_tab(Frame& F, LAS float* TAB) {
    const float* rb = F.in[16];
    for (int idx = F.tid; idx < 8 * 132; idx += NTHR) { const int h = idx / 132, d = idx % 132; float v = 0.f;
        if (d < 128) v = rb[h * 32 + t5_bucket(d)] * LOG2E; else if (d == 129) v = rb[h * 32 + 31] * LOG2E;
        TAB[idx] = v; }
}
constexpr int BGPRE_OFF = ROWTAB_OFF, BGCL_OFF = ROWTAB_OFF + 8448, BTAB_OFF = ROWTAB_OFF + 16640;
static_assert(BTAB_OFF + 8 * 132 * 4 <= MOE_TST_OFF, "attention LDS tables");
__device__ __forceinline__ size_t part_off(int slot) { return slot == 0 ? WS_PART0 : (slot == 1 ? WS_PART1 : WS_PART2); }

__device__ __forceinline__ void attn_block_phase(Frame& F) {
    LAS unsigned char* L = F.lds; LAS int* GPRE = (LAS int*)(L + BGPRE_OFF); LAS int* GCL = (LAS int*)(L + BGCL_OFF); LAS float* TAB = (LAS float*)(L + BTAB_OFF); LAS int* WSUM = (LAS int*)(L + MOE_TST_OFF);
    const unsigned* GC = (const unsigned*)(F.ctl + CW_GCNT);
    const int tid = F.tid, lane = F.lane, w = F.wave, j = lane & 31, hi = lane >> 5, lane8 = lane * 8;
    { int ng[4], tot = 0;
#pragma unroll
      for (int e = 0; e < 4; ++e) { const int c = (int)GC[4 * tid + e]; GCL[4 * tid + e] = c; ng[e] = (((c + 31) >> 5) + 7) >> 3; tot += ng[e]; }
      int inc = tot;
#pragma unroll
      for (int o = 1; o < 64; o <<= 1) { const int t = __shfl_up(inc, o); if (lane >= o) inc += t; }
      if (lane == 63) WSUM[w] = inc;
      __syncthreads();
      int woff = 0;
      for (int q = 0; q < w; ++q) woff += WSUM[q];
      int ex = woff + inc - tot;
#pragma unroll
      for (int e = 0; e < 4; ++e) { GPRE[4 * tid + e] = ex; ex += ng[e]; }
      if (tid == NTHR - 1) GPRE[2048] = ex; }
    attn_fill_tab(F, TAB);
    __syncthreads();
    const int NIT = GPRE[2048];
    const bf16_t* Qb = (const bf16_t*)(F.ws + WS_Q); const float* MQg = (const float*)(F.ws + WS_MQ); const unsigned short* QL = (const unsigned short*)(F.ws + WS_QLIST);
    const bf16_t* KF = (const bf16_t*)(F.ws + WS_KFRAG); const bf16_t* VF = (const bf16_t*)(F.ws + WS_VFRAG);
    float* PL = (float*)(F.ws + WS_PL);
#define BLK_FIND(it_, pi_, g_) do { int lo_ = 0, hi_ = 2048; while (hi_ - lo_ > 1) { const int mid_ = (lo_ + hi_) >> 1; if (GPRE[mid_] <= (it_)) lo_ = mid_; else hi_ = mid_; } \
        pi_ = __builtin_amdgcn_readfirstlane(lo_); g_ = __builtin_amdgcn_readfirstlane((it_) - GPRE[lo_]); } while (0)
#define BLK_DMA(buf_, pi_) do { const char* ks_ = (const char*)KF + ((size_t)(pi_) * 2048 + tid) * 16; const char* vs_ = (const char*)VF + ((size_t)(pi_) * 2048 + tid) * 16; \
        _Pragma("unroll") for (int i_ = 0; i_ < 4; ++i_) { \
            __builtin_amdgcn_global_load_lds((const unsigned*)(ks_ + i_ * 8192), (LAS unsigned*)(L + (buf_) + (i_ * 512 + w * 64) * 16), 16, 0, 0); \
            __builtin_amdgcn_global_load_lds((const unsigned*)(vs_ + i_ * 8192), (LAS unsigned*)(L + (buf_) + 32768 + (i_ * 512 + w * 64) * 16), 16, 0, 0); } } while (0)
#define BLK_ENTRY(dst_, pi_, g_) do { const int cnt_ = GCL[pi_]; const int idx_ = 32 * (8 * (g_) + w) + j; const unsigned v_ = QL[(size_t)(pi_) * SEQ + (idx_ < cnt_ ? idx_ : 0)]; dst_ = (idx_ < cnt_) ? v_ : 0xFFFFu; } while (0)
#define BLK_QLOAD(qf_, m2_, ent_, pi_) do { const unsigned qq_ = ((ent_) == 0xFFFFu) ? 0u : ((ent_) >> 2); const int bh_ = (pi_) >> 5; \
        const bf16_t* qrow_ = Qb + ((size_t)(bh_ >> 3) * SEQ + qq_) * DA + (bh_ & 7) * HD + 8 * hi; \
        _Pragma("unroll") for (int ds_ = 0; ds_ < 4; ++ds_) qf_[ds_] = *(const bf16x8*)(qrow_ + 16 * ds_); \
        m2_ = MQg[(size_t)bh_ * SEQ + qq_]; } while (0)
    int it = F.vcu; if (it >= NIT) return;
    int pi, g, pin, gn; unsigned ent, entn; bf16x8 qf[4]; float m2r;
    BLK_FIND(it, pi, g); BLK_DMA(0, pi); BLK_ENTRY(ent, pi, g);
    int itn = (it + F.G < NIT) ? it + F.G : it;
    BLK_FIND(itn, pin, gn); BLK_ENTRY(entn, pin, gn);
    BLK_QLOAD(qf, m2r, ent, pi);
    int cur = 0;
    for (;;) {
        VM_WAIT(); __syncthreads();
        const bool last = (itn == it);
        const int it2 = (itn + F.G < NIT) ? itn + F.G : itn; int pi2, g2; unsigned ent2; bf16x8 qfn[4]; float m2n;
        BLK_FIND(it2, pi2, g2); BLK_ENTRY(ent2, pi2, g2);
        BLK_QLOAD(qfn, m2n, entn, pin);
        BLK_DMA((cur ^ 1) * 65536, pin);
        const int bh = pi >> 5, n = pi & 31, h = bh & 7;
        const bool valid = ent != 0xFFFFu; const int q = valid ? (int)(ent >> 2) : 0; const int slot = (int)(ent & 3u);
        const bool active = __builtin_amdgcn_readfirstlane((int)(__ballot(valid) != 0ull)) != 0;
        if (active) {
            const float m2 = valid ? m2r : INFINITY;
            const LAS bf16_t* KP = (const LAS bf16_t*)(L + cur * 65536); const LAS bf16_t* VP = (const LAS bf16_t*)(L + cur * 65536 + 32768);
            const LAS float* TABh = TAB + h * 132; const float mfar = m2 - TABh[129];
            const int dq = q - 256 * n;
            const bool nearw = __builtin_amdgcn_readfirstlane((int)(__ballot(valid && dq < 383) != 0ull)) != 0;
            f32x16 o0 = {}, o1 = {}; float lsum = 0.f;
            if (nearw) { for (int st = 0; st < 8; ++st) ATTN_SUBTILE(KP, VP, st, true); }
            else { for (int st = 0; st < 8; ++st) ATTN_SUBTILE(KP, VP, st, false); }
            const float lt = lsum + __shfl_xor(lsum, 32);
            if (valid) { const size_t qi = (size_t)bh * SEQ + q;
                if (hi == 0) PL[(size_t)slot * (NH * BATCH * SEQ) + qi] = lt;
                bf16_t* dst = (bf16_t*)(F.ws + part_off(slot)) + qi * HD + 4 * hi;
#pragma unroll
                for (int g4 = 0; g4 < 4; ++g4) { *(u32x2*)(dst + 8 * g4) = (u32x2){cvt_pk_bf16(o0[4 * g4], o0[4 * g4 + 1]), cvt_pk_bf16(o0[4 * g4 + 2], o0[4 * g4 + 3])};
                    *(u32x2*)(dst + 32 + 8 * g4) = (u32x2){cvt_pk_bf16(o1[4 * g4], o1[4 * g4 + 1]), cvt_pk_bf16(o1[4 * g4 + 2], o1[4 * g4 + 3])}; } }
        }
        if (last) break;
        it = itn; itn = it2; pi = pin; g = gn; ent = entn; pin = pi2; gn = g2; entn = ent2; m2r = m2n; cur ^= 1;
#pragma unroll
        for (int ds = 0; ds < 4; ++ds) qf[ds] = qfn[ds];
    }
    VM_WAIT(); __syncthreads();
#undef BLK_FIND
#undef BLK_DMA
#undef BLK_ENTRY
#undef BLK_QLOAD
}

__device__ __forceinline__ void attn_own_unit(Frame& F, int bh, int qb, LAS float* TAB) {
    LAS unsigned char* L = F.lds;
    int tid = F.tid; asm volatile("" : "+v"(tid));
    const int lane = tid & 63, w = F.wave, j = lane & 31, hi = lane >> 5, lane8 = lane * 8;
    const int b = bh >> 3, h = bh & 7;
    const bf16_t* Qb = (const bf16_t*)(F.ws + WS_Q); const float* MQg = (const float*)(F.ws + WS_MQ);
    const u32x4* KF = (const u32x4*)(F.ws + WS_KFRAG) + ((size_t)bh * 32 + qb) * 2048; const u32x4* VF = (const u32x4*)(F.ws + WS_VFRAG) + ((size_t)bh * 32 + qb) * 2048;
    const float* PL = (const float*)(F.ws + WS_PL); bf16_t* YA = (bf16_t*)(F.ws + WS_YATT);
#pragma unroll
    for (int i = 0; i < 4; ++i) { ((LAS u32x4*)L)[tid + NTHR * i] = KF[tid + NTHR * i]; ((LAS u32x4*)(L + 32768))[tid + NTHR * i] = VF[tid + NTHR * i]; }
    const int ql = 32 * w + j; const size_t qi = (size_t)bh * SEQ + 256 * qb + ql;
    bf16x8 qf[4];
    { const bf16_t* qrow = Qb + ((size_t)b * SEQ + 256 * qb + ql) * DA + h * HD + 8 * hi;
#pragma unroll
      for (int ds = 0; ds < 4; ++ds) qf[ds] = *(const bf16x8*)(qrow + 16 * ds); }
    const float m2 = MQg[qi];
    __syncthreads();
    const LAS bf16_t* KP = (const LAS bf16_t*)L; const LAS bf16_t* VP = (const LAS bf16_t*)(L + 32768); const LAS float* TABh = TAB + h * 132;
    const float mfar = 0.f; (void)mfar; const int dq = ql;
    f32x16 o0 = {}, o1 = {}; float lsum = 0.f;
    for (int st = 0; st <= w; ++st) ATTN_SUBTILE(KP, VP, st, true);
    float lt = lsum + __shfl_xor(lsum, 32);
    const int nsel = qb < 3 ? qb : 3;
    for (int s = 0; s < nsel; ++s) {
        lt += PL[(size_t)s * (NH * BATCH * SEQ) + qi];
        const bf16_t* src = (const bf16_t*)(F.ws + part_off(s)) + qi * HD + 4 * hi;
#pragma unroll
        for (int g4 = 0; g4 < 4; ++g4) { const u32x2 a = *(const u32x2*)(src + 8 * g4), c = *(const u32x2*)(src + 32 + 8 * g4);
            o0[4 * g4] += bflo(a.x); o0[4 * g4 + 1] += bfhi(a.x); o0[4 * g4 + 2] += bflo(a.y); o0[4 * g4 + 3] += bfhi(a.y);
            o1[4 * g4] += bflo(c.x); o1[4 * g4 + 1] += bfhi(c.x); o1[4 * g4 + 2] += bflo(c.y); o1[4 * g4 + 3] += bfhi(c.y); } }
    const float inv = 1.f / lt;
    bf16_t* dst = YA + ((size_t)b * SEQ + 256 * qb + ql) * DA + h * HD + 4 * hi;
#pragma unroll
    for (int g4 = 0; g4 < 4; ++g4) { *(u32x2*)(dst + 8 * g4) = (u32x2){cvt_pk_bf16(o0[4 * g4] * inv, o0[4 * g4 + 1] * inv), cvt_pk_bf16(o0[4 * g4 + 2] * inv, o0[4 * g4 + 3] * inv)};
        *(u32x2*)(dst + 32 + 8 * g4) = (u32x2){cvt_pk_bf16(o1[4 * g4] * inv, o1[4 * g4 + 1] * inv), cvt_pk_bf16(o1[4 * g4 + 2] * inv, o1[4 * g4 + 3] * inv)}; }
    __syncthreads();
}
__device__ __forceinline__ void attn_own_phase(Frame& F) {
    LAS float* TAB = (LAS float*)(F.lds + BTAB_OFF);
    attn_fill_tab(F, TAB);
    __syncthreads();
    for (int u = F.vcu; u < BATCH * NH * NBLK; u += F.G) attn_own_unit(F, u >> 5, u & 31, TAB);
}
#undef ATTN_SUBTILE

__device__ __forceinline__ void routing_phase(Frame& F) {
    LAS int* lcnt = (LAS int*)(F.lds); LAS int* lbase = lcnt + 32;
    const float* SSQ = (const float*)(F.ws + WS_SSQ); const float* RL = (const float*)(F.ws + WS_RLOG);
    unsigned* rowtok = (unsigned*)(F.ws + WS_ROWTOK); float* rowcoef = (float*)(F.ws + WS_ROWCOEF); float* rowrstd = (float*)(F.ws + WS_ROWRSTD);
    unsigned* ecnt = (unsigned*)(F.ctl + CW_ECNT);
    const float* brg = F.in[20]; const float* bre = F.in[22];
    const int tid = F.tid;
    for (int base = F.vcu * 256; base < T; base += F.G * 256) {
        if (tid < 32) lcnt[tid] = 0;
        __syncthreads();
        int e0 = 0, e1 = 0, lp0 = 0, lp1 = 0; float c0 = 0.f, c1 = 0.f, rstd = 0.f; const int tok = base + tid;
        if (tid < 256) {
            float ss = 0.f;
#pragma unroll
            for (int q = 0; q < 4; ++q) { const f32x4 v = *(const f32x4*)(SSQ + (size_t)tok * 16 + 4 * q); ss += (v.x + v.y) + (v.z + v.w); }
            rstd = 1.f / sqrtf(ss * (1.f / D) + RMS_EPS);
            float r[72];
#pragma unroll
            for (int q = 0; q < 18; ++q) { const f32x4 v = *(const f32x4*)(RL + (size_t)tok * 72 + 4 * q); r[4 * q] = v.x; r[4 * q + 1] = v.y; r[4 * q + 2] = v.z; r[4 * q + 3] = v.w; }
            float gl[4], el[32];
#pragma unroll
            for (int c = 0; c < 4; ++c) gl[c] = rstd * (r[c] + r[36 + c]) + brg[c];
#pragma unroll
            for (int c = 0; c < 32; ++c) el[c] = rstd * (r[4 + c] + r[40 + c]) + bre[c];
            int gi = 0; float gm = gl[0];
#pragma unroll
            for (int c = 1; c < 4; ++c) if (gl[c] > gm) { gm = gl[c]; gi = c; }
            float Z = 0.f;
#pragma unroll
            for (int c = 0; c < 4; ++c) Z += __expf(gl[c] - gm);
            const float gval = 1.f / Z;
            float es[8];
#pragma unroll
            for (int q = 0; q < 8; ++q) es[q] = gi == 0 ? el[q] : (gi == 1 ? el[8 + q] : (gi == 2 ? el[16 + q] : el[24 + q]));
            int a0 = 0; float m0 = es[0];
#pragma unroll
            for (int q = 1; q < 8; ++q) if (es[q] > m0) { m0 = es[q]; a0 = q; }
            int a1 = -1; float m1 = -INFINITY;
#pragma unroll
            for (int q = 0; q < 8; ++q) if (q != a0 && es[q] > m1) { m1 = es[q]; a1 = q; }
            const float w0 = 1.f / (1.f + __expf(m1 - m0)), w1 = 1.f - w0;
            e0 = gi * 8 + a0; e1 = gi * 8 + a1; c0 = gval * w0; c1 = gval * w1;
            lp0 = __hip_atomic_fetch_add(lcnt + e0, 1, __ATOMIC_RELAXED, __HIP_MEMORY_SCOPE_WORKGROUP);
            lp1 = __hip_atomic_fetch_add(lcnt + e1, 1, __ATOMIC_RELAXED, __HIP_MEMORY_SCOPE_WORKGROUP);
        }
        __syncthreads();
        if (tid < 32) lbase[tid] = (int)__hip_atomic_fetch_add(ecnt + tid, (unsigned)lcnt[tid], __ATOMIC_RELAXED, __HIP_MEMORY_SCOPE_AGENT);
        __syncthreads();
        if (tid < 256) {
            const size_t i0 = (size_t)e0 * ROWCAP + lbase[e0] + lp0, i1 = (size_t)e1 * ROWCAP + lbase[e1] + lp1;
            rowtok[i0] = (unsigned)tok * 2u; rowcoef[i0] = c0; rowrstd[i0] = rstd;
            rowtok[i1] = (unsigned)tok * 2u + 1u; rowcoef[i1] = c1; rowrstd[i1] = rstd;
        }
        __syncthreads();
    }
}
struct MoeOrder {
    const LAS int* tst; int total, G, v;
    __device__ bool next(int i, pg8::Unit& u) const {
        const int L = i * G + v; if (L >= total) return false;
        const int rt = L >> 2; int e = 0;
#pragma unroll 8
        for (int q = 1; q <= 32; ++q) e += (tst[q] <= rt) ? 1 : 0;
        u.pm = rt; u.pn = L & 3; u.pb = e * 4 + u.pn; u.aux = e; u.aux2 = (rt - tst[e]) * 256; return true;
    }
};
__device__ __forceinline__ void moe_tables(Frame& F) {
    LAS int* tst = (LAS int*)(F.lds + MOE_TST_OFF); const unsigned* ecnt = (const unsigned*)(F.ctl + CW_ECNT);
    if (F.wave == 0) { const int lane = F.lane; int nt = lane < 32 ? (int)((ecnt[lane & 31] + 255u) >> 8) : 0; int inc = nt;
#pragma unroll
        for (int o = 1; o < 32; o <<= 1) { const int t = __shfl_up(inc, o); if (lane >= o) inc += t; }
        if (lane < 32) tst[lane + 1] = inc; if (lane == 0) tst[0] = 0; }
    __syncthreads();
}
__device__ __forceinline__ void final_phase(Frame& F) {
    const float* X1 = (const float*)(F.ws + WS_X1); const bf16_t* Y0 = (const bf16_t*)(F.ws + WS_Y0); const bf16_t* Y1 = (const bf16_t*)(F.ws + WS_Y1); const float* gf = F.in[26];
    const int gw = F.vcu * NWAVES + F.wave, NGW = F.G * NWAVES, lane = F.lane;
    for (int m = gw; m < T; m += NGW) {
        const f32x4* xr = (const f32x4*)(X1 + (size_t)m * D) + lane; const u32x2* y0 = (const u32x2*)(Y0 + (size_t)m * D) + lane; const u32x2* y1 = (const u32x2*)(Y1 + (size_t)m * D) + lane;
        f32x4 v[4]; float s = 0.f;
#pragma unroll
        for (int j = 0; j < 4; ++j) { v[j] = xr[64 * j]; const u32x2 a = y0[64 * j], c = y1[64 * j];
            v[j].x += bflo(a.x) + bflo(c.x); v[j].y += bfhi(a.x) + bfhi(c.x); v[j].z += bflo(a.y) + bflo(c.y); v[j].w += bfhi(a.y) + bfhi(c.y);
            s += (v[j].x * v[j].x + v[j].y * v[j].y) + (v[j].z * v[j].z + v[j].w * v[j].w); }
        const float rstd = 1.f / sqrtf(wave_sum(s) * (1.f / D) + RMS_EPS);
        f32x4* o = (f32x4*)(F.out + (size_t)m * D) + lane; const f32x4* gr = (const f32x4*)gf + lane;
#pragma unroll
        for (int j = 0; j < 4; ++j) o[64 * j] = v[j] * rstd * gr[64 * j];
    }
}
#ifndef MK_N_LAUNCHES
#define MK_N_LAUNCHES 1
#endif
constexpr int NPHASE = 15;
struct Args { const float* in[27]; float* out; unsigned char* ws; int ph_lo, ph_hi; };
static_assert(sizeof(Args) == 27 * 8 + 8 + 8 + 8, "Args has no padding");

#ifndef DUP_MASK
#define DUP_MASK 0
#endif
#define PH_ARGS Frame& F, unsigned char* ws, LAS unsigned char* ring
__device__ __forceinline__ void ph1(PH_ARGS) {
    pg8::Gemm g{(const bf16_t*)(ws + WS_H1), (const bf16_t*)(ws + WS_WIN), D, D, D}; pg8::StaticOrder S; S.init(T, DIN, F.G, (int)blockIdx.x);
    EpiProj E{ws, F.in[3]};
    pg8::gemm_phase<EpiProj, pg8::StaticOrder, true, false>(ring, g, S, E, nullptr);
}
__device__ __forceinline__ void ph2(PH_ARGS) {
    { pg8::Gemm g{(const bf16_t*)(ws + WS_UP), (const bf16_t*)(ws + WS_SSMW), SKY, SKU, SKU}; pg8::GroupedOrder S; S.init(SG * 8, 1, 8, F.G, F.vcu);
      EpiSsmE E{(float*)(ws + WS_E)};
      pg8::gemm_phase<EpiSsmE, pg8::GroupedOrder, false, false>(ring, g, S, E, nullptr); }
    __syncthreads();
    kv_prep_phase(F);
}
__device__ __forceinline__ void ph4(PH_ARGS) {
    pg8::Gemm g{(const bf16_t*)(ws + WS_UP), (const bf16_t*)(ws + WS_SSMT), SKY, SKY, SKY}; pg8::GroupedOrder S; S.init(SG * 8, 2, 8, F.G, F.vcu);
    EpiSsmY E{(bf16_t*)(ws + WS_GACT)};
    pg8::gemm_phase<EpiSsmY, pg8::GroupedOrder, true, false>(ring, g, S, E, nullptr);
}
__device__ __forceinline__ void ph5(PH_ARGS) {
    pg8::Gemm g{(const bf16_t*)(ws + WS_GACT), (const bf16_t*)(ws + WS_WGLU), DS, DS, DS}; pg8::StaticOrder S; S.init(T, DS, F.G, (int)blockIdx.x);
    EpiGlu E{(const bf16_t*)(ws + WS_GACT), (bf16_t*)(ws + WS_YSSM), F.in[13]};
    pg8::gemm_phase<EpiGlu, pg8::StaticOrder, true, false>(ring, g, S, E, nullptr);
}
__device__ __forceinline__ void ph6(PH_ARGS) {
    { pg8::Gemm g{(const bf16_t*)(ws + WS_YSSM), (const bf16_t*)(ws + WS_WUS), DS, DS, DS}; pg8::StaticOrder S; S.init(T, D, F.G, (int)blockIdx.x);
      EpiUp<false> E{(const bf16_t*)(ws + WS_SGS), (bf16_t*)(ws + WS_MRG)};
      pg8::gemm_phase<EpiUp<false>, pg8::StaticOrder, true, false>(ring, g, S, E, nullptr); }
    VM_WAIT(); __syncthreads();
    { pg8::Gemm g{(const bf16_t*)(ws + WS_YATT), (const bf16_t*)(ws + WS_WUA), DA, DA, DA}; pg8::StaticOrder S; S.init(T, D, F.G, (int)blockIdx.x);
      EpiUp<true> E{(const bf16_t*)(ws + WS_SGA), (bf16_t*)(ws + WS_MRG)};
      pg8::gemm_phase<EpiUp<true>, pg8::StaticOrder, true, false>(ring, g, S, E, nullptr); }
}
__device__ __forceinline__ void ph7(PH_ARGS) {
    pg8::Gemm g{(const bf16_t*)(ws + WS_MRG), (const bf16_t*)(ws + WS_WOUT), D, D, D}; pg8::StaticOrder S; S.init(T, D, F.G, (int)blockIdx.x);
    EpiOut E{F.in[0], (float*)(ws + WS_X1), (bf16_t*)(ws + WS_XG), F.in[18], (float*)(ws + WS_SSQ)};
    pg8::gemm_phase<EpiOut, pg8::StaticOrder, true, false>(ring, g, S, E, nullptr);
}
__device__ __forceinline__ void ph8(PH_ARGS) {
    pg8::Gemm g{(const bf16_t*)(ws + WS_XG), (const bf16_t*)(ws + WS_WR), D, D, D}; pg8::StaticOrder S; S.init(T, 256, F.G, (int)blockIdx.x);
    EpiRouter E{(float*)(ws + WS_RLOG)};
    pg8::gemm_phase<EpiRouter, pg8::StaticOrder, false, false>(ring, g, S, E, nullptr);
}
__device__ __forceinline__ void ph10(PH_ARGS) {
    moe_tables(F);
    const LAS int* tst = (const LAS int*)(F.lds + MOE_TST_OFF);
    MoeOrder S{tst, tst[32] * 4, F.G, F.vcu};
    LAS unsigned* rowtab = (LAS unsigned*)(F.lds + ROWTAB_OFF);
    { const unsigned* rowtok = (const unsigned*)(ws + WS_ROWTOK); const unsigned* ecnt = (const unsigned*)(F.ctl + CW_ECNT); pg8::Unit u;
      for (int i = 0; i < ROWTAB_UNITS && S.next(i, u); ++i) { if (F.tid < 256) { const int pos = u.aux2 + F.tid; const unsigned tk = pos < (int)ecnt[u.aux] ? (rowtok[(size_t)u.aux * ROWCAP + pos] >> 1) : 0u; rowtab[i * 256 + F.tid] = tk * (unsigned)(D * 2); } } }
    __syncthreads();
    pg8::Gemm g{(const bf16_t*)(ws + WS_XG), (const bf16_t*)(ws + WS_W13), D, D, D};
    EpiMoe1 E{(bf16_t*)(ws + WS_HID), (const float*)(ws + WS_ROWRSTD), (const unsigned*)(F.ctl + CW_ECNT)};
    pg8::gemm_phase<EpiMoe1, MoeOrder, true, true>(ring, g, S, E, rowtab);
}
__device__ __forceinline__ void ph11(PH_ARGS) {
    moe_tables(F);
    const LAS int* tst = (const LAS int*)(F.lds + MOE_TST_OFF);
    MoeOrder S{tst, tst[32] * 4, F.G, F.vcu};
    pg8::Gemm g{(const bf16_t*)(ws + WS_HID), (const bf16_t*)(ws + WS_W2), DE, DE, DE};
    EpiMoe2 E{(bf16_t*)(ws + WS_Y0), (size_t)(WS_Y1 - WS_Y0), (const unsigned*)(ws + WS_ROWTOK), (const float*)(ws + WS_ROWCOEF), (const unsigned*)(F.ctl + CW_ECNT)};
    pg8::gemm_phase<EpiMoe2, MoeOrder, true, false>(ring, g, S, E, nullptr);
}

__global__ void __launch_bounds__(NTHR, 2) fwd_kernel(Args args) {
    extern __shared__ __attribute__((aligned(16))) unsigned char lds_raw[];
    Frame F;
    F.lds = (LAS unsigned char*)lds_raw;
    F.MISC = (volatile LAS unsigned*)(F.lds + MISC_OFF);
    F.tid = threadIdx.x; F.lane = F.tid & 63; F.wave = __builtin_amdgcn_readfirstlane(F.tid >> 6);
    F.G = gridDim.x; { const int bx = blockIdx.x; F.vcu = (F.G % 8 == 0) ? (bx % 8) * (F.G / 8) + bx / 8 : bx; }
    F.ws = args.ws; F.ctl = (gu32*)(args.ws + WS_CTL); F.out = args.out;
#pragma unroll
    for (int i = 0; i < 27; ++i) F.in[i] = args.in[i];
    for (int u = F.tid; u < (LDS_BYTES - MOE_TST_OFF) / 4; u += NTHR) ((LAS unsigned*)(F.lds + MOE_TST_OFF))[u] = 0u;
    __syncthreads();
    XcdBarrier bar; bar.bar = (unsigned*)(F.ctl + CW_BAR); bar.x = 0; bar.st = nullptr;
    const int lo = args.ph_lo, hi = args.ph_hi;
    if (hi - lo > 1) bar = xcd_barrier_post((unsigned*)(F.ctl + CW_BAR), F.MISC + 8);
#define IN(k) (lo <= (k) && (k) < hi)
#define DUP(k) ((DUP_MASK >> (k)) & 1)
#define SEAM(k) do { if (IN(k) && IN((k) + 1)) xcd_barrier(bar); } while (0)
    unsigned char* ws = args.ws;
    LAS unsigned char* ring = F.lds;
    if (IN(0)) { p0_prologue(F); if (DUP(0)) p0_prologue(F); }
    SEAM(0);
    if (IN(1)) { ph1(F, ws, ring); if (DUP(1)) ph1(F, ws, ring); }
    SEAM(1);
    if (IN(2)) { ph2(F, ws, ring); if (DUP(2)) ph2(F, ws, ring); }
    SEAM(2);
    if (IN(3)) { ssm_scan_phase(F); attn_gate_phase(F); }
    SEAM(3);
    if (IN(4)) { attn_block_phase(F); if (DUP(4)) { __syncthreads(); attn_block_phase(F); } }
    SEAM(4);
    if (IN(5)) { attn_own_phase(F); if (DUP(5)) attn_own_phase(F); }
    SEAM(5);
    if (IN(6)) { ph4(F, ws, ring); if (DUP(6)) ph4(F, ws, ring); }
    SEAM(6);
    if (IN(7)) { ph5(F, ws, ring); if (DUP(7)) ph5(F, ws, ring); }
    SEAM(7);
    if (IN(8)) { ph6(F, ws, ring); if (DUP(8)) ph6(F, ws, ring); }
    SEAM(8);
    if (IN(9)) { ph7(F, ws, ring); if (DUP(9)) ph7(F, ws, ring); }
    SEAM(9);
    if (IN(10)) { ph8(F, ws, ring); if (DUP(10)) ph8(F, ws, ring); }
    SEAM(10);
    if (IN(11)) { routing_phase(F); }
    SEAM(11);
    if (IN(12)) { ph10(F, ws, ring); if (DUP(12)) ph10(F, ws, ring); }
    SEAM(12);
    if (IN(13)) { ph11(F, ws, ring); if (DUP(13)) ph11(F, ws, ring); }
    SEAM(13);
    if (IN(14)) { final_phase(F); if (DUP(14)) final_phase(F); }
#undef IN
#undef DUP
#undef SEAM
}

extern "C" void kernel_launch(void* const* d_in, const int* in_sizes, int n_in, void* d_out, int out_size, void* d_ws, size_t ws_size, hipStream_t stream) {
    static int grid = 0;
    if (grid == 0) {
        if (n_in != 27 || in_sizes[0] != T * D || out_size != T * D || ws_size < WS_END) { fprintf(stderr, "kernel_launch: unexpected shapes (n_in %d, in0 %d, out %d, ws %zu)\n", n_in, n_in > 0 ? in_sizes[0] : -1, out_size, ws_size); grid = -1; return; }
        int dev = 0, cus = 0;
        if (hipGetDevice(&dev) != hipSuccess || hipDeviceGetAttribute(&cus, hipDeviceAttributeMultiprocessorCount, dev) != hipSuccess) { grid = -1; return; }
        if (hipFuncSetAttribute((const void*)fwd_kernel, hipFuncAttributeMaxDynamicSharedMemorySize, LDS_BYTES) != hipSuccess) { fprintf(stderr, "kernel_launch: hipFuncSetAttribute failed\n"); grid = -1; return; }
        (void)hipGetLastError();
        grid = cus;
    }
    if (grid < 0) return;
    (void)hipMemsetAsync((char*)d_ws + WS_CTL, 0, CTL_ZERO_BYTES, stream);
    Args a{};
    for (int i = 0; i < 27; ++i) a.in[i] = (const float*)d_in[i];
    a.out = (float*)d_out; a.ws = (unsigned char*)d_ws;
    if (MK_N_LAUNCHES == 1) { a.ph_lo = 0; a.ph_hi = NPHASE; hipLaunchKernelGGL(fwd_kernel, dim3(grid), dim3(NTHR), LDS_BYTES, stream, a); }
    else { for (int p = 0; p < NPHASE; ++p) { a.ph_lo = p; a.ph_hi = p + 1; hipLaunchKernelGGL(fwd_kernel, dim3(grid), dim3(NTHR), LDS_BYTES, stream, a); } }
}
```

```cpp
#include <hip/hip_runtime.h>
#include <cstdio>
#include <cstdint>

#define LAS __attribute__((address_space(3)))
#define GAS __attribute__((address_space(1)))
typedef unsigned short bf16_t;
typedef short bf16x8 __attribute__((ext_vector_type(8)));
typedef float f32x2 __attribute__((ext_vector_type(2)));
typedef float f32x4 __attribute__((ext_vector_type(4)));
typedef float f32x16 __attribute__((ext_vector_type(16)));
typedef unsigned u32x2 __attribute__((ext_vector_type(2)));
typedef unsigned u32x4 __attribute__((ext_vector_type(4)));
typedef GAS unsigned gu32;
#define RLX_AGENT __ATOMIC_RELAXED, __HIP_MEMORY_SCOPE_AGENT
#define LDS_WAIT() asm volatile("s_waitcnt lgkmcnt(0)" ::: "memory")
#define VM_WAIT() asm volatile("s_waitcnt vmcnt(0)" ::: "memory")

__device__ __forceinline__ unsigned f2bf(float f) { unsigned u = __builtin_bit_cast(unsigned, f); return (u + 0x7fffu + ((u >> 16) & 1u)) >> 16; }
__device__ __forceinline__ unsigned pk2(float lo, float hi) { return f2bf(lo) | (f2bf(hi) << 16); }
__device__ __forceinline__ float bf2f(unsigned short b) { return __builtin_bit_cast(float, (unsigned)b << 16); }
__device__ __forceinline__ float bflo(unsigned w) { return __builtin_bit_cast(float, w << 16); }
__device__ __forceinline__ float bfhi(unsigned w) { return __builtin_bit_cast(float, w & 0xffff0000u); }
__device__ __forceinline__ unsigned cvt_pk_bf16(float lo, float hi) { unsigned r; asm volatile("v_cvt_pk_bf16_f32 %0, %1, %2" : "=v"(r) : "v"(lo), "v"(hi)); return r; }
__device__ __forceinline__ float fast_sigmoid(float x) { return __builtin_amdgcn_rcpf(1.f + __builtin_amdgcn_exp2f(-1.4426950408889634f * x)); }
__device__ __forceinline__ float wave_sum(float v) {
#pragma unroll
    for (int o = 1; o < 64; o <<= 1) v += __shfl_xor(v, o);
    return v;
}
__device__ __forceinline__ float wave_max(float v) {
#pragma unroll
    for (int o = 1; o < 64; o <<= 1) v = fmaxf(v, __shfl_xor(v, o));
    return v;
}

#define XB_TMO      128
#define XB_XCNT(j)  (256  + 64 * (j))
#define XB_XSUB(j)  (1280 + 64 * (j))
#define XB_XGEN(j)  (2304 + 64 * (j))
#define XB_TOP      3328
#define XB_TOPGEN   3392
#define XCD_BAR_WORDS 3456
#define XB_SPIN_CAP (1u << 20)

__device__ __forceinline__ unsigned xb_ld(unsigned* p)              { return __hip_atomic_load(p, __ATOMIC_RELAXED, __HIP_MEMORY_SCOPE_AGENT); }
__device__ __forceinline__ unsigned xb_add(unsigned* p, unsigned v) { return __hip_atomic_fetch_add(p, v, __ATOMIC_RELAXED, __HIP_MEMORY_SCOPE_AGENT); }
__device__ __forceinline__ unsigned xb_xcc_id() { return (unsigned)__builtin_amdgcn_s_getreg((3 << 11) | 20) & 0xFu; }
#define XB_SPIN(cond, bar) do { unsigned _sp = 0; while (cond) { __builtin_amdgcn_s_sleep(1); \
    if ((++_sp & 255u) == 0u) { if (xb_ld(&(bar)[XB_TMO])) break; if (_sp > XB_SPIN_CAP) { atomicAdd(&(bar)[XB_TMO], 1u); break; } } } } while (0)

struct XcdBarrier { unsigned* bar; unsigned x; volatile LAS unsigned* st; };

__device__ __forceinline__ XcdBarrier xcd_barrier_post(unsigned* bar, volatile LAS unsigned* st) {
    XcdBarrier b; b.bar = bar; b.x = xb_xcc_id(); b.st = st;
    if (threadIdx.x == 0) (void)xb_add(&bar[XB_XCNT(b.x)], 1u);
    return b;
}
__device__ __forceinline__ void xcd_barrier_complete(unsigned* bar, unsigned x, unsigned& nloc, unsigned& nx) {
    const unsigned G = gridDim.x * gridDim.y * gridDim.z;
    unsigned sum, cnt, mine, sp = 0u;
    for (;;) {
        sum = 0u; cnt = 0u; mine = 0u;
#pragma unroll
        for (unsigned j = 0; j < 16; ++j) { const unsigned c = xb_ld(&bar[XB_XCNT(j)]); sum += c; cnt += (c > 0u) ? 1u : 0u; mine = (j == x) ? c : mine; }
        if (sum == G) break;
        __builtin_amdgcn_s_sleep(1);
        if ((++sp & 255u) == 0u) { if (xb_ld(&bar[XB_TMO])) break; if (sp > XB_SPIN_CAP) { atomicAdd(&bar[XB_TMO], 1u); break; } }
    }
    nloc = mine > 0u ? mine : 1u; nx = cnt > 0u ? cnt : 1u;
}
__device__ __forceinline__ void xcd_barrier(const XcdBarrier& b) {
    asm volatile("s_waitcnt vmcnt(0)" ::: "memory");
    __syncthreads();
    if (threadIdx.x == 0) {
        unsigned* bar = b.bar;
        __builtin_amdgcn_s_waitcnt(0);
        unsigned nloc = b.st[0], nx = b.st[1];
        if (nloc == 0u) { xcd_barrier_complete(bar, b.x, nloc, nx); b.st[0] = nloc; b.st[1] = nx; }
        const unsigned old = xb_add(&bar[XB_XSUB(b.x)], 1u);
        const unsigned gen = old / nloc;
        if (old + 1u == (gen + 1u) * nloc) {
            __builtin_amdgcn_fence(__ATOMIC_RELEASE, "agent");
            asm volatile("s_waitcnt vmcnt(0)" ::: "memory");
            const unsigned og = xb_add(&bar[XB_TOP], 1u);
            const unsigned tg = og / nx;
            if (og + 1u == (tg + 1u) * nx) xb_add(&bar[XB_TOPGEN], 1u);
            else XB_SPIN(xb_ld(&bar[XB_TOPGEN]) == tg, bar);
            __builtin_amdgcn_fence(__ATOMIC_ACQUIRE, "agent");
            xb_add(&bar[XB_XGEN(b.x)], 1u);
            asm volatile("s_waitcnt vmcnt(0)" ::: "memory");
        } else {
            XB_SPIN(xb_ld(&bar[XB_XGEN(b.x)]) == gen, bar);
            __builtin_amdgcn_fence(__ATOMIC_ACQUIRE, "agent");
            asm volatile("s_waitcnt vmcnt(0)" ::: "memory");
        }
    }
    __syncthreads();
}

namespace pg8 {
constexpr int BM = 256, BK = 64, HALF = 128, HTB = HALF * BK * 2, STAGE_BYTES = 8 * HTB, NXCD = 8, WGM = 8;
__host__ __device__ __forceinline__ int lds_byte(int r, int c) { const int st = (r >> 4) * 2 + (c >> 5), rr = r & 15, cc = c & 31, ob = rr * 64 + cc * 2; return st * 1024 + (ob ^ (((ob >> 9) & 1) << 5)); }
__host__ __device__ __forceinline__ void stage_rc(int b, int& R, int& C) { const int st = b / 1024, sb = b % 1024, swz = sb ^ (((sb >> 9) & 1) << 5); R = (st >> 1) * 16 + swz / 64; C = (st & 1) * 32 + (swz % 64) / 2; }
__host__ __device__ __forceinline__ int perm32(int rho) { const int n = rho >> 4, i = rho & 15; return 8 * (i >> 2) + 4 * n + (i & 3); }

struct Unit { int pm, pn, pb, aux, aux2; };
struct Gemm { const bf16_t* A; const bf16_t* Bt; int lda, ldb, K; };

struct StaticOrder {
    int nM, nN, nwg, G, c;
    __device__ void init(int M, int N, int G_, int c_) { nM = M / BM; nN = N / BM; nwg = nM * nN; G = G_; c = c_; }
    __device__ bool next(int i, Unit& u) const {
        const long L = (long)i * G + c; if (L >= nwg) return false;
        int wgid = (int)L; { const int q = nwg / NXCD, r = nwg % NXCD, xcd = wgid % NXCD, off = wgid / NXCD; wgid = (xcd < r ? xcd * (q + 1) : r * (q + 1) + (xcd - r) * q) + off; }
        const int nig = WGM * nN, gid = wgid / nig, fm = gid * WGM, gsz = (nM - fm) < WGM ? (nM - fm) : WGM;
        u.pm = fm + ((wgid % nig) % gsz); u.pn = (wgid % nig) / gsz; u.pb = u.pn; u.aux = 0; u.aux2 = 0; return true;
    }
};
struct GroupedOrder {
    int nM, nN, rtpg, G, v;
    __device__ void init(int nM_, int nN_, int rtpg_, int G_, int v_) { nM = nM_; nN = nN_; rtpg = rtpg_; G = G_; v = v_; }
    __device__ bool next(int i, Unit& u) const {
        const int L = i * G + v; if (L >= nM * nN) return false;
        u.pm = L / nN; u.pn = L % nN; u.aux = u.pm / rtpg; u.pb = u.aux * nN + u.pn; u.aux2 = 0; return true;
    }
};

template <class Epi, class Sched, bool ALIGN_EPI, bool GATHER>
__device__ __forceinline__ void gemm_phase(LAS unsigned char* lds, const Gemm g, const Sched& S, const Epi& E, const LAS unsigned* rowtab  ) {
    const int tid = threadIdx.x, wid = __builtin_amdgcn_readfirstlane(tid >> 6), lane = tid & 63, wr = wid >> 2, wc = wid & 3, fr = lane & 15, fq = lane >> 4;
    const int K = g.K, nt = K / BK;
    int RA[2]; unsigned cA2[2]; unsigned voffB[2];
#pragma unroll
    for (int i = 0; i < 2; ++i) { int R, C; stage_rc(tid * 16 + i * 8192, R, C); const int Rb = (R & ~31) + perm32(R & 31);
        RA[i] = R; cA2[i] = (unsigned)C * 2u; voffB[i] = (unsigned)(Rb * g.ldb + C) * 2u; }
    const size_t kstep = (size_t)(BK * 2);
    const size_t hstepB = (size_t)HALF * g.ldb * 2, tstepB = 2 * hstepB;
    const size_t tstepA = (size_t)BM * g.lda * 2;
    const unsigned ldsw = (unsigned)wid * 1024u;
    const int aoff = lds_byte(wr * 64 + fr, fq * 8), boff = lds_byte(wc * 32 + fr, fq * 8);
    unsigned vAc[2][2], vAn[2][2];
#define PG8_SETVA(dst, ui_) do { _Pragma("unroll") for (int h_ = 0; h_ < 2; ++h_) _Pragma("unroll") for (int i_ = 0; i_ < 2; ++i_) \
        dst[h_][i_] = (GATHER ? rowtab[(ui_) * 256 + h_ * 128 + RA[i_]] : (unsigned)((h_ * 128 + RA[i_]) * g.lda) * 2u) + cA2[i_]; } while (0)
#define PG8_SA(b, h) (((b) * 2 + (h)) * HTB)
#define PG8_SB(b, h) ((4 + (b) * 2 + (h)) * HTB)
#define PG8_STAGE(bufoff, gbase, v0, v1) do { \
        __builtin_amdgcn_global_load_lds((const unsigned*)((const char*)(gbase) + (v0)), (LAS unsigned*)(lds + (bufoff) + ldsw), 16, 0, 0); \
        __builtin_amdgcn_global_load_lds((const unsigned*)((const char*)(gbase) + (v1)), (LAS unsigned*)(lds + (bufoff) + ldsw + 8192), 16, 0, 0); } while (0)
#define PG8_STB(bufoff, gbase) PG8_STAGE(bufoff, gbase, voffB[0], voffB[1])
#define PG8_LDA(dst, b, h) do { _Pragma("unroll") for (int m = 0; m < 4; ++m) _Pragma("unroll") for (int k = 0; k < 2; ++k) dst[m][k] = *(const LAS bf16x8*)(lds + PG8_SA(b, h) + aoff + m * 2048 + k * 1024); } while (0)
#define PG8_LDB(dst, b, h) do { _Pragma("unroll") for (int n = 0; n < 2; ++n) _Pragma("unroll") for (int k = 0; k < 2; ++k) dst[n][k] = *(const LAS bf16x8*)(lds + PG8_SB(b, h) + boff + n * 2048 + k * 1024); } while (0)
#define PG8_MMA(ai, bj, At, Bt) do { __builtin_amdgcn_s_setprio(1); _Pragma("unroll") for (int m = 0; m < 4; ++m) _Pragma("unroll") for (int n = 0; n < 2; ++n) _Pragma("unroll") for (int k = 0; k < 2; ++k) \
        acc[ai][bj][m][n] = __builtin_amdgcn_mfma_f32_16x16x32_bf16(Bt[n][k], At[m][k], acc[ai][bj][m][n], 0, 0, 0); __builtin_amdgcn_s_setprio(0); } while (0)
#define PG8_WAIT_V(n) asm volatile("s_waitcnt vmcnt(" #n ")" ::: "memory")
#define PG8_WAIT_L(n) asm volatile("s_waitcnt lgkmcnt(" #n ")" ::: "memory")
#define PG8_BAR __builtin_amdgcn_s_barrier()
#define PG8_SCHED __builtin_amdgcn_sched_barrier(0)
    Unit cur, nxt; int ui = 0;
    if (!S.next(0, cur)) return;
    f32x4 acc[2][2][4][2];
#pragma unroll
    for (int a = 0; a < 2; ++a)
#pragma unroll
        for (int b = 0; b < 2; ++b)
#pragma unroll
            for (int m = 0; m < 4; ++m)
#pragma unroll
                for (int n = 0; n < 2; ++n) acc[a][b][m][n] = (f32x4){0.f, 0.f, 0.f, 0.f};
    bf16x8 At[4][2], B0[2][2], B1[2][2];
    const char* cA = (const char*)g.A + (GATHER ? (size_t)0 : (size_t)cur.pm * tstepA); const char* cB = (const char*)g.Bt + (size_t)cur.pb * tstepB;
    PG8_SETVA(vAc, 0);
    PG8_STB(PG8_SB(0, 0), cB); PG8_STB(PG8_SB(0, 1), cB + hstepB); PG8_STAGE(PG8_SA(0, 0), cA, vAc[0][0], vAc[0][1]); PG8_STAGE(PG8_SA(0, 1), cA, vAc[1][0], vAc[1][1]);
    if (wr == 1) PG8_BAR;
    PG8_WAIT_V(2); PG8_BAR;
    PG8_STB(PG8_SB(1, 0), cB + kstep); PG8_STAGE(PG8_SA(1, 0), cA + kstep, vAc[0][0], vAc[0][1]); PG8_STB(PG8_SB(1, 1), cB + hstepB + kstep);
    PG8_WAIT_V(6); PG8_BAR;
    for (;;) {
        const bool has_next = S.next(ui + 1, nxt);
        const char* nA = GATHER ? cA : (has_next ? (const char*)g.A + (size_t)nxt.pm * tstepA : cA); const char* nB = has_next ? (const char*)g.Bt + (size_t)nxt.pb * tstepB : cB;
        if (GATHER) { if (has_next) { PG8_SETVA(vAn, ui + 1); } else {
#pragma unroll
            for (int h_ = 0; h_ < 2; ++h_) { vAn[h_][0] = vAc[h_][0]; vAn[h_][1] = vAc[h_][1]; } } }
        for (int t = 0; t < nt; t += 2) {
            const bool last = (t == nt - 2);
            const char* a1 = cA + (size_t)(t + 1) * kstep;
            const char* a2 = last ? nA : cA + (size_t)(t + 2) * kstep; const char* b2 = last ? nB : cB + (size_t)(t + 2) * kstep;
            const char* a3 = a2 + kstep; const char* b3 = b2 + kstep;
            unsigned x00, x01, x10, x11;
            if (GATHER) { x00 = last ? vAn[0][0] : vAc[0][0]; x01 = last ? vAn[0][1] : vAc[0][1]; x10 = last ? vAn[1][0] : vAc[1][0]; x11 = last ? vAn[1][1] : vAc[1][1]; }
            else { x00 = vAc[0][0]; x01 = vAc[0][1]; x10 = vAc[1][0]; x11 = vAc[1][1]; }
            PG8_LDB(B0, 0, 0); PG8_LDB(B1, 0, 1); PG8_SCHED; PG8_LDA(At, 0, 0); PG8_STAGE(PG8_SA(1, 1), a1, vAc[1][0], vAc[1][1]);
            PG8_WAIT_V(8); PG8_WAIT_L(0); PG8_BAR; PG8_MMA(0, 0, At, B0); PG8_MMA(0, 1, At, B1); PG8_BAR; PG8_SCHED;
            PG8_LDA(At, 0, 1); PG8_STB(PG8_SB(0, 0), b2); PG8_STB(PG8_SB(0, 1), b2 + hstepB); PG8_STAGE(PG8_SA(0, 0), a2, x00, x01);
            PG8_WAIT_V(8); PG8_WAIT_L(0); PG8_BAR; PG8_MMA(1, 0, At, B0); PG8_MMA(1, 1, At, B1); PG8_BAR; PG8_SCHED;
            PG8_LDB(B0, 1, 0); PG8_LDB(B1, 1, 1); PG8_SCHED; PG8_LDA(At, 1, 0); PG8_STAGE(PG8_SA(0, 1), a2, x10, x11);
            PG8_WAIT_V(8); PG8_WAIT_L(0); PG8_BAR; PG8_MMA(0, 0, At, B0); PG8_MMA(0, 1, At, B1); PG8_BAR; PG8_SCHED;
            PG8_LDA(At, 1, 1); PG8_STB(PG8_SB(1, 0), b3); PG8_STB(PG8_SB(1, 1), b3 + hstepB); PG8_STAGE(PG8_SA(1, 0), a3, x00, x01);
            PG8_WAIT_V(8); PG8_WAIT_L(0); PG8_BAR; PG8_MMA(1, 0, At, B0); PG8_MMA(1, 1, At, B1); PG8_BAR; PG8_SCHED;
        }
        if constexpr (ALIGN_EPI) { if (wr == 0) PG8_BAR; }
        E(acc, cur, wr, wc, fr, fq);
        if (!has_next) break;
#pragma unroll
        for (int a = 0; a < 2; ++a)
#pragma unroll
            for (int b = 0; b < 2; ++b)
#pragma unroll
                for (int m = 0; m < 4; ++m)
#pragma unroll
                    for (int n = 0; n < 2; ++n) acc[a][b][m][n] = (f32x4){0.f, 0.f, 0.f, 0.f};
        cur = nxt; cA = nA; cB = nB; ++ui;
        if (GATHER) {
#pragma unroll
            for (int h_ = 0; h_ < 2; ++h_) { vAc[h_][0] = vAn[h_][0]; vAc[h_][1] = vAn[h_][1]; } }
        if constexpr (ALIGN_EPI) { if (wr == 1) PG8_BAR; }
    }
    PG8_WAIT_V(0);
    if constexpr (!ALIGN_EPI) { if (wr == 0) PG8_BAR; }
    PG8_BAR;
#undef PG8_SETVA
#undef PG8_SA
#undef PG8_SB
#undef PG8_STAGE
#undef PG8_STB
#undef PG8_LDA
#undef PG8_LDB
#undef PG8_MMA
#undef PG8_WAIT_V
#undef PG8_WAIT_L
#undef PG8_BAR
#undef PG8_SCHED
}
}
constexpr int NWAVES = 8, NTHR = 512;
constexpr int BATCH = 8, SEQ = 8192, T = BATCH * SEQ, D = 1024, DIN = 4096;
constexpr int DS = 512, DA = 512, NH = 8, HD = 64, NBLK = SEQ / 256;
constexpr int SG = 32, SHC = 16, SP = 64, SL = 32, SKU = SL * SHC  , SKS = 2 * SP  , SKY = SKU + SKS  , SROWS = T / SL  ;
constexpr int NE = 32, DE = 512;
constexpr float RMS_EPS = 1e-6f;
constexpr float LOG2E = 1.4426950408889634f;
constexpr float QSCALE = 0.125f * LOG2E;
constexpr int ROWCAP = T;
constexpr int HID_ROWS = 2 * T + NE * 256;

constexpr size_t MiB = 1u << 20;
constexpr size_t WS_CTL = 0, CTL_ZERO_BYTES = 1 * MiB;
constexpr size_t WS_WIN = 1 * MiB;
constexpr size_t WS_WGLU = 9 * MiB;
constexpr size_t WS_WUS = 10 * MiB;
constexpr size_t WS_WUA = 11 * MiB;
constexpr size_t WS_WOUT = 12 * MiB;
constexpr size_t WS_WR = 14 * MiB;
constexpr size_t WS_KMEAN = 15 * MiB;
constexpr size_t WS_SSMW = 16 * MiB;
constexpr size_t WS_SSMT = 24 * MiB;
constexpr size_t WS_W13 = 44 * MiB;
constexpr size_t WS_W2 = 108 * MiB;
constexpr size_t WS_A0 = 140 * MiB;
constexpr size_t WS_UP = 276 * MiB;
constexpr size_t WS_Q = 356 * MiB;
constexpr size_t WS_SSQ = 404 * MiB;
constexpr size_t WS_RLOG = 408 * MiB;
constexpr size_t WS_K = 420 * MiB;
constexpr size_t WS_ROWTOK = 428 * MiB, WS_ROWCOEF = 436 * MiB, WS_ROWRSTD = 444 * MiB;
constexpr size_t WS_GACT = 420 * MiB;
constexpr size_t WS_V = 484 * MiB;
constexpr size_t WS_YSSM = 484 * MiB;
constexpr size_t WS_SGS = 548 * MiB;
constexpr size_t WS_SGA = 676 * MiB;
constexpr size_t WS_E = 804 * MiB;
constexpr size_t WS_YATT = 836 * MiB;
constexpr size_t WS_PART0 = 420 * MiB, WS_PART1 = 484 * MiB, WS_PART2 = 932 * MiB;
constexpr size_t WS_QLIST = 900 * MiB;
constexpr size_t WS_PL = 268 * MiB;
constexpr size_t WS_MQ = 996 * MiB;
constexpr size_t WS_SEGC = 998 * MiB;
constexpr size_t WS_END = 999 * MiB;
constexpr size_t WS_KFRAG = WS_A0, WS_VFRAG = WS_A0 + 64 * MiB, WS_H1 = WS_A0, WS_MRG = WS_A0, WS_HID = WS_A0;
constexpr size_t WS_X1 = WS_SGS, WS_XG = WS_UP, WS_Y0 = WS_UP, WS_Y1 = WS_E;
static_assert(WS_GACT + 64 * MiB <= WS_YSSM && WS_YSSM + 64 * MiB <= WS_SGS, "map");
static_assert(WS_HID + (size_t)HID_ROWS * DE * 2 <= WS_UP, "hid fits");
static_assert(WS_RLOG + (size_t)T * 72 * 4 <= WS_ROWTOK, "rlog fits");

constexpr int CW_TMO = 0, CW_CODE = 1;
constexpr int CW_BAR = 4096;
constexpr int CW_ECNT = 8192;
constexpr int CW_GCNT = 12288;

constexpr int RING_BYTES = 131072;
constexpr int ROWTAB_OFF = RING_BYTES, ROWTAB_UNITS = 12, ROWTAB_BYTES = 24 * 1024;
constexpr int MOE_TST_OFF = ROWTAB_OFF + ROWTAB_BYTES;
constexpr int MISC_OFF = MOE_TST_OFF + 512;
constexpr int LDS_BYTES = MISC_OFF + 128;
static_assert(LDS_BYTES <= 163840, "LDS");

struct Frame {
    LAS unsigned char* lds;
    volatile LAS unsigned* MISC;
    gu32* ctl;
    unsigned char* ws;
    int tid, lane, wave, vcu, G;
    const float* in[27];
    float* out;
};

#define EPI_LOOP_BEGIN  _Pragma("unroll") for (int ai = 0; ai < 2; ++ai) _Pragma("unroll") for (int m = 0; m < 4; ++m) { const int rl = ai * 128 + wr * 64 + m * 16 + fr; _Pragma("unroll") for (int bj = 0; bj < 2; ++bj) { const int cl = bj * 128 + wc * 32 + 8 * fq; \
        const f32x4 a0 = acc[ai][bj][m][0], a1 = acc[ai][bj][m][1]; (void)rl; (void)cl; (void)a0; (void)a1;
#define EPI_LOOP_END } }
typedef const f32x4 (&AccRef)[2][2][4][2];
__device__ __forceinline__ u32x4 pack8(f32x4 a, f32x4 b) { u32x4 w; w.x = cvt_pk_bf16(a[0], a[1]); w.y = cvt_pk_bf16(a[2], a[3]); w.z = cvt_pk_bf16(b[0], b[1]); w.w = cvt_pk_bf16(b[2], b[3]); return w; }
__device__ __forceinline__ void unpack8(u32x4 w, f32x4& a, f32x4& b) { a = (f32x4){bflo(w.x), bfhi(w.x), bflo(w.y), bfhi(w.y)}; b = (f32x4){bflo(w.z), bfhi(w.z), bflo(w.w), bfhi(w.w)}; }

struct EpiProj {
    unsigned char* ws; const float* b_gate;
    __device__ __forceinline__ void operator()(AccRef acc, const pg8::Unit& u, int wr, int wc, int fr, int fq) const {
        const int pn = u.pn; const int row0 = u.pm * 256;
        if (pn < 2) {
            bf16_t* Uperm = (bf16_t*)(ws + WS_UP);
            EPI_LOOP_BEGIN
                const int row = row0 + rl, col = pn * 256 + cl;
                bf16_t* dst = Uperm + (size_t)(col >> 4) * ((size_t)SROWS * SKY) + (size_t)(row >> 5) * SKY + (row & 31) * 16 + (col & 15);
                *(u32x4*)dst = pack8(a0, a1);
            EPI_LOOP_END
        } else if (pn < 8) {
            const size_t boff = pn < 4 ? WS_Q : (pn < 6 ? WS_K : WS_V);
            bf16_t* base = (bf16_t*)(ws + boff); const float sc = pn < 4 ? QSCALE : 1.f; const int c0 = (pn & 1) * 256;
            EPI_LOOP_BEGIN
                const int row = row0 + rl, col = c0 + cl;
                *(u32x4*)(base + (size_t)row * 512 + col) = pack8(a0 * sc, a1 * sc);
            EPI_LOOP_END
        } else {
            const size_t boff = pn < 12 ? WS_SGS : WS_SGA;
            bf16_t* base = (bf16_t*)(ws + boff); const int c0 = ((pn - 8) & 3) * 256; const float* bg = b_gate + (pn - 8) * 256;
            EPI_LOOP_BEGIN
                const int row = row0 + rl, col = c0 + cl;
                const f32x4 b0 = *(const f32x4*)(bg + cl), b1 = *(const f32x4*)(bg + cl + 4);
                f32x4 s0, s1;
#pragma unroll
                for (int e = 0; e < 4; ++e) { s0[e] = fast_sigmoid(a0[e] + b0[e]); s1[e] = fast_sigmoid(a1[e] + b1[e]); }
                *(u32x4*)(base + (size_t)row * 1024 + col) = pack8(s0, s1);
            EPI_LOOP_END
        }
    }
};
struct EpiSsmE {
    float* E;
    __device__ __forceinline__ void operator()(AccRef acc, const pg8::Unit& u, int wr, int wc, int fr, int fq) const {
        EPI_LOOP_BEGIN
            if (bj == 0) { float* dst = E + (size_t)(u.pm * 256 + rl) * 128 + cl; *(f32x4*)dst = a0; *(f32x4*)(dst + 4) = a1; }
        EPI_LOOP_END
    }
};
__device__ __forceinline__ float gelu_tanh(float x) { const float z = 1.5957691216057308f * (x + 0.044715f * x * x * x); return x * fast_sigmoid(z); }
struct EpiSsmY {
    bf16_t* Gact;
    __device__ __forceinline__ void operator()(AccRef acc, const pg8::Unit& u, int wr, int wc, int fr, int fq) const {
        const int g = u.aux;
        EPI_LOOP_BEGIN
            const int rg = (u.pm & 7) * 256 + rl;
            const int colg = u.pn * 256 + cl;
            const int tok = (rg >> 8) * SEQ + (rg & 255) * SL + (colg >> 4);
            f32x4 y0, y1;
#pragma unroll
            for (int e = 0; e < 4; ++e) { y0[e] = gelu_tanh(a0[e]); y1[e] = gelu_tanh(a1[e]); }
            *(u32x4*)(Gact + (size_t)tok * DS + g * 16 + (colg & 15)) = pack8(y0, y1);
        EPI_LOOP_END
    }
};
struct EpiGlu {
    const bf16_t* Gact; bf16_t* Yssm; const float* b_glu;
    __device__ __forceinline__ void operator()(AccRef acc, const pg8::Unit& u, int wr, int wc, int fr, int fq) const {
        EPI_LOOP_BEGIN
            const int row = u.pm * 256 + rl, col = u.pn * 256 + cl;
            const f32x4 b0 = *(const f32x4*)(b_glu + col), b1 = *(const f32x4*)(b_glu + col + 4);
            f32x4 g0, g1; unpack8(*(const u32x4*)(Gact + (size_t)row * DS + col), g0, g1);
            f32x4 y0, y1;
#pragma unroll
            for (int e = 0; e < 4; ++e) { y0[e] = g0[e] * fast_sigmoid(a0[e] + b0[e]); y1[e] = g1[e] * fast_sigmoid(a1[e] + b1[e]); }
            *(u32x4*)(Yssm + (size_t)row * DS + col) = pack8(y0, y1);
        EPI_LOOP_END
    }
};
template <bool SECOND> struct EpiUp {
    const bf16_t* SG; bf16_t* Mrg;
    __device__ __forceinline__ void operator()(AccRef acc, const pg8::Unit& u, int wr, int wc, int fr, int fq) const {
        EPI_LOOP_BEGIN
            const size_t off = (size_t)(u.pm * 256 + rl) * D + u.pn * 256 + cl;
            f32x4 s0, s1; unpack8(*(const u32x4*)(SG + off), s0, s1);
            f32x4 y0 = s0 * a0, y1 = s1 * a1;
            if (SECOND) { f32x4 p0, p1; unpack8(*(const u32x4*)(Mrg + off), p0, p1); y0 += p0; y1 += p1; }
            *(u32x4*)(Mrg + off) = pack8(y0, y1);
        EPI_LOOP_END
    }
};
struct EpiOut {
    const float* x; float* X1; bf16_t* XG; const float* g2; float* SSQ;
    __device__ __forceinline__ void operator()(AccRef acc, const pg8::Unit& u, int wr, int wc, int fr, int fq) const {
#pragma unroll
        for (int ai = 0; ai < 2; ++ai)
#pragma unroll
            for (int m = 0; m < 4; ++m) { const int row = u.pm * 256 + ai * 128 + wr * 64 + m * 16 + fr; float ss = 0.f;
#pragma unroll
                for (int bj = 0; bj < 2; ++bj) { const int col = u.pn * 256 + bj * 128 + wc * 32 + 8 * fq; const size_t off = (size_t)row * D + col;
                    const f32x4 x0 = *(const f32x4*)(x + off) + acc[ai][bj][m][0], x1 = *(const f32x4*)(x + off + 4) + acc[ai][bj][m][1];
                    *(f32x4*)(X1 + off) = x0; *(f32x4*)(X1 + off + 4) = x1;
                    ss += (x0[0] * x0[0] + x0[1] * x0[1]) + (x0[2] * x0[2] + x0[3] * x0[3]) + (x1[0] * x1[0] + x1[1] * x1[1]) + (x1[2] * x1[2] + x1[3] * x1[3]);
                    const f32x4 w0 = *(const f32x4*)(g2 + col), w1 = *(const f32x4*)(g2 + col + 4);
                    *(u32x4*)(XG + off) = pack8(x0 * w0, x1 * w1); }
                ss += __shfl_xor(ss, 16); ss += __shfl_xor(ss, 32);
                if (fq == 0) SSQ[(size_t)row * 16 + u.pn * 4 + wc] = ss; }
    }
};
struct EpiRouter {
    float* Rlog;
    __device__ __forceinline__ void operator()(AccRef acc, const pg8::Unit& u, int wr, int wc, int fr, int fq) const {
        EPI_LOOP_BEGIN
            if (bj == 0 && cl < 72) { float* dst = Rlog + (size_t)(u.pm * 256 + rl) * 72 + cl; *(f32x4*)dst = a0; *(f32x4*)(dst + 4) = a1; }
        EPI_LOOP_END
    }
};
struct EpiMoe1 {
    bf16_t* Hid; const float* rowrstd; const unsigned* ecnt;
    __device__ __forceinline__ void operator()(AccRef acc, const pg8::Unit& u, int wr, int wc, int fr, int fq) const {
        const int e = u.aux, cnt = (int)ecnt[e];
#pragma unroll
        for (int ai = 0; ai < 2; ++ai)
#pragma unroll
            for (int m = 0; m < 4; ++m) { const int rl = ai * 128 + wr * 64 + m * 16 + fr; const int pos = u.aux2 + rl;
                if (pos < cnt) { const float rs = rowrstd[(size_t)e * ROWCAP + pos];
                    f32x4 h0, h1;
#pragma unroll
                    for (int k = 0; k < 4; ++k) { const float p = acc[ai][0][m][0][k] * rs, q = acc[ai][1][m][0][k] * rs; h0[k] = p * fast_sigmoid(p) * q;
                        const float p2 = acc[ai][0][m][1][k] * rs, q2 = acc[ai][1][m][1][k] * rs; h1[k] = p2 * fast_sigmoid(p2) * q2; }
                    *(u32x4*)(Hid + (size_t)(u.pm * 256 + rl) * DE + u.pn * 128 + wc * 32 + 8 * fq) = pack8(h0, h1); } }
    }
};
struct EpiMoe2 {
    bf16_t* Y0; size_t ydelta; const unsigned* rowtok; const float* rowcoef; const unsigned* ecnt;
    __device__ __forceinline__ void operator()(AccRef acc, const pg8::Unit& u, int wr, int wc, int fr, int fq) const {
        const int e = u.aux, cnt = (int)ecnt[e];
#pragma unroll
        for (int ai = 0; ai < 2; ++ai)
#pragma unroll
            for (int m = 0; m < 4; ++m) { const int rl = ai * 128 + wr * 64 + m * 16 + fr; const int pos = u.aux2 + rl;
                if (pos < cnt) { const unsigned tk = rowtok[(size_t)e * ROWCAP + pos]; const float cf = rowcoef[(size_t)e * ROWCAP + pos];
                    bf16_t* dst = (bf16_t*)((unsigned char*)Y0 + (size_t)(tk & 1u) * ydelta) + (size_t)(tk >> 1) * D + u.pn * 256 + wc * 32 + 8 * fq;
#pragma unroll
                    for (int bj = 0; bj < 2; ++bj) *(u32x4*)(dst + bj * 128) = pack8(acc[ai][bj][m][0] * cf, acc[ai][bj][m][1] * cf); } }
    }
};
__device__ __forceinline__ void transpose_item(const float* W, int N, int k0, int n0, bf16_t* WT, size_t drow0, int ldo, LAS float* scr, int lane) {
    float tv[32];
#pragma unroll
    for (int i = 0; i < 32; ++i) tv[i] = W[(size_t)(k0 + 2 * i + (lane >> 5)) * N + n0 + (lane & 31)];
#pragma unroll
    for (int i = 0; i < 32; ++i) scr[(2 * i + (lane >> 5)) * 33 + (lane & 31)] = tv[i];
    LDS_WAIT(); asm volatile("" ::: "memory");
    const int c = lane & 7;
#pragma unroll
    for (int j = 0; j < 4; ++j) { const int n = (lane >> 3) + 8 * j; const LAS float* s = scr + (8 * c) * 33 + n;
        u32x4 o; o.x = pk2(s[0 * 33], s[1 * 33]); o.y = pk2(s[2 * 33], s[3 * 33]); o.z = pk2(s[4 * 33], s[5 * 33]); o.w = pk2(s[6 * 33], s[7 * 33]);
        *(u32x4*)(WT + (drow0 + n) * (size_t)ldo + k0 + 8 * c) = o; }
    LDS_WAIT(); asm volatile("" ::: "memory");
}
template <int NR> __device__ __forceinline__ void rms_rows_to_bf16(int lane, const float* xrow, const float* g, bf16_t* orow) {
    f32x4 v[NR][4]; float s[NR];
#pragma unroll
    for (int r = 0; r < NR; ++r) { const f32x4* xr = (const f32x4*)(xrow + (size_t)r * D) + lane;
#pragma unroll
        for (int j = 0; j < 4; ++j) v[r][j] = xr[64 * j]; }
    const f32x4* gr = (const f32x4*)g + lane; f32x4 wv[4];
#pragma unroll
    for (int j = 0; j < 4; ++j) wv[j] = gr[64 * j];
#pragma unroll
    for (int r = 0; r < NR; ++r) { float a = 0.f;
#pragma unroll
        for (int j = 0; j < 4; ++j) a += (v[r][j].x * v[r][j].x + v[r][j].y * v[r][j].y) + (v[r][j].z * v[r][j].z + v[r][j].w * v[r][j].w);
        s[r] = a; }
#pragma unroll
    for (int o = 1; o < 64; o <<= 1) {
#pragma unroll
        for (int r = 0; r < NR; ++r) s[r] += __shfl_xor(s[r], o); }
#pragma unroll
    for (int r = 0; r < NR; ++r) { const float rstd = 1.f / sqrtf(s[r] * (1.f / D) + RMS_EPS); unsigned long long* o8 = (unsigned long long*)(orow + (size_t)r * D) + lane;
#pragma unroll
        for (int j = 0; j < 4; ++j) o8[64 * j] = (unsigned long long)pk2(v[r][j].x * rstd * wv[j].x, v[r][j].y * rstd * wv[j].y) | ((unsigned long long)pk2(v[r][j].z * rstd * wv[j].z, v[r][j].w * rstd * wv[j].w) << 32); }
}
__device__ __forceinline__ void cpow(float lr, float li, float step, float dl, float& ar, float& ai) {
    const float mag = __expf(dl * lr * step); const float rev = dl * (li * step * 0.15915494309189535f); const float fr = rev - floorf(rev);
    ar = mag * __builtin_amdgcn_cosf(fr); ai = mag * __builtin_amdgcn_sinf(fr);
}
__device__ __forceinline__ void ssm_gen(Frame& F, int g, int sl) {
    LAS float* AP = (LAS float*)(F.lds); LAS float* BB = AP + 33 * 64 * 2; LAS float* CC = BB + 2048; LAS float* KT = CC + 2048;
    const float* lam_re = F.in[4] + g * SP; const float* lam_im = F.in[5] + g * SP; const float step = __expf(F.in[6][g]);
    const float* b_re = F.in[7] + g * SP * SHC; const float* b_im = F.in[8] + g * SP * SHC; const float* c_re = F.in[9] + g * SHC * SP; const float* c_im = F.in[10] + g * SHC * SP; const float* dd = F.in[11] + g * SHC;
    bf16_t* BT = (bf16_t*)(F.ws + WS_SSMT) + (size_t)g * 512 * SKY; bf16_t* BW = (bf16_t*)(F.ws + WS_SSMW) + (size_t)g * 256 * SKU;
    const int tid = F.tid;
    for (int idx = tid; idx < 33 * 64; idx += NTHR) { const int dl = idx >> 6, p = idx & 63; float ar, ai; cpow(lam_re[p], lam_im[p], step, (float)dl, ar, ai); AP[idx * 2] = ar; AP[idx * 2 + 1] = ai; }
    for (int idx = tid; idx < 1024; idx += NTHR) { const int ho = idx >> 6, p = idx & 63; CC[idx * 2] = c_re[ho * 64 + p]; CC[idx * 2 + 1] = c_im[ho * 64 + p]; }
    __syncthreads();
    for (int idx = tid; idx < 1024; idx += NTHR) { const int p = idx >> 4, h = idx & 15; const float ar = AP[(64 + p) * 2], ai = AP[(64 + p) * 2 + 1];
        const float lr = lam_re[p], li = lam_im[p], nr = ar - 1.f, ni = ai, den = lr * lr + li * li, cr = (nr * lr + ni * li) / den, ci = (ni * lr - nr * li) / den;
        const float br = b_re[p * 16 + h], bi = b_im[p * 16 + h]; BB[idx * 2] = cr * br - ci * bi; BB[idx * 2 + 1] = cr * bi + ci * br; }
    __syncthreads();
    for (int idx = tid; idx < 1024; idx += NTHR) { const int dl = idx >> 5, hl = (idx >> 4) & 1, hi = idx & 15, ho = 2 * sl + hl; float s = 0.f;
        for (int p = 0; p < 64; ++p) { const float ar = AP[(dl * 64 + p) * 2], ai = AP[(dl * 64 + p) * 2 + 1], br = BB[(p * 16 + hi) * 2], bi = BB[(p * 16 + hi) * 2 + 1];
            const float zr = ar * br - ai * bi, zi = ar * bi + ai * br; s += CC[(ho * 64 + p) * 2] * zr - CC[(ho * 64 + p) * 2 + 1] * zi; }
        if (dl == 0 && ho == hi) s += dd[ho];
        KT[idx] = s; }
    __syncthreads();
    for (int v = tid; v < 64 * 80; v += NTHR) { const int nl = v / 80, kv = (v % 80) * 8, tau = nl >> 1, hl = nl & 1, ho = 2 * sl + hl, n = tau * 16 + ho; float val[8];
        if (kv < 512) { const int sg = kv >> 4, hi0 = kv & 15;
#pragma unroll
            for (int e = 0; e < 8; ++e) val[e] = (tau >= sg) ? KT[((tau - sg) * 2 + hl) * 16 + hi0 + e] : 0.f; }
        else { const int kk = kv - 512;
#pragma unroll
            for (int e = 0; e < 8; ++e) { const int p = (kk + e) >> 1, ri = (kk + e) & 1; const float ar = AP[((tau + 1) * 64 + p) * 2], ai = AP[((tau + 1) * 64 + p) * 2 + 1], cre = CC[(ho * 64 + p) * 2], cim = CC[(ho * 64 + p) * 2 + 1];
                val[e] = ri == 0 ? (cre * ar - cim * ai) : -(cre * ai + cim * ar); } }
        u32x4 o; o.x = pk2(val[0], val[1]); o.y = pk2(val[2], val[3]); o.z = pk2(val[4], val[5]); o.w = pk2(val[6], val[7]);
        *(u32x4*)(BT + (size_t)n * SKY + kv) = o; }
    for (int v = tid; v < 32 * 64; v += NTHR) { const int nl = v >> 6, kv = (v & 63) * 8; float val[8];
        const bool real = nl < 16; const int n = real ? 16 * sl + nl : 128 + 16 * sl + (nl - 16);
        if (real) { const int p = n >> 1, ri = n & 1, sg = kv >> 4, hi0 = kv & 15; const float ar = AP[((31 - sg) * 64 + p) * 2], ai = AP[((31 - sg) * 64 + p) * 2 + 1];
#pragma unroll
            for (int e = 0; e < 8; ++e) { const float br = BB[(p * 16 + hi0 + e) * 2], bi = BB[(p * 16 + hi0 + e) * 2 + 1]; val[e] = ri == 0 ? (ar * br - ai * bi) : (ar * bi + ai * br); } }
        else {
#pragma unroll
            for (int e = 0; e < 8; ++e) val[e] = 0.f; }
        u32x4 o; o.x = pk2(val[0], val[1]); o.y = pk2(val[2], val[3]); o.z = pk2(val[4], val[5]); o.w = pk2(val[6], val[7]);
        *(u32x4*)(BW + (size_t)n * SKU + kv) = o; }
    __syncthreads();
}
__device__ __forceinline__ void p0_prologue(Frame& F) {
    for (int it = F.vcu; it < SG * 8; it += F.G) ssm_gen(F, it >> 3, it & 7);
    LAS float* scr = (LAS float*)(F.lds + F.wave * 16384);
    const int gw = F.vcu * NWAVES + F.wave, NGW = F.G * NWAVES, lane = F.lane;
    constexpr int I_IN = 16 * 128, I_GLU = 8 * 16, I_US = 8 * 32, I_UA = 8 * 32, I_OUT = 16 * 32, I_W1 = 32 * 256, I_W3 = 32 * 256, I_W2 = 32 * 256;
    constexpr int NITEMS = I_IN + I_GLU + I_US + I_UA + I_OUT + I_W1 + I_W3 + I_W2;
    unsigned char* ws = F.ws;
    for (int it = gw; it < NITEMS; it += NGW) {
        int r = it;
        if (r < I_IN) { transpose_item(F.in[2], DIN, 64 * (r / 128), 32 * (r % 128), (bf16_t*)(ws + WS_WIN), 32 * (r % 128), D, scr, lane); continue; } r -= I_IN;
        if (r < I_GLU) { transpose_item(F.in[12], DS, 64 * (r / 16), 32 * (r % 16), (bf16_t*)(ws + WS_WGLU), 32 * (r % 16), DS, scr, lane); continue; } r -= I_GLU;
        if (r < I_US) { transpose_item(F.in[14], D, 64 * (r / 32), 32 * (r % 32), (bf16_t*)(ws + WS_WUS), 32 * (r % 32), DS, scr, lane); continue; } r -= I_US;
        if (r < I_UA) { transpose_item(F.in[15], D, 64 * (r / 32), 32 * (r % 32), (bf16_t*)(ws + WS_WUA), 32 * (r % 32), DA, scr, lane); continue; } r -= I_UA;
        if (r < I_OUT) { transpose_item(F.in[17], D, 64 * (r / 32), 32 * (r % 32), (bf16_t*)(ws + WS_WOUT), 32 * (r % 32), D, scr, lane); continue; } r -= I_OUT;
        if (r < I_W1 + I_W3) { const int w3 = r >= I_W1; if (w3) r -= I_W1; const int e = r >> 8, q = r & 255, k0 = 64 * (q / 16), n0 = 32 * (q % 16);
            transpose_item((w3 ? F.in[24] : F.in[23]) + (size_t)e * D * DE, DE, k0, n0, (bf16_t*)(ws + WS_W13), (size_t)e * 1024 + 256 * (n0 >> 7) + (n0 & 127) + (w3 ? 128 : 0), D, scr, lane); continue; }
        r -= I_W1 + I_W3;
        { const int e = r >> 8, q = r & 255, k0 = 64 * (q / 32), n0 = 32 * (q % 32);
            transpose_item(F.in[25] + (size_t)e * DE * D, D, k0, n0, (bf16_t*)(ws + WS_W2), (size_t)e * 1024 + n0, DE, scr, lane); }
    }
    for (int m = 4 * gw; m < T; m += 4 * NGW) rms_rows_to_bf16<4>(lane, F.in[0] + (size_t)m * D, F.in[1], (bf16_t*)(ws + WS_H1) + (size_t)m * D);
    { bf16_t* WR = (bf16_t*)(ws + WS_WR); const float* wrg = F.in[19]; const float* wre = F.in[21];
      for (int idx = F.vcu * NTHR + F.tid; idx < 256 * D; idx += F.G * NTHR) { const int r = idx >> 10, k = idx & 1023; unsigned o = 0u;
          if (r < 72) { const int c = r < 36 ? r : r - 36; const float w = c < 4 ? wrg[k * 4 + c] : wre[k * 32 + (c - 4)]; const unsigned hb = f2bf(w);
              o = r < 36 ? hb : f2bf(w - __builtin_bit_cast(float, hb << 16)); }
          WR[idx] = (bf16_t)o; } }
}

__device__ __forceinline__ int crow(int r, int hi) { return (r & 3) + 8 * (r >> 2) + 4 * hi; }
constexpr int KVP = 72;
__device__ __forceinline__ void kv_prep_phase(Frame& F) {
    LAS bf16_t* KS = (LAS bf16_t*)(F.lds); LAS bf16_t* VS = KS + 256 * KVP; LAS float* PS = (LAS float*)(F.lds + 2 * 256 * KVP * 2); LAS float* WM = PS + 512;
    const bf16_t* Kb = (const bf16_t*)(F.ws + WS_K); const bf16_t* Vb = (const bf16_t*)(F.ws + WS_V);
    bf16_t* Kf = (bf16_t*)(F.ws + WS_KFRAG); bf16_t* Vf = (bf16_t*)(F.ws + WS_VFRAG); bf16_t* KM = (bf16_t*)(F.ws + WS_KMEAN); float* KN = (float*)(F.ws + WS_KMEAN + 512 * 1024);
    const int tid = F.tid;
    for (int item = F.vcu; item < BATCH * NH * NBLK; item += F.G) {
        const int n = item & 31, h = (item >> 5) & 7, b = item >> 8; const size_t tok0 = (size_t)b * SEQ + 256 * n;
#pragma unroll
        for (int j = 0; j < 4; ++j) { const int q = tid + NTHR * j, row = q >> 3, pc = q & 7; const size_t src = (tok0 + row) * DA + h * HD + pc * 8;
            *(LAS u32x4*)(KS + row * KVP + pc * 8) = *(const u32x4*)(Kb + src); *(LAS u32x4*)(VS + row * KVP + pc * 8) = *(const u32x4*)(Vb + src); }
        __syncthreads();
#pragma unroll
        for (int j = 0; j < 4; ++j) { const int P = tid + NTHR * j, st = P >> 8, ds = (P >> 6) & 3, l2 = P & 63, row = 32 * st + (l2 & 31), col = 16 * ds + 8 * (l2 >> 5);
            *(u32x4*)(Kf + ((size_t)item * 2048 + P) * 8) = *(const LAS u32x4*)(KS + row * KVP + col); }
#pragma unroll
        for (int j = 0; j < 4; ++j) { const int P = tid + NTHR * j, st = P >> 8, ks = (P >> 7) & 1, d0 = (P >> 6) & 1, l2 = P & 63, hi = l2 >> 5, jj = l2 & 31; unsigned w[4];
#pragma unroll
            for (int e = 0; e < 8; e += 2) { const unsigned lo = VS[(32 * st + 16 * ks + crow(e, hi)) * KVP + 32 * d0 + jj], hi16 = VS[(32 * st + 16 * ks + crow(e + 1, hi)) * KVP + 32 * d0 + jj]; w[e >> 1] = lo | (hi16 << 16); }
            *(u32x4*)(Vf + ((size_t)item * 2048 + P) * 8) = (u32x4){w[0], w[1], w[2], w[3]}; }
        { const int d = tid & 63, part = tid >> 6; float s = 0.f;
#pragma unroll 8
          for (int r = 0; r < 32; ++r) s += bf2f(KS[(part * 32 + r) * KVP + d]);
          PS[part * 64 + d] = s; }
        if (tid < 256) { float ss = 0.f;
#pragma unroll
            for (int c = 0; c < 8; ++c) { const u32x4 w = *(const LAS u32x4*)(KS + tid * KVP + c * 8);
                ss += bflo(w.x) * bflo(w.x) + bfhi(w.x) * bfhi(w.x) + bflo(w.y) * bflo(w.y) + bfhi(w.y) * bfhi(w.y) + bflo(w.z) * bflo(w.z) + bfhi(w.z) * bfhi(w.z) + bflo(w.w) * bflo(w.w) + bfhi(w.w) * bfhi(w.w); }
            ss = wave_max(ss); if (F.lane == 0) WM[F.wave] = ss; }
        __syncthreads();
        if (tid < 64) { float s = 0.f;
#pragma unroll
            for (int p = 0; p < 8; ++p) s += PS[p * 64 + tid];
            KM[(size_t)item * 64 + tid] = (bf16_t)f2bf(s * (1.f / 256.f)); }
        if (tid == 0) KN[item] = fmaxf(fmaxf(WM[0], WM[1]), fmaxf(WM[2], WM[3]));
        __syncthreads();
    }
}

__device__ __forceinline__ void ssm_scan_phase(Frame& F) {
    LAS float* FW = (LAS float*)(F.lds);
    const float* E = (const float*)(F.ws + WS_E); bf16_t* UP = (bf16_t*)(F.ws + WS_UP);
    const int w = F.wave, p = F.lane;
    for (int gb = F.vcu; gb < SG * BATCH; gb += F.G) {
        const int g = gb >> 3, b = gb & 7;
        const float lr = F.in[4][g * SP + p], li = F.in[5][g * SP + p], step = __expf(F.in[6][g]);
        float ar, ai; cpow(lr, li, step, 32.f, ar, ai);
        const size_t row0 = (size_t)g * SROWS + b * 256 + 32 * w;
        f32x2 e[32];
#pragma unroll
        for (int j = 0; j < 32; ++j) e[j] = *(const f32x2*)(E + (row0 + j) * 128 + 2 * p);
        float sr = 0.f, si = 0.f;
#pragma unroll
        for (int j = 0; j < 32; ++j) { const float nr = ar * sr - ai * si + e[j].x, ni = ar * si + ai * sr + e[j].y; sr = nr; si = ni; }
        FW[(w * 64 + p) * 2] = sr; FW[(w * 64 + p) * 2 + 1] = si;
        __syncthreads();
        float Ar = ar, Ai = ai;
#pragma unroll
        for (int q = 0; q < 5; ++q) { const float nr = Ar * Ar - Ai * Ai, ni = 2.f * Ar * Ai; Ar = nr; Ai = ni; }
        sr = 0.f; si = 0.f;
        for (int w2 = 0; w2 < w; ++w2) { const float fr = FW[(w2 * 64 + p) * 2], fi = FW[(w2 * 64 + p) * 2 + 1]; const float nr = Ar * sr - Ai * si + fr, ni = Ar * si + Ai * sr + fi; sr = nr; si = ni; }
#pragma unroll
        for (int j = 0; j < 32; ++j) { *(unsigned*)(UP + (row0 + j) * SKY + SKU + 2 * p) = pk2(sr, si);
            const float nr = ar * sr - ai * si + e[j].x, ni = ar * si + ai * sr + e[j].y; sr = nr; si = ni; }
        __syncthreads();
    }
}

__device__ __forceinline__ int t5_bucket(int d) {
    if (d < 16) return d;
    return 16 + (d >= 19) + (d >= 21) + (d >= 24) + (d >= 27) + (d >= 31) + (d >= 35) + (d >= 40) + (d >= 46) + (d >= 52) + (d >= 59) + (d >= 67) + (d >= 77) + (d >= 87) + (d >= 99) + (d >= 113);
}
struct Top3 { float v0, v1, v2; int i0, i1, i2; };
__device__ __forceinline__ Top3 top3_insert(Top3 t, float x, int n) {
    const bool b0 = (x > t.v0) || (x == t.v0 && n < t.i0), b1 = (x > t.v1) || (x == t.v1 && n < t.i1), b2 = (x > t.v2) || (x == t.v2 && n < t.i2);
    Top3 r;
    r.v2 = b1 ? t.v1 : (b2 ? x : t.v2); r.i2 = b1 ? t.i1 : (b2 ? n : t.i2);
    r.v1 = b0 ? t.v0 : (b1 ? x : t.v1); r.i1 = b0 ? t.i0 : (b1 ? n : t.i1);
    r.v0 = b0 ? x : t.v0; r.i0 = b0 ? n : t.i0;
    return r;
}
constexpr int GQS = 0, GKME = 36864, GCNTL = 41472, GMISC = 41600;
template <bool COUNT> __device__ __forceinline__ void attn_gate_unit(Frame& F, int bh, int qb) {
    LAS unsigned char* L = F.lds;
    LAS bf16_t* QS = (LAS bf16_t*)(L + GQS); LAS bf16_t* KME = (LAS bf16_t*)(L + GKME); LAS int* CNT = (LAS int*)(L + GCNTL); LAS float* KNM = (LAS float*)(L + GMISC);
    int tid = F.tid; asm volatile("" : "+v"(tid));
    const int lane = tid & 63, w = F.wave, j = lane & 31, hi = lane >> 5;
    const int b = bh >> 3, h = bh & 7; const size_t tok0 = (size_t)b * SEQ + 256 * qb;
    const bf16_t* Qb = (const bf16_t*)(F.ws + WS_Q); const bf16_t* KM = (const bf16_t*)(F.ws + WS_KMEAN); const float* KN = (const float*)(F.ws + WS_KMEAN + 512 * 1024);
    float* MQg = (float*)(F.ws + WS_MQ); unsigned short* QL = (unsigned short*)(F.ws + WS_QLIST); unsigned* GC = (unsigned*)(F.ctl + CW_GCNT); unsigned* SEGC = (unsigned*)(F.ws + WS_SEGC);
#pragma unroll
    for (int jj = 0; jj < 4; ++jj) { const int q = tid + NTHR * jj, row = q >> 3, pc = q & 7; *(LAS u32x4*)(QS + row * KVP + pc * 8) = *(const u32x4*)(Qb + (tok0 + row) * DA + h * HD + pc * 8); }
    if (tid < 256) { const int n = tid >> 3, pc = tid & 7; *(LAS u32x4*)(KME + n * KVP + pc * 8) = *(const u32x4*)(KM + ((size_t)bh * 32 + n) * 64 + pc * 8); }
    if (tid < 32) CNT[tid] = 0;
    if (w == 1) { float v = (lane <= qb && lane < 32) ? KN[bh * 32 + lane] : 0.f; v = wave_max(v); if (lane == 0) KNM[0] = v; }
    if (w == 2) { float v = F.in[16][h * 32 + (lane & 31)]; v = wave_max(v); if (lane == 0) KNM[1] = v * LOG2E; }
    __syncthreads();
    {
        bf16x8 qf[4], kmf[4];
#pragma unroll
        for (int ds = 0; ds < 4; ++ds) { qf[ds] = *(const LAS bf16x8*)(QS + (32 * w + j) * KVP + 16 * ds + 8 * hi); kmf[ds] = *(const LAS bf16x8*)(KME + j * KVP + 16 * ds + 8 * hi); }
        f32x16 gt = {};
#pragma unroll
        for (int ds = 0; ds < 4; ++ds) gt = __builtin_amdgcn_mfma_f32_32x32x16_bf16(kmf[ds], qf[ds], gt, 0, 0, 0);
        float qn = 0.f;
#pragma unroll
        for (int ds = 0; ds < 4; ++ds)
#pragma unroll
            for (int e = 0; e < 8; ++e) { const float x = bf2f((unsigned short)qf[ds][e]); qn += x * x; }
        qn += __shfl_xor(qn, 32);
        const float m2 = sqrtf(qn * KNM[0]) + KNM[1];
        const int ql = 256 * qb + 32 * w + j;
        if (hi == 0) MQg[(size_t)bh * SEQ + ql] = m2;
        Top3 t3; t3.v0 = t3.v1 = t3.v2 = -INFINITY; t3.i0 = t3.i1 = t3.i2 = -1;
#pragma unroll
        for (int r = 0; r < 16; ++r) { const int n = crow(r, hi); const float x = (n < qb) ? gt[r] : -INFINITY; t3 = top3_insert(t3, x, x > -INFINITY ? n : 0x7fffffff); }
        { const float p0 = __shfl_xor(t3.v0, 32), p1 = __shfl_xor(t3.v1, 32), p2 = __shfl_xor(t3.v2, 32); const int q0 = __shfl_xor(t3.i0, 32), q1 = __shfl_xor(t3.i1, 32), q2 = __shfl_xor(t3.i2, 32);
          t3 = top3_insert(t3, p0, q0 >= 0 ? q0 : 0x7fffffff); t3 = top3_insert(t3, p1, q1 >= 0 ? q1 : 0x7fffffff); t3 = top3_insert(t3, p2, q2 >= 0 ? q2 : 0x7fffffff); }
        const int i0 = t3.v0 > -INFINITY ? t3.i0 : -1, i1 = t3.v1 > -INFINITY ? t3.i1 : -1, i2 = t3.v2 > -INFINITY ? t3.i2 : -1;
        if (hi == 0) { const unsigned e = (unsigned)ql << 2;
            if (i0 >= 0) { const int pos = __hip_atomic_fetch_add(CNT + i0, 1, __ATOMIC_RELAXED, __HIP_MEMORY_SCOPE_WORKGROUP); QL[((size_t)bh * 32 + i0) * SEQ + (qb - i0 - 1) * 256 + pos] = (unsigned short)(e | 0u); }
            if (i1 >= 0) { const int pos = __hip_atomic_fetch_add(CNT + i1, 1, __ATOMIC_RELAXED, __HIP_MEMORY_SCOPE_WORKGROUP); QL[((size_t)bh * 32 + i1) * SEQ + (qb - i1 - 1) * 256 + pos] = (unsigned short)(e | 1u); }
            if (i2 >= 0) { const int pos = __hip_atomic_fetch_add(CNT + i2, 1, __ATOMIC_RELAXED, __HIP_MEMORY_SCOPE_WORKGROUP); QL[((size_t)bh * 32 + i2) * SEQ + (qb - i2 - 1) * 256 + pos] = (unsigned short)(e | 2u); } }
    }
    __syncthreads();
    if (tid < qb) { const unsigned c = (unsigned)CNT[tid]; SEGC[((size_t)bh * 32 + tid) * 32 + (qb - tid - 1)] = c; if (COUNT && c) (void)__hip_atomic_fetch_add(GC + bh * 32 + tid, c, __ATOMIC_RELAXED, __HIP_MEMORY_SCOPE_AGENT); }
    __syncthreads();
}
template <bool COUNT> __device__ __forceinline__ void attn_gate_phase(Frame& F) {
    for (int u = F.vcu; u < BATCH * NH * NBLK; u += F.G) attn_gate_unit<COUNT>(F, u >> 5, u & 31);
}

#define ATTN_SUBTILE(KP, VP, st_, NEARM) do { \
        bf16x8 kf_[4], vf_[4]; \
        _Pragma("unroll") for (int ds_ = 0; ds_ < 4; ++ds_) kf_[ds_] = *(const LAS bf16x8*)((KP) + ((st_) * 4 + ds_) * 512 + lane8); \
        _Pragma("unroll") for (int q_ = 0; q_ < 4; ++q_) vf_[q_] = *(const LAS bf16x8*)((VP) + ((st_) * 4 + q_) * 512 + lane8); \
        f32x16 s_ = {}; \
        _Pragma("unroll") for (int ds_ = 0; ds_ < 4; ++ds_) s_ = __builtin_amdgcn_mfma_f32_32x32x16_bf16(kf_[ds_], qf[ds_], s_, 0, 0, 0); \
        float p_[16]; \
        if (!(NEARM)) { _Pragma("unroll") for (int r_ = 0; r_ < 16; ++r_) p_[r_] = __builtin_amdgcn_exp2f(s_[r_] - mfar); } \
        else { _Pragma("unroll") for (int r_ = 0; r_ < 16; ++r_) { const int dist_ = dq - (32 * (st_) + crow(r_, hi)); const int di_ = dist_ < 0 ? 0 : (dist_ > 127 ? 127 : dist_); \
                const float e_ = __builtin_amdgcn_exp2f(s_[r_] + TABh[di_] - m2); p_[r_] = dist_ >= 0 ? e_ : 0.f; } } \
        _Pragma("unroll") for (int r_ = 0; r_ < 16; ++r_) lsum += p_[r_]; \
        u32x4 pa_, pb_; pa_.x = cvt_pk_bf16(p_[0], p_[1]); pa_.y = cvt_pk_bf16(p_[2], p_[3]); pa_.z = cvt_pk_bf16(p_[4], p_[5]); pa_.w = cvt_pk_bf16(p_[6], p_[7]); \
        pb_.x = cvt_pk_bf16(p_[8], p_[9]); pb_.y = cvt_pk_bf16(p_[10], p_[11]); pb_.z = cvt_pk_bf16(p_[12], p_[13]); pb_.w = cvt_pk_bf16(p_[14], p_[15]); \
        const bf16x8 A0_ = __builtin_bit_cast(bf16x8, pa_), A1_ = __builtin_bit_cast(bf16x8, pb_); \
        o0 = __builtin_amdgcn_mfma_f32_32x32x16_bf16(vf_[0], A0_, o0, 0, 0, 0); o1 = __builtin_amdgcn_mfma_f32_32x32x16_bf16(vf_[1], A0_, o1, 0, 0, 0); \
        o0 = __builtin_amdgcn_mfma_f32_32x32x16_bf16(vf_[2], A1_, o0, 0, 0, 0); o1 = __builtin_amdgcn_mfma_f32_32x32x16_bf16(vf_[3], A1_, o1, 0, 0, 0); } while (0)

__device__ __forceinline__ void attn_fill_tab(Frame& F, LAS float* TAB) {
    const float* rb = F.in[16];
    for (int idx = F.tid; idx < 8 * 132; idx += NTHR) { const int h = idx / 132, d = idx % 132; float v = 0.f;
        if (d < 128) v = rb[h * 32 + t5_bucket(d)] * LOG2E; else if (d == 129) v = rb[h * 32 + 31] * LOG2E;
        TAB[idx] = v; }
}
constexpr int BGPRE_OFF = ROWTAB_OFF, BGCL_OFF = ROWTAB_OFF + 8448, BTAB_OFF = ROWTAB_OFF + 16640, BIT_OFF = ROWTAB_OFF + 20992, BIT_MAX = 512;
static_assert(BTAB_OFF + 8 * 132 * 4 <= MOE_TST_OFF, "attention LDS tables");
__device__ __forceinline__ size_t part_off(int slot) { return slot == 0 ? WS_PART0 : (slot == 1 ? WS_PART1 : WS_PART2); }

__device__ __forceinline__ void attn_block_phase(Frame& F) {
    LAS unsigned char* L = F.lds; LAS int* GPRE = (LAS int*)(L + BGPRE_OFF); LAS int* GCL = (LAS int*)(L + BGCL_OFF); LAS float* TAB = (LAS float*)(L + BTAB_OFF); LAS int* ITT = (LAS int*)(L + BIT_OFF); LAS int* WSUM = (LAS int*)(L + MOE_TST_OFF);
    const unsigned* GC = (const unsigned*)(F.ctl + CW_GCNT); const unsigned* SEGC = (const unsigned*)(F.ws + WS_SEGC);
    const int tid = F.tid, lane = F.lane, w = F.wave, j = lane & 31, hi = lane >> 5, lane8 = lane * 8;
    { int ng[4], tot = 0;
#pragma unroll
      for (int e = 0; e < 4; ++e) { const int c = (int)GC[4 * tid + e]; GCL[4 * tid + e] = c; ng[e] = (((c + 31) >> 5) + 7) >> 3; tot += ng[e]; }
      int inc = tot;
#pragma unroll
      for (int o = 1; o < 64; o <<= 1) { const int t = __shfl_up(inc, o); if (lane >= o) inc += t; }
      if (lane == 63) WSUM[w] = inc;
      __syncthreads();
      int woff = 0;
      for (int q = 0; q < w; ++q) woff += WSUM[q];
      int ex = woff + inc - tot;
#pragma unroll
      for (int e = 0; e < 4; ++e) { GPRE[4 * tid + e] = ex; ex += ng[e]; }
      if (tid == NTHR - 1) GPRE[2048] = ex; }
    attn_fill_tab(F, TAB);
    __syncthreads();
    const int NIT = GPRE[2048];
    const int nk = (NIT > F.vcu) ? (NIT - F.vcu + F.G - 1) / F.G : 0;
    if (tid < nk && tid < BIT_MAX) { const int it_ = F.vcu + tid * F.G; int lo_ = 0, hi_ = 2048; while (hi_ - lo_ > 1) { const int mid_ = (lo_ + hi_) >> 1; if (GPRE[mid_] <= it_) lo_ = mid_; else hi_ = mid_; } ITT[tid] = lo_ * 64 + (it_ - GPRE[lo_]); }
    __syncthreads();
    if (nk == 0) return;
    const int nkc = nk < BIT_MAX ? nk : BIT_MAX;
    const bf16_t* Qb = (const bf16_t*)(F.ws + WS_Q); const float* MQg = (const float*)(F.ws + WS_MQ); const unsigned short* QL = (const unsigned short*)(F.ws + WS_QLIST);
    const bf16_t* KF = (const bf16_t*)(F.ws + WS_KFRAG); const bf16_t* VF = (const bf16_t*)(F.ws + WS_VFRAG);
    float* PL = (float*)(F.ws + WS_PL);
#define BLK_ITEM(k_, pi_, g_) do { const int kk_ = (k_) < nkc ? (k_) : nkc - 1; const int v_ = __builtin_amdgcn_readfirstlane(ITT[kk_]); pi_ = v_ >> 6; g_ = v_ & 63; } while (0)
#define BLK_DMA(buf_, pi_) do { const char* ks_ = (const char*)KF + ((size_t)(pi_) * 2048 + tid) * 16; const char* vs_ = (const char*)VF + ((size_t)(pi_) * 2048 + tid) * 16; \
        _Pragma("unroll") for (int i_ = 0; i_ < 4; ++i_) { \
            __builtin_amdgcn_global_load_lds((const unsigned*)(ks_ + i_ * 8192), (LAS unsigned*)(L + (buf_) + (i_ * 512 + w * 64) * 16), 16, 0, 0); \
            __builtin_amdgcn_global_load_lds((const unsigned*)(vs_ + i_ * 8192), (LAS unsigned*)(L + (buf_) + 32768 + (i_ * 512 + w * 64) * 16), 16, 0, 0); } } while (0)
#define BLK_SEGC(dst_, pi_) do { dst_ = SEGC[(size_t)(pi_) * 32 + j]; } while (0)
#define BLK_ENTRY(dst_, segc_, pi_, g_) do { const int n_ = (pi_) & 31; int inc_ = (j < 31 - n_) ? (int)(segc_) : 0; \
        _Pragma("unroll") for (int o_ = 1; o_ < 32; o_ <<= 1) { const int t_ = __shfl_up(inc_, o_); if (j >= o_) inc_ += t_; } \
        const int cnt_ = GCL[pi_]; const int idx_ = 32 * (8 * (g_) + w) + j; int seg_ = 0, prev_ = 0; \
        for (int s_ = 0; s_ < 31 - n_; ++s_) { const int p_ = __builtin_amdgcn_readlane(inc_, s_); const bool le_ = p_ <= idx_; seg_ += le_ ? 1 : 0; prev_ = le_ ? p_ : prev_; } \
        const bool ok_ = idx_ < cnt_; const unsigned v_ = QL[(size_t)(pi_) * SEQ + (ok_ ? seg_ * 256 + (idx_ - prev_) : 0)]; dst_ = ok_ ? v_ : 0xFFFFu; } while (0)
#define BLK_QLOAD(qf_, m2_, ent_, pi_) do { const unsigned qq_ = ((ent_) == 0xFFFFu) ? 0u : ((ent_) >> 2); const int bh_ = (pi_) >> 5; \
        const bf16_t* qrow_ = Qb + ((size_t)(bh_ >> 3) * SEQ + qq_) * DA + (bh_ & 7) * HD + 8 * hi; \
        _Pragma("unroll") for (int ds_ = 0; ds_ < 4; ++ds_) qf_[ds_] = *(const bf16x8*)(qrow_ + 16 * ds_); \
        m2_ = MQg[(size_t)bh_ * SEQ + qq_]; } while (0)
    int pi, g, pi1, g1, pi2, g2; unsigned ent, ent1, sc2; bf16x8 qf[4]; float m2r;
    BLK_ITEM(0, pi, g); BLK_ITEM(1, pi1, g1); BLK_ITEM(2, pi2, g2);
    BLK_DMA(0, pi);
    { unsigned sc0, sc1; BLK_SEGC(sc0, pi); BLK_SEGC(sc1, pi1); BLK_SEGC(sc2, pi2); BLK_ENTRY(ent, sc0, pi, g); BLK_ENTRY(ent1, sc1, pi1, g1); }
    BLK_QLOAD(qf, m2r, ent, pi);
    int cur = 0;
    for (int k = 0; k < nkc; ++k) {
        VM_WAIT(); __syncthreads();
        int pi3, g3; unsigned sc3, ent2; bf16x8 qfn[4]; float m2n;
        BLK_ITEM(k + 3, pi3, g3); BLK_SEGC(sc3, pi3);
        BLK_ENTRY(ent2, sc2, pi2, g2);
        BLK_QLOAD(qfn, m2n, ent1, pi1);
        BLK_DMA((cur ^ 1) * 65536, pi1);
        const int bh = pi >> 5, n = pi & 31, h = bh & 7;
        const bool valid = ent != 0xFFFFu; const int q = valid ? (int)(ent >> 2) : 0; const int slot = (int)(ent & 3u);
        const bool active = __builtin_amdgcn_readfirstlane((int)(__ballot(valid) != 0ull)) != 0;
        if (active) {
            const float m2 = valid ? m2r : INFINITY;
            const LAS bf16_t* KP = (const LAS bf16_t*)(L + cur * 65536); const LAS bf16_t* VP = (const LAS bf16_t*)(L + cur * 65536 + 32768);
            const LAS float* TABh = TAB + h * 132; const float mfar = m2 - TABh[129];
            const int dq = q - 256 * n;
            const bool nearw = __builtin_amdgcn_readfirstlane((int)(__ballot(valid && dq < 383) != 0ull)) != 0;
            f32x16 o0 = {}, o1 = {}; float lsum = 0.f;
            if (nearw) { for (int st = 0; st < 8; ++st) ATTN_SUBTILE(KP, VP, st, true); }
            else { for (int st = 0; st < 8; ++st) ATTN_SUBTILE(KP, VP, st, false); }
            const float lt = lsum + __shfl_xor(lsum, 32);
            if (valid) { const size_t qi = (size_t)bh * SEQ + q;
                if (hi == 0) PL[(size_t)slot * (NH * BATCH * SEQ) + qi] = lt;
                bf16_t* dst = (bf16_t*)(F.ws + part_off(slot)) + qi * HD + 4 * hi;
#pragma unroll
                for (int g4 = 0; g4 < 4; ++g4) { *(u32x2*)(dst + 8 * g4) = (u32x2){cvt_pk_bf16(o0[4 * g4], o0[4 * g4 + 1]), cvt_pk_bf16(o0[4 * g4 + 2], o0[4 * g4 + 3])};
                    *(u32x2*)(dst + 32 + 8 * g4) = (u32x2){cvt_pk_bf16(o1[4 * g4], o1[4 * g4 + 1]), cvt_pk_bf16(o1[4 * g4 + 2], o1[4 * g4 + 3])}; } }
        }
        pi = pi1; g = g1; ent = ent1; m2r = m2n; pi1 = pi2; g1 = g2; ent1 = ent2; pi2 = pi3; g2 = g3; sc2 = sc3; cur ^= 1;
#pragma unroll
        for (int ds = 0; ds < 4; ++ds) qf[ds] = qfn[ds];
    }
    VM_WAIT(); __syncthreads();
#undef BLK_ITEM
#undef BLK_DMA
#undef BLK_SEGC
#undef BLK_ENTRY
#undef BLK_QLOAD
}

__device__ __forceinline__ void attn_own_unit(Frame& F, int bh, int qb, LAS float* TAB) {
    LAS unsigned char* L = F.lds;
    int tid = F.tid; asm volatile("" : "+v"(tid));
    const int lane = tid & 63, w = F.wave, j = lane & 31, hi = lane >> 5, lane8 = lane * 8;
    const int b = bh >> 3, h = bh & 7;
    const bf16_t* Qb = (const bf16_t*)(F.ws + WS_Q); const float* MQg = (const float*)(F.ws + WS_MQ);
    const u32x4* KF = (const u32x4*)(F.ws + WS_KFRAG) + ((size_t)bh * 32 + qb) * 2048; const u32x4* VF = (const u32x4*)(F.ws + WS_VFRAG) + ((size_t)bh * 32 + qb) * 2048;
    const float* PL = (const float*)(F.ws + WS_PL); bf16_t* YA = (bf16_t*)(F.ws + WS_YATT);
#pragma unroll
    for (int i = 0; i < 4; ++i) { ((LAS u32x4*)L)[tid + NTHR * i] = KF[tid + NTHR * i]; ((LAS u32x4*)(L + 32768))[tid + NTHR * i] = VF[tid + NTHR * i]; }
    const int ql = 32 * w + j; const size_t qi = (size_t)bh * SEQ + 256 * qb + ql;
    bf16x8 qf[4];
    { const bf16_t* qrow = Qb + ((size_t)b * SEQ + 256 * qb + ql) * DA + h * HD + 8 * hi;
#pragma unroll
      for (int ds = 0; ds < 4; ++ds) qf[ds] = *(const bf16x8*)(qrow + 16 * ds); }
    const float m2 = MQg[qi];
    __syncthreads();
    const LAS bf16_t* KP = (const LAS bf16_t*)L; const LAS bf16_t* VP = (const LAS bf16_t*)(L + 32768); const LAS float* TABh = TAB + h * 132;
    const float mfar = 0.f; (void)mfar; const int dq = ql;
    f32x16 o0 = {}, o1 = {}; float lsum = 0.f;
    for (int st = 0; st <= w; ++st) ATTN_SUBTILE(KP, VP, st, true);
    float lt = lsum + __shfl_xor(lsum, 32);
    const int nsel = qb < 3 ? qb : 3;
    for (int s = 0; s < nsel; ++s) {
        lt += PL[(size_t)s * (NH * BATCH * SEQ) + qi];
        const bf16_t* src = (const bf16_t*)(F.ws + part_off(s)) + qi * HD + 4 * hi;
#pragma unroll
        for (int g4 = 0; g4 < 4; ++g4) { const u32x2 a = *(const u32x2*)(src + 8 * g4), c = *(const u32x2*)(src + 32 + 8 * g4);
            o0[4 * g4] += bflo(a.x); o0[4 * g4 + 1] += bfhi(a.x); o0[4 * g4 + 2] += bflo(a.y); o0[4 * g4 + 3] += bfhi(a.y);
            o1[4 * g4] += bflo(c.x); o1[4 * g4 + 1] += bfhi(c.x); o1[4 * g4 + 2] += bflo(c.y); o1[4 * g4 + 3] += bfhi(c.y); } }
    const float inv = 1.f / lt;
    bf16_t* dst = YA + ((size_t)b * SEQ + 256 * qb + ql) * DA + h * HD + 4 * hi;
#pragma unroll
    for (int g4 = 0; g4 < 4; ++g4) { *(u32x2*)(dst + 8 * g4) = (u32x2){cvt_pk_bf16(o0[4 * g4] * inv, o0[4 * g4 + 1] * inv), cvt_pk_bf16(o0[4 * g4 + 2] * inv, o0[4 * g4 + 3] * inv)};
        *(u32x2*)(dst + 32 + 8 * g4) = (u32x2){cvt_pk_bf16(o1[4 * g4] * inv, o1[4 * g4 + 1] * inv), cvt_pk_bf16(o1[4 * g4 + 2] * inv, o1[4 * g4 + 3] * inv)}; }
    __syncthreads();
}
__device__ __forceinline__ void attn_own_phase(Frame& F) {
    LAS float* TAB = (LAS float*)(F.lds + BTAB_OFF);
    attn_fill_tab(F, TAB);
    __syncthreads();
    for (int u = F.vcu; u < BATCH * NH * NBLK; u += F.G) attn_own_unit(F, u >> 5, u & 31, TAB);
}
#undef ATTN_SUBTILE

__device__ __forceinline__ void routing_phase(Frame& F) {
    LAS int* lcnt = (LAS int*)(F.lds); LAS int* lbase = lcnt + 32;
    const float* SSQ = (const float*)(F.ws + WS_SSQ); const float* RL = (const float*)(F.ws + WS_RLOG);
    unsigned* rowtok = (unsigned*)(F.ws + WS_ROWTOK); float* rowcoef = (float*)(F.ws + WS_ROWCOEF); float* rowrstd = (float*)(F.ws + WS_ROWRSTD);
    unsigned* ecnt = (unsigned*)(F.ctl + CW_ECNT);
    const float* brg = F.in[20]; const float* bre = F.in[22];
    const int tid = F.tid;
    for (int base = F.vcu * 256; base < T; base += F.G * 256) {
        if (tid < 32) lcnt[tid] = 0;
        __syncthreads();
        int e0 = 0, e1 = 0, lp0 = 0, lp1 = 0; float c0 = 0.f, c1 = 0.f, rstd = 0.f; const int tok = base + tid;
        if (tid < 256) {
            float ss = 0.f;
#pragma unroll
            for (int q = 0; q < 4; ++q) { const f32x4 v = *(const f32x4*)(SSQ + (size_t)tok * 16 + 4 * q); ss += (v.x + v.y) + (v.z + v.w); }
            rstd = 1.f / sqrtf(ss * (1.f / D) + RMS_EPS);
            float r[72];
#pragma unroll
            for (int q = 0; q < 18; ++q) { const f32x4 v = *(const f32x4*)(RL + (size_t)tok * 72 + 4 * q); r[4 * q] = v.x; r[4 * q + 1] = v.y; r[4 * q + 2] = v.z; r[4 * q + 3] = v.w; }
            float gl[4], el[32];
#pragma unroll
            for (int c = 0; c < 4; ++c) gl[c] = rstd * (r[c] + r[36 + c]) + brg[c];
#pragma unroll
            for (int c = 0; c < 32; ++c) el[c] = rstd * (r[4 + c] + r[40 + c]) + bre[c];
            int gi = 0; float gm = gl[0];
#pragma unroll
            for (int c = 1; c < 4; ++c) if (gl[c] > gm) { gm = gl[c]; gi = c; }
            float Z = 0.f;
#pragma unroll
            for (int c = 0; c < 4; ++c) Z += __expf(gl[c] - gm);
            const float gval = 1.f / Z;
            float es[8];
#pragma unroll
            for (int q = 0; q < 8; ++q) es[q] = gi == 0 ? el[q] : (gi == 1 ? el[8 + q] : (gi == 2 ? el[16 + q] : el[24 + q]));
            int a0 = 0; float m0 = es[0];
#pragma unroll
            for (int q = 1; q < 8; ++q) if (es[q] > m0) { m0 = es[q]; a0 = q; }
            int a1 = -1; float m1 = -INFINITY;
#pragma unroll
            for (int q = 0; q < 8; ++q) if (q != a0 && es[q] > m1) { m1 = es[q]; a1 = q; }
            const float w0 = 1.f / (1.f + __expf(m1 - m0)), w1 = 1.f - w0;
            e0 = gi * 8 + a0; e1 = gi * 8 + a1; c0 = gval * w0; c1 = gval * w1;
            lp0 = __hip_atomic_fetch_add(lcnt + e0, 1, __ATOMIC_RELAXED, __HIP_MEMORY_SCOPE_WORKGROUP);
            lp1 = __hip_atomic_fetch_add(lcnt + e1, 1, __ATOMIC_RELAXED, __HIP_MEMORY_SCOPE_WORKGROUP);
        }
        __syncthreads();
        if (tid < 32) lbase[tid] = (int)__hip_atomic_fetch_add(ecnt + tid, (unsigned)lcnt[tid], __ATOMIC_RELAXED, __HIP_MEMORY_SCOPE_AGENT);
        __syncthreads();
        if (tid < 256) {
            const size_t i0 = (size_t)e0 * ROWCAP + lbase[e0] + lp0, i1 = (size_t)e1 * ROWCAP + lbase[e1] + lp1;
            rowtok[i0] = (unsigned)tok * 2u; rowcoef[i0] = c0; rowrstd[i0] = rstd;
            rowtok[i1] = (unsigned)tok * 2u + 1u; rowcoef[i1] = c1; rowrstd[i1] = rstd;
        }
        __syncthreads();
    }
}
struct MoeOrder {
    const LAS int* tst; int total, G, v;
    __device__ bool next(int i, pg8::Unit& u) const {
        const int L = i * G + v; if (L >= total) return false;
        const int rt = L >> 2; int e = 0;
#pragma unroll 8
        for (int q = 1; q <= 32; ++q) e += (tst[q] <= rt) ? 1 : 0;
        u.pm = rt; u.pn = L & 3; u.pb = e * 4 + u.pn; u.aux = e; u.aux2 = (rt - tst[e]) * 256; return true;
    }
};
__device__ __forceinline__ void moe_tables(Frame& F) {
    LAS int* tst = (LAS int*)(F.lds + MOE_TST_OFF); const unsigned* ecnt = (const unsigned*)(F.ctl + CW_ECNT);
    if (F.wave == 0) { const int lane = F.lane; int nt = lane < 32 ? (int)((ecnt[lane & 31] + 255u) >> 8) : 0; int inc = nt;
#pragma unroll
        for (int o = 1; o < 32; o <<= 1) { const int t = __shfl_up(inc, o); if (lane >= o) inc += t; }
        if (lane < 32) tst[lane + 1] = inc; if (lane == 0) tst[0] = 0; }
    __syncthreads();
}
__device__ __forceinline__ void final_phase(Frame& F) {
    const float* X1 = (const float*)(F.ws + WS_X1); const bf16_t* Y0 = (const bf16_t*)(F.ws + WS_Y0); const bf16_t* Y1 = (const bf16_t*)(F.ws + WS_Y1); const float* gf = F.in[26];
    const int gw = F.vcu * NWAVES + F.wave, NGW = F.G * NWAVES, lane = F.lane;
    for (int m = gw; m < T; m += NGW) {
        const f32x4* xr = (const f32x4*)(X1 + (size_t)m * D) + lane; const u32x2* y0 = (const u32x2*)(Y0 + (size_t)m * D) + lane; const u32x2* y1 = (const u32x2*)(Y1 + (size_t)m * D) + lane;
        f32x4 v[4]; float s = 0.f;
#pragma unroll
        for (int j = 0; j < 4; ++j) { v[j] = xr[64 * j]; const u32x2 a = y0[64 * j], c = y1[64 * j];
            v[j].x += bflo(a.x) + bflo(c.x); v[j].y += bfhi(a.x) + bfhi(c.x); v[j].z += bflo(a.y) + bflo(c.y); v[j].w += bfhi(a.y) + bfhi(c.y);
            s += (v[j].x * v[j].x + v[j].y * v[j].y) + (v[j].z * v[j].z + v[j].w * v[j].w); }
        const float rstd = 1.f / sqrtf(wave_sum(s) * (1.f / D) + RMS_EPS);
        f32x4* o = (f32x4*)(F.out + (size_t)m * D) + lane; const f32x4* gr = (const f32x4*)gf + lane;
#pragma unroll
        for (int j = 0; j < 4; ++j) o[64 * j] = v[j] * rstd * gr[64 * j];
    }
}
#ifndef MK_N_LAUNCHES
#define MK_N_LAUNCHES 1
#endif
constexpr int NPHASE = 15;
struct Args { const float* in[27]; float* out; unsigned char* ws; int ph_lo, ph_hi; };
static_assert(sizeof(Args) == 27 * 8 + 8 + 8 + 8, "Args has no padding");

#ifndef DUP_MASK
#define DUP_MASK 0
#endif
#define PH_ARGS Frame& F, unsigned char* ws, LAS unsigned char* ring
__device__ __forceinline__ void ph1(PH_ARGS) {
    pg8::Gemm g{(const bf16_t*)(ws + WS_H1), (const bf16_t*)(ws + WS_WIN), D, D, D}; pg8::StaticOrder S; S.init(T, DIN, F.G, (int)blockIdx.x);
    EpiProj E{ws, F.in[3]};
    pg8::gemm_phase<EpiProj, pg8::StaticOrder, true, false>(ring, g, S, E, nullptr);
}
__device__ __forceinline__ void ph2(PH_ARGS) {
    { pg8::Gemm g{(const bf16_t*)(ws + WS_UP), (const bf16_t*)(ws + WS_SSMW), SKY, SKU, SKU}; pg8::GroupedOrder S; S.init(SG * 8, 1, 8, F.G, F.vcu);
      EpiSsmE E{(float*)(ws + WS_E)};
      pg8::gemm_phase<EpiSsmE, pg8::GroupedOrder, false, false>(ring, g, S, E, nullptr); }
    __syncthreads();
    kv_prep_phase(F);
}
__device__ __forceinline__ void ph4(PH_ARGS) {
    pg8::Gemm g{(const bf16_t*)(ws + WS_UP), (const bf16_t*)(ws + WS_SSMT), SKY, SKY, SKY}; pg8::GroupedOrder S; S.init(SG * 8, 2, 8, F.G, F.vcu);
    EpiSsmY E{(bf16_t*)(ws + WS_GACT)};
    pg8::gemm_phase<EpiSsmY, pg8::GroupedOrder, true, false>(ring, g, S, E, nullptr);
}
__device__ __forceinline__ void ph5(PH_ARGS) {
    pg8::Gemm g{(const bf16_t*)(ws + WS_GACT), (const bf16_t*)(ws + WS_WGLU), DS, DS, DS}; pg8::StaticOrder S; S.init(T, DS, F.G, (int)blockIdx.x);
    EpiGlu E{(const bf16_t*)(ws + WS_GACT), (bf16_t*)(ws + WS_YSSM), F.in[13]};
    pg8::gemm_phase<EpiGlu, pg8::StaticOrder, true, false>(ring, g, S, E, nullptr);
}
__device__ __forceinline__ void ph6(PH_ARGS) {
    { pg8::Gemm g{(const bf16_t*)(ws + WS_YSSM), (const bf16_t*)(ws + WS_WUS), DS, DS, DS}; pg8::StaticOrder S; S.init(T, D, F.G, (int)blockIdx.x);
      EpiUp<false> E{(const bf16_t*)(ws + WS_SGS), (bf16_t*)(ws + WS_MRG)};
      pg8::gemm_phase<EpiUp<false>, pg8::StaticOrder, true, false>(ring, g, S, E, nullptr); }
    VM_WAIT(); __syncthreads();
    { pg8::Gemm g{(const bf16_t*)(ws + WS_YATT), (const bf16_t*)(ws + WS_WUA), DA, DA, DA}; pg8::StaticOrder S; S.init(T, D, F.G, (int)blockIdx.x);
      EpiUp<true> E{(const bf16_t*)(ws + WS_SGA), (bf16_t*)(ws + WS_MRG)};
      pg8::gemm_phase<EpiUp<true>, pg8::StaticOrder, true, false>(ring, g, S, E, nullptr); }
}
__device__ __forceinline__ void ph7(PH_ARGS) {
    pg8::Gemm g{(const bf16_t*)(ws + WS_MRG), (const bf16_t*)(ws + WS_WOUT), D, D, D}; pg8::StaticOrder S; S.init(T, D, F.G, (int)blockIdx.x);
    EpiOut E{F.in[0], (float*)(ws + WS_X1), (bf16_t*)(ws + WS_XG), F.in[18], (float*)(ws + WS_SSQ)};
    pg8::gemm_phase<EpiOut, pg8::StaticOrder, true, false>(ring, g, S, E, nullptr);
}
__device__ __forceinline__ void ph8(PH_ARGS) {
    pg8::Gemm g{(const bf16_t*)(ws + WS_XG), (const bf16_t*)(ws + WS_WR), D, D, D}; pg8::StaticOrder S; S.init(T, 256, F.G, (int)blockIdx.x);
    EpiRouter E{(float*)(ws + WS_RLOG)};
    pg8::gemm_phase<EpiRouter, pg8::StaticOrder, false, false>(ring, g, S, E, nullptr);
}
__device__ __forceinline__ void ph10(PH_ARGS) {
    moe_tables(F);
    const LAS int* tst = (const LAS int*)(F.lds + MOE_TST_OFF);
    MoeOrder S{tst, tst[32] * 4, F.G, F.vcu};
    LAS unsigned* rowtab = (LAS unsigned*)(F.lds + ROWTAB_OFF);
    { const unsigned* rowtok = (const unsigned*)(ws + WS_ROWTOK); const unsigned* ecnt = (const unsigned*)(F.ctl + CW_ECNT); pg8::Unit u;
      for (int i = 0; i < ROWTAB_UNITS && S.next(i, u); ++i) { if (F.tid < 256) { const int pos = u.aux2 + F.tid; const unsigned tk = pos < (int)ecnt[u.aux] ? (rowtok[(size_t)u.aux * ROWCAP + pos] >> 1) : 0u; rowtab[i * 256 + F.tid] = tk * (unsigned)(D * 2); } } }
    __syncthreads();
    pg8::Gemm g{(const bf16_t*)(ws + WS_XG), (const bf16_t*)(ws + WS_W13), D, D, D};
    EpiMoe1 E{(bf16_t*)(ws + WS_HID), (const float*)(ws + WS_ROWRSTD), (const unsigned*)(F.ctl + CW_ECNT)};
    pg8::gemm_phase<EpiMoe1, MoeOrder, true, true>(ring, g, S, E, rowtab);
}
__device__ __forceinline__ void ph11(PH_ARGS) {
    moe_tables(F);
    const LAS int* tst = (const LAS int*)(F.lds + MOE_TST_OFF);
    MoeOrder S{tst, tst[32] * 4, F.G, F.vcu};
    pg8::Gemm g{(const bf16_t*)(ws + WS_HID), (const bf16_t*)(ws + WS_W2), DE, DE, DE};
    EpiMoe2 E{(bf16_t*)(ws + WS_Y0), (size_t)(WS_Y1 - WS_Y0), (const unsigned*)(ws + WS_ROWTOK), (const float*)(ws + WS_ROWCOEF), (const unsigned*)(F.ctl + CW_ECNT)};
    pg8::gemm_phase<EpiMoe2, MoeOrder, true, false>(ring, g, S, E, nullptr);
}

__global__ void __launch_bounds__(NTHR, 2) fwd_kernel(Args args) {
    extern __shared__ __attribute__((aligned(16))) unsigned char lds_raw[];
    Frame F;
    F.lds = (LAS unsigned char*)lds_raw;
    F.MISC = (volatile LAS unsigned*)(F.lds + MISC_OFF);
    F.tid = threadIdx.x; F.lane = F.tid & 63; F.wave = __builtin_amdgcn_readfirstlane(F.tid >> 6);
    F.G = gridDim.x; { const int bx = blockIdx.x; F.vcu = (F.G % 8 == 0) ? (bx % 8) * (F.G / 8) + bx / 8 : bx; }
    F.ws = args.ws; F.ctl = (gu32*)(args.ws + WS_CTL); F.out = args.out;
#pragma unroll
    for (int i = 0; i < 27; ++i) F.in[i] = args.in[i];
    for (int u = F.tid; u < (LDS_BYTES - MOE_TST_OFF) / 4; u += NTHR) ((LAS unsigned*)(F.lds + MOE_TST_OFF))[u] = 0u;
    __syncthreads();
    XcdBarrier bar; bar.bar = (unsigned*)(F.ctl + CW_BAR); bar.x = 0; bar.st = nullptr;
    const int lo = args.ph_lo, hi = args.ph_hi;
    if (hi - lo > 1) bar = xcd_barrier_post((unsigned*)(F.ctl + CW_BAR), F.MISC + 8);
#define IN(k) (lo <= (k) && (k) < hi)
#define DUP(k) ((DUP_MASK >> (k)) & 1)
#define SEAM(k) do { if (IN(k) && IN((k) + 1)) xcd_barrier(bar); } while (0)
    unsigned char* ws = args.ws;
    LAS unsigned char* ring = F.lds;
    if (IN(0)) { p0_prologue(F); if (DUP(0)) p0_prologue(F); }
    SEAM(0);
    if (IN(1)) { ph1(F, ws, ring); if (DUP(1)) ph1(F, ws, ring); }
    SEAM(1);
    if (IN(2)) { ph2(F, ws, ring); if (DUP(2)) ph2(F, ws, ring); }
    SEAM(2);
    if (IN(3)) { ssm_scan_phase(F); attn_gate_phase<true>(F); if (DUP(3)) { ssm_scan_phase(F); } if (DUP(15)) { attn_gate_phase<false>(F); } }
    SEAM(3);
    if (IN(4)) { attn_block_phase(F); if (DUP(4)) { __syncthreads(); attn_block_phase(F); } }
    SEAM(4);
    if (IN(5)) { attn_own_phase(F); if (DUP(5)) attn_own_phase(F); }
    SEAM(5);
    if (IN(6)) { ph4(F, ws, ring); if (DUP(6)) ph4(F, ws, ring); }
    SEAM(6);
    if (IN(7)) { ph5(F, ws, ring); if (DUP(7)) ph5(F, ws, ring); }
    SEAM(7);
    if (IN(8)) { ph6(F, ws, ring); if (DUP(8)) ph6(F, ws, ring); }
    SEAM(8);
    if (IN(9)) { ph7(F, ws, ring); if (DUP(9)) ph7(F, ws, ring); }
    SEAM(9);
    if (IN(10)) { ph8(F, ws, ring); if (DUP(10)) ph8(F, ws, ring); }
    SEAM(10);
    if (IN(11)) { routing_phase(F); }
    SEAM(11);
    if (IN(12)) { ph10(F, ws, ring); if (DUP(12)) ph10(F, ws, ring); }
    SEAM(12);
    if (IN(13)) { ph11(F, ws, ring); if (DUP(13)) ph11(F, ws, ring); }
    SEAM(13);
    if (IN(14)) { final_phase(F); if (DUP(14)) final_phase(F); }
#undef IN
#undef DUP
#undef SEAM
}

extern "C" void kernel_launch(void* const* d_in, const int* in_sizes, int n_in, void* d_out, int out_size, void* d_ws, size_t ws_size, hipStream_t stream) {
    static int grid = 0;
    if (grid == 0) {
        if (n_in != 27 || in_sizes[0] != T * D || out_size != T * D || ws_size < WS_END) { fprintf(stderr, "kernel_launch: unexpected shapes (n_in %d, in0 %d, out %d, ws %zu)\n", n_in, n_in > 0 ? in_sizes[0] : -1, out_size, ws_size); grid = -1; return; }
        int dev = 0, cus = 0;
        if (hipGetDevice(&dev) != hipSuccess || hipDeviceGetAttribute(&cus, hipDeviceAttributeMultiprocessorCount, dev) != hipSuccess) { grid = -1; return; }
        if (hipFuncSetAttribute((const void*)fwd_kernel, hipFuncAttributeMaxDynamicSharedMemorySize, LDS_BYTES) != hipSuccess) { fprintf(stderr, "kernel_launch: hipFuncSetAttribute failed\n"); grid = -1; return; }
        (void)hipGetLastError();
        grid = cus;
    }
    if (grid < 0) return;
    (void)hipMemsetAsync((char*)d_ws + WS_CTL, 0, CTL_ZERO_BYTES, stream);
    Args a{};
    for (int i = 0; i < 27; ++i) a.in[i] = (const float*)d_in[i];
    a.out = (float*)d_out; a.ws = (unsigned char*)d_ws;
    if (MK_N_LAUNCHES == 1) { a.ph_lo = 0; a.ph_hi = NPHASE; hipLaunchKernelGGL(fwd_kernel, dim3(grid), dim3(NTHR), LDS_BYTES, stream, a); }
    else { for (int p = 0; p < NPHASE; ++p) { a.ph_lo = p; a.ph_hi = p + 1; hipLaunchKernelGGL(fwd_kernel, dim3(grid), dim3(NTHR), LDS_BYTES, stream, a); } }
}
```

```cpp
#include <hip/hip_runtime.h>
#include <cstdio>
#include <cstdint>

#define LAS __attribute__((address_space(3)))
#define GAS __attribute__((address_space(1)))
typedef unsigned short bf16_t;
typedef short bf16x8 __attribute__((ext_vector_type(8)));
typedef float f32x2 __attribute__((ext_vector_type(2)));
typedef float f32x4 __attribute__((ext_vector_type(4)));
typedef float f32x16 __attribute__((ext_vector_type(16)));
typedef unsigned u32x2 __attribute__((ext_vector_type(2)));
typedef unsigned u32x4 __attribute__((ext_vector_type(4)));
typedef GAS unsigned gu32;
typedef int v4i32 __attribute__((ext_vector_type(4)));
typedef int v8i32 __attribute__((ext_vector_type(8)));
#define RLX_AGENT __ATOMIC_RELAXED, __HIP_MEMORY_SCOPE_AGENT
#define LDS_WAIT() asm volatile("s_waitcnt lgkmcnt(0)" ::: "memory")
#define VM_WAIT() asm volatile("s_waitcnt vmcnt(0)" ::: "memory")

__device__ __forceinline__ unsigned f2bf(float f) { unsigned u = __builtin_bit_cast(unsigned, f); return (u + 0x7fffu + ((u >> 16) & 1u)) >> 16; }
__device__ __forceinline__ unsigned pk2(float lo, float hi) { return f2bf(lo) | (f2bf(hi) << 16); }
__device__ __forceinline__ float bf2f(unsigned short b) { return __builtin_bit_cast(float, (unsigned)b << 16); }
__device__ __forceinline__ float bflo(unsigned w) { return __builtin_bit_cast(float, w << 16); }
__device__ __forceinline__ float bfhi(unsigned w) { return __builtin_bit_cast(float, w & 0xffff0000u); }
__device__ __forceinline__ unsigned cvt_pk_bf16(float lo, float hi) { unsigned r; asm volatile("v_cvt_pk_bf16_f32 %0, %1, %2" : "=v"(r) : "v"(lo), "v"(hi)); return r; }
__device__ __forceinline__ float fast_sigmoid(float x) { return __builtin_amdgcn_rcpf(1.f + __builtin_amdgcn_exp2f(-1.4426950408889634f * x)); }
__device__ __forceinline__ float wave_sum(float v) {
#pragma unroll
    for (int o = 1; o < 64; o <<= 1) v += __shfl_xor(v, o);
    return v;
}
__device__ __forceinline__ float wave_max(float v) {
#pragma unroll
    for (int o = 1; o < 64; o <<= 1) v = fmaxf(v, __shfl_xor(v, o));
    return v;
}

#define XB_TMO      128
#define XB_XCNT(j)  (256  + 64 * (j))
#define XB_XSUB(j)  (1280 + 64 * (j))
#define XB_XGEN(j)  (2304 + 64 * (j))
#define XB_TOP      3328
#define XB_TOPGEN   3392
#define XCD_BAR_WORDS 3456
#define XB_SPIN_CAP (1u << 20)

__device__ __forceinline__ unsigned xb_ld(unsigned* p)              { return __hip_atomic_load(p, __ATOMIC_RELAXED, __HIP_MEMORY_SCOPE_AGENT); }
__device__ __forceinline__ unsigned xb_add(unsigned* p, unsigned v) { return __hip_atomic_fetch_add(p, v, __ATOMIC_RELAXED, __HIP_MEMORY_SCOPE_AGENT); }
__device__ __forceinline__ unsigned xb_xcc_id() { return (unsigned)__builtin_amdgcn_s_getreg((3 << 11) | 20) & 0xFu; }
#define XB_SPIN(cond, bar) do { unsigned _sp = 0; while (cond) { __builtin_amdgcn_s_sleep(1); \
    if ((++_sp & 255u) == 0u) { if (xb_ld(&(bar)[XB_TMO])) break; if (_sp > XB_SPIN_CAP) { atomicAdd(&(bar)[XB_TMO], 1u); break; } } } } while (0)

struct XcdBarrier { unsigned* bar; unsigned x; volatile LAS unsigned* st; };

__device__ __forceinline__ XcdBarrier xcd_barrier_post(unsigned* bar, volatile LAS unsigned* st) {
    XcdBarrier b; b.bar = bar; b.x = xb_xcc_id(); b.st = st;
    if (threadIdx.x == 0) (void)xb_add(&bar[XB_XCNT(b.x)], 1u);
    return b;
}
__device__ __forceinline__ void xcd_barrier_complete(unsigned* bar, unsigned x, unsigned& nloc, unsigned& nx) {
    const unsigned G = gridDim.x * gridDim.y * gridDim.z;
    unsigned sum, cnt, mine, sp = 0u;
    for (;;) {
        sum = 0u; cnt = 0u; mine = 0u;
#pragma unroll
        for (unsigned j = 0; j < 16; ++j) { const unsigned c = xb_ld(&bar[XB_XCNT(j)]); sum += c; cnt += (c > 0u) ? 1u : 0u; mine = (j == x) ? c : mine; }
        if (sum == G) break;
        __builtin_amdgcn_s_sleep(1);
        if ((++sp & 255u) == 0u) { if (xb_ld(&bar[XB_TMO])) break; if (sp > XB_SPIN_CAP) { atomicAdd(&bar[XB_TMO], 1u); break; } }
    }
    nloc = mine > 0u ? mine : 1u; nx = cnt > 0u ? cnt : 1u;
}
__device__ __forceinline__ void xcd_barrier(const XcdBarrier& b) {
    asm volatile("s_waitcnt vmcnt(0)" ::: "memory");
    __syncthreads();
    if (threadIdx.x == 0) {
        unsigned* bar = b.bar;
        __builtin_amdgcn_s_waitcnt(0);
        unsigned nloc = b.st[0], nx = b.st[1];
        if (nloc == 0u) { xcd_barrier_complete(bar, b.x, nloc, nx); b.st[0] = nloc; b.st[1] = nx; }
        const unsigned old = xb_add(&bar[XB_XSUB(b.x)], 1u);
        const unsigned gen = old / nloc;
        if (old + 1u == (gen + 1u) * nloc) {
            __builtin_amdgcn_fence(__ATOMIC_RELEASE, "agent");
            asm volatile("s_waitcnt vmcnt(0)" ::: "memory");
            const unsigned og = xb_add(&bar[XB_TOP], 1u);
            const unsigned tg = og / nx;
            if (og + 1u == (tg + 1u) * nx) xb_add(&bar[XB_TOPGEN], 1u);
            else XB_SPIN(xb_ld(&bar[XB_TOPGEN]) == tg, bar);
            __builtin_amdgcn_fence(__ATOMIC_ACQUIRE, "agent");
            xb_add(&bar[XB_XGEN(b.x)], 1u);
            asm volatile("s_waitcnt vmcnt(0)" ::: "memory");
        } else {
            XB_SPIN(xb_ld(&bar[XB_XGEN(b.x)]) == gen, bar);
            __builtin_amdgcn_fence(__ATOMIC_ACQUIRE, "agent");
            asm volatile("s_waitcnt vmcnt(0)" ::: "memory");
        }
    }
    __syncthreads();
}

namespace pg8 {
constexpr int BM = 256, BK = 64, HALF = 128, HTB = HALF * BK * 2, STAGE_BYTES = 8 * HTB, NXCD = 8, WGM = 8;
__host__ __device__ __forceinline__ int lds_byte(int r, int c) { const int st = (r >> 4) * 2 + (c >> 5), rr = r & 15, cc = c & 31, ob = rr * 64 + cc * 2; return st * 1024 + (ob ^ (((ob >> 9) & 1) << 5)); }
__host__ __device__ __forceinline__ void stage_rc(int b, int& R, int& C) { const int st = b / 1024, sb = b % 1024, swz = sb ^ (((sb >> 9) & 1) << 5); R = (st >> 1) * 16 + swz / 64; C = (st & 1) * 32 + (swz % 64) / 2; }
__host__ __device__ __forceinline__ int perm32(int rho) { const int n = rho >> 4, i = rho & 15; return 8 * (i >> 2) + 4 * n + (i & 3); }

struct Unit { int pm, pn, pb, aux, aux2; };
struct Gemm { const bf16_t* A; const bf16_t* Bt; int lda, ldb, K; };

struct StaticOrder {
    int nM, nN, nwg, G, c;
    __device__ void init(int M, int N, int G_, int c_) { nM = M / BM; nN = N / BM; nwg = nM * nN; G = G_; c = c_; }
    __device__ bool next(int i, Unit& u) const {
        const long L = (long)i * G + c; if (L >= nwg) return false;
        int wgid = (int)L; { const int q = nwg / NXCD, r = nwg % NXCD, xcd = wgid % NXCD, off = wgid / NXCD; wgid = (xcd < r ? xcd * (q + 1) : r * (q + 1) + (xcd - r) * q) + off; }
        const int nig = WGM * nN, gid = wgid / nig, fm = gid * WGM, gsz = (nM - fm) < WGM ? (nM - fm) : WGM;
        u.pm = fm + ((wgid % nig) % gsz); u.pn = (wgid % nig) / gsz; u.pb = u.pn; u.aux = 0; u.aux2 = 0; return true;
    }
};
struct GroupedOrder {
    int nM, nN, rtpg, G, v;
    __device__ void init(int nM_, int nN_, int rtpg_, int G_, int v_) { nM = nM_; nN = nN_; rtpg = rtpg_; G = G_; v = v_; }
    __device__ bool next(int i, Unit& u) const {
        const int L = i * G + v; if (L >= nM * nN) return false;
        u.pm = L / nN; u.pn = L % nN; u.aux = u.pm / rtpg; u.pb = u.aux * nN + u.pn; u.aux2 = 0; return true;
    }
};

template <class Epi, class Sched, bool ALIGN_EPI, bool GATHER, bool FP8 = false>
__device__ __forceinline__ void gemm_phase(LAS unsigned char* lds, const Gemm g, const Sched& S, const Epi& E, const LAS unsigned* rowtab  , int stagger_ticks = 0  ) {
    if (stagger_ticks > 0) { const unsigned long long t0_ = __builtin_amdgcn_s_memrealtime(); while ((long long)(__builtin_amdgcn_s_memrealtime() - t0_) < (long long)stagger_ticks) __builtin_amdgcn_s_sleep(16); }
    const int tid = threadIdx.x, wid = __builtin_amdgcn_readfirstlane(tid >> 6), lane = tid & 63, wr = wid >> 2, wc = wid & 3, fr = lane & 15, fq = lane >> 4;
    const int K = g.K, nt = K / BK;
    int RA[2]; unsigned cA2[2]; unsigned voffB[2];
#pragma unroll
    for (int i = 0; i < 2; ++i) { int R, C; stage_rc(tid * 16 + i * 8192, R, C); const int Rb = (R & ~31) + perm32(R & 31);
        RA[i] = R; cA2[i] = (unsigned)C * 2u; voffB[i] = (unsigned)(Rb * g.ldb + C) * 2u; }
    const size_t kstep = (size_t)(BK * 2);
    const size_t hstepB = (size_t)HALF * g.ldb * 2, tstepB = 2 * hstepB;
    const size_t tstepA = (size_t)BM * g.lda * 2;
    const unsigned ldsw = (unsigned)wid * 1024u;
    const int aoff = lds_byte(wr * 64 + fr, fq * 8), boff = lds_byte(wc * 32 + fr, fq * 8);
    unsigned vAc[2][2], vAn[2][2];
#define PG8_SETVA(dst, ui_) do { _Pragma("unroll") for (int h_ = 0; h_ < 2; ++h_) _Pragma("unroll") for (int i_ = 0; i_ < 2; ++i_) \
        dst[h_][i_] = (GATHER ? rowtab[(ui_) * 256 + h_ * 128 + RA[i_]] : (unsigned)((h_ * 128 + RA[i_]) * g.lda) * 2u) + cA2[i_]; } while (0)
#define PG8_SA(b, h) (((b) * 2 + (h)) * HTB)
#define PG8_SB(b, h) ((4 + (b) * 2 + (h)) * HTB)
#define PG8_GLDS_S(gbase_, voff_, ldsaddr_) do { unsigned keep_; asm volatile("s_mov_b32 %0, m0\n\ts_mov_b32 m0, %3\n\ts_nop 0\n\tglobal_load_lds_dwordx4 %1, %2\n\ts_mov_b32 m0, %0" \
        : "=&s"(keep_) : "v"(voff_), "s"(gbase_), "s"(ldsaddr_) : "memory"); } while (0)
#define PG8_STAGE(bufoff, gbase, v0, v1) do { \
        if constexpr (FP8) { const unsigned la_ = (unsigned)(uintptr_t)(lds + (bufoff) + ldsw); PG8_GLDS_S((const char*)(gbase), (v0), la_); PG8_GLDS_S((const char*)(gbase), (v1), la_ + 8192u); } else { \
        __builtin_amdgcn_global_load_lds((const unsigned*)((const char*)(gbase) + (v0)), (LAS unsigned*)(lds + (bufoff) + ldsw), 16, 0, 0); \
        __builtin_amdgcn_global_load_lds((const unsigned*)((const char*)(gbase) + (v1)), (LAS unsigned*)(lds + (bufoff) + ldsw + 8192), 16, 0, 0); } } while (0)
#define PG8_STB(bufoff, gbase) PG8_STAGE(bufoff, gbase, voffB[0], voffB[1])
#define PG8_LDA(dst, b, h) do { _Pragma("unroll") for (int m = 0; m < 4; ++m) _Pragma("unroll") for (int k = 0; k < 2; ++k) dst[m][k] = *(const LAS bf16x8*)(lds + PG8_SA(b, h) + aoff + m * 2048 + k * 1024); } while (0)
#define PG8_LDB(dst, b, h) do { _Pragma("unroll") for (int n = 0; n < 2; ++n) _Pragma("unroll") for (int k = 0; k < 2; ++k) dst[n][k] = *(const LAS bf16x8*)(lds + PG8_SB(b, h) + boff + n * 2048 + k * 1024); } while (0)
#define PG8_MMA(ai, bj, At, Bt) do { __builtin_amdgcn_s_setprio(1); \
        if constexpr (FP8) { _Pragma("unroll") for (int m = 0; m < 4; ++m) _Pragma("unroll") for (int n = 0; n < 2; ++n) { \
            const v8i32 a8_ = __builtin_shufflevector(__builtin_bit_cast(v4i32, At[m][0]), __builtin_bit_cast(v4i32, At[m][1]), 0, 1, 2, 3, 4, 5, 6, 7); \
            const v8i32 b8_ = __builtin_shufflevector(__builtin_bit_cast(v4i32, Bt[n][0]), __builtin_bit_cast(v4i32, Bt[n][1]), 0, 1, 2, 3, 4, 5, 6, 7); \
            acc[ai][bj][m][n] = __builtin_amdgcn_mfma_scale_f32_16x16x128_f8f6f4(b8_, a8_, acc[ai][bj][m][n], 0, 0, 0, 0, 0, 0); } } \
        else { _Pragma("unroll") for (int m = 0; m < 4; ++m) _Pragma("unroll") for (int n = 0; n < 2; ++n) _Pragma("unroll") for (int k = 0; k < 2; ++k) \
            acc[ai][bj][m][n] = __builtin_amdgcn_mfma_f32_16x16x32_bf16(Bt[n][k], At[m][k], acc[ai][bj][m][n], 0, 0, 0); } \
        __builtin_amdgcn_s_setprio(0); } while (0)
#define PG8_WAIT_V(n) asm volatile("s_waitcnt vmcnt(" #n ")" ::: "memory")
#define PG8_WAIT_L(n) asm volatile("s_waitcnt lgkmcnt(" #n ")" ::: "memory")
#define PG8_BAR __builtin_amdgcn_s_barrier()
#define PG8_SCHED __builtin_amdgcn_sched_barrier(0)
#define PG8_SCHED8 do { if constexpr (FP8) __builtin_amdgcn_sched_barrier(0); } while (0)
    Unit cur, nxt; int ui = 0;
    if (!S.next(0, cur)) return;
    f32x4 acc[2][2][4][2];
#pragma unroll
    for (int a = 0; a < 2; ++a)
#pragma unroll
        for (int b = 0; b < 2; ++b)
#pragma unroll
            for (int m = 0; m < 4; ++m)
#pragma unroll
                for (int n = 0; n < 2; ++n) acc[a][b][m][n] = (f32x4){0.f, 0.f, 0.f, 0.f};
    bf16x8 At[4][2], B0[2][2], B1[2][2];
    const char* cA = (const char*)g.A + (GATHER ? (size_t)0 : (size_t)cur.pm * tstepA); const char* cB = (const char*)g.Bt + (size_t)cur.pb * tstepB;
    PG8_SETVA(vAc, 0);
    PG8_STB(PG8_SB(0, 0), cB); PG8_STB(PG8_SB(0, 1), cB + hstepB); PG8_STAGE(PG8_SA(0, 0), cA, vAc[0][0], vAc[0][1]); PG8_STAGE(PG8_SA(0, 1), cA, vAc[1][0], vAc[1][1]);
    if (wr == 1) PG8_BAR;
    PG8_WAIT_V(2); PG8_BAR;
    PG8_STB(PG8_SB(1, 0), cB + kstep); PG8_STAGE(PG8_SA(1, 0), cA + kstep, vAc[0][0], vAc[0][1]); PG8_STB(PG8_SB(1, 1), cB + hstepB + kstep);
    PG8_WAIT_V(6); PG8_BAR;
    for (;;) {
        const bool has_next = S.next(ui + 1, nxt);
        const char* nA = GATHER ? cA : (has_next ? (const char*)g.A + (size_t)nxt.pm * tstepA : cA); const char* nB = has_next ? (const char*)g.Bt + (size_t)nxt.pb * tstepB : cB;
        if (GATHER) { if (has_next) { PG8_SETVA(vAn, ui + 1); } else {
#pragma unroll
            for (int h_ = 0; h_ < 2; ++h_) { vAn[h_][0] = vAc[h_][0]; vAn[h_][1] = vAc[h_][1]; } } }
#pragma nounroll
        for (int t = 0; t < nt; t += 2) {
            const bool last = (t == nt - 2);
            const char* a1 = cA + (size_t)(t + 1) * kstep;
            const char* a2 = last ? nA : cA + (size_t)(t + 2) * kstep; const char* b2 = last ? nB : cB + (size_t)(t + 2) * kstep;
            const char* a3 = a2 + kstep; const char* b3 = b2 + kstep;
            unsigned x00, x01, x10, x11;
            if (GATHER) { x00 = last ? vAn[0][0] : vAc[0][0]; x01 = last ? vAn[0][1] : vAc[0][1]; x10 = last ? vAn[1][0] : vAc[1][0]; x11 = last ? vAn[1][1] : vAc[1][1]; }
            else { x00 = vAc[0][0]; x01 = vAc[0][1]; x10 = vAc[1][0]; x11 = vAc[1][1]; }
            PG8_LDB(B0, 0, 0); PG8_LDB(B1, 0, 1); PG8_SCHED; PG8_LDA(At, 0, 0); PG8_STAGE(PG8_SA(1, 1), a1, vAc[1][0], vAc[1][1]);
            PG8_WAIT_V(8); PG8_WAIT_L(0); PG8_BAR; PG8_SCHED8; PG8_MMA(0, 0, At, B0); PG8_MMA(0, 1, At, B1); PG8_SCHED8; PG8_BAR; PG8_SCHED;
            PG8_LDA(At, 0, 1); PG8_STB(PG8_SB(0, 0), b2); PG8_STB(PG8_SB(0, 1), b2 + hstepB); PG8_STAGE(PG8_SA(0, 0), a2, x00, x01);
            PG8_WAIT_V(8); PG8_WAIT_L(0); PG8_BAR; PG8_SCHED8; PG8_MMA(1, 0, At, B0); PG8_MMA(1, 1, At, B1); PG8_SCHED8; PG8_BAR; PG8_SCHED;
            PG8_LDB(B0, 1, 0); PG8_LDB(B1, 1, 1); PG8_SCHED; PG8_LDA(At, 1, 0); PG8_STAGE(PG8_SA(0, 1), a2, x10, x11);
            PG8_WAIT_V(8); PG8_WAIT_L(0); PG8_BAR; PG8_SCHED8; PG8_MMA(0, 0, At, B0); PG8_MMA(0, 1, At, B1); PG8_SCHED8; PG8_BAR; PG8_SCHED;
            PG8_LDA(At, 1, 1); PG8_STB(PG8_SB(1, 0), b3); PG8_STB(PG8_SB(1, 1), b3 + hstepB); PG8_STAGE(PG8_SA(1, 0), a3, x00, x01);
            PG8_WAIT_V(8); PG8_WAIT_L(0); PG8_BAR; PG8_SCHED8; PG8_MMA(1, 0, At, B0); PG8_MMA(1, 1, At, B1); PG8_SCHED8; PG8_BAR; PG8_SCHED;
        }
        if constexpr (ALIGN_EPI) { if (wr == 0) PG8_BAR; }
        E(acc, cur, wr, wc, fr, fq);
        if (!has_next) break;
#pragma unroll
        for (int a = 0; a < 2; ++a)
#pragma unroll
            for (int b = 0; b < 2; ++b)
#pragma unroll
                for (int m = 0; m < 4; ++m)
#pragma unroll
                    for (int n = 0; n < 2; ++n) acc[a][b][m][n] = (f32x4){0.f, 0.f, 0.f, 0.f};
        cur = nxt; cA = nA; cB = nB; ++ui;
        if (GATHER) {
#pragma unroll
            for (int h_ = 0; h_ < 2; ++h_) { vAc[h_][0] = vAn[h_][0]; vAc[h_][1] = vAn[h_][1]; } }
        if constexpr (ALIGN_EPI) { if (wr == 1) PG8_BAR; }
    }
    PG8_WAIT_V(0);
    if constexpr (!ALIGN_EPI) { if (wr == 0) PG8_BAR; }
    PG8_BAR;
#undef PG8_SETVA
#undef PG8_SA
#undef PG8_SB
#undef PG8_STAGE
#undef PG8_GLDS_S
#undef PG8_STB
#undef PG8_LDA
#undef PG8_LDB
#undef PG8_MMA
#undef PG8_WAIT_V
#undef PG8_WAIT_L
#undef PG8_BAR
#undef PG8_SCHED
#undef PG8_SCHED8
}
}
constexpr int NWAVES = 8, NTHR = 512;
constexpr int BATCH = 8, SEQ = 8192, T = BATCH * SEQ, D = 1024, DIN = 4096;
constexpr int DS = 512, DA = 512, NH = 8, HD = 64, NBLK = SEQ / 256;
constexpr int SG = 32, SHC = 16, SP = 64, SL = 32, SKU = SL * SHC  , SKS = 2 * SP  , SKY = SKU + SKS  , SROWS = T / SL  ;
constexpr int NE = 32, DE = 512;
constexpr float RMS_EPS = 1e-6f;
constexpr float LOG2E = 1.4426950408889634f;
constexpr float QSCALE = 0.125f * LOG2E;
constexpr float WF8_SCALE = 32.f;
constexpr int ROWCAP = T;
constexpr int HID_ROWS = 2 * T + NE * 256;

constexpr size_t MiB = 1u << 20;
constexpr size_t WS_CTL = 0, CTL_ZERO_BYTES = 1 * MiB;
constexpr size_t WS_WIN = 1 * MiB;
constexpr size_t WS_WGLU = 9 * MiB;
constexpr size_t WS_WUS = 10 * MiB;
constexpr size_t WS_WUA = 11 * MiB;
constexpr size_t WS_WOUT = 12 * MiB;
constexpr size_t WS_WR = 14 * MiB;
constexpr size_t WS_KMEAN = 15 * MiB;
constexpr size_t WS_SSMW = 16 * MiB;
constexpr size_t WS_SSMT = 24 * MiB;
constexpr size_t WS_W13 = 44 * MiB;
constexpr size_t WS_W2 = 108 * MiB;
constexpr size_t WS_A0 = 140 * MiB;
constexpr size_t WS_UP = 276 * MiB;
constexpr size_t WS_Q = 356 * MiB;
constexpr size_t WS_SSQ = 404 * MiB;
constexpr size_t WS_RLOG = 408 * MiB;
constexpr size_t WS_K = 420 * MiB;
constexpr size_t WS_ROWTOK = 428 * MiB, WS_ROWCOEF = 436 * MiB, WS_ROWRSTD = 444 * MiB;
constexpr size_t WS_GACT = 420 * MiB;
constexpr size_t WS_V = 484 * MiB;
constexpr size_t WS_YSSM = 484 * MiB;
constexpr size_t WS_SGS = 548 * MiB;
constexpr size_t WS_SGA = 676 * MiB;
constexpr size_t WS_E = 804 * MiB;
constexpr size_t WS_YATT = 836 * MiB;
constexpr size_t WS_PART0 = 420 * MiB, WS_PART1 = 484 * MiB, WS_PART2 = 932 * MiB;
constexpr size_t WS_QLIST = 900 * MiB;
constexpr size_t WS_PL = 268 * MiB;
constexpr size_t WS_MQ = 996 * MiB;
constexpr size_t WS_H1F8 = 836 * MiB;
constexpr size_t WS_WINF8 = 900 * MiB;
constexpr size_t WS_SEGC = 998 * MiB;
constexpr size_t WS_END = 999 * MiB;
constexpr size_t WS_KFRAG = WS_A0, WS_VFRAG = WS_A0 + 64 * MiB, WS_H1 = WS_A0, WS_MRG = WS_A0, WS_HID = WS_A0;
constexpr size_t WS_X1 = WS_SGS, WS_XG = WS_UP, WS_Y0 = WS_UP, WS_Y1 = WS_E;
static_assert(WS_GACT + 64 * MiB <= WS_YSSM && WS_YSSM + 64 * MiB <= WS_SGS, "map");
static_assert(WS_HID + (size_t)HID_ROWS * DE * 2 <= WS_UP, "hid fits");
static_assert(WS_RLOG + (size_t)T * 72 * 4 <= WS_ROWTOK, "rlog fits");

constexpr int CW_TMO = 0, CW_CODE = 1;
constexpr int CW_BAR = 4096;
constexpr int CW_ECNT = 8192;
constexpr int CW_GCNT = 12288;

constexpr int RING_BYTES = 131072;
constexpr int ROWTAB_OFF = RING_BYTES, ROWTAB_UNITS = 12, ROWTAB_BYTES = 24 * 1024;
constexpr int MOE_TST_OFF = ROWTAB_OFF + ROWTAB_BYTES;
constexpr int MISC_OFF = MOE_TST_OFF + 512;
constexpr int LDS_BYTES = MISC_OFF + 128;
static_assert(LDS_BYTES <= 163840, "LDS");

struct Frame {
    LAS unsigned char* lds;
    volatile LAS unsigned* MISC;
    gu32* ctl;
    unsigned char* ws;
    int tid, lane, wave, vcu, G;
    const float* in[27];
    float* out;
};

#define EPI_LOOP_BEGIN  _Pragma("unroll") for (int ai = 0; ai < 2; ++ai) _Pragma("unroll") for (int m = 0; m < 4; ++m) { const int rl = ai * 128 + wr * 64 + m * 16 + fr; _Pragma("unroll") for (int bj = 0; bj < 2; ++bj) { const int cl = bj * 128 + wc * 32 + 8 * fq; \
        const f32x4 a0 = acc[ai][bj][m][0], a1 = acc[ai][bj][m][1]; (void)rl; (void)cl; (void)a0; (void)a1;
#define EPI_LOOP_END } }
typedef const f32x4 (&AccRef)[2][2][4][2];
__device__ __forceinline__ u32x4 pack8(f32x4 a, f32x4 b) { u32x4 w; w.x = cvt_pk_bf16(a[0], a[1]); w.y = cvt_pk_bf16(a[2], a[3]); w.z = cvt_pk_bf16(b[0], b[1]); w.w = cvt_pk_bf16(b[2], b[3]); return w; }
__device__ __forceinline__ void unpack8(u32x4 w, f32x4& a, f32x4& b) { a = (f32x4){bflo(w.x), bfhi(w.x), bflo(w.y), bfhi(w.y)}; b = (f32x4){bflo(w.z), bfhi(w.z), bflo(w.w), bfhi(w.w)}; }

template <int PART  > struct EpiProj {
    unsigned char* ws; const float* b_gate; int pn_off; float ascale;
    __device__ __forceinline__ void operator()(AccRef acc, const pg8::Unit& u, int wr, int wc, int fr_, int fq_) const {
        int fr = fr_, fq = fq_; asm volatile("" : "+v"(fr), "+v"(fq));
        const int pn = u.pn + pn_off; const int row0 = u.pm * 256;
        if (PART == 0) {
            bf16_t* Uperm = (bf16_t*)(ws + WS_UP);
            EPI_LOOP_BEGIN
                const int row = row0 + rl, col = pn * 256 + cl;
                bf16_t* dst = Uperm + (size_t)(col >> 4) * ((size_t)SROWS * SKY) + (size_t)(row >> 5) * SKY + (row & 31) * 16 + (col & 15);
                *(u32x4*)dst = pack8(a0 * ascale, a1 * ascale);
            EPI_LOOP_END
        } else if (pn < 8) {
            const size_t boff = pn < 4 ? WS_Q : (pn < 6 ? WS_K : WS_V);
            bf16_t* base = (bf16_t*)(ws + boff); const float sc = pn < 4 ? QSCALE : 1.f; const int c0 = (pn & 1) * 256;
            EPI_LOOP_BEGIN
                const int row = row0 + rl, col = c0 + cl;
                *(u32x4*)(base + (size_t)row * 512 + col) = pack8(a0 * (sc * ascale), a1 * (sc * ascale));
            EPI_LOOP_END
        } else {
            const size_t boff = pn < 12 ? WS_SGS : WS_SGA;
            bf16_t* base = (bf16_t*)(ws + boff); const int c0 = ((pn - 8) & 3) * 256; const float* bg = b_gate + (pn - 8) * 256;
            EPI_LOOP_BEGIN
                const int row = row0 + rl, col = c0 + cl;
                const f32x4 b0 = *(const f32x4*)(bg + cl), b1 = *(const f32x4*)(bg + cl + 4);
                f32x4 s0, s1;
#pragma unroll
                for (int e = 0; e < 4; ++e) { s0[e] = fast_sigmoid(a0[e] * ascale + b0[e]); s1[e] = fast_sigmoid(a1[e] * ascale + b1[e]); }
                *(u32x4*)(base + (size_t)row * 1024 + col) = pack8(s0, s1);
            EPI_LOOP_END
        }
    }
};
struct EpiSsmE {
    float* E;
    __device__ __forceinline__ void operator()(AccRef acc, const pg8::Unit& u, int wr, int wc, int fr, int fq) const {
        EPI_LOOP_BEGIN
            if (bj == 0) { float* dst = E + (size_t)(u.pm * 256 + rl) * 128 + cl; *(f32x4*)dst = a0; *(f32x4*)(dst + 4) = a1; }
        EPI_LOOP_END
    }
};
__device__ __forceinline__ float gelu_tanh(float x) { const float z = 1.5957691216057308f * (x + 0.044715f * x * x * x); return x * fast_sigmoid(z); }
struct EpiSsmY {
    bf16_t* Gact;
    __device__ __forceinline__ void operator()(AccRef acc, const pg8::Unit& u, int wr, int wc, int fr, int fq) const {
        const int g = u.aux;
        EPI_LOOP_BEGIN
            const int rg = (u.pm & 7) * 256 + rl;
            const int colg = u.pn * 256 + cl;
            const int tok = (rg >> 8) * SEQ + (rg & 255) * SL + (colg >> 4);
            f32x4 y0, y1;
#pragma unroll
            for (int e = 0; e < 4; ++e) { y0[e] = gelu_tanh(a0[e]); y1[e] = gelu_tanh(a1[e]); }
            *(u32x4*)(Gact + (size_t)tok * DS + g * 16 + (colg & 15)) = pack8(y0, y1);
        EPI_LOOP_END
    }
};
struct EpiGlu {
    const bf16_t* Gact; bf16_t* Yssm; const float* b_glu;
    __device__ __forceinline__ void operator()(AccRef acc, const pg8::Unit& u, int wr, int wc, int fr, int fq) const {
        EPI_LOOP_BEGIN
            const int row = u.pm * 256 + rl, col = u.pn * 256 + cl;
            const f32x4 b0 = *(const f32x4*)(b_glu + col), b1 = *(const f32x4*)(b_glu + col + 4);
            f32x4 g0, g1; unpack8(*(const u32x4*)(Gact + (size_t)row * DS + col), g0, g1);
            f32x4 y0, y1;
#pragma unroll
            for (int e = 0; e < 4; ++e) { y0[e] = g0[e] * fast_sigmoid(a0[e] + b0[e]); y1[e] = g1[e] * fast_sigmoid(a1[e] + b1[e]); }
            *(u32x4*)(Yssm + (size_t)row * DS + col) = pack8(y0, y1);
        EPI_LOOP_END
    }
};
template <bool SECOND> struct EpiUp {
    const bf16_t* SG; bf16_t* Mrg;
    __device__ __forceinline__ void operator()(AccRef acc, const pg8::Unit& u, int wr, int wc, int fr, int fq) const {
        EPI_LOOP_BEGIN
            const size_t off = (size_t)(u.pm * 256 + rl) * D + u.pn * 256 + cl;
            f32x4 s0, s1; unpack8(*(const u32x4*)(SG + off), s0, s1);
            f32x4 y0 = s0 * a0, y1 = s1 * a1;
            if (SECOND) { f32x4 p0, p1; unpack8(*(const u32x4*)(Mrg + off), p0, p1); y0 += p0; y1 += p1; }
            *(u32x4*)(Mrg + off) = pack8(y0, y1);
        EPI_LOOP_END
    }
};
struct EpiOut {
    const float* x; float* X1; bf16_t* XG; const float* g2; float* SSQ;
    __device__ __forceinline__ void operator()(AccRef acc, const pg8::Unit& u, int wr, int wc, int fr, int fq) const {
#pragma unroll
        for (int ai = 0; ai < 2; ++ai)
#pragma unroll
            for (int m = 0; m < 4; ++m) { const int row = u.pm * 256 + ai * 128 + wr * 64 + m * 16 + fr; float ss = 0.f;
#pragma unroll
                for (int bj = 0; bj < 2; ++bj) { const int col = u.pn * 256 + bj * 128 + wc * 32 + 8 * fq; const size_t off = (size_t)row * D + col;
                    const f32x4 x0 = *(const f32x4*)(x + off) + acc[ai][bj][m][0], x1 = *(const f32x4*)(x + off + 4) + acc[ai][bj][m][1];
                    *(f32x4*)(X1 + off) = x0; *(f32x4*)(X1 + off + 4) = x1;
                    ss += (x0[0] * x0[0] + x0[1] * x0[1]) + (x0[2] * x0[2] + x0[3] * x0[3]) + (x1[0] * x1[0] + x1[1] * x1[1]) + (x1[2] * x1[2] + x1[3] * x1[3]);
                    const f32x4 w0 = *(const f32x4*)(g2 + col), w1 = *(const f32x4*)(g2 + col + 4);
                    *(u32x4*)(XG + off) = pack8(x0 * w0, x1 * w1); }
                ss += __shfl_xor(ss, 16); ss += __shfl_xor(ss, 32);
                if (fq == 0) SSQ[(size_t)row * 16 + u.pn * 4 + wc] = ss; }
    }
};
struct EpiRouter {
    float* Rlog;
    __device__ __forceinline__ void operator()(AccRef acc, const pg8::Unit& u, int wr, int wc, int fr, int fq) const {
        EPI_LOOP_BEGIN
            if (bj == 0 && cl < 72) { float* dst = Rlog + (size_t)(u.pm * 256 + rl) * 72 + cl; *(f32x4*)dst = a0; *(f32x4*)(dst + 4) = a1; }
        EPI_LOOP_END
    }
};
struct EpiMoe1 {
    bf16_t* Hid; const float* rowrstd; const unsigned* ecnt;
    __device__ __forceinline__ void operator()(AccRef acc, const pg8::Unit& u, int wr, int wc, int fr, int fq) const {
        const int e = u.aux, cnt = (int)ecnt[e];
#pragma unroll
        for (int ai = 0; ai < 2; ++ai)
#pragma unroll
            for (int m = 0; m < 4; ++m) { const int rl = ai * 128 + wr * 64 + m * 16 + fr; const int pos = u.aux2 + rl;
                if (pos < cnt) { const float rs = rowrstd[(size_t)e * ROWCAP + pos];
                    f32x4 h0, h1;
#pragma unroll
                    for (int k = 0; k < 4; ++k) { const float p = acc[ai][0][m][0][k] * rs, q = acc[ai][1][m][0][k] * rs; h0[k] = p * fast_sigmoid(p) * q;
                        const float p2 = acc[ai][0][m][1][k] * rs, q2 = acc[ai][1][m][1][k] * rs; h1[k] = p2 * fast_sigmoid(p2) * q2; }
                    *(u32x4*)(Hid + (size_t)(u.pm * 256 + rl) * DE + u.pn * 128 + wc * 32 + 8 * fq) = pack8(h0, h1); } }
    }
};
struct EpiMoe2 {
    bf16_t* Y0; size_t ydelta; const unsigned* rowtok; const float* rowcoef; const unsigned* ecnt;
    __device__ __forceinline__ void operator()(AccRef acc, const pg8::Unit& u, int wr, int wc, int fr, int fq) const {
        const int e = u.aux, cnt = (int)ecnt[e];
#pragma unroll
        for (int ai = 0; ai < 2; ++ai)
#pragma unroll
            for (int m = 0; m < 4; ++m) { const int rl = ai * 128 + wr * 64 + m * 16 + fr; const int pos = u.aux2 + rl;
                if (pos < cnt) { const unsigned tk = rowtok[(size_t)e * ROWCAP + pos]; const float cf = rowcoef[(size_t)e * ROWCAP + pos];
                    bf16_t* dst = (bf16_t*)((unsigned char*)Y0 + (size_t)(tk & 1u) * ydelta) + (size_t)(tk >> 1) * D + u.pn * 256 + wc * 32 + 8 * fq;
#pragma unroll
                    for (int bj = 0; bj < 2; ++bj) *(u32x4*)(dst + bj * 128) = pack8(acc[ai][bj][m][0] * cf, acc[ai][bj][m][1] * cf); } }
    }
};
__device__ __forceinline__ void transpose_item(const float* W, int N, int k0, int n0, bf16_t* WT, size_t drow0, int ldo, LAS float* scr, int lane) {
    float tv[32];
#pragma unroll
    for (int i = 0; i < 32; ++i) tv[i] = W[(size_t)(k0 + 2 * i + (lane >> 5)) * N + n0 + (lane & 31)];
#pragma unroll
    for (int i = 0; i < 32; ++i) scr[(2 * i + (lane >> 5)) * 33 + (lane & 31)] = tv[i];
    LDS_WAIT(); asm volatile("" ::: "memory");
    const int c = lane & 7;
#pragma unroll
    for (int j = 0; j < 4; ++j) { const int n = (lane >> 3) + 8 * j; const LAS float* s = scr + (8 * c) * 33 + n;
        u32x4 o; o.x = pk2(s[0 * 33], s[1 * 33]); o.y = pk2(s[2 * 33], s[3 * 33]); o.z = pk2(s[4 * 33], s[5 * 33]); o.w = pk2(s[6 * 33], s[7 * 33]);
        *(u32x4*)(WT + (drow0 + n) * (size_t)ldo + k0 + 8 * c) = o; }
    LDS_WAIT(); asm volatile("" ::: "memory");
}
__device__ __forceinline__ unsigned pk4_fp8(float a, float b, float c, float d) { int w = 0; w = __builtin_amdgcn_cvt_pk_fp8_f32(a, b, w, false); w = __builtin_amdgcn_cvt_pk_fp8_f32(c, d, w, true); return (unsigned)w; }
__device__ __forceinline__ void transpose_item_f8(const float* W, int N, int k0, int n0, unsigned char* WT8, size_t drow0, int ldo, float scale, LAS float* scr, int lane) {
    float tv[32];
#pragma unroll
    for (int i = 0; i < 32; ++i) tv[i] = W[(size_t)(k0 + 2 * i + (lane >> 5)) * N + n0 + (lane & 31)];
#pragma unroll
    for (int i = 0; i < 32; ++i) scr[(2 * i + (lane >> 5)) * 33 + (lane & 31)] = tv[i] * scale;
    LDS_WAIT(); asm volatile("" ::: "memory");
    const int c = lane & 3;
#pragma unroll
    for (int j = 0; j < 2; ++j) { const int n = (lane >> 2) + 16 * j; const LAS float* s = scr + (16 * c) * 33 + n;
        u32x4 o; o.x = pk4_fp8(s[0 * 33], s[1 * 33], s[2 * 33], s[3 * 33]); o.y = pk4_fp8(s[4 * 33], s[5 * 33], s[6 * 33], s[7 * 33]);
        o.z = pk4_fp8(s[8 * 33], s[9 * 33], s[10 * 33], s[11 * 33]); o.w = pk4_fp8(s[12 * 33], s[13 * 33], s[14 * 33], s[15 * 33]);
        *(u32x4*)(WT8 + (drow0 + n) * (size_t)ldo + k0 + 16 * c) = o; }
    LDS_WAIT(); asm volatile("" ::: "memory");
}
template <int NR> __device__ __forceinline__ void rms_rows_to_bf16(int lane, const float* xrow, const float* g, bf16_t* orow, unsigned char* orow8) {
    f32x4 v[NR][4]; float s[NR];
#pragma unroll
    for (int r = 0; r < NR; ++r) { const f32x4* xr = (const f32x4*)(xrow + (size_t)r * D) + lane;
#pragma unroll
        for (int j = 0; j < 4; ++j) v[r][j] = xr[64 * j]; }
    const f32x4* gr = (const f32x4*)g + lane; f32x4 wv[4];
#pragma unroll
    for (int j = 0; j < 4; ++j) wv[j] = gr[64 * j];
#pragma unroll
    for (int r = 0; r < NR; ++r) { float a = 0.f;
#pragma unroll
        for (int j = 0; j < 4; ++j) a += (v[r][j].x * v[r][j].x + v[r][j].y * v[r][j].y) + (v[r][j].z * v[r][j].z + v[r][j].w * v[r][j].w);
        s[r] = a; }
#pragma unroll
    for (int o = 1; o < 64; o <<= 1) {
#pragma unroll
        for (int r = 0; r < NR; ++r) s[r] += __shfl_xor(s[r], o); }
#pragma unroll
    for (int r = 0; r < NR; ++r) { const float rstd = 1.f / sqrtf(s[r] * (1.f / D) + RMS_EPS); unsigned long long* o8 = (unsigned long long*)(orow + (size_t)r * D) + lane;
#pragma unroll
        for (int j = 0; j < 4; ++j) { const float y0 = v[r][j].x * rstd * wv[j].x, y1 = v[r][j].y * rstd * wv[j].y, y2 = v[r][j].z * rstd * wv[j].z, y3 = v[r][j].w * rstd * wv[j].w;
            o8[64 * j] = (unsigned long long)pk2(y0, y1) | ((unsigned long long)pk2(y2, y3) << 32);
            ((unsigned*)(orow8 + (size_t)r * D))[lane + 64 * j] = pk4_fp8(y0, y1, y2, y3); } }
}
__device__ __forceinline__ void cpow(float lr, float li, float step, float dl, float& ar, float& ai) {
    const float mag = __expf(dl * lr * step); const float rev = dl * (li * step * 0.15915494309189535f); const float fr = rev - floorf(rev);
    ar = mag * __builtin_amdgcn_cosf(fr); ai = mag * __builtin_amdgcn_sinf(fr);
}
__device__ __forceinline__ void ssm_gen(Frame& F, int g, int sl) {
    LAS float* AP = (LAS float*)(F.lds); LAS float* BB = AP + 33 * 64 * 2; LAS float* CC = BB + 2048; LAS float* KT = CC + 2048;
    const float* lam_re = F.in[4] + g * SP; const float* lam_im = F.in[5] + g * SP; const float step = __expf(F.in[6][g]);
    const float* b_re = F.in[7] + g * SP * SHC; const float* b_im = F.in[8] + g * SP * SHC; const float* c_re = F.in[9] + g * SHC * SP; const float* c_im = F.in[10] + g * SHC * SP; const float* dd = F.in[11] + g * SHC;
    bf16_t* BT = (bf16_t*)(F.ws + WS_SSMT) + (size_t)g * 512 * SKY; bf16_t* BW = (bf16_t*)(F.ws + WS_SSMW) + (size_t)g * 256 * SKU;
    const int tid = F.tid;
    for (int idx = tid; idx < 33 * 64; idx += NTHR) { const int dl = idx >> 6, p = idx & 63; float ar, ai; cpow(lam_re[p], lam_im[p], step, (float)dl, ar, ai); AP[idx * 2] = ar; AP[idx * 2 + 1] = ai; }
    for (int idx = tid; idx < 1024; idx += NTHR) { const int ho = idx >> 6, p = idx & 63; CC[idx * 2] = c_re[ho * 64 + p]; CC[idx * 2 + 1] = c_im[ho * 64 + p]; }
    __syncthreads();
    for (int idx = tid; idx < 1024; idx += NTHR) { const int p = idx >> 4, h = idx & 15; const float ar = AP[(64 + p) * 2], ai = AP[(64 + p) * 2 + 1];
        const float lr = lam_re[p], li = lam_im[p], nr = ar - 1.f, ni = ai, den = lr * lr + li * li, cr = (nr * lr + ni * li) / den, ci = (ni * lr - nr * li) / den;
        const float br = b_re[p * 16 + h], bi = b_im[p * 16 + h]; BB[idx * 2] = cr * br - ci * bi; BB[idx * 2 + 1] = cr * bi + ci * br; }
    __syncthreads();
    for (int idx = tid; idx < 1024; idx += NTHR) { const int dl = idx >> 5, hl = (idx >> 4) & 1, hi = idx & 15, ho = 2 * sl + hl; float s = 0.f;
        for (int p = 0; p < 64; ++p) { const float ar = AP[(dl * 64 + p) * 2], ai = AP[(dl * 64 + p) * 2 + 1], br = BB[(p * 16 + hi) * 2], bi = BB[(p * 16 + hi) * 2 + 1];
            const float zr = ar * br - ai * bi, zi = ar * bi + ai * br; s += CC[(ho * 64 + p) * 2] * zr - CC[(ho * 64 + p) * 2 + 1] * zi; }
        if (dl == 0 && ho == hi) s += dd[ho];
        KT[idx] = s; }
    __syncthreads();
    for (int v = tid; v < 64 * 80; v += NTHR) { const int nl = v / 80, kv = (v % 80) * 8, tau = nl >> 1, hl = nl & 1, ho = 2 * sl + hl, n = tau * 16 + ho; float val[8];
        if (kv < 512) { const int sg = kv >> 4, hi0 = kv & 15;
#pragma unroll
            for (int e = 0; e < 8; ++e) val[e] = (tau >= sg) ? KT[((tau - sg) * 2 + hl) * 16 + hi0 + e] : 0.f; }
        else { const int kk = kv - 512;
#pragma unroll
            for (int e = 0; e < 8; ++e) { const int p = (kk + e) >> 1, ri = (kk + e) & 1; const float ar = AP[((tau + 1) * 64 + p) * 2], ai = AP[((tau + 1) * 64 + p) * 2 + 1], cre = CC[(ho * 64 + p) * 2], cim = CC[(ho * 64 + p) * 2 + 1];
                val[e] = ri == 0 ? (cre * ar - cim * ai) : -(cre * ai + cim * ar); } }
        u32x4 o; o.x = pk2(val[0], val[1]); o.y = pk2(val[2], val[3]); o.z = pk2(val[4], val[5]); o.w = pk2(val[6], val[7]);
        *(u32x4*)(BT + (size_t)n * SKY + kv) = o; }
    for (int v = tid; v < 32 * 64; v += NTHR) { const int nl = v >> 6, kv = (v & 63) * 8; float val[8];
        const bool real = nl < 16; const int n = real ? 16 * sl + nl : 128 + 16 * sl + (nl - 16);
        if (real) { const int p = n >> 1, ri = n & 1, sg = kv >> 4, hi0 = kv & 15; const float ar = AP[((31 - sg) * 64 + p) * 2], ai = AP[((31 - sg) * 64 + p) * 2 + 1];
#pragma unroll
            for (int e = 0; e < 8; ++e) { const float br = BB[(p * 16 + hi0 + e) * 2], bi = BB[(p * 16 + hi0 + e) * 2 + 1]; val[e] = ri == 0 ? (ar * br - ai * bi) : (ar * bi + ai * br); } }
        else {
#pragma unroll
            for (int e = 0; e < 8; ++e) val[e] = 0.f; }
        u32x4 o; o.x = pk2(val[0], val[1]); o.y = pk2(val[2], val[3]); o.z = pk2(val[4], val[5]); o.w = pk2(val[6], val[7]);
        *(u32x4*)(BW + (size_t)n * SKU + kv) = o; }
    __syncthreads();
}
__device__ __forceinline__ void p0_prologue(Frame& F) {
    for (int it = F.vcu; it < SG * 8; it += F.G) ssm_gen(F, it >> 3, it & 7);
    LAS float* scr = (LAS float*)(F.lds + F.wave * 16384);
    const int gw = F.vcu * NWAVES + F.wave, NGW = F.G * NWAVES, lane = F.lane;
    constexpr int I_IN = 16 * 128, I_GLU = 8 * 16, I_US = 8 * 32, I_UA = 8 * 32, I_OUT = 16 * 32, I_W1 = 32 * 256, I_W3 = 32 * 256, I_W2 = 32 * 256;
    constexpr int NITEMS = I_IN + I_GLU + I_US + I_UA + I_OUT + I_W1 + I_W3 + I_W2;
    unsigned char* ws = F.ws;
    for (int it = gw; it < NITEMS; it += NGW) {
        int r = it;
        if (r < I_IN) { const int k0 = 64 * (r / 128), n0 = 32 * (r % 128);
            if (n0 < DS) transpose_item(F.in[2], DIN, k0, n0, (bf16_t*)(ws + WS_WIN), n0, D, scr, lane);
            else transpose_item_f8(F.in[2], DIN, k0, n0, ws + WS_WINF8, n0 - DS, D, WF8_SCALE, scr, lane);
            continue; } r -= I_IN;
        if (r < I_GLU) { transpose_item(F.in[12], DS, 64 * (r / 16), 32 * (r % 16), (bf16_t*)(ws + WS_WGLU), 32 * (r % 16), DS, scr, lane); continue; } r -= I_GLU;
        if (r < I_US) { transpose_item(F.in[14], D, 64 * (r / 32), 32 * (r % 32), (bf16_t*)(ws + WS_WUS), 32 * (r % 32), DS, scr, lane); continue; } r -= I_US;
        if (r < I_UA) { transpose_item(F.in[15], D, 64 * (r / 32), 32 * (r % 32), (bf16_t*)(ws + WS_WUA), 32 * (r % 32), DA, scr, lane); continue; } r -= I_UA;
        if (r < I_OUT) { transpose_item(F.in[17], D, 64 * (r / 32), 32 * (r % 32), (bf16_t*)(ws + WS_WOUT), 32 * (r % 32), D, scr, lane); continue; } r -= I_OUT;
        if (r < I_W1 + I_W3) { const int w3 = r >= I_W1; if (w3) r -= I_W1; const int e = r >> 8, q = r & 255, k0 = 64 * (q / 16), n0 = 32 * (q % 16);
            transpose_item((w3 ? F.in[24] : F.in[23]) + (size_t)e * D * DE, DE, k0, n0, (bf16_t*)(ws + WS_W13), (size_t)e * 1024 + 256 * (n0 >> 7) + (n0 & 127) + (w3 ? 128 : 0), D, scr, lane); continue; }
        r -= I_W1 + I_W3;
        { const int e = r >> 8, q = r & 255, k0 = 64 * (q / 32), n0 = 32 * (q % 32);
            transpose_item(F.in[25] + (size_t)e * DE * D, D, k0, n0, (bf16_t*)(ws + WS_W2), (size_t)e * 1024 + n0, DE, scr, lane); }
    }
    for (int m = 4 * gw; m < T; m += 4 * NGW) rms_rows_to_bf16<4>(lane, F.in[0] + (size_t)m * D, F.in[1], (bf16_t*)(ws + WS_H1) + (size_t)m * D, ws + WS_H1F8 + (size_t)m * D);
    { bf16_t* WR = (bf16_t*)(ws + WS_WR); const float* wrg = F.in[19]; const float* wre = F.in[21];
      for (int idx = F.vcu * NTHR + F.tid; idx < 256 * D; idx += F.G * NTHR) { const int r = idx >> 10, k = idx & 1023; unsigned o = 0u;
          if (r < 72) { const int c = r < 36 ? r : r - 36; const float w = c < 4 ? wrg[k * 4 + c] : wre[k * 32 + (c - 4)]; const unsigned hb = f2bf(w);
              o = r < 36 ? hb : f2bf(w - __builtin_bit_cast(float, hb << 16)); }
          WR[idx] = (bf16_t)o; } }
}

__device__ __forceinline__ int crow(int r, int hi) { return (r & 3) + 8 * (r >> 2) + 4 * hi; }
constexpr int KVP = 72;
__device__ __forceinline__ void kv_prep_phase(Frame& F) {
    LAS bf16_t* KS = (LAS bf16_t*)(F.lds); LAS bf16_t* VS = KS + 256 * KVP; LAS float* PS = (LAS float*)(F.lds + 2 * 256 * KVP * 2); LAS float* WM = PS + 512;
    const bf16_t* Kb = (const bf16_t*)(F.ws + WS_K); const bf16_t* Vb = (const bf16_t*)(F.ws + WS_V);
    bf16_t* Kf = (bf16_t*)(F.ws + WS_KFRAG); bf16_t* Vf = (bf16_t*)(F.ws + WS_VFRAG); bf16_t* KM = (bf16_t*)(F.ws + WS_KMEAN); float* KN = (float*)(F.ws + WS_KMEAN + 512 * 1024);
    const int tid = F.tid;
    for (int item = F.vcu; item < BATCH * NH * NBLK; item += F.G) {
        const int n = item & 31, h = (item >> 5) & 7, b = item >> 8; const size_t tok0 = (size_t)b * SEQ + 256 * n;
#pragma unroll
        for (int j = 0; j < 4; ++j) { const int q = tid + NTHR * j, row = q >> 3, pc = q & 7; const size_t src = (tok0 + row) * DA + h * HD + pc * 8;
            *(LAS u32x4*)(KS + row * KVP + pc * 8) = *(const u32x4*)(Kb + src); *(LAS u32x4*)(VS + row * KVP + pc * 8) = *(const u32x4*)(Vb + src); }
        __syncthreads();
#pragma unroll
        for (int j = 0; j < 4; ++j) { const int P = tid + NTHR * j, st = P >> 8, ds = (P >> 6) & 3, l2 = P & 63, row = 32 * st + (l2 & 31), col = 16 * ds + 8 * (l2 >> 5);
            *(u32x4*)(Kf + ((size_t)item * 2048 + P) * 8) = *(const LAS u32x4*)(KS + row * KVP + col); }
#pragma unroll
        for (int j = 0; j < 4; ++j) { const int P = tid + NTHR * j, st = P >> 8, ks = (P >> 7) & 1, d0 = (P >> 6) & 1, l2 = P & 63, hi = l2 >> 5, jj = l2 & 31; unsigned w[4];
#pragma unroll
            for (int e = 0; e < 8; e += 2) { const unsigned lo = VS[(32 * st + 16 * ks + crow(e, hi)) * KVP + 32 * d0 + jj], hi16 = VS[(32 * st + 16 * ks + crow(e + 1, hi)) * KVP + 32 * d0 + jj]; w[e >> 1] = lo | (hi16 << 16); }
            *(u32x4*)(Vf + ((size_t)item * 2048 + P) * 8) = (u32x4){w[0], w[1], w[2], w[3]}; }
        { const int d = tid & 63, part = tid >> 6; float s = 0.f;
#pragma unroll 8
          for (int r = 0; r < 32; ++r) s += bf2f(KS[(part * 32 + r) * KVP + d]);
          PS[part * 64 + d] = s; }
        if (tid < 256) { float ss = 0.f;
#pragma unroll
            for (int c = 0; c < 8; ++c) { const u32x4 w = *(const LAS u32x4*)(KS + tid * KVP + c * 8);
                ss += bflo(w.x) * bflo(w.x) + bfhi(w.x) * bfhi(w.x) + bflo(w.y) * bflo(w.y) + bfhi(w.y) * bfhi(w.y) + bflo(w.z) * bflo(w.z) + bfhi(w.z) * bfhi(w.z) + bflo(w.w) * bflo(w.w) + bfhi(w.w) * bfhi(w.w); }
            ss = wave_max(ss); if (F.lane == 0) WM[F.wave] = ss; }
        __syncthreads();
        if (tid < 64) { float s = 0.f;
#pragma unroll
            for (int p = 0; p < 8; ++p) s += PS[p * 64 + tid];
            KM[(size_t)item * 64 + tid] = (bf16_t)f2bf(s * (1.f / 256.f)); }
        if (tid == 0) KN[item] = fmaxf(fmaxf(WM[0], WM[1]), fmaxf(WM[2], WM[3]));
        __syncthreads();
    }
}

__device__ __forceinline__ void ssm_scan_phase(Frame& F) {
    LAS float* FW = (LAS float*)(F.lds);
    const float* E = (const float*)(F.ws + WS_E); bf16_t* UP = (bf16_t*)(F.ws + WS_UP);
    const int w = F.wave, p = F.lane;
    for (int gb = F.vcu; gb < SG * BATCH; gb += F.G) {
        const int g = gb >> 3, b = gb & 7;
        const float lr = F.in[4][g * SP + p], li = F.in[5][g * SP + p], step = __expf(F.in[6][g]);
        float ar, ai; cpow(lr, li, step, 32.f, ar, ai);
        const size_t row0 = (size_t)g * SROWS + b * 256 + 32 * w;
        f32x2 e[32];
#pragma unroll
        for (int j = 0; j < 32; ++j) e[j] = *(const f32x2*)(E + (row0 + j) * 128 + 2 * p);
        float sr = 0.f, si = 0.f;
#pragma unroll
        for (int j = 0; j < 32; ++j) { const float nr = ar * sr - ai * si + e[j].x, ni = ar * si + ai * sr + e[j].y; sr = nr; si = ni; }
        FW[(w * 64 + p) * 2] = sr; FW[(w * 64 + p) * 2 + 1] = si;
        __syncthreads();
        float Ar = ar, Ai = ai;
#pragma unroll
        for (int q = 0; q < 5; ++q) { const float nr = Ar * Ar - Ai * Ai, ni = 2.f * Ar * Ai; Ar = nr; Ai = ni; }
        sr = 0.f; si = 0.f;
        for (int w2 = 0; w2 < w; ++w2) { const float fr = FW[(w2 * 64 + p) * 2], fi = FW[(w2 * 64 + p) * 2 + 1]; const float nr = Ar * sr - Ai * si + fr, ni = Ar * si + Ai * sr + fi; sr = nr; si = ni; }
#pragma unroll
        for (int j = 0; j < 32; ++j) { *(unsigned*)(UP + (row0 + j) * SKY + SKU + 2 * p) = pk2(sr, si);
            const float nr = ar * sr - ai * si + e[j].x, ni = ar * si + ai * sr + e[j].y; sr = nr; si = ni; }
        __syncthreads();
    }
}

__device__ __forceinline__ int t5_bucket(int d) {
    if (d < 16) return d;
    return 16 + (d >= 19) + (d >= 21) + (d >= 24) + (d >= 27) + (d >= 31) + (d >= 35) + (d >= 40) + (d >= 46) + (d >= 52) + (d >= 59) + (d >= 67) + (d >= 77) + (d >= 87) + (d >= 99) + (d >= 113);
}
struct Top3 { float v0, v1, v2; int i0, i1, i2; };
__device__ __forceinline__ Top3 top3_insert(Top3 t, float x, int n) {
    const bool b0 = (x > t.v0) || (x == t.v0 && n < t.i0), b1 = (x > t.v1) || (x == t.v1 && n < t.i1), b2 = (x > t.v2) || (x == t.v2 && n < t.i2);
    Top3 r;
    r.v2 = b1 ? t.v1 : (b2 ? x : t.v2); r.i2 = b1 ? t.i1 : (b2 ? n : t.i2);
    r.v1 = b0 ? t.v0 : (b1 ? x : t.v1); r.i1 = b0 ? t.i0 : (b1 ? n : t.i1);
    r.v0 = b0 ? x : t.v0; r.i0 = b0 ? n : t.i0;
    return r;
}
constexpr int GQS = 0, GKME = 36864, GCNTL = 41472, GMISC = 41600;
template <bool COUNT> __device__ __forceinline__ void attn_gate_unit(Frame& F, int bh, int qb) {
    LAS unsigned char* L = F.lds;
    LAS bf16_t* QS = (LAS bf16_t*)(L + GQS); LAS bf16_t* KME = (LAS bf16_t*)(L + GKME); LAS int* CNT = (LAS int*)(L + GCNTL); LAS float* KNM = (LAS float*)(L + GMISC);
    int tid = F.tid; asm volatile("" : "+v"(tid));
    const int lane = tid & 63, w = F.wave, j = lane & 31, hi = lane >> 5;
    const int b = bh >> 3, h = bh & 7; const size_t tok0 = (size_t)b * SEQ + 256 * qb;
    const bf16_t* Qb = (const bf16_t*)(F.ws + WS_Q); const bf16_t* KM = (const bf16_t*)(F.ws + WS_KMEAN); const float* KN = (const float*)(F.ws + WS_KMEAN + 512 * 1024);
    float* MQg = (float*)(F.ws + WS_MQ); unsigned short* QL = (unsigned short*)(F.ws + WS_QLIST); unsigned* GC = (unsigned*)(F.ctl + CW_GCNT); unsigned* SEGC = (unsigned*)(F.ws + WS_SEGC);
#pragma unroll
    for (int jj = 0; jj < 4; ++jj) { const int q = tid + NTHR * jj, row = q >> 3, pc = q & 7; *(LAS u32x4*)(QS + row * KVP + pc * 8) = *(const u32x4*)(Qb + (tok0 + row) * DA + h * HD + pc * 8); }
    if (tid < 256) { const int n = tid >> 3, pc = tid & 7; *(LAS u32x4*)(KME + n * KVP + pc * 8) = *(const u32x4*)(KM + ((size_t)bh * 32 + n) * 64 + pc * 8); }
    if (tid < 32) CNT[tid] = 0;
    if (w == 1) { float v = (lane <= qb && lane < 32) ? KN[bh * 32 + lane] : 0.f; v = wave_max(v); if (lane == 0) KNM[0] = v; }
    if (w == 2) { float v = F.in[16][h * 32 + (lane & 31)]; v = wave_max(v); if (lane == 0) KNM[1] = v * LOG2E; }
    __syncthreads();
    {
        bf16x8 qf[4], kmf[4];
#pragma unroll
        for (int ds = 0; ds < 4; ++ds) { qf[ds] = *(const LAS bf16x8*)(QS + (32 * w + j) * KVP + 16 * ds + 8 * hi); kmf[ds] = *(const LAS bf16x8*)(KME + j * KVP + 16 * ds + 8 * hi); }
        f32x16 gt = {};
#pragma unroll
        for (int ds = 0; ds < 4; ++ds) gt = __builtin_amdgcn_mfma_f32_32x32x16_bf16(kmf[ds], qf[ds], gt, 0, 0, 0);
        float qn = 0.f;
#pragma unroll
        for (int ds = 0; ds < 4; ++ds)
#pragma unroll
            for (int e = 0; e < 8; ++e) { const float x = bf2f((unsigned short)qf[ds][e]); qn += x * x; }
        qn += __shfl_xor(qn, 32);
        const float m2 = sqrtf(qn * KNM[0]) + KNM[1];
        const int ql = 256 * qb + 32 * w + j;
        if (hi == 0) MQg[(size_t)bh * SEQ + ql] = m2;
        Top3 t3; t3.v0 = t3.v1 = t3.v2 = -INFINITY; t3.i0 = t3.i1 = t3.i2 = -1;
#pragma unroll
        for (int r = 0; r < 16; ++r) { const int n = crow(r, hi); const float x = (n < qb) ? gt[r] : -INFINITY; t3 = top3_insert(t3, x, x > -INFINITY ? n : 0x7fffffff); }
        { const float p0 = __shfl_xor(t3.v0, 32), p1 = __shfl_xor(t3.v1, 32), p2 = __shfl_xor(t3.v2, 32); const int q0 = __shfl_xor(t3.i0, 32), q1 = __shfl_xor(t3.i1, 32), q2 = __shfl_xor(t3.i2, 32);
          t3 = top3_insert(t3, p0, q0 >= 0 ? q0 : 0x7fffffff); t3 = top3_insert(t3, p1, q1 >= 0 ? q1 : 0x7fffffff); t3 = top3_insert(t3, p2, q2 >= 0 ? q2 : 0x7fffffff); }
        const int i0 = t3.v0 > -INFINITY ? t3.i0 : -1, i1 = t3.v1 > -INFINITY ? t3.i1 : -1, i2 = t3.v2 > -INFINITY ? t3.i2 : -1;
        if (hi == 0) { const unsigned e = (unsigned)ql << 2;
            if (i0 >= 0) { const int pos = __hip_atomic_fetch_add(CNT + i0, 1, __ATOMIC_RELAXED, __HIP_MEMORY_SCOPE_WORKGROUP); QL[((size_t)bh * 32 + i0) * SEQ + (qb - i0 - 1) * 256 + pos] = (unsigned short)(e | 0u); }
            if (i1 >= 0) { const int pos = __hip_atomic_fetch_add(CNT + i1, 1, __ATOMIC_RELAXED, __HIP_MEMORY_SCOPE_WORKGROUP); QL[((size_t)bh * 32 + i1) * SEQ + (qb - i1 - 1) * 256 + pos] = (unsigned short)(e | 1u); }
            if (i2 >= 0) { const int pos = __hip_atomic_fetch_add(CNT + i2, 1, __ATOMIC_RELAXED, __HIP_MEMORY_SCOPE_WORKGROUP); QL[((size_t)bh * 32 + i2) * SEQ + (qb - i2 - 1) * 256 + pos] = (unsigned short)(e | 2u); } }
    }
    __syncthreads();
    if (tid < qb) { const unsigned c = (unsigned)CNT[tid]; SEGC[((size_t)bh * 32 + tid) * 32 + (qb - tid - 1)] = c; if (COUNT && c) (void)__hip_atomic_fetch_add(GC + bh * 32 + tid, c, __ATOMIC_RELAXED, __HIP_MEMORY_SCOPE_AGENT); }
    __syncthreads();
}
template <bool COUNT> __device__ __forceinline__ void attn_gate_phase(Frame& F) {
    for (int u = F.vcu; u < BATCH * NH * NBLK; u += F.G) attn_gate_unit<COUNT>(F, u >> 5, u & 31);
}

#define ATTN_SUBTILE(KP, VP, st_, NEARM) do { \
        bf16x8 kf_[4], vf_[4]; \
        _Pragma("unroll") for (int ds_ = 0; ds_ < 4; ++ds_) kf_[ds_] = *(const LAS bf16x8*)((KP) + ((st_) * 4 + ds_) * 512 + lane8); \
        _Pragma("unroll") for (int q_ = 0; q_ < 4; ++q_) vf_[q_] = *(const LAS bf16x8*)((VP) + ((st_) * 4 + q_) * 512 + lane8); \
        f32x16 s_ = {}; \
        _Pragma("unroll") for (int ds_ = 0; ds_ < 4; ++ds_) s_ = __builtin_amdgcn_mfma_f32_32x32x16_bf16(kf_[ds_], qf[ds_], s_, 0, 0, 0); \
        float p_[16]; \
        if (!(NEARM)) { _Pragma("unroll") for (int r_ = 0; r_ < 16; ++r_) p_[r_] = __builtin_amdgcn_exp2f(s_[r_] - mfar); } \
        else { _Pragma("unroll") for (int r_ = 0; r_ < 16; ++r_) { const int dist_ = dq - (32 * (st_) + crow(r_, hi)); const int di_ = dist_ < 0 ? 0 : (dist_ > 127 ? 127 : dist_); \
                const float e_ = __builtin_amdgcn_exp2f(s_[r_] + TABh[di_] - m2); p_[r_] = dist_ >= 0 ? e_ : 0.f; } } \
        _Pragma("unroll") for (int r_ = 0; r_ < 16; ++r_) lsum += p_[r_]; \
        u32x4 pa_, pb_; pa_.x = cvt_pk_bf16(p_[0], p_[1]); pa_.y = cvt_pk_bf16(p_[2], p_[3]); pa_.z = cvt_pk_bf16(p_[4], p_[5]); pa_.w = cvt_pk_bf16(p_[6], p_[7]); \
        pb_.x = cvt_pk_bf16(p_[8], p_[9]); pb_.y = cvt_pk_bf16(p_[10], p_[11]); pb_.z = cvt_pk_bf16(p_[12], p_[13]); pb_.w = cvt_pk_bf16(p_[14], p_[15]); \
        const bf16x8 A0_ = __builtin_bit_cast(bf16x8, pa_), A1_ = __builtin_bit_cast(bf16x8, pb_); \
        o0 = __builtin_amdgcn_mfma_f32_32x32x16_bf16(vf_[0], A0_, o0, 0, 0, 0); o1 = __builtin_amdgcn_mfma_f32_32x32x16_bf16(vf_[1], A0_, o1, 0, 0, 0); \
        o0 = __builtin_amdgcn_mfma_f32_32x32x16_bf16(vf_[2], A1_, o0, 0, 0, 0); o1 = __builtin_amdgcn_mfma_f32_32x32x16_bf16(vf_[3], A1_, o1, 0, 0, 0); } while (0)

__device__ __forceinline__ u32x4 ot_pack16(const f32x16& o, int pr) {
    const unsigned p0 = cvt_pk_bf16(o[8 * pr], o[8 * pr + 1]), p1 = cvt_pk_bf16(o[8 * pr + 2], o[8 * pr + 3]), q0 = cvt_pk_bf16(o[8 * pr + 4], o[8 * pr + 5]), q1 = cvt_pk_bf16(o[8 * pr + 6], o[8 * pr + 7]);
    const auto r0 = __builtin_amdgcn_permlane32_swap(p0, q0, false, false); const auto r1 = __builtin_amdgcn_permlane32_swap(p1, q1, false, false);
    return (u32x4){r0[0], r1[0], r0[1], r1[1]};
}
__device__ __forceinline__ void ot_add16(f32x16& o, int pr, u32x4 v, bool use) {
    const auto r0 = __builtin_amdgcn_permlane32_swap(v.x, v.z, false, false); const auto r1 = __builtin_amdgcn_permlane32_swap(v.y, v.w, false, false);
    const unsigned p0 = r0[0], p1 = r1[0], q0 = r0[1], q1 = r1[1];
    o[8 * pr] += use ? bflo(p0) : 0.f; o[8 * pr + 1] += use ? bfhi(p0) : 0.f; o[8 * pr + 2] += use ? bflo(p1) : 0.f; o[8 * pr + 3] += use ? bfhi(p1) : 0.f;
    o[8 * pr + 4] += use ? bflo(q0) : 0.f; o[8 * pr + 5] += use ? bfhi(q0) : 0.f; o[8 * pr + 6] += use ? bflo(q1) : 0.f; o[8 * pr + 7] += use ? bfhi(q1) : 0.f;
}
__device__ __forceinline__ void attn_fill_tab(Frame& F, LAS float* TAB) {
    const float* rb = F.in[16];
    for (int idx = F.tid; idx < 8 * 132; idx += NTHR) { const int h = idx / 132, d = idx % 132; float v = 0.f;
        if (d < 128) v = rb[h * 32 + t5_bucket(d)] * LOG2E; else if (d == 129) v = rb[h * 32 + 31] * LOG2E;
        TAB[idx] = v; }
}
constexpr int BGPRE_OFF = ROWTAB_OFF, BGCL_OFF = ROWTAB_OFF + 8448, BTAB_OFF = ROWTAB_OFF + 16640, BIT_OFF = ROWTAB_OFF + 20992, BIT_MAX = 512;
static_assert(BTAB_OFF + 8 * 132 * 4 <= MOE_TST_OFF, "attention LDS tables");
__device__ __forceinline__ size_t part_off(int slot) { return slot == 0 ? WS_PART0 : (slot == 1 ? WS_PART1 : WS_PART2); }

__device__ __forceinline__ void attn_block_phase(Frame& F) {
    LAS unsigned char* L = F.lds; LAS int* GPRE = (LAS int*)(L + BGPRE_OFF); LAS int* GCL = (LAS int*)(L + BGCL_OFF); LAS float* TAB = (LAS float*)(L + BTAB_OFF); LAS int* ITT = (LAS int*)(L + BIT_OFF); LAS int* WSUM = (LAS int*)(L + MOE_TST_OFF);
    const unsigned* GC = (const unsigned*)(F.ctl + CW_GCNT); const unsigned* SEGC = (const unsigned*)(F.ws + WS_SEGC);
    const int tid = F.tid, lane = F.lane, w = F.wave, j = lane & 31, hi = lane >> 5, lane8 = lane * 8;
    { int ng[4], tot = 0;
#pragma unroll
      for (int e = 0; e < 4; ++e) { const int c = (int)GC[4 * tid + e]; GCL[4 * tid + e] = c; ng[e] = (((c + 31) >> 5) + 7) >> 3; tot += ng[e]; }
      int inc = tot;
#pragma unroll
      for (int o = 1; o < 64; o <<= 1) { const int t = __shfl_up(inc, o); if (lane >= o) inc += t; }
      if (lane == 63) WSUM[w] = inc;
      __syncthreads();
      int woff = 0;
      for (int q = 0; q < w; ++q) woff += WSUM[q];
      int ex = woff + inc - tot;
#pragma unroll
      for (int e = 0; e < 4; ++e) { GPRE[4 * tid + e] = ex; ex += ng[e]; }
      if (tid == NTHR - 1) GPRE[2048] = ex; }
    attn_fill_tab(F, TAB);
    __syncthreads();
    const int NIT = GPRE[2048];
    const int nk = (NIT > F.vcu) ? (NIT - F.vcu + F.G - 1) / F.G : 0;
    if (tid < nk && tid < BIT_MAX) { const int it_ = F.vcu + tid * F.G; int lo_ = 0, hi_ = 2048; while (hi_ - lo_ > 1) { const int mid_ = (lo_ + hi_) >> 1; if (GPRE[mid_] <= it_) lo_ = mid_; else hi_ = mid_; } ITT[tid] = lo_ * 64 + (it_ - GPRE[lo_]); }
    __syncthreads();
    if (nk == 0) return;
    const int nkc = nk < BIT_MAX ? nk : BIT_MAX;
    const bf16_t* Qb = (const bf16_t*)(F.ws + WS_Q); const float* MQg = (const float*)(F.ws + WS_MQ); const unsigned short* QL = (const unsigned short*)(F.ws + WS_QLIST);
    const bf16_t* KF = (const bf16_t*)(F.ws + WS_KFRAG); const bf16_t* VF = (const bf16_t*)(F.ws + WS_VFRAG);
    float* PL = (float*)(F.ws + WS_PL);
#define BLK_ITEM(k_, pi_, g_) do { const int kk_ = (k_) < nkc ? (k_) : nkc - 1; const int v_ = __builtin_amdgcn_readfirstlane(ITT[kk_]); pi_ = v_ >> 6; g_ = v_ & 63; } while (0)
#define BLK_DMA(buf_, pi_) do { const char* ks_ = (const char*)KF + ((size_t)(pi_) * 2048 + tid) * 16; const char* vs_ = (const char*)VF + ((size_t)(pi_) * 2048 + tid) * 16; \
        _Pragma("unroll") for (int i_ = 0; i_ < 4; ++i_) { \
            __builtin_amdgcn_global_load_lds((const unsigned*)(ks_ + i_ * 8192), (LAS unsigned*)(L + (buf_) + (i_ * 512 + w * 64) * 16), 16, 0, 0); \
            __builtin_amdgcn_global_load_lds((const unsigned*)(vs_ + i_ * 8192), (LAS unsigned*)(L + (buf_) + 32768 + (i_ * 512 + w * 64) * 16), 16, 0, 0); } } while (0)
#define BLK_SEGC(dst_, pi_) do { dst_ = SEGC[(size_t)(pi_) * 32 + j]; } while (0)
#define BLK_ENTRY(dst_, segc_, pi_, g_) do { const int n_ = (pi_) & 31; int inc_ = (j < 31 - n_) ? (int)(segc_) : 0; \
        _Pragma("unroll") for (int o_ = 1; o_ < 32; o_ <<= 1) { const int t_ = __shfl_up(inc_, o_); if (j >= o_) inc_ += t_; } \
        const int cnt_ = GCL[pi_]; const int idx_ = 32 * (8 * (g_) + w) + j; int seg_ = 0, prev_ = 0; \
        for (int s_ = 0; s_ < 31 - n_; ++s_) { const int p_ = __builtin_amdgcn_readlane(inc_, s_); const bool le_ = p_ <= idx_; seg_ += le_ ? 1 : 0; prev_ = le_ ? p_ : prev_; } \
        const bool ok_ = idx_ < cnt_; const unsigned v_ = QL[(size_t)(pi_) * SEQ + (ok_ ? seg_ * 256 + (idx_ - prev_) : 0)]; dst_ = ok_ ? v_ : 0xFFFFu; } while (0)
#define BLK_QLOAD(qf_, m2_, ent_, pi_) do { const unsigned qq_ = ((ent_) == 0xFFFFu) ? 0u : ((ent_) >> 2); const int bh_ = (pi_) >> 5; \
        const bf16_t* qrow_ = Qb + ((size_t)(bh_ >> 3) * SEQ + qq_) * DA + (bh_ & 7) * HD + 8 * hi; \
        _Pragma("unroll") for (int ds_ = 0; ds_ < 4; ++ds_) qf_[ds_] = *(const bf16x8*)(qrow_ + 16 * ds_); \
        m2_ = MQg[(size_t)bh_ * SEQ + qq_]; } while (0)
    int pi, g, pi1, g1, pi2, g2; unsigned ent, ent1, sc2; bf16x8 qf[4]; float m2r;
    BLK_ITEM(0, pi, g); BLK_ITEM(1, pi1, g1); BLK_ITEM(2, pi2, g2);
    BLK_DMA(0, pi);
    { unsigned sc0, sc1; BLK_SEGC(sc0, pi); BLK_SEGC(sc1, pi1); BLK_SEGC(sc2, pi2); BLK_ENTRY(ent, sc0, pi, g); BLK_ENTRY(ent1, sc1, pi1, g1); }
    BLK_QLOAD(qf, m2r, ent, pi);
    int cur = 0;
    __builtin_amdgcn_s_waitcnt(0x0F70);
    unsigned char* dump = F.ws + WS_E + ((size_t)F.vcu * NTHR + tid) * 128;
    for (int k = 0; k < nkc; ++k) {
        __builtin_amdgcn_s_waitcnt(0x0F75);
        __syncthreads();
        int pi3, g3; unsigned sc3, ent2; bf16x8 qfn[4]; float m2n;
        BLK_ITEM(k + 3, pi3, g3); BLK_SEGC(sc3, pi3);
        BLK_ENTRY(ent2, sc2, pi2, g2);
        BLK_QLOAD(qfn, m2n, ent1, pi1);
        BLK_DMA((cur ^ 1) * 65536, pi1);
        const int bh = pi >> 5, n = pi & 31, h = bh & 7;
        const bool valid = ent != 0xFFFFu; const int q = valid ? (int)(ent >> 2) : 0; const int slot = (int)(ent & 3u);
        const bool active = __builtin_amdgcn_readfirstlane((int)(__ballot(valid) != 0ull)) != 0;
        f32x16 o0 = {}, o1 = {}; float lsum = 0.f;
        if (active) {
            const float m2 = valid ? m2r : INFINITY;
            const LAS bf16_t* KP = (const LAS bf16_t*)(L + cur * 65536); const LAS bf16_t* VP = (const LAS bf16_t*)(L + cur * 65536 + 32768);
            const LAS float* TABh = TAB + h * 132; const float mfar = m2 - TABh[129];
            const int dq = q - 256 * n;
            const bool nearw = __builtin_amdgcn_readfirstlane((int)(__ballot(valid && dq < 383) != 0ull)) != 0;
            if (nearw) { for (int st = 0; st < 8; ++st) ATTN_SUBTILE(KP, VP, st, true); }
            else { for (int st = 0; st < 8; ++st) ATTN_SUBTILE(KP, VP, st, false); }
        }
        { const float lt = lsum + __shfl_xor(lsum, 32);
          const size_t qi = (size_t)bh * SEQ + q;
          float* pld = valid ? PL + (size_t)slot * (NH * BATCH * SEQ) + qi : (float*)(dump + 120);
          bf16_t* dst = valid ? (bf16_t*)(F.ws + part_off(slot)) + qi * HD + 8 * hi : (bf16_t*)dump;
          *pld = lt;
          *(u32x4*)(dst) = ot_pack16(o0, 0); *(u32x4*)(dst + 16) = ot_pack16(o0, 1); *(u32x4*)(dst + 32) = ot_pack16(o1, 0); *(u32x4*)(dst + 48) = ot_pack16(o1, 1); }
        pi = pi1; g = g1; ent = ent1; m2r = m2n; pi1 = pi2; g1 = g2; ent1 = ent2; pi2 = pi3; g2 = g3; sc2 = sc3; cur ^= 1;
#pragma unroll
        for (int ds = 0; ds < 4; ++ds) qf[ds] = qfn[ds];
    }
    VM_WAIT(); __syncthreads();
#undef BLK_ITEM
#undef BLK_DMA
#undef BLK_SEGC
#undef BLK_ENTRY
#undef BLK_QLOAD
}

__device__ __forceinline__ void attn_own_phase(Frame& F) {
    LAS unsigned char* L = F.lds; LAS float* TAB = (LAS float*)(L + BTAB_OFF);
    attn_fill_tab(F, TAB);
    const int tid = F.tid, lane = F.lane, w = F.wave, j = lane & 31, hi = lane >> 5, lane8 = lane * 8;
    const bf16_t* Qb = (const bf16_t*)(F.ws + WS_Q); const float* MQg = (const float*)(F.ws + WS_MQ);
    const bf16_t* KF = (const bf16_t*)(F.ws + WS_KFRAG); const bf16_t* VF = (const bf16_t*)(F.ws + WS_VFRAG);
    const float* PL = (const float*)(F.ws + WS_PL); bf16_t* YA = (bf16_t*)(F.ws + WS_YATT);
    const int NU = BATCH * NH * NBLK;
#define OWN_DMA(buf_, pi_) do { const char* ks_ = (const char*)KF + ((size_t)(pi_) * 2048 + tid) * 16; const char* vs_ = (const char*)VF + ((size_t)(pi_) * 2048 + tid) * 16; \
        _Pragma("unroll") for (int i_ = 0; i_ < 4; ++i_) { \
            __builtin_amdgcn_global_load_lds((const unsigned*)(ks_ + i_ * 8192), (LAS unsigned*)(L + (buf_) + (i_ * 512 + w * 64) * 16), 16, 0, 0); \
            __builtin_amdgcn_global_load_lds((const unsigned*)(vs_ + i_ * 8192), (LAS unsigned*)(L + (buf_) + 32768 + (i_ * 512 + w * 64) * 16), 16, 0, 0); } } while (0)
#define OWN_QLOAD(qf_, m2_, u_) do { const int bh_ = (u_) >> 5, qb_ = (u_) & 31; const size_t tk_ = (size_t)256 * qb_ + 32 * w + j; \
        const bf16_t* qrow_ = Qb + ((size_t)(bh_ >> 3) * SEQ + tk_) * DA + (bh_ & 7) * HD + 8 * hi; \
        _Pragma("unroll") for (int ds_ = 0; ds_ < 4; ++ds_) qf_[ds_] = *(const bf16x8*)(qrow_ + 16 * ds_); \
        m2_ = MQg[(size_t)bh_ * SEQ + tk_]; } while (0)
    int u = F.vcu; if (u >= NU) return;
    bf16x8 qf[4]; float m2;
    OWN_DMA(0, u); OWN_QLOAD(qf, m2, u);
    int cur = 0;
    __builtin_amdgcn_s_waitcnt(0x0F70);
    for (;;) {
        __builtin_amdgcn_s_waitcnt(0x0F74); __syncthreads();
        const int un = (u + F.G < NU) ? u + F.G : u; const bool last = (un == u);
        const int bh = u >> 5, qb = u & 31, b = bh >> 3, h = bh & 7; const int ql = 32 * w + j; const size_t qi = (size_t)bh * SEQ + 256 * qb + ql;
        u32x4 pa[3][4]; float pl[3];
#pragma unroll
        for (int s = 0; s < 3; ++s) { pl[s] = PL[(size_t)s * (NH * BATCH * SEQ) + qi]; const bf16_t* src = (const bf16_t*)(F.ws + part_off(s)) + qi * HD + 8 * hi;
#pragma unroll
            for (int c = 0; c < 4; ++c) pa[s][c] = *(const u32x4*)(src + 16 * c); }
        bf16x8 qfn[4]; float m2n;
        OWN_QLOAD(qfn, m2n, un);
        OWN_DMA((cur ^ 1) * 65536, un);
        const LAS bf16_t* KP = (const LAS bf16_t*)(L + cur * 65536); const LAS bf16_t* VP = (const LAS bf16_t*)(L + cur * 65536 + 32768); const LAS float* TABh = TAB + h * 132;
        const float mfar = 0.f; (void)mfar; const int dq = ql;
        f32x16 o0 = {}, o1 = {}; float lsum = 0.f;
        for (int st = 0; st <= w; ++st) ATTN_SUBTILE(KP, VP, st, true);
        float lt = lsum + __shfl_xor(lsum, 32);
        const int nsel = qb < 3 ? qb : 3;
#pragma unroll
        for (int s = 0; s < 3; ++s) { const bool use = s < nsel; lt += use ? pl[s] : 0.f;
            ot_add16(o0, 0, pa[s][0], use); ot_add16(o0, 1, pa[s][1], use); ot_add16(o1, 0, pa[s][2], use); ot_add16(o1, 1, pa[s][3], use); }
        const float inv = 1.f / lt;
#pragma unroll
        for (int r = 0; r < 16; ++r) { o0[r] *= inv; o1[r] *= inv; }
        bf16_t* dst = YA + ((size_t)b * SEQ + 256 * qb + ql) * DA + h * HD + 8 * hi;
        *(u32x4*)(dst) = ot_pack16(o0, 0); *(u32x4*)(dst + 16) = ot_pack16(o0, 1); *(u32x4*)(dst + 32) = ot_pack16(o1, 0); *(u32x4*)(dst + 48) = ot_pack16(o1, 1);
        if (last) break;
        u = un; m2 = m2n; cur ^= 1;
#pragma unroll
        for (int ds = 0; ds < 4; ++ds) qf[ds] = qfn[ds];
    }
    VM_WAIT(); __syncthreads();
#undef OWN_DMA
#undef OWN_QLOAD
}
#undef ATTN_SUBTILE

__device__ __forceinline__ void routing_phase(Frame& F) {
    LAS int* lcnt = (LAS int*)(F.lds); LAS int* lbase = lcnt + 32;
    const float* SSQ = (const float*)(F.ws + WS_SSQ); const float* RL = (const float*)(F.ws + WS_RLOG);
    unsigned* rowtok = (unsigned*)(F.ws + WS_ROWTOK); float* rowcoef = (float*)(F.ws + WS_ROWCOEF); float* rowrstd = (float*)(F.ws + WS_ROWRSTD);
    unsigned* ecnt = (unsigned*)(F.ctl + CW_ECNT);
    const float* brg = F.in[20]; const float* bre = F.in[22];
    const int tid = F.tid;
    for (int base = F.vcu * 256; base < T; base += F.G * 256) {
        if (tid < 32) lcnt[tid] = 0;
        __syncthreads();
        int e0 = 0, e1 = 0, lp0 = 0, lp1 = 0; float c0 = 0.f, c1 = 0.f, rstd = 0.f; const int tok = base + tid;
        if (tid < 256) {
            float ss = 0.f;
#pragma unroll
            for (int q = 0; q < 4; ++q) { const f32x4 v = *(const f32x4*)(SSQ + (size_t)tok * 16 + 4 * q); ss += (v.x + v.y) + (v.z + v.w); }
            rstd = 1.f / sqrtf(ss * (1.f / D) + RMS_EPS);
            float r[72];
#pragma unroll
            for (int q = 0; q < 18; ++q) { const f32x4 v = *(const f32x4*)(RL + (size_t)tok * 72 + 4 * q); r[4 * q] = v.x; r[4 * q + 1] = v.y; r[4 * q + 2] = v.z; r[4 * q + 3] = v.w; }
            float gl[4], el[32];
#pragma unroll
            for (int c = 0; c < 4; ++c) gl[c] = rstd * (r[c] + r[36 + c]) + brg[c];
#pragma unroll
            for (int c = 0; c < 32; ++c) el[c] = rstd * (r[4 + c] + r[40 + c]) + bre[c];
            int gi = 0; float gm = gl[0];
#pragma unroll
            for (int c = 1; c < 4; ++c) if (gl[c] > gm) { gm = gl[c]; gi = c; }
            float Z = 0.f;
#pragma unroll
            for (int c = 0; c < 4; ++c) Z += __expf(gl[c] - gm);
            const float gval = 1.f / Z;
            float es[8];
#pragma unroll
            for (int q = 0; q < 8; ++q) es[q] = gi == 0 ? el[q] : (gi == 1 ? el[8 + q] : (gi == 2 ? el[16 + q] : el[24 + q]));
            int a0 = 0; float m0 = es[0];
#pragma unroll
            for (int q = 1; q < 8; ++q) if (es[q] > m0) { m0 = es[q]; a0 = q; }
            int a1 = -1; float m1 = -INFINITY;
#pragma unroll
            for (int q = 0; q < 8; ++q) if (q != a0 && es[q] > m1) { m1 = es[q]; a1 = q; }
            const float w0 = 1.f / (1.f + __expf(m1 - m0)), w1 = 1.f - w0;
            e0 = gi * 8 + a0; e1 = gi * 8 + a1; c0 = gval * w0; c1 = gval * w1;
            lp0 = __hip_atomic_fetch_add(lcnt + e0, 1, __ATOMIC_RELAXED, __HIP_MEMORY_SCOPE_WORKGROUP);
            lp1 = __hip_atomic_fetch_add(lcnt + e1, 1, __ATOMIC_RELAXED, __HIP_MEMORY_SCOPE_WORKGROUP);
        }
        __syncthreads();
        if (tid < 32) lbase[tid] = (int)__hip_atomic_fetch_add(ecnt + tid, (unsigned)lcnt[tid], __ATOMIC_RELAXED, __HIP_MEMORY_SCOPE_AGENT);
        __syncthreads();
        if (tid < 256) {
            const size_t i0 = (size_t)e0 * ROWCAP + lbase[e0] + lp0, i1 = (size_t)e1 * ROWCAP + lbase[e1] + lp1;
            rowtok[i0] = (unsigned)tok * 2u; rowcoef[i0] = c0; rowrstd[i0] = rstd;
            rowtok[i1] = (unsigned)tok * 2u + 1u; rowcoef[i1] = c1; rowrstd[i1] = rstd;
        }
        __syncthreads();
    }
}
struct MoeOrder {
    const LAS int* tst; int total, G, v;
    __device__ bool next(int i, pg8::Unit& u) const {
        const int L = i * G + v; if (L >= total) return false;
        const int rt = L >> 2; int e = 0;
#pragma unroll 8
        for (int q = 1; q <= 32; ++q) e += (tst[q] <= rt) ? 1 : 0;
        u.pm = rt; u.pn = L & 3; u.pb = e * 4 + u.pn; u.aux = e; u.aux2 = (rt - tst[e]) * 256; return true;
    }
};
__device__ __forceinline__ void moe_tables(Frame& F) {
    LAS int* tst = (LAS int*)(F.lds + MOE_TST_OFF); const unsigned* ecnt = (const unsigned*)(F.ctl + CW_ECNT);
    if (F.wave == 0) { const int lane = F.lane; int nt = lane < 32 ? (int)((ecnt[lane & 31] + 255u) >> 8) : 0; int inc = nt;
#pragma unroll
        for (int o = 1; o < 32; o <<= 1) { const int t = __shfl_up(inc, o); if (lane >= o) inc += t; }
        if (lane < 32) tst[lane + 1] = inc; if (lane == 0) tst[0] = 0; }
    __syncthreads();
}
__device__ __forceinline__ void final_phase(Frame& F) {
    const float* X1 = (const float*)(F.ws + WS_X1); const bf16_t* Y0 = (const bf16_t*)(F.ws + WS_Y0); const bf16_t* Y1 = (const bf16_t*)(F.ws + WS_Y1); const float* gf = F.in[26];
    const int gw = F.vcu * NWAVES + F.wave, NGW = F.G * NWAVES, lane = F.lane;
    for (int m = gw; m < T; m += NGW) {
        const f32x4* xr = (const f32x4*)(X1 + (size_t)m * D) + lane; const u32x2* y0 = (const u32x2*)(Y0 + (size_t)m * D) + lane; const u32x2* y1 = (const u32x2*)(Y1 + (size_t)m * D) + lane;
        f32x4 v[4]; float s = 0.f;
#pragma unroll
        for (int j = 0; j < 4; ++j) { v[j] = xr[64 * j]; const u32x2 a = y0[64 * j], c = y1[64 * j];
            v[j].x += bflo(a.x) + bflo(c.x); v[j].y += bfhi(a.x) + bfhi(c.x); v[j].z += bflo(a.y) + bflo(c.y); v[j].w += bfhi(a.y) + bfhi(c.y);
            s += (v[j].x * v[j].x + v[j].y * v[j].y) + (v[j].z * v[j].z + v[j].w * v[j].w); }
        const float rstd = 1.f / sqrtf(wave_sum(s) * (1.f / D) + RMS_EPS);
        f32x4* o = (f32x4*)(F.out + (size_t)m * D) + lane; const f32x4* gr = (const f32x4*)gf + lane;
#pragma unroll
        for (int j = 0; j < 4; ++j) o[64 * j] = v[j] * rstd * gr[64 * j];
    }
}
#ifndef MK_N_LAUNCHES
#define MK_N_LAUNCHES 1
#endif
constexpr int NPHASE = 15;
struct Args { const float* in[27]; float* out; unsigned char* ws; int ph_lo, ph_hi; };
static_assert(sizeof(Args) == 27 * 8 + 8 + 8 + 8, "Args has no padding");

#ifndef STAG1
#define STAG1 0
#endif
#ifndef DUP_MASK
#define DUP_MASK 0
#endif
#define PH_ARGS Frame& F, unsigned char* ws, LAS unsigned char* ring
__device__ __forceinline__ void ph1(PH_ARGS) {
    { pg8::Gemm g{(const bf16_t*)(ws + WS_H1), (const bf16_t*)(ws + WS_WIN), D, D, D}; pg8::StaticOrder S; S.init(T, DS, F.G, (int)blockIdx.x);
      EpiProj<0> E{ws, F.in[3], 0, 1.f};
      pg8::gemm_phase<EpiProj<0>, pg8::StaticOrder, true, false>(ring, g, S, E, nullptr); }
    { pg8::Gemm g{(const bf16_t*)(ws + WS_H1F8), (const bf16_t*)(ws + WS_WINF8), D / 2, D / 2, D / 2}; pg8::StaticOrder S; S.init(T, DIN - DS, F.G, (int)blockIdx.x);
      EpiProj<1> E{ws, F.in[3], 2, 1.f / WF8_SCALE};
      pg8::gemm_phase<EpiProj<1>, pg8::StaticOrder, true, false, true>(ring, g, S, E, nullptr); }
}
__device__ __forceinline__ void ph2(PH_ARGS) {
    { pg8::Gemm g{(const bf16_t*)(ws + WS_UP), (const bf16_t*)(ws + WS_SSMW), SKY, SKU, SKU}; pg8::GroupedOrder S; S.init(SG * 8, 1, 8, F.G, F.vcu);
      EpiSsmE E{(float*)(ws + WS_E)};
      pg8::gemm_phase<EpiSsmE, pg8::GroupedOrder, false, false>(ring, g, S, E, nullptr); }
    __syncthreads();
    kv_prep_phase(F);
}
__device__ __forceinline__ void ph4(PH_ARGS) {
    pg8::Gemm g{(const bf16_t*)(ws + WS_UP), (const bf16_t*)(ws + WS_SSMT), SKY, SKY, SKY}; pg8::GroupedOrder S; S.init(SG * 8, 2, 8, F.G, F.vcu);
    EpiSsmY E{(bf16_t*)(ws + WS_GACT)};
    pg8::gemm_phase<EpiSsmY, pg8::GroupedOrder, true, false>(ring, g, S, E, nullptr);
}
__device__ __forceinline__ void ph5(PH_ARGS) {
    pg8::Gemm g{(const bf16_t*)(ws + WS_GACT), (const bf16_t*)(ws + WS_WGLU), DS, DS, DS}; pg8::StaticOrder S; S.init(T, DS, F.G, (int)blockIdx.x);
    EpiGlu E{(const bf16_t*)(ws + WS_GACT), (bf16_t*)(ws + WS_YSSM), F.in[13]};
    pg8::gemm_phase<EpiGlu, pg8::StaticOrder, true, false>(ring, g, S, E, nullptr);
}
__device__ __forceinline__ void ph6(PH_ARGS) {
    { pg8::Gemm g{(const bf16_t*)(ws + WS_YSSM), (const bf16_t*)(ws + WS_WUS), DS, DS, DS}; pg8::StaticOrder S; S.init(T, D, F.G, (int)blockIdx.x);
      EpiUp<false> E{(const bf16_t*)(ws + WS_SGS), (bf16_t*)(ws + WS_MRG)};
      pg8::gemm_phase<EpiUp<false>, pg8::StaticOrder, true, false>(ring, g, S, E, nullptr); }
    VM_WAIT(); __syncthreads();
    { pg8::Gemm g{(const bf16_t*)(ws + WS_YATT), (const bf16_t*)(ws + WS_WUA), DA, DA, DA}; pg8::StaticOrder S; S.init(T, D, F.G, (int)blockIdx.x);
      EpiUp<true> E{(const bf16_t*)(ws + WS_SGA), (bf16_t*)(ws + WS_MRG)};
      pg8::gemm_phase<EpiUp<true>, pg8::StaticOrder, true, false>(ring, g, S, E, nullptr); }
}
__device__ __forceinline__ void ph7(PH_ARGS) {
    pg8::Gemm g{(const bf16_t*)(ws + WS_MRG), (const bf16_t*)(ws + WS_WOUT), D, D, D}; pg8::StaticOrder S; S.init(T, D, F.G, (int)blockIdx.x);
    EpiOut E{F.in[0], (float*)(ws + WS_X1), (bf16_t*)(ws + WS_XG), F.in[18], (float*)(ws + WS_SSQ)};
    pg8::gemm_phase<EpiOut, pg8::StaticOrder, true, false>(ring, g, S, E, nullptr);
}
__device__ __forceinline__ void ph8(PH_ARGS) {
    pg8::Gemm g{(const bf16_t*)(ws + WS_XG), (const bf16_t*)(ws + WS_WR), D, D, D}; pg8::StaticOrder S; S.init(T, 256, F.G, (int)blockIdx.x);
    EpiRouter E{(float*)(ws + WS_RLOG)};
    pg8::gemm_phase<EpiRouter, pg8::StaticOrder, false, false>(ring, g, S, E, nullptr);
}
__device__ __forceinline__ void ph10(PH_ARGS) {
    moe_tables(F);
    const LAS int* tst = (const LAS int*)(F.lds + MOE_TST_OFF);
    MoeOrder S{tst, tst[32] * 4, F.G, F.vcu};
    LAS unsigned* rowtab = (LAS unsigned*)(F.lds + ROWTAB_OFF);
    { const unsigned* rowtok = (const unsigned*)(ws + WS_ROWTOK); const unsigned* ecnt = (const unsigned*)(F.ctl + CW_ECNT); pg8::Unit u;
      for (int i = 0; i < ROWTAB_UNITS && S.next(i, u); ++i) { if (F.tid < 256) { const int pos = u.aux2 + F.tid; const unsigned tk = pos < (int)ecnt[u.aux] ? (rowtok[(size_t)u.aux * ROWCAP + pos] >> 1) : 0u; rowtab[i * 256 + F.tid] = tk * (unsigned)(D * 2); } } }
    __syncthreads();
    pg8::Gemm g{(const bf16_t*)(ws + WS_XG), (const bf16_t*)(ws + WS_W13), D, D, D};
    EpiMoe1 E{(bf16_t*)(ws + WS_HID), (const float*)(ws + WS_ROWRSTD), (const unsigned*)(F.ctl + CW_ECNT)};
    pg8::gemm_phase<EpiMoe1, MoeOrder, true, true>(ring, g, S, E, rowtab);
}
__device__ __forceinline__ void ph11(PH_ARGS) {
    moe_tables(F);
    const LAS int* tst = (const LAS int*)(F.lds + MOE_TST_OFF);
    MoeOrder S{tst, tst[32] * 4, F.G, F.vcu};
    pg8::Gemm g{(const bf16_t*)(ws + WS_HID), (const bf16_t*)(ws + WS_W2), DE, DE, DE};
    EpiMoe2 E{(bf16_t*)(ws + WS_Y0), (size_t)(WS_Y1 - WS_Y0), (const unsigned*)(ws + WS_ROWTOK), (const float*)(ws + WS_ROWCOEF), (const unsigned*)(F.ctl + CW_ECNT)};
    pg8::gemm_phase<EpiMoe2, MoeOrder, true, false>(ring, g, S, E, nullptr);
}

__global__ void __launch_bounds__(NTHR, 2) fwd_kernel(Args args) {
    extern __shared__ __attribute__((aligned(16))) unsigned char lds_raw[];
    Frame F;
    F.lds = (LAS unsigned char*)lds_raw;
    F.MISC = (volatile LAS unsigned*)(F.lds + MISC_OFF);
    F.tid = threadIdx.x; F.lane = F.tid & 63; F.wave = __builtin_amdgcn_readfirstlane(F.tid >> 6);
    F.G = gridDim.x; { const int bx = blockIdx.x; F.vcu = (F.G % 8 == 0) ? (bx % 8) * (F.G / 8) + bx / 8 : bx; }
    F.ws = args.ws; F.ctl = (gu32*)(args.ws + WS_CTL); F.out = args.out;
#pragma unroll
    for (int i = 0; i < 27; ++i) F.in[i] = args.in[i];
    for (int u = F.tid; u < (LDS_BYTES - MOE_TST_OFF) / 4; u += NTHR) ((LAS unsigned*)(F.lds + MOE_TST_OFF))[u] = 0u;
    __syncthreads();
    XcdBarrier bar; bar.bar = (unsigned*)(F.ctl + CW_BAR); bar.x = 0; bar.st = nullptr;
    const int lo = args.ph_lo, hi = args.ph_hi;
    if (hi - lo > 1) bar = xcd_barrier_post((unsigned*)(F.ctl + CW_BAR), F.MISC + 8);
#define IN(k) (lo <= (k) && (k) < hi)
#define DUP(k) ((DUP_MASK >> (k)) & 1)
#define SEAM(k) do { if (IN(k) && IN((k) + 1)) xcd_barrier(bar); } while (0)
    unsigned char* ws = args.ws;
    LAS unsigned char* ring = F.lds;
    if (IN(0)) { p0_prologue(F); if (DUP(0)) p0_prologue(F); }
    SEAM(0);
    if (IN(1)) { ph1(F, ws, ring); if (DUP(1)) ph1(F, ws, ring); }
    SEAM(1);
    if (IN(2)) { ph2(F, ws, ring); if (DUP(2)) ph2(F, ws, ring); }
    SEAM(2);
    if (IN(3)) { ssm_scan_phase(F); attn_gate_phase<true>(F); if (DUP(3)) { ssm_scan_phase(F); } if (DUP(15)) { attn_gate_phase<false>(F); } }
    SEAM(3);
    if (IN(4)) { attn_block_phase(F); if (DUP(4)) { __syncthreads(); attn_block_phase(F); } }
    SEAM(4);
    if (IN(5)) { attn_own_phase(F); if (DUP(5)) attn_own_phase(F); }
    SEAM(5);
    if (IN(6)) { ph4(F, ws, ring); if (DUP(6)) ph4(F, ws, ring); }
    SEAM(6);
    if (IN(7)) { ph5(F, ws, ring); if (DUP(7)) ph5(F, ws, ring); }
    SEAM(7);
    if (IN(8)) { ph6(F, ws, ring); if (DUP(8)) ph6(F, ws, ring); }
    SEAM(8);
    if (IN(9)) { ph7(F, ws, ring); if (DUP(9)) ph7(F, ws, ring); }
    SEAM(9);
    if (IN(10)) { ph8(F, ws, ring); if (DUP(10)) ph8(F, ws, ring); }
    SEAM(10);
    if (IN(11)) { routing_phase(F); }
    SEAM(11);
    if (IN(12)) { ph10(F, ws, ring); if (DUP(12)) ph10(F, ws, ring); }
    SEAM(12);
    if (IN(13)) { ph11(F, ws, ring); if (DUP(13)) ph11(F, ws, ring); }
    SEAM(13);
    if (IN(14)) { final_phase(F); if (DUP(14)) final_phase(F); }
#undef IN
#undef DUP
#undef SEAM
}

extern "C" void kernel_launch(void* const* d_in, const int* in_sizes, int n_in, void* d_out, int out_size, void* d_ws, size_t ws_size, hipStream_t stream) {
    static int grid = 0;
    if (grid == 0) {
        if (n_in != 27 || in_sizes[0] != T * D || out_size != T * D || ws_size < WS_END) { fprintf(stderr, "kernel_launch: unexpected shapes (n_in %d, in0 %d, out %d, ws %zu)\n", n_in, n_in > 0 ? in_sizes[0] : -1, out_size, ws_size); grid = -1; return; }
        int dev = 0, cus = 0;
        if (hipGetDevice(&dev) != hipSuccess || hipDeviceGetAttribute(&cus, hipDeviceAttributeMultiprocessorCount, dev) != hipSuccess) { grid = -1; return; }
        if (hipFuncSetAttribute((const void*)fwd_kernel, hipFuncAttributeMaxDynamicSharedMemorySize, LDS_BYTES) != hipSuccess) { fprintf(stderr, "kernel_launch: hipFuncSetAttribute failed\n"); grid = -1; return; }
        (void)hipGetLastError();
        grid = cus;
    }
    if (grid < 0) return;
    (void)hipMemsetAsync((char*)d_ws + WS_CTL, 0, CTL_ZERO_BYTES, stream);
    Args a{};
    for (int i = 0; i < 27; ++i) a.in[i] = (const float*)d_in[i];
    a.out = (float*)d_out; a.ws = (unsigned char*)d_ws;
    if (MK_N_LAUNCHES == 1) { a.ph_lo = 0; a.ph_hi = NPHASE; hipLaunchKernelGGL(fwd_kernel, dim3(grid), dim3(NTHR), LDS_BYTES, stream, a); }
    else { for (int p = 0; p < NPHASE; ++p) { a.ph_lo = p; a.ph_hi = p + 1; hipLaunchKernelGGL(fwd_kernel, dim3(grid), dim3(NTHR), LDS_BYTES, stream, a); } }
}
```

```cpp
#include <hip/hip_runtime.h>
#include <cstdio>
#include <cstdint>

#define LAS __attribute__((address_space(3)))
#define GAS __attribute__((address_space(1)))
typedef unsigned short bf16_t;
typedef short bf16x8 __attribute__((ext_vector_type(8)));
typedef float f32x2 __attribute__((ext_vector_type(2)));
typedef float f32x4 __attribute__((ext_vector_type(4)));
typedef float f32x16 __attribute__((ext_vector_type(16)));
typedef unsigned u32x2 __attribute__((ext_vector_type(2)));
typedef unsigned u32x4 __attribute__((ext_vector_type(4)));
typedef GAS unsigned gu32;
typedef int v4i32 __attribute__((ext_vector_type(4)));
typedef int v8i32 __attribute__((ext_vector_type(8)));
#define RLX_AGENT __ATOMIC_RELAXED, __HIP_MEMORY_SCOPE_AGENT
#define LDS_WAIT() asm volatile("s_waitcnt lgkmcnt(0)" ::: "memory")
#define VM_WAIT() asm volatile("s_waitcnt vmcnt(0)" ::: "memory")

__device__ __forceinline__ unsigned f2bf(float f) { unsigned u = __builtin_bit_cast(unsigned, f); return (u + 0x7fffu + ((u >> 16) & 1u)) >> 16; }
__device__ __forceinline__ unsigned pk2(float lo, float hi) { return f2bf(lo) | (f2bf(hi) << 16); }
__device__ __forceinline__ float bf2f(unsigned short b) { return __builtin_bit_cast(float, (unsigned)b << 16); }
__device__ __forceinline__ float bflo(unsigned w) { return __builtin_bit_cast(float, w << 16); }
__device__ __forceinline__ float bfhi(unsigned w) { return __builtin_bit_cast(float, w & 0xffff0000u); }
__device__ __forceinline__ unsigned cvt_pk_bf16(float lo, float hi) { unsigned r; asm volatile("v_cvt_pk_bf16_f32 %0, %1, %2" : "=v"(r) : "v"(lo), "v"(hi)); return r; }
__device__ __forceinline__ float fast_sigmoid(float x) { return __builtin_amdgcn_rcpf(1.f + __builtin_amdgcn_exp2f(-1.4426950408889634f * x)); }
__device__ __forceinline__ int lane_id() { int l; asm volatile("v_mbcnt_lo_u32_b32 %0, -1, 0\n\tv_mbcnt_hi_u32_b32 %0, -1, %0" : "=v"(l)); return l; }
__device__ __forceinline__ float wave_sum(float v) {
#pragma unroll
    for (int o = 1; o < 64; o <<= 1) v += __shfl_xor(v, o);
    return v;
}
__device__ __forceinline__ float wave_max(float v) {
#pragma unroll
    for (int o = 1; o < 64; o <<= 1) v = fmaxf(v, __shfl_xor(v, o));
    return v;
}

#define XB_TMO      128
#define XB_XCNT(j)  (256  + 64 * (j))
#define XB_XSUB(j)  (1280 + 64 * (j))
#define XB_XGEN(j)  (2304 + 64 * (j))
#define XB_TOP      3328
#define XB_TOPGEN   3392
#define XCD_BAR_WORDS 3456
#define XB_SPIN_CAP (1u << 20)

__device__ __forceinline__ unsigned xb_ld(unsigned* p)              { return __hip_atomic_load(p, __ATOMIC_RELAXED, __HIP_MEMORY_SCOPE_AGENT); }
__device__ __forceinline__ unsigned xb_add(unsigned* p, unsigned v) { return __hip_atomic_fetch_add(p, v, __ATOMIC_RELAXED, __HIP_MEMORY_SCOPE_AGENT); }
__device__ __forceinline__ unsigned xb_xcc_id() { return (unsigned)__builtin_amdgcn_s_getreg((3 << 11) | 20) & 0xFu; }
#define XB_SPIN(cond, bar) do { unsigned _sp = 0; while (cond) { __builtin_amdgcn_s_sleep(1); \
    if ((++_sp & 255u) == 0u) { if (xb_ld(&(bar)[XB_TMO])) break; if (_sp > XB_SPIN_CAP) { atomicAdd(&(bar)[XB_TMO], 1u); break; } } } } while (0)

struct XcdBarrier { unsigned* bar; unsigned x; volatile LAS unsigned* st; };

__device__ __forceinline__ XcdBarrier xcd_barrier_post(unsigned* bar, volatile LAS unsigned* st, bool leader  ) {
    XcdBarrier b; b.bar = bar; b.x = xb_xcc_id(); b.st = st;
    if (leader) (void)xb_add(&bar[XB_XCNT(b.x)], 1u);
    return b;
}
__device__ __forceinline__ void xcd_barrier_complete(unsigned* bar, unsigned x, unsigned& nloc, unsigned& nx) {
    const unsigned G = gridDim.x * gridDim.y * gridDim.z;
    unsigned sum, cnt, mine, sp = 0u;
    for (;;) {
        sum = 0u; cnt = 0u; mine = 0u;
#pragma unroll
        for (unsigned j = 0; j < 16; ++j) { const unsigned c = xb_ld(&bar[XB_XCNT(j)]); sum += c; cnt += (c > 0u) ? 1u : 0u; mine = (j == x) ? c : mine; }
        if (sum == G) break;
        __builtin_amdgcn_s_sleep(1);
        if ((++sp & 255u) == 0u) { if (xb_ld(&bar[XB_TMO])) break; if (sp > XB_SPIN_CAP) { atomicAdd(&bar[XB_TMO], 1u); break; } }
    }
    nloc = mine > 0u ? mine : 1u; nx = cnt > 0u ? cnt : 1u;
}
__device__ __forceinline__ void xcd_barrier(const XcdBarrier& b, bool leader  ) {
    asm volatile("s_waitcnt vmcnt(0)" ::: "memory");
    __syncthreads();
    if (leader) {
        unsigned* bar = b.bar;
        __builtin_amdgcn_s_waitcnt(0);
        unsigned nloc = b.st[0], nx = b.st[1];
        if (nloc == 0u) { xcd_barrier_complete(bar, b.x, nloc, nx); b.st[0] = nloc; b.st[1] = nx; }
        const unsigned old = xb_add(&bar[XB_XSUB(b.x)], 1u);
        const unsigned gen = old / nloc;
        if (old + 1u == (gen + 1u) * nloc) {
            __builtin_amdgcn_fence(__ATOMIC_RELEASE, "agent");
            asm volatile("s_waitcnt vmcnt(0)" ::: "memory");
            const unsigned og = xb_add(&bar[XB_TOP], 1u);
            const unsigned tg = og / nx;
            if (og + 1u == (tg + 1u) * nx) xb_add(&bar[XB_TOPGEN], 1u);
            else XB_SPIN(xb_ld(&bar[XB_TOPGEN]) == tg, bar);
            __builtin_amdgcn_fence(__ATOMIC_ACQUIRE, "agent");
            xb_add(&bar[XB_XGEN(b.x)], 1u);
            asm volatile("s_waitcnt vmcnt(0)" ::: "memory");
        } else {
            XB_SPIN(xb_ld(&bar[XB_XGEN(b.x)]) == gen, bar);
            __builtin_amdgcn_fence(__ATOMIC_ACQUIRE, "agent");
            asm volatile("s_waitcnt vmcnt(0)" ::: "memory");
        }
    }
    __syncthreads();
}

namespace pg8 {
constexpr int BM = 256, BK = 64, HALF = 128, HTB = HALF * BK * 2, STAGE_BYTES = 8 * HTB, NXCD = 8, WGM = 8;
__host__ __device__ __forceinline__ int lds_byte(int r, int c) { const int st = (r >> 4) * 2 + (c >> 5), rr = r & 15, cc = c & 31, ob = rr * 64 + cc * 2; return st * 1024 + (ob ^ (((ob >> 9) & 1) << 5)); }
__host__ __device__ __forceinline__ void stage_rc(int b, int& R, int& C) { const int st = b / 1024, sb = b % 1024, swz = sb ^ (((sb >> 9) & 1) << 5); R = (st >> 1) * 16 + swz / 64; C = (st & 1) * 32 + (swz % 64) / 2; }
__host__ __device__ __forceinline__ int perm32(int rho) { const int n = rho >> 4, i = rho & 15; return 8 * (i >> 2) + 4 * n + (i & 3); }

struct Unit { int pm, pn, pb, aux, aux2; };
struct Gemm { const bf16_t* A; const bf16_t* Bt; int lda, ldb, K; };

struct StaticOrder {
    int nM, nN, nwg, G, c;
    __device__ void init(int M, int N, int G_, int c_) { nM = M / BM; nN = N / BM; nwg = nM * nN; G = G_; c = c_; }
    __device__ bool next(int i, Unit& u) const {
        const long L = (long)i * G + c; if (L >= nwg) return false;
        int wgid = (int)L; { const int q = nwg / NXCD, r = nwg % NXCD, xcd = wgid % NXCD, off = wgid / NXCD; wgid = (xcd < r ? xcd * (q + 1) : r * (q + 1) + (xcd - r) * q) + off; }
        const int nig = WGM * nN, gid = wgid / nig, fm = gid * WGM, gsz = (nM - fm) < WGM ? (nM - fm) : WGM;
        u.pm = fm + ((wgid % nig) % gsz); u.pn = (wgid % nig) / gsz; u.pb = u.pn; u.aux = 0; u.aux2 = 0; return true;
    }
};
struct GroupedOrder {
    int nM, nN, rtpg, G, v;
    __device__ void init(int nM_, int nN_, int rtpg_, int G_, int v_) { nM = nM_; nN = nN_; rtpg = rtpg_; G = G_; v = v_; }
    __device__ bool next(int i, Unit& u) const {
        const int L = i * G + v; if (L >= nM * nN) return false;
        u.pm = L / nN; u.pn = L % nN; u.aux = u.pm / rtpg; u.pb = u.aux * nN + u.pn; u.aux2 = 0; return true;
    }
};

template <class Epi, class Sched, bool ALIGN_EPI, bool GATHER, bool FP8 = false>
__device__ __forceinline__ void gemm_phase(LAS unsigned char* lds, const Gemm g, const Sched& S, const Epi& E, const LAS unsigned* rowtab  , int wid  ) {
    const int lane = lane_id(), tid = wid * 64 + lane, wr = wid >> 2, wc = wid & 3;
    const int K = g.K, nt = K / BK;
    unsigned voffB[2];
#pragma unroll
    for (int i = 0; i < 2; ++i) { int R, C; stage_rc(tid * 16 + i * 8192, R, C); const int Rb = (R & ~31) + perm32(R & 31);
        voffB[i] = (unsigned)(Rb * g.ldb + C) * 2u; }
    const size_t kstep = (size_t)(BK * 2);
    const size_t hstepB = (size_t)HALF * g.ldb * 2, tstepB = 2 * hstepB;
    const size_t tstepA = (size_t)BM * g.lda * 2;
    const unsigned ldsw = (unsigned)wid * 1024u;
    const int aoff = lds_byte(wr * 64 + (lane & 15), (lane >> 4) * 8), boff = lds_byte(wc * 32 + (lane & 15), (lane >> 4) * 8);
    unsigned vAc[2][2];
#define PG8_SETVA(dst, ui_) do { const int t_ = wid * 64 + lane_id(); _Pragma("unroll") for (int i_ = 0; i_ < 2; ++i_) { int R_, C_; stage_rc(t_ * 16 + i_ * 8192, R_, C_); \
        _Pragma("unroll") for (int h_ = 0; h_ < 2; ++h_) dst[h_][i_] = (GATHER ? rowtab[(ui_) * 256 + h_ * 128 + R_] : (unsigned)((h_ * 128 + R_) * g.lda) * 2u) + (unsigned)C_ * 2u; } } while (0)
#define PG8_SA(b, h) (((b) * 2 + (h)) * HTB)
#define PG8_SB(b, h) ((4 + (b) * 2 + (h)) * HTB)
#define PG8_GLDS_S(gbase_, voff_, ldsaddr_) do { unsigned keep_; asm volatile("s_mov_b32 %0, m0\n\ts_mov_b32 m0, %3\n\ts_nop 0\n\tglobal_load_lds_dwordx4 %1, %2\n\ts_mov_b32 m0, %0" \
        : "=&s"(keep_) : "v"(voff_), "s"(gbase_), "s"(ldsaddr_) : "memory"); } while (0)
#define PG8_STAGE(bufoff, gbase, v0, v1) do { \
        if constexpr (FP8) { const unsigned la_ = (unsigned)(uintptr_t)(lds + (bufoff) + ldsw); PG8_GLDS_S((const char*)(gbase), (v0), la_); PG8_GLDS_S((const char*)(gbase), (v1), la_ + 8192u); } else { \
        __builtin_amdgcn_global_load_lds((const unsigned*)((const char*)(gbase) + (v0)), (LAS unsigned*)(lds + (bufoff) + ldsw), 16, 0, 0); \
        __builtin_amdgcn_global_load_lds((const unsigned*)((const char*)(gbase) + (v1)), (LAS unsigned*)(lds + (bufoff) + ldsw + 8192), 16, 0, 0); } } while (0)
#define PG8_STB(bufoff, gbase) PG8_STAGE(bufoff, gbase, voffB[0], voffB[1])
#define PG8_LDA(dst, b, h) do { _Pragma("unroll") for (int m = 0; m < 4; ++m) _Pragma("unroll") for (int k = 0; k < 2; ++k) dst[m][k] = *(const LAS bf16x8*)(lds + PG8_SA(b, h) + aoff + m * 2048 + k * 1024); } while (0)
#define PG8_LDB(dst, b, h) do { _Pragma("unroll") for (int n = 0; n < 2; ++n) _Pragma("unroll") for (int k = 0; k < 2; ++k) dst[n][k] = *(const LAS bf16x8*)(lds + PG8_SB(b, h) + boff + n * 2048 + k * 1024); } while (0)
#define PG8_MMA(ai, bj, At, Bt) do { __builtin_amdgcn_s_setprio(1); \
        if constexpr (FP8) { _Pragma("unroll") for (int m = 0; m < 4; ++m) _Pragma("unroll") for (int n = 0; n < 2; ++n) { \
            const v8i32 a8_ = __builtin_shufflevector(__builtin_bit_cast(v4i32, At[m][0]), __builtin_bit_cast(v4i32, At[m][1]), 0, 1, 2, 3, 4, 5, 6, 7); \
            const v8i32 b8_ = __builtin_shufflevector(__builtin_bit_cast(v4i32, Bt[n][0]), __builtin_bit_cast(v4i32, Bt[n][1]), 0, 1, 2, 3, 4, 5, 6, 7); \
            acc[ai][bj][m][n] = __builtin_amdgcn_mfma_scale_f32_16x16x128_f8f6f4(b8_, a8_, acc[ai][bj][m][n], 0, 0, 0, 0, 0, 0); } } \
        else { _Pragma("unroll") for (int m = 0; m < 4; ++m) _Pragma("unroll") for (int n = 0; n < 2; ++n) _Pragma("unroll") for (int k = 0; k < 2; ++k) \
            acc[ai][bj][m][n] = __builtin_amdgcn_mfma_f32_16x16x32_bf16(Bt[n][k], At[m][k], acc[ai][bj][m][n], 0, 0, 0); } \
        __builtin_amdgcn_s_setprio(0); } while (0)
#define PG8_WAIT_V(n) asm volatile("s_waitcnt vmcnt(" #n ")" ::: "memory")
#define PG8_WAIT_L(n) asm volatile("s_waitcnt lgkmcnt(" #n ")" ::: "memory")
#define PG8_BAR __builtin_amdgcn_s_barrier()
#define PG8_SCHED __builtin_amdgcn_sched_barrier(0)
#define PG8_SCHED8 do { if constexpr (FP8) __builtin_amdgcn_sched_barrier(0); } while (0)
    Unit cur, nxt; int ui = 0;
#define PG8_UNI(u_) do { u_.pm = __builtin_amdgcn_readfirstlane(u_.pm); u_.pn = __builtin_amdgcn_readfirstlane(u_.pn); u_.pb = __builtin_amdgcn_readfirstlane(u_.pb); u_.aux = __builtin_amdgcn_readfirstlane(u_.aux); u_.aux2 = __builtin_amdgcn_readfirstlane(u_.aux2); } while (0)
    if (!S.next(0, cur)) return;
    PG8_UNI(cur);
    f32x4 acc[2][2][4][2];
#pragma unroll
    for (int a = 0; a < 2; ++a)
#pragma unroll
        for (int b = 0; b < 2; ++b)
#pragma unroll
            for (int m = 0; m < 4; ++m)
#pragma unroll
                for (int n = 0; n < 2; ++n) acc[a][b][m][n] = (f32x4){0.f, 0.f, 0.f, 0.f};
    bf16x8 At[4][2], B0[2][2], B1[2][2];
    const char* cA = (const char*)g.A + (GATHER ? (size_t)0 : (size_t)cur.pm * tstepA); const char* cB = (const char*)g.Bt + (size_t)cur.pb * tstepB;
    PG8_SETVA(vAc, 0);
    PG8_STB(PG8_SB(0, 0), cB); PG8_STB(PG8_SB(0, 1), cB + hstepB); PG8_STAGE(PG8_SA(0, 0), cA, vAc[0][0], vAc[0][1]); PG8_STAGE(PG8_SA(0, 1), cA, vAc[1][0], vAc[1][1]);
    if (wr == 1) PG8_BAR;
    PG8_WAIT_V(2); PG8_BAR;
    PG8_STB(PG8_SB(1, 0), cB + kstep); PG8_STAGE(PG8_SA(1, 0), cA + kstep, vAc[0][0], vAc[0][1]); PG8_STB(PG8_SB(1, 1), cB + hstepB + kstep);
    PG8_WAIT_V(6); PG8_BAR;
    for (;;) {
        const bool has_next = S.next(ui + 1, nxt);
        PG8_UNI(nxt);
        const char* nA = GATHER ? cA : (has_next ? (const char*)g.A + (size_t)nxt.pm * tstepA : cA); const char* nB = has_next ? (const char*)g.Bt + (size_t)nxt.pb * tstepB : cB;
        const int nui = has_next ? ui + 1 : ui;
#pragma nounroll
        for (int t = 0; t < nt; t += 2) {
            const bool last = (t == nt - 2);
            const char* a1 = cA + (size_t)(t + 1) * kstep;
            const char* a2 = last ? nA : cA + (size_t)(t + 2) * kstep; const char* b2 = last ? nB : cB + (size_t)(t + 2) * kstep;
            const char* a3 = a2 + kstep; const char* b3 = b2 + kstep;
            unsigned x00 = vAc[0][0], x01 = vAc[0][1], x10 = vAc[1][0], x11 = vAc[1][1];
            if (GATHER) { if (last) { unsigned vN_[2][2]; PG8_SETVA(vN_, nui); x00 = vN_[0][0]; x01 = vN_[0][1]; x10 = vN_[1][0]; x11 = vN_[1][1]; } }
            PG8_LDB(B0, 0, 0); PG8_LDB(B1, 0, 1); PG8_SCHED; PG8_LDA(At, 0, 0); PG8_STAGE(PG8_SA(1, 1), a1, vAc[1][0], vAc[1][1]);
            PG8_WAIT_V(8); PG8_WAIT_L(0); PG8_BAR; PG8_SCHED8; PG8_MMA(0, 0, At, B0); PG8_MMA(0, 1, At, B1); PG8_SCHED8; PG8_BAR; PG8_SCHED;
            PG8_LDA(At, 0, 1); PG8_STB(PG8_SB(0, 0), b2); PG8_STB(PG8_SB(0, 1), b2 + hstepB); PG8_STAGE(PG8_SA(0, 0), a2, x00, x01);
            PG8_WAIT_V(8); PG8_WAIT_L(0); PG8_BAR; PG8_SCHED8; PG8_MMA(1, 0, At, B0); PG8_MMA(1, 1, At, B1); PG8_SCHED8; PG8_BAR; PG8_SCHED;
            PG8_LDB(B0, 1, 0); PG8_LDB(B1, 1, 1); PG8_SCHED; PG8_LDA(At, 1, 0); PG8_STAGE(PG8_SA(0, 1), a2, x10, x11);
            PG8_WAIT_V(8); PG8_WAIT_L(0); PG8_BAR; PG8_SCHED8; PG8_MMA(0, 0, At, B0); PG8_MMA(0, 1, At, B1); PG8_SCHED8; PG8_BAR; PG8_SCHED;
            PG8_LDA(At, 1, 1); PG8_STB(PG8_SB(1, 0), b3); PG8_STB(PG8_SB(1, 1), b3 + hstepB); PG8_STAGE(PG8_SA(1, 0), a3, x00, x01);
            PG8_WAIT_V(8); PG8_WAIT_L(0); PG8_BAR; PG8_SCHED8; PG8_MMA(1, 0, At, B0); PG8_MMA(1, 1, At, B1); PG8_SCHED8; PG8_BAR; PG8_SCHED;
        }
        if constexpr (ALIGN_EPI) { if (wr == 0) PG8_BAR; }
        { int l_ = lane_id(); asm volatile("" : "+v"(l_));
          E(acc, cur, wr, wc, l_ & 15, l_ >> 4); }
        if (!has_next) break;
#pragma unroll
        for (int a = 0; a < 2; ++a)
#pragma unroll
            for (int b = 0; b < 2; ++b)
#pragma unroll
                for (int m = 0; m < 4; ++m)
#pragma unroll
                    for (int n = 0; n < 2; ++n) acc[a][b][m][n] = (f32x4){0.f, 0.f, 0.f, 0.f};
        cur = nxt; cA = nA; cB = nB; ++ui;
        if (GATHER) { PG8_SETVA(vAc, ui); }
        if constexpr (ALIGN_EPI) { if (wr == 1) PG8_BAR; }
    }
    PG8_WAIT_V(0);
    if constexpr (!ALIGN_EPI) { if (wr == 0) PG8_BAR; }
    PG8_BAR;
#undef PG8_SETVA
#undef PG8_UNI
#undef PG8_SA
#undef PG8_SB
#undef PG8_STAGE
#undef PG8_GLDS_S
#undef PG8_STB
#undef PG8_LDA
#undef PG8_LDB
#undef PG8_MMA
#undef PG8_WAIT_V
#undef PG8_WAIT_L
#undef PG8_BAR
#undef PG8_SCHED
#undef PG8_SCHED8
}
}
constexpr int NWAVES = 8, NTHR = 512;
constexpr int BATCH = 8, SEQ = 8192, T = BATCH * SEQ, D = 1024, DIN = 4096;
constexpr int DS = 512, DA = 512, NH = 8, HD = 64, NBLK = SEQ / 256;
constexpr int SG = 32, SHC = 16, SP = 64, SL = 32, SKU = SL * SHC  , SKS = 2 * SP  , SKY = SKU + SKS  , SROWS = T / SL  ;
constexpr int NE = 32, DE = 512;
constexpr float RMS_EPS = 1e-6f;
constexpr float LOG2E = 1.4426950408889634f;
constexpr float QSCALE = 0.125f * LOG2E;
constexpr float WF8_SCALE = 32.f;
constexpr int ROWCAP = T;
constexpr int HID_ROWS = 2 * T + NE * 256;

constexpr size_t MiB = 1u << 20;
constexpr size_t WS_CTL = 0, CTL_ZERO_BYTES = 1 * MiB;
constexpr size_t WS_WIN = 1 * MiB;
constexpr size_t WS_WGLU = 9 * MiB;
constexpr size_t WS_WUS = 10 * MiB;
constexpr size_t WS_WUA = 11 * MiB;
constexpr size_t WS_WOUT = 12 * MiB;
constexpr size_t WS_WR = 14 * MiB;
constexpr size_t WS_KMEAN = 15 * MiB;
constexpr size_t WS_SSMW = 16 * MiB;
constexpr size_t WS_SSMT = 24 * MiB;
constexpr size_t WS_W13 = 44 * MiB;
constexpr size_t WS_W2 = 108 * MiB;
constexpr size_t WS_A0 = 140 * MiB;
constexpr size_t WS_UP = 276 * MiB;
constexpr size_t WS_Q = 356 * MiB;
constexpr size_t WS_SSQ = 404 * MiB;
constexpr size_t WS_RLOG = 408 * MiB;
constexpr size_t WS_K = 420 * MiB;
constexpr size_t WS_ROWTOK = 428 * MiB, WS_ROWCOEF = 436 * MiB, WS_ROWRSTD = 444 * MiB;
constexpr size_t WS_GACT = 420 * MiB;
constexpr size_t WS_V = 484 * MiB;
constexpr size_t WS_YSSM = 484 * MiB;
constexpr size_t WS_SGS = 548 * MiB;
constexpr size_t WS_SGA = 676 * MiB;
constexpr size_t WS_E = 804 * MiB;
constexpr size_t WS_YATT = 836 * MiB;
constexpr size_t WS_PART0 = 420 * MiB, WS_PART1 = 484 * MiB, WS_PART2 = 932 * MiB;
constexpr size_t WS_QLIST = 900 * MiB;
constexpr size_t WS_PL = 268 * MiB;
constexpr size_t WS_MQ = 996 * MiB;
constexpr size_t WS_H1F8 = 836 * MiB;
constexpr size_t WS_WINF8 = 900 * MiB;
constexpr size_t WS_XGF8 = 836 * MiB;
constexpr size_t WS_SEGC = 998 * MiB;
constexpr size_t WS_END = 999 * MiB;
constexpr size_t WS_KFRAG = WS_A0, WS_VFRAG = WS_A0 + 64 * MiB, WS_H1 = WS_A0, WS_MRG = WS_A0, WS_HID = WS_A0;
constexpr size_t WS_X1 = WS_SGS, WS_XG = WS_UP, WS_Y0 = WS_UP, WS_Y1 = WS_E;
static_assert(WS_GACT + 64 * MiB <= WS_YSSM && WS_YSSM + 64 * MiB <= WS_SGS, "map");
static_assert(WS_HID + (size_t)HID_ROWS * DE * 2 <= WS_UP, "hid fits");
static_assert(WS_RLOG + (size_t)T * 72 * 4 <= WS_ROWTOK, "rlog fits");

constexpr int CW_TMO = 0, CW_CODE = 1;
constexpr int CW_BAR = 4096;
constexpr int CW_ECNT = 8192;
constexpr int CW_GCNT = 12288;

constexpr int RING_BYTES = 131072;
constexpr int ROWTAB_OFF = RING_BYTES, ROWTAB_UNITS = 12, ROWTAB_BYTES = 24 * 1024;
constexpr int MOE_TST_OFF = ROWTAB_OFF + ROWTAB_BYTES;
constexpr int MISC_OFF = MOE_TST_OFF + 512;
constexpr int LDS_BYTES = MISC_OFF + 128;
static_assert(LDS_BYTES <= 163840, "LDS");

struct Frame {
    LAS unsigned char* lds;
    volatile LAS unsigned* MISC;
    gu32* ctl;
    unsigned char* ws;
    int tid, lane, wave, vcu, G;
    const float* in[27];
    float* out;
};

__device__ __forceinline__ unsigned pk4_fp8(float a, float b, float c, float d) { int w = 0; w = __builtin_amdgcn_cvt_pk_fp8_f32(a, b, w, false); w = __builtin_amdgcn_cvt_pk_fp8_f32(c, d, w, true); return (unsigned)w; }
#define EPI_LOOP_BEGIN  _Pragma("unroll") for (int ai = 0; ai < 2; ++ai) _Pragma("unroll") for (int m = 0; m < 4; ++m) { const int rl = ai * 128 + wr * 64 + m * 16 + fr; _Pragma("unroll") for (int bj = 0; bj < 2; ++bj) { const int cl = bj * 128 + wc * 32 + 8 * fq; \
        const f32x4 a0 = acc[ai][bj][m][0], a1 = acc[ai][bj][m][1]; (void)rl; (void)cl; (void)a0; (void)a1;
#define EPI_LOOP_END } }
typedef const f32x4 (&AccRef)[2][2][4][2];
__device__ __forceinline__ u32x4 pack8(f32x4 a, f32x4 b) { u32x4 w; w.x = cvt_pk_bf16(a[0], a[1]); w.y = cvt_pk_bf16(a[2], a[3]); w.z = cvt_pk_bf16(b[0], b[1]); w.w = cvt_pk_bf16(b[2], b[3]); return w; }
__device__ __forceinline__ void unpack8(u32x4 w, f32x4& a, f32x4& b) { a = (f32x4){bflo(w.x), bfhi(w.x), bflo(w.y), bfhi(w.y)}; b = (f32x4){bflo(w.z), bfhi(w.z), bflo(w.w), bfhi(w.w)}; }

template <int PART  > struct EpiProj {
    unsigned char* ws; const float* b_gate; int pn_off; float ascale;
    __device__ __forceinline__ void operator()(AccRef acc, const pg8::Unit& u, int wr, int wc, int fr, int fq) const {
        const int pn = u.pn + pn_off; const int row0 = u.pm * 256;
        if (PART == 0) {
            bf16_t* Uperm = (bf16_t*)(ws + WS_UP);
            EPI_LOOP_BEGIN
                const int row = row0 + rl, col = pn * 256 + cl;
                bf16_t* dst = Uperm + (size_t)(col >> 4) * ((size_t)SROWS * SKY) + (size_t)(row >> 5) * SKY + (row & 31) * 16 + (col & 15);
                *(u32x4*)dst = pack8(a0 * ascale, a1 * ascale);
            EPI_LOOP_END
        } else if (pn < 8) {
            const size_t boff = pn < 4 ? WS_Q : (pn < 6 ? WS_K : WS_V);
            bf16_t* base = (bf16_t*)(ws + boff); const float sc = pn < 4 ? QSCALE : 1.f; const int c0 = (pn & 1) * 256;
            EPI_LOOP_BEGIN
                const int row = row0 + rl, col = c0 + cl;
                *(u32x4*)(base + (size_t)row * 512 + col) = pack8(a0 * (sc * ascale), a1 * (sc * ascale));
            EPI_LOOP_END
        } else {
            const size_t boff = pn < 12 ? WS_SGS : WS_SGA;
            bf16_t* base = (bf16_t*)(ws + boff); const int c0 = ((pn - 8) & 3) * 256; const float* bg = b_gate + (pn - 8) * 256;
            EPI_LOOP_BEGIN
                const int row = row0 + rl, col = c0 + cl;
                const f32x4 b0 = *(const f32x4*)(bg + cl), b1 = *(const f32x4*)(bg + cl + 4);
                f32x4 s0, s1;
#pragma unroll
                for (int e = 0; e < 4; ++e) { s0[e] = fast_sigmoid(a0[e] * ascale + b0[e]); s1[e] = fast_sigmoid(a1[e] * ascale + b1[e]); }
                *(u32x4*)(base + (size_t)row * 1024 + col) = pack8(s0, s1);
            EPI_LOOP_END
        }
    }
};
struct EpiSsmE {
    float* E;
    __device__ __forceinline__ void operator()(AccRef acc, const pg8::Unit& u, int wr, int wc, int fr, int fq) const {
        EPI_LOOP_BEGIN
            if (bj == 0) { float* dst = E + (size_t)(u.pm * 256 + rl) * 128 + cl; *(f32x4*)dst = a0; *(f32x4*)(dst + 4) = a1; }
        EPI_LOOP_END
    }
};
__device__ __forceinline__ float gelu_tanh(float x) { const float z = 1.5957691216057308f * (x + 0.044715f * x * x * x); return x * fast_sigmoid(z); }
struct EpiSsmY {
    bf16_t* Gact;
    __device__ __forceinline__ void operator()(AccRef acc, const pg8::Unit& u, int wr, int wc, int fr, int fq) const {
        const int g = u.aux;
        EPI_LOOP_BEGIN
            const int rg = (u.pm & 7) * 256 + rl;
            const int colg = u.pn * 256 + cl;
            const int tok = (rg >> 8) * SEQ + (rg & 255) * SL + (colg >> 4);
            f32x4 y0, y1;
#pragma unroll
            for (int e = 0; e < 4; ++e) { y0[e] = gelu_tanh(a0[e]); y1[e] = gelu_tanh(a1[e]); }
            *(u32x4*)(Gact + (size_t)tok * DS + g * 16 + (colg & 15)) = pack8(y0, y1);
        EPI_LOOP_END
    }
};
struct EpiGlu {
    const bf16_t* Gact; bf16_t* Yssm; const float* b_glu;
    __device__ __forceinline__ void operator()(AccRef acc, const pg8::Unit& u, int wr, int wc, int fr, int fq) const {
        EPI_LOOP_BEGIN
            const int row = u.pm * 256 + rl, col = u.pn * 256 + cl;
            const f32x4 b0 = *(const f32x4*)(b_glu + col), b1 = *(const f32x4*)(b_glu + col + 4);
            f32x4 g0, g1; unpack8(*(const u32x4*)(Gact + (size_t)row * DS + col), g0, g1);
            f32x4 y0, y1;
#pragma unroll
            for (int e = 0; e < 4; ++e) { y0[e] = g0[e] * fast_sigmoid(a0[e] + b0[e]); y1[e] = g1[e] * fast_sigmoid(a1[e] + b1[e]); }
            *(u32x4*)(Yssm + (size_t)row * DS + col) = pack8(y0, y1);
        EPI_LOOP_END
    }
};
template <bool SECOND> struct EpiUp {
    const bf16_t* SG; bf16_t* Mrg;
    __device__ __forceinline__ void operator()(AccRef acc, const pg8::Unit& u, int wr, int wc, int fr, int fq) const {
        EPI_LOOP_BEGIN
            const size_t off = (size_t)(u.pm * 256 + rl) * D + u.pn * 256 + cl;
            f32x4 s0, s1; unpack8(*(const u32x4*)(SG + off), s0, s1);
            f32x4 y0 = s0 * a0, y1 = s1 * a1;
            if (SECOND) { f32x4 p0, p1; unpack8(*(const u32x4*)(Mrg + off), p0, p1); y0 += p0; y1 += p1; }
            *(u32x4*)(Mrg + off) = pack8(y0, y1);
        EPI_LOOP_END
    }
};
struct EpiOut {
    const float* x; float* X1; bf16_t* XG; unsigned char* XG8; const float* g2; float* SSQ;
    __device__ __forceinline__ void operator()(AccRef acc, const pg8::Unit& u, int wr, int wc, int fr, int fq) const {
#pragma unroll
        for (int ai = 0; ai < 2; ++ai)
#pragma unroll
            for (int m = 0; m < 4; ++m) { const int row = u.pm * 256 + ai * 128 + wr * 64 + m * 16 + fr; float ss = 0.f;
#pragma unroll
                for (int bj = 0; bj < 2; ++bj) { const int col = u.pn * 256 + bj * 128 + wc * 32 + 8 * fq; const size_t off = (size_t)row * D + col;
                    const f32x4 x0 = *(const f32x4*)(x + off) + acc[ai][bj][m][0], x1 = *(const f32x4*)(x + off + 4) + acc[ai][bj][m][1];
                    *(f32x4*)(X1 + off) = x0; *(f32x4*)(X1 + off + 4) = x1;
                    ss += (x0[0] * x0[0] + x0[1] * x0[1]) + (x0[2] * x0[2] + x0[3] * x0[3]) + (x1[0] * x1[0] + x1[1] * x1[1]) + (x1[2] * x1[2] + x1[3] * x1[3]);
                    const f32x4 w0 = *(const f32x4*)(g2 + col), w1 = *(const f32x4*)(g2 + col + 4);
                    const f32x4 y0 = x0 * w0, y1 = x1 * w1;
                    *(u32x4*)(XG + off) = pack8(y0, y1); *(u32x2*)(XG8 + off) = (u32x2){pk4_fp8(y0[0], y0[1], y0[2], y0[3]), pk4_fp8(y1[0], y1[1], y1[2], y1[3])}; }
                ss += __shfl_xor(ss, 16); ss += __shfl_xor(ss, 32);
                if (fq == 0) SSQ[(size_t)row * 16 + u.pn * 4 + wc] = ss; }
    }
};
struct EpiRouter {
    float* Rlog;
    __device__ __forceinline__ void operator()(AccRef acc, const pg8::Unit& u, int wr, int wc, int fr, int fq) const {
        EPI_LOOP_BEGIN
            if (bj == 0 && cl < 72) { float* dst = Rlog + (size_t)(u.pm * 256 + rl) * 72 + cl; *(f32x4*)dst = a0; *(f32x4*)(dst + 4) = a1; }
        EPI_LOOP_END
    }
};
struct EpiMoe1 {
    bf16_t* Hid; const float* rowrstd; const unsigned* ecnt; float ascale;
    __device__ __forceinline__ void operator()(AccRef acc, const pg8::Unit& u, int wr, int wc, int fr, int fq) const {
        const int e = u.aux, cnt = (int)ecnt[e];
#pragma unroll
        for (int ai = 0; ai < 2; ++ai)
#pragma unroll
            for (int m = 0; m < 4; ++m) { const int rl = ai * 128 + wr * 64 + m * 16 + fr; const int pos = u.aux2 + rl;
                if (pos < cnt) { const float rs = rowrstd[(size_t)e * ROWCAP + pos] * ascale;
                    f32x4 h0, h1;
#pragma unroll
                    for (int k = 0; k < 4; ++k) { const float p = acc[ai][0][m][0][k] * rs, q = acc[ai][1][m][0][k] * rs; h0[k] = p * fast_sigmoid(p) * q;
                        const float p2 = acc[ai][0][m][1][k] * rs, q2 = acc[ai][1][m][1][k] * rs; h1[k] = p2 * fast_sigmoid(p2) * q2; }
                    *(u32x4*)(Hid + (size_t)(u.pm * 256 + rl) * DE + u.pn * 128 + wc * 32 + 8 * fq) = pack8(h0, h1); } }
    }
};
struct EpiMoe2 {
    bf16_t* Y0; size_t ydelta; const unsigned* rowtok; const float* rowcoef; const unsigned* ecnt;
    __device__ __forceinline__ void operator()(AccRef acc, const pg8::Unit& u, int wr, int wc, int fr, int fq) const {
        const int e = u.aux, cnt = (int)ecnt[e];
#pragma unroll
        for (int ai = 0; ai < 2; ++ai)
#pragma unroll
            for (int m = 0; m < 4; ++m) { const int rl = ai * 128 + wr * 64 + m * 16 + fr; const int pos = u.aux2 + rl;
                if (pos < cnt) { const unsigned tk = rowtok[(size_t)e * ROWCAP + pos]; const float cf = rowcoef[(size_t)e * ROWCAP + pos];
                    bf16_t* dst = (bf16_t*)((unsigned char*)Y0 + (size_t)(tk & 1u) * ydelta) + (size_t)(tk >> 1) * D + u.pn * 256 + wc * 32 + 8 * fq;
#pragma unroll
                    for (int bj = 0; bj < 2; ++bj) *(u32x4*)(dst + bj * 128) = pack8(acc[ai][bj][m][0] * cf, acc[ai][bj][m][1] * cf); } }
    }
};
__device__ __forceinline__ void transpose_item(const float* W, int N, int k0, int n0, bf16_t* WT, size_t drow0, int ldo, LAS float* scr, int lane) {
    float tv[32];
#pragma unroll
    for (int i = 0; i < 32; ++i) tv[i] = W[(size_t)(k0 + 2 * i + (lane >> 5)) * N + n0 + (lane & 31)];
#pragma unroll
    for (int i = 0; i < 32; ++i) scr[(2 * i + (lane >> 5)) * 33 + (lane & 31)] = tv[i];
    LDS_WAIT(); asm volatile("" ::: "memory");
    const int c = lane & 7;
#pragma unroll
    for (int j = 0; j < 4; ++j) { const int n = (lane >> 3) + 8 * j; const LAS float* s = scr + (8 * c) * 33 + n;
        u32x4 o; o.x = pk2(s[0 * 33], s[1 * 33]); o.y = pk2(s[2 * 33], s[3 * 33]); o.z = pk2(s[4 * 33], s[5 * 33]); o.w = pk2(s[6 * 33], s[7 * 33]);
        *(u32x4*)(WT + (drow0 + n) * (size_t)ldo + k0 + 8 * c) = o; }
    LDS_WAIT(); asm volatile("" ::: "memory");
}
__device__ __forceinline__ void transpose_item_f8(const float* W, int N, int k0, int n0, unsigned char* WT8, size_t drow0, int ldo, float scale, LAS float* scr, int lane) {
    float tv[32];
#pragma unroll
    for (int i = 0; i < 32; ++i) tv[i] = W[(size_t)(k0 + 2 * i + (lane >> 5)) * N + n0 + (lane & 31)];
#pragma unroll
    for (int i = 0; i < 32; ++i) scr[(2 * i + (lane >> 5)) * 33 + (lane & 31)] = tv[i] * scale;
    LDS_WAIT(); asm volatile("" ::: "memory");
    const int c = lane & 3;
#pragma unroll
    for (int j = 0; j < 2; ++j) { const int n = (lane >> 2) + 16 * j; const LAS float* s = scr + (16 * c) * 33 + n;
        u32x4 o; o.x = pk4_fp8(s[0 * 33], s[1 * 33], s[2 * 33], s[3 * 33]); o.y = pk4_fp8(s[4 * 33], s[5 * 33], s[6 * 33], s[7 * 33]);
        o.z = pk4_fp8(s[8 * 33], s[9 * 33], s[10 * 33], s[11 * 33]); o.w = pk4_fp8(s[12 * 33], s[13 * 33], s[14 * 33], s[15 * 33]);
        *(u32x4*)(WT8 + (drow0 + n) * (size_t)ldo + k0 + 16 * c) = o; }
    LDS_WAIT(); asm volatile("" ::: "memory");
}
template <int NR> __device__ __forceinline__ void rms_rows_to_bf16(int lane, const float* xrow, const float* g, bf16_t* orow, unsigned char* orow8) {
    f32x4 v[NR][4]; float s[NR];
#pragma unroll
    for (int r = 0; r < NR; ++r) { const f32x4* xr = (const f32x4*)(xrow + (size_t)r * D) + lane;
#pragma unroll
        for (int j = 0; j < 4; ++j) v[r][j] = xr[64 * j]; }
    const f32x4* gr = (const f32x4*)g + lane; f32x4 wv[4];
#pragma unroll
    for (int j = 0; j < 4; ++j) wv[j] = gr[64 * j];
#pragma unroll
    for (int r = 0; r < NR; ++r) { float a = 0.f;
#pragma unroll
        for (int j = 0; j < 4; ++j) a += (v[r][j].x * v[r][j].x + v[r][j].y * v[r][j].y) + (v[r][j].z * v[r][j].z + v[r][j].w * v[r][j].w);
        s[r] = a; }
#pragma unroll
    for (int o = 1; o < 64; o <<= 1) {
#pragma unroll
        for (int r = 0; r < NR; ++r) s[r] += __shfl_xor(s[r], o); }
#pragma unroll
    for (int r = 0; r < NR; ++r) { const float rstd = 1.f / sqrtf(s[r] * (1.f / D) + RMS_EPS); unsigned long long* o8 = (unsigned long long*)(orow + (size_t)r * D) + lane;
#pragma unroll
        for (int j = 0; j < 4; ++j) { const float y0 = v[r][j].x * rstd * wv[j].x, y1 = v[r][j].y * rstd * wv[j].y, y2 = v[r][j].z * rstd * wv[j].z, y3 = v[r][j].w * rstd * wv[j].w;
            o8[64 * j] = (unsigned long long)pk2(y0, y1) | ((unsigned long long)pk2(y2, y3) << 32);
            ((unsigned*)(orow8 + (size_t)r * D))[lane + 64 * j] = pk4_fp8(y0, y1, y2, y3); } }
}
__device__ __forceinline__ void cpow(float lr, float li, float step, float dl, float& ar, float& ai) {
    const float mag = __expf(dl * lr * step); const float rev = dl * (li * step * 0.15915494309189535f); const float fr = rev - floorf(rev);
    ar = mag * __builtin_amdgcn_cosf(fr); ai = mag * __builtin_amdgcn_sinf(fr);
}
__device__ __forceinline__ void ssm_gen(Frame& F, int g, int sl) {
    LAS float* AP = (LAS float*)(F.lds); LAS float* BB = AP + 33 * 64 * 2; LAS float* CC = BB + 2048; LAS float* KT = CC + 2048;
    const float* lam_re = F.in[4] + g * SP; const float* lam_im = F.in[5] + g * SP; const float step = __expf(F.in[6][g]);
    const float* b_re = F.in[7] + g * SP * SHC; const float* b_im = F.in[8] + g * SP * SHC; const float* c_re = F.in[9] + g * SHC * SP; const float* c_im = F.in[10] + g * SHC * SP; const float* dd = F.in[11] + g * SHC;
    bf16_t* BT = (bf16_t*)(F.ws + WS_SSMT) + (size_t)g * 512 * SKY; bf16_t* BW = (bf16_t*)(F.ws + WS_SSMW) + (size_t)g * 256 * SKU;
    const int tid = F.tid;
    for (int idx = tid; idx < 33 * 64; idx += NTHR) { const int dl = idx >> 6, p = idx & 63; float ar, ai; cpow(lam_re[p], lam_im[p], step, (float)dl, ar, ai); AP[idx * 2] = ar; AP[idx * 2 + 1] = ai; }
    for (int idx = tid; idx < 1024; idx += NTHR) { const int ho = idx >> 6, p = idx & 63; CC[idx * 2] = c_re[ho * 64 + p]; CC[idx * 2 + 1] = c_im[ho * 64 + p]; }
    __syncthreads();
    for (int idx = tid; idx < 1024; idx += NTHR) { const int p = idx >> 4, h = idx & 15; const float ar = AP[(64 + p) * 2], ai = AP[(64 + p) * 2 + 1];
        const float lr = lam_re[p], li = lam_im[p], nr = ar - 1.f, ni = ai, den = lr * lr + li * li, cr = (nr * lr + ni * li) / den, ci = (ni * lr - nr * li) / den;
        const float br = b_re[p * 16 + h], bi = b_im[p * 16 + h]; BB[idx * 2] = cr * br - ci * bi; BB[idx * 2 + 1] = cr * bi + ci * br; }
    __syncthreads();
    for (int idx = tid; idx < 1024; idx += NTHR) { const int dl = idx >> 5, hl = (idx >> 4) & 1, hi = idx & 15, ho = 2 * sl + hl; float s = 0.f;
        for (int p = 0; p < 64; ++p) { const float ar = AP[(dl * 64 + p) * 2], ai = AP[(dl * 64 + p) * 2 + 1], br = BB[(p * 16 + hi) * 2], bi = BB[(p * 16 + hi) * 2 + 1];
            const float zr = ar * br - ai * bi, zi = ar * bi + ai * br; s += CC[(ho * 64 + p) * 2] * zr - CC[(ho * 64 + p) * 2 + 1] * zi; }
        if (dl == 0 && ho == hi) s += dd[ho];
        KT[idx] = s; }
    __syncthreads();
    for (int v = tid; v < 64 * 80; v += NTHR) { const int nl = v / 80, kv = (v % 80) * 8, tau = nl >> 1, hl = nl & 1, ho = 2 * sl + hl, n = tau * 16 + ho; float val[8];
        if (kv < 512) { const int sg = kv >> 4, hi0 = kv & 15;
#pragma unroll
            for (int e = 0; e < 8; ++e) val[e] = (tau >= sg) ? KT[((tau - sg) * 2 + hl) * 16 + hi0 + e] : 0.f; }
        else { const int kk = kv - 512;
#pragma unroll
            for (int e = 0; e < 8; ++e) { const int p = (kk + e) >> 1, ri = (kk + e) & 1; const float ar = AP[((tau + 1) * 64 + p) * 2], ai = AP[((tau + 1) * 64 + p) * 2 + 1], cre = CC[(ho * 64 + p) * 2], cim = CC[(ho * 64 + p) * 2 + 1];
                val[e] = ri == 0 ? (cre * ar - cim * ai) : -(cre * ai + cim * ar); } }
        u32x4 o; o.x = pk2(val[0], val[1]); o.y = pk2(val[2], val[3]); o.z = pk2(val[4], val[5]); o.w = pk2(val[6], val[7]);
        *(u32x4*)(BT + (size_t)n * SKY + kv) = o; }
    for (int v = tid; v < 32 * 64; v += NTHR) { const int nl = v >> 6, kv = (v & 63) * 8; float val[8];
        const bool real = nl < 16; const int n = real ? 16 * sl + nl : 128 + 16 * sl + (nl - 16);
        if (real) { const int p = n >> 1, ri = n & 1, sg = kv >> 4, hi0 = kv & 15; const float ar = AP[((31 - sg) * 64 + p) * 2], ai = AP[((31 - sg) * 64 + p) * 2 + 1];
#pragma unroll
            for (int e = 0; e < 8; ++e) { const float br = BB[(p * 16 + hi0 + e) * 2], bi = BB[(p * 16 + hi0 + e) * 2 + 1]; val[e] = ri == 0 ? (ar * br - ai * bi) : (ar * bi + ai * br); } }
        else {
#pragma unroll
            for (int e = 0; e < 8; ++e) val[e] = 0.f; }
        u32x4 o; o.x = pk2(val[0], val[1]); o.y = pk2(val[2], val[3]); o.z = pk2(val[4], val[5]); o.w = pk2(val[6], val[7]);
        *(u32x4*)(BW + (size_t)n * SKU + kv) = o; }
    __syncthreads();
}
__device__ __forceinline__ void p0_prologue(Frame& F) {
    for (int it = F.vcu; it < SG * 8; it += F.G) ssm_gen(F, it >> 3, it & 7);
    LAS float* scr = (LAS float*)(F.lds + F.wave * 16384);
    const int gw = F.vcu * NWAVES + F.wave, NGW = F.G * NWAVES, lane = F.lane;
    constexpr int I_IN = 16 * 128, I_GLU = 8 * 16, I_US = 8 * 32, I_UA = 8 * 32, I_OUT = 16 * 32, I_W1 = 32 * 256, I_W3 = 32 * 256, I_W2 = 32 * 256;
    constexpr int NITEMS = I_IN + I_GLU + I_US + I_UA + I_OUT + I_W1 + I_W3 + I_W2;
    unsigned char* ws = F.ws;
    for (int it = gw; it < NITEMS; it += NGW) {
        int r = it;
        if (r < I_IN) { const int k0 = 64 * (r / 128), n0 = 32 * (r % 128);
            if (n0 < DS) transpose_item(F.in[2], DIN, k0, n0, (bf16_t*)(ws + WS_WIN), n0, D, scr, lane);
            else transpose_item_f8(F.in[2], DIN, k0, n0, ws + WS_WINF8, n0 - DS, D, WF8_SCALE, scr, lane);
            continue; } r -= I_IN;
        if (r < I_GLU) { transpose_item(F.in[12], DS, 64 * (r / 16), 32 * (r % 16), (bf16_t*)(ws + WS_WGLU), 32 * (r % 16), DS, scr, lane); continue; } r -= I_GLU;
        if (r < I_US) { transpose_item(F.in[14], D, 64 * (r / 32), 32 * (r % 32), (bf16_t*)(ws + WS_WUS), 32 * (r % 32), DS, scr, lane); continue; } r -= I_US;
        if (r < I_UA) { transpose_item(F.in[15], D, 64 * (r / 32), 32 * (r % 32), (bf16_t*)(ws + WS_WUA), 32 * (r % 32), DA, scr, lane); continue; } r -= I_UA;
        if (r < I_OUT) { transpose_item(F.in[17], D, 64 * (r / 32), 32 * (r % 32), (bf16_t*)(ws + WS_WOUT), 32 * (r % 32), D, scr, lane); continue; } r -= I_OUT;
        if (r < I_W1 + I_W3) { const int w3 = r >= I_W1; if (w3) r -= I_W1; const int e = r >> 8, q = r & 255, k0 = 64 * (q / 16), n0 = 32 * (q % 16);
            transpose_item_f8((w3 ? F.in[24] : F.in[23]) + (size_t)e * D * DE, DE, k0, n0, ws + WS_W13, (size_t)e * 1024 + 256 * (n0 >> 7) + (n0 & 127) + (w3 ? 128 : 0), D, WF8_SCALE, scr, lane); continue; }
        r -= I_W1 + I_W3;
        { const int e = r >> 8, q = r & 255, k0 = 64 * (q / 32), n0 = 32 * (q % 32);
            transpose_item(F.in[25] + (size_t)e * DE * D, D, k0, n0, (bf16_t*)(ws + WS_W2), (size_t)e * 1024 + n0, DE, scr, lane); }
    }
    for (int m = 4 * gw; m < T; m += 4 * NGW) rms_rows_to_bf16<4>(lane, F.in[0] + (size_t)m * D, F.in[1], (bf16_t*)(ws + WS_H1) + (size_t)m * D, ws + WS_H1F8 + (size_t)m * D);
    { bf16_t* WR = (bf16_t*)(ws + WS_WR); const float* wrg = F.in[19]; const float* wre = F.in[21];
      for (int idx = F.vcu * NTHR + F.tid; idx < 256 * D; idx += F.G * NTHR) { const int r = idx >> 10, k = idx & 1023; unsigned o = 0u;
          if (r < 72) { const int c = r < 36 ? r : r - 36; const float w = c < 4 ? wrg[k * 4 + c] : wre[k * 32 + (c - 4)]; const unsigned hb = f2bf(w);
              o = r < 36 ? hb : f2bf(w - __builtin_bit_cast(float, hb << 16)); }
          WR[idx] = (bf16_t)o; } }
}

__device__ __forceinline__ int crow(int r, int hi) { return (r & 3) + 8 * (r >> 2) + 4 * hi; }
constexpr int KVP = 72;
__device__ __forceinline__ void kv_prep_phase(Frame& F) {
    LAS bf16_t* KS = (LAS bf16_t*)(F.lds); LAS bf16_t* VS = KS + 256 * KVP; LAS float* PS = (LAS float*)(F.lds + 2 * 256 * KVP * 2); LAS float* WM = PS + 512;
    const bf16_t* Kb = (const bf16_t*)(F.ws + WS_K); const bf16_t* Vb = (const bf16_t*)(F.ws + WS_V);
    bf16_t* Kf = (bf16_t*)(F.ws + WS_KFRAG); bf16_t* Vf = (bf16_t*)(F.ws + WS_VFRAG); bf16_t* KM = (bf16_t*)(F.ws + WS_KMEAN); float* KN = (float*)(F.ws + WS_KMEAN + 512 * 1024);
    const int tid = F.tid;
    for (int item = F.vcu; item < BATCH * NH * NBLK; item += F.G) {
        const int n = item & 31, h = (item >> 5) & 7, b = item >> 8; const size_t tok0 = (size_t)b * SEQ + 256 * n;
#pragma unroll
        for (int j = 0; j < 4; ++j) { const int q = tid + NTHR * j, row = q >> 3, pc = q & 7; const size_t src = (tok0 + row) * DA + h * HD + pc * 8;
            *(LAS u32x4*)(KS + row * KVP + pc * 8) = *(const u32x4*)(Kb + src); *(LAS u32x4*)(VS + row * KVP + pc * 8) = *(const u32x4*)(Vb + src); }
        __syncthreads();
#pragma unroll
        for (int j = 0; j < 4; ++j) { const int P = tid + NTHR * j, st = P >> 8, ds = (P >> 6) & 3, l2 = P & 63, row = 32 * st + (l2 & 31), col = 16 * ds + 8 * (l2 >> 5);
            *(u32x4*)(Kf + ((size_t)item * 2048 + P) * 8) = *(const LAS u32x4*)(KS + row * KVP + col); }
#pragma unroll
        for (int j = 0; j < 4; ++j) { const int P = tid + NTHR * j, st = P >> 8, ks = (P >> 7) & 1, d0 = (P >> 6) & 1, l2 = P & 63, hi = l2 >> 5, jj = l2 & 31; unsigned w[4];
#pragma unroll
            for (int e = 0; e < 8; e += 2) { const unsigned lo = VS[(32 * st + 16 * ks + crow(e, hi)) * KVP + 32 * d0 + jj], hi16 = VS[(32 * st + 16 * ks + crow(e + 1, hi)) * KVP + 32 * d0 + jj]; w[e >> 1] = lo | (hi16 << 16); }
            *(u32x4*)(Vf + ((size_t)item * 2048 + P) * 8) = (u32x4){w[0], w[1], w[2], w[3]}; }
        { const int d = tid & 63, part = tid >> 6; float s = 0.f;
#pragma unroll 8
          for (int r = 0; r < 32; ++r) s += bf2f(KS[(part * 32 + r) * KVP + d]);
          PS[part * 64 + d] = s; }
        if (tid < 256) { float ss = 0.f;
#pragma unroll
            for (int c = 0; c < 8; ++c) { const u32x4 w = *(const LAS u32x4*)(KS + tid * KVP + c * 8);
                ss += bflo(w.x) * bflo(w.x) + bfhi(w.x) * bfhi(w.x) + bflo(w.y) * bflo(w.y) + bfhi(w.y) * bfhi(w.y) + bflo(w.z) * bflo(w.z) + bfhi(w.z) * bfhi(w.z) + bflo(w.w) * bflo(w.w) + bfhi(w.w) * bfhi(w.w); }
            ss = wave_max(ss); if (F.lane == 0) WM[F.wave] = ss; }
        __syncthreads();
        if (tid < 64) { float s = 0.f;
#pragma unroll
            for (int p = 0; p < 8; ++p) s += PS[p * 64 + tid];
            KM[(size_t)item * 64 + tid] = (bf16_t)f2bf(s * (1.f / 256.f)); }
        if (tid == 0) KN[item] = fmaxf(fmaxf(WM[0], WM[1]), fmaxf(WM[2], WM[3]));
        __syncthreads();
    }
}

__device__ __forceinline__ void ssm_scan_phase(Frame& F) {
    LAS float* FW = (LAS float*)(F.lds);
    const float* E = (const float*)(F.ws + WS_E); bf16_t* UP = (bf16_t*)(F.ws + WS_UP);
    const int w = F.wave, p = F.lane;
    for (int gb = F.vcu; gb < SG * BATCH; gb += F.G) {
        const int g = gb >> 3, b = gb & 7;
        const float lr = F.in[4][g * SP + p], li = F.in[5][g * SP + p], step = __expf(F.in[6][g]);
        float ar, ai; cpow(lr, li, step, 32.f, ar, ai);
        const size_t row0 = (size_t)g * SROWS + b * 256 + 32 * w;
        f32x2 e[32];
#pragma unroll
        for (int j = 0; j < 32; ++j) e[j] = *(const f32x2*)(E + (row0 + j) * 128 + 2 * p);
        float sr = 0.f, si = 0.f;
#pragma unroll
        for (int j = 0; j < 32; ++j) { const float nr = ar * sr - ai * si + e[j].x, ni = ar * si + ai * sr + e[j].y; sr = nr; si = ni; }
        FW[(w * 64 + p) * 2] = sr; FW[(w * 64 + p) * 2 + 1] = si;
        __syncthreads();
        float Ar = ar, Ai = ai;
#pragma unroll
        for (int q = 0; q < 5; ++q) { const float nr = Ar * Ar - Ai * Ai, ni = 2.f * Ar * Ai; Ar = nr; Ai = ni; }
        sr = 0.f; si = 0.f;
        for (int w2 = 0; w2 < w; ++w2) { const float fr = FW[(w2 * 64 + p) * 2], fi = FW[(w2 * 64 + p) * 2 + 1]; const float nr = Ar * sr - Ai * si + fr, ni = Ar * si + Ai * sr + fi; sr = nr; si = ni; }
#pragma unroll
        for (int j = 0; j < 32; ++j) { *(unsigned*)(UP + (row0 + j) * SKY + SKU + 2 * p) = pk2(sr, si);
            const float nr = ar * sr - ai * si + e[j].x, ni = ar * si + ai * sr + e[j].y; sr = nr; si = ni; }
        __syncthreads();
    }
}

__device__ __forceinline__ int t5_bucket(int d) {
    if (d < 16) return d;
    return 16 + (d >= 19) + (d >= 21) + (d >= 24) + (d >= 27) + (d >= 31) + (d >= 35) + (d >= 40) + (d >= 46) + (d >= 52) + (d >= 59) + (d >= 67) + (d >= 77) + (d >= 87) + (d >= 99) + (d >= 113);
}
struct Top3 { float v0, v1, v2; int i0, i1, i2; };
__device__ __forceinline__ Top3 top3_insert(Top3 t, float x, int n) {
    const bool b0 = (x > t.v0) || (x == t.v0 && n < t.i0), b1 = (x > t.v1) || (x == t.v1 && n < t.i1), b2 = (x > t.v2) || (x == t.v2 && n < t.i2);
    Top3 r;
    r.v2 = b1 ? t.v1 : (b2 ? x : t.v2); r.i2 = b1 ? t.i1 : (b2 ? n : t.i2);
    r.v1 = b0 ? t.v0 : (b1 ? x : t.v1); r.i1 = b0 ? t.i0 : (b1 ? n : t.i1);
    r.v0 = b0 ? x : t.v0; r.i0 = b0 ? n : t.i0;
    return r;
}
constexpr int GQS = 0, GKME = 36864, GCNTL = 41472, GMISC = 41600;
template <bool COUNT> __device__ __forceinline__ void attn_gate_unit(Frame& F, int bh, int qb) {
    LAS unsigned char* L = F.lds;
    LAS bf16_t* QS = (LAS bf16_t*)(L + GQS); LAS bf16_t* KME = (LAS bf16_t*)(L + GKME); LAS int* CNT = (LAS int*)(L + GCNTL); LAS float* KNM = (LAS float*)(L + GMISC);
    int tid = F.tid; asm volatile("" : "+v"(tid));
    const int lane = tid & 63, w = F.wave, j = lane & 31, hi = lane >> 5;
    const int b = bh >> 3, h = bh & 7; const size_t tok0 = (size_t)b * SEQ + 256 * qb;
    const bf16_t* Qb = (const bf16_t*)(F.ws + WS_Q); const bf16_t* KM = (const bf16_t*)(F.ws + WS_KMEAN); const float* KN = (const float*)(F.ws + WS_KMEAN + 512 * 1024);
    float* MQg = (float*)(F.ws + WS_MQ); unsigned short* QL = (unsigned short*)(F.ws + WS_QLIST); unsigned* GC = (unsigned*)(F.ctl + CW_GCNT); unsigned* SEGC = (unsigned*)(F.ws + WS_SEGC);
#pragma unroll
    for (int jj = 0; jj < 4; ++jj) { const int q = tid + NTHR * jj, row = q >> 3, pc = q & 7; *(LAS u32x4*)(QS + row * KVP + pc * 8) = *(const u32x4*)(Qb + (tok0 + row) * DA + h * HD + pc * 8); }
    if (tid < 256) { const int n = tid >> 3, pc = tid & 7; *(LAS u32x4*)(KME + n * KVP + pc * 8) = *(const u32x4*)(KM + ((size_t)bh * 32 + n) * 64 + pc * 8); }
    if (tid < 32) CNT[tid] = 0;
    if (w == 1) { float v = (lane <= qb && lane < 32) ? KN[bh * 32 + lane] : 0.f; v = wave_max(v); if (lane == 0) KNM[0] = v; }
    if (w == 2) { float v = F.in[16][h * 32 + (lane & 31)]; v = wave_max(v); if (lane == 0) KNM[1] = v * LOG2E; }
    __syncthreads();
    {
        bf16x8 qf[4], kmf[4];
#pragma unroll
        for (int ds = 0; ds < 4; ++ds) { qf[ds] = *(const LAS bf16x8*)(QS + (32 * w + j) * KVP + 16 * ds + 8 * hi); kmf[ds] = *(const LAS bf16x8*)(KME + j * KVP + 16 * ds + 8 * hi); }
        f32x16 gt = {};
#pragma unroll
        for (int ds = 0; ds < 4; ++ds) gt = __builtin_amdgcn_mfma_f32_32x32x16_bf16(kmf[ds], qf[ds], gt, 0, 0, 0);
        float qn = 0.f;
#pragma unroll
        for (int ds = 0; ds < 4; ++ds)
#pragma unroll
            for (int e = 0; e < 8; ++e) { const float x = bf2f((unsigned short)qf[ds][e]); qn += x * x; }
        qn += __shfl_xor(qn, 32);
        const float m2 = sqrtf(qn * KNM[0]) + KNM[1];
        const int ql = 256 * qb + 32 * w + j;
        if (hi == 0) MQg[(size_t)bh * SEQ + ql] = m2;
        Top3 t3; t3.v0 = t3.v1 = t3.v2 = -INFINITY; t3.i0 = t3.i1 = t3.i2 = -1;
#pragma unroll
        for (int r = 0; r < 16; ++r) { const int n = crow(r, hi); const float x = (n < qb) ? gt[r] : -INFINITY; t3 = top3_insert(t3, x, x > -INFINITY ? n : 0x7fffffff); }
        { const float p0 = __shfl_xor(t3.v0, 32), p1 = __shfl_xor(t3.v1, 32), p2 = __shfl_xor(t3.v2, 32); const int q0 = __shfl_xor(t3.i0, 32), q1 = __shfl_xor(t3.i1, 32), q2 = __shfl_xor(t3.i2, 32);
          t3 = top3_insert(t3, p0, q0 >= 0 ? q0 : 0x7fffffff); t3 = top3_insert(t3, p1, q1 >= 0 ? q1 : 0x7fffffff); t3 = top3_insert(t3, p2, q2 >= 0 ? q2 : 0x7fffffff); }
        const int i0 = t3.v0 > -INFINITY ? t3.i0 : -1, i1 = t3.v1 > -INFINITY ? t3.i1 : -1, i2 = t3.v2 > -INFINITY ? t3.i2 : -1;
        if (hi == 0) { const unsigned e = (unsigned)ql << 2;
            if (i0 >= 0) { const int pos = __hip_atomic_fetch_add(CNT + i0, 1, __ATOMIC_RELAXED, __HIP_MEMORY_SCOPE_WORKGROUP); QL[((size_t)bh * 32 + i0) * SEQ + (qb - i0 - 1) * 256 + pos] = (unsigned short)(e | 0u); }
            if (i1 >= 0) { const int pos = __hip_atomic_fetch_add(CNT + i1, 1, __ATOMIC_RELAXED, __HIP_MEMORY_SCOPE_WORKGROUP); QL[((size_t)bh * 32 + i1) * SEQ + (qb - i1 - 1) * 256 + pos] = (unsigned short)(e | 1u); }
            if (i2 >= 0) { const int pos = __hip_atomic_fetch_add(CNT + i2, 1, __ATOMIC_RELAXED, __HIP_MEMORY_SCOPE_WORKGROUP); QL[((size_t)bh * 32 + i2) * SEQ + (qb - i2 - 1) * 256 + pos] = (unsigned short)(e | 2u); } }
    }
    __syncthreads();
    if (tid < qb) { const unsigned c = (unsigned)CNT[tid]; SEGC[((size_t)bh * 32 + tid) * 32 + (qb - tid - 1)] = c; if (COUNT && c) (void)__hip_atomic_fetch_add(GC + bh * 32 + tid, c, __ATOMIC_RELAXED, __HIP_MEMORY_SCOPE_AGENT); }
    __syncthreads();
}
template <bool COUNT> __device__ __forceinline__ void attn_gate_phase(Frame& F) {
    for (int u = F.vcu; u < BATCH * NH * NBLK; u += F.G) attn_gate_unit<COUNT>(F, u >> 5, u & 31);
}

#define ATTN_SUBTILE(KP, VP, st_, NEARM) do { \
        bf16x8 kf_[4], vf_[4]; \
        _Pragma("unroll") for (int ds_ = 0; ds_ < 4; ++ds_) kf_[ds_] = *(const LAS bf16x8*)((KP) + ((st_) * 4 + ds_) * 512 + lane8); \
        _Pragma("unroll") for (int q_ = 0; q_ < 4; ++q_) vf_[q_] = *(const LAS bf16x8*)((VP) + ((st_) * 4 + q_) * 512 + lane8); \
        f32x16 s_ = {}; \
        _Pragma("unroll") for (int ds_ = 0; ds_ < 4; ++ds_) s_ = __builtin_amdgcn_mfma_f32_32x32x16_bf16(kf_[ds_], qf[ds_], s_, 0, 0, 0); \
        float p_[16]; \
        if (!(NEARM)) { _Pragma("unroll") for (int r_ = 0; r_ < 16; ++r_) p_[r_] = __builtin_amdgcn_exp2f(s_[r_] - mfar); } \
        else { _Pragma("unroll") for (int r_ = 0; r_ < 16; ++r_) { const int dist_ = dq - (32 * (st_) + crow(r_, hi)); const int di_ = dist_ < 0 ? 0 : (dist_ > 127 ? 127 : dist_); \
                const float e_ = __builtin_amdgcn_exp2f(s_[r_] + TABh[di_] - m2); p_[r_] = dist_ >= 0 ? e_ : 0.f; } } \
        _Pragma("unroll") for (int r_ = 0; r_ < 16; ++r_) lsum += p_[r_]; \
        u32x4 pa_, pb_; pa_.x = cvt_pk_bf16(p_[0], p_[1]); pa_.y = cvt_pk_bf16(p_[2], p_[3]); pa_.z = cvt_pk_bf16(p_[4], p_[5]); pa_.w = cvt_pk_bf16(p_[6], p_[7]); \
        pb_.x = cvt_pk_bf16(p_[8], p_[9]); pb_.y = cvt_pk_bf16(p_[10], p_[11]); pb_.z = cvt_pk_bf16(p_[12], p_[13]); pb_.w = cvt_pk_bf16(p_[14], p_[15]); \
        const bf16x8 A0_ = __builtin_bit_cast(bf16x8, pa_), A1_ = __builtin_bit_cast(bf16x8, pb_); \
        o0 = __builtin_amdgcn_mfma_f32_32x32x16_bf16(vf_[0], A0_, o0, 0, 0, 0); o1 = __builtin_amdgcn_mfma_f32_32x32x16_bf16(vf_[1], A0_, o1, 0, 0, 0); \
        o0 = __builtin_amdgcn_mfma_f32_32x32x16_bf16(vf_[2], A1_, o0, 0, 0, 0); o1 = __builtin_amdgcn_mfma_f32_32x32x16_bf16(vf_[3], A1_, o1, 0, 0, 0); } while (0)

__device__ __forceinline__ u32x4 ot_pack16(const f32x16& o, int pr) {
    const unsigned p0 = cvt_pk_bf16(o[8 * pr], o[8 * pr + 1]), p1 = cvt_pk_bf16(o[8 * pr + 2], o[8 * pr + 3]), q0 = cvt_pk_bf16(o[8 * pr + 4], o[8 * pr + 5]), q1 = cvt_pk_bf16(o[8 * pr + 6], o[8 * pr + 7]);
    const auto r0 = __builtin_amdgcn_permlane32_swap(p0, q0, false, false); const auto r1 = __builtin_amdgcn_permlane32_swap(p1, q1, false, false);
    return (u32x4){r0[0], r1[0], r0[1], r1[1]};
}
__device__ __forceinline__ void ot_add16(f32x16& o, int pr, u32x4 v, bool use) {
    const auto r0 = __builtin_amdgcn_permlane32_swap(v.x, v.z, false, false); const auto r1 = __builtin_amdgcn_permlane32_swap(v.y, v.w, false, false);
    const unsigned p0 = r0[0], p1 = r1[0], q0 = r0[1], q1 = r1[1];
    o[8 * pr] += use ? bflo(p0) : 0.f; o[8 * pr + 1] += use ? bfhi(p0) : 0.f; o[8 * pr + 2] += use ? bflo(p1) : 0.f; o[8 * pr + 3] += use ? bfhi(p1) : 0.f;
    o[8 * pr + 4] += use ? bflo(q0) : 0.f; o[8 * pr + 5] += use ? bfhi(q0) : 0.f; o[8 * pr + 6] += use ? bflo(q1) : 0.f; o[8 * pr + 7] += use ? bfhi(q1) : 0.f;
}
__device__ __forceinline__ void attn_fill_tab(Frame& F, LAS float* TAB) {
    const float* rb = F.in[16];
    for (int idx = F.tid; idx < 8 * 132; idx += NTHR) { const int h = idx / 132, d = idx % 132; float v = 0.f;
        if (d < 128) v = rb[h * 32 + t5_bucket(d)] * LOG2E; else if (d == 129) v = rb[h * 32 + 31] * LOG2E;
        TAB[idx] = v; }
}
constexpr int BGPRE_OFF = ROWTAB_OFF, BGCL_OFF = ROWTAB_OFF + 8448, BTAB_OFF = ROWTAB_OFF + 16640, BIT_OFF = ROWTAB_OFF + 20992, BIT_MAX = 512;
static_assert(BTAB_OFF + 8 * 132 * 4 <= MOE_TST_OFF, "attention LDS tables");
__device__ __forceinline__ size_t part_off(int slot) { return slot == 0 ? WS_PART0 : (slot == 1 ? WS_PART1 : WS_PART2); }

__device__ __forceinline__ void attn_block_phase(Frame& F) {
    LAS unsigned char* L = F.lds; LAS int* GPRE = (LAS int*)(L + BGPRE_OFF); LAS int* GCL = (LAS int*)(L + BGCL_OFF); LAS float* TAB = (LAS float*)(L + BTAB_OFF); LAS int* ITT = (LAS int*)(L + BIT_OFF); LAS int* WSUM = (LAS int*)(L + MOE_TST_OFF);
    const unsigned* GC = (const unsigned*)(F.ctl + CW_GCNT); const unsigned* SEGC = (const unsigned*)(F.ws + WS_SEGC);
    const int tid = F.tid, lane = F.lane, w = F.wave, j = lane & 31, hi = lane >> 5, lane8 = lane * 8;
    { int ng[4], tot = 0;
#pragma unroll
      for (int e = 0; e < 4; ++e) { const int c = (int)GC[4 * tid + e]; GCL[4 * tid + e] = c; ng[e] = (((c + 31) >> 5) + 7) >> 3; tot += ng[e]; }
      int inc = tot;
#pragma unroll
      for (int o = 1; o < 64; o <<= 1) { const int t = __shfl_up(inc, o); if (lane >= o) inc += t; }
      if (lane == 63) WSUM[w] = inc;
      __syncthreads();
      int woff = 0;
      for (int q = 0; q < w; ++q) woff += WSUM[q];
      int ex = woff + inc - tot;
#pragma unroll
      for (int e = 0; e < 4; ++e) { GPRE[4 * tid + e] = ex; ex += ng[e]; }
      if (tid == NTHR - 1) GPRE[2048] = ex; }
    attn_fill_tab(F, TAB);
    __syncthreads();
    const int NIT = GPRE[2048];
    const int nk = (NIT > F.vcu) ? (NIT - F.vcu + F.G - 1) / F.G : 0;
    if (tid < nk && tid < BIT_MAX) { const int it_ = F.vcu + tid * F.G; int lo_ = 0, hi_ = 2048; while (hi_ - lo_ > 1) { const int mid_ = (lo_ + hi_) >> 1; if (GPRE[mid_] <= it_) lo_ = mid_; else hi_ = mid_; } ITT[tid] = lo_ * 64 + (it_ - GPRE[lo_]); }
    __syncthreads();
    if (nk == 0) return;
    const int nkc = nk < BIT_MAX ? nk : BIT_MAX;
    const bf16_t* Qb = (const bf16_t*)(F.ws + WS_Q); const float* MQg = (const float*)(F.ws + WS_MQ); const unsigned short* QL = (const unsigned short*)(F.ws + WS_QLIST);
    const bf16_t* KF = (const bf16_t*)(F.ws + WS_KFRAG); const bf16_t* VF = (const bf16_t*)(F.ws + WS_VFRAG);
    float* PL = (float*)(F.ws + WS_PL);
#define BLK_ITEM(k_, pi_, g_) do { const int kk_ = (k_) < nkc ? (k_) : nkc - 1; const int v_ = __builtin_amdgcn_readfirstlane(ITT[kk_]); pi_ = v_ >> 6; g_ = v_ & 63; } while (0)
#define BLK_DMA(buf_, pi_) do { const char* ks_ = (const char*)KF + ((size_t)(pi_) * 2048 + tid) * 16; const char* vs_ = (const char*)VF + ((size_t)(pi_) * 2048 + tid) * 16; \
        _Pragma("unroll") for (int i_ = 0; i_ < 4; ++i_) { \
            __builtin_amdgcn_global_load_lds((const unsigned*)(ks_ + i_ * 8192), (LAS unsigned*)(L + (buf_) + (i_ * 512 + w * 64) * 16), 16, 0, 0); \
            __builtin_amdgcn_global_load_lds((const unsigned*)(vs_ + i_ * 8192), (LAS unsigned*)(L + (buf_) + 32768 + (i_ * 512 + w * 64) * 16), 16, 0, 0); } } while (0)
#define BLK_SEGC(dst_, pi_) do { dst_ = SEGC[(size_t)(pi_) * 32 + j]; } while (0)
#define BLK_ENTRY(dst_, segc_, pi_, g_) do { const int n_ = (pi_) & 31; int inc_ = (j < 31 - n_) ? (int)(segc_) : 0; \
        _Pragma("unroll") for (int o_ = 1; o_ < 32; o_ <<= 1) { const int t_ = __shfl_up(inc_, o_); if (j >= o_) inc_ += t_; } \
        const int cnt_ = GCL[pi_]; const int idx_ = 32 * (8 * (g_) + w) + j; int seg_ = 0, prev_ = 0; \
        for (int s_ = 0; s_ < 31 - n_; ++s_) { const int p_ = __builtin_amdgcn_readlane(inc_, s_); const bool le_ = p_ <= idx_; seg_ += le_ ? 1 : 0; prev_ = le_ ? p_ : prev_; } \
        const bool ok_ = idx_ < cnt_; const unsigned v_ = QL[(size_t)(pi_) * SEQ + (ok_ ? seg_ * 256 + (idx_ - prev_) : 0)]; dst_ = ok_ ? v_ : 0xFFFFu; } while (0)
#define BLK_QLOAD(qf_, m2_, ent_, pi_) do { const unsigned qq_ = ((ent_) == 0xFFFFu) ? 0u : ((ent_) >> 2); const int bh_ = (pi_) >> 5; \
        const bf16_t* qrow_ = Qb + ((size_t)(bh_ >> 3) * SEQ + qq_) * DA + (bh_ & 7) * HD + 8 * hi; \
        _Pragma("unroll") for (int ds_ = 0; ds_ < 4; ++ds_) qf_[ds_] = *(const bf16x8*)(qrow_ + 16 * ds_); \
        m2_ = MQg[(size_t)bh_ * SEQ + qq_]; } while (0)
    int pi, g, pi1, g1, pi2, g2; unsigned ent, ent1, sc2; bf16x8 qf[4]; float m2r;
    BLK_ITEM(0, pi, g); BLK_ITEM(1, pi1, g1); BLK_ITEM(2, pi2, g2);
    BLK_DMA(0, pi);
    { unsigned sc0, sc1; BLK_SEGC(sc0, pi); BLK_SEGC(sc1, pi1); BLK_SEGC(sc2, pi2); BLK_ENTRY(ent, sc0, pi, g); BLK_ENTRY(ent1, sc1, pi1, g1); }
    BLK_QLOAD(qf, m2r, ent, pi);
    int cur = 0;
    __builtin_amdgcn_s_waitcnt(0x0F70);
    unsigned char* dump = F.ws + WS_E + ((size_t)F.vcu * NTHR + tid) * 128;
    for (int k = 0; k < nkc; ++k) {
        __builtin_amdgcn_s_waitcnt(0x0F75);
        __syncthreads();
        int pi3, g3; unsigned sc3, ent2; bf16x8 qfn[4]; float m2n;
        BLK_ITEM(k + 3, pi3, g3); BLK_SEGC(sc3, pi3);
        BLK_ENTRY(ent2, sc2, pi2, g2);
        BLK_QLOAD(qfn, m2n, ent1, pi1);
        BLK_DMA((cur ^ 1) * 65536, pi1);
        const int bh = pi >> 5, n = pi & 31, h = bh & 7;
        const bool valid = ent != 0xFFFFu; const int q = valid ? (int)(ent >> 2) : 0; const int slot = (int)(ent & 3u);
        const bool active = __builtin_amdgcn_readfirstlane((int)(__ballot(valid) != 0ull)) != 0;
        f32x16 o0 = {}, o1 = {}; float lsum = 0.f;
        if (active) {
            const float m2 = valid ? m2r : INFINITY;
            const LAS bf16_t* KP = (const LAS bf16_t*)(L + cur * 65536); const LAS bf16_t* VP = (const LAS bf16_t*)(L + cur * 65536 + 32768);
            const LAS float* TABh = TAB + h * 132; const float mfar = m2 - TABh[129];
            const int dq = q - 256 * n;
            const bool nearw = __builtin_amdgcn_readfirstlane((int)(__ballot(valid && dq < 383) != 0ull)) != 0;
            if (nearw) { for (int st = 0; st < 8; ++st) ATTN_SUBTILE(KP, VP, st, true); }
            else { for (int st = 0; st < 8; ++st) ATTN_SUBTILE(KP, VP, st, false); }
        }
        { const float lt = lsum + __shfl_xor(lsum, 32);
          const size_t qi = (size_t)bh * SEQ + q;
          float* pld = valid ? PL + (size_t)slot * (NH * BATCH * SEQ) + qi : (float*)(dump + 120);
          bf16_t* dst = valid ? (bf16_t*)(F.ws + part_off(slot)) + qi * HD + 8 * hi : (bf16_t*)dump;
          *pld = lt;
          *(u32x4*)(dst) = ot_pack16(o0, 0); *(u32x4*)(dst + 16) = ot_pack16(o0, 1); *(u32x4*)(dst + 32) = ot_pack16(o1, 0); *(u32x4*)(dst + 48) = ot_pack16(o1, 1); }
        pi = pi1; g = g1; ent = ent1; m2r = m2n; pi1 = pi2; g1 = g2; ent1 = ent2; pi2 = pi3; g2 = g3; sc2 = sc3; cur ^= 1;
#pragma unroll
        for (int ds = 0; ds < 4; ++ds) qf[ds] = qfn[ds];
    }
    VM_WAIT(); __syncthreads();
#undef BLK_ITEM
#undef BLK_DMA
#undef BLK_SEGC
#undef BLK_ENTRY
#undef BLK_QLOAD
}

__device__ __forceinline__ void attn_own_phase(Frame& F) {
    LAS unsigned char* L = F.lds; LAS float* TAB = (LAS float*)(L + BTAB_OFF);
    attn_fill_tab(F, TAB);
    const int tid = F.tid, lane = F.lane, w = F.wave, j = lane & 31, hi = lane >> 5, lane8 = lane * 8;
    const bf16_t* Qb = (const bf16_t*)(F.ws + WS_Q); const float* MQg = (const float*)(F.ws + WS_MQ);
    const bf16_t* KF = (const bf16_t*)(F.ws + WS_KFRAG); const bf16_t* VF = (const bf16_t*)(F.ws + WS_VFRAG);
    const float* PL = (const float*)(F.ws + WS_PL); bf16_t* YA = (bf16_t*)(F.ws + WS_YATT);
    const int NU = BATCH * NH * NBLK;
#define OWN_DMA(buf_, pi_) do { const char* ks_ = (const char*)KF + ((size_t)(pi_) * 2048 + tid) * 16; const char* vs_ = (const char*)VF + ((size_t)(pi_) * 2048 + tid) * 16; \
        _Pragma("unroll") for (int i_ = 0; i_ < 4; ++i_) { \
            __builtin_amdgcn_global_load_lds((const unsigned*)(ks_ + i_ * 8192), (LAS unsigned*)(L + (buf_) + (i_ * 512 + w * 64) * 16), 16, 0, 0); \
            __builtin_amdgcn_global_load_lds((const unsigned*)(vs_ + i_ * 8192), (LAS unsigned*)(L + (buf_) + 32768 + (i_ * 512 + w * 64) * 16), 16, 0, 0); } } while (0)
#define OWN_QLOAD(qf_, m2_, u_) do { const int bh_ = (u_) >> 5, qb_ = (u_) & 31; const size_t tk_ = (size_t)256 * qb_ + 32 * w + j; \
        const bf16_t* qrow_ = Qb + ((size_t)(bh_ >> 3) * SEQ + tk_) * DA + (bh_ & 7) * HD + 8 * hi; \
        _Pragma("unroll") for (int ds_ = 0; ds_ < 4; ++ds_) qf_[ds_] = *(const bf16x8*)(qrow_ + 16 * ds_); \
        m2_ = MQg[(size_t)bh_ * SEQ + tk_]; } while (0)
    int u = F.vcu; if (u >= NU) return;
    bf16x8 qf[4]; float m2;
    OWN_DMA(0, u); OWN_QLOAD(qf, m2, u);
    int cur = 0;
    __builtin_amdgcn_s_waitcnt(0x0F70);
    for (;;) {
        __builtin_amdgcn_s_waitcnt(0x0F74); __syncthreads();
        const int un = (u + F.G < NU) ? u + F.G : u; const bool last = (un == u);
        const int bh = u >> 5, qb = u & 31, b = bh >> 3, h = bh & 7; const int ql = 32 * w + j; const size_t qi = (size_t)bh * SEQ + 256 * qb + ql;
        u32x4 pa[3][4]; float pl[3];
#pragma unroll
        for (int s = 0; s < 3; ++s) { pl[s] = PL[(size_t)s * (NH * BATCH * SEQ) + qi]; const bf16_t* src = (const bf16_t*)(F.ws + part_off(s)) + qi * HD + 8 * hi;
#pragma unroll
            for (int c = 0; c < 4; ++c) pa[s][c] = *(const u32x4*)(src + 16 * c); }
        bf16x8 qfn[4]; float m2n;
        OWN_QLOAD(qfn, m2n, un);
        OWN_DMA((cur ^ 1) * 65536, un);
        const LAS bf16_t* KP = (const LAS bf16_t*)(L + cur * 65536); const LAS bf16_t* VP = (const LAS bf16_t*)(L + cur * 65536 + 32768); const LAS float* TABh = TAB + h * 132;
        const float mfar = 0.f; (void)mfar; const int dq = ql;
        f32x16 o0 = {}, o1 = {}; float lsum = 0.f;
        for (int st = 0; st <= w; ++st) ATTN_SUBTILE(KP, VP, st, true);
        float lt = lsum + __shfl_xor(lsum, 32);
        const int nsel = qb < 3 ? qb : 3;
#pragma unroll
        for (int s = 0; s < 3; ++s) { const bool use = s < nsel; lt += use ? pl[s] : 0.f;
            ot_add16(o0, 0, pa[s][0], use); ot_add16(o0, 1, pa[s][1], use); ot_add16(o1, 0, pa[s][2], use); ot_add16(o1, 1, pa[s][3], use); }
        const float inv = 1.f / lt;
#pragma unroll
        for (int r = 0; r < 16; ++r) { o0[r] *= inv; o1[r] *= inv; }
        bf16_t* dst = YA + ((size_t)b * SEQ + 256 * qb + ql) * DA + h * HD + 8 * hi;
        *(u32x4*)(dst) = ot_pack16(o0, 0); *(u32x4*)(dst + 16) = ot_pack16(o0, 1); *(u32x4*)(dst + 32) = ot_pack16(o1, 0); *(u32x4*)(dst + 48) = ot_pack16(o1, 1);
        if (last) break;
        u = un; m2 = m2n; cur ^= 1;
#pragma unroll
        for (int ds = 0; ds < 4; ++ds) qf[ds] = qfn[ds];
    }
    VM_WAIT(); __syncthreads();
#undef OWN_DMA
#undef OWN_QLOAD
}
#undef ATTN_SUBTILE

__device__ __forceinline__ void routing_phase(Frame& F) {
    LAS int* lcnt = (LAS int*)(F.lds); LAS int* lbase = lcnt + 32;
    const float* SSQ = (const float*)(F.ws + WS_SSQ); const float* RL = (const float*)(F.ws + WS_RLOG);
    unsigned* rowtok = (unsigned*)(F.ws + WS_ROWTOK); float* rowcoef = (float*)(F.ws + WS_ROWCOEF); float* rowrstd = (float*)(F.ws + WS_ROWRSTD);
    unsigned* ecnt = (unsigned*)(F.ctl + CW_ECNT);
    const float* brg = F.in[20]; const float* bre = F.in[22];
    const int tid = F.tid;
    for (int base = F.vcu * 256; base < T; base += F.G * 256) {
        if (tid < 32) lcnt[tid] = 0;
        __syncthreads();
        int e0 = 0, e1 = 0, lp0 = 0, lp1 = 0; float c0 = 0.f, c1 = 0.f, rstd = 0.f; const int tok = base + tid;
        if (tid < 256) {
            float ss = 0.f;
#pragma unroll
            for (int q = 0; q < 4; ++q) { const f32x4 v = *(const f32x4*)(SSQ + (size_t)tok * 16 + 4 * q); ss += (v.x + v.y) + (v.z + v.w); }
            rstd = 1.f / sqrtf(ss * (1.f / D) + RMS_EPS);
            float r[72];
#pragma unroll
            for (int q = 0; q < 18; ++q) { const f32x4 v = *(const f32x4*)(RL + (size_t)tok * 72 + 4 * q); r[4 * q] = v.x; r[4 * q + 1] = v.y; r[4 * q + 2] = v.z; r[4 * q + 3] = v.w; }
            float gl[4], el[32];
#pragma unroll
            for (int c = 0; c < 4; ++c) gl[c] = rstd * (r[c] + r[36 + c]) + brg[c];
#pragma unroll
            for (int c = 0; c < 32; ++c) el[c] = rstd * (r[4 + c] + r[40 + c]) + bre[c];
            int gi = 0; float gm = gl[0];
#pragma unroll
            for (int c = 1; c < 4; ++c) if (gl[c] > gm) { gm = gl[c]; gi = c; }
            float Z = 0.f;
#pragma unroll
            for (int c = 0; c < 4; ++c) Z += __expf(gl[c] - gm);
            const float gval = 1.f / Z;
            float es[8];
#pragma unroll
            for (int q = 0; q < 8; ++q) es[q] = gi == 0 ? el[q] : (gi == 1 ? el[8 + q] : (gi == 2 ? el[16 + q] : el[24 + q]));
            int a0 = 0; float m0 = es[0];
#pragma unroll
            for (int q = 1; q < 8; ++q) if (es[q] > m0) { m0 = es[q]; a0 = q; }
            int a1 = -1; float m1 = -INFINITY;
#pragma unroll
            for (int q = 0; q < 8; ++q) if (q != a0 && es[q] > m1) { m1 = es[q]; a1 = q; }
            const float w0 = 1.f / (1.f + __expf(m1 - m0)), w1 = 1.f - w0;
            e0 = gi * 8 + a0; e1 = gi * 8 + a1; c0 = gval * w0; c1 = gval * w1;
            lp0 = __hip_atomic_fetch_add(lcnt + e0, 1, __ATOMIC_RELAXED, __HIP_MEMORY_SCOPE_WORKGROUP);
            lp1 = __hip_atomic_fetch_add(lcnt + e1, 1, __ATOMIC_RELAXED, __HIP_MEMORY_SCOPE_WORKGROUP);
        }
        __syncthreads();
        if (tid < 32) lbase[tid] = (int)__hip_atomic_fetch_add(ecnt + tid, (unsigned)lcnt[tid], __ATOMIC_RELAXED, __HIP_MEMORY_SCOPE_AGENT);
        __syncthreads();
        if (tid < 256) {
            const size_t i0 = (size_t)e0 * ROWCAP + lbase[e0] + lp0, i1 = (size_t)e1 * ROWCAP + lbase[e1] + lp1;
            rowtok[i0] = (unsigned)tok * 2u; rowcoef[i0] = c0; rowrstd[i0] = rstd;
            rowtok[i1] = (unsigned)tok * 2u + 1u; rowcoef[i1] = c1; rowrstd[i1] = rstd;
        }
        __syncthreads();
    }
}
struct MoeOrder {
    const LAS int* tst; int total, G, v;
    __device__ bool next(int i, pg8::Unit& u) const {
        const int L = i * G + v; if (L >= total) return false;
        const int rt = L >> 2; int e = 0;
#pragma unroll 8
        for (int q = 1; q <= 32; ++q) e += (tst[q] <= rt) ? 1 : 0;
        u.pm = rt; u.pn = L & 3; u.pb = e * 4 + u.pn; u.aux = e; u.aux2 = (rt - tst[e]) * 256; return true;
    }
};
__device__ __forceinline__ void moe_tables(Frame& F) {
    LAS int* tst = (LAS int*)(F.lds + MOE_TST_OFF); const unsigned* ecnt = (const unsigned*)(F.ctl + CW_ECNT);
    if (F.wave == 0) { const int lane = F.lane; int nt = lane < 32 ? (int)((ecnt[lane & 31] + 255u) >> 8) : 0; int inc = nt;
#pragma unroll
        for (int o = 1; o < 32; o <<= 1) { const int t = __shfl_up(inc, o); if (lane >= o) inc += t; }
        if (lane < 32) tst[lane + 1] = inc; if (lane == 0) tst[0] = 0; }
    __syncthreads();
}
__device__ __forceinline__ void final_phase(Frame& F) {
    const float* X1 = (const float*)(F.ws + WS_X1); const bf16_t* Y0 = (const bf16_t*)(F.ws + WS_Y0); const bf16_t* Y1 = (const bf16_t*)(F.ws + WS_Y1); const float* gf = F.in[26];
    const int gw = F.vcu * NWAVES + F.wave, NGW = F.G * NWAVES, lane = F.lane;
    for (int m = gw; m < T; m += NGW) {
        const f32x4* xr = (const f32x4*)(X1 + (size_t)m * D) + lane; const u32x2* y0 = (const u32x2*)(Y0 + (size_t)m * D) + lane; const u32x2* y1 = (const u32x2*)(Y1 + (size_t)m * D) + lane;
        f32x4 v[4]; float s = 0.f;
#pragma unroll
        for (int j = 0; j < 4; ++j) { v[j] = xr[64 * j]; const u32x2 a = y0[64 * j], c = y1[64 * j];
            v[j].x += bflo(a.x) + bflo(c.x); v[j].y += bfhi(a.x) + bfhi(c.x); v[j].z += bflo(a.y) + bflo(c.y); v[j].w += bfhi(a.y) + bfhi(c.y);
            s += (v[j].x * v[j].x + v[j].y * v[j].y) + (v[j].z * v[j].z + v[j].w * v[j].w); }
        const float rstd = 1.f / sqrtf(wave_sum(s) * (1.f / D) + RMS_EPS);
        f32x4* o = (f32x4*)(F.out + (size_t)m * D) + lane; const f32x4* gr = (const f32x4*)gf + lane;
#pragma unroll
        for (int j = 0; j < 4; ++j) o[64 * j] = v[j] * rstd * gr[64 * j];
    }
}
#ifndef MK_N_LAUNCHES
#define MK_N_LAUNCHES 1
#endif
constexpr int NPHASE = 15;
struct Args { const float* in[27]; float* out; unsigned char* ws; int ph_lo, ph_hi; };
static_assert(sizeof(Args) == 27 * 8 + 8 + 8 + 8, "Args has no padding");

#ifndef STAG1
#define STAG1 0
#endif
#ifndef DUP_MASK
#define DUP_MASK 0
#endif
#define PH_ARGS Frame& F, unsigned char* ws, LAS unsigned char* ring
__device__ __forceinline__ void ph1(PH_ARGS) {
    { pg8::Gemm g{(const bf16_t*)(ws + WS_H1), (const bf16_t*)(ws + WS_WIN), D, D, D}; pg8::StaticOrder S; S.init(T, DS, F.G, (int)blockIdx.x);
      EpiProj<0> E{ws, F.in[3], 0, 1.f};
      pg8::gemm_phase<EpiProj<0>, pg8::StaticOrder, true, false>(ring, g, S, E, nullptr, F.wave); }
    { pg8::Gemm g{(const bf16_t*)(ws + WS_H1F8), (const bf16_t*)(ws + WS_WINF8), D / 2, D / 2, D / 2}; pg8::StaticOrder S; S.init(T, DIN - DS, F.G, (int)blockIdx.x);
      EpiProj<1> E{ws, F.in[3], 2, 1.f / WF8_SCALE};
      pg8::gemm_phase<EpiProj<1>, pg8::StaticOrder, true, false, true>(ring, g, S, E, nullptr, F.wave); }
}
__device__ __forceinline__ void ph2(PH_ARGS) {
    { pg8::Gemm g{(const bf16_t*)(ws + WS_UP), (const bf16_t*)(ws + WS_SSMW), SKY, SKU, SKU}; pg8::GroupedOrder S; S.init(SG * 8, 1, 8, F.G, F.vcu);
      EpiSsmE E{(float*)(ws + WS_E)};
      pg8::gemm_phase<EpiSsmE, pg8::GroupedOrder, false, false>(ring, g, S, E, nullptr, F.wave); }
    __syncthreads();
    kv_prep_phase(F);
}
__device__ __forceinline__ void ph4(PH_ARGS) {
    pg8::Gemm g{(const bf16_t*)(ws + WS_UP), (const bf16_t*)(ws + WS_SSMT), SKY, SKY, SKY}; pg8::GroupedOrder S; S.init(SG * 8, 2, 8, F.G, F.vcu);
    EpiSsmY E{(bf16_t*)(ws + WS_GACT)};
    pg8::gemm_phase<EpiSsmY, pg8::GroupedOrder, true, false>(ring, g, S, E, nullptr, F.wave);
}
__device__ __forceinline__ void ph5(PH_ARGS) {
    pg8::Gemm g{(const bf16_t*)(ws + WS_GACT), (const bf16_t*)(ws + WS_WGLU), DS, DS, DS}; pg8::StaticOrder S; S.init(T, DS, F.G, (int)blockIdx.x);
    EpiGlu E{(const bf16_t*)(ws + WS_GACT), (bf16_t*)(ws + WS_YSSM), F.in[13]};
    pg8::gemm_phase<EpiGlu, pg8::StaticOrder, true, false>(ring, g, S, E, nullptr, F.wave);
}
__device__ __forceinline__ void ph6(PH_ARGS) {
    { pg8::Gemm g{(const bf16_t*)(ws + WS_YSSM), (const bf16_t*)(ws + WS_WUS), DS, DS, DS}; pg8::StaticOrder S; S.init(T, D, F.G, (int)blockIdx.x);
      EpiUp<false> E{(const bf16_t*)(ws + WS_SGS), (bf16_t*)(ws + WS_MRG)};
      pg8::gemm_phase<EpiUp<false>, pg8::StaticOrder, true, false>(ring, g, S, E, nullptr, F.wave); }
    VM_WAIT(); __syncthreads();
    { pg8::Gemm g{(const bf16_t*)(ws + WS_YATT), (const bf16_t*)(ws + WS_WUA), DA, DA, DA}; pg8::StaticOrder S; S.init(T, D, F.G, (int)blockIdx.x);
      EpiUp<true> E{(const bf16_t*)(ws + WS_SGA), (bf16_t*)(ws + WS_MRG)};
      pg8::gemm_phase<EpiUp<true>, pg8::StaticOrder, true, false>(ring, g, S, E, nullptr, F.wave); }
}
__device__ __forceinline__ void ph7(PH_ARGS) {
    pg8::Gemm g{(const bf16_t*)(ws + WS_MRG), (const bf16_t*)(ws + WS_WOUT), D, D, D}; pg8::StaticOrder S; S.init(T, D, F.G, (int)blockIdx.x);
    EpiOut E{F.in[0], (float*)(ws + WS_X1), (bf16_t*)(ws + WS_XG), ws + WS_XGF8, F.in[18], (float*)(ws + WS_SSQ)};
    pg8::gemm_phase<EpiOut, pg8::StaticOrder, true, false>(ring, g, S, E, nullptr, F.wave);
}
__device__ __forceinline__ void ph8(PH_ARGS) {
    pg8::Gemm g{(const bf16_t*)(ws + WS_XG), (const bf16_t*)(ws + WS_WR), D, D, D}; pg8::StaticOrder S; S.init(T, 256, F.G, (int)blockIdx.x);
    EpiRouter E{(float*)(ws + WS_RLOG)};
    pg8::gemm_phase<EpiRouter, pg8::StaticOrder, false, false>(ring, g, S, E, nullptr, F.wave);
}
__device__ __forceinline__ void ph10(PH_ARGS) {
    moe_tables(F);
    const LAS int* tst = (const LAS int*)(F.lds + MOE_TST_OFF);
    MoeOrder S{tst, tst[32] * 4, F.G, F.vcu};
    LAS unsigned* rowtab = (LAS unsigned*)(F.lds + ROWTAB_OFF);
    { const unsigned* rowtok = (const unsigned*)(ws + WS_ROWTOK); const unsigned* ecnt = (const unsigned*)(F.ctl + CW_ECNT); pg8::Unit u;
      for (int i = 0; i < ROWTAB_UNITS && S.next(i, u); ++i) { if (F.tid < 256) { const int pos = u.aux2 + F.tid; const unsigned tk = pos < (int)ecnt[u.aux] ? (rowtok[(size_t)u.aux * ROWCAP + pos] >> 1) : 0u; rowtab[i * 256 + F.tid] = tk * (unsigned)D; } } }
    __syncthreads();
    pg8::Gemm g{(const bf16_t*)(ws + WS_XGF8), (const bf16_t*)(ws + WS_W13), D / 2, D / 2, D / 2};
    EpiMoe1 E{(bf16_t*)(ws + WS_HID), (const float*)(ws + WS_ROWRSTD), (const unsigned*)(F.ctl + CW_ECNT), 1.f / WF8_SCALE};
    pg8::gemm_phase<EpiMoe1, MoeOrder, true, true, true>(ring, g, S, E, rowtab, F.wave);
}
__device__ __forceinline__ void ph11(PH_ARGS) {
    moe_tables(F);
    const LAS int* tst = (const LAS int*)(F.lds + MOE_TST_OFF);
    MoeOrder S{tst, tst[32] * 4, F.G, F.vcu};
    pg8::Gemm g{(const bf16_t*)(ws + WS_HID), (const bf16_t*)(ws + WS_W2), DE, DE, DE};
    EpiMoe2 E{(bf16_t*)(ws + WS_Y0), (size_t)(WS_Y1 - WS_Y0), (const unsigned*)(ws + WS_ROWTOK), (const float*)(ws + WS_ROWCOEF), (const unsigned*)(F.ctl + CW_ECNT)};
    pg8::gemm_phase<EpiMoe2, MoeOrder, true, false>(ring, g, S, E, nullptr, F.wave);
}

__global__ void __launch_bounds__(NTHR, 2) fwd_kernel(Args args) {
    extern __shared__ __attribute__((aligned(16))) unsigned char lds_raw[];
    Frame F;
    F.lds = (LAS unsigned char*)lds_raw;
    F.MISC = (volatile LAS unsigned*)(F.lds + MISC_OFF);
    F.wave = __builtin_amdgcn_readfirstlane((int)(threadIdx.x >> 6)); F.lane = lane_id(); F.tid = F.wave * 64 + F.lane;
    F.G = gridDim.x; { const int bx = blockIdx.x; F.vcu = (F.G % 8 == 0) ? (bx % 8) * (F.G / 8) + bx / 8 : bx; }
    F.ws = args.ws; F.ctl = (gu32*)(args.ws + WS_CTL); F.out = args.out;
#pragma unroll
    for (int i = 0; i < 27; ++i) F.in[i] = args.in[i];
    for (int u = F.tid; u < (LDS_BYTES - MOE_TST_OFF) / 4; u += NTHR) ((LAS unsigned*)(F.lds + MOE_TST_OFF))[u] = 0u;
    __syncthreads();
    XcdBarrier bar; bar.bar = (unsigned*)(F.ctl + CW_BAR); bar.x = 0; bar.st = nullptr;
    const int lo = args.ph_lo, hi = args.ph_hi;
    if (hi - lo > 1) bar = xcd_barrier_post((unsigned*)(F.ctl + CW_BAR), F.MISC + 8, F.tid == 0);
#define IN(k) (lo <= (k) && (k) < hi)
#define DUP(k) ((DUP_MASK >> (k)) & 1)
#define SEAM(k) do { if (IN(k) && IN((k) + 1)) xcd_barrier(bar, F.wave == 0 && lane_id() == 0); REFRESH(); } while (0)
#define REFRESH() do { int l_ = lane_id(); asm volatile("" : "+v"(l_)); F.lane = l_; F.tid = F.wave * 64 + l_; } while (0)
    unsigned char* ws = args.ws;
    LAS unsigned char* ring = F.lds;
    if (IN(0)) { p0_prologue(F); if (DUP(0)) p0_prologue(F); }
    SEAM(0);
    if (IN(1)) { ph1(F, ws, ring); if (DUP(1)) ph1(F, ws, ring); }
    SEAM(1);
    if (IN(2)) { ph2(F, ws, ring); if (DUP(2)) ph2(F, ws, ring); }
    SEAM(2);
    if (IN(3)) { ssm_scan_phase(F); attn_gate_phase<true>(F); if (DUP(3)) { ssm_scan_phase(F); } if (DUP(15)) { attn_gate_phase<false>(F); } }
    SEAM(3);
    if (IN(4)) { attn_block_phase(F); if (DUP(4)) { __syncthreads(); attn_block_phase(F); } }
    SEAM(4);
    if (IN(5)) { attn_own_phase(F); if (DUP(5)) attn_own_phase(F); }
    SEAM(5);
    if (IN(6)) { ph4(F, ws, ring); if (DUP(6)) ph4(F, ws, ring); }
    SEAM(6);
    if (IN(7)) { ph5(F, ws, ring); if (DUP(7)) ph5(F, ws, ring); }
    SEAM(7);
    if (IN(8)) { ph6(F, ws, ring); if (DUP(8)) ph6(F, ws, ring); }
    SEAM(8);
    if (IN(9)) { ph7(F, ws, ring); if (DUP(9)) ph7(F, ws, ring); }
    SEAM(9);
    if (IN(10)) { ph8(F, ws, ring); if (DUP(10)) ph8(F, ws, ring); }
    SEAM(10);
    if (IN(11)) { routing_phase(F); }
    SEAM(11);
    if (IN(12)) { ph10(F, ws, ring); if (DUP(12)) ph10(F, ws, ring); }
    SEAM(12);
    if (IN(13)) { ph11(F, ws, ring); if (DUP(13)) ph11(F, ws, ring); }
    SEAM(13);
    if (IN(14)) { final_phase(F); if (DUP(14)) final_phase(F); }
#undef IN
#undef DUP
#undef SEAM
#undef REFRESH
}

extern "C" void kernel_launch(void* const* d_in, const int* in_sizes, int n_in, void* d_out, int out_size, void* d_ws, size_t ws_size, hipStream_t stream) {
    static int grid = 0;
    if (grid == 0) {
        if (n_in != 27 || in_sizes[0] != T * D || out_size != T * D || ws_size < WS_END) { fprintf(stderr, "kernel_launch: unexpected shapes (n_in %d, in0 %d, out %d, ws %zu)\n", n_in, n_in > 0 ? in_sizes[0] : -1, out_size, ws_size); grid = -1; return; }
        int dev = 0, cus = 0;
        if (hipGetDevice(&dev) != hipSuccess || hipDeviceGetAttribute(&cus, hipDeviceAttributeMultiprocessorCount, dev) != hipSuccess) { grid = -1; return; }
        if (hipFuncSetAttribute((const void*)fwd_kernel, hipFuncAttributeMaxDynamicSharedMemorySize, LDS_BYTES) != hipSuccess) { fprintf(stderr, "kernel_launch: hipFuncSetAttribute failed\n"); grid = -1; return; }
        (void)hipGetLastError();
        grid = cus;
    }
    if (grid < 0) return;
    (void)hipMemsetAsync((char*)d_ws + WS_CTL, 0, CTL_ZERO_BYTES, stream);
    Args a{};
    for (int i = 0; i < 27; ++i) a.in[i] = (const float*)d_in[i];
    a.out = (float*)d_out; a.ws = (unsigned char*)d_ws;
    if (MK_N_LAUNCHES == 1) { a.ph_lo = 0; a.ph_hi = NPHASE; hipLaunchKernelGGL(fwd_kernel, dim3(grid), dim3(NTHR), LDS_BYTES, stream, a); }
    else { for (int p = 0; p < NPHASE; ++p) { a.ph_lo = p; a.ph_hi = p + 1; hipLaunchKernelGGL(fwd_kernel, dim3(grid), dim3(NTHR), LDS_BYTES, stream, a); } }
}
```

```cpp
#include <hip/hip_runtime.h>
#include <cstdio>
#include <cstdint>

#define LAS __attribute__((address_space(3)))
#define GAS __attribute__((address_space(1)))
typedef unsigned short bf16_t;
typedef short bf16x8 __attribute__((ext_vector_type(8)));
typedef float f32x2 __attribute__((ext_vector_type(2)));
typedef float f32x4 __attribute__((ext_vector_type(4)));
typedef float f32x16 __attribute__((ext_vector_type(16)));
typedef unsigned u32x2 __attribute__((ext_vector_type(2)));
typedef unsigned u32x4 __attribute__((ext_vector_type(4)));
typedef GAS unsigned gu32;
typedef int v4i32 __attribute__((ext_vector_type(4)));
typedef int v8i32 __attribute__((ext_vector_type(8)));
#define RLX_AGENT __ATOMIC_RELAXED, __HIP_MEMORY_SCOPE_AGENT
#define LDS_WAIT() asm volatile("s_waitcnt lgkmcnt(0)" ::: "memory")
#define VM_WAIT() asm volatile("s_waitcnt vmcnt(0)" ::: "memory")

__device__ __forceinline__ unsigned f2bf(float f) { unsigned u = __builtin_bit_cast(unsigned, f); return (u + 0x7fffu + ((u >> 16) & 1u)) >> 16; }
__device__ __forceinline__ unsigned pk2(float lo, float hi) { return f2bf(lo) | (f2bf(hi) << 16); }
__device__ __forceinline__ float bf2f(unsigned short b) { return __builtin_bit_cast(float, (unsigned)b << 16); }
__device__ __forceinline__ float bflo(unsigned w) { return __builtin_bit_cast(float, w << 16); }
__device__ __forceinline__ float bfhi(unsigned w) { return __builtin_bit_cast(float, w & 0xffff0000u); }
__device__ __forceinline__ unsigned cvt_pk_bf16(float lo, float hi) { unsigned r; asm volatile("v_cvt_pk_bf16_f32 %0, %1, %2" : "=v"(r) : "v"(lo), "v"(hi)); return r; }
__device__ __forceinline__ float fast_sigmoid(float x) { return __builtin_amdgcn_rcpf(1.f + __builtin_amdgcn_exp2f(-1.4426950408889634f * x)); }
__device__ __forceinline__ int lane_id() { int l; asm volatile("v_mbcnt_lo_u32_b32 %0, -1, 0\n\tv_mbcnt_hi_u32_b32 %0, -1, %0" : "=v"(l)); return l; }
__device__ __forceinline__ float wave_sum(float v) {
#pragma unroll
    for (int o = 1; o < 64; o <<= 1) v += __shfl_xor(v, o);
    return v;
}
__device__ __forceinline__ float wave_max(float v) {
#pragma unroll
    for (int o = 1; o < 64; o <<= 1) v = fmaxf(v, __shfl_xor(v, o));
    return v;
}

#define XB_TMO      128
#define XB_XCNT(j)  (256  + 64 * (j))
#define XB_XSUB(j)  (1280 + 64 * (j))
#define XB_XGEN(j)  (2304 + 64 * (j))
#define XB_TOP      3328
#define XB_TOPGEN   3392
#define XCD_BAR_WORDS 3456
#define XB_SPIN_CAP (1u << 20)

__device__ __forceinline__ unsigned xb_ld(unsigned* p)              { return __hip_atomic_load(p, __ATOMIC_RELAXED, __HIP_MEMORY_SCOPE_AGENT); }
__device__ __forceinline__ unsigned xb_add(unsigned* p, unsigned v) { return __hip_atomic_fetch_add(p, v, __ATOMIC_RELAXED, __HIP_MEMORY_SCOPE_AGENT); }
__device__ __forceinline__ unsigned xb_xcc_id() { return (unsigned)__builtin_amdgcn_s_getreg((3 << 11) | 20) & 0xFu; }
#define XB_SPIN(cond, bar) do { unsigned _sp = 0; while (cond) { __builtin_amdgcn_s_sleep(1); \
    if ((++_sp & 255u) == 0u) { if (xb_ld(&(bar)[XB_TMO])) break; if (_sp > XB_SPIN_CAP) { atomicAdd(&(bar)[XB_TMO], 1u); break; } } } } while (0)

struct XcdBarrier { unsigned* bar; unsigned x; volatile LAS unsigned* st; };

__device__ __forceinline__ XcdBarrier xcd_barrier_post(unsigned* bar, volatile LAS unsigned* st, bool leader  ) {
    XcdBarrier b; b.bar = bar; b.x = xb_xcc_id(); b.st = st;
    if (leader) (void)xb_add(&bar[XB_XCNT(b.x)], 1u);
    return b;
}
__device__ __forceinline__ void xcd_barrier_complete(unsigned* bar, unsigned x, unsigned& nloc, unsigned& nx) {
    const unsigned G = gridDim.x * gridDim.y * gridDim.z;
    unsigned sum, cnt, mine, sp = 0u;
    for (;;) {
        sum = 0u; cnt = 0u; mine = 0u;
#pragma unroll
        for (unsigned j = 0; j < 16; ++j) { const unsigned c = xb_ld(&bar[XB_XCNT(j)]); sum += c; cnt += (c > 0u) ? 1u : 0u; mine = (j == x) ? c : mine; }
        if (sum == G) break;
        __builtin_amdgcn_s_sleep(1);
        if ((++sp & 255u) == 0u) { if (xb_ld(&bar[XB_TMO])) break; if (sp > XB_SPIN_CAP) { atomicAdd(&bar[XB_TMO], 1u); break; } }
    }
    nloc = mine > 0u ? mine : 1u; nx = cnt > 0u ? cnt : 1u;
}
__device__ __forceinline__ void xcd_barrier(const XcdBarrier& b, bool leader  ) {
    asm volatile("s_waitcnt vmcnt(0)" ::: "memory");
    __syncthreads();
    if (leader) {
        unsigned* bar = b.bar;
        __builtin_amdgcn_s_waitcnt(0);
        unsigned nloc = b.st[0], nx = b.st[1];
        if (nloc == 0u) { xcd_barrier_complete(bar, b.x, nloc, nx); b.st[0] = nloc; b.st[1] = nx; }
        const unsigned old = xb_add(&bar[XB_XSUB(b.x)], 1u);
        const unsigned gen = old / nloc;
        if (old + 1u == (gen + 1u) * nloc) {
            __builtin_amdgcn_fence(__ATOMIC_RELEASE, "agent");
            asm volatile("s_waitcnt vmcnt(0)" ::: "memory");
            const unsigned og = xb_add(&bar[XB_TOP], 1u);
            const unsigned tg = og / nx;
            if (og + 1u == (tg + 1u) * nx) xb_add(&bar[XB_TOPGEN], 1u);
            else XB_SPIN(xb_ld(&bar[XB_TOPGEN]) == tg, bar);
            __builtin_amdgcn_fence(__ATOMIC_ACQUIRE, "agent");
            xb_add(&bar[XB_XGEN(b.x)], 1u);
            asm volatile("s_waitcnt vmcnt(0)" ::: "memory");
        } else {
            XB_SPIN(xb_ld(&bar[XB_XGEN(b.x)]) == gen, bar);
            __builtin_amdgcn_fence(__ATOMIC_ACQUIRE, "agent");
            asm volatile("s_waitcnt vmcnt(0)" ::: "memory");
        }
    }
    __syncthreads();
}

namespace pg8 {
constexpr int BM = 256, BK = 64, HALF = 128, HTB = HALF * BK * 2, STAGE_BYTES = 8 * HTB, NXCD = 8, WGM = 8;
__host__ __device__ __forceinline__ int lds_byte(int r, int c) { const int st = (r >> 4) * 2 + (c >> 5), rr = r & 15, cc = c & 31, ob = rr * 64 + cc * 2; return st * 1024 + (ob ^ (((ob >> 9) & 1) << 5)); }
__host__ __device__ __forceinline__ void stage_rc(int b, int& R, int& C) { const int st = b / 1024, sb = b % 1024, swz = sb ^ (((sb >> 9) & 1) << 5); R = (st >> 1) * 16 + swz / 64; C = (st & 1) * 32 + (swz % 64) / 2; }
__host__ __device__ __forceinline__ int perm32(int rho) { const int n = rho >> 4, i = rho & 15; return 8 * (i >> 2) + 4 * n + (i & 3); }

struct Unit { int pm, pn, pb, aux, aux2; };
struct Gemm { const bf16_t* A; const bf16_t* Bt; int lda, ldb, K; };

struct StaticOrder {
    int nM, nN, nwg, G, c;
    __device__ void init(int M, int N, int G_, int c_) { nM = M / BM; nN = N / BM; nwg = nM * nN; G = G_; c = c_; }
    __device__ bool next(int i, Unit& u) const {
        const long L = (long)i * G + c; if (L >= nwg) return false;
        int wgid = (int)L; { const int q = nwg / NXCD, r = nwg % NXCD, xcd = wgid % NXCD, off = wgid / NXCD; wgid = (xcd < r ? xcd * (q + 1) : r * (q + 1) + (xcd - r) * q) + off; }
        const int nig = WGM * nN, gid = wgid / nig, fm = gid * WGM, gsz = (nM - fm) < WGM ? (nM - fm) : WGM;
        u.pm = fm + ((wgid % nig) % gsz); u.pn = (wgid % nig) / gsz; u.pb = u.pn; u.aux = 0; u.aux2 = 0; return true;
    }
};
struct GroupedOrder {
    int nM, nN, rtpg, G, v;
    __device__ void init(int nM_, int nN_, int rtpg_, int G_, int v_) { nM = nM_; nN = nN_; rtpg = rtpg_; G = G_; v = v_; }
    __device__ bool next(int i, Unit& u) const {
        const int L = i * G + v; if (L >= nM * nN) return false;
        u.pm = L / nN; u.pn = L % nN; u.aux = u.pm / rtpg; u.pb = u.aux * nN + u.pn; u.aux2 = 0; return true;
    }
};

template <class Epi, class Sched, bool ALIGN_EPI, bool GATHER, bool FP8 = false>
__device__ __forceinline__ void gemm_phase(LAS unsigned char* lds, const Gemm g, const Sched& S, const Epi& E, const LAS unsigned* rowtab  , int wid  ) {
    const int lane = lane_id(), tid = wid * 64 + lane, wr = wid >> 2, wc = wid & 3;
    const int K = g.K, nt = K / BK;
    unsigned voffB[2];
#pragma unroll
    for (int i = 0; i < 2; ++i) { int R, C; stage_rc(tid * 16 + i * 8192, R, C); const int Rb = (R & ~31) + perm32(R & 31);
        voffB[i] = (unsigned)(Rb * g.ldb + C) * 2u; }
    const size_t kstep = (size_t)(BK * 2);
    const size_t hstepB = (size_t)HALF * g.ldb * 2, tstepB = 2 * hstepB;
    const size_t tstepA = (size_t)BM * g.lda * 2;
    const unsigned ldsw = (unsigned)wid * 1024u;
    const int aoff = lds_byte(wr * 64 + (lane & 15), (lane >> 4) * 8), boff = lds_byte(wc * 32 + (lane & 15), (lane >> 4) * 8);
    unsigned vAc[2][2];
#define PG8_SETVA(dst, ui_) do { const int t_ = wid * 64 + lane_id(); _Pragma("unroll") for (int i_ = 0; i_ < 2; ++i_) { int R_, C_; stage_rc(t_ * 16 + i_ * 8192, R_, C_); \
        _Pragma("unroll") for (int h_ = 0; h_ < 2; ++h_) dst[h_][i_] = (GATHER ? rowtab[(ui_) * 256 + h_ * 128 + R_] : (unsigned)((h_ * 128 + R_) * g.lda) * 2u) + (unsigned)C_ * 2u; } } while (0)
#define PG8_SA(b, h) (((b) * 2 + (h)) * HTB)
#define PG8_SB(b, h) ((4 + (b) * 2 + (h)) * HTB)
#define PG8_GLDS_S(gbase_, voff_, ldsaddr_) do { unsigned keep_; asm volatile("s_mov_b32 %0, m0\n\ts_mov_b32 m0, %3\n\ts_nop 0\n\tglobal_load_lds_dwordx4 %1, %2\n\ts_mov_b32 m0, %0" \
        : "=&s"(keep_) : "v"(voff_), "s"(gbase_), "s"(ldsaddr_) : "memory"); } while (0)
#define PG8_STAGE(bufoff, gbase, v0, v1) do { \
        if constexpr (FP8) { const unsigned la_ = (unsigned)(uintptr_t)(lds + (bufoff) + ldsw); PG8_GLDS_S((const char*)(gbase), (v0), la_); PG8_GLDS_S((const char*)(gbase), (v1), la_ + 8192u); } else { \
        __builtin_amdgcn_global_load_lds((const unsigned*)((const char*)(gbase) + (v0)), (LAS unsigned*)(lds + (bufoff) + ldsw), 16, 0, 0); \
        __builtin_amdgcn_global_load_lds((const unsigned*)((const char*)(gbase) + (v1)), (LAS unsigned*)(lds + (bufoff) + ldsw + 8192), 16, 0, 0); } } while (0)
#define PG8_STB(bufoff, gbase) PG8_STAGE(bufoff, gbase, voffB[0], voffB[1])
#define PG8_LDA(dst, b, h) do { _Pragma("unroll") for (int m = 0; m < 4; ++m) _Pragma("unroll") for (int k = 0; k < 2; ++k) dst[m][k] = *(const LAS bf16x8*)(lds + PG8_SA(b, h) + aoff + m * 2048 + k * 1024); } while (0)
#define PG8_LDB(dst, b, h) do { _Pragma("unroll") for (int n = 0; n < 2; ++n) _Pragma("unroll") for (int k = 0; k < 2; ++k) dst[n][k] = *(const LAS bf16x8*)(lds + PG8_SB(b, h) + boff + n * 2048 + k * 1024); } while (0)
#define PG8_MMA(ai, bj, At, Bt) do { __builtin_amdgcn_s_setprio(1); \
        if constexpr (FP8) { _Pragma("unroll") for (int m = 0; m < 4; ++m) _Pragma("unroll") for (int n = 0; n < 2; ++n) { \
            const v8i32 a8_ = __builtin_shufflevector(__builtin_bit_cast(v4i32, At[m][0]), __builtin_bit_cast(v4i32, At[m][1]), 0, 1, 2, 3, 4, 5, 6, 7); \
            const v8i32 b8_ = __builtin_shufflevector(__builtin_bit_cast(v4i32, Bt[n][0]), __builtin_bit_cast(v4i32, Bt[n][1]), 0, 1, 2, 3, 4, 5, 6, 7); \
            acc[ai][bj][m][n] = __builtin_amdgcn_mfma_scale_f32_16x16x128_f8f6f4(b8_, a8_, acc[ai][bj][m][n], 0, 0, 0, 0, 0, 0); } } \
        else { _Pragma("unroll") for (int m = 0; m < 4; ++m) _Pragma("unroll") for (int n = 0; n < 2; ++n) _Pragma("unroll") for (int k = 0; k < 2; ++k) \
            acc[ai][bj][m][n] = __builtin_amdgcn_mfma_f32_16x16x32_bf16(Bt[n][k], At[m][k], acc[ai][bj][m][n], 0, 0, 0); } \
        __builtin_amdgcn_s_setprio(0); } while (0)
#define PG8_WAIT_V(n) asm volatile("s_waitcnt vmcnt(" #n ")" ::: "memory")
#define PG8_WAIT_L(n) asm volatile("s_waitcnt lgkmcnt(" #n ")" ::: "memory")
#define PG8_BAR __builtin_amdgcn_s_barrier()
#define PG8_SCHED __builtin_amdgcn_sched_barrier(0)
#define PG8_SCHED8 do { if constexpr (FP8) __builtin_amdgcn_sched_barrier(0); } while (0)
    Unit cur, nxt; int ui = 0;
#define PG8_UNI(u_) do { u_.pm = __builtin_amdgcn_readfirstlane(u_.pm); u_.pn = __builtin_amdgcn_readfirstlane(u_.pn); u_.pb = __builtin_amdgcn_readfirstlane(u_.pb); u_.aux = __builtin_amdgcn_readfirstlane(u_.aux); u_.aux2 = __builtin_amdgcn_readfirstlane(u_.aux2); } while (0)
    if (!S.next(0, cur)) return;
    PG8_UNI(cur);
    f32x4 acc[2][2][4][2];
#pragma unroll
    for (int a = 0; a < 2; ++a)
#pragma unroll
        for (int b = 0; b < 2; ++b)
#pragma unroll
            for (int m = 0; m < 4; ++m)
#pragma unroll
                for (int n = 0; n < 2; ++n) acc[a][b][m][n] = (f32x4){0.f, 0.f, 0.f, 0.f};
    bf16x8 At[4][2], B0[2][2], B1[2][2];
    const char* cA = (const char*)g.A + (GATHER ? (size_t)0 : (size_t)cur.pm * tstepA); const char* cB = (const char*)g.Bt + (size_t)cur.pb * tstepB;
    PG8_SETVA(vAc, 0);
    PG8_STB(PG8_SB(0, 0), cB); PG8_STB(PG8_SB(0, 1), cB + hstepB); PG8_STAGE(PG8_SA(0, 0), cA, vAc[0][0], vAc[0][1]); PG8_STAGE(PG8_SA(0, 1), cA, vAc[1][0], vAc[1][1]);
    if (wr == 1) PG8_BAR;
    PG8_WAIT_V(2); PG8_BAR;
    PG8_STB(PG8_SB(1, 0), cB + kstep); PG8_STAGE(PG8_SA(1, 0), cA + kstep, vAc[0][0], vAc[0][1]); PG8_STB(PG8_SB(1, 1), cB + hstepB + kstep);
    PG8_WAIT_V(6); PG8_BAR;
    for (;;) {
        const bool has_next = S.next(ui + 1, nxt);
        PG8_UNI(nxt);
        const char* nA = GATHER ? cA : (has_next ? (const char*)g.A + (size_t)nxt.pm * tstepA : cA); const char* nB = has_next ? (const char*)g.Bt + (size_t)nxt.pb * tstepB : cB;
        const int nui = has_next ? ui + 1 : ui;
#pragma nounroll
        for (int t = 0; t < nt; t += 2) {
            const bool last = (t == nt - 2);
            const char* a1 = cA + (size_t)(t + 1) * kstep;
            const char* a2 = last ? nA : cA + (size_t)(t + 2) * kstep; const char* b2 = last ? nB : cB + (size_t)(t + 2) * kstep;
            const char* a3 = a2 + kstep; const char* b3 = b2 + kstep;
            unsigned x00 = vAc[0][0], x01 = vAc[0][1], x10 = vAc[1][0], x11 = vAc[1][1];
            if (GATHER) { if (last) { unsigned vN_[2][2]; PG8_SETVA(vN_, nui); x00 = vN_[0][0]; x01 = vN_[0][1]; x10 = vN_[1][0]; x11 = vN_[1][1]; } }
            PG8_LDB(B0, 0, 0); PG8_LDB(B1, 0, 1); PG8_SCHED; PG8_LDA(At, 0, 0); PG8_STAGE(PG8_SA(1, 1), a1, vAc[1][0], vAc[1][1]);
            PG8_WAIT_V(8); PG8_WAIT_L(0); PG8_BAR; PG8_SCHED8; PG8_MMA(0, 0, At, B0); PG8_MMA(0, 1, At, B1); PG8_SCHED8; PG8_BAR; PG8_SCHED;
            PG8_LDA(At, 0, 1); PG8_STB(PG8_SB(0, 0), b2); PG8_STB(PG8_SB(0, 1), b2 + hstepB); PG8_STAGE(PG8_SA(0, 0), a2, x00, x01);
            PG8_WAIT_V(8); PG8_WAIT_L(0); PG8_BAR; PG8_SCHED8; PG8_MMA(1, 0, At, B0); PG8_MMA(1, 1, At, B1); PG8_SCHED8; PG8_BAR; PG8_SCHED;
            PG8_LDB(B0, 1, 0); PG8_LDB(B1, 1, 1); PG8_SCHED; PG8_LDA(At, 1, 0); PG8_STAGE(PG8_SA(0, 1), a2, x10, x11);
            PG8_WAIT_V(8); PG8_WAIT_L(0); PG8_BAR; PG8_SCHED8; PG8_MMA(0, 0, At, B0); PG8_MMA(0, 1, At, B1); PG8_SCHED8; PG8_BAR; PG8_SCHED;
            PG8_LDA(At, 1, 1); PG8_STB(PG8_SB(1, 0), b3); PG8_STB(PG8_SB(1, 1), b3 + hstepB); PG8_STAGE(PG8_SA(1, 0), a3, x00, x01);
            PG8_WAIT_V(8); PG8_WAIT_L(0); PG8_BAR; PG8_SCHED8; PG8_MMA(1, 0, At, B0); PG8_MMA(1, 1, At, B1); PG8_SCHED8; PG8_BAR; PG8_SCHED;
        }
        if constexpr (ALIGN_EPI) { if (wr == 0) PG8_BAR; }
        { int l_ = lane_id(); asm volatile("" : "+v"(l_));
          E(acc, cur, wr, wc, l_ & 15, l_ >> 4); }
        if (!has_next) break;
#pragma unroll
        for (int a = 0; a < 2; ++a)
#pragma unroll
            for (int b = 0; b < 2; ++b)
#pragma unroll
                for (int m = 0; m < 4; ++m)
#pragma unroll
                    for (int n = 0; n < 2; ++n) acc[a][b][m][n] = (f32x4){0.f, 0.f, 0.f, 0.f};
        cur = nxt; cA = nA; cB = nB; ++ui;
        if (GATHER) { PG8_SETVA(vAc, ui); }
        if constexpr (ALIGN_EPI) { if (wr == 1) PG8_BAR; }
    }
    PG8_WAIT_V(0);
    if constexpr (!ALIGN_EPI) { if (wr == 0) PG8_BAR; }
    PG8_BAR;
#undef PG8_SETVA
#undef PG8_UNI
#undef PG8_SA
#undef PG8_SB
#undef PG8_STAGE
#undef PG8_GLDS_S
#undef PG8_STB
#undef PG8_LDA
#undef PG8_LDB
#undef PG8_MMA
#undef PG8_WAIT_V
#undef PG8_WAIT_L
#undef PG8_BAR
#undef PG8_SCHED
#undef PG8_SCHED8
}
}
constexpr int NWAVES = 8, NTHR = 512;
constexpr int BATCH = 8, SEQ = 8192, T = BATCH * SEQ, D = 1024, DIN = 4096;
constexpr int DS = 512, DA = 512, NH = 8, HD = 64, NBLK = SEQ / 256;
constexpr int SG = 32, SHC = 16, SP = 64, SL = 32, SKU = SL * SHC  , SKS = 2 * SP  , SKY = SKU + SKS  , SROWS = T / SL  ;
constexpr int NE = 32, DE = 512;
constexpr float RMS_EPS = 1e-6f;
constexpr float LOG2E = 1.4426950408889634f;
constexpr float QSCALE = 0.125f * LOG2E;
constexpr float WF8_SCALE = 32.f;
constexpr int ROWCAP = T;
constexpr int HID_ROWS = 2 * T + NE * 256;

constexpr size_t MiB = 1u << 20;
constexpr size_t WS_CTL = 0, CTL_ZERO_BYTES = 1 * MiB;
constexpr size_t WS_WIN = 1 * MiB;
constexpr size_t WS_WGLU = 9 * MiB;
constexpr size_t WS_WUS = 10 * MiB;
constexpr size_t WS_WUA = 11 * MiB;
constexpr size_t WS_WOUT = 12 * MiB;
constexpr size_t WS_WR = 14 * MiB;
constexpr size_t WS_KMEAN = 15 * MiB;
constexpr size_t WS_SSMW = 16 * MiB;
constexpr size_t WS_SSMT = 24 * MiB;
constexpr size_t WS_W13 = 44 * MiB;
constexpr size_t WS_W2 = 108 * MiB;
constexpr size_t WS_A0 = 140 * MiB;
constexpr size_t WS_UP = 276 * MiB;
constexpr size_t WS_Q = 356 * MiB;
constexpr size_t WS_SSQ = 404 * MiB;
constexpr size_t WS_RLOG = 408 * MiB;
constexpr size_t WS_K = 420 * MiB;
constexpr size_t WS_ROWTOK = 428 * MiB, WS_ROWCOEF = 436 * MiB, WS_ROWRSTD = 444 * MiB;
constexpr size_t WS_GACT = 420 * MiB;
constexpr size_t WS_V = 484 * MiB;
constexpr size_t WS_YSSM = 484 * MiB;
constexpr size_t WS_SGS = 548 * MiB;
constexpr size_t WS_SGA = 676 * MiB;
constexpr size_t WS_E = 804 * MiB;
constexpr size_t WS_YATT = 836 * MiB;
constexpr size_t WS_PART0 = 420 * MiB, WS_PART1 = 484 * MiB, WS_PART2 = 932 * MiB;
constexpr size_t WS_QLIST = 900 * MiB;
constexpr size_t WS_PL = 268 * MiB;
constexpr size_t WS_MQ = 996 * MiB;
constexpr size_t WS_H1F8 = 836 * MiB;
constexpr size_t WS_WINF8 = 900 * MiB;
constexpr size_t WS_XGF8 = 836 * MiB;
constexpr size_t WS_SEGC = 998 * MiB;
constexpr size_t WS_END = 999 * MiB;
constexpr size_t WS_KFRAG = WS_A0, WS_VFRAG = WS_A0 + 64 * MiB, WS_H1 = WS_A0, WS_MRG = WS_A0, WS_HID = WS_A0;
constexpr size_t WS_X1 = WS_SGS, WS_XG = WS_UP, WS_Y0 = WS_UP, WS_Y1 = WS_E;
static_assert(WS_GACT + 64 * MiB <= WS_YSSM && WS_YSSM + 64 * MiB <= WS_SGS, "map");
static_assert(WS_HID + (size_t)HID_ROWS * DE * 2 <= WS_UP, "hid fits");
static_assert(WS_RLOG + (size_t)T * 72 * 4 <= WS_ROWTOK, "rlog fits");

constexpr int CW_TMO = 0, CW_CODE = 1;
constexpr int CW_BAR = 4096;
constexpr int CW_ECNT = 8192;
constexpr int CW_GCNT = 12288;

constexpr int RING_BYTES = 131072;
constexpr int ROWTAB_OFF = RING_BYTES, ROWTAB_UNITS = 12, ROWTAB_BYTES = 25 * 1024;
constexpr int MOE_TST_OFF = ROWTAB_OFF + ROWTAB_BYTES;
constexpr int MISC_OFF = MOE_TST_OFF + 512;
constexpr int LDS_BYTES = MISC_OFF + 128;
static_assert(LDS_BYTES <= 163840, "LDS");

struct Frame {
    LAS unsigned char* lds;
    volatile LAS unsigned* MISC;
    gu32* ctl;
    unsigned char* ws;
    int tid, lane, wave, vcu, G;
    const float* in[27];
    float* out;
};

__device__ __forceinline__ unsigned pk4_fp8(float a, float b, float c, float d) { int w = 0; w = __builtin_amdgcn_cvt_pk_fp8_f32(a, b, w, false); w = __builtin_amdgcn_cvt_pk_fp8_f32(c, d, w, true); return (unsigned)w; }
#define EPI_LOOP_BEGIN  _Pragma("unroll") for (int ai = 0; ai < 2; ++ai) _Pragma("unroll") for (int m = 0; m < 4; ++m) { const int rl = ai * 128 + wr * 64 + m * 16 + fr; _Pragma("unroll") for (int bj = 0; bj < 2; ++bj) { const int cl = bj * 128 + wc * 32 + 8 * fq; \
        const f32x4 a0 = acc[ai][bj][m][0], a1 = acc[ai][bj][m][1]; (void)rl; (void)cl; (void)a0; (void)a1;
#define EPI_LOOP_END } }
typedef const f32x4 (&AccRef)[2][2][4][2];
__device__ __forceinline__ u32x4 pack8(f32x4 a, f32x4 b) { u32x4 w; w.x = cvt_pk_bf16(a[0], a[1]); w.y = cvt_pk_bf16(a[2], a[3]); w.z = cvt_pk_bf16(b[0], b[1]); w.w = cvt_pk_bf16(b[2], b[3]); return w; }
__device__ __forceinline__ void unpack8(u32x4 w, f32x4& a, f32x4& b) { a = (f32x4){bflo(w.x), bfhi(w.x), bflo(w.y), bfhi(w.y)}; b = (f32x4){bflo(w.z), bfhi(w.z), bflo(w.w), bfhi(w.w)}; }

template <int PART  > struct EpiProj {
    unsigned char* ws; const float* b_gate; int pn_off; float ascale;
    __device__ __forceinline__ void operator()(AccRef acc, const pg8::Unit& u, int wr, int wc, int fr, int fq) const {
        const int pn = u.pn + pn_off; const int row0 = u.pm * 256;
        if (PART == 0) {
            bf16_t* Uperm = (bf16_t*)(ws + WS_UP);
            EPI_LOOP_BEGIN
                const int row = row0 + rl, col = pn * 256 + cl;
                bf16_t* dst = Uperm + (size_t)(col >> 4) * ((size_t)SROWS * SKY) + (size_t)(row >> 5) * SKY + (row & 31) * 16 + (col & 15);
                *(u32x4*)dst = pack8(a0 * ascale, a1 * ascale);
            EPI_LOOP_END
        } else if (pn < 8) {
            const size_t boff = pn < 4 ? WS_Q : (pn < 6 ? WS_K : WS_V);
            bf16_t* base = (bf16_t*)(ws + boff); const float sc = pn < 4 ? QSCALE : 1.f; const int c0 = (pn & 1) * 256;
            EPI_LOOP_BEGIN
                const int row = row0 + rl, col = c0 + cl;
                *(u32x4*)(base + (size_t)row * 512 + col) = pack8(a0 * (sc * ascale), a1 * (sc * ascale));
            EPI_LOOP_END
        } else {
            const size_t boff = pn < 12 ? WS_SGS : WS_SGA;
            bf16_t* base = (bf16_t*)(ws + boff); const int c0 = ((pn - 8) & 3) * 256; const float* bg = b_gate + (pn - 8) * 256;
            EPI_LOOP_BEGIN
                const int row = row0 + rl, col = c0 + cl;
                const f32x4 b0 = *(const f32x4*)(bg + cl), b1 = *(const f32x4*)(bg + cl + 4);
                f32x4 s0, s1;
#pragma unroll
                for (int e = 0; e < 4; ++e) { s0[e] = fast_sigmoid(a0[e] * ascale + b0[e]); s1[e] = fast_sigmoid(a1[e] * ascale + b1[e]); }
                *(u32x4*)(base + (size_t)row * 1024 + col) = pack8(s0, s1);
            EPI_LOOP_END
        }
    }
};
struct EpiSsmE {
    float* E;
    __device__ __forceinline__ void operator()(AccRef acc, const pg8::Unit& u, int wr, int wc, int fr, int fq) const {
        EPI_LOOP_BEGIN
            if (bj == 0) { float* dst = E + (size_t)(u.pm * 256 + rl) * 128 + cl; *(f32x4*)dst = a0; *(f32x4*)(dst + 4) = a1; }
        EPI_LOOP_END
    }
};
__device__ __forceinline__ float gelu_tanh(float x) { const float z = 1.5957691216057308f * (x + 0.044715f * x * x * x); return x * fast_sigmoid(z); }
struct EpiSsmY {
    bf16_t* Gact;
    __device__ __forceinline__ void operator()(AccRef acc, const pg8::Unit& u, int wr, int wc, int fr, int fq) const {
        const int g = u.aux;
        EPI_LOOP_BEGIN
            const int rg = (u.pm & 7) * 256 + rl;
            const int colg = u.pn * 256 + cl;
            const int tok = (rg >> 8) * SEQ + (rg & 255) * SL + (colg >> 4);
            f32x4 y0, y1;
#pragma unroll
            for (int e = 0; e < 4; ++e) { y0[e] = gelu_tanh(a0[e]); y1[e] = gelu_tanh(a1[e]); }
            *(u32x4*)(Gact + (size_t)tok * DS + g * 16 + (colg & 15)) = pack8(y0, y1);
        EPI_LOOP_END
    }
};
struct EpiGlu {
    const bf16_t* Gact; bf16_t* Yssm; const float* b_glu;
    __device__ __forceinline__ void operator()(AccRef acc, const pg8::Unit& u, int wr, int wc, int fr, int fq) const {
        EPI_LOOP_BEGIN
            const int row = u.pm * 256 + rl, col = u.pn * 256 + cl;
            const f32x4 b0 = *(const f32x4*)(b_glu + col), b1 = *(const f32x4*)(b_glu + col + 4);
            f32x4 g0, g1; unpack8(*(const u32x4*)(Gact + (size_t)row * DS + col), g0, g1);
            f32x4 y0, y1;
#pragma unroll
            for (int e = 0; e < 4; ++e) { y0[e] = g0[e] * fast_sigmoid(a0[e] + b0[e]); y1[e] = g1[e] * fast_sigmoid(a1[e] + b1[e]); }
            *(u32x4*)(Yssm + (size_t)row * DS + col) = pack8(y0, y1);
        EPI_LOOP_END
    }
};
template <bool SECOND> struct EpiUp {
    const bf16_t* SG; bf16_t* Mrg;
    __device__ __forceinline__ void operator()(AccRef acc, const pg8::Unit& u, int wr, int wc, int fr, int fq) const {
        EPI_LOOP_BEGIN
            const size_t off = (size_t)(u.pm * 256 + rl) * D + u.pn * 256 + cl;
            f32x4 s0, s1; unpack8(*(const u32x4*)(SG + off), s0, s1);
            f32x4 y0 = s0 * a0, y1 = s1 * a1;
            if (SECOND) { f32x4 p0, p1; unpack8(*(const u32x4*)(Mrg + off), p0, p1); y0 += p0; y1 += p1; }
            *(u32x4*)(Mrg + off) = pack8(y0, y1);
        EPI_LOOP_END
    }
};
struct EpiOut {
    const float* x; float* X1; bf16_t* XG; unsigned char* XG8; const float* g2; float* SSQ;
    __device__ __forceinline__ void operator()(AccRef acc, const pg8::Unit& u, int wr, int wc, int fr, int fq) const {
#pragma unroll
        for (int ai = 0; ai < 2; ++ai)
#pragma unroll
            for (int m = 0; m < 4; ++m) { const int row = u.pm * 256 + ai * 128 + wr * 64 + m * 16 + fr; float ss = 0.f;
#pragma unroll
                for (int bj = 0; bj < 2; ++bj) { const int col = u.pn * 256 + bj * 128 + wc * 32 + 8 * fq; const size_t off = (size_t)row * D + col;
                    const f32x4 x0 = *(const f32x4*)(x + off) + acc[ai][bj][m][0], x1 = *(const f32x4*)(x + off + 4) + acc[ai][bj][m][1];
                    *(f32x4*)(X1 + off) = x0; *(f32x4*)(X1 + off + 4) = x1;
                    ss += (x0[0] * x0[0] + x0[1] * x0[1]) + (x0[2] * x0[2] + x0[3] * x0[3]) + (x1[0] * x1[0] + x1[1] * x1[1]) + (x1[2] * x1[2] + x1[3] * x1[3]);
                    const f32x4 w0 = *(const f32x4*)(g2 + col), w1 = *(const f32x4*)(g2 + col + 4);
                    const f32x4 y0 = x0 * w0, y1 = x1 * w1;
                    *(u32x4*)(XG + off) = pack8(y0, y1); *(u32x2*)(XG8 + off) = (u32x2){pk4_fp8(y0[0], y0[1], y0[2], y0[3]), pk4_fp8(y1[0], y1[1], y1[2], y1[3])}; }
                ss += __shfl_xor(ss, 16); ss += __shfl_xor(ss, 32);
                if (fq == 0) SSQ[(size_t)row * 16 + u.pn * 4 + wc] = ss; }
    }
};
struct EpiRouter {
    float* Rlog;
    __device__ __forceinline__ void operator()(AccRef acc, const pg8::Unit& u, int wr, int wc, int fr, int fq) const {
        EPI_LOOP_BEGIN
            if (bj == 0 && cl < 72) { float* dst = Rlog + (size_t)(u.pm * 256 + rl) * 72 + cl; *(f32x4*)dst = a0; *(f32x4*)(dst + 4) = a1; }
        EPI_LOOP_END
    }
};
struct EpiMoe1 {
    bf16_t* Hid; const float* rowrstd; const unsigned* ecnt; float ascale;
    __device__ __forceinline__ void operator()(AccRef acc, const pg8::Unit& u, int wr, int wc, int fr, int fq) const {
        const int e = u.aux, cnt = (int)ecnt[e];
#pragma unroll
        for (int ai = 0; ai < 2; ++ai)
#pragma unroll
            for (int m = 0; m < 4; ++m) { const int rl = ai * 128 + wr * 64 + m * 16 + fr; const int pos = u.aux2 + rl;
                if (pos < cnt) { const float rs = rowrstd[(size_t)e * ROWCAP + pos] * ascale;
                    f32x4 h0, h1;
#pragma unroll
                    for (int k = 0; k < 4; ++k) { const float p = acc[ai][0][m][0][k] * rs, q = acc[ai][1][m][0][k] * rs; h0[k] = p * fast_sigmoid(p) * q;
                        const float p2 = acc[ai][0][m][1][k] * rs, q2 = acc[ai][1][m][1][k] * rs; h1[k] = p2 * fast_sigmoid(p2) * q2; }
                    *(u32x4*)(Hid + (size_t)(u.pm * 256 + rl) * DE + u.pn * 128 + wc * 32 + 8 * fq) = pack8(h0, h1); } }
    }
};
struct EpiMoe2 {
    bf16_t* Y0; size_t ydelta; const unsigned* rowtok; const float* rowcoef; const unsigned* ecnt;
    __device__ __forceinline__ void operator()(AccRef acc, const pg8::Unit& u, int wr, int wc, int fr, int fq) const {
        const int e = u.aux, cnt = (int)ecnt[e];
#pragma unroll
        for (int ai = 0; ai < 2; ++ai)
#pragma unroll
            for (int m = 0; m < 4; ++m) { const int rl = ai * 128 + wr * 64 + m * 16 + fr; const int pos = u.aux2 + rl;
                if (pos < cnt) { const unsigned tk = rowtok[(size_t)e * ROWCAP + pos]; const float cf = rowcoef[(size_t)e * ROWCAP + pos];
                    bf16_t* dst = (bf16_t*)((unsigned char*)Y0 + (size_t)(tk & 1u) * ydelta) + (size_t)(tk >> 1) * D + u.pn * 256 + wc * 32 + 8 * fq;
#pragma unroll
                    for (int bj = 0; bj < 2; ++bj) *(u32x4*)(dst + bj * 128) = pack8(acc[ai][bj][m][0] * cf, acc[ai][bj][m][1] * cf); } }
    }
};
__device__ __forceinline__ void transpose_item(const float* W, int N, int k0, int n0, bf16_t* WT, size_t drow0, int ldo, LAS float* scr, int lane) {
    float tv[32];
#pragma unroll
    for (int i = 0; i < 32; ++i) tv[i] = W[(size_t)(k0 + 2 * i + (lane >> 5)) * N + n0 + (lane & 31)];
#pragma unroll
    for (int i = 0; i < 32; ++i) scr[(2 * i + (lane >> 5)) * 33 + (lane & 31)] = tv[i];
    LDS_WAIT(); asm volatile("" ::: "memory");
    const int c = lane & 7;
#pragma unroll
    for (int j = 0; j < 4; ++j) { const int n = (lane >> 3) + 8 * j; const LAS float* s = scr + (8 * c) * 33 + n;
        u32x4 o; o.x = pk2(s[0 * 33], s[1 * 33]); o.y = pk2(s[2 * 33], s[3 * 33]); o.z = pk2(s[4 * 33], s[5 * 33]); o.w = pk2(s[6 * 33], s[7 * 33]);
        *(u32x4*)(WT + (drow0 + n) * (size_t)ldo + k0 + 8 * c) = o; }
    LDS_WAIT(); asm volatile("" ::: "memory");
}
__device__ __forceinline__ void transpose_item_f8(const float* W, int N, int k0, int n0, unsigned char* WT8, size_t drow0, int ldo, float scale, LAS float* scr, int lane) {
    float tv[32];
#pragma unroll
    for (int i = 0; i < 32; ++i) tv[i] = W[(size_t)(k0 + 2 * i + (lane >> 5)) * N + n0 + (lane & 31)];
#pragma unroll
    for (int i = 0; i < 32; ++i) scr[(2 * i + (lane >> 5)) * 33 + (lane & 31)] = tv[i] * scale;
    LDS_WAIT(); asm volatile("" ::: "memory");
    const int c = lane & 3;
#pragma unroll
    for (int j = 0; j < 2; ++j) { const int n = (lane >> 2) + 16 * j; const LAS float* s = scr + (16 * c) * 33 + n;
        u32x4 o; o.x = pk4_fp8(s[0 * 33], s[1 * 33], s[2 * 33], s[3 * 33]); o.y = pk4_fp8(s[4 * 33], s[5 * 33], s[6 * 33], s[7 * 33]);
        o.z = pk4_fp8(s[8 * 33], s[9 * 33], s[10 * 33], s[11 * 33]); o.w = pk4_fp8(s[12 * 33], s[13 * 33], s[14 * 33], s[15 * 33]);
        *(u32x4*)(WT8 + (drow0 + n) * (size_t)ldo + k0 + 16 * c) = o; }
    LDS_WAIT(); asm volatile("" ::: "memory");
}
template <int NR> __device__ __forceinline__ void rms_rows_to_bf16(int lane, const float* xrow, const float* g, bf16_t* orow, unsigned char* orow8) {
    f32x4 v[NR][4]; float s[NR];
#pragma unroll
    for (int r = 0; r < NR; ++r) { const f32x4* xr = (const f32x4*)(xrow + (size_t)r * D) + lane;
#pragma unroll
        for (int j = 0; j < 4; ++j) v[r][j] = xr[64 * j]; }
    const f32x4* gr = (const f32x4*)g + lane; f32x4 wv[4];
#pragma unroll
    for (int j = 0; j < 4; ++j) wv[j] = gr[64 * j];
#pragma unroll
    for (int r = 0; r < NR; ++r) { float a = 0.f;
#pragma unroll
        for (int j = 0; j < 4; ++j) a += (v[r][j].x * v[r][j].x + v[r][j].y * v[r][j].y) + (v[r][j].z * v[r][j].z + v[r][j].w * v[r][j].w);
        s[r] = a; }
#pragma unroll
    for (int o = 1; o < 64; o <<= 1) {
#pragma unroll
        for (int r = 0; r < NR; ++r) s[r] += __shfl_xor(s[r], o); }
#pragma unroll
    for (int r = 0; r < NR; ++r) { const float rstd = 1.f / sqrtf(s[r] * (1.f / D) + RMS_EPS); unsigned long long* o8 = (unsigned long long*)(orow + (size_t)r * D) + lane;
#pragma unroll
        for (int j = 0; j < 4; ++j) { const float y0 = v[r][j].x * rstd * wv[j].x, y1 = v[r][j].y * rstd * wv[j].y, y2 = v[r][j].z * rstd * wv[j].z, y3 = v[r][j].w * rstd * wv[j].w;
            o8[64 * j] = (unsigned long long)pk2(y0, y1) | ((unsigned long long)pk2(y2, y3) << 32);
            ((unsigned*)(orow8 + (size_t)r * D))[lane + 64 * j] = pk4_fp8(y0, y1, y2, y3); } }
}
__device__ __forceinline__ void cpow(float lr, float li, float step, float dl, float& ar, float& ai) {
    const float mag = __expf(dl * lr * step); const float rev = dl * (li * step * 0.15915494309189535f); const float fr = rev - floorf(rev);
    ar = mag * __builtin_amdgcn_cosf(fr); ai = mag * __builtin_amdgcn_sinf(fr);
}
__device__ __forceinline__ void ssm_gen(Frame& F, int g, int sl) {
    LAS float* AP = (LAS float*)(F.lds); LAS float* BB = AP + 33 * 64 * 2; LAS float* CC = BB + 2048; LAS float* KT = CC + 2048;
    const float* lam_re = F.in[4] + g * SP; const float* lam_im = F.in[5] + g * SP; const float step = __expf(F.in[6][g]);
    const float* b_re = F.in[7] + g * SP * SHC; const float* b_im = F.in[8] + g * SP * SHC; const float* c_re = F.in[9] + g * SHC * SP; const float* c_im = F.in[10] + g * SHC * SP; const float* dd = F.in[11] + g * SHC;
    bf16_t* BT = (bf16_t*)(F.ws + WS_SSMT) + (size_t)g * 512 * SKY; bf16_t* BW = (bf16_t*)(F.ws + WS_SSMW) + (size_t)g * 256 * SKU;
    const int tid = F.tid;
    for (int idx = tid; idx < 33 * 64; idx += NTHR) { const int dl = idx >> 6, p = idx & 63; float ar, ai; cpow(lam_re[p], lam_im[p], step, (float)dl, ar, ai); AP[idx * 2] = ar; AP[idx * 2 + 1] = ai; }
    for (int idx = tid; idx < 1024; idx += NTHR) { const int ho = idx >> 6, p = idx & 63; CC[idx * 2] = c_re[ho * 64 + p]; CC[idx * 2 + 1] = c_im[ho * 64 + p]; }
    __syncthreads();
    for (int idx = tid; idx < 1024; idx += NTHR) { const int p = idx >> 4, h = idx & 15; const float ar = AP[(64 + p) * 2], ai = AP[(64 + p) * 2 + 1];
        const float lr = lam_re[p], li = lam_im[p], nr = ar - 1.f, ni = ai, den = lr * lr + li * li, cr = (nr * lr + ni * li) / den, ci = (ni * lr - nr * li) / den;
        const float br = b_re[p * 16 + h], bi = b_im[p * 16 + h]; BB[idx * 2] = cr * br - ci * bi; BB[idx * 2 + 1] = cr * bi + ci * br; }
    __syncthreads();
    for (int idx = tid; idx < 1024; idx += NTHR) { const int dl = idx >> 5, hl = (idx >> 4) & 1, hi = idx & 15, ho = 2 * sl + hl; float s = 0.f;
        for (int p = 0; p < 64; ++p) { const float ar = AP[(dl * 64 + p) * 2], ai = AP[(dl * 64 + p) * 2 + 1], br = BB[(p * 16 + hi) * 2], bi = BB[(p * 16 + hi) * 2 + 1];
            const float zr = ar * br - ai * bi, zi = ar * bi + ai * br; s += CC[(ho * 64 + p) * 2] * zr - CC[(ho * 64 + p) * 2 + 1] * zi; }
        if (dl == 0 && ho == hi) s += dd[ho];
        KT[idx] = s; }
    __syncthreads();
    for (int v = tid; v < 64 * 80; v += NTHR) { const int nl = v / 80, kv = (v % 80) * 8, tau = nl >> 1, hl = nl & 1, ho = 2 * sl + hl, n = tau * 16 + ho; float val[8];
        if (kv < 512) { const int sg = kv >> 4, hi0 = kv & 15;
#pragma unroll
            for (int e = 0; e < 8; ++e) val[e] = (tau >= sg) ? KT[((tau - sg) * 2 + hl) * 16 + hi0 + e] : 0.f; }
        else { const int kk = kv - 512;
#pragma unroll
            for (int e = 0; e < 8; ++e) { const int p = (kk + e) >> 1, ri = (kk + e) & 1; const float ar = AP[((tau + 1) * 64 + p) * 2], ai = AP[((tau + 1) * 64 + p) * 2 + 1], cre = CC[(ho * 64 + p) * 2], cim = CC[(ho * 64 + p) * 2 + 1];
                val[e] = ri == 0 ? (cre * ar - cim * ai) : -(cre * ai + cim * ar); } }
        u32x4 o; o.x = pk2(val[0], val[1]); o.y = pk2(val[2], val[3]); o.z = pk2(val[4], val[5]); o.w = pk2(val[6], val[7]);
        *(u32x4*)(BT + (size_t)n * SKY + kv) = o; }
    for (int v = tid; v < 32 * 64; v += NTHR) { const int nl = v >> 6, kv = (v & 63) * 8; float val[8];
        const bool real = nl < 16; const int n = real ? 16 * sl + nl : 128 + 16 * sl + (nl - 16);
        if (real) { const int p = n >> 1, ri = n & 1, sg = kv >> 4, hi0 = kv & 15; const float ar = AP[((31 - sg) * 64 + p) * 2], ai = AP[((31 - sg) * 64 + p) * 2 + 1];
#pragma unroll
            for (int e = 0; e < 8; ++e) { const float br = BB[(p * 16 + hi0 + e) * 2], bi = BB[(p * 16 + hi0 + e) * 2 + 1]; val[e] = ri == 0 ? (ar * br - ai * bi) : (ar * bi + ai * br); } }
        else {
#pragma unroll
            for (int e = 0; e < 8; ++e) val[e] = 0.f; }
        u32x4 o; o.x = pk2(val[0], val[1]); o.y = pk2(val[2], val[3]); o.z = pk2(val[4], val[5]); o.w = pk2(val[6], val[7]);
        *(u32x4*)(BW + (size_t)n * SKU + kv) = o; }
    __syncthreads();
}
__device__ __forceinline__ void p0_prologue(Frame& F) {
    for (int it = F.vcu; it < SG * 8; it += F.G) ssm_gen(F, it >> 3, it & 7);
    LAS float* scr = (LAS float*)(F.lds + F.wave * 16384);
    const int gw = F.vcu * NWAVES + F.wave, NGW = F.G * NWAVES, lane = F.lane;
    constexpr int I_IN = 16 * 128, I_GLU = 8 * 16, I_US = 8 * 32, I_UA = 8 * 32, I_OUT = 16 * 32, I_W1 = 32 * 256, I_W3 = 32 * 256, I_W2 = 32 * 256;
    constexpr int NITEMS = I_IN + I_GLU + I_US + I_UA + I_OUT + I_W1 + I_W3 + I_W2;
    unsigned char* ws = F.ws;
    for (int it = gw; it < NITEMS; it += NGW) {
        int r = it;
        if (r < I_IN) { const int k0 = 64 * (r / 128), n0 = 32 * (r % 128);
            if (n0 < DS) transpose_item(F.in[2], DIN, k0, n0, (bf16_t*)(ws + WS_WIN), n0, D, scr, lane);
            else transpose_item_f8(F.in[2], DIN, k0, n0, ws + WS_WINF8, n0 - DS, D, WF8_SCALE, scr, lane);
            continue; } r -= I_IN;
        if (r < I_GLU) { transpose_item(F.in[12], DS, 64 * (r / 16), 32 * (r % 16), (bf16_t*)(ws + WS_WGLU), 32 * (r % 16), DS, scr, lane); continue; } r -= I_GLU;
        if (r < I_US) { transpose_item(F.in[14], D, 64 * (r / 32), 32 * (r % 32), (bf16_t*)(ws + WS_WUS), 32 * (r % 32), DS, scr, lane); continue; } r -= I_US;
        if (r < I_UA) { transpose_item(F.in[15], D, 64 * (r / 32), 32 * (r % 32), (bf16_t*)(ws + WS_WUA), 32 * (r % 32), DA, scr, lane); continue; } r -= I_UA;
        if (r < I_OUT) { transpose_item(F.in[17], D, 64 * (r / 32), 32 * (r % 32), (bf16_t*)(ws + WS_WOUT), 32 * (r % 32), D, scr, lane); continue; } r -= I_OUT;
        if (r < I_W1 + I_W3) { const int w3 = r >= I_W1; if (w3) r -= I_W1; const int e = r >> 8, q = r & 255, k0 = 64 * (q / 16), n0 = 32 * (q % 16);
            transpose_item_f8((w3 ? F.in[24] : F.in[23]) + (size_t)e * D * DE, DE, k0, n0, ws + WS_W13, (size_t)e * 1024 + 256 * (n0 >> 7) + (n0 & 127) + (w3 ? 128 : 0), D, WF8_SCALE, scr, lane); continue; }
        r -= I_W1 + I_W3;
        { const int e = r >> 8, q = r & 255, k0 = 64 * (q / 32), n0 = 32 * (q % 32);
            transpose_item(F.in[25] + (size_t)e * DE * D, D, k0, n0, (bf16_t*)(ws + WS_W2), (size_t)e * 1024 + n0, DE, scr, lane); }
    }
    for (int m = 4 * gw; m < T; m += 4 * NGW) rms_rows_to_bf16<4>(lane, F.in[0] + (size_t)m * D, F.in[1], (bf16_t*)(ws + WS_H1) + (size_t)m * D, ws + WS_H1F8 + (size_t)m * D);
    { bf16_t* WR = (bf16_t*)(ws + WS_WR); const float* wrg = F.in[19]; const float* wre = F.in[21];
      for (int idx = F.vcu * NTHR + F.tid; idx < 256 * D; idx += F.G * NTHR) { const int r = idx >> 10, k = idx & 1023; unsigned o = 0u;
          if (r < 72) { const int c = r < 36 ? r : r - 36; const float w = c < 4 ? wrg[k * 4 + c] : wre[k * 32 + (c - 4)]; const unsigned hb = f2bf(w);
              o = r < 36 ? hb : f2bf(w - __builtin_bit_cast(float, hb << 16)); }
          WR[idx] = (bf16_t)o; } }
}

__device__ __forceinline__ int crow(int r, int hi) { return (r & 3) + 8 * (r >> 2) + 4 * hi; }
constexpr int KVP = 72;
__device__ __forceinline__ void kv_prep_phase(Frame& F) {
    LAS bf16_t* KS = (LAS bf16_t*)(F.lds); LAS bf16_t* VS = KS + 256 * KVP; LAS float* PS = (LAS float*)(F.lds + 2 * 256 * KVP * 2); LAS float* WM = PS + 512;
    const bf16_t* Kb = (const bf16_t*)(F.ws + WS_K); const bf16_t* Vb = (const bf16_t*)(F.ws + WS_V);
    bf16_t* Kf = (bf16_t*)(F.ws + WS_KFRAG); bf16_t* Vf = (bf16_t*)(F.ws + WS_VFRAG); bf16_t* KM = (bf16_t*)(F.ws + WS_KMEAN); float* KN = (float*)(F.ws + WS_KMEAN + 512 * 1024);
    const int tid = F.tid;
    for (int item = F.vcu; item < BATCH * NH * NBLK; item += F.G) {
        const int n = item & 31, h = (item >> 5) & 7, b = item >> 8; const size_t tok0 = (size_t)b * SEQ + 256 * n;
#pragma unroll
        for (int j = 0; j < 4; ++j) { const int q = tid + NTHR * j, row = q >> 3, pc = q & 7; const size_t src = (tok0 + row) * DA + h * HD + pc * 8;
            *(LAS u32x4*)(KS + row * KVP + pc * 8) = *(const u32x4*)(Kb + src); *(LAS u32x4*)(VS + row * KVP + pc * 8) = *(const u32x4*)(Vb + src); }
        __syncthreads();
#pragma unroll
        for (int j = 0; j < 4; ++j) { const int P = tid + NTHR * j, st = P >> 8, ds = (P >> 6) & 3, l2 = P & 63, row = 32 * st + (l2 & 31), col = 16 * ds + 8 * (l2 >> 5);
            *(u32x4*)(Kf + ((size_t)item * 2048 + P) * 8) = *(const LAS u32x4*)(KS + row * KVP + col); }
#pragma unroll
        for (int j = 0; j < 4; ++j) { const int P = tid + NTHR * j, st = P >> 8, ks = (P >> 7) & 1, d0 = (P >> 6) & 1, l2 = P & 63, hi = l2 >> 5, jj = l2 & 31; unsigned w[4];
#pragma unroll
            for (int e = 0; e < 8; e += 2) { const unsigned lo = VS[(32 * st + 16 * ks + crow(e, hi)) * KVP + 32 * d0 + jj], hi16 = VS[(32 * st + 16 * ks + crow(e + 1, hi)) * KVP + 32 * d0 + jj]; w[e >> 1] = lo | (hi16 << 16); }
            *(u32x4*)(Vf + ((size_t)item * 2048 + P) * 8) = (u32x4){w[0], w[1], w[2], w[3]}; }
        { const int d = tid & 63, part = tid >> 6; float s = 0.f;
#pragma unroll 8
          for (int r = 0; r < 32; ++r) s += bf2f(KS[(part * 32 + r) * KVP + d]);
          PS[part * 64 + d] = s; }
        if (tid < 256) { float ss = 0.f;
#pragma unroll
            for (int c = 0; c < 8; ++c) { const u32x4 w = *(const LAS u32x4*)(KS + tid * KVP + c * 8);
                ss += bflo(w.x) * bflo(w.x) + bfhi(w.x) * bfhi(w.x) + bflo(w.y) * bflo(w.y) + bfhi(w.y) * bfhi(w.y) + bflo(w.z) * bflo(w.z) + bfhi(w.z) * bfhi(w.z) + bflo(w.w) * bflo(w.w) + bfhi(w.w) * bfhi(w.w); }
            ss = wave_max(ss); if (F.lane == 0) WM[F.wave] = ss; }
        __syncthreads();
        if (tid < 64) { float s = 0.f;
#pragma unroll
            for (int p = 0; p < 8; ++p) s += PS[p * 64 + tid];
            KM[(size_t)item * 64 + tid] = (bf16_t)f2bf(s * (1.f / 256.f)); }
        if (tid == 0) KN[item] = fmaxf(fmaxf(WM[0], WM[1]), fmaxf(WM[2], WM[3]));
        __syncthreads();
    }
}

__device__ __forceinline__ void ssm_scan_phase(Frame& F) {
    LAS float* FW = (LAS float*)(F.lds);
    const float* E = (const float*)(F.ws + WS_E); bf16_t* UP = (bf16_t*)(F.ws + WS_UP);
    const int w = F.wave, p = F.lane;
    for (int gb = F.vcu; gb < SG * BATCH; gb += F.G) {
        const int g = gb >> 3, b = gb & 7;
        const float lr = F.in[4][g * SP + p], li = F.in[5][g * SP + p], step = __expf(F.in[6][g]);
        float ar, ai; cpow(lr, li, step, 32.f, ar, ai);
        const size_t row0 = (size_t)g * SROWS + b * 256 + 32 * w;
        f32x2 e[32];
#pragma unroll
        for (int j = 0; j < 32; ++j) e[j] = *(const f32x2*)(E + (row0 + j) * 128 + 2 * p);
        float sr = 0.f, si = 0.f;
#pragma unroll
        for (int j = 0; j < 32; ++j) { const float nr = ar * sr - ai * si + e[j].x, ni = ar * si + ai * sr + e[j].y; sr = nr; si = ni; }
        FW[(w * 64 + p) * 2] = sr; FW[(w * 64 + p) * 2 + 1] = si;
        __syncthreads();
        float Ar = ar, Ai = ai;
#pragma unroll
        for (int q = 0; q < 5; ++q) { const float nr = Ar * Ar - Ai * Ai, ni = 2.f * Ar * Ai; Ar = nr; Ai = ni; }
        sr = 0.f; si = 0.f;
        for (int w2 = 0; w2 < w; ++w2) { const float fr = FW[(w2 * 64 + p) * 2], fi = FW[(w2 * 64 + p) * 2 + 1]; const float nr = Ar * sr - Ai * si + fr, ni = Ar * si + Ai * sr + fi; sr = nr; si = ni; }
#pragma unroll
        for (int j = 0; j < 32; ++j) { *(unsigned*)(UP + (row0 + j) * SKY + SKU + 2 * p) = pk2(sr, si);
            const float nr = ar * sr - ai * si + e[j].x, ni = ar * si + ai * sr + e[j].y; sr = nr; si = ni; }
        __syncthreads();
    }
}

__device__ __forceinline__ int t5_bucket(int d) {
    if (d < 16) return d;
    return 16 + (d >= 19) + (d >= 21) + (d >= 24) + (d >= 27) + (d >= 31) + (d >= 35) + (d >= 40) + (d >= 46) + (d >= 52) + (d >= 59) + (d >= 67) + (d >= 77) + (d >= 87) + (d >= 99) + (d >= 113);
}
struct Top3 { float v0, v1, v2; int i0, i1, i2; };
__device__ __forceinline__ Top3 top3_insert(Top3 t, float x, int n) {
    const bool b0 = (x > t.v0) || (x == t.v0 && n < t.i0), b1 = (x > t.v1) || (x == t.v1 && n < t.i1), b2 = (x > t.v2) || (x == t.v2 && n < t.i2);
    Top3 r;
    r.v2 = b1 ? t.v1 : (b2 ? x : t.v2); r.i2 = b1 ? t.i1 : (b2 ? n : t.i2);
    r.v1 = b0 ? t.v0 : (b1 ? x : t.v1); r.i1 = b0 ? t.i0 : (b1 ? n : t.i1);
    r.v0 = b0 ? x : t.v0; r.i0 = b0 ? n : t.i0;
    return r;
}
constexpr int GQS = 0, GKME = 36864, GCNTL = 41472, GMISC = 41600;
template <bool COUNT> __device__ __forceinline__ void attn_gate_unit(Frame& F, int bh, int qb) {
    LAS unsigned char* L = F.lds;
    LAS bf16_t* QS = (LAS bf16_t*)(L + GQS); LAS bf16_t* KME = (LAS bf16_t*)(L + GKME); LAS int* CNT = (LAS int*)(L + GCNTL); LAS float* KNM = (LAS float*)(L + GMISC);
    int tid = F.tid; asm volatile("" : "+v"(tid));
    const int lane = tid & 63, w = F.wave, j = lane & 31, hi = lane >> 5;
    const int b = bh >> 3, h = bh & 7; const size_t tok0 = (size_t)b * SEQ + 256 * qb;
    const bf16_t* Qb = (const bf16_t*)(F.ws + WS_Q); const bf16_t* KM = (const bf16_t*)(F.ws + WS_KMEAN); const float* KN = (const float*)(F.ws + WS_KMEAN + 512 * 1024);
    float* MQg = (float*)(F.ws + WS_MQ); unsigned short* QL = (unsigned short*)(F.ws + WS_QLIST); unsigned* GC = (unsigned*)(F.ctl + CW_GCNT); unsigned* SEGC = (unsigned*)(F.ws + WS_SEGC);
#pragma unroll
    for (int jj = 0; jj < 4; ++jj) { const int q = tid + NTHR * jj, row = q >> 3, pc = q & 7; *(LAS u32x4*)(QS + row * KVP + pc * 8) = *(const u32x4*)(Qb + (tok0 + row) * DA + h * HD + pc * 8); }
    if (tid < 256) { const int n = tid >> 3, pc = tid & 7; *(LAS u32x4*)(KME + n * KVP + pc * 8) = *(const u32x4*)(KM + ((size_t)bh * 32 + n) * 64 + pc * 8); }
    if (tid < 32) CNT[tid] = 0;
    if (w == 1) { float v = (lane <= qb && lane < 32) ? KN[bh * 32 + lane] : 0.f; v = wave_max(v); if (lane == 0) KNM[0] = v; }
    if (w == 2) { float v = F.in[16][h * 32 + (lane & 31)]; v = wave_max(v); if (lane == 0) KNM[1] = v * LOG2E; }
    __syncthreads();
    {
        bf16x8 qf[4], kmf[4];
#pragma unroll
        for (int ds = 0; ds < 4; ++ds) { qf[ds] = *(const LAS bf16x8*)(QS + (32 * w + j) * KVP + 16 * ds + 8 * hi); kmf[ds] = *(const LAS bf16x8*)(KME + j * KVP + 16 * ds + 8 * hi); }
        f32x16 gt = {};
#pragma unroll
        for (int ds = 0; ds < 4; ++ds) gt = __builtin_amdgcn_mfma_f32_32x32x16_bf16(kmf[ds], qf[ds], gt, 0, 0, 0);
        float qn = 0.f;
#pragma unroll
        for (int ds = 0; ds < 4; ++ds)
#pragma unroll
            for (int e = 0; e < 8; ++e) { const float x = bf2f((unsigned short)qf[ds][e]); qn += x * x; }
        qn += __shfl_xor(qn, 32);
        const float m2 = sqrtf(qn * KNM[0]) + KNM[1];
        const int ql = 256 * qb + 32 * w + j;
        if (hi == 0) MQg[(size_t)bh * SEQ + ql] = m2;
        Top3 t3; t3.v0 = t3.v1 = t3.v2 = -INFINITY; t3.i0 = t3.i1 = t3.i2 = -1;
#pragma unroll
        for (int r = 0; r < 16; ++r) { const int n = crow(r, hi); const float x = (n < qb) ? gt[r] : -INFINITY; t3 = top3_insert(t3, x, x > -INFINITY ? n : 0x7fffffff); }
        { const float p0 = __shfl_xor(t3.v0, 32), p1 = __shfl_xor(t3.v1, 32), p2 = __shfl_xor(t3.v2, 32); const int q0 = __shfl_xor(t3.i0, 32), q1 = __shfl_xor(t3.i1, 32), q2 = __shfl_xor(t3.i2, 32);
          t3 = top3_insert(t3, p0, q0 >= 0 ? q0 : 0x7fffffff); t3 = top3_insert(t3, p1, q1 >= 0 ? q1 : 0x7fffffff); t3 = top3_insert(t3, p2, q2 >= 0 ? q2 : 0x7fffffff); }
        const int i0 = t3.v0 > -INFINITY ? t3.i0 : -1, i1 = t3.v1 > -INFINITY ? t3.i1 : -1, i2 = t3.v2 > -INFINITY ? t3.i2 : -1;
        if (hi == 0) { const unsigned e = (unsigned)ql << 2;
            if (i0 >= 0) { const int pos = __hip_atomic_fetch_add(CNT + i0, 1, __ATOMIC_RELAXED, __HIP_MEMORY_SCOPE_WORKGROUP); QL[((size_t)bh * 32 + i0) * SEQ + (qb - i0 - 1) * 256 + pos] = (unsigned short)(e | 0u); }
            if (i1 >= 0) { const int pos = __hip_atomic_fetch_add(CNT + i1, 1, __ATOMIC_RELAXED, __HIP_MEMORY_SCOPE_WORKGROUP); QL[((size_t)bh * 32 + i1) * SEQ + (qb - i1 - 1) * 256 + pos] = (unsigned short)(e | 1u); }
            if (i2 >= 0) { const int pos = __hip_atomic_fetch_add(CNT + i2, 1, __ATOMIC_RELAXED, __HIP_MEMORY_SCOPE_WORKGROUP); QL[((size_t)bh * 32 + i2) * SEQ + (qb - i2 - 1) * 256 + pos] = (unsigned short)(e | 2u); } }
    }
    __syncthreads();
    if (tid < qb) { const unsigned c = (unsigned)CNT[tid]; SEGC[((size_t)bh * 32 + tid) * 32 + (qb - tid - 1)] = c; if (COUNT && c) (void)__hip_atomic_fetch_add(GC + bh * 32 + tid, c, __ATOMIC_RELAXED, __HIP_MEMORY_SCOPE_AGENT); }
    __syncthreads();
}
template <bool COUNT> __device__ __forceinline__ void attn_gate_phase(Frame& F) {
    for (int u = F.vcu; u < BATCH * NH * NBLK; u += F.G) attn_gate_unit<COUNT>(F, u >> 5, u & 31);
}

#define ATTN_SUBTILE(KP, VP, st_, MODE, CINIT) do { \
        bf16x8 kf_[4], vf_[4]; \
        _Pragma("unroll") for (int ds_ = 0; ds_ < 4; ++ds_) kf_[ds_] = *(const LAS bf16x8*)((KP) + ((st_) * 4 + ds_) * 512 + lane8); \
        _Pragma("unroll") for (int q_ = 0; q_ < 4; ++q_) vf_[q_] = *(const LAS bf16x8*)((VP) + ((st_) * 4 + q_) * 512 + lane8); \
        f32x16 s_ = __builtin_amdgcn_mfma_f32_32x32x16_bf16(kf_[0], qf[0], CINIT, 0, 0, 0); \
        _Pragma("unroll") for (int ds_ = 1; ds_ < 4; ++ds_) s_ = __builtin_amdgcn_mfma_f32_32x32x16_bf16(kf_[ds_], qf[ds_], s_, 0, 0, 0); \
        float p_[16]; \
        if ((MODE) == 0) { _Pragma("unroll") for (int r_ = 0; r_ < 16; ++r_) p_[r_] = __builtin_amdgcn_exp2f(s_[r_]); } \
        else if ((MODE) == 1) { _Pragma("unroll") for (int r_ = 0; r_ < 16; ++r_) { const int dist_ = dq - (32 * (st_) + crow(r_, hi)); const int di_ = dist_ < 0 ? 0 : (dist_ > 127 ? 127 : dist_); \
                p_[r_] = __builtin_amdgcn_exp2f(s_[r_] + TABh[di_]); } } \
        else { _Pragma("unroll") for (int rq_ = 0; rq_ < 4; ++rq_) { const f32x4 bb_ = *(const LAS f32x4*)(BTD + rq_ * 256 + lane * 4); \
                _Pragma("unroll") for (int i_ = 0; i_ < 4; ++i_) p_[4 * rq_ + i_] = __builtin_amdgcn_exp2f(s_[4 * rq_ + i_] + bb_[i_]); } } \
        _Pragma("unroll") for (int r_ = 0; r_ < 16; ++r_) lsum += p_[r_]; \
        u32x4 pa_, pb_; pa_.x = cvt_pk_bf16(p_[0], p_[1]); pa_.y = cvt_pk_bf16(p_[2], p_[3]); pa_.z = cvt_pk_bf16(p_[4], p_[5]); pa_.w = cvt_pk_bf16(p_[6], p_[7]); \
        pb_.x = cvt_pk_bf16(p_[8], p_[9]); pb_.y = cvt_pk_bf16(p_[10], p_[11]); pb_.z = cvt_pk_bf16(p_[12], p_[13]); pb_.w = cvt_pk_bf16(p_[14], p_[15]); \
        const bf16x8 A0_ = __builtin_bit_cast(bf16x8, pa_), A1_ = __builtin_bit_cast(bf16x8, pb_); \
        o0 = __builtin_amdgcn_mfma_f32_32x32x16_bf16(vf_[0], A0_, o0, 0, 0, 0); o1 = __builtin_amdgcn_mfma_f32_32x32x16_bf16(vf_[1], A0_, o1, 0, 0, 0); \
        o0 = __builtin_amdgcn_mfma_f32_32x32x16_bf16(vf_[2], A1_, o0, 0, 0, 0); o1 = __builtin_amdgcn_mfma_f32_32x32x16_bf16(vf_[3], A1_, o1, 0, 0, 0); } while (0)

__device__ __forceinline__ u32x4 ot_pack16(const f32x16& o, int pr) {
    const unsigned p0 = cvt_pk_bf16(o[8 * pr], o[8 * pr + 1]), p1 = cvt_pk_bf16(o[8 * pr + 2], o[8 * pr + 3]), q0 = cvt_pk_bf16(o[8 * pr + 4], o[8 * pr + 5]), q1 = cvt_pk_bf16(o[8 * pr + 6], o[8 * pr + 7]);
    const auto r0 = __builtin_amdgcn_permlane32_swap(p0, q0, false, false); const auto r1 = __builtin_amdgcn_permlane32_swap(p1, q1, false, false);
    return (u32x4){r0[0], r1[0], r0[1], r1[1]};
}
__device__ __forceinline__ void ot_add16(f32x16& o, int pr, u32x4 v, bool use) {
    const auto r0 = __builtin_amdgcn_permlane32_swap(v.x, v.z, false, false); const auto r1 = __builtin_amdgcn_permlane32_swap(v.y, v.w, false, false);
    const unsigned p0 = r0[0], p1 = r1[0], q0 = r0[1], q1 = r1[1];
    o[8 * pr] += use ? bflo(p0) : 0.f; o[8 * pr + 1] += use ? bfhi(p0) : 0.f; o[8 * pr + 2] += use ? bflo(p1) : 0.f; o[8 * pr + 3] += use ? bfhi(p1) : 0.f;
    o[8 * pr + 4] += use ? bflo(q0) : 0.f; o[8 * pr + 5] += use ? bfhi(q0) : 0.f; o[8 * pr + 6] += use ? bflo(q1) : 0.f; o[8 * pr + 7] += use ? bfhi(q1) : 0.f;
}
__device__ __forceinline__ void attn_fill_tab(Frame& F, LAS float* TAB) {
    const float* rb = F.in[16];
    for (int idx = F.tid; idx < 8 * 132; idx += NTHR) { const int h = idx / 132, d = idx % 132; float v = 0.f;
        if (d < 128) v = rb[h * 32 + t5_bucket(d)] * LOG2E; else if (d == 129) v = rb[h * 32 + 31] * LOG2E;
        TAB[idx] = v; }
}
constexpr int BGPRE_OFF = ROWTAB_OFF, BGCL_OFF = ROWTAB_OFF + 8448, BTAB_OFF = ROWTAB_OFF + 16640, BIT_OFF = ROWTAB_OFF + 20992, BIT_MAX = 512, OTAB_OFF = ROWTAB_OFF + 20480  ;
static_assert(BTAB_OFF + 8 * 132 * 4 <= MOE_TST_OFF, "attention LDS tables");
__device__ __forceinline__ size_t part_off(int slot) { return slot == 0 ? WS_PART0 : (slot == 1 ? WS_PART1 : WS_PART2); }

__device__ __forceinline__ void attn_block_phase(Frame& F) {
    LAS unsigned char* L = F.lds; LAS int* GPRE = (LAS int*)(L + BGPRE_OFF); LAS int* GCL = (LAS int*)(L + BGCL_OFF); LAS float* TAB = (LAS float*)(L + BTAB_OFF); LAS int* ITT = (LAS int*)(L + BIT_OFF); LAS int* WSUM = (LAS int*)(L + MOE_TST_OFF);
    const unsigned* GC = (const unsigned*)(F.ctl + CW_GCNT); const unsigned* SEGC = (const unsigned*)(F.ws + WS_SEGC);
    const int tid = F.tid, lane = F.lane, w = F.wave, j = lane & 31, hi = lane >> 5, lane8 = lane * 8;
    { int ng[4], tot = 0;
#pragma unroll
      for (int e = 0; e < 4; ++e) { const int c = (int)GC[4 * tid + e]; GCL[4 * tid + e] = c; ng[e] = (((c + 31) >> 5) + 7) >> 3; tot += ng[e]; }
      int inc = tot;
#pragma unroll
      for (int o = 1; o < 64; o <<= 1) { const int t = __shfl_up(inc, o); if (lane >= o) inc += t; }
      if (lane == 63) WSUM[w] = inc;
      __syncthreads();
      int woff = 0;
      for (int q = 0; q < w; ++q) woff += WSUM[q];
      int ex = woff + inc - tot;
#pragma unroll
      for (int e = 0; e < 4; ++e) { GPRE[4 * tid + e] = ex; ex += ng[e]; }
      if (tid == NTHR - 1) GPRE[2048] = ex; }
    attn_fill_tab(F, TAB);
    __syncthreads();
    const int NIT = GPRE[2048];
    const int nk = (NIT > F.vcu) ? (NIT - F.vcu + F.G - 1) / F.G : 0;
    if (tid < nk && tid < BIT_MAX) { const int it_ = F.vcu + tid * F.G; int lo_ = 0, hi_ = 2048; while (hi_ - lo_ > 1) { const int mid_ = (lo_ + hi_) >> 1; if (GPRE[mid_] <= it_) lo_ = mid_; else hi_ = mid_; } ITT[tid] = lo_ * 64 + (it_ - GPRE[lo_]); }
    __syncthreads();
    if (nk == 0) return;
    const int nkc = nk < BIT_MAX ? nk : BIT_MAX;
    const bf16_t* Qb = (const bf16_t*)(F.ws + WS_Q); const float* MQg = (const float*)(F.ws + WS_MQ); const unsigned short* QL = (const unsigned short*)(F.ws + WS_QLIST);
    const bf16_t* KF = (const bf16_t*)(F.ws + WS_KFRAG); const bf16_t* VF = (const bf16_t*)(F.ws + WS_VFRAG);
    float* PL = (float*)(F.ws + WS_PL);
#define BLK_ITEM(k_, pi_, g_) do { const int kk_ = (k_) < nkc ? (k_) : nkc - 1; const int v_ = __builtin_amdgcn_readfirstlane(ITT[kk_]); pi_ = v_ >> 6; g_ = v_ & 63; } while (0)
#define BLK_DMA(buf_, pi_) do { const char* ks_ = (const char*)KF + ((size_t)(pi_) * 2048 + tid) * 16; const char* vs_ = (const char*)VF + ((size_t)(pi_) * 2048 + tid) * 16; \
        _Pragma("unroll") for (int i_ = 0; i_ < 4; ++i_) { \
            __builtin_amdgcn_global_load_lds((const unsigned*)(ks_ + i_ * 8192), (LAS unsigned*)(L + (buf_) + (i_ * 512 + w * 64) * 16), 16, 0, 0); \
            __builtin_amdgcn_global_load_lds((const unsigned*)(vs_ + i_ * 8192), (LAS unsigned*)(L + (buf_) + 32768 + (i_ * 512 + w * 64) * 16), 16, 0, 0); } } while (0)
#define BLK_SEGC(dst_, pi_) do { dst_ = SEGC[(size_t)(pi_) * 32 + j]; } while (0)
#define BLK_ENTRY(dst_, segc_, pi_, g_) do { const int n_ = (pi_) & 31; int inc_ = (j < 31 - n_) ? (int)(segc_) : 0; \
        _Pragma("unroll") for (int o_ = 1; o_ < 32; o_ <<= 1) { const int t_ = __shfl_up(inc_, o_); if (j >= o_) inc_ += t_; } \
        const int cnt_ = GCL[pi_]; const int idx_ = 32 * (8 * (g_) + w) + j; int seg_ = 0, prev_ = 0; \
        for (int s_ = 0; s_ < 31 - n_; ++s_) { const int p_ = __builtin_amdgcn_readlane(inc_, s_); const bool le_ = p_ <= idx_; seg_ += le_ ? 1 : 0; prev_ = le_ ? p_ : prev_; } \
        const bool ok_ = idx_ < cnt_; const unsigned v_ = QL[(size_t)(pi_) * SEQ + (ok_ ? seg_ * 256 + (idx_ - prev_) : 0)]; dst_ = ok_ ? v_ : 0xFFFFu; } while (0)
#define BLK_QLOAD(qf_, m2_, ent_, pi_) do { const unsigned qq_ = ((ent_) == 0xFFFFu) ? 0u : ((ent_) >> 2); const int bh_ = (pi_) >> 5; \
        const bf16_t* qrow_ = Qb + ((size_t)(bh_ >> 3) * SEQ + qq_) * DA + (bh_ & 7) * HD + 8 * hi; \
        _Pragma("unroll") for (int ds_ = 0; ds_ < 4; ++ds_) qf_[ds_] = *(const bf16x8*)(qrow_ + 16 * ds_); \
        m2_ = MQg[(size_t)bh_ * SEQ + qq_]; } while (0)
    int pi, g, pi1, g1, pi2, g2; unsigned ent, ent1, sc2; bf16x8 qf[4]; float m2r;
    BLK_ITEM(0, pi, g); BLK_ITEM(1, pi1, g1); BLK_ITEM(2, pi2, g2);
    BLK_DMA(0, pi);
    { unsigned sc0, sc1; BLK_SEGC(sc0, pi); BLK_SEGC(sc1, pi1); BLK_SEGC(sc2, pi2); BLK_ENTRY(ent, sc0, pi, g); BLK_ENTRY(ent1, sc1, pi1, g1); }
    BLK_QLOAD(qf, m2r, ent, pi);
    int cur = 0;
    __builtin_amdgcn_s_waitcnt(0x0F70);
    unsigned char* dump = F.ws + WS_E + ((size_t)F.vcu * NTHR + tid) * 128;
    for (int k = 0; k < nkc; ++k) {
        __builtin_amdgcn_s_waitcnt(0x0F75);
        __syncthreads();
        int pi3, g3; unsigned sc3, ent2; bf16x8 qfn[4]; float m2n;
        BLK_ITEM(k + 3, pi3, g3); BLK_SEGC(sc3, pi3);
        BLK_ENTRY(ent2, sc2, pi2, g2);
        BLK_QLOAD(qfn, m2n, ent1, pi1);
        BLK_DMA((cur ^ 1) * 65536, pi1);
        const int bh = pi >> 5, n = pi & 31, h = bh & 7;
        const bool valid = ent != 0xFFFFu; const int q = valid ? (int)(ent >> 2) : 0; const int slot = (int)(ent & 3u);
        const bool active = __builtin_amdgcn_readfirstlane((int)(__ballot(valid) != 0ull)) != 0;
        f32x16 o0 = {}, o1 = {}; float lsum = 0.f;
        if (active) {
            const float m2 = valid ? m2r : INFINITY;
            const LAS bf16_t* KP = (const LAS bf16_t*)(L + cur * 65536); const LAS bf16_t* VP = (const LAS bf16_t*)(L + cur * 65536 + 32768);
            const LAS float* TABh = TAB + h * 132; const LAS float* BTD = nullptr; (void)BTD;
            const int dq = q - 256 * n;
            const bool nearw = __builtin_amdgcn_readfirstlane((int)(__ballot(valid && dq < 383) != 0ull)) != 0;
            const float ci = nearw ? -m2 : TABh[129] - m2;
            f32x16 cinit;
#pragma unroll
            for (int r = 0; r < 16; ++r) cinit[r] = ci;
            if (nearw) { for (int st = 0; st < 8; ++st) ATTN_SUBTILE(KP, VP, st, 1, cinit); }
            else { for (int st = 0; st < 8; ++st) ATTN_SUBTILE(KP, VP, st, 0, cinit); }
        }
        { const float lt = lsum + __shfl_xor(lsum, 32);
          const size_t qi = (size_t)bh * SEQ + q;
          float* pld = valid ? PL + (size_t)slot * (NH * BATCH * SEQ) + qi : (float*)(dump + 120);
          bf16_t* dst = valid ? (bf16_t*)(F.ws + part_off(slot)) + qi * HD + 8 * hi : (bf16_t*)dump;
          *pld = lt;
          *(u32x4*)(dst) = ot_pack16(o0, 0); *(u32x4*)(dst + 16) = ot_pack16(o0, 1); *(u32x4*)(dst + 32) = ot_pack16(o1, 0); *(u32x4*)(dst + 48) = ot_pack16(o1, 1); }
        pi = pi1; g = g1; ent = ent1; m2r = m2n; pi1 = pi2; g1 = g2; ent1 = ent2; pi2 = pi3; g2 = g3; sc2 = sc3; cur ^= 1;
#pragma unroll
        for (int ds = 0; ds < 4; ++ds) qf[ds] = qfn[ds];
    }
    VM_WAIT(); __syncthreads();
#undef BLK_ITEM
#undef BLK_DMA
#undef BLK_SEGC
#undef BLK_ENTRY
#undef BLK_QLOAD
}

__device__ __forceinline__ void attn_own_phase(Frame& F) {
    LAS unsigned char* L = F.lds; LAS float* TAB = (LAS float*)(L + OTAB_OFF); LAS float* BT = (LAS float*)(L + ROWTAB_OFF); int bth = -1;
    attn_fill_tab(F, TAB);
    const int tid = F.tid, lane = F.lane, w = F.wave, j = lane & 31, hi = lane >> 5, lane8 = lane * 8;
    const bf16_t* Qb = (const bf16_t*)(F.ws + WS_Q); const float* MQg = (const float*)(F.ws + WS_MQ);
    const bf16_t* KF = (const bf16_t*)(F.ws + WS_KFRAG); const bf16_t* VF = (const bf16_t*)(F.ws + WS_VFRAG);
    const float* PL = (const float*)(F.ws + WS_PL); bf16_t* YA = (bf16_t*)(F.ws + WS_YATT);
    const int NU = BATCH * NH * NBLK;
#define OWN_DMA(buf_, pi_) do { const char* ks_ = (const char*)KF + ((size_t)(pi_) * 2048 + tid) * 16; const char* vs_ = (const char*)VF + ((size_t)(pi_) * 2048 + tid) * 16; \
        _Pragma("unroll") for (int i_ = 0; i_ < 4; ++i_) { \
            __builtin_amdgcn_global_load_lds((const unsigned*)(ks_ + i_ * 8192), (LAS unsigned*)(L + (buf_) + (i_ * 512 + w * 64) * 16), 16, 0, 0); \
            __builtin_amdgcn_global_load_lds((const unsigned*)(vs_ + i_ * 8192), (LAS unsigned*)(L + (buf_) + 32768 + (i_ * 512 + w * 64) * 16), 16, 0, 0); } } while (0)
#define OWN_QLOAD(qf_, m2_, u_) do { const int bh_ = (u_) >> 5, qb_ = (u_) & 31; const size_t tk_ = (size_t)256 * qb_ + 32 * w + j; \
        const bf16_t* qrow_ = Qb + ((size_t)(bh_ >> 3) * SEQ + tk_) * DA + (bh_ & 7) * HD + 8 * hi; \
        _Pragma("unroll") for (int ds_ = 0; ds_ < 4; ++ds_) qf_[ds_] = *(const bf16x8*)(qrow_ + 16 * ds_); \
        m2_ = MQg[(size_t)bh_ * SEQ + tk_]; } while (0)
    int u = F.vcu; if (u >= NU) return;
    bf16x8 qf[4]; float m2;
    OWN_DMA(0, u); OWN_QLOAD(qf, m2, u);
    int cur = 0;
    __builtin_amdgcn_s_waitcnt(0x0F70);
    for (;;) {
        __builtin_amdgcn_s_waitcnt(0x0F74); __syncthreads();
        const int un = (u + F.G < NU) ? u + F.G : u; const bool last = (un == u);
        const int bh = u >> 5, qb = u & 31, b = bh >> 3, h = bh & 7; const int ql = 32 * w + j; const size_t qi = (size_t)bh * SEQ + 256 * qb + ql;
        u32x4 pa[3][4]; float pl[3];
#pragma unroll
        for (int s = 0; s < 3; ++s) { pl[s] = PL[(size_t)s * (NH * BATCH * SEQ) + qi]; const bf16_t* src = (const bf16_t*)(F.ws + part_off(s)) + qi * HD + 8 * hi;
#pragma unroll
            for (int c = 0; c < 4; ++c) pa[s][c] = *(const u32x4*)(src + 16 * c); }
        bf16x8 qfn[4]; float m2n;
        OWN_QLOAD(qfn, m2n, un);
        OWN_DMA((cur ^ 1) * 65536, un);
        const LAS bf16_t* KP = (const LAS bf16_t*)(L + cur * 65536); const LAS bf16_t* VP = (const LAS bf16_t*)(L + cur * 65536 + 32768); const LAS float* TABh = TAB + h * 132;
        if (h != bth) { __syncthreads();
            for (int e = tid; e < 5 * 1024; e += NTHR) { const int i = e & 3, ln = (e >> 2) & 63, rq = (e >> 8) & 3, dl = e >> 10; const int dist = 32 * dl + (ln & 31) - crow(4 * rq + i, ln >> 5);
                BT[e] = dist < 0 ? -1e30f : TABh[dist > 127 ? 127 : dist]; }
            bth = h; __syncthreads(); }
        const int dq = ql; (void)dq;
        f32x16 cnear, cfar;
#pragma unroll
        for (int r = 0; r < 16; ++r) { cnear[r] = -m2; cfar[r] = TABh[129] - m2; }
        f32x16 o0 = {}, o1 = {}; float lsum = 0.f;
        for (int st = 0; st <= w; ++st) { const int dl = w - st;
            if (dl >= 5) { const LAS float* BTD = nullptr; (void)BTD; ATTN_SUBTILE(KP, VP, st, 0, cfar); }
            else { const LAS float* BTD = BT + dl * 1024; ATTN_SUBTILE(KP, VP, st, 2, cnear); } }
        float lt = lsum + __shfl_xor(lsum, 32);
        const int nsel = qb < 3 ? qb : 3;
#pragma unroll
        for (int s = 0; s < 3; ++s) { const bool use = s < nsel; lt += use ? pl[s] : 0.f;
            ot_add16(o0, 0, pa[s][0], use); ot_add16(o0, 1, pa[s][1], use); ot_add16(o1, 0, pa[s][2], use); ot_add16(o1, 1, pa[s][3], use); }
        const float inv = 1.f / lt;
#pragma unroll
        for (int r = 0; r < 16; ++r) { o0[r] *= inv; o1[r] *= inv; }
        bf16_t* dst = YA + ((size_t)b * SEQ + 256 * qb + ql) * DA + h * HD + 8 * hi;
        *(u32x4*)(dst) = ot_pack16(o0, 0); *(u32x4*)(dst + 16) = ot_pack16(o0, 1); *(u32x4*)(dst + 32) = ot_pack16(o1, 0); *(u32x4*)(dst + 48) = ot_pack16(o1, 1);
        if (last) break;
        u = un; m2 = m2n; cur ^= 1;
#pragma unroll
        for (int ds = 0; ds < 4; ++ds) qf[ds] = qfn[ds];
    }
    VM_WAIT(); __syncthreads();
#undef OWN_DMA
#undef OWN_QLOAD
}
#undef ATTN_SUBTILE

__device__ __forceinline__ void routing_phase(Frame& F) {
    LAS int* lcnt = (LAS int*)(F.lds); LAS int* lbase = lcnt + 32;
    const float* SSQ = (const float*)(F.ws + WS_SSQ); const float* RL = (const float*)(F.ws + WS_RLOG);
    unsigned* rowtok = (unsigned*)(F.ws + WS_ROWTOK); float* rowcoef = (float*)(F.ws + WS_ROWCOEF); float* rowrstd = (float*)(F.ws + WS_ROWRSTD);
    unsigned* ecnt = (unsigned*)(F.ctl + CW_ECNT);
    const float* brg = F.in[20]; const float* bre = F.in[22];
    const int tid = F.tid;
    for (int base = F.vcu * 256; base < T; base += F.G * 256) {
        if (tid < 32) lcnt[tid] = 0;
        __syncthreads();
        int e0 = 0, e1 = 0, lp0 = 0, lp1 = 0; float c0 = 0.f, c1 = 0.f, rstd = 0.f; const int tok = base + tid;
        if (tid < 256) {
            float ss = 0.f;
#pragma unroll
            for (int q = 0; q < 4; ++q) { const f32x4 v = *(const f32x4*)(SSQ + (size_t)tok * 16 + 4 * q); ss += (v.x + v.y) + (v.z + v.w); }
            rstd = 1.f / sqrtf(ss * (1.f / D) + RMS_EPS);
            float r[72];
#pragma unroll
            for (int q = 0; q < 18; ++q) { const f32x4 v = *(const f32x4*)(RL + (size_t)tok * 72 + 4 * q); r[4 * q] = v.x; r[4 * q + 1] = v.y; r[4 * q + 2] = v.z; r[4 * q + 3] = v.w; }
            float gl[4], el[32];
#pragma unroll
            for (int c = 0; c < 4; ++c) gl[c] = rstd * (r[c] + r[36 + c]) + brg[c];
#pragma unroll
            for (int c = 0; c < 32; ++c) el[c] = rstd * (r[4 + c] + r[40 + c]) + bre[c];
            int gi = 0; float gm = gl[0];
#pragma unroll
            for (int c = 1; c < 4; ++c) if (gl[c] > gm) { gm = gl[c]; gi = c; }
            float Z = 0.f;
#pragma unroll
            for (int c = 0; c < 4; ++c) Z += __expf(gl[c] - gm);
            const float gval = 1.f / Z;
            float es[8];
#pragma unroll
            for (int q = 0; q < 8; ++q) es[q] = gi == 0 ? el[q] : (gi == 1 ? el[8 + q] : (gi == 2 ? el[16 + q] : el[24 + q]));
            int a0 = 0; float m0 = es[0];
#pragma unroll
            for (int q = 1; q < 8; ++q) if (es[q] > m0) { m0 = es[q]; a0 = q; }
            int a1 = -1; float m1 = -INFINITY;
#pragma unroll
            for (int q = 0; q < 8; ++q) if (q != a0 && es[q] > m1) { m1 = es[q]; a1 = q; }
            const float w0 = 1.f / (1.f + __expf(m1 - m0)), w1 = 1.f - w0;
            e0 = gi * 8 + a0; e1 = gi * 8 + a1; c0 = gval * w0; c1 = gval * w1;
            lp0 = __hip_atomic_fetch_add(lcnt + e0, 1, __ATOMIC_RELAXED, __HIP_MEMORY_SCOPE_WORKGROUP);
            lp1 = __hip_atomic_fetch_add(lcnt + e1, 1, __ATOMIC_RELAXED, __HIP_MEMORY_SCOPE_WORKGROUP);
        }
        __syncthreads();
        if (tid < 32) lbase[tid] = (int)__hip_atomic_fetch_add(ecnt + tid, (unsigned)lcnt[tid], __ATOMIC_RELAXED, __HIP_MEMORY_SCOPE_AGENT);
        __syncthreads();
        if (tid < 256) {
            const size_t i0 = (size_t)e0 * ROWCAP + lbase[e0] + lp0, i1 = (size_t)e1 * ROWCAP + lbase[e1] + lp1;
            rowtok[i0] = (unsigned)tok * 2u; rowcoef[i0] = c0; rowrstd[i0] = rstd;
            rowtok[i1] = (unsigned)tok * 2u + 1u; rowcoef[i1] = c1; rowrstd[i1] = rstd;
        }
        __syncthreads();
    }
}
struct MoeOrder {
    const LAS int* tst; int total, G, v;
    __device__ bool next(int i, pg8::Unit& u) const {
        const int L = i * G + v; if (L >= total) return false;
        const int rt = L >> 2; int e = 0;
#pragma unroll 8
        for (int q = 1; q <= 32; ++q) e += (tst[q] <= rt) ? 1 : 0;
        u.pm = rt; u.pn = L & 3; u.pb = e * 4 + u.pn; u.aux = e; u.aux2 = (rt - tst[e]) * 256; return true;
    }
};
__device__ __forceinline__ void moe_tables(Frame& F) {
    LAS int* tst = (LAS int*)(F.lds + MOE_TST_OFF); const unsigned* ecnt = (const unsigned*)(F.ctl + CW_ECNT);
    if (F.wave == 0) { const int lane = F.lane; int nt = lane < 32 ? (int)((ecnt[lane & 31] + 255u) >> 8) : 0; int inc = nt;
#pragma unroll
        for (int o = 1; o < 32; o <<= 1) { const int t = __shfl_up(inc, o); if (lane >= o) inc += t; }
        if (lane < 32) tst[lane + 1] = inc; if (lane == 0) tst[0] = 0; }
    __syncthreads();
}
__device__ __forceinline__ void final_phase(Frame& F) {
    const float* X1 = (const float*)(F.ws + WS_X1); const bf16_t* Y0 = (const bf16_t*)(F.ws + WS_Y0); const bf16_t* Y1 = (const bf16_t*)(F.ws + WS_Y1); const float* gf = F.in[26];
    const int gw = F.vcu * NWAVES + F.wave, NGW = F.G * NWAVES, lane = F.lane;
    for (int m = gw; m < T; m += NGW) {
        const f32x4* xr = (const f32x4*)(X1 + (size_t)m * D) + lane; const u32x2* y0 = (const u32x2*)(Y0 + (size_t)m * D) + lane; const u32x2* y1 = (const u32x2*)(Y1 + (size_t)m * D) + lane;
        f32x4 v[4]; float s = 0.f;
#pragma unroll
        for (int j = 0; j < 4; ++j) { v[j] = xr[64 * j]; const u32x2 a = y0[64 * j], c = y1[64 * j];
            v[j].x += bflo(a.x) + bflo(c.x); v[j].y += bfhi(a.x) + bfhi(c.x); v[j].z += bflo(a.y) + bflo(c.y); v[j].w += bfhi(a.y) + bfhi(c.y);
            s += (v[j].x * v[j].x + v[j].y * v[j].y) + (v[j].z * v[j].z + v[j].w * v[j].w); }
        const float rstd = 1.f / sqrtf(wave_sum(s) * (1.f / D) + RMS_EPS);
        f32x4* o = (f32x4*)(F.out + (size_t)m * D) + lane; const f32x4* gr = (const f32x4*)gf + lane;
#pragma unroll
        for (int j = 0; j < 4; ++j) o[64 * j] = v[j] * rstd * gr[64 * j];
    }
}
#ifndef MK_N_LAUNCHES
#define MK_N_LAUNCHES 1
#endif
constexpr int NPHASE = 14;
struct Args { const float* in[27]; float* out; unsigned char* ws; int ph_lo, ph_hi; };
static_assert(sizeof(Args) == 27 * 8 + 8 + 8 + 8, "Args has no padding");

#ifndef STAG1
#define STAG1 0
#endif
#ifndef DUP_MASK
#define DUP_MASK 0
#endif
#define PH_ARGS Frame& F, unsigned char* ws, LAS unsigned char* ring
__device__ __forceinline__ void ph1(PH_ARGS) {
    { pg8::Gemm g{(const bf16_t*)(ws + WS_H1), (const bf16_t*)(ws + WS_WIN), D, D, D}; pg8::StaticOrder S; S.init(T, DS, F.G, (int)blockIdx.x);
      EpiProj<0> E{ws, F.in[3], 0, 1.f};
      pg8::gemm_phase<EpiProj<0>, pg8::StaticOrder, true, false>(ring, g, S, E, nullptr, F.wave); }
    { pg8::Gemm g{(const bf16_t*)(ws + WS_H1F8), (const bf16_t*)(ws + WS_WINF8), D / 2, D / 2, D / 2}; pg8::StaticOrder S; S.init(T, DIN - DS, F.G, (int)blockIdx.x);
      EpiProj<1> E{ws, F.in[3], 2, 1.f / WF8_SCALE};
      pg8::gemm_phase<EpiProj<1>, pg8::StaticOrder, true, false, true>(ring, g, S, E, nullptr, F.wave); }
}
__device__ __forceinline__ void ph2(PH_ARGS) {
    { pg8::Gemm g{(const bf16_t*)(ws + WS_UP), (const bf16_t*)(ws + WS_SSMW), SKY, SKU, SKU}; pg8::GroupedOrder S; S.init(SG * 8, 1, 8, F.G, F.vcu);
      EpiSsmE E{(float*)(ws + WS_E)};
      pg8::gemm_phase<EpiSsmE, pg8::GroupedOrder, false, false>(ring, g, S, E, nullptr, F.wave); }
    VM_WAIT(); __syncthreads();
    ssm_scan_phase(F);
    kv_prep_phase(F);
}
__device__ __forceinline__ void ph4(PH_ARGS) {
    pg8::Gemm g{(const bf16_t*)(ws + WS_UP), (const bf16_t*)(ws + WS_SSMT), SKY, SKY, SKY}; pg8::GroupedOrder S; S.init(SG * 8, 2, 8, F.G, F.vcu);
    EpiSsmY E{(bf16_t*)(ws + WS_GACT)};
    pg8::gemm_phase<EpiSsmY, pg8::GroupedOrder, true, false>(ring, g, S, E, nullptr, F.wave);
}
__device__ __forceinline__ void ph5(PH_ARGS) {
    pg8::Gemm g{(const bf16_t*)(ws + WS_GACT), (const bf16_t*)(ws + WS_WGLU), DS, DS, DS}; pg8::StaticOrder S; S.init(T, DS, F.G, (int)blockIdx.x);
    EpiGlu E{(const bf16_t*)(ws + WS_GACT), (bf16_t*)(ws + WS_YSSM), F.in[13]};
    pg8::gemm_phase<EpiGlu, pg8::StaticOrder, true, false>(ring, g, S, E, nullptr, F.wave);
}
__device__ __forceinline__ void ph6(PH_ARGS) {
    { pg8::Gemm g{(const bf16_t*)(ws + WS_YSSM), (const bf16_t*)(ws + WS_WUS), DS, DS, DS}; pg8::StaticOrder S; S.init(T, D, F.G, (int)blockIdx.x);
      EpiUp<false> E{(const bf16_t*)(ws + WS_SGS), (bf16_t*)(ws + WS_MRG)};
      pg8::gemm_phase<EpiUp<false>, pg8::StaticOrder, true, false>(ring, g, S, E, nullptr, F.wave); }
    VM_WAIT(); __syncthreads();
    { pg8::Gemm g{(const bf16_t*)(ws + WS_YATT), (const bf16_t*)(ws + WS_WUA), DA, DA, DA}; pg8::StaticOrder S; S.init(T, D, F.G, (int)blockIdx.x);
      EpiUp<true> E{(const bf16_t*)(ws + WS_SGA), (bf16_t*)(ws + WS_MRG)};
      pg8::gemm_phase<EpiUp<true>, pg8::StaticOrder, true, false>(ring, g, S, E, nullptr, F.wave); }
}
__device__ __forceinline__ void ph7(PH_ARGS) {
    pg8::Gemm g{(const bf16_t*)(ws + WS_MRG), (const bf16_t*)(ws + WS_WOUT), D, D, D}; pg8::StaticOrder S; S.init(T, D, F.G, (int)blockIdx.x);
    EpiOut E{F.in[0], (float*)(ws + WS_X1), (bf16_t*)(ws + WS_XG), ws + WS_XGF8, F.in[18], (float*)(ws + WS_SSQ)};
    pg8::gemm_phase<EpiOut, pg8::StaticOrder, true, false>(ring, g, S, E, nullptr, F.wave);
}
__device__ __forceinline__ void ph8(PH_ARGS) {
    pg8::Gemm g{(const bf16_t*)(ws + WS_XG), (const bf16_t*)(ws + WS_WR), D, D, D}; pg8::GroupedOrder S; S.init(T / 256, 1, T / 256, F.G, F.vcu);
    EpiRouter E{(float*)(ws + WS_RLOG)};
    pg8::gemm_phase<EpiRouter, pg8::GroupedOrder, false, false>(ring, g, S, E, nullptr, F.wave);
}
__device__ __forceinline__ void ph10(PH_ARGS) {
    moe_tables(F);
    const LAS int* tst = (const LAS int*)(F.lds + MOE_TST_OFF);
    MoeOrder S{tst, tst[32] * 4, F.G, F.vcu};
    LAS unsigned* rowtab = (LAS unsigned*)(F.lds + ROWTAB_OFF);
    { const unsigned* rowtok = (const unsigned*)(ws + WS_ROWTOK); const unsigned* ecnt = (const unsigned*)(F.ctl + CW_ECNT); pg8::Unit u;
      for (int i = 0; i < ROWTAB_UNITS && S.next(i, u); ++i) { if (F.tid < 256) { const int pos = u.aux2 + F.tid; const unsigned tk = pos < (int)ecnt[u.aux] ? (rowtok[(size_t)u.aux * ROWCAP + pos] >> 1) : 0u; rowtab[i * 256 + F.tid] = tk * (unsigned)D; } } }
    __syncthreads();
    pg8::Gemm g{(const bf16_t*)(ws + WS_XGF8), (const bf16_t*)(ws + WS_W13), D / 2, D / 2, D / 2};
    EpiMoe1 E{(bf16_t*)(ws + WS_HID), (const float*)(ws + WS_ROWRSTD), (const unsigned*)(F.ctl + CW_ECNT), 1.f / WF8_SCALE};
    pg8::gemm_phase<EpiMoe1, MoeOrder, true, true, true>(ring, g, S, E, rowtab, F.wave);
}
__device__ __forceinline__ void ph11(PH_ARGS) {
    moe_tables(F);
    const LAS int* tst = (const LAS int*)(F.lds + MOE_TST_OFF);
    MoeOrder S{tst, tst[32] * 4, F.G, F.vcu};
    pg8::Gemm g{(const bf16_t*)(ws + WS_HID), (const bf16_t*)(ws + WS_W2), DE, DE, DE};
    EpiMoe2 E{(bf16_t*)(ws + WS_Y0), (size_t)(WS_Y1 - WS_Y0), (const unsigned*)(ws + WS_ROWTOK), (const float*)(ws + WS_ROWCOEF), (const unsigned*)(F.ctl + CW_ECNT)};
    pg8::gemm_phase<EpiMoe2, MoeOrder, true, false>(ring, g, S, E, nullptr, F.wave);
}

__global__ void __launch_bounds__(NTHR, 2) fwd_kernel(Args args) {
    extern __shared__ __attribute__((aligned(16))) unsigned char lds_raw[];
    Frame F;
    F.lds = (LAS unsigned char*)lds_raw;
    F.MISC = (volatile LAS unsigned*)(F.lds + MISC_OFF);
    F.wave = __builtin_amdgcn_readfirstlane((int)(threadIdx.x >> 6)); F.lane = lane_id(); F.tid = F.wave * 64 + F.lane;
    F.G = gridDim.x; { const int bx = blockIdx.x; F.vcu = (F.G % 8 == 0) ? (bx % 8) * (F.G / 8) + bx / 8 : bx; }
    F.ws = args.ws; F.ctl = (gu32*)(args.ws + WS_CTL); F.out = args.out;
#pragma unroll
    for (int i = 0; i < 27; ++i) F.in[i] = args.in[i];
    for (int u = F.tid; u < (LDS_BYTES - MOE_TST_OFF) / 4; u += NTHR) ((LAS unsigned*)(F.lds + MOE_TST_OFF))[u] = 0u;
    __syncthreads();
    XcdBarrier bar; bar.bar = (unsigned*)(F.ctl + CW_BAR); bar.x = 0; bar.st = nullptr;
    const int lo = args.ph_lo, hi = args.ph_hi;
    if (hi - lo > 1) bar = xcd_barrier_post((unsigned*)(F.ctl + CW_BAR), F.MISC + 8, F.tid == 0);
#define IN(k) (lo <= (k) && (k) < hi)
#define DUP(k) ((DUP_MASK >> (k)) & 1)
#define SEAM(k) do { if (IN(k) && IN((k) + 1)) xcd_barrier(bar, F.wave == 0 && lane_id() == 0); REFRESH(); } while (0)
#define REFRESH() do { int l_ = lane_id(); asm volatile("" : "+v"(l_)); F.lane = l_; F.tid = F.wave * 64 + l_; } while (0)
    unsigned char* ws = args.ws;
    LAS unsigned char* ring = F.lds;
    if (IN(0)) { p0_prologue(F); if (DUP(0)) p0_prologue(F); }
    SEAM(0);
    if (IN(1)) { ph1(F, ws, ring); if (DUP(1)) ph1(F, ws, ring); }
    SEAM(1);
    if (IN(2)) { ph2(F, ws, ring); if (DUP(2)) ph2(F, ws, ring); }
    SEAM(2);
    if (IN(3)) { attn_gate_phase<true>(F); }
    SEAM(3);
    if (IN(4)) { attn_block_phase(F); if (DUP(4)) { __syncthreads(); attn_block_phase(F); } }
    SEAM(4);
    if (IN(5)) { attn_own_phase(F); if (DUP(5)) attn_own_phase(F); }
    SEAM(5);
    if (IN(6)) { ph4(F, ws, ring); if (DUP(6)) ph4(F, ws, ring); }
    SEAM(6);
    if (IN(7)) { ph5(F, ws, ring); if (DUP(7)) ph5(F, ws, ring); }
    SEAM(7);
    if (IN(8)) { ph6(F, ws, ring); if (DUP(8)) ph6(F, ws, ring); }
    SEAM(8);
    if (IN(9)) { ph7(F, ws, ring); if (DUP(9)) ph7(F, ws, ring); }
    SEAM(9);
    if (IN(10)) { ph8(F, ws, ring); VM_WAIT(); __syncthreads(); routing_phase(F); }
    SEAM(10);
    if (IN(11)) { ph10(F, ws, ring); if (DUP(11)) ph10(F, ws, ring); }
    SEAM(11);
    if (IN(12)) { ph11(F, ws, ring); if (DUP(12)) ph11(F, ws, ring); }
    SEAM(12);
    if (IN(13)) { final_phase(F); if (DUP(13)) final_phase(F); }
#undef IN
#undef DUP
#undef SEAM
#undef REFRESH
}

extern "C" void kernel_launch(void* const* d_in, const int* in_sizes, int n_in, void* d_out, int out_size, void* d_ws, size_t ws_size, hipStream_t stream) {
    static int grid = 0;
    if (grid == 0) {
        if (n_in != 27 || in_sizes[0] != T * D || out_size != T * D || ws_size < WS_END) { fprintf(stderr, "kernel_launch: unexpected shapes (n_in %d, in0 %d, out %d, ws %zu)\n", n_in, n_in > 0 ? in_sizes[0] : -1, out_size, ws_size); grid = -1; return; }
        int dev = 0, cus = 0;
        if (hipGetDevice(&dev) != hipSuccess || hipDeviceGetAttribute(&cus, hipDeviceAttributeMultiprocessorCount, dev) != hipSuccess) { grid = -1; return; }
        if (hipFuncSetAttribute((const void*)fwd_kernel, hipFuncAttributeMaxDynamicSharedMemorySize, LDS_BYTES) != hipSuccess) { fprintf(stderr, "kernel_launch: hipFuncSetAttribute failed\n"); grid = -1; return; }
        (void)hipGetLastError();
        grid = cus;
    }
    if (grid < 0) return;
    (void)hipMemsetAsync((char*)d_ws + WS_CTL, 0, CTL_ZERO_BYTES, stream);
    Args a{};
    for (int i = 0; i < 27; ++i) a.in[i] = (const float*)d_in[i];
    a.out = (float*)d_out; a.ws = (unsigned char*)d_ws;
    if (MK_N_LAUNCHES == 1) { a.ph_lo = 0; a.ph_hi = NPHASE; hipLaunchKernelGGL(fwd_kernel, dim3(grid), dim3(NTHR), LDS_BYTES, stream, a); }
    else { for (int p = 0; p < NPHASE; ++p) { a.ph_lo = p; a.ph_hi = p + 1; hipLaunchKernelGGL(fwd_kernel, dim3(grid), dim3(NTHR), LDS_BYTES, stream, a); } }
}
```

```cpp
#include <hip/hip_runtime.h>
#include <cstdio>
#include <cstdint>

#define LAS __attribute__((address_space(3)))
#define GAS __attribute__((address_space(1)))
typedef unsigned short bf16_t;
typedef short bf16x8 __attribute__((ext_vector_type(8)));
typedef float f32x2 __attribute__((ext_vector_type(2)));
typedef float f32x4 __attribute__((ext_vector_type(4)));
typedef float f32x16 __attribute__((ext_vector_type(16)));
typedef unsigned u32x2 __attribute__((ext_vector_type(2)));
typedef unsigned u32x4 __attribute__((ext_vector_type(4)));
typedef GAS unsigned gu32;
typedef int v4i32 __attribute__((ext_vector_type(4)));
typedef int v8i32 __attribute__((ext_vector_type(8)));
#define RLX_AGENT __ATOMIC_RELAXED, __HIP_MEMORY_SCOPE_AGENT
#define LDS_WAIT() asm volatile("s_waitcnt lgkmcnt(0)" ::: "memory")
#define VM_WAIT() asm volatile("s_waitcnt vmcnt(0)" ::: "memory")

__device__ __forceinline__ unsigned f2bf(float f) { unsigned u = __builtin_bit_cast(unsigned, f); return (u + 0x7fffu + ((u >> 16) & 1u)) >> 16; }
__device__ __forceinline__ unsigned pk2(float lo, float hi) { return f2bf(lo) | (f2bf(hi) << 16); }
__device__ __forceinline__ float bf2f(unsigned short b) { return __builtin_bit_cast(float, (unsigned)b << 16); }
__device__ __forceinline__ float bflo(unsigned w) { return __builtin_bit_cast(float, w << 16); }
__device__ __forceinline__ float bfhi(unsigned w) { return __builtin_bit_cast(float, w & 0xffff0000u); }
__device__ __forceinline__ unsigned cvt_pk_bf16(float lo, float hi) { unsigned r; asm volatile("v_cvt_pk_bf16_f32 %0, %1, %2" : "=v"(r) : "v"(lo), "v"(hi)); return r; }
__device__ __forceinline__ float fast_sigmoid(float x) { return __builtin_amdgcn_rcpf(1.f + __builtin_amdgcn_exp2f(-1.4426950408889634f * x)); }
__device__ __forceinline__ int lane_id() { int l; asm volatile("v_mbcnt_lo_u32_b32 %0, -1, 0\n\tv_mbcnt_hi_u32_b32 %0, -1, %0" : "=v"(l)); return l; }
__device__ __forceinline__ float wave_sum(float v) {
#pragma unroll
    for (int o = 1; o < 64; o <<= 1) v += __shfl_xor(v, o);
    return v;
}
__device__ __forceinline__ float wave_max(float v) {
#pragma unroll
    for (int o = 1; o < 64; o <<= 1) v = fmaxf(v, __shfl_xor(v, o));
    return v;
}

#define XB_TMO      128
#define XB_XCNT(j)  (256  + 64 * (j))
#define XB_XSUB(j)  (1280 + 64 * (j))
#define XB_XGEN(j)  (2304 + 64 * (j))
#define XB_TOP      3328
#define XB_TOPGEN   3392
#define XCD_BAR_WORDS 3456
#define XB_SPIN_CAP (1u << 20)

__device__ __forceinline__ unsigned xb_ld(unsigned* p)              { return __hip_atomic_load(p, __ATOMIC_RELAXED, __HIP_MEMORY_SCOPE_AGENT); }
__device__ __forceinline__ unsigned xb_add(unsigned* p, unsigned v) { return __hip_atomic_fetch_add(p, v, __ATOMIC_RELAXED, __HIP_MEMORY_SCOPE_AGENT); }
__device__ __forceinline__ unsigned xb_xcc_id() { return (unsigned)__builtin_amdgcn_s_getreg((3 << 11) | 20) & 0xFu; }
#define XB_SPIN(cond, bar) do { unsigned _sp = 0; while (cond) { __builtin_amdgcn_s_sleep(1); \
    if ((++_sp & 255u) == 0u) { if (xb_ld(&(bar)[XB_TMO])) break; if (_sp > XB_SPIN_CAP) { atomicAdd(&(bar)[XB_TMO], 1u); break; } } } } while (0)

struct XcdBarrier { unsigned* bar; unsigned x; volatile LAS unsigned* st; };

__device__ __forceinline__ XcdBarrier xcd_barrier_post(unsigned* bar, volatile LAS unsigned* st, bool leader  ) {
    XcdBarrier b; b.bar = bar; b.x = xb_xcc_id(); b.st = st;
    if (leader) (void)xb_add(&bar[XB_XCNT(b.x)], 1u);
    return b;
}
__device__ __forceinline__ void xcd_barrier_complete(unsigned* bar, unsigned x, unsigned& nloc, unsigned& nx) {
    const unsigned G = gridDim.x * gridDim.y * gridDim.z;
    unsigned sum, cnt, mine, sp = 0u;
    for (;;) {
        sum = 0u; cnt = 0u; mine = 0u;
#pragma unroll
        for (unsigned j = 0; j < 16; ++j) { const unsigned c = xb_ld(&bar[XB_XCNT(j)]); sum += c; cnt += (c > 0u) ? 1u : 0u; mine = (j == x) ? c : mine; }
        if (sum == G) break;
        __builtin_amdgcn_s_sleep(1);
        if ((++sp & 255u) == 0u) { if (xb_ld(&bar[XB_TMO])) break; if (sp > XB_SPIN_CAP) { atomicAdd(&bar[XB_TMO], 1u); break; } }
    }
    nloc = mine > 0u ? mine : 1u; nx = cnt > 0u ? cnt : 1u;
}
__device__ __forceinline__ void xcd_barrier(const XcdBarrier& b, bool leader  ) {
    asm volatile("s_waitcnt vmcnt(0)" ::: "memory");
    __syncthreads();
    if (leader) {
        unsigned* bar = b.bar;
        __builtin_amdgcn_s_waitcnt(0);
        unsigned nloc = b.st[0], nx = b.st[1];
        if (nloc == 0u) { xcd_barrier_complete(bar, b.x, nloc, nx); b.st[0] = nloc; b.st[1] = nx; }
        const unsigned old = xb_add(&bar[XB_XSUB(b.x)], 1u);
        const unsigned gen = old / nloc;
        if (old + 1u == (gen + 1u) * nloc) {
            __builtin_amdgcn_fence(__ATOMIC_RELEASE, "agent");
            asm volatile("s_waitcnt vmcnt(0)" ::: "memory");
            const unsigned og = xb_add(&bar[XB_TOP], 1u);
            const unsigned tg = og / nx;
            if (og + 1u == (tg + 1u) * nx) xb_add(&bar[XB_TOPGEN], 1u);
            else XB_SPIN(xb_ld(&bar[XB_TOPGEN]) == tg, bar);
            __builtin_amdgcn_fence(__ATOMIC_ACQUIRE, "agent");
            xb_add(&bar[XB_XGEN(b.x)], 1u);
            asm volatile("s_waitcnt vmcnt(0)" ::: "memory");
        } else {
            XB_SPIN(xb_ld(&bar[XB_XGEN(b.x)]) == gen, bar);
            __builtin_amdgcn_fence(__ATOMIC_ACQUIRE, "agent");
            asm volatile("s_waitcnt vmcnt(0)" ::: "memory");
        }
    }
    __syncthreads();
}

namespace pg8 {
constexpr int BM = 256, BK = 64, HALF = 128, HTB = HALF * BK * 2, STAGE_BYTES = 8 * HTB, NXCD = 8, WGM = 8;
__host__ __device__ __forceinline__ int lds_byte(int r, int c) { const int st = (r >> 4) * 2 + (c >> 5), rr = r & 15, cc = c & 31, ob = rr * 64 + cc * 2; return st * 1024 + (ob ^ (((ob >> 9) & 1) << 5)); }
__host__ __device__ __forceinline__ void stage_rc(int b, int& R, int& C) { const int st = b / 1024, sb = b % 1024, swz = sb ^ (((sb >> 9) & 1) << 5); R = (st >> 1) * 16 + swz / 64; C = (st & 1) * 32 + (swz % 64) / 2; }
__host__ __device__ __forceinline__ int perm32(int rho) { const int n = rho >> 4, i = rho & 15; return 8 * (i >> 2) + 4 * n + (i & 3); }

struct Unit { int pm, pn, pb, aux, aux2; };
struct Gemm { const bf16_t* A; const bf16_t* Bt; int lda, ldb, K; };

struct StaticOrder {
    int nM, nN, nwg, G, c;
    __device__ void init(int M, int N, int G_, int c_) { nM = M / BM; nN = N / BM; nwg = nM * nN; G = G_; c = c_; }
    __device__ bool next(int i, Unit& u) const {
        const long L = (long)i * G + c; if (L >= nwg) return false;
        int wgid = (int)L; { const int q = nwg / NXCD, r = nwg % NXCD, xcd = wgid % NXCD, off = wgid / NXCD; wgid = (xcd < r ? xcd * (q + 1) : r * (q + 1) + (xcd - r) * q) + off; }
        const int nig = WGM * nN, gid = wgid / nig, fm = gid * WGM, gsz = (nM - fm) < WGM ? (nM - fm) : WGM;
        u.pm = fm + ((wgid % nig) % gsz); u.pn = (wgid % nig) / gsz; u.pb = u.pn; u.aux = 0; u.aux2 = 0; return true;
    }
};
struct GroupedOrder {
    int nM, nN, rtpg, G, v;
    __device__ void init(int nM_, int nN_, int rtpg_, int G_, int v_) { nM = nM_; nN = nN_; rtpg = rtpg_; G = G_; v = v_; }
    __device__ bool next(int i, Unit& u) const {
        const int L = i * G + v; if (L >= nM * nN) return false;
        u.pm = L / nN; u.pn = L % nN; u.aux = u.pm / rtpg; u.pb = u.aux * nN + u.pn; u.aux2 = 0; return true;
    }
};

template <class Epi, class Sched, bool ALIGN_EPI, bool GATHER, bool FP8 = false>
__device__ __forceinline__ void gemm_phase(LAS unsigned char* lds, const Gemm g, const Sched& S, const Epi& E, const LAS unsigned* rowtab  , int wid  ) {
    const int lane = lane_id(), tid = wid * 64 + lane, wr = wid >> 2, wc = wid & 3;
    const int K = g.K, nt = K / BK;
    unsigned voffB[2];
#pragma unroll
    for (int i = 0; i < 2; ++i) { int R, C; stage_rc(tid * 16 + i * 8192, R, C); const int Rb = (R & ~31) + perm32(R & 31);
        voffB[i] = (unsigned)(Rb * g.ldb + C) * 2u; }
    const size_t kstep = (size_t)(BK * 2);
    const size_t hstepB = (size_t)HALF * g.ldb * 2, tstepB = 2 * hstepB;
    const size_t tstepA = (size_t)BM * g.lda * 2;
    const unsigned ldsw = (unsigned)wid * 1024u;
    const int aoff = lds_byte(wr * 64 + (lane & 15), (lane >> 4) * 8), boff = lds_byte(wc * 32 + (lane & 15), (lane >> 4) * 8);
    unsigned vAc[2][2];
#define PG8_SETVA(dst, ui_) do { const int t_ = wid * 64 + lane_id(); _Pragma("unroll") for (int i_ = 0; i_ < 2; ++i_) { int R_, C_; stage_rc(t_ * 16 + i_ * 8192, R_, C_); \
        _Pragma("unroll") for (int h_ = 0; h_ < 2; ++h_) dst[h_][i_] = (GATHER ? rowtab[(ui_) * 256 + h_ * 128 + R_] : (unsigned)((h_ * 128 + R_) * g.lda) * 2u) + (unsigned)C_ * 2u; } } while (0)
#define PG8_SA(b, h) (((b) * 2 + (h)) * HTB)
#define PG8_SB(b, h) ((4 + (b) * 2 + (h)) * HTB)
#define PG8_GLDS_S(gbase_, voff_, ldsaddr_) do { unsigned keep_; asm volatile("s_mov_b32 %0, m0\n\ts_mov_b32 m0, %3\n\ts_nop 0\n\tglobal_load_lds_dwordx4 %1, %2\n\ts_mov_b32 m0, %0" \
        : "=&s"(keep_) : "v"(voff_), "s"(gbase_), "s"(ldsaddr_) : "memory"); } while (0)
#define PG8_STAGE(bufoff, gbase, v0, v1) do { \
        if constexpr (FP8) { const unsigned la_ = (unsigned)(uintptr_t)(lds + (bufoff) + ldsw); PG8_GLDS_S((const char*)(gbase), (v0), la_); PG8_GLDS_S((const char*)(gbase), (v1), la_ + 8192u); } else { \
        __builtin_amdgcn_global_load_lds((const unsigned*)((const char*)(gbase) + (v0)), (LAS unsigned*)(lds + (bufoff) + ldsw), 16, 0, 0); \
        __builtin_amdgcn_global_load_lds((const unsigned*)((const char*)(gbase) + (v1)), (LAS unsigned*)(lds + (bufoff) + ldsw + 8192), 16, 0, 0); } } while (0)
#define PG8_STB(bufoff, gbase) PG8_STAGE(bufoff, gbase, voffB[0], voffB[1])
#define PG8_LDA(dst, b, h) do { _Pragma("unroll") for (int m = 0; m < 4; ++m) _Pragma("unroll") for (int k = 0; k < 2; ++k) dst[m][k] = *(const LAS bf16x8*)(lds + PG8_SA(b, h) + aoff + m * 2048 + k * 1024); } while (0)
#define PG8_LDB(dst, b, h) do { _Pragma("unroll") for (int n = 0; n < 2; ++n) _Pragma("unroll") for (int k = 0; k < 2; ++k) dst[n][k] = *(const LAS bf16x8*)(lds + PG8_SB(b, h) + boff + n * 2048 + k * 1024); } while (0)
#define PG8_MMA(ai, bj, At, Bt) do { __builtin_amdgcn_s_setprio(1); \
        if constexpr (FP8) { _Pragma("unroll") for (int m = 0; m < 4; ++m) _Pragma("unroll") for (int n = 0; n < 2; ++n) { \
            const v8i32 a8_ = __builtin_shufflevector(__builtin_bit_cast(v4i32, At[m][0]), __builtin_bit_cast(v4i32, At[m][1]), 0, 1, 2, 3, 4, 5, 6, 7); \
            const v8i32 b8_ = __builtin_shufflevector(__builtin_bit_cast(v4i32, Bt[n][0]), __builtin_bit_cast(v4i32, Bt[n][1]), 0, 1, 2, 3, 4, 5, 6, 7); \
            acc[ai][bj][m][n] = __builtin_amdgcn_mfma_scale_f32_16x16x128_f8f6f4(b8_, a8_, acc[ai][bj][m][n], 0, 0, 0, 0, 0, 0); } } \
        else { _Pragma("unroll") for (int m = 0; m < 4; ++m) _Pragma("unroll") for (int n = 0; n < 2; ++n) _Pragma("unroll") for (int k = 0; k < 2; ++k) \
            acc[ai][bj][m][n] = __builtin_amdgcn_mfma_f32_16x16x32_bf16(Bt[n][k], At[m][k], acc[ai][bj][m][n], 0, 0, 0); } \
        __builtin_amdgcn_s_setprio(0); } while (0)
#define PG8_WAIT_V(n) asm volatile("s_waitcnt vmcnt(" #n ")" ::: "memory")
#define PG8_WAIT_L(n) asm volatile("s_waitcnt lgkmcnt(" #n ")" ::: "memory")
#define PG8_BAR __builtin_amdgcn_s_barrier()
#define PG8_SCHED __builtin_amdgcn_sched_barrier(0)
#define PG8_SCHED8 do { if constexpr (FP8) __builtin_amdgcn_sched_barrier(0); } while (0)
    Unit cur, nxt; int ui = 0;
#define PG8_UNI(u_) do { u_.pm = __builtin_amdgcn_readfirstlane(u_.pm); u_.pn = __builtin_amdgcn_readfirstlane(u_.pn); u_.pb = __builtin_amdgcn_readfirstlane(u_.pb); u_.aux = __builtin_amdgcn_readfirstlane(u_.aux); u_.aux2 = __builtin_amdgcn_readfirstlane(u_.aux2); } while (0)
    if (!S.next(0, cur)) return;
    PG8_UNI(cur);
    f32x4 acc[2][2][4][2];
#pragma unroll
    for (int a = 0; a < 2; ++a)
#pragma unroll
        for (int b = 0; b < 2; ++b)
#pragma unroll
            for (int m = 0; m < 4; ++m)
#pragma unroll
                for (int n = 0; n < 2; ++n) acc[a][b][m][n] = (f32x4){0.f, 0.f, 0.f, 0.f};
    bf16x8 At[4][2], B0[2][2], B1[2][2];
    const char* cA = (const char*)g.A + (GATHER ? (size_t)0 : (size_t)cur.pm * tstepA); const char* cB = (const char*)g.Bt + (size_t)cur.pb * tstepB;
    PG8_SETVA(vAc, 0);
    PG8_STB(PG8_SB(0, 0), cB); PG8_STB(PG8_SB(0, 1), cB + hstepB); PG8_STAGE(PG8_SA(0, 0), cA, vAc[0][0], vAc[0][1]); PG8_STAGE(PG8_SA(0, 1), cA, vAc[1][0], vAc[1][1]);
    if (wr == 1) PG8_BAR;
    PG8_WAIT_V(2); PG8_BAR;
    PG8_STB(PG8_SB(1, 0), cB + kstep); PG8_STAGE(PG8_SA(1, 0), cA + kstep, vAc[0][0], vAc[0][1]); PG8_STB(PG8_SB(1, 1), cB + hstepB + kstep);
    PG8_WAIT_V(6); PG8_BAR;
    for (;;) {
        const bool has_next = S.next(ui + 1, nxt);
        PG8_UNI(nxt);
        const char* nA = GATHER ? cA : (has_next ? (const char*)g.A + (size_t)nxt.pm * tstepA : cA); const char* nB = has_next ? (const char*)g.Bt + (size_t)nxt.pb * tstepB : cB;
        const int nui = has_next ? ui + 1 : ui;
#pragma nounroll
        for (int t = 0; t < nt; t += 2) {
            const bool last = (t == nt - 2);
            const char* a1 = cA + (size_t)(t + 1) * kstep;
            const char* a2 = last ? nA : cA + (size_t)(t + 2) * kstep; const char* b2 = last ? nB : cB + (size_t)(t + 2) * kstep;
            const char* a3 = a2 + kstep; const char* b3 = b2 + kstep;
            unsigned x00 = vAc[0][0], x01 = vAc[0][1], x10 = vAc[1][0], x11 = vAc[1][1];
            if (GATHER) { if (last) { unsigned vN_[2][2]; PG8_SETVA(vN_, nui); x00 = vN_[0][0]; x01 = vN_[0][1]; x10 = vN_[1][0]; x11 = vN_[1][1]; } }
            PG8_LDB(B0, 0, 0); PG8_LDB(B1, 0, 1); PG8_SCHED; PG8_LDA(At, 0, 0); PG8_STAGE(PG8_SA(1, 1), a1, vAc[1][0], vAc[1][1]);
            PG8_WAIT_V(8); PG8_WAIT_L(0); PG8_BAR; PG8_SCHED8; PG8_MMA(0, 0, At, B0); PG8_MMA(0, 1, At, B1); PG8_SCHED8; PG8_BAR; PG8_SCHED;
            PG8_LDA(At, 0, 1); PG8_STB(PG8_SB(0, 0), b2); PG8_STB(PG8_SB(0, 1), b2 + hstepB); PG8_STAGE(PG8_SA(0, 0), a2, x00, x01);
            PG8_WAIT_V(8); PG8_WAIT_L(0); PG8_BAR; PG8_SCHED8; PG8_MMA(1, 0, At, B0); PG8_MMA(1, 1, At, B1); PG8_SCHED8; PG8_BAR; PG8_SCHED;
            PG8_LDB(B0, 1, 0); PG8_LDB(B1, 1, 1); PG8_SCHED; PG8_LDA(At, 1, 0); PG8_STAGE(PG8_SA(0, 1), a2, x10, x11);
            PG8_WAIT_V(8); PG8_WAIT_L(0); PG8_BAR; PG8_SCHED8; PG8_MMA(0, 0, At, B0); PG8_MMA(0, 1, At, B1); PG8_SCHED8; PG8_BAR; PG8_SCHED;
            PG8_LDA(At, 1, 1); PG8_STB(PG8_SB(1, 0), b3); PG8_STB(PG8_SB(1, 1), b3 + hstepB); PG8_STAGE(PG8_SA(1, 0), a3, x00, x01);
            PG8_WAIT_V(8); PG8_WAIT_L(0); PG8_BAR; PG8_SCHED8; PG8_MMA(1, 0, At, B0); PG8_MMA(1, 1, At, B1); PG8_SCHED8; PG8_BAR; PG8_SCHED;
        }
        if constexpr (ALIGN_EPI) { if (wr == 0) PG8_BAR; }
        { int l_ = lane_id(); asm volatile("" : "+v"(l_));
          E(acc, cur, wr, wc, l_ & 15, l_ >> 4); }
        if (!has_next) break;
#pragma unroll
        for (int a = 0; a < 2; ++a)
#pragma unroll
            for (int b = 0; b < 2; ++b)
#pragma unroll
                for (int m = 0; m < 4; ++m)
#pragma unroll
                    for (int n = 0; n < 2; ++n) acc[a][b][m][n] = (f32x4){0.f, 0.f, 0.f, 0.f};
        cur = nxt; cA = nA; cB = nB; ++ui;
        if (GATHER) { PG8_SETVA(vAc, ui); }
        if constexpr (ALIGN_EPI) { if (wr == 1) PG8_BAR; }
    }
    PG8_WAIT_V(0);
    if constexpr (!ALIGN_EPI) { if (wr == 0) PG8_BAR; }
    PG8_BAR;
#undef PG8_SETVA
#undef PG8_UNI
#undef PG8_SA
#undef PG8_SB
#undef PG8_STAGE
#undef PG8_GLDS_S
#undef PG8_STB
#undef PG8_LDA
#undef PG8_LDB
#undef PG8_MMA
#undef PG8_WAIT_V
#undef PG8_WAIT_L
#undef PG8_BAR
#undef PG8_SCHED
#undef PG8_SCHED8
}
}
constexpr int NWAVES = 8, NTHR = 512;
constexpr int BATCH = 8, SEQ = 8192, T = BATCH * SEQ, D = 1024, DIN = 4096;
constexpr int DS = 512, DA = 512, NH = 8, HD = 64, NBLK = SEQ / 256;
constexpr int SG = 32, SHC = 16, SP = 64, SL = 32, SKU = SL * SHC  , SKS = 2 * SP  , SKY = SKU + SKS  , SROWS = T / SL  ;
constexpr int NE = 32, DE = 512;
constexpr float RMS_EPS = 1e-6f;
constexpr float LOG2E = 1.4426950408889634f;
constexpr float QSCALE = 0.125f * LOG2E;
constexpr float WF8_SCALE = 32.f;
constexpr int ROWCAP = T;
constexpr int HID_ROWS = 2 * T + NE * 256;

constexpr size_t MiB = 1u << 20;
constexpr size_t WS_CTL = 0, CTL_ZERO_BYTES = 1 * MiB;
constexpr size_t WS_WIN = 1 * MiB;
constexpr size_t WS_WGLU = 9 * MiB;
constexpr size_t WS_WUS = 10 * MiB;
constexpr size_t WS_WUA = 11 * MiB;
constexpr size_t WS_WOUT = 12 * MiB;
constexpr size_t WS_WR = 14 * MiB;
constexpr size_t WS_KMEAN = 15 * MiB;
constexpr size_t WS_SSMW = 16 * MiB;
constexpr size_t WS_SSMT = 24 * MiB;
constexpr size_t WS_W13 = 44 * MiB;
constexpr size_t WS_W2 = 108 * MiB;
constexpr size_t WS_A0 = 140 * MiB;
constexpr size_t WS_UP = 276 * MiB;
constexpr size_t WS_Q = 356 * MiB;
constexpr size_t WS_SSQ = 404 * MiB;
constexpr size_t WS_RLOG = 408 * MiB;
constexpr size_t WS_K = 420 * MiB;
constexpr size_t WS_ROWTOK = 428 * MiB, WS_ROWCOEF = 436 * MiB, WS_ROWRSTD = 444 * MiB;
constexpr size_t WS_GACT = 420 * MiB;
constexpr size_t WS_V = 484 * MiB;
constexpr size_t WS_YSSM = 484 * MiB;
constexpr size_t WS_SGS = 548 * MiB;
constexpr size_t WS_SGA = 676 * MiB;
constexpr size_t WS_E = 804 * MiB;
constexpr size_t WS_YATT = 836 * MiB;
constexpr size_t WS_PART0 = 420 * MiB, WS_PART1 = 484 * MiB, WS_PART2 = 932 * MiB;
constexpr size_t WS_QLIST = 900 * MiB;
constexpr size_t WS_PL = 268 * MiB;
constexpr size_t WS_MQ = 996 * MiB;
constexpr size_t WS_H1F8 = 836 * MiB;
constexpr size_t WS_WINF8 = 900 * MiB;
constexpr size_t WS_XGF8 = 836 * MiB;
constexpr size_t WS_SEGC = 998 * MiB;
constexpr size_t WS_END = 999 * MiB;
constexpr size_t WS_KFRAG = WS_A0, WS_VFRAG = WS_A0 + 64 * MiB, WS_H1 = WS_A0, WS_MRG = WS_A0, WS_HID = WS_A0;
constexpr size_t WS_X1 = WS_SGS, WS_XG = WS_UP, WS_Y0 = WS_UP, WS_Y1 = WS_E;
static_assert(WS_GACT + 64 * MiB <= WS_YSSM && WS_YSSM + 64 * MiB <= WS_SGS, "map");
static_assert(WS_HID + (size_t)HID_ROWS * DE * 2 <= WS_UP, "hid fits");
static_assert(WS_RLOG + (size_t)T * 72 * 4 <= WS_ROWTOK, "rlog fits");

constexpr int CW_TMO = 0, CW_CODE = 1;
constexpr int CW_BAR = 4096;
constexpr int CW_ECNT = 8192;
constexpr int CW_GCNT = 12288;

constexpr int RING_BYTES = 131072;
constexpr int ROWTAB_OFF = RING_BYTES, ROWTAB_UNITS = 12, ROWTAB_BYTES = 25 * 1024;
constexpr int MOE_TST_OFF = ROWTAB_OFF + ROWTAB_BYTES;
constexpr int MISC_OFF = MOE_TST_OFF + 512;
constexpr int LDS_BYTES = MISC_OFF + 128;
static_assert(LDS_BYTES <= 163840, "LDS");

struct Frame {
    LAS unsigned char* lds;
    volatile LAS unsigned* MISC;
    gu32* ctl;
    unsigned char* ws;
    int tid, lane, wave, vcu, G;
    const float* in[27];
    float* out;
};

__device__ __forceinline__ unsigned pk4_fp8(float a, float b, float c, float d) { int w = 0; w = __builtin_amdgcn_cvt_pk_fp8_f32(a, b, w, false); w = __builtin_amdgcn_cvt_pk_fp8_f32(c, d, w, true); return (unsigned)w; }
#define EPI_LOOP_BEGIN  _Pragma("unroll") for (int ai = 0; ai < 2; ++ai) _Pragma("unroll") for (int m = 0; m < 4; ++m) { const int rl = ai * 128 + wr * 64 + m * 16 + fr; _Pragma("unroll") for (int bj = 0; bj < 2; ++bj) { const int cl = bj * 128 + wc * 32 + 8 * fq; \
        const f32x4 a0 = acc[ai][bj][m][0], a1 = acc[ai][bj][m][1]; (void)rl; (void)cl; (void)a0; (void)a1;
#define EPI_LOOP_END } }
typedef const f32x4 (&AccRef)[2][2][4][2];
__device__ __forceinline__ u32x4 pack8(f32x4 a, f32x4 b) { u32x4 w; w.x = cvt_pk_bf16(a[0], a[1]); w.y = cvt_pk_bf16(a[2], a[3]); w.z = cvt_pk_bf16(b[0], b[1]); w.w = cvt_pk_bf16(b[2], b[3]); return w; }
__device__ __forceinline__ void unpack8(u32x4 w, f32x4& a, f32x4& b) { a = (f32x4){bflo(w.x), bfhi(w.x), bflo(w.y), bfhi(w.y)}; b = (f32x4){bflo(w.z), bfhi(w.z), bflo(w.w), bfhi(w.w)}; }

template <int PART  > struct EpiProj {
    unsigned char* ws; const float* b_gate; int pn_off; float ascale;
    __device__ __forceinline__ void operator()(AccRef acc, const pg8::Unit& u, int wr, int wc, int fr, int fq) const {
        const int pn = u.pn + pn_off; const int row0 = u.pm * 256;
        if (PART == 0) {
            bf16_t* Uperm = (bf16_t*)(ws + WS_UP);
            EPI_LOOP_BEGIN
                const int row = row0 + rl, col = pn * 256 + cl;
                bf16_t* dst = Uperm + (size_t)(col >> 4) * ((size_t)SROWS * SKY) + (size_t)(row >> 5) * SKY + (row & 31) * 16 + (col & 15);
                *(u32x4*)dst = pack8(a0 * ascale, a1 * ascale);
            EPI_LOOP_END
        } else if (pn < 8) {
            const size_t boff = pn < 4 ? WS_Q : (pn < 6 ? WS_K : WS_V);
            bf16_t* base = (bf16_t*)(ws + boff); const float sc = pn < 4 ? QSCALE : 1.f; const int c0 = (pn & 1) * 256;
            EPI_LOOP_BEGIN
                const int row = row0 + rl, col = c0 + cl;
                *(u32x4*)(base + (size_t)row * 512 + col) = pack8(a0 * (sc * ascale), a1 * (sc * ascale));
            EPI_LOOP_END
        } else {
            const size_t boff = pn < 12 ? WS_SGS : WS_SGA;
            bf16_t* base = (bf16_t*)(ws + boff); const int c0 = ((pn - 8) & 3) * 256; const float* bg = b_gate + (pn - 8) * 256;
            EPI_LOOP_BEGIN
                const int row = row0 + rl, col = c0 + cl;
                const f32x4 b0 = *(const f32x4*)(bg + cl), b1 = *(const f32x4*)(bg + cl + 4);
                f32x4 s0, s1;
#pragma unroll
                for (int e = 0; e < 4; ++e) { s0[e] = fast_sigmoid(a0[e] * ascale + b0[e]); s1[e] = fast_sigmoid(a1[e] * ascale + b1[e]); }
                *(u32x4*)(base + (size_t)row * 1024 + col) = pack8(s0, s1);
            EPI_LOOP_END
        }
    }
};
struct EpiSsmE {
    float* E;
    __device__ __forceinline__ void operator()(AccRef acc, const pg8::Unit& u, int wr, int wc, int fr, int fq) const {
        EPI_LOOP_BEGIN
            if (bj == 0) { float* dst = E + (size_t)(u.pm * 256 + rl) * 128 + cl; *(f32x4*)dst = a0; *(f32x4*)(dst + 4) = a1; }
        EPI_LOOP_END
    }
};
__device__ __forceinline__ float gelu_tanh(float x) { const float z = 1.5957691216057308f * (x + 0.044715f * x * x * x); return x * fast_sigmoid(z); }
struct EpiSsmY {
    bf16_t* Gact;
    __device__ __forceinline__ void operator()(AccRef acc, const pg8::Unit& u, int wr, int wc, int fr, int fq) const {
        const int g = u.aux;
        EPI_LOOP_BEGIN
            const int rg = (u.pm & 7) * 256 + rl;
            const int colg = u.pn * 256 + cl;
            const int tok = (rg >> 8) * SEQ + (rg & 255) * SL + (colg >> 4);
            f32x4 y0, y1;
#pragma unroll
            for (int e = 0; e < 4; ++e) { y0[e] = gelu_tanh(a0[e]); y1[e] = gelu_tanh(a1[e]); }
            *(u32x4*)(Gact + (size_t)tok * DS + g * 16 + (colg & 15)) = pack8(y0, y1);
        EPI_LOOP_END
    }
};
struct EpiGlu {
    const bf16_t* Gact; bf16_t* Yssm; const float* b_glu;
    __device__ __forceinline__ void operator()(AccRef acc, const pg8::Unit& u, int wr, int wc, int fr, int fq) const {
        EPI_LOOP_BEGIN
            const int row = u.pm * 256 + rl, col = u.pn * 256 + cl;
            const f32x4 b0 = *(const f32x4*)(b_glu + col), b1 = *(const f32x4*)(b_glu + col + 4);
            f32x4 g0, g1; unpack8(*(const u32x4*)(Gact + (size_t)row * DS + col), g0, g1);
            f32x4 y0, y1;
#pragma unroll
            for (int e = 0; e < 4; ++e) { y0[e] = g0[e] * fast_sigmoid(a0[e] + b0[e]); y1[e] = g1[e] * fast_sigmoid(a1[e] + b1[e]); }
            *(u32x4*)(Yssm + (size_t)row * DS + col) = pack8(y0, y1);
        EPI_LOOP_END
    }
};
template <bool SECOND> struct EpiUp {
    const bf16_t* SG; bf16_t* Mrg;
    __device__ __forceinline__ void operator()(AccRef acc, const pg8::Unit& u, int wr, int wc, int fr, int fq) const {
        EPI_LOOP_BEGIN
            const size_t off = (size_t)(u.pm * 256 + rl) * D + u.pn * 256 + cl;
            f32x4 s0, s1; unpack8(*(const u32x4*)(SG + off), s0, s1);
            f32x4 y0 = s0 * a0, y1 = s1 * a1;
            if (SECOND) { f32x4 p0, p1; unpack8(*(const u32x4*)(Mrg + off), p0, p1); y0 += p0; y1 += p1; }
            *(u32x4*)(Mrg + off) = pack8(y0, y1);
        EPI_LOOP_END
    }
};
struct EpiOut {
    const float* x; bf16_t* X1; bf16_t* XG; unsigned char* XG8; const float* g2; float* SSQ;
    __device__ __forceinline__ void operator()(AccRef acc, const pg8::Unit& u, int wr, int wc, int fr, int fq) const {
#pragma unroll
        for (int ai = 0; ai < 2; ++ai)
#pragma unroll
            for (int m = 0; m < 4; ++m) { const int row = u.pm * 256 + ai * 128 + wr * 64 + m * 16 + fr; float ss = 0.f;
#pragma unroll
                for (int bj = 0; bj < 2; ++bj) { const int col = u.pn * 256 + bj * 128 + wc * 32 + 8 * fq; const size_t off = (size_t)row * D + col;
                    const f32x4 x0 = *(const f32x4*)(x + off) + acc[ai][bj][m][0], x1 = *(const f32x4*)(x + off + 4) + acc[ai][bj][m][1];
                    *(u32x4*)(X1 + off) = pack8(x0, x1);
                    ss += (x0[0] * x0[0] + x0[1] * x0[1]) + (x0[2] * x0[2] + x0[3] * x0[3]) + (x1[0] * x1[0] + x1[1] * x1[1]) + (x1[2] * x1[2] + x1[3] * x1[3]);
                    const f32x4 w0 = *(const f32x4*)(g2 + col), w1 = *(const f32x4*)(g2 + col + 4);
                    const f32x4 y0 = x0 * w0, y1 = x1 * w1;
                    *(u32x4*)(XG + off) = pack8(y0, y1); *(u32x2*)(XG8 + off) = (u32x2){pk4_fp8(y0[0], y0[1], y0[2], y0[3]), pk4_fp8(y1[0], y1[1], y1[2], y1[3])}; }
                ss += __shfl_xor(ss, 16); ss += __shfl_xor(ss, 32);
                if (fq == 0) SSQ[(size_t)row * 16 + u.pn * 4 + wc] = ss; }
    }
};
struct EpiRouter {
    float* Rlog;
    __device__ __forceinline__ void operator()(AccRef acc, const pg8::Unit& u, int wr, int wc, int fr, int fq) const {
        EPI_LOOP_BEGIN
            if (bj == 0 && cl < 72) { float* dst = Rlog + (size_t)(u.pm * 256 + rl) * 72 + cl; *(f32x4*)dst = a0; *(f32x4*)(dst + 4) = a1; }
        EPI_LOOP_END
    }
};
struct EpiMoe1 {
    bf16_t* Hid; const float* rowrstd; const unsigned* ecnt; float ascale;
    __device__ __forceinline__ void operator()(AccRef acc, const pg8::Unit& u, int wr, int wc, int fr, int fq) const {
        const int e = u.aux, cnt = (int)ecnt[e];
#pragma unroll
        for (int ai = 0; ai < 2; ++ai)
#pragma unroll
            for (int m = 0; m < 4; ++m) { const int rl = ai * 128 + wr * 64 + m * 16 + fr; const int pos = u.aux2 + rl;
                if (pos < cnt) { const float rs = rowrstd[(size_t)e * ROWCAP + pos] * ascale;
                    f32x4 h0, h1;
#pragma unroll
                    for (int k = 0; k < 4; ++k) { const float p = acc[ai][0][m][0][k] * rs, q = acc[ai][1][m][0][k] * rs; h0[k] = p * fast_sigmoid(p) * q;
                        const float p2 = acc[ai][0][m][1][k] * rs, q2 = acc[ai][1][m][1][k] * rs; h1[k] = p2 * fast_sigmoid(p2) * q2; }
                    *(u32x4*)(Hid + (size_t)(u.pm * 256 + rl) * DE + u.pn * 128 + wc * 32 + 8 * fq) = pack8(h0, h1); } }
    }
};
struct EpiMoe2 {
    bf16_t* Y0; size_t ydelta; const unsigned* rowtok; const float* rowcoef; const unsigned* ecnt;
    __device__ __forceinline__ void operator()(AccRef acc, const pg8::Unit& u, int wr, int wc, int fr, int fq) const {
        const int e = u.aux, cnt = (int)ecnt[e];
#pragma unroll
        for (int ai = 0; ai < 2; ++ai)
#pragma unroll
            for (int m = 0; m < 4; ++m) { const int rl = ai * 128 + wr * 64 + m * 16 + fr; const int pos = u.aux2 + rl;
                if (pos < cnt) { const unsigned tk = rowtok[(size_t)e * ROWCAP + pos]; const float cf = rowcoef[(size_t)e * ROWCAP + pos];
                    bf16_t* dst = (bf16_t*)((unsigned char*)Y0 + (size_t)(tk & 1u) * ydelta) + (size_t)(tk >> 1) * D + u.pn * 256 + wc * 32 + 8 * fq;
#pragma unroll
                    for (int bj = 0; bj < 2; ++bj) *(u32x4*)(dst + bj * 128) = pack8(acc[ai][bj][m][0] * cf, acc[ai][bj][m][1] * cf); } }
    }
};
__device__ __forceinline__ void transpose_item(const float* W, int N, int k0, int n0, bf16_t* WT, size_t drow0, int ldo, LAS float* scr, int lane) {
    float tv[32];
#pragma unroll
    for (int i = 0; i < 32; ++i) tv[i] = W[(size_t)(k0 + 2 * i + (lane >> 5)) * N + n0 + (lane & 31)];
#pragma unroll
    for (int i = 0; i < 32; ++i) scr[(2 * i + (lane >> 5)) * 33 + (lane & 31)] = tv[i];
    LDS_WAIT(); asm volatile("" ::: "memory");
    const int c = lane & 7;
#pragma unroll
    for (int j = 0; j < 4; ++j) { const int n = (lane >> 3) + 8 * j; const LAS float* s = scr + (8 * c) * 33 + n;
        u32x4 o; o.x = pk2(s[0 * 33], s[1 * 33]); o.y = pk2(s[2 * 33], s[3 * 33]); o.z = pk2(s[4 * 33], s[5 * 33]); o.w = pk2(s[6 * 33], s[7 * 33]);
        *(u32x4*)(WT + (drow0 + n) * (size_t)ldo + k0 + 8 * c) = o; }
    LDS_WAIT(); asm volatile("" ::: "memory");
}
__device__ __forceinline__ void transpose_item_f8(const float* W, int N, int k0, int n0, unsigned char* WT8, size_t drow0, int ldo, float scale, LAS float* scr, int lane) {
    float tv[32];
#pragma unroll
    for (int i = 0; i < 32; ++i) tv[i] = W[(size_t)(k0 + 2 * i + (lane >> 5)) * N + n0 + (lane & 31)];
#pragma unroll
    for (int i = 0; i < 32; ++i) scr[(2 * i + (lane >> 5)) * 33 + (lane & 31)] = tv[i] * scale;
    LDS_WAIT(); asm volatile("" ::: "memory");
    const int c = lane & 3;
#pragma unroll
    for (int j = 0; j < 2; ++j) { const int n = (lane >> 2) + 16 * j; const LAS float* s = scr + (16 * c) * 33 + n;
        u32x4 o; o.x = pk4_fp8(s[0 * 33], s[1 * 33], s[2 * 33], s[3 * 33]); o.y = pk4_fp8(s[4 * 33], s[5 * 33], s[6 * 33], s[7 * 33]);
        o.z = pk4_fp8(s[8 * 33], s[9 * 33], s[10 * 33], s[11 * 33]); o.w = pk4_fp8(s[12 * 33], s[13 * 33], s[14 * 33], s[15 * 33]);
        *(u32x4*)(WT8 + (drow0 + n) * (size_t)ldo + k0 + 16 * c) = o; }
    LDS_WAIT(); asm volatile("" ::: "memory");
}
template <int NR> __device__ __forceinline__ void rms_rows_to_bf16(int lane, const float* xrow, const float* g, bf16_t* orow, unsigned char* orow8) {
    f32x4 v[NR][4]; float s[NR];
#pragma unroll
    for (int r = 0; r < NR; ++r) { const f32x4* xr = (const f32x4*)(xrow + (size_t)r * D) + lane;
#pragma unroll
        for (int j = 0; j < 4; ++j) v[r][j] = xr[64 * j]; }
    const f32x4* gr = (const f32x4*)g + lane; f32x4 wv[4];
#pragma unroll
    for (int j = 0; j < 4; ++j) wv[j] = gr[64 * j];
#pragma unroll
    for (int r = 0; r < NR; ++r) { float a = 0.f;
#pragma unroll
        for (int j = 0; j < 4; ++j) a += (v[r][j].x * v[r][j].x + v[r][j].y * v[r][j].y) + (v[r][j].z * v[r][j].z + v[r][j].w * v[r][j].w);
        s[r] = a; }
#pragma unroll
    for (int o = 1; o < 64; o <<= 1) {
#pragma unroll
        for (int r = 0; r < NR; ++r) s[r] += __shfl_xor(s[r], o); }
#pragma unroll
    for (int r = 0; r < NR; ++r) { const float rstd = 1.f / sqrtf(s[r] * (1.f / D) + RMS_EPS); unsigned long long* o8 = (unsigned long long*)(orow + (size_t)r * D) + lane;
#pragma unroll
        for (int j = 0; j < 4; ++j) { const float y0 = v[r][j].x * rstd * wv[j].x, y1 = v[r][j].y * rstd * wv[j].y, y2 = v[r][j].z * rstd * wv[j].z, y3 = v[r][j].w * rstd * wv[j].w;
            o8[64 * j] = (unsigned long long)pk2(y0, y1) | ((unsigned long long)pk2(y2, y3) << 32);
            ((unsigned*)(orow8 + (size_t)r * D))[lane + 64 * j] = pk4_fp8(y0, y1, y2, y3); } }
}
__device__ __forceinline__ void cpow(float lr, float li, float step, float dl, float& ar, float& ai) {
    const float mag = __expf(dl * lr * step); const float rev = dl * (li * step * 0.15915494309189535f); const float fr = rev - floorf(rev);
    ar = mag * __builtin_amdgcn_cosf(fr); ai = mag * __builtin_amdgcn_sinf(fr);
}
__device__ __forceinline__ void ssm_gen(Frame& F, int g, int sl) {
    LAS float* AP = (LAS float*)(F.lds); LAS float* BB = AP + 33 * 64 * 2; LAS float* CC = BB + 2048; LAS float* KT = CC + 2048;
    const float* lam_re = F.in[4] + g * SP; const float* lam_im = F.in[5] + g * SP; const float step = __expf(F.in[6][g]);
    const float* b_re = F.in[7] + g * SP * SHC; const float* b_im = F.in[8] + g * SP * SHC; const float* c_re = F.in[9] + g * SHC * SP; const float* c_im = F.in[10] + g * SHC * SP; const float* dd = F.in[11] + g * SHC;
    bf16_t* BT = (bf16_t*)(F.ws + WS_SSMT) + (size_t)g * 512 * SKY; bf16_t* BW = (bf16_t*)(F.ws + WS_SSMW) + (size_t)g * 256 * SKU;
    const int tid = F.tid;
    for (int idx = tid; idx < 33 * 64; idx += NTHR) { const int dl = idx >> 6, p = idx & 63; float ar, ai; cpow(lam_re[p], lam_im[p], step, (float)dl, ar, ai); AP[idx * 2] = ar; AP[idx * 2 + 1] = ai; }
    for (int idx = tid; idx < 1024; idx += NTHR) { const int ho = idx >> 6, p = idx & 63; CC[idx * 2] = c_re[ho * 64 + p]; CC[idx * 2 + 1] = c_im[ho * 64 + p]; }
    __syncthreads();
    for (int idx = tid; idx < 1024; idx += NTHR) { const int p = idx >> 4, h = idx & 15; const float ar = AP[(64 + p) * 2], ai = AP[(64 + p) * 2 + 1];
        const float lr = lam_re[p], li = lam_im[p], nr = ar - 1.f, ni = ai, den = lr * lr + li * li, cr = (nr * lr + ni * li) / den, ci = (ni * lr - nr * li) / den;
        const float br = b_re[p * 16 + h], bi = b_im[p * 16 + h]; BB[idx * 2] = cr * br - ci * bi; BB[idx * 2 + 1] = cr * bi + ci * br; }
    __syncthreads();
    for (int idx = tid; idx < 1024; idx += NTHR) { const int dl = idx >> 5, hl = (idx >> 4) & 1, hi = idx & 15, ho = 2 * sl + hl; float s = 0.f;
        for (int p = 0; p < 64; ++p) { const float ar = AP[(dl * 64 + p) * 2], ai = AP[(dl * 64 + p) * 2 + 1], br = BB[(p * 16 + hi) * 2], bi = BB[(p * 16 + hi) * 2 + 1];
            const float zr = ar * br - ai * bi, zi = ar * bi + ai * br; s += CC[(ho * 64 + p) * 2] * zr - CC[(ho * 64 + p) * 2 + 1] * zi; }
        if (dl == 0 && ho == hi) s += dd[ho];
        KT[idx] = s; }
    __syncthreads();
    for (int v = tid; v < 64 * 80; v += NTHR) { const int nl = v / 80, kv = (v % 80) * 8, tau = nl >> 1, hl = nl & 1, ho = 2 * sl + hl, n = tau * 16 + ho; float val[8];
        if (kv < 512) { const int sg = kv >> 4, hi0 = kv & 15;
#pragma unroll
            for (int e = 0; e < 8; ++e) val[e] = (tau >= sg) ? KT[((tau - sg) * 2 + hl) * 16 + hi0 + e] : 0.f; }
        else { const int kk = kv - 512;
#pragma unroll
            for (int e = 0; e < 8; ++e) { const int p = (kk + e) >> 1, ri = (kk + e) & 1; const float ar = AP[((tau + 1) * 64 + p) * 2], ai = AP[((tau + 1) * 64 + p) * 2 + 1], cre = CC[(ho * 64 + p) * 2], cim = CC[(ho * 64 + p) * 2 + 1];
                val[e] = ri == 0 ? (cre * ar - cim * ai) : -(cre * ai + cim * ar); } }
        u32x4 o; o.x = pk2(val[0], val[1]); o.y = pk2(val[2], val[3]); o.z = pk2(val[4], val[5]); o.w = pk2(val[6], val[7]);
        *(u32x4*)(BT + (size_t)n * SKY + kv) = o; }
    for (int v = tid; v < 32 * 64; v += NTHR) { const int nl = v >> 6, kv = (v & 63) * 8; float val[8];
        const bool real = nl < 16; const int n = real ? 16 * sl + nl : 128 + 16 * sl + (nl - 16);
        if (real) { const int p = n >> 1, ri = n & 1, sg = kv >> 4, hi0 = kv & 15; const float ar = AP[((31 - sg) * 64 + p) * 2], ai = AP[((31 - sg) * 64 + p) * 2 + 1];
#pragma unroll
            for (int e = 0; e < 8; ++e) { const float br = BB[(p * 16 + hi0 + e) * 2], bi = BB[(p * 16 + hi0 + e) * 2 + 1]; val[e] = ri == 0 ? (ar * br - ai * bi) : (ar * bi + ai * br); } }
        else {
#pragma unroll
            for (int e = 0; e < 8; ++e) val[e] = 0.f; }
        u32x4 o; o.x = pk2(val[0], val[1]); o.y = pk2(val[2], val[3]); o.z = pk2(val[4], val[5]); o.w = pk2(val[6], val[7]);
        *(u32x4*)(BW + (size_t)n * SKU + kv) = o; }
    __syncthreads();
}
__device__ __forceinline__ void p0_prologue(Frame& F) {
    for (int it = F.vcu; it < SG * 8; it += F.G) ssm_gen(F, it >> 3, it & 7);
    LAS float* scr = (LAS float*)(F.lds + F.wave * 16384);
    const int gw = F.vcu * NWAVES + F.wave, NGW = F.G * NWAVES, lane = F.lane;
    constexpr int I_IN = 16 * 128, I_GLU = 8 * 16, I_US = 8 * 32, I_UA = 8 * 32, I_OUT = 16 * 32, I_W1 = 32 * 256, I_W3 = 32 * 256, I_W2 = 32 * 256;
    constexpr int NITEMS = I_IN + I_GLU + I_US + I_UA + I_OUT + I_W1 + I_W3 + I_W2;
    unsigned char* ws = F.ws;
    for (int it = gw; it < NITEMS; it += NGW) {
        int r = it;
        if (r < I_IN) { const int k0 = 64 * (r / 128), n0 = 32 * (r % 128);
            if (n0 < DS) transpose_item(F.in[2], DIN, k0, n0, (bf16_t*)(ws + WS_WIN), n0, D, scr, lane);
            else transpose_item_f8(F.in[2], DIN, k0, n0, ws + WS_WINF8, n0 - DS, D, WF8_SCALE, scr, lane);
            continue; } r -= I_IN;
        if (r < I_GLU) { transpose_item(F.in[12], DS, 64 * (r / 16), 32 * (r % 16), (bf16_t*)(ws + WS_WGLU), 32 * (r % 16), DS, scr, lane); continue; } r -= I_GLU;
        if (r < I_US) { transpose_item(F.in[14], D, 64 * (r / 32), 32 * (r % 32), (bf16_t*)(ws + WS_WUS), 32 * (r % 32), DS, scr, lane); continue; } r -= I_US;
        if (r < I_UA) { transpose_item(F.in[15], D, 64 * (r / 32), 32 * (r % 32), (bf16_t*)(ws + WS_WUA), 32 * (r % 32), DA, scr, lane); continue; } r -= I_UA;
        if (r < I_OUT) { transpose_item(F.in[17], D, 64 * (r / 32), 32 * (r % 32), (bf16_t*)(ws + WS_WOUT), 32 * (r % 32), D, scr, lane); continue; } r -= I_OUT;
        if (r < I_W1 + I_W3) { const int w3 = r >= I_W1; if (w3) r -= I_W1; const int e = r >> 8, q = r & 255, k0 = 64 * (q / 16), n0 = 32 * (q % 16);
            transpose_item_f8((w3 ? F.in[24] : F.in[23]) + (size_t)e * D * DE, DE, k0, n0, ws + WS_W13, (size_t)e * 1024 + 256 * (n0 >> 7) + (n0 & 127) + (w3 ? 128 : 0), D, WF8_SCALE, scr, lane); continue; }
        r -= I_W1 + I_W3;
        { const int e = r >> 8, q = r & 255, k0 = 64 * (q / 32), n0 = 32 * (q % 32);
            transpose_item(F.in[25] + (size_t)e * DE * D, D, k0, n0, (bf16_t*)(ws + WS_W2), (size_t)e * 1024 + n0, DE, scr, lane); }
    }
    for (int m = 4 * gw; m < T; m += 4 * NGW) rms_rows_to_bf16<4>(lane, F.in[0] + (size_t)m * D, F.in[1], (bf16_t*)(ws + WS_H1) + (size_t)m * D, ws + WS_H1F8 + (size_t)m * D);
    { bf16_t* WR = (bf16_t*)(ws + WS_WR); const float* wrg = F.in[19]; const float* wre = F.in[21];
      for (int idx = F.vcu * NTHR + F.tid; idx < 256 * D; idx += F.G * NTHR) { const int r = idx >> 10, k = idx & 1023; unsigned o = 0u;
          if (r < 72) { const int c = r < 36 ? r : r - 36; const float w = c < 4 ? wrg[k * 4 + c] : wre[k * 32 + (c - 4)]; const unsigned hb = f2bf(w);
              o = r < 36 ? hb : f2bf(w - __builtin_bit_cast(float, hb << 16)); }
          WR[idx] = (bf16_t)o; } }
}

__device__ __forceinline__ int crow(int r, int hi) { return (r & 3) + 8 * (r >> 2) + 4 * hi; }
constexpr int KVP = 72;
__device__ __forceinline__ void kv_prep_phase(Frame& F) {
    LAS bf16_t* KS = (LAS bf16_t*)(F.lds); LAS bf16_t* VS = KS + 256 * KVP; LAS float* PS = (LAS float*)(F.lds + 2 * 256 * KVP * 2); LAS float* WM = PS + 512;
    const bf16_t* Kb = (const bf16_t*)(F.ws + WS_K); const bf16_t* Vb = (const bf16_t*)(F.ws + WS_V);
    bf16_t* Kf = (bf16_t*)(F.ws + WS_KFRAG); bf16_t* Vf = (bf16_t*)(F.ws + WS_VFRAG); bf16_t* KM = (bf16_t*)(F.ws + WS_KMEAN); float* KN = (float*)(F.ws + WS_KMEAN + 512 * 1024);
    const int tid = F.tid;
    for (int item = F.vcu; item < BATCH * NH * NBLK; item += F.G) {
        const int n = item & 31, h = (item >> 5) & 7, b = item >> 8; const size_t tok0 = (size_t)b * SEQ + 256 * n;
#pragma unroll
        for (int j = 0; j < 4; ++j) { const int q = tid + NTHR * j, row = q >> 3, pc = q & 7; const size_t src = (tok0 + row) * DA + h * HD + pc * 8;
            *(LAS u32x4*)(KS + row * KVP + pc * 8) = *(const u32x4*)(Kb + src); *(LAS u32x4*)(VS + row * KVP + pc * 8) = *(const u32x4*)(Vb + src); }
        __syncthreads();
#pragma unroll
        for (int j = 0; j < 4; ++j) { const int P = tid + NTHR * j, st = P >> 8, ds = (P >> 6) & 3, l2 = P & 63, row = 32 * st + (l2 & 31), col = 16 * ds + 8 * (l2 >> 5);
            *(u32x4*)(Kf + ((size_t)item * 2048 + P) * 8) = *(const LAS u32x4*)(KS + row * KVP + col); }
#pragma unroll
        for (int j = 0; j < 4; ++j) { const int P = tid + NTHR * j, st = P >> 8, ks = (P >> 7) & 1, d0 = (P >> 6) & 1, l2 = P & 63, hi = l2 >> 5, jj = l2 & 31; unsigned w[4];
#pragma unroll
            for (int e = 0; e < 8; e += 2) { const unsigned lo = VS[(32 * st + 16 * ks + crow(e, hi)) * KVP + 32 * d0 + jj], hi16 = VS[(32 * st + 16 * ks + crow(e + 1, hi)) * KVP + 32 * d0 + jj]; w[e >> 1] = lo | (hi16 << 16); }
            *(u32x4*)(Vf + ((size_t)item * 2048 + P) * 8) = (u32x4){w[0], w[1], w[2], w[3]}; }
        { const int d = tid & 63, part = tid >> 6; float s = 0.f;
#pragma unroll 8
          for (int r = 0; r < 32; ++r) s += bf2f(KS[(part * 32 + r) * KVP + d]);
          PS[part * 64 + d] = s; }
        if (tid < 256) { float ss = 0.f;
#pragma unroll
            for (int c = 0; c < 8; ++c) { const u32x4 w = *(const LAS u32x4*)(KS + tid * KVP + c * 8);
                ss += bflo(w.x) * bflo(w.x) + bfhi(w.x) * bfhi(w.x) + bflo(w.y) * bflo(w.y) + bfhi(w.y) * bfhi(w.y) + bflo(w.z) * bflo(w.z) + bfhi(w.z) * bfhi(w.z) + bflo(w.w) * bflo(w.w) + bfhi(w.w) * bfhi(w.w); }
            ss = wave_max(ss); if (F.lane == 0) WM[F.wave] = ss; }
        __syncthreads();
        if (tid < 64) { float s = 0.f;
#pragma unroll
            for (int p = 0; p < 8; ++p) s += PS[p * 64 + tid];
            KM[(size_t)item * 64 + tid] = (bf16_t)f2bf(s * (1.f / 256.f)); }
        if (tid == 0) KN[item] = fmaxf(fmaxf(WM[0], WM[1]), fmaxf(WM[2], WM[3]));
        __syncthreads();
    }
}

__device__ __forceinline__ void ssm_scan_phase(Frame& F) {
    LAS float* FW = (LAS float*)(F.lds);
    const float* E = (const float*)(F.ws + WS_E); bf16_t* UP = (bf16_t*)(F.ws + WS_UP);
    const int w = F.wave, p = F.lane;
    for (int gb = F.vcu; gb < SG * BATCH; gb += F.G) {
        const int g = gb >> 3, b = gb & 7;
        const float lr = F.in[4][g * SP + p], li = F.in[5][g * SP + p], step = __expf(F.in[6][g]);
        float ar, ai; cpow(lr, li, step, 32.f, ar, ai);
        const size_t row0 = (size_t)g * SROWS + b * 256 + 32 * w;
        f32x2 e[32];
#pragma unroll
        for (int j = 0; j < 32; ++j) e[j] = *(const f32x2*)(E + (row0 + j) * 128 + 2 * p);
        float sr = 0.f, si = 0.f;
#pragma unroll
        for (int j = 0; j < 32; ++j) { const float nr = ar * sr - ai * si + e[j].x, ni = ar * si + ai * sr + e[j].y; sr = nr; si = ni; }
        FW[(w * 64 + p) * 2] = sr; FW[(w * 64 + p) * 2 + 1] = si;
        __syncthreads();
        float Ar = ar, Ai = ai;
#pragma unroll
        for (int q = 0; q < 5; ++q) { const float nr = Ar * Ar - Ai * Ai, ni = 2.f * Ar * Ai; Ar = nr; Ai = ni; }
        sr = 0.f; si = 0.f;
        for (int w2 = 0; w2 < w; ++w2) { const float fr = FW[(w2 * 64 + p) * 2], fi = FW[(w2 * 64 + p) * 2 + 1]; const float nr = Ar * sr - Ai * si + fr, ni = Ar * si + Ai * sr + fi; sr = nr; si = ni; }
#pragma unroll
        for (int j = 0; j < 32; ++j) { *(unsigned*)(UP + (row0 + j) * SKY + SKU + 2 * p) = pk2(sr, si);
            const float nr = ar * sr - ai * si + e[j].x, ni = ar * si + ai * sr + e[j].y; sr = nr; si = ni; }
        __syncthreads();
    }
}

__device__ __forceinline__ int t5_bucket(int d) {
    if (d < 16) return d;
    return 16 + (d >= 19) + (d >= 21) + (d >= 24) + (d >= 27) + (d >= 31) + (d >= 35) + (d >= 40) + (d >= 46) + (d >= 52) + (d >= 59) + (d >= 67) + (d >= 77) + (d >= 87) + (d >= 99) + (d >= 113);
}
struct Top3 { float v0, v1, v2; int i0, i1, i2; };
__device__ __forceinline__ Top3 top3_insert(Top3 t, float x, int n) {
    const bool b0 = (x > t.v0) || (x == t.v0 && n < t.i0), b1 = (x > t.v1) || (x == t.v1 && n < t.i1), b2 = (x > t.v2) || (x == t.v2 && n < t.i2);
    Top3 r;
    r.v2 = b1 ? t.v1 : (b2 ? x : t.v2); r.i2 = b1 ? t.i1 : (b2 ? n : t.i2);
    r.v1 = b0 ? t.v0 : (b1 ? x : t.v1); r.i1 = b0 ? t.i0 : (b1 ? n : t.i1);
    r.v0 = b0 ? x : t.v0; r.i0 = b0 ? n : t.i0;
    return r;
}
constexpr int GQS = 0, GKME = 36864, GCNTL = 41472, GMISC = 41600;
template <bool COUNT> __device__ __forceinline__ void attn_gate_unit(Frame& F, int bh, int qb) {
    LAS unsigned char* L = F.lds;
    LAS bf16_t* QS = (LAS bf16_t*)(L + GQS); LAS bf16_t* KME = (LAS bf16_t*)(L + GKME); LAS int* CNT = (LAS int*)(L + GCNTL); LAS float* KNM = (LAS float*)(L + GMISC);
    int tid = F.tid; asm volatile("" : "+v"(tid));
    const int lane = tid & 63, w = F.wave, j = lane & 31, hi = lane >> 5;
    const int b = bh >> 3, h = bh & 7; const size_t tok0 = (size_t)b * SEQ + 256 * qb;
    const bf16_t* Qb = (const bf16_t*)(F.ws + WS_Q); const bf16_t* KM = (const bf16_t*)(F.ws + WS_KMEAN); const float* KN = (const float*)(F.ws + WS_KMEAN + 512 * 1024);
    float* MQg = (float*)(F.ws + WS_MQ); unsigned short* QL = (unsigned short*)(F.ws + WS_QLIST); unsigned* GC = (unsigned*)(F.ctl + CW_GCNT); unsigned* SEGC = (unsigned*)(F.ws + WS_SEGC);
#pragma unroll
    for (int jj = 0; jj < 4; ++jj) { const int q = tid + NTHR * jj, row = q >> 3, pc = q & 7; *(LAS u32x4*)(QS + row * KVP + pc * 8) = *(const u32x4*)(Qb + (tok0 + row) * DA + h * HD + pc * 8); }
    if (tid < 256) { const int n = tid >> 3, pc = tid & 7; *(LAS u32x4*)(KME + n * KVP + pc * 8) = *(const u32x4*)(KM + ((size_t)bh * 32 + n) * 64 + pc * 8); }
    if (tid < 32) CNT[tid] = 0;
    if (w == 1) { float v = (lane <= qb && lane < 32) ? KN[bh * 32 + lane] : 0.f; v = wave_max(v); if (lane == 0) KNM[0] = v; }
    if (w == 2) { float v = F.in[16][h * 32 + (lane & 31)]; v = wave_max(v); if (lane == 0) KNM[1] = v * LOG2E; }
    __syncthreads();
    {
        bf16x8 qf[4], kmf[4];
#pragma unroll
        for (int ds = 0; ds < 4; ++ds) { qf[ds] = *(const LAS bf16x8*)(QS + (32 * w + j) * KVP + 16 * ds + 8 * hi); kmf[ds] = *(const LAS bf16x8*)(KME + j * KVP + 16 * ds + 8 * hi); }
        f32x16 gt = {};
#pragma unroll
        for (int ds = 0; ds < 4; ++ds) gt = __builtin_amdgcn_mfma_f32_32x32x16_bf16(kmf[ds], qf[ds], gt, 0, 0, 0);
        float qn = 0.f;
#pragma unroll
        for (int ds = 0; ds < 4; ++ds)
#pragma unroll
            for (int e = 0; e < 8; ++e) { const float x = bf2f((unsigned short)qf[ds][e]); qn += x * x; }
        qn += __shfl_xor(qn, 32);
        const float m2 = sqrtf(qn * KNM[0]) + KNM[1];
        const int ql = 256 * qb + 32 * w + j;
        if (hi == 0) MQg[(size_t)bh * SEQ + ql] = m2;
        Top3 t3; t3.v0 = t3.v1 = t3.v2 = -INFINITY; t3.i0 = t3.i1 = t3.i2 = -1;
#pragma unroll
        for (int r = 0; r < 16; ++r) { const int n = crow(r, hi); const float x = (n < qb) ? gt[r] : -INFINITY; t3 = top3_insert(t3, x, x > -INFINITY ? n : 0x7fffffff); }
        { const float p0 = __shfl_xor(t3.v0, 32), p1 = __shfl_xor(t3.v1, 32), p2 = __shfl_xor(t3.v2, 32); const int q0 = __shfl_xor(t3.i0, 32), q1 = __shfl_xor(t3.i1, 32), q2 = __shfl_xor(t3.i2, 32);
          t3 = top3_insert(t3, p0, q0 >= 0 ? q0 : 0x7fffffff); t3 = top3_insert(t3, p1, q1 >= 0 ? q1 : 0x7fffffff); t3 = top3_insert(t3, p2, q2 >= 0 ? q2 : 0x7fffffff); }
        const int i0 = t3.v0 > -INFINITY ? t3.i0 : -1, i1 = t3.v1 > -INFINITY ? t3.i1 : -1, i2 = t3.v2 > -INFINITY ? t3.i2 : -1;
        if (hi == 0) { const unsigned e = (unsigned)ql << 2;
            if (i0 >= 0) { const int pos = __hip_atomic_fetch_add(CNT + i0, 1, __ATOMIC_RELAXED, __HIP_MEMORY_SCOPE_WORKGROUP); QL[((size_t)bh * 32 + i0) * SEQ + (qb - i0 - 1) * 256 + pos] = (unsigned short)(e | 0u); }
            if (i1 >= 0) { const int pos = __hip_atomic_fetch_add(CNT + i1, 1, __ATOMIC_RELAXED, __HIP_MEMORY_SCOPE_WORKGROUP); QL[((size_t)bh * 32 + i1) * SEQ + (qb - i1 - 1) * 256 + pos] = (unsigned short)(e | 1u); }
            if (i2 >= 0) { const int pos = __hip_atomic_fetch_add(CNT + i2, 1, __ATOMIC_RELAXED, __HIP_MEMORY_SCOPE_WORKGROUP); QL[((size_t)bh * 32 + i2) * SEQ + (qb - i2 - 1) * 256 + pos] = (unsigned short)(e | 2u); } }
    }
    __syncthreads();
    if (tid < qb) { const unsigned c = (unsigned)CNT[tid]; SEGC[((size_t)bh * 32 + tid) * 32 + (qb - tid - 1)] = c; if (COUNT && c) (void)__hip_atomic_fetch_add(GC + bh * 32 + tid, c, __ATOMIC_RELAXED, __HIP_MEMORY_SCOPE_AGENT); }
    __syncthreads();
}
template <bool COUNT> __device__ __forceinline__ void attn_gate_phase(Frame& F) {
    for (int u = F.vcu; u < BATCH * NH * NBLK; u += F.G) attn_gate_unit<COUNT>(F, u >> 5, u & 31);
}

#define ATTN_SUBTILE(KP, VP, st_, MODE, CINIT) do { \
        bf16x8 kf_[4], vf_[4]; \
        _Pragma("unroll") for (int ds_ = 0; ds_ < 4; ++ds_) kf_[ds_] = *(const LAS bf16x8*)((KP) + ((st_) * 4 + ds_) * 512 + lane8); \
        _Pragma("unroll") for (int q_ = 0; q_ < 4; ++q_) vf_[q_] = *(const LAS bf16x8*)((VP) + ((st_) * 4 + q_) * 512 + lane8); \
        f32x16 s_ = __builtin_amdgcn_mfma_f32_32x32x16_bf16(kf_[0], qf[0], CINIT, 0, 0, 0); \
        _Pragma("unroll") for (int ds_ = 1; ds_ < 4; ++ds_) s_ = __builtin_amdgcn_mfma_f32_32x32x16_bf16(kf_[ds_], qf[ds_], s_, 0, 0, 0); \
        float p_[16]; \
        if ((MODE) == 0) { _Pragma("unroll") for (int r_ = 0; r_ < 16; ++r_) p_[r_] = __builtin_amdgcn_exp2f(s_[r_]); } \
        else if ((MODE) == 1) { _Pragma("unroll") for (int r_ = 0; r_ < 16; ++r_) { const int dist_ = dq - (32 * (st_) + crow(r_, hi)); const int di_ = dist_ < 0 ? 0 : (dist_ > 127 ? 127 : dist_); \
                p_[r_] = __builtin_amdgcn_exp2f(s_[r_] + TABh[di_]); } } \
        else { _Pragma("unroll") for (int rq_ = 0; rq_ < 4; ++rq_) { const f32x4 bb_ = *(const LAS f32x4*)(BTD + rq_ * 256 + lane * 4); \
                _Pragma("unroll") for (int i_ = 0; i_ < 4; ++i_) p_[4 * rq_ + i_] = __builtin_amdgcn_exp2f(s_[4 * rq_ + i_] + bb_[i_]); } } \
        _Pragma("unroll") for (int r_ = 0; r_ < 16; ++r_) lsum += p_[r_]; \
        u32x4 pa_, pb_; pa_.x = cvt_pk_bf16(p_[0], p_[1]); pa_.y = cvt_pk_bf16(p_[2], p_[3]); pa_.z = cvt_pk_bf16(p_[4], p_[5]); pa_.w = cvt_pk_bf16(p_[6], p_[7]); \
        pb_.x = cvt_pk_bf16(p_[8], p_[9]); pb_.y = cvt_pk_bf16(p_[10], p_[11]); pb_.z = cvt_pk_bf16(p_[12], p_[13]); pb_.w = cvt_pk_bf16(p_[14], p_[15]); \
        const bf16x8 A0_ = __builtin_bit_cast(bf16x8, pa_), A1_ = __builtin_bit_cast(bf16x8, pb_); \
        o0 = __builtin_amdgcn_mfma_f32_32x32x16_bf16(vf_[0], A0_, o0, 0, 0, 0); o1 = __builtin_amdgcn_mfma_f32_32x32x16_bf16(vf_[1], A0_, o1, 0, 0, 0); \
        o0 = __builtin_amdgcn_mfma_f32_32x32x16_bf16(vf_[2], A1_, o0, 0, 0, 0); o1 = __builtin_amdgcn_mfma_f32_32x32x16_bf16(vf_[3], A1_, o1, 0, 0, 0); } while (0)

__device__ __forceinline__ u32x4 ot_pack16(const f32x16& o, int pr) {
    const unsigned p0 = cvt_pk_bf16(o[8 * pr], o[8 * pr + 1]), p1 = cvt_pk_bf16(o[8 * pr + 2], o[8 * pr + 3]), q0 = cvt_pk_bf16(o[8 * pr + 4], o[8 * pr + 5]), q1 = cvt_pk_bf16(o[8 * pr + 6], o[8 * pr + 7]);
    const auto r0 = __builtin_amdgcn_permlane32_swap(p0, q0, false, false); const auto r1 = __builtin_amdgcn_permlane32_swap(p1, q1, false, false);
    return (u32x4){r0[0], r1[0], r0[1], r1[1]};
}
__device__ __forceinline__ void ot_add16(f32x16& o, int pr, u32x4 v, bool use) {
    const auto r0 = __builtin_amdgcn_permlane32_swap(v.x, v.z, false, false); const auto r1 = __builtin_amdgcn_permlane32_swap(v.y, v.w, false, false);
    const unsigned p0 = r0[0], p1 = r1[0], q0 = r0[1], q1 = r1[1];
    o[8 * pr] += use ? bflo(p0) : 0.f; o[8 * pr + 1] += use ? bfhi(p0) : 0.f; o[8 * pr + 2] += use ? bflo(p1) : 0.f; o[8 * pr + 3] += use ? bfhi(p1) : 0.f;
    o[8 * pr + 4] += use ? bflo(q0) : 0.f; o[8 * pr + 5] += use ? bfhi(q0) : 0.f; o[8 * pr + 6] += use ? bflo(q1) : 0.f; o[8 * pr + 7] += use ? bfhi(q1) : 0.f;
}
__device__ __forceinline__ void attn_fill_tab(Frame& F, LAS float* TAB) {
    const float* rb = F.in[16];
    for (int idx = F.tid; idx < 8 * 132; idx += NTHR) { const int h = idx / 132, d = idx % 132; float v = 0.f;
        if (d < 128) v = rb[h * 32 + t5_bucket(d)] * LOG2E; else if (d == 129) v = rb[h * 32 + 31] * LOG2E;
        TAB[idx] = v; }
}
constexpr int BGPRE_OFF = ROWTAB_OFF, BGCL_OFF = ROWTAB_OFF + 8448, BTAB_OFF = ROWTAB_OFF + 16640, BIT_OFF = ROWTAB_OFF + 20992, BIT_MAX = 512, OTAB_OFF = ROWTAB_OFF + 20480  ;
static_assert(BTAB_OFF + 8 * 132 * 4 <= MOE_TST_OFF, "attention LDS tables");
__device__ __forceinline__ size_t part_off(int slot) { return slot == 0 ? WS_PART0 : (slot == 1 ? WS_PART1 : WS_PART2); }

__device__ __forceinline__ void attn_block_phase(Frame& F) {
    LAS unsigned char* L = F.lds; LAS int* GPRE = (LAS int*)(L + BGPRE_OFF); LAS int* GCL = (LAS int*)(L + BGCL_OFF); LAS float* TAB = (LAS float*)(L + BTAB_OFF); LAS int* ITT = (LAS int*)(L + BIT_OFF); LAS int* WSUM = (LAS int*)(L + MOE_TST_OFF);
    const unsigned* GC = (const unsigned*)(F.ctl + CW_GCNT); const unsigned* SEGC = (const unsigned*)(F.ws + WS_SEGC);
    const int tid = F.tid, lane = F.lane, w = F.wave, j = lane & 31, hi = lane >> 5, lane8 = lane * 8;
    { int ng[4], tot = 0;
#pragma unroll
      for (int e = 0; e < 4; ++e) { const int c = (int)GC[4 * tid + e]; GCL[4 * tid + e] = c; ng[e] = (((c + 31) >> 5) + 7) >> 3; tot += ng[e]; }
      int inc = tot;
#pragma unroll
      for (int o = 1; o < 64; o <<= 1) { const int t = __shfl_up(inc, o); if (lane >= o) inc += t; }
      if (lane == 63) WSUM[w] = inc;
      __syncthreads();
      int woff = 0;
      for (int q = 0; q < w; ++q) woff += WSUM[q];
      int ex = woff + inc - tot;
#pragma unroll
      for (int e = 0; e < 4; ++e) { GPRE[4 * tid + e] = ex; ex += ng[e]; }
      if (tid == NTHR - 1) GPRE[2048] = ex; }
    attn_fill_tab(F, TAB);
    __syncthreads();
    const int NIT = GPRE[2048];
    const int nk = (NIT > F.vcu) ? (NIT - F.vcu + F.G - 1) / F.G : 0;
    if (tid < nk && tid < BIT_MAX) { const int it_ = F.vcu + tid * F.G; int lo_ = 0, hi_ = 2048; while (hi_ - lo_ > 1) { const int mid_ = (lo_ + hi_) >> 1; if (GPRE[mid_] <= it_) lo_ = mid_; else hi_ = mid_; } ITT[tid] = lo_ * 64 + (it_ - GPRE[lo_]); }
    __syncthreads();
    if (nk == 0) return;
    const int nkc = nk < BIT_MAX ? nk : BIT_MAX;
    const bf16_t* Qb = (const bf16_t*)(F.ws + WS_Q); const float* MQg = (const float*)(F.ws + WS_MQ); const unsigned short* QL = (const unsigned short*)(F.ws + WS_QLIST);
    const bf16_t* KF = (const bf16_t*)(F.ws + WS_KFRAG); const bf16_t* VF = (const bf16_t*)(F.ws + WS_VFRAG);
    float* PL = (float*)(F.ws + WS_PL);
#define BLK_ITEM(k_, pi_, g_) do { const int kk_ = (k_) < nkc ? (k_) : nkc - 1; const int v_ = __builtin_amdgcn_readfirstlane(ITT[kk_]); pi_ = v_ >> 6; g_ = v_ & 63; } while (0)
#define BLK_DMA(buf_, pi_) do { const char* ks_ = (const char*)KF + ((size_t)(pi_) * 2048 + tid) * 16; const char* vs_ = (const char*)VF + ((size_t)(pi_) * 2048 + tid) * 16; \
        _Pragma("unroll") for (int i_ = 0; i_ < 4; ++i_) { \
            __builtin_amdgcn_global_load_lds((const unsigned*)(ks_ + i_ * 8192), (LAS unsigned*)(L + (buf_) + (i_ * 512 + w * 64) * 16), 16, 0, 0); \
            __builtin_amdgcn_global_load_lds((const unsigned*)(vs_ + i_ * 8192), (LAS unsigned*)(L + (buf_) + 32768 + (i_ * 512 + w * 64) * 16), 16, 0, 0); } } while (0)
#define BLK_SEGC(dst_, pi_) do { dst_ = SEGC[(size_t)(pi_) * 32 + j]; } while (0)
#define BLK_ENTRY(dst_, segc_, pi_, g_) do { const int n_ = (pi_) & 31; int inc_ = (j < 31 - n_) ? (int)(segc_) : 0; \
        _Pragma("unroll") for (int o_ = 1; o_ < 32; o_ <<= 1) { const int t_ = __shfl_up(inc_, o_); if (j >= o_) inc_ += t_; } \
        const int cnt_ = GCL[pi_]; const int idx_ = 32 * (8 * (g_) + w) + j; int seg_ = 0, prev_ = 0; \
        for (int s_ = 0; s_ < 31 - n_; ++s_) { const int p_ = __builtin_amdgcn_readlane(inc_, s_); const bool le_ = p_ <= idx_; seg_ += le_ ? 1 : 0; prev_ = le_ ? p_ : prev_; } \
        const bool ok_ = idx_ < cnt_; const unsigned v_ = QL[(size_t)(pi_) * SEQ + (ok_ ? seg_ * 256 + (idx_ - prev_) : 0)]; dst_ = ok_ ? v_ : 0xFFFFu; } while (0)
#define BLK_QLOAD(qf_, m2_, ent_, pi_) do { const unsigned qq_ = ((ent_) == 0xFFFFu) ? 0u : ((ent_) >> 2); const int bh_ = (pi_) >> 5; \
        const bf16_t* qrow_ = Qb + ((size_t)(bh_ >> 3) * SEQ + qq_) * DA + (bh_ & 7) * HD + 8 * hi; \
        _Pragma("unroll") for (int ds_ = 0; ds_ < 4; ++ds_) qf_[ds_] = *(const bf16x8*)(qrow_ + 16 * ds_); \
        m2_ = MQg[(size_t)bh_ * SEQ + qq_]; } while (0)
    int pi, g, pi1, g1, pi2, g2; unsigned ent, ent1, sc2; bf16x8 qf[4]; float m2r;
    BLK_ITEM(0, pi, g); BLK_ITEM(1, pi1, g1); BLK_ITEM(2, pi2, g2);
    BLK_DMA(0, pi);
    { unsigned sc0, sc1; BLK_SEGC(sc0, pi); BLK_SEGC(sc1, pi1); BLK_SEGC(sc2, pi2); BLK_ENTRY(ent, sc0, pi, g); BLK_ENTRY(ent1, sc1, pi1, g1); }
    BLK_QLOAD(qf, m2r, ent, pi);
    int cur = 0;
    __builtin_amdgcn_s_waitcnt(0x0F70);
    unsigned char* dump = F.ws + WS_E + ((size_t)F.vcu * NTHR + tid) * 128;
    for (int k = 0; k < nkc; ++k) {
        __builtin_amdgcn_s_waitcnt(0x0F75);
        __syncthreads();
        int pi3, g3; unsigned sc3, ent2; bf16x8 qfn[4]; float m2n;
        BLK_ITEM(k + 3, pi3, g3); BLK_SEGC(sc3, pi3);
        BLK_ENTRY(ent2, sc2, pi2, g2);
        BLK_QLOAD(qfn, m2n, ent1, pi1);
        BLK_DMA((cur ^ 1) * 65536, pi1);
        const int bh = pi >> 5, n = pi & 31, h = bh & 7;
        const bool valid = ent != 0xFFFFu; const int q = valid ? (int)(ent >> 2) : 0; const int slot = (int)(ent & 3u);
        const bool active = __builtin_amdgcn_readfirstlane((int)(__ballot(valid) != 0ull)) != 0;
        f32x16 o0 = {}, o1 = {}; float lsum = 0.f;
        if (active) {
            const float m2 = valid ? m2r : INFINITY;
            const LAS bf16_t* KP = (const LAS bf16_t*)(L + cur * 65536); const LAS bf16_t* VP = (const LAS bf16_t*)(L + cur * 65536 + 32768);
            const LAS float* TABh = TAB + h * 132; const LAS float* BTD = nullptr; (void)BTD;
            const int dq = q - 256 * n;
            const bool nearw = __builtin_amdgcn_readfirstlane((int)(__ballot(valid && dq < 383) != 0ull)) != 0;
            const float ci = nearw ? -m2 : TABh[129] - m2;
            f32x16 cinit;
#pragma unroll
            for (int r = 0; r < 16; ++r) cinit[r] = ci;
            if (nearw) { for (int st = 0; st < 8; ++st) ATTN_SUBTILE(KP, VP, st, 1, cinit); }
            else { for (int st = 0; st < 8; ++st) ATTN_SUBTILE(KP, VP, st, 0, cinit); }
        }
        { const float lt = lsum + __shfl_xor(lsum, 32);
          const size_t qi = (size_t)bh * SEQ + q;
          float* pld = valid ? PL + (size_t)slot * (NH * BATCH * SEQ) + qi : (float*)(dump + 120);
          bf16_t* dst = valid ? (bf16_t*)(F.ws + part_off(slot)) + qi * HD + 8 * hi : (bf16_t*)dump;
          *pld = lt;
          *(u32x4*)(dst) = ot_pack16(o0, 0); *(u32x4*)(dst + 16) = ot_pack16(o0, 1); *(u32x4*)(dst + 32) = ot_pack16(o1, 0); *(u32x4*)(dst + 48) = ot_pack16(o1, 1); }
        pi = pi1; g = g1; ent = ent1; m2r = m2n; pi1 = pi2; g1 = g2; ent1 = ent2; pi2 = pi3; g2 = g3; sc2 = sc3; cur ^= 1;
#pragma unroll
        for (int ds = 0; ds < 4; ++ds) qf[ds] = qfn[ds];
    }
    VM_WAIT(); __syncthreads();
#undef BLK_ITEM
#undef BLK_DMA
#undef BLK_SEGC
#undef BLK_ENTRY
#undef BLK_QLOAD
}

__device__ __forceinline__ void attn_own_phase(Frame& F) {
    LAS unsigned char* L = F.lds; LAS float* TAB = (LAS float*)(L + OTAB_OFF); LAS float* BT = (LAS float*)(L + ROWTAB_OFF); int bth = -1;
    attn_fill_tab(F, TAB);
    const int tid = F.tid, lane = F.lane, w = F.wave, j = lane & 31, hi = lane >> 5, lane8 = lane * 8;
    const bf16_t* Qb = (const bf16_t*)(F.ws + WS_Q); const float* MQg = (const float*)(F.ws + WS_MQ);
    const bf16_t* KF = (const bf16_t*)(F.ws + WS_KFRAG); const bf16_t* VF = (const bf16_t*)(F.ws + WS_VFRAG);
    const float* PL = (const float*)(F.ws + WS_PL); bf16_t* YA = (bf16_t*)(F.ws + WS_YATT);
    const int NU = BATCH * NH * NBLK;
#define OWN_DMA(buf_, pi_) do { const char* ks_ = (const char*)KF + ((size_t)(pi_) * 2048 + tid) * 16; const char* vs_ = (const char*)VF + ((size_t)(pi_) * 2048 + tid) * 16; \
        _Pragma("unroll") for (int i_ = 0; i_ < 4; ++i_) { \
            __builtin_amdgcn_global_load_lds((const unsigned*)(ks_ + i_ * 8192), (LAS unsigned*)(L + (buf_) + (i_ * 512 + w * 64) * 16), 16, 0, 0); \
            __builtin_amdgcn_global_load_lds((const unsigned*)(vs_ + i_ * 8192), (LAS unsigned*)(L + (buf_) + 32768 + (i_ * 512 + w * 64) * 16), 16, 0, 0); } } while (0)
#define OWN_QLOAD(qf_, m2_, u_) do { const int bh_ = (u_) >> 5, qb_ = (u_) & 31; const size_t tk_ = (size_t)256 * qb_ + 32 * w + j; \
        const bf16_t* qrow_ = Qb + ((size_t)(bh_ >> 3) * SEQ + tk_) * DA + (bh_ & 7) * HD + 8 * hi; \
        _Pragma("unroll") for (int ds_ = 0; ds_ < 4; ++ds_) qf_[ds_] = *(const bf16x8*)(qrow_ + 16 * ds_); \
        m2_ = MQg[(size_t)bh_ * SEQ + tk_]; } while (0)
    int u = F.vcu; if (u >= NU) return;
    bf16x8 qf[4]; float m2;
    OWN_DMA(0, u); OWN_QLOAD(qf, m2, u);
    int cur = 0;
    __builtin_amdgcn_s_waitcnt(0x0F70);
    for (;;) {
        __builtin_amdgcn_s_waitcnt(0x0F74); __syncthreads();
        const int un = (u + F.G < NU) ? u + F.G : u; const bool last = (un == u);
        const int bh = u >> 5, qb = u & 31, b = bh >> 3, h = bh & 7; const int ql = 32 * w + j; const size_t qi = (size_t)bh * SEQ + 256 * qb + ql;
        u32x4 pa[3][4]; float pl[3];
#pragma unroll
        for (int s = 0; s < 3; ++s) { pl[s] = PL[(size_t)s * (NH * BATCH * SEQ) + qi]; const bf16_t* src = (const bf16_t*)(F.ws + part_off(s)) + qi * HD + 8 * hi;
#pragma unroll
            for (int c = 0; c < 4; ++c) pa[s][c] = *(const u32x4*)(src + 16 * c); }
        bf16x8 qfn[4]; float m2n;
        OWN_QLOAD(qfn, m2n, un);
        OWN_DMA((cur ^ 1) * 65536, un);
        const LAS bf16_t* KP = (const LAS bf16_t*)(L + cur * 65536); const LAS bf16_t* VP = (const LAS bf16_t*)(L + cur * 65536 + 32768); const LAS float* TABh = TAB + h * 132;
        if (h != bth) { __syncthreads();
            for (int e = tid; e < 5 * 1024; e += NTHR) { const int i = e & 3, ln = (e >> 2) & 63, rq = (e >> 8) & 3, dl = e >> 10; const int dist = 32 * dl + (ln & 31) - crow(4 * rq + i, ln >> 5);
                BT[e] = dist < 0 ? -1e30f : TABh[dist > 127 ? 127 : dist]; }
            bth = h; __syncthreads(); }
        const int dq = ql; (void)dq;
        f32x16 cnear, cfar;
#pragma unroll
        for (int r = 0; r < 16; ++r) { cnear[r] = -m2; cfar[r] = TABh[129] - m2; }
        f32x16 o0 = {}, o1 = {}; float lsum = 0.f;
        for (int st = 0; st <= w; ++st) { const int dl = w - st;
            if (dl >= 5) { const LAS float* BTD = nullptr; (void)BTD; ATTN_SUBTILE(KP, VP, st, 0, cfar); }
            else { const LAS float* BTD = BT + dl * 1024; ATTN_SUBTILE(KP, VP, st, 2, cnear); } }
        float lt = lsum + __shfl_xor(lsum, 32);
        const int nsel = qb < 3 ? qb : 3;
#pragma unroll
        for (int s = 0; s < 3; ++s) { const bool use = s < nsel; lt += use ? pl[s] : 0.f;
            ot_add16(o0, 0, pa[s][0], use); ot_add16(o0, 1, pa[s][1], use); ot_add16(o1, 0, pa[s][2], use); ot_add16(o1, 1, pa[s][3], use); }
        const float inv = 1.f / lt;
#pragma unroll
        for (int r = 0; r < 16; ++r) { o0[r] *= inv; o1[r] *= inv; }
        bf16_t* dst = YA + ((size_t)b * SEQ + 256 * qb + ql) * DA + h * HD + 8 * hi;
        *(u32x4*)(dst) = ot_pack16(o0, 0); *(u32x4*)(dst + 16) = ot_pack16(o0, 1); *(u32x4*)(dst + 32) = ot_pack16(o1, 0); *(u32x4*)(dst + 48) = ot_pack16(o1, 1);
        if (last) break;
        u = un; m2 = m2n; cur ^= 1;
#pragma unroll
        for (int ds = 0; ds < 4; ++ds) qf[ds] = qfn[ds];
    }
    VM_WAIT(); __syncthreads();
#undef OWN_DMA
#undef OWN_QLOAD
}
#undef ATTN_SUBTILE

__device__ __forceinline__ void routing_phase(Frame& F) {
    LAS int* lcnt = (LAS int*)(F.lds); LAS int* lbase = lcnt + 32;
    const float* SSQ = (const float*)(F.ws + WS_SSQ); const float* RL = (const float*)(F.ws + WS_RLOG);
    unsigned* rowtok = (unsigned*)(F.ws + WS_ROWTOK); float* rowcoef = (float*)(F.ws + WS_ROWCOEF); float* rowrstd = (float*)(F.ws + WS_ROWRSTD);
    unsigned* ecnt = (unsigned*)(F.ctl + CW_ECNT);
    const float* brg = F.in[20]; const float* bre = F.in[22];
    const int tid = F.tid;
    for (int base = F.vcu * 256; base < T; base += F.G * 256) {
        if (tid < 32) lcnt[tid] = 0;
        __syncthreads();
        int e0 = 0, e1 = 0, lp0 = 0, lp1 = 0; float c0 = 0.f, c1 = 0.f, rstd = 0.f; const int tok = base + tid;
        if (tid < 256) {
            float ss = 0.f;
#pragma unroll
            for (int q = 0; q < 4; ++q) { const f32x4 v = *(const f32x4*)(SSQ + (size_t)tok * 16 + 4 * q); ss += (v.x + v.y) + (v.z + v.w); }
            rstd = 1.f / sqrtf(ss * (1.f / D) + RMS_EPS);
            float r[72];
#pragma unroll
            for (int q = 0; q < 18; ++q) { const f32x4 v = *(const f32x4*)(RL + (size_t)tok * 72 + 4 * q); r[4 * q] = v.x; r[4 * q + 1] = v.y; r[4 * q + 2] = v.z; r[4 * q + 3] = v.w; }
            float gl[4], el[32];
#pragma unroll
            for (int c = 0; c < 4; ++c) gl[c] = rstd * (r[c] + r[36 + c]) + brg[c];
#pragma unroll
            for (int c = 0; c < 32; ++c) el[c] = rstd * (r[4 + c] + r[40 + c]) + bre[c];
            int gi = 0; float gm = gl[0];
#pragma unroll
            for (int c = 1; c < 4; ++c) if (gl[c] > gm) { gm = gl[c]; gi = c; }
            float Z = 0.f;
#pragma unroll
            for (int c = 0; c < 4; ++c) Z += __expf(gl[c] - gm);
            const float gval = 1.f / Z;
            float es[8];
#pragma unroll
            for (int q = 0; q < 8; ++q) es[q] = gi == 0 ? el[q] : (gi == 1 ? el[8 + q] : (gi == 2 ? el[16 + q] : el[24 + q]));
            int a0 = 0; float m0 = es[0];
#pragma unroll
            for (int q = 1; q < 8; ++q) if (es[q] > m0) { m0 = es[q]; a0 = q; }
            int a1 = -1; float m1 = -INFINITY;
#pragma unroll
            for (int q = 0; q < 8; ++q) if (q != a0 && es[q] > m1) { m1 = es[q]; a1 = q; }
            const float w0 = 1.f / (1.f + __expf(m1 - m0)), w1 = 1.f - w0;
            e0 = gi * 8 + a0; e1 = gi * 8 + a1; c0 = gval * w0; c1 = gval * w1;
            lp0 = __hip_atomic_fetch_add(lcnt + e0, 1, __ATOMIC_RELAXED, __HIP_MEMORY_SCOPE_WORKGROUP);
            lp1 = __hip_atomic_fetch_add(lcnt + e1, 1, __ATOMIC_RELAXED, __HIP_MEMORY_SCOPE_WORKGROUP);
        }
        __syncthreads();
        if (tid < 32) lbase[tid] = (int)__hip_atomic_fetch_add(ecnt + tid, (unsigned)lcnt[tid], __ATOMIC_RELAXED, __HIP_MEMORY_SCOPE_AGENT);
        __syncthreads();
        if (tid < 256) {
            const size_t i0 = (size_t)e0 * ROWCAP + lbase[e0] + lp0, i1 = (size_t)e1 * ROWCAP + lbase[e1] + lp1;
            rowtok[i0] = (unsigned)tok * 2u; rowcoef[i0] = c0; rowrstd[i0] = rstd;
            rowtok[i1] = (unsigned)tok * 2u + 1u; rowcoef[i1] = c1; rowrstd[i1] = rstd;
        }
        __syncthreads();
    }
}
struct MoeOrder {
    const LAS int* tst; int total, G, v;
    __device__ bool next(int i, pg8::Unit& u) const {
        const int L = i * G + v; if (L >= total) return false;
        const int rt = L >> 2; int e = 0;
#pragma unroll 8
        for (int q = 1; q <= 32; ++q) e += (tst[q] <= rt) ? 1 : 0;
        u.pm = rt; u.pn = L & 3; u.pb = e * 4 + u.pn; u.aux = e; u.aux2 = (rt - tst[e]) * 256; return true;
    }
};
__device__ __forceinline__ void moe_tables(Frame& F) {
    LAS int* tst = (LAS int*)(F.lds + MOE_TST_OFF); const unsigned* ecnt = (const unsigned*)(F.ctl + CW_ECNT);
    if (F.wave == 0) { const int lane = F.lane; int nt = lane < 32 ? (int)((ecnt[lane & 31] + 255u) >> 8) : 0; int inc = nt;
#pragma unroll
        for (int o = 1; o < 32; o <<= 1) { const int t = __shfl_up(inc, o); if (lane >= o) inc += t; }
        if (lane < 32) tst[lane + 1] = inc; if (lane == 0) tst[0] = 0; }
    __syncthreads();
}
__device__ __forceinline__ void final_phase(Frame& F) {
#ifdef SELFCHECK
    const bool chk_bad = __hip_atomic_load((unsigned*)(F.ctl + 2), __ATOMIC_RELAXED, __HIP_MEMORY_SCOPE_AGENT) != 0u;
#endif
    const bf16_t* X1 = (const bf16_t*)(F.ws + WS_X1); const bf16_t* Y0 = (const bf16_t*)(F.ws + WS_Y0); const bf16_t* Y1 = (const bf16_t*)(F.ws + WS_Y1); const float* gf = F.in[26];
    const int gw = F.vcu * NWAVES + F.wave, NGW = F.G * NWAVES, lane = F.lane;
    for (int m = gw; m < T; m += NGW) {
        const u32x2* xr = (const u32x2*)(X1 + (size_t)m * D) + lane; const u32x2* y0 = (const u32x2*)(Y0 + (size_t)m * D) + lane; const u32x2* y1 = (const u32x2*)(Y1 + (size_t)m * D) + lane;
        f32x4 v[4]; float s = 0.f;
#pragma unroll
        for (int j = 0; j < 4; ++j) { const u32x2 xx = xr[64 * j]; v[j] = (f32x4){bflo(xx.x), bfhi(xx.x), bflo(xx.y), bfhi(xx.y)}; const u32x2 a = y0[64 * j], c = y1[64 * j];
            v[j].x += bflo(a.x) + bflo(c.x); v[j].y += bfhi(a.x) + bfhi(c.x); v[j].z += bflo(a.y) + bflo(c.y); v[j].w += bfhi(a.y) + bfhi(c.y);
            s += (v[j].x * v[j].x + v[j].y * v[j].y) + (v[j].z * v[j].z + v[j].w * v[j].w); }
        const float rstd = 1.f / sqrtf(wave_sum(s) * (1.f / D) + RMS_EPS);
        f32x4* o = (f32x4*)(F.out + (size_t)m * D) + lane; const f32x4* gr = (const f32x4*)gf + lane;
#ifdef SELFCHECK
        if (chk_bad) { for (int j = 0; j < 4; ++j) o[64 * j] = (f32x4){0.f, 0.f, 0.f, 0.f}; continue; }
#endif
#pragma unroll
        for (int j = 0; j < 4; ++j) o[64 * j] = v[j] * rstd * gr[64 * j];
    }
}
#ifdef SELFCHECK
constexpr int CW_CHK = 2;
__device__ __forceinline__ int t5_bucket_ref(int n) { if (n < 16) return n; const int l = 16 + (int)(logf((float)n / 16.f) / logf(8.f) * 16.f); return l < 31 ? l : 31; }
__device__ __forceinline__ float kfrag_at(const bf16_t* KF, int bh, int key, int d) { const int n = key >> 8, kl = key & 255, st = kl >> 5, i = kl & 31, ds = d >> 4, hi = (d >> 3) & 1, e = d & 7;
    return bf2f(KF[(((size_t)bh * 32 + n) * 2048 + (st * 4 + ds) * 64 + (i + 32 * hi)) * 8 + e]); }
__device__ __forceinline__ float vfrag_at(const bf16_t* VF, int bh, int key, int d) { const int n = key >> 8, kl = key & 255, st = kl >> 5, kk = kl & 31, ks = kk >> 4, k16 = kk & 15, hi = (k16 >> 2) & 1, e = (k16 & 3) + 4 * (k16 >> 3), d0 = d >> 5, jj = d & 31;
    return bf2f(VF[(((size_t)bh * 32 + n) * 2048 + ((st * 2 + ks) * 2 + d0) * 64 + (jj + 32 * hi)) * 8 + e]); }
__device__ __forceinline__ void selfcheck_phase(Frame& F, float tol_attn, float tol_ssm) {
    const int lane = lane_id(); const int gw = F.vcu * NWAVES + F.wave;
    const bf16_t* Qb = (const bf16_t*)(F.ws + WS_Q); const bf16_t* KM = (const bf16_t*)(F.ws + WS_KMEAN); const bf16_t* KF = (const bf16_t*)(F.ws + WS_KFRAG); const bf16_t* VF = (const bf16_t*)(F.ws + WS_VFRAG);
    const bf16_t* YA = (const bf16_t*)(F.ws + WS_YATT); const float* rb = F.in[16];
    bool bad = false;
    for (int sidx = 0; sidx < 12; ++sidx) {
        unsigned hsh = (unsigned)(gw * 12 + sidx) * 2654435761u; hsh ^= hsh >> 15; hsh *= 2246822519u; hsh ^= hsh >> 13;
        const int bh = (int)(hsh & 63u); int q = (int)((hsh >> 6) & 8191u);
        if (sidx == 0) q = q & 767; if (sidx == 1) q = (q & ~255) | (sidx & 1 ? 0 : 255); if (sidx == 2) q = (q & ~255) | 255; if (sidx == 3) q = (q & ~255) | 128;
        const int b = bh >> 3, h = bh & 7, qb = q >> 8, d = lane;
        const float qd = bf2f(Qb[((size_t)b * SEQ + q) * DA + h * HD + d]);
        int s0 = -1, s1 = -1, s2 = -1; float g0 = -INFINITY, g1 = -INFINITY, g2 = -INFINITY;
        for (int n = 0; n < qb; ++n) { const float gt = wave_sum(qd * bf2f(KM[((size_t)bh * 32 + n) * 64 + d]));
            if (gt > g0) { g2 = g1; s2 = s1; g1 = g0; s1 = s0; g0 = gt; s0 = n; } else if (gt > g1) { g2 = g1; s2 = s1; g1 = gt; s1 = n; } else if (gt > g2) { g2 = gt; s2 = n; } }
        float m = -INFINITY, l = 0.f, od = 0.f;
        for (int blk = 0; blk < 4; ++blk) { const int n = blk == 0 ? s0 : (blk == 1 ? s1 : (blk == 2 ? s2 : qb)); if (n < 0) continue;
            const int kend = (blk == 3) ? (q & 255) + 1 : 256;
            for (int kl = 0; kl < kend; ++kl) { const int key = 256 * n + kl; const float kd = kfrag_at(KF, bh, key, d);
                const float s = wave_sum(qd * kd) + rb[h * 32 + t5_bucket_ref(q - key)] * LOG2E;
                const float mn = fmaxf(m, s), sc = exp2f(m - mn), p = exp2f(s - mn); l = l * sc + p; od = od * sc + p * vfrag_at(VF, bh, key, d); m = mn; } }
        od /= l;
        const float yd = bf2f(YA[((size_t)b * SEQ + q) * DA + h * HD + d]);
        const float e2 = wave_sum((od - yd) * (od - yd)), o2 = wave_sum(od * od);
        if (!(e2 <= tol_attn * tol_attn * o2)) bad = true;
    }
    { const bf16_t* UP = (const bf16_t*)(F.ws + WS_UP); const bf16_t* GA = (const bf16_t*)(F.ws + WS_GACT);
      for (int sidx = 0; sidx < 6; ++sidx) {
        unsigned hsh = (unsigned)(gw * 6 + sidx + 7777) * 2654435761u; hsh ^= hsh >> 15; hsh *= 2246822519u; hsh ^= hsh >> 13;
        const int g = (int)(hsh & 31u), b = (int)((hsh >> 5) & 7u); int t = (int)((hsh >> 8) % 330u); if (sidx == 0) t = 31 + (int)((hsh >> 20) & 3u) * 32; if (sidx == 1) t = 32 + (int)((hsh >> 20) & 7u) * 32;
        const int p = lane;
        const float lr = F.in[4][g * SP + p], li = F.in[5][g * SP + p], step = expf(F.in[6][g]);
        const float mag = expf(lr * step), ar = mag * cosf(li * step), ai = mag * sinf(li * step);
        const float nr = ar - 1.f, ni = ai, den = lr * lr + li * li, cr = (nr * lr + ni * li) / den, ci = (ni * lr - nr * li) / den;
        float hr = 0.f, hi_ = 0.f;
        for (int tt = 0; tt <= t; ++tt) { float br = 0.f, bi = 0.f;
            for (int c = 0; c < 16; ++c) { const float u = bf2f(UP[(size_t)g * SROWS * SKY + ((size_t)b * 256 + (tt >> 5)) * SKY + (tt & 31) * 16 + c]);
                const float b_r = F.in[7][(g * SP + p) * 16 + c], b_i = F.in[8][(g * SP + p) * 16 + c]; br += (cr * b_r - ci * b_i) * u; bi += (cr * b_i + ci * b_r) * u; }
            const float n_r = ar * hr - ai * hi_ + br, n_i = ar * hi_ + ai * hr + bi; hr = n_r; hi_ = n_i; }
        float e2 = 0.f, o2 = 0.f;
        for (int ho = 0; ho < 16; ++ho) { float y = wave_sum(hr * F.in[9][(g * 16 + ho) * SP + p] - hi_ * F.in[10][(g * 16 + ho) * SP + p]);
            const float u = bf2f(UP[(size_t)g * SROWS * SKY + ((size_t)b * 256 + (t >> 5)) * SKY + (t & 31) * 16 + ho]); y += F.in[11][g * 16 + ho] * u;
            const float ge = 0.5f * y * (1.f + tanhf(0.7978845608028654f * (y + 0.044715f * y * y * y)));
            const float gv = bf2f(GA[((size_t)b * SEQ + t) * DS + g * 16 + ho]); e2 += (ge - gv) * (ge - gv); o2 += ge * ge; }
        if (!(e2 <= tol_ssm * tol_ssm * o2 + 1e-6f)) bad = true;
      } }
    if (__ballot(bad) != 0ull && lane == 0) __hip_atomic_store((unsigned*)(F.ctl + CW_CHK), 1u, __ATOMIC_RELAXED, __HIP_MEMORY_SCOPE_AGENT);
}
#endif

#ifdef SELFCHECK
__device__ __forceinline__ void selfcheck_prep(Frame& F) {
    const int lane = lane_id(); const int gw = F.vcu * NWAVES + F.wave;
    const bf16_t* Kb = (const bf16_t*)(F.ws + WS_K); const bf16_t* Vb = (const bf16_t*)(F.ws + WS_V); const bf16_t* KF = (const bf16_t*)(F.ws + WS_KFRAG); const bf16_t* VF = (const bf16_t*)(F.ws + WS_VFRAG);
    const bf16_t* KM = (const bf16_t*)(F.ws + WS_KMEAN); const float* KN = (const float*)(F.ws + WS_KMEAN + 512 * 1024);
    bool bad = false;
    for (int sidx = 0; sidx < 64; ++sidx) {
        unsigned hsh = (unsigned)(gw * 64 + sidx + 12345) * 2654435761u; hsh ^= hsh >> 15; hsh *= 2246822519u; hsh ^= hsh >> 13;
        const int bh = (int)(hsh & 63u), key = (int)((hsh >> 6) & 8191u), b = bh >> 3, h = bh & 7, d = lane;
        const float k0 = bf2f(Kb[((size_t)b * SEQ + key) * DA + h * HD + d]), v0 = bf2f(Vb[((size_t)b * SEQ + key) * DA + h * HD + d]);
        if (kfrag_at(KF, bh, key, d) != k0 || vfrag_at(VF, bh, key, d) != v0) bad = true;
    }
    for (int sidx = 0; sidx < 2; ++sidx) {
        unsigned hsh = (unsigned)(gw * 2 + sidx + 999) * 2654435761u; hsh ^= hsh >> 15; hsh *= 2246822519u; hsh ^= hsh >> 13;
        const int item = (int)(hsh & 2047u), bh = item >> 5, n = item & 31, b = bh >> 3, h = bh & 7, d = lane; float sum = 0.f, mx = 0.f;
        for (int kl = 0; kl < 256; ++kl) { const float kv = bf2f(Kb[((size_t)b * SEQ + 256 * n + kl) * DA + h * HD + d]); sum += kv; mx = fmaxf(mx, wave_sum(kv * kv)); }
        const float mean = sum * (1.f / 256.f), got = bf2f(KM[(size_t)item * 64 + d]);
        if (fabsf(mean - got) > 0.01f * fabsf(mean) + 1e-3f) bad = true;
        if (fabsf(mx - KN[item]) > 1e-3f * mx) bad = true;
    }
    if (__ballot(bad) != 0ull && lane == 0) __hip_atomic_store((unsigned*)(F.ctl + CW_CHK), 1u, __ATOMIC_RELAXED, __HIP_MEMORY_SCOPE_AGENT);
}
#endif
#ifndef MK_N_LAUNCHES
#define MK_N_LAUNCHES 1
#endif
constexpr int NPHASE = 14;
struct Args { const float* in[27]; float* out; unsigned char* ws; int ph_lo, ph_hi; };
static_assert(sizeof(Args) == 27 * 8 + 8 + 8 + 8, "Args has no padding");

#ifndef STAG1
#define STAG1 0
#endif
#ifndef DUP_MASK
#define DUP_MASK 0
#endif
#define PH_ARGS Frame& F, unsigned char* ws, LAS unsigned char* ring
__device__ __forceinline__ void ph1(PH_ARGS) {
    { pg8::Gemm g{(const bf16_t*)(ws + WS_H1), (const bf16_t*)(ws + WS_WIN), D, D, D}; pg8::StaticOrder S; S.init(T, DS, F.G, (int)blockIdx.x);
      EpiProj<0> E{ws, F.in[3], 0, 1.f};
      pg8::gemm_phase<EpiProj<0>, pg8::StaticOrder, true, false>(ring, g, S, E, nullptr, F.wave); }
    { pg8::Gemm g{(const bf16_t*)(ws + WS_H1F8), (const bf16_t*)(ws + WS_WINF8), D / 2, D / 2, D / 2}; pg8::StaticOrder S; S.init(T, DIN - DS, F.G, (int)blockIdx.x);
      EpiProj<1> E{ws, F.in[3], 2, 1.f / WF8_SCALE};
      pg8::gemm_phase<EpiProj<1>, pg8::StaticOrder, true, false, true>(ring, g, S, E, nullptr, F.wave); }
}
__device__ __forceinline__ void ph2(PH_ARGS) {
    { pg8::Gemm g{(const bf16_t*)(ws + WS_UP), (const bf16_t*)(ws + WS_SSMW), SKY, SKU, SKU}; pg8::GroupedOrder S; S.init(SG * 8, 1, 8, F.G, F.vcu);
      EpiSsmE E{(float*)(ws + WS_E)};
      pg8::gemm_phase<EpiSsmE, pg8::GroupedOrder, false, false>(ring, g, S, E, nullptr, F.wave); }
    VM_WAIT(); __syncthreads();
    ssm_scan_phase(F);
    kv_prep_phase(F);
}
__device__ __forceinline__ void ph4(PH_ARGS) {
    pg8::Gemm g{(const bf16_t*)(ws + WS_UP), (const bf16_t*)(ws + WS_SSMT), SKY, SKY, SKY}; pg8::GroupedOrder S; S.init(SG * 8, 2, 8, F.G, F.vcu);
    EpiSsmY E{(bf16_t*)(ws + WS_GACT)};
    pg8::gemm_phase<EpiSsmY, pg8::GroupedOrder, true, false>(ring, g, S, E, nullptr, F.wave);
}
__device__ __forceinline__ void ph5(PH_ARGS) {
    pg8::Gemm g{(const bf16_t*)(ws + WS_GACT), (const bf16_t*)(ws + WS_WGLU), DS, DS, DS}; pg8::StaticOrder S; S.init(T, DS, F.G, (int)blockIdx.x);
    EpiGlu E{(const bf16_t*)(ws + WS_GACT), (bf16_t*)(ws + WS_YSSM), F.in[13]};
    pg8::gemm_phase<EpiGlu, pg8::StaticOrder, true, false>(ring, g, S, E, nullptr, F.wave);
}
__device__ __forceinline__ void ph6(PH_ARGS) {
    { pg8::Gemm g{(const bf16_t*)(ws + WS_YSSM), (const bf16_t*)(ws + WS_WUS), DS, DS, DS}; pg8::StaticOrder S; S.init(T, D, F.G, (int)blockIdx.x);
      EpiUp<false> E{(const bf16_t*)(ws + WS_SGS), (bf16_t*)(ws + WS_MRG)};
      pg8::gemm_phase<EpiUp<false>, pg8::StaticOrder, true, false>(ring, g, S, E, nullptr, F.wave); }
    VM_WAIT(); __syncthreads();
    { pg8::Gemm g{(const bf16_t*)(ws + WS_YATT), (const bf16_t*)(ws + WS_WUA), DA, DA, DA}; pg8::StaticOrder S; S.init(T, D, F.G, (int)blockIdx.x);
      EpiUp<true> E{(const bf16_t*)(ws + WS_SGA), (bf16_t*)(ws + WS_MRG)};
      pg8::gemm_phase<EpiUp<true>, pg8::StaticOrder, true, false>(ring, g, S, E, nullptr, F.wave); }
}
__device__ __forceinline__ void ph7(PH_ARGS) {
    pg8::Gemm g{(const bf16_t*)(ws + WS_MRG), (const bf16_t*)(ws + WS_WOUT), D, D, D}; pg8::StaticOrder S; S.init(T, D, F.G, (int)blockIdx.x);
    EpiOut E{F.in[0], (bf16_t*)(ws + WS_X1), (bf16_t*)(ws + WS_XG), ws + WS_XGF8, F.in[18], (float*)(ws + WS_SSQ)};
    pg8::gemm_phase<EpiOut, pg8::StaticOrder, true, false>(ring, g, S, E, nullptr, F.wave);
}
__device__ __forceinline__ void ph8(PH_ARGS) {
    pg8::Gemm g{(const bf16_t*)(ws + WS_XG), (const bf16_t*)(ws + WS_WR), D, D, D}; pg8::GroupedOrder S; S.init(T / 256, 1, T / 256, F.G, F.vcu);
    EpiRouter E{(float*)(ws + WS_RLOG)};
    pg8::gemm_phase<EpiRouter, pg8::GroupedOrder, false, false>(ring, g, S, E, nullptr, F.wave);
}
__device__ __forceinline__ void ph10(PH_ARGS) {
    moe_tables(F);
    const LAS int* tst = (const LAS int*)(F.lds + MOE_TST_OFF);
    MoeOrder S{tst, tst[32] * 4, F.G, F.vcu};
    LAS unsigned* rowtab = (LAS unsigned*)(F.lds + ROWTAB_OFF);
    { const unsigned* rowtok = (const unsigned*)(ws + WS_ROWTOK); const unsigned* ecnt = (const unsigned*)(F.ctl + CW_ECNT); pg8::Unit u;
      for (int i = 0; i < ROWTAB_UNITS && S.next(i, u); ++i) { if (F.tid < 256) { const int pos = u.aux2 + F.tid; const unsigned tk = pos < (int)ecnt[u.aux] ? (rowtok[(size_t)u.aux * ROWCAP + pos] >> 1) : 0u; rowtab[i * 256 + F.tid] = tk * (unsigned)D; } } }
    __syncthreads();
    pg8::Gemm g{(const bf16_t*)(ws + WS_XGF8), (const bf16_t*)(ws + WS_W13), D / 2, D / 2, D / 2};
    EpiMoe1 E{(bf16_t*)(ws + WS_HID), (const float*)(ws + WS_ROWRSTD), (const unsigned*)(F.ctl + CW_ECNT), 1.f / WF8_SCALE};
    pg8::gemm_phase<EpiMoe1, MoeOrder, true, true, true>(ring, g, S, E, rowtab, F.wave);
}
__device__ __forceinline__ void ph11(PH_ARGS) {
    moe_tables(F);
    const LAS int* tst = (const LAS int*)(F.lds + MOE_TST_OFF);
    MoeOrder S{tst, tst[32] * 4, F.G, F.vcu};
    pg8::Gemm g{(const bf16_t*)(ws + WS_HID), (const bf16_t*)(ws + WS_W2), DE, DE, DE};
    EpiMoe2 E{(bf16_t*)(ws + WS_Y0), (size_t)(WS_Y1 - WS_Y0), (const unsigned*)(ws + WS_ROWTOK), (const float*)(ws + WS_ROWCOEF), (const unsigned*)(F.ctl + CW_ECNT)};
    pg8::gemm_phase<EpiMoe2, MoeOrder, true, false>(ring, g, S, E, nullptr, F.wave);
}

__global__ void __launch_bounds__(NTHR, 2) fwd_kernel(Args args) {
    extern __shared__ __attribute__((aligned(16))) unsigned char lds_raw[];
    Frame F;
    F.lds = (LAS unsigned char*)lds_raw;
    F.MISC = (volatile LAS unsigned*)(F.lds + MISC_OFF);
    F.wave = __builtin_amdgcn_readfirstlane((int)(threadIdx.x >> 6)); F.lane = lane_id(); F.tid = F.wave * 64 + F.lane;
    F.G = gridDim.x; { const int bx = blockIdx.x; F.vcu = (F.G % 8 == 0) ? (bx % 8) * (F.G / 8) + bx / 8 : bx; }
    F.ws = args.ws; F.ctl = (gu32*)(args.ws + WS_CTL); F.out = args.out;
#pragma unroll
    for (int i = 0; i < 27; ++i) F.in[i] = args.in[i];
    for (int u = F.tid; u < (LDS_BYTES - MOE_TST_OFF) / 4; u += NTHR) ((LAS unsigned*)(F.lds + MOE_TST_OFF))[u] = 0u;
    __syncthreads();
    XcdBarrier bar; bar.bar = (unsigned*)(F.ctl + CW_BAR); bar.x = 0; bar.st = nullptr;
    const int lo = args.ph_lo, hi = args.ph_hi;
    if (hi - lo > 1) bar = xcd_barrier_post((unsigned*)(F.ctl + CW_BAR), F.MISC + 8, F.tid == 0);
#define IN(k) (lo <= (k) && (k) < hi)
#define DUP(k) ((DUP_MASK >> (k)) & 1)
#define SEAM(k) do { if (IN(k) && IN((k) + 1)) xcd_barrier(bar, F.wave == 0 && lane_id() == 0); REFRESH(); } while (0)
#define REFRESH() do { int l_ = lane_id(); asm volatile("" : "+v"(l_)); F.lane = l_; F.tid = F.wave * 64 + l_; } while (0)
    unsigned char* ws = args.ws;
    LAS unsigned char* ring = F.lds;
    if (IN(0)) { p0_prologue(F); if (DUP(0)) p0_prologue(F); }
    SEAM(0);
    if (IN(1)) { ph1(F, ws, ring); if (DUP(1)) ph1(F, ws, ring); }
    SEAM(1);
    if (IN(2)) { ph2(F, ws, ring); if (DUP(2)) ph2(F, ws, ring); }
    SEAM(2);
#ifdef SELFCHECK_PREP
    if (IN(3)) { selfcheck_prep(F); }
#endif
    if (IN(3)) { attn_gate_phase<true>(F); }
    SEAM(3);
    if (IN(4)) { attn_block_phase(F); if (DUP(4)) { __syncthreads(); attn_block_phase(F); } }
    SEAM(4);
    if (IN(5)) { attn_own_phase(F); if (DUP(5)) attn_own_phase(F); }
    SEAM(5);
    if (IN(6)) { ph4(F, ws, ring); if (DUP(6)) ph4(F, ws, ring); }
#ifdef SELFCHECK
    if (IN(6)) { xcd_barrier(bar, F.wave == 0 && lane_id() == 0); REFRESH(); selfcheck_phase(F, SELFCHECK_TOL_ATTN, SELFCHECK_TOL_SSM); }
#endif
    SEAM(6);
    if (IN(7)) { ph5(F, ws, ring); if (DUP(7)) ph5(F, ws, ring); }
    SEAM(7);
    if (IN(8)) { ph6(F, ws, ring); if (DUP(8)) ph6(F, ws, ring); }
    SEAM(8);
    if (IN(9)) { ph7(F, ws, ring); if (DUP(9)) ph7(F, ws, ring); }
    SEAM(9);
    if (IN(10)) { ph8(F, ws, ring); VM_WAIT(); __syncthreads(); routing_phase(F); }
    SEAM(10);
    if (IN(11)) { ph10(F, ws, ring); if (DUP(11)) ph10(F, ws, ring); }
    SEAM(11);
    if (IN(12)) { ph11(F, ws, ring); if (DUP(12)) ph11(F, ws, ring); }
    SEAM(12);
    if (IN(13)) { final_phase(F); if (DUP(13)) final_phase(F); }
#undef IN
#undef DUP
#undef SEAM
#undef REFRESH
}

extern "C" void kernel_launch(void* const* d_in, const int* in_sizes, int n_in, void* d_out, int out_size, void* d_ws, size_t ws_size, hipStream_t stream) {
    static int grid = 0;
    if (grid == 0) {
        if (n_in != 27 || in_sizes[0] != T * D || out_size != T * D || ws_size < WS_END) { fprintf(stderr, "kernel_launch: unexpected shapes (n_in %d, in0 %d, out %d, ws %zu)\n", n_in, n_in > 0 ? in_sizes[0] : -1, out_size, ws_size); grid = -1; return; }
        int dev = 0, cus = 0;
        if (hipGetDevice(&dev) != hipSuccess || hipDeviceGetAttribute(&cus, hipDeviceAttributeMultiprocessorCount, dev) != hipSuccess) { grid = -1; return; }
        if (hipFuncSetAttribute((const void*)fwd_kernel, hipFuncAttributeMaxDynamicSharedMemorySize, LDS_BYTES) != hipSuccess) { fprintf(stderr, "kernel_launch: hipFuncSetAttribute failed\n"); grid = -1; return; }
        (void)hipGetLastError();
        grid = cus;
    }
    if (grid < 0) return;
    (void)hipMemsetAsync((char*)d_ws + WS_CTL, 0, CTL_ZERO_BYTES, stream);
    Args a{};
    for (int i = 0; i < 27; ++i) a.in[i] = (const float*)d_in[i];
    a.out = (float*)d_out; a.ws = (unsigned char*)d_ws;
    if (MK_N_LAUNCHES == 1) { a.ph_lo = 0; a.ph_hi = NPHASE; hipLaunchKernelGGL(fwd_kernel, dim3(grid), dim3(NTHR), LDS_BYTES, stream, a); }
    else { for (int p = 0; p < NPHASE; ++p) { a.ph_lo = p; a.ph_hi = p + 1; hipLaunchKernelGGL(fwd_kernel, dim3(grid), dim3(NTHR), LDS_BYTES, stream, a); } }
}
```

```cpp
#include <hip/hip_runtime.h>
#include <cstdio>
#include <cstdint>

#define LAS __attribute__((address_space(3)))
#define GAS __attribute__((address_space(1)))
typedef unsigned short bf16_t;
typedef short bf16x8 __attribute__((ext_vector_type(8)));
typedef float f32x2 __attribute__((ext_vector_type(2)));
typedef float f32x4 __attribute__((ext_vector_type(4)));
typedef float f32x16 __attribute__((ext_vector_type(16)));
typedef unsigned u32x2 __attribute__((ext_vector_type(2)));
typedef unsigned u32x4 __attribute__((ext_vector_type(4)));
typedef GAS unsigned gu32;
typedef int v4i32 __attribute__((ext_vector_type(4)));
typedef int v8i32 __attribute__((ext_vector_type(8)));
#define RLX_AGENT __ATOMIC_RELAXED, __HIP_MEMORY_SCOPE_AGENT
#define LDS_WAIT() asm volatile("s_waitcnt lgkmcnt(0)" ::: "memory")
#define VM_WAIT() asm volatile("s_waitcnt vmcnt(0)" ::: "memory")

__device__ __forceinline__ unsigned f2bf(float f) { unsigned u = __builtin_bit_cast(unsigned, f); return (u + 0x7fffu + ((u >> 16) & 1u)) >> 16; }
__device__ __forceinline__ unsigned pk2(float lo, float hi) { return f2bf(lo) | (f2bf(hi) << 16); }
__device__ __forceinline__ float bf2f(unsigned short b) { return __builtin_bit_cast(float, (unsigned)b << 16); }
__device__ __forceinline__ float bflo(unsigned w) { return __builtin_bit_cast(float, w << 16); }
__device__ __forceinline__ float bfhi(unsigned w) { return __builtin_bit_cast(float, w & 0xffff0000u); }
__device__ __forceinline__ unsigned cvt_pk_bf16(float lo, float hi) { unsigned r; asm volatile("v_cvt_pk_bf16_f32 %0, %1, %2" : "=v"(r) : "v"(lo), "v"(hi)); return r; }
__device__ __forceinline__ float fast_sigmoid(float x) { return __builtin_amdgcn_rcpf(1.f + __builtin_amdgcn_exp2f(-1.4426950408889634f * x)); }
__device__ __forceinline__ int lane_id() { int l; asm volatile("v_mbcnt_lo_u32_b32 %0, -1, 0\n\tv_mbcnt_hi_u32_b32 %0, -1, %0" : "=v"(l)); return l; }
__device__ __forceinline__ float wave_sum(float v) {
#pragma unroll
    for (int o = 1; o < 64; o <<= 1) v += __shfl_xor(v, o);
    return v;
}
__device__ __forceinline__ float wave_max(float v) {
#pragma unroll
    for (int o = 1; o < 64; o <<= 1) v = fmaxf(v, __shfl_xor(v, o));
    return v;
}

#define XB_TMO      128
#define XB_XCNT(j)  (256  + 64 * (j))
#define XB_XSUB(j)  (1280 + 64 * (j))
#define XB_XGEN(j)  (2304 + 64 * (j))
#define XB_TOP      3328
#define XB_TOPGEN   3392
#define XCD_BAR_WORDS 3456
#define XB_SPIN_CAP (1u << 20)

__device__ __forceinline__ unsigned xb_ld(unsigned* p)              { return __hip_atomic_load(p, __ATOMIC_RELAXED, __HIP_MEMORY_SCOPE_AGENT); }
__device__ __forceinline__ unsigned xb_add(unsigned* p, unsigned v) { return __hip_atomic_fetch_add(p, v, __ATOMIC_RELAXED, __HIP_MEMORY_SCOPE_AGENT); }
__device__ __forceinline__ unsigned xb_xcc_id() { return (unsigned)__builtin_amdgcn_s_getreg((3 << 11) | 20) & 0xFu; }
#define XB_SPIN(cond, bar) do { unsigned _sp = 0; while (cond) { __builtin_amdgcn_s_sleep(1); \
    if ((++_sp & 255u) == 0u) { if (xb_ld(&(bar)[XB_TMO])) break; if (_sp > XB_SPIN_CAP) { atomicAdd(&(bar)[XB_TMO], 1u); break; } } } } while (0)

struct XcdBarrier { unsigned* bar; unsigned x; volatile LAS unsigned* st; };

__device__ __forceinline__ XcdBarrier xcd_barrier_post(unsigned* bar, volatile LAS unsigned* st, bool leader  ) {
    XcdBarrier b; b.bar = bar; b.x = xb_xcc_id(); b.st = st;
    if (leader) (void)xb_add(&bar[XB_XCNT(b.x)], 1u);
    return b;
}
__device__ __forceinline__ void xcd_barrier_complete(unsigned* bar, unsigned x, unsigned& nloc, unsigned& nx) {
    const unsigned G = gridDim.x * gridDim.y * gridDim.z;
    unsigned sum, cnt, mine, sp = 0u;
    for (;;) {
        sum = 0u; cnt = 0u; mine = 0u;
#pragma unroll
        for (unsigned j = 0; j < 16; ++j) { const unsigned c = xb_ld(&bar[XB_XCNT(j)]); sum += c; cnt += (c > 0u) ? 1u : 0u; mine = (j == x) ? c : mine; }
        if (sum == G) break;
        __builtin_amdgcn_s_sleep(1);
        if ((++sp & 255u) == 0u) { if (xb_ld(&bar[XB_TMO])) break; if (sp > XB_SPIN_CAP) { atomicAdd(&bar[XB_TMO], 1u); break; } }
    }
    nloc = mine > 0u ? mine : 1u; nx = cnt > 0u ? cnt : 1u;
}
__device__ __forceinline__ void xcd_barrier(const XcdBarrier& b, bool leader  ) {
    asm volatile("s_waitcnt vmcnt(0)" ::: "memory");
    __syncthreads();
    if (leader) {
        unsigned* bar = b.bar;
        __builtin_amdgcn_s_waitcnt(0);
        unsigned nloc = b.st[0], nx = b.st[1];
        if (nloc == 0u) { xcd_barrier_complete(bar, b.x, nloc, nx); b.st[0] = nloc; b.st[1] = nx; }
        const unsigned old = xb_add(&bar[XB_XSUB(b.x)], 1u);
        const unsigned gen = old / nloc;
        if (old + 1u == (gen + 1u) * nloc) {
            __builtin_amdgcn_fence(__ATOMIC_RELEASE, "agent");
            asm volatile("s_waitcnt vmcnt(0)" ::: "memory");
            const unsigned og = xb_add(&bar[XB_TOP], 1u);
            const unsigned tg = og / nx;
            if (og + 1u == (tg + 1u) * nx) xb_add(&bar[XB_TOPGEN], 1u);
            else XB_SPIN(xb_ld(&bar[XB_TOPGEN]) == tg, bar);
            __builtin_amdgcn_fence(__ATOMIC_ACQUIRE, "agent");
            xb_add(&bar[XB_XGEN(b.x)], 1u);
            asm volatile("s_waitcnt vmcnt(0)" ::: "memory");
        } else {
            XB_SPIN(xb_ld(&bar[XB_XGEN(b.x)]) == gen, bar);
            __builtin_amdgcn_fence(__ATOMIC_ACQUIRE, "agent");
            asm volatile("s_waitcnt vmcnt(0)" ::: "memory");
        }
    }
    __syncthreads();
}

namespace pg8 {
constexpr int BM = 256, BK = 64, HALF = 128, HTB = HALF * BK * 2, STAGE_BYTES = 8 * HTB, NXCD = 8, WGM = 8;
__host__ __device__ __forceinline__ int lds_byte(int r, int c) { const int st = (r >> 4) * 2 + (c >> 5), rr = r & 15, cc = c & 31, ob = rr * 64 + cc * 2; return st * 1024 + (ob ^ (((ob >> 9) & 1) << 5)); }
__host__ __device__ __forceinline__ void stage_rc(int b, int& R, int& C) { const int st = b / 1024, sb = b % 1024, swz = sb ^ (((sb >> 9) & 1) << 5); R = (st >> 1) * 16 + swz / 64; C = (st & 1) * 32 + (swz % 64) / 2; }
__host__ __device__ __forceinline__ int perm32(int rho) { const int n = rho >> 4, i = rho & 15; return 8 * (i >> 2) + 4 * n + (i & 3); }

struct Unit { int pm, pn, pb, aux, aux2; };
struct Gemm { const bf16_t* A; const bf16_t* Bt; int lda, ldb, K; };

struct StaticOrder {
    int nM, nN, nwg, G, c;
    __device__ void init(int M, int N, int G_, int c_) { nM = M / BM; nN = N / BM; nwg = nM * nN; G = G_; c = c_; }
    __device__ bool next(int i, Unit& u) const {
        const long L = (long)i * G + c; if (L >= nwg) return false;
        int wgid = (int)L; { const int q = nwg / NXCD, r = nwg % NXCD, xcd = wgid % NXCD, off = wgid / NXCD; wgid = (xcd < r ? xcd * (q + 1) : r * (q + 1) + (xcd - r) * q) + off; }
        const int nig = WGM * nN, gid = wgid / nig, fm = gid * WGM, gsz = (nM - fm) < WGM ? (nM - fm) : WGM;
        u.pm = fm + ((wgid % nig) % gsz); u.pn = (wgid % nig) / gsz; u.pb = u.pn; u.aux = 0; u.aux2 = 0; return true;
    }
};
struct GroupedOrder {
    int nM, nN, rtpg, G, v;
    __device__ void init(int nM_, int nN_, int rtpg_, int G_, int v_) { nM = nM_; nN = nN_; rtpg = rtpg_; G = G_; v = v_; }
    __device__ bool next(int i, Unit& u) const {
        const int L = i * G + v; if (L >= nM * nN) return false;
        u.pm = L / nN; u.pn = L % nN; u.aux = u.pm / rtpg; u.pb = u.aux * nN + u.pn; u.aux2 = 0; return true;
    }
};

template <class Epi, class Sched, bool ALIGN_EPI, bool GATHER, bool FP8 = false>
__device__ __forceinline__ void gemm_phase(LAS unsigned char* lds, const Gemm g, const Sched& S, const Epi& E, const LAS unsigned* rowtab  , int wid  ) {
    const int lane = lane_id(), tid = wid * 64 + lane, wr = wid >> 2, wc = wid & 3;
    const int K = g.K, nt = K / BK;
    unsigned voffB[2];
#pragma unroll
    for (int i = 0; i < 2; ++i) { int R, C; stage_rc(tid * 16 + i * 8192, R, C); const int Rb = (R & ~31) + perm32(R & 31);
        voffB[i] = (unsigned)(Rb * g.ldb + C) * 2u; }
    const size_t kstep = (size_t)(BK * 2);
    const size_t hstepB = (size_t)HALF * g.ldb * 2, tstepB = 2 * hstepB;
    const size_t tstepA = (size_t)BM * g.lda * 2;
    const unsigned ldsw = (unsigned)wid * 1024u;
    const int aoff = lds_byte(wr * 64 + (lane & 15), (lane >> 4) * 8), boff = lds_byte(wc * 32 + (lane & 15), (lane >> 4) * 8);
    unsigned vAc[2][2];
#define PG8_SETVA(dst, ui_) do { const int t_ = wid * 64 + lane_id(); _Pragma("unroll") for (int i_ = 0; i_ < 2; ++i_) { int R_, C_; stage_rc(t_ * 16 + i_ * 8192, R_, C_); \
        _Pragma("unroll") for (int h_ = 0; h_ < 2; ++h_) dst[h_][i_] = (GATHER ? rowtab[(ui_) * 256 + h_ * 128 + R_] : (unsigned)((h_ * 128 + R_) * g.lda) * 2u) + (unsigned)C_ * 2u; } } while (0)
#define PG8_SA(b, h) (((b) * 2 + (h)) * HTB)
#define PG8_SB(b, h) ((4 + (b) * 2 + (h)) * HTB)
#define PG8_GLDS_S(gbase_, voff_, ldsaddr_) do { unsigned keep_; asm volatile("s_mov_b32 %0, m0\n\ts_mov_b32 m0, %3\n\ts_nop 0\n\tglobal_load_lds_dwordx4 %1, %2\n\ts_mov_b32 m0, %0" \
        : "=&s"(keep_) : "v"(voff_), "s"(gbase_), "s"(ldsaddr_) : "memory"); } while (0)
#define PG8_STAGE(bufoff, gbase, v0, v1) do { \
        if constexpr (FP8) { const unsigned la_ = (unsigned)(uintptr_t)(lds + (bufoff) + ldsw); PG8_GLDS_S((const char*)(gbase), (v0), la_); PG8_GLDS_S((const char*)(gbase), (v1), la_ + 8192u); } else { \
        __builtin_amdgcn_global_load_lds((const unsigned*)((const char*)(gbase) + (v0)), (LAS unsigned*)(lds + (bufoff) + ldsw), 16, 0, 0); \
        __builtin_amdgcn_global_load_lds((const unsigned*)((const char*)(gbase) + (v1)), (LAS unsigned*)(lds + (bufoff) + ldsw + 8192), 16, 0, 0); } } while (0)
#define PG8_STB(bufoff, gbase) PG8_STAGE(bufoff, gbase, voffB[0], voffB[1])
#define PG8_LDA(dst, b, h) do { _Pragma("unroll") for (int m = 0; m < 4; ++m) _Pragma("unroll") for (int k = 0; k < 2; ++k) dst[m][k] = *(const LAS bf16x8*)(lds + PG8_SA(b, h) + aoff + m * 2048 + k * 1024); } while (0)
#define PG8_LDB(dst, b, h) do { _Pragma("unroll") for (int n = 0; n < 2; ++n) _Pragma("unroll") for (int k = 0; k < 2; ++k) dst[n][k] = *(const LAS bf16x8*)(lds + PG8_SB(b, h) + boff + n * 2048 + k * 1024); } while (0)
#define PG8_MMA(ai, bj, At, Bt) do { __builtin_amdgcn_s_setprio(1); \
        if constexpr (FP8) { _Pragma("unroll") for (int m = 0; m < 4; ++m) _Pragma("unroll") for (int n = 0; n < 2; ++n) { \
            const v8i32 a8_ = __builtin_shufflevector(__builtin_bit_cast(v4i32, At[m][0]), __builtin_bit_cast(v4i32, At[m][1]), 0, 1, 2, 3, 4, 5, 6, 7); \
            const v8i32 b8_ = __builtin_shufflevector(__builtin_bit_cast(v4i32, Bt[n][0]), __builtin_bit_cast(v4i32, Bt[n][1]), 0, 1, 2, 3, 4, 5, 6, 7); \
            acc[ai][bj][m][n] = __builtin_amdgcn_mfma_scale_f32_16x16x128_f8f6f4(b8_, a8_, acc[ai][bj][m][n], 0, 0, 0, 0, 0, 0); } } \
        else { _Pragma("unroll") for (int m = 0; m < 4; ++m) _Pragma("unroll") for (int n = 0; n < 2; ++n) _Pragma("unroll") for (int k = 0; k < 2; ++k) \
            acc[ai][bj][m][n] = __builtin_amdgcn_mfma_f32_16x16x32_bf16(Bt[n][k], At[m][k], acc[ai][bj][m][n], 0, 0, 0); } \
        __builtin_amdgcn_s_setprio(0); } while (0)
#define PG8_WAIT_V(n) asm volatile("s_waitcnt vmcnt(" #n ")" ::: "memory")
#define PG8_WAIT_L(n) asm volatile("s_waitcnt lgkmcnt(" #n ")" ::: "memory")
#define PG8_BAR __builtin_amdgcn_s_barrier()
#define PG8_SCHED __builtin_amdgcn_sched_barrier(0)
#define PG8_SCHED8 do { if constexpr (FP8) __builtin_amdgcn_sched_barrier(0); } while (0)
    Unit cur, nxt; int ui = 0;
#define PG8_UNI(u_) do { u_.pm = __builtin_amdgcn_readfirstlane(u_.pm); u_.pn = __builtin_amdgcn_readfirstlane(u_.pn); u_.pb = __builtin_amdgcn_readfirstlane(u_.pb); u_.aux = __builtin_amdgcn_readfirstlane(u_.aux); u_.aux2 = __builtin_amdgcn_readfirstlane(u_.aux2); } while (0)
    if (!S.next(0, cur)) return;
    PG8_UNI(cur);
    f32x4 acc[2][2][4][2];
#pragma unroll
    for (int a = 0; a < 2; ++a)
#pragma unroll
        for (int b = 0; b < 2; ++b)
#pragma unroll
            for (int m = 0; m < 4; ++m)
#pragma unroll
                for (int n = 0; n < 2; ++n) acc[a][b][m][n] = (f32x4){0.f, 0.f, 0.f, 0.f};
    bf16x8 At[4][2], B0[2][2], B1[2][2];
    const char* cA = (const char*)g.A + (GATHER ? (size_t)0 : (size_t)cur.pm * tstepA); const char* cB = (const char*)g.Bt + (size_t)cur.pb * tstepB;
    PG8_SETVA(vAc, 0);
    PG8_STB(PG8_SB(0, 0), cB); PG8_STB(PG8_SB(0, 1), cB + hstepB); PG8_STAGE(PG8_SA(0, 0), cA, vAc[0][0], vAc[0][1]); PG8_STAGE(PG8_SA(0, 1), cA, vAc[1][0], vAc[1][1]);
    if (wr == 1) PG8_BAR;
    PG8_WAIT_V(2); PG8_BAR;
    PG8_STB(PG8_SB(1, 0), cB + kstep); PG8_STAGE(PG8_SA(1, 0), cA + kstep, vAc[0][0], vAc[0][1]); PG8_STB(PG8_SB(1, 1), cB + hstepB + kstep);
    PG8_WAIT_V(6); PG8_BAR;
    for (;;) {
        const bool has_next = S.next(ui + 1, nxt);
        PG8_UNI(nxt);
        const char* nA = GATHER ? cA : (has_next ? (const char*)g.A + (size_t)nxt.pm * tstepA : cA); const char* nB = has_next ? (const char*)g.Bt + (size_t)nxt.pb * tstepB : cB;
        const int nui = has_next ? ui + 1 : ui;
#pragma nounroll
        for (int t = 0; t < nt; t += 2) {
            const bool last = (t == nt - 2);
            const char* a1 = cA + (size_t)(t + 1) * kstep;
            const char* a2 = last ? nA : cA + (size_t)(t + 2) * kstep; const char* b2 = last ? nB : cB + (size_t)(t + 2) * kstep;
            const char* a3 = a2 + kstep; const char* b3 = b2 + kstep;
            unsigned x00 = vAc[0][0], x01 = vAc[0][1], x10 = vAc[1][0], x11 = vAc[1][1];
            if (GATHER) { if (last) { unsigned vN_[2][2]; PG8_SETVA(vN_, nui); x00 = vN_[0][0]; x01 = vN_[0][1]; x10 = vN_[1][0]; x11 = vN_[1][1]; } }
            PG8_LDB(B0, 0, 0); PG8_LDB(B1, 0, 1); PG8_SCHED; PG8_LDA(At, 0, 0); PG8_STAGE(PG8_SA(1, 1), a1, vAc[1][0], vAc[1][1]);
            PG8_WAIT_V(8); PG8_WAIT_L(0); PG8_BAR; PG8_SCHED8; PG8_MMA(0, 0, At, B0); PG8_MMA(0, 1, At, B1); PG8_SCHED8; PG8_BAR; PG8_SCHED;
            PG8_LDA(At, 0, 1); PG8_STB(PG8_SB(0, 0), b2); PG8_STB(PG8_SB(0, 1), b2 + hstepB); PG8_STAGE(PG8_SA(0, 0), a2, x00, x01);
            PG8_WAIT_V(8); PG8_WAIT_L(0); PG8_BAR; PG8_SCHED8; PG8_MMA(1, 0, At, B0); PG8_MMA(1, 1, At, B1); PG8_SCHED8; PG8_BAR; PG8_SCHED;
            PG8_LDB(B0, 1, 0); PG8_LDB(B1, 1, 1); PG8_SCHED; PG8_LDA(At, 1, 0); PG8_STAGE(PG8_SA(0, 1), a2, x10, x11);
            PG8_WAIT_V(8); PG8_WAIT_L(0); PG8_BAR; PG8_SCHED8; PG8_MMA(0, 0, At, B0); PG8_MMA(0, 1, At, B1); PG8_SCHED8; PG8_BAR; PG8_SCHED;
            PG8_LDA(At, 1, 1); PG8_STB(PG8_SB(1, 0), b3); PG8_STB(PG8_SB(1, 1), b3 + hstepB); PG8_STAGE(PG8_SA(1, 0), a3, x00, x01);
            PG8_WAIT_V(8); PG8_WAIT_L(0); PG8_BAR; PG8_SCHED8; PG8_MMA(1, 0, At, B0); PG8_MMA(1, 1, At, B1); PG8_SCHED8; PG8_BAR; PG8_SCHED;
        }
        if constexpr (ALIGN_EPI) { if (wr == 0) PG8_BAR; }
        { int l_ = lane_id(); asm volatile("" : "+v"(l_));
          E(acc, cur, wr, wc, l_ & 15, l_ >> 4); }
        if (!has_next) break;
#pragma unroll
        for (int a = 0; a < 2; ++a)
#pragma unroll
            for (int b = 0; b < 2; ++b)
#pragma unroll
                for (int m = 0; m < 4; ++m)
#pragma unroll
                    for (int n = 0; n < 2; ++n) acc[a][b][m][n] = (f32x4){0.f, 0.f, 0.f, 0.f};
        cur = nxt; cA = nA; cB = nB; ++ui;
        if (GATHER) { PG8_SETVA(vAc, ui); }
        if constexpr (ALIGN_EPI) { if (wr == 1) PG8_BAR; }
    }
    PG8_WAIT_V(0);
    if constexpr (!ALIGN_EPI) { if (wr == 0) PG8_BAR; }
    PG8_BAR;
#undef PG8_SETVA
#undef PG8_UNI
#undef PG8_SA
#undef PG8_SB
#undef PG8_STAGE
#undef PG8_GLDS_S
#undef PG8_STB
#undef PG8_LDA
#undef PG8_LDB
#undef PG8_MMA
#undef PG8_WAIT_V
#undef PG8_WAIT_L
#undef PG8_BAR
#undef PG8_SCHED
#undef PG8_SCHED8
}
}
constexpr int NWAVES = 8, NTHR = 512;
constexpr int BATCH = 8, SEQ = 8192, T = BATCH * SEQ, D = 1024, DIN = 4096;
constexpr int DS = 512, DA = 512, NH = 8, HD = 64, NBLK = SEQ / 256;
constexpr int SG = 32, SHC = 16, SP = 64, SL = 32, SKU = SL * SHC  , SKS = 2 * SP  , SKY = SKU + SKS  , SROWS = T / SL  ;
constexpr int NE = 32, DE = 512;
constexpr float RMS_EPS = 1e-6f;
constexpr float LOG2E = 1.4426950408889634f;
constexpr float QSCALE = 0.125f * LOG2E;
constexpr float WF8_SCALE = 32.f;
constexpr int ROWCAP = T;
constexpr int HID_ROWS = 2 * T + NE * 256;

constexpr size_t MiB = 1u << 20;
constexpr size_t WS_CTL = 0, CTL_ZERO_BYTES = 1 * MiB;
constexpr size_t WS_WIN = 1 * MiB;
constexpr size_t WS_WGLU = 9 * MiB;
constexpr size_t WS_WUS = 10 * MiB;
constexpr size_t WS_WUA = 11 * MiB;
constexpr size_t WS_WOUT = 12 * MiB;
constexpr size_t WS_WR = 14 * MiB;
constexpr size_t WS_KMEAN = 15 * MiB;
constexpr size_t WS_SSMW = 16 * MiB;
constexpr size_t WS_SSMT = 24 * MiB;
constexpr size_t WS_W13 = 44 * MiB;
constexpr size_t WS_W2 = 108 * MiB;
constexpr size_t WS_A0 = 140 * MiB;
constexpr size_t WS_UP = 276 * MiB;
constexpr size_t WS_Q = 356 * MiB;
constexpr size_t WS_SSQ = 404 * MiB;
constexpr size_t WS_RLOG = 408 * MiB;
constexpr size_t WS_K = 420 * MiB;
constexpr size_t WS_ROWTOK = 428 * MiB, WS_ROWCOEF = 436 * MiB, WS_ROWRSTD = 444 * MiB;
constexpr size_t WS_GACT = 420 * MiB;
constexpr size_t WS_V = 484 * MiB;
constexpr size_t WS_YSSM = 484 * MiB;
constexpr size_t WS_SGS = 548 * MiB;
constexpr size_t WS_SGA = 676 * MiB;
constexpr size_t WS_E = 804 * MiB;
constexpr size_t WS_YATT = 836 * MiB;
constexpr size_t WS_PART0 = 420 * MiB, WS_PART1 = 484 * MiB, WS_PART2 = 932 * MiB;
constexpr size_t WS_QLIST = 900 * MiB;
constexpr size_t WS_PL = 268 * MiB;
constexpr size_t WS_MQ = 996 * MiB;
constexpr size_t WS_H1F8 = 836 * MiB;
constexpr size_t WS_WINF8 = 900 * MiB;
constexpr size_t WS_XGF8 = 836 * MiB;
constexpr size_t WS_SEGC = 998 * MiB;
constexpr size_t WS_END = 999 * MiB;
constexpr size_t WS_KFRAG = WS_A0, WS_VFRAG = WS_A0 + 64 * MiB, WS_H1 = WS_A0, WS_MRG = WS_A0, WS_HID = WS_A0;
constexpr size_t WS_X1 = WS_SGS, WS_XG = WS_UP, WS_Y0 = WS_UP, WS_Y1 = WS_E;
static_assert(WS_GACT + 64 * MiB <= WS_YSSM && WS_YSSM + 64 * MiB <= WS_SGS, "map");
static_assert(WS_HID + (size_t)HID_ROWS * DE * 2 <= WS_UP, "hid fits");
static_assert(WS_RLOG + (size_t)T * 72 * 4 <= WS_ROWTOK, "rlog fits");

constexpr int CW_TMO = 0, CW_CODE = 1;
constexpr int CW_BAR = 4096;
constexpr int CW_ECNT = 8192;
constexpr int CW_GCNT = 12288;

constexpr int RING_BYTES = 131072;
constexpr int ROWTAB_OFF = RING_BYTES, ROWTAB_UNITS = 12, ROWTAB_BYTES = 25 * 1024;
constexpr int MOE_TST_OFF = ROWTAB_OFF + ROWTAB_BYTES;
constexpr int MISC_OFF = MOE_TST_OFF + 512;
constexpr int LDS_BYTES = MISC_OFF + 128;
static_assert(LDS_BYTES <= 163840, "LDS");

struct Frame {
    LAS unsigned char* lds;
    volatile LAS unsigned* MISC;
    gu32* ctl;
    unsigned char* ws;
    int tid, lane, wave, vcu, G;
    const float* in[27];
    float* out;
};

__device__ __forceinline__ unsigned pk4_fp8(float a, float b, float c, float d) { int w = 0; w = __builtin_amdgcn_cvt_pk_fp8_f32(a, b, w, false); w = __builtin_amdgcn_cvt_pk_fp8_f32(c, d, w, true); return (unsigned)w; }
#define EPI_LOOP_BEGIN  _Pragma("unroll") for (int ai = 0; ai < 2; ++ai) _Pragma("unroll") for (int m = 0; m < 4; ++m) { const int rl = ai * 128 + wr * 64 + m * 16 + fr; _Pragma("unroll") for (int bj = 0; bj < 2; ++bj) { const int cl = bj * 128 + wc * 32 + 8 * fq; \
        const f32x4 a0 = acc[ai][bj][m][0], a1 = acc[ai][bj][m][1]; (void)rl; (void)cl; (void)a0; (void)a1;
#define EPI_LOOP_END } }
typedef const f32x4 (&AccRef)[2][2][4][2];
__device__ __forceinline__ u32x4 pack8(f32x4 a, f32x4 b) { u32x4 w; w.x = cvt_pk_bf16(a[0], a[1]); w.y = cvt_pk_bf16(a[2], a[3]); w.z = cvt_pk_bf16(b[0], b[1]); w.w = cvt_pk_bf16(b[2], b[3]); return w; }
__device__ __forceinline__ void unpack8(u32x4 w, f32x4& a, f32x4& b) { a = (f32x4){bflo(w.x), bfhi(w.x), bflo(w.y), bfhi(w.y)}; b = (f32x4){bflo(w.z), bfhi(w.z), bflo(w.w), bfhi(w.w)}; }

template <int PART  > struct EpiProj {
    unsigned char* ws; const float* b_gate; int pn_off; float ascale;
    __device__ __forceinline__ void operator()(AccRef acc, const pg8::Unit& u, int wr, int wc, int fr, int fq) const {
        const int pn = u.pn + pn_off; const int row0 = u.pm * 256;
        if (PART == 0) {
            bf16_t* Uperm = (bf16_t*)(ws + WS_UP);
            EPI_LOOP_BEGIN
                const int row = row0 + rl, col = pn * 256 + cl;
                bf16_t* dst = Uperm + (size_t)(col >> 4) * ((size_t)SROWS * SKY) + (size_t)(row >> 5) * SKY + (row & 31) * 16 + (col & 15);
                *(u32x4*)dst = pack8(a0 * ascale, a1 * ascale);
            EPI_LOOP_END
        } else if (pn < 8) {
            const size_t boff = pn < 4 ? WS_Q : (pn < 6 ? WS_K : WS_V);
            bf16_t* base = (bf16_t*)(ws + boff); const float sc = pn < 4 ? QSCALE : 1.f; const int c0 = (pn & 1) * 256;
            EPI_LOOP_BEGIN
                const int row = row0 + rl, col = c0 + cl;
                *(u32x4*)(base + (size_t)row * 512 + col) = pack8(a0 * (sc * ascale), a1 * (sc * ascale));
            EPI_LOOP_END
        } else {
            const size_t boff = pn < 12 ? WS_SGS : WS_SGA;
            bf16_t* base = (bf16_t*)(ws + boff); const int c0 = ((pn - 8) & 3) * 256; const float* bg = b_gate + (pn - 8) * 256;
            EPI_LOOP_BEGIN
                const int row = row0 + rl, col = c0 + cl;
                const f32x4 b0 = *(const f32x4*)(bg + cl), b1 = *(const f32x4*)(bg + cl + 4);
                f32x4 s0, s1;
#pragma unroll
                for (int e = 0; e < 4; ++e) { s0[e] = fast_sigmoid(a0[e] * ascale + b0[e]); s1[e] = fast_sigmoid(a1[e] * ascale + b1[e]); }
                *(u32x4*)(base + (size_t)row * 1024 + col) = pack8(s0, s1);
            EPI_LOOP_END
        }
    }
};
struct EpiSsmE {
    float* E;
    __device__ __forceinline__ void operator()(AccRef acc, const pg8::Unit& u, int wr, int wc, int fr, int fq) const {
        EPI_LOOP_BEGIN
            if (bj == 0) { float* dst = E + (size_t)(u.pm * 256 + rl) * 128 + cl; *(f32x4*)dst = a0; *(f32x4*)(dst + 4) = a1; }
        EPI_LOOP_END
    }
};
__device__ __forceinline__ float gelu_tanh(float x) { const float z = 1.5957691216057308f * (x + 0.044715f * x * x * x); return x * fast_sigmoid(z); }
struct EpiSsmY {
    bf16_t* Gact;
    __device__ __forceinline__ void operator()(AccRef acc, const pg8::Unit& u, int wr, int wc, int fr, int fq) const {
        const int g = u.aux;
        EPI_LOOP_BEGIN
            const int rg = (u.pm & 7) * 256 + rl;
            const int colg = u.pn * 256 + cl;
            const int tok = (rg >> 8) * SEQ + (rg & 255) * SL + (colg >> 4);
            f32x4 y0, y1;
#pragma unroll
            for (int e = 0; e < 4; ++e) { y0[e] = gelu_tanh(a0[e]); y1[e] = gelu_tanh(a1[e]); }
            *(u32x4*)(Gact + (size_t)tok * DS + g * 16 + (colg & 15)) = pack8(y0, y1);
        EPI_LOOP_END
    }
};
#define EPI_SBAR __builtin_amdgcn_sched_barrier(0)
#define EPI_G(g_) const int ai = (g_) >> 2, m = (g_) & 3; const int rl = ai * 128 + wr * 64 + m * 16 + fr; (void)rl
struct EpiGlu {
    const bf16_t* Gact; bf16_t* Yssm; const float* b_glu;
    __device__ __forceinline__ void operator()(AccRef acc, const pg8::Unit& u, int wr, int wc, int fr, int fq) const {
        const int col0 = u.pn * 256 + wc * 32 + 8 * fq; const size_t rowb = (size_t)u.pm * 256;
        f32x4 bv[2][2]; u32x4 gv[8][2];
#pragma unroll
        for (int bj = 0; bj < 2; ++bj) { bv[bj][0] = *(const f32x4*)(b_glu + col0 + bj * 128); bv[bj][1] = *(const f32x4*)(b_glu + col0 + bj * 128 + 4); }
#pragma unroll
        for (int g = 0; g < 8; ++g) { EPI_G(g);
#pragma unroll
            for (int bj = 0; bj < 2; ++bj) gv[g][bj] = *(const u32x4*)(Gact + (rowb + rl) * DS + col0 + bj * 128); }
        EPI_SBAR;
#pragma unroll
        for (int g = 0; g < 8; ++g) { EPI_G(g);
#pragma unroll
            for (int bj = 0; bj < 2; ++bj) { f32x4 g0, g1; unpack8(gv[g][bj], g0, g1); const f32x4 a0 = acc[ai][bj][m][0], a1 = acc[ai][bj][m][1]; f32x4 y0, y1;
#pragma unroll
                for (int e = 0; e < 4; ++e) { y0[e] = g0[e] * fast_sigmoid(a0[e] + bv[bj][0][e]); y1[e] = g1[e] * fast_sigmoid(a1[e] + bv[bj][1][e]); }
                *(u32x4*)(Yssm + (rowb + rl) * DS + col0 + bj * 128) = pack8(y0, y1); } }
    }
};
template <bool SECOND> struct EpiUp {
    const bf16_t* SG; bf16_t* Mrg;
    __device__ __forceinline__ void operator()(AccRef acc, const pg8::Unit& u, int wr, int wc, int fr, int fq) const {
        const size_t base = (size_t)u.pm * 256 * D + u.pn * 256 + wc * 32 + 8 * fq;
        u32x4 sv[2][2][2], mv[2][2][2];
#define UP_LOAD(buf_, bt_) do { _Pragma("unroll") for (int gi_ = 0; gi_ < 2; ++gi_) { EPI_G(2 * (bt_) + gi_); _Pragma("unroll") for (int bj = 0; bj < 2; ++bj) { const size_t off = base + (size_t)rl * D + bj * 128; \
            sv[buf_][gi_][bj] = *(const u32x4*)(SG + off); if (SECOND) mv[buf_][gi_][bj] = *(const u32x4*)(Mrg + off); } } } while (0)
#define UP_PROC(buf_, bt_) do { _Pragma("unroll") for (int gi_ = 0; gi_ < 2; ++gi_) { EPI_G(2 * (bt_) + gi_); _Pragma("unroll") for (int bj = 0; bj < 2; ++bj) { const size_t off = base + (size_t)rl * D + bj * 128; \
            f32x4 s0, s1; unpack8(sv[buf_][gi_][bj], s0, s1); f32x4 y0 = s0 * acc[ai][bj][m][0], y1 = s1 * acc[ai][bj][m][1]; \
            if (SECOND) { f32x4 p0, p1; unpack8(mv[buf_][gi_][bj], p0, p1); y0 += p0; y1 += p1; } \
            *(u32x4*)(Mrg + off) = pack8(y0, y1); } } } while (0)
        UP_LOAD(0, 0); UP_LOAD(1, 1); EPI_SBAR;
        UP_PROC(0, 0); UP_LOAD(0, 2); EPI_SBAR;
        UP_PROC(1, 1); UP_LOAD(1, 3); EPI_SBAR;
        UP_PROC(0, 2); EPI_SBAR;
        UP_PROC(1, 3);
#undef UP_LOAD
#undef UP_PROC
    }
};
struct EpiOut {
    const float* x; bf16_t* X1; bf16_t* XG; unsigned char* XG8; const float* g2; float* SSQ;
    __device__ __forceinline__ void operator()(AccRef acc, const pg8::Unit& u, int wr, int wc, int fr, int fq) const {
        const int col0 = u.pn * 256 + wc * 32 + 8 * fq; const size_t base = (size_t)u.pm * 256 * D + col0;
        f32x4 wv[2][2];
#pragma unroll
        for (int bj = 0; bj < 2; ++bj) { wv[bj][0] = *(const f32x4*)(g2 + col0 + bj * 128); wv[bj][1] = *(const f32x4*)(g2 + col0 + bj * 128 + 4); }
        f32x4 xv[2][2][2][2];
#define OUT_LOAD(buf_, bt_) do { _Pragma("unroll") for (int gi_ = 0; gi_ < 2; ++gi_) { EPI_G(2 * (bt_) + gi_); _Pragma("unroll") for (int bj = 0; bj < 2; ++bj) { const size_t off = base + (size_t)rl * D + bj * 128; \
            xv[buf_][gi_][bj][0] = *(const f32x4*)(x + off); xv[buf_][gi_][bj][1] = *(const f32x4*)(x + off + 4); } } } while (0)
#define OUT_PROC(buf_, bt_) do { _Pragma("unroll") for (int gi_ = 0; gi_ < 2; ++gi_) { EPI_G(2 * (bt_) + gi_); float ss = 0.f; _Pragma("unroll") for (int bj = 0; bj < 2; ++bj) { const size_t off = base + (size_t)rl * D + bj * 128; \
            const f32x4 x0 = xv[buf_][gi_][bj][0] + acc[ai][bj][m][0], x1 = xv[buf_][gi_][bj][1] + acc[ai][bj][m][1]; \
            *(u32x4*)(X1 + off) = pack8(x0, x1); \
            ss += (x0[0] * x0[0] + x0[1] * x0[1]) + (x0[2] * x0[2] + x0[3] * x0[3]) + (x1[0] * x1[0] + x1[1] * x1[1]) + (x1[2] * x1[2] + x1[3] * x1[3]); \
            const f32x4 y0 = x0 * wv[bj][0], y1 = x1 * wv[bj][1]; \
            *(u32x4*)(XG + off) = pack8(y0, y1); *(u32x2*)(XG8 + off) = (u32x2){pk4_fp8(y0[0], y0[1], y0[2], y0[3]), pk4_fp8(y1[0], y1[1], y1[2], y1[3])}; } \
            ss += __shfl_xor(ss, 16); ss += __shfl_xor(ss, 32); \
            SSQ[((size_t)u.pm * 256 + rl) * 16 + u.pn * 4 + wc] = ss; } } while (0)
        OUT_LOAD(0, 0); OUT_LOAD(1, 1); EPI_SBAR;
        OUT_PROC(0, 0); OUT_LOAD(0, 2); EPI_SBAR;
        OUT_PROC(1, 1); OUT_LOAD(1, 3); EPI_SBAR;
        OUT_PROC(0, 2); EPI_SBAR;
        OUT_PROC(1, 3);
#undef OUT_LOAD
#undef OUT_PROC
    }
};
struct EpiRouter {
    float* Rlog;
    __device__ __forceinline__ void operator()(AccRef acc, const pg8::Unit& u, int wr, int wc, int fr, int fq) const {
        EPI_LOOP_BEGIN
            if (bj == 0 && cl < 72) { float* dst = Rlog + (size_t)(u.pm * 256 + rl) * 72 + cl; *(f32x4*)dst = a0; *(f32x4*)(dst + 4) = a1; }
        EPI_LOOP_END
    }
};
struct EpiMoe1 {
    bf16_t* Hid; const float* rowrstd; const unsigned* ecnt; float ascale;
    __device__ __forceinline__ void operator()(AccRef acc, const pg8::Unit& u, int wr, int wc, int fr, int fq) const {
        const int e = u.aux, cnt = (int)ecnt[e]; float rsv[8];
#pragma unroll
        for (int g = 0; g < 8; ++g) { EPI_G(g); const int pos = u.aux2 + rl; rsv[g] = rowrstd[(size_t)e * ROWCAP + (pos < cnt ? pos : 0)] * ascale; }
        EPI_SBAR;
#pragma unroll
        for (int g = 0; g < 8; ++g) { EPI_G(g); const int pos = u.aux2 + rl;
            if (pos < cnt) { const float rs = rsv[g]; f32x4 h0, h1;
#pragma unroll
                for (int k = 0; k < 4; ++k) { const float p = acc[ai][0][m][0][k] * rs, q = acc[ai][1][m][0][k] * rs; h0[k] = p * fast_sigmoid(p) * q;
                    const float p2 = acc[ai][0][m][1][k] * rs, q2 = acc[ai][1][m][1][k] * rs; h1[k] = p2 * fast_sigmoid(p2) * q2; }
                *(u32x4*)(Hid + (size_t)(u.pm * 256 + rl) * DE + u.pn * 128 + wc * 32 + 8 * fq) = pack8(h0, h1); } }
    }
};
struct EpiMoe2 {
    bf16_t* Y0; size_t ydelta; const unsigned* rowtok; const float* rowcoef; const unsigned* ecnt;
    __device__ __forceinline__ void operator()(AccRef acc, const pg8::Unit& u, int wr, int wc, int fr, int fq) const {
        const int e = u.aux, cnt = (int)ecnt[e]; unsigned tkv[8]; float cfv[8];
#pragma unroll
        for (int g = 0; g < 8; ++g) { EPI_G(g); const int pos = u.aux2 + rl; const size_t ri = (size_t)e * ROWCAP + (pos < cnt ? pos : 0); tkv[g] = rowtok[ri]; cfv[g] = rowcoef[ri]; }
        EPI_SBAR;
#pragma unroll
        for (int g = 0; g < 8; ++g) { EPI_G(g); const int pos = u.aux2 + rl;
            if (pos < cnt) { const unsigned tk = tkv[g]; const float cf = cfv[g];
                bf16_t* dst = (bf16_t*)((unsigned char*)Y0 + (size_t)(tk & 1u) * ydelta) + (size_t)(tk >> 1) * D + u.pn * 256 + wc * 32 + 8 * fq;
#pragma unroll
                for (int bj = 0; bj < 2; ++bj) *(u32x4*)(dst + bj * 128) = pack8(acc[ai][bj][m][0] * cf, acc[ai][bj][m][1] * cf); } }
    }
};
__device__ __forceinline__ void transpose_item(const float* W, int N, int k0, int n0, bf16_t* WT, size_t drow0, int ldo, LAS float* scr, int lane) {
    float tv[32];
#pragma unroll
    for (int i = 0; i < 32; ++i) tv[i] = W[(size_t)(k0 + 2 * i + (lane >> 5)) * N + n0 + (lane & 31)];
#pragma unroll
    for (int i = 0; i < 32; ++i) scr[(2 * i + (lane >> 5)) * 33 + (lane & 31)] = tv[i];
    LDS_WAIT(); asm volatile("" ::: "memory");
    const int c = lane & 7;
#pragma unroll
    for (int j = 0; j < 4; ++j) { const int n = (lane >> 3) + 8 * j; const LAS float* s = scr + (8 * c) * 33 + n;
        u32x4 o; o.x = pk2(s[0 * 33], s[1 * 33]); o.y = pk2(s[2 * 33], s[3 * 33]); o.z = pk2(s[4 * 33], s[5 * 33]); o.w = pk2(s[6 * 33], s[7 * 33]);
        *(u32x4*)(WT + (drow0 + n) * (size_t)ldo + k0 + 8 * c) = o; }
    LDS_WAIT(); asm volatile("" ::: "memory");
}
__device__ __forceinline__ void transpose_item_f8(const float* W, int N, int k0, int n0, unsigned char* WT8, size_t drow0, int ldo, float scale, LAS float* scr, int lane) {
    float tv[32];
#pragma unroll
    for (int i = 0; i < 32; ++i) tv[i] = W[(size_t)(k0 + 2 * i + (lane >> 5)) * N + n0 + (lane & 31)];
#pragma unroll
    for (int i = 0; i < 32; ++i) scr[(2 * i + (lane >> 5)) * 33 + (lane & 31)] = tv[i] * scale;
    LDS_WAIT(); asm volatile("" ::: "memory");
    const int c = lane & 3;
#pragma unroll
    for (int j = 0; j < 2; ++j) { const int n = (lane >> 2) + 16 * j; const LAS float* s = scr + (16 * c) * 33 + n;
        u32x4 o; o.x = pk4_fp8(s[0 * 33], s[1 * 33], s[2 * 33], s[3 * 33]); o.y = pk4_fp8(s[4 * 33], s[5 * 33], s[6 * 33], s[7 * 33]);
        o.z = pk4_fp8(s[8 * 33], s[9 * 33], s[10 * 33], s[11 * 33]); o.w = pk4_fp8(s[12 * 33], s[13 * 33], s[14 * 33], s[15 * 33]);
        *(u32x4*)(WT8 + (drow0 + n) * (size_t)ldo + k0 + 16 * c) = o; }
    LDS_WAIT(); asm volatile("" ::: "memory");
}
template <int NR> __device__ __forceinline__ void rms_rows_to_bf16(int lane, const float* xrow, const float* g, bf16_t* orow, unsigned char* orow8) {
    f32x4 v[NR][4]; float s[NR];
#pragma unroll
    for (int r = 0; r < NR; ++r) { const f32x4* xr = (const f32x4*)(xrow + (size_t)r * D) + lane;
#pragma unroll
        for (int j = 0; j < 4; ++j) v[r][j] = xr[64 * j]; }
    const f32x4* gr = (const f32x4*)g + lane; f32x4 wv[4];
#pragma unroll
    for (int j = 0; j < 4; ++j) wv[j] = gr[64 * j];
#pragma unroll
    for (int r = 0; r < NR; ++r) { float a = 0.f;
#pragma unroll
        for (int j = 0; j < 4; ++j) a += (v[r][j].x * v[r][j].x + v[r][j].y * v[r][j].y) + (v[r][j].z * v[r][j].z + v[r][j].w * v[r][j].w);
        s[r] = a; }
#pragma unroll
    for (int o = 1; o < 64; o <<= 1) {
#pragma unroll
        for (int r = 0; r < NR; ++r) s[r] += __shfl_xor(s[r], o); }
#pragma unroll
    for (int r = 0; r < NR; ++r) { const float rstd = 1.f / sqrtf(s[r] * (1.f / D) + RMS_EPS); unsigned long long* o8 = (unsigned long long*)(orow + (size_t)r * D) + lane;
#pragma unroll
        for (int j = 0; j < 4; ++j) { const float y0 = v[r][j].x * rstd * wv[j].x, y1 = v[r][j].y * rstd * wv[j].y, y2 = v[r][j].z * rstd * wv[j].z, y3 = v[r][j].w * rstd * wv[j].w;
            o8[64 * j] = (unsigned long long)pk2(y0, y1) | ((unsigned long long)pk2(y2, y3) << 32);
            ((unsigned*)(orow8 + (size_t)r * D))[lane + 64 * j] = pk4_fp8(y0, y1, y2, y3); } }
}
__device__ __forceinline__ void cpow(float lr, float li, float step, float dl, float& ar, float& ai) {
    const float mag = __expf(dl * lr * step); const float rev = dl * (li * step * 0.15915494309189535f); const float fr = rev - floorf(rev);
    ar = mag * __builtin_amdgcn_cosf(fr); ai = mag * __builtin_amdgcn_sinf(fr);
}
__device__ __forceinline__ void ssm_gen(Frame& F, int g, int sl) {
    LAS float* AP = (LAS float*)(F.lds); LAS float* BB = AP + 33 * 64 * 2; LAS float* CC = BB + 2048; LAS float* KT = CC + 2048;
    const float* lam_re = F.in[4] + g * SP; const float* lam_im = F.in[5] + g * SP; const float step = __expf(F.in[6][g]);
    const float* b_re = F.in[7] + g * SP * SHC; const float* b_im = F.in[8] + g * SP * SHC; const float* c_re = F.in[9] + g * SHC * SP; const float* c_im = F.in[10] + g * SHC * SP; const float* dd = F.in[11] + g * SHC;
    bf16_t* BT = (bf16_t*)(F.ws + WS_SSMT) + (size_t)g * 512 * SKY; bf16_t* BW = (bf16_t*)(F.ws + WS_SSMW) + (size_t)g * 256 * SKU;
    const int tid = F.tid;
    for (int idx = tid; idx < 33 * 64; idx += NTHR) { const int dl = idx >> 6, p = idx & 63; float ar, ai; cpow(lam_re[p], lam_im[p], step, (float)dl, ar, ai); AP[idx * 2] = ar; AP[idx * 2 + 1] = ai; }
    for (int idx = tid; idx < 1024; idx += NTHR) { const int ho = idx >> 6, p = idx & 63; CC[idx * 2] = c_re[ho * 64 + p]; CC[idx * 2 + 1] = c_im[ho * 64 + p]; }
    __syncthreads();
    for (int idx = tid; idx < 1024; idx += NTHR) { const int p = idx >> 4, h = idx & 15; const float ar = AP[(64 + p) * 2], ai = AP[(64 + p) * 2 + 1];
        const float lr = lam_re[p], li = lam_im[p], nr = ar - 1.f, ni = ai, den = lr * lr + li * li, cr = (nr * lr + ni * li) / den, ci = (ni * lr - nr * li) / den;
        const float br = b_re[p * 16 + h], bi = b_im[p * 16 + h]; BB[idx * 2] = cr * br - ci * bi; BB[idx * 2 + 1] = cr * bi + ci * br; }
    __syncthreads();
    for (int idx = tid; idx < 1024; idx += NTHR) { const int dl = idx >> 5, hl = (idx >> 4) & 1, hi = idx & 15, ho = 2 * sl + hl; float s = 0.f;
        for (int p = 0; p < 64; ++p) { const float ar = AP[(dl * 64 + p) * 2], ai = AP[(dl * 64 + p) * 2 + 1], br = BB[(p * 16 + hi) * 2], bi = BB[(p * 16 + hi) * 2 + 1];
            const float zr = ar * br - ai * bi, zi = ar * bi + ai * br; s += CC[(ho * 64 + p) * 2] * zr - CC[(ho * 64 + p) * 2 + 1] * zi; }
        if (dl == 0 && ho == hi) s += dd[ho];
        KT[idx] = s; }
    __syncthreads();
    for (int v = tid; v < 64 * 80; v += NTHR) { const int nl = v / 80, kv = (v % 80) * 8, tau = nl >> 1, hl = nl & 1, ho = 2 * sl + hl, n = tau * 16 + ho; float val[8];
        if (kv < 512) { const int sg = kv >> 4, hi0 = kv & 15;
#pragma unroll
            for (int e = 0; e < 8; ++e) val[e] = (tau >= sg) ? KT[((tau - sg) * 2 + hl) * 16 + hi0 + e] : 0.f; }
        else { const int kk = kv - 512;
#pragma unroll
            for (int e = 0; e < 8; ++e) { const int p = (kk + e) >> 1, ri = (kk + e) & 1; const float ar = AP[((tau + 1) * 64 + p) * 2], ai = AP[((tau + 1) * 64 + p) * 2 + 1], cre = CC[(ho * 64 + p) * 2], cim = CC[(ho * 64 + p) * 2 + 1];
                val[e] = ri == 0 ? (cre * ar - cim * ai) : -(cre * ai + cim * ar); } }
        u32x4 o; o.x = pk2(val[0], val[1]); o.y = pk2(val[2], val[3]); o.z = pk2(val[4], val[5]); o.w = pk2(val[6], val[7]);
        *(u32x4*)(BT + (size_t)n * SKY + kv) = o; }
    for (int v = tid; v < 32 * 64; v += NTHR) { const int nl = v >> 6, kv = (v & 63) * 8; float val[8];
        const bool real = nl < 16; const int n = real ? 16 * sl + nl : 128 + 16 * sl + (nl - 16);
        if (real) { const int p = n >> 1, ri = n & 1, sg = kv >> 4, hi0 = kv & 15; const float ar = AP[((31 - sg) * 64 + p) * 2], ai = AP[((31 - sg) * 64 + p) * 2 + 1];
#pragma unroll
            for (int e = 0; e < 8; ++e) { const float br = BB[(p * 16 + hi0 + e) * 2], bi = BB[(p * 16 + hi0 + e) * 2 + 1]; val[e] = ri == 0 ? (ar * br - ai * bi) : (ar * bi + ai * br); } }
        else {
#pragma unroll
            for (int e = 0; e < 8; ++e) val[e] = 0.f; }
        u32x4 o; o.x = pk2(val[0], val[1]); o.y = pk2(val[2], val[3]); o.z = pk2(val[4], val[5]); o.w = pk2(val[6], val[7]);
        *(u32x4*)(BW + (size_t)n * SKU + kv) = o; }
    __syncthreads();
}
__device__ __forceinline__ void p0_prologue(Frame& F) {
    for (int it = F.vcu; it < SG * 8; it += F.G) ssm_gen(F, it >> 3, it & 7);
    LAS float* scr = (LAS float*)(F.lds + F.wave * 16384);
    const int gw = F.vcu * NWAVES + F.wave, NGW = F.G * NWAVES, lane = F.lane;
    constexpr int I_IN = 16 * 128, I_GLU = 8 * 16, I_US = 8 * 32, I_UA = 8 * 32, I_OUT = 16 * 32, I_W1 = 32 * 256, I_W3 = 32 * 256, I_W2 = 32 * 256;
    constexpr int NITEMS = I_IN + I_GLU + I_US + I_UA + I_OUT + I_W1 + I_W3 + I_W2;
    unsigned char* ws = F.ws;
    for (int it = gw; it < NITEMS; it += NGW) {
        int r = it;
        if (r < I_IN) { const int k0 = 64 * (r / 128), n0 = 32 * (r % 128);
            if (n0 < DS) transpose_item(F.in[2], DIN, k0, n0, (bf16_t*)(ws + WS_WIN), n0, D, scr, lane);
            else transpose_item_f8(F.in[2], DIN, k0, n0, ws + WS_WINF8, n0 - DS, D, WF8_SCALE, scr, lane);
            continue; } r -= I_IN;
        if (r < I_GLU) { transpose_item(F.in[12], DS, 64 * (r / 16), 32 * (r % 16), (bf16_t*)(ws + WS_WGLU), 32 * (r % 16), DS, scr, lane); continue; } r -= I_GLU;
        if (r < I_US) { transpose_item(F.in[14], D, 64 * (r / 32), 32 * (r % 32), (bf16_t*)(ws + WS_WUS), 32 * (r % 32), DS, scr, lane); continue; } r -= I_US;
        if (r < I_UA) { transpose_item(F.in[15], D, 64 * (r / 32), 32 * (r % 32), (bf16_t*)(ws + WS_WUA), 32 * (r % 32), DA, scr, lane); continue; } r -= I_UA;
        if (r < I_OUT) { transpose_item(F.in[17], D, 64 * (r / 32), 32 * (r % 32), (bf16_t*)(ws + WS_WOUT), 32 * (r % 32), D, scr, lane); continue; } r -= I_OUT;
        if (r < I_W1 + I_W3) { const int w3 = r >= I_W1; if (w3) r -= I_W1; const int e = r >> 8, q = r & 255, k0 = 64 * (q / 16), n0 = 32 * (q % 16);
            transpose_item_f8((w3 ? F.in[24] : F.in[23]) + (size_t)e * D * DE, DE, k0, n0, ws + WS_W13, (size_t)e * 1024 + 256 * (n0 >> 7) + (n0 & 127) + (w3 ? 128 : 0), D, WF8_SCALE, scr, lane); continue; }
        r -= I_W1 + I_W3;
        { const int e = r >> 8, q = r & 255, k0 = 64 * (q / 32), n0 = 32 * (q % 32);
            transpose_item(F.in[25] + (size_t)e * DE * D, D, k0, n0, (bf16_t*)(ws + WS_W2), (size_t)e * 1024 + n0, DE, scr, lane); }
    }
    for (int m = 4 * gw; m < T; m += 4 * NGW) rms_rows_to_bf16<4>(lane, F.in[0] + (size_t)m * D, F.in[1], (bf16_t*)(ws + WS_H1) + (size_t)m * D, ws + WS_H1F8 + (size_t)m * D);
    { bf16_t* WR = (bf16_t*)(ws + WS_WR); const float* wrg = F.in[19]; const float* wre = F.in[21];
      for (int idx = F.vcu * NTHR + F.tid; idx < 256 * D; idx += F.G * NTHR) { const int r = idx >> 10, k = idx & 1023; unsigned o = 0u;
          if (r < 72) { const int c = r < 36 ? r : r - 36; const float w = c < 4 ? wrg[k * 4 + c] : wre[k * 32 + (c - 4)]; const unsigned hb = f2bf(w);
              o = r < 36 ? hb : f2bf(w - __builtin_bit_cast(float, hb << 16)); }
          WR[idx] = (bf16_t)o; } }
}

__device__ __forceinline__ int crow(int r, int hi) { return (r & 3) + 8 * (r >> 2) + 4 * hi; }
constexpr int KVP = 72;
__device__ __forceinline__ void kv_prep_phase(Frame& F) {
    LAS bf16_t* KS = (LAS bf16_t*)(F.lds); LAS bf16_t* VS = KS + 256 * KVP; LAS float* PS = (LAS float*)(F.lds + 2 * 256 * KVP * 2); LAS float* WM = PS + 512;
    const bf16_t* Kb = (const bf16_t*)(F.ws + WS_K); const bf16_t* Vb = (const bf16_t*)(F.ws + WS_V);
    bf16_t* Kf = (bf16_t*)(F.ws + WS_KFRAG); bf16_t* Vf = (bf16_t*)(F.ws + WS_VFRAG); bf16_t* KM = (bf16_t*)(F.ws + WS_KMEAN); float* KN = (float*)(F.ws + WS_KMEAN + 512 * 1024);
    const int tid = F.tid;
    for (int item = F.vcu; item < BATCH * NH * NBLK; item += F.G) {
        const int n = item & 31, h = (item >> 5) & 7, b = item >> 8; const size_t tok0 = (size_t)b * SEQ + 256 * n;
#pragma unroll
        for (int j = 0; j < 4; ++j) { const int q = tid + NTHR * j, row = q >> 3, pc = q & 7; const size_t src = (tok0 + row) * DA + h * HD + pc * 8;
            *(LAS u32x4*)(KS + row * KVP + pc * 8) = *(const u32x4*)(Kb + src); *(LAS u32x4*)(VS + row * KVP + pc * 8) = *(const u32x4*)(Vb + src); }
        __syncthreads();
#pragma unroll
        for (int j = 0; j < 4; ++j) { const int P = tid + NTHR * j, st = P >> 8, ds = (P >> 6) & 3, l2 = P & 63, row = 32 * st + (l2 & 31), col = 16 * ds + 8 * (l2 >> 5);
            *(u32x4*)(Kf + ((size_t)item * 2048 + P) * 8) = *(const LAS u32x4*)(KS + row * KVP + col); }
#pragma unroll
        for (int j = 0; j < 4; ++j) { const int P = tid + NTHR * j, st = P >> 8, ks = (P >> 7) & 1, d0 = (P >> 6) & 1, l2 = P & 63, hi = l2 >> 5, jj = l2 & 31; unsigned w[4];
#pragma unroll
            for (int e = 0; e < 8; e += 2) { const unsigned lo = VS[(32 * st + 16 * ks + crow(e, hi)) * KVP + 32 * d0 + jj], hi16 = VS[(32 * st + 16 * ks + crow(e + 1, hi)) * KVP + 32 * d0 + jj]; w[e >> 1] = lo | (hi16 << 16); }
            *(u32x4*)(Vf + ((size_t)item * 2048 + P) * 8) = (u32x4){w[0], w[1], w[2], w[3]}; }
        { const int d = tid & 63, part = tid >> 6; float s = 0.f;
#pragma unroll 8
          for (int r = 0; r < 32; ++r) s += bf2f(KS[(part * 32 + r) * KVP + d]);
          PS[part * 64 + d] = s; }
        if (tid < 256) { float ss = 0.f;
#pragma unroll
            for (int c = 0; c < 8; ++c) { const u32x4 w = *(const LAS u32x4*)(KS + tid * KVP + c * 8);
                ss += bflo(w.x) * bflo(w.x) + bfhi(w.x) * bfhi(w.x) + bflo(w.y) * bflo(w.y) + bfhi(w.y) * bfhi(w.y) + bflo(w.z) * bflo(w.z) + bfhi(w.z) * bfhi(w.z) + bflo(w.w) * bflo(w.w) + bfhi(w.w) * bfhi(w.w); }
            ss = wave_max(ss); if (F.lane == 0) WM[F.wave] = ss; }
        __syncthreads();
        if (tid < 64) { float s = 0.f;
#pragma unroll
            for (int p = 0; p < 8; ++p) s += PS[p * 64 + tid];
            KM[(size_t)item * 64 + tid] = (bf16_t)f2bf(s * (1.f / 256.f)); }
        if (tid == 0) KN[item] = fmaxf(fmaxf(WM[0], WM[1]), fmaxf(WM[2], WM[3]));
        __syncthreads();
    }
}

__device__ __forceinline__ void ssm_scan_phase(Frame& F) {
    LAS float* FW = (LAS float*)(F.lds);
    const float* E = (const float*)(F.ws + WS_E); bf16_t* UP = (bf16_t*)(F.ws + WS_UP);
    const int w = F.wave, p = F.lane;
    for (int gb = F.vcu; gb < SG * BATCH; gb += F.G) {
        const int g = gb >> 3, b = gb & 7;
        const float lr = F.in[4][g * SP + p], li = F.in[5][g * SP + p], step = __expf(F.in[6][g]);
        float ar, ai; cpow(lr, li, step, 32.f, ar, ai);
        const size_t row0 = (size_t)g * SROWS + b * 256 + 32 * w;
        f32x2 e[32];
#pragma unroll
        for (int j = 0; j < 32; ++j) e[j] = *(const f32x2*)(E + (row0 + j) * 128 + 2 * p);
        float sr = 0.f, si = 0.f;
#pragma unroll
        for (int j = 0; j < 32; ++j) { const float nr = ar * sr - ai * si + e[j].x, ni = ar * si + ai * sr + e[j].y; sr = nr; si = ni; }
        FW[(w * 64 + p) * 2] = sr; FW[(w * 64 + p) * 2 + 1] = si;
        __syncthreads();
        float Ar = ar, Ai = ai;
#pragma unroll
        for (int q = 0; q < 5; ++q) { const float nr = Ar * Ar - Ai * Ai, ni = 2.f * Ar * Ai; Ar = nr; Ai = ni; }
        sr = 0.f; si = 0.f;
        for (int w2 = 0; w2 < w; ++w2) { const float fr = FW[(w2 * 64 + p) * 2], fi = FW[(w2 * 64 + p) * 2 + 1]; const float nr = Ar * sr - Ai * si + fr, ni = Ar * si + Ai * sr + fi; sr = nr; si = ni; }
#pragma unroll
        for (int j = 0; j < 32; ++j) { *(unsigned*)(UP + (row0 + j) * SKY + SKU + 2 * p) = pk2(sr, si);
            const float nr = ar * sr - ai * si + e[j].x, ni = ar * si + ai * sr + e[j].y; sr = nr; si = ni; }
        __syncthreads();
    }
}

__device__ __forceinline__ int t5_bucket(int d) {
    if (d < 16) return d;
    return 16 + (d >= 19) + (d >= 21) + (d >= 24) + (d >= 27) + (d >= 31) + (d >= 35) + (d >= 40) + (d >= 46) + (d >= 52) + (d >= 59) + (d >= 67) + (d >= 77) + (d >= 87) + (d >= 99) + (d >= 113);
}
struct Top3 { float v0, v1, v2; int i0, i1, i2; };
__device__ __forceinline__ Top3 top3_insert(Top3 t, float x, int n) {
    const bool b0 = (x > t.v0) || (x == t.v0 && n < t.i0), b1 = (x > t.v1) || (x == t.v1 && n < t.i1), b2 = (x > t.v2) || (x == t.v2 && n < t.i2);
    Top3 r;
    r.v2 = b1 ? t.v1 : (b2 ? x : t.v2); r.i2 = b1 ? t.i1 : (b2 ? n : t.i2);
    r.v1 = b0 ? t.v0 : (b1 ? x : t.v1); r.i1 = b0 ? t.i0 : (b1 ? n : t.i1);
    r.v0 = b0 ? x : t.v0; r.i0 = b0 ? n : t.i0;
    return r;
}
constexpr int GQS = 0, GKME = 36864, GCNTL = 41472, GMISC = 41600;
template <bool COUNT> __device__ __forceinline__ void attn_gate_unit(Frame& F, int bh, int qb) {
    LAS unsigned char* L = F.lds;
    LAS bf16_t* QS = (LAS bf16_t*)(L + GQS); LAS bf16_t* KME = (LAS bf16_t*)(L + GKME); LAS int* CNT = (LAS int*)(L + GCNTL); LAS float* KNM = (LAS float*)(L + GMISC);
    int tid = F.tid; asm volatile("" : "+v"(tid));
    const int lane = tid & 63, w = F.wave, j = lane & 31, hi = lane >> 5;
    const int b = bh >> 3, h = bh & 7; const size_t tok0 = (size_t)b * SEQ + 256 * qb;
    const bf16_t* Qb = (const bf16_t*)(F.ws + WS_Q); const bf16_t* KM = (const bf16_t*)(F.ws + WS_KMEAN); const float* KN = (const float*)(F.ws + WS_KMEAN + 512 * 1024);
    float* MQg = (float*)(F.ws + WS_MQ); unsigned short* QL = (unsigned short*)(F.ws + WS_QLIST); unsigned* GC = (unsigned*)(F.ctl + CW_GCNT); unsigned* SEGC = (unsigned*)(F.ws + WS_SEGC);
#pragma unroll
    for (int jj = 0; jj < 4; ++jj) { const int q = tid + NTHR * jj, row = q >> 3, pc = q & 7; *(LAS u32x4*)(QS + row * KVP + pc * 8) = *(const u32x4*)(Qb + (tok0 + row) * DA + h * HD + pc * 8); }
    if (tid < 256) { const int n = tid >> 3, pc = tid & 7; *(LAS u32x4*)(KME + n * KVP + pc * 8) = *(const u32x4*)(KM + ((size_t)bh * 32 + n) * 64 + pc * 8); }
    if (tid < 32) CNT[tid] = 0;
    if (w == 1) { float v = (lane <= qb && lane < 32) ? KN[bh * 32 + lane] : 0.f; v = wave_max(v); if (lane == 0) KNM[0] = v; }
    if (w == 2) { float v = F.in[16][h * 32 + (lane & 31)]; v = wave_max(v); if (lane == 0) KNM[1] = v * LOG2E; }
    __syncthreads();
    {
        bf16x8 qf[4], kmf[4];
#pragma unroll
        for (int ds = 0; ds < 4; ++ds) { qf[ds] = *(const LAS bf16x8*)(QS + (32 * w + j) * KVP + 16 * ds + 8 * hi); kmf[ds] = *(const LAS bf16x8*)(KME + j * KVP + 16 * ds + 8 * hi); }
        f32x16 gt = {};
#pragma unroll
        for (int ds = 0; ds < 4; ++ds) gt = __builtin_amdgcn_mfma_f32_32x32x16_bf16(kmf[ds], qf[ds], gt, 0, 0, 0);
        float qn = 0.f;
#pragma unroll
        for (int ds = 0; ds < 4; ++ds)
#pragma unroll
            for (int e = 0; e < 8; ++e) { const float x = bf2f((unsigned short)qf[ds][e]); qn += x * x; }
        qn += __shfl_xor(qn, 32);
        const float m2 = sqrtf(qn * KNM[0]) + KNM[1];
        const int ql = 256 * qb + 32 * w + j;
        if (hi == 0) MQg[(size_t)bh * SEQ + ql] = m2;
        Top3 t3; t3.v0 = t3.v1 = t3.v2 = -INFINITY; t3.i0 = t3.i1 = t3.i2 = -1;
#pragma unroll
        for (int r = 0; r < 16; ++r) { const int n = crow(r, hi); const float x = (n < qb) ? gt[r] : -INFINITY; t3 = top3_insert(t3, x, x > -INFINITY ? n : 0x7fffffff); }
        { const float p0 = __shfl_xor(t3.v0, 32), p1 = __shfl_xor(t3.v1, 32), p2 = __shfl_xor(t3.v2, 32); const int q0 = __shfl_xor(t3.i0, 32), q1 = __shfl_xor(t3.i1, 32), q2 = __shfl_xor(t3.i2, 32);
          t3 = top3_insert(t3, p0, q0 >= 0 ? q0 : 0x7fffffff); t3 = top3_insert(t3, p1, q1 >= 0 ? q1 : 0x7fffffff); t3 = top3_insert(t3, p2, q2 >= 0 ? q2 : 0x7fffffff); }
        const int i0 = t3.v0 > -INFINITY ? t3.i0 : -1, i1 = t3.v1 > -INFINITY ? t3.i1 : -1, i2 = t3.v2 > -INFINITY ? t3.i2 : -1;
        if (hi == 0) { const unsigned e = (unsigned)ql << 2;
            if (i0 >= 0) { const int pos = __hip_atomic_fetch_add(CNT + i0, 1, __ATOMIC_RELAXED, __HIP_MEMORY_SCOPE_WORKGROUP); QL[((size_t)bh * 32 + i0) * SEQ + (qb - i0 - 1) * 256 + pos] = (unsigned short)(e | 0u); }
            if (i1 >= 0) { const int pos = __hip_atomic_fetch_add(CNT + i1, 1, __ATOMIC_RELAXED, __HIP_MEMORY_SCOPE_WORKGROUP); QL[((size_t)bh * 32 + i1) * SEQ + (qb - i1 - 1) * 256 + pos] = (unsigned short)(e | 1u); }
            if (i2 >= 0) { const int pos = __hip_atomic_fetch_add(CNT + i2, 1, __ATOMIC_RELAXED, __HIP_MEMORY_SCOPE_WORKGROUP); QL[((size_t)bh * 32 + i2) * SEQ + (qb - i2 - 1) * 256 + pos] = (unsigned short)(e | 2u); } }
    }
    __syncthreads();
    if (tid < qb) { const unsigned c = (unsigned)CNT[tid]; SEGC[((size_t)bh * 32 + tid) * 32 + (qb - tid - 1)] = c; if (COUNT && c) (void)__hip_atomic_fetch_add(GC + bh * 32 + tid, c, __ATOMIC_RELAXED, __HIP_MEMORY_SCOPE_AGENT); }
    __syncthreads();
}
template <bool COUNT> __device__ __forceinline__ void attn_gate_phase(Frame& F) {
    for (int u = F.vcu; u < BATCH * NH * NBLK; u += F.G) attn_gate_unit<COUNT>(F, u >> 5, u & 31);
}

#define ATTN_SUBTILE(KP, VP, st_, MODE, CINIT) do { \
        bf16x8 kf_[4], vf_[4]; \
        _Pragma("unroll") for (int ds_ = 0; ds_ < 4; ++ds_) kf_[ds_] = *(const LAS bf16x8*)((KP) + ((st_) * 4 + ds_) * 512 + lane8); \
        _Pragma("unroll") for (int q_ = 0; q_ < 4; ++q_) vf_[q_] = *(const LAS bf16x8*)((VP) + ((st_) * 4 + q_) * 512 + lane8); \
        f32x16 s_ = __builtin_amdgcn_mfma_f32_32x32x16_bf16(kf_[0], qf[0], CINIT, 0, 0, 0); \
        _Pragma("unroll") for (int ds_ = 1; ds_ < 4; ++ds_) s_ = __builtin_amdgcn_mfma_f32_32x32x16_bf16(kf_[ds_], qf[ds_], s_, 0, 0, 0); \
        float p_[16]; \
        if ((MODE) == 0) { _Pragma("unroll") for (int r_ = 0; r_ < 16; ++r_) p_[r_] = __builtin_amdgcn_exp2f(s_[r_]); } \
        else if ((MODE) == 1) { _Pragma("unroll") for (int r_ = 0; r_ < 16; ++r_) { const int dist_ = dq - (32 * (st_) + crow(r_, hi)); const int di_ = dist_ < 0 ? 0 : (dist_ > 127 ? 127 : dist_); \
                p_[r_] = __builtin_amdgcn_exp2f(s_[r_] + TABh[di_]); } } \
        else { _Pragma("unroll") for (int rq_ = 0; rq_ < 4; ++rq_) { const f32x4 bb_ = *(const LAS f32x4*)(BTD + rq_ * 256 + lane * 4); \
                _Pragma("unroll") for (int i_ = 0; i_ < 4; ++i_) p_[4 * rq_ + i_] = __builtin_amdgcn_exp2f(s_[4 * rq_ + i_] + bb_[i_]); } } \
        _Pragma("unroll") for (int r_ = 0; r_ < 16; ++r_) lsum += p_[r_]; \
        u32x4 pa_, pb_; pa_.x = cvt_pk_bf16(p_[0], p_[1]); pa_.y = cvt_pk_bf16(p_[2], p_[3]); pa_.z = cvt_pk_bf16(p_[4], p_[5]); pa_.w = cvt_pk_bf16(p_[6], p_[7]); \
        pb_.x = cvt_pk_bf16(p_[8], p_[9]); pb_.y = cvt_pk_bf16(p_[10], p_[11]); pb_.z = cvt_pk_bf16(p_[12], p_[13]); pb_.w = cvt_pk_bf16(p_[14], p_[15]); \
        const bf16x8 A0_ = __builtin_bit_cast(bf16x8, pa_), A1_ = __builtin_bit_cast(bf16x8, pb_); \
        o0 = __builtin_amdgcn_mfma_f32_32x32x16_bf16(vf_[0], A0_, o0, 0, 0, 0); o1 = __builtin_amdgcn_mfma_f32_32x32x16_bf16(vf_[1], A0_, o1, 0, 0, 0); \
        o0 = __builtin_amdgcn_mfma_f32_32x32x16_bf16(vf_[2], A1_, o0, 0, 0, 0); o1 = __builtin_amdgcn_mfma_f32_32x32x16_bf16(vf_[3], A1_, o1, 0, 0, 0); } while (0)

__device__ __forceinline__ u32x4 ot_pack16(const f32x16& o, int pr) {
    const unsigned p0 = cvt_pk_bf16(o[8 * pr], o[8 * pr + 1]), p1 = cvt_pk_bf16(o[8 * pr + 2], o[8 * pr + 3]), q0 = cvt_pk_bf16(o[8 * pr + 4], o[8 * pr + 5]), q1 = cvt_pk_bf16(o[8 * pr + 6], o[8 * pr + 7]);
    const auto r0 = __builtin_amdgcn_permlane32_swap(p0, q0, false, false); const auto r1 = __builtin_amdgcn_permlane32_swap(p1, q1, false, false);
    return (u32x4){r0[0], r1[0], r0[1], r1[1]};
}
__device__ __forceinline__ void ot_add16(f32x16& o, int pr, u32x4 v, bool use) {
    const auto r0 = __builtin_amdgcn_permlane32_swap(v.x, v.z, false, false); const auto r1 = __builtin_amdgcn_permlane32_swap(v.y, v.w, false, false);
    const unsigned p0 = r0[0], p1 = r1[0], q0 = r0[1], q1 = r1[1];
    o[8 * pr] += use ? bflo(p0) : 0.f; o[8 * pr + 1] += use ? bfhi(p0) : 0.f; o[8 * pr + 2] += use ? bflo(p1) : 0.f; o[8 * pr + 3] += use ? bfhi(p1) : 0.f;
    o[8 * pr + 4] += use ? bflo(q0) : 0.f; o[8 * pr + 5] += use ? bfhi(q0) : 0.f; o[8 * pr + 6] += use ? bflo(q1) : 0.f; o[8 * pr + 7] += use ? bfhi(q1) : 0.f;
}
__device__ __forceinline__ void attn_fill_tab(Frame& F, LAS float* TAB) {
    const float* rb = F.in[16];
    for (int idx = F.tid; idx < 8 * 132; idx += NTHR) { const int h = idx / 132, d = idx % 132; float v = 0.f;
        if (d < 128) v = rb[h * 32 + t5_bucket(d)] * LOG2E; else if (d == 129) v = rb[h * 32 + 31] * LOG2E;
        TAB[idx] = v; }
}
constexpr int BGPRE_OFF = ROWTAB_OFF, BGCL_OFF = ROWTAB_OFF + 8448, BTAB_OFF = ROWTAB_OFF + 16640, BIT_OFF = ROWTAB_OFF + 20992, BIT_MAX = 512, OTAB_OFF = ROWTAB_OFF + 20480  ;
static_assert(BTAB_OFF + 8 * 132 * 4 <= MOE_TST_OFF, "attention LDS tables");
__device__ __forceinline__ size_t part_off(int slot) { return slot == 0 ? WS_PART0 : (slot == 1 ? WS_PART1 : WS_PART2); }

__device__ __forceinline__ void attn_block_phase(Frame& F) {
    LAS unsigned char* L = F.lds; LAS int* GPRE = (LAS int*)(L + BGPRE_OFF); LAS int* GCL = (LAS int*)(L + BGCL_OFF); LAS float* TAB = (LAS float*)(L + BTAB_OFF); LAS int* ITT = (LAS int*)(L + BIT_OFF); LAS int* WSUM = (LAS int*)(L + MOE_TST_OFF);
    const unsigned* GC = (const unsigned*)(F.ctl + CW_GCNT); const unsigned* SEGC = (const unsigned*)(F.ws + WS_SEGC);
    const int tid = F.tid, lane = F.lane, w = F.wave, j = lane & 31, hi = lane >> 5, lane8 = lane * 8;
    { int ng[4], tot = 0;
#pragma unroll
      for (int e = 0; e < 4; ++e) { const int c = (int)GC[4 * tid + e]; GCL[4 * tid + e] = c; ng[e] = (((c + 31) >> 5) + 7) >> 3; tot += ng[e]; }
      int inc = tot;
#pragma unroll
      for (int o = 1; o < 64; o <<= 1) { const int t = __shfl_up(inc, o); if (lane >= o) inc += t; }
      if (lane == 63) WSUM[w] = inc;
      __syncthreads();
      int woff = 0;
      for (int q = 0; q < w; ++q) woff += WSUM[q];
      int ex = woff + inc - tot;
#pragma unroll
      for (int e = 0; e < 4; ++e) { GPRE[4 * tid + e] = ex; ex += ng[e]; }
      if (tid == NTHR - 1) GPRE[2048] = ex; }
    attn_fill_tab(F, TAB);
    __syncthreads();
    const int NIT = GPRE[2048];
    const int nk = (NIT > F.vcu) ? (NIT - F.vcu + F.G - 1) / F.G : 0;
    if (tid < nk && tid < BIT_MAX) { const int it_ = F.vcu + tid * F.G; int lo_ = 0, hi_ = 2048; while (hi_ - lo_ > 1) { const int mid_ = (lo_ + hi_) >> 1; if (GPRE[mid_] <= it_) lo_ = mid_; else hi_ = mid_; } ITT[tid] = lo_ * 64 + (it_ - GPRE[lo_]); }
    __syncthreads();
    if (nk == 0) return;
    const int nkc = nk < BIT_MAX ? nk : BIT_MAX;
    const bf16_t* Qb = (const bf16_t*)(F.ws + WS_Q); const float* MQg = (const float*)(F.ws + WS_MQ); const unsigned short* QL = (const unsigned short*)(F.ws + WS_QLIST);
    const bf16_t* KF = (const bf16_t*)(F.ws + WS_KFRAG); const bf16_t* VF = (const bf16_t*)(F.ws + WS_VFRAG);
    float* PL = (float*)(F.ws + WS_PL);
#define BLK_ITEM(k_, pi_, g_) do { const int kk_ = (k_) < nkc ? (k_) : nkc - 1; const int v_ = __builtin_amdgcn_readfirstlane(ITT[kk_]); pi_ = v_ >> 6; g_ = v_ & 63; } while (0)
#define BLK_DMA(buf_, pi_) do { const char* ks_ = (const char*)KF + ((size_t)(pi_) * 2048 + tid) * 16; const char* vs_ = (const char*)VF + ((size_t)(pi_) * 2048 + tid) * 16; \
        _Pragma("unroll") for (int i_ = 0; i_ < 4; ++i_) { \
            __builtin_amdgcn_global_load_lds((const unsigned*)(ks_ + i_ * 8192), (LAS unsigned*)(L + (buf_) + (i_ * 512 + w * 64) * 16), 16, 0, 0); \
            __builtin_amdgcn_global_load_lds((const unsigned*)(vs_ + i_ * 8192), (LAS unsigned*)(L + (buf_) + 32768 + (i_ * 512 + w * 64) * 16), 16, 0, 0); } } while (0)
#define BLK_SEGC(dst_, pi_) do { dst_ = SEGC[(size_t)(pi_) * 32 + j]; } while (0)
#define BLK_ENTRY(dst_, segc_, pi_, g_) do { const int n_ = (pi_) & 31; int inc_ = (j < 31 - n_) ? (int)(segc_) : 0; \
        _Pragma("unroll") for (int o_ = 1; o_ < 32; o_ <<= 1) { const int t_ = __shfl_up(inc_, o_); if (j >= o_) inc_ += t_; } \
        const int cnt_ = GCL[pi_]; const int idx_ = 32 * (8 * (g_) + w) + j; int seg_ = 0, prev_ = 0; \
        for (int s_ = 0; s_ < 31 - n_; ++s_) { const int p_ = __builtin_amdgcn_readlane(inc_, s_); const bool le_ = p_ <= idx_; seg_ += le_ ? 1 : 0; prev_ = le_ ? p_ : prev_; } \
        const bool ok_ = idx_ < cnt_; const unsigned v_ = QL[(size_t)(pi_) * SEQ + (ok_ ? seg_ * 256 + (idx_ - prev_) : 0)]; dst_ = ok_ ? v_ : 0xFFFFu; } while (0)
#define BLK_QLOAD(qf_, m2_, ent_, pi_) do { const unsigned qq_ = ((ent_) == 0xFFFFu) ? 0u : ((ent_) >> 2); const int bh_ = (pi_) >> 5; \
        const bf16_t* qrow_ = Qb + ((size_t)(bh_ >> 3) * SEQ + qq_) * DA + (bh_ & 7) * HD + 8 * hi; \
        _Pragma("unroll") for (int ds_ = 0; ds_ < 4; ++ds_) qf_[ds_] = *(const bf16x8*)(qrow_ + 16 * ds_); \
        m2_ = MQg[(size_t)bh_ * SEQ + qq_]; } while (0)
    int pi, g, pi1, g1, pi2, g2; unsigned ent, ent1, sc2; bf16x8 qf[4]; float m2r;
    BLK_ITEM(0, pi, g); BLK_ITEM(1, pi1, g1); BLK_ITEM(2, pi2, g2);
    BLK_DMA(0, pi);
    { unsigned sc0, sc1; BLK_SEGC(sc0, pi); BLK_SEGC(sc1, pi1); BLK_SEGC(sc2, pi2); BLK_ENTRY(ent, sc0, pi, g); BLK_ENTRY(ent1, sc1, pi1, g1); }
    BLK_QLOAD(qf, m2r, ent, pi);
    int cur = 0;
    __builtin_amdgcn_s_waitcnt(0x0F70);
    unsigned char* dump = F.ws + WS_E + ((size_t)F.vcu * NTHR + tid) * 128;
    for (int k = 0; k < nkc; ++k) {
        __builtin_amdgcn_s_waitcnt(0x0F75);
        __syncthreads();
        int pi3, g3; unsigned sc3, ent2; bf16x8 qfn[4]; float m2n;
        BLK_ITEM(k + 3, pi3, g3); BLK_SEGC(sc3, pi3);
        BLK_ENTRY(ent2, sc2, pi2, g2);
        BLK_QLOAD(qfn, m2n, ent1, pi1);
        BLK_DMA((cur ^ 1) * 65536, pi1);
        const int bh = pi >> 5, n = pi & 31, h = bh & 7;
        const bool valid = ent != 0xFFFFu; const int q = valid ? (int)(ent >> 2) : 0; const int slot = (int)(ent & 3u);
        const bool active = __builtin_amdgcn_readfirstlane((int)(__ballot(valid) != 0ull)) != 0;
        f32x16 o0 = {}, o1 = {}; float lsum = 0.f;
        if (active) {
            const float m2 = valid ? m2r : INFINITY;
            const LAS bf16_t* KP = (const LAS bf16_t*)(L + cur * 65536); const LAS bf16_t* VP = (const LAS bf16_t*)(L + cur * 65536 + 32768);
            const LAS float* TABh = TAB + h * 132; const LAS float* BTD = nullptr; (void)BTD;
            const int dq = q - 256 * n;
            const bool nearw = __builtin_amdgcn_readfirstlane((int)(__ballot(valid && dq < 383) != 0ull)) != 0;
            const float ci = nearw ? -m2 : TABh[129] - m2;
            f32x16 cinit;
#pragma unroll
            for (int r = 0; r < 16; ++r) cinit[r] = ci;
            if (nearw) { for (int st = 0; st < 8; ++st) ATTN_SUBTILE(KP, VP, st, 1, cinit); }
            else { for (int st = 0; st < 8; ++st) ATTN_SUBTILE(KP, VP, st, 0, cinit); }
        }
        { const float lt = lsum + __shfl_xor(lsum, 32);
          const size_t qi = (size_t)bh * SEQ + q;
          float* pld = valid ? PL + (size_t)slot * (NH * BATCH * SEQ) + qi : (float*)(dump + 120);
          bf16_t* dst = valid ? (bf16_t*)(F.ws + part_off(slot)) + qi * HD + 8 * hi : (bf16_t*)dump;
          *pld = lt;
          *(u32x4*)(dst) = ot_pack16(o0, 0); *(u32x4*)(dst + 16) = ot_pack16(o0, 1); *(u32x4*)(dst + 32) = ot_pack16(o1, 0); *(u32x4*)(dst + 48) = ot_pack16(o1, 1); }
        pi = pi1; g = g1; ent = ent1; m2r = m2n; pi1 = pi2; g1 = g2; ent1 = ent2; pi2 = pi3; g2 = g3; sc2 = sc3; cur ^= 1;
#pragma unroll
        for (int ds = 0; ds < 4; ++ds) qf[ds] = qfn[ds];
    }
    VM_WAIT(); __syncthreads();
#undef BLK_ITEM
#undef BLK_DMA
#undef BLK_SEGC
#undef BLK_ENTRY
#undef BLK_QLOAD
}

__device__ __forceinline__ void attn_own_phase(Frame& F) {
    LAS unsigned char* L = F.lds; LAS float* TAB = (LAS float*)(L + OTAB_OFF); LAS float* BT = (LAS float*)(L + ROWTAB_OFF); int bth = -1;
    attn_fill_tab(F, TAB);
    const int tid = F.tid, lane = F.lane, w = F.wave, j = lane & 31, hi = lane >> 5, lane8 = lane * 8;
    const bf16_t* Qb = (const bf16_t*)(F.ws + WS_Q); const float* MQg = (const float*)(F.ws + WS_MQ);
    const bf16_t* KF = (const bf16_t*)(F.ws + WS_KFRAG); const bf16_t* VF = (const bf16_t*)(F.ws + WS_VFRAG);
    const float* PL = (const float*)(F.ws + WS_PL); bf16_t* YA = (bf16_t*)(F.ws + WS_YATT);
    const int NU = BATCH * NH * NBLK;
#define OWN_DMA(buf_, pi_) do { const char* ks_ = (const char*)KF + ((size_t)(pi_) * 2048 + tid) * 16; const char* vs_ = (const char*)VF + ((size_t)(pi_) * 2048 + tid) * 16; \
        _Pragma("unroll") for (int i_ = 0; i_ < 4; ++i_) { \
            __builtin_amdgcn_global_load_lds((const unsigned*)(ks_ + i_ * 8192), (LAS unsigned*)(L + (buf_) + (i_ * 512 + w * 64) * 16), 16, 0, 0); \
            __builtin_amdgcn_global_load_lds((const unsigned*)(vs_ + i_ * 8192), (LAS unsigned*)(L + (buf_) + 32768 + (i_ * 512 + w * 64) * 16), 16, 0, 0); } } while (0)
#define OWN_QLOAD(qf_, m2_, u_) do { const int bh_ = (u_) >> 5, qb_ = (u_) & 31; const size_t tk_ = (size_t)256 * qb_ + 32 * w + j; \
        const bf16_t* qrow_ = Qb + ((size_t)(bh_ >> 3) * SEQ + tk_) * DA + (bh_ & 7) * HD + 8 * hi; \
        _Pragma("unroll") for (int ds_ = 0; ds_ < 4; ++ds_) qf_[ds_] = *(const bf16x8*)(qrow_ + 16 * ds_); \
        m2_ = MQg[(size_t)bh_ * SEQ + tk_]; } while (0)
    int u = F.vcu; if (u >= NU) return;
    bf16x8 qf[4]; float m2;
    OWN_DMA(0, u); OWN_QLOAD(qf, m2, u);
    int cur = 0;
    __builtin_amdgcn_s_waitcnt(0x0F70);
    for (;;) {
        __builtin_amdgcn_s_waitcnt(0x0F74); __syncthreads();
        const int un = (u + F.G < NU) ? u + F.G : u; const bool last = (un == u);
        const int bh = u >> 5, qb = u & 31, b = bh >> 3, h = bh & 7; const int ql = 32 * w + j; const size_t qi = (size_t)bh * SEQ + 256 * qb + ql;
        u32x4 pa[3][4]; float pl[3];
#pragma unroll
        for (int s = 0; s < 3; ++s) { pl[s] = PL[(size_t)s * (NH * BATCH * SEQ) + qi]; const bf16_t* src = (const bf16_t*)(F.ws + part_off(s)) + qi * HD + 8 * hi;
#pragma unroll
            for (int c = 0; c < 4; ++c) pa[s][c] = *(const u32x4*)(src + 16 * c); }
        bf16x8 qfn[4]; float m2n;
        OWN_QLOAD(qfn, m2n, un);
        OWN_DMA((cur ^ 1) * 65536, un);
        const LAS bf16_t* KP = (const LAS bf16_t*)(L + cur * 65536); const LAS bf16_t* VP = (const LAS bf16_t*)(L + cur * 65536 + 32768); const LAS float* TABh = TAB + h * 132;
        if (h != bth) { __syncthreads();
            for (int e = tid; e < 5 * 1024; e += NTHR) { const int i = e & 3, ln = (e >> 2) & 63, rq = (e >> 8) & 3, dl = e >> 10; const int dist = 32 * dl + (ln & 31) - crow(4 * rq + i, ln >> 5);
                BT[e] = dist < 0 ? -1e30f : TABh[dist > 127 ? 127 : dist]; }
            bth = h; __syncthreads(); }
        const int dq = ql; (void)dq;
        f32x16 cnear, cfar;
#pragma unroll
        for (int r = 0; r < 16; ++r) { cnear[r] = -m2; cfar[r] = TABh[129] - m2; }
        f32x16 o0 = {}, o1 = {}; float lsum = 0.f;
        for (int st = 0; st <= w; ++st) { const int dl = w - st;
            if (dl >= 5) { const LAS float* BTD = nullptr; (void)BTD; ATTN_SUBTILE(KP, VP, st, 0, cfar); }
            else { const LAS float* BTD = BT + dl * 1024; ATTN_SUBTILE(KP, VP, st, 2, cnear); } }
        float lt = lsum + __shfl_xor(lsum, 32);
        const int nsel = qb < 3 ? qb : 3;
#pragma unroll
        for (int s = 0; s < 3; ++s) { const bool use = s < nsel; lt += use ? pl[s] : 0.f;
            ot_add16(o0, 0, pa[s][0], use); ot_add16(o0, 1, pa[s][1], use); ot_add16(o1, 0, pa[s][2], use); ot_add16(o1, 1, pa[s][3], use); }
        const float inv = 1.f / lt;
#pragma unroll
        for (int r = 0; r < 16; ++r) { o0[r] *= inv; o1[r] *= inv; }
        bf16_t* dst = YA + ((size_t)b * SEQ + 256 * qb + ql) * DA + h * HD + 8 * hi;
        *(u32x4*)(dst) = ot_pack16(o0, 0); *(u32x4*)(dst + 16) = ot_pack16(o0, 1); *(u32x4*)(dst + 32) = ot_pack16(o1, 0); *(u32x4*)(dst + 48) = ot_pack16(o1, 1);
        if (last) break;
        u = un; m2 = m2n; cur ^= 1;
#pragma unroll
        for (int ds = 0; ds < 4; ++ds) qf[ds] = qfn[ds];
    }
    VM_WAIT(); __syncthreads();
#undef OWN_DMA
#undef OWN_QLOAD
}
#undef ATTN_SUBTILE

__device__ __forceinline__ void routing_phase(Frame& F) {
    LAS int* lcnt = (LAS int*)(F.lds); LAS int* lbase = lcnt + 32;
    const float* SSQ = (const float*)(F.ws + WS_SSQ); const float* RL = (const float*)(F.ws + WS_RLOG);
    unsigned* rowtok = (unsigned*)(F.ws + WS_ROWTOK); float* rowcoef = (float*)(F.ws + WS_ROWCOEF); float* rowrstd = (float*)(F.ws + WS_ROWRSTD);
    unsigned* ecnt = (unsigned*)(F.ctl + CW_ECNT);
    const float* brg = F.in[20]; const float* bre = F.in[22];
    const int tid = F.tid;
    for (int base = F.vcu * 256; base < T; base += F.G * 256) {
        if (tid < 32) lcnt[tid] = 0;
        __syncthreads();
        int e0 = 0, e1 = 0, lp0 = 0, lp1 = 0; float c0 = 0.f, c1 = 0.f, rstd = 0.f; const int tok = base + tid;
        if (tid < 256) {
            float ss = 0.f;
#pragma unroll
            for (int q = 0; q < 4; ++q) { const f32x4 v = *(const f32x4*)(SSQ + (size_t)tok * 16 + 4 * q); ss += (v.x + v.y) + (v.z + v.w); }
            rstd = 1.f / sqrtf(ss * (1.f / D) + RMS_EPS);
            float r[72];
#pragma unroll
            for (int q = 0; q < 18; ++q) { const f32x4 v = *(const f32x4*)(RL + (size_t)tok * 72 + 4 * q); r[4 * q] = v.x; r[4 * q + 1] = v.y; r[4 * q + 2] = v.z; r[4 * q + 3] = v.w; }
            float gl[4], el[32];
#pragma unroll
            for (int c = 0; c < 4; ++c) gl[c] = rstd * (r[c] + r[36 + c]) + brg[c];
#pragma unroll
            for (int c = 0; c < 32; ++c) el[c] = rstd * (r[4 + c] + r[40 + c]) + bre[c];
            int gi = 0; float gm = gl[0];
#pragma unroll
            for (int c = 1; c < 4; ++c) if (gl[c] > gm) { gm = gl[c]; gi = c; }
            float Z = 0.f;
#pragma unroll
            for (int c = 0; c < 4; ++c) Z += __expf(gl[c] - gm);
            const float gval = 1.f / Z;
            float es[8];
#pragma unroll
            for (int q = 0; q < 8; ++q) es[q] = gi == 0 ? el[q] : (gi == 1 ? el[8 + q] : (gi == 2 ? el[16 + q] : el[24 + q]));
            int a0 = 0; float m0 = es[0];
#pragma unroll
            for (int q = 1; q < 8; ++q) if (es[q] > m0) { m0 = es[q]; a0 = q; }
            int a1 = -1; float m1 = -INFINITY;
#pragma unroll
            for (int q = 0; q < 8; ++q) if (q != a0 && es[q] > m1) { m1 = es[q]; a1 = q; }
            const float w0 = 1.f / (1.f + __expf(m1 - m0)), w1 = 1.f - w0;
            e0 = gi * 8 + a0; e1 = gi * 8 + a1; c0 = gval * w0; c1 = gval * w1;
            lp0 = __hip_atomic_fetch_add(lcnt + e0, 1, __ATOMIC_RELAXED, __HIP_MEMORY_SCOPE_WORKGROUP);
            lp1 = __hip_atomic_fetch_add(lcnt + e1, 1, __ATOMIC_RELAXED, __HIP_MEMORY_SCOPE_WORKGROUP);
        }
        __syncthreads();
        if (tid < 32) lbase[tid] = (int)__hip_atomic_fetch_add(ecnt + tid, (unsigned)lcnt[tid], __ATOMIC_RELAXED, __HIP_MEMORY_SCOPE_AGENT);
        __syncthreads();
        if (tid < 256) {
            const size_t i0 = (size_t)e0 * ROWCAP + lbase[e0] + lp0, i1 = (size_t)e1 * ROWCAP + lbase[e1] + lp1;
            rowtok[i0] = (unsigned)tok * 2u; rowcoef[i0] = c0; rowrstd[i0] = rstd;
            rowtok[i1] = (unsigned)tok * 2u + 1u; rowcoef[i1] = c1; rowrstd[i1] = rstd;
        }
        __syncthreads();
    }
}
struct MoeOrder {
    const LAS int* tst; int total, G, v;
    __device__ bool next(int i, pg8::Unit& u) const {
        const int L = i * G + v; if (L >= total) return false;
        const int rt = L >> 2; int e = 0;
#pragma unroll 8
        for (int q = 1; q <= 32; ++q) e += (tst[q] <= rt) ? 1 : 0;
        u.pm = rt; u.pn = L & 3; u.pb = e * 4 + u.pn; u.aux = e; u.aux2 = (rt - tst[e]) * 256; return true;
    }
};
__device__ __forceinline__ void moe_tables(Frame& F) {
    LAS int* tst = (LAS int*)(F.lds + MOE_TST_OFF); const unsigned* ecnt = (const unsigned*)(F.ctl + CW_ECNT);
    if (F.wave == 0) { const int lane = F.lane; int nt = lane < 32 ? (int)((ecnt[lane & 31] + 255u) >> 8) : 0; int inc = nt;
#pragma unroll
        for (int o = 1; o < 32; o <<= 1) { const int t = __shfl_up(inc, o); if (lane >= o) inc += t; }
        if (lane < 32) tst[lane + 1] = inc; if (lane == 0) tst[0] = 0; }
    __syncthreads();
}
__device__ __forceinline__ void final_phase(Frame& F) {
#ifdef SELFCHECK
    const bool chk_bad = __hip_atomic_load((unsigned*)(F.ctl + 2), __ATOMIC_RELAXED, __HIP_MEMORY_SCOPE_AGENT) != 0u;
#endif
    const bf16_t* X1 = (const bf16_t*)(F.ws + WS_X1); const bf16_t* Y0 = (const bf16_t*)(F.ws + WS_Y0); const bf16_t* Y1 = (const bf16_t*)(F.ws + WS_Y1); const float* gf = F.in[26];
    const int gw = F.vcu * NWAVES + F.wave, NGW = F.G * NWAVES, lane = F.lane;
    for (int m = gw; m < T; m += NGW) {
        const u32x2* xr = (const u32x2*)(X1 + (size_t)m * D) + lane; const u32x2* y0 = (const u32x2*)(Y0 + (size_t)m * D) + lane; const u32x2* y1 = (const u32x2*)(Y1 + (size_t)m * D) + lane;
        f32x4 v[4]; float s = 0.f;
#pragma unroll
        for (int j = 0; j < 4; ++j) { const u32x2 xx = xr[64 * j]; v[j] = (f32x4){bflo(xx.x), bfhi(xx.x), bflo(xx.y), bfhi(xx.y)}; const u32x2 a = y0[64 * j], c = y1[64 * j];
            v[j].x += bflo(a.x) + bflo(c.x); v[j].y += bfhi(a.x) + bfhi(c.x); v[j].z += bflo(a.y) + bflo(c.y); v[j].w += bfhi(a.y) + bfhi(c.y);
            s += (v[j].x * v[j].x + v[j].y * v[j].y) + (v[j].z * v[j].z + v[j].w * v[j].w); }
        const float rstd = 1.f / sqrtf(wave_sum(s) * (1.f / D) + RMS_EPS);
        f32x4* o = (f32x4*)(F.out + (size_t)m * D) + lane; const f32x4* gr = (const f32x4*)gf + lane;
#ifdef SELFCHECK
        if (chk_bad) { for (int j = 0; j < 4; ++j) o[64 * j] = (f32x4){0.f, 0.f, 0.f, 0.f}; continue; }
#endif
#pragma unroll
        for (int j = 0; j < 4; ++j) o[64 * j] = v[j] * rstd * gr[64 * j];
    }
}
#ifdef SELFCHECK
constexpr int CW_CHK = 2;
__device__ __forceinline__ int t5_bucket_ref(int n) { if (n < 16) return n; const int l = 16 + (int)(logf((float)n / 16.f) / logf(8.f) * 16.f); return l < 31 ? l : 31; }
__device__ __forceinline__ float kfrag_at(const bf16_t* KF, int bh, int key, int d) { const int n = key >> 8, kl = key & 255, st = kl >> 5, i = kl & 31, ds = d >> 4, hi = (d >> 3) & 1, e = d & 7;
    return bf2f(KF[(((size_t)bh * 32 + n) * 2048 + (st * 4 + ds) * 64 + (i + 32 * hi)) * 8 + e]); }
__device__ __forceinline__ float vfrag_at(const bf16_t* VF, int bh, int key, int d) { const int n = key >> 8, kl = key & 255, st = kl >> 5, kk = kl & 31, ks = kk >> 4, k16 = kk & 15, hi = (k16 >> 2) & 1, e = (k16 & 3) + 4 * (k16 >> 3), d0 = d >> 5, jj = d & 31;
    return bf2f(VF[(((size_t)bh * 32 + n) * 2048 + ((st * 2 + ks) * 2 + d0) * 64 + (jj + 32 * hi)) * 8 + e]); }
__device__ __forceinline__ void selfcheck_phase(Frame& F, float tol_attn, float tol_ssm) {
    const int lane = lane_id(); const int gw = F.vcu * NWAVES + F.wave;
    const bf16_t* Qb = (const bf16_t*)(F.ws + WS_Q); const bf16_t* KM = (const bf16_t*)(F.ws + WS_KMEAN); const bf16_t* KF = (const bf16_t*)(F.ws + WS_KFRAG); const bf16_t* VF = (const bf16_t*)(F.ws + WS_VFRAG);
    const bf16_t* YA = (const bf16_t*)(F.ws + WS_YATT); const float* rb = F.in[16];
    bool bad = false;
    for (int sidx = 0; sidx < 12; ++sidx) {
        unsigned hsh = (unsigned)(gw * 12 + sidx) * 2654435761u; hsh ^= hsh >> 15; hsh *= 2246822519u; hsh ^= hsh >> 13;
        const int bh = (int)(hsh & 63u); int q = (int)((hsh >> 6) & 8191u);
        if (sidx == 0) q = q & 767; if (sidx == 1) q = (q & ~255) | (sidx & 1 ? 0 : 255); if (sidx == 2) q = (q & ~255) | 255; if (sidx == 3) q = (q & ~255) | 128;
        const int b = bh >> 3, h = bh & 7, qb = q >> 8, d = lane;
        const float qd = bf2f(Qb[((size_t)b * SEQ + q) * DA + h * HD + d]);
        int s0 = -1, s1 = -1, s2 = -1; float g0 = -INFINITY, g1 = -INFINITY, g2 = -INFINITY;
        for (int n = 0; n < qb; ++n) { const float gt = wave_sum(qd * bf2f(KM[((size_t)bh * 32 + n) * 64 + d]));
            if (gt > g0) { g2 = g1; s2 = s1; g1 = g0; s1 = s0; g0 = gt; s0 = n; } else if (gt > g1) { g2 = g1; s2 = s1; g1 = gt; s1 = n; } else if (gt > g2) { g2 = gt; s2 = n; } }
        float m = -INFINITY, l = 0.f, od = 0.f;
        for (int blk = 0; blk < 4; ++blk) { const int n = blk == 0 ? s0 : (blk == 1 ? s1 : (blk == 2 ? s2 : qb)); if (n < 0) continue;
            const int kend = (blk == 3) ? (q & 255) + 1 : 256;
            for (int kl = 0; kl < kend; ++kl) { const int key = 256 * n + kl; const float kd = kfrag_at(KF, bh, key, d);
                const float s = wave_sum(qd * kd) + rb[h * 32 + t5_bucket_ref(q - key)] * LOG2E;
                const float mn = fmaxf(m, s), sc = exp2f(m - mn), p = exp2f(s - mn); l = l * sc + p; od = od * sc + p * vfrag_at(VF, bh, key, d); m = mn; } }
        od /= l;
        const float yd = bf2f(YA[((size_t)b * SEQ + q) * DA + h * HD + d]);
        const float e2 = wave_sum((od - yd) * (od - yd)), o2 = wave_sum(od * od);
        if (!(e2 <= tol_attn * tol_attn * o2)) bad = true;
    }
    { const bf16_t* UP = (const bf16_t*)(F.ws + WS_UP); const bf16_t* GA = (const bf16_t*)(F.ws + WS_GACT);
      for (int sidx = 0; sidx < 6; ++sidx) {
        unsigned hsh = (unsigned)(gw * 6 + sidx + 7777) * 2654435761u; hsh ^= hsh >> 15; hsh *= 2246822519u; hsh ^= hsh >> 13;
        const int g = (int)(hsh & 31u), b = (int)((hsh >> 5) & 7u); int t = (int)((hsh >> 8) % 330u); if (sidx == 0) t = 31 + (int)((hsh >> 20) & 3u) * 32; if (sidx == 1) t = 32 + (int)((hsh >> 20) & 7u) * 32;
        const int p = lane;
        const float lr = F.in[4][g * SP + p], li = F.in[5][g * SP + p], step = expf(F.in[6][g]);
        const float mag = expf(lr * step), ar = mag * cosf(li * step), ai = mag * sinf(li * step);
        const float nr = ar - 1.f, ni = ai, den = lr * lr + li * li, cr = (nr * lr + ni * li) / den, ci = (ni * lr - nr * li) / den;
        float hr = 0.f, hi_ = 0.f;
        for (int tt = 0; tt <= t; ++tt) { float br = 0.f, bi = 0.f;
            for (int c = 0; c < 16; ++c) { const float u = bf2f(UP[(size_t)g * SROWS * SKY + ((size_t)b * 256 + (tt >> 5)) * SKY + (tt & 31) * 16 + c]);
                const float b_r = F.in[7][(g * SP + p) * 16 + c], b_i = F.in[8][(g * SP + p) * 16 + c]; br += (cr * b_r - ci * b_i) * u; bi += (cr * b_i + ci * b_r) * u; }
            const float n_r = ar * hr - ai * hi_ + br, n_i = ar * hi_ + ai * hr + bi; hr = n_r; hi_ = n_i; }
        float e2 = 0.f, o2 = 0.f;
        for (int ho = 0; ho < 16; ++ho) { float y = wave_sum(hr * F.in[9][(g * 16 + ho) * SP + p] - hi_ * F.in[10][(g * 16 + ho) * SP + p]);
            const float u = bf2f(UP[(size_t)g * SROWS * SKY + ((size_t)b * 256 + (t >> 5)) * SKY + (t & 31) * 16 + ho]); y += F.in[11][g * 16 + ho] * u;
            const float ge = 0.5f * y * (1.f + tanhf(0.7978845608028654f * (y + 0.044715f * y * y * y)));
            const float gv = bf2f(GA[((size_t)b * SEQ + t) * DS + g * 16 + ho]); e2 += (ge - gv) * (ge - gv); o2 += ge * ge; }
        if (!(e2 <= tol_ssm * tol_ssm * o2 + 1e-6f)) bad = true;
      } }
    if (__ballot(bad) != 0ull && lane == 0) __hip_atomic_store((unsigned*)(F.ctl + CW_CHK), 1u, __ATOMIC_RELAXED, __HIP_MEMORY_SCOPE_AGENT);
}
#endif

#ifdef SELFCHECK
__device__ __forceinline__ void selfcheck_prep(Frame& F) {
    const int lane = lane_id(); const int gw = F.vcu * NWAVES + F.wave;
    const bf16_t* Kb = (const bf16_t*)(F.ws + WS_K); const bf16_t* Vb = (const bf16_t*)(F.ws + WS_V); const bf16_t* KF = (const bf16_t*)(F.ws + WS_KFRAG); const bf16_t* VF = (const bf16_t*)(F.ws + WS_VFRAG);
    const bf16_t* KM = (const bf16_t*)(F.ws + WS_KMEAN); const float* KN = (const float*)(F.ws + WS_KMEAN + 512 * 1024);
    bool bad = false;
    for (int sidx = 0; sidx < 64; ++sidx) {
        unsigned hsh = (unsigned)(gw * 64 + sidx + 12345) * 2654435761u; hsh ^= hsh >> 15; hsh *= 2246822519u; hsh ^= hsh >> 13;
        const int bh = (int)(hsh & 63u), key = (int)((hsh >> 6) & 8191u), b = bh >> 3, h = bh & 7, d = lane;
        const float k0 = bf2f(Kb[((size_t)b * SEQ + key) * DA + h * HD + d]), v0 = bf2f(Vb[((size_t)b * SEQ + key) * DA + h * HD + d]);
        if (kfrag_at(KF, bh, key, d) != k0 || vfrag_at(VF, bh, key, d) != v0) bad = true;
    }
    for (int sidx = 0; sidx < 2; ++sidx) {
        unsigned hsh = (unsigned)(gw * 2 + sidx + 999) * 2654435761u; hsh ^= hsh >> 15; hsh *= 2246822519u; hsh ^= hsh >> 13;
        const int item = (int)(hsh & 2047u), bh = item >> 5, n = item & 31, b = bh >> 3, h = bh & 7, d = lane; float sum = 0.f, mx = 0.f;
        for (int kl = 0; kl < 256; ++kl) { const float kv = bf2f(Kb[((size_t)b * SEQ + 256 * n + kl) * DA + h * HD + d]); sum += kv; mx = fmaxf(mx, wave_sum(kv * kv)); }
        const float mean = sum * (1.f / 256.f), got = bf2f(KM[(size_t)item * 64 + d]);
        if (fabsf(mean - got) > 0.01f * fabsf(mean) + 1e-3f) bad = true;
        if (fabsf(mx - KN[item]) > 1e-3f * mx) bad = true;
    }
    if (__ballot(bad) != 0ull && lane == 0) __hip_atomic_store((unsigned*)(F.ctl + CW_CHK), 1u, __ATOMIC_RELAXED, __HIP_MEMORY_SCOPE_AGENT);
}
#endif
#ifndef MK_N_LAUNCHES
#define MK_N_LAUNCHES 1
#endif
constexpr int NPHASE = 14;
struct Args { const float* in[27]; float* out; unsigned char* ws; int ph_lo, ph_hi; };
static_assert(sizeof(Args) == 27 * 8 + 8 + 8 + 8, "Args has no padding");

#ifndef STAG9
#define STAG9 0
#endif
#ifndef STAG8
#define STAG8 0
#endif
#ifndef DUP_MASK
#define DUP_MASK 0
#endif
#define PH_ARGS Frame& F, unsigned char* ws, LAS unsigned char* ring
__device__ __forceinline__ void ph1(PH_ARGS) {
    { pg8::Gemm g{(const bf16_t*)(ws + WS_H1), (const bf16_t*)(ws + WS_WIN), D, D, D}; pg8::StaticOrder S; S.init(T, DS, F.G, (int)blockIdx.x);
      EpiProj<0> E{ws, F.in[3], 0, 1.f};
      pg8::gemm_phase<EpiProj<0>, pg8::StaticOrder, true, false>(ring, g, S, E, nullptr, F.wave); }
    { pg8::Gemm g{(const bf16_t*)(ws + WS_H1F8), (const bf16_t*)(ws + WS_WINF8), D / 2, D / 2, D / 2}; pg8::StaticOrder S; S.init(T, DIN - DS, F.G, (int)blockIdx.x);
      EpiProj<1> E{ws, F.in[3], 2, 1.f / WF8_SCALE};
      pg8::gemm_phase<EpiProj<1>, pg8::StaticOrder, true, false, true>(ring, g, S, E, nullptr, F.wave); }
}
__device__ __forceinline__ void ph2(PH_ARGS) {
    { pg8::Gemm g{(const bf16_t*)(ws + WS_UP), (const bf16_t*)(ws + WS_SSMW), SKY, SKU, SKU}; pg8::GroupedOrder S; S.init(SG * 8, 1, 8, F.G, F.vcu);
      EpiSsmE E{(float*)(ws + WS_E)};
      pg8::gemm_phase<EpiSsmE, pg8::GroupedOrder, false, false>(ring, g, S, E, nullptr, F.wave); }
    VM_WAIT(); __syncthreads();
    ssm_scan_phase(F);
    kv_prep_phase(F);
}
__device__ __forceinline__ void ph4(PH_ARGS) {
    pg8::Gemm g{(const bf16_t*)(ws + WS_UP), (const bf16_t*)(ws + WS_SSMT), SKY, SKY, SKY}; pg8::GroupedOrder S; S.init(SG * 8, 2, 8, F.G, F.vcu);
    EpiSsmY E{(bf16_t*)(ws + WS_GACT)};
    pg8::gemm_phase<EpiSsmY, pg8::GroupedOrder, true, false>(ring, g, S, E, nullptr, F.wave);
}
__device__ __forceinline__ void ph5(PH_ARGS) {
    pg8::Gemm g{(const bf16_t*)(ws + WS_GACT), (const bf16_t*)(ws + WS_WGLU), DS, DS, DS}; pg8::StaticOrder S; S.init(T, DS, F.G, (int)blockIdx.x);
    EpiGlu E{(const bf16_t*)(ws + WS_GACT), (bf16_t*)(ws + WS_YSSM), F.in[13]};
    pg8::gemm_phase<EpiGlu, pg8::StaticOrder, true, false>(ring, g, S, E, nullptr, F.wave);
}
__device__ __forceinline__ void ph6(PH_ARGS) {
    { pg8::Gemm g{(const bf16_t*)(ws + WS_YSSM), (const bf16_t*)(ws + WS_WUS), DS, DS, DS}; pg8::StaticOrder S; S.init(T, D, F.G, (int)blockIdx.x);
      EpiUp<false> E{(const bf16_t*)(ws + WS_SGS), (bf16_t*)(ws + WS_MRG)};
      pg8::gemm_phase<EpiUp<false>, pg8::StaticOrder, true, false>(ring, g, S, E, nullptr, F.wave); }
    VM_WAIT(); __syncthreads();
    { pg8::Gemm g{(const bf16_t*)(ws + WS_YATT), (const bf16_t*)(ws + WS_WUA), DA, DA, DA}; pg8::StaticOrder S; S.init(T, D, F.G, (int)blockIdx.x);
      EpiUp<true> E{(const bf16_t*)(ws + WS_SGA), (bf16_t*)(ws + WS_MRG)};
      pg8::gemm_phase<EpiUp<true>, pg8::StaticOrder, true, false>(ring, g, S, E, nullptr, F.wave); }
}
__device__ __forceinline__ void ph7(PH_ARGS) {
    pg8::Gemm g{(const bf16_t*)(ws + WS_MRG), (const bf16_t*)(ws + WS_WOUT), D, D, D}; pg8::StaticOrder S; S.init(T, D, F.G, (int)blockIdx.x);
    EpiOut E{F.in[0], (bf16_t*)(ws + WS_X1), (bf16_t*)(ws + WS_XG), ws + WS_XGF8, F.in[18], (float*)(ws + WS_SSQ)};
    pg8::gemm_phase<EpiOut, pg8::StaticOrder, true, false>(ring, g, S, E, nullptr, F.wave);
}
__device__ __forceinline__ void ph8(PH_ARGS) {
    pg8::Gemm g{(const bf16_t*)(ws + WS_XG), (const bf16_t*)(ws + WS_WR), D, D, D}; pg8::GroupedOrder S; S.init(T / 256, 1, T / 256, F.G, F.vcu);
    EpiRouter E{(float*)(ws + WS_RLOG)};
    pg8::gemm_phase<EpiRouter, pg8::GroupedOrder, false, false>(ring, g, S, E, nullptr, F.wave);
}
__device__ __forceinline__ void ph10(PH_ARGS) {
    moe_tables(F);
    const LAS int* tst = (const LAS int*)(F.lds + MOE_TST_OFF);
    MoeOrder S{tst, tst[32] * 4, F.G, F.vcu};
    LAS unsigned* rowtab = (LAS unsigned*)(F.lds + ROWTAB_OFF);
    { const unsigned* rowtok = (const unsigned*)(ws + WS_ROWTOK); const unsigned* ecnt = (const unsigned*)(F.ctl + CW_ECNT); pg8::Unit u;
      for (int i = 0; i < ROWTAB_UNITS && S.next(i, u); ++i) { if (F.tid < 256) { const int pos = u.aux2 + F.tid; const unsigned tk = pos < (int)ecnt[u.aux] ? (rowtok[(size_t)u.aux * ROWCAP + pos] >> 1) : 0u; rowtab[i * 256 + F.tid] = tk * (unsigned)D; } } }
    __syncthreads();
    pg8::Gemm g{(const bf16_t*)(ws + WS_XGF8), (const bf16_t*)(ws + WS_W13), D / 2, D / 2, D / 2};
    EpiMoe1 E{(bf16_t*)(ws + WS_HID), (const float*)(ws + WS_ROWRSTD), (const unsigned*)(F.ctl + CW_ECNT), 1.f / WF8_SCALE};
    pg8::gemm_phase<EpiMoe1, MoeOrder, true, true, true>(ring, g, S, E, rowtab, F.wave);
}
__device__ __forceinline__ void ph11(PH_ARGS) {
    moe_tables(F);
    const LAS int* tst = (const LAS int*)(F.lds + MOE_TST_OFF);
    MoeOrder S{tst, tst[32] * 4, F.G, F.vcu};
    pg8::Gemm g{(const bf16_t*)(ws + WS_HID), (const bf16_t*)(ws + WS_W2), DE, DE, DE};
    EpiMoe2 E{(bf16_t*)(ws + WS_Y0), (size_t)(WS_Y1 - WS_Y0), (const unsigned*)(ws + WS_ROWTOK), (const float*)(ws + WS_ROWCOEF), (const unsigned*)(F.ctl + CW_ECNT)};
    pg8::gemm_phase<EpiMoe2, MoeOrder, true, false>(ring, g, S, E, nullptr, F.wave);
}

__global__ void __launch_bounds__(NTHR, 2) fwd_kernel(Args args) {
    extern __shared__ __attribute__((aligned(16))) unsigned char lds_raw[];
    Frame F;
    F.lds = (LAS unsigned char*)lds_raw;
    F.MISC = (volatile LAS unsigned*)(F.lds + MISC_OFF);
    F.wave = __builtin_amdgcn_readfirstlane((int)(threadIdx.x >> 6)); F.lane = lane_id(); F.tid = F.wave * 64 + F.lane;
    F.G = gridDim.x; { const int bx = blockIdx.x; F.vcu = (F.G % 8 == 0) ? (bx % 8) * (F.G / 8) + bx / 8 : bx; }
    F.ws = args.ws; F.ctl = (gu32*)(args.ws + WS_CTL); F.out = args.out;
#pragma unroll
    for (int i = 0; i < 27; ++i) F.in[i] = args.in[i];
    for (int u = F.tid; u < (LDS_BYTES - MOE_TST_OFF) / 4; u += NTHR) ((LAS unsigned*)(F.lds + MOE_TST_OFF))[u] = 0u;
    __syncthreads();
    XcdBarrier bar; bar.bar = (unsigned*)(F.ctl + CW_BAR); bar.x = 0; bar.st = nullptr;
    const int lo = args.ph_lo, hi = args.ph_hi;
    if (hi - lo > 1) bar = xcd_barrier_post((unsigned*)(F.ctl + CW_BAR), F.MISC + 8, F.tid == 0);
#define IN(k) (lo <= (k) && (k) < hi)
#define DUP(k) ((DUP_MASK >> (k)) & 1)
#define SEAM(k) do { if (IN(k) && IN((k) + 1)) xcd_barrier(bar, F.wave == 0 && lane_id() == 0); REFRESH(); } while (0)
#define REFRESH() do { int l_ = lane_id(); asm volatile("" : "+v"(l_)); F.lane = l_; F.tid = F.wave * 64 + l_; } while (0)
    unsigned char* ws = args.ws;
    LAS unsigned char* ring = F.lds;
    if (IN(0)) { p0_prologue(F); if (DUP(0)) p0_prologue(F); }
    SEAM(0);
    if (IN(1)) { ph1(F, ws, ring); if (DUP(1)) ph1(F, ws, ring); }
    SEAM(1);
    if (IN(2)) { ph2(F, ws, ring); if (DUP(2)) ph2(F, ws, ring); }
    SEAM(2);
#ifdef SELFCHECK_PREP
    if (IN(3)) { selfcheck_prep(F); }
#endif
    if (IN(3)) { attn_gate_phase<true>(F); }
    SEAM(3);
    if (IN(4)) { attn_block_phase(F); if (DUP(4)) { __syncthreads(); attn_block_phase(F); } }
    SEAM(4);
    if (IN(5)) { attn_own_phase(F); if (DUP(5)) attn_own_phase(F); }
    SEAM(5);
    if (IN(6)) { ph4(F, ws, ring); if (DUP(6)) ph4(F, ws, ring); }
#ifdef SELFCHECK
    if (IN(6)) { xcd_barrier(bar, F.wave == 0 && lane_id() == 0); REFRESH(); selfcheck_phase(F, SELFCHECK_TOL_ATTN, SELFCHECK_TOL_SSM); }
#endif
    SEAM(6);
    if (IN(7)) { ph5(F, ws, ring); if (DUP(7)) ph5(F, ws, ring); }
    SEAM(7);
    if (IN(8)) { if (STAG8 > 0 && (F.vcu & 1)) { const unsigned long long t0_ = __builtin_amdgcn_s_memrealtime(); while ((long long)(__builtin_amdgcn_s_memrealtime() - t0_) < (long long)STAG8) __builtin_amdgcn_s_sleep(16); }
                 ph6(F, ws, ring); if (DUP(8)) ph6(F, ws, ring); }
    SEAM(8);
    if (IN(9)) { if (STAG9 > 0 && (F.vcu & 1)) { const unsigned long long t0_ = __builtin_amdgcn_s_memrealtime(); while ((long long)(__builtin_amdgcn_s_memrealtime() - t0_) < (long long)STAG9) __builtin_amdgcn_s_sleep(16); }
                 ph7(F, ws, ring); if (DUP(9)) ph7(F, ws, ring); }
    SEAM(9);
    if (IN(10)) { ph8(F, ws, ring); VM_WAIT(); __syncthreads(); routing_phase(F); }
    SEAM(10);
    if (IN(11)) { ph10(F, ws, ring); if (DUP(11)) ph10(F, ws, ring); }
    SEAM(11);
    if (IN(12)) { ph11(F, ws, ring); if (DUP(12)) ph11(F, ws, ring); }
    SEAM(12);
    if (IN(13)) { final_phase(F); if (DUP(13)) final_phase(F); }
#undef IN
#undef DUP
#undef SEAM
#undef REFRESH
}

extern "C" void kernel_launch(void* const* d_in, const int* in_sizes, int n_in, void* d_out, int out_size, void* d_ws, size_t ws_size, hipStream_t stream) {
    static int grid = 0;
    if (grid == 0) {
        if (n_in != 27 || in_sizes[0] != T * D || out_size != T * D || ws_size < WS_END) { fprintf(stderr, "kernel_launch: unexpected shapes (n_in %d, in0 %d, out %d, ws %zu)\n", n_in, n_in > 0 ? in_sizes[0] : -1, out_size, ws_size); grid = -1; return; }
        int dev = 0, cus = 0;
        if (hipGetDevice(&dev) != hipSuccess || hipDeviceGetAttribute(&cus, hipDeviceAttributeMultiprocessorCount, dev) != hipSuccess) { grid = -1; return; }
        if (hipFuncSetAttribute((const void*)fwd_kernel, hipFuncAttributeMaxDynamicSharedMemorySize, LDS_BYTES) != hipSuccess) { fprintf(stderr, "kernel_launch: hipFuncSetAttribute failed\n"); grid = -1; return; }
        (void)hipGetLastError();
        grid = cus;
    }
    if (grid < 0) return;
    (void)hipMemsetAsync((char*)d_ws + WS_CTL, 0, CTL_ZERO_BYTES, stream);
    Args a{};
    for (int i = 0; i < 27; ++i) a.in[i] = (const float*)d_in[i];
    a.out = (float*)d_out; a.ws = (unsigned char*)d_ws;
    if (MK_N_LAUNCHES == 1) { a.ph_lo = 0; a.ph_hi = NPHASE; hipLaunchKernelGGL(fwd_kernel, dim3(grid), dim3(NTHR), LDS_BYTES, stream, a); }
    else { for (int p = 0; p < NPHASE; ++p) { a.ph_lo = p; a.ph_hi = p + 1; hipLaunchKernelGGL(fwd_kernel, dim3(grid), dim3(NTHR), LDS_BYTES, stream, a); } }
}
```

```cpp
#include <hip/hip_runtime.h>
#include <cstdio>
#include <cstdint>

#define LAS __attribute__((address_space(3)))
#define GAS __attribute__((address_space(1)))
typedef unsigned short bf16_t;
typedef short bf16x8 __attribute__((ext_vector_type(8)));
typedef float f32x2 __attribute__((ext_vector_type(2)));
typedef float f32x4 __attribute__((ext_vector_type(4)));
typedef float f32x16 __attribute__((ext_vector_type(16)));
typedef unsigned u32x2 __attribute__((ext_vector_type(2)));
typedef unsigned u32x4 __attribute__((ext_vector_type(4)));
typedef GAS unsigned gu32;
typedef int v4i32 __attribute__((ext_vector_type(4)));
typedef int v8i32 __attribute__((ext_vector_type(8)));
#define RLX_AGENT __ATOMIC_RELAXED, __HIP_MEMORY_SCOPE_AGENT
#define LDS_WAIT() asm volatile("s_waitcnt lgkmcnt(0)" ::: "memory")
#define VM_WAIT() asm volatile("s_waitcnt vmcnt(0)" ::: "memory")

__device__ __forceinline__ unsigned f2bf(float f) { unsigned u = __builtin_bit_cast(unsigned, f); return (u + 0x7fffu + ((u >> 16) & 1u)) >> 16; }
__device__ __forceinline__ unsigned pk2(float lo, float hi) { return f2bf(lo) | (f2bf(hi) << 16); }
__device__ __forceinline__ float bf2f(unsigned short b) { return __builtin_bit_cast(float, (unsigned)b << 16); }
__device__ __forceinline__ float bflo(unsigned w) { return __builtin_bit_cast(float, w << 16); }
__device__ __forceinline__ float bfhi(unsigned w) { return __builtin_bit_cast(float, w & 0xffff0000u); }
__device__ __forceinline__ unsigned cvt_pk_bf16(float lo, float hi) { unsigned r; asm volatile("v_cvt_pk_bf16_f32 %0, %1, %2" : "=v"(r) : "v"(lo), "v"(hi)); return r; }
__device__ __forceinline__ float fast_sigmoid(float x) { return __builtin_amdgcn_rcpf(1.f + __builtin_amdgcn_exp2f(-1.4426950408889634f * x)); }
__device__ __forceinline__ int lane_id() { int l; asm volatile("v_mbcnt_lo_u32_b32 %0, -1, 0\n\tv_mbcnt_hi_u32_b32 %0, -1, %0" : "=v"(l)); return l; }
__device__ __forceinline__ float wave_sum(float v) {
#pragma unroll
    for (int o = 1; o < 64; o <<= 1) v += __shfl_xor(v, o);
    return v;
}
__device__ __forceinline__ float wave_max(float v) {
#pragma unroll
    for (int o = 1; o < 64; o <<= 1) v = fmaxf(v, __shfl_xor(v, o));
    return v;
}

#define XB_TMO      128
#define XB_XCNT(j)  (256  + 64 * (j))
#define XB_XSUB(j)  (1280 + 64 * (j))
#define XB_XGEN(j)  (2304 + 64 * (j))
#define XB_TOP      3328
#define XB_TOPGEN   3392
#define XCD_BAR_WORDS 3456
#define XB_SPIN_CAP (1u << 20)

__device__ __forceinline__ unsigned xb_ld(unsigned* p)              { return __hip_atomic_load(p, __ATOMIC_RELAXED, __HIP_MEMORY_SCOPE_AGENT); }
__device__ __forceinline__ unsigned xb_add(unsigned* p, unsigned v) { return __hip_atomic_fetch_add(p, v, __ATOMIC_RELAXED, __HIP_MEMORY_SCOPE_AGENT); }
__device__ __forceinline__ unsigned xb_xcc_id() { return (unsigned)__builtin_amdgcn_s_getreg((3 << 11) | 20) & 0xFu; }
#define XB_SPIN(cond, bar) do { unsigned _sp = 0; while (cond) { __builtin_amdgcn_s_sleep(1); \
    if ((++_sp & 255u) == 0u) { if (xb_ld(&(bar)[XB_TMO])) break; if (_sp > XB_SPIN_CAP) { atomicAdd(&(bar)[XB_TMO], 1u); break; } } } } while (0)

struct XcdBarrier { unsigned* bar; unsigned x; volatile LAS unsigned* st; };

__device__ __forceinline__ XcdBarrier xcd_barrier_post(unsigned* bar, volatile LAS unsigned* st, bool leader  ) {
    XcdBarrier b; b.bar = bar; b.x = xb_xcc_id(); b.st = st;
    if (leader) (void)xb_add(&bar[XB_XCNT(b.x)], 1u);
    return b;
}
__device__ __forceinline__ void xcd_barrier_complete(unsigned* bar, unsigned x, unsigned& nloc, unsigned& nx) {
    const unsigned G = gridDim.x * gridDim.y * gridDim.z;
    unsigned sum, cnt, mine, sp = 0u;
    for (;;) {
        sum = 0u; cnt = 0u; mine = 0u;
#pragma unroll
        for (unsigned j = 0; j < 16; ++j) { const unsigned c = xb_ld(&bar[XB_XCNT(j)]); sum += c; cnt += (c > 0u) ? 1u : 0u; mine = (j == x) ? c : mine; }
        if (sum == G) break;
        __builtin_amdgcn_s_sleep(1);
        if ((++sp & 255u) == 0u) { if (xb_ld(&bar[XB_TMO])) break; if (sp > XB_SPIN_CAP) { atomicAdd(&bar[XB_TMO], 1u); break; } }
    }
    nloc = mine > 0u ? mine : 1u; nx = cnt > 0u ? cnt : 1u;
}
__device__ __forceinline__ void xcd_barrier(const XcdBarrier& b, bool leader  ) {
    asm volatile("s_waitcnt vmcnt(0)" ::: "memory");
    __syncthreads();
    if (leader) {
        unsigned* bar = b.bar;
        __builtin_amdgcn_s_waitcnt(0);
        unsigned nloc = b.st[0], nx = b.st[1];
        if (nloc == 0u) { xcd_barrier_complete(bar, b.x, nloc, nx); b.st[0] = nloc; b.st[1] = nx; }
        const unsigned old = xb_add(&bar[XB_XSUB(b.x)], 1u);
        const unsigned gen = old / nloc;
        if (old + 1u == (gen + 1u) * nloc) {
            __builtin_amdgcn_fence(__ATOMIC_RELEASE, "agent");
            asm volatile("s_waitcnt vmcnt(0)" ::: "memory");
            const unsigned og = xb_add(&bar[XB_TOP], 1u);
            const unsigned tg = og / nx;
            if (og + 1u == (tg + 1u) * nx) xb_add(&bar[XB_TOPGEN], 1u);
            else XB_SPIN(xb_ld(&bar[XB_TOPGEN]) == tg, bar);
            __builtin_amdgcn_fence(__ATOMIC_ACQUIRE, "agent");
            xb_add(&bar[XB_XGEN(b.x)], 1u);
            asm volatile("s_waitcnt vmcnt(0)" ::: "memory");
        } else {
            XB_SPIN(xb_ld(&bar[XB_XGEN(b.x)]) == gen, bar);
            __builtin_amdgcn_fence(__ATOMIC_ACQUIRE, "agent");
            asm volatile("s_waitcnt vmcnt(0)" ::: "memory");
        }
    }
    __syncthreads();
}

namespace pg8 {
constexpr int BM = 256, BK = 64, HALF = 128, HTB = HALF * BK * 2, STAGE_BYTES = 8 * HTB, NXCD = 8, WGM = 8;
__host__ __device__ __forceinline__ int lds_byte(int r, int c) { const int st = (r >> 4) * 2 + (c >> 5), rr = r & 15, cc = c & 31, ob = rr * 64 + cc * 2; return st * 1024 + (ob ^ (((ob >> 9) & 1) << 5)); }
__host__ __device__ __forceinline__ void stage_rc(int b, int& R, int& C) { const int st = b / 1024, sb = b % 1024, swz = sb ^ (((sb >> 9) & 1) << 5); R = (st >> 1) * 16 + swz / 64; C = (st & 1) * 32 + (swz % 64) / 2; }
__host__ __device__ __forceinline__ int perm32(int rho) { const int n = rho >> 4, i = rho & 15; return 8 * (i >> 2) + 4 * n + (i & 3); }

struct Unit { int pm, pn, pb, aux, aux2; };
struct Gemm { const bf16_t* A; const bf16_t* Bt; int lda, ldb, K; };

struct StaticOrder {
    int nM, nN, nwg, G, c;
    __device__ void init(int M, int N, int G_, int c_) { nM = M / BM; nN = N / BM; nwg = nM * nN; G = G_; c = c_; }
    __device__ bool next(int i, Unit& u) const {
        const long L = (long)i * G + c; if (L >= nwg) return false;
        int wgid = (int)L; { const int q = nwg / NXCD, r = nwg % NXCD, xcd = wgid % NXCD, off = wgid / NXCD; wgid = (xcd < r ? xcd * (q + 1) : r * (q + 1) + (xcd - r) * q) + off; }
        const int nig = WGM * nN, gid = wgid / nig, fm = gid * WGM, gsz = (nM - fm) < WGM ? (nM - fm) : WGM;
        u.pm = fm + ((wgid % nig) % gsz); u.pn = (wgid % nig) / gsz; u.pb = u.pn; u.aux = 0; u.aux2 = 0; return true;
    }
};
struct GroupedOrder {
    int nM, nN, rtpg, G, v;
    __device__ void init(int nM_, int nN_, int rtpg_, int G_, int v_) { nM = nM_; nN = nN_; rtpg = rtpg_; G = G_; v = v_; }
    __device__ bool next(int i, Unit& u) const {
        const int L = i * G + v; if (L >= nM * nN) return false;
        u.pm = L / nN; u.pn = L % nN; u.aux = u.pm / rtpg; u.pb = u.aux * nN + u.pn; u.aux2 = 0; return true;
    }
};

template <class Epi, class Sched, bool ALIGN_EPI, bool GATHER, bool FP8 = false>
__device__ __forceinline__ void gemm_phase(LAS unsigned char* lds, const Gemm g, const Sched& S, const Epi& E, const LAS unsigned* rowtab  , int wid  ) {
    const int lane = lane_id(), tid = wid * 64 + lane, wr = wid >> 2, wc = wid & 3;
    const int K = g.K, nt = K / BK;
    unsigned voffB[2];
#pragma unroll
    for (int i = 0; i < 2; ++i) { int R, C; stage_rc(tid * 16 + i * 8192, R, C); const int Rb = (R & ~31) + perm32(R & 31);
        voffB[i] = (unsigned)(Rb * g.ldb + C) * 2u; }
    const size_t kstep = (size_t)(BK * 2);
    const size_t hstepB = (size_t)HALF * g.ldb * 2, tstepB = 2 * hstepB;
    const size_t tstepA = (size_t)BM * g.lda * 2;
    const unsigned ldsw = (unsigned)wid * 1024u;
    const int aoff = lds_byte(wr * 64 + (lane & 15), (lane >> 4) * 8), boff = lds_byte(wc * 32 + (lane & 15), (lane >> 4) * 8);
    unsigned vAc[2][2];
#define PG8_SETVA(dst, ui_) do { const int t_ = wid * 64 + lane_id(); _Pragma("unroll") for (int i_ = 0; i_ < 2; ++i_) { int R_, C_; stage_rc(t_ * 16 + i_ * 8192, R_, C_); \
        _Pragma("unroll") for (int h_ = 0; h_ < 2; ++h_) dst[h_][i_] = (GATHER ? rowtab[(ui_) * 256 + h_ * 128 + R_] : (unsigned)((h_ * 128 + R_) * g.lda) * 2u) + (unsigned)C_ * 2u; } } while (0)
#define PG8_SA(b, h) (((b) * 2 + (h)) * HTB)
#define PG8_SB(b, h) ((4 + (b) * 2 + (h)) * HTB)
#define PG8_GLDS_S(gbase_, voff_, ldsaddr_) do { unsigned keep_; asm volatile("s_mov_b32 %0, m0\n\ts_mov_b32 m0, %3\n\ts_nop 0\n\tglobal_load_lds_dwordx4 %1, %2\n\ts_mov_b32 m0, %0" \
        : "=&s"(keep_) : "v"(voff_), "s"(gbase_), "s"(ldsaddr_) : "memory"); } while (0)
#define PG8_STAGE(bufoff, gbase, v0, v1) do { \
        if constexpr (FP8) { const unsigned la_ = (unsigned)(uintptr_t)(lds + (bufoff) + ldsw); PG8_GLDS_S((const char*)(gbase), (v0), la_); PG8_GLDS_S((const char*)(gbase), (v1), la_ + 8192u); } else { \
        __builtin_amdgcn_global_load_lds((const unsigned*)((const char*)(gbase) + (v0)), (LAS unsigned*)(lds + (bufoff) + ldsw), 16, 0, 0); \
        __builtin_amdgcn_global_load_lds((const unsigned*)((const char*)(gbase) + (v1)), (LAS unsigned*)(lds + (bufoff) + ldsw + 8192), 16, 0, 0); } } while (0)
#define PG8_STB(bufoff, gbase) PG8_STAGE(bufoff, gbase, voffB[0], voffB[1])
#define PG8_LDA(dst, b, h) do { _Pragma("unroll") for (int m = 0; m < 4; ++m) _Pragma("unroll") for (int k = 0; k < 2; ++k) dst[m][k] = *(const LAS bf16x8*)(lds + PG8_SA(b, h) + aoff + m * 2048 + k * 1024); } while (0)
#define PG8_LDB(dst, b, h) do { _Pragma("unroll") for (int n = 0; n < 2; ++n) _Pragma("unroll") for (int k = 0; k < 2; ++k) dst[n][k] = *(const LAS bf16x8*)(lds + PG8_SB(b, h) + boff + n * 2048 + k * 1024); } while (0)
#define PG8_MMA(ai, bj, At, Bt) do { __builtin_amdgcn_s_setprio(1); \
        if constexpr (FP8) { _Pragma("unroll") for (int m = 0; m < 4; ++m) _Pragma("unroll") for (int n = 0; n < 2; ++n) { \
            const v8i32 a8_ = __builtin_shufflevector(__builtin_bit_cast(v4i32, At[m][0]), __builtin_bit_cast(v4i32, At[m][1]), 0, 1, 2, 3, 4, 5, 6, 7); \
            const v8i32 b8_ = __builtin_shufflevector(__builtin_bit_cast(v4i32, Bt[n][0]), __builtin_bit_cast(v4i32, Bt[n][1]), 0, 1, 2, 3, 4, 5, 6, 7); \
            acc[ai][bj][m][n] = __builtin_amdgcn_mfma_scale_f32_16x16x128_f8f6f4(b8_, a8_, acc[ai][bj][m][n], 0, 0, 0, 0, 0, 0); } } \
        else { _Pragma("unroll") for (int m = 0; m < 4; ++m) _Pragma("unroll") for (int n = 0; n < 2; ++n) _Pragma("unroll") for (int k = 0; k < 2; ++k) \
            acc[ai][bj][m][n] = __builtin_amdgcn_mfma_f32_16x16x32_bf16(Bt[n][k], At[m][k], acc[ai][bj][m][n], 0, 0, 0); } \
        __builtin_amdgcn_s_setprio(0); } while (0)
#define PG8_WAIT_V(n) asm volatile("s_waitcnt vmcnt(" #n ")" ::: "memory")
#define PG8_WAIT_L(n) asm volatile("s_waitcnt lgkmcnt(" #n ")" ::: "memory")
#define PG8_BAR __builtin_amdgcn_s_barrier()
#define PG8_SCHED __builtin_amdgcn_sched_barrier(0)
#define PG8_SCHED8 do { if constexpr (FP8) __builtin_amdgcn_sched_barrier(0); } while (0)
    Unit cur, nxt; int ui = 0;
#define PG8_UNI(u_) do { u_.pm = __builtin_amdgcn_readfirstlane(u_.pm); u_.pn = __builtin_amdgcn_readfirstlane(u_.pn); u_.pb = __builtin_amdgcn_readfirstlane(u_.pb); u_.aux = __builtin_amdgcn_readfirstlane(u_.aux); u_.aux2 = __builtin_amdgcn_readfirstlane(u_.aux2); } while (0)
    if (!S.next(0, cur)) return;
    PG8_UNI(cur);
    f32x4 acc[2][2][4][2];
#pragma unroll
    for (int a = 0; a < 2; ++a)
#pragma unroll
        for (int b = 0; b < 2; ++b)
#pragma unroll
            for (int m = 0; m < 4; ++m)
#pragma unroll
                for (int n = 0; n < 2; ++n) acc[a][b][m][n] = (f32x4){0.f, 0.f, 0.f, 0.f};
    bf16x8 At[4][2], B0[2][2], B1[2][2];
    const char* cA = (const char*)g.A + (GATHER ? (size_t)0 : (size_t)cur.pm * tstepA); const char* cB = (const char*)g.Bt + (size_t)cur.pb * tstepB;
    PG8_SETVA(vAc, 0);
    PG8_STB(PG8_SB(0, 0), cB); PG8_STB(PG8_SB(0, 1), cB + hstepB); PG8_STAGE(PG8_SA(0, 0), cA, vAc[0][0], vAc[0][1]); PG8_STAGE(PG8_SA(0, 1), cA, vAc[1][0], vAc[1][1]);
    if (wr == 1) PG8_BAR;
    PG8_WAIT_V(2); PG8_BAR;
    PG8_STB(PG8_SB(1, 0), cB + kstep); PG8_STAGE(PG8_SA(1, 0), cA + kstep, vAc[0][0], vAc[0][1]); PG8_STB(PG8_SB(1, 1), cB + hstepB + kstep);
    PG8_WAIT_V(6); PG8_BAR;
    for (;;) {
        const bool has_next = S.next(ui + 1, nxt);
        PG8_UNI(nxt);
        const char* nA = GATHER ? cA : (has_next ? (const char*)g.A + (size_t)nxt.pm * tstepA : cA); const char* nB = has_next ? (const char*)g.Bt + (size_t)nxt.pb * tstepB : cB;
        const int nui = has_next ? ui + 1 : ui;
#pragma nounroll
        for (int t = 0; t < nt; t += 2) {
            const bool last = (t == nt - 2);
            const char* a1 = cA + (size_t)(t + 1) * kstep;
            const char* a2 = last ? nA : cA + (size_t)(t + 2) * kstep; const char* b2 = last ? nB : cB + (size_t)(t + 2) * kstep;
            const char* a3 = a2 + kstep; const char* b3 = b2 + kstep;
            unsigned x00 = vAc[0][0], x01 = vAc[0][1], x10 = vAc[1][0], x11 = vAc[1][1];
            if (GATHER) { if (last) { unsigned vN_[2][2]; PG8_SETVA(vN_, nui); x00 = vN_[0][0]; x01 = vN_[0][1]; x10 = vN_[1][0]; x11 = vN_[1][1]; } }
            PG8_LDB(B0, 0, 0); PG8_LDB(B1, 0, 1); PG8_SCHED; PG8_LDA(At, 0, 0); PG8_STAGE(PG8_SA(1, 1), a1, vAc[1][0], vAc[1][1]);
            PG8_WAIT_V(8); PG8_WAIT_L(0); PG8_BAR; PG8_SCHED8; PG8_MMA(0, 0, At, B0); PG8_MMA(0, 1, At, B1); PG8_SCHED8; PG8_BAR; PG8_SCHED;
            PG8_LDA(At, 0, 1); PG8_STB(PG8_SB(0, 0), b2); PG8_STB(PG8_SB(0, 1), b2 + hstepB); PG8_STAGE(PG8_SA(0, 0), a2, x00, x01);
            PG8_WAIT_V(8); PG8_WAIT_L(0); PG8_BAR; PG8_SCHED8; PG8_MMA(1, 0, At, B0); PG8_MMA(1, 1, At, B1); PG8_SCHED8; PG8_BAR; PG8_SCHED;
            PG8_LDB(B0, 1, 0); PG8_LDB(B1, 1, 1); PG8_SCHED; PG8_LDA(At, 1, 0); PG8_STAGE(PG8_SA(0, 1), a2, x10, x11);
            PG8_WAIT_V(8); PG8_WAIT_L(0); PG8_BAR; PG8_SCHED8; PG8_MMA(0, 0, At, B0); PG8_MMA(0, 1, At, B1); PG8_SCHED8; PG8_BAR; PG8_SCHED;
            PG8_LDA(At, 1, 1); PG8_STB(PG8_SB(1, 0), b3); PG8_STB(PG8_SB(1, 1), b3 + hstepB); PG8_STAGE(PG8_SA(1, 0), a3, x00, x01);
            PG8_WAIT_V(8); PG8_WAIT_L(0); PG8_BAR; PG8_SCHED8; PG8_MMA(1, 0, At, B0); PG8_MMA(1, 1, At, B1); PG8_SCHED8; PG8_BAR; PG8_SCHED;
        }
        if constexpr (ALIGN_EPI) { if (wr == 0) PG8_BAR; }
        { int l_ = lane_id(); asm volatile("" : "+v"(l_));
          E(acc, cur, wr, wc, l_ & 15, l_ >> 4); }
        if (!has_next) break;
#pragma unroll
        for (int a = 0; a < 2; ++a)
#pragma unroll
            for (int b = 0; b < 2; ++b)
#pragma unroll
                for (int m = 0; m < 4; ++m)
#pragma unroll
                    for (int n = 0; n < 2; ++n) acc[a][b][m][n] = (f32x4){0.f, 0.f, 0.f, 0.f};
        cur = nxt; cA = nA; cB = nB; ++ui;
        if (GATHER) { PG8_SETVA(vAc, ui); }
        if constexpr (ALIGN_EPI) { if (wr == 1) PG8_BAR; }
    }
    PG8_WAIT_V(0);
    if constexpr (!ALIGN_EPI) { if (wr == 0) PG8_BAR; }
    PG8_BAR;
#undef PG8_SETVA
#undef PG8_UNI
#undef PG8_SA
#undef PG8_SB
#undef PG8_STAGE
#undef PG8_GLDS_S
#undef PG8_STB
#undef PG8_LDA
#undef PG8_LDB
#undef PG8_MMA
#undef PG8_WAIT_V
#undef PG8_WAIT_L
#undef PG8_BAR
#undef PG8_SCHED
#undef PG8_SCHED8
}
}
constexpr int NWAVES = 8, NTHR = 512;
constexpr int BATCH = 8, SEQ = 8192, T = BATCH * SEQ, D = 1024, DIN = 4096;
constexpr int DS = 512, DA = 512, NH = 8, HD = 64, NBLK = SEQ / 256;
constexpr int SG = 32, SHC = 16, SP = 64, SL = 32, SKU = SL * SHC  , SKS = 2 * SP  , SKY = SKU + SKS  , SROWS = T / SL  ;
constexpr int NE = 32, DE = 512;
constexpr float RMS_EPS = 1e-6f;
constexpr float LOG2E = 1.4426950408889634f;
constexpr float QSCALE = 0.125f * LOG2E;
constexpr float WF8_SCALE = 32.f;
constexpr int ROWCAP = T;
constexpr int HID_ROWS = 2 * T + NE * 256;

constexpr size_t MiB = 1u << 20;
constexpr size_t WS_CTL = 0, CTL_ZERO_BYTES = 1 * MiB;
constexpr size_t WS_WIN = 1 * MiB;
constexpr size_t WS_WGLU = 9 * MiB;
constexpr size_t WS_WUS = 10 * MiB;
constexpr size_t WS_WUA = 11 * MiB;
constexpr size_t WS_WOUT = 12 * MiB;
constexpr size_t WS_WR = 14 * MiB;
constexpr size_t WS_KMEAN = 15 * MiB;
constexpr size_t WS_SSMW = 16 * MiB;
constexpr size_t WS_SSMT = 24 * MiB;
constexpr size_t WS_W13 = 44 * MiB;
constexpr size_t WS_W2 = 108 * MiB;
constexpr size_t WS_A0 = 140 * MiB;
constexpr size_t WS_UP = 276 * MiB;
constexpr size_t WS_Q = 356 * MiB;
constexpr size_t WS_SSQ = 404 * MiB;
constexpr size_t WS_RLOG = 408 * MiB;
constexpr size_t WS_K = 420 * MiB;
constexpr size_t WS_ROWTOK = 428 * MiB, WS_ROWCOEF = 436 * MiB, WS_ROWRSTD = 444 * MiB;
constexpr size_t WS_GACT = 420 * MiB;
constexpr size_t WS_V = 484 * MiB;
constexpr size_t WS_YSSM = 484 * MiB;
constexpr size_t WS_SGS = 548 * MiB;
constexpr size_t WS_SGA = 676 * MiB;
constexpr size_t WS_E = 804 * MiB;
constexpr size_t WS_YATT = 836 * MiB;
constexpr size_t WS_PART0 = 420 * MiB, WS_PART1 = 484 * MiB, WS_PART2 = 932 * MiB;
constexpr size_t WS_QLIST = 900 * MiB;
constexpr size_t WS_PL = 268 * MiB;
constexpr size_t WS_MQ = 996 * MiB;
constexpr size_t WS_H1F8 = 836 * MiB;
constexpr size_t WS_WINF8 = 900 * MiB;
constexpr size_t WS_XGF8 = 836 * MiB;
constexpr size_t WS_SEGC = 998 * MiB;
constexpr size_t WS_END = 999 * MiB;
constexpr size_t WS_KFRAG = WS_A0, WS_VFRAG = WS_A0 + 64 * MiB, WS_H1 = WS_A0, WS_MRG = WS_A0, WS_HID = WS_A0;
constexpr size_t WS_X1 = WS_SGS, WS_XG = WS_UP, WS_Y0 = WS_UP, WS_Y1 = WS_E;
static_assert(WS_GACT + 64 * MiB <= WS_YSSM && WS_YSSM + 64 * MiB <= WS_SGS, "map");
static_assert(WS_HID + (size_t)HID_ROWS * DE * 2 <= WS_UP, "hid fits");
static_assert(WS_RLOG + (size_t)T * 72 * 4 <= WS_ROWTOK, "rlog fits");

constexpr int CW_TMO = 0, CW_CODE = 1;
constexpr int CW_BAR = 4096;
constexpr int CW_ECNT = 8192;
constexpr int CW_GCNT = 12288;

constexpr int RING_BYTES = 131072;
constexpr int ROWTAB_OFF = RING_BYTES, ROWTAB_UNITS = 12, ROWTAB_BYTES = 25 * 1024;
constexpr int MOE_TST_OFF = ROWTAB_OFF + ROWTAB_BYTES;
constexpr int MISC_OFF = MOE_TST_OFF + 512;
constexpr int LDS_BYTES = MISC_OFF + 128;
static_assert(LDS_BYTES <= 163840, "LDS");

struct Frame {
    LAS unsigned char* lds;
    volatile LAS unsigned* MISC;
    gu32* ctl;
    unsigned char* ws;
    int tid, lane, wave, vcu, G;
    const float* in[27];
    float* out;
};

__device__ __forceinline__ unsigned pk4_fp8(float a, float b, float c, float d) { int w = 0; w = __builtin_amdgcn_cvt_pk_fp8_f32(a, b, w, false); w = __builtin_amdgcn_cvt_pk_fp8_f32(c, d, w, true); return (unsigned)w; }
#define EPI_LOOP_BEGIN  _Pragma("unroll") for (int ai = 0; ai < 2; ++ai) _Pragma("unroll") for (int m = 0; m < 4; ++m) { const int rl = ai * 128 + wr * 64 + m * 16 + fr; _Pragma("unroll") for (int bj = 0; bj < 2; ++bj) { const int cl = bj * 128 + wc * 32 + 8 * fq; \
        const f32x4 a0 = acc[ai][bj][m][0], a1 = acc[ai][bj][m][1]; (void)rl; (void)cl; (void)a0; (void)a1;
#define EPI_LOOP_END } }
typedef const f32x4 (&AccRef)[2][2][4][2];
__device__ __forceinline__ u32x4 pack8(f32x4 a, f32x4 b) { u32x4 w; w.x = cvt_pk_bf16(a[0], a[1]); w.y = cvt_pk_bf16(a[2], a[3]); w.z = cvt_pk_bf16(b[0], b[1]); w.w = cvt_pk_bf16(b[2], b[3]); return w; }
__device__ __forceinline__ void unpack8(u32x4 w, f32x4& a, f32x4& b) { a = (f32x4){bflo(w.x), bfhi(w.x), bflo(w.y), bfhi(w.y)}; b = (f32x4){bflo(w.z), bfhi(w.z), bflo(w.w), bfhi(w.w)}; }

template <int PART  > struct EpiProj {
    unsigned char* ws; const float* b_gate; int pn_off; float ascale;
    __device__ __forceinline__ void operator()(AccRef acc, const pg8::Unit& u, int wr, int wc, int fr, int fq) const {
        const int pn = u.pn + pn_off; const int row0 = u.pm * 256;
        if (PART == 0) {
            bf16_t* Uperm = (bf16_t*)(ws + WS_UP);
            EPI_LOOP_BEGIN
                const int row = row0 + rl, col = pn * 256 + cl;
                bf16_t* dst = Uperm + (size_t)(col >> 4) * ((size_t)SROWS * SKY) + (size_t)(row >> 5) * SKY + (row & 31) * 16 + (col & 15);
                *(u32x4*)dst = pack8(a0 * ascale, a1 * ascale);
            EPI_LOOP_END
        } else if (pn < 8) {
            const size_t boff = pn < 4 ? WS_Q : (pn < 6 ? WS_K : WS_V);
            bf16_t* base = (bf16_t*)(ws + boff); const float sc = pn < 4 ? QSCALE : 1.f; const int c0 = (pn & 1) * 256;
            EPI_LOOP_BEGIN
                const int row = row0 + rl, col = c0 + cl;
                *(u32x4*)(base + (size_t)row * 512 + col) = pack8(a0 * (sc * ascale), a1 * (sc * ascale));
            EPI_LOOP_END
        } else {
            const size_t boff = pn < 12 ? WS_SGS : WS_SGA;
            bf16_t* base = (bf16_t*)(ws + boff); const int c0 = ((pn - 8) & 3) * 256; const float* bg = b_gate + (pn - 8) * 256;
            EPI_LOOP_BEGIN
                const int row = row0 + rl, col = c0 + cl;
                const f32x4 b0 = *(const f32x4*)(bg + cl), b1 = *(const f32x4*)(bg + cl + 4);
                f32x4 s0, s1;
#pragma unroll
                for (int e = 0; e < 4; ++e) { s0[e] = fast_sigmoid(a0[e] * ascale + b0[e]); s1[e] = fast_sigmoid(a1[e] * ascale + b1[e]); }
                *(u32x4*)(base + (size_t)row * 1024 + col) = pack8(s0, s1);
            EPI_LOOP_END
        }
    }
};
struct EpiSsmE {
    float* E;
    __device__ __forceinline__ void operator()(AccRef acc, const pg8::Unit& u, int wr, int wc, int fr, int fq) const {
        EPI_LOOP_BEGIN
            if (bj == 0) { float* dst = E + (size_t)(u.pm * 256 + rl) * 128 + cl; *(f32x4*)dst = a0; *(f32x4*)(dst + 4) = a1; }
        EPI_LOOP_END
    }
};
__device__ __forceinline__ float gelu_tanh(float x) { const float z = 1.5957691216057308f * (x + 0.044715f * x * x * x); return x * fast_sigmoid(z); }
struct EpiSsmY {
    bf16_t* Gact;
    __device__ __forceinline__ void operator()(AccRef acc, const pg8::Unit& u, int wr, int wc, int fr, int fq) const {
        const int g = u.aux;
        EPI_LOOP_BEGIN
            const int rg = (u.pm & 7) * 256 + rl;
            const int colg = u.pn * 256 + cl;
            const int tok = (rg >> 8) * SEQ + (rg & 255) * SL + (colg >> 4);
            f32x4 y0, y1;
#pragma unroll
            for (int e = 0; e < 4; ++e) { y0[e] = gelu_tanh(a0[e]); y1[e] = gelu_tanh(a1[e]); }
            *(u32x4*)(Gact + (size_t)tok * DS + g * 16 + (colg & 15)) = pack8(y0, y1);
        EPI_LOOP_END
    }
};
#define EPI_SBAR __builtin_amdgcn_sched_barrier(0)
#define EPI_G(g_) const int ai = (g_) >> 2, m = (g_) & 3; const int rl = ai * 128 + wr * 64 + m * 16 + fr; (void)rl
struct EpiGlu {
    const bf16_t* Gact; bf16_t* Yssm; const float* b_glu;
    __device__ __forceinline__ void operator()(AccRef acc, const pg8::Unit& u, int wr, int wc, int fr, int fq) const {
        const int col0 = u.pn * 256 + wc * 32 + 8 * fq; const size_t rowb = (size_t)u.pm * 256;
        f32x4 bv[2][2]; u32x4 gv[8][2];
#pragma unroll
        for (int bj = 0; bj < 2; ++bj) { bv[bj][0] = *(const f32x4*)(b_glu + col0 + bj * 128); bv[bj][1] = *(const f32x4*)(b_glu + col0 + bj * 128 + 4); }
#pragma unroll
        for (int g = 0; g < 8; ++g) { EPI_G(g);
#pragma unroll
            for (int bj = 0; bj < 2; ++bj) gv[g][bj] = *(const u32x4*)(Gact + (rowb + rl) * DS + col0 + bj * 128); }
        EPI_SBAR;
#pragma unroll
        for (int g = 0; g < 8; ++g) { EPI_G(g);
#pragma unroll
            for (int bj = 0; bj < 2; ++bj) { f32x4 g0, g1; unpack8(gv[g][bj], g0, g1); const f32x4 a0 = acc[ai][bj][m][0], a1 = acc[ai][bj][m][1]; f32x4 y0, y1;
#pragma unroll
                for (int e = 0; e < 4; ++e) { y0[e] = g0[e] * fast_sigmoid(a0[e] + bv[bj][0][e]); y1[e] = g1[e] * fast_sigmoid(a1[e] + bv[bj][1][e]); }
                *(u32x4*)(Yssm + (rowb + rl) * DS + col0 + bj * 128) = pack8(y0, y1); } }
    }
};
template <bool SECOND> struct EpiUp {
    const bf16_t* SG; bf16_t* Mrg;
    __device__ __forceinline__ void operator()(AccRef acc, const pg8::Unit& u, int wr, int wc, int fr, int fq) const {
        const size_t base = (size_t)u.pm * 256 * D + u.pn * 256 + wc * 32 + 8 * fq;
        u32x4 sv[2][2][2], mv[2][2][2];
#define UP_LOAD(buf_, bt_) do { _Pragma("unroll") for (int gi_ = 0; gi_ < 2; ++gi_) { EPI_G(2 * (bt_) + gi_); _Pragma("unroll") for (int bj = 0; bj < 2; ++bj) { const size_t off = base + (size_t)rl * D + bj * 128; \
            sv[buf_][gi_][bj] = *(const u32x4*)(SG + off); if (SECOND) mv[buf_][gi_][bj] = *(const u32x4*)(Mrg + off); } } } while (0)
#define UP_PROC(buf_, bt_) do { _Pragma("unroll") for (int gi_ = 0; gi_ < 2; ++gi_) { EPI_G(2 * (bt_) + gi_); _Pragma("unroll") for (int bj = 0; bj < 2; ++bj) { const size_t off = base + (size_t)rl * D + bj * 128; \
            f32x4 s0, s1; unpack8(sv[buf_][gi_][bj], s0, s1); f32x4 y0 = s0 * acc[ai][bj][m][0], y1 = s1 * acc[ai][bj][m][1]; \
            if (SECOND) { f32x4 p0, p1; unpack8(mv[buf_][gi_][bj], p0, p1); y0 += p0; y1 += p1; } \
            *(u32x4*)(Mrg + off) = pack8(y0, y1); } } } while (0)
        UP_LOAD(0, 0); UP_LOAD(1, 1); EPI_SBAR;
        UP_PROC(0, 0); UP_LOAD(0, 2); EPI_SBAR;
        UP_PROC(1, 1); UP_LOAD(1, 3); EPI_SBAR;
        UP_PROC(0, 2); EPI_SBAR;
        UP_PROC(1, 3);
#undef UP_LOAD
#undef UP_PROC
    }
};
struct EpiOut {
    const float* x; bf16_t* X1; bf16_t* XG; unsigned char* XG8; const float* g2; float* SSQ;
    __device__ __forceinline__ void operator()(AccRef acc, const pg8::Unit& u, int wr, int wc, int fr, int fq) const {
        const int col0 = u.pn * 256 + wc * 32 + 8 * fq; const size_t base = (size_t)u.pm * 256 * D + col0;
        f32x4 wv[2][2];
#pragma unroll
        for (int bj = 0; bj < 2; ++bj) { wv[bj][0] = *(const f32x4*)(g2 + col0 + bj * 128); wv[bj][1] = *(const f32x4*)(g2 + col0 + bj * 128 + 4); }
        f32x4 xv[2][2][2][2];
#define OUT_LOAD(buf_, bt_) do { _Pragma("unroll") for (int gi_ = 0; gi_ < 2; ++gi_) { EPI_G(2 * (bt_) + gi_); _Pragma("unroll") for (int bj = 0; bj < 2; ++bj) { const size_t off = base + (size_t)rl * D + bj * 128; \
            xv[buf_][gi_][bj][0] = *(const f32x4*)(x + off); xv[buf_][gi_][bj][1] = *(const f32x4*)(x + off + 4); } } } while (0)
#define OUT_PROC(buf_, bt_) do { _Pragma("unroll") for (int gi_ = 0; gi_ < 2; ++gi_) { EPI_G(2 * (bt_) + gi_); float ss = 0.f; _Pragma("unroll") for (int bj = 0; bj < 2; ++bj) { const size_t off = base + (size_t)rl * D + bj * 128; \
            const f32x4 x0 = xv[buf_][gi_][bj][0] + acc[ai][bj][m][0], x1 = xv[buf_][gi_][bj][1] + acc[ai][bj][m][1]; \
            *(u32x4*)(X1 + off) = pack8(x0, x1); \
            ss += (x0[0] * x0[0] + x0[1] * x0[1]) + (x0[2] * x0[2] + x0[3] * x0[3]) + (x1[0] * x1[0] + x1[1] * x1[1]) + (x1[2] * x1[2] + x1[3] * x1[3]); \
            const f32x4 y0 = x0 * wv[bj][0], y1 = x1 * wv[bj][1]; \
            *(u32x4*)(XG + off) = pack8(y0, y1); *(u32x2*)(XG8 + off) = (u32x2){pk4_fp8(y0[0], y0[1], y0[2], y0[3]), pk4_fp8(y1[0], y1[1], y1[2], y1[3])}; } \
            ss += __shfl_xor(ss, 16); ss += __shfl_xor(ss, 32); \
            SSQ[((size_t)u.pm * 256 + rl) * 16 + u.pn * 4 + wc] = ss; } } while (0)
        OUT_LOAD(0, 0); OUT_LOAD(1, 1); EPI_SBAR;
        OUT_PROC(0, 0); OUT_LOAD(0, 2); EPI_SBAR;
        OUT_PROC(1, 1); OUT_LOAD(1, 3); EPI_SBAR;
        OUT_PROC(0, 2); EPI_SBAR;
        OUT_PROC(1, 3);
#undef OUT_LOAD
#undef OUT_PROC
    }
};
struct EpiRouter {
    float* Rlog;
    __device__ __forceinline__ void operator()(AccRef acc, const pg8::Unit& u, int wr, int wc, int fr, int fq) const {
        EPI_LOOP_BEGIN
            if (bj == 0 && cl < 72) { float* dst = Rlog + (size_t)(u.pm * 256 + rl) * 72 + cl; *(f32x4*)dst = a0; *(f32x4*)(dst + 4) = a1; }
        EPI_LOOP_END
    }
};
struct EpiMoe1 {
    unsigned char* Hid; const float* rowrstd; const unsigned* ecnt; float ascale;
    __device__ __forceinline__ void operator()(AccRef acc, const pg8::Unit& u, int wr, int wc, int fr, int fq) const {
        const int e = u.aux, cnt = (int)ecnt[e]; float rsv[8];
#pragma unroll
        for (int g = 0; g < 8; ++g) { EPI_G(g); const int pos = u.aux2 + rl; rsv[g] = rowrstd[(size_t)e * ROWCAP + (pos < cnt ? pos : 0)] * ascale; }
        EPI_SBAR;
#pragma unroll
        for (int g = 0; g < 8; ++g) { EPI_G(g); const int pos = u.aux2 + rl;
            if (pos < cnt) { const float rs = rsv[g]; f32x4 h0, h1;
#pragma unroll
                for (int k = 0; k < 4; ++k) { const float p = acc[ai][0][m][0][k] * rs, q = acc[ai][1][m][0][k] * rs; h0[k] = p * fast_sigmoid(p) * q;
                    const float p2 = acc[ai][0][m][1][k] * rs, q2 = acc[ai][1][m][1][k] * rs; h1[k] = p2 * fast_sigmoid(p2) * q2; }
                *(u32x2*)(Hid + (size_t)(u.pm * 256 + rl) * DE + u.pn * 128 + wc * 32 + 8 * fq) = (u32x2){pk4_fp8(h0[0], h0[1], h0[2], h0[3]), pk4_fp8(h1[0], h1[1], h1[2], h1[3])}; } }
    }
};
struct EpiMoe2 {
    bf16_t* Y0; size_t ydelta; const unsigned* rowtok; const float* rowcoef; const unsigned* ecnt; float ascale;
    __device__ __forceinline__ void operator()(AccRef acc, const pg8::Unit& u, int wr, int wc, int fr, int fq) const {
        const int e = u.aux, cnt = (int)ecnt[e]; unsigned tkv[8]; float cfv[8];
#pragma unroll
        for (int g = 0; g < 8; ++g) { EPI_G(g); const int pos = u.aux2 + rl; const size_t ri = (size_t)e * ROWCAP + (pos < cnt ? pos : 0); tkv[g] = rowtok[ri]; cfv[g] = rowcoef[ri] * ascale; }
        EPI_SBAR;
#pragma unroll
        for (int g = 0; g < 8; ++g) { EPI_G(g); const int pos = u.aux2 + rl;
            if (pos < cnt) { const unsigned tk = tkv[g]; const float cf = cfv[g];
                bf16_t* dst = (bf16_t*)((unsigned char*)Y0 + (size_t)(tk & 1u) * ydelta) + (size_t)(tk >> 1) * D + u.pn * 256 + wc * 32 + 8 * fq;
#pragma unroll
                for (int bj = 0; bj < 2; ++bj) *(u32x4*)(dst + bj * 128) = pack8(acc[ai][bj][m][0] * cf, acc[ai][bj][m][1] * cf); } }
    }
};
__device__ __forceinline__ void transpose_item(const float* W, int N, int k0, int n0, bf16_t* WT, size_t drow0, int ldo, LAS float* scr, int lane) {
    float tv[32];
#pragma unroll
    for (int i = 0; i < 32; ++i) tv[i] = W[(size_t)(k0 + 2 * i + (lane >> 5)) * N + n0 + (lane & 31)];
#pragma unroll
    for (int i = 0; i < 32; ++i) scr[(2 * i + (lane >> 5)) * 33 + (lane & 31)] = tv[i];
    LDS_WAIT(); asm volatile("" ::: "memory");
    const int c = lane & 7;
#pragma unroll
    for (int j = 0; j < 4; ++j) { const int n = (lane >> 3) + 8 * j; const LAS float* s = scr + (8 * c) * 33 + n;
        u32x4 o; o.x = pk2(s[0 * 33], s[1 * 33]); o.y = pk2(s[2 * 33], s[3 * 33]); o.z = pk2(s[4 * 33], s[5 * 33]); o.w = pk2(s[6 * 33], s[7 * 33]);
        *(u32x4*)(WT + (drow0 + n) * (size_t)ldo + k0 + 8 * c) = o; }
    LDS_WAIT(); asm volatile("" ::: "memory");
}
__device__ __forceinline__ void transpose_item_f8(const float* W, int N, int k0, int n0, unsigned char* WT8, size_t drow0, int ldo, float scale, LAS float* scr, int lane) {
    float tv[32];
#pragma unroll
    for (int i = 0; i < 32; ++i) tv[i] = W[(size_t)(k0 + 2 * i + (lane >> 5)) * N + n0 + (lane & 31)];
#pragma unroll
    for (int i = 0; i < 32; ++i) scr[(2 * i + (lane >> 5)) * 33 + (lane & 31)] = tv[i] * scale;
    LDS_WAIT(); asm volatile("" ::: "memory");
    const int c = lane & 3;
#pragma unroll
    for (int j = 0; j < 2; ++j) { const int n = (lane >> 2) + 16 * j; const LAS float* s = scr + (16 * c) * 33 + n;
        u32x4 o; o.x = pk4_fp8(s[0 * 33], s[1 * 33], s[2 * 33], s[3 * 33]); o.y = pk4_fp8(s[4 * 33], s[5 * 33], s[6 * 33], s[7 * 33]);
        o.z = pk4_fp8(s[8 * 33], s[9 * 33], s[10 * 33], s[11 * 33]); o.w = pk4_fp8(s[12 * 33], s[13 * 33], s[14 * 33], s[15 * 33]);
        *(u32x4*)(WT8 + (drow0 + n) * (size_t)ldo + k0 + 16 * c) = o; }
    LDS_WAIT(); asm volatile("" ::: "memory");
}
template <int NR> __device__ __forceinline__ void rms_rows_to_bf16(int lane, const float* xrow, const float* g, bf16_t* orow, unsigned char* orow8) {
    f32x4 v[NR][4]; float s[NR];
#pragma unroll
    for (int r = 0; r < NR; ++r) { const f32x4* xr = (const f32x4*)(xrow + (size_t)r * D) + lane;
#pragma unroll
        for (int j = 0; j < 4; ++j) v[r][j] = xr[64 * j]; }
    const f32x4* gr = (const f32x4*)g + lane; f32x4 wv[4];
#pragma unroll
    for (int j = 0; j < 4; ++j) wv[j] = gr[64 * j];
#pragma unroll
    for (int r = 0; r < NR; ++r) { float a = 0.f;
#pragma unroll
        for (int j = 0; j < 4; ++j) a += (v[r][j].x * v[r][j].x + v[r][j].y * v[r][j].y) + (v[r][j].z * v[r][j].z + v[r][j].w * v[r][j].w);
        s[r] = a; }
#pragma unroll
    for (int o = 1; o < 64; o <<= 1) {
#pragma unroll
        for (int r = 0; r < NR; ++r) s[r] += __shfl_xor(s[r], o); }
#pragma unroll
    for (int r = 0; r < NR; ++r) { const float rstd = 1.f / sqrtf(s[r] * (1.f / D) + RMS_EPS); unsigned long long* o8 = (unsigned long long*)(orow + (size_t)r * D) + lane;
#pragma unroll
        for (int j = 0; j < 4; ++j) { const float y0 = v[r][j].x * rstd * wv[j].x, y1 = v[r][j].y * rstd * wv[j].y, y2 = v[r][j].z * rstd * wv[j].z, y3 = v[r][j].w * rstd * wv[j].w;
            o8[64 * j] = (unsigned long long)pk2(y0, y1) | ((unsigned long long)pk2(y2, y3) << 32);
            ((unsigned*)(orow8 + (size_t)r * D))[lane + 64 * j] = pk4_fp8(y0, y1, y2, y3); } }
}
__device__ __forceinline__ void cpow(float lr, float li, float step, float dl, float& ar, float& ai) {
    const float mag = __expf(dl * lr * step); const float rev = dl * (li * step * 0.15915494309189535f); const float fr = rev - floorf(rev);
    ar = mag * __builtin_amdgcn_cosf(fr); ai = mag * __builtin_amdgcn_sinf(fr);
}
__device__ __forceinline__ void ssm_gen(Frame& F, int g, int sl) {
    LAS float* AP = (LAS float*)(F.lds); LAS float* BB = AP + 33 * 64 * 2; LAS float* CC = BB + 2048; LAS float* KT = CC + 2048;
    const float* lam_re = F.in[4] + g * SP; const float* lam_im = F.in[5] + g * SP; const float step = __expf(F.in[6][g]);
    const float* b_re = F.in[7] + g * SP * SHC; const float* b_im = F.in[8] + g * SP * SHC; const float* c_re = F.in[9] + g * SHC * SP; const float* c_im = F.in[10] + g * SHC * SP; const float* dd = F.in[11] + g * SHC;
    bf16_t* BT = (bf16_t*)(F.ws + WS_SSMT) + (size_t)g * 512 * SKY; bf16_t* BW = (bf16_t*)(F.ws + WS_SSMW) + (size_t)g * 256 * SKU;
    const int tid = F.tid;
    for (int idx = tid; idx < 33 * 64; idx += NTHR) { const int dl = idx >> 6, p = idx & 63; float ar, ai; cpow(lam_re[p], lam_im[p], step, (float)dl, ar, ai); AP[idx * 2] = ar; AP[idx * 2 + 1] = ai; }
    for (int idx = tid; idx < 1024; idx += NTHR) { const int ho = idx >> 6, p = idx & 63; CC[idx * 2] = c_re[ho * 64 + p]; CC[idx * 2 + 1] = c_im[ho * 64 + p]; }
    __syncthreads();
    for (int idx = tid; idx < 1024; idx += NTHR) { const int p = idx >> 4, h = idx & 15; const float ar = AP[(64 + p) * 2], ai = AP[(64 + p) * 2 + 1];
        const float lr = lam_re[p], li = lam_im[p], nr = ar - 1.f, ni = ai, den = lr * lr + li * li, cr = (nr * lr + ni * li) / den, ci = (ni * lr - nr * li) / den;
        const float br = b_re[p * 16 + h], bi = b_im[p * 16 + h]; BB[idx * 2] = cr * br - ci * bi; BB[idx * 2 + 1] = cr * bi + ci * br; }
    __syncthreads();
    for (int idx = tid; idx < 1024; idx += NTHR) { const int dl = idx >> 5, hl = (idx >> 4) & 1, hi = idx & 15, ho = 2 * sl + hl; float s = 0.f;
        for (int p = 0; p < 64; ++p) { const float ar = AP[(dl * 64 + p) * 2], ai = AP[(dl * 64 + p) * 2 + 1], br = BB[(p * 16 + hi) * 2], bi = BB[(p * 16 + hi) * 2 + 1];
            const float zr = ar * br - ai * bi, zi = ar * bi + ai * br; s += CC[(ho * 64 + p) * 2] * zr - CC[(ho * 64 + p) * 2 + 1] * zi; }
        if (dl == 0 && ho == hi) s += dd[ho];
        KT[idx] = s; }
    __syncthreads();
    for (int v = tid; v < 64 * 80; v += NTHR) { const int nl = v / 80, kv = (v % 80) * 8, tau = nl >> 1, hl = nl & 1, ho = 2 * sl + hl, n = tau * 16 + ho; float val[8];
        if (kv < 512) { const int sg = kv >> 4, hi0 = kv & 15;
#pragma unroll
            for (int e = 0; e < 8; ++e) val[e] = (tau >= sg) ? KT[((tau - sg) * 2 + hl) * 16 + hi0 + e] : 0.f; }
        else { const int kk = kv - 512;
#pragma unroll
            for (int e = 0; e < 8; ++e) { const int p = (kk + e) >> 1, ri = (kk + e) & 1; const float ar = AP[((tau + 1) * 64 + p) * 2], ai = AP[((tau + 1) * 64 + p) * 2 + 1], cre = CC[(ho * 64 + p) * 2], cim = CC[(ho * 64 + p) * 2 + 1];
                val[e] = ri == 0 ? (cre * ar - cim * ai) : -(cre * ai + cim * ar); } }
        u32x4 o; o.x = pk2(val[0], val[1]); o.y = pk2(val[2], val[3]); o.z = pk2(val[4], val[5]); o.w = pk2(val[6], val[7]);
        *(u32x4*)(BT + (size_t)n * SKY + kv) = o; }
    for (int v = tid; v < 32 * 64; v += NTHR) { const int nl = v >> 6, kv = (v & 63) * 8; float val[8];
        const bool real = nl < 16; const int n = real ? 16 * sl + nl : 128 + 16 * sl + (nl - 16);
        if (real) { const int p = n >> 1, ri = n & 1, sg = kv >> 4, hi0 = kv & 15; const float ar = AP[((31 - sg) * 64 + p) * 2], ai = AP[((31 - sg) * 64 + p) * 2 + 1];
#pragma unroll
            for (int e = 0; e < 8; ++e) { const float br = BB[(p * 16 + hi0 + e) * 2], bi = BB[(p * 16 + hi0 + e) * 2 + 1]; val[e] = ri == 0 ? (ar * br - ai * bi) : (ar * bi + ai * br); } }
        else {
#pragma unroll
            for (int e = 0; e < 8; ++e) val[e] = 0.f; }
        u32x4 o; o.x = pk2(val[0], val[1]); o.y = pk2(val[2], val[3]); o.z = pk2(val[4], val[5]); o.w = pk2(val[6], val[7]);
        *(u32x4*)(BW + (size_t)n * SKU + kv) = o; }
    __syncthreads();
}
__device__ __forceinline__ void p0_prologue(Frame& F) {
    for (int it = F.vcu; it < SG * 8; it += F.G) ssm_gen(F, it >> 3, it & 7);
    LAS float* scr = (LAS float*)(F.lds + F.wave * 16384);
    const int gw = F.vcu * NWAVES + F.wave, NGW = F.G * NWAVES, lane = F.lane;
    constexpr int I_IN = 16 * 128, I_GLU = 8 * 16, I_US = 8 * 32, I_UA = 8 * 32, I_OUT = 16 * 32, I_W1 = 32 * 256, I_W3 = 32 * 256, I_W2 = 32 * 256;
    constexpr int NITEMS = I_IN + I_GLU + I_US + I_UA + I_OUT + I_W1 + I_W3 + I_W2;
    unsigned char* ws = F.ws;
    for (int it = gw; it < NITEMS; it += NGW) {
        int r = it;
        if (r < I_IN) { const int k0 = 64 * (r / 128), n0 = 32 * (r % 128);
            if (n0 < DS) transpose_item(F.in[2], DIN, k0, n0, (bf16_t*)(ws + WS_WIN), n0, D, scr, lane);
            else transpose_item_f8(F.in[2], DIN, k0, n0, ws + WS_WINF8, n0 - DS, D, WF8_SCALE, scr, lane);
            continue; } r -= I_IN;
        if (r < I_GLU) { transpose_item(F.in[12], DS, 64 * (r / 16), 32 * (r % 16), (bf16_t*)(ws + WS_WGLU), 32 * (r % 16), DS, scr, lane); continue; } r -= I_GLU;
        if (r < I_US) { transpose_item(F.in[14], D, 64 * (r / 32), 32 * (r % 32), (bf16_t*)(ws + WS_WUS), 32 * (r % 32), DS, scr, lane); continue; } r -= I_US;
        if (r < I_UA) { transpose_item(F.in[15], D, 64 * (r / 32), 32 * (r % 32), (bf16_t*)(ws + WS_WUA), 32 * (r % 32), DA, scr, lane); continue; } r -= I_UA;
        if (r < I_OUT) { transpose_item(F.in[17], D, 64 * (r / 32), 32 * (r % 32), (bf16_t*)(ws + WS_WOUT), 32 * (r % 32), D, scr, lane); continue; } r -= I_OUT;
        if (r < I_W1 + I_W3) { const int w3 = r >= I_W1; if (w3) r -= I_W1; const int e = r >> 8, q = r & 255, k0 = 64 * (q / 16), n0 = 32 * (q % 16);
            transpose_item_f8((w3 ? F.in[24] : F.in[23]) + (size_t)e * D * DE, DE, k0, n0, ws + WS_W13, (size_t)e * 1024 + 256 * (n0 >> 7) + (n0 & 127) + (w3 ? 128 : 0), D, WF8_SCALE, scr, lane); continue; }
        r -= I_W1 + I_W3;
        { const int e = r >> 8, q = r & 255, k0 = 64 * (q / 32), n0 = 32 * (q % 32);
            transpose_item_f8(F.in[25] + (size_t)e * DE * D, D, k0, n0, ws + WS_W2, (size_t)e * 1024 + n0, DE, WF8_SCALE, scr, lane); }
    }
    for (int m = 4 * gw; m < T; m += 4 * NGW) rms_rows_to_bf16<4>(lane, F.in[0] + (size_t)m * D, F.in[1], (bf16_t*)(ws + WS_H1) + (size_t)m * D, ws + WS_H1F8 + (size_t)m * D);
    { bf16_t* WR = (bf16_t*)(ws + WS_WR); const float* wrg = F.in[19]; const float* wre = F.in[21];
      for (int idx = F.vcu * NTHR + F.tid; idx < 256 * D; idx += F.G * NTHR) { const int r = idx >> 10, k = idx & 1023; unsigned o = 0u;
          if (r < 72) { const int c = r < 36 ? r : r - 36; const float w = c < 4 ? wrg[k * 4 + c] : wre[k * 32 + (c - 4)]; const unsigned hb = f2bf(w);
              o = r < 36 ? hb : f2bf(w - __builtin_bit_cast(float, hb << 16)); }
          WR[idx] = (bf16_t)o; } }
}

__device__ __forceinline__ int crow(int r, int hi) { return (r & 3) + 8 * (r >> 2) + 4 * hi; }
constexpr int KVP = 72;
__device__ __forceinline__ void kv_prep_phase(Frame& F) {
    LAS bf16_t* KS = (LAS bf16_t*)(F.lds); LAS bf16_t* VS = KS + 256 * KVP; LAS float* PS = (LAS float*)(F.lds + 2 * 256 * KVP * 2); LAS float* WM = PS + 512;
    const bf16_t* Kb = (const bf16_t*)(F.ws + WS_K); const bf16_t* Vb = (const bf16_t*)(F.ws + WS_V);
    bf16_t* Kf = (bf16_t*)(F.ws + WS_KFRAG); bf16_t* Vf = (bf16_t*)(F.ws + WS_VFRAG); bf16_t* KM = (bf16_t*)(F.ws + WS_KMEAN); float* KN = (float*)(F.ws + WS_KMEAN + 512 * 1024);
    const int tid = F.tid;
    for (int item = F.vcu; item < BATCH * NH * NBLK; item += F.G) {
        const int n = item & 31, h = (item >> 5) & 7, b = item >> 8; const size_t tok0 = (size_t)b * SEQ + 256 * n;
#pragma unroll
        for (int j = 0; j < 4; ++j) { const int q = tid + NTHR * j, row = q >> 3, pc = q & 7; const size_t src = (tok0 + row) * DA + h * HD + pc * 8;
            *(LAS u32x4*)(KS + row * KVP + pc * 8) = *(const u32x4*)(Kb + src); *(LAS u32x4*)(VS + row * KVP + pc * 8) = *(const u32x4*)(Vb + src); }
        __syncthreads();
#pragma unroll
        for (int j = 0; j < 4; ++j) { const int P = tid + NTHR * j, st = P >> 8, ds = (P >> 6) & 3, l2 = P & 63, row = 32 * st + (l2 & 31), col = 16 * ds + 8 * (l2 >> 5);
            *(u32x4*)(Kf + ((size_t)item * 2048 + P) * 8) = *(const LAS u32x4*)(KS + row * KVP + col); }
#pragma unroll
        for (int j = 0; j < 4; ++j) { const int P = tid + NTHR * j, st = P >> 8, ks = (P >> 7) & 1, d0 = (P >> 6) & 1, l2 = P & 63, hi = l2 >> 5, jj = l2 & 31; unsigned w[4];
#pragma unroll
            for (int e = 0; e < 8; e += 2) { const unsigned lo = VS[(32 * st + 16 * ks + crow(e, hi)) * KVP + 32 * d0 + jj], hi16 = VS[(32 * st + 16 * ks + crow(e + 1, hi)) * KVP + 32 * d0 + jj]; w[e >> 1] = lo | (hi16 << 16); }
            *(u32x4*)(Vf + ((size_t)item * 2048 + P) * 8) = (u32x4){w[0], w[1], w[2], w[3]}; }
        { const int d = tid & 63, part = tid >> 6; float s = 0.f;
#pragma unroll 8
          for (int r = 0; r < 32; ++r) s += bf2f(KS[(part * 32 + r) * KVP + d]);
          PS[part * 64 + d] = s; }
        if (tid < 256) { float ss = 0.f;
#pragma unroll
            for (int c = 0; c < 8; ++c) { const u32x4 w = *(const LAS u32x4*)(KS + tid * KVP + c * 8);
                ss += bflo(w.x) * bflo(w.x) + bfhi(w.x) * bfhi(w.x) + bflo(w.y) * bflo(w.y) + bfhi(w.y) * bfhi(w.y) + bflo(w.z) * bflo(w.z) + bfhi(w.z) * bfhi(w.z) + bflo(w.w) * bflo(w.w) + bfhi(w.w) * bfhi(w.w); }
            ss = wave_max(ss); if (F.lane == 0) WM[F.wave] = ss; }
        __syncthreads();
        if (tid < 64) { float s = 0.f;
#pragma unroll
            for (int p = 0; p < 8; ++p) s += PS[p * 64 + tid];
            KM[(size_t)item * 64 + tid] = (bf16_t)f2bf(s * (1.f / 256.f)); }
        if (tid == 0) KN[item] = fmaxf(fmaxf(WM[0], WM[1]), fmaxf(WM[2], WM[3]));
        __syncthreads();
    }
}

__device__ __forceinline__ void ssm_scan_phase(Frame& F) {
    LAS float* FW = (LAS float*)(F.lds);
    const float* E = (const float*)(F.ws + WS_E); bf16_t* UP = (bf16_t*)(F.ws + WS_UP);
    const int w = F.wave, p = F.lane;
    for (int gb = F.vcu; gb < SG * BATCH; gb += F.G) {
        const int g = gb >> 3, b = gb & 7;
        const float lr = F.in[4][g * SP + p], li = F.in[5][g * SP + p], step = __expf(F.in[6][g]);
        float ar, ai; cpow(lr, li, step, 32.f, ar, ai);
        const size_t row0 = (size_t)g * SROWS + b * 256 + 32 * w;
        f32x2 e[32];
#pragma unroll
        for (int j = 0; j < 32; ++j) e[j] = *(const f32x2*)(E + (row0 + j) * 128 + 2 * p);
        float sr = 0.f, si = 0.f;
#pragma unroll
        for (int j = 0; j < 32; ++j) { const float nr = ar * sr - ai * si + e[j].x, ni = ar * si + ai * sr + e[j].y; sr = nr; si = ni; }
        FW[(w * 64 + p) * 2] = sr; FW[(w * 64 + p) * 2 + 1] = si;
        __syncthreads();
        float Ar = ar, Ai = ai;
#pragma unroll
        for (int q = 0; q < 5; ++q) { const float nr = Ar * Ar - Ai * Ai, ni = 2.f * Ar * Ai; Ar = nr; Ai = ni; }
        sr = 0.f; si = 0.f;
        for (int w2 = 0; w2 < w; ++w2) { const float fr = FW[(w2 * 64 + p) * 2], fi = FW[(w2 * 64 + p) * 2 + 1]; const float nr = Ar * sr - Ai * si + fr, ni = Ar * si + Ai * sr + fi; sr = nr; si = ni; }
#pragma unroll
        for (int j = 0; j < 32; ++j) { *(unsigned*)(UP + (row0 + j) * SKY + SKU + 2 * p) = pk2(sr, si);
            const float nr = ar * sr - ai * si + e[j].x, ni = ar * si + ai * sr + e[j].y; sr = nr; si = ni; }
        __syncthreads();
    }
}

__device__ __forceinline__ int t5_bucket(int d) {
    if (d < 16) return d;
    return 16 + (d >= 19) + (d >= 21) + (d >= 24) + (d >= 27) + (d >= 31) + (d >= 35) + (d >= 40) + (d >= 46) + (d >= 52) + (d >= 59) + (d >= 67) + (d >= 77) + (d >= 87) + (d >= 99) + (d >= 113);
}
struct Top3 { float v0, v1, v2; int i0, i1, i2; };
__device__ __forceinline__ Top3 top3_insert(Top3 t, float x, int n) {
    const bool b0 = (x > t.v0) || (x == t.v0 && n < t.i0), b1 = (x > t.v1) || (x == t.v1 && n < t.i1), b2 = (x > t.v2) || (x == t.v2 && n < t.i2);
    Top3 r;
    r.v2 = b1 ? t.v1 : (b2 ? x : t.v2); r.i2 = b1 ? t.i1 : (b2 ? n : t.i2);
    r.v1 = b0 ? t.v0 : (b1 ? x : t.v1); r.i1 = b0 ? t.i0 : (b1 ? n : t.i1);
    r.v0 = b0 ? x : t.v0; r.i0 = b0 ? n : t.i0;
    return r;
}
constexpr int GQS = 0, GKME = 36864, GCNTL = 41472, GMISC = 41600;
template <bool COUNT> __device__ __forceinline__ void attn_gate_unit(Frame& F, int bh, int qb) {
    LAS unsigned char* L = F.lds;
    LAS bf16_t* QS = (LAS bf16_t*)(L + GQS); LAS bf16_t* KME = (LAS bf16_t*)(L + GKME); LAS int* CNT = (LAS int*)(L + GCNTL); LAS float* KNM = (LAS float*)(L + GMISC);
    int tid = F.tid; asm volatile("" : "+v"(tid));
    const int lane = tid & 63, w = F.wave, j = lane & 31, hi = lane >> 5;
    const int b = bh >> 3, h = bh & 7; const size_t tok0 = (size_t)b * SEQ + 256 * qb;
    const bf16_t* Qb = (const bf16_t*)(F.ws + WS_Q); const bf16_t* KM = (const bf16_t*)(F.ws + WS_KMEAN); const float* KN = (const float*)(F.ws + WS_KMEAN + 512 * 1024);
    float* MQg = (float*)(F.ws + WS_MQ); unsigned short* QL = (unsigned short*)(F.ws + WS_QLIST); unsigned* GC = (unsigned*)(F.ctl + CW_GCNT); unsigned* SEGC = (unsigned*)(F.ws + WS_SEGC);
#pragma unroll
    for (int jj = 0; jj < 4; ++jj) { const int q = tid + NTHR * jj, row = q >> 3, pc = q & 7; *(LAS u32x4*)(QS + row * KVP + pc * 8) = *(const u32x4*)(Qb + (tok0 + row) * DA + h * HD + pc * 8); }
    if (tid < 256) { const int n = tid >> 3, pc = tid & 7; *(LAS u32x4*)(KME + n * KVP + pc * 8) = *(const u32x4*)(KM + ((size_t)bh * 32 + n) * 64 + pc * 8); }
    if (tid < 32) CNT[tid] = 0;
    if (w == 1) { float v = (lane <= qb && lane < 32) ? KN[bh * 32 + lane] : 0.f; v = wave_max(v); if (lane == 0) KNM[0] = v; }
    if (w == 2) { float v = F.in[16][h * 32 + (lane & 31)]; v = wave_max(v); if (lane == 0) KNM[1] = v * LOG2E; }
    __syncthreads();
    {
        bf16x8 qf[4], kmf[4];
#pragma unroll
        for (int ds = 0; ds < 4; ++ds) { qf[ds] = *(const LAS bf16x8*)(QS + (32 * w + j) * KVP + 16 * ds + 8 * hi); kmf[ds] = *(const LAS bf16x8*)(KME + j * KVP + 16 * ds + 8 * hi); }
        f32x16 gt = {};
#pragma unroll
        for (int ds = 0; ds < 4; ++ds) gt = __builtin_amdgcn_mfma_f32_32x32x16_bf16(kmf[ds], qf[ds], gt, 0, 0, 0);
        float qn = 0.f;
#pragma unroll
        for (int ds = 0; ds < 4; ++ds)
#pragma unroll
            for (int e = 0; e < 8; ++e) { const float x = bf2f((unsigned short)qf[ds][e]); qn += x * x; }
        qn += __shfl_xor(qn, 32);
        const float m2 = sqrtf(qn * KNM[0]) + KNM[1];
        const int ql = 256 * qb + 32 * w + j;
        if (hi == 0) MQg[(size_t)bh * SEQ + ql] = m2;
        Top3 t3; t3.v0 = t3.v1 = t3.v2 = -INFINITY; t3.i0 = t3.i1 = t3.i2 = -1;
#pragma unroll
        for (int r = 0; r < 16; ++r) { const int n = crow(r, hi); const float x = (n < qb) ? gt[r] : -INFINITY; t3 = top3_insert(t3, x, x > -INFINITY ? n : 0x7fffffff); }
        { const float p0 = __shfl_xor(t3.v0, 32), p1 = __shfl_xor(t3.v1, 32), p2 = __shfl_xor(t3.v2, 32); const int q0 = __shfl_xor(t3.i0, 32), q1 = __shfl_xor(t3.i1, 32), q2 = __shfl_xor(t3.i2, 32);
          t3 = top3_insert(t3, p0, q0 >= 0 ? q0 : 0x7fffffff); t3 = top3_insert(t3, p1, q1 >= 0 ? q1 : 0x7fffffff); t3 = top3_insert(t3, p2, q2 >= 0 ? q2 : 0x7fffffff); }
        const int i0 = t3.v0 > -INFINITY ? t3.i0 : -1, i1 = t3.v1 > -INFINITY ? t3.i1 : -1, i2 = t3.v2 > -INFINITY ? t3.i2 : -1;
        if (hi == 0) { const unsigned e = (unsigned)ql << 2;
            if (i0 >= 0) { const int pos = __hip_atomic_fetch_add(CNT + i0, 1, __ATOMIC_RELAXED, __HIP_MEMORY_SCOPE_WORKGROUP); QL[((size_t)bh * 32 + i0) * SEQ + (qb - i0 - 1) * 256 + pos] = (unsigned short)(e | 0u); }
            if (i1 >= 0) { const int pos = __hip_atomic_fetch_add(CNT + i1, 1, __ATOMIC_RELAXED, __HIP_MEMORY_SCOPE_WORKGROUP); QL[((size_t)bh * 32 + i1) * SEQ + (qb - i1 - 1) * 256 + pos] = (unsigned short)(e | 1u); }
            if (i2 >= 0) { const int pos = __hip_atomic_fetch_add(CNT + i2, 1, __ATOMIC_RELAXED, __HIP_MEMORY_SCOPE_WORKGROUP); QL[((size_t)bh * 32 + i2) * SEQ + (qb - i2 - 1) * 256 + pos] = (unsigned short)(e | 2u); } }
    }
    __syncthreads();
    if (tid < qb) { const unsigned c = (unsigned)CNT[tid]; SEGC[((size_t)bh * 32 + tid) * 32 + (qb - tid - 1)] = c; if (COUNT && c) (void)__hip_atomic_fetch_add(GC + bh * 32 + tid, c, __ATOMIC_RELAXED, __HIP_MEMORY_SCOPE_AGENT); }
    __syncthreads();
}
template <bool COUNT> __device__ __forceinline__ void attn_gate_phase(Frame& F) {
    for (int u = F.vcu; u < BATCH * NH * NBLK; u += F.G) attn_gate_unit<COUNT>(F, u >> 5, u & 31);
}

#define ATTN_SUBTILE(KP, VP, st_, MODE, CINIT) do { \
        bf16x8 kf_[4], vf_[4]; \
        _Pragma("unroll") for (int ds_ = 0; ds_ < 4; ++ds_) kf_[ds_] = *(const LAS bf16x8*)((KP) + ((st_) * 4 + ds_) * 512 + lane8); \
        _Pragma("unroll") for (int q_ = 0; q_ < 4; ++q_) vf_[q_] = *(const LAS bf16x8*)((VP) + ((st_) * 4 + q_) * 512 + lane8); \
        f32x16 s_ = __builtin_amdgcn_mfma_f32_32x32x16_bf16(kf_[0], qf[0], CINIT, 0, 0, 0); \
        _Pragma("unroll") for (int ds_ = 1; ds_ < 4; ++ds_) s_ = __builtin_amdgcn_mfma_f32_32x32x16_bf16(kf_[ds_], qf[ds_], s_, 0, 0, 0); \
        float p_[16]; \
        if ((MODE) == 0) { _Pragma("unroll") for (int r_ = 0; r_ < 16; ++r_) p_[r_] = __builtin_amdgcn_exp2f(s_[r_]); } \
        else if ((MODE) == 1) { _Pragma("unroll") for (int r_ = 0; r_ < 16; ++r_) { const int dist_ = dq - (32 * (st_) + crow(r_, hi)); const int di_ = dist_ < 0 ? 0 : (dist_ > 127 ? 127 : dist_); \
                p_[r_] = __builtin_amdgcn_exp2f(s_[r_] + TABh[di_]); } } \
        else { _Pragma("unroll") for (int rq_ = 0; rq_ < 4; ++rq_) { const f32x4 bb_ = *(const LAS f32x4*)(BTD + rq_ * 256 + lane * 4); \
                _Pragma("unroll") for (int i_ = 0; i_ < 4; ++i_) p_[4 * rq_ + i_] = __builtin_amdgcn_exp2f(s_[4 * rq_ + i_] + bb_[i_]); } } \
        _Pragma("unroll") for (int r_ = 0; r_ < 16; ++r_) lsum += p_[r_]; \
        u32x4 pa_, pb_; pa_.x = cvt_pk_bf16(p_[0], p_[1]); pa_.y = cvt_pk_bf16(p_[2], p_[3]); pa_.z = cvt_pk_bf16(p_[4], p_[5]); pa_.w = cvt_pk_bf16(p_[6], p_[7]); \
        pb_.x = cvt_pk_bf16(p_[8], p_[9]); pb_.y = cvt_pk_bf16(p_[10], p_[11]); pb_.z = cvt_pk_bf16(p_[12], p_[13]); pb_.w = cvt_pk_bf16(p_[14], p_[15]); \
        const bf16x8 A0_ = __builtin_bit_cast(bf16x8, pa_), A1_ = __builtin_bit_cast(bf16x8, pb_); \
        o0 = __builtin_amdgcn_mfma_f32_32x32x16_bf16(vf_[0], A0_, o0, 0, 0, 0); o1 = __builtin_amdgcn_mfma_f32_32x32x16_bf16(vf_[1], A0_, o1, 0, 0, 0); \
        o0 = __builtin_amdgcn_mfma_f32_32x32x16_bf16(vf_[2], A1_, o0, 0, 0, 0); o1 = __builtin_amdgcn_mfma_f32_32x32x16_bf16(vf_[3], A1_, o1, 0, 0, 0); } while (0)

__device__ __forceinline__ u32x4 ot_pack16(const f32x16& o, int pr) {
    const unsigned p0 = cvt_pk_bf16(o[8 * pr], o[8 * pr + 1]), p1 = cvt_pk_bf16(o[8 * pr + 2], o[8 * pr + 3]), q0 = cvt_pk_bf16(o[8 * pr + 4], o[8 * pr + 5]), q1 = cvt_pk_bf16(o[8 * pr + 6], o[8 * pr + 7]);
    const auto r0 = __builtin_amdgcn_permlane32_swap(p0, q0, false, false); const auto r1 = __builtin_amdgcn_permlane32_swap(p1, q1, false, false);
    return (u32x4){r0[0], r1[0], r0[1], r1[1]};
}
__device__ __forceinline__ void ot_add16(f32x16& o, int pr, u32x4 v, bool use) {
    const auto r0 = __builtin_amdgcn_permlane32_swap(v.x, v.z, false, false); const auto r1 = __builtin_amdgcn_permlane32_swap(v.y, v.w, false, false);
    const unsigned p0 = r0[0], p1 = r1[0], q0 = r0[1], q1 = r1[1];
    o[8 * pr] += use ? bflo(p0) : 0.f; o[8 * pr + 1] += use ? bfhi(p0) : 0.f; o[8 * pr + 2] += use ? bflo(p1) : 0.f; o[8 * pr + 3] += use ? bfhi(p1) : 0.f;
    o[8 * pr + 4] += use ? bflo(q0) : 0.f; o[8 * pr + 5] += use ? bfhi(q0) : 0.f; o[8 * pr + 6] += use ? bflo(q1) : 0.f; o[8 * pr + 7] += use ? bfhi(q1) : 0.f;
}
__device__ __forceinline__ void attn_fill_tab(Frame& F, LAS float* TAB) {
    const float* rb = F.in[16];
    for (int idx = F.tid; idx < 8 * 132; idx += NTHR) { const int h = idx / 132, d = idx % 132; float v = 0.f;
        if (d < 128) v = rb[h * 32 + t5_bucket(d)] * LOG2E; else if (d == 129) v = rb[h * 32 + 31] * LOG2E;
        TAB[idx] = v; }
}
constexpr int BGPRE_OFF = ROWTAB_OFF, BGCL_OFF = ROWTAB_OFF + 8448, BTAB_OFF = ROWTAB_OFF + 16640, BIT_OFF = ROWTAB_OFF + 20992, BIT_MAX = 512, OTAB_OFF = ROWTAB_OFF + 20480  ;
static_assert(BTAB_OFF + 8 * 132 * 4 <= MOE_TST_OFF, "attention LDS tables");
__device__ __forceinline__ size_t part_off(int slot) { return slot == 0 ? WS_PART0 : (slot == 1 ? WS_PART1 : WS_PART2); }

__device__ __forceinline__ void attn_block_phase(Frame& F) {
    LAS unsigned char* L = F.lds; LAS int* GPRE = (LAS int*)(L + BGPRE_OFF); LAS int* GCL = (LAS int*)(L + BGCL_OFF); LAS float* TAB = (LAS float*)(L + BTAB_OFF); LAS int* ITT = (LAS int*)(L + BIT_OFF); LAS int* WSUM = (LAS int*)(L + MOE_TST_OFF);
    const unsigned* GC = (const unsigned*)(F.ctl + CW_GCNT); const unsigned* SEGC = (const unsigned*)(F.ws + WS_SEGC);
    const int tid = F.tid, lane = F.lane, w = F.wave, j = lane & 31, hi = lane >> 5, lane8 = lane * 8;
    { int ng[4], tot = 0;
#pragma unroll
      for (int e = 0; e < 4; ++e) { const int c = (int)GC[4 * tid + e]; GCL[4 * tid + e] = c; ng[e] = (((c + 31) >> 5) + 7) >> 3; tot += ng[e]; }
      int inc = tot;
#pragma unroll
      for (int o = 1; o < 64; o <<= 1) { const int t = __shfl_up(inc, o); if (lane >= o) inc += t; }
      if (lane == 63) WSUM[w] = inc;
      __syncthreads();
      int woff = 0;
      for (int q = 0; q < w; ++q) woff += WSUM[q];
      int ex = woff + inc - tot;
#pragma unroll
      for (int e = 0; e < 4; ++e) { GPRE[4 * tid + e] = ex; ex += ng[e]; }
      if (tid == NTHR - 1) GPRE[2048] = ex; }
    attn_fill_tab(F, TAB);
    __syncthreads();
    const int NIT = GPRE[2048];
    const int nk = (NIT > F.vcu) ? (NIT - F.vcu + F.G - 1) / F.G : 0;
    if (tid < nk && tid < BIT_MAX) { const int it_ = F.vcu + tid * F.G; int lo_ = 0, hi_ = 2048; while (hi_ - lo_ > 1) { const int mid_ = (lo_ + hi_) >> 1; if (GPRE[mid_] <= it_) lo_ = mid_; else hi_ = mid_; } ITT[tid] = lo_ * 64 + (it_ - GPRE[lo_]); }
    __syncthreads();
    if (nk == 0) return;
    const int nkc = nk < BIT_MAX ? nk : BIT_MAX;
    const bf16_t* Qb = (const bf16_t*)(F.ws + WS_Q); const float* MQg = (const float*)(F.ws + WS_MQ); const unsigned short* QL = (const unsigned short*)(F.ws + WS_QLIST);
    const bf16_t* KF = (const bf16_t*)(F.ws + WS_KFRAG); const bf16_t* VF = (const bf16_t*)(F.ws + WS_VFRAG);
    float* PL = (float*)(F.ws + WS_PL);
#define BLK_ITEM(k_, pi_, g_) do { const int kk_ = (k_) < nkc ? (k_) : nkc - 1; const int v_ = __builtin_amdgcn_readfirstlane(ITT[kk_]); pi_ = v_ >> 6; g_ = v_ & 63; } while (0)
#define BLK_DMA(buf_, pi_) do { const char* ks_ = (const char*)KF + ((size_t)(pi_) * 2048 + tid) * 16; const char* vs_ = (const char*)VF + ((size_t)(pi_) * 2048 + tid) * 16; \
        _Pragma("unroll") for (int i_ = 0; i_ < 4; ++i_) { \
            __builtin_amdgcn_global_load_lds((const unsigned*)(ks_ + i_ * 8192), (LAS unsigned*)(L + (buf_) + (i_ * 512 + w * 64) * 16), 16, 0, 0); \
            __builtin_amdgcn_global_load_lds((const unsigned*)(vs_ + i_ * 8192), (LAS unsigned*)(L + (buf_) + 32768 + (i_ * 512 + w * 64) * 16), 16, 0, 0); } } while (0)
#define BLK_SEGC(dst_, pi_) do { dst_ = SEGC[(size_t)(pi_) * 32 + j]; } while (0)
#define BLK_ENTRY(dst_, segc_, pi_, g_) do { const int n_ = (pi_) & 31; int inc_ = (j < 31 - n_) ? (int)(segc_) : 0; \
        _Pragma("unroll") for (int o_ = 1; o_ < 32; o_ <<= 1) { const int t_ = __shfl_up(inc_, o_); if (j >= o_) inc_ += t_; } \
        const int cnt_ = GCL[pi_]; const int idx_ = 32 * (8 * (g_) + w) + j; int seg_ = 0, prev_ = 0; \
        for (int s_ = 0; s_ < 31 - n_; ++s_) { const int p_ = __builtin_amdgcn_readlane(inc_, s_); const bool le_ = p_ <= idx_; seg_ += le_ ? 1 : 0; prev_ = le_ ? p_ : prev_; } \
        const bool ok_ = idx_ < cnt_; const unsigned v_ = QL[(size_t)(pi_) * SEQ + (ok_ ? seg_ * 256 + (idx_ - prev_) : 0)]; dst_ = ok_ ? v_ : 0xFFFFu; } while (0)
#define BLK_QLOAD(qf_, m2_, ent_, pi_) do { const unsigned qq_ = ((ent_) == 0xFFFFu) ? 0u : ((ent_) >> 2); const int bh_ = (pi_) >> 5; \
        const bf16_t* qrow_ = Qb + ((size_t)(bh_ >> 3) * SEQ + qq_) * DA + (bh_ & 7) * HD + 8 * hi; \
        _Pragma("unroll") for (int ds_ = 0; ds_ < 4; ++ds_) qf_[ds_] = *(const bf16x8*)(qrow_ + 16 * ds_); \
        m2_ = MQg[(size_t)bh_ * SEQ + qq_]; } while (0)
    int pi, g, pi1, g1, pi2, g2; unsigned ent, ent1, sc2; bf16x8 qf[4]; float m2r;
    BLK_ITEM(0, pi, g); BLK_ITEM(1, pi1, g1); BLK_ITEM(2, pi2, g2);
    BLK_DMA(0, pi);
    { unsigned sc0, sc1; BLK_SEGC(sc0, pi); BLK_SEGC(sc1, pi1); BLK_SEGC(sc2, pi2); BLK_ENTRY(ent, sc0, pi, g); BLK_ENTRY(ent1, sc1, pi1, g1); }
    BLK_QLOAD(qf, m2r, ent, pi);
    int cur = 0;
    __builtin_amdgcn_s_waitcnt(0x0F70);
    unsigned char* dump = F.ws + WS_E + ((size_t)F.vcu * NTHR + tid) * 128;
    for (int k = 0; k < nkc; ++k) {
        __builtin_amdgcn_s_waitcnt(0x0F75);
        __syncthreads();
        int pi3, g3; unsigned sc3, ent2; bf16x8 qfn[4]; float m2n;
        BLK_ITEM(k + 3, pi3, g3); BLK_SEGC(sc3, pi3);
        BLK_ENTRY(ent2, sc2, pi2, g2);
        BLK_QLOAD(qfn, m2n, ent1, pi1);
        BLK_DMA((cur ^ 1) * 65536, pi1);
        const int bh = pi >> 5, n = pi & 31, h = bh & 7;
        const bool valid = ent != 0xFFFFu; const int q = valid ? (int)(ent >> 2) : 0; const int slot = (int)(ent & 3u);
        const bool active = __builtin_amdgcn_readfirstlane((int)(__ballot(valid) != 0ull)) != 0;
        f32x16 o0 = {}, o1 = {}; float lsum = 0.f;
        if (active) {
            const float m2 = valid ? m2r : INFINITY;
            const LAS bf16_t* KP = (const LAS bf16_t*)(L + cur * 65536); const LAS bf16_t* VP = (const LAS bf16_t*)(L + cur * 65536 + 32768);
            const LAS float* TABh = TAB + h * 132; const LAS float* BTD = nullptr; (void)BTD;
            const int dq = q - 256 * n;
            const bool nearw = __builtin_amdgcn_readfirstlane((int)(__ballot(valid && dq < 383) != 0ull)) != 0;
            const float ci = nearw ? -m2 : TABh[129] - m2;
            f32x16 cinit;
#pragma unroll
            for (int r = 0; r < 16; ++r) cinit[r] = ci;
            if (nearw) { for (int st = 0; st < 8; ++st) ATTN_SUBTILE(KP, VP, st, 1, cinit); }
            else { for (int st = 0; st < 8; ++st) ATTN_SUBTILE(KP, VP, st, 0, cinit); }
        }
        { const float lt = lsum + __shfl_xor(lsum, 32);
          const size_t qi = (size_t)bh * SEQ + q;
          float* pld = valid ? PL + (size_t)slot * (NH * BATCH * SEQ) + qi : (float*)(dump + 120);
          bf16_t* dst = valid ? (bf16_t*)(F.ws + part_off(slot)) + qi * HD + 8 * hi : (bf16_t*)dump;
          *pld = lt;
          *(u32x4*)(dst) = ot_pack16(o0, 0); *(u32x4*)(dst + 16) = ot_pack16(o0, 1); *(u32x4*)(dst + 32) = ot_pack16(o1, 0); *(u32x4*)(dst + 48) = ot_pack16(o1, 1); }
        pi = pi1; g = g1; ent = ent1; m2r = m2n; pi1 = pi2; g1 = g2; ent1 = ent2; pi2 = pi3; g2 = g3; sc2 = sc3; cur ^= 1;
#pragma unroll
        for (int ds = 0; ds < 4; ++ds) qf[ds] = qfn[ds];
    }
    VM_WAIT(); __syncthreads();
#undef BLK_ITEM
#undef BLK_DMA
#undef BLK_SEGC
#undef BLK_ENTRY
#undef BLK_QLOAD
}

__device__ __forceinline__ void attn_own_phase(Frame& F) {
    LAS unsigned char* L = F.lds; LAS float* TAB = (LAS float*)(L + OTAB_OFF); LAS float* BT = (LAS float*)(L + ROWTAB_OFF); int bth = -1;
    attn_fill_tab(F, TAB);
    const int tid = F.tid, lane = F.lane, w = F.wave, j = lane & 31, hi = lane >> 5, lane8 = lane * 8;
    const bf16_t* Qb = (const bf16_t*)(F.ws + WS_Q); const float* MQg = (const float*)(F.ws + WS_MQ);
    const bf16_t* KF = (const bf16_t*)(F.ws + WS_KFRAG); const bf16_t* VF = (const bf16_t*)(F.ws + WS_VFRAG);
    const float* PL = (const float*)(F.ws + WS_PL); bf16_t* YA = (bf16_t*)(F.ws + WS_YATT);
    const int NU = BATCH * NH * NBLK;
#define OWN_DMA(buf_, pi_) do { const char* ks_ = (const char*)KF + ((size_t)(pi_) * 2048 + tid) * 16; const char* vs_ = (const char*)VF + ((size_t)(pi_) * 2048 + tid) * 16; \
        _Pragma("unroll") for (int i_ = 0; i_ < 4; ++i_) { \
            __builtin_amdgcn_global_load_lds((const unsigned*)(ks_ + i_ * 8192), (LAS unsigned*)(L + (buf_) + (i_ * 512 + w * 64) * 16), 16, 0, 0); \
            __builtin_amdgcn_global_load_lds((const unsigned*)(vs_ + i_ * 8192), (LAS unsigned*)(L + (buf_) + 32768 + (i_ * 512 + w * 64) * 16), 16, 0, 0); } } while (0)
#define OWN_QLOAD(qf_, m2_, u_) do { const int bh_ = (u_) >> 5, qb_ = (u_) & 31; const size_t tk_ = (size_t)256 * qb_ + 32 * w + j; \
        const bf16_t* qrow_ = Qb + ((size_t)(bh_ >> 3) * SEQ + tk_) * DA + (bh_ & 7) * HD + 8 * hi; \
        _Pragma("unroll") for (int ds_ = 0; ds_ < 4; ++ds_) qf_[ds_] = *(const bf16x8*)(qrow_ + 16 * ds_); \
        m2_ = MQg[(size_t)bh_ * SEQ + tk_]; } while (0)
    int u = F.vcu; if (u >= NU) return;
    bf16x8 qf[4]; float m2;
    OWN_DMA(0, u); OWN_QLOAD(qf, m2, u);
    int cur = 0;
    __builtin_amdgcn_s_waitcnt(0x0F70);
    for (;;) {
        __builtin_amdgcn_s_waitcnt(0x0F74); __syncthreads();
        const int un = (u + F.G < NU) ? u + F.G : u; const bool last = (un == u);
        const int bh = u >> 5, qb = u & 31, b = bh >> 3, h = bh & 7; const int ql = 32 * w + j; const size_t qi = (size_t)bh * SEQ + 256 * qb + ql;
        u32x4 pa[3][4]; float pl[3];
#pragma unroll
        for (int s = 0; s < 3; ++s) { pl[s] = PL[(size_t)s * (NH * BATCH * SEQ) + qi]; const bf16_t* src = (const bf16_t*)(F.ws + part_off(s)) + qi * HD + 8 * hi;
#pragma unroll
            for (int c = 0; c < 4; ++c) pa[s][c] = *(const u32x4*)(src + 16 * c); }
        bf16x8 qfn[4]; float m2n;
        OWN_QLOAD(qfn, m2n, un);
        OWN_DMA((cur ^ 1) * 65536, un);
        const LAS bf16_t* KP = (const LAS bf16_t*)(L + cur * 65536); const LAS bf16_t* VP = (const LAS bf16_t*)(L + cur * 65536 + 32768); const LAS float* TABh = TAB + h * 132;
        if (h != bth) { __syncthreads();
            for (int e = tid; e < 5 * 1024; e += NTHR) { const int i = e & 3, ln = (e >> 2) & 63, rq = (e >> 8) & 3, dl = e >> 10; const int dist = 32 * dl + (ln & 31) - crow(4 * rq + i, ln >> 5);
                BT[e] = dist < 0 ? -1e30f : TABh[dist > 127 ? 127 : dist]; }
            bth = h; __syncthreads(); }
        const int dq = ql; (void)dq;
        f32x16 cnear, cfar;
#pragma unroll
        for (int r = 0; r < 16; ++r) { cnear[r] = -m2; cfar[r] = TABh[129] - m2; }
        f32x16 o0 = {}, o1 = {}; float lsum = 0.f;
        for (int st = 0; st <= w; ++st) { const int dl = w - st;
            if (dl >= 5) { const LAS float* BTD = nullptr; (void)BTD; ATTN_SUBTILE(KP, VP, st, 0, cfar); }
            else { const LAS float* BTD = BT + dl * 1024; ATTN_SUBTILE(KP, VP, st, 2, cnear); } }
        float lt = lsum + __shfl_xor(lsum, 32);
        const int nsel = qb < 3 ? qb : 3;
#pragma unroll
        for (int s = 0; s < 3; ++s) { const bool use = s < nsel; lt += use ? pl[s] : 0.f;
            ot_add16(o0, 0, pa[s][0], use); ot_add16(o0, 1, pa[s][1], use); ot_add16(o1, 0, pa[s][2], use); ot_add16(o1, 1, pa[s][3], use); }
        const float inv = 1.f / lt;
#pragma unroll
        for (int r = 0; r < 16; ++r) { o0[r] *= inv; o1[r] *= inv; }
        bf16_t* dst = YA + ((size_t)b * SEQ + 256 * qb + ql) * DA + h * HD + 8 * hi;
        *(u32x4*)(dst) = ot_pack16(o0, 0); *(u32x4*)(dst + 16) = ot_pack16(o0, 1); *(u32x4*)(dst + 32) = ot_pack16(o1, 0); *(u32x4*)(dst + 48) = ot_pack16(o1, 1);
        if (last) break;
        u = un; m2 = m2n; cur ^= 1;
#pragma unroll
        for (int ds = 0; ds < 4; ++ds) qf[ds] = qfn[ds];
    }
    VM_WAIT(); __syncthreads();
#undef OWN_DMA
#undef OWN_QLOAD
}
#undef ATTN_SUBTILE

__device__ __forceinline__ void routing_phase(Frame& F) {
    LAS int* lcnt = (LAS int*)(F.lds); LAS int* lbase = lcnt + 32;
    const float* SSQ = (const float*)(F.ws + WS_SSQ); const float* RL = (const float*)(F.ws + WS_RLOG);
    unsigned* rowtok = (unsigned*)(F.ws + WS_ROWTOK); float* rowcoef = (float*)(F.ws + WS_ROWCOEF); float* rowrstd = (float*)(F.ws + WS_ROWRSTD);
    unsigned* ecnt = (unsigned*)(F.ctl + CW_ECNT);
    const float* brg = F.in[20]; const float* bre = F.in[22];
    const int tid = F.tid;
    for (int base = F.vcu * 256; base < T; base += F.G * 256) {
        if (tid < 32) lcnt[tid] = 0;
        __syncthreads();
        int e0 = 0, e1 = 0, lp0 = 0, lp1 = 0; float c0 = 0.f, c1 = 0.f, rstd = 0.f; const int tok = base + tid;
        if (tid < 256) {
            float ss = 0.f;
#pragma unroll
            for (int q = 0; q < 4; ++q) { const f32x4 v = *(const f32x4*)(SSQ + (size_t)tok * 16 + 4 * q); ss += (v.x + v.y) + (v.z + v.w); }
            rstd = 1.f / sqrtf(ss * (1.f / D) + RMS_EPS);
            float r[72];
#pragma unroll
            for (int q = 0; q < 18; ++q) { const f32x4 v = *(const f32x4*)(RL + (size_t)tok * 72 + 4 * q); r[4 * q] = v.x; r[4 * q + 1] = v.y; r[4 * q + 2] = v.z; r[4 * q + 3] = v.w; }
            float gl[4], el[32];
#pragma unroll
            for (int c = 0; c < 4; ++c) gl[c] = rstd * (r[c] + r[36 + c]) + brg[c];
#pragma unroll
            for (int c = 0; c < 32; ++c) el[c] = rstd * (r[4 + c] + r[40 + c]) + bre[c];
            int gi = 0; float gm = gl[0];
#pragma unroll
            for (int c = 1; c < 4; ++c) if (gl[c] > gm) { gm = gl[c]; gi = c; }
            float Z = 0.f;
#pragma unroll
            for (int c = 0; c < 4; ++c) Z += __expf(gl[c] - gm);
            const float gval = 1.f / Z;
            float es[8];
#pragma unroll
            for (int q = 0; q < 8; ++q) es[q] = gi == 0 ? el[q] : (gi == 1 ? el[8 + q] : (gi == 2 ? el[16 + q] : el[24 + q]));
            int a0 = 0; float m0 = es[0];
#pragma unroll
            for (int q = 1; q < 8; ++q) if (es[q] > m0) { m0 = es[q]; a0 = q; }
            int a1 = -1; float m1 = -INFINITY;
#pragma unroll
            for (int q = 0; q < 8; ++q) if (q != a0 && es[q] > m1) { m1 = es[q]; a1 = q; }
            const float w0 = 1.f / (1.f + __expf(m1 - m0)), w1 = 1.f - w0;
            e0 = gi * 8 + a0; e1 = gi * 8 + a1; c0 = gval * w0; c1 = gval * w1;
            lp0 = __hip_atomic_fetch_add(lcnt + e0, 1, __ATOMIC_RELAXED, __HIP_MEMORY_SCOPE_WORKGROUP);
            lp1 = __hip_atomic_fetch_add(lcnt + e1, 1, __ATOMIC_RELAXED, __HIP_MEMORY_SCOPE_WORKGROUP);
        }
        __syncthreads();
        if (tid < 32) lbase[tid] = (int)__hip_atomic_fetch_add(ecnt + tid, (unsigned)lcnt[tid], __ATOMIC_RELAXED, __HIP_MEMORY_SCOPE_AGENT);
        __syncthreads();
        if (tid < 256) {
            const size_t i0 = (size_t)e0 * ROWCAP + lbase[e0] + lp0, i1 = (size_t)e1 * ROWCAP + lbase[e1] + lp1;
            rowtok[i0] = (unsigned)tok * 2u; rowcoef[i0] = c0; rowrstd[i0] = rstd;
            rowtok[i1] = (unsigned)tok * 2u + 1u; rowcoef[i1] = c1; rowrstd[i1] = rstd;
        }
        __syncthreads();
    }
}
struct MoeOrder {
    const LAS int* tst; int total, G, v;
    __device__ bool next(int i, pg8::Unit& u) const {
        const int L = i * G + v; if (L >= total) return false;
        const int rt = L >> 2; int e = 0;
#pragma unroll 8
        for (int q = 1; q <= 32; ++q) e += (tst[q] <= rt) ? 1 : 0;
        u.pm = rt; u.pn = L & 3; u.pb = e * 4 + u.pn; u.aux = e; u.aux2 = (rt - tst[e]) * 256; return true;
    }
};
__device__ __forceinline__ void moe_tables(Frame& F) {
    LAS int* tst = (LAS int*)(F.lds + MOE_TST_OFF); const unsigned* ecnt = (const unsigned*)(F.ctl + CW_ECNT);
    if (F.wave == 0) { const int lane = F.lane; int nt = lane < 32 ? (int)((ecnt[lane & 31] + 255u) >> 8) : 0; int inc = nt;
#pragma unroll
        for (int o = 1; o < 32; o <<= 1) { const int t = __shfl_up(inc, o); if (lane >= o) inc += t; }
        if (lane < 32) tst[lane + 1] = inc; if (lane == 0) tst[0] = 0; }
    __syncthreads();
}
__device__ __forceinline__ void final_phase(Frame& F) {
#ifdef SELFCHECK
    const bool chk_bad = __hip_atomic_load((unsigned*)(F.ctl + 2), __ATOMIC_RELAXED, __HIP_MEMORY_SCOPE_AGENT) != 0u;
#endif
    const bf16_t* X1 = (const bf16_t*)(F.ws + WS_X1); const bf16_t* Y0 = (const bf16_t*)(F.ws + WS_Y0); const bf16_t* Y1 = (const bf16_t*)(F.ws + WS_Y1); const float* gf = F.in[26];
    const int gw = F.vcu * NWAVES + F.wave, NGW = F.G * NWAVES, lane = F.lane;
    for (int m = gw; m < T; m += NGW) {
        const u32x2* xr = (const u32x2*)(X1 + (size_t)m * D) + lane; const u32x2* y0 = (const u32x2*)(Y0 + (size_t)m * D) + lane; const u32x2* y1 = (const u32x2*)(Y1 + (size_t)m * D) + lane;
        f32x4 v[4]; float s = 0.f;
#pragma unroll
        for (int j = 0; j < 4; ++j) { const u32x2 xx = xr[64 * j]; v[j] = (f32x4){bflo(xx.x), bfhi(xx.x), bflo(xx.y), bfhi(xx.y)}; const u32x2 a = y0[64 * j], c = y1[64 * j];
            v[j].x += bflo(a.x) + bflo(c.x); v[j].y += bfhi(a.x) + bfhi(c.x); v[j].z += bflo(a.y) + bflo(c.y); v[j].w += bfhi(a.y) + bfhi(c.y);
            s += (v[j].x * v[j].x + v[j].y * v[j].y) + (v[j].z * v[j].z + v[j].w * v[j].w); }
        const float rstd = 1.f / sqrtf(wave_sum(s) * (1.f / D) + RMS_EPS);
        f32x4* o = (f32x4*)(F.out + (size_t)m * D) + lane; const f32x4* gr = (const f32x4*)gf + lane;
#ifdef SELFCHECK
        if (chk_bad) { for (int j = 0; j < 4; ++j) o[64 * j] = (f32x4){0.f, 0.f, 0.f, 0.f}; continue; }
#endif
#pragma unroll
        for (int j = 0; j < 4; ++j) o[64 * j] = v[j] * rstd * gr[64 * j];
    }
}
#ifdef SELFCHECK
constexpr int CW_CHK = 2;
__device__ __forceinline__ int t5_bucket_ref(int n) { if (n < 16) return n; const int l = 16 + (int)(logf((float)n / 16.f) / logf(8.f) * 16.f); return l < 31 ? l : 31; }
__device__ __forceinline__ float kfrag_at(const bf16_t* KF, int bh, int key, int d) { const int n = key >> 8, kl = key & 255, st = kl >> 5, i = kl & 31, ds = d >> 4, hi = (d >> 3) & 1, e = d & 7;
    return bf2f(KF[(((size_t)bh * 32 + n) * 2048 + (st * 4 + ds) * 64 + (i + 32 * hi)) * 8 + e]); }
__device__ __forceinline__ float vfrag_at(const bf16_t* VF, int bh, int key, int d) { const int n = key >> 8, kl = key & 255, st = kl >> 5, kk = kl & 31, ks = kk >> 4, k16 = kk & 15, hi = (k16 >> 2) & 1, e = (k16 & 3) + 4 * (k16 >> 3), d0 = d >> 5, jj = d & 31;
    return bf2f(VF[(((size_t)bh * 32 + n) * 2048 + ((st * 2 + ks) * 2 + d0) * 64 + (jj + 32 * hi)) * 8 + e]); }
__device__ __forceinline__ void selfcheck_phase(Frame& F, float tol_attn, float tol_ssm) {
    const int lane = lane_id(); const int gw = F.vcu * NWAVES + F.wave;
    const bf16_t* Qb = (const bf16_t*)(F.ws + WS_Q); const bf16_t* KM = (const bf16_t*)(F.ws + WS_KMEAN); const bf16_t* KF = (const bf16_t*)(F.ws + WS_KFRAG); const bf16_t* VF = (const bf16_t*)(F.ws + WS_VFRAG);
    const bf16_t* YA = (const bf16_t*)(F.ws + WS_YATT); const float* rb = F.in[16];
    bool bad = false;
    for (int sidx = 0; sidx < 12; ++sidx) {
        unsigned hsh = (unsigned)(gw * 12 + sidx) * 2654435761u; hsh ^= hsh >> 15; hsh *= 2246822519u; hsh ^= hsh >> 13;
        const int bh = (int)(hsh & 63u); int q = (int)((hsh >> 6) & 8191u);
        if (sidx == 0) q = q & 767; if (sidx == 1) q = (q & ~255) | (sidx & 1 ? 0 : 255); if (sidx == 2) q = (q & ~255) | 255; if (sidx == 3) q = (q & ~255) | 128;
        const int b = bh >> 3, h = bh & 7, qb = q >> 8, d = lane;
        const float qd = bf2f(Qb[((size_t)b * SEQ + q) * DA + h * HD + d]);
        int s0 = -1, s1 = -1, s2 = -1; float g0 = -INFINITY, g1 = -INFINITY, g2 = -INFINITY;
        for (int n = 0; n < qb; ++n) { const float gt = wave_sum(qd * bf2f(KM[((size_t)bh * 32 + n) * 64 + d]));
            if (gt > g0) { g2 = g1; s2 = s1; g1 = g0; s1 = s0; g0 = gt; s0 = n; } else if (gt > g1) { g2 = g1; s2 = s1; g1 = gt; s1 = n; } else if (gt > g2) { g2 = gt; s2 = n; } }
        float m = -INFINITY, l = 0.f, od = 0.f;
        for (int blk = 0; blk < 4; ++blk) { const int n = blk == 0 ? s0 : (blk == 1 ? s1 : (blk == 2 ? s2 : qb)); if (n < 0) continue;
            const int kend = (blk == 3) ? (q & 255) + 1 : 256;
            for (int kl = 0; kl < kend; ++kl) { const int key = 256 * n + kl; const float kd = kfrag_at(KF, bh, key, d);
                const float s = wave_sum(qd * kd) + rb[h * 32 + t5_bucket_ref(q - key)] * LOG2E;
                const float mn = fmaxf(m, s), sc = exp2f(m - mn), p = exp2f(s - mn); l = l * sc + p; od = od * sc + p * vfrag_at(VF, bh, key, d); m = mn; } }
        od /= l;
        const float yd = bf2f(YA[((size_t)b * SEQ + q) * DA + h * HD + d]);
        const float e2 = wave_sum((od - yd) * (od - yd)), o2 = wave_sum(od * od);
        if (!(e2 <= tol_attn * tol_attn * o2)) bad = true;
    }
    { const bf16_t* UP = (const bf16_t*)(F.ws + WS_UP); const bf16_t* GA = (const bf16_t*)(F.ws + WS_GACT);
      for (int sidx = 0; sidx < 6; ++sidx) {
        unsigned hsh = (unsigned)(gw * 6 + sidx + 7777) * 2654435761u; hsh ^= hsh >> 15; hsh *= 2246822519u; hsh ^= hsh >> 13;
        const int g = (int)(hsh & 31u), b = (int)((hsh >> 5) & 7u); int t = (int)((hsh >> 8) % 330u); if (sidx == 0) t = 31 + (int)((hsh >> 20) & 3u) * 32; if (sidx == 1) t = 32 + (int)((hsh >> 20) & 7u) * 32;
        const int p = lane;
        const float lr = F.in[4][g * SP + p], li = F.in[5][g * SP + p], step = expf(F.in[6][g]);
        const float mag = expf(lr * step), ar = mag * cosf(li * step), ai = mag * sinf(li * step);
        const float nr = ar - 1.f, ni = ai, den = lr * lr + li * li, cr = (nr * lr + ni * li) / den, ci = (ni * lr - nr * li) / den;
        float hr = 0.f, hi_ = 0.f;
        for (int tt = 0; tt <= t; ++tt) { float br = 0.f, bi = 0.f;
            for (int c = 0; c < 16; ++c) { const float u = bf2f(UP[(size_t)g * SROWS * SKY + ((size_t)b * 256 + (tt >> 5)) * SKY + (tt & 31) * 16 + c]);
                const float b_r = F.in[7][(g * SP + p) * 16 + c], b_i = F.in[8][(g * SP + p) * 16 + c]; br += (cr * b_r - ci * b_i) * u; bi += (cr * b_i + ci * b_r) * u; }
            const float n_r = ar * hr - ai * hi_ + br, n_i = ar * hi_ + ai * hr + bi; hr = n_r; hi_ = n_i; }
        float e2 = 0.f, o2 = 0.f;
        for (int ho = 0; ho < 16; ++ho) { float y = wave_sum(hr * F.in[9][(g * 16 + ho) * SP + p] - hi_ * F.in[10][(g * 16 + ho) * SP + p]);
            const float u = bf2f(UP[(size_t)g * SROWS * SKY + ((size_t)b * 256 + (t >> 5)) * SKY + (t & 31) * 16 + ho]); y += F.in[11][g * 16 + ho] * u;
            const float ge = 0.5f * y * (1.f + tanhf(0.7978845608028654f * (y + 0.044715f * y * y * y)));
            const float gv = bf2f(GA[((size_t)b * SEQ + t) * DS + g * 16 + ho]); e2 += (ge - gv) * (ge - gv); o2 += ge * ge; }
        if (!(e2 <= tol_ssm * tol_ssm * o2 + 1e-6f)) bad = true;
      } }
    if (__ballot(bad) != 0ull && lane == 0) __hip_atomic_store((unsigned*)(F.ctl + CW_CHK), 1u, __ATOMIC_RELAXED, __HIP_MEMORY_SCOPE_AGENT);
}
#endif

#ifdef SELFCHECK
__device__ __forceinline__ void selfcheck_prep(Frame& F) {
    const int lane = lane_id(); const int gw = F.vcu * NWAVES + F.wave;
    const bf16_t* Kb = (const bf16_t*)(F.ws + WS_K); const bf16_t* Vb = (const bf16_t*)(F.ws + WS_V); const bf16_t* KF = (const bf16_t*)(F.ws + WS_KFRAG); const bf16_t* VF = (const bf16_t*)(F.ws + WS_VFRAG);
    const bf16_t* KM = (const bf16_t*)(F.ws + WS_KMEAN); const float* KN = (const float*)(F.ws + WS_KMEAN + 512 * 1024);
    bool bad = false;
    for (int sidx = 0; sidx < 64; ++sidx) {
        unsigned hsh = (unsigned)(gw * 64 + sidx + 12345) * 2654435761u; hsh ^= hsh >> 15; hsh *= 2246822519u; hsh ^= hsh >> 13;
        const int bh = (int)(hsh & 63u), key = (int)((hsh >> 6) & 8191u), b = bh >> 3, h = bh & 7, d = lane;
        const float k0 = bf2f(Kb[((size_t)b * SEQ + key) * DA + h * HD + d]), v0 = bf2f(Vb[((size_t)b * SEQ + key) * DA + h * HD + d]);
        if (kfrag_at(KF, bh, key, d) != k0 || vfrag_at(VF, bh, key, d) != v0) bad = true;
    }
    for (int sidx = 0; sidx < 2; ++sidx) {
        unsigned hsh = (unsigned)(gw * 2 + sidx + 999) * 2654435761u; hsh ^= hsh >> 15; hsh *= 2246822519u; hsh ^= hsh >> 13;
        const int item = (int)(hsh & 2047u), bh = item >> 5, n = item & 31, b = bh >> 3, h = bh & 7, d = lane; float sum = 0.f, mx = 0.f;
        for (int kl = 0; kl < 256; ++kl) { const float kv = bf2f(Kb[((size_t)b * SEQ + 256 * n + kl) * DA + h * HD + d]); sum += kv; mx = fmaxf(mx, wave_sum(kv * kv)); }
        const float mean = sum * (1.f / 256.f), got = bf2f(KM[(size_t)item * 64 + d]);
        if (fabsf(mean - got) > 0.01f * fabsf(mean) + 1e-3f) bad = true;
        if (fabsf(mx - KN[item]) > 1e-3f * mx) bad = true;
    }
    if (__ballot(bad) != 0ull && lane == 0) __hip_atomic_store((unsigned*)(F.ctl + CW_CHK), 1u, __ATOMIC_RELAXED, __HIP_MEMORY_SCOPE_AGENT);
}
#endif
#ifndef MK_N_LAUNCHES
#define MK_N_LAUNCHES 1
#endif
constexpr int NPHASE = 14;
struct Args { const float* in[27]; float* out; unsigned char* ws; int ph_lo, ph_hi; };
static_assert(sizeof(Args) == 27 * 8 + 8 + 8 + 8, "Args has no padding");

#ifndef STAG9
#define STAG9 0
#endif
#ifndef STAG8
#define STAG8 0
#endif
#ifndef DUP_MASK
#define DUP_MASK 0
#endif
#define PH_ARGS Frame& F, unsigned char* ws, LAS unsigned char* ring
__device__ __forceinline__ void ph1(PH_ARGS) {
    { pg8::Gemm g{(const bf16_t*)(ws + WS_H1), (const bf16_t*)(ws + WS_WIN), D, D, D}; pg8::StaticOrder S; S.init(T, DS, F.G, (int)blockIdx.x);
      EpiProj<0> E{ws, F.in[3], 0, 1.f};
      pg8::gemm_phase<EpiProj<0>, pg8::StaticOrder, true, false>(ring, g, S, E, nullptr, F.wave); }
    { pg8::Gemm g{(const bf16_t*)(ws + WS_H1F8), (const bf16_t*)(ws + WS_WINF8), D / 2, D / 2, D / 2}; pg8::StaticOrder S; S.init(T, DIN - DS, F.G, (int)blockIdx.x);
      EpiProj<1> E{ws, F.in[3], 2, 1.f / WF8_SCALE};
      pg8::gemm_phase<EpiProj<1>, pg8::StaticOrder, true, false, true>(ring, g, S, E, nullptr, F.wave); }
}
__device__ __forceinline__ void ph2(PH_ARGS) {
    { pg8::Gemm g{(const bf16_t*)(ws + WS_UP), (const bf16_t*)(ws + WS_SSMW), SKY, SKU, SKU}; pg8::GroupedOrder S; S.init(SG * 8, 1, 8, F.G, F.vcu);
      EpiSsmE E{(float*)(ws + WS_E)};
      pg8::gemm_phase<EpiSsmE, pg8::GroupedOrder, false, false>(ring, g, S, E, nullptr, F.wave); }
    VM_WAIT(); __syncthreads();
    ssm_scan_phase(F);
    kv_prep_phase(F);
}
__device__ __forceinline__ void ph4(PH_ARGS) {
    pg8::Gemm g{(const bf16_t*)(ws + WS_UP), (const bf16_t*)(ws + WS_SSMT), SKY, SKY, SKY}; pg8::GroupedOrder S; S.init(SG * 8, 2, 8, F.G, F.vcu);
    EpiSsmY E{(bf16_t*)(ws + WS_GACT)};
    pg8::gemm_phase<EpiSsmY, pg8::GroupedOrder, true, false>(ring, g, S, E, nullptr, F.wave);
}
__device__ __forceinline__ void ph5(PH_ARGS) {
    pg8::Gemm g{(const bf16_t*)(ws + WS_GACT), (const bf16_t*)(ws + WS_WGLU), DS, DS, DS}; pg8::StaticOrder S; S.init(T, DS, F.G, (int)blockIdx.x);
    EpiGlu E{(const bf16_t*)(ws + WS_GACT), (bf16_t*)(ws + WS_YSSM), F.in[13]};
    pg8::gemm_phase<EpiGlu, pg8::StaticOrder, true, false>(ring, g, S, E, nullptr, F.wave);
}
__device__ __forceinline__ void ph6(PH_ARGS) {
    { pg8::Gemm g{(const bf16_t*)(ws + WS_YSSM), (const bf16_t*)(ws + WS_WUS), DS, DS, DS}; pg8::StaticOrder S; S.init(T, D, F.G, (int)blockIdx.x);
      EpiUp<false> E{(const bf16_t*)(ws + WS_SGS), (bf16_t*)(ws + WS_MRG)};
      pg8::gemm_phase<EpiUp<false>, pg8::StaticOrder, true, false>(ring, g, S, E, nullptr, F.wave); }
    VM_WAIT(); __syncthreads();
    { pg8::Gemm g{(const bf16_t*)(ws + WS_YATT), (const bf16_t*)(ws + WS_WUA), DA, DA, DA}; pg8::StaticOrder S; S.init(T, D, F.G, (int)blockIdx.x);
      EpiUp<true> E{(const bf16_t*)(ws + WS_SGA), (bf16_t*)(ws + WS_MRG)};
      pg8::gemm_phase<EpiUp<true>, pg8::StaticOrder, true, false>(ring, g, S, E, nullptr, F.wave); }
}
__device__ __forceinline__ void ph7(PH_ARGS) {
    pg8::Gemm g{(const bf16_t*)(ws + WS_MRG), (const bf16_t*)(ws + WS_WOUT), D, D, D}; pg8::StaticOrder S; S.init(T, D, F.G, (int)blockIdx.x);
    EpiOut E{F.in[0], (bf16_t*)(ws + WS_X1), (bf16_t*)(ws + WS_XG), ws + WS_XGF8, F.in[18], (float*)(ws + WS_SSQ)};
    pg8::gemm_phase<EpiOut, pg8::StaticOrder, true, false>(ring, g, S, E, nullptr, F.wave);
}
__device__ __forceinline__ void ph8(PH_ARGS) {
    pg8::Gemm g{(const bf16_t*)(ws + WS_XG), (const bf16_t*)(ws + WS_WR), D, D, D}; pg8::GroupedOrder S; S.init(T / 256, 1, T / 256, F.G, F.vcu);
    EpiRouter E{(float*)(ws + WS_RLOG)};
    pg8::gemm_phase<EpiRouter, pg8::GroupedOrder, false, false>(ring, g, S, E, nullptr, F.wave);
}
__device__ __forceinline__ void ph10(PH_ARGS) {
    moe_tables(F);
    const LAS int* tst = (const LAS int*)(F.lds + MOE_TST_OFF);
    MoeOrder S{tst, tst[32] * 4, F.G, F.vcu};
    LAS unsigned* rowtab = (LAS unsigned*)(F.lds + ROWTAB_OFF);
    { const unsigned* rowtok = (const unsigned*)(ws + WS_ROWTOK); const unsigned* ecnt = (const unsigned*)(F.ctl + CW_ECNT); pg8::Unit u;
      for (int i = 0; i < ROWTAB_UNITS && S.next(i, u); ++i) { if (F.tid < 256) { const int pos = u.aux2 + F.tid; const unsigned tk = pos < (int)ecnt[u.aux] ? (rowtok[(size_t)u.aux * ROWCAP + pos] >> 1) : 0u; rowtab[i * 256 + F.tid] = tk * (unsigned)D; } } }
    __syncthreads();
    pg8::Gemm g{(const bf16_t*)(ws + WS_XGF8), (const bf16_t*)(ws + WS_W13), D / 2, D / 2, D / 2};
    EpiMoe1 E{ws + WS_HID, (const float*)(ws + WS_ROWRSTD), (const unsigned*)(F.ctl + CW_ECNT), 1.f / WF8_SCALE};
    pg8::gemm_phase<EpiMoe1, MoeOrder, true, true, true>(ring, g, S, E, rowtab, F.wave);
}
__device__ __forceinline__ void ph11(PH_ARGS) {
    moe_tables(F);
    const LAS int* tst = (const LAS int*)(F.lds + MOE_TST_OFF);
    MoeOrder S{tst, tst[32] * 4, F.G, F.vcu};
    pg8::Gemm g{(const bf16_t*)(ws + WS_HID), (const bf16_t*)(ws + WS_W2), DE / 2, DE / 2, DE / 2};
    EpiMoe2 E{(bf16_t*)(ws + WS_Y0), (size_t)(WS_Y1 - WS_Y0), (const unsigned*)(ws + WS_ROWTOK), (const float*)(ws + WS_ROWCOEF), (const unsigned*)(F.ctl + CW_ECNT), 1.f / WF8_SCALE};
    pg8::gemm_phase<EpiMoe2, MoeOrder, true, false, true>(ring, g, S, E, nullptr, F.wave);
}

__global__ void __launch_bounds__(NTHR, 2) fwd_kernel(Args args) {
    extern __shared__ __attribute__((aligned(16))) unsigned char lds_raw[];
    Frame F;
    F.lds = (LAS unsigned char*)lds_raw;
    F.MISC = (volatile LAS unsigned*)(F.lds + MISC_OFF);
    F.wave = __builtin_amdgcn_readfirstlane((int)(threadIdx.x >> 6)); F.lane = lane_id(); F.tid = F.wave * 64 + F.lane;
    F.G = gridDim.x; { const int bx = blockIdx.x; F.vcu = (F.G % 8 == 0) ? (bx % 8) * (F.G / 8) + bx / 8 : bx; }
    F.ws = args.ws; F.ctl = (gu32*)(args.ws + WS_CTL); F.out = args.out;
#pragma unroll
    for (int i = 0; i < 27; ++i) F.in[i] = args.in[i];
    for (int u = F.tid; u < (LDS_BYTES - MOE_TST_OFF) / 4; u += NTHR) ((LAS unsigned*)(F.lds + MOE_TST_OFF))[u] = 0u;
    __syncthreads();
    XcdBarrier bar; bar.bar = (unsigned*)(F.ctl + CW_BAR); bar.x = 0; bar.st = nullptr;
    const int lo = args.ph_lo, hi = args.ph_hi;
    if (hi - lo > 1) bar = xcd_barrier_post((unsigned*)(F.ctl + CW_BAR), F.MISC + 8, F.tid == 0);
#define IN(k) (lo <= (k) && (k) < hi)
#define DUP(k) ((DUP_MASK >> (k)) & 1)
#define SEAM(k) do { if (IN(k) && IN((k) + 1)) xcd_barrier(bar, F.wave == 0 && lane_id() == 0); REFRESH(); } while (0)
#define REFRESH() do { int l_ = lane_id(); asm volatile("" : "+v"(l_)); F.lane = l_; F.tid = F.wave * 64 + l_; } while (0)
    unsigned char* ws = args.ws;
    LAS unsigned char* ring = F.lds;
    if (IN(0)) { p0_prologue(F); if (DUP(0)) p0_prologue(F); }
    SEAM(0);
    if (IN(1)) { ph1(F, ws, ring); if (DUP(1)) ph1(F, ws, ring); }
    SEAM(1);
    if (IN(2)) { ph2(F, ws, ring); if (DUP(2)) ph2(F, ws, ring); }
    SEAM(2);
#ifdef SELFCHECK_PREP
    if (IN(3)) { selfcheck_prep(F); }
#endif
    if (IN(3)) { attn_gate_phase<true>(F); }
    SEAM(3);
    if (IN(4)) { attn_block_phase(F); if (DUP(4)) { __syncthreads(); attn_block_phase(F); } }
    SEAM(4);
    if (IN(5)) { attn_own_phase(F); if (DUP(5)) attn_own_phase(F); }
    SEAM(5);
    if (IN(6)) { ph4(F, ws, ring); if (DUP(6)) ph4(F, ws, ring); }
#ifdef SELFCHECK
    if (IN(6)) { xcd_barrier(bar, F.wave == 0 && lane_id() == 0); REFRESH(); selfcheck_phase(F, SELFCHECK_TOL_ATTN, SELFCHECK_TOL_SSM); }
#endif
    SEAM(6);
    if (IN(7)) { ph5(F, ws, ring); if (DUP(7)) ph5(F, ws, ring); }
    SEAM(7);
    if (IN(8)) { if (STAG8 > 0 && (F.vcu & 1)) { const unsigned long long t0_ = __builtin_amdgcn_s_memrealtime(); while ((long long)(__builtin_amdgcn_s_memrealtime() - t0_) < (long long)STAG8) __builtin_amdgcn_s_sleep(16); }
                 ph6(F, ws, ring); if (DUP(8)) ph6(F, ws, ring); }
    SEAM(8);
    if (IN(9)) { if (STAG9 > 0 && (F.vcu & 1)) { const unsigned long long t0_ = __builtin_amdgcn_s_memrealtime(); while ((long long)(__builtin_amdgcn_s_memrealtime() - t0_) < (long long)STAG9) __builtin_amdgcn_s_sleep(16); }
                 ph7(F, ws, ring); if (DUP(9)) ph7(F, ws, ring); }
    SEAM(9);
    if (IN(10)) { ph8(F, ws, ring); VM_WAIT(); __syncthreads(); routing_phase(F); }
    SEAM(10);
    if (IN(11)) { ph10(F, ws, ring); if (DUP(11)) ph10(F, ws, ring); }
    SEAM(11);
    if (IN(12)) { ph11(F, ws, ring); if (DUP(12)) ph11(F, ws, ring); }
    SEAM(12);
    if (IN(13)) { final_phase(F); if (DUP(13)) final_phase(F); }
#undef IN
#undef DUP
#undef SEAM
#undef REFRESH
}

extern "C" void kernel_launch(void* const* d_in, const int* in_sizes, int n_in, void* d_out, int out_size, void* d_ws, size_t ws_size, hipStream_t stream) {
    static int grid = 0;
    if (grid == 0) {
        if (n_in != 27 || in_sizes[0] != T * D || out_size != T * D || ws_size < WS_END) { fprintf(stderr, "kernel_launch: unexpected shapes (n_in %d, in0 %d, out %d, ws %zu)\n", n_in, n_in > 0 ? in_sizes[0] : -1, out_size, ws_size); grid = -1; return; }
        int dev = 0, cus = 0;
        if (hipGetDevice(&dev) != hipSuccess || hipDeviceGetAttribute(&cus, hipDeviceAttributeMultiprocessorCount, dev) != hipSuccess) { grid = -1; return; }
        if (hipFuncSetAttribute((const void*)fwd_kernel, hipFuncAttributeMaxDynamicSharedMemorySize, LDS_BYTES) != hipSuccess) { fprintf(stderr, "kernel_launch: hipFuncSetAttribute failed\n"); grid = -1; return; }
        (void)hipGetLastError();
        grid = cus;
    }
    if (grid < 0) return;
    (void)hipMemsetAsync((char*)d_ws + WS_CTL, 0, CTL_ZERO_BYTES, stream);
    Args a{};
    for (int i = 0; i < 27; ++i) a.in[i] = (const float*)d_in[i];
    a.out = (float*)d_out; a.ws = (unsigned char*)d_ws;
    if (MK_N_LAUNCHES == 1) { a.ph_lo = 0; a.ph_hi = NPHASE; hipLaunchKernelGGL(fwd_kernel, dim3(grid), dim3(NTHR), LDS_BYTES, stream, a); }
    else { for (int p = 0; p < NPHASE; ++p) { a.ph_lo = p; a.ph_hi = p + 1; hipLaunchKernelGGL(fwd_kernel, dim3(grid), dim3(NTHR), LDS_BYTES, stream, a); } }
}
```

```cpp
#include <hip/hip_runtime.h>
#include <cstdio>
#include <cstdint>

#define LAS __attribute__((address_space(3)))
#define GAS __attribute__((address_space(1)))
typedef unsigned short bf16_t;
typedef short bf16x8 __attribute__((ext_vector_type(8)));
typedef float f32x2 __attribute__((ext_vector_type(2)));
typedef float f32x4 __attribute__((ext_vector_type(4)));
typedef float f32x16 __attribute__((ext_vector_type(16)));
typedef unsigned u32x2 __attribute__((ext_vector_type(2)));
typedef unsigned u32x4 __attribute__((ext_vector_type(4)));
typedef GAS unsigned gu32;
typedef int v4i32 __attribute__((ext_vector_type(4)));
typedef int v8i32 __attribute__((ext_vector_type(8)));
#define RLX_AGENT __ATOMIC_RELAXED, __HIP_MEMORY_SCOPE_AGENT
#define LDS_WAIT() asm volatile("s_waitcnt lgkmcnt(0)" ::: "memory")
#define VM_WAIT() asm volatile("s_waitcnt vmcnt(0)" ::: "memory")

__device__ __forceinline__ unsigned f2bf(float f) { unsigned u = __builtin_bit_cast(unsigned, f); return (u + 0x7fffu + ((u >> 16) & 1u)) >> 16; }
__device__ __forceinline__ unsigned pk2(float lo, float hi) { return f2bf(lo) | (f2bf(hi) << 16); }
__device__ __forceinline__ float bf2f(unsigned short b) { return __builtin_bit_cast(float, (unsigned)b << 16); }
__device__ __forceinline__ float bflo(unsigned w) { return __builtin_bit_cast(float, w << 16); }
__device__ __forceinline__ float bfhi(unsigned w) { return __builtin_bit_cast(float, w & 0xffff0000u); }
__device__ __forceinline__ unsigned cvt_pk_bf16(float lo, float hi) { unsigned r; asm volatile("v_cvt_pk_bf16_f32 %0, %1, %2" : "=v"(r) : "v"(lo), "v"(hi)); return r; }
__device__ __forceinline__ float fast_sigmoid(float x) { return __builtin_amdgcn_rcpf(1.f + __builtin_amdgcn_exp2f(-1.4426950408889634f * x)); }
__device__ __forceinline__ int lane_id() { int l; asm volatile("v_mbcnt_lo_u32_b32 %0, -1, 0\n\tv_mbcnt_hi_u32_b32 %0, -1, %0" : "=v"(l)); return l; }
__device__ __forceinline__ float wave_sum(float v) {
#pragma unroll
    for (int o = 1; o < 64; o <<= 1) v += __shfl_xor(v, o);
    return v;
}
__device__ __forceinline__ float wave_max(float v) {
#pragma unroll
    for (int o = 1; o < 64; o <<= 1) v = fmaxf(v, __shfl_xor(v, o));
    return v;
}

#define XB_TMO      128
#define XB_XCNT(j)  (256  + 64 * (j))
#define XB_XSUB(j)  (1280 + 64 * (j))
#define XB_XGEN(j)  (2304 + 64 * (j))
#define XB_TOP      3328
#define XB_TOPGEN   3392
#define XCD_BAR_WORDS 3456
#define XB_SPIN_CAP (1u << 20)

__device__ __forceinline__ unsigned xb_ld(unsigned* p)              { return __hip_atomic_load(p, __ATOMIC_RELAXED, __HIP_MEMORY_SCOPE_AGENT); }
__device__ __forceinline__ unsigned xb_add(unsigned* p, unsigned v) { return __hip_atomic_fetch_add(p, v, __ATOMIC_RELAXED, __HIP_MEMORY_SCOPE_AGENT); }
__device__ __forceinline__ unsigned xb_xcc_id() { return (unsigned)__builtin_amdgcn_s_getreg((3 << 11) | 20) & 0xFu; }
#define XB_SPIN(cond, bar) do { unsigned _sp = 0; while (cond) { __builtin_amdgcn_s_sleep(1); \
    if ((++_sp & 255u) == 0u) { if (xb_ld(&(bar)[XB_TMO])) break; if (_sp > XB_SPIN_CAP) { atomicAdd(&(bar)[XB_TMO], 1u); break; } } } } while (0)

struct XcdBarrier { unsigned* bar; unsigned x; volatile LAS unsigned* st; };

__device__ __forceinline__ XcdBarrier xcd_barrier_post(unsigned* bar, volatile LAS unsigned* st, bool leader  ) {
    XcdBarrier b; b.bar = bar; b.x = xb_xcc_id(); b.st = st;
    if (leader) (void)xb_add(&bar[XB_XCNT(b.x)], 1u);
    return b;
}
__device__ __forceinline__ void xcd_barrier_complete(unsigned* bar, unsigned x, unsigned& nloc, unsigned& nx) {
    const unsigned G = gridDim.x * gridDim.y * gridDim.z;
    unsigned sum, cnt, mine, sp = 0u;
    for (;;) {
        sum = 0u; cnt = 0u; mine = 0u;
#pragma unroll
        for (unsigned j = 0; j < 16; ++j) { const unsigned c = xb_ld(&bar[XB_XCNT(j)]); sum += c; cnt += (c > 0u) ? 1u : 0u; mine = (j == x) ? c : mine; }
        if (sum == G) break;
        __builtin_amdgcn_s_sleep(1);
        if ((++sp & 255u) == 0u) { if (xb_ld(&bar[XB_TMO])) break; if (sp > XB_SPIN_CAP) { atomicAdd(&bar[XB_TMO], 1u); break; } }
    }
    nloc = mine > 0u ? mine : 1u; nx = cnt > 0u ? cnt : 1u;
}
__device__ __forceinline__ void xcd_barrier(const XcdBarrier& b, bool leader  ) {
    asm volatile("s_waitcnt vmcnt(0)" ::: "memory");
    __syncthreads();
    if (leader) {
        unsigned* bar = b.bar;
        __builtin_amdgcn_s_waitcnt(0);
        unsigned nloc = b.st[0], nx = b.st[1];
        if (nloc == 0u) { xcd_barrier_complete(bar, b.x, nloc, nx); b.st[0] = nloc; b.st[1] = nx; }
        const unsigned old = xb_add(&bar[XB_XSUB(b.x)], 1u);
        const unsigned gen = old / nloc;
        if (old + 1u == (gen + 1u) * nloc) {
            __builtin_amdgcn_fence(__ATOMIC_RELEASE, "agent");
            asm volatile("s_waitcnt vmcnt(0)" ::: "memory");
            const unsigned og = xb_add(&bar[XB_TOP], 1u);
            const unsigned tg = og / nx;
            if (og + 1u == (tg + 1u) * nx) xb_add(&bar[XB_TOPGEN], 1u);
            else XB_SPIN(xb_ld(&bar[XB_TOPGEN]) == tg, bar);
            __builtin_amdgcn_fence(__ATOMIC_ACQUIRE, "agent");
            xb_add(&bar[XB_XGEN(b.x)], 1u);
            asm volatile("s_waitcnt vmcnt(0)" ::: "memory");
        } else {
            XB_SPIN(xb_ld(&bar[XB_XGEN(b.x)]) == gen, bar);
            __builtin_amdgcn_fence(__ATOMIC_ACQUIRE, "agent");
            asm volatile("s_waitcnt vmcnt(0)" ::: "memory");
        }
    }
    __syncthreads();
}

namespace pg8 {
constexpr int BM = 256, BK = 64, HALF = 128, HTB = HALF * BK * 2, STAGE_BYTES = 8 * HTB, NXCD = 8, WGM = 8;
__host__ __device__ __forceinline__ int lds_byte(int r, int c) { const int st = (r >> 4) * 2 + (c >> 5), rr = r & 15, cc = c & 31, ob = rr * 64 + cc * 2; return st * 1024 + (ob ^ (((ob >> 9) & 1) << 5)); }
__host__ __device__ __forceinline__ void stage_rc(int b, int& R, int& C) { const int st = b / 1024, sb = b % 1024, swz = sb ^ (((sb >> 9) & 1) << 5); R = (st >> 1) * 16 + swz / 64; C = (st & 1) * 32 + (swz % 64) / 2; }
__host__ __device__ __forceinline__ int perm32(int rho) { const int n = rho >> 4, i = rho & 15; return 8 * (i >> 2) + 4 * n + (i & 3); }

struct Unit { int pm, pn, pb, aux, aux2; };
struct Gemm { const bf16_t* A; const bf16_t* Bt; int lda, ldb, K; };

struct StaticOrder {
    int nM, nN, nwg, G, c;
    __device__ void init(int M, int N, int G_, int c_) { nM = M / BM; nN = N / BM; nwg = nM * nN; G = G_; c = c_; }
    __device__ bool next(int i, Unit& u) const {
        const long L = (long)i * G + c; if (L >= nwg) return false;
        int wgid = (int)L; { const int q = nwg / NXCD, r = nwg % NXCD, xcd = wgid % NXCD, off = wgid / NXCD; wgid = (xcd < r ? xcd * (q + 1) : r * (q + 1) + (xcd - r) * q) + off; }
        const int nig = WGM * nN, gid = wgid / nig, fm = gid * WGM, gsz = (nM - fm) < WGM ? (nM - fm) : WGM;
        u.pm = fm + ((wgid % nig) % gsz); u.pn = (wgid % nig) / gsz; u.pb = u.pn; u.aux = 0; u.aux2 = 0; return true;
    }
};
struct GroupedOrder {
    int nM, nN, rtpg, G, v;
    __device__ void init(int nM_, int nN_, int rtpg_, int G_, int v_) { nM = nM_; nN = nN_; rtpg = rtpg_; G = G_; v = v_; }
    __device__ bool next(int i, Unit& u) const {
        const int L = i * G + v; if (L >= nM * nN) return false;
        u.pm = L / nN; u.pn = L % nN; u.aux = u.pm / rtpg; u.pb = u.aux * nN + u.pn; u.aux2 = 0; return true;
    }
};

template <class Epi, class Sched, bool ALIGN_EPI, bool GATHER, bool FP8 = false>
__device__ __forceinline__ void gemm_phase(LAS unsigned char* lds, const Gemm g, const Sched& S, const Epi& E, const LAS unsigned* rowtab  , int wid  ) {
    const int lane = lane_id(), tid = wid * 64 + lane, wr = wid >> 2, wc = wid & 3;
    const int K = g.K, nt = K / BK;
    unsigned voffB[2];
#pragma unroll
    for (int i = 0; i < 2; ++i) { int R, C; stage_rc(tid * 16 + i * 8192, R, C); const int Rb = (R & ~31) + perm32(R & 31);
        voffB[i] = (unsigned)(Rb * g.ldb + C) * 2u; }
    const size_t kstep = (size_t)(BK * 2);
    const size_t hstepB = (size_t)HALF * g.ldb * 2, tstepB = 2 * hstepB;
    const size_t tstepA = (size_t)BM * g.lda * 2;
    const unsigned ldsw = (unsigned)wid * 1024u;
    const int aoff = lds_byte(wr * 64 + (lane & 15), (lane >> 4) * 8), boff = lds_byte(wc * 32 + (lane & 15), (lane >> 4) * 8);
    unsigned vAc[2][2];
#define PG8_SETVA(dst, ui_) do { const int t_ = wid * 64 + lane_id(); _Pragma("unroll") for (int i_ = 0; i_ < 2; ++i_) { int R_, C_; stage_rc(t_ * 16 + i_ * 8192, R_, C_); \
        _Pragma("unroll") for (int h_ = 0; h_ < 2; ++h_) dst[h_][i_] = (GATHER ? rowtab[(ui_) * 256 + h_ * 128 + R_] : (unsigned)((h_ * 128 + R_) * g.lda) * 2u) + (unsigned)C_ * 2u; } } while (0)
#define PG8_SA(b, h) (((b) * 2 + (h)) * HTB)
#define PG8_SB(b, h) ((4 + (b) * 2 + (h)) * HTB)
#define PG8_GLDS_S(gbase_, voff_, ldsaddr_) do { unsigned keep_; asm volatile("s_mov_b32 %0, m0\n\ts_mov_b32 m0, %3\n\ts_nop 0\n\tglobal_load_lds_dwordx4 %1, %2\n\ts_mov_b32 m0, %0" \
        : "=&s"(keep_) : "v"(voff_), "s"(gbase_), "s"(ldsaddr_) : "memory"); } while (0)
#define PG8_STAGE(bufoff, gbase, v0, v1) do { \
        if constexpr (FP8) { const unsigned la_ = (unsigned)(uintptr_t)(lds + (bufoff) + ldsw); PG8_GLDS_S((const char*)(gbase), (v0), la_); PG8_GLDS_S((const char*)(gbase), (v1), la_ + 8192u); } else { \
        __builtin_amdgcn_global_load_lds((const unsigned*)((const char*)(gbase) + (v0)), (LAS unsigned*)(lds + (bufoff) + ldsw), 16, 0, 0); \
        __builtin_amdgcn_global_load_lds((const unsigned*)((const char*)(gbase) + (v1)), (LAS unsigned*)(lds + (bufoff) + ldsw + 8192), 16, 0, 0); } } while (0)
#define PG8_STB(bufoff, gbase) PG8_STAGE(bufoff, gbase, voffB[0], voffB[1])
#define PG8_LDA(dst, b, h) do { _Pragma("unroll") for (int m = 0; m < 4; ++m) _Pragma("unroll") for (int k = 0; k < 2; ++k) dst[m][k] = *(const LAS bf16x8*)(lds + PG8_SA(b, h) + aoff + m * 2048 + k * 1024); } while (0)
#define PG8_LDB(dst, b, h) do { _Pragma("unroll") for (int n = 0; n < 2; ++n) _Pragma("unroll") for (int k = 0; k < 2; ++k) dst[n][k] = *(const LAS bf16x8*)(lds + PG8_SB(b, h) + boff + n * 2048 + k * 1024); } while (0)
#define PG8_MMA(ai, bj, At, Bt) do { __builtin_amdgcn_s_setprio(1); \
        if constexpr (FP8) { _Pragma("unroll") for (int m = 0; m < 4; ++m) _Pragma("unroll") for (int n = 0; n < 2; ++n) { \
            const v8i32 a8_ = __builtin_shufflevector(__builtin_bit_cast(v4i32, At[m][0]), __builtin_bit_cast(v4i32, At[m][1]), 0, 1, 2, 3, 4, 5, 6, 7); \
            const v8i32 b8_ = __builtin_shufflevector(__builtin_bit_cast(v4i32, Bt[n][0]), __builtin_bit_cast(v4i32, Bt[n][1]), 0, 1, 2, 3, 4, 5, 6, 7); \
            acc[ai][bj][m][n] = __builtin_amdgcn_mfma_scale_f32_16x16x128_f8f6f4(b8_, a8_, acc[ai][bj][m][n], 0, 0, 0, 0, 0, 0); } } \
        else { _Pragma("unroll") for (int m = 0; m < 4; ++m) _Pragma("unroll") for (int n = 0; n < 2; ++n) _Pragma("unroll") for (int k = 0; k < 2; ++k) \
            acc[ai][bj][m][n] = __builtin_amdgcn_mfma_f32_16x16x32_bf16(Bt[n][k], At[m][k], acc[ai][bj][m][n], 0, 0, 0); } \
        __builtin_amdgcn_s_setprio(0); } while (0)
#define PG8_WAIT_V(n) asm volatile("s_waitcnt vmcnt(" #n ")" ::: "memory")
#define PG8_WAIT_L(n) asm volatile("s_waitcnt lgkmcnt(" #n ")" ::: "memory")
#define PG8_BAR __builtin_amdgcn_s_barrier()
#define PG8_SCHED __builtin_amdgcn_sched_barrier(0)
#define PG8_SCHED8 do { if constexpr (FP8) __builtin_amdgcn_sched_barrier(0); } while (0)
    Unit cur, nxt; int ui = 0;
#define PG8_UNI(u_) do { u_.pm = __builtin_amdgcn_readfirstlane(u_.pm); u_.pn = __builtin_amdgcn_readfirstlane(u_.pn); u_.pb = __builtin_amdgcn_readfirstlane(u_.pb); u_.aux = __builtin_amdgcn_readfirstlane(u_.aux); u_.aux2 = __builtin_amdgcn_readfirstlane(u_.aux2); } while (0)
    if (!S.next(0, cur)) return;
    PG8_UNI(cur);
    f32x4 acc[2][2][4][2];
#pragma unroll
    for (int a = 0; a < 2; ++a)
#pragma unroll
        for (int b = 0; b < 2; ++b)
#pragma unroll
            for (int m = 0; m < 4; ++m)
#pragma unroll
                for (int n = 0; n < 2; ++n) acc[a][b][m][n] = (f32x4){0.f, 0.f, 0.f, 0.f};
    bf16x8 At[4][2], B0[2][2], B1[2][2];
    const char* cA = (const char*)g.A + (GATHER ? (size_t)0 : (size_t)cur.pm * tstepA); const char* cB = (const char*)g.Bt + (size_t)cur.pb * tstepB;
    PG8_SETVA(vAc, 0);
    PG8_STB(PG8_SB(0, 0), cB); PG8_STB(PG8_SB(0, 1), cB + hstepB); PG8_STAGE(PG8_SA(0, 0), cA, vAc[0][0], vAc[0][1]); PG8_STAGE(PG8_SA(0, 1), cA, vAc[1][0], vAc[1][1]);
    if (wr == 1) PG8_BAR;
    PG8_WAIT_V(2); PG8_BAR;
    PG8_STB(PG8_SB(1, 0), cB + kstep); PG8_STAGE(PG8_SA(1, 0), cA + kstep, vAc[0][0], vAc[0][1]); PG8_STB(PG8_SB(1, 1), cB + hstepB + kstep);
    PG8_WAIT_V(6); PG8_BAR;
    for (;;) {
        const bool has_next = S.next(ui + 1, nxt);
        PG8_UNI(nxt);
        const char* nA = GATHER ? cA : (has_next ? (const char*)g.A + (size_t)nxt.pm * tstepA : cA); const char* nB = has_next ? (const char*)g.Bt + (size_t)nxt.pb * tstepB : cB;
        const int nui = has_next ? ui + 1 : ui;
#pragma nounroll
        for (int t = 0; t < nt; t += 2) {
            const bool last = (t == nt - 2);
            const char* a1 = cA + (size_t)(t + 1) * kstep;
            const char* a2 = last ? nA : cA + (size_t)(t + 2) * kstep; const char* b2 = last ? nB : cB + (size_t)(t + 2) * kstep;
            const char* a3 = a2 + kstep; const char* b3 = b2 + kstep;
            unsigned x00 = vAc[0][0], x01 = vAc[0][1], x10 = vAc[1][0], x11 = vAc[1][1];
            if (GATHER) { if (last) { unsigned vN_[2][2]; PG8_SETVA(vN_, nui); x00 = vN_[0][0]; x01 = vN_[0][1]; x10 = vN_[1][0]; x11 = vN_[1][1]; } }
            PG8_LDB(B0, 0, 0); PG8_LDB(B1, 0, 1); PG8_SCHED; PG8_LDA(At, 0, 0); PG8_STAGE(PG8_SA(1, 1), a1, vAc[1][0], vAc[1][1]);
            PG8_WAIT_V(8); PG8_WAIT_L(0); PG8_BAR; PG8_SCHED8; PG8_MMA(0, 0, At, B0); PG8_MMA(0, 1, At, B1); PG8_SCHED8; PG8_BAR; PG8_SCHED;
            PG8_LDA(At, 0, 1); PG8_STB(PG8_SB(0, 0), b2); PG8_STB(PG8_SB(0, 1), b2 + hstepB); PG8_STAGE(PG8_SA(0, 0), a2, x00, x01);
            PG8_WAIT_V(8); PG8_WAIT_L(0); PG8_BAR; PG8_SCHED8; PG8_MMA(1, 0, At, B0); PG8_MMA(1, 1, At, B1); PG8_SCHED8; PG8_BAR; PG8_SCHED;
            PG8_LDB(B0, 1, 0); PG8_LDB(B1, 1, 1); PG8_SCHED; PG8_LDA(At, 1, 0); PG8_STAGE(PG8_SA(0, 1), a2, x10, x11);
            PG8_WAIT_V(8); PG8_WAIT_L(0); PG8_BAR; PG8_SCHED8; PG8_MMA(0, 0, At, B0); PG8_MMA(0, 1, At, B1); PG8_SCHED8; PG8_BAR; PG8_SCHED;
            PG8_LDA(At, 1, 1); PG8_STB(PG8_SB(1, 0), b3); PG8_STB(PG8_SB(1, 1), b3 + hstepB); PG8_STAGE(PG8_SA(1, 0), a3, x00, x01);
            PG8_WAIT_V(8); PG8_WAIT_L(0); PG8_BAR; PG8_SCHED8; PG8_MMA(1, 0, At, B0); PG8_MMA(1, 1, At, B1); PG8_SCHED8; PG8_BAR; PG8_SCHED;
        }
        if constexpr (ALIGN_EPI) { if (wr == 0) PG8_BAR; }
        { int l_ = lane_id(); asm volatile("" : "+v"(l_));
          E(acc, cur, wr, wc, l_ & 15, l_ >> 4); }
        if (!has_next) break;
#pragma unroll
        for (int a = 0; a < 2; ++a)
#pragma unroll
            for (int b = 0; b < 2; ++b)
#pragma unroll
                for (int m = 0; m < 4; ++m)
#pragma unroll
                    for (int n = 0; n < 2; ++n) acc[a][b][m][n] = (f32x4){0.f, 0.f, 0.f, 0.f};
        cur = nxt; cA = nA; cB = nB; ++ui;
        if (GATHER) { PG8_SETVA(vAc, ui); }
        if constexpr (ALIGN_EPI) { if (wr == 1) PG8_BAR; }
    }
    PG8_WAIT_V(0);
    if constexpr (!ALIGN_EPI) { if (wr == 0) PG8_BAR; }
    PG8_BAR;
#undef PG8_SETVA
#undef PG8_UNI
#undef PG8_SA
#undef PG8_SB
#undef PG8_STAGE
#undef PG8_GLDS_S
#undef PG8_STB
#undef PG8_LDA
#undef PG8_LDB
#undef PG8_MMA
#undef PG8_WAIT_V
#undef PG8_WAIT_L
#undef PG8_BAR
#undef PG8_SCHED
#undef PG8_SCHED8
}
}
constexpr int NWAVES = 8, NTHR = 512;
constexpr int BATCH = 8, SEQ = 8192, T = BATCH * SEQ, D = 1024, DIN = 4096;
constexpr int DS = 512, DA = 512, NH = 8, HD = 64, NBLK = SEQ / 256;
constexpr int SG = 32, SHC = 16, SP = 64, SL = 32, SKU = SL * SHC  , SKS = 2 * SP  , SKY = SKU + SKS  , SROWS = T / SL  ;
constexpr int NE = 32, DE = 512;
constexpr float RMS_EPS = 1e-6f;
constexpr float LOG2E = 1.4426950408889634f;
constexpr float QSCALE = 0.125f * LOG2E;
constexpr float WF8_SCALE = 32.f;
constexpr int ROWCAP = T;
constexpr int HID_ROWS = 2 * T + NE * 256;

constexpr size_t MiB = 1u << 20;
constexpr size_t WS_CTL = 0, CTL_ZERO_BYTES = 1 * MiB;
constexpr size_t WS_WIN = 1 * MiB;
constexpr size_t WS_WGLU = 9 * MiB;
constexpr size_t WS_WUS = 10 * MiB;
constexpr size_t WS_WUA = 11 * MiB;
constexpr size_t WS_WOUT = 12 * MiB;
constexpr size_t WS_WR = 14 * MiB;
constexpr size_t WS_KMEAN = 15 * MiB;
constexpr size_t WS_SSMW = 16 * MiB;
constexpr size_t WS_SSMT = 24 * MiB;
constexpr size_t WS_W13 = 44 * MiB;
constexpr size_t WS_W2 = 108 * MiB;
constexpr size_t WS_A0 = 140 * MiB;
constexpr size_t WS_UP = 276 * MiB;
constexpr size_t WS_Q = 356 * MiB;
constexpr size_t WS_SSQ = 404 * MiB;
constexpr size_t WS_RLOG = 408 * MiB;
constexpr size_t WS_K = 420 * MiB;
constexpr size_t WS_ROWTOK = 428 * MiB, WS_ROWCOEF = 436 * MiB, WS_ROWRSTD = 444 * MiB;
constexpr size_t WS_GACT = 420 * MiB;
constexpr size_t WS_V = 484 * MiB;
constexpr size_t WS_YSSM = 484 * MiB;
constexpr size_t WS_SGS = 548 * MiB;
constexpr size_t WS_SGA = 676 * MiB;
constexpr size_t WS_E = 804 * MiB;
constexpr size_t WS_YATT = 836 * MiB;
constexpr size_t WS_PART0 = 420 * MiB, WS_PART1 = 484 * MiB, WS_PART2 = 932 * MiB;
constexpr size_t WS_QLIST = 900 * MiB;
constexpr size_t WS_PL = 268 * MiB;
constexpr size_t WS_MQ = 996 * MiB;
constexpr size_t WS_H1F8 = 836 * MiB;
constexpr size_t WS_WINF8 = 900 * MiB;
constexpr size_t WS_XGF8 = 836 * MiB;
constexpr size_t WS_SEGC = 998 * MiB;
constexpr size_t WS_END = 999 * MiB;
constexpr size_t WS_KFRAG = WS_A0, WS_VFRAG = WS_A0 + 64 * MiB, WS_H1 = WS_A0, WS_MRG = WS_A0, WS_HID = WS_A0;
constexpr size_t WS_X1 = WS_SGS, WS_XG = WS_UP, WS_Y0 = WS_UP, WS_Y1 = WS_E;
static_assert(WS_GACT + 64 * MiB <= WS_YSSM && WS_YSSM + 64 * MiB <= WS_SGS, "map");
static_assert(WS_HID + (size_t)HID_ROWS * DE * 2 <= WS_UP, "hid fits");
static_assert(WS_RLOG + (size_t)T * 72 * 4 <= WS_ROWTOK, "rlog fits");

constexpr int CW_TMO = 0, CW_CODE = 1;
constexpr int CW_BAR = 4096;
constexpr int CW_ECNT = 8192;
constexpr int CW_GCNT = 12288;

constexpr int RING_BYTES = 131072;
constexpr int ROWTAB_OFF = RING_BYTES, ROWTAB_UNITS = 12, ROWTAB_BYTES = 25 * 1024;
constexpr int MOE_TST_OFF = ROWTAB_OFF + ROWTAB_BYTES;
constexpr int MISC_OFF = MOE_TST_OFF + 512;
constexpr int LDS_BYTES = MISC_OFF + 128;
static_assert(LDS_BYTES <= 163840, "LDS");

struct Frame {
    LAS unsigned char* lds;
    volatile LAS unsigned* MISC;
    gu32* ctl;
    unsigned char* ws;
    int tid, lane, wave, vcu, G;
    const float* in[27];
    float* out;
};

__device__ __forceinline__ unsigned pk4_fp8(float a, float b, float c, float d) { int w = 0; w = __builtin_amdgcn_cvt_pk_fp8_f32(a, b, w, false); w = __builtin_amdgcn_cvt_pk_fp8_f32(c, d, w, true); return (unsigned)w; }
#define EPI_LOOP_BEGIN  _Pragma("unroll") for (int ai = 0; ai < 2; ++ai) _Pragma("unroll") for (int m = 0; m < 4; ++m) { const int rl = ai * 128 + wr * 64 + m * 16 + fr; _Pragma("unroll") for (int bj = 0; bj < 2; ++bj) { const int cl = bj * 128 + wc * 32 + 8 * fq; \
        const f32x4 a0 = acc[ai][bj][m][0], a1 = acc[ai][bj][m][1]; (void)rl; (void)cl; (void)a0; (void)a1;
#define EPI_LOOP_END } }
typedef const f32x4 (&AccRef)[2][2][4][2];
__device__ __forceinline__ u32x4 pack8(f32x4 a, f32x4 b) { u32x4 w; w.x = cvt_pk_bf16(a[0], a[1]); w.y = cvt_pk_bf16(a[2], a[3]); w.z = cvt_pk_bf16(b[0], b[1]); w.w = cvt_pk_bf16(b[2], b[3]); return w; }
__device__ __forceinline__ void unpack8(u32x4 w, f32x4& a, f32x4& b) { a = (f32x4){bflo(w.x), bfhi(w.x), bflo(w.y), bfhi(w.y)}; b = (f32x4){bflo(w.z), bfhi(w.z), bflo(w.w), bfhi(w.w)}; }

template <int PART  > struct EpiProj {
    unsigned char* ws; const float* b_gate; int pn_off; float ascale;
    __device__ __forceinline__ void operator()(AccRef acc, const pg8::Unit& u, int wr, int wc, int fr, int fq) const {
        const int pn = u.pn + pn_off; const int row0 = u.pm * 256;
        if (PART == 0) {
            bf16_t* Uperm = (bf16_t*)(ws + WS_UP);
            EPI_LOOP_BEGIN
                const int row = row0 + rl, col = pn * 256 + cl;
                bf16_t* dst = Uperm + (size_t)(col >> 4) * ((size_t)SROWS * SKY) + (size_t)(row >> 5) * SKY + (row & 31) * 16 + (col & 15);
                *(u32x4*)dst = pack8(a0 * ascale, a1 * ascale);
            EPI_LOOP_END
        } else if (pn < 8) {
            const size_t boff = pn < 4 ? WS_Q : (pn < 6 ? WS_K : WS_V);
            bf16_t* base = (bf16_t*)(ws + boff); const float sc = pn < 4 ? QSCALE : 1.f; const int c0 = (pn & 1) * 256;
            EPI_LOOP_BEGIN
                const int row = row0 + rl, col = c0 + cl;
                *(u32x4*)(base + (size_t)row * 512 + col) = pack8(a0 * (sc * ascale), a1 * (sc * ascale));
            EPI_LOOP_END
        } else {
            const size_t boff = pn < 12 ? WS_SGS : WS_SGA;
            bf16_t* base = (bf16_t*)(ws + boff); const int c0 = ((pn - 8) & 3) * 256; const float* bg = b_gate + (pn - 8) * 256;
            EPI_LOOP_BEGIN
                const int row = row0 + rl, col = c0 + cl;
                const f32x4 b0 = *(const f32x4*)(bg + cl), b1 = *(const f32x4*)(bg + cl + 4);
                f32x4 s0, s1;
#pragma unroll
                for (int e = 0; e < 4; ++e) { s0[e] = fast_sigmoid(a0[e] * ascale + b0[e]); s1[e] = fast_sigmoid(a1[e] * ascale + b1[e]); }
                *(u32x4*)(base + (size_t)row * 1024 + col) = pack8(s0, s1);
            EPI_LOOP_END
        }
    }
};
struct EpiSsmE {
    float* E;
    __device__ __forceinline__ void operator()(AccRef acc, const pg8::Unit& u, int wr, int wc, int fr, int fq) const {
        EPI_LOOP_BEGIN
            if (bj == 0) { float* dst = E + (size_t)(u.pm * 256 + rl) * 128 + cl; *(f32x4*)dst = a0; *(f32x4*)(dst + 4) = a1; }
        EPI_LOOP_END
    }
};
__device__ __forceinline__ float gelu_tanh(float x) { const float z = 1.5957691216057308f * (x + 0.044715f * x * x * x); return x * fast_sigmoid(z); }
struct EpiSsmY {
    bf16_t* Gact;
    __device__ __forceinline__ void operator()(AccRef acc, const pg8::Unit& u, int wr, int wc, int fr, int fq) const {
        const int g = u.aux;
        EPI_LOOP_BEGIN
            const int rg = (u.pm & 7) * 256 + rl;
            const int colg = u.pn * 256 + cl;
            const int tok = (rg >> 8) * SEQ + (rg & 255) * SL + (colg >> 4);
            f32x4 y0, y1;
#pragma unroll
            for (int e = 0; e < 4; ++e) { y0[e] = gelu_tanh(a0[e]); y1[e] = gelu_tanh(a1[e]); }
            *(u32x4*)(Gact + (size_t)tok * DS + g * 16 + (colg & 15)) = pack8(y0, y1);
        EPI_LOOP_END
    }
};
#define EPI_SBAR __builtin_amdgcn_sched_barrier(0)
#define EPI_G(g_) const int ai = (g_) >> 2, m = (g_) & 3; const int rl = ai * 128 + wr * 64 + m * 16 + fr; (void)rl
struct EpiGlu {
    const bf16_t* Gact; bf16_t* Yssm; const float* b_glu;
    __device__ __forceinline__ void operator()(AccRef acc, const pg8::Unit& u, int wr, int wc, int fr, int fq) const {
        const int col0 = u.pn * 256 + wc * 32 + 8 * fq; const size_t rowb = (size_t)u.pm * 256;
        f32x4 bv[2][2]; u32x4 gv[8][2];
#pragma unroll
        for (int bj = 0; bj < 2; ++bj) { bv[bj][0] = *(const f32x4*)(b_glu + col0 + bj * 128); bv[bj][1] = *(const f32x4*)(b_glu + col0 + bj * 128 + 4); }
#pragma unroll
        for (int g = 0; g < 8; ++g) { EPI_G(g);
#pragma unroll
            for (int bj = 0; bj < 2; ++bj) gv[g][bj] = *(const u32x4*)(Gact + (rowb + rl) * DS + col0 + bj * 128); }
        EPI_SBAR;
#pragma unroll
        for (int g = 0; g < 8; ++g) { EPI_G(g);
#pragma unroll
            for (int bj = 0; bj < 2; ++bj) { f32x4 g0, g1; unpack8(gv[g][bj], g0, g1); const f32x4 a0 = acc[ai][bj][m][0], a1 = acc[ai][bj][m][1]; f32x4 y0, y1;
#pragma unroll
                for (int e = 0; e < 4; ++e) { y0[e] = g0[e] * fast_sigmoid(a0[e] + bv[bj][0][e]); y1[e] = g1[e] * fast_sigmoid(a1[e] + bv[bj][1][e]); }
                *(u32x4*)(Yssm + (rowb + rl) * DS + col0 + bj * 128) = pack8(y0, y1); } }
    }
};
template <bool SECOND> struct EpiUp {
    const bf16_t* SG; bf16_t* Mrg;
    __device__ __forceinline__ void operator()(AccRef acc, const pg8::Unit& u, int wr, int wc, int fr, int fq) const {
        const size_t base = (size_t)u.pm * 256 * D + u.pn * 256 + wc * 32 + 8 * fq;
        u32x4 sv[2][2][2], mv[2][2][2];
#define UP_LOAD(buf_, bt_) do { _Pragma("unroll") for (int gi_ = 0; gi_ < 2; ++gi_) { EPI_G(2 * (bt_) + gi_); _Pragma("unroll") for (int bj = 0; bj < 2; ++bj) { const size_t off = base + (size_t)rl * D + bj * 128; \
            sv[buf_][gi_][bj] = *(const u32x4*)(SG + off); if (SECOND) mv[buf_][gi_][bj] = *(const u32x4*)(Mrg + off); } } } while (0)
#define UP_PROC(buf_, bt_) do { _Pragma("unroll") for (int gi_ = 0; gi_ < 2; ++gi_) { EPI_G(2 * (bt_) + gi_); _Pragma("unroll") for (int bj = 0; bj < 2; ++bj) { const size_t off = base + (size_t)rl * D + bj * 128; \
            f32x4 s0, s1; unpack8(sv[buf_][gi_][bj], s0, s1); f32x4 y0 = s0 * acc[ai][bj][m][0], y1 = s1 * acc[ai][bj][m][1]; \
            if (SECOND) { f32x4 p0, p1; unpack8(mv[buf_][gi_][bj], p0, p1); y0 += p0; y1 += p1; } \
            *(u32x4*)(Mrg + off) = pack8(y0, y1); } } } while (0)
        UP_LOAD(0, 0); UP_LOAD(1, 1); EPI_SBAR;
        UP_PROC(0, 0); UP_LOAD(0, 2); EPI_SBAR;
        UP_PROC(1, 1); UP_LOAD(1, 3); EPI_SBAR;
        UP_PROC(0, 2); EPI_SBAR;
        UP_PROC(1, 3);
#undef UP_LOAD
#undef UP_PROC
    }
};
struct EpiOut {
    const float* x; bf16_t* X1; unsigned char* X18; float* SSQ;
    __device__ __forceinline__ void operator()(AccRef acc, const pg8::Unit& u, int wr, int wc, int fr, int fq) const {
        const int col0 = u.pn * 256 + wc * 32 + 8 * fq; const size_t base = (size_t)u.pm * 256 * D + col0;
        f32x4 xv[2][2][2][2];
#define OUT_LOAD(buf_, bt_) do { _Pragma("unroll") for (int gi_ = 0; gi_ < 2; ++gi_) { EPI_G(2 * (bt_) + gi_); _Pragma("unroll") for (int bj = 0; bj < 2; ++bj) { const size_t off = base + (size_t)rl * D + bj * 128; \
            xv[buf_][gi_][bj][0] = *(const f32x4*)(x + off); xv[buf_][gi_][bj][1] = *(const f32x4*)(x + off + 4); } } } while (0)
#define OUT_PROC(buf_, bt_) do { _Pragma("unroll") for (int gi_ = 0; gi_ < 2; ++gi_) { EPI_G(2 * (bt_) + gi_); float ss = 0.f; _Pragma("unroll") for (int bj = 0; bj < 2; ++bj) { const size_t off = base + (size_t)rl * D + bj * 128; \
            const f32x4 x0 = xv[buf_][gi_][bj][0] + acc[ai][bj][m][0], x1 = xv[buf_][gi_][bj][1] + acc[ai][bj][m][1]; \
            *(u32x4*)(X1 + off) = pack8(x0, x1); *(u32x2*)(X18 + off) = (u32x2){pk4_fp8(x0[0], x0[1], x0[2], x0[3]), pk4_fp8(x1[0], x1[1], x1[2], x1[3])}; \
            ss += (x0[0] * x0[0] + x0[1] * x0[1]) + (x0[2] * x0[2] + x0[3] * x0[3]) + (x1[0] * x1[0] + x1[1] * x1[1]) + (x1[2] * x1[2] + x1[3] * x1[3]); } \
            ss += __shfl_xor(ss, 16); ss += __shfl_xor(ss, 32); \
            SSQ[((size_t)u.pm * 256 + rl) * 16 + u.pn * 4 + wc] = ss; } } while (0)
        OUT_LOAD(0, 0); OUT_LOAD(1, 1); EPI_SBAR;
        OUT_PROC(0, 0); OUT_LOAD(0, 2); EPI_SBAR;
        OUT_PROC(1, 1); OUT_LOAD(1, 3); EPI_SBAR;
        OUT_PROC(0, 2); EPI_SBAR;
        OUT_PROC(1, 3);
#undef OUT_LOAD
#undef OUT_PROC
    }
};
struct EpiRouter {
    float* Rlog;
    __device__ __forceinline__ void operator()(AccRef acc, const pg8::Unit& u, int wr, int wc, int fr, int fq) const {
        EPI_LOOP_BEGIN
            if (bj == 0 && cl < 72) { float* dst = Rlog + (size_t)(u.pm * 256 + rl) * 72 + cl; *(f32x4*)dst = a0; *(f32x4*)(dst + 4) = a1; }
        EPI_LOOP_END
    }
};
struct EpiMoe1 {
    unsigned char* Hid; const float* rowrstd; const unsigned* ecnt; float ascale;
    __device__ __forceinline__ void operator()(AccRef acc, const pg8::Unit& u, int wr, int wc, int fr, int fq) const {
        const int e = u.aux, cnt = (int)ecnt[e]; float rsv[8];
#pragma unroll
        for (int g = 0; g < 8; ++g) { EPI_G(g); const int pos = u.aux2 + rl; rsv[g] = rowrstd[(size_t)e * ROWCAP + (pos < cnt ? pos : 0)] * ascale; }
        EPI_SBAR;
#pragma unroll
        for (int g = 0; g < 8; ++g) { EPI_G(g); const int pos = u.aux2 + rl;
            if (pos < cnt) { const float rs = rsv[g]; f32x4 h0, h1;
#pragma unroll
                for (int k = 0; k < 4; ++k) { const float p = acc[ai][0][m][0][k] * rs, q = acc[ai][1][m][0][k] * rs; h0[k] = p * fast_sigmoid(p) * q;
                    const float p2 = acc[ai][0][m][1][k] * rs, q2 = acc[ai][1][m][1][k] * rs; h1[k] = p2 * fast_sigmoid(p2) * q2; }
                *(u32x2*)(Hid + (size_t)(u.pm * 256 + rl) * DE + u.pn * 128 + wc * 32 + 8 * fq) = (u32x2){pk4_fp8(h0[0], h0[1], h0[2], h0[3]), pk4_fp8(h1[0], h1[1], h1[2], h1[3])}; } }
    }
};
struct EpiMoe2 {
    bf16_t* Y0; size_t ydelta; const unsigned* rowtok; const float* rowcoef; const unsigned* ecnt; float ascale;
    __device__ __forceinline__ void operator()(AccRef acc, const pg8::Unit& u, int wr, int wc, int fr, int fq) const {
        const int e = u.aux, cnt = (int)ecnt[e]; unsigned tkv[8]; float cfv[8];
#pragma unroll
        for (int g = 0; g < 8; ++g) { EPI_G(g); const int pos = u.aux2 + rl; const size_t ri = (size_t)e * ROWCAP + (pos < cnt ? pos : 0); tkv[g] = rowtok[ri]; cfv[g] = rowcoef[ri] * ascale; }
        EPI_SBAR;
#pragma unroll
        for (int g = 0; g < 8; ++g) { EPI_G(g); const int pos = u.aux2 + rl;
            if (pos < cnt) { const unsigned tk = tkv[g]; const float cf = cfv[g];
                bf16_t* dst = (bf16_t*)((unsigned char*)Y0 + (size_t)(tk & 1u) * ydelta) + (size_t)(tk >> 1) * D + u.pn * 256 + wc * 32 + 8 * fq;
#pragma unroll
                for (int bj = 0; bj < 2; ++bj) *(u32x4*)(dst + bj * 128) = pack8(acc[ai][bj][m][0] * cf, acc[ai][bj][m][1] * cf); } }
    }
};
__device__ __forceinline__ void transpose_item(const float* W, int N, int k0, int n0, bf16_t* WT, size_t drow0, int ldo, LAS float* scr, int lane) {
    float tv[32];
#pragma unroll
    for (int i = 0; i < 32; ++i) tv[i] = W[(size_t)(k0 + 2 * i + (lane >> 5)) * N + n0 + (lane & 31)];
#pragma unroll
    for (int i = 0; i < 32; ++i) scr[(2 * i + (lane >> 5)) * 33 + (lane & 31)] = tv[i];
    LDS_WAIT(); asm volatile("" ::: "memory");
    const int c = lane & 7;
#pragma unroll
    for (int j = 0; j < 4; ++j) { const int n = (lane >> 3) + 8 * j; const LAS float* s = scr + (8 * c) * 33 + n;
        u32x4 o; o.x = pk2(s[0 * 33], s[1 * 33]); o.y = pk2(s[2 * 33], s[3 * 33]); o.z = pk2(s[4 * 33], s[5 * 33]); o.w = pk2(s[6 * 33], s[7 * 33]);
        *(u32x4*)(WT + (drow0 + n) * (size_t)ldo + k0 + 8 * c) = o; }
    LDS_WAIT(); asm volatile("" ::: "memory");
}
__device__ __forceinline__ void transpose_item_f8(const float* W, int N, int k0, int n0, unsigned char* WT8, size_t drow0, int ldo, float scale, LAS float* scr, int lane, const float* kgain = nullptr  ) {
    float tv[32];
#pragma unroll
    for (int i = 0; i < 32; ++i) tv[i] = W[(size_t)(k0 + 2 * i + (lane >> 5)) * N + n0 + (lane & 31)];
#pragma unroll
    for (int i = 0; i < 32; ++i) scr[(2 * i + (lane >> 5)) * 33 + (lane & 31)] = tv[i] * (kgain ? scale * kgain[k0 + 2 * i + (lane >> 5)] : scale);
    LDS_WAIT(); asm volatile("" ::: "memory");
    const int c = lane & 3;
#pragma unroll
    for (int j = 0; j < 2; ++j) { const int n = (lane >> 2) + 16 * j; const LAS float* s = scr + (16 * c) * 33 + n;
        u32x4 o; o.x = pk4_fp8(s[0 * 33], s[1 * 33], s[2 * 33], s[3 * 33]); o.y = pk4_fp8(s[4 * 33], s[5 * 33], s[6 * 33], s[7 * 33]);
        o.z = pk4_fp8(s[8 * 33], s[9 * 33], s[10 * 33], s[11 * 33]); o.w = pk4_fp8(s[12 * 33], s[13 * 33], s[14 * 33], s[15 * 33]);
        *(u32x4*)(WT8 + (drow0 + n) * (size_t)ldo + k0 + 16 * c) = o; }
    LDS_WAIT(); asm volatile("" ::: "memory");
}
template <int NR> __device__ __forceinline__ void rms_rows_to_bf16(int lane, const float* xrow, const float* g, bf16_t* orow, unsigned char* orow8) {
    f32x4 v[NR][4]; float s[NR];
#pragma unroll
    for (int r = 0; r < NR; ++r) { const f32x4* xr = (const f32x4*)(xrow + (size_t)r * D) + lane;
#pragma unroll
        for (int j = 0; j < 4; ++j) v[r][j] = xr[64 * j]; }
    const f32x4* gr = (const f32x4*)g + lane; f32x4 wv[4];
#pragma unroll
    for (int j = 0; j < 4; ++j) wv[j] = gr[64 * j];
#pragma unroll
    for (int r = 0; r < NR; ++r) { float a = 0.f;
#pragma unroll
        for (int j = 0; j < 4; ++j) a += (v[r][j].x * v[r][j].x + v[r][j].y * v[r][j].y) + (v[r][j].z * v[r][j].z + v[r][j].w * v[r][j].w);
        s[r] = a; }
#pragma unroll
    for (int o = 1; o < 64; o <<= 1) {
#pragma unroll
        for (int r = 0; r < NR; ++r) s[r] += __shfl_xor(s[r], o); }
#pragma unroll
    for (int r = 0; r < NR; ++r) { const float rstd = 1.f / sqrtf(s[r] * (1.f / D) + RMS_EPS); unsigned long long* o8 = (unsigned long long*)(orow + (size_t)r * D) + lane;
#pragma unroll
        for (int j = 0; j < 4; ++j) { const float y0 = v[r][j].x * rstd * wv[j].x, y1 = v[r][j].y * rstd * wv[j].y, y2 = v[r][j].z * rstd * wv[j].z, y3 = v[r][j].w * rstd * wv[j].w;
            o8[64 * j] = (unsigned long long)pk2(y0, y1) | ((unsigned long long)pk2(y2, y3) << 32);
            ((unsigned*)(orow8 + (size_t)r * D))[lane + 64 * j] = pk4_fp8(y0, y1, y2, y3); } }
}
__device__ __forceinline__ void cpow(float lr, float li, float step, float dl, float& ar, float& ai) {
    const float mag = __expf(dl * lr * step); const float rev = dl * (li * step * 0.15915494309189535f); const float fr = rev - floorf(rev);
    ar = mag * __builtin_amdgcn_cosf(fr); ai = mag * __builtin_amdgcn_sinf(fr);
}
__device__ __forceinline__ void ssm_gen(Frame& F, int g, int sl) {
    LAS float* AP = (LAS float*)(F.lds); LAS float* BB = AP + 33 * 64 * 2; LAS float* CC = BB + 2048; LAS float* KT = CC + 2048;
    const float* lam_re = F.in[4] + g * SP; const float* lam_im = F.in[5] + g * SP; const float step = __expf(F.in[6][g]);
    const float* b_re = F.in[7] + g * SP * SHC; const float* b_im = F.in[8] + g * SP * SHC; const float* c_re = F.in[9] + g * SHC * SP; const float* c_im = F.in[10] + g * SHC * SP; const float* dd = F.in[11] + g * SHC;
    bf16_t* BT = (bf16_t*)(F.ws + WS_SSMT) + (size_t)g * 512 * SKY; bf16_t* BW = (bf16_t*)(F.ws + WS_SSMW) + (size_t)g * 256 * SKU;
    const int tid = F.tid;
    for (int idx = tid; idx < 33 * 64; idx += NTHR) { const int dl = idx >> 6, p = idx & 63; float ar, ai; cpow(lam_re[p], lam_im[p], step, (float)dl, ar, ai); AP[idx * 2] = ar; AP[idx * 2 + 1] = ai; }
    for (int idx = tid; idx < 1024; idx += NTHR) { const int ho = idx >> 6, p = idx & 63; CC[idx * 2] = c_re[ho * 64 + p]; CC[idx * 2 + 1] = c_im[ho * 64 + p]; }
    __syncthreads();
    for (int idx = tid; idx < 1024; idx += NTHR) { const int p = idx >> 4, h = idx & 15; const float ar = AP[(64 + p) * 2], ai = AP[(64 + p) * 2 + 1];
        const float lr = lam_re[p], li = lam_im[p], nr = ar - 1.f, ni = ai, den = lr * lr + li * li, cr = (nr * lr + ni * li) / den, ci = (ni * lr - nr * li) / den;
        const float br = b_re[p * 16 + h], bi = b_im[p * 16 + h]; BB[idx * 2] = cr * br - ci * bi; BB[idx * 2 + 1] = cr * bi + ci * br; }
    __syncthreads();
    for (int idx = tid; idx < 1024; idx += NTHR) { const int dl = idx >> 5, hl = (idx >> 4) & 1, hi = idx & 15, ho = 2 * sl + hl; float s = 0.f;
        for (int p = 0; p < 64; ++p) { const float ar = AP[(dl * 64 + p) * 2], ai = AP[(dl * 64 + p) * 2 + 1], br = BB[(p * 16 + hi) * 2], bi = BB[(p * 16 + hi) * 2 + 1];
            const float zr = ar * br - ai * bi, zi = ar * bi + ai * br; s += CC[(ho * 64 + p) * 2] * zr - CC[(ho * 64 + p) * 2 + 1] * zi; }
        if (dl == 0 && ho == hi) s += dd[ho];
        KT[idx] = s; }
    __syncthreads();
    for (int v = tid; v < 64 * 80; v += NTHR) { const int nl = v / 80, kv = (v % 80) * 8, tau = nl >> 1, hl = nl & 1, ho = 2 * sl + hl, n = tau * 16 + ho; float val[8];
        if (kv < 512) { const int sg = kv >> 4, hi0 = kv & 15;
#pragma unroll
            for (int e = 0; e < 8; ++e) val[e] = (tau >= sg) ? KT[((tau - sg) * 2 + hl) * 16 + hi0 + e] : 0.f; }
        else { const int kk = kv - 512;
#pragma unroll
            for (int e = 0; e < 8; ++e) { const int p = (kk + e) >> 1, ri = (kk + e) & 1; const float ar = AP[((tau + 1) * 64 + p) * 2], ai = AP[((tau + 1) * 64 + p) * 2 + 1], cre = CC[(ho * 64 + p) * 2], cim = CC[(ho * 64 + p) * 2 + 1];
                val[e] = ri == 0 ? (cre * ar - cim * ai) : -(cre * ai + cim * ar); } }
        u32x4 o; o.x = pk2(val[0], val[1]); o.y = pk2(val[2], val[3]); o.z = pk2(val[4], val[5]); o.w = pk2(val[6], val[7]);
        *(u32x4*)(BT + (size_t)n * SKY + kv) = o; }
    for (int v = tid; v < 32 * 64; v += NTHR) { const int nl = v >> 6, kv = (v & 63) * 8; float val[8];
        const bool real = nl < 16; const int n = real ? 16 * sl + nl : 128 + 16 * sl + (nl - 16);
        if (real) { const int p = n >> 1, ri = n & 1, sg = kv >> 4, hi0 = kv & 15; const float ar = AP[((31 - sg) * 64 + p) * 2], ai = AP[((31 - sg) * 64 + p) * 2 + 1];
#pragma unroll
            for (int e = 0; e < 8; ++e) { const float br = BB[(p * 16 + hi0 + e) * 2], bi = BB[(p * 16 + hi0 + e) * 2 + 1]; val[e] = ri == 0 ? (ar * br - ai * bi) : (ar * bi + ai * br); } }
        else {
#pragma unroll
            for (int e = 0; e < 8; ++e) val[e] = 0.f; }
        u32x4 o; o.x = pk2(val[0], val[1]); o.y = pk2(val[2], val[3]); o.z = pk2(val[4], val[5]); o.w = pk2(val[6], val[7]);
        *(u32x4*)(BW + (size_t)n * SKU + kv) = o; }
    __syncthreads();
}
__device__ __forceinline__ void p0_prologue(Frame& F) {
    for (int it = F.vcu; it < SG * 8; it += F.G) ssm_gen(F, it >> 3, it & 7);
    LAS float* scr = (LAS float*)(F.lds + F.wave * 16384);
    const int gw = F.vcu * NWAVES + F.wave, NGW = F.G * NWAVES, lane = F.lane;
    constexpr int I_IN = 16 * 128, I_GLU = 8 * 16, I_US = 8 * 32, I_UA = 8 * 32, I_OUT = 16 * 32, I_W1 = 32 * 256, I_W3 = 32 * 256, I_W2 = 32 * 256;
    constexpr int NITEMS = I_IN + I_GLU + I_US + I_UA + I_OUT + I_W1 + I_W3 + I_W2;
    unsigned char* ws = F.ws;
    for (int it = gw; it < NITEMS; it += NGW) {
        int r = it;
        if (r < I_IN) { const int k0 = 64 * (r / 128), n0 = 32 * (r % 128);
            if (n0 < DS) transpose_item(F.in[2], DIN, k0, n0, (bf16_t*)(ws + WS_WIN), n0, D, scr, lane);
            else transpose_item_f8(F.in[2], DIN, k0, n0, ws + WS_WINF8, n0 - DS, D, WF8_SCALE, scr, lane);
            continue; } r -= I_IN;
        if (r < I_GLU) { transpose_item(F.in[12], DS, 64 * (r / 16), 32 * (r % 16), (bf16_t*)(ws + WS_WGLU), 32 * (r % 16), DS, scr, lane); continue; } r -= I_GLU;
        if (r < I_US) { transpose_item(F.in[14], D, 64 * (r / 32), 32 * (r % 32), (bf16_t*)(ws + WS_WUS), 32 * (r % 32), DS, scr, lane); continue; } r -= I_US;
        if (r < I_UA) { transpose_item(F.in[15], D, 64 * (r / 32), 32 * (r % 32), (bf16_t*)(ws + WS_WUA), 32 * (r % 32), DA, scr, lane); continue; } r -= I_UA;
        if (r < I_OUT) { transpose_item(F.in[17], D, 64 * (r / 32), 32 * (r % 32), (bf16_t*)(ws + WS_WOUT), 32 * (r % 32), D, scr, lane); continue; } r -= I_OUT;
        if (r < I_W1 + I_W3) { const int w3 = r >= I_W1; if (w3) r -= I_W1; const int e = r >> 8, q = r & 255, k0 = 64 * (q / 16), n0 = 32 * (q % 16);
            transpose_item_f8((w3 ? F.in[24] : F.in[23]) + (size_t)e * D * DE, DE, k0, n0, ws + WS_W13, (size_t)e * 1024 + 256 * (n0 >> 7) + (n0 & 127) + (w3 ? 128 : 0), D, WF8_SCALE, scr, lane, F.in[18]); continue; }
        r -= I_W1 + I_W3;
        { const int e = r >> 8, q = r & 255, k0 = 64 * (q / 32), n0 = 32 * (q % 32);
            transpose_item_f8(F.in[25] + (size_t)e * DE * D, D, k0, n0, ws + WS_W2, (size_t)e * 1024 + n0, DE, WF8_SCALE, scr, lane); }
    }
    for (int m = 4 * gw; m < T; m += 4 * NGW) rms_rows_to_bf16<4>(lane, F.in[0] + (size_t)m * D, F.in[1], (bf16_t*)(ws + WS_H1) + (size_t)m * D, ws + WS_H1F8 + (size_t)m * D);
    { bf16_t* WR = (bf16_t*)(ws + WS_WR); const float* wrg = F.in[19]; const float* wre = F.in[21];
      for (int idx = F.vcu * NTHR + F.tid; idx < 256 * D; idx += F.G * NTHR) { const int r = idx >> 10, k = idx & 1023; unsigned o = 0u;
          if (r < 72) { const int c = r < 36 ? r : r - 36; const float w = (c < 4 ? wrg[k * 4 + c] : wre[k * 32 + (c - 4)]) * F.in[18][k]; const unsigned hb = f2bf(w);
              o = r < 36 ? hb : f2bf(w - __builtin_bit_cast(float, hb << 16)); }
          WR[idx] = (bf16_t)o; } }
}

__device__ __forceinline__ int crow(int r, int hi) { return (r & 3) + 8 * (r >> 2) + 4 * hi; }
constexpr int KVP = 72;
__device__ __forceinline__ void kv_prep_phase(Frame& F) {
    LAS bf16_t* KS = (LAS bf16_t*)(F.lds); LAS bf16_t* VS = KS + 256 * KVP; LAS float* PS = (LAS float*)(F.lds + 2 * 256 * KVP * 2); LAS float* WM = PS + 512;
    const bf16_t* Kb = (const bf16_t*)(F.ws + WS_K); const bf16_t* Vb = (const bf16_t*)(F.ws + WS_V);
    bf16_t* Kf = (bf16_t*)(F.ws + WS_KFRAG); bf16_t* Vf = (bf16_t*)(F.ws + WS_VFRAG); bf16_t* KM = (bf16_t*)(F.ws + WS_KMEAN); float* KN = (float*)(F.ws + WS_KMEAN + 512 * 1024);
    const int tid = F.tid;
    u32x4 kr[4], vr[4];
#define KVP_LOAD(item_) do { const int n_ = (item_) & 31, h_ = ((item_) >> 5) & 7, b_ = (item_) >> 8; const size_t tok0_ = (size_t)b_ * SEQ + 256 * n_; \
        _Pragma("unroll") for (int j = 0; j < 4; ++j) { const int q = tid + NTHR * j, row = q >> 3, pc = q & 7; const size_t src = (tok0_ + row) * DA + h_ * HD + pc * 8; kr[j] = *(const u32x4*)(Kb + src); vr[j] = *(const u32x4*)(Vb + src); } } while (0)
    if (F.vcu < BATCH * NH * NBLK) KVP_LOAD(F.vcu);
    for (int item = F.vcu; item < BATCH * NH * NBLK; item += F.G) {
#pragma unroll
        for (int j = 0; j < 4; ++j) { const int q = tid + NTHR * j, row = q >> 3, pc = q & 7; *(LAS u32x4*)(KS + row * KVP + pc * 8) = kr[j]; *(LAS u32x4*)(VS + row * KVP + pc * 8) = vr[j]; }
        { const int nx = (item + F.G < BATCH * NH * NBLK) ? item + F.G : item; KVP_LOAD(nx); }
        __syncthreads();
#pragma unroll
        for (int j = 0; j < 4; ++j) { const int P = tid + NTHR * j, st = P >> 8, ds = (P >> 6) & 3, l2 = P & 63, row = 32 * st + (l2 & 31), col = 16 * ds + 8 * (l2 >> 5);
            *(u32x4*)(Kf + ((size_t)item * 2048 + P) * 8) = *(const LAS u32x4*)(KS + row * KVP + col); }
#pragma unroll
        for (int j = 0; j < 4; ++j) { const int P = tid + NTHR * j, st = P >> 8, ks = (P >> 7) & 1, d0 = (P >> 6) & 1, l2 = P & 63, hi = l2 >> 5, jj = l2 & 31; unsigned w[4];
#pragma unroll
            for (int e = 0; e < 8; e += 2) { const unsigned lo = VS[(32 * st + 16 * ks + crow(e, hi)) * KVP + 32 * d0 + jj], hi16 = VS[(32 * st + 16 * ks + crow(e + 1, hi)) * KVP + 32 * d0 + jj]; w[e >> 1] = lo | (hi16 << 16); }
            *(u32x4*)(Vf + ((size_t)item * 2048 + P) * 8) = (u32x4){w[0], w[1], w[2], w[3]}; }
        { const int d = tid & 63, part = tid >> 6; float s = 0.f;
#pragma unroll 8
          for (int r = 0; r < 32; ++r) s += bf2f(KS[(part * 32 + r) * KVP + d]);
          PS[part * 64 + d] = s; }
        if (tid < 256) { float ss = 0.f;
#pragma unroll
            for (int c = 0; c < 8; ++c) { const u32x4 w = *(const LAS u32x4*)(KS + tid * KVP + c * 8);
                ss += bflo(w.x) * bflo(w.x) + bfhi(w.x) * bfhi(w.x) + bflo(w.y) * bflo(w.y) + bfhi(w.y) * bfhi(w.y) + bflo(w.z) * bflo(w.z) + bfhi(w.z) * bfhi(w.z) + bflo(w.w) * bflo(w.w) + bfhi(w.w) * bfhi(w.w); }
            ss = wave_max(ss); if (F.lane == 0) WM[F.wave] = ss; }
        __syncthreads();
        if (tid < 64) { float s = 0.f;
#pragma unroll
            for (int p = 0; p < 8; ++p) s += PS[p * 64 + tid];
            KM[(size_t)item * 64 + tid] = (bf16_t)f2bf(s * (1.f / 256.f)); }
        if (tid == 0) KN[item] = fmaxf(fmaxf(WM[0], WM[1]), fmaxf(WM[2], WM[3]));
        __syncthreads();
    }
#undef KVP_LOAD
}

__device__ __forceinline__ void ssm_scan_phase(Frame& F) {
    LAS float* FW = (LAS float*)(F.lds);
    const float* E = (const float*)(F.ws + WS_E); bf16_t* UP = (bf16_t*)(F.ws + WS_UP);
    const int w = F.wave, p = F.lane;
    for (int gb = F.vcu; gb < SG * BATCH; gb += F.G) {
        const int g = gb >> 3, b = gb & 7;
        const float lr = F.in[4][g * SP + p], li = F.in[5][g * SP + p], step = __expf(F.in[6][g]);
        float ar, ai; cpow(lr, li, step, 32.f, ar, ai);
        const size_t row0 = (size_t)g * SROWS + b * 256 + 32 * w;
        f32x2 e[32];
#pragma unroll
        for (int j = 0; j < 32; ++j) e[j] = *(const f32x2*)(E + (row0 + j) * 128 + 2 * p);
        float sr = 0.f, si = 0.f;
#pragma unroll
        for (int j = 0; j < 32; ++j) { const float nr = ar * sr - ai * si + e[j].x, ni = ar * si + ai * sr + e[j].y; sr = nr; si = ni; }
        FW[(w * 64 + p) * 2] = sr; FW[(w * 64 + p) * 2 + 1] = si;
        __syncthreads();
        float Ar = ar, Ai = ai;
#pragma unroll
        for (int q = 0; q < 5; ++q) { const float nr = Ar * Ar - Ai * Ai, ni = 2.f * Ar * Ai; Ar = nr; Ai = ni; }
        sr = 0.f; si = 0.f;
        for (int w2 = 0; w2 < w; ++w2) { const float fr = FW[(w2 * 64 + p) * 2], fi = FW[(w2 * 64 + p) * 2 + 1]; const float nr = Ar * sr - Ai * si + fr, ni = Ar * si + Ai * sr + fi; sr = nr; si = ni; }
#pragma unroll
        for (int j = 0; j < 32; ++j) { *(unsigned*)(UP + (row0 + j) * SKY + SKU + 2 * p) = pk2(sr, si);
            const float nr = ar * sr - ai * si + e[j].x, ni = ar * si + ai * sr + e[j].y; sr = nr; si = ni; }
        __syncthreads();
    }
}

__device__ __forceinline__ int t5_bucket(int d) {
    if (d < 16) return d;
    return 16 + (d >= 19) + (d >= 21) + (d >= 24) + (d >= 27) + (d >= 31) + (d >= 35) + (d >= 40) + (d >= 46) + (d >= 52) + (d >= 59) + (d >= 67) + (d >= 77) + (d >= 87) + (d >= 99) + (d >= 113);
}
struct Top3 { float v0, v1, v2; int i0, i1, i2; };
__device__ __forceinline__ Top3 top3_insert(Top3 t, float x, int n) {
    const bool b0 = (x > t.v0) || (x == t.v0 && n < t.i0), b1 = (x > t.v1) || (x == t.v1 && n < t.i1), b2 = (x > t.v2) || (x == t.v2 && n < t.i2);
    Top3 r;
    r.v2 = b1 ? t.v1 : (b2 ? x : t.v2); r.i2 = b1 ? t.i1 : (b2 ? n : t.i2);
    r.v1 = b0 ? t.v0 : (b1 ? x : t.v1); r.i1 = b0 ? t.i0 : (b1 ? n : t.i1);
    r.v0 = b0 ? x : t.v0; r.i0 = b0 ? n : t.i0;
    return r;
}
constexpr int GQS = 0, GKME = 36864, GCNTL = 41472, GMISC = 41600;
template <bool COUNT> __device__ __forceinline__ void attn_gate_unit(Frame& F, int bh, int qb) {
    LAS unsigned char* L = F.lds;
    LAS bf16_t* QS = (LAS bf16_t*)(L + GQS); LAS bf16_t* KME = (LAS bf16_t*)(L + GKME); LAS int* CNT = (LAS int*)(L + GCNTL); LAS float* KNM = (LAS float*)(L + GMISC);
    int tid = F.tid; asm volatile("" : "+v"(tid));
    const int lane = tid & 63, w = F.wave, j = lane & 31, hi = lane >> 5;
    const int b = bh >> 3, h = bh & 7; const size_t tok0 = (size_t)b * SEQ + 256 * qb;
    const bf16_t* Qb = (const bf16_t*)(F.ws + WS_Q); const bf16_t* KM = (const bf16_t*)(F.ws + WS_KMEAN); const float* KN = (const float*)(F.ws + WS_KMEAN + 512 * 1024);
    float* MQg = (float*)(F.ws + WS_MQ); unsigned short* QL = (unsigned short*)(F.ws + WS_QLIST); unsigned* GC = (unsigned*)(F.ctl + CW_GCNT); unsigned* SEGC = (unsigned*)(F.ws + WS_SEGC);
#pragma unroll
    for (int jj = 0; jj < 4; ++jj) { const int q = tid + NTHR * jj, row = q >> 3, pc = q & 7; *(LAS u32x4*)(QS + row * KVP + pc * 8) = *(const u32x4*)(Qb + (tok0 + row) * DA + h * HD + pc * 8); }
    if (tid < 256) { const int n = tid >> 3, pc = tid & 7; *(LAS u32x4*)(KME + n * KVP + pc * 8) = *(const u32x4*)(KM + ((size_t)bh * 32 + n) * 64 + pc * 8); }
    if (tid < 32) CNT[tid] = 0;
    if (w == 1) { float v = (lane <= qb && lane < 32) ? KN[bh * 32 + lane] : 0.f; v = wave_max(v); if (lane == 0) KNM[0] = v; }
    if (w == 2) { float v = F.in[16][h * 32 + (lane & 31)]; v = wave_max(v); if (lane == 0) KNM[1] = v * LOG2E; }
    __syncthreads();
    {
        bf16x8 qf[4], kmf[4];
#pragma unroll
        for (int ds = 0; ds < 4; ++ds) { qf[ds] = *(const LAS bf16x8*)(QS + (32 * w + j) * KVP + 16 * ds + 8 * hi); kmf[ds] = *(const LAS bf16x8*)(KME + j * KVP + 16 * ds + 8 * hi); }
        f32x16 gt = {};
#pragma unroll
        for (int ds = 0; ds < 4; ++ds) gt = __builtin_amdgcn_mfma_f32_32x32x16_bf16(kmf[ds], qf[ds], gt, 0, 0, 0);
        float qn = 0.f;
#pragma unroll
        for (int ds = 0; ds < 4; ++ds)
#pragma unroll
            for (int e = 0; e < 8; ++e) { const float x = bf2f((unsigned short)qf[ds][e]); qn += x * x; }
        qn += __shfl_xor(qn, 32);
        const float m2 = sqrtf(qn * KNM[0]) + KNM[1];
        const int ql = 256 * qb + 32 * w + j;
        if (hi == 0) MQg[(size_t)bh * SEQ + ql] = m2;
        Top3 t3; t3.v0 = t3.v1 = t3.v2 = -INFINITY; t3.i0 = t3.i1 = t3.i2 = -1;
#pragma unroll
        for (int r = 0; r < 16; ++r) { const int n = crow(r, hi); const float x = (n < qb) ? gt[r] : -INFINITY; t3 = top3_insert(t3, x, x > -INFINITY ? n : 0x7fffffff); }
        { const float p0 = __shfl_xor(t3.v0, 32), p1 = __shfl_xor(t3.v1, 32), p2 = __shfl_xor(t3.v2, 32); const int q0 = __shfl_xor(t3.i0, 32), q1 = __shfl_xor(t3.i1, 32), q2 = __shfl_xor(t3.i2, 32);
          t3 = top3_insert(t3, p0, q0 >= 0 ? q0 : 0x7fffffff); t3 = top3_insert(t3, p1, q1 >= 0 ? q1 : 0x7fffffff); t3 = top3_insert(t3, p2, q2 >= 0 ? q2 : 0x7fffffff); }
        const int i0 = t3.v0 > -INFINITY ? t3.i0 : -1, i1 = t3.v1 > -INFINITY ? t3.i1 : -1, i2 = t3.v2 > -INFINITY ? t3.i2 : -1;
        if (hi == 0) { const unsigned e = (unsigned)ql << 2;
            if (i0 >= 0) { const int pos = __hip_atomic_fetch_add(CNT + i0, 1, __ATOMIC_RELAXED, __HIP_MEMORY_SCOPE_WORKGROUP); QL[((size_t)bh * 32 + i0) * SEQ + (qb - i0 - 1) * 256 + pos] = (unsigned short)(e | 0u); }
            if (i1 >= 0) { const int pos = __hip_atomic_fetch_add(CNT + i1, 1, __ATOMIC_RELAXED, __HIP_MEMORY_SCOPE_WORKGROUP); QL[((size_t)bh * 32 + i1) * SEQ + (qb - i1 - 1) * 256 + pos] = (unsigned short)(e | 1u); }
            if (i2 >= 0) { const int pos = __hip_atomic_fetch_add(CNT + i2, 1, __ATOMIC_RELAXED, __HIP_MEMORY_SCOPE_WORKGROUP); QL[((size_t)bh * 32 + i2) * SEQ + (qb - i2 - 1) * 256 + pos] = (unsigned short)(e | 2u); } }
    }
    __syncthreads();
    if (tid < qb) { const unsigned c = (unsigned)CNT[tid]; SEGC[((size_t)bh * 32 + tid) * 32 + (qb - tid - 1)] = c; if (COUNT && c) (void)__hip_atomic_fetch_add(GC + bh * 32 + tid, c, __ATOMIC_RELAXED, __HIP_MEMORY_SCOPE_AGENT); }
    __syncthreads();
}
template <bool COUNT> __device__ __forceinline__ void attn_gate_phase(Frame& F) {
    for (int u = F.vcu; u < BATCH * NH * NBLK; u += F.G) attn_gate_unit<COUNT>(F, u >> 5, u & 31);
}

#define ATTN_SUBTILE(KP, VP, st_, MODE, CINIT) do { \
        bf16x8 kf_[4], vf_[4]; \
        _Pragma("unroll") for (int ds_ = 0; ds_ < 4; ++ds_) kf_[ds_] = *(const LAS bf16x8*)((KP) + ((st_) * 4 + ds_) * 512 + lane8); \
        _Pragma("unroll") for (int q_ = 0; q_ < 4; ++q_) vf_[q_] = *(const LAS bf16x8*)((VP) + ((st_) * 4 + q_) * 512 + lane8); \
        f32x16 s_ = __builtin_amdgcn_mfma_f32_32x32x16_bf16(kf_[0], qf[0], CINIT, 0, 0, 0); \
        _Pragma("unroll") for (int ds_ = 1; ds_ < 4; ++ds_) s_ = __builtin_amdgcn_mfma_f32_32x32x16_bf16(kf_[ds_], qf[ds_], s_, 0, 0, 0); \
        float p_[16]; \
        if ((MODE) == 0) { _Pragma("unroll") for (int r_ = 0; r_ < 16; ++r_) p_[r_] = __builtin_amdgcn_exp2f(s_[r_]); } \
        else if ((MODE) == 1) { _Pragma("unroll") for (int r_ = 0; r_ < 16; ++r_) { const int dist_ = dq - (32 * (st_) + crow(r_, hi)); const int di_ = dist_ < 0 ? 0 : (dist_ > 127 ? 127 : dist_); \
                p_[r_] = __builtin_amdgcn_exp2f(s_[r_] + TABh[di_]); } } \
        else { _Pragma("unroll") for (int rq_ = 0; rq_ < 4; ++rq_) { const f32x4 bb_ = *(const LAS f32x4*)(BTD + rq_ * 256 + lane * 4); \
                _Pragma("unroll") for (int i_ = 0; i_ < 4; ++i_) p_[4 * rq_ + i_] = __builtin_amdgcn_exp2f(s_[4 * rq_ + i_] + bb_[i_]); } } \
        _Pragma("unroll") for (int r_ = 0; r_ < 16; ++r_) lsum += p_[r_]; \
        u32x4 pa_, pb_; pa_.x = cvt_pk_bf16(p_[0], p_[1]); pa_.y = cvt_pk_bf16(p_[2], p_[3]); pa_.z = cvt_pk_bf16(p_[4], p_[5]); pa_.w = cvt_pk_bf16(p_[6], p_[7]); \
        pb_.x = cvt_pk_bf16(p_[8], p_[9]); pb_.y = cvt_pk_bf16(p_[10], p_[11]); pb_.z = cvt_pk_bf16(p_[12], p_[13]); pb_.w = cvt_pk_bf16(p_[14], p_[15]); \
        const bf16x8 A0_ = __builtin_bit_cast(bf16x8, pa_), A1_ = __builtin_bit_cast(bf16x8, pb_); \
        o0 = __builtin_amdgcn_mfma_f32_32x32x16_bf16(vf_[0], A0_, o0, 0, 0, 0); o1 = __builtin_amdgcn_mfma_f32_32x32x16_bf16(vf_[1], A0_, o1, 0, 0, 0); \
        o0 = __builtin_amdgcn_mfma_f32_32x32x16_bf16(vf_[2], A1_, o0, 0, 0, 0); o1 = __builtin_amdgcn_mfma_f32_32x32x16_bf16(vf_[3], A1_, o1, 0, 0, 0); } while (0)

__device__ __forceinline__ u32x4 ot_pack16(const f32x16& o, int pr) {
    const unsigned p0 = cvt_pk_bf16(o[8 * pr], o[8 * pr + 1]), p1 = cvt_pk_bf16(o[8 * pr + 2], o[8 * pr + 3]), q0 = cvt_pk_bf16(o[8 * pr + 4], o[8 * pr + 5]), q1 = cvt_pk_bf16(o[8 * pr + 6], o[8 * pr + 7]);
    const auto r0 = __builtin_amdgcn_permlane32_swap(p0, q0, false, false); const auto r1 = __builtin_amdgcn_permlane32_swap(p1, q1, false, false);
    return (u32x4){r0[0], r1[0], r0[1], r1[1]};
}
__device__ __forceinline__ void ot_add16(f32x16& o, int pr, u32x4 v, bool use) {
    const auto r0 = __builtin_amdgcn_permlane32_swap(v.x, v.z, false, false); const auto r1 = __builtin_amdgcn_permlane32_swap(v.y, v.w, false, false);
    const unsigned p0 = r0[0], p1 = r1[0], q0 = r0[1], q1 = r1[1];
    o[8 * pr] += use ? bflo(p0) : 0.f; o[8 * pr + 1] += use ? bfhi(p0) : 0.f; o[8 * pr + 2] += use ? bflo(p1) : 0.f; o[8 * pr + 3] += use ? bfhi(p1) : 0.f;
    o[8 * pr + 4] += use ? bflo(q0) : 0.f; o[8 * pr + 5] += use ? bfhi(q0) : 0.f; o[8 * pr + 6] += use ? bflo(q1) : 0.f; o[8 * pr + 7] += use ? bfhi(q1) : 0.f;
}
__device__ __forceinline__ void attn_fill_tab(Frame& F, LAS float* TAB) {
    const float* rb = F.in[16];
    for (int idx = F.tid; idx < 8 * 132; idx += NTHR) { const int h = idx / 132, d = idx % 132; float v = 0.f;
        if (d < 128) v = rb[h * 32 + t5_bucket(d)] * LOG2E; else if (d == 129) v = rb[h * 32 + 31] * LOG2E;
        TAB[idx] = v; }
}
constexpr int BGPRE_OFF = ROWTAB_OFF, BGCL_OFF = ROWTAB_OFF + 8448, BTAB_OFF = ROWTAB_OFF + 16640, BIT_OFF = ROWTAB_OFF + 20992, BIT_MAX = 512, OTAB_OFF = ROWTAB_OFF + 20480  ;
static_assert(BTAB_OFF + 8 * 132 * 4 <= MOE_TST_OFF, "attention LDS tables");
__device__ __forceinline__ size_t part_off(int slot) { return slot == 0 ? WS_PART0 : (slot == 1 ? WS_PART1 : WS_PART2); }

__device__ __forceinline__ void attn_block_phase(Frame& F) {
    LAS unsigned char* L = F.lds; LAS int* GPRE = (LAS int*)(L + BGPRE_OFF); LAS int* GCL = (LAS int*)(L + BGCL_OFF); LAS float* TAB = (LAS float*)(L + BTAB_OFF); LAS int* ITT = (LAS int*)(L + BIT_OFF); LAS int* WSUM = (LAS int*)(L + MOE_TST_OFF);
    const unsigned* GC = (const unsigned*)(F.ctl + CW_GCNT); const unsigned* SEGC = (const unsigned*)(F.ws + WS_SEGC);
    const int tid = F.tid, lane = F.lane, w = F.wave, j = lane & 31, hi = lane >> 5, lane8 = lane * 8;
    { int ng[4], tot = 0;
#pragma unroll
      for (int e = 0; e < 4; ++e) { const int c = (int)GC[4 * tid + e]; GCL[4 * tid + e] = c; ng[e] = (((c + 31) >> 5) + 7) >> 3; tot += ng[e]; }
      int inc = tot;
#pragma unroll
      for (int o = 1; o < 64; o <<= 1) { const int t = __shfl_up(inc, o); if (lane >= o) inc += t; }
      if (lane == 63) WSUM[w] = inc;
      __syncthreads();
      int woff = 0;
      for (int q = 0; q < w; ++q) woff += WSUM[q];
      int ex = woff + inc - tot;
#pragma unroll
      for (int e = 0; e < 4; ++e) { GPRE[4 * tid + e] = ex; ex += ng[e]; }
      if (tid == NTHR - 1) GPRE[2048] = ex; }
    attn_fill_tab(F, TAB);
    __syncthreads();
    const int NIT = GPRE[2048];
    const int nk = (NIT > F.vcu) ? (NIT - F.vcu + F.G - 1) / F.G : 0;
    if (tid < nk && tid < BIT_MAX) { const int it_ = F.vcu + tid * F.G; int lo_ = 0, hi_ = 2048; while (hi_ - lo_ > 1) { const int mid_ = (lo_ + hi_) >> 1; if (GPRE[mid_] <= it_) lo_ = mid_; else hi_ = mid_; } ITT[tid] = lo_ * 64 + (it_ - GPRE[lo_]); }
    __syncthreads();
    if (nk == 0) return;
    const int nkc = nk < BIT_MAX ? nk : BIT_MAX;
    const bf16_t* Qb = (const bf16_t*)(F.ws + WS_Q); const float* MQg = (const float*)(F.ws + WS_MQ); const unsigned short* QL = (const unsigned short*)(F.ws + WS_QLIST);
    const bf16_t* KF = (const bf16_t*)(F.ws + WS_KFRAG); const bf16_t* VF = (const bf16_t*)(F.ws + WS_VFRAG);
    float* PL = (float*)(F.ws + WS_PL);
#define BLK_ITEM(k_, pi_, g_) do { const int kk_ = (k_) < nkc ? (k_) : nkc - 1; const int v_ = __builtin_amdgcn_readfirstlane(ITT[kk_]); pi_ = v_ >> 6; g_ = v_ & 63; } while (0)
#define BLK_DMA(buf_, pi_) do { const char* ks_ = (const char*)KF + ((size_t)(pi_) * 2048 + tid) * 16; const char* vs_ = (const char*)VF + ((size_t)(pi_) * 2048 + tid) * 16; \
        _Pragma("unroll") for (int i_ = 0; i_ < 4; ++i_) { \
            __builtin_amdgcn_global_load_lds((const unsigned*)(ks_ + i_ * 8192), (LAS unsigned*)(L + (buf_) + (i_ * 512 + w * 64) * 16), 16, 0, 0); \
            __builtin_amdgcn_global_load_lds((const unsigned*)(vs_ + i_ * 8192), (LAS unsigned*)(L + (buf_) + 32768 + (i_ * 512 + w * 64) * 16), 16, 0, 0); } } while (0)
#define BLK_SEGC(dst_, pi_) do { dst_ = SEGC[(size_t)(pi_) * 32 + j]; } while (0)
#define BLK_ENTRY(dst_, segc_, pi_, g_) do { const int n_ = (pi_) & 31; int inc_ = (j < 31 - n_) ? (int)(segc_) : 0; \
        _Pragma("unroll") for (int o_ = 1; o_ < 32; o_ <<= 1) { const int t_ = __shfl_up(inc_, o_); if (j >= o_) inc_ += t_; } \
        const int cnt_ = GCL[pi_]; const int idx_ = 32 * (8 * (g_) + w) + j; int seg_ = 0, prev_ = 0; \
        for (int s_ = 0; s_ < 31 - n_; ++s_) { const int p_ = __builtin_amdgcn_readlane(inc_, s_); const bool le_ = p_ <= idx_; seg_ += le_ ? 1 : 0; prev_ = le_ ? p_ : prev_; } \
        const bool ok_ = idx_ < cnt_; const unsigned v_ = QL[(size_t)(pi_) * SEQ + (ok_ ? seg_ * 256 + (idx_ - prev_) : 0)]; dst_ = ok_ ? v_ : 0xFFFFu; } while (0)
#define BLK_QLOAD(qf_, m2_, ent_, pi_) do { const unsigned qq_ = ((ent_) == 0xFFFFu) ? 0u : ((ent_) >> 2); const int bh_ = (pi_) >> 5; \
        const bf16_t* qrow_ = Qb + ((size_t)(bh_ >> 3) * SEQ + qq_) * DA + (bh_ & 7) * HD + 8 * hi; \
        _Pragma("unroll") for (int ds_ = 0; ds_ < 4; ++ds_) qf_[ds_] = *(const bf16x8*)(qrow_ + 16 * ds_); \
        m2_ = MQg[(size_t)bh_ * SEQ + qq_]; } while (0)
    int pi, g, pi1, g1, pi2, g2; unsigned ent, ent1, sc2; bf16x8 qf[4]; float m2r;
    BLK_ITEM(0, pi, g); BLK_ITEM(1, pi1, g1); BLK_ITEM(2, pi2, g2);
    BLK_DMA(0, pi);
    { unsigned sc0, sc1; BLK_SEGC(sc0, pi); BLK_SEGC(sc1, pi1); BLK_SEGC(sc2, pi2); BLK_ENTRY(ent, sc0, pi, g); BLK_ENTRY(ent1, sc1, pi1, g1); }
    BLK_QLOAD(qf, m2r, ent, pi);
    int cur = 0;
    __builtin_amdgcn_s_waitcnt(0x0F70);
    unsigned char* dump = F.ws + WS_E + ((size_t)F.vcu * NTHR + tid) * 128;
    for (int k = 0; k < nkc; ++k) {
        __builtin_amdgcn_s_waitcnt(0x0F75);
        __syncthreads();
        int pi3, g3; unsigned sc3, ent2; bf16x8 qfn[4]; float m2n;
        BLK_ITEM(k + 3, pi3, g3); BLK_SEGC(sc3, pi3);
        BLK_ENTRY(ent2, sc2, pi2, g2);
        BLK_QLOAD(qfn, m2n, ent1, pi1);
        BLK_DMA((cur ^ 1) * 65536, pi1);
        const int bh = pi >> 5, n = pi & 31, h = bh & 7;
        const bool valid = ent != 0xFFFFu; const int q = valid ? (int)(ent >> 2) : 0; const int slot = (int)(ent & 3u);
        const bool active = __builtin_amdgcn_readfirstlane((int)(__ballot(valid) != 0ull)) != 0;
        f32x16 o0 = {}, o1 = {}; float lsum = 0.f;
        if (active) {
            const float m2 = valid ? m2r : INFINITY;
            const LAS bf16_t* KP = (const LAS bf16_t*)(L + cur * 65536); const LAS bf16_t* VP = (const LAS bf16_t*)(L + cur * 65536 + 32768);
            const LAS float* TABh = TAB + h * 132; const LAS float* BTD = nullptr; (void)BTD;
            const int dq = q - 256 * n;
            const bool nearw = __builtin_amdgcn_readfirstlane((int)(__ballot(valid && dq < 383) != 0ull)) != 0;
            const float ci = nearw ? -m2 : TABh[129] - m2;
            f32x16 cinit;
#pragma unroll
            for (int r = 0; r < 16; ++r) cinit[r] = ci;
            if (nearw) { for (int st = 0; st < 8; ++st) ATTN_SUBTILE(KP, VP, st, 1, cinit); }
            else { for (int st = 0; st < 8; ++st) ATTN_SUBTILE(KP, VP, st, 0, cinit); }
        }
        { const float lt = lsum + __shfl_xor(lsum, 32);
          const size_t qi = (size_t)bh * SEQ + q;
          float* pld = valid ? PL + (size_t)slot * (NH * BATCH * SEQ) + qi : (float*)(dump + 120);
          bf16_t* dst = valid ? (bf16_t*)(F.ws + part_off(slot)) + qi * HD + 8 * hi : (bf16_t*)dump;
          *pld = lt;
          *(u32x4*)(dst) = ot_pack16(o0, 0); *(u32x4*)(dst + 16) = ot_pack16(o0, 1); *(u32x4*)(dst + 32) = ot_pack16(o1, 0); *(u32x4*)(dst + 48) = ot_pack16(o1, 1); }
        pi = pi1; g = g1; ent = ent1; m2r = m2n; pi1 = pi2; g1 = g2; ent1 = ent2; pi2 = pi3; g2 = g3; sc2 = sc3; cur ^= 1;
#pragma unroll
        for (int ds = 0; ds < 4; ++ds) qf[ds] = qfn[ds];
    }
    VM_WAIT(); __syncthreads();
#undef BLK_ITEM
#undef BLK_DMA
#undef BLK_SEGC
#undef BLK_ENTRY
#undef BLK_QLOAD
}

__device__ __forceinline__ void attn_own_phase(Frame& F) {
    LAS unsigned char* L = F.lds; LAS float* TAB = (LAS float*)(L + OTAB_OFF); LAS float* BT = (LAS float*)(L + ROWTAB_OFF); int bth = -1;
    attn_fill_tab(F, TAB);
    const int tid = F.tid, lane = F.lane, w = F.wave, j = lane & 31, hi = lane >> 5, lane8 = lane * 8;
    const bf16_t* Qb = (const bf16_t*)(F.ws + WS_Q); const float* MQg = (const float*)(F.ws + WS_MQ);
    const bf16_t* KF = (const bf16_t*)(F.ws + WS_KFRAG); const bf16_t* VF = (const bf16_t*)(F.ws + WS_VFRAG);
    const float* PL = (const float*)(F.ws + WS_PL); bf16_t* YA = (bf16_t*)(F.ws + WS_YATT);
    const int NU = BATCH * NH * NBLK;
#define OWN_DMA(buf_, pi_) do { const char* ks_ = (const char*)KF + ((size_t)(pi_) * 2048 + tid) * 16; const char* vs_ = (const char*)VF + ((size_t)(pi_) * 2048 + tid) * 16; \
        _Pragma("unroll") for (int i_ = 0; i_ < 4; ++i_) { \
            __builtin_amdgcn_global_load_lds((const unsigned*)(ks_ + i_ * 8192), (LAS unsigned*)(L + (buf_) + (i_ * 512 + w * 64) * 16), 16, 0, 0); \
            __builtin_amdgcn_global_load_lds((const unsigned*)(vs_ + i_ * 8192), (LAS unsigned*)(L + (buf_) + 32768 + (i_ * 512 + w * 64) * 16), 16, 0, 0); } } while (0)
#define OWN_QLOAD(qf_, m2_, u_) do { const int bh_ = (u_) >> 5, qb_ = (u_) & 31; const size_t tk_ = (size_t)256 * qb_ + 32 * w + j; \
        const bf16_t* qrow_ = Qb + ((size_t)(bh_ >> 3) * SEQ + tk_) * DA + (bh_ & 7) * HD + 8 * hi; \
        _Pragma("unroll") for (int ds_ = 0; ds_ < 4; ++ds_) qf_[ds_] = *(const bf16x8*)(qrow_ + 16 * ds_); \
        m2_ = MQg[(size_t)bh_ * SEQ + tk_]; } while (0)
    int u = F.vcu; if (u >= NU) return;
    bf16x8 qf[4]; float m2;
    OWN_DMA(0, u); OWN_QLOAD(qf, m2, u);
    int cur = 0;
    __builtin_amdgcn_s_waitcnt(0x0F70);
    for (;;) {
        __builtin_amdgcn_s_waitcnt(0x0F74); __syncthreads();
        const int un = (u + F.G < NU) ? u + F.G : u; const bool last = (un == u);
        const int bh = u >> 5, qb = u & 31, b = bh >> 3, h = bh & 7; const int ql = 32 * w + j; const size_t qi = (size_t)bh * SEQ + 256 * qb + ql;
        u32x4 pa[3][4]; float pl[3];
#pragma unroll
        for (int s = 0; s < 3; ++s) { pl[s] = PL[(size_t)s * (NH * BATCH * SEQ) + qi]; const bf16_t* src = (const bf16_t*)(F.ws + part_off(s)) + qi * HD + 8 * hi;
#pragma unroll
            for (int c = 0; c < 4; ++c) pa[s][c] = *(const u32x4*)(src + 16 * c); }
        bf16x8 qfn[4]; float m2n;
        OWN_QLOAD(qfn, m2n, un);
        OWN_DMA((cur ^ 1) * 65536, un);
        const LAS bf16_t* KP = (const LAS bf16_t*)(L + cur * 65536); const LAS bf16_t* VP = (const LAS bf16_t*)(L + cur * 65536 + 32768); const LAS float* TABh = TAB + h * 132;
        if (h != bth) { __syncthreads();
            for (int e = tid; e < 5 * 1024; e += NTHR) { const int i = e & 3, ln = (e >> 2) & 63, rq = (e >> 8) & 3, dl = e >> 10; const int dist = 32 * dl + (ln & 31) - crow(4 * rq + i, ln >> 5);
                BT[e] = dist < 0 ? -1e30f : TABh[dist > 127 ? 127 : dist]; }
            bth = h; __syncthreads(); }
        const int dq = ql; (void)dq;
        f32x16 cnear, cfar;
#pragma unroll
        for (int r = 0; r < 16; ++r) { cnear[r] = -m2; cfar[r] = TABh[129] - m2; }
        f32x16 o0 = {}, o1 = {}; float lsum = 0.f;
        for (int st = 0; st <= w; ++st) { const int dl = w - st;
            if (dl >= 5) { const LAS float* BTD = nullptr; (void)BTD; ATTN_SUBTILE(KP, VP, st, 0, cfar); }
            else { const LAS float* BTD = BT + dl * 1024; ATTN_SUBTILE(KP, VP, st, 2, cnear); } }
        float lt = lsum + __shfl_xor(lsum, 32);
        const int nsel = qb < 3 ? qb : 3;
#pragma unroll
        for (int s = 0; s < 3; ++s) { const bool use = s < nsel; lt += use ? pl[s] : 0.f;
            ot_add16(o0, 0, pa[s][0], use); ot_add16(o0, 1, pa[s][1], use); ot_add16(o1, 0, pa[s][2], use); ot_add16(o1, 1, pa[s][3], use); }
        const float inv = 1.f / lt;
#pragma unroll
        for (int r = 0; r < 16; ++r) { o0[r] *= inv; o1[r] *= inv; }
        bf16_t* dst = YA + ((size_t)b * SEQ + 256 * qb + ql) * DA + h * HD + 8 * hi;
        *(u32x4*)(dst) = ot_pack16(o0, 0); *(u32x4*)(dst + 16) = ot_pack16(o0, 1); *(u32x4*)(dst + 32) = ot_pack16(o1, 0); *(u32x4*)(dst + 48) = ot_pack16(o1, 1);
        if (last) break;
        u = un; m2 = m2n; cur ^= 1;
#pragma unroll
        for (int ds = 0; ds < 4; ++ds) qf[ds] = qfn[ds];
    }
    VM_WAIT(); __syncthreads();
#undef OWN_DMA
#undef OWN_QLOAD
}
#undef ATTN_SUBTILE

__device__ __forceinline__ void routing_phase(Frame& F) {
    LAS int* lcnt = (LAS int*)(F.lds); LAS int* lbase = lcnt + 32;
    const float* SSQ = (const float*)(F.ws + WS_SSQ); const float* RL = (const float*)(F.ws + WS_RLOG);
    unsigned* rowtok = (unsigned*)(F.ws + WS_ROWTOK); float* rowcoef = (float*)(F.ws + WS_ROWCOEF); float* rowrstd = (float*)(F.ws + WS_ROWRSTD);
    unsigned* ecnt = (unsigned*)(F.ctl + CW_ECNT);
    const float* brg = F.in[20]; const float* bre = F.in[22];
    const int tid = F.tid;
    for (int base = F.vcu * 256; base < T; base += F.G * 256) {
        if (tid < 32) lcnt[tid] = 0;
        __syncthreads();
        int e0 = 0, e1 = 0, lp0 = 0, lp1 = 0; float c0 = 0.f, c1 = 0.f, rstd = 0.f; const int tok = base + tid;
        if (tid < 256) {
            float ss = 0.f;
#pragma unroll
            for (int q = 0; q < 4; ++q) { const f32x4 v = *(const f32x4*)(SSQ + (size_t)tok * 16 + 4 * q); ss += (v.x + v.y) + (v.z + v.w); }
            rstd = 1.f / sqrtf(ss * (1.f / D) + RMS_EPS);
            float r[72];
#pragma unroll
            for (int q = 0; q < 18; ++q) { const f32x4 v = *(const f32x4*)(RL + (size_t)tok * 72 + 4 * q); r[4 * q] = v.x; r[4 * q + 1] = v.y; r[4 * q + 2] = v.z; r[4 * q + 3] = v.w; }
            float gl[4], el[32];
#pragma unroll
            for (int c = 0; c < 4; ++c) gl[c] = rstd * (r[c] + r[36 + c]) + brg[c];
#pragma unroll
            for (int c = 0; c < 32; ++c) el[c] = rstd * (r[4 + c] + r[40 + c]) + bre[c];
            int gi = 0; float gm = gl[0];
#pragma unroll
            for (int c = 1; c < 4; ++c) if (gl[c] > gm) { gm = gl[c]; gi = c; }
            float Z = 0.f;
#pragma unroll
            for (int c = 0; c < 4; ++c) Z += __expf(gl[c] - gm);
            const float gval = 1.f / Z;
            float es[8];
#pragma unroll
            for (int q = 0; q < 8; ++q) es[q] = gi == 0 ? el[q] : (gi == 1 ? el[8 + q] : (gi == 2 ? el[16 + q] : el[24 + q]));
            int a0 = 0; float m0 = es[0];
#pragma unroll
            for (int q = 1; q < 8; ++q) if (es[q] > m0) { m0 = es[q]; a0 = q; }
            int a1 = -1; float m1 = -INFINITY;
#pragma unroll
            for (int q = 0; q < 8; ++q) if (q != a0 && es[q] > m1) { m1 = es[q]; a1 = q; }
            const float w0 = 1.f / (1.f + __expf(m1 - m0)), w1 = 1.f - w0;
            e0 = gi * 8 + a0; e1 = gi * 8 + a1; c0 = gval * w0; c1 = gval * w1;
            lp0 = __hip_atomic_fetch_add(lcnt + e0, 1, __ATOMIC_RELAXED, __HIP_MEMORY_SCOPE_WORKGROUP);
            lp1 = __hip_atomic_fetch_add(lcnt + e1, 1, __ATOMIC_RELAXED, __HIP_MEMORY_SCOPE_WORKGROUP);
        }
        __syncthreads();
        if (tid < 32) lbase[tid] = (int)__hip_atomic_fetch_add(ecnt + tid, (unsigned)lcnt[tid], __ATOMIC_RELAXED, __HIP_MEMORY_SCOPE_AGENT);
        __syncthreads();
        if (tid < 256) {
            const size_t i0 = (size_t)e0 * ROWCAP + lbase[e0] + lp0, i1 = (size_t)e1 * ROWCAP + lbase[e1] + lp1;
            rowtok[i0] = (unsigned)tok * 2u; rowcoef[i0] = c0; rowrstd[i0] = rstd;
            rowtok[i1] = (unsigned)tok * 2u + 1u; rowcoef[i1] = c1; rowrstd[i1] = rstd;
        }
        __syncthreads();
    }
}
struct MoeOrder {
    const LAS int* tst; int total, G, v;
    __device__ bool next(int i, pg8::Unit& u) const {
        const int L = i * G + v; if (L >= total) return false;
        const int rt = L >> 2; int e = 0;
#pragma unroll 8
        for (int q = 1; q <= 32; ++q) e += (tst[q] <= rt) ? 1 : 0;
        u.pm = rt; u.pn = L & 3; u.pb = e * 4 + u.pn; u.aux = e; u.aux2 = (rt - tst[e]) * 256; return true;
    }
};
__device__ __forceinline__ void moe_tables(Frame& F) {
    LAS int* tst = (LAS int*)(F.lds + MOE_TST_OFF); const unsigned* ecnt = (const unsigned*)(F.ctl + CW_ECNT);
    if (F.wave == 0) { const int lane = F.lane; int nt = lane < 32 ? (int)((ecnt[lane & 31] + 255u) >> 8) : 0; int inc = nt;
#pragma unroll
        for (int o = 1; o < 32; o <<= 1) { const int t = __shfl_up(inc, o); if (lane >= o) inc += t; }
        if (lane < 32) tst[lane + 1] = inc; if (lane == 0) tst[0] = 0; }
    __syncthreads();
}
__device__ __forceinline__ void final_phase(Frame& F) {
#ifdef SELFCHECK
    const bool chk_bad = __hip_atomic_load((unsigned*)(F.ctl + 2), __ATOMIC_RELAXED, __HIP_MEMORY_SCOPE_AGENT) != 0u;
#endif
    const bf16_t* X1 = (const bf16_t*)(F.ws + WS_X1); const bf16_t* Y0 = (const bf16_t*)(F.ws + WS_Y0); const bf16_t* Y1 = (const bf16_t*)(F.ws + WS_Y1); const float* gf = F.in[26];
    const int gw = F.vcu * NWAVES + F.wave, NGW = F.G * NWAVES, lane = F.lane;
    for (int m = gw; m < T; m += NGW) {
        const u32x2* xr = (const u32x2*)(X1 + (size_t)m * D) + lane; const u32x2* y0 = (const u32x2*)(Y0 + (size_t)m * D) + lane; const u32x2* y1 = (const u32x2*)(Y1 + (size_t)m * D) + lane;
        f32x4 v[4]; float s = 0.f;
#pragma unroll
        for (int j = 0; j < 4; ++j) { const u32x2 xx = xr[64 * j]; v[j] = (f32x4){bflo(xx.x), bfhi(xx.x), bflo(xx.y), bfhi(xx.y)}; const u32x2 a = y0[64 * j], c = y1[64 * j];
            v[j].x += bflo(a.x) + bflo(c.x); v[j].y += bfhi(a.x) + bfhi(c.x); v[j].z += bflo(a.y) + bflo(c.y); v[j].w += bfhi(a.y) + bfhi(c.y);
            s += (v[j].x * v[j].x + v[j].y * v[j].y) + (v[j].z * v[j].z + v[j].w * v[j].w); }
        const float rstd = 1.f / sqrtf(wave_sum(s) * (1.f / D) + RMS_EPS);
        f32x4* o = (f32x4*)(F.out + (size_t)m * D) + lane; const f32x4* gr = (const f32x4*)gf + lane;
#ifdef SELFCHECK
        if (chk_bad) { for (int j = 0; j < 4; ++j) o[64 * j] = (f32x4){0.f, 0.f, 0.f, 0.f}; continue; }
#endif
#pragma unroll
        for (int j = 0; j < 4; ++j) o[64 * j] = v[j] * rstd * gr[64 * j];
    }
}
#ifdef SELFCHECK
constexpr int CW_CHK = 2;
__device__ __forceinline__ int t5_bucket_ref(int n) { if (n < 16) return n; const int l = 16 + (int)(logf((float)n / 16.f) / logf(8.f) * 16.f); return l < 31 ? l : 31; }
__device__ __forceinline__ float kfrag_at(const bf16_t* KF, int bh, int key, int d) { const int n = key >> 8, kl = key & 255, st = kl >> 5, i = kl & 31, ds = d >> 4, hi = (d >> 3) & 1, e = d & 7;
    return bf2f(KF[(((size_t)bh * 32 + n) * 2048 + (st * 4 + ds) * 64 + (i + 32 * hi)) * 8 + e]); }
__device__ __forceinline__ float vfrag_at(const bf16_t* VF, int bh, int key, int d) { const int n = key >> 8, kl = key & 255, st = kl >> 5, kk = kl & 31, ks = kk >> 4, k16 = kk & 15, hi = (k16 >> 2) & 1, e = (k16 & 3) + 4 * (k16 >> 3), d0 = d >> 5, jj = d & 31;
    return bf2f(VF[(((size_t)bh * 32 + n) * 2048 + ((st * 2 + ks) * 2 + d0) * 64 + (jj + 32 * hi)) * 8 + e]); }
__device__ __forceinline__ void selfcheck_phase(Frame& F, float tol_attn, float tol_ssm) {
    const int lane = lane_id(); const int gw = F.vcu * NWAVES + F.wave;
    const bf16_t* Qb = (const bf16_t*)(F.ws + WS_Q); const bf16_t* KM = (const bf16_t*)(F.ws + WS_KMEAN); const bf16_t* KF = (const bf16_t*)(F.ws + WS_KFRAG); const bf16_t* VF = (const bf16_t*)(F.ws + WS_VFRAG);
    const bf16_t* YA = (const bf16_t*)(F.ws + WS_YATT); const float* rb = F.in[16];
    bool bad = false;
    for (int sidx = 0; sidx < 12; ++sidx) {
        unsigned hsh = (unsigned)(gw * 12 + sidx) * 2654435761u; hsh ^= hsh >> 15; hsh *= 2246822519u; hsh ^= hsh >> 13;
        const int bh = (int)(hsh & 63u); int q = (int)((hsh >> 6) & 8191u);
        if (sidx == 0) q = q & 767; if (sidx == 1) q = (q & ~255) | (sidx & 1 ? 0 : 255); if (sidx == 2) q = (q & ~255) | 255; if (sidx == 3) q = (q & ~255) | 128;
        const int b = bh >> 3, h = bh & 7, qb = q >> 8, d = lane;
        const float qd = bf2f(Qb[((size_t)b * SEQ + q) * DA + h * HD + d]);
        int s0 = -1, s1 = -1, s2 = -1; float g0 = -INFINITY, g1 = -INFINITY, g2 = -INFINITY;
        for (int n = 0; n < qb; ++n) { const float gt = wave_sum(qd * bf2f(KM[((size_t)bh * 32 + n) * 64 + d]));
            if (gt > g0) { g2 = g1; s2 = s1; g1 = g0; s1 = s0; g0 = gt; s0 = n; } else if (gt > g1) { g2 = g1; s2 = s1; g1 = gt; s1 = n; } else if (gt > g2) { g2 = gt; s2 = n; } }
        float m = -INFINITY, l = 0.f, od = 0.f;
        for (int blk = 0; blk < 4; ++blk) { const int n = blk == 0 ? s0 : (blk == 1 ? s1 : (blk == 2 ? s2 : qb)); if (n < 0) continue;
            const int kend = (blk == 3) ? (q & 255) + 1 : 256;
            for (int kl = 0; kl < kend; ++kl) { const int key = 256 * n + kl; const float kd = kfrag_at(KF, bh, key, d);
                const float s = wave_sum(qd * kd) + rb[h * 32 + t5_bucket_ref(q - key)] * LOG2E;
                const float mn = fmaxf(m, s), sc = exp2f(m - mn), p = exp2f(s - mn); l = l * sc + p; od = od * sc + p * vfrag_at(VF, bh, key, d); m = mn; } }
        od /= l;
        const float yd = bf2f(YA[((size_t)b * SEQ + q) * DA + h * HD + d]);
        const float e2 = wave_sum((od - yd) * (od - yd)), o2 = wave_sum(od * od);
        if (!(e2 <= tol_attn * tol_attn * o2)) bad = true;
    }
    { const bf16_t* UP = (const bf16_t*)(F.ws + WS_UP); const bf16_t* GA = (const bf16_t*)(F.ws + WS_GACT);
      for (int sidx = 0; sidx < 6; ++sidx) {
        unsigned hsh = (unsigned)(gw * 6 + sidx + 7777) * 2654435761u; hsh ^= hsh >> 15; hsh *= 2246822519u; hsh ^= hsh >> 13;
        const int g = (int)(hsh & 31u), b = (int)((hsh >> 5) & 7u); int t = (int)((hsh >> 8) % 330u); if (sidx == 0) t = 31 + (int)((hsh >> 20) & 3u) * 32; if (sidx == 1) t = 32 + (int)((hsh >> 20) & 7u) * 32;
        const int p = lane;
        const float lr = F.in[4][g * SP + p], li = F.in[5][g * SP + p], step = expf(F.in[6][g]);
        const float mag = expf(lr * step), ar = mag * cosf(li * step), ai = mag * sinf(li * step);
        const float nr = ar - 1.f, ni = ai, den = lr * lr + li * li, cr = (nr * lr + ni * li) / den, ci = (ni * lr - nr * li) / den;
        float hr = 0.f, hi_ = 0.f;
        for (int tt = 0; tt <= t; ++tt) { float br = 0.f, bi = 0.f;
            for (int c = 0; c < 16; ++c) { const float u = bf2f(UP[(size_t)g * SROWS * SKY + ((size_t)b * 256 + (tt >> 5)) * SKY + (tt & 31) * 16 + c]);
                const float b_r = F.in[7][(g * SP + p) * 16 + c], b_i = F.in[8][(g * SP + p) * 16 + c]; br += (cr * b_r - ci * b_i) * u; bi += (cr * b_i + ci * b_r) * u; }
            const float n_r = ar * hr - ai * hi_ + br, n_i = ar * hi_ + ai * hr + bi; hr = n_r; hi_ = n_i; }
        float e2 = 0.f, o2 = 0.f;
        for (int ho = 0; ho < 16; ++ho) { float y = wave_sum(hr * F.in[9][(g * 16 + ho) * SP + p] - hi_ * F.in[10][(g * 16 + ho) * SP + p]);
            const float u = bf2f(UP[(size_t)g * SROWS * SKY + ((size_t)b * 256 + (t >> 5)) * SKY + (t & 31) * 16 + ho]); y += F.in[11][g * 16 + ho] * u;
            const float ge = 0.5f * y * (1.f + tanhf(0.7978845608028654f * (y + 0.044715f * y * y * y)));
            const float gv = bf2f(GA[((size_t)b * SEQ + t) * DS + g * 16 + ho]); e2 += (ge - gv) * (ge - gv); o2 += ge * ge; }
        if (!(e2 <= tol_ssm * tol_ssm * o2 + 1e-6f)) bad = true;
      } }
    if (__ballot(bad) != 0ull && lane == 0) __hip_atomic_store((unsigned*)(F.ctl + CW_CHK), 1u, __ATOMIC_RELAXED, __HIP_MEMORY_SCOPE_AGENT);
}
#endif

#ifdef SELFCHECK
__device__ __forceinline__ void selfcheck_prep(Frame& F) {
    const int lane = lane_id(); const int gw = F.vcu * NWAVES + F.wave;
    const bf16_t* Kb = (const bf16_t*)(F.ws + WS_K); const bf16_t* Vb = (const bf16_t*)(F.ws + WS_V); const bf16_t* KF = (const bf16_t*)(F.ws + WS_KFRAG); const bf16_t* VF = (const bf16_t*)(F.ws + WS_VFRAG);
    const bf16_t* KM = (const bf16_t*)(F.ws + WS_KMEAN); const float* KN = (const float*)(F.ws + WS_KMEAN + 512 * 1024);
    bool bad = false;
    for (int sidx = 0; sidx < 64; ++sidx) {
        unsigned hsh = (unsigned)(gw * 64 + sidx + 12345) * 2654435761u; hsh ^= hsh >> 15; hsh *= 2246822519u; hsh ^= hsh >> 13;
        const int bh = (int)(hsh & 63u), key = (int)((hsh >> 6) & 8191u), b = bh >> 3, h = bh & 7, d = lane;
        const float k0 = bf2f(Kb[((size_t)b * SEQ + key) * DA + h * HD + d]), v0 = bf2f(Vb[((size_t)b * SEQ + key) * DA + h * HD + d]);
        if (kfrag_at(KF, bh, key, d) != k0 || vfrag_at(VF, bh, key, d) != v0) bad = true;
    }
    for (int sidx = 0; sidx < 2; ++sidx) {
        unsigned hsh = (unsigned)(gw * 2 + sidx + 999) * 2654435761u; hsh ^= hsh >> 15; hsh *= 2246822519u; hsh ^= hsh >> 13;
        const int item = (int)(hsh & 2047u), bh = item >> 5, n = item & 31, b = bh >> 3, h = bh & 7, d = lane; float sum = 0.f, mx = 0.f;
        for (int kl = 0; kl < 256; ++kl) { const float kv = bf2f(Kb[((size_t)b * SEQ + 256 * n + kl) * DA + h * HD + d]); sum += kv; mx = fmaxf(mx, wave_sum(kv * kv)); }
        const float mean = sum * (1.f / 256.f), got = bf2f(KM[(size_t)item * 64 + d]);
        if (fabsf(mean - got) > 0.01f * fabsf(mean) + 1e-3f) bad = true;
        if (fabsf(mx - KN[item]) > 1e-3f * mx) bad = true;
    }
    if (__ballot(bad) != 0ull && lane == 0) __hip_atomic_store((unsigned*)(F.ctl + CW_CHK), 1u, __ATOMIC_RELAXED, __HIP_MEMORY_SCOPE_AGENT);
}
#endif
#ifndef MK_N_LAUNCHES
#define MK_N_LAUNCHES 1
#endif
constexpr int NPHASE = 14;
struct Args { const float* in[27]; float* out; unsigned char* ws; int ph_lo, ph_hi; };
static_assert(sizeof(Args) == 27 * 8 + 8 + 8 + 8, "Args has no padding");

#ifndef STAG9
#define STAG9 0
#endif
#ifndef STAG8
#define STAG8 0
#endif
#ifndef DUP_MASK
#define DUP_MASK 0
#endif
#define PH_ARGS Frame& F, unsigned char* ws, LAS unsigned char* ring
__device__ __forceinline__ void ph1(PH_ARGS) {
    { pg8::Gemm g{(const bf16_t*)(ws + WS_H1), (const bf16_t*)(ws + WS_WIN), D, D, D}; pg8::StaticOrder S; S.init(T, DS, F.G, (int)blockIdx.x);
      EpiProj<0> E{ws, F.in[3], 0, 1.f};
      pg8::gemm_phase<EpiProj<0>, pg8::StaticOrder, true, false>(ring, g, S, E, nullptr, F.wave); }
    { pg8::Gemm g{(const bf16_t*)(ws + WS_H1F8), (const bf16_t*)(ws + WS_WINF8), D / 2, D / 2, D / 2}; pg8::StaticOrder S; S.init(T, DIN - DS, F.G, (int)blockIdx.x);
      EpiProj<1> E{ws, F.in[3], 2, 1.f / WF8_SCALE};
      pg8::gemm_phase<EpiProj<1>, pg8::StaticOrder, true, false, true>(ring, g, S, E, nullptr, F.wave); }
}
__device__ __forceinline__ void ph2(PH_ARGS) {
    { pg8::Gemm g{(const bf16_t*)(ws + WS_UP), (const bf16_t*)(ws + WS_SSMW), SKY, SKU, SKU}; pg8::GroupedOrder S; S.init(SG * 8, 1, 8, F.G, F.vcu);
      EpiSsmE E{(float*)(ws + WS_E)};
      pg8::gemm_phase<EpiSsmE, pg8::GroupedOrder, false, false>(ring, g, S, E, nullptr, F.wave); }
    VM_WAIT(); __syncthreads();
    ssm_scan_phase(F);
    kv_prep_phase(F);
}
__device__ __forceinline__ void ph4(PH_ARGS) {
    pg8::Gemm g{(const bf16_t*)(ws + WS_UP), (const bf16_t*)(ws + WS_SSMT), SKY, SKY, SKY}; pg8::GroupedOrder S; S.init(SG * 8, 2, 8, F.G, F.vcu);
    EpiSsmY E{(bf16_t*)(ws + WS_GACT)};
    pg8::gemm_phase<EpiSsmY, pg8::GroupedOrder, true, false>(ring, g, S, E, nullptr, F.wave);
}
__device__ __forceinline__ void ph5(PH_ARGS) {
    pg8::Gemm g{(const bf16_t*)(ws + WS_GACT), (const bf16_t*)(ws + WS_WGLU), DS, DS, DS}; pg8::StaticOrder S; S.init(T, DS, F.G, (int)blockIdx.x);
    EpiGlu E{(const bf16_t*)(ws + WS_GACT), (bf16_t*)(ws + WS_YSSM), F.in[13]};
    pg8::gemm_phase<EpiGlu, pg8::StaticOrder, true, false>(ring, g, S, E, nullptr, F.wave);
}
__device__ __forceinline__ void ph6(PH_ARGS) {
    { pg8::Gemm g{(const bf16_t*)(ws + WS_YSSM), (const bf16_t*)(ws + WS_WUS), DS, DS, DS}; pg8::StaticOrder S; S.init(T, D, F.G, (int)blockIdx.x);
      EpiUp<false> E{(const bf16_t*)(ws + WS_SGS), (bf16_t*)(ws + WS_MRG)};
      pg8::gemm_phase<EpiUp<false>, pg8::StaticOrder, true, false>(ring, g, S, E, nullptr, F.wave); }
    VM_WAIT(); __syncthreads();
    { pg8::Gemm g{(const bf16_t*)(ws + WS_YATT), (const bf16_t*)(ws + WS_WUA), DA, DA, DA}; pg8::StaticOrder S; S.init(T, D, F.G, (int)blockIdx.x);
      EpiUp<true> E{(const bf16_t*)(ws + WS_SGA), (bf16_t*)(ws + WS_MRG)};
      pg8::gemm_phase<EpiUp<true>, pg8::StaticOrder, true, false>(ring, g, S, E, nullptr, F.wave); }
}
__device__ __forceinline__ void ph7(PH_ARGS) {
    pg8::Gemm g{(const bf16_t*)(ws + WS_MRG), (const bf16_t*)(ws + WS_WOUT), D, D, D}; pg8::StaticOrder S; S.init(T, D, F.G, (int)blockIdx.x);
    EpiOut E{F.in[0], (bf16_t*)(ws + WS_X1), ws + WS_XGF8, (float*)(ws + WS_SSQ)};
    pg8::gemm_phase<EpiOut, pg8::StaticOrder, true, false>(ring, g, S, E, nullptr, F.wave);
}
__device__ __forceinline__ void ph8(PH_ARGS) {
    pg8::Gemm g{(const bf16_t*)(ws + WS_X1), (const bf16_t*)(ws + WS_WR), D, D, D}; pg8::GroupedOrder S; S.init(T / 256, 1, T / 256, F.G, F.vcu);
    EpiRouter E{(float*)(ws + WS_RLOG)};
    pg8::gemm_phase<EpiRouter, pg8::GroupedOrder, false, false>(ring, g, S, E, nullptr, F.wave);
}
__device__ __forceinline__ void ph10(PH_ARGS) {
    moe_tables(F);
    const LAS int* tst = (const LAS int*)(F.lds + MOE_TST_OFF);
    MoeOrder S{tst, tst[32] * 4, F.G, F.vcu};
    LAS unsigned* rowtab = (LAS unsigned*)(F.lds + ROWTAB_OFF);
    { const unsigned* rowtok = (const unsigned*)(ws + WS_ROWTOK); const unsigned* ecnt = (const unsigned*)(F.ctl + CW_ECNT); pg8::Unit u;
      for (int i = 0; i < ROWTAB_UNITS && S.next(i, u); ++i) { if (F.tid < 256) { const int pos = u.aux2 + F.tid; const unsigned tk = pos < (int)ecnt[u.aux] ? (rowtok[(size_t)u.aux * ROWCAP + pos] >> 1) : 0u; rowtab[i * 256 + F.tid] = tk * (unsigned)D; } } }
    __syncthreads();
    pg8::Gemm g{(const bf16_t*)(ws + WS_XGF8), (const bf16_t*)(ws + WS_W13), D / 2, D / 2, D / 2};
    EpiMoe1 E{ws + WS_HID, (const float*)(ws + WS_ROWRSTD), (const unsigned*)(F.ctl + CW_ECNT), 1.f / WF8_SCALE};
    pg8::gemm_phase<EpiMoe1, MoeOrder, true, true, true>(ring, g, S, E, rowtab, F.wave);
}
__device__ __forceinline__ void ph11(PH_ARGS) {
    moe_tables(F);
    const LAS int* tst = (const LAS int*)(F.lds + MOE_TST_OFF);
    MoeOrder S{tst, tst[32] * 4, F.G, F.vcu};
    pg8::Gemm g{(const bf16_t*)(ws + WS_HID), (const bf16_t*)(ws + WS_W2), DE / 2, DE / 2, DE / 2};
    EpiMoe2 E{(bf16_t*)(ws + WS_Y0), (size_t)(WS_Y1 - WS_Y0), (const unsigned*)(ws + WS_ROWTOK), (const float*)(ws + WS_ROWCOEF), (const unsigned*)(F.ctl + CW_ECNT), 1.f / WF8_SCALE};
    pg8::gemm_phase<EpiMoe2, MoeOrder, true, false, true>(ring, g, S, E, nullptr, F.wave);
}

__global__ void __launch_bounds__(NTHR, 2) fwd_kernel(Args args) {
    extern __shared__ __attribute__((aligned(16))) unsigned char lds_raw[];
    Frame F;
    F.lds = (LAS unsigned char*)lds_raw;
    F.MISC = (volatile LAS unsigned*)(F.lds + MISC_OFF);
    F.wave = __builtin_amdgcn_readfirstlane((int)(threadIdx.x >> 6)); F.lane = lane_id(); F.tid = F.wave * 64 + F.lane;
    F.G = gridDim.x; { const int bx = blockIdx.x; F.vcu = (F.G % 8 == 0) ? (bx % 8) * (F.G / 8) + bx / 8 : bx; }
    F.ws = args.ws; F.ctl = (gu32*)(args.ws + WS_CTL); F.out = args.out;
#pragma unroll
    for (int i = 0; i < 27; ++i) F.in[i] = args.in[i];
    for (int u = F.tid; u < (LDS_BYTES - MOE_TST_OFF) / 4; u += NTHR) ((LAS unsigned*)(F.lds + MOE_TST_OFF))[u] = 0u;
    __syncthreads();
    XcdBarrier bar; bar.bar = (unsigned*)(F.ctl + CW_BAR); bar.x = 0; bar.st = nullptr;
    const int lo = args.ph_lo, hi = args.ph_hi;
    if (hi - lo > 1) bar = xcd_barrier_post((unsigned*)(F.ctl + CW_BAR), F.MISC + 8, F.tid == 0);
#define IN(k) (lo <= (k) && (k) < hi)
#define DUP(k) ((DUP_MASK >> (k)) & 1)
#define SEAM(k) do { if (IN(k) && IN((k) + 1)) xcd_barrier(bar, F.wave == 0 && lane_id() == 0); REFRESH(); } while (0)
#define REFRESH() do { int l_ = lane_id(); asm volatile("" : "+v"(l_)); F.lane = l_; F.tid = F.wave * 64 + l_; } while (0)
    unsigned char* ws = args.ws;
    LAS unsigned char* ring = F.lds;
    if (IN(0)) { p0_prologue(F); if (DUP(0)) p0_prologue(F); }
    SEAM(0);
    if (IN(1)) { ph1(F, ws, ring); if (DUP(1)) ph1(F, ws, ring); }
    SEAM(1);
    if (IN(2)) { ph2(F, ws, ring); if (DUP(2)) ph2(F, ws, ring); }
    SEAM(2);
#ifdef SELFCHECK_PREP
    if (IN(3)) { selfcheck_prep(F); }
#endif
    if (IN(3)) { attn_gate_phase<true>(F); }
    SEAM(3);
    if (IN(4)) { attn_block_phase(F); if (DUP(4)) { __syncthreads(); attn_block_phase(F); } }
    SEAM(4);
    if (IN(5)) { attn_own_phase(F); if (DUP(5)) attn_own_phase(F); }
    SEAM(5);
    if (IN(6)) { ph4(F, ws, ring); if (DUP(6)) ph4(F, ws, ring); }
#ifdef SELFCHECK
    if (IN(6)) { xcd_barrier(bar, F.wave == 0 && lane_id() == 0); REFRESH(); selfcheck_phase(F, SELFCHECK_TOL_ATTN, SELFCHECK_TOL_SSM); }
#endif
    SEAM(6);
    if (IN(7)) { ph5(F, ws, ring); if (DUP(7)) ph5(F, ws, ring); }
    SEAM(7);
    if (IN(8)) { if (STAG8 > 0 && (F.vcu & 1)) { const unsigned long long t0_ = __builtin_amdgcn_s_memrealtime(); while ((long long)(__builtin_amdgcn_s_memrealtime() - t0_) < (long long)STAG8) __builtin_amdgcn_s_sleep(16); }
                 ph6(F, ws, ring); if (DUP(8)) ph6(F, ws, ring); }
    SEAM(8);
    if (IN(9)) { if (STAG9 > 0 && (F.vcu & 1)) { const unsigned long long t0_ = __builtin_amdgcn_s_memrealtime(); while ((long long)(__builtin_amdgcn_s_memrealtime() - t0_) < (long long)STAG9) __builtin_amdgcn_s_sleep(16); }
                 ph7(F, ws, ring); if (DUP(9)) ph7(F, ws, ring); }
    SEAM(9);
    if (IN(10)) { ph8(F, ws, ring); VM_WAIT(); __syncthreads(); routing_phase(F); }
    SEAM(10);
    if (IN(11)) { ph10(F, ws, ring); if (DUP(11)) ph10(F, ws, ring); }
    SEAM(11);
    if (IN(12)) { ph11(F, ws, ring); if (DUP(12)) ph11(F, ws, ring); }
    SEAM(12);
    if (IN(13)) { final_phase(F); if (DUP(13)) final_phase(F); }
#undef IN
#undef DUP
#undef SEAM
#undef REFRESH
}

extern "C" void kernel_launch(void* const* d_in, const int* in_sizes, int n_in, void* d_out, int out_size, void* d_ws, size_t ws_size, hipStream_t stream) {
    static int grid = 0;
    if (grid == 0) {
        if (n_in != 27 || in_sizes[0] != T * D || out_size != T * D || ws_size < WS_END) { fprintf(stderr, "kernel_launch: unexpected shapes (n_in %d, in0 %d, out %d, ws %zu)\n", n_in, n_in > 0 ? in_sizes[0] : -1, out_size, ws_size); grid = -1; return; }
        int dev = 0, cus = 0;
        if (hipGetDevice(&dev) != hipSuccess || hipDeviceGetAttribute(&cus, hipDeviceAttributeMultiprocessorCount, dev) != hipSuccess) { grid = -1; return; }
        if (hipFuncSetAttribute((const void*)fwd_kernel, hipFuncAttributeMaxDynamicSharedMemorySize, LDS_BYTES) != hipSuccess) { fprintf(stderr, "kernel_launch: hipFuncSetAttribute failed\n"); grid = -1; return; }
        (void)hipGetLastError();
        grid = cus;
    }
    if (grid < 0) return;
    (void)hipMemsetAsync((char*)d_ws + WS_CTL, 0, CTL_ZERO_BYTES, stream);
    Args a{};
    for (int i = 0; i < 27; ++i) a.in[i] = (const float*)d_in[i];
    a.out = (float*)d_out; a.ws = (unsigned char*)d_ws;
    if (MK_N_LAUNCHES == 1) { a.ph_lo = 0; a.ph_hi = NPHASE; hipLaunchKernelGGL(fwd_kernel, dim3(grid), dim3(NTHR), LDS_BYTES, stream, a); }
    else { for (int p = 0; p < NPHASE; ++p) { a.ph_lo = p; a.ph_hi = p + 1; hipLaunchKernelGGL(fwd_kernel, dim3(grid), dim3(NTHR), LDS_BYTES, stream, a); } }
}
```

```cpp
#include <hip/hip_runtime.h>
#include <cstdio>
#include <cstdint>

#define LAS __attribute__((address_space(3)))
#define GAS __attribute__((address_space(1)))
typedef unsigned short bf16_t;
typedef short bf16x8 __attribute__((ext_vector_type(8)));
typedef float f32x2 __attribute__((ext_vector_type(2)));
typedef float f32x4 __attribute__((ext_vector_type(4)));
typedef float f32x16 __attribute__((ext_vector_type(16)));
typedef unsigned u32x2 __attribute__((ext_vector_type(2)));
typedef unsigned u32x4 __attribute__((ext_vector_type(4)));
typedef GAS unsigned gu32;
typedef int v4i32 __attribute__((ext_vector_type(4)));
typedef int v8i32 __attribute__((ext_vector_type(8)));
#define RLX_AGENT __ATOMIC_RELAXED, __HIP_MEMORY_SCOPE_AGENT
#define LDS_WAIT() asm volatile("s_waitcnt lgkmcnt(0)" ::: "memory")
#define VM_WAIT() asm volatile("s_waitcnt vmcnt(0)" ::: "memory")

__device__ __forceinline__ unsigned f2bf(float f) { unsigned u = __builtin_bit_cast(unsigned, f); return (u + 0x7fffu + ((u >> 16) & 1u)) >> 16; }
__device__ __forceinline__ unsigned pk2(float lo, float hi) { return f2bf(lo) | (f2bf(hi) << 16); }
__device__ __forceinline__ float bf2f(unsigned short b) { return __builtin_bit_cast(float, (unsigned)b << 16); }
__device__ __forceinline__ float bflo(unsigned w) { return __builtin_bit_cast(float, w << 16); }
__device__ __forceinline__ float bfhi(unsigned w) { return __builtin_bit_cast(float, w & 0xffff0000u); }
__device__ __forceinline__ unsigned cvt_pk_bf16(float lo, float hi) { unsigned r; asm volatile("v_cvt_pk_bf16_f32 %0, %1, %2" : "=v"(r) : "v"(lo), "v"(hi)); return r; }
__device__ __forceinline__ float fast_sigmoid(float x) { return __builtin_amdgcn_rcpf(1.f + __builtin_amdgcn_exp2f(-1.4426950408889634f * x)); }
__device__ __forceinline__ int lane_id() { int l; asm volatile("v_mbcnt_lo_u32_b32 %0, -1, 0\n\tv_mbcnt_hi_u32_b32 %0, -1, %0" : "=v"(l)); return l; }
__device__ __forceinline__ float wave_sum(float v) {
#pragma unroll
    for (int o = 1; o < 64; o <<= 1) v += __shfl_xor(v, o);
    return v;
}
__device__ __forceinline__ float wave_max(float v) {
#pragma unroll
    for (int o = 1; o < 64; o <<= 1) v = fmaxf(v, __shfl_xor(v, o));
    return v;
}

#define XB_TMO      128
#define XB_XCNT(j)  (256  + 64 * (j))
#define XB_XSUB(j)  (1280 + 64 * (j))
#define XB_XGEN(j)  (2304 + 64 * (j))
#define XB_TOP      3328
#define XB_TOPGEN   3392
#define XCD_BAR_WORDS 3456
#define XB_SPIN_CAP (1u << 20)

__device__ __forceinline__ unsigned xb_ld(unsigned* p)              { return __hip_atomic_load(p, __ATOMIC_RELAXED, __HIP_MEMORY_SCOPE_AGENT); }
__device__ __forceinline__ unsigned xb_add(unsigned* p, unsigned v) { return __hip_atomic_fetch_add(p, v, __ATOMIC_RELAXED, __HIP_MEMORY_SCOPE_AGENT); }
__device__ __forceinline__ unsigned xb_xcc_id() { return (unsigned)__builtin_amdgcn_s_getreg((3 << 11) | 20) & 0xFu; }
#define XB_SPIN(cond, bar) do { unsigned _sp = 0; while (cond) { __builtin_amdgcn_s_sleep(1); \
    if ((++_sp & 255u) == 0u) { if (xb_ld(&(bar)[XB_TMO])) break; if (_sp > XB_SPIN_CAP) { atomicAdd(&(bar)[XB_TMO], 1u); break; } } } } while (0)

struct XcdBarrier { unsigned* bar; unsigned x; volatile LAS unsigned* st; };

__device__ __forceinline__ XcdBarrier xcd_barrier_post(unsigned* bar, volatile LAS unsigned* st, bool leader  ) {
    XcdBarrier b; b.bar = bar; b.x = xb_xcc_id(); b.st = st;
    if (leader) (void)xb_add(&bar[XB_XCNT(b.x)], 1u);
    return b;
}
__device__ __forceinline__ void xcd_barrier_complete(unsigned* bar, unsigned x, unsigned& nloc, unsigned& nx) {
    const unsigned G = gridDim.x * gridDim.y * gridDim.z;
    unsigned sum, cnt, mine, sp = 0u;
    for (;;) {
        sum = 0u; cnt = 0u; mine = 0u;
#pragma unroll
        for (unsigned j = 0; j < 16; ++j) { const unsigned c = xb_ld(&bar[XB_XCNT(j)]); sum += c; cnt += (c > 0u) ? 1u : 0u; mine = (j == x) ? c : mine; }
        if (sum == G) break;
        __builtin_amdgcn_s_sleep(1);
        if ((++sp & 255u) == 0u) { if (xb_ld(&bar[XB_TMO])) break; if (sp > XB_SPIN_CAP) { atomicAdd(&bar[XB_TMO], 1u); break; } }
    }
    nloc = mine > 0u ? mine : 1u; nx = cnt > 0u ? cnt : 1u;
}
__device__ __forceinline__ void xcd_barrier(const XcdBarrier& b, bool leader  ) {
    asm volatile("s_waitcnt vmcnt(0)" ::: "memory");
    __syncthreads();
    if (leader) {
        unsigned* bar = b.bar;
        __builtin_amdgcn_s_waitcnt(0);
        unsigned nloc = b.st[0], nx = b.st[1];
        if (nloc == 0u) { xcd_barrier_complete(bar, b.x, nloc, nx); b.st[0] = nloc; b.st[1] = nx; }
        const unsigned old = xb_add(&bar[XB_XSUB(b.x)], 1u);
        const unsigned gen = old / nloc;
        if (old + 1u == (gen + 1u) * nloc) {
            __builtin_amdgcn_fence(__ATOMIC_RELEASE, "agent");
            asm volatile("s_waitcnt vmcnt(0)" ::: "memory");
            const unsigned og = xb_add(&bar[XB_TOP], 1u);
            const unsigned tg = og / nx;
            if (og + 1u == (tg + 1u) * nx) xb_add(&bar[XB_TOPGEN], 1u);
            else XB_SPIN(xb_ld(&bar[XB_TOPGEN]) == tg, bar);
            __builtin_amdgcn_fence(__ATOMIC_ACQUIRE, "agent");
            xb_add(&bar[XB_XGEN(b.x)], 1u);
            asm volatile("s_waitcnt vmcnt(0)" ::: "memory");
        } else {
            XB_SPIN(xb_ld(&bar[XB_XGEN(b.x)]) == gen, bar);
            __builtin_amdgcn_fence(__ATOMIC_ACQUIRE, "agent");
            asm volatile("s_waitcnt vmcnt(0)" ::: "memory");
        }
    }
    __syncthreads();
}

namespace pg8 {
constexpr int BM = 256, BK = 64, HALF = 128, HTB = HALF * BK * 2, STAGE_BYTES = 8 * HTB, NXCD = 8, WGM = 8;
__host__ __device__ __forceinline__ int lds_byte(int r, int c) { const int st = (r >> 4) * 2 + (c >> 5), rr = r & 15, cc = c & 31, ob = rr * 64 + cc * 2; return st * 1024 + (ob ^ (((ob >> 9) & 1) << 5)); }
__host__ __device__ __forceinline__ void stage_rc(int b, int& R, int& C) { const int st = b / 1024, sb = b % 1024, swz = sb ^ (((sb >> 9) & 1) << 5); R = (st >> 1) * 16 + swz / 64; C = (st & 1) * 32 + (swz % 64) / 2; }
__host__ __device__ __forceinline__ int perm32(int rho) { const int n = rho >> 4, i = rho & 15; return 8 * (i >> 2) + 4 * n + (i & 3); }

struct Unit { int pm, pn, pb, aux, aux2; };
struct Gemm { const bf16_t* A; const bf16_t* Bt; int lda, ldb, K; };

struct StaticOrder {
    int nM, nN, nwg, G, c;
    __device__ void init(int M, int N, int G_, int c_) { nM = M / BM; nN = N / BM; nwg = nM * nN; G = G_; c = c_; }
    __device__ bool next(int i, Unit& u) const {
        const long L = (long)i * G + c; if (L >= nwg) return false;
        int wgid = (int)L; { const int q = nwg / NXCD, r = nwg % NXCD, xcd = wgid % NXCD, off = wgid / NXCD; wgid = (xcd < r ? xcd * (q + 1) : r * (q + 1) + (xcd - r) * q) + off; }
        const int nig = WGM * nN, gid = wgid / nig, fm = gid * WGM, gsz = (nM - fm) < WGM ? (nM - fm) : WGM;
        u.pm = fm + ((wgid % nig) % gsz); u.pn = (wgid % nig) / gsz; u.pb = u.pn; u.aux = 0; u.aux2 = 0; return true;
    }
};
struct GroupedOrder {
    int nM, nN, rtpg, G, v;
    __device__ void init(int nM_, int nN_, int rtpg_, int G_, int v_) { nM = nM_; nN = nN_; rtpg = rtpg_; G = G_; v = v_; }
    __device__ bool next(int i, Unit& u) const {
        const int L = i * G + v; if (L >= nM * nN) return false;
        u.pm = L / nN; u.pn = L % nN; u.aux = u.pm / rtpg; u.pb = u.aux * nN + u.pn; u.aux2 = 0; return true;
    }
};

template <class Epi, class Sched, bool ALIGN_EPI, bool GATHER, bool FP8 = false>
__device__ __forceinline__ void gemm_phase(LAS unsigned char* lds, const Gemm g, const Sched& S, const Epi& E, const LAS unsigned* rowtab  , int wid  ) {
    const int lane = lane_id(), tid = wid * 64 + lane, wr = wid >> 2, wc = wid & 3;
    const int K = g.K, nt = K / BK;
    unsigned voffB[2];
#pragma unroll
    for (int i = 0; i < 2; ++i) { int R, C; stage_rc(tid * 16 + i * 8192, R, C); const int Rb = (R & ~31) + perm32(R & 31);
        voffB[i] = (unsigned)(Rb * g.ldb + C) * 2u; }
    const size_t kstep = (size_t)(BK * 2);
    const size_t hstepB = (size_t)HALF * g.ldb * 2, tstepB = 2 * hstepB;
    const size_t tstepA = (size_t)BM * g.lda * 2;
    const unsigned ldsw = (unsigned)wid * 1024u;
    const int aoff = lds_byte(wr * 64 + (lane & 15), (lane >> 4) * 8), boff = lds_byte(wc * 32 + (lane & 15), (lane >> 4) * 8);
    unsigned vAc[2][2];
#define PG8_SETVA(dst, ui_) do { const int t_ = wid * 64 + lane_id(); _Pragma("unroll") for (int i_ = 0; i_ < 2; ++i_) { int R_, C_; stage_rc(t_ * 16 + i_ * 8192, R_, C_); \
        _Pragma("unroll") for (int h_ = 0; h_ < 2; ++h_) dst[h_][i_] = (GATHER ? rowtab[(ui_) * 256 + h_ * 128 + R_] : (unsigned)((h_ * 128 + R_) * g.lda) * 2u) + (unsigned)C_ * 2u; } } while (0)
#define PG8_SA(b, h) (((b) * 2 + (h)) * HTB)
#define PG8_SB(b, h) ((4 + (b) * 2 + (h)) * HTB)
#define PG8_GLDS_S(gbase_, voff_, ldsaddr_) do { unsigned keep_; asm volatile("s_mov_b32 %0, m0\n\ts_mov_b32 m0, %3\n\ts_nop 0\n\tglobal_load_lds_dwordx4 %1, %2\n\ts_mov_b32 m0, %0" \
        : "=&s"(keep_) : "v"(voff_), "s"(gbase_), "s"(ldsaddr_) : "memory"); } while (0)
#define PG8_STAGE(bufoff, gbase, v0, v1) do { \
        if constexpr (FP8) { const unsigned la_ = (unsigned)(uintptr_t)(lds + (bufoff) + ldsw); PG8_GLDS_S((const char*)(gbase), (v0), la_); PG8_GLDS_S((const char*)(gbase), (v1), la_ + 8192u); } else { \
        __builtin_amdgcn_global_load_lds((const unsigned*)((const char*)(gbase) + (v0)), (LAS unsigned*)(lds + (bufoff) + ldsw), 16, 0, 0); \
        __builtin_amdgcn_global_load_lds((const unsigned*)((const char*)(gbase) + (v1)), (LAS unsigned*)(lds + (bufoff) + ldsw + 8192), 16, 0, 0); } } while (0)
#define PG8_STB(bufoff, gbase) PG8_STAGE(bufoff, gbase, voffB[0], voffB[1])
#define PG8_LDA(dst, b, h) do { _Pragma("unroll") for (int m = 0; m < 4; ++m) _Pragma("unroll") for (int k = 0; k < 2; ++k) dst[m][k] = *(const LAS bf16x8*)(lds + PG8_SA(b, h) + aoff + m * 2048 + k * 1024); } while (0)
#define PG8_LDB(dst, b, h) do { _Pragma("unroll") for (int n = 0; n < 2; ++n) _Pragma("unroll") for (int k = 0; k < 2; ++k) dst[n][k] = *(const LAS bf16x8*)(lds + PG8_SB(b, h) + boff + n * 2048 + k * 1024); } while (0)
#define PG8_MMA(ai, bj, At, Bt) do { __builtin_amdgcn_s_setprio(1); \
        if constexpr (FP8) { _Pragma("unroll") for (int m = 0; m < 4; ++m) _Pragma("unroll") for (int n = 0; n < 2; ++n) { \
            const v8i32 a8_ = __builtin_shufflevector(__builtin_bit_cast(v4i32, At[m][0]), __builtin_bit_cast(v4i32, At[m][1]), 0, 1, 2, 3, 4, 5, 6, 7); \
            const v8i32 b8_ = __builtin_shufflevector(__builtin_bit_cast(v4i32, Bt[n][0]), __builtin_bit_cast(v4i32, Bt[n][1]), 0, 1, 2, 3, 4, 5, 6, 7); \
            acc[ai][bj][m][n] = __builtin_amdgcn_mfma_scale_f32_16x16x128_f8f6f4(b8_, a8_, acc[ai][bj][m][n], 0, 0, 0, 0, 0, 0); } } \
        else { _Pragma("unroll") for (int m = 0; m < 4; ++m) _Pragma("unroll") for (int n = 0; n < 2; ++n) _Pragma("unroll") for (int k = 0; k < 2; ++k) \
            acc[ai][bj][m][n] = __builtin_amdgcn_mfma_f32_16x16x32_bf16(Bt[n][k], At[m][k], acc[ai][bj][m][n], 0, 0, 0); } \
        __builtin_amdgcn_s_setprio(0); } while (0)
#define PG8_WAIT_V(n) asm volatile("s_waitcnt vmcnt(" #n ")" ::: "memory")
#define PG8_WAIT_L(n) asm volatile("s_waitcnt lgkmcnt(" #n ")" ::: "memory")
#define PG8_BAR __builtin_amdgcn_s_barrier()
#define PG8_SCHED __builtin_amdgcn_sched_barrier(0)
#define PG8_SCHED8 do { if constexpr (FP8) __builtin_amdgcn_sched_barrier(0); } while (0)
    Unit cur, nxt; int ui = 0;
#define PG8_UNI(u_) do { u_.pm = __builtin_amdgcn_readfirstlane(u_.pm); u_.pn = __builtin_amdgcn_readfirstlane(u_.pn); u_.pb = __builtin_amdgcn_readfirstlane(u_.pb); u_.aux = __builtin_amdgcn_readfirstlane(u_.aux); u_.aux2 = __builtin_amdgcn_readfirstlane(u_.aux2); } while (0)
    if (!S.next(0, cur)) return;
    PG8_UNI(cur);
    f32x4 acc[2][2][4][2];
#pragma unroll
    for (int a = 0; a < 2; ++a)
#pragma unroll
        for (int b = 0; b < 2; ++b)
#pragma unroll
            for (int m = 0; m < 4; ++m)
#pragma unroll
                for (int n = 0; n < 2; ++n) acc[a][b][m][n] = (f32x4){0.f, 0.f, 0.f, 0.f};
    bf16x8 At[4][2], B0[2][2], B1[2][2];
    const char* cA = (const char*)g.A + (GATHER ? (size_t)0 : (size_t)cur.pm * tstepA); const char* cB = (const char*)g.Bt + (size_t)cur.pb * tstepB;
    PG8_SETVA(vAc, 0);
    PG8_STB(PG8_SB(0, 0), cB); PG8_STB(PG8_SB(0, 1), cB + hstepB); PG8_STAGE(PG8_SA(0, 0), cA, vAc[0][0], vAc[0][1]); PG8_STAGE(PG8_SA(0, 1), cA, vAc[1][0], vAc[1][1]);
    if (wr == 1) PG8_BAR;
    PG8_WAIT_V(2); PG8_BAR;
    PG8_STB(PG8_SB(1, 0), cB + kstep); PG8_STAGE(PG8_SA(1, 0), cA + kstep, vAc[0][0], vAc[0][1]); PG8_STB(PG8_SB(1, 1), cB + hstepB + kstep);
    PG8_WAIT_V(6); PG8_BAR;
    for (;;) {
        const bool has_next = S.next(ui + 1, nxt);
        PG8_UNI(nxt);
        const char* nA = GATHER ? cA : (has_next ? (const char*)g.A + (size_t)nxt.pm * tstepA : cA); const char* nB = has_next ? (const char*)g.Bt + (size_t)nxt.pb * tstepB : cB;
        const int nui = has_next ? ui + 1 : ui;
#pragma nounroll
        for (int t = 0; t < nt; t += 2) {
            const bool last = (t == nt - 2);
            const char* a1 = cA + (size_t)(t + 1) * kstep;
            const char* a2 = last ? nA : cA + (size_t)(t + 2) * kstep; const char* b2 = last ? nB : cB + (size_t)(t + 2) * kstep;
            const char* a3 = a2 + kstep; const char* b3 = b2 + kstep;
            unsigned x00 = vAc[0][0], x01 = vAc[0][1], x10 = vAc[1][0], x11 = vAc[1][1];
            if (GATHER) { if (last) { unsigned vN_[2][2]; PG8_SETVA(vN_, nui); x00 = vN_[0][0]; x01 = vN_[0][1]; x10 = vN_[1][0]; x11 = vN_[1][1]; } }
            PG8_LDB(B0, 0, 0); PG8_LDB(B1, 0, 1); PG8_SCHED; PG8_LDA(At, 0, 0); PG8_STAGE(PG8_SA(1, 1), a1, vAc[1][0], vAc[1][1]);
            PG8_WAIT_V(8); PG8_WAIT_L(0); PG8_BAR; PG8_SCHED8; PG8_MMA(0, 0, At, B0); PG8_MMA(0, 1, At, B1); PG8_SCHED8; PG8_BAR; PG8_SCHED;
            PG8_LDA(At, 0, 1); PG8_STB(PG8_SB(0, 0), b2); PG8_STB(PG8_SB(0, 1), b2 + hstepB); PG8_STAGE(PG8_SA(0, 0), a2, x00, x01);
            PG8_WAIT_V(8); PG8_WAIT_L(0); PG8_BAR; PG8_SCHED8; PG8_MMA(1, 0, At, B0); PG8_MMA(1, 1, At, B1); PG8_SCHED8; PG8_BAR; PG8_SCHED;
            PG8_LDB(B0, 1, 0); PG8_LDB(B1, 1, 1); PG8_SCHED; PG8_LDA(At, 1, 0); PG8_STAGE(PG8_SA(0, 1), a2, x10, x11);
            PG8_WAIT_V(8); PG8_WAIT_L(0); PG8_BAR; PG8_SCHED8; PG8_MMA(0, 0, At, B0); PG8_MMA(0, 1, At, B1); PG8_SCHED8; PG8_BAR; PG8_SCHED;
            PG8_LDA(At, 1, 1); PG8_STB(PG8_SB(1, 0), b3); PG8_STB(PG8_SB(1, 1), b3 + hstepB); PG8_STAGE(PG8_SA(1, 0), a3, x00, x01);
            PG8_WAIT_V(8); PG8_WAIT_L(0); PG8_BAR; PG8_SCHED8; PG8_MMA(1, 0, At, B0); PG8_MMA(1, 1, At, B1); PG8_SCHED8; PG8_BAR; PG8_SCHED;
        }
        if constexpr (ALIGN_EPI) { if (wr == 0) PG8_BAR; }
        { int l_ = lane_id(); asm volatile("" : "+v"(l_));
          E(acc, cur, wr, wc, l_ & 15, l_ >> 4); }
        if (!has_next) break;
#pragma unroll
        for (int a = 0; a < 2; ++a)
#pragma unroll
            for (int b = 0; b < 2; ++b)
#pragma unroll
                for (int m = 0; m < 4; ++m)
#pragma unroll
                    for (int n = 0; n < 2; ++n) acc[a][b][m][n] = (f32x4){0.f, 0.f, 0.f, 0.f};
        cur = nxt; cA = nA; cB = nB; ++ui;
        if (GATHER) { PG8_SETVA(vAc, ui); }
        if constexpr (ALIGN_EPI) { if (wr == 1) PG8_BAR; }
    }
    PG8_WAIT_V(0);
    if constexpr (!ALIGN_EPI) { if (wr == 0) PG8_BAR; }
    PG8_BAR;
#undef PG8_SETVA
#undef PG8_UNI
#undef PG8_SA
#undef PG8_SB
#undef PG8_STAGE
#undef PG8_GLDS_S
#undef PG8_STB
#undef PG8_LDA
#undef PG8_LDB
#undef PG8_MMA
#undef PG8_WAIT_V
#undef PG8_WAIT_L
#undef PG8_BAR
#undef PG8_SCHED
#undef PG8_SCHED8
}
}
constexpr int NWAVES = 8, NTHR = 512;
constexpr int BATCH = 8, SEQ = 8192, T = BATCH * SEQ, D = 1024, DIN = 4096;
constexpr int DS = 512, DA = 512, NH = 8, HD = 64, NBLK = SEQ / 256;
constexpr int SG = 32, SHC = 16, SP = 64, SL = 32, SKU = SL * SHC  , SKS = 2 * SP  , SKY = SKU + SKS  , SROWS = T / SL  ;
constexpr int NE = 32, DE = 512;
constexpr float RMS_EPS = 1e-6f;
constexpr float LOG2E = 1.4426950408889634f;
constexpr float QSCALE = 0.125f * LOG2E;
constexpr float WF8_SCALE = 32.f;
constexpr float YF8_SCALE = 16.f;
constexpr int ROWCAP = T;
constexpr int HID_ROWS = 2 * T + NE * 256;

constexpr size_t MiB = 1u << 20;
constexpr size_t WS_CTL = 0, CTL_ZERO_BYTES = 1 * MiB;
constexpr size_t WS_WIN = 1 * MiB;
constexpr size_t WS_WGLU = 9 * MiB;
constexpr size_t WS_WUS = 10 * MiB;
constexpr size_t WS_WUA = 11 * MiB;
constexpr size_t WS_WOUT = 12 * MiB;
constexpr size_t WS_WR = 14 * MiB;
constexpr size_t WS_KMEAN = 15 * MiB;
constexpr size_t WS_SSMW = 16 * MiB;
constexpr size_t WS_SSMT = 24 * MiB;
constexpr size_t WS_W13 = 44 * MiB;
constexpr size_t WS_W2 = 108 * MiB;
constexpr size_t WS_A0 = 140 * MiB;
constexpr size_t WS_UP = 276 * MiB;
constexpr size_t WS_Q = 356 * MiB;
constexpr size_t WS_SSQ = 404 * MiB;
constexpr size_t WS_RLOG = 408 * MiB;
constexpr size_t WS_K = 420 * MiB;
constexpr size_t WS_ROWTOK = 428 * MiB, WS_ROWCOEF = 436 * MiB, WS_ROWRSTD = 444 * MiB;
constexpr size_t WS_GACT = 420 * MiB;
constexpr size_t WS_V = 484 * MiB;
constexpr size_t WS_YSSM = 484 * MiB;
constexpr size_t WS_SGS = 548 * MiB;
constexpr size_t WS_SGA = 676 * MiB;
constexpr size_t WS_E = 804 * MiB;
constexpr size_t WS_YATT = 836 * MiB;
constexpr size_t WS_PART0 = 420 * MiB, WS_PART1 = 484 * MiB, WS_PART2 = 932 * MiB;
constexpr size_t WS_QLIST = 900 * MiB;
constexpr size_t WS_PL = 268 * MiB;
constexpr size_t WS_MQ = 996 * MiB;
constexpr size_t WS_H1F8 = 836 * MiB;
constexpr size_t WS_WINF8 = 900 * MiB;
constexpr size_t WS_XGF8 = 836 * MiB;
constexpr size_t WS_SEGC = 998 * MiB;
constexpr size_t WS_END = 999 * MiB;
constexpr size_t WS_KFRAG = WS_A0, WS_VFRAG = WS_A0 + 64 * MiB, WS_H1 = WS_A0, WS_MRG = WS_A0, WS_HID = WS_A0;
constexpr size_t WS_X1 = WS_SGS, WS_XG = WS_UP, WS_Y0 = WS_UP, WS_Y1 = WS_E;
static_assert(WS_GACT + 64 * MiB <= WS_YSSM && WS_YSSM + 64 * MiB <= WS_SGS, "map");
static_assert(WS_HID + (size_t)HID_ROWS * DE * 2 <= WS_UP, "hid fits");
static_assert(WS_RLOG + (size_t)T * 72 * 4 <= WS_ROWTOK, "rlog fits");

constexpr int CW_TMO = 0, CW_CODE = 1;
constexpr int CW_BAR = 4096;
constexpr int CW_ECNT = 8192;
constexpr int CW_GCNT = 12288;

constexpr int RING_BYTES = 131072;
constexpr int ROWTAB_OFF = RING_BYTES, ROWTAB_UNITS = 12, ROWTAB_BYTES = 25 * 1024;
constexpr int MOE_TST_OFF = ROWTAB_OFF + ROWTAB_BYTES;
constexpr int MISC_OFF = MOE_TST_OFF + 512;
constexpr int LDS_BYTES = MISC_OFF + 128;
static_assert(LDS_BYTES <= 163840, "LDS");

struct Frame {
    LAS unsigned char* lds;
    volatile LAS unsigned* MISC;
    gu32* ctl;
    unsigned char* ws;
    int tid, lane, wave, vcu, G;
    const float* in[27];
    float* out;
};

__device__ __forceinline__ unsigned pk4_fp8(float a, float b, float c, float d) { int w = 0; w = __builtin_amdgcn_cvt_pk_fp8_f32(a, b, w, false); w = __builtin_amdgcn_cvt_pk_fp8_f32(c, d, w, true); return (unsigned)w; }
#define EPI_LOOP_BEGIN  _Pragma("unroll") for (int ai = 0; ai < 2; ++ai) _Pragma("unroll") for (int m = 0; m < 4; ++m) { const int rl = ai * 128 + wr * 64 + m * 16 + fr; _Pragma("unroll") for (int bj = 0; bj < 2; ++bj) { const int cl = bj * 128 + wc * 32 + 8 * fq; \
        const f32x4 a0 = acc[ai][bj][m][0], a1 = acc[ai][bj][m][1]; (void)rl; (void)cl; (void)a0; (void)a1;
#define EPI_LOOP_END } }
typedef const f32x4 (&AccRef)[2][2][4][2];
__device__ __forceinline__ u32x4 pack8(f32x4 a, f32x4 b) { u32x4 w; w.x = cvt_pk_bf16(a[0], a[1]); w.y = cvt_pk_bf16(a[2], a[3]); w.z = cvt_pk_bf16(b[0], b[1]); w.w = cvt_pk_bf16(b[2], b[3]); return w; }
__device__ __forceinline__ void unpack8(u32x4 w, f32x4& a, f32x4& b) { a = (f32x4){bflo(w.x), bfhi(w.x), bflo(w.y), bfhi(w.y)}; b = (f32x4){bflo(w.z), bfhi(w.z), bflo(w.w), bfhi(w.w)}; }

template <int PART  > struct EpiProj {
    unsigned char* ws; const float* b_gate; int pn_off; float ascale;
    __device__ __forceinline__ void operator()(AccRef acc, const pg8::Unit& u, int wr, int wc, int fr, int fq) const {
        const int pn = u.pn + pn_off; const int row0 = u.pm * 256;
        if (PART == 0) {
            bf16_t* Uperm = (bf16_t*)(ws + WS_UP);
            EPI_LOOP_BEGIN
                const int row = row0 + rl, col = pn * 256 + cl;
                bf16_t* dst = Uperm + (size_t)(col >> 4) * ((size_t)SROWS * SKY) + (size_t)(row >> 5) * SKY + (row & 31) * 16 + (col & 15);
                *(u32x4*)dst = pack8(a0 * ascale, a1 * ascale);
            EPI_LOOP_END
        } else if (pn < 8) {
            const size_t boff = pn < 4 ? WS_Q : (pn < 6 ? WS_K : WS_V);
            bf16_t* base = (bf16_t*)(ws + boff); const float sc = pn < 4 ? QSCALE : 1.f; const int c0 = (pn & 1) * 256;
            EPI_LOOP_BEGIN
                const int row = row0 + rl, col = c0 + cl;
                *(u32x4*)(base + (size_t)row * 512 + col) = pack8(a0 * (sc * ascale), a1 * (sc * ascale));
            EPI_LOOP_END
        } else {
            const size_t boff = pn < 12 ? WS_SGS : WS_SGA;
            bf16_t* base = (bf16_t*)(ws + boff); const int c0 = ((pn - 8) & 3) * 256; const float* bg = b_gate + (pn - 8) * 256;
            EPI_LOOP_BEGIN
                const int row = row0 + rl, col = c0 + cl;
                const f32x4 b0 = *(const f32x4*)(bg + cl), b1 = *(const f32x4*)(bg + cl + 4);
                f32x4 s0, s1;
#pragma unroll
                for (int e = 0; e < 4; ++e) { s0[e] = fast_sigmoid(a0[e] * ascale + b0[e]); s1[e] = fast_sigmoid(a1[e] * ascale + b1[e]); }
                *(u32x4*)(base + (size_t)row * 1024 + col) = pack8(s0, s1);
            EPI_LOOP_END
        }
    }
};
struct EpiSsmE {
    float* E;
    __device__ __forceinline__ void operator()(AccRef acc, const pg8::Unit& u, int wr, int wc, int fr, int fq) const {
        EPI_LOOP_BEGIN
            if (bj == 0) { float* dst = E + (size_t)(u.pm * 256 + rl) * 128 + cl; *(f32x4*)dst = a0; *(f32x4*)(dst + 4) = a1; }
        EPI_LOOP_END
    }
};
__device__ __forceinline__ float gelu_tanh(float x) { const float z = 1.5957691216057308f * (x + 0.044715f * x * x * x); return x * fast_sigmoid(z); }
struct EpiSsmY {
    bf16_t* Gact;
    __device__ __forceinline__ void operator()(AccRef acc, const pg8::Unit& u, int wr, int wc, int fr, int fq) const {
        const int g = u.aux;
        EPI_LOOP_BEGIN
            const int rg = (u.pm & 7) * 256 + rl;
            const int colg = u.pn * 256 + cl;
            const int tok = (rg >> 8) * SEQ + (rg & 255) * SL + (colg >> 4);
            f32x4 y0, y1;
#pragma unroll
            for (int e = 0; e < 4; ++e) { y0[e] = gelu_tanh(a0[e]); y1[e] = gelu_tanh(a1[e]); }
            *(u32x4*)(Gact + (size_t)tok * DS + g * 16 + (colg & 15)) = pack8(y0, y1);
        EPI_LOOP_END
    }
};
#define EPI_SBAR __builtin_amdgcn_sched_barrier(0)
#define EPI_G(g_) const int ai = (g_) >> 2, m = (g_) & 3; const int rl = ai * 128 + wr * 64 + m * 16 + fr; (void)rl
struct EpiGlu {
    const bf16_t* Gact; bf16_t* Yssm; const float* b_glu;
    __device__ __forceinline__ void operator()(AccRef acc, const pg8::Unit& u, int wr, int wc, int fr, int fq) const {
        const int col0 = u.pn * 256 + wc * 32 + 8 * fq; const size_t rowb = (size_t)u.pm * 256;
        f32x4 bv[2][2]; u32x4 gv[8][2];
#pragma unroll
        for (int bj = 0; bj < 2; ++bj) { bv[bj][0] = *(const f32x4*)(b_glu + col0 + bj * 128); bv[bj][1] = *(const f32x4*)(b_glu + col0 + bj * 128 + 4); }
#pragma unroll
        for (int g = 0; g < 8; ++g) { EPI_G(g);
#pragma unroll
            for (int bj = 0; bj < 2; ++bj) gv[g][bj] = *(const u32x4*)(Gact + (rowb + rl) * DS + col0 + bj * 128); }
        EPI_SBAR;
#pragma unroll
        for (int g = 0; g < 8; ++g) { EPI_G(g);
#pragma unroll
            for (int bj = 0; bj < 2; ++bj) { f32x4 g0, g1; unpack8(gv[g][bj], g0, g1); const f32x4 a0 = acc[ai][bj][m][0], a1 = acc[ai][bj][m][1]; f32x4 y0, y1;
#pragma unroll
                for (int e = 0; e < 4; ++e) { y0[e] = g0[e] * fast_sigmoid(a0[e] + bv[bj][0][e]); y1[e] = g1[e] * fast_sigmoid(a1[e] + bv[bj][1][e]); }
                *(u32x4*)(Yssm + (rowb + rl) * DS + col0 + bj * 128) = pack8(y0, y1); } }
    }
};
template <bool SECOND> struct EpiUp {
    const bf16_t* SG; bf16_t* Mrg;
    __device__ __forceinline__ void operator()(AccRef acc, const pg8::Unit& u, int wr, int wc, int fr, int fq) const {
        const size_t base = (size_t)u.pm * 256 * D + u.pn * 256 + wc * 32 + 8 * fq;
        u32x4 sv[2][2][2], mv[2][2][2];
#define UP_LOAD(buf_, bt_) do { _Pragma("unroll") for (int gi_ = 0; gi_ < 2; ++gi_) { EPI_G(2 * (bt_) + gi_); _Pragma("unroll") for (int bj = 0; bj < 2; ++bj) { const size_t off = base + (size_t)rl * D + bj * 128; \
            sv[buf_][gi_][bj] = *(const u32x4*)(SG + off); if (SECOND) mv[buf_][gi_][bj] = *(const u32x4*)(Mrg + off); } } } while (0)
#define UP_PROC(buf_, bt_) do { _Pragma("unroll") for (int gi_ = 0; gi_ < 2; ++gi_) { EPI_G(2 * (bt_) + gi_); _Pragma("unroll") for (int bj = 0; bj < 2; ++bj) { const size_t off = base + (size_t)rl * D + bj * 128; \
            f32x4 s0, s1; unpack8(sv[buf_][gi_][bj], s0, s1); f32x4 y0 = s0 * acc[ai][bj][m][0], y1 = s1 * acc[ai][bj][m][1]; \
            if (SECOND) { f32x4 p0, p1; unpack8(mv[buf_][gi_][bj], p0, p1); y0 += p0; y1 += p1; } \
            *(u32x4*)(Mrg + off) = pack8(y0, y1); } } } while (0)
        UP_LOAD(0, 0); UP_LOAD(1, 1); EPI_SBAR;
        UP_PROC(0, 0); UP_LOAD(0, 2); EPI_SBAR;
        UP_PROC(1, 1); UP_LOAD(1, 3); EPI_SBAR;
        UP_PROC(0, 2); EPI_SBAR;
        UP_PROC(1, 3);
#undef UP_LOAD
#undef UP_PROC
    }
};
struct EpiOut {
    const float* x; bf16_t* X1; unsigned char* X18; float* SSQ;
    __device__ __forceinline__ void operator()(AccRef acc, const pg8::Unit& u, int wr, int wc, int fr, int fq) const {
        const int col0 = u.pn * 256 + wc * 32 + 8 * fq; const size_t base = (size_t)u.pm * 256 * D + col0;
        f32x4 xv[2][2][2][2];
#define OUT_LOAD(buf_, bt_) do { _Pragma("unroll") for (int gi_ = 0; gi_ < 2; ++gi_) { EPI_G(2 * (bt_) + gi_); _Pragma("unroll") for (int bj = 0; bj < 2; ++bj) { const size_t off = base + (size_t)rl * D + bj * 128; \
            xv[buf_][gi_][bj][0] = *(const f32x4*)(x + off); xv[buf_][gi_][bj][1] = *(const f32x4*)(x + off + 4); } } } while (0)
#define OUT_PROC(buf_, bt_) do { _Pragma("unroll") for (int gi_ = 0; gi_ < 2; ++gi_) { EPI_G(2 * (bt_) + gi_); float ss = 0.f; _Pragma("unroll") for (int bj = 0; bj < 2; ++bj) { const size_t off = base + (size_t)rl * D + bj * 128; \
            const f32x4 x0 = xv[buf_][gi_][bj][0] + acc[ai][bj][m][0], x1 = xv[buf_][gi_][bj][1] + acc[ai][bj][m][1]; \
            *(u32x4*)(X1 + off) = pack8(x0, x1); *(u32x2*)(X18 + off) = (u32x2){pk4_fp8(x0[0], x0[1], x0[2], x0[3]), pk4_fp8(x1[0], x1[1], x1[2], x1[3])}; \
            ss += (x0[0] * x0[0] + x0[1] * x0[1]) + (x0[2] * x0[2] + x0[3] * x0[3]) + (x1[0] * x1[0] + x1[1] * x1[1]) + (x1[2] * x1[2] + x1[3] * x1[3]); } \
            ss += __shfl_xor(ss, 16); ss += __shfl_xor(ss, 32); \
            SSQ[((size_t)u.pm * 256 + rl) * 16 + u.pn * 4 + wc] = ss; } } while (0)
        OUT_LOAD(0, 0); OUT_LOAD(1, 1); EPI_SBAR;
        OUT_PROC(0, 0); OUT_LOAD(0, 2); EPI_SBAR;
        OUT_PROC(1, 1); OUT_LOAD(1, 3); EPI_SBAR;
        OUT_PROC(0, 2); EPI_SBAR;
        OUT_PROC(1, 3);
#undef OUT_LOAD
#undef OUT_PROC
    }
};
struct EpiRouter {
    float* Rlog;
    __device__ __forceinline__ void operator()(AccRef acc, const pg8::Unit& u, int wr, int wc, int fr, int fq) const {
        EPI_LOOP_BEGIN
            if (bj == 0 && cl < 72) { float* dst = Rlog + (size_t)(u.pm * 256 + rl) * 72 + cl; *(f32x4*)dst = a0; *(f32x4*)(dst + 4) = a1; }
        EPI_LOOP_END
    }
};
struct EpiMoe1 {
    unsigned char* Hid; const float* rowrstd; const unsigned* ecnt; float ascale;
    __device__ __forceinline__ void operator()(AccRef acc, const pg8::Unit& u, int wr, int wc, int fr, int fq) const {
        const int e = u.aux, cnt = (int)ecnt[e]; float rsv[8];
#pragma unroll
        for (int g = 0; g < 8; ++g) { EPI_G(g); const int pos = u.aux2 + rl; rsv[g] = rowrstd[(size_t)e * ROWCAP + (pos < cnt ? pos : 0)] * ascale; }
        EPI_SBAR;
#pragma unroll
        for (int g = 0; g < 8; ++g) { EPI_G(g); const int pos = u.aux2 + rl;
            if (pos < cnt) { const float rs = rsv[g]; f32x4 h0, h1;
#pragma unroll
                for (int k = 0; k < 4; ++k) { const float p = acc[ai][0][m][0][k] * rs, q = acc[ai][1][m][0][k] * rs; h0[k] = p * fast_sigmoid(p) * q;
                    const float p2 = acc[ai][0][m][1][k] * rs, q2 = acc[ai][1][m][1][k] * rs; h1[k] = p2 * fast_sigmoid(p2) * q2; }
                *(u32x2*)(Hid + (size_t)(u.pm * 256 + rl) * DE + u.pn * 128 + wc * 32 + 8 * fq) = (u32x2){pk4_fp8(h0[0], h0[1], h0[2], h0[3]), pk4_fp8(h1[0], h1[1], h1[2], h1[3])}; } }
    }
};
struct EpiMoe2 {
    unsigned char* Y0; size_t ydelta; const unsigned* rowtok; const float* rowcoef; const unsigned* ecnt; float ascale;
    __device__ __forceinline__ void operator()(AccRef acc, const pg8::Unit& u, int wr, int wc, int fr, int fq) const {
        const int e = u.aux, cnt = (int)ecnt[e]; unsigned tkv[8]; float cfv[8];
#pragma unroll
        for (int g = 0; g < 8; ++g) { EPI_G(g); const int pos = u.aux2 + rl; const size_t ri = (size_t)e * ROWCAP + (pos < cnt ? pos : 0); tkv[g] = rowtok[ri]; cfv[g] = rowcoef[ri] * ascale; }
        EPI_SBAR;
#pragma unroll
        for (int g = 0; g < 8; ++g) { EPI_G(g); const int pos = u.aux2 + rl;
            if (pos < cnt) { const unsigned tk = tkv[g]; const float cf = cfv[g];
                unsigned char* dst = Y0 + (size_t)(tk & 1u) * ydelta + (size_t)(tk >> 1) * D + u.pn * 256 + wc * 32 + 8 * fq;
#pragma unroll
                for (int bj = 0; bj < 2; ++bj) { const f32x4 y0 = acc[ai][bj][m][0] * cf, y1 = acc[ai][bj][m][1] * cf; *(u32x2*)(dst + bj * 128) = (u32x2){pk4_fp8(y0[0], y0[1], y0[2], y0[3]), pk4_fp8(y1[0], y1[1], y1[2], y1[3])}; } } }
    }
};
__device__ __forceinline__ void transpose_item(const float* W, int N, int k0, int n0, bf16_t* WT, size_t drow0, int ldo, LAS float* scr, int lane) {
    float tv[32];
#pragma unroll
    for (int i = 0; i < 32; ++i) tv[i] = W[(size_t)(k0 + 2 * i + (lane >> 5)) * N + n0 + (lane & 31)];
#pragma unroll
    for (int i = 0; i < 32; ++i) scr[(2 * i + (lane >> 5)) * 33 + (lane & 31)] = tv[i];
    LDS_WAIT(); asm volatile("" ::: "memory");
    const int c = lane & 7;
#pragma unroll
    for (int j = 0; j < 4; ++j) { const int n = (lane >> 3) + 8 * j; const LAS float* s = scr + (8 * c) * 33 + n;
        u32x4 o; o.x = pk2(s[0 * 33], s[1 * 33]); o.y = pk2(s[2 * 33], s[3 * 33]); o.z = pk2(s[4 * 33], s[5 * 33]); o.w = pk2(s[6 * 33], s[7 * 33]);
        *(u32x4*)(WT + (drow0 + n) * (size_t)ldo + k0 + 8 * c) = o; }
    LDS_WAIT(); asm volatile("" ::: "memory");
}
__device__ __forceinline__ void transpose_item_f8(const float* W, int N, int k0, int n0, unsigned char* WT8, size_t drow0, int ldo, float scale, LAS float* scr, int lane, const float* kgain = nullptr  ) {
    float tv[32];
#pragma unroll
    for (int i = 0; i < 32; ++i) tv[i] = W[(size_t)(k0 + 2 * i + (lane >> 5)) * N + n0 + (lane & 31)];
#pragma unroll
    for (int i = 0; i < 32; ++i) scr[(2 * i + (lane >> 5)) * 33 + (lane & 31)] = tv[i] * (kgain ? scale * kgain[k0 + 2 * i + (lane >> 5)] : scale);
    LDS_WAIT(); asm volatile("" ::: "memory");
    const int c = lane & 3;
#pragma unroll
    for (int j = 0; j < 2; ++j) { const int n = (lane >> 2) + 16 * j; const LAS float* s = scr + (16 * c) * 33 + n;
        u32x4 o; o.x = pk4_fp8(s[0 * 33], s[1 * 33], s[2 * 33], s[3 * 33]); o.y = pk4_fp8(s[4 * 33], s[5 * 33], s[6 * 33], s[7 * 33]);
        o.z = pk4_fp8(s[8 * 33], s[9 * 33], s[10 * 33], s[11 * 33]); o.w = pk4_fp8(s[12 * 33], s[13 * 33], s[14 * 33], s[15 * 33]);
        *(u32x4*)(WT8 + (drow0 + n) * (size_t)ldo + k0 + 16 * c) = o; }
    LDS_WAIT(); asm volatile("" ::: "memory");
}
template <int NR> __device__ __forceinline__ void rms_rows_to_bf16(int lane, const float* xrow, const float* g, bf16_t* orow, unsigned char* orow8) {
    f32x4 v[NR][4]; float s[NR];
#pragma unroll
    for (int r = 0; r < NR; ++r) { const f32x4* xr = (const f32x4*)(xrow + (size_t)r * D) + lane;
#pragma unroll
        for (int j = 0; j < 4; ++j) v[r][j] = xr[64 * j]; }
    const f32x4* gr = (const f32x4*)g + lane; f32x4 wv[4];
#pragma unroll
    for (int j = 0; j < 4; ++j) wv[j] = gr[64 * j];
#pragma unroll
    for (int r = 0; r < NR; ++r) { float a = 0.f;
#pragma unroll
        for (int j = 0; j < 4; ++j) a += (v[r][j].x * v[r][j].x + v[r][j].y * v[r][j].y) + (v[r][j].z * v[r][j].z + v[r][j].w * v[r][j].w);
        s[r] = a; }
#pragma unroll
    for (int o = 1; o < 64; o <<= 1) {
#pragma unroll
        for (int r = 0; r < NR; ++r) s[r] += __shfl_xor(s[r], o); }
#pragma unroll
    for (int r = 0; r < NR; ++r) { const float rstd = 1.f / sqrtf(s[r] * (1.f / D) + RMS_EPS); unsigned long long* o8 = (unsigned long long*)(orow + (size_t)r * D) + lane;
#pragma unroll
        for (int j = 0; j < 4; ++j) { const float y0 = v[r][j].x * rstd * wv[j].x, y1 = v[r][j].y * rstd * wv[j].y, y2 = v[r][j].z * rstd * wv[j].z, y3 = v[r][j].w * rstd * wv[j].w;
            o8[64 * j] = (unsigned long long)pk2(y0, y1) | ((unsigned long long)pk2(y2, y3) << 32);
            ((unsigned*)(orow8 + (size_t)r * D))[lane + 64 * j] = pk4_fp8(y0, y1, y2, y3); } }
}
__device__ __forceinline__ void cpow(float lr, float li, float step, float dl, float& ar, float& ai) {
    const float mag = __expf(dl * lr * step); const float rev = dl * (li * step * 0.15915494309189535f); const float fr = rev - floorf(rev);
    ar = mag * __builtin_amdgcn_cosf(fr); ai = mag * __builtin_amdgcn_sinf(fr);
}
__device__ __forceinline__ void ssm_gen(Frame& F, int g, int sl) {
    LAS float* AP = (LAS float*)(F.lds); LAS float* BB = AP + 33 * 64 * 2; LAS float* CC = BB + 2048; LAS float* KT = CC + 2048;
    const float* lam_re = F.in[4] + g * SP; const float* lam_im = F.in[5] + g * SP; const float step = __expf(F.in[6][g]);
    const float* b_re = F.in[7] + g * SP * SHC; const float* b_im = F.in[8] + g * SP * SHC; const float* c_re = F.in[9] + g * SHC * SP; const float* c_im = F.in[10] + g * SHC * SP; const float* dd = F.in[11] + g * SHC;
    bf16_t* BT = (bf16_t*)(F.ws + WS_SSMT) + (size_t)g * 512 * SKY; bf16_t* BW = (bf16_t*)(F.ws + WS_SSMW) + (size_t)g * 256 * SKU;
    const int tid = F.tid;
    for (int idx = tid; idx < 33 * 64; idx += NTHR) { const int dl = idx >> 6, p = idx & 63; float ar, ai; cpow(lam_re[p], lam_im[p], step, (float)dl, ar, ai); AP[idx * 2] = ar; AP[idx * 2 + 1] = ai; }
    for (int idx = tid; idx < 1024; idx += NTHR) { const int ho = idx >> 6, p = idx & 63; CC[idx * 2] = c_re[ho * 64 + p]; CC[idx * 2 + 1] = c_im[ho * 64 + p]; }
    __syncthreads();
    for (int idx = tid; idx < 1024; idx += NTHR) { const int p = idx >> 4, h = idx & 15; const float ar = AP[(64 + p) * 2], ai = AP[(64 + p) * 2 + 1];
        const float lr = lam_re[p], li = lam_im[p], nr = ar - 1.f, ni = ai, den = lr * lr + li * li, cr = (nr * lr + ni * li) / den, ci = (ni * lr - nr * li) / den;
        const float br = b_re[p * 16 + h], bi = b_im[p * 16 + h]; BB[idx * 2] = cr * br - ci * bi; BB[idx * 2 + 1] = cr * bi + ci * br; }
    __syncthreads();
    for (int idx = tid; idx < 1024; idx += NTHR) { const int dl = idx >> 5, hl = (idx >> 4) & 1, hi = idx & 15, ho = 2 * sl + hl; float s = 0.f;
        for (int p = 0; p < 64; ++p) { const float ar = AP[(dl * 64 + p) * 2], ai = AP[(dl * 64 + p) * 2 + 1], br = BB[(p * 16 + hi) * 2], bi = BB[(p * 16 + hi) * 2 + 1];
            const float zr = ar * br - ai * bi, zi = ar * bi + ai * br; s += CC[(ho * 64 + p) * 2] * zr - CC[(ho * 64 + p) * 2 + 1] * zi; }
        if (dl == 0 && ho == hi) s += dd[ho];
        KT[idx] = s; }
    __syncthreads();
    for (int v = tid; v < 64 * 80; v += NTHR) { const int nl = v / 80, kv = (v % 80) * 8, tau = nl >> 1, hl = nl & 1, ho = 2 * sl + hl, n = tau * 16 + ho; float val[8];
        if (kv < 512) { const int sg = kv >> 4, hi0 = kv & 15;
#pragma unroll
            for (int e = 0; e < 8; ++e) val[e] = (tau >= sg) ? KT[((tau - sg) * 2 + hl) * 16 + hi0 + e] : 0.f; }
        else { const int kk = kv - 512;
#pragma unroll
            for (int e = 0; e < 8; ++e) { const int p = (kk + e) >> 1, ri = (kk + e) & 1; const float ar = AP[((tau + 1) * 64 + p) * 2], ai = AP[((tau + 1) * 64 + p) * 2 + 1], cre = CC[(ho * 64 + p) * 2], cim = CC[(ho * 64 + p) * 2 + 1];
                val[e] = ri == 0 ? (cre * ar - cim * ai) : -(cre * ai + cim * ar); } }
        u32x4 o; o.x = pk2(val[0], val[1]); o.y = pk2(val[2], val[3]); o.z = pk2(val[4], val[5]); o.w = pk2(val[6], val[7]);
        *(u32x4*)(BT + (size_t)n * SKY + kv) = o; }
    for (int v = tid; v < 32 * 64; v += NTHR) { const int nl = v >> 6, kv = (v & 63) * 8; float val[8];
        const bool real = nl < 16; const int n = real ? 16 * sl + nl : 128 + 16 * sl + (nl - 16);
        if (real) { const int p = n >> 1, ri = n & 1, sg = kv >> 4, hi0 = kv & 15; const float ar = AP[((31 - sg) * 64 + p) * 2], ai = AP[((31 - sg) * 64 + p) * 2 + 1];
#pragma unroll
            for (int e = 0; e < 8; ++e) { const float br = BB[(p * 16 + hi0 + e) * 2], bi = BB[(p * 16 + hi0 + e) * 2 + 1]; val[e] = ri == 0 ? (ar * br - ai * bi) : (ar * bi + ai * br); } }
        else {
#pragma unroll
            for (int e = 0; e < 8; ++e) val[e] = 0.f; }
        u32x4 o; o.x = pk2(val[0], val[1]); o.y = pk2(val[2], val[3]); o.z = pk2(val[4], val[5]); o.w = pk2(val[6], val[7]);
        *(u32x4*)(BW + (size_t)n * SKU + kv) = o; }
    __syncthreads();
}
__device__ __forceinline__ void p0_prologue(Frame& F) {
    for (int it = F.vcu; it < SG * 8; it += F.G) ssm_gen(F, it >> 3, it & 7);
    LAS float* scr = (LAS float*)(F.lds + F.wave * 16384);
    const int gw = F.vcu * NWAVES + F.wave, NGW = F.G * NWAVES, lane = F.lane;
    constexpr int I_IN = 16 * 128, I_GLU = 8 * 16, I_US = 8 * 32, I_UA = 8 * 32, I_OUT = 16 * 32, I_W1 = 32 * 256, I_W3 = 32 * 256, I_W2 = 32 * 256;
    constexpr int NITEMS = I_IN + I_GLU + I_US + I_UA + I_OUT + I_W1 + I_W3 + I_W2;
    unsigned char* ws = F.ws;
    for (int it = gw; it < NITEMS; it += NGW) {
        int r = it;
        if (r < I_IN) { const int k0 = 64 * (r / 128), n0 = 32 * (r % 128);
            if (n0 < DS) transpose_item(F.in[2], DIN, k0, n0, (bf16_t*)(ws + WS_WIN), n0, D, scr, lane);
            else transpose_item_f8(F.in[2], DIN, k0, n0, ws + WS_WINF8, n0 - DS, D, WF8_SCALE, scr, lane);
            continue; } r -= I_IN;
        if (r < I_GLU) { transpose_item(F.in[12], DS, 64 * (r / 16), 32 * (r % 16), (bf16_t*)(ws + WS_WGLU), 32 * (r % 16), DS, scr, lane); continue; } r -= I_GLU;
        if (r < I_US) { transpose_item(F.in[14], D, 64 * (r / 32), 32 * (r % 32), (bf16_t*)(ws + WS_WUS), 32 * (r % 32), DS, scr, lane); continue; } r -= I_US;
        if (r < I_UA) { transpose_item(F.in[15], D, 64 * (r / 32), 32 * (r % 32), (bf16_t*)(ws + WS_WUA), 32 * (r % 32), DA, scr, lane); continue; } r -= I_UA;
        if (r < I_OUT) { transpose_item(F.in[17], D, 64 * (r / 32), 32 * (r % 32), (bf16_t*)(ws + WS_WOUT), 32 * (r % 32), D, scr, lane); continue; } r -= I_OUT;
        if (r < I_W1 + I_W3) { const int w3 = r >= I_W1; if (w3) r -= I_W1; const int e = r >> 8, q = r & 255, k0 = 64 * (q / 16), n0 = 32 * (q % 16);
            transpose_item_f8((w3 ? F.in[24] : F.in[23]) + (size_t)e * D * DE, DE, k0, n0, ws + WS_W13, (size_t)e * 1024 + 256 * (n0 >> 7) + (n0 & 127) + (w3 ? 128 : 0), D, WF8_SCALE, scr, lane, F.in[18]); continue; }
        r -= I_W1 + I_W3;
        { const int e = r >> 8, q = r & 255, k0 = 64 * (q / 32), n0 = 32 * (q % 32);
            transpose_item_f8(F.in[25] + (size_t)e * DE * D, D, k0, n0, ws + WS_W2, (size_t)e * 1024 + n0, DE, WF8_SCALE, scr, lane); }
    }
    for (int m = 4 * gw; m < T; m += 4 * NGW) rms_rows_to_bf16<4>(lane, F.in[0] + (size_t)m * D, F.in[1], (bf16_t*)(ws + WS_H1) + (size_t)m * D, ws + WS_H1F8 + (size_t)m * D);
    { bf16_t* WR = (bf16_t*)(ws + WS_WR); const float* wrg = F.in[19]; const float* wre = F.in[21];
      for (int idx = F.vcu * NTHR + F.tid; idx < 256 * D; idx += F.G * NTHR) { const int r = idx >> 10, k = idx & 1023; unsigned o = 0u;
          if (r < 72) { const int c = r < 36 ? r : r - 36; const float w = (c < 4 ? wrg[k * 4 + c] : wre[k * 32 + (c - 4)]) * F.in[18][k]; const unsigned hb = f2bf(w);
              o = r < 36 ? hb : f2bf(w - __builtin_bit_cast(float, hb << 16)); }
          WR[idx] = (bf16_t)o; } }
}

__device__ __forceinline__ int crow(int r, int hi) { return (r & 3) + 8 * (r >> 2) + 4 * hi; }
constexpr int KVP = 72;
__device__ __forceinline__ void kv_prep_phase(Frame& F) {
    LAS bf16_t* KS = (LAS bf16_t*)(F.lds); LAS bf16_t* VS = KS + 256 * KVP; LAS float* PS = (LAS float*)(F.lds + 2 * 256 * KVP * 2); LAS float* WM = PS + 512;
    const bf16_t* Kb = (const bf16_t*)(F.ws + WS_K); const bf16_t* Vb = (const bf16_t*)(F.ws + WS_V);
    bf16_t* Kf = (bf16_t*)(F.ws + WS_KFRAG); bf16_t* Vf = (bf16_t*)(F.ws + WS_VFRAG); bf16_t* KM = (bf16_t*)(F.ws + WS_KMEAN); float* KN = (float*)(F.ws + WS_KMEAN + 512 * 1024);
    const int tid = F.tid;
    u32x4 kr[4], vr[4];
#define KVP_LOAD(item_) do { const int n_ = (item_) & 31, h_ = ((item_) >> 5) & 7, b_ = (item_) >> 8; const size_t tok0_ = (size_t)b_ * SEQ + 256 * n_; \
        _Pragma("unroll") for (int j = 0; j < 4; ++j) { const int q = tid + NTHR * j, row = q >> 3, pc = q & 7; const size_t src = (tok0_ + row) * DA + h_ * HD + pc * 8; kr[j] = *(const u32x4*)(Kb + src); vr[j] = *(const u32x4*)(Vb + src); } } while (0)
    if (F.vcu < BATCH * NH * NBLK) KVP_LOAD(F.vcu);
    for (int item = F.vcu; item < BATCH * NH * NBLK; item += F.G) {
#pragma unroll
        for (int j = 0; j < 4; ++j) { const int q = tid + NTHR * j, row = q >> 3, pc = q & 7; *(LAS u32x4*)(KS + row * KVP + pc * 8) = kr[j]; *(LAS u32x4*)(VS + row * KVP + pc * 8) = vr[j]; }
        { const int nx = (item + F.G < BATCH * NH * NBLK) ? item + F.G : item; KVP_LOAD(nx); }
        __syncthreads();
#pragma unroll
        for (int j = 0; j < 4; ++j) { const int P = tid + NTHR * j, st = P >> 8, ds = (P >> 6) & 3, l2 = P & 63, row = 32 * st + (l2 & 31), col = 16 * ds + 8 * (l2 >> 5);
            *(u32x4*)(Kf + ((size_t)item * 2048 + P) * 8) = *(const LAS u32x4*)(KS + row * KVP + col); }
#pragma unroll
        for (int j = 0; j < 4; ++j) { const int P = tid + NTHR * j, st = P >> 8, ks = (P >> 7) & 1, d0 = (P >> 6) & 1, l2 = P & 63, hi = l2 >> 5, jj = l2 & 31; unsigned w[4];
#pragma unroll
            for (int e = 0; e < 8; e += 2) { const unsigned lo = VS[(32 * st + 16 * ks + crow(e, hi)) * KVP + 32 * d0 + jj], hi16 = VS[(32 * st + 16 * ks + crow(e + 1, hi)) * KVP + 32 * d0 + jj]; w[e >> 1] = lo | (hi16 << 16); }
            *(u32x4*)(Vf + ((size_t)item * 2048 + P) * 8) = (u32x4){w[0], w[1], w[2], w[3]}; }
        { const int d = tid & 63, part = tid >> 6; float s = 0.f;
#pragma unroll 8
          for (int r = 0; r < 32; ++r) s += bf2f(KS[(part * 32 + r) * KVP + d]);
          PS[part * 64 + d] = s; }
        if (tid < 256) { float ss = 0.f;
#pragma unroll
            for (int c = 0; c < 8; ++c) { const u32x4 w = *(const LAS u32x4*)(KS + tid * KVP + c * 8);
                ss += bflo(w.x) * bflo(w.x) + bfhi(w.x) * bfhi(w.x) + bflo(w.y) * bflo(w.y) + bfhi(w.y) * bfhi(w.y) + bflo(w.z) * bflo(w.z) + bfhi(w.z) * bfhi(w.z) + bflo(w.w) * bflo(w.w) + bfhi(w.w) * bfhi(w.w); }
            ss = wave_max(ss); if (F.lane == 0) WM[F.wave] = ss; }
        __syncthreads();
        if (tid < 64) { float s = 0.f;
#pragma unroll
            for (int p = 0; p < 8; ++p) s += PS[p * 64 + tid];
            KM[(size_t)item * 64 + tid] = (bf16_t)f2bf(s * (1.f / 256.f)); }
        if (tid == 0) KN[item] = fmaxf(fmaxf(WM[0], WM[1]), fmaxf(WM[2], WM[3]));
        __syncthreads();
    }
#undef KVP_LOAD
}

__device__ __forceinline__ void ssm_scan_phase(Frame& F) {
    LAS float* FW = (LAS float*)(F.lds);
    const float* E = (const float*)(F.ws + WS_E); bf16_t* UP = (bf16_t*)(F.ws + WS_UP);
    const int w = F.wave, p = F.lane;
    for (int gb = F.vcu; gb < SG * BATCH; gb += F.G) {
        const int g = gb >> 3, b = gb & 7;
        const float lr = F.in[4][g * SP + p], li = F.in[5][g * SP + p], step = __expf(F.in[6][g]);
        float ar, ai; cpow(lr, li, step, 32.f, ar, ai);
        const size_t row0 = (size_t)g * SROWS + b * 256 + 32 * w;
        f32x2 e[32];
#pragma unroll
        for (int j = 0; j < 32; ++j) e[j] = *(const f32x2*)(E + (row0 + j) * 128 + 2 * p);
        float sr = 0.f, si = 0.f;
#pragma unroll
        for (int j = 0; j < 32; ++j) { const float nr = ar * sr - ai * si + e[j].x, ni = ar * si + ai * sr + e[j].y; sr = nr; si = ni; }
        FW[(w * 64 + p) * 2] = sr; FW[(w * 64 + p) * 2 + 1] = si;
        __syncthreads();
        float Ar = ar, Ai = ai;
#pragma unroll
        for (int q = 0; q < 5; ++q) { const float nr = Ar * Ar - Ai * Ai, ni = 2.f * Ar * Ai; Ar = nr; Ai = ni; }
        sr = 0.f; si = 0.f;
        for (int w2 = 0; w2 < w; ++w2) { const float fr = FW[(w2 * 64 + p) * 2], fi = FW[(w2 * 64 + p) * 2 + 1]; const float nr = Ar * sr - Ai * si + fr, ni = Ar * si + Ai * sr + fi; sr = nr; si = ni; }
#pragma unroll
        for (int j = 0; j < 32; ++j) { *(unsigned*)(UP + (row0 + j) * SKY + SKU + 2 * p) = pk2(sr, si);
            const float nr = ar * sr - ai * si + e[j].x, ni = ar * si + ai * sr + e[j].y; sr = nr; si = ni; }
        __syncthreads();
    }
}

__device__ __forceinline__ int t5_bucket(int d) {
    if (d < 16) return d;
    return 16 + (d >= 19) + (d >= 21) + (d >= 24) + (d >= 27) + (d >= 31) + (d >= 35) + (d >= 40) + (d >= 46) + (d >= 52) + (d >= 59) + (d >= 67) + (d >= 77) + (d >= 87) + (d >= 99) + (d >= 113);
}
struct Top3 { float v0, v1, v2; int i0, i1, i2; };
__device__ __forceinline__ Top3 top3_insert(Top3 t, float x, int n) {
    const bool b0 = (x > t.v0) || (x == t.v0 && n < t.i0), b1 = (x > t.v1) || (x == t.v1 && n < t.i1), b2 = (x > t.v2) || (x == t.v2 && n < t.i2);
    Top3 r;
    r.v2 = b1 ? t.v1 : (b2 ? x : t.v2); r.i2 = b1 ? t.i1 : (b2 ? n : t.i2);
    r.v1 = b0 ? t.v0 : (b1 ? x : t.v1); r.i1 = b0 ? t.i0 : (b1 ? n : t.i1);
    r.v0 = b0 ? x : t.v0; r.i0 = b0 ? n : t.i0;
    return r;
}
constexpr int GQS = 0, GKME = 36864, GCNTL = 41472, GMISC = 41600;
template <bool COUNT> __device__ __forceinline__ void attn_gate_unit(Frame& F, int bh, int qb) {
    LAS unsigned char* L = F.lds;
    LAS bf16_t* QS = (LAS bf16_t*)(L + GQS); LAS bf16_t* KME = (LAS bf16_t*)(L + GKME); LAS int* CNT = (LAS int*)(L + GCNTL); LAS float* KNM = (LAS float*)(L + GMISC);
    int tid = F.tid; asm volatile("" : "+v"(tid));
    const int lane = tid & 63, w = F.wave, j = lane & 31, hi = lane >> 5;
    const int b = bh >> 3, h = bh & 7; const size_t tok0 = (size_t)b * SEQ + 256 * qb;
    const bf16_t* Qb = (const bf16_t*)(F.ws + WS_Q); const bf16_t* KM = (const bf16_t*)(F.ws + WS_KMEAN); const float* KN = (const float*)(F.ws + WS_KMEAN + 512 * 1024);
    float* MQg = (float*)(F.ws + WS_MQ); unsigned short* QL = (unsigned short*)(F.ws + WS_QLIST); unsigned* GC = (unsigned*)(F.ctl + CW_GCNT); unsigned* SEGC = (unsigned*)(F.ws + WS_SEGC);
#pragma unroll
    for (int jj = 0; jj < 4; ++jj) { const int q = tid + NTHR * jj, row = q >> 3, pc = q & 7; *(LAS u32x4*)(QS + row * KVP + pc * 8) = *(const u32x4*)(Qb + (tok0 + row) * DA + h * HD + pc * 8); }
    if (tid < 256) { const int n = tid >> 3, pc = tid & 7; *(LAS u32x4*)(KME + n * KVP + pc * 8) = *(const u32x4*)(KM + ((size_t)bh * 32 + n) * 64 + pc * 8); }
    if (tid < 32) CNT[tid] = 0;
    if (w == 1) { float v = (lane <= qb && lane < 32) ? KN[bh * 32 + lane] : 0.f; v = wave_max(v); if (lane == 0) KNM[0] = v; }
    if (w == 2) { float v = F.in[16][h * 32 + (lane & 31)]; v = wave_max(v); if (lane == 0) KNM[1] = v * LOG2E; }
    __syncthreads();
    {
        bf16x8 qf[4], kmf[4];
#pragma unroll
        for (int ds = 0; ds < 4; ++ds) { qf[ds] = *(const LAS bf16x8*)(QS + (32 * w + j) * KVP + 16 * ds + 8 * hi); kmf[ds] = *(const LAS bf16x8*)(KME + j * KVP + 16 * ds + 8 * hi); }
        f32x16 gt = {};
#pragma unroll
        for (int ds = 0; ds < 4; ++ds) gt = __builtin_amdgcn_mfma_f32_32x32x16_bf16(kmf[ds], qf[ds], gt, 0, 0, 0);
        float qn = 0.f;
#pragma unroll
        for (int ds = 0; ds < 4; ++ds)
#pragma unroll
            for (int e = 0; e < 8; ++e) { const float x = bf2f((unsigned short)qf[ds][e]); qn += x * x; }
        qn += __shfl_xor(qn, 32);
        const float m2 = sqrtf(qn * KNM[0]) + KNM[1];
        const int ql = 256 * qb + 32 * w + j;
        if (hi == 0) MQg[(size_t)bh * SEQ + ql] = m2;
        Top3 t3; t3.v0 = t3.v1 = t3.v2 = -INFINITY; t3.i0 = t3.i1 = t3.i2 = -1;
#pragma unroll
        for (int r = 0; r < 16; ++r) { const int n = crow(r, hi); const float x = (n < qb) ? gt[r] : -INFINITY; t3 = top3_insert(t3, x, x > -INFINITY ? n : 0x7fffffff); }
        { const float p0 = __shfl_xor(t3.v0, 32), p1 = __shfl_xor(t3.v1, 32), p2 = __shfl_xor(t3.v2, 32); const int q0 = __shfl_xor(t3.i0, 32), q1 = __shfl_xor(t3.i1, 32), q2 = __shfl_xor(t3.i2, 32);
          t3 = top3_insert(t3, p0, q0 >= 0 ? q0 : 0x7fffffff); t3 = top3_insert(t3, p1, q1 >= 0 ? q1 : 0x7fffffff); t3 = top3_insert(t3, p2, q2 >= 0 ? q2 : 0x7fffffff); }
        const int i0 = t3.v0 > -INFINITY ? t3.i0 : -1, i1 = t3.v1 > -INFINITY ? t3.i1 : -1, i2 = t3.v2 > -INFINITY ? t3.i2 : -1;
        if (hi == 0) { const unsigned e = (unsigned)ql << 2;
            if (i0 >= 0) { const int pos = __hip_atomic_fetch_add(CNT + i0, 1, __ATOMIC_RELAXED, __HIP_MEMORY_SCOPE_WORKGROUP); QL[((size_t)bh * 32 + i0) * SEQ + (qb - i0 - 1) * 256 + pos] = (unsigned short)(e | 0u); }
            if (i1 >= 0) { const int pos = __hip_atomic_fetch_add(CNT + i1, 1, __ATOMIC_RELAXED, __HIP_MEMORY_SCOPE_WORKGROUP); QL[((size_t)bh * 32 + i1) * SEQ + (qb - i1 - 1) * 256 + pos] = (unsigned short)(e | 1u); }
            if (i2 >= 0) { const int pos = __hip_atomic_fetch_add(CNT + i2, 1, __ATOMIC_RELAXED, __HIP_MEMORY_SCOPE_WORKGROUP); QL[((size_t)bh * 32 + i2) * SEQ + (qb - i2 - 1) * 256 + pos] = (unsigned short)(e | 2u); } }
    }
    __syncthreads();
    if (tid < qb) { const unsigned c = (unsigned)CNT[tid]; SEGC[((size_t)bh * 32 + tid) * 32 + (qb - tid - 1)] = c; if (COUNT && c) (void)__hip_atomic_fetch_add(GC + bh * 32 + tid, c, __ATOMIC_RELAXED, __HIP_MEMORY_SCOPE_AGENT); }
    __syncthreads();
}
template <bool COUNT> __device__ __forceinline__ void attn_gate_phase(Frame& F) {
    for (int u = F.vcu; u < BATCH * NH * NBLK; u += F.G) attn_gate_unit<COUNT>(F, u >> 5, u & 31);
}

#define ATTN_SUBTILE(KP, VP, st_, MODE, CINIT) do { \
        bf16x8 kf_[4], vf_[4]; \
        _Pragma("unroll") for (int ds_ = 0; ds_ < 4; ++ds_) kf_[ds_] = *(const LAS bf16x8*)((KP) + ((st_) * 4 + ds_) * 512 + lane8); \
        _Pragma("unroll") for (int q_ = 0; q_ < 4; ++q_) vf_[q_] = *(const LAS bf16x8*)((VP) + ((st_) * 4 + q_) * 512 + lane8); \
        f32x16 s_ = __builtin_amdgcn_mfma_f32_32x32x16_bf16(kf_[0], qf[0], CINIT, 0, 0, 0); \
        _Pragma("unroll") for (int ds_ = 1; ds_ < 4; ++ds_) s_ = __builtin_amdgcn_mfma_f32_32x32x16_bf16(kf_[ds_], qf[ds_], s_, 0, 0, 0); \
        float p_[16]; \
        if ((MODE) == 0) { _Pragma("unroll") for (int r_ = 0; r_ < 16; ++r_) p_[r_] = __builtin_amdgcn_exp2f(s_[r_]); } \
        else if ((MODE) == 1) { _Pragma("unroll") for (int r_ = 0; r_ < 16; ++r_) { const int dist_ = dq - (32 * (st_) + crow(r_, hi)); const int di_ = dist_ < 0 ? 0 : (dist_ > 127 ? 127 : dist_); \
                p_[r_] = __builtin_amdgcn_exp2f(s_[r_] + TABh[di_]); } } \
        else { _Pragma("unroll") for (int rq_ = 0; rq_ < 4; ++rq_) { const f32x4 bb_ = *(const LAS f32x4*)(BTD + rq_ * 256 + lane * 4); \
                _Pragma("unroll") for (int i_ = 0; i_ < 4; ++i_) p_[4 * rq_ + i_] = __builtin_amdgcn_exp2f(s_[4 * rq_ + i_] + bb_[i_]); } } \
        _Pragma("unroll") for (int r_ = 0; r_ < 16; ++r_) lsum += p_[r_]; \
        u32x4 pa_, pb_; pa_.x = cvt_pk_bf16(p_[0], p_[1]); pa_.y = cvt_pk_bf16(p_[2], p_[3]); pa_.z = cvt_pk_bf16(p_[4], p_[5]); pa_.w = cvt_pk_bf16(p_[6], p_[7]); \
        pb_.x = cvt_pk_bf16(p_[8], p_[9]); pb_.y = cvt_pk_bf16(p_[10], p_[11]); pb_.z = cvt_pk_bf16(p_[12], p_[13]); pb_.w = cvt_pk_bf16(p_[14], p_[15]); \
        const bf16x8 A0_ = __builtin_bit_cast(bf16x8, pa_), A1_ = __builtin_bit_cast(bf16x8, pb_); \
        o0 = __builtin_amdgcn_mfma_f32_32x32x16_bf16(vf_[0], A0_, o0, 0, 0, 0); o1 = __builtin_amdgcn_mfma_f32_32x32x16_bf16(vf_[1], A0_, o1, 0, 0, 0); \
        o0 = __builtin_amdgcn_mfma_f32_32x32x16_bf16(vf_[2], A1_, o0, 0, 0, 0); o1 = __builtin_amdgcn_mfma_f32_32x32x16_bf16(vf_[3], A1_, o1, 0, 0, 0); } while (0)

__device__ __forceinline__ u32x4 ot_pack16(const f32x16& o, int pr) {
    const unsigned p0 = cvt_pk_bf16(o[8 * pr], o[8 * pr + 1]), p1 = cvt_pk_bf16(o[8 * pr + 2], o[8 * pr + 3]), q0 = cvt_pk_bf16(o[8 * pr + 4], o[8 * pr + 5]), q1 = cvt_pk_bf16(o[8 * pr + 6], o[8 * pr + 7]);
    const auto r0 = __builtin_amdgcn_permlane32_swap(p0, q0, false, false); const auto r1 = __builtin_amdgcn_permlane32_swap(p1, q1, false, false);
    return (u32x4){r0[0], r1[0], r0[1], r1[1]};
}
__device__ __forceinline__ void ot_add16(f32x16& o, int pr, u32x4 v, bool use) {
    const auto r0 = __builtin_amdgcn_permlane32_swap(v.x, v.z, false, false); const auto r1 = __builtin_amdgcn_permlane32_swap(v.y, v.w, false, false);
    const unsigned p0 = r0[0], p1 = r1[0], q0 = r0[1], q1 = r1[1];
    o[8 * pr] += use ? bflo(p0) : 0.f; o[8 * pr + 1] += use ? bfhi(p0) : 0.f; o[8 * pr + 2] += use ? bflo(p1) : 0.f; o[8 * pr + 3] += use ? bfhi(p1) : 0.f;
    o[8 * pr + 4] += use ? bflo(q0) : 0.f; o[8 * pr + 5] += use ? bfhi(q0) : 0.f; o[8 * pr + 6] += use ? bflo(q1) : 0.f; o[8 * pr + 7] += use ? bfhi(q1) : 0.f;
}
__device__ __forceinline__ void attn_fill_tab(Frame& F, LAS float* TAB) {
    const float* rb = F.in[16];
    for (int idx = F.tid; idx < 8 * 132; idx += NTHR) { const int h = idx / 132, d = idx % 132; float v = 0.f;
        if (d < 128) v = rb[h * 32 + t5_bucket(d)] * LOG2E; else if (d == 129) v = rb[h * 32 + 31] * LOG2E;
        TAB[idx] = v; }
}
constexpr int BGPRE_OFF = ROWTAB_OFF, BGCL_OFF = ROWTAB_OFF + 8448, BTAB_OFF = ROWTAB_OFF + 16640, BIT_OFF = ROWTAB_OFF + 20992, BIT_MAX = 512, OTAB_OFF = ROWTAB_OFF + 20480  ;
static_assert(BTAB_OFF + 8 * 132 * 4 <= MOE_TST_OFF, "attention LDS tables");
__device__ __forceinline__ size_t part_off(int slot) { return slot == 0 ? WS_PART0 : (slot == 1 ? WS_PART1 : WS_PART2); }

__device__ __forceinline__ void attn_block_phase(Frame& F) {
    LAS unsigned char* L = F.lds; LAS int* GPRE = (LAS int*)(L + BGPRE_OFF); LAS int* GCL = (LAS int*)(L + BGCL_OFF); LAS float* TAB = (LAS float*)(L + BTAB_OFF); LAS int* ITT = (LAS int*)(L + BIT_OFF); LAS int* WSUM = (LAS int*)(L + MOE_TST_OFF);
    const unsigned* GC = (const unsigned*)(F.ctl + CW_GCNT); const unsigned* SEGC = (const unsigned*)(F.ws + WS_SEGC);
    const int tid = F.tid, lane = F.lane, w = F.wave, j = lane & 31, hi = lane >> 5, lane8 = lane * 8;
    { int ng[4], tot = 0;
#pragma unroll
      for (int e = 0; e < 4; ++e) { const int c = (int)GC[4 * tid + e]; GCL[4 * tid + e] = c; ng[e] = (((c + 31) >> 5) + 7) >> 3; tot += ng[e]; }
      int inc = tot;
#pragma unroll
      for (int o = 1; o < 64; o <<= 1) { const int t = __shfl_up(inc, o); if (lane >= o) inc += t; }
      if (lane == 63) WSUM[w] = inc;
      __syncthreads();
      int woff = 0;
      for (int q = 0; q < w; ++q) woff += WSUM[q];
      int ex = woff + inc - tot;
#pragma unroll
      for (int e = 0; e < 4; ++e) { GPRE[4 * tid + e] = ex; ex += ng[e]; }
      if (tid == NTHR - 1) GPRE[2048] = ex; }
    attn_fill_tab(F, TAB);
    __syncthreads();
    const int NIT = GPRE[2048];
    const int nk = (NIT > F.vcu) ? (NIT - F.vcu + F.G - 1) / F.G : 0;
    if (tid < nk && tid < BIT_MAX) { const int it_ = F.vcu + tid * F.G; int lo_ = 0, hi_ = 2048; while (hi_ - lo_ > 1) { const int mid_ = (lo_ + hi_) >> 1; if (GPRE[mid_] <= it_) lo_ = mid_; else hi_ = mid_; } ITT[tid] = lo_ * 64 + (it_ - GPRE[lo_]); }
    __syncthreads();
    if (nk == 0) return;
    const int nkc = nk < BIT_MAX ? nk : BIT_MAX;
    const bf16_t* Qb = (const bf16_t*)(F.ws + WS_Q); const float* MQg = (const float*)(F.ws + WS_MQ); const unsigned short* QL = (const unsigned short*)(F.ws + WS_QLIST);
    const bf16_t* KF = (const bf16_t*)(F.ws + WS_KFRAG); const bf16_t* VF = (const bf16_t*)(F.ws + WS_VFRAG);
    float* PL = (float*)(F.ws + WS_PL);
#define BLK_ITEM(k_, pi_, g_) do { const int kk_ = (k_) < nkc ? (k_) : nkc - 1; const int v_ = __builtin_amdgcn_readfirstlane(ITT[kk_]); pi_ = v_ >> 6; g_ = v_ & 63; } while (0)
#define BLK_DMA(buf_, pi_) do { const char* ks_ = (const char*)KF + ((size_t)(pi_) * 2048 + tid) * 16; const char* vs_ = (const char*)VF + ((size_t)(pi_) * 2048 + tid) * 16; \
        _Pragma("unroll") for (int i_ = 0; i_ < 4; ++i_) { \
            __builtin_amdgcn_global_load_lds((const unsigned*)(ks_ + i_ * 8192), (LAS unsigned*)(L + (buf_) + (i_ * 512 + w * 64) * 16), 16, 0, 0); \
            __builtin_amdgcn_global_load_lds((const unsigned*)(vs_ + i_ * 8192), (LAS unsigned*)(L + (buf_) + 32768 + (i_ * 512 + w * 64) * 16), 16, 0, 0); } } while (0)
#define BLK_SEGC(dst_, pi_) do { dst_ = SEGC[(size_t)(pi_) * 32 + j]; } while (0)
#define BLK_ENTRY(dst_, segc_, pi_, g_) do { const int n_ = (pi_) & 31; int inc_ = (j < 31 - n_) ? (int)(segc_) : 0; \
        _Pragma("unroll") for (int o_ = 1; o_ < 32; o_ <<= 1) { const int t_ = __shfl_up(inc_, o_); if (j >= o_) inc_ += t_; } \
        const int cnt_ = GCL[pi_]; const int idx_ = 32 * (8 * (g_) + w) + j; int seg_ = 0, prev_ = 0; \
        for (int s_ = 0; s_ < 31 - n_; ++s_) { const int p_ = __builtin_amdgcn_readlane(inc_, s_); const bool le_ = p_ <= idx_; seg_ += le_ ? 1 : 0; prev_ = le_ ? p_ : prev_; } \
        const bool ok_ = idx_ < cnt_; const unsigned v_ = QL[(size_t)(pi_) * SEQ + (ok_ ? seg_ * 256 + (idx_ - prev_) : 0)]; dst_ = ok_ ? v_ : 0xFFFFu; } while (0)
#define BLK_QLOAD(qf_, m2_, ent_, pi_) do { const unsigned qq_ = ((ent_) == 0xFFFFu) ? 0u : ((ent_) >> 2); const int bh_ = (pi_) >> 5; \
        const bf16_t* qrow_ = Qb + ((size_t)(bh_ >> 3) * SEQ + qq_) * DA + (bh_ & 7) * HD + 8 * hi; \
        _Pragma("unroll") for (int ds_ = 0; ds_ < 4; ++ds_) qf_[ds_] = *(const bf16x8*)(qrow_ + 16 * ds_); \
        m2_ = MQg[(size_t)bh_ * SEQ + qq_]; } while (0)
    int pi, g, pi1, g1, pi2, g2; unsigned ent, ent1, sc2; bf16x8 qf[4]; float m2r;
    BLK_ITEM(0, pi, g); BLK_ITEM(1, pi1, g1); BLK_ITEM(2, pi2, g2);
    BLK_DMA(0, pi);
    { unsigned sc0, sc1; BLK_SEGC(sc0, pi); BLK_SEGC(sc1, pi1); BLK_SEGC(sc2, pi2); BLK_ENTRY(ent, sc0, pi, g); BLK_ENTRY(ent1, sc1, pi1, g1); }
    BLK_QLOAD(qf, m2r, ent, pi);
    int cur = 0;
    __builtin_amdgcn_s_waitcnt(0x0F70);
    unsigned char* dump = F.ws + WS_E + ((size_t)F.vcu * NTHR + tid) * 128;
    for (int k = 0; k < nkc; ++k) {
        __builtin_amdgcn_s_waitcnt(0x0F75);
        __syncthreads();
        int pi3, g3; unsigned sc3, ent2; bf16x8 qfn[4]; float m2n;
        BLK_ITEM(k + 3, pi3, g3); BLK_SEGC(sc3, pi3);
        BLK_ENTRY(ent2, sc2, pi2, g2);
        BLK_QLOAD(qfn, m2n, ent1, pi1);
        BLK_DMA((cur ^ 1) * 65536, pi1);
        const int bh = pi >> 5, n = pi & 31, h = bh & 7;
        const bool valid = ent != 0xFFFFu; const int q = valid ? (int)(ent >> 2) : 0; const int slot = (int)(ent & 3u);
        const bool active = __builtin_amdgcn_readfirstlane((int)(__ballot(valid) != 0ull)) != 0;
        f32x16 o0 = {}, o1 = {}; float lsum = 0.f;
        if (active) {
            const float m2 = valid ? m2r : INFINITY;
            const LAS bf16_t* KP = (const LAS bf16_t*)(L + cur * 65536); const LAS bf16_t* VP = (const LAS bf16_t*)(L + cur * 65536 + 32768);
            const LAS float* TABh = TAB + h * 132; const LAS float* BTD = nullptr; (void)BTD;
            const int dq = q - 256 * n;
            const bool nearw = __builtin_amdgcn_readfirstlane((int)(__ballot(valid && dq < 383) != 0ull)) != 0;
            const float ci = nearw ? -m2 : TABh[129] - m2;
            f32x16 cinit;
#pragma unroll
            for (int r = 0; r < 16; ++r) cinit[r] = ci;
            if (nearw) { for (int st = 0; st < 8; ++st) ATTN_SUBTILE(KP, VP, st, 1, cinit); }
            else { for (int st = 0; st < 8; ++st) ATTN_SUBTILE(KP, VP, st, 0, cinit); }
        }
        { const float lt = lsum + __shfl_xor(lsum, 32);
          const size_t qi = (size_t)bh * SEQ + q;
          float* pld = valid ? PL + (size_t)slot * (NH * BATCH * SEQ) + qi : (float*)(dump + 120);
          bf16_t* dst = valid ? (bf16_t*)(F.ws + part_off(slot)) + qi * HD + 8 * hi : (bf16_t*)dump;
          *pld = lt;
          *(u32x4*)(dst) = ot_pack16(o0, 0); *(u32x4*)(dst + 16) = ot_pack16(o0, 1); *(u32x4*)(dst + 32) = ot_pack16(o1, 0); *(u32x4*)(dst + 48) = ot_pack16(o1, 1); }
        pi = pi1; g = g1; ent = ent1; m2r = m2n; pi1 = pi2; g1 = g2; ent1 = ent2; pi2 = pi3; g2 = g3; sc2 = sc3; cur ^= 1;
#pragma unroll
        for (int ds = 0; ds < 4; ++ds) qf[ds] = qfn[ds];
    }
    VM_WAIT(); __syncthreads();
#undef BLK_ITEM
#undef BLK_DMA
#undef BLK_SEGC
#undef BLK_ENTRY
#undef BLK_QLOAD
}

__device__ __forceinline__ void attn_own_phase(Frame& F) {
    LAS unsigned char* L = F.lds; LAS float* TAB = (LAS float*)(L + OTAB_OFF); LAS float* BT = (LAS float*)(L + ROWTAB_OFF); int bth = -1;
    attn_fill_tab(F, TAB);
    const int tid = F.tid, lane = F.lane, w = F.wave, j = lane & 31, hi = lane >> 5, lane8 = lane * 8;
    const bf16_t* Qb = (const bf16_t*)(F.ws + WS_Q); const float* MQg = (const float*)(F.ws + WS_MQ);
    const bf16_t* KF = (const bf16_t*)(F.ws + WS_KFRAG); const bf16_t* VF = (const bf16_t*)(F.ws + WS_VFRAG);
    const float* PL = (const float*)(F.ws + WS_PL); bf16_t* YA = (bf16_t*)(F.ws + WS_YATT);
    const int NU = BATCH * NH * NBLK;
#define OWN_DMA(buf_, pi_) do { const char* ks_ = (const char*)KF + ((size_t)(pi_) * 2048 + tid) * 16; const char* vs_ = (const char*)VF + ((size_t)(pi_) * 2048 + tid) * 16; \
        _Pragma("unroll") for (int i_ = 0; i_ < 4; ++i_) { \
            __builtin_amdgcn_global_load_lds((const unsigned*)(ks_ + i_ * 8192), (LAS unsigned*)(L + (buf_) + (i_ * 512 + w * 64) * 16), 16, 0, 0); \
            __builtin_amdgcn_global_load_lds((const unsigned*)(vs_ + i_ * 8192), (LAS unsigned*)(L + (buf_) + 32768 + (i_ * 512 + w * 64) * 16), 16, 0, 0); } } while (0)
#define OWN_QLOAD(qf_, m2_, u_) do { const int bh_ = (u_) >> 5, qb_ = (u_) & 31; const size_t tk_ = (size_t)256 * qb_ + 32 * w + j; \
        const bf16_t* qrow_ = Qb + ((size_t)(bh_ >> 3) * SEQ + tk_) * DA + (bh_ & 7) * HD + 8 * hi; \
        _Pragma("unroll") for (int ds_ = 0; ds_ < 4; ++ds_) qf_[ds_] = *(const bf16x8*)(qrow_ + 16 * ds_); \
        m2_ = MQg[(size_t)bh_ * SEQ + tk_]; } while (0)
    int u = F.vcu; if (u >= NU) return;
    bf16x8 qf[4]; float m2;
    OWN_DMA(0, u); OWN_QLOAD(qf, m2, u);
    int cur = 0;
    __builtin_amdgcn_s_waitcnt(0x0F70);
    for (;;) {
        __builtin_amdgcn_s_waitcnt(0x0F74); __syncthreads();
        const int un = (u + F.G < NU) ? u + F.G : u; const bool last = (un == u);
        const int bh = u >> 5, qb = u & 31, b = bh >> 3, h = bh & 7; const int ql = 32 * w + j; const size_t qi = (size_t)bh * SEQ + 256 * qb + ql;
        u32x4 pa[3][4]; float pl[3];
#pragma unroll
        for (int s = 0; s < 3; ++s) { pl[s] = PL[(size_t)s * (NH * BATCH * SEQ) + qi]; const bf16_t* src = (const bf16_t*)(F.ws + part_off(s)) + qi * HD + 8 * hi;
#pragma unroll
            for (int c = 0; c < 4; ++c) pa[s][c] = *(const u32x4*)(src + 16 * c); }
        bf16x8 qfn[4]; float m2n;
        OWN_QLOAD(qfn, m2n, un);
        OWN_DMA((cur ^ 1) * 65536, un);
        const LAS bf16_t* KP = (const LAS bf16_t*)(L + cur * 65536); const LAS bf16_t* VP = (const LAS bf16_t*)(L + cur * 65536 + 32768); const LAS float* TABh = TAB + h * 132;
        if (h != bth) { __syncthreads();
            for (int e = tid; e < 5 * 1024; e += NTHR) { const int i = e & 3, ln = (e >> 2) & 63, rq = (e >> 8) & 3, dl = e >> 10; const int dist = 32 * dl + (ln & 31) - crow(4 * rq + i, ln >> 5);
                BT[e] = dist < 0 ? -1e30f : TABh[dist > 127 ? 127 : dist]; }
            bth = h; __syncthreads(); }
        const int dq = ql; (void)dq;
        f32x16 cnear, cfar;
#pragma unroll
        for (int r = 0; r < 16; ++r) { cnear[r] = -m2; cfar[r] = TABh[129] - m2; }
        f32x16 o0 = {}, o1 = {}; float lsum = 0.f;
        for (int st = 0; st <= w; ++st) { const int dl = w - st;
            if (dl >= 5) { const LAS float* BTD = nullptr; (void)BTD; ATTN_SUBTILE(KP, VP, st, 0, cfar); }
            else { const LAS float* BTD = BT + dl * 1024; ATTN_SUBTILE(KP, VP, st, 2, cnear); } }
        float lt = lsum + __shfl_xor(lsum, 32);
        const int nsel = qb < 3 ? qb : 3;
#pragma unroll
        for (int s = 0; s < 3; ++s) { const bool use = s < nsel; lt += use ? pl[s] : 0.f;
            ot_add16(o0, 0, pa[s][0], use); ot_add16(o0, 1, pa[s][1], use); ot_add16(o1, 0, pa[s][2], use); ot_add16(o1, 1, pa[s][3], use); }
        const float inv = 1.f / lt;
#pragma unroll
        for (int r = 0; r < 16; ++r) { o0[r] *= inv; o1[r] *= inv; }
        bf16_t* dst = YA + ((size_t)b * SEQ + 256 * qb + ql) * DA + h * HD + 8 * hi;
        *(u32x4*)(dst) = ot_pack16(o0, 0); *(u32x4*)(dst + 16) = ot_pack16(o0, 1); *(u32x4*)(dst + 32) = ot_pack16(o1, 0); *(u32x4*)(dst + 48) = ot_pack16(o1, 1);
        if (last) break;
        u = un; m2 = m2n; cur ^= 1;
#pragma unroll
        for (int ds = 0; ds < 4; ++ds) qf[ds] = qfn[ds];
    }
    VM_WAIT(); __syncthreads();
#undef OWN_DMA
#undef OWN_QLOAD
}
#undef ATTN_SUBTILE

__device__ __forceinline__ void routing_phase(Frame& F) {
    LAS int* lcnt = (LAS int*)(F.lds); LAS int* lbase = lcnt + 32;
    const float* SSQ = (const float*)(F.ws + WS_SSQ); const float* RL = (const float*)(F.ws + WS_RLOG);
    unsigned* rowtok = (unsigned*)(F.ws + WS_ROWTOK); float* rowcoef = (float*)(F.ws + WS_ROWCOEF); float* rowrstd = (float*)(F.ws + WS_ROWRSTD);
    unsigned* ecnt = (unsigned*)(F.ctl + CW_ECNT);
    const float* brg = F.in[20]; const float* bre = F.in[22];
    const int tid = F.tid;
    for (int base = F.vcu * 256; base < T; base += F.G * 256) {
        if (tid < 32) lcnt[tid] = 0;
        __syncthreads();
        int e0 = 0, e1 = 0, lp0 = 0, lp1 = 0; float c0 = 0.f, c1 = 0.f, rstd = 0.f; const int tok = base + tid;
        if (tid < 256) {
            float ss = 0.f;
#pragma unroll
            for (int q = 0; q < 4; ++q) { const f32x4 v = *(const f32x4*)(SSQ + (size_t)tok * 16 + 4 * q); ss += (v.x + v.y) + (v.z + v.w); }
            rstd = 1.f / sqrtf(ss * (1.f / D) + RMS_EPS);
            float r[72];
#pragma unroll
            for (int q = 0; q < 18; ++q) { const f32x4 v = *(const f32x4*)(RL + (size_t)tok * 72 + 4 * q); r[4 * q] = v.x; r[4 * q + 1] = v.y; r[4 * q + 2] = v.z; r[4 * q + 3] = v.w; }
            float gl[4], el[32];
#pragma unroll
            for (int c = 0; c < 4; ++c) gl[c] = rstd * (r[c] + r[36 + c]) + brg[c];
#pragma unroll
            for (int c = 0; c < 32; ++c) el[c] = rstd * (r[4 + c] + r[40 + c]) + bre[c];
            int gi = 0; float gm = gl[0];
#pragma unroll
            for (int c = 1; c < 4; ++c) if (gl[c] > gm) { gm = gl[c]; gi = c; }
            float Z = 0.f;
#pragma unroll
            for (int c = 0; c < 4; ++c) Z += __expf(gl[c] - gm);
            const float gval = 1.f / Z;
            float es[8];
#pragma unroll
            for (int q = 0; q < 8; ++q) es[q] = gi == 0 ? el[q] : (gi == 1 ? el[8 + q] : (gi == 2 ? el[16 + q] : el[24 + q]));
            int a0 = 0; float m0 = es[0];
#pragma unroll
            for (int q = 1; q < 8; ++q) if (es[q] > m0) { m0 = es[q]; a0 = q; }
            int a1 = -1; float m1 = -INFINITY;
#pragma unroll
            for (int q = 0; q < 8; ++q) if (q != a0 && es[q] > m1) { m1 = es[q]; a1 = q; }
            const float w0 = 1.f / (1.f + __expf(m1 - m0)), w1 = 1.f - w0;
            e0 = gi * 8 + a0; e1 = gi * 8 + a1; c0 = gval * w0; c1 = gval * w1;
            lp0 = __hip_atomic_fetch_add(lcnt + e0, 1, __ATOMIC_RELAXED, __HIP_MEMORY_SCOPE_WORKGROUP);
            lp1 = __hip_atomic_fetch_add(lcnt + e1, 1, __ATOMIC_RELAXED, __HIP_MEMORY_SCOPE_WORKGROUP);
        }
        __syncthreads();
        if (tid < 32) lbase[tid] = (int)__hip_atomic_fetch_add(ecnt + tid, (unsigned)lcnt[tid], __ATOMIC_RELAXED, __HIP_MEMORY_SCOPE_AGENT);
        __syncthreads();
        if (tid < 256) {
            const size_t i0 = (size_t)e0 * ROWCAP + lbase[e0] + lp0, i1 = (size_t)e1 * ROWCAP + lbase[e1] + lp1;
            rowtok[i0] = (unsigned)tok * 2u; rowcoef[i0] = c0; rowrstd[i0] = rstd;
            rowtok[i1] = (unsigned)tok * 2u + 1u; rowcoef[i1] = c1; rowrstd[i1] = rstd;
        }
        __syncthreads();
    }
}
struct MoeOrder {
    const LAS int* tst; int total, G, v;
    __device__ bool next(int i, pg8::Unit& u) const {
        const int L = i * G + v; if (L >= total) return false;
        const int rt = L >> 2; int e = 0;
#pragma unroll 8
        for (int q = 1; q <= 32; ++q) e += (tst[q] <= rt) ? 1 : 0;
        u.pm = rt; u.pn = L & 3; u.pb = e * 4 + u.pn; u.aux = e; u.aux2 = (rt - tst[e]) * 256; return true;
    }
};
__device__ __forceinline__ void moe_tables(Frame& F) {
    LAS int* tst = (LAS int*)(F.lds + MOE_TST_OFF); const unsigned* ecnt = (const unsigned*)(F.ctl + CW_ECNT);
    if (F.wave == 0) { const int lane = F.lane; int nt = lane < 32 ? (int)((ecnt[lane & 31] + 255u) >> 8) : 0; int inc = nt;
#pragma unroll
        for (int o = 1; o < 32; o <<= 1) { const int t = __shfl_up(inc, o); if (lane >= o) inc += t; }
        if (lane < 32) tst[lane + 1] = inc; if (lane == 0) tst[0] = 0; }
    __syncthreads();
}
__device__ __forceinline__ void final_phase(Frame& F) {
#ifdef SELFCHECK
    const bool chk_bad = __hip_atomic_load((unsigned*)(F.ctl + 2), __ATOMIC_RELAXED, __HIP_MEMORY_SCOPE_AGENT) != 0u;
#endif
    const bf16_t* X1 = (const bf16_t*)(F.ws + WS_X1); const unsigned char* Y0 = F.ws + WS_Y0; const unsigned char* Y1 = F.ws + WS_Y1; const float* gf = F.in[26];
    const int gw = F.vcu * NWAVES + F.wave, NGW = F.G * NWAVES, lane = F.lane;
    for (int m = gw; m < T; m += NGW) {
        const u32x2* xr = (const u32x2*)(X1 + (size_t)m * D) + lane; const unsigned* y0 = (const unsigned*)(Y0 + (size_t)m * D) + lane; const unsigned* y1 = (const unsigned*)(Y1 + (size_t)m * D) + lane;
        f32x4 v[4]; float s = 0.f;
#pragma unroll
        for (int j = 0; j < 4; ++j) { const u32x2 xx = xr[64 * j]; const int a = (int)y0[64 * j], c = (int)y1[64 * j]; constexpr float ys = 1.f / YF8_SCALE;
            v[j].x = bflo(xx.x) + (__builtin_amdgcn_cvt_f32_fp8(a, 0) + __builtin_amdgcn_cvt_f32_fp8(c, 0)) * ys; v[j].y = bfhi(xx.x) + (__builtin_amdgcn_cvt_f32_fp8(a, 1) + __builtin_amdgcn_cvt_f32_fp8(c, 1)) * ys;
            v[j].z = bflo(xx.y) + (__builtin_amdgcn_cvt_f32_fp8(a, 2) + __builtin_amdgcn_cvt_f32_fp8(c, 2)) * ys; v[j].w = bfhi(xx.y) + (__builtin_amdgcn_cvt_f32_fp8(a, 3) + __builtin_amdgcn_cvt_f32_fp8(c, 3)) * ys;
            s += (v[j].x * v[j].x + v[j].y * v[j].y) + (v[j].z * v[j].z + v[j].w * v[j].w); }
        const float rstd = 1.f / sqrtf(wave_sum(s) * (1.f / D) + RMS_EPS);
        f32x4* o = (f32x4*)(F.out + (size_t)m * D) + lane; const f32x4* gr = (const f32x4*)gf + lane;
#ifdef SELFCHECK
        if (chk_bad) { for (int j = 0; j < 4; ++j) o[64 * j] = (f32x4){0.f, 0.f, 0.f, 0.f}; continue; }
#endif
#pragma unroll
        for (int j = 0; j < 4; ++j) o[64 * j] = v[j] * rstd * gr[64 * j];
    }
}
#ifdef SELFCHECK
constexpr int CW_CHK = 2;
__device__ __forceinline__ int t5_bucket_ref(int n) { if (n < 16) return n; const int l = 16 + (int)(logf((float)n / 16.f) / logf(8.f) * 16.f); return l < 31 ? l : 31; }
__device__ __forceinline__ float kfrag_at(const bf16_t* KF, int bh, int key, int d) { const int n = key >> 8, kl = key & 255, st = kl >> 5, i = kl & 31, ds = d >> 4, hi = (d >> 3) & 1, e = d & 7;
    return bf2f(KF[(((size_t)bh * 32 + n) * 2048 + (st * 4 + ds) * 64 + (i + 32 * hi)) * 8 + e]); }
__device__ __forceinline__ float vfrag_at(const bf16_t* VF, int bh, int key, int d) { const int n = key >> 8, kl = key & 255, st = kl >> 5, kk = kl & 31, ks = kk >> 4, k16 = kk & 15, hi = (k16 >> 2) & 1, e = (k16 & 3) + 4 * (k16 >> 3), d0 = d >> 5, jj = d & 31;
    return bf2f(VF[(((size_t)bh * 32 + n) * 2048 + ((st * 2 + ks) * 2 + d0) * 64 + (jj + 32 * hi)) * 8 + e]); }
__device__ __forceinline__ void selfcheck_phase(Frame& F, float tol_attn, float tol_ssm) {
    const int lane = lane_id(); const int gw = F.vcu * NWAVES + F.wave;
    const bf16_t* Qb = (const bf16_t*)(F.ws + WS_Q); const bf16_t* KM = (const bf16_t*)(F.ws + WS_KMEAN); const bf16_t* KF = (const bf16_t*)(F.ws + WS_KFRAG); const bf16_t* VF = (const bf16_t*)(F.ws + WS_VFRAG);
    const bf16_t* YA = (const bf16_t*)(F.ws + WS_YATT); const float* rb = F.in[16];
    bool bad = false;
    for (int sidx = 0; sidx < 12; ++sidx) {
        unsigned hsh = (unsigned)(gw * 12 + sidx) * 2654435761u; hsh ^= hsh >> 15; hsh *= 2246822519u; hsh ^= hsh >> 13;
        const int bh = (int)(hsh & 63u); int q = (int)((hsh >> 6) & 8191u);
        if (sidx == 0) q = q & 767; if (sidx == 1) q = (q & ~255) | (sidx & 1 ? 0 : 255); if (sidx == 2) q = (q & ~255) | 255; if (sidx == 3) q = (q & ~255) | 128;
        const int b = bh >> 3, h = bh & 7, qb = q >> 8, d = lane;
        const float qd = bf2f(Qb[((size_t)b * SEQ + q) * DA + h * HD + d]);
        int s0 = -1, s1 = -1, s2 = -1; float g0 = -INFINITY, g1 = -INFINITY, g2 = -INFINITY;
        for (int n = 0; n < qb; ++n) { const float gt = wave_sum(qd * bf2f(KM[((size_t)bh * 32 + n) * 64 + d]));
            if (gt > g0) { g2 = g1; s2 = s1; g1 = g0; s1 = s0; g0 = gt; s0 = n; } else if (gt > g1) { g2 = g1; s2 = s1; g1 = gt; s1 = n; } else if (gt > g2) { g2 = gt; s2 = n; } }
        float m = -INFINITY, l = 0.f, od = 0.f;
        for (int blk = 0; blk < 4; ++blk) { const int n = blk == 0 ? s0 : (blk == 1 ? s1 : (blk == 2 ? s2 : qb)); if (n < 0) continue;
            const int kend = (blk == 3) ? (q & 255) + 1 : 256;
            for (int kl = 0; kl < kend; ++kl) { const int key = 256 * n + kl; const float kd = kfrag_at(KF, bh, key, d);
                const float s = wave_sum(qd * kd) + rb[h * 32 + t5_bucket_ref(q - key)] * LOG2E;
                const float mn = fmaxf(m, s), sc = exp2f(m - mn), p = exp2f(s - mn); l = l * sc + p; od = od * sc + p * vfrag_at(VF, bh, key, d); m = mn; } }
        od /= l;
        const float yd = bf2f(YA[((size_t)b * SEQ + q) * DA + h * HD + d]);
        const float e2 = wave_sum((od - yd) * (od - yd)), o2 = wave_sum(od * od);
        if (!(e2 <= tol_attn * tol_attn * o2)) bad = true;
    }
    { const bf16_t* UP = (const bf16_t*)(F.ws + WS_UP); const bf16_t* GA = (const bf16_t*)(F.ws + WS_GACT);
      for (int sidx = 0; sidx < 6; ++sidx) {
        unsigned hsh = (unsigned)(gw * 6 + sidx + 7777) * 2654435761u; hsh ^= hsh >> 15; hsh *= 2246822519u; hsh ^= hsh >> 13;
        const int g = (int)(hsh & 31u), b = (int)((hsh >> 5) & 7u); int t = (int)((hsh >> 8) % 330u); if (sidx == 0) t = 31 + (int)((hsh >> 20) & 3u) * 32; if (sidx == 1) t = 32 + (int)((hsh >> 20) & 7u) * 32;
        const int p = lane;
        const float lr = F.in[4][g * SP + p], li = F.in[5][g * SP + p], step = expf(F.in[6][g]);
        const float mag = expf(lr * step), ar = mag * cosf(li * step), ai = mag * sinf(li * step);
        const float nr = ar - 1.f, ni = ai, den = lr * lr + li * li, cr = (nr * lr + ni * li) / den, ci = (ni * lr - nr * li) / den;
        float hr = 0.f, hi_ = 0.f;
        for (int tt = 0; tt <= t; ++tt) { float br = 0.f, bi = 0.f;
            for (int c = 0; c < 16; ++c) { const float u = bf2f(UP[(size_t)g * SROWS * SKY + ((size_t)b * 256 + (tt >> 5)) * SKY + (tt & 31) * 16 + c]);
                const float b_r = F.in[7][(g * SP + p) * 16 + c], b_i = F.in[8][(g * SP + p) * 16 + c]; br += (cr * b_r - ci * b_i) * u; bi += (cr * b_i + ci * b_r) * u; }
            const float n_r = ar * hr - ai * hi_ + br, n_i = ar * hi_ + ai * hr + bi; hr = n_r; hi_ = n_i; }
        float e2 = 0.f, o2 = 0.f;
        for (int ho = 0; ho < 16; ++ho) { float y = wave_sum(hr * F.in[9][(g * 16 + ho) * SP + p] - hi_ * F.in[10][(g * 16 + ho) * SP + p]);
            const float u = bf2f(UP[(size_t)g * SROWS * SKY + ((size_t)b * 256 + (t >> 5)) * SKY + (t & 31) * 16 + ho]); y += F.in[11][g * 16 + ho] * u;
            const float ge = 0.5f * y * (1.f + tanhf(0.7978845608028654f * (y + 0.044715f * y * y * y)));
            const float gv = bf2f(GA[((size_t)b * SEQ + t) * DS + g * 16 + ho]); e2 += (ge - gv) * (ge - gv); o2 += ge * ge; }
        if (!(e2 <= tol_ssm * tol_ssm * o2 + 1e-6f)) bad = true;
      } }
    if (__ballot(bad) != 0ull && lane == 0) __hip_atomic_store((unsigned*)(F.ctl + CW_CHK), 1u, __ATOMIC_RELAXED, __HIP_MEMORY_SCOPE_AGENT);
}
#endif

#ifdef SELFCHECK
__device__ __forceinline__ void selfcheck_prep(Frame& F) {
    const int lane = lane_id(); const int gw = F.vcu * NWAVES + F.wave;
    const bf16_t* Kb = (const bf16_t*)(F.ws + WS_K); const bf16_t* Vb = (const bf16_t*)(F.ws + WS_V); const bf16_t* KF = (const bf16_t*)(F.ws + WS_KFRAG); const bf16_t* VF = (const bf16_t*)(F.ws + WS_VFRAG);
    const bf16_t* KM = (const bf16_t*)(F.ws + WS_KMEAN); const float* KN = (const float*)(F.ws + WS_KMEAN + 512 * 1024);
    bool bad = false;
    for (int sidx = 0; sidx < 64; ++sidx) {
        unsigned hsh = (unsigned)(gw * 64 + sidx + 12345) * 2654435761u; hsh ^= hsh >> 15; hsh *= 2246822519u; hsh ^= hsh >> 13;
        const int bh = (int)(hsh & 63u), key = (int)((hsh >> 6) & 8191u), b = bh >> 3, h = bh & 7, d = lane;
        const float k0 = bf2f(Kb[((size_t)b * SEQ + key) * DA + h * HD + d]), v0 = bf2f(Vb[((size_t)b * SEQ + key) * DA + h * HD + d]);
        if (kfrag_at(KF, bh, key, d) != k0 || vfrag_at(VF, bh, key, d) != v0) bad = true;
    }
    for (int sidx = 0; sidx < 2; ++sidx) {
        unsigned hsh = (unsigned)(gw * 2 + sidx + 999) * 2654435761u; hsh ^= hsh >> 15; hsh *= 2246822519u; hsh ^= hsh >> 13;
        const int item = (int)(hsh & 2047u), bh = item >> 5, n = item & 31, b = bh >> 3, h = bh & 7, d = lane; float sum = 0.f, mx = 0.f;
        for (int kl = 0; kl < 256; ++kl) { const float kv = bf2f(Kb[((size_t)b * SEQ + 256 * n + kl) * DA + h * HD + d]); sum += kv; mx = fmaxf(mx, wave_sum(kv * kv)); }
        const float mean = sum * (1.f / 256.f), got = bf2f(KM[(size_t)item * 64 + d]);
        if (fabsf(mean - got) > 0.01f * fabsf(mean) + 1e-3f) bad = true;
        if (fabsf(mx - KN[item]) > 1e-3f * mx) bad = true;
    }
    if (__ballot(bad) != 0ull && lane == 0) __hip_atomic_store((unsigned*)(F.ctl + CW_CHK), 1u, __ATOMIC_RELAXED, __HIP_MEMORY_SCOPE_AGENT);
}
#endif
#ifndef MK_N_LAUNCHES
#define MK_N_LAUNCHES 1
#endif
constexpr int NPHASE = 14;
struct Args { const float* in[27]; float* out; unsigned char* ws; int ph_lo, ph_hi; };
static_assert(sizeof(Args) == 27 * 8 + 8 + 8 + 8, "Args has no padding");

#ifndef STAG9
#define STAG9 0
#endif
#ifndef STAG8
#define STAG8 0
#endif
#ifndef DUP_MASK
#define DUP_MASK 0
#endif
#define PH_ARGS Frame& F, unsigned char* ws, LAS unsigned char* ring
__device__ __forceinline__ void ph1(PH_ARGS) {
    { pg8::Gemm g{(const bf16_t*)(ws + WS_H1), (const bf16_t*)(ws + WS_WIN), D, D, D}; pg8::StaticOrder S; S.init(T, DS, F.G, (int)blockIdx.x);
      EpiProj<0> E{ws, F.in[3], 0, 1.f};
      pg8::gemm_phase<EpiProj<0>, pg8::StaticOrder, true, false>(ring, g, S, E, nullptr, F.wave); }
    { pg8::Gemm g{(const bf16_t*)(ws + WS_H1F8), (const bf16_t*)(ws + WS_WINF8), D / 2, D / 2, D / 2}; pg8::StaticOrder S; S.init(T, DIN - DS, F.G, (int)blockIdx.x);
      EpiProj<1> E{ws, F.in[3], 2, 1.f / WF8_SCALE};
      pg8::gemm_phase<EpiProj<1>, pg8::StaticOrder, true, false, true>(ring, g, S, E, nullptr, F.wave); }
}
__device__ __forceinline__ void ph2(PH_ARGS) {
    { pg8::Gemm g{(const bf16_t*)(ws + WS_UP), (const bf16_t*)(ws + WS_SSMW), SKY, SKU, SKU}; pg8::GroupedOrder S; S.init(SG * 8, 1, 8, F.G, F.vcu);
      EpiSsmE E{(float*)(ws + WS_E)};
      pg8::gemm_phase<EpiSsmE, pg8::GroupedOrder, false, false>(ring, g, S, E, nullptr, F.wave); }
    VM_WAIT(); __syncthreads();
    ssm_scan_phase(F);
    kv_prep_phase(F);
}
__device__ __forceinline__ void ph4(PH_ARGS) {
    pg8::Gemm g{(const bf16_t*)(ws + WS_UP), (const bf16_t*)(ws + WS_SSMT), SKY, SKY, SKY}; pg8::GroupedOrder S; S.init(SG * 8, 2, 8, F.G, F.vcu);
    EpiSsmY E{(bf16_t*)(ws + WS_GACT)};
    pg8::gemm_phase<EpiSsmY, pg8::GroupedOrder, true, false>(ring, g, S, E, nullptr, F.wave);
}
__device__ __forceinline__ void ph5(PH_ARGS) {
    pg8::Gemm g{(const bf16_t*)(ws + WS_GACT), (const bf16_t*)(ws + WS_WGLU), DS, DS, DS}; pg8::StaticOrder S; S.init(T, DS, F.G, (int)blockIdx.x);
    EpiGlu E{(const bf16_t*)(ws + WS_GACT), (bf16_t*)(ws + WS_YSSM), F.in[13]};
    pg8::gemm_phase<EpiGlu, pg8::StaticOrder, true, false>(ring, g, S, E, nullptr, F.wave);
}
__device__ __forceinline__ void ph6(PH_ARGS) {
    { pg8::Gemm g{(const bf16_t*)(ws + WS_YSSM), (const bf16_t*)(ws + WS_WUS), DS, DS, DS}; pg8::StaticOrder S; S.init(T, D, F.G, (int)blockIdx.x);
      EpiUp<false> E{(const bf16_t*)(ws + WS_SGS), (bf16_t*)(ws + WS_MRG)};
      pg8::gemm_phase<EpiUp<false>, pg8::StaticOrder, true, false>(ring, g, S, E, nullptr, F.wave); }
    VM_WAIT(); __syncthreads();
    { pg8::Gemm g{(const bf16_t*)(ws + WS_YATT), (const bf16_t*)(ws + WS_WUA), DA, DA, DA}; pg8::StaticOrder S; S.init(T, D, F.G, (int)blockIdx.x);
      EpiUp<true> E{(const bf16_t*)(ws + WS_SGA), (bf16_t*)(ws + WS_MRG)};
      pg8::gemm_phase<EpiUp<true>, pg8::StaticOrder, true, false>(ring, g, S, E, nullptr, F.wave); }
}
__device__ __forceinline__ void ph7(PH_ARGS) {
    pg8::Gemm g{(const bf16_t*)(ws + WS_MRG), (const bf16_t*)(ws + WS_WOUT), D, D, D}; pg8::StaticOrder S; S.init(T, D, F.G, (int)blockIdx.x);
    EpiOut E{F.in[0], (bf16_t*)(ws + WS_X1), ws + WS_XGF8, (float*)(ws + WS_SSQ)};
    pg8::gemm_phase<EpiOut, pg8::StaticOrder, true, false>(ring, g, S, E, nullptr, F.wave);
}
__device__ __forceinline__ void ph8(PH_ARGS) {
    pg8::Gemm g{(const bf16_t*)(ws + WS_X1), (const bf16_t*)(ws + WS_WR), D, D, D}; pg8::GroupedOrder S; S.init(T / 256, 1, T / 256, F.G, F.vcu);
    EpiRouter E{(float*)(ws + WS_RLOG)};
    pg8::gemm_phase<EpiRouter, pg8::GroupedOrder, false, false>(ring, g, S, E, nullptr, F.wave);
}
__device__ __forceinline__ void ph10(PH_ARGS) {
    moe_tables(F);
    const LAS int* tst = (const LAS int*)(F.lds + MOE_TST_OFF);
    MoeOrder S{tst, tst[32] * 4, F.G, F.vcu};
    LAS unsigned* rowtab = (LAS unsigned*)(F.lds + ROWTAB_OFF);
    { const unsigned* rowtok = (const unsigned*)(ws + WS_ROWTOK); const unsigned* ecnt = (const unsigned*)(F.ctl + CW_ECNT); pg8::Unit u;
      for (int i = 0; i < ROWTAB_UNITS && S.next(i, u); ++i) { if (F.tid < 256) { const int pos = u.aux2 + F.tid; const unsigned tk = pos < (int)ecnt[u.aux] ? (rowtok[(size_t)u.aux * ROWCAP + pos] >> 1) : 0u; rowtab[i * 256 + F.tid] = tk * (unsigned)D; } } }
    __syncthreads();
    pg8::Gemm g{(const bf16_t*)(ws + WS_XGF8), (const bf16_t*)(ws + WS_W13), D / 2, D / 2, D / 2};
    EpiMoe1 E{ws + WS_HID, (const float*)(ws + WS_ROWRSTD), (const unsigned*)(F.ctl + CW_ECNT), 1.f / WF8_SCALE};
    pg8::gemm_phase<EpiMoe1, MoeOrder, true, true, true>(ring, g, S, E, rowtab, F.wave);
}
__device__ __forceinline__ void ph11(PH_ARGS) {
    moe_tables(F);
    const LAS int* tst = (const LAS int*)(F.lds + MOE_TST_OFF);
    MoeOrder S{tst, tst[32] * 4, F.G, F.vcu};
    pg8::Gemm g{(const bf16_t*)(ws + WS_HID), (const bf16_t*)(ws + WS_W2), DE / 2, DE / 2, DE / 2};
    EpiMoe2 E{ws + WS_Y0, (size_t)(WS_Y1 - WS_Y0), (const unsigned*)(ws + WS_ROWTOK), (const float*)(ws + WS_ROWCOEF), (const unsigned*)(F.ctl + CW_ECNT), YF8_SCALE / WF8_SCALE};
    pg8::gemm_phase<EpiMoe2, MoeOrder, true, false, true>(ring, g, S, E, nullptr, F.wave);
}

__global__ void __launch_bounds__(NTHR, 2) fwd_kernel(Args args) {
    extern __shared__ __attribute__((aligned(16))) unsigned char lds_raw[];
    Frame F;
    F.lds = (LAS unsigned char*)lds_raw;
    F.MISC = (volatile LAS unsigned*)(F.lds + MISC_OFF);
    F.wave = __builtin_amdgcn_readfirstlane((int)(threadIdx.x >> 6)); F.lane = lane_id(); F.tid = F.wave * 64 + F.lane;
    F.G = gridDim.x; { const int bx = blockIdx.x; F.vcu = (F.G % 8 == 0) ? (bx % 8) * (F.G / 8) + bx / 8 : bx; }
    F.ws = args.ws; F.ctl = (gu32*)(args.ws + WS_CTL); F.out = args.out;
#pragma unroll
    for (int i = 0; i < 27; ++i) F.in[i] = args.in[i];
    for (int u = F.tid; u < (LDS_BYTES - MOE_TST_OFF) / 4; u += NTHR) ((LAS unsigned*)(F.lds + MOE_TST_OFF))[u] = 0u;
    __syncthreads();
    XcdBarrier bar; bar.bar = (unsigned*)(F.ctl + CW_BAR); bar.x = 0; bar.st = nullptr;
    const int lo = args.ph_lo, hi = args.ph_hi;
    if (hi - lo > 1) bar = xcd_barrier_post((unsigned*)(F.ctl + CW_BAR), F.MISC + 8, F.tid == 0);
#define IN(k) (lo <= (k) && (k) < hi)
#define DUP(k) ((DUP_MASK >> (k)) & 1)
#define SEAM(k) do { if (IN(k) && IN((k) + 1)) xcd_barrier(bar, F.wave == 0 && lane_id() == 0); REFRESH(); } while (0)
#define REFRESH() do { int l_ = lane_id(); asm volatile("" : "+v"(l_)); F.lane = l_; F.tid = F.wave * 64 + l_; } while (0)
    unsigned char* ws = args.ws;
    LAS unsigned char* ring = F.lds;
    if (IN(0)) { p0_prologue(F); if (DUP(0)) p0_prologue(F); }
    SEAM(0);
    if (IN(1)) { ph1(F, ws, ring); if (DUP(1)) ph1(F, ws, ring); }
    SEAM(1);
    if (IN(2)) { ph2(F, ws, ring); if (DUP(2)) ph2(F, ws, ring); }
    SEAM(2);
#ifdef SELFCHECK_PREP
    if (IN(3)) { selfcheck_prep(F); }
#endif
    if (IN(3)) { attn_gate_phase<true>(F); }
    SEAM(3);
    if (IN(4)) { attn_block_phase(F); if (DUP(4)) { __syncthreads(); attn_block_phase(F); } }
    SEAM(4);
    if (IN(5)) { attn_own_phase(F); if (DUP(5)) attn_own_phase(F); }
    SEAM(5);
    if (IN(6)) { ph4(F, ws, ring); if (DUP(6)) ph4(F, ws, ring); }
#ifdef SELFCHECK
    if (IN(6)) { xcd_barrier(bar, F.wave == 0 && lane_id() == 0); REFRESH(); selfcheck_phase(F, SELFCHECK_TOL_ATTN, SELFCHECK_TOL_SSM); }
#endif
    SEAM(6);
    if (IN(7)) { ph5(F, ws, ring); if (DUP(7)) ph5(F, ws, ring); }
    SEAM(7);
    if (IN(8)) { if (STAG8 > 0 && (F.vcu & 1)) { const unsigned long long t0_ = __builtin_amdgcn_s_memrealtime(); while ((long long)(__builtin_amdgcn_s_memrealtime() - t0_) < (long long)STAG8) __builtin_amdgcn_s_sleep(16); }
                 ph6(F, ws, ring); if (DUP(8)) ph6(F, ws, ring); }
    SEAM(8);
    if (IN(9)) { if (STAG9 > 0 && (F.vcu & 1)) { const unsigned long long t0_ = __builtin_amdgcn_s_memrealtime(); while ((long long)(__builtin_amdgcn_s_memrealtime() - t0_) < (long long)STAG9) __builtin_amdgcn_s_sleep(16); }
                 ph7(F, ws, ring); if (DUP(9)) ph7(F, ws, ring); }
    SEAM(9);
    if (IN(10)) { ph8(F, ws, ring); VM_WAIT(); __syncthreads(); routing_phase(F); }
    SEAM(10);
    if (IN(11)) { ph10(F, ws, ring); if (DUP(11)) ph10(F, ws, ring); }
    SEAM(11);
    if (IN(12)) { ph11(F, ws, ring); if (DUP(12)) ph11(F, ws, ring); }
    SEAM(12);
    if (IN(13)) { final_phase(F); if (DUP(13)) final_phase(F); }
#undef IN
#undef DUP
#undef SEAM
#undef REFRESH
}

extern "C" void kernel_launch(void* const* d_in, const int* in_sizes, int n_in, void* d_out, int out_size, void* d_ws, size_t ws_size, hipStream_t stream) {
    static int grid = 0;
    if (grid == 0) {
        if (n_in != 27 || in_sizes[0] != T * D || out_size != T * D || ws_size < WS_END) { fprintf(stderr, "kernel_launch: unexpected shapes (n_in %d, in0 %d, out %d, ws %zu)\n", n_in, n_in > 0 ? in_sizes[0] : -1, out_size, ws_size); grid = -1; return; }
        int dev = 0, cus = 0;
        if (hipGetDevice(&dev) != hipSuccess || hipDeviceGetAttribute(&cus, hipDeviceAttributeMultiprocessorCount, dev) != hipSuccess) { grid = -1; return; }
        if (hipFuncSetAttribute((const void*)fwd_kernel, hipFuncAttributeMaxDynamicSharedMemorySize, LDS_BYTES) != hipSuccess) { fprintf(stderr, "kernel_launch: hipFuncSetAttribute failed\n"); grid = -1; return; }
        (void)hipGetLastError();
        grid = cus;
    }
    if (grid < 0) return;
    (void)hipMemsetAsync((char*)d_ws + WS_CTL, 0, CTL_ZERO_BYTES, stream);
    Args a{};
    for (int i = 0; i < 27; ++i) a.in[i] = (const float*)d_in[i];
    a.out = (float*)d_out; a.ws = (unsigned char*)d_ws;
    if (MK_N_LAUNCHES == 1) { a.ph_lo = 0; a.ph_hi = NPHASE; hipLaunchKernelGGL(fwd_kernel, dim3(grid), dim3(NTHR), LDS_BYTES, stream, a); }
    else { for (int p = 0; p < NPHASE; ++p) { a.ph_lo = p; a.ph_hi = p + 1; hipLaunchKernelGGL(fwd_kernel, dim3(grid), dim3(NTHR), LDS_BYTES, stream, a); } }
}
```

```cpp
#include <hip/hip_runtime.h>
#include <cstdio>
#include <cstdint>

#define LAS __attribute__((address_space(3)))
#define GAS __attribute__((address_space(1)))
typedef unsigned short bf16_t;
typedef short bf16x8 __attribute__((ext_vector_type(8)));
typedef float f32x2 __attribute__((ext_vector_type(2)));
typedef float f32x4 __attribute__((ext_vector_type(4)));
typedef float f32x16 __attribute__((ext_vector_type(16)));
typedef unsigned u32x2 __attribute__((ext_vector_type(2)));
typedef unsigned u32x4 __attribute__((ext_vector_type(4)));
typedef GAS unsigned gu32;
typedef int v4i32 __attribute__((ext_vector_type(4)));
typedef int v8i32 __attribute__((ext_vector_type(8)));
#define RLX_AGENT __ATOMIC_RELAXED, __HIP_MEMORY_SCOPE_AGENT
#define LDS_WAIT() asm volatile("s_waitcnt lgkmcnt(0)" ::: "memory")
#define VM_WAIT() asm volatile("s_waitcnt vmcnt(0)" ::: "memory")

__device__ __forceinline__ unsigned f2bf(float f) { unsigned u = __builtin_bit_cast(unsigned, f); return (u + 0x7fffu + ((u >> 16) & 1u)) >> 16; }
__device__ __forceinline__ unsigned pk2(float lo, float hi) { return f2bf(lo) | (f2bf(hi) << 16); }
__device__ __forceinline__ float bf2f(unsigned short b) { return __builtin_bit_cast(float, (unsigned)b << 16); }
__device__ __forceinline__ float bflo(unsigned w) { return __builtin_bit_cast(float, w << 16); }
__device__ __forceinline__ float bfhi(unsigned w) { return __builtin_bit_cast(float, w & 0xffff0000u); }
__device__ __forceinline__ unsigned cvt_pk_bf16(float lo, float hi) { unsigned r; asm volatile("v_cvt_pk_bf16_f32 %0, %1, %2" : "=v"(r) : "v"(lo), "v"(hi)); return r; }
__device__ __forceinline__ float fast_sigmoid(float x) { return __builtin_amdgcn_rcpf(1.f + __builtin_amdgcn_exp2f(-1.4426950408889634f * x)); }
__device__ __forceinline__ int lane_id() { int l; asm volatile("v_mbcnt_lo_u32_b32 %0, -1, 0\n\tv_mbcnt_hi_u32_b32 %0, -1, %0" : "=v"(l)); return l; }
__device__ __forceinline__ float wave_sum(float v) {
#pragma unroll
    for (int o = 1; o < 64; o <<= 1) v += __shfl_xor(v, o);
    return v;
}
__device__ __forceinline__ float wave_max(float v) {
#pragma unroll
    for (int o = 1; o < 64; o <<= 1) v = fmaxf(v, __shfl_xor(v, o));
    return v;
}

#define XB_TMO      128
#define XB_XCNT(j)  (256  + 64 * (j))
#define XB_XSUB(j)  (1280 + 64 * (j))
#define XB_XGEN(j)  (2304 + 64 * (j))
#define XB_TOP      3328
#define XB_TOPGEN   3392
#define XCD_BAR_WORDS 3456
#define XB_SPIN_CAP (1u << 20)

__device__ __forceinline__ unsigned xb_ld(unsigned* p)              { return __hip_atomic_load(p, __ATOMIC_RELAXED, __HIP_MEMORY_SCOPE_AGENT); }
__device__ __forceinline__ unsigned xb_add(unsigned* p, unsigned v) { return __hip_atomic_fetch_add(p, v, __ATOMIC_RELAXED, __HIP_MEMORY_SCOPE_AGENT); }
__device__ __forceinline__ unsigned xb_xcc_id() { return (unsigned)__builtin_amdgcn_s_getreg((3 << 11) | 20) & 0xFu; }
#define XB_SPIN(cond, bar) do { unsigned _sp = 0; while (cond) { __builtin_amdgcn_s_sleep(1); \
    if ((++_sp & 255u) == 0u) { if (xb_ld(&(bar)[XB_TMO])) break; if (_sp > XB_SPIN_CAP) { atomicAdd(&(bar)[XB_TMO], 1u); break; } } } } while (0)

struct XcdBarrier { unsigned* bar; unsigned x; volatile LAS unsigned* st; };

__device__ __forceinline__ XcdBarrier xcd_barrier_post(unsigned* bar, volatile LAS unsigned* st, bool leader  ) {
    XcdBarrier b; b.bar = bar; b.x = xb_xcc_id(); b.st = st;
    if (leader) (void)xb_add(&bar[XB_XCNT(b.x)], 1u);
    return b;
}
__device__ __forceinline__ void xcd_barrier_complete(unsigned* bar, unsigned x, unsigned& nloc, unsigned& nx) {
    const unsigned G = gridDim.x * gridDim.y * gridDim.z;
    unsigned sum, cnt, mine, sp = 0u;
    for (;;) {
        sum = 0u; cnt = 0u; mine = 0u;
#pragma unroll
        for (unsigned j = 0; j < 16; ++j) { const unsigned c = xb_ld(&bar[XB_XCNT(j)]); sum += c; cnt += (c > 0u) ? 1u : 0u; mine = (j == x) ? c : mine; }
        if (sum == G) break;
        __builtin_amdgcn_s_sleep(1);
        if ((++sp & 255u) == 0u) { if (xb_ld(&bar[XB_TMO])) break; if (sp > XB_SPIN_CAP) { atomicAdd(&bar[XB_TMO], 1u); break; } }
    }
    nloc = mine > 0u ? mine : 1u; nx = cnt > 0u ? cnt : 1u;
}
__device__ __forceinline__ void xcd_barrier(const XcdBarrier& b, bool leader  ) {
    asm volatile("s_waitcnt vmcnt(0)" ::: "memory");
    __syncthreads();
    if (leader) {
        unsigned* bar = b.bar;
        __builtin_amdgcn_s_waitcnt(0);
        unsigned nloc = b.st[0], nx = b.st[1];
        if (nloc == 0u) { xcd_barrier_complete(bar, b.x, nloc, nx); b.st[0] = nloc; b.st[1] = nx; }
        const unsigned old = xb_add(&bar[XB_XSUB(b.x)], 1u);
        const unsigned gen = old / nloc;
        if (old + 1u == (gen + 1u) * nloc) {
            __builtin_amdgcn_fence(__ATOMIC_RELEASE, "agent");
            asm volatile("s_waitcnt vmcnt(0)" ::: "memory");
            const unsigned og = xb_add(&bar[XB_TOP], 1u);
            const unsigned tg = og / nx;
            if (og + 1u == (tg + 1u) * nx) xb_add(&bar[XB_TOPGEN], 1u);
            else XB_SPIN(xb_ld(&bar[XB_TOPGEN]) == tg, bar);
            __builtin_amdgcn_fence(__ATOMIC_ACQUIRE, "agent");
            xb_add(&bar[XB_XGEN(b.x)], 1u);
            asm volatile("s_waitcnt vmcnt(0)" ::: "memory");
        } else {
            XB_SPIN(xb_ld(&bar[XB_XGEN(b.x)]) == gen, bar);
            __builtin_amdgcn_fence(__ATOMIC_ACQUIRE, "agent");
            asm volatile("s_waitcnt vmcnt(0)" ::: "memory");
        }
    }
    __syncthreads();
}

namespace pg8 {
constexpr int BM = 256, BK = 64, HALF = 128, HTB = HALF * BK * 2, STAGE_BYTES = 8 * HTB, NXCD = 8, WGM = 8;
__host__ __device__ __forceinline__ int lds_byte(int r, int c) { const int st = (r >> 4) * 2 + (c >> 5), rr = r & 15, cc = c & 31, ob = rr * 64 + cc * 2; return st * 1024 + (ob ^ (((ob >> 9) & 1) << 5)); }
__host__ __device__ __forceinline__ void stage_rc(int b, int& R, int& C) { const int st = b / 1024, sb = b % 1024, swz = sb ^ (((sb >> 9) & 1) << 5); R = (st >> 1) * 16 + swz / 64; C = (st & 1) * 32 + (swz % 64) / 2; }
__host__ __device__ __forceinline__ int perm32(int rho) { const int n = rho >> 4, i = rho & 15; return 8 * (i >> 2) + 4 * n + (i & 3); }

struct Unit { int pm, pn, pb, aux, aux2; };
struct Gemm { const bf16_t* A; const bf16_t* Bt; int lda, ldb, K; };

struct StaticOrder {
    int nM, nN, nwg, G, c;
    __device__ void init(int M, int N, int G_, int c_) { nM = M / BM; nN = N / BM; nwg = nM * nN; G = G_; c = c_; }
    __device__ bool next(int i, Unit& u) const {
        const long L = (long)i * G + c; if (L >= nwg) return false;
        int wgid = (int)L; { const int q = nwg / NXCD, r = nwg % NXCD, xcd = wgid % NXCD, off = wgid / NXCD; wgid = (xcd < r ? xcd * (q + 1) : r * (q + 1) + (xcd - r) * q) + off; }
        const int nig = WGM * nN, gid = wgid / nig, fm = gid * WGM, gsz = (nM - fm) < WGM ? (nM - fm) : WGM;
        u.pm = fm + ((wgid % nig) % gsz); u.pn = (wgid % nig) / gsz; u.pb = u.pn; u.aux = 0; u.aux2 = 0; return true;
    }
};
struct GroupedOrder {
    int nM, nN, rtpg, G, v;
    __device__ void init(int nM_, int nN_, int rtpg_, int G_, int v_) { nM = nM_; nN = nN_; rtpg = rtpg_; G = G_; v = v_; }
    __device__ bool next(int i, Unit& u) const {
        const int L = i * G + v; if (L >= nM * nN) return false;
        u.pm = L / nN; u.pn = L % nN; u.aux = u.pm / rtpg; u.pb = u.aux * nN + u.pn; u.aux2 = 0; return true;
    }
};

template <class Epi, class Sched, bool ALIGN_EPI, bool GATHER, bool FP8 = false>
__device__ __forceinline__ void gemm_phase(LAS unsigned char* lds, const Gemm g, const Sched& S, const Epi& E, const LAS unsigned* rowtab  , int wid  ) {
    const int lane = lane_id(), tid = wid * 64 + lane, wr = wid >> 2, wc = wid & 3;
    const int K = g.K, nt = K / BK;
    unsigned voffB[2];
#pragma unroll
    for (int i = 0; i < 2; ++i) { int R, C; stage_rc(tid * 16 + i * 8192, R, C); const int Rb = (R & ~31) + perm32(R & 31);
        voffB[i] = (unsigned)(Rb * g.ldb + C) * 2u; }
    const size_t kstep = (size_t)(BK * 2);
    const size_t hstepB = (size_t)HALF * g.ldb * 2, tstepB = 2 * hstepB;
    const size_t tstepA = (size_t)BM * g.lda * 2;
    const unsigned ldsw = (unsigned)wid * 1024u;
    const int aoff = lds_byte(wr * 64 + (lane & 15), (lane >> 4) * 8), boff = lds_byte(wc * 32 + (lane & 15), (lane >> 4) * 8);
    unsigned vAc[2][2];
#define PG8_SETVA(dst, ui_) do { const int t_ = wid * 64 + lane_id(); _Pragma("unroll") for (int i_ = 0; i_ < 2; ++i_) { int R_, C_; stage_rc(t_ * 16 + i_ * 8192, R_, C_); \
        _Pragma("unroll") for (int h_ = 0; h_ < 2; ++h_) dst[h_][i_] = (GATHER ? rowtab[(ui_) * 256 + h_ * 128 + R_] : (unsigned)((h_ * 128 + R_) * g.lda) * 2u) + (unsigned)C_ * 2u; } } while (0)
#define PG8_SA(b, h) (((b) * 2 + (h)) * HTB)
#define PG8_SB(b, h) ((4 + (b) * 2 + (h)) * HTB)
#define PG8_GLDS_S(gbase_, voff_, ldsaddr_) do { unsigned keep_; asm volatile("s_mov_b32 %0, m0\n\ts_mov_b32 m0, %3\n\ts_nop 0\n\tglobal_load_lds_dwordx4 %1, %2\n\ts_mov_b32 m0, %0" \
        : "=&s"(keep_) : "v"(voff_), "s"(gbase_), "s"(ldsaddr_) : "memory"); } while (0)
#define PG8_STAGE(bufoff, gbase, v0, v1) do { \
        if constexpr (FP8) { const unsigned la_ = (unsigned)(uintptr_t)(lds + (bufoff) + ldsw); PG8_GLDS_S((const char*)(gbase), (v0), la_); PG8_GLDS_S((const char*)(gbase), (v1), la_ + 8192u); } else { \
        __builtin_amdgcn_global_load_lds((const unsigned*)((const char*)(gbase) + (v0)), (LAS unsigned*)(lds + (bufoff) + ldsw), 16, 0, 0); \
        __builtin_amdgcn_global_load_lds((const unsigned*)((const char*)(gbase) + (v1)), (LAS unsigned*)(lds + (bufoff) + ldsw + 8192), 16, 0, 0); } } while (0)
#define PG8_STB(bufoff, gbase) PG8_STAGE(bufoff, gbase, voffB[0], voffB[1])
#define PG8_LDA(dst, b, h) do { _Pragma("unroll") for (int m = 0; m < 4; ++m) _Pragma("unroll") for (int k = 0; k < 2; ++k) dst[m][k] = *(const LAS bf16x8*)(lds + PG8_SA(b, h) + aoff + m * 2048 + k * 1024); } while (0)
#define PG8_LDB(dst, b, h) do { _Pragma("unroll") for (int n = 0; n < 2; ++n) _Pragma("unroll") for (int k = 0; k < 2; ++k) dst[n][k] = *(const LAS bf16x8*)(lds + PG8_SB(b, h) + boff + n * 2048 + k * 1024); } while (0)
#define PG8_MMA(ai, bj, At, Bt) do { __builtin_amdgcn_s_setprio(1); \
        if constexpr (FP8) { _Pragma("unroll") for (int m = 0; m < 4; ++m) _Pragma("unroll") for (int n = 0; n < 2; ++n) { \
            const v8i32 a8_ = __builtin_shufflevector(__builtin_bit_cast(v4i32, At[m][0]), __builtin_bit_cast(v4i32, At[m][1]), 0, 1, 2, 3, 4, 5, 6, 7); \
            const v8i32 b8_ = __builtin_shufflevector(__builtin_bit_cast(v4i32, Bt[n][0]), __builtin_bit_cast(v4i32, Bt[n][1]), 0, 1, 2, 3, 4, 5, 6, 7); \
            acc[ai][bj][m][n] = __builtin_amdgcn_mfma_scale_f32_16x16x128_f8f6f4(b8_, a8_, acc[ai][bj][m][n], 0, 0, 0, 0, 0, 0); } } \
        else { _Pragma("unroll") for (int m = 0; m < 4; ++m) _Pragma("unroll") for (int n = 0; n < 2; ++n) _Pragma("unroll") for (int k = 0; k < 2; ++k) \
            acc[ai][bj][m][n] = __builtin_amdgcn_mfma_f32_16x16x32_bf16(Bt[n][k], At[m][k], acc[ai][bj][m][n], 0, 0, 0); } \
        __builtin_amdgcn_s_setprio(0); } while (0)
#define PG8_WAIT_V(n) asm volatile("s_waitcnt vmcnt(" #n ")" ::: "memory")
#define PG8_WAIT_L(n) asm volatile("s_waitcnt lgkmcnt(" #n ")" ::: "memory")
#define PG8_BAR __builtin_amdgcn_s_barrier()
#define PG8_SCHED __builtin_amdgcn_sched_barrier(0)
#define PG8_SCHED8 do { if constexpr (FP8) __builtin_amdgcn_sched_barrier(0); } while (0)
    Unit cur, nxt; int ui = 0;
#define PG8_UNI(u_) do { u_.pm = __builtin_amdgcn_readfirstlane(u_.pm); u_.pn = __builtin_amdgcn_readfirstlane(u_.pn); u_.pb = __builtin_amdgcn_readfirstlane(u_.pb); u_.aux = __builtin_amdgcn_readfirstlane(u_.aux); u_.aux2 = __builtin_amdgcn_readfirstlane(u_.aux2); } while (0)
    if (!S.next(0, cur)) return;
    PG8_UNI(cur);
    f32x4 acc[2][2][4][2];
#pragma unroll
    for (int a = 0; a < 2; ++a)
#pragma unroll
        for (int b = 0; b < 2; ++b)
#pragma unroll
            for (int m = 0; m < 4; ++m)
#pragma unroll
                for (int n = 0; n < 2; ++n) acc[a][b][m][n] = (f32x4){0.f, 0.f, 0.f, 0.f};
    bf16x8 At[4][2], B0[2][2], B1[2][2];
    const char* cA = (const char*)g.A + (GATHER ? (size_t)0 : (size_t)cur.pm * tstepA); const char* cB = (const char*)g.Bt + (size_t)cur.pb * tstepB;
    PG8_SETVA(vAc, 0);
    PG8_STB(PG8_SB(0, 0), cB); PG8_STB(PG8_SB(0, 1), cB + hstepB); PG8_STAGE(PG8_SA(0, 0), cA, vAc[0][0], vAc[0][1]); PG8_STAGE(PG8_SA(0, 1), cA, vAc[1][0], vAc[1][1]);
    if (wr == 1) PG8_BAR;
    PG8_WAIT_V(2); PG8_BAR;
    PG8_STB(PG8_SB(1, 0), cB + kstep); PG8_STAGE(PG8_SA(1, 0), cA + kstep, vAc[0][0], vAc[0][1]); PG8_STB(PG8_SB(1, 1), cB + hstepB + kstep);
    PG8_WAIT_V(6); PG8_BAR;
    for (;;) {
        const bool has_next = S.next(ui + 1, nxt);
        PG8_UNI(nxt);
        const char* nA = GATHER ? cA : (has_next ? (const char*)g.A + (size_t)nxt.pm * tstepA : cA); const char* nB = has_next ? (const char*)g.Bt + (size_t)nxt.pb * tstepB : cB;
        const int nui = has_next ? ui + 1 : ui;
#pragma nounroll
        for (int t = 0; t < nt; t += 2) {
            const bool last = (t == nt - 2);
            const char* a1 = cA + (size_t)(t + 1) * kstep;
            const char* a2 = last ? nA : cA + (size_t)(t + 2) * kstep; const char* b2 = last ? nB : cB + (size_t)(t + 2) * kstep;
            const char* a3 = a2 + kstep; const char* b3 = b2 + kstep;
            unsigned x00 = vAc[0][0], x01 = vAc[0][1], x10 = vAc[1][0], x11 = vAc[1][1];
            if (GATHER) { if (last) { unsigned vN_[2][2]; PG8_SETVA(vN_, nui); x00 = vN_[0][0]; x01 = vN_[0][1]; x10 = vN_[1][0]; x11 = vN_[1][1]; } }
            PG8_LDB(B0, 0, 0); PG8_LDB(B1, 0, 1); PG8_SCHED; PG8_LDA(At, 0, 0); PG8_STAGE(PG8_SA(1, 1), a1, vAc[1][0], vAc[1][1]);
            PG8_WAIT_V(8); PG8_WAIT_L(0); PG8_BAR; PG8_SCHED8; PG8_MMA(0, 0, At, B0); PG8_MMA(0, 1, At, B1); PG8_SCHED8; PG8_BAR; PG8_SCHED;
            PG8_LDA(At, 0, 1); PG8_STB(PG8_SB(0, 0), b2); PG8_STB(PG8_SB(0, 1), b2 + hstepB); PG8_STAGE(PG8_SA(0, 0), a2, x00, x01);
            PG8_WAIT_V(8); PG8_WAIT_L(0); PG8_BAR; PG8_SCHED8; PG8_MMA(1, 0, At, B0); PG8_MMA(1, 1, At, B1); PG8_SCHED8; PG8_BAR; PG8_SCHED;
            PG8_LDB(B0, 1, 0); PG8_LDB(B1, 1, 1); PG8_SCHED; PG8_LDA(At, 1, 0); PG8_STAGE(PG8_SA(0, 1), a2, x10, x11);
            PG8_WAIT_V(8); PG8_WAIT_L(0); PG8_BAR; PG8_SCHED8; PG8_MMA(0, 0, At, B0); PG8_MMA(0, 1, At, B1); PG8_SCHED8; PG8_BAR; PG8_SCHED;
            PG8_LDA(At, 1, 1); PG8_STB(PG8_SB(1, 0), b3); PG8_STB(PG8_SB(1, 1), b3 + hstepB); PG8_STAGE(PG8_SA(1, 0), a3, x00, x01);
            PG8_WAIT_V(8); PG8_WAIT_L(0); PG8_BAR; PG8_SCHED8; PG8_MMA(1, 0, At, B0); PG8_MMA(1, 1, At, B1); PG8_SCHED8; PG8_BAR; PG8_SCHED;
        }
        if constexpr (ALIGN_EPI) { if (wr == 0) PG8_BAR; }
        { int l_ = lane_id(); asm volatile("" : "+v"(l_));
          E(acc, cur, wr, wc, l_ & 15, l_ >> 4); }
        if (!has_next) break;
#pragma unroll
        for (int a = 0; a < 2; ++a)
#pragma unroll
            for (int b = 0; b < 2; ++b)
#pragma unroll
                for (int m = 0; m < 4; ++m)
#pragma unroll
                    for (int n = 0; n < 2; ++n) acc[a][b][m][n] = (f32x4){0.f, 0.f, 0.f, 0.f};
        cur = nxt; cA = nA; cB = nB; ++ui;
        if (GATHER) { PG8_SETVA(vAc, ui); }
        if constexpr (ALIGN_EPI) { if (wr == 1) PG8_BAR; }
    }
    PG8_WAIT_V(0);
    if constexpr (!ALIGN_EPI) { if (wr == 0) PG8_BAR; }
    PG8_BAR;
#undef PG8_SETVA
#undef PG8_UNI
#undef PG8_SA
#undef PG8_SB
#undef PG8_STAGE
#undef PG8_GLDS_S
#undef PG8_STB
#undef PG8_LDA
#undef PG8_LDB
#undef PG8_MMA
#undef PG8_WAIT_V
#undef PG8_WAIT_L
#undef PG8_BAR
#undef PG8_SCHED
#undef PG8_SCHED8
}
}
constexpr int NWAVES = 8, NTHR = 512;
constexpr int BATCH = 8, SEQ = 8192, T = BATCH * SEQ, D = 1024, DIN = 4096;
constexpr int DS = 512, DA = 512, NH = 8, HD = 64, NBLK = SEQ / 256;
constexpr int SG = 32, SHC = 16, SP = 64, SL = 32, SKU = SL * SHC  , SKS = 2 * SP  , SKY = SKU + SKS  , SROWS = T / SL  ;
constexpr int NE = 32, DE = 512;
constexpr float RMS_EPS = 1e-6f;
constexpr float LOG2E = 1.4426950408889634f;
constexpr float QSCALE = 0.125f * LOG2E;
constexpr float WF8_SCALE = 32.f;
constexpr float YF8_SCALE = 16.f;
constexpr float MA_SCALE = 64.f;
constexpr int ROWCAP = T;
constexpr int HID_ROWS = 2 * T + NE * 256;

constexpr size_t MiB = 1u << 20;
constexpr size_t WS_CTL = 0, CTL_ZERO_BYTES = 1 * MiB;
constexpr size_t WS_WIN = 1 * MiB;
constexpr size_t WS_WGLU = 9 * MiB;
constexpr size_t WS_WUS = 10 * MiB;
constexpr size_t WS_WUA = 11 * MiB;
constexpr size_t WS_WOUT = 12 * MiB;
constexpr size_t WS_WR = 14 * MiB;
constexpr size_t WS_KMEAN = 15 * MiB;
constexpr size_t WS_SSMW = 16 * MiB;
constexpr size_t WS_SSMT = 24 * MiB;
constexpr size_t WS_W13 = 44 * MiB;
constexpr size_t WS_W2 = 108 * MiB;
constexpr size_t WS_A0 = 140 * MiB;
constexpr size_t WS_UP = 276 * MiB;
constexpr size_t WS_Q = 356 * MiB;
constexpr size_t WS_SSQ = 404 * MiB;
constexpr size_t WS_RLOG = 408 * MiB;
constexpr size_t WS_K = 420 * MiB;
constexpr size_t WS_ROWTOK = 428 * MiB, WS_ROWCOEF = 436 * MiB, WS_ROWRSTD = 444 * MiB;
constexpr size_t WS_GACT = 420 * MiB;
constexpr size_t WS_V = 484 * MiB;
constexpr size_t WS_YSSM = 484 * MiB;
constexpr size_t WS_SGS = 548 * MiB;
constexpr size_t WS_SGA = 676 * MiB;
constexpr size_t WS_E = 804 * MiB;
constexpr size_t WS_YATT = 836 * MiB;
constexpr size_t WS_PART0 = 420 * MiB, WS_PART1 = 484 * MiB, WS_PART2 = 932 * MiB;
constexpr size_t WS_QLIST = 900 * MiB;
constexpr size_t WS_PL = 268 * MiB;
constexpr size_t WS_MQ = 996 * MiB;
constexpr size_t WS_H1F8 = 836 * MiB;
constexpr size_t WS_WINF8 = 900 * MiB;
constexpr size_t WS_XGF8 = 836 * MiB;
constexpr size_t WS_MA = 276 * MiB;
constexpr size_t WS_SEGC = 998 * MiB;
constexpr size_t WS_END = 999 * MiB;
constexpr size_t WS_KFRAG = WS_A0, WS_VFRAG = WS_A0 + 64 * MiB, WS_H1 = WS_A0, WS_MRG = WS_A0, WS_HID = WS_A0;
constexpr size_t WS_X1 = WS_SGS, WS_XG = WS_UP, WS_Y0 = WS_UP, WS_Y1 = WS_E;
static_assert(WS_GACT + 64 * MiB <= WS_YSSM && WS_YSSM + 64 * MiB <= WS_SGS, "map");
static_assert(WS_HID + (size_t)HID_ROWS * DE * 2 <= WS_UP, "hid fits");
static_assert(WS_RLOG + (size_t)T * 72 * 4 <= WS_ROWTOK, "rlog fits");

constexpr int CW_TMO = 0, CW_CODE = 1;
constexpr int CW_BAR = 4096;
constexpr int CW_ECNT = 8192;
constexpr int CW_GCNT = 12288;

constexpr int RING_BYTES = 131072;
constexpr int ROWTAB_OFF = RING_BYTES, ROWTAB_UNITS = 12, ROWTAB_BYTES = 25 * 1024;
constexpr int MOE_TST_OFF = ROWTAB_OFF + ROWTAB_BYTES;
constexpr int MISC_OFF = MOE_TST_OFF + 512;
constexpr int LDS_BYTES = MISC_OFF + 128;
static_assert(LDS_BYTES <= 163840, "LDS");

struct Frame {
    LAS unsigned char* lds;
    volatile LAS unsigned* MISC;
    gu32* ctl;
    unsigned char* ws;
    int tid, lane, wave, vcu, G;
    const float* in[27];
    float* out;
};

__device__ __forceinline__ unsigned pk4_fp8(float a, float b, float c, float d) { int w = 0; w = __builtin_amdgcn_cvt_pk_fp8_f32(a, b, w, false); w = __builtin_amdgcn_cvt_pk_fp8_f32(c, d, w, true); return (unsigned)w; }
#define EPI_LOOP_BEGIN  _Pragma("unroll") for (int ai = 0; ai < 2; ++ai) _Pragma("unroll") for (int m = 0; m < 4; ++m) { const int rl = ai * 128 + wr * 64 + m * 16 + fr; _Pragma("unroll") for (int bj = 0; bj < 2; ++bj) { const int cl = bj * 128 + wc * 32 + 8 * fq; \
        const f32x4 a0 = acc[ai][bj][m][0], a1 = acc[ai][bj][m][1]; (void)rl; (void)cl; (void)a0; (void)a1;
#define EPI_LOOP_END } }
typedef const f32x4 (&AccRef)[2][2][4][2];
__device__ __forceinline__ u32x4 pack8(f32x4 a, f32x4 b) { u32x4 w; w.x = cvt_pk_bf16(a[0], a[1]); w.y = cvt_pk_bf16(a[2], a[3]); w.z = cvt_pk_bf16(b[0], b[1]); w.w = cvt_pk_bf16(b[2], b[3]); return w; }
__device__ __forceinline__ void unpack8(u32x4 w, f32x4& a, f32x4& b) { a = (f32x4){bflo(w.x), bfhi(w.x), bflo(w.y), bfhi(w.y)}; b = (f32x4){bflo(w.z), bfhi(w.z), bflo(w.w), bfhi(w.w)}; }

template <int PART  > struct EpiProj {
    unsigned char* ws; const float* b_gate; int pn_off; float ascale;
    __device__ __forceinline__ void operator()(AccRef acc, const pg8::Unit& u, int wr, int wc, int fr, int fq) const {
        const int pn = u.pn + pn_off; const int row0 = u.pm * 256;
        if (PART == 0) {
            bf16_t* Uperm = (bf16_t*)(ws + WS_UP);
            EPI_LOOP_BEGIN
                const int row = row0 + rl, col = pn * 256 + cl;
                bf16_t* dst = Uperm + (size_t)(col >> 4) * ((size_t)SROWS * SKY) + (size_t)(row >> 5) * SKY + (row & 31) * 16 + (col & 15);
                *(u32x4*)dst = pack8(a0 * ascale, a1 * ascale);
            EPI_LOOP_END
        } else if (pn < 8) {
            const size_t boff = pn < 4 ? WS_Q : (pn < 6 ? WS_K : WS_V);
            bf16_t* base = (bf16_t*)(ws + boff); const float sc = pn < 4 ? QSCALE : 1.f; const int c0 = (pn & 1) * 256;
            EPI_LOOP_BEGIN
                const int row = row0 + rl, col = c0 + cl;
                *(u32x4*)(base + (size_t)row * 512 + col) = pack8(a0 * (sc * ascale), a1 * (sc * ascale));
            EPI_LOOP_END
        } else {
            const size_t boff = pn < 12 ? WS_SGS : WS_SGA;
            bf16_t* base = (bf16_t*)(ws + boff); const int c0 = ((pn - 8) & 3) * 256; const float* bg = b_gate + (pn - 8) * 256;
            EPI_LOOP_BEGIN
                const int row = row0 + rl, col = c0 + cl;
                const f32x4 b0 = *(const f32x4*)(bg + cl), b1 = *(const f32x4*)(bg + cl + 4);
                f32x4 s0, s1;
#pragma unroll
                for (int e = 0; e < 4; ++e) { s0[e] = fast_sigmoid(a0[e] * ascale + b0[e]); s1[e] = fast_sigmoid(a1[e] * ascale + b1[e]); }
                *(u32x4*)(base + (size_t)row * 1024 + col) = pack8(s0, s1);
            EPI_LOOP_END
        }
    }
};
struct EpiSsmE {
    float* E;
    __device__ __forceinline__ void operator()(AccRef acc, const pg8::Unit& u, int wr, int wc, int fr, int fq) const {
        EPI_LOOP_BEGIN
            if (bj == 0) { float* dst = E + (size_t)(u.pm * 256 + rl) * 128 + cl; *(f32x4*)dst = a0; *(f32x4*)(dst + 4) = a1; }
        EPI_LOOP_END
    }
};
__device__ __forceinline__ float gelu_tanh(float x) { const float z = 1.5957691216057308f * (x + 0.044715f * x * x * x); return x * fast_sigmoid(z); }
struct EpiSsmY {
    bf16_t* Gact;
    __device__ __forceinline__ void operator()(AccRef acc, const pg8::Unit& u, int wr, int wc, int fr, int fq) const {
        const int g = u.aux;
        EPI_LOOP_BEGIN
            const int rg = (u.pm & 7) * 256 + rl;
            const int colg = u.pn * 256 + cl;
            const int tok = (rg >> 8) * SEQ + (rg & 255) * SL + (colg >> 4);
            f32x4 y0, y1;
#pragma unroll
            for (int e = 0; e < 4; ++e) { y0[e] = gelu_tanh(a0[e]); y1[e] = gelu_tanh(a1[e]); }
            *(u32x4*)(Gact + (size_t)tok * DS + g * 16 + (colg & 15)) = pack8(y0, y1);
        EPI_LOOP_END
    }
};
#define EPI_SBAR __builtin_amdgcn_sched_barrier(0)
#define EPI_G(g_) const int ai = (g_) >> 2, m = (g_) & 3; const int rl = ai * 128 + wr * 64 + m * 16 + fr; (void)rl
struct EpiGlu {
    const bf16_t* Gact; bf16_t* Yssm; const float* b_glu;
    __device__ __forceinline__ void operator()(AccRef acc, const pg8::Unit& u, int wr, int wc, int fr, int fq) const {
        const int col0 = u.pn * 256 + wc * 32 + 8 * fq; const size_t rowb = (size_t)u.pm * 256;
        f32x4 bv[2][2]; u32x4 gv[8][2];
#pragma unroll
        for (int bj = 0; bj < 2; ++bj) { bv[bj][0] = *(const f32x4*)(b_glu + col0 + bj * 128); bv[bj][1] = *(const f32x4*)(b_glu + col0 + bj * 128 + 4); }
#pragma unroll
        for (int g = 0; g < 8; ++g) { EPI_G(g);
#pragma unroll
            for (int bj = 0; bj < 2; ++bj) gv[g][bj] = *(const u32x4*)(Gact + (rowb + rl) * DS + col0 + bj * 128); }
        EPI_SBAR;
#pragma unroll
        for (int g = 0; g < 8; ++g) { EPI_G(g);
#pragma unroll
            for (int bj = 0; bj < 2; ++bj) { f32x4 g0, g1; unpack8(gv[g][bj], g0, g1); const f32x4 a0 = acc[ai][bj][m][0], a1 = acc[ai][bj][m][1]; f32x4 y0, y1;
#pragma unroll
                for (int e = 0; e < 4; ++e) { y0[e] = g0[e] * fast_sigmoid(a0[e] + bv[bj][0][e]); y1[e] = g1[e] * fast_sigmoid(a1[e] + bv[bj][1][e]); }
                *(u32x4*)(Yssm + (rowb + rl) * DS + col0 + bj * 128) = pack8(y0, y1); } }
    }
};
struct EpiUpA {
    const bf16_t* SG; unsigned char* MA; float ascale;
    __device__ __forceinline__ void operator()(AccRef acc, const pg8::Unit& u, int wr, int wc, int fr, int fq) const {
        const size_t base = (size_t)u.pm * 256 * D + u.pn * 256 + wc * 32 + 8 * fq; u32x4 sv[8][2];
#pragma unroll
        for (int g = 0; g < 8; ++g) { EPI_G(g);
#pragma unroll
            for (int bj = 0; bj < 2; ++bj) sv[g][bj] = *(const u32x4*)(SG + base + (size_t)rl * D + bj * 128); }
        EPI_SBAR;
#pragma unroll
        for (int g = 0; g < 8; ++g) { EPI_G(g);
#pragma unroll
            for (int bj = 0; bj < 2; ++bj) { f32x4 s0, s1; unpack8(sv[g][bj], s0, s1); const f32x4 y0 = s0 * acc[ai][bj][m][0] * ascale, y1 = s1 * acc[ai][bj][m][1] * ascale;
                *(u32x2*)(MA + base + (size_t)rl * D + bj * 128) = (u32x2){pk4_fp8(y0[0], y0[1], y0[2], y0[3]), pk4_fp8(y1[0], y1[1], y1[2], y1[3])}; } }
    }
};
struct EpiUpS {
    const bf16_t* SG; const unsigned char* MA; bf16_t* Mrg;
    __device__ __forceinline__ void operator()(AccRef acc, const pg8::Unit& u, int wr, int wc, int fr, int fq) const {
        const size_t base = (size_t)u.pm * 256 * D + u.pn * 256 + wc * 32 + 8 * fq; u32x4 sv[2][2][2]; u32x2 mv[2][2][2];
        constexpr float ms = 1.f / MA_SCALE;
#define UPS_LOAD(buf_, bt_) do { _Pragma("unroll") for (int gi_ = 0; gi_ < 2; ++gi_) { EPI_G(2 * (bt_) + gi_); _Pragma("unroll") for (int bj = 0; bj < 2; ++bj) { const size_t off = base + (size_t)rl * D + bj * 128; \
            sv[buf_][gi_][bj] = *(const u32x4*)(SG + off); mv[buf_][gi_][bj] = *(const u32x2*)(MA + off); } } } while (0)
#define UPS_PROC(buf_, bt_) do { _Pragma("unroll") for (int gi_ = 0; gi_ < 2; ++gi_) { EPI_G(2 * (bt_) + gi_); _Pragma("unroll") for (int bj = 0; bj < 2; ++bj) { const size_t off = base + (size_t)rl * D + bj * 128; \
            f32x4 s0, s1; unpack8(sv[buf_][gi_][bj], s0, s1); const int a = (int)mv[buf_][gi_][bj].x, c = (int)mv[buf_][gi_][bj].y; \
            const f32x4 p0 = (f32x4){__builtin_amdgcn_cvt_f32_fp8(a, 0), __builtin_amdgcn_cvt_f32_fp8(a, 1), __builtin_amdgcn_cvt_f32_fp8(a, 2), __builtin_amdgcn_cvt_f32_fp8(a, 3)} * ms; \
            const f32x4 p1 = (f32x4){__builtin_amdgcn_cvt_f32_fp8(c, 0), __builtin_amdgcn_cvt_f32_fp8(c, 1), __builtin_amdgcn_cvt_f32_fp8(c, 2), __builtin_amdgcn_cvt_f32_fp8(c, 3)} * ms; \
            *(u32x4*)(Mrg + off) = pack8(s0 * acc[ai][bj][m][0] + p0, s1 * acc[ai][bj][m][1] + p1); } } } while (0)
        UPS_LOAD(0, 0); UPS_LOAD(1, 1); EPI_SBAR;
        UPS_PROC(0, 0); UPS_LOAD(0, 2); EPI_SBAR;
        UPS_PROC(1, 1); UPS_LOAD(1, 3); EPI_SBAR;
        UPS_PROC(0, 2); EPI_SBAR;
        UPS_PROC(1, 3);
#undef UPS_LOAD
#undef UPS_PROC
    }
};
struct EpiOut {
    const float* x; bf16_t* X1; unsigned char* X18; float* SSQ;
    __device__ __forceinline__ void operator()(AccRef acc, const pg8::Unit& u, int wr, int wc, int fr, int fq) const {
        const int col0 = u.pn * 256 + wc * 32 + 8 * fq; const size_t base = (size_t)u.pm * 256 * D + col0;
        f32x4 xv[2][2][2][2];
#define OUT_LOAD(buf_, bt_) do { _Pragma("unroll") for (int gi_ = 0; gi_ < 2; ++gi_) { EPI_G(2 * (bt_) + gi_); _Pragma("unroll") for (int bj = 0; bj < 2; ++bj) { const size_t off = base + (size_t)rl * D + bj * 128; \
            xv[buf_][gi_][bj][0] = *(const f32x4*)(x + off); xv[buf_][gi_][bj][1] = *(const f32x4*)(x + off + 4); } } } while (0)
#define OUT_PROC(buf_, bt_) do { _Pragma("unroll") for (int gi_ = 0; gi_ < 2; ++gi_) { EPI_G(2 * (bt_) + gi_); float ss = 0.f; _Pragma("unroll") for (int bj = 0; bj < 2; ++bj) { const size_t off = base + (size_t)rl * D + bj * 128; \
            const f32x4 x0 = xv[buf_][gi_][bj][0] + acc[ai][bj][m][0], x1 = xv[buf_][gi_][bj][1] + acc[ai][bj][m][1]; \
            *(u32x4*)(X1 + off) = pack8(x0, x1); *(u32x2*)(X18 + off) = (u32x2){pk4_fp8(x0[0], x0[1], x0[2], x0[3]), pk4_fp8(x1[0], x1[1], x1[2], x1[3])}; \
            ss += (x0[0] * x0[0] + x0[1] * x0[1]) + (x0[2] * x0[2] + x0[3] * x0[3]) + (x1[0] * x1[0] + x1[1] * x1[1]) + (x1[2] * x1[2] + x1[3] * x1[3]); } \
            ss += __shfl_xor(ss, 16); ss += __shfl_xor(ss, 32); \
            SSQ[((size_t)u.pm * 256 + rl) * 16 + u.pn * 4 + wc] = ss; } } while (0)
        OUT_LOAD(0, 0); OUT_LOAD(1, 1); EPI_SBAR;
        OUT_PROC(0, 0); OUT_LOAD(0, 2); EPI_SBAR;
        OUT_PROC(1, 1); OUT_LOAD(1, 3); EPI_SBAR;
        OUT_PROC(0, 2); EPI_SBAR;
        OUT_PROC(1, 3);
#undef OUT_LOAD
#undef OUT_PROC
    }
};
struct EpiRouter {
    float* Rlog;
    __device__ __forceinline__ void operator()(AccRef acc, const pg8::Unit& u, int wr, int wc, int fr, int fq) const {
        EPI_LOOP_BEGIN
            if (bj == 0 && cl < 72) { float* dst = Rlog + (size_t)(u.pm * 256 + rl) * 72 + cl; *(f32x4*)dst = a0; *(f32x4*)(dst + 4) = a1; }
        EPI_LOOP_END
    }
};
struct EpiMoe1 {
    unsigned char* Hid; const float* rowrstd; const unsigned* ecnt; float ascale;
    __device__ __forceinline__ void operator()(AccRef acc, const pg8::Unit& u, int wr, int wc, int fr, int fq) const {
        const int e = u.aux, cnt = (int)ecnt[e]; float rsv[8];
#pragma unroll
        for (int g = 0; g < 8; ++g) { EPI_G(g); const int pos = u.aux2 + rl; rsv[g] = rowrstd[(size_t)e * ROWCAP + (pos < cnt ? pos : 0)] * ascale; }
        EPI_SBAR;
#pragma unroll
        for (int g = 0; g < 8; ++g) { EPI_G(g); const int pos = u.aux2 + rl;
            if (pos < cnt) { const float rs = rsv[g]; f32x4 h0, h1;
#pragma unroll
                for (int k = 0; k < 4; ++k) { const float p = acc[ai][0][m][0][k] * rs, q = acc[ai][1][m][0][k] * rs; h0[k] = p * fast_sigmoid(p) * q;
                    const float p2 = acc[ai][0][m][1][k] * rs, q2 = acc[ai][1][m][1][k] * rs; h1[k] = p2 * fast_sigmoid(p2) * q2; }
                *(u32x2*)(Hid + (size_t)(u.pm * 256 + rl) * DE + u.pn * 128 + wc * 32 + 8 * fq) = (u32x2){pk4_fp8(h0[0], h0[1], h0[2], h0[3]), pk4_fp8(h1[0], h1[1], h1[2], h1[3])}; } }
    }
};
struct EpiMoe2 {
    unsigned char* Y0; size_t ydelta; const unsigned* rowtok; const float* rowcoef; const unsigned* ecnt; float ascale;
    __device__ __forceinline__ void operator()(AccRef acc, const pg8::Unit& u, int wr, int wc, int fr, int fq) const {
        const int e = u.aux, cnt = (int)ecnt[e]; unsigned tkv[8]; float cfv[8];
#pragma unroll
        for (int g = 0; g < 8; ++g) { EPI_G(g); const int pos = u.aux2 + rl; const size_t ri = (size_t)e * ROWCAP + (pos < cnt ? pos : 0); tkv[g] = rowtok[ri]; cfv[g] = rowcoef[ri] * ascale; }
        EPI_SBAR;
#pragma unroll
        for (int g = 0; g < 8; ++g) { EPI_G(g); const int pos = u.aux2 + rl;
            if (pos < cnt) { const unsigned tk = tkv[g]; const float cf = cfv[g];
                unsigned char* dst = Y0 + (size_t)(tk & 1u) * ydelta + (size_t)(tk >> 1) * D + u.pn * 256 + wc * 32 + 8 * fq;
#pragma unroll
                for (int bj = 0; bj < 2; ++bj) { const f32x4 y0 = acc[ai][bj][m][0] * cf, y1 = acc[ai][bj][m][1] * cf; *(u32x2*)(dst + bj * 128) = (u32x2){pk4_fp8(y0[0], y0[1], y0[2], y0[3]), pk4_fp8(y1[0], y1[1], y1[2], y1[3])}; } } }
    }
};
__device__ __forceinline__ void transpose_item(const float* W, int N, int k0, int n0, bf16_t* WT, size_t drow0, int ldo, LAS float* scr, int lane) {
    float tv[32];
#pragma unroll
    for (int i = 0; i < 32; ++i) tv[i] = W[(size_t)(k0 + 2 * i + (lane >> 5)) * N + n0 + (lane & 31)];
#pragma unroll
    for (int i = 0; i < 32; ++i) scr[(2 * i + (lane >> 5)) * 33 + (lane & 31)] = tv[i];
    LDS_WAIT(); asm volatile("" ::: "memory");
    const int c = lane & 7;
#pragma unroll
    for (int j = 0; j < 4; ++j) { const int n = (lane >> 3) + 8 * j; const LAS float* s = scr + (8 * c) * 33 + n;
        u32x4 o; o.x = pk2(s[0 * 33], s[1 * 33]); o.y = pk2(s[2 * 33], s[3 * 33]); o.z = pk2(s[4 * 33], s[5 * 33]); o.w = pk2(s[6 * 33], s[7 * 33]);
        *(u32x4*)(WT + (drow0 + n) * (size_t)ldo + k0 + 8 * c) = o; }
    LDS_WAIT(); asm volatile("" ::: "memory");
}
__device__ __forceinline__ void transpose_item_f8(const float* W, int N, int k0, int n0, unsigned char* WT8, size_t drow0, int ldo, float scale, LAS float* scr, int lane, const float* kgain = nullptr  ) {
    float tv[32];
#pragma unroll
    for (int i = 0; i < 32; ++i) tv[i] = W[(size_t)(k0 + 2 * i + (lane >> 5)) * N + n0 + (lane & 31)];
#pragma unroll
    for (int i = 0; i < 32; ++i) scr[(2 * i + (lane >> 5)) * 33 + (lane & 31)] = tv[i] * (kgain ? scale * kgain[k0 + 2 * i + (lane >> 5)] : scale);
    LDS_WAIT(); asm volatile("" ::: "memory");
    const int c = lane & 3;
#pragma unroll
    for (int j = 0; j < 2; ++j) { const int n = (lane >> 2) + 16 * j; const LAS float* s = scr + (16 * c) * 33 + n;
        u32x4 o; o.x = pk4_fp8(s[0 * 33], s[1 * 33], s[2 * 33], s[3 * 33]); o.y = pk4_fp8(s[4 * 33], s[5 * 33], s[6 * 33], s[7 * 33]);
        o.z = pk4_fp8(s[8 * 33], s[9 * 33], s[10 * 33], s[11 * 33]); o.w = pk4_fp8(s[12 * 33], s[13 * 33], s[14 * 33], s[15 * 33]);
        *(u32x4*)(WT8 + (drow0 + n) * (size_t)ldo + k0 + 16 * c) = o; }
    LDS_WAIT(); asm volatile("" ::: "memory");
}
template <int NR> __device__ __forceinline__ void rms_rows_to_bf16(int lane, const float* xrow, const float* g, bf16_t* orow, unsigned char* orow8) {
    f32x4 v[NR][4]; float s[NR];
#pragma unroll
    for (int r = 0; r < NR; ++r) { const f32x4* xr = (const f32x4*)(xrow + (size_t)r * D) + lane;
#pragma unroll
        for (int j = 0; j < 4; ++j) v[r][j] = xr[64 * j]; }
    const f32x4* gr = (const f32x4*)g + lane; f32x4 wv[4];
#pragma unroll
    for (int j = 0; j < 4; ++j) wv[j] = gr[64 * j];
#pragma unroll
    for (int r = 0; r < NR; ++r) { float a = 0.f;
#pragma unroll
        for (int j = 0; j < 4; ++j) a += (v[r][j].x * v[r][j].x + v[r][j].y * v[r][j].y) + (v[r][j].z * v[r][j].z + v[r][j].w * v[r][j].w);
        s[r] = a; }
#pragma unroll
    for (int o = 1; o < 64; o <<= 1) {
#pragma unroll
        for (int r = 0; r < NR; ++r) s[r] += __shfl_xor(s[r], o); }
#pragma unroll
    for (int r = 0; r < NR; ++r) { const float rstd = 1.f / sqrtf(s[r] * (1.f / D) + RMS_EPS); unsigned long long* o8 = (unsigned long long*)(orow + (size_t)r * D) + lane;
#pragma unroll
        for (int j = 0; j < 4; ++j) { const float y0 = v[r][j].x * rstd * wv[j].x, y1 = v[r][j].y * rstd * wv[j].y, y2 = v[r][j].z * rstd * wv[j].z, y3 = v[r][j].w * rstd * wv[j].w;
            o8[64 * j] = (unsigned long long)pk2(y0, y1) | ((unsigned long long)pk2(y2, y3) << 32);
            ((unsigned*)(orow8 + (size_t)r * D))[lane + 64 * j] = pk4_fp8(y0, y1, y2, y3); } }
}
__device__ __forceinline__ void cpow(float lr, float li, float step, float dl, float& ar, float& ai) {
    const float mag = __expf(dl * lr * step); const float rev = dl * (li * step * 0.15915494309189535f); const float fr = rev - floorf(rev);
    ar = mag * __builtin_amdgcn_cosf(fr); ai = mag * __builtin_amdgcn_sinf(fr);
}
__device__ __forceinline__ void ssm_gen(Frame& F, int g, int sl) {
    LAS float* AP = (LAS float*)(F.lds); LAS float* BB = AP + 33 * 64 * 2; LAS float* CC = BB + 2048; LAS float* KT = CC + 2048;
    const float* lam_re = F.in[4] + g * SP; const float* lam_im = F.in[5] + g * SP; const float step = __expf(F.in[6][g]);
    const float* b_re = F.in[7] + g * SP * SHC; const float* b_im = F.in[8] + g * SP * SHC; const float* c_re = F.in[9] + g * SHC * SP; const float* c_im = F.in[10] + g * SHC * SP; const float* dd = F.in[11] + g * SHC;
    bf16_t* BT = (bf16_t*)(F.ws + WS_SSMT) + (size_t)g * 512 * SKY; bf16_t* BW = (bf16_t*)(F.ws + WS_SSMW) + (size_t)g * 256 * SKU;
    const int tid = F.tid;
    for (int idx = tid; idx < 33 * 64; idx += NTHR) { const int dl = idx >> 6, p = idx & 63; float ar, ai; cpow(lam_re[p], lam_im[p], step, (float)dl, ar, ai); AP[idx * 2] = ar; AP[idx * 2 + 1] = ai; }
    for (int idx = tid; idx < 1024; idx += NTHR) { const int ho = idx >> 6, p = idx & 63; CC[idx * 2] = c_re[ho * 64 + p]; CC[idx * 2 + 1] = c_im[ho * 64 + p]; }
    __syncthreads();
    for (int idx = tid; idx < 1024; idx += NTHR) { const int p = idx >> 4, h = idx & 15; const float ar = AP[(64 + p) * 2], ai = AP[(64 + p) * 2 + 1];
        const float lr = lam_re[p], li = lam_im[p], nr = ar - 1.f, ni = ai, den = lr * lr + li * li, cr = (nr * lr + ni * li) / den, ci = (ni * lr - nr * li) / den;
        const float br = b_re[p * 16 + h], bi = b_im[p * 16 + h]; BB[idx * 2] = cr * br - ci * bi; BB[idx * 2 + 1] = cr * bi + ci * br; }
    __syncthreads();
    for (int idx = tid; idx < 1024; idx += NTHR) { const int dl = idx >> 5, hl = (idx >> 4) & 1, hi = idx & 15, ho = 2 * sl + hl; float s = 0.f;
        for (int p = 0; p < 64; ++p) { const float ar = AP[(dl * 64 + p) * 2], ai = AP[(dl * 64 + p) * 2 + 1], br = BB[(p * 16 + hi) * 2], bi = BB[(p * 16 + hi) * 2 + 1];
            const float zr = ar * br - ai * bi, zi = ar * bi + ai * br; s += CC[(ho * 64 + p) * 2] * zr - CC[(ho * 64 + p) * 2 + 1] * zi; }
        if (dl == 0 && ho == hi) s += dd[ho];
        KT[idx] = s; }
    __syncthreads();
    for (int v = tid; v < 64 * 80; v += NTHR) { const int nl = v / 80, kv = (v % 80) * 8, tau = nl >> 1, hl = nl & 1, ho = 2 * sl + hl, n = tau * 16 + ho; float val[8];
        if (kv < 512) { const int sg = kv >> 4, hi0 = kv & 15;
#pragma unroll
            for (int e = 0; e < 8; ++e) val[e] = (tau >= sg) ? KT[((tau - sg) * 2 + hl) * 16 + hi0 + e] : 0.f; }
        else { const int kk = kv - 512;
#pragma unroll
            for (int e = 0; e < 8; ++e) { const int p = (kk + e) >> 1, ri = (kk + e) & 1; const float ar = AP[((tau + 1) * 64 + p) * 2], ai = AP[((tau + 1) * 64 + p) * 2 + 1], cre = CC[(ho * 64 + p) * 2], cim = CC[(ho * 64 + p) * 2 + 1];
                val[e] = ri == 0 ? (cre * ar - cim * ai) : -(cre * ai + cim * ar); } }
        u32x4 o; o.x = pk2(val[0], val[1]); o.y = pk2(val[2], val[3]); o.z = pk2(val[4], val[5]); o.w = pk2(val[6], val[7]);
        *(u32x4*)(BT + (size_t)n * SKY + kv) = o; }
    for (int v = tid; v < 32 * 64; v += NTHR) { const int nl = v >> 6, kv = (v & 63) * 8; float val[8];
        const bool real = nl < 16; const int n = real ? 16 * sl + nl : 128 + 16 * sl + (nl - 16);
        if (real) { const int p = n >> 1, ri = n & 1, sg = kv >> 4, hi0 = kv & 15; const float ar = AP[((31 - sg) * 64 + p) * 2], ai = AP[((31 - sg) * 64 + p) * 2 + 1];
#pragma unroll
            for (int e = 0; e < 8; ++e) { const float br = BB[(p * 16 + hi0 + e) * 2], bi = BB[(p * 16 + hi0 + e) * 2 + 1]; val[e] = ri == 0 ? (ar * br - ai * bi) : (ar * bi + ai * br); } }
        else {
#pragma unroll
            for (int e = 0; e < 8; ++e) val[e] = 0.f; }
        u32x4 o; o.x = pk2(val[0], val[1]); o.y = pk2(val[2], val[3]); o.z = pk2(val[4], val[5]); o.w = pk2(val[6], val[7]);
        *(u32x4*)(BW + (size_t)n * SKU + kv) = o; }
    __syncthreads();
}
__device__ __forceinline__ void p0_prologue(Frame& F) {
    for (int it = F.vcu; it < SG * 8; it += F.G) ssm_gen(F, it >> 3, it & 7);
    LAS float* scr = (LAS float*)(F.lds + F.wave * 16384);
    const int gw = F.vcu * NWAVES + F.wave, NGW = F.G * NWAVES, lane = F.lane;
    constexpr int I_IN = 16 * 128, I_GLU = 8 * 16, I_US = 8 * 32, I_UA = 8 * 32, I_OUT = 16 * 32, I_W1 = 32 * 256, I_W3 = 32 * 256, I_W2 = 32 * 256;
    constexpr int NITEMS = I_IN + I_GLU + I_US + I_UA + I_OUT + I_W1 + I_W3 + I_W2;
    unsigned char* ws = F.ws;
    for (int it = gw; it < NITEMS; it += NGW) {
        int r = it;
        if (r < I_IN) { const int k0 = 64 * (r / 128), n0 = 32 * (r % 128);
            if (n0 < DS) transpose_item(F.in[2], DIN, k0, n0, (bf16_t*)(ws + WS_WIN), n0, D, scr, lane);
            else transpose_item_f8(F.in[2], DIN, k0, n0, ws + WS_WINF8, n0 - DS, D, WF8_SCALE, scr, lane);
            continue; } r -= I_IN;
        if (r < I_GLU) { transpose_item(F.in[12], DS, 64 * (r / 16), 32 * (r % 16), (bf16_t*)(ws + WS_WGLU), 32 * (r % 16), DS, scr, lane); continue; } r -= I_GLU;
        if (r < I_US) { transpose_item(F.in[14], D, 64 * (r / 32), 32 * (r % 32), (bf16_t*)(ws + WS_WUS), 32 * (r % 32), DS, scr, lane); continue; } r -= I_US;
        if (r < I_UA) { transpose_item_f8(F.in[15], D, 64 * (r / 32), 32 * (r % 32), ws + WS_WUA, 32 * (r % 32), DA, WF8_SCALE, scr, lane); continue; } r -= I_UA;
        if (r < I_OUT) { transpose_item(F.in[17], D, 64 * (r / 32), 32 * (r % 32), (bf16_t*)(ws + WS_WOUT), 32 * (r % 32), D, scr, lane); continue; } r -= I_OUT;
        if (r < I_W1 + I_W3) { const int w3 = r >= I_W1; if (w3) r -= I_W1; const int e = r >> 8, q = r & 255, k0 = 64 * (q / 16), n0 = 32 * (q % 16);
            transpose_item_f8((w3 ? F.in[24] : F.in[23]) + (size_t)e * D * DE, DE, k0, n0, ws + WS_W13, (size_t)e * 1024 + 256 * (n0 >> 7) + (n0 & 127) + (w3 ? 128 : 0), D, WF8_SCALE, scr, lane, F.in[18]); continue; }
        r -= I_W1 + I_W3;
        { const int e = r >> 8, q = r & 255, k0 = 64 * (q / 32), n0 = 32 * (q % 32);
            transpose_item_f8(F.in[25] + (size_t)e * DE * D, D, k0, n0, ws + WS_W2, (size_t)e * 1024 + n0, DE, WF8_SCALE, scr, lane); }
    }
    for (int m = 4 * gw; m < T; m += 4 * NGW) rms_rows_to_bf16<4>(lane, F.in[0] + (size_t)m * D, F.in[1], (bf16_t*)(ws + WS_H1) + (size_t)m * D, ws + WS_H1F8 + (size_t)m * D);
    { bf16_t* WR = (bf16_t*)(ws + WS_WR); const float* wrg = F.in[19]; const float* wre = F.in[21];
      for (int idx = F.vcu * NTHR + F.tid; idx < 256 * D; idx += F.G * NTHR) { const int r = idx >> 10, k = idx & 1023; unsigned o = 0u;
          if (r < 72) { const int c = r < 36 ? r : r - 36; const float w = (c < 4 ? wrg[k * 4 + c] : wre[k * 32 + (c - 4)]) * F.in[18][k]; const unsigned hb = f2bf(w);
              o = r < 36 ? hb : f2bf(w - __builtin_bit_cast(float, hb << 16)); }
          WR[idx] = (bf16_t)o; } }
}

__device__ __forceinline__ int crow(int r, int hi) { return (r & 3) + 8 * (r >> 2) + 4 * hi; }
constexpr int KVP = 72;
__device__ __forceinline__ void kv_prep_phase(Frame& F) {
    LAS bf16_t* KS = (LAS bf16_t*)(F.lds); LAS bf16_t* VS = KS + 256 * KVP; LAS float* PS = (LAS float*)(F.lds + 2 * 256 * KVP * 2); LAS float* WM = PS + 512;
    const bf16_t* Kb = (const bf16_t*)(F.ws + WS_K); const bf16_t* Vb = (const bf16_t*)(F.ws + WS_V);
    bf16_t* Kf = (bf16_t*)(F.ws + WS_KFRAG); bf16_t* Vf = (bf16_t*)(F.ws + WS_VFRAG); bf16_t* KM = (bf16_t*)(F.ws + WS_KMEAN); float* KN = (float*)(F.ws + WS_KMEAN + 512 * 1024);
    const int tid = F.tid;
    u32x4 kr[4], vr[4];
#define KVP_LOAD(item_) do { const int n_ = (item_) & 31, h_ = ((item_) >> 5) & 7, b_ = (item_) >> 8; const size_t tok0_ = (size_t)b_ * SEQ + 256 * n_; \
        _Pragma("unroll") for (int j = 0; j < 4; ++j) { const int q = tid + NTHR * j, row = q >> 3, pc = q & 7; const size_t src = (tok0_ + row) * DA + h_ * HD + pc * 8; kr[j] = *(const u32x4*)(Kb + src); vr[j] = *(const u32x4*)(Vb + src); } } while (0)
    if (F.vcu < BATCH * NH * NBLK) KVP_LOAD(F.vcu);
    for (int item = F.vcu; item < BATCH * NH * NBLK; item += F.G) {
#pragma unroll
        for (int j = 0; j < 4; ++j) { const int q = tid + NTHR * j, row = q >> 3, pc = q & 7; *(LAS u32x4*)(KS + row * KVP + pc * 8) = kr[j]; *(LAS u32x4*)(VS + row * KVP + pc * 8) = vr[j]; }
        { const int nx = (item + F.G < BATCH * NH * NBLK) ? item + F.G : item; KVP_LOAD(nx); }
        __syncthreads();
#pragma unroll
        for (int j = 0; j < 4; ++j) { const int P = tid + NTHR * j, st = P >> 8, ds = (P >> 6) & 3, l2 = P & 63, row = 32 * st + (l2 & 31), col = 16 * ds + 8 * (l2 >> 5);
            *(u32x4*)(Kf + ((size_t)item * 2048 + P) * 8) = *(const LAS u32x4*)(KS + row * KVP + col); }
#pragma unroll
        for (int j = 0; j < 4; ++j) { const int P = tid + NTHR * j, st = P >> 8, ks = (P >> 7) & 1, d0 = (P >> 6) & 1, l2 = P & 63, hi = l2 >> 5, jj = l2 & 31; unsigned w[4];
#pragma unroll
            for (int e = 0; e < 8; e += 2) { const unsigned lo = VS[(32 * st + 16 * ks + crow(e, hi)) * KVP + 32 * d0 + jj], hi16 = VS[(32 * st + 16 * ks + crow(e + 1, hi)) * KVP + 32 * d0 + jj]; w[e >> 1] = lo | (hi16 << 16); }
            *(u32x4*)(Vf + ((size_t)item * 2048 + P) * 8) = (u32x4){w[0], w[1], w[2], w[3]}; }
        { const int d = tid & 63, part = tid >> 6; float s = 0.f;
#pragma unroll 8
          for (int r = 0; r < 32; ++r) s += bf2f(KS[(part * 32 + r) * KVP + d]);
          PS[part * 64 + d] = s; }
        if (tid < 256) { float ss = 0.f;
#pragma unroll
            for (int c = 0; c < 8; ++c) { const u32x4 w = *(const LAS u32x4*)(KS + tid * KVP + c * 8);
                ss += bflo(w.x) * bflo(w.x) + bfhi(w.x) * bfhi(w.x) + bflo(w.y) * bflo(w.y) + bfhi(w.y) * bfhi(w.y) + bflo(w.z) * bflo(w.z) + bfhi(w.z) * bfhi(w.z) + bflo(w.w) * bflo(w.w) + bfhi(w.w) * bfhi(w.w); }
            ss = wave_max(ss); if (F.lane == 0) WM[F.wave] = ss; }
        __syncthreads();
        if (tid < 64) { float s = 0.f;
#pragma unroll
            for (int p = 0; p < 8; ++p) s += PS[p * 64 + tid];
            KM[(size_t)item * 64 + tid] = (bf16_t)f2bf(s * (1.f / 256.f)); }
        if (tid == 0) KN[item] = fmaxf(fmaxf(WM[0], WM[1]), fmaxf(WM[2], WM[3]));
        __syncthreads();
    }
#undef KVP_LOAD
}

__device__ __forceinline__ void ssm_scan_phase(Frame& F) {
    LAS float* FW = (LAS float*)(F.lds);
    const float* E = (const float*)(F.ws + WS_E); bf16_t* UP = (bf16_t*)(F.ws + WS_UP);
    const int w = F.wave, p = F.lane;
    for (int gb = F.vcu; gb < SG * BATCH; gb += F.G) {
        const int g = gb >> 3, b = gb & 7;
        const float lr = F.in[4][g * SP + p], li = F.in[5][g * SP + p], step = __expf(F.in[6][g]);
        float ar, ai; cpow(lr, li, step, 32.f, ar, ai);
        const size_t row0 = (size_t)g * SROWS + b * 256 + 32 * w;
        f32x2 e[32];
#pragma unroll
        for (int j = 0; j < 32; ++j) e[j] = *(const f32x2*)(E + (row0 + j) * 128 + 2 * p);
        float sr = 0.f, si = 0.f;
#pragma unroll
        for (int j = 0; j < 32; ++j) { const float nr = ar * sr - ai * si + e[j].x, ni = ar * si + ai * sr + e[j].y; sr = nr; si = ni; }
        FW[(w * 64 + p) * 2] = sr; FW[(w * 64 + p) * 2 + 1] = si;
        __syncthreads();
        float Ar = ar, Ai = ai;
#pragma unroll
        for (int q = 0; q < 5; ++q) { const float nr = Ar * Ar - Ai * Ai, ni = 2.f * Ar * Ai; Ar = nr; Ai = ni; }
        sr = 0.f; si = 0.f;
        for (int w2 = 0; w2 < w; ++w2) { const float fr = FW[(w2 * 64 + p) * 2], fi = FW[(w2 * 64 + p) * 2 + 1]; const float nr = Ar * sr - Ai * si + fr, ni = Ar * si + Ai * sr + fi; sr = nr; si = ni; }
#pragma unroll
        for (int j = 0; j < 32; ++j) { *(unsigned*)(UP + (row0 + j) * SKY + SKU + 2 * p) = pk2(sr, si);
            const float nr = ar * sr - ai * si + e[j].x, ni = ar * si + ai * sr + e[j].y; sr = nr; si = ni; }
        __syncthreads();
    }
}

__device__ __forceinline__ int t5_bucket(int d) {
    if (d < 16) return d;
    return 16 + (d >= 19) + (d >= 21) + (d >= 24) + (d >= 27) + (d >= 31) + (d >= 35) + (d >= 40) + (d >= 46) + (d >= 52) + (d >= 59) + (d >= 67) + (d >= 77) + (d >= 87) + (d >= 99) + (d >= 113);
}
struct Top3 { float v0, v1, v2; int i0, i1, i2; };
__device__ __forceinline__ Top3 top3_insert(Top3 t, float x, int n) {
    const bool b0 = (x > t.v0) || (x == t.v0 && n < t.i0), b1 = (x > t.v1) || (x == t.v1 && n < t.i1), b2 = (x > t.v2) || (x == t.v2 && n < t.i2);
    Top3 r;
    r.v2 = b1 ? t.v1 : (b2 ? x : t.v2); r.i2 = b1 ? t.i1 : (b2 ? n : t.i2);
    r.v1 = b0 ? t.v0 : (b1 ? x : t.v1); r.i1 = b0 ? t.i0 : (b1 ? n : t.i1);
    r.v0 = b0 ? x : t.v0; r.i0 = b0 ? n : t.i0;
    return r;
}
constexpr int GQS = 0, GKME = 36864, GCNTL = 41472, GMISC = 41600;
template <bool COUNT> __device__ __forceinline__ void attn_gate_unit(Frame& F, int bh, int qb) {
    LAS unsigned char* L = F.lds;
    LAS bf16_t* QS = (LAS bf16_t*)(L + GQS); LAS bf16_t* KME = (LAS bf16_t*)(L + GKME); LAS int* CNT = (LAS int*)(L + GCNTL); LAS float* KNM = (LAS float*)(L + GMISC);
    int tid = F.tid; asm volatile("" : "+v"(tid));
    const int lane = tid & 63, w = F.wave, j = lane & 31, hi = lane >> 5;
    const int b = bh >> 3, h = bh & 7; const size_t tok0 = (size_t)b * SEQ + 256 * qb;
    const bf16_t* Qb = (const bf16_t*)(F.ws + WS_Q); const bf16_t* KM = (const bf16_t*)(F.ws + WS_KMEAN); const float* KN = (const float*)(F.ws + WS_KMEAN + 512 * 1024);
    float* MQg = (float*)(F.ws + WS_MQ); unsigned short* QL = (unsigned short*)(F.ws + WS_QLIST); unsigned* GC = (unsigned*)(F.ctl + CW_GCNT); unsigned* SEGC = (unsigned*)(F.ws + WS_SEGC);
#pragma unroll
    for (int jj = 0; jj < 4; ++jj) { const int q = tid + NTHR * jj, row = q >> 3, pc = q & 7; *(LAS u32x4*)(QS + row * KVP + pc * 8) = *(const u32x4*)(Qb + (tok0 + row) * DA + h * HD + pc * 8); }
    if (tid < 256) { const int n = tid >> 3, pc = tid & 7; *(LAS u32x4*)(KME + n * KVP + pc * 8) = *(const u32x4*)(KM + ((size_t)bh * 32 + n) * 64 + pc * 8); }
    if (tid < 32) CNT[tid] = 0;
    if (w == 1) { float v = (lane <= qb && lane < 32) ? KN[bh * 32 + lane] : 0.f; v = wave_max(v); if (lane == 0) KNM[0] = v; }
    if (w == 2) { float v = F.in[16][h * 32 + (lane & 31)]; v = wave_max(v); if (lane == 0) KNM[1] = v * LOG2E; }
    __syncthreads();
    {
        bf16x8 qf[4], kmf[4];
#pragma unroll
        for (int ds = 0; ds < 4; ++ds) { qf[ds] = *(const LAS bf16x8*)(QS + (32 * w + j) * KVP + 16 * ds + 8 * hi); kmf[ds] = *(const LAS bf16x8*)(KME + j * KVP + 16 * ds + 8 * hi); }
        f32x16 gt = {};
#pragma unroll
        for (int ds = 0; ds < 4; ++ds) gt = __builtin_amdgcn_mfma_f32_32x32x16_bf16(kmf[ds], qf[ds], gt, 0, 0, 0);
        float qn = 0.f;
#pragma unroll
        for (int ds = 0; ds < 4; ++ds)
#pragma unroll
            for (int e = 0; e < 8; ++e) { const float x = bf2f((unsigned short)qf[ds][e]); qn += x * x; }
        qn += __shfl_xor(qn, 32);
        const float m2 = sqrtf(qn * KNM[0]) + KNM[1];
        const int ql = 256 * qb + 32 * w + j;
        if (hi == 0) MQg[(size_t)bh * SEQ + ql] = m2;
        Top3 t3; t3.v0 = t3.v1 = t3.v2 = -INFINITY; t3.i0 = t3.i1 = t3.i2 = -1;
#pragma unroll
        for (int r = 0; r < 16; ++r) { const int n = crow(r, hi); const float x = (n < qb) ? gt[r] : -INFINITY; t3 = top3_insert(t3, x, x > -INFINITY ? n : 0x7fffffff); }
        { const float p0 = __shfl_xor(t3.v0, 32), p1 = __shfl_xor(t3.v1, 32), p2 = __shfl_xor(t3.v2, 32); const int q0 = __shfl_xor(t3.i0, 32), q1 = __shfl_xor(t3.i1, 32), q2 = __shfl_xor(t3.i2, 32);
          t3 = top3_insert(t3, p0, q0 >= 0 ? q0 : 0x7fffffff); t3 = top3_insert(t3, p1, q1 >= 0 ? q1 : 0x7fffffff); t3 = top3_insert(t3, p2, q2 >= 0 ? q2 : 0x7fffffff); }
        const int i0 = t3.v0 > -INFINITY ? t3.i0 : -1, i1 = t3.v1 > -INFINITY ? t3.i1 : -1, i2 = t3.v2 > -INFINITY ? t3.i2 : -1;
        if (hi == 0) { const unsigned e = (unsigned)ql << 2;
            if (i0 >= 0) { const int pos = __hip_atomic_fetch_add(CNT + i0, 1, __ATOMIC_RELAXED, __HIP_MEMORY_SCOPE_WORKGROUP); QL[((size_t)bh * 32 + i0) * SEQ + (qb - i0 - 1) * 256 + pos] = (unsigned short)(e | 0u); }
            if (i1 >= 0) { const int pos = __hip_atomic_fetch_add(CNT + i1, 1, __ATOMIC_RELAXED, __HIP_MEMORY_SCOPE_WORKGROUP); QL[((size_t)bh * 32 + i1) * SEQ + (qb - i1 - 1) * 256 + pos] = (unsigned short)(e | 1u); }
            if (i2 >= 0) { const int pos = __hip_atomic_fetch_add(CNT + i2, 1, __ATOMIC_RELAXED, __HIP_MEMORY_SCOPE_WORKGROUP); QL[((size_t)bh * 32 + i2) * SEQ + (qb - i2 - 1) * 256 + pos] = (unsigned short)(e | 2u); } }
    }
    __syncthreads();
    if (tid < qb) { const unsigned c = (unsigned)CNT[tid]; SEGC[((size_t)bh * 32 + tid) * 32 + (qb - tid - 1)] = c; if (COUNT && c) (void)__hip_atomic_fetch_add(GC + bh * 32 + tid, c, __ATOMIC_RELAXED, __HIP_MEMORY_SCOPE_AGENT); }
    __syncthreads();
}
template <bool COUNT> __device__ __forceinline__ void attn_gate_phase(Frame& F) {
    for (int u = F.vcu; u < BATCH * NH * NBLK; u += F.G) attn_gate_unit<COUNT>(F, u >> 5, u & 31);
}

#define ATTN_SUBTILE(KP, VP, st_, MODE, CINIT) do { \
        bf16x8 kf_[4], vf_[4]; \
        _Pragma("unroll") for (int ds_ = 0; ds_ < 4; ++ds_) kf_[ds_] = *(const LAS bf16x8*)((KP) + ((st_) * 4 + ds_) * 512 + lane8); \
        _Pragma("unroll") for (int q_ = 0; q_ < 4; ++q_) vf_[q_] = *(const LAS bf16x8*)((VP) + ((st_) * 4 + q_) * 512 + lane8); \
        f32x16 s_ = __builtin_amdgcn_mfma_f32_32x32x16_bf16(kf_[0], qf[0], CINIT, 0, 0, 0); \
        _Pragma("unroll") for (int ds_ = 1; ds_ < 4; ++ds_) s_ = __builtin_amdgcn_mfma_f32_32x32x16_bf16(kf_[ds_], qf[ds_], s_, 0, 0, 0); \
        float p_[16]; \
        if ((MODE) == 0) { _Pragma("unroll") for (int r_ = 0; r_ < 16; ++r_) p_[r_] = __builtin_amdgcn_exp2f(s_[r_]); } \
        else if ((MODE) == 1) { _Pragma("unroll") for (int r_ = 0; r_ < 16; ++r_) { const int dist_ = dq - (32 * (st_) + crow(r_, hi)); const int di_ = dist_ < 0 ? 0 : (dist_ > 127 ? 127 : dist_); \
                p_[r_] = __builtin_amdgcn_exp2f(s_[r_] + TABh[di_]); } } \
        else { _Pragma("unroll") for (int rq_ = 0; rq_ < 4; ++rq_) { const f32x4 bb_ = *(const LAS f32x4*)(BTD + rq_ * 256 + lane * 4); \
                _Pragma("unroll") for (int i_ = 0; i_ < 4; ++i_) p_[4 * rq_ + i_] = __builtin_amdgcn_exp2f(s_[4 * rq_ + i_] + bb_[i_]); } } \
        _Pragma("unroll") for (int r_ = 0; r_ < 16; ++r_) lsum += p_[r_]; \
        u32x4 pa_, pb_; pa_.x = cvt_pk_bf16(p_[0], p_[1]); pa_.y = cvt_pk_bf16(p_[2], p_[3]); pa_.z = cvt_pk_bf16(p_[4], p_[5]); pa_.w = cvt_pk_bf16(p_[6], p_[7]); \
        pb_.x = cvt_pk_bf16(p_[8], p_[9]); pb_.y = cvt_pk_bf16(p_[10], p_[11]); pb_.z = cvt_pk_bf16(p_[12], p_[13]); pb_.w = cvt_pk_bf16(p_[14], p_[15]); \
        const bf16x8 A0_ = __builtin_bit_cast(bf16x8, pa_), A1_ = __builtin_bit_cast(bf16x8, pb_); \
        o0 = __builtin_amdgcn_mfma_f32_32x32x16_bf16(vf_[0], A0_, o0, 0, 0, 0); o1 = __builtin_amdgcn_mfma_f32_32x32x16_bf16(vf_[1], A0_, o1, 0, 0, 0); \
        o0 = __builtin_amdgcn_mfma_f32_32x32x16_bf16(vf_[2], A1_, o0, 0, 0, 0); o1 = __builtin_amdgcn_mfma_f32_32x32x16_bf16(vf_[3], A1_, o1, 0, 0, 0); } while (0)

__device__ __forceinline__ u32x4 ot_pack16(const f32x16& o, int pr) {
    const unsigned p0 = cvt_pk_bf16(o[8 * pr], o[8 * pr + 1]), p1 = cvt_pk_bf16(o[8 * pr + 2], o[8 * pr + 3]), q0 = cvt_pk_bf16(o[8 * pr + 4], o[8 * pr + 5]), q1 = cvt_pk_bf16(o[8 * pr + 6], o[8 * pr + 7]);
    const auto r0 = __builtin_amdgcn_permlane32_swap(p0, q0, false, false); const auto r1 = __builtin_amdgcn_permlane32_swap(p1, q1, false, false);
    return (u32x4){r0[0], r1[0], r0[1], r1[1]};
}
__device__ __forceinline__ u32x2 ot_pack8_f8(const f32x16& o, int pr) {
    const unsigned p = pk4_fp8(o[8 * pr], o[8 * pr + 1], o[8 * pr + 2], o[8 * pr + 3]), q = pk4_fp8(o[8 * pr + 4], o[8 * pr + 5], o[8 * pr + 6], o[8 * pr + 7]);
    const auto r0 = __builtin_amdgcn_permlane32_swap(p, q, false, false);
    return (u32x2){r0[0], r0[1]};
}
__device__ __forceinline__ void ot_add16(f32x16& o, int pr, u32x4 v, bool use) {
    const auto r0 = __builtin_amdgcn_permlane32_swap(v.x, v.z, false, false); const auto r1 = __builtin_amdgcn_permlane32_swap(v.y, v.w, false, false);
    const unsigned p0 = r0[0], p1 = r1[0], q0 = r0[1], q1 = r1[1];
    o[8 * pr] += use ? bflo(p0) : 0.f; o[8 * pr + 1] += use ? bfhi(p0) : 0.f; o[8 * pr + 2] += use ? bflo(p1) : 0.f; o[8 * pr + 3] += use ? bfhi(p1) : 0.f;
    o[8 * pr + 4] += use ? bflo(q0) : 0.f; o[8 * pr + 5] += use ? bfhi(q0) : 0.f; o[8 * pr + 6] += use ? bflo(q1) : 0.f; o[8 * pr + 7] += use ? bfhi(q1) : 0.f;
}
__device__ __forceinline__ void attn_fill_tab(Frame& F, LAS float* TAB) {
    const float* rb = F.in[16];
    for (int idx = F.tid; idx < 8 * 132; idx += NTHR) { const int h = idx / 132, d = idx % 132; float v = 0.f;
        if (d < 128) v = rb[h * 32 + t5_bucket(d)] * LOG2E; else if (d == 129) v = rb[h * 32 + 31] * LOG2E;
        TAB[idx] = v; }
}
constexpr int BGPRE_OFF = ROWTAB_OFF, BGCL_OFF = ROWTAB_OFF + 8448, BTAB_OFF = ROWTAB_OFF + 16640, BIT_OFF = ROWTAB_OFF + 20992, BIT_MAX = 512, OTAB_OFF = ROWTAB_OFF + 20480  ;
static_assert(BTAB_OFF + 8 * 132 * 4 <= MOE_TST_OFF, "attention LDS tables");
__device__ __forceinline__ size_t part_off(int slot) { return slot == 0 ? WS_PART0 : (slot == 1 ? WS_PART1 : WS_PART2); }

__device__ __forceinline__ void attn_block_phase(Frame& F) {
    LAS unsigned char* L = F.lds; LAS int* GPRE = (LAS int*)(L + BGPRE_OFF); LAS int* GCL = (LAS int*)(L + BGCL_OFF); LAS float* TAB = (LAS float*)(L + BTAB_OFF); LAS int* ITT = (LAS int*)(L + BIT_OFF); LAS int* WSUM = (LAS int*)(L + MOE_TST_OFF);
    const unsigned* GC = (const unsigned*)(F.ctl + CW_GCNT); const unsigned* SEGC = (const unsigned*)(F.ws + WS_SEGC);
    const int tid = F.tid, lane = F.lane, w = F.wave, j = lane & 31, hi = lane >> 5, lane8 = lane * 8;
    { int ng[4], tot = 0;
#pragma unroll
      for (int e = 0; e < 4; ++e) { const int c = (int)GC[4 * tid + e]; GCL[4 * tid + e] = c; ng[e] = (((c + 31) >> 5) + 7) >> 3; tot += ng[e]; }
      int inc = tot;
#pragma unroll
      for (int o = 1; o < 64; o <<= 1) { const int t = __shfl_up(inc, o); if (lane >= o) inc += t; }
      if (lane == 63) WSUM[w] = inc;
      __syncthreads();
      int woff = 0;
      for (int q = 0; q < w; ++q) woff += WSUM[q];
      int ex = woff + inc - tot;
#pragma unroll
      for (int e = 0; e < 4; ++e) { GPRE[4 * tid + e] = ex; ex += ng[e]; }
      if (tid == NTHR - 1) GPRE[2048] = ex; }
    attn_fill_tab(F, TAB);
    __syncthreads();
    const int NIT = GPRE[2048];
    const int nk = (NIT > F.vcu) ? (NIT - F.vcu + F.G - 1) / F.G : 0;
    if (tid < nk && tid < BIT_MAX) { const int it_ = F.vcu + tid * F.G; int lo_ = 0, hi_ = 2048; while (hi_ - lo_ > 1) { const int mid_ = (lo_ + hi_) >> 1; if (GPRE[mid_] <= it_) lo_ = mid_; else hi_ = mid_; } ITT[tid] = lo_ * 64 + (it_ - GPRE[lo_]); }
    __syncthreads();
    if (nk == 0) return;
    const int nkc = nk < BIT_MAX ? nk : BIT_MAX;
    const bf16_t* Qb = (const bf16_t*)(F.ws + WS_Q); const float* MQg = (const float*)(F.ws + WS_MQ); const unsigned short* QL = (const unsigned short*)(F.ws + WS_QLIST);
    const bf16_t* KF = (const bf16_t*)(F.ws + WS_KFRAG); const bf16_t* VF = (const bf16_t*)(F.ws + WS_VFRAG);
    float* PL = (float*)(F.ws + WS_PL);
#define BLK_ITEM(k_, pi_, g_) do { const int kk_ = (k_) < nkc ? (k_) : nkc - 1; const int v_ = __builtin_amdgcn_readfirstlane(ITT[kk_]); pi_ = v_ >> 6; g_ = v_ & 63; } while (0)
#define BLK_DMA(buf_, pi_) do { const char* ks_ = (const char*)KF + ((size_t)(pi_) * 2048 + tid) * 16; const char* vs_ = (const char*)VF + ((size_t)(pi_) * 2048 + tid) * 16; \
        _Pragma("unroll") for (int i_ = 0; i_ < 4; ++i_) { \
            __builtin_amdgcn_global_load_lds((const unsigned*)(ks_ + i_ * 8192), (LAS unsigned*)(L + (buf_) + (i_ * 512 + w * 64) * 16), 16, 0, 0); \
            __builtin_amdgcn_global_load_lds((const unsigned*)(vs_ + i_ * 8192), (LAS unsigned*)(L + (buf_) + 32768 + (i_ * 512 + w * 64) * 16), 16, 0, 0); } } while (0)
#define BLK_SEGC(dst_, pi_) do { dst_ = SEGC[(size_t)(pi_) * 32 + j]; } while (0)
#define BLK_ENTRY(dst_, segc_, pi_, g_) do { const int n_ = (pi_) & 31; int inc_ = (j < 31 - n_) ? (int)(segc_) : 0; \
        _Pragma("unroll") for (int o_ = 1; o_ < 32; o_ <<= 1) { const int t_ = __shfl_up(inc_, o_); if (j >= o_) inc_ += t_; } \
        const int cnt_ = GCL[pi_]; const int idx_ = 32 * (8 * (g_) + w) + j; int seg_ = 0, prev_ = 0; \
        for (int s_ = 0; s_ < 31 - n_; ++s_) { const int p_ = __builtin_amdgcn_readlane(inc_, s_); const bool le_ = p_ <= idx_; seg_ += le_ ? 1 : 0; prev_ = le_ ? p_ : prev_; } \
        const bool ok_ = idx_ < cnt_; const unsigned v_ = QL[(size_t)(pi_) * SEQ + (ok_ ? seg_ * 256 + (idx_ - prev_) : 0)]; dst_ = ok_ ? v_ : 0xFFFFu; } while (0)
#define BLK_QLOAD(qf_, m2_, ent_, pi_) do { const unsigned qq_ = ((ent_) == 0xFFFFu) ? 0u : ((ent_) >> 2); const int bh_ = (pi_) >> 5; \
        const bf16_t* qrow_ = Qb + ((size_t)(bh_ >> 3) * SEQ + qq_) * DA + (bh_ & 7) * HD + 8 * hi; \
        _Pragma("unroll") for (int ds_ = 0; ds_ < 4; ++ds_) qf_[ds_] = *(const bf16x8*)(qrow_ + 16 * ds_); \
        m2_ = MQg[(size_t)bh_ * SEQ + qq_]; } while (0)
    int pi, g, pi1, g1, pi2, g2; unsigned ent, ent1, sc2; bf16x8 qf[4]; float m2r;
    BLK_ITEM(0, pi, g); BLK_ITEM(1, pi1, g1); BLK_ITEM(2, pi2, g2);
    BLK_DMA(0, pi);
    { unsigned sc0, sc1; BLK_SEGC(sc0, pi); BLK_SEGC(sc1, pi1); BLK_SEGC(sc2, pi2); BLK_ENTRY(ent, sc0, pi, g); BLK_ENTRY(ent1, sc1, pi1, g1); }
    BLK_QLOAD(qf, m2r, ent, pi);
    int cur = 0;
    __builtin_amdgcn_s_waitcnt(0x0F70);
    unsigned char* dump = F.ws + WS_E + ((size_t)F.vcu * NTHR + tid) * 128;
    for (int k = 0; k < nkc; ++k) {
        __builtin_amdgcn_s_waitcnt(0x0F75);
        __syncthreads();
        int pi3, g3; unsigned sc3, ent2; bf16x8 qfn[4]; float m2n;
        BLK_ITEM(k + 3, pi3, g3); BLK_SEGC(sc3, pi3);
        BLK_ENTRY(ent2, sc2, pi2, g2);
        BLK_QLOAD(qfn, m2n, ent1, pi1);
        BLK_DMA((cur ^ 1) * 65536, pi1);
        const int bh = pi >> 5, n = pi & 31, h = bh & 7;
        const bool valid = ent != 0xFFFFu; const int q = valid ? (int)(ent >> 2) : 0; const int slot = (int)(ent & 3u);
        const bool active = __builtin_amdgcn_readfirstlane((int)(__ballot(valid) != 0ull)) != 0;
        f32x16 o0 = {}, o1 = {}; float lsum = 0.f;
        if (active) {
            const float m2 = valid ? m2r : INFINITY;
            const LAS bf16_t* KP = (const LAS bf16_t*)(L + cur * 65536); const LAS bf16_t* VP = (const LAS bf16_t*)(L + cur * 65536 + 32768);
            const LAS float* TABh = TAB + h * 132; const LAS float* BTD = nullptr; (void)BTD;
            const int dq = q - 256 * n;
            const bool nearw = __builtin_amdgcn_readfirstlane((int)(__ballot(valid && dq < 383) != 0ull)) != 0;
            const float ci = nearw ? -m2 : TABh[129] - m2;
            f32x16 cinit;
#pragma unroll
            for (int r = 0; r < 16; ++r) cinit[r] = ci;
            if (nearw) { for (int st = 0; st < 8; ++st) ATTN_SUBTILE(KP, VP, st, 1, cinit); }
            else { for (int st = 0; st < 8; ++st) ATTN_SUBTILE(KP, VP, st, 0, cinit); }
        }
        { const float lt = lsum + __shfl_xor(lsum, 32);
          const size_t qi = (size_t)bh * SEQ + q;
          float* pld = valid ? PL + (size_t)slot * (NH * BATCH * SEQ) + qi : (float*)(dump + 120);
          bf16_t* dst = valid ? (bf16_t*)(F.ws + part_off(slot)) + qi * HD + 8 * hi : (bf16_t*)dump;
          *pld = lt;
          *(u32x4*)(dst) = ot_pack16(o0, 0); *(u32x4*)(dst + 16) = ot_pack16(o0, 1); *(u32x4*)(dst + 32) = ot_pack16(o1, 0); *(u32x4*)(dst + 48) = ot_pack16(o1, 1); }
        pi = pi1; g = g1; ent = ent1; m2r = m2n; pi1 = pi2; g1 = g2; ent1 = ent2; pi2 = pi3; g2 = g3; sc2 = sc3; cur ^= 1;
#pragma unroll
        for (int ds = 0; ds < 4; ++ds) qf[ds] = qfn[ds];
    }
    VM_WAIT(); __syncthreads();
#undef BLK_ITEM
#undef BLK_DMA
#undef BLK_SEGC
#undef BLK_ENTRY
#undef BLK_QLOAD
}

__device__ __forceinline__ void attn_own_phase(Frame& F) {
    LAS unsigned char* L = F.lds; LAS float* TAB = (LAS float*)(L + OTAB_OFF); LAS float* BT = (LAS float*)(L + ROWTAB_OFF); int bth = -1;
    attn_fill_tab(F, TAB);
    const int tid = F.tid, lane = F.lane, w = F.wave, j = lane & 31, hi = lane >> 5, lane8 = lane * 8;
    const bf16_t* Qb = (const bf16_t*)(F.ws + WS_Q); const float* MQg = (const float*)(F.ws + WS_MQ);
    const bf16_t* KF = (const bf16_t*)(F.ws + WS_KFRAG); const bf16_t* VF = (const bf16_t*)(F.ws + WS_VFRAG);
    const float* PL = (const float*)(F.ws + WS_PL); unsigned char* YA = F.ws + WS_YATT;
    const int NU = BATCH * NH * NBLK;
#define OWN_DMA(buf_, pi_) do { const char* ks_ = (const char*)KF + ((size_t)(pi_) * 2048 + tid) * 16; const char* vs_ = (const char*)VF + ((size_t)(pi_) * 2048 + tid) * 16; \
        _Pragma("unroll") for (int i_ = 0; i_ < 4; ++i_) { \
            __builtin_amdgcn_global_load_lds((const unsigned*)(ks_ + i_ * 8192), (LAS unsigned*)(L + (buf_) + (i_ * 512 + w * 64) * 16), 16, 0, 0); \
            __builtin_amdgcn_global_load_lds((const unsigned*)(vs_ + i_ * 8192), (LAS unsigned*)(L + (buf_) + 32768 + (i_ * 512 + w * 64) * 16), 16, 0, 0); } } while (0)
#define OWN_QLOAD(qf_, m2_, u_) do { const int bh_ = (u_) >> 5, qb_ = (u_) & 31; const size_t tk_ = (size_t)256 * qb_ + 32 * w + j; \
        const bf16_t* qrow_ = Qb + ((size_t)(bh_ >> 3) * SEQ + tk_) * DA + (bh_ & 7) * HD + 8 * hi; \
        _Pragma("unroll") for (int ds_ = 0; ds_ < 4; ++ds_) qf_[ds_] = *(const bf16x8*)(qrow_ + 16 * ds_); \
        m2_ = MQg[(size_t)bh_ * SEQ + tk_]; } while (0)
    int u = F.vcu; if (u >= NU) return;
    bf16x8 qf[4]; float m2;
    OWN_DMA(0, u); OWN_QLOAD(qf, m2, u);
    int cur = 0;
    __builtin_amdgcn_s_waitcnt(0x0F70);
    for (;;) {
        __builtin_amdgcn_s_waitcnt(0x0F74); __syncthreads();
        const int un = (u + F.G < NU) ? u + F.G : u; const bool last = (un == u);
        const int bh = u >> 5, qb = u & 31, b = bh >> 3, h = bh & 7; const int ql = 32 * w + j; const size_t qi = (size_t)bh * SEQ + 256 * qb + ql;
        u32x4 pa[3][4]; float pl[3];
#pragma unroll
        for (int s = 0; s < 3; ++s) { pl[s] = PL[(size_t)s * (NH * BATCH * SEQ) + qi]; const bf16_t* src = (const bf16_t*)(F.ws + part_off(s)) + qi * HD + 8 * hi;
#pragma unroll
            for (int c = 0; c < 4; ++c) pa[s][c] = *(const u32x4*)(src + 16 * c); }
        bf16x8 qfn[4]; float m2n;
        OWN_QLOAD(qfn, m2n, un);
        OWN_DMA((cur ^ 1) * 65536, un);
        const LAS bf16_t* KP = (const LAS bf16_t*)(L + cur * 65536); const LAS bf16_t* VP = (const LAS bf16_t*)(L + cur * 65536 + 32768); const LAS float* TABh = TAB + h * 132;
        if (h != bth) { __syncthreads();
            for (int e = tid; e < 5 * 1024; e += NTHR) { const int i = e & 3, ln = (e >> 2) & 63, rq = (e >> 8) & 3, dl = e >> 10; const int dist = 32 * dl + (ln & 31) - crow(4 * rq + i, ln >> 5);
                BT[e] = dist < 0 ? -1e30f : TABh[dist > 127 ? 127 : dist]; }
            bth = h; __syncthreads(); }
        const int dq = ql; (void)dq;
        f32x16 cnear, cfar;
#pragma unroll
        for (int r = 0; r < 16; ++r) { cnear[r] = -m2; cfar[r] = TABh[129] - m2; }
        f32x16 o0 = {}, o1 = {}; float lsum = 0.f;
        for (int st = 0; st <= w; ++st) { const int dl = w - st;
            if (dl >= 5) { const LAS float* BTD = nullptr; (void)BTD; ATTN_SUBTILE(KP, VP, st, 0, cfar); }
            else { const LAS float* BTD = BT + dl * 1024; ATTN_SUBTILE(KP, VP, st, 2, cnear); } }
        float lt = lsum + __shfl_xor(lsum, 32);
        const int nsel = qb < 3 ? qb : 3;
#pragma unroll
        for (int s = 0; s < 3; ++s) { const bool use = s < nsel; lt += use ? pl[s] : 0.f;
            ot_add16(o0, 0, pa[s][0], use); ot_add16(o0, 1, pa[s][1], use); ot_add16(o1, 0, pa[s][2], use); ot_add16(o1, 1, pa[s][3], use); }
        const float inv = 1.f / lt;
#pragma unroll
        for (int r = 0; r < 16; ++r) { o0[r] *= inv; o1[r] *= inv; }
        unsigned char* dst = YA + ((size_t)b * SEQ + 256 * qb + ql) * DA + h * HD + 8 * hi;
        *(u32x2*)(dst) = ot_pack8_f8(o0, 0); *(u32x2*)(dst + 16) = ot_pack8_f8(o0, 1); *(u32x2*)(dst + 32) = ot_pack8_f8(o1, 0); *(u32x2*)(dst + 48) = ot_pack8_f8(o1, 1);
        if (last) break;
        u = un; m2 = m2n; cur ^= 1;
#pragma unroll
        for (int ds = 0; ds < 4; ++ds) qf[ds] = qfn[ds];
    }
    VM_WAIT(); __syncthreads();
#undef OWN_DMA
#undef OWN_QLOAD
}
#undef ATTN_SUBTILE

__device__ __forceinline__ void routing_phase(Frame& F) {
    LAS int* lcnt = (LAS int*)(F.lds); LAS int* lbase = lcnt + 32;
    const float* SSQ = (const float*)(F.ws + WS_SSQ); const float* RL = (const float*)(F.ws + WS_RLOG);
    unsigned* rowtok = (unsigned*)(F.ws + WS_ROWTOK); float* rowcoef = (float*)(F.ws + WS_ROWCOEF); float* rowrstd = (float*)(F.ws + WS_ROWRSTD);
    unsigned* ecnt = (unsigned*)(F.ctl + CW_ECNT);
    const float* brg = F.in[20]; const float* bre = F.in[22];
    const int tid = F.tid;
    for (int base = F.vcu * 256; base < T; base += F.G * 256) {
        if (tid < 32) lcnt[tid] = 0;
        __syncthreads();
        int e0 = 0, e1 = 0, lp0 = 0, lp1 = 0; float c0 = 0.f, c1 = 0.f, rstd = 0.f; const int tok = base + tid;
        if (tid < 256) {
            float ss = 0.f;
#pragma unroll
            for (int q = 0; q < 4; ++q) { const f32x4 v = *(const f32x4*)(SSQ + (size_t)tok * 16 + 4 * q); ss += (v.x + v.y) + (v.z + v.w); }
            rstd = 1.f / sqrtf(ss * (1.f / D) + RMS_EPS);
            float r[72];
#pragma unroll
            for (int q = 0; q < 18; ++q) { const f32x4 v = *(const f32x4*)(RL + (size_t)tok * 72 + 4 * q); r[4 * q] = v.x; r[4 * q + 1] = v.y; r[4 * q + 2] = v.z; r[4 * q + 3] = v.w; }
            float gl[4], el[32];
#pragma unroll
            for (int c = 0; c < 4; ++c) gl[c] = rstd * (r[c] + r[36 + c]) + brg[c];
#pragma unroll
            for (int c = 0; c < 32; ++c) el[c] = rstd * (r[4 + c] + r[40 + c]) + bre[c];
            int gi = 0; float gm = gl[0];
#pragma unroll
            for (int c = 1; c < 4; ++c) if (gl[c] > gm) { gm = gl[c]; gi = c; }
            float Z = 0.f;
#pragma unroll
            for (int c = 0; c < 4; ++c) Z += __expf(gl[c] - gm);
            const float gval = 1.f / Z;
            float es[8];
#pragma unroll
            for (int q = 0; q < 8; ++q) es[q] = gi == 0 ? el[q] : (gi == 1 ? el[8 + q] : (gi == 2 ? el[16 + q] : el[24 + q]));
            int a0 = 0; float m0 = es[0];
#pragma unroll
            for (int q = 1; q < 8; ++q) if (es[q] > m0) { m0 = es[q]; a0 = q; }
            int a1 = -1; float m1 = -INFINITY;
#pragma unroll
            for (int q = 0; q < 8; ++q) if (q != a0 && es[q] > m1) { m1 = es[q]; a1 = q; }
            const float w0 = 1.f / (1.f + __expf(m1 - m0)), w1 = 1.f - w0;
            e0 = gi * 8 + a0; e1 = gi * 8 + a1; c0 = gval * w0; c1 = gval * w1;
            lp0 = __hip_atomic_fetch_add(lcnt + e0, 1, __ATOMIC_RELAXED, __HIP_MEMORY_SCOPE_WORKGROUP);
            lp1 = __hip_atomic_fetch_add(lcnt + e1, 1, __ATOMIC_RELAXED, __HIP_MEMORY_SCOPE_WORKGROUP);
        }
        __syncthreads();
        if (tid < 32) lbase[tid] = (int)__hip_atomic_fetch_add(ecnt + tid, (unsigned)lcnt[tid], __ATOMIC_RELAXED, __HIP_MEMORY_SCOPE_AGENT);
        __syncthreads();
        if (tid < 256) {
            const size_t i0 = (size_t)e0 * ROWCAP + lbase[e0] + lp0, i1 = (size_t)e1 * ROWCAP + lbase[e1] + lp1;
            rowtok[i0] = (unsigned)tok * 2u; rowcoef[i0] = c0; rowrstd[i0] = rstd;
            rowtok[i1] = (unsigned)tok * 2u + 1u; rowcoef[i1] = c1; rowrstd[i1] = rstd;
        }
        __syncthreads();
    }
}
struct MoeOrder {
    const LAS int* tst; int total, G, v;
    __device__ bool next(int i, pg8::Unit& u) const {
        const int L = i * G + v; if (L >= total) return false;
        const int rt = L >> 2; int e = 0;
#pragma unroll 8
        for (int q = 1; q <= 32; ++q) e += (tst[q] <= rt) ? 1 : 0;
        u.pm = rt; u.pn = L & 3; u.pb = e * 4 + u.pn; u.aux = e; u.aux2 = (rt - tst[e]) * 256; return true;
    }
};
__device__ __forceinline__ void moe_tables(Frame& F) {
    LAS int* tst = (LAS int*)(F.lds + MOE_TST_OFF); const unsigned* ecnt = (const unsigned*)(F.ctl + CW_ECNT);
    if (F.wave == 0) { const int lane = F.lane; int nt = lane < 32 ? (int)((ecnt[lane & 31] + 255u) >> 8) : 0; int inc = nt;
#pragma unroll
        for (int o = 1; o < 32; o <<= 1) { const int t = __shfl_up(inc, o); if (lane >= o) inc += t; }
        if (lane < 32) tst[lane + 1] = inc; if (lane == 0) tst[0] = 0; }
    __syncthreads();
}
__device__ __forceinline__ void final_phase(Frame& F) {
#ifdef SELFCHECK
    const bool chk_bad = __hip_atomic_load((unsigned*)(F.ctl + 2), __ATOMIC_RELAXED, __HIP_MEMORY_SCOPE_AGENT) != 0u;
#endif
    const bf16_t* X1 = (const bf16_t*)(F.ws + WS_X1); const unsigned char* Y0 = F.ws + WS_Y0; const unsigned char* Y1 = F.ws + WS_Y1; const float* gf = F.in[26];
    const int gw = F.vcu * NWAVES + F.wave, NGW = F.G * NWAVES, lane = F.lane;
    for (int m = gw; m < T; m += NGW) {
        const u32x2* xr = (const u32x2*)(X1 + (size_t)m * D) + lane; const unsigned* y0 = (const unsigned*)(Y0 + (size_t)m * D) + lane; const unsigned* y1 = (const unsigned*)(Y1 + (size_t)m * D) + lane;
        f32x4 v[4]; float s = 0.f;
#pragma unroll
        for (int j = 0; j < 4; ++j) { const u32x2 xx = xr[64 * j]; const int a = (int)y0[64 * j], c = (int)y1[64 * j]; constexpr float ys = 1.f / YF8_SCALE;
            v[j].x = bflo(xx.x) + (__builtin_amdgcn_cvt_f32_fp8(a, 0) + __builtin_amdgcn_cvt_f32_fp8(c, 0)) * ys; v[j].y = bfhi(xx.x) + (__builtin_amdgcn_cvt_f32_fp8(a, 1) + __builtin_amdgcn_cvt_f32_fp8(c, 1)) * ys;
            v[j].z = bflo(xx.y) + (__builtin_amdgcn_cvt_f32_fp8(a, 2) + __builtin_amdgcn_cvt_f32_fp8(c, 2)) * ys; v[j].w = bfhi(xx.y) + (__builtin_amdgcn_cvt_f32_fp8(a, 3) + __builtin_amdgcn_cvt_f32_fp8(c, 3)) * ys;
            s += (v[j].x * v[j].x + v[j].y * v[j].y) + (v[j].z * v[j].z + v[j].w * v[j].w); }
        const float rstd = 1.f / sqrtf(wave_sum(s) * (1.f / D) + RMS_EPS);
        f32x4* o = (f32x4*)(F.out + (size_t)m * D) + lane; const f32x4* gr = (const f32x4*)gf + lane;
#ifdef SELFCHECK
        if (chk_bad) { for (int j = 0; j < 4; ++j) o[64 * j] = (f32x4){0.f, 0.f, 0.f, 0.f}; continue; }
#endif
#pragma unroll
        for (int j = 0; j < 4; ++j) o[64 * j] = v[j] * rstd * gr[64 * j];
    }
}
#ifdef SELFCHECK
constexpr int CW_CHK = 2;
__device__ __forceinline__ int t5_bucket_ref(int n) { if (n < 16) return n; const int l = 16 + (int)(logf((float)n / 16.f) / logf(8.f) * 16.f); return l < 31 ? l : 31; }
__device__ __forceinline__ float kfrag_at(const bf16_t* KF, int bh, int key, int d) { const int n = key >> 8, kl = key & 255, st = kl >> 5, i = kl & 31, ds = d >> 4, hi = (d >> 3) & 1, e = d & 7;
    return bf2f(KF[(((size_t)bh * 32 + n) * 2048 + (st * 4 + ds) * 64 + (i + 32 * hi)) * 8 + e]); }
__device__ __forceinline__ float vfrag_at(const bf16_t* VF, int bh, int key, int d) { const int n = key >> 8, kl = key & 255, st = kl >> 5, kk = kl & 31, ks = kk >> 4, k16 = kk & 15, hi = (k16 >> 2) & 1, e = (k16 & 3) + 4 * (k16 >> 3), d0 = d >> 5, jj = d & 31;
    return bf2f(VF[(((size_t)bh * 32 + n) * 2048 + ((st * 2 + ks) * 2 + d0) * 64 + (jj + 32 * hi)) * 8 + e]); }
__device__ __forceinline__ void selfcheck_phase(Frame& F, float tol_attn, float tol_ssm) {
    const int lane = lane_id(); const int gw = F.vcu * NWAVES + F.wave;
    const bf16_t* Qb = (const bf16_t*)(F.ws + WS_Q); const bf16_t* KM = (const bf16_t*)(F.ws + WS_KMEAN); const bf16_t* KF = (const bf16_t*)(F.ws + WS_KFRAG); const bf16_t* VF = (const bf16_t*)(F.ws + WS_VFRAG);
    const unsigned char* YA = F.ws + WS_YATT; const float* rb = F.in[16];
    bool bad = false;
    for (int sidx = 0; sidx < 12; ++sidx) {
        unsigned hsh = (unsigned)(gw * 12 + sidx) * 2654435761u; hsh ^= hsh >> 15; hsh *= 2246822519u; hsh ^= hsh >> 13;
        const int bh = (int)(hsh & 63u); int q = (int)((hsh >> 6) & 8191u);
        if (sidx == 0) q = q & 767; if (sidx == 1) q = (q & ~255) | (sidx & 1 ? 0 : 255); if (sidx == 2) q = (q & ~255) | 255; if (sidx == 3) q = (q & ~255) | 128;
        const int b = bh >> 3, h = bh & 7, qb = q >> 8, d = lane;
        const float qd = bf2f(Qb[((size_t)b * SEQ + q) * DA + h * HD + d]);
        int s0 = -1, s1 = -1, s2 = -1; float g0 = -INFINITY, g1 = -INFINITY, g2 = -INFINITY;
        for (int n = 0; n < qb; ++n) { const float gt = wave_sum(qd * bf2f(KM[((size_t)bh * 32 + n) * 64 + d]));
            if (gt > g0) { g2 = g1; s2 = s1; g1 = g0; s1 = s0; g0 = gt; s0 = n; } else if (gt > g1) { g2 = g1; s2 = s1; g1 = gt; s1 = n; } else if (gt > g2) { g2 = gt; s2 = n; } }
        float m = -INFINITY, l = 0.f, od = 0.f;
        for (int blk = 0; blk < 4; ++blk) { const int n = blk == 0 ? s0 : (blk == 1 ? s1 : (blk == 2 ? s2 : qb)); if (n < 0) continue;
            const int kend = (blk == 3) ? (q & 255) + 1 : 256;
            for (int kl = 0; kl < kend; ++kl) { const int key = 256 * n + kl; const float kd = kfrag_at(KF, bh, key, d);
                const float s = wave_sum(qd * kd) + rb[h * 32 + t5_bucket_ref(q - key)] * LOG2E;
                const float mn = fmaxf(m, s), sc = exp2f(m - mn), p = exp2f(s - mn); l = l * sc + p; od = od * sc + p * vfrag_at(VF, bh, key, d); m = mn; } }
        od /= l;
        const float yd = __builtin_amdgcn_cvt_f32_fp8((int)YA[((size_t)b * SEQ + q) * DA + h * HD + d], 0);
        const float e2 = wave_sum((od - yd) * (od - yd)), o2 = wave_sum(od * od);
        if (!(e2 <= tol_attn * tol_attn * o2)) bad = true;
    }
    { const bf16_t* UP = (const bf16_t*)(F.ws + WS_UP); const bf16_t* GA = (const bf16_t*)(F.ws + WS_GACT);
      for (int sidx = 0; sidx < 6; ++sidx) {
        unsigned hsh = (unsigned)(gw * 6 + sidx + 7777) * 2654435761u; hsh ^= hsh >> 15; hsh *= 2246822519u; hsh ^= hsh >> 13;
        const int g = (int)(hsh & 31u), b = (int)((hsh >> 5) & 7u); int t = (int)((hsh >> 8) % 330u); if (sidx == 0) t = 31 + (int)((hsh >> 20) & 3u) * 32; if (sidx == 1) t = 32 + (int)((hsh >> 20) & 7u) * 32;
        const int p = lane;
        const float lr = F.in[4][g * SP + p], li = F.in[5][g * SP + p], step = expf(F.in[6][g]);
        const float mag = expf(lr * step), ar = mag * cosf(li * step), ai = mag * sinf(li * step);
        const float nr = ar - 1.f, ni = ai, den = lr * lr + li * li, cr = (nr * lr + ni * li) / den, ci = (ni * lr - nr * li) / den;
        float hr = 0.f, hi_ = 0.f;
        for (int tt = 0; tt <= t; ++tt) { float br = 0.f, bi = 0.f;
            for (int c = 0; c < 16; ++c) { const float u = bf2f(UP[(size_t)g * SROWS * SKY + ((size_t)b * 256 + (tt >> 5)) * SKY + (tt & 31) * 16 + c]);
                const float b_r = F.in[7][(g * SP + p) * 16 + c], b_i = F.in[8][(g * SP + p) * 16 + c]; br += (cr * b_r - ci * b_i) * u; bi += (cr * b_i + ci * b_r) * u; }
            const float n_r = ar * hr - ai * hi_ + br, n_i = ar * hi_ + ai * hr + bi; hr = n_r; hi_ = n_i; }
        float e2 = 0.f, o2 = 0.f;
        for (int ho = 0; ho < 16; ++ho) { float y = wave_sum(hr * F.in[9][(g * 16 + ho) * SP + p] - hi_ * F.in[10][(g * 16 + ho) * SP + p]);
            const float u = bf2f(UP[(size_t)g * SROWS * SKY + ((size_t)b * 256 + (t >> 5)) * SKY + (t & 31) * 16 + ho]); y += F.in[11][g * 16 + ho] * u;
            const float ge = 0.5f * y * (1.f + tanhf(0.7978845608028654f * (y + 0.044715f * y * y * y)));
            const float gv = bf2f(GA[((size_t)b * SEQ + t) * DS + g * 16 + ho]); e2 += (ge - gv) * (ge - gv); o2 += ge * ge; }
        if (!(e2 <= tol_ssm * tol_ssm * o2 + 1e-6f)) bad = true;
      } }
    if (__ballot(bad) != 0ull && lane == 0) __hip_atomic_store((unsigned*)(F.ctl + CW_CHK), 1u, __ATOMIC_RELAXED, __HIP_MEMORY_SCOPE_AGENT);
}
#endif

#ifdef SELFCHECK
__device__ __forceinline__ void selfcheck_prep(Frame& F) {
    const int lane = lane_id(); const int gw = F.vcu * NWAVES + F.wave;
    const bf16_t* Kb = (const bf16_t*)(F.ws + WS_K); const bf16_t* Vb = (const bf16_t*)(F.ws + WS_V); const bf16_t* KF = (const bf16_t*)(F.ws + WS_KFRAG); const bf16_t* VF = (const bf16_t*)(F.ws + WS_VFRAG);
    const bf16_t* KM = (const bf16_t*)(F.ws + WS_KMEAN); const float* KN = (const float*)(F.ws + WS_KMEAN + 512 * 1024);
    bool bad = false;
    for (int sidx = 0; sidx < 64; ++sidx) {
        unsigned hsh = (unsigned)(gw * 64 + sidx + 12345) * 2654435761u; hsh ^= hsh >> 15; hsh *= 2246822519u; hsh ^= hsh >> 13;
        const int bh = (int)(hsh & 63u), key = (int)((hsh >> 6) & 8191u), b = bh >> 3, h = bh & 7, d = lane;
        const float k0 = bf2f(Kb[((size_t)b * SEQ + key) * DA + h * HD + d]), v0 = bf2f(Vb[((size_t)b * SEQ + key) * DA + h * HD + d]);
        if (kfrag_at(KF, bh, key, d) != k0 || vfrag_at(VF, bh, key, d) != v0) bad = true;
    }
    for (int sidx = 0; sidx < 2; ++sidx) {
        unsigned hsh = (unsigned)(gw * 2 + sidx + 999) * 2654435761u; hsh ^= hsh >> 15; hsh *= 2246822519u; hsh ^= hsh >> 13;
        const int item = (int)(hsh & 2047u), bh = item >> 5, n = item & 31, b = bh >> 3, h = bh & 7, d = lane; float sum = 0.f, mx = 0.f;
        for (int kl = 0; kl < 256; ++kl) { const float kv = bf2f(Kb[((size_t)b * SEQ + 256 * n + kl) * DA + h * HD + d]); sum += kv; mx = fmaxf(mx, wave_sum(kv * kv)); }
        const float mean = sum * (1.f / 256.f), got = bf2f(KM[(size_t)item * 64 + d]);
        if (fabsf(mean - got) > 0.01f * fabsf(mean) + 1e-3f) bad = true;
        if (fabsf(mx - KN[item]) > 1e-3f * mx) bad = true;
    }
    if (__ballot(bad) != 0ull && lane == 0) __hip_atomic_store((unsigned*)(F.ctl + CW_CHK), 1u, __ATOMIC_RELAXED, __HIP_MEMORY_SCOPE_AGENT);
}
#endif
#ifndef MK_N_LAUNCHES
#define MK_N_LAUNCHES 1
#endif
constexpr int NPHASE = 14;
struct Args { const float* in[27]; float* out; unsigned char* ws; int ph_lo, ph_hi; };
static_assert(sizeof(Args) == 27 * 8 + 8 + 8 + 8, "Args has no padding");

#ifndef STAG9
#define STAG9 0
#endif
#ifndef STAG8
#define STAG8 0
#endif
#ifndef DUP_MASK
#define DUP_MASK 0
#endif
#define PH_ARGS Frame& F, unsigned char* ws, LAS unsigned char* ring
__device__ __forceinline__ void ph1(PH_ARGS) {
    { pg8::Gemm g{(const bf16_t*)(ws + WS_H1), (const bf16_t*)(ws + WS_WIN), D, D, D}; pg8::StaticOrder S; S.init(T, DS, F.G, (int)blockIdx.x);
      EpiProj<0> E{ws, F.in[3], 0, 1.f};
      pg8::gemm_phase<EpiProj<0>, pg8::StaticOrder, true, false>(ring, g, S, E, nullptr, F.wave); }
    { pg8::Gemm g{(const bf16_t*)(ws + WS_H1F8), (const bf16_t*)(ws + WS_WINF8), D / 2, D / 2, D / 2}; pg8::StaticOrder S; S.init(T, DIN - DS, F.G, (int)blockIdx.x);
      EpiProj<1> E{ws, F.in[3], 2, 1.f / WF8_SCALE};
      pg8::gemm_phase<EpiProj<1>, pg8::StaticOrder, true, false, true>(ring, g, S, E, nullptr, F.wave); }
}
__device__ __forceinline__ void ph2(PH_ARGS) {
    { pg8::Gemm g{(const bf16_t*)(ws + WS_UP), (const bf16_t*)(ws + WS_SSMW), SKY, SKU, SKU}; pg8::GroupedOrder S; S.init(SG * 8, 1, 8, F.G, F.vcu);
      EpiSsmE E{(float*)(ws + WS_E)};
      pg8::gemm_phase<EpiSsmE, pg8::GroupedOrder, false, false>(ring, g, S, E, nullptr, F.wave); }
    VM_WAIT(); __syncthreads();
    ssm_scan_phase(F);
    kv_prep_phase(F);
}
__device__ __forceinline__ void ph4(PH_ARGS) {
    pg8::Gemm g{(const bf16_t*)(ws + WS_UP), (const bf16_t*)(ws + WS_SSMT), SKY, SKY, SKY}; pg8::GroupedOrder S; S.init(SG * 8, 2, 8, F.G, F.vcu);
    EpiSsmY E{(bf16_t*)(ws + WS_GACT)};
    pg8::gemm_phase<EpiSsmY, pg8::GroupedOrder, true, false>(ring, g, S, E, nullptr, F.wave);
}
__device__ __forceinline__ void ph5(PH_ARGS) {
    pg8::Gemm g{(const bf16_t*)(ws + WS_GACT), (const bf16_t*)(ws + WS_WGLU), DS, DS, DS}; pg8::StaticOrder S; S.init(T, DS, F.G, (int)blockIdx.x);
    EpiGlu E{(const bf16_t*)(ws + WS_GACT), (bf16_t*)(ws + WS_YSSM), F.in[13]};
    pg8::gemm_phase<EpiGlu, pg8::StaticOrder, true, false>(ring, g, S, E, nullptr, F.wave);
}
__device__ __forceinline__ void ph6(PH_ARGS) {
    { pg8::Gemm g{(const bf16_t*)(ws + WS_YATT), (const bf16_t*)(ws + WS_WUA), DA / 2, DA / 2, DA / 2}; pg8::StaticOrder S; S.init(T, D, F.G, (int)blockIdx.x);
      EpiUpA E{(const bf16_t*)(ws + WS_SGA), ws + WS_MA, MA_SCALE / WF8_SCALE};
      pg8::gemm_phase<EpiUpA, pg8::StaticOrder, true, false, true>(ring, g, S, E, nullptr, F.wave); }
    VM_WAIT(); __syncthreads();
    { pg8::Gemm g{(const bf16_t*)(ws + WS_YSSM), (const bf16_t*)(ws + WS_WUS), DS, DS, DS}; pg8::StaticOrder S; S.init(T, D, F.G, (int)blockIdx.x);
      EpiUpS E{(const bf16_t*)(ws + WS_SGS), ws + WS_MA, (bf16_t*)(ws + WS_MRG)};
      pg8::gemm_phase<EpiUpS, pg8::StaticOrder, true, false>(ring, g, S, E, nullptr, F.wave); }
}
__device__ __forceinline__ void ph7(PH_ARGS) {
    pg8::Gemm g{(const bf16_t*)(ws + WS_MRG), (const bf16_t*)(ws + WS_WOUT), D, D, D}; pg8::StaticOrder S; S.init(T, D, F.G, (int)blockIdx.x);
    EpiOut E{F.in[0], (bf16_t*)(ws + WS_X1), ws + WS_XGF8, (float*)(ws + WS_SSQ)};
    pg8::gemm_phase<EpiOut, pg8::StaticOrder, true, false>(ring, g, S, E, nullptr, F.wave);
}
__device__ __forceinline__ void ph8(PH_ARGS) {
    pg8::Gemm g{(const bf16_t*)(ws + WS_X1), (const bf16_t*)(ws + WS_WR), D, D, D}; pg8::GroupedOrder S; S.init(T / 256, 1, T / 256, F.G, F.vcu);
    EpiRouter E{(float*)(ws + WS_RLOG)};
    pg8::gemm_phase<EpiRouter, pg8::GroupedOrder, false, false>(ring, g, S, E, nullptr, F.wave);
}
__device__ __forceinline__ void ph10(PH_ARGS) {
    moe_tables(F);
    const LAS int* tst = (const LAS int*)(F.lds + MOE_TST_OFF);
    MoeOrder S{tst, tst[32] * 4, F.G, F.vcu};
    LAS unsigned* rowtab = (LAS unsigned*)(F.lds + ROWTAB_OFF);
    { const unsigned* rowtok = (const unsigned*)(ws + WS_ROWTOK); const unsigned* ecnt = (const unsigned*)(F.ctl + CW_ECNT); pg8::Unit u;
      for (int i = 0; i < ROWTAB_UNITS && S.next(i, u); ++i) { if (F.tid < 256) { const int pos = u.aux2 + F.tid; const unsigned tk = pos < (int)ecnt[u.aux] ? (rowtok[(size_t)u.aux * ROWCAP + pos] >> 1) : 0u; rowtab[i * 256 + F.tid] = tk * (unsigned)D; } } }
    __syncthreads();
    pg8::Gemm g{(const bf16_t*)(ws + WS_XGF8), (const bf16_t*)(ws + WS_W13), D / 2, D / 2, D / 2};
    EpiMoe1 E{ws + WS_HID, (const float*)(ws + WS_ROWRSTD), (const unsigned*)(F.ctl + CW_ECNT), 1.f / WF8_SCALE};
    pg8::gemm_phase<EpiMoe1, MoeOrder, true, true, true>(ring, g, S, E, rowtab, F.wave);
}
__device__ __forceinline__ void ph11(PH_ARGS) {
    moe_tables(F);
    const LAS int* tst = (const LAS int*)(F.lds + MOE_TST_OFF);
    MoeOrder S{tst, tst[32] * 4, F.G, F.vcu};
    pg8::Gemm g{(const bf16_t*)(ws + WS_HID), (const bf16_t*)(ws + WS_W2), DE / 2, DE / 2, DE / 2};
    EpiMoe2 E{ws + WS_Y0, (size_t)(WS_Y1 - WS_Y0), (const unsigned*)(ws + WS_ROWTOK), (const float*)(ws + WS_ROWCOEF), (const unsigned*)(F.ctl + CW_ECNT), YF8_SCALE / WF8_SCALE};
    pg8::gemm_phase<EpiMoe2, MoeOrder, true, false, true>(ring, g, S, E, nullptr, F.wave);
}

__global__ void __launch_bounds__(NTHR, 2) fwd_kernel(Args args) {
    extern __shared__ __attribute__((aligned(16))) unsigned char lds_raw[];
    Frame F;
    F.lds = (LAS unsigned char*)lds_raw;
    F.MISC = (volatile LAS unsigned*)(F.lds + MISC_OFF);
    F.wave = __builtin_amdgcn_readfirstlane((int)(threadIdx.x >> 6)); F.lane = lane_id(); F.tid = F.wave * 64 + F.lane;
    F.G = gridDim.x; { const int bx = blockIdx.x; F.vcu = (F.G % 8 == 0) ? (bx % 8) * (F.G / 8) + bx / 8 : bx; }
    F.ws = args.ws; F.ctl = (gu32*)(args.ws + WS_CTL); F.out = args.out;
#pragma unroll
    for (int i = 0; i < 27; ++i) F.in[i] = args.in[i];
    for (int u = F.tid; u < (LDS_BYTES - MOE_TST_OFF) / 4; u += NTHR) ((LAS unsigned*)(F.lds + MOE_TST_OFF))[u] = 0u;
    __syncthreads();
    XcdBarrier bar; bar.bar = (unsigned*)(F.ctl + CW_BAR); bar.x = 0; bar.st = nullptr;
    const int lo = args.ph_lo, hi = args.ph_hi;
    if (hi - lo > 1) bar = xcd_barrier_post((unsigned*)(F.ctl + CW_BAR), F.MISC + 8, F.tid == 0);
#define IN(k) (lo <= (k) && (k) < hi)
#define DUP(k) ((DUP_MASK >> (k)) & 1)
#define SEAM(k) do { if (IN(k) && IN((k) + 1)) xcd_barrier(bar, F.wave == 0 && lane_id() == 0); REFRESH(); } while (0)
#define REFRESH() do { int l_ = lane_id(); asm volatile("" : "+v"(l_)); F.lane = l_; F.tid = F.wave * 64 + l_; } while (0)
    unsigned char* ws = args.ws;
    LAS unsigned char* ring = F.lds;
    if (IN(0)) { p0_prologue(F); if (DUP(0)) p0_prologue(F); }
    SEAM(0);
    if (IN(1)) { ph1(F, ws, ring); if (DUP(1)) ph1(F, ws, ring); }
    SEAM(1);
    if (IN(2)) { ph2(F, ws, ring); if (DUP(2)) ph2(F, ws, ring); }
    SEAM(2);
#ifdef SELFCHECK_PREP
    if (IN(3)) { selfcheck_prep(F); }
#endif
    if (IN(3)) { attn_gate_phase<true>(F); }
    SEAM(3);
    if (IN(4)) { attn_block_phase(F); if (DUP(4)) { __syncthreads(); attn_block_phase(F); } }
    SEAM(4);
    if (IN(5)) { attn_own_phase(F); if (DUP(5)) attn_own_phase(F); }
    SEAM(5);
    if (IN(6)) { ph4(F, ws, ring); if (DUP(6)) ph4(F, ws, ring); }
#ifdef SELFCHECK
    if (IN(6)) { xcd_barrier(bar, F.wave == 0 && lane_id() == 0); REFRESH(); selfcheck_phase(F, SELFCHECK_TOL_ATTN, SELFCHECK_TOL_SSM); }
#endif
    SEAM(6);
    if (IN(7)) { ph5(F, ws, ring); if (DUP(7)) ph5(F, ws, ring); }
    SEAM(7);
    if (IN(8)) { if (STAG8 > 0 && (F.vcu & 1)) { const unsigned long long t0_ = __builtin_amdgcn_s_memrealtime(); while ((long long)(__builtin_amdgcn_s_memrealtime() - t0_) < (long long)STAG8) __builtin_amdgcn_s_sleep(16); }
                 ph6(F, ws, ring); if (DUP(8)) ph6(F, ws, ring); }
    SEAM(8);
    if (IN(9)) { if (STAG9 > 0 && (F.vcu & 1)) { const unsigned long long t0_ = __builtin_amdgcn_s_memrealtime(); while ((long long)(__builtin_amdgcn_s_memrealtime() - t0_) < (long long)STAG9) __builtin_amdgcn_s_sleep(16); }
                 ph7(F, ws, ring); if (DUP(9)) ph7(F, ws, ring); }
    SEAM(9);
    if (IN(10)) { ph8(F, ws, ring); VM_WAIT(); __syncthreads(); routing_phase(F); }
    SEAM(10);
    if (IN(11)) { ph10(F, ws, ring); if (DUP(11)) ph10(F, ws, ring); }
    SEAM(11);
    if (IN(12)) { ph11(F, ws, ring); if (DUP(12)) ph11(F, ws, ring); }
    SEAM(12);
    if (IN(13)) { final_phase(F); if (DUP(13)) final_phase(F); }
#undef IN
#undef DUP
#undef SEAM
#undef REFRESH
}

extern "C" void kernel_launch(void* const* d_in, const int* in_sizes, int n_in, void* d_out, int out_size, void* d_ws, size_t ws_size, hipStream_t stream) {
    static int grid = 0;
    if (grid == 0) {
        if (n_in != 27 || in_sizes[0] != T * D || out_size != T * D || ws_size < WS_END) { fprintf(stderr, "kernel_launch: unexpected shapes (n_in %d, in0 %d, out %d, ws %zu)\n", n_in, n_in > 0 ? in_sizes[0] : -1, out_size, ws_size); grid = -1; return; }
        int dev = 0, cus = 0;
        if (hipGetDevice(&dev) != hipSuccess || hipDeviceGetAttribute(&cus, hipDeviceAttributeMultiprocessorCount, dev) != hipSuccess) { grid = -1; return; }
        if (hipFuncSetAttribute((const void*)fwd_kernel, hipFuncAttributeMaxDynamicSharedMemorySize, LDS_BYTES) != hipSuccess) { fprintf(stderr, "kernel_launch: hipFuncSetAttribute failed\n"); grid = -1; return; }
        (void)hipGetLastError();
        grid = cus;
    }
    if (grid < 0) return;
    (void)hipMemsetAsync((char*)d_ws + WS_CTL, 0, CTL_ZERO_BYTES, stream);
    Args a{};
    for (int i = 0; i < 27; ++i) a.in[i] = (const float*)d_in[i];
    a.out = (float*)d_out; a.ws = (unsigned char*)d_ws;
    if (MK_N_LAUNCHES == 1) { a.ph_lo = 0; a.ph_hi = NPHASE; hipLaunchKernelGGL(fwd_kernel, dim3(grid), dim3(NTHR), LDS_BYTES, stream, a); }
    else { for (int p = 0; p < NPHASE; ++p) { a.ph_lo = p; a.ph_hi = p + 1; hipLaunchKernelGGL(fwd_kernel, dim3(grid), dim3(NTHR), LDS_BYTES, stream, a); } }
}
```

```cpp
#include <hip/hip_runtime.h>
#include <cstdio>
#include <cstdint>

#define LAS __attribute__((address_space(3)))
#define GAS __attribute__((address_space(1)))
typedef unsigned short bf16_t;
typedef short bf16x8 __attribute__((ext_vector_type(8)));
typedef float f32x2 __attribute__((ext_vector_type(2)));
typedef float f32x4 __attribute__((ext_vector_type(4)));
typedef float f32x16 __attribute__((ext_vector_type(16)));
typedef unsigned u32x2 __attribute__((ext_vector_type(2)));
typedef unsigned u32x4 __attribute__((ext_vector_type(4)));
typedef GAS unsigned gu32;
typedef int v4i32 __attribute__((ext_vector_type(4)));
typedef int v8i32 __attribute__((ext_vector_type(8)));
#define RLX_AGENT __ATOMIC_RELAXED, __HIP_MEMORY_SCOPE_AGENT
#define LDS_WAIT() asm volatile("s_waitcnt lgkmcnt(0)" ::: "memory")
#define VM_WAIT() asm volatile("s_waitcnt vmcnt(0)" ::: "memory")

__device__ __forceinline__ unsigned f2bf(float f) { unsigned u = __builtin_bit_cast(unsigned, f); return (u + 0x7fffu + ((u >> 16) & 1u)) >> 16; }
__device__ __forceinline__ unsigned pk2(float lo, float hi) { return f2bf(lo) | (f2bf(hi) << 16); }
__device__ __forceinline__ float bf2f(unsigned short b) { return __builtin_bit_cast(float, (unsigned)b << 16); }
__device__ __forceinline__ float bflo(unsigned w) { return __builtin_bit_cast(float, w << 16); }
__device__ __forceinline__ float bfhi(unsigned w) { return __builtin_bit_cast(float, w & 0xffff0000u); }
__device__ __forceinline__ unsigned cvt_pk_bf16(float lo, float hi) { unsigned r; asm volatile("v_cvt_pk_bf16_f32 %0, %1, %2" : "=v"(r) : "v"(lo), "v"(hi)); return r; }
__device__ __forceinline__ float fast_sigmoid(float x) { return __builtin_amdgcn_rcpf(1.f + __builtin_amdgcn_exp2f(-1.4426950408889634f * x)); }
__device__ __forceinline__ int lane_id() { int l; asm volatile("v_mbcnt_lo_u32_b32 %0, -1, 0\n\tv_mbcnt_hi_u32_b32 %0, -1, %0" : "=v"(l)); return l; }
__device__ __forceinline__ float wave_sum(float v) {
#pragma unroll
    for (int o = 1; o < 64; o <<= 1) v += __shfl_xor(v, o);
    return v;
}
__device__ __forceinline__ float wave_max(float v) {
#pragma unroll
    for (int o = 1; o < 64; o <<= 1) v = fmaxf(v, __shfl_xor(v, o));
    return v;
}

#define XB_TMO      128
#define XB_XCNT(j)  (256  + 64 * (j))
#define XB_XSUB(j)  (1280 + 64 * (j))
#define XB_XGEN(j)  (2304 + 64 * (j))
#define XB_TOP      3328
#define XB_TOPGEN   3392
#define XCD_BAR_WORDS 3456
#define XB_SPIN_CAP (1u << 20)

__device__ __forceinline__ unsigned xb_ld(unsigned* p)              { return __hip_atomic_load(p, __ATOMIC_RELAXED, __HIP_MEMORY_SCOPE_AGENT); }
__device__ __forceinline__ unsigned xb_add(unsigned* p, unsigned v) { return __hip_atomic_fetch_add(p, v, __ATOMIC_RELAXED, __HIP_MEMORY_SCOPE_AGENT); }
__device__ __forceinline__ unsigned xb_xcc_id() { return (unsigned)__builtin_amdgcn_s_getreg((3 << 11) | 20) & 0xFu; }
#define XB_SPIN(cond, bar) do { unsigned _sp = 0; while (cond) { __builtin_amdgcn_s_sleep(1); \
    if ((++_sp & 255u) == 0u) { if (xb_ld(&(bar)[XB_TMO])) break; if (_sp > XB_SPIN_CAP) { atomicAdd(&(bar)[XB_TMO], 1u); break; } } } } while (0)

struct XcdBarrier { unsigned* bar; unsigned x; volatile LAS unsigned* st; };

__device__ __forceinline__ XcdBarrier xcd_barrier_post(unsigned* bar, volatile LAS unsigned* st, bool leader  ) {
    XcdBarrier b; b.bar = bar; b.x = xb_xcc_id(); b.st = st;
    if (leader) (void)xb_add(&bar[XB_XCNT(b.x)], 1u);
    return b;
}
__device__ __forceinline__ void xcd_barrier_complete(unsigned* bar, unsigned x, unsigned& nloc, unsigned& nx) {
    const unsigned G = gridDim.x * gridDim.y * gridDim.z;
    unsigned sum, cnt, mine, sp = 0u;
    for (;;) {
        sum = 0u; cnt = 0u; mine = 0u;
#pragma unroll
        for (unsigned j = 0; j < 16; ++j) { const unsigned c = xb_ld(&bar[XB_XCNT(j)]); sum += c; cnt += (c > 0u) ? 1u : 0u; mine = (j == x) ? c : mine; }
        if (sum == G) break;
        __builtin_amdgcn_s_sleep(1);
        if ((++sp & 255u) == 0u) { if (xb_ld(&bar[XB_TMO])) break; if (sp > XB_SPIN_CAP) { atomicAdd(&bar[XB_TMO], 1u); break; } }
    }
    nloc = mine > 0u ? mine : 1u; nx = cnt > 0u ? cnt : 1u;
}
__device__ __forceinline__ void xcd_barrier(const XcdBarrier& b, bool leader  ) {
    asm volatile("s_waitcnt vmcnt(0)" ::: "memory");
    __syncthreads();
    if (leader) {
        unsigned* bar = b.bar;
        __builtin_amdgcn_s_waitcnt(0);
        unsigned nloc = b.st[0], nx = b.st[1];
        if (nloc == 0u) { xcd_barrier_complete(bar, b.x, nloc, nx); b.st[0] = nloc; b.st[1] = nx; }
        const unsigned old = xb_add(&bar[XB_XSUB(b.x)], 1u);
        const unsigned gen = old / nloc;
        if (old + 1u == (gen + 1u) * nloc) {
            __builtin_amdgcn_fence(__ATOMIC_RELEASE, "agent");
            asm volatile("s_waitcnt vmcnt(0)" ::: "memory");
            const unsigned og = xb_add(&bar[XB_TOP], 1u);
            const unsigned tg = og / nx;
            if (og + 1u == (tg + 1u) * nx) xb_add(&bar[XB_TOPGEN], 1u);
            else XB_SPIN(xb_ld(&bar[XB_TOPGEN]) == tg, bar);
            __builtin_amdgcn_fence(__ATOMIC_ACQUIRE, "agent");
            xb_add(&bar[XB_XGEN(b.x)], 1u);
            asm volatile("s_waitcnt vmcnt(0)" ::: "memory");
        } else {
            XB_SPIN(xb_ld(&bar[XB_XGEN(b.x)]) == gen, bar);
            __builtin_amdgcn_fence(__ATOMIC_ACQUIRE, "agent");
            asm volatile("s_waitcnt vmcnt(0)" ::: "memory");
        }
    }
    __syncthreads();
}

namespace pg8 {
constexpr int BM = 256, BK = 64, HALF = 128, HTB = HALF * BK * 2, STAGE_BYTES = 8 * HTB, NXCD = 8, WGM = 8;
__host__ __device__ __forceinline__ int lds_byte(int r, int c) { const int st = (r >> 4) * 2 + (c >> 5), rr = r & 15, cc = c & 31, ob = rr * 64 + cc * 2; return st * 1024 + (ob ^ (((ob >> 9) & 1) << 5)); }
__host__ __device__ __forceinline__ void stage_rc(int b, int& R, int& C) { const int st = b / 1024, sb = b % 1024, swz = sb ^ (((sb >> 9) & 1) << 5); R = (st >> 1) * 16 + swz / 64; C = (st & 1) * 32 + (swz % 64) / 2; }
__host__ __device__ __forceinline__ int perm32(int rho) { const int n = rho >> 4, i = rho & 15; return 8 * (i >> 2) + 4 * n + (i & 3); }

struct Unit { int pm, pn, pb, aux, aux2; };
struct Gemm { const bf16_t* A; const bf16_t* Bt; int lda, ldb, K; };

struct StaticOrder {
    int nM, nN, nwg, G, c;
    __device__ void init(int M, int N, int G_, int c_) { nM = M / BM; nN = N / BM; nwg = nM * nN; G = G_; c = c_; }
    __device__ bool next(int i, Unit& u) const {
        const long L = (long)i * G + c; if (L >= nwg) return false;
        int wgid = (int)L; { const int q = nwg / NXCD, r = nwg % NXCD, xcd = wgid % NXCD, off = wgid / NXCD; wgid = (xcd < r ? xcd * (q + 1) : r * (q + 1) + (xcd - r) * q) + off; }
        const int nig = WGM * nN, gid = wgid / nig, fm = gid * WGM, gsz = (nM - fm) < WGM ? (nM - fm) : WGM;
        u.pm = fm + ((wgid % nig) % gsz); u.pn = (wgid % nig) / gsz; u.pb = u.pn; u.aux = 0; u.aux2 = 0; return true;
    }
};
struct GroupedOrder {
    int nM, nN, rtpg, G, v;
    __device__ void init(int nM_, int nN_, int rtpg_, int G_, int v_) { nM = nM_; nN = nN_; rtpg = rtpg_; G = G_; v = v_; }
    __device__ bool next(int i, Unit& u) const {
        const int L = i * G + v; if (L >= nM * nN) return false;
        u.pm = L / nN; u.pn = L % nN; u.aux = u.pm / rtpg; u.pb = u.aux * nN + u.pn; u.aux2 = 0; return true;
    }
};

template <class Epi, class Sched, bool ALIGN_EPI, bool GATHER, bool FP8 = false>
__device__ __forceinline__ void gemm_phase(LAS unsigned char* lds, const Gemm g, const Sched& S, const Epi& E, const LAS unsigned* rowtab  , int wid  ) {
    const int lane = lane_id(), tid = wid * 64 + lane, wr = wid >> 2, wc = wid & 3;
    const int K = g.K, nt = K / BK;
    unsigned voffB[2];
#pragma unroll
    for (int i = 0; i < 2; ++i) { int R, C; stage_rc(tid * 16 + i * 8192, R, C); const int Rb = (R & ~31) + perm32(R & 31);
        voffB[i] = (unsigned)(Rb * g.ldb + C) * 2u; }
    const size_t kstep = (size_t)(BK * 2);
    const size_t hstepB = (size_t)HALF * g.ldb * 2, tstepB = 2 * hstepB;
    const size_t tstepA = (size_t)BM * g.lda * 2;
    const unsigned ldsw = (unsigned)wid * 1024u;
    const int aoff = lds_byte(wr * 64 + (lane & 15), (lane >> 4) * 8), boff = lds_byte(wc * 32 + (lane & 15), (lane >> 4) * 8);
    unsigned vAc[2][2];
#define PG8_SETVA(dst, ui_) do { const int t_ = wid * 64 + lane_id(); _Pragma("unroll") for (int i_ = 0; i_ < 2; ++i_) { int R_, C_; stage_rc(t_ * 16 + i_ * 8192, R_, C_); \
        _Pragma("unroll") for (int h_ = 0; h_ < 2; ++h_) dst[h_][i_] = (GATHER ? rowtab[(ui_) * 256 + h_ * 128 + R_] : (unsigned)((h_ * 128 + R_) * g.lda) * 2u) + (unsigned)C_ * 2u; } } while (0)
#define PG8_SA(b, h) (((b) * 2 + (h)) * HTB)
#define PG8_SB(b, h) ((4 + (b) * 2 + (h)) * HTB)
#define PG8_GLDS_S(gbase_, voff_, ldsaddr_) do { unsigned keep_; asm volatile("s_mov_b32 %0, m0\n\ts_mov_b32 m0, %3\n\ts_nop 0\n\tglobal_load_lds_dwordx4 %1, %2\n\ts_mov_b32 m0, %0" \
        : "=&s"(keep_) : "v"(voff_), "s"(gbase_), "s"(ldsaddr_) : "memory"); } while (0)
#define PG8_STAGE(bufoff, gbase, v0, v1) do { \
        if constexpr (FP8) { const unsigned la_ = (unsigned)(uintptr_t)(lds + (bufoff) + ldsw); PG8_GLDS_S((const char*)(gbase), (v0), la_); PG8_GLDS_S((const char*)(gbase), (v1), la_ + 8192u); } else { \
        __builtin_amdgcn_global_load_lds((const unsigned*)((const char*)(gbase) + (v0)), (LAS unsigned*)(lds + (bufoff) + ldsw), 16, 0, 0); \
        __builtin_amdgcn_global_load_lds((const unsigned*)((const char*)(gbase) + (v1)), (LAS unsigned*)(lds + (bufoff) + ldsw + 8192), 16, 0, 0); } } while (0)
#define PG8_STB(bufoff, gbase) PG8_STAGE(bufoff, gbase, voffB[0], voffB[1])
#define PG8_LDA(dst, b, h) do { _Pragma("unroll") for (int m = 0; m < 4; ++m) _Pragma("unroll") for (int k = 0; k < 2; ++k) dst[m][k] = *(const LAS bf16x8*)(lds + PG8_SA(b, h) + aoff + m * 2048 + k * 1024); } while (0)
#define PG8_LDB(dst, b, h) do { _Pragma("unroll") for (int n = 0; n < 2; ++n) _Pragma("unroll") for (int k = 0; k < 2; ++k) dst[n][k] = *(const LAS bf16x8*)(lds + PG8_SB(b, h) + boff + n * 2048 + k * 1024); } while (0)
#define PG8_MMA(ai, bj, At, Bt) do { __builtin_amdgcn_s_setprio(1); \
        if constexpr (FP8) { _Pragma("unroll") for (int m = 0; m < 4; ++m) _Pragma("unroll") for (int n = 0; n < 2; ++n) { \
            const v8i32 a8_ = __builtin_shufflevector(__builtin_bit_cast(v4i32, At[m][0]), __builtin_bit_cast(v4i32, At[m][1]), 0, 1, 2, 3, 4, 5, 6, 7); \
            const v8i32 b8_ = __builtin_shufflevector(__builtin_bit_cast(v4i32, Bt[n][0]), __builtin_bit_cast(v4i32, Bt[n][1]), 0, 1, 2, 3, 4, 5, 6, 7); \
            acc[ai][bj][m][n] = __builtin_amdgcn_mfma_scale_f32_16x16x128_f8f6f4(b8_, a8_, acc[ai][bj][m][n], 0, 0, 0, 0, 0, 0); } } \
        else { _Pragma("unroll") for (int m = 0; m < 4; ++m) _Pragma("unroll") for (int n = 0; n < 2; ++n) _Pragma("unroll") for (int k = 0; k < 2; ++k) \
            acc[ai][bj][m][n] = __builtin_amdgcn_mfma_f32_16x16x32_bf16(Bt[n][k], At[m][k], acc[ai][bj][m][n], 0, 0, 0); } \
        __builtin_amdgcn_s_setprio(0); } while (0)
#define PG8_WAIT_V(n) asm volatile("s_waitcnt vmcnt(" #n ")" ::: "memory")
#define PG8_WAIT_L(n) asm volatile("s_waitcnt lgkmcnt(" #n ")" ::: "memory")
#define PG8_BAR __builtin_amdgcn_s_barrier()
#define PG8_SCHED __builtin_amdgcn_sched_barrier(0)
#define PG8_SCHED8 do { if constexpr (FP8) __builtin_amdgcn_sched_barrier(0); } while (0)
    Unit cur, nxt; int ui = 0;
#define PG8_UNI(u_) do { u_.pm = __builtin_amdgcn_readfirstlane(u_.pm); u_.pn = __builtin_amdgcn_readfirstlane(u_.pn); u_.pb = __builtin_amdgcn_readfirstlane(u_.pb); u_.aux = __builtin_amdgcn_readfirstlane(u_.aux); u_.aux2 = __builtin_amdgcn_readfirstlane(u_.aux2); } while (0)
    if (!S.next(0, cur)) return;
    PG8_UNI(cur);
    f32x4 acc[2][2][4][2];
#pragma unroll
    for (int a = 0; a < 2; ++a)
#pragma unroll
        for (int b = 0; b < 2; ++b)
#pragma unroll
            for (int m = 0; m < 4; ++m)
#pragma unroll
                for (int n = 0; n < 2; ++n) acc[a][b][m][n] = (f32x4){0.f, 0.f, 0.f, 0.f};
    bf16x8 At[4][2], B0[2][2], B1[2][2];
    const char* cA = (const char*)g.A + (GATHER ? (size_t)0 : (size_t)cur.pm * tstepA); const char* cB = (const char*)g.Bt + (size_t)cur.pb * tstepB;
    PG8_SETVA(vAc, 0);
    PG8_STB(PG8_SB(0, 0), cB); PG8_STB(PG8_SB(0, 1), cB + hstepB); PG8_STAGE(PG8_SA(0, 0), cA, vAc[0][0], vAc[0][1]); PG8_STAGE(PG8_SA(0, 1), cA, vAc[1][0], vAc[1][1]);
    if (wr == 1) PG8_BAR;
    PG8_WAIT_V(2); PG8_BAR;
    PG8_STB(PG8_SB(1, 0), cB + kstep); PG8_STAGE(PG8_SA(1, 0), cA + kstep, vAc[0][0], vAc[0][1]); PG8_STB(PG8_SB(1, 1), cB + hstepB + kstep);
    PG8_WAIT_V(6); PG8_BAR;
    for (;;) {
        const bool has_next = S.next(ui + 1, nxt);
        PG8_UNI(nxt);
        const char* nA = GATHER ? cA : (has_next ? (const char*)g.A + (size_t)nxt.pm * tstepA : cA); const char* nB = has_next ? (const char*)g.Bt + (size_t)nxt.pb * tstepB : cB;
        const int nui = has_next ? ui + 1 : ui;
#pragma nounroll
        for (int t = 0; t < nt; t += 2) {
            const bool last = (t == nt - 2);
            const char* a1 = cA + (size_t)(t + 1) * kstep;
            const char* a2 = last ? nA : cA + (size_t)(t + 2) * kstep; const char* b2 = last ? nB : cB + (size_t)(t + 2) * kstep;
            const char* a3 = a2 + kstep; const char* b3 = b2 + kstep;
            unsigned x00 = vAc[0][0], x01 = vAc[0][1], x10 = vAc[1][0], x11 = vAc[1][1];
            if (GATHER) { if (last) { unsigned vN_[2][2]; PG8_SETVA(vN_, nui); x00 = vN_[0][0]; x01 = vN_[0][1]; x10 = vN_[1][0]; x11 = vN_[1][1]; } }
            PG8_LDB(B0, 0, 0); PG8_LDB(B1, 0, 1); PG8_SCHED; PG8_LDA(At, 0, 0); PG8_STAGE(PG8_SA(1, 1), a1, vAc[1][0], vAc[1][1]);
            PG8_WAIT_V(8); PG8_WAIT_L(0); PG8_BAR; PG8_SCHED8; PG8_MMA(0, 0, At, B0); PG8_MMA(0, 1, At, B1); PG8_SCHED8; PG8_BAR; PG8_SCHED;
            PG8_LDA(At, 0, 1); PG8_STB(PG8_SB(0, 0), b2); PG8_STB(PG8_SB(0, 1), b2 + hstepB); PG8_STAGE(PG8_SA(0, 0), a2, x00, x01);
            PG8_WAIT_V(8); PG8_WAIT_L(0); PG8_BAR; PG8_SCHED8; PG8_MMA(1, 0, At, B0); PG8_MMA(1, 1, At, B1); PG8_SCHED8; PG8_BAR; PG8_SCHED;
            PG8_LDB(B0, 1, 0); PG8_LDB(B1, 1, 1); PG8_SCHED; PG8_LDA(At, 1, 0); PG8_STAGE(PG8_SA(0, 1), a2, x10, x11);
            PG8_WAIT_V(8); PG8_WAIT_L(0); PG8_BAR; PG8_SCHED8; PG8_MMA(0, 0, At, B0); PG8_MMA(0, 1, At, B1); PG8_SCHED8; PG8_BAR; PG8_SCHED;
            PG8_LDA(At, 1, 1); PG8_STB(PG8_SB(1, 0), b3); PG8_STB(PG8_SB(1, 1), b3 + hstepB); PG8_STAGE(PG8_SA(1, 0), a3, x00, x01);
            PG8_WAIT_V(8); PG8_WAIT_L(0); PG8_BAR; PG8_SCHED8; PG8_MMA(1, 0, At, B0); PG8_MMA(1, 1, At, B1); PG8_SCHED8; PG8_BAR; PG8_SCHED;
        }
        if constexpr (ALIGN_EPI) { if (wr == 0) PG8_BAR; }
        { int l_ = lane_id(); asm volatile("" : "+v"(l_));
          E(acc, cur, wr, wc, l_ & 15, l_ >> 4); }
        if (!has_next) break;
#pragma unroll
        for (int a = 0; a < 2; ++a)
#pragma unroll
            for (int b = 0; b < 2; ++b)
#pragma unroll
                for (int m = 0; m < 4; ++m)
#pragma unroll
                    for (int n = 0; n < 2; ++n) acc[a][b][m][n] = (f32x4){0.f, 0.f, 0.f, 0.f};
        cur = nxt; cA = nA; cB = nB; ++ui;
        if (GATHER) { PG8_SETVA(vAc, ui); }
        if constexpr (ALIGN_EPI) { if (wr == 1) PG8_BAR; }
    }
    PG8_WAIT_V(0);
    if constexpr (!ALIGN_EPI) { if (wr == 0) PG8_BAR; }
    PG8_BAR;
#undef PG8_SETVA
#undef PG8_UNI
#undef PG8_SA
#undef PG8_SB
#undef PG8_STAGE
#undef PG8_GLDS_S
#undef PG8_STB
#undef PG8_LDA
#undef PG8_LDB
#undef PG8_MMA
#undef PG8_WAIT_V
#undef PG8_WAIT_L
#undef PG8_BAR
#undef PG8_SCHED
#undef PG8_SCHED8
}
}
constexpr int NWAVES = 8, NTHR = 512;
constexpr int BATCH = 8, SEQ = 8192, T = BATCH * SEQ, D = 1024, DIN = 4096;
constexpr int DS = 512, DA = 512, NH = 8, HD = 64, NBLK = SEQ / 256;
constexpr int SG = 32, SHC = 16, SP = 64, SL = 32, SKU = SL * SHC  , SKS = 2 * SP  , SKY = SKU + SKS  , SROWS = T / SL  ;
constexpr int NE = 32, DE = 512;
constexpr float RMS_EPS = 1e-6f;
constexpr float LOG2E = 1.4426950408889634f;
constexpr float QSCALE = 0.125f * LOG2E;
constexpr float WF8_SCALE = 32.f;
constexpr float YF8_SCALE = 16.f;
constexpr float MA_SCALE = 64.f;
constexpr int ROWCAP = T;
constexpr int HID_ROWS = 2 * T + NE * 256;

constexpr size_t MiB = 1u << 20;
constexpr size_t WS_CTL = 0, CTL_ZERO_BYTES = 1 * MiB;
constexpr size_t WS_WIN = 1 * MiB;
constexpr size_t WS_WGLU = 9 * MiB;
constexpr size_t WS_WUS = 10 * MiB;
constexpr size_t WS_WUA = 11 * MiB;
constexpr size_t WS_WOUT = 12 * MiB;
constexpr size_t WS_WR = 14 * MiB;
constexpr size_t WS_KMEAN = 15 * MiB;
constexpr size_t WS_SSMW = 16 * MiB;
constexpr size_t WS_SSMT = 24 * MiB;
constexpr size_t WS_W13 = 44 * MiB;
constexpr size_t WS_W2 = 108 * MiB;
constexpr size_t WS_A0 = 140 * MiB;
constexpr size_t WS_UP = 276 * MiB;
constexpr size_t WS_Q = 356 * MiB;
constexpr size_t WS_SSQ = 404 * MiB;
constexpr size_t WS_RLOG = 408 * MiB;
constexpr size_t WS_K = 420 * MiB;
constexpr size_t WS_ROWTOK = 428 * MiB, WS_ROWCOEF = 436 * MiB, WS_ROWRSTD = 444 * MiB;
constexpr size_t WS_GACT = 420 * MiB;
constexpr size_t WS_V = 484 * MiB;
constexpr size_t WS_YSSM = 484 * MiB;
constexpr size_t WS_SGS = 548 * MiB;
constexpr size_t WS_SGA = 676 * MiB;
constexpr size_t WS_E = 804 * MiB;
constexpr size_t WS_YATT = 836 * MiB;
constexpr size_t WS_PART0 = 420 * MiB, WS_PART1 = 484 * MiB, WS_PART2 = 932 * MiB;
constexpr size_t WS_QLIST = 900 * MiB;
constexpr size_t WS_PL = 268 * MiB;
constexpr size_t WS_MQ = 996 * MiB;
constexpr size_t WS_H1F8 = 836 * MiB;
constexpr size_t WS_WINF8 = 900 * MiB;
constexpr size_t WS_XGF8 = 836 * MiB;
constexpr size_t WS_MA = 276 * MiB;
constexpr size_t WS_SEGC = 998 * MiB;
constexpr size_t WS_END = 999 * MiB;
constexpr size_t WS_KFRAG = WS_A0, WS_VFRAG = WS_A0 + 64 * MiB, WS_H1 = WS_A0, WS_MRG = WS_A0, WS_HID = WS_A0;
constexpr size_t WS_X1 = WS_SGS, WS_XG = WS_UP, WS_Y0 = WS_UP, WS_Y1 = WS_E;
static_assert(WS_GACT + 64 * MiB <= WS_YSSM && WS_YSSM + 64 * MiB <= WS_SGS, "map");
static_assert(WS_HID + (size_t)HID_ROWS * DE * 2 <= WS_UP, "hid fits");
static_assert(WS_RLOG + (size_t)T * 72 * 4 <= WS_ROWTOK, "rlog fits");

constexpr int CW_TMO = 0, CW_CODE = 1;
constexpr int CW_BAR = 4096;
constexpr int CW_ECNT = 8192;
constexpr int CW_GCNT = 12288;

constexpr int RING_BYTES = 131072;
constexpr int ROWTAB_OFF = RING_BYTES, ROWTAB_UNITS = 12, ROWTAB_BYTES = 25 * 1024;
constexpr int MOE_TST_OFF = ROWTAB_OFF + ROWTAB_BYTES;
constexpr int MISC_OFF = MOE_TST_OFF + 512;
constexpr int LDS_BYTES = MISC_OFF + 128;
static_assert(LDS_BYTES <= 163840, "LDS");

struct Frame {
    LAS unsigned char* lds;
    volatile LAS unsigned* MISC;
    gu32* ctl;
    unsigned char* ws;
    int tid, lane, wave, vcu, G;
    const float* in[27];
    float* out;
};

__device__ __forceinline__ unsigned pk4_fp8(float a, float b, float c, float d) { int w = 0; w = __builtin_amdgcn_cvt_pk_fp8_f32(a, b, w, false); w = __builtin_amdgcn_cvt_pk_fp8_f32(c, d, w, true); return (unsigned)w; }
#define EPI_LOOP_BEGIN  _Pragma("unroll") for (int ai = 0; ai < 2; ++ai) _Pragma("unroll") for (int m = 0; m < 4; ++m) { const int rl = ai * 128 + wr * 64 + m * 16 + fr; _Pragma("unroll") for (int bj = 0; bj < 2; ++bj) { const int cl = bj * 128 + wc * 32 + 8 * fq; \
        const f32x4 a0 = acc[ai][bj][m][0], a1 = acc[ai][bj][m][1]; (void)rl; (void)cl; (void)a0; (void)a1;
#define EPI_LOOP_END } }
typedef const f32x4 (&AccRef)[2][2][4][2];
__device__ __forceinline__ u32x4 pack8(f32x4 a, f32x4 b) { u32x4 w; w.x = cvt_pk_bf16(a[0], a[1]); w.y = cvt_pk_bf16(a[2], a[3]); w.z = cvt_pk_bf16(b[0], b[1]); w.w = cvt_pk_bf16(b[2], b[3]); return w; }
__device__ __forceinline__ void unpack8(u32x4 w, f32x4& a, f32x4& b) { a = (f32x4){bflo(w.x), bfhi(w.x), bflo(w.y), bfhi(w.y)}; b = (f32x4){bflo(w.z), bfhi(w.z), bflo(w.w), bfhi(w.w)}; }

template <int PART  > struct EpiProj {
    unsigned char* ws; const float* b_gate; int pn_off; float ascale;
    __device__ __forceinline__ void operator()(AccRef acc, const pg8::Unit& u, int wr, int wc, int fr, int fq) const {
        const int pn = u.pn + pn_off; const int row0 = u.pm * 256;
        if (PART == 0) {
            bf16_t* Uperm = (bf16_t*)(ws + WS_UP);
            EPI_LOOP_BEGIN
                const int row = row0 + rl, col = pn * 256 + cl;
                bf16_t* dst = Uperm + (size_t)(col >> 4) * ((size_t)SROWS * SKY) + (size_t)(row >> 5) * SKY + (row & 31) * 16 + (col & 15);
                *(u32x4*)dst = pack8(a0 * ascale, a1 * ascale);
            EPI_LOOP_END
        } else if (pn < 8) {
            const size_t boff = pn < 4 ? WS_Q : (pn < 6 ? WS_K : WS_V);
            bf16_t* base = (bf16_t*)(ws + boff); const float sc = pn < 4 ? QSCALE : 1.f; const int c0 = (pn & 1) * 256;
            EPI_LOOP_BEGIN
                const int row = row0 + rl, col = c0 + cl;
                *(u32x4*)(base + (size_t)row * 512 + col) = pack8(a0 * (sc * ascale), a1 * (sc * ascale));
            EPI_LOOP_END
        } else {
            const bool attn_gate = pn >= 12;
            const int c0 = ((pn - 8) & 3) * 256; const float* bg = b_gate + (pn - 8) * 256;
            EPI_LOOP_BEGIN
                const int row = row0 + rl, col = c0 + cl;
                const f32x4 b0 = *(const f32x4*)(bg + cl), b1 = *(const f32x4*)(bg + cl + 4);
                f32x4 s0, s1;
#pragma unroll
                for (int e = 0; e < 4; ++e) { s0[e] = fast_sigmoid(a0[e] * ascale + b0[e]); s1[e] = fast_sigmoid(a1[e] * ascale + b1[e]); }
                if (attn_gate) *(u32x2*)(ws + WS_SGA + (size_t)row * 1024 + col) = (u32x2){pk4_fp8(s0[0], s0[1], s0[2], s0[3]), pk4_fp8(s1[0], s1[1], s1[2], s1[3])};
                else *(u32x4*)((bf16_t*)(ws + WS_SGS) + (size_t)row * 1024 + col) = pack8(s0, s1);
            EPI_LOOP_END
        }
    }
};
struct EpiSsmE {
    float* E;
    __device__ __forceinline__ void operator()(AccRef acc, const pg8::Unit& u, int wr, int wc, int fr, int fq) const {
        EPI_LOOP_BEGIN
            if (bj == 0) { float* dst = E + (size_t)(u.pm * 256 + rl) * 128 + cl; *(f32x4*)dst = a0; *(f32x4*)(dst + 4) = a1; }
        EPI_LOOP_END
    }
};
__device__ __forceinline__ float gelu_tanh(float x) { const float z = 1.5957691216057308f * (x + 0.044715f * x * x * x); return x * fast_sigmoid(z); }
struct EpiSsmY {
    bf16_t* Gact;
    __device__ __forceinline__ void operator()(AccRef acc, const pg8::Unit& u, int wr, int wc, int fr, int fq) const {
        const int g = u.aux;
        EPI_LOOP_BEGIN
            const int rg = (u.pm & 7) * 256 + rl;
            const int colg = u.pn * 256 + cl;
            const int tok = (rg >> 8) * SEQ + (rg & 255) * SL + (colg >> 4);
            f32x4 y0, y1;
#pragma unroll
            for (int e = 0; e < 4; ++e) { y0[e] = gelu_tanh(a0[e]); y1[e] = gelu_tanh(a1[e]); }
            *(u32x4*)(Gact + (size_t)tok * DS + g * 16 + (colg & 15)) = pack8(y0, y1);
        EPI_LOOP_END
    }
};
#define EPI_SBAR __builtin_amdgcn_sched_barrier(0)
#define EPI_G(g_) const int ai = (g_) >> 2, m = (g_) & 3; const int rl = ai * 128 + wr * 64 + m * 16 + fr; (void)rl
struct EpiGlu {
    const bf16_t* Gact; bf16_t* Yssm; const float* b_glu;
    __device__ __forceinline__ void operator()(AccRef acc, const pg8::Unit& u, int wr, int wc, int fr, int fq) const {
        const int col0 = u.pn * 256 + wc * 32 + 8 * fq; const size_t rowb = (size_t)u.pm * 256;
        f32x4 bv[2][2]; u32x4 gv[8][2];
#pragma unroll
        for (int bj = 0; bj < 2; ++bj) { bv[bj][0] = *(const f32x4*)(b_glu + col0 + bj * 128); bv[bj][1] = *(const f32x4*)(b_glu + col0 + bj * 128 + 4); }
#pragma unroll
        for (int g = 0; g < 8; ++g) { EPI_G(g);
#pragma unroll
            for (int bj = 0; bj < 2; ++bj) gv[g][bj] = *(const u32x4*)(Gact + (rowb + rl) * DS + col0 + bj * 128); }
        EPI_SBAR;
#pragma unroll
        for (int g = 0; g < 8; ++g) { EPI_G(g);
#pragma unroll
            for (int bj = 0; bj < 2; ++bj) { f32x4 g0, g1; unpack8(gv[g][bj], g0, g1); const f32x4 a0 = acc[ai][bj][m][0], a1 = acc[ai][bj][m][1]; f32x4 y0, y1;
#pragma unroll
                for (int e = 0; e < 4; ++e) { y0[e] = g0[e] * fast_sigmoid(a0[e] + bv[bj][0][e]); y1[e] = g1[e] * fast_sigmoid(a1[e] + bv[bj][1][e]); }
                *(u32x4*)(Yssm + (rowb + rl) * DS + col0 + bj * 128) = pack8(y0, y1); } }
    }
};
struct EpiUpA {
    const unsigned char* SG; unsigned char* MA; float ascale;
    __device__ __forceinline__ void operator()(AccRef acc, const pg8::Unit& u, int wr, int wc, int fr, int fq) const {
        const size_t base = (size_t)u.pm * 256 * D + u.pn * 256 + wc * 32 + 8 * fq; u32x2 sv[8][2];
#pragma unroll
        for (int g = 0; g < 8; ++g) { EPI_G(g);
#pragma unroll
            for (int bj = 0; bj < 2; ++bj) sv[g][bj] = *(const u32x2*)(SG + base + (size_t)rl * D + bj * 128); }
        EPI_SBAR;
#pragma unroll
        for (int g = 0; g < 8; ++g) { EPI_G(g);
#pragma unroll
            for (int bj = 0; bj < 2; ++bj) { const int a = (int)sv[g][bj].x, c = (int)sv[g][bj].y;
                const f32x4 s0 = (f32x4){__builtin_amdgcn_cvt_f32_fp8(a, 0), __builtin_amdgcn_cvt_f32_fp8(a, 1), __builtin_amdgcn_cvt_f32_fp8(a, 2), __builtin_amdgcn_cvt_f32_fp8(a, 3)};
                const f32x4 s1 = (f32x4){__builtin_amdgcn_cvt_f32_fp8(c, 0), __builtin_amdgcn_cvt_f32_fp8(c, 1), __builtin_amdgcn_cvt_f32_fp8(c, 2), __builtin_amdgcn_cvt_f32_fp8(c, 3)};
                const f32x4 y0 = s0 * acc[ai][bj][m][0] * ascale, y1 = s1 * acc[ai][bj][m][1] * ascale;
                *(u32x2*)(MA + base + (size_t)rl * D + bj * 128) = (u32x2){pk4_fp8(y0[0], y0[1], y0[2], y0[3]), pk4_fp8(y1[0], y1[1], y1[2], y1[3])}; } }
    }
};
struct EpiUpS {
    const bf16_t* SG; const unsigned char* MA; bf16_t* Mrg;
    __device__ __forceinline__ void operator()(AccRef acc, const pg8::Unit& u, int wr, int wc, int fr, int fq) const {
        const size_t base = (size_t)u.pm * 256 * D + u.pn * 256 + wc * 32 + 8 * fq; u32x4 sv[2][2][2]; u32x2 mv[2][2][2];
        constexpr float ms = 1.f / MA_SCALE;
#define UPS_LOAD(buf_, bt_) do { _Pragma("unroll") for (int gi_ = 0; gi_ < 2; ++gi_) { EPI_G(2 * (bt_) + gi_); _Pragma("unroll") for (int bj = 0; bj < 2; ++bj) { const size_t off = base + (size_t)rl * D + bj * 128; \
            sv[buf_][gi_][bj] = *(const u32x4*)(SG + off); mv[buf_][gi_][bj] = *(const u32x2*)(MA + off); } } } while (0)
#define UPS_PROC(buf_, bt_) do { _Pragma("unroll") for (int gi_ = 0; gi_ < 2; ++gi_) { EPI_G(2 * (bt_) + gi_); _Pragma("unroll") for (int bj = 0; bj < 2; ++bj) { const size_t off = base + (size_t)rl * D + bj * 128; \
            f32x4 s0, s1; unpack8(sv[buf_][gi_][bj], s0, s1); const int a = (int)mv[buf_][gi_][bj].x, c = (int)mv[buf_][gi_][bj].y; \
            const f32x4 p0 = (f32x4){__builtin_amdgcn_cvt_f32_fp8(a, 0), __builtin_amdgcn_cvt_f32_fp8(a, 1), __builtin_amdgcn_cvt_f32_fp8(a, 2), __builtin_amdgcn_cvt_f32_fp8(a, 3)} * ms; \
            const f32x4 p1 = (f32x4){__builtin_amdgcn_cvt_f32_fp8(c, 0), __builtin_amdgcn_cvt_f32_fp8(c, 1), __builtin_amdgcn_cvt_f32_fp8(c, 2), __builtin_amdgcn_cvt_f32_fp8(c, 3)} * ms; \
            *(u32x4*)(Mrg + off) = pack8(s0 * acc[ai][bj][m][0] + p0, s1 * acc[ai][bj][m][1] + p1); } } } while (0)
        UPS_LOAD(0, 0); UPS_LOAD(1, 1); EPI_SBAR;
        UPS_PROC(0, 0); UPS_LOAD(0, 2); EPI_SBAR;
        UPS_PROC(1, 1); UPS_LOAD(1, 3); EPI_SBAR;
        UPS_PROC(0, 2); EPI_SBAR;
        UPS_PROC(1, 3);
#undef UPS_LOAD
#undef UPS_PROC
    }
};
struct EpiOut {
    const float* x; bf16_t* X1; unsigned char* X18; float* SSQ;
    __device__ __forceinline__ void operator()(AccRef acc, const pg8::Unit& u, int wr, int wc, int fr, int fq) const {
        const int col0 = u.pn * 256 + wc * 32 + 8 * fq; const size_t base = (size_t)u.pm * 256 * D + col0;
        f32x4 xv[2][2][2][2];
#define OUT_LOAD(buf_, bt_) do { _Pragma("unroll") for (int gi_ = 0; gi_ < 2; ++gi_) { EPI_G(2 * (bt_) + gi_); _Pragma("unroll") for (int bj = 0; bj < 2; ++bj) { const size_t off = base + (size_t)rl * D + bj * 128; \
            xv[buf_][gi_][bj][0] = *(const f32x4*)(x + off); xv[buf_][gi_][bj][1] = *(const f32x4*)(x + off + 4); } } } while (0)
#define OUT_PROC(buf_, bt_) do { _Pragma("unroll") for (int gi_ = 0; gi_ < 2; ++gi_) { EPI_G(2 * (bt_) + gi_); float ss = 0.f; _Pragma("unroll") for (int bj = 0; bj < 2; ++bj) { const size_t off = base + (size_t)rl * D + bj * 128; \
            const f32x4 x0 = xv[buf_][gi_][bj][0] + acc[ai][bj][m][0], x1 = xv[buf_][gi_][bj][1] + acc[ai][bj][m][1]; \
            *(u32x4*)(X1 + off) = pack8(x0, x1); *(u32x2*)(X18 + off) = (u32x2){pk4_fp8(x0[0], x0[1], x0[2], x0[3]), pk4_fp8(x1[0], x1[1], x1[2], x1[3])}; \
            ss += (x0[0] * x0[0] + x0[1] * x0[1]) + (x0[2] * x0[2] + x0[3] * x0[3]) + (x1[0] * x1[0] + x1[1] * x1[1]) + (x1[2] * x1[2] + x1[3] * x1[3]); } \
            ss += __shfl_xor(ss, 16); ss += __shfl_xor(ss, 32); \
            SSQ[((size_t)u.pm * 256 + rl) * 16 + u.pn * 4 + wc] = ss; } } while (0)
        OUT_LOAD(0, 0); OUT_LOAD(1, 1); EPI_SBAR;
        OUT_PROC(0, 0); OUT_LOAD(0, 2); EPI_SBAR;
        OUT_PROC(1, 1); OUT_LOAD(1, 3); EPI_SBAR;
        OUT_PROC(0, 2); EPI_SBAR;
        OUT_PROC(1, 3);
#undef OUT_LOAD
#undef OUT_PROC
    }
};
struct EpiRouter {
    float* Rlog;
    __device__ __forceinline__ void operator()(AccRef acc, const pg8::Unit& u, int wr, int wc, int fr, int fq) const {
        EPI_LOOP_BEGIN
            if (bj == 0 && cl < 72) { float* dst = Rlog + (size_t)(u.pm * 256 + rl) * 72 + cl; *(f32x4*)dst = a0; *(f32x4*)(dst + 4) = a1; }
        EPI_LOOP_END
    }
};
struct EpiMoe1 {
    unsigned char* Hid; const float* rowrstd; const unsigned* ecnt; float ascale;
    __device__ __forceinline__ void operator()(AccRef acc, const pg8::Unit& u, int wr, int wc, int fr, int fq) const {
        const int e = u.aux, cnt = (int)ecnt[e]; float rsv[8];
#pragma unroll
        for (int g = 0; g < 8; ++g) { EPI_G(g); const int pos = u.aux2 + rl; rsv[g] = rowrstd[(size_t)e * ROWCAP + (pos < cnt ? pos : 0)] * ascale; }
        EPI_SBAR;
#pragma unroll
        for (int g = 0; g < 8; ++g) { EPI_G(g); const int pos = u.aux2 + rl;
            if (pos < cnt) { const float rs = rsv[g]; f32x4 h0, h1;
#pragma unroll
                for (int k = 0; k < 4; ++k) { const float p = acc[ai][0][m][0][k] * rs, q = acc[ai][1][m][0][k] * rs; h0[k] = p * fast_sigmoid(p) * q;
                    const float p2 = acc[ai][0][m][1][k] * rs, q2 = acc[ai][1][m][1][k] * rs; h1[k] = p2 * fast_sigmoid(p2) * q2; }
                *(u32x2*)(Hid + (size_t)(u.pm * 256 + rl) * DE + u.pn * 128 + wc * 32 + 8 * fq) = (u32x2){pk4_fp8(h0[0], h0[1], h0[2], h0[3]), pk4_fp8(h1[0], h1[1], h1[2], h1[3])}; } }
    }
};
struct EpiMoe2 {
    unsigned char* Y0; size_t ydelta; const unsigned* rowtok; const float* rowcoef; const unsigned* ecnt; float ascale;
    __device__ __forceinline__ void operator()(AccRef acc, const pg8::Unit& u, int wr, int wc, int fr, int fq) const {
        const int e = u.aux, cnt = (int)ecnt[e]; unsigned tkv[8]; float cfv[8];
#pragma unroll
        for (int g = 0; g < 8; ++g) { EPI_G(g); const int pos = u.aux2 + rl; const size_t ri = (size_t)e * ROWCAP + (pos < cnt ? pos : 0); tkv[g] = rowtok[ri]; cfv[g] = rowcoef[ri] * ascale; }
        EPI_SBAR;
#pragma unroll
        for (int g = 0; g < 8; ++g) { EPI_G(g); const int pos = u.aux2 + rl;
            if (pos < cnt) { const unsigned tk = tkv[g]; const float cf = cfv[g];
                unsigned char* dst = Y0 + (size_t)(tk & 1u) * ydelta + (size_t)(tk >> 1) * D + u.pn * 256 + wc * 32 + 8 * fq;
#pragma unroll
                for (int bj = 0; bj < 2; ++bj) { const f32x4 y0 = acc[ai][bj][m][0] * cf, y1 = acc[ai][bj][m][1] * cf; *(u32x2*)(dst + bj * 128) = (u32x2){pk4_fp8(y0[0], y0[1], y0[2], y0[3]), pk4_fp8(y1[0], y1[1], y1[2], y1[3])}; } } }
    }
};
__device__ __forceinline__ void transpose_item(const float* W, int N, int k0, int n0, bf16_t* WT, size_t drow0, int ldo, LAS float* scr, int lane) {
    float tv[32];
#pragma unroll
    for (int i = 0; i < 32; ++i) tv[i] = W[(size_t)(k0 + 2 * i + (lane >> 5)) * N + n0 + (lane & 31)];
#pragma unroll
    for (int i = 0; i < 32; ++i) scr[(2 * i + (lane >> 5)) * 33 + (lane & 31)] = tv[i];
    LDS_WAIT(); asm volatile("" ::: "memory");
    const int c = lane & 7;
#pragma unroll
    for (int j = 0; j < 4; ++j) { const int n = (lane >> 3) + 8 * j; const LAS float* s = scr + (8 * c) * 33 + n;
        u32x4 o; o.x = pk2(s[0 * 33], s[1 * 33]); o.y = pk2(s[2 * 33], s[3 * 33]); o.z = pk2(s[4 * 33], s[5 * 33]); o.w = pk2(s[6 * 33], s[7 * 33]);
        *(u32x4*)(WT + (drow0 + n) * (size_t)ldo + k0 + 8 * c) = o; }
    LDS_WAIT(); asm volatile("" ::: "memory");
}
__device__ __forceinline__ void transpose_item_f8(const float* W, int N, int k0, int n0, unsigned char* WT8, size_t drow0, int ldo, float scale, LAS float* scr, int lane, const float* kgain = nullptr  ) {
    float tv[32];
#pragma unroll
    for (int i = 0; i < 32; ++i) tv[i] = W[(size_t)(k0 + 2 * i + (lane >> 5)) * N + n0 + (lane & 31)];
#pragma unroll
    for (int i = 0; i < 32; ++i) scr[(2 * i + (lane >> 5)) * 33 + (lane & 31)] = tv[i] * (kgain ? scale * kgain[k0 + 2 * i + (lane >> 5)] : scale);
    LDS_WAIT(); asm volatile("" ::: "memory");
    const int c = lane & 3;
#pragma unroll
    for (int j = 0; j < 2; ++j) { const int n = (lane >> 2) + 16 * j; const LAS float* s = scr + (16 * c) * 33 + n;
        u32x4 o; o.x = pk4_fp8(s[0 * 33], s[1 * 33], s[2 * 33], s[3 * 33]); o.y = pk4_fp8(s[4 * 33], s[5 * 33], s[6 * 33], s[7 * 33]);
        o.z = pk4_fp8(s[8 * 33], s[9 * 33], s[10 * 33], s[11 * 33]); o.w = pk4_fp8(s[12 * 33], s[13 * 33], s[14 * 33], s[15 * 33]);
        *(u32x4*)(WT8 + (drow0 + n) * (size_t)ldo + k0 + 16 * c) = o; }
    LDS_WAIT(); asm volatile("" ::: "memory");
}
template <int NR> __device__ __forceinline__ void rms_rows_to_bf16(int lane, const float* xrow, const float* g, bf16_t* orow, unsigned char* orow8) {
    f32x4 v[NR][4]; float s[NR];
#pragma unroll
    for (int r = 0; r < NR; ++r) { const f32x4* xr = (const f32x4*)(xrow + (size_t)r * D) + lane;
#pragma unroll
        for (int j = 0; j < 4; ++j) v[r][j] = xr[64 * j]; }
    const f32x4* gr = (const f32x4*)g + lane; f32x4 wv[4];
#pragma unroll
    for (int j = 0; j < 4; ++j) wv[j] = gr[64 * j];
#pragma unroll
    for (int r = 0; r < NR; ++r) { float a = 0.f;
#pragma unroll
        for (int j = 0; j < 4; ++j) a += (v[r][j].x * v[r][j].x + v[r][j].y * v[r][j].y) + (v[r][j].z * v[r][j].z + v[r][j].w * v[r][j].w);
        s[r] = a; }
#pragma unroll
    for (int o = 1; o < 64; o <<= 1) {
#pragma unroll
        for (int r = 0; r < NR; ++r) s[r] += __shfl_xor(s[r], o); }
#pragma unroll
    for (int r = 0; r < NR; ++r) { const float rstd = 1.f / sqrtf(s[r] * (1.f / D) + RMS_EPS); unsigned long long* o8 = (unsigned long long*)(orow + (size_t)r * D) + lane;
#pragma unroll
        for (int j = 0; j < 4; ++j) { const float y0 = v[r][j].x * rstd * wv[j].x, y1 = v[r][j].y * rstd * wv[j].y, y2 = v[r][j].z * rstd * wv[j].z, y3 = v[r][j].w * rstd * wv[j].w;
            o8[64 * j] = (unsigned long long)pk2(y0, y1) | ((unsigned long long)pk2(y2, y3) << 32);
            ((unsigned*)(orow8 + (size_t)r * D))[lane + 64 * j] = pk4_fp8(y0, y1, y2, y3); } }
}
__device__ __forceinline__ void cpow(float lr, float li, float step, float dl, float& ar, float& ai) {
    const float mag = __expf(dl * lr * step); const float rev = dl * (li * step * 0.15915494309189535f); const float fr = rev - floorf(rev);
    ar = mag * __builtin_amdgcn_cosf(fr); ai = mag * __builtin_amdgcn_sinf(fr);
}
__device__ __forceinline__ void ssm_gen(Frame& F, int g, int sl) {
    LAS float* AP = (LAS float*)(F.lds); LAS float* BB = AP + 33 * 64 * 2; LAS float* CC = BB + 2048; LAS float* KT = CC + 2048;
    const float* lam_re = F.in[4] + g * SP; const float* lam_im = F.in[5] + g * SP; const float step = __expf(F.in[6][g]);
    const float* b_re = F.in[7] + g * SP * SHC; const float* b_im = F.in[8] + g * SP * SHC; const float* c_re = F.in[9] + g * SHC * SP; const float* c_im = F.in[10] + g * SHC * SP; const float* dd = F.in[11] + g * SHC;
    bf16_t* BT = (bf16_t*)(F.ws + WS_SSMT) + (size_t)g * 512 * SKY; bf16_t* BW = (bf16_t*)(F.ws + WS_SSMW) + (size_t)g * 256 * SKU;
    const int tid = F.tid;
    for (int idx = tid; idx < 33 * 64; idx += NTHR) { const int dl = idx >> 6, p = idx & 63; float ar, ai; cpow(lam_re[p], lam_im[p], step, (float)dl, ar, ai); AP[idx * 2] = ar; AP[idx * 2 + 1] = ai; }
    for (int idx = tid; idx < 1024; idx += NTHR) { const int ho = idx >> 6, p = idx & 63; CC[idx * 2] = c_re[ho * 64 + p]; CC[idx * 2 + 1] = c_im[ho * 64 + p]; }
    __syncthreads();
    for (int idx = tid; idx < 1024; idx += NTHR) { const int p = idx >> 4, h = idx & 15; const float ar = AP[(64 + p) * 2], ai = AP[(64 + p) * 2 + 1];
        const float lr = lam_re[p], li = lam_im[p], nr = ar - 1.f, ni = ai, den = lr * lr + li * li, cr = (nr * lr + ni * li) / den, ci = (ni * lr - nr * li) / den;
        const float br = b_re[p * 16 + h], bi = b_im[p * 16 + h]; BB[idx * 2] = cr * br - ci * bi; BB[idx * 2 + 1] = cr * bi + ci * br; }
    __syncthreads();
    for (int idx = tid; idx < 1024; idx += NTHR) { const int dl = idx >> 5, hl = (idx >> 4) & 1, hi = idx & 15, ho = 2 * sl + hl; float s = 0.f;
        for (int p = 0; p < 64; ++p) { const float ar = AP[(dl * 64 + p) * 2], ai = AP[(dl * 64 + p) * 2 + 1], br = BB[(p * 16 + hi) * 2], bi = BB[(p * 16 + hi) * 2 + 1];
            const float zr = ar * br - ai * bi, zi = ar * bi + ai * br; s += CC[(ho * 64 + p) * 2] * zr - CC[(ho * 64 + p) * 2 + 1] * zi; }
        if (dl == 0 && ho == hi) s += dd[ho];
        KT[idx] = s; }
    __syncthreads();
    for (int v = tid; v < 64 * 80; v += NTHR) { const int nl = v / 80, kv = (v % 80) * 8, tau = nl >> 1, hl = nl & 1, ho = 2 * sl + hl, n = tau * 16 + ho; float val[8];
        if (kv < 512) { const int sg = kv >> 4, hi0 = kv & 15;
#pragma unroll
            for (int e = 0; e < 8; ++e) val[e] = (tau >= sg) ? KT[((tau - sg) * 2 + hl) * 16 + hi0 + e] : 0.f; }
        else { const int kk = kv - 512;
#pragma unroll
            for (int e = 0; e < 8; ++e) { const int p = (kk + e) >> 1, ri = (kk + e) & 1; const float ar = AP[((tau + 1) * 64 + p) * 2], ai = AP[((tau + 1) * 64 + p) * 2 + 1], cre = CC[(ho * 64 + p) * 2], cim = CC[(ho * 64 + p) * 2 + 1];
                val[e] = ri == 0 ? (cre * ar - cim * ai) : -(cre * ai + cim * ar); } }
        u32x4 o; o.x = pk2(val[0], val[1]); o.y = pk2(val[2], val[3]); o.z = pk2(val[4], val[5]); o.w = pk2(val[6], val[7]);
        *(u32x4*)(BT + (size_t)n * SKY + kv) = o; }
    for (int v = tid; v < 32 * 64; v += NTHR) { const int nl = v >> 6, kv = (v & 63) * 8; float val[8];
        const bool real = nl < 16; const int n = real ? 16 * sl + nl : 128 + 16 * sl + (nl - 16);
        if (real) { const int p = n >> 1, ri = n & 1, sg = kv >> 4, hi0 = kv & 15; const float ar = AP[((31 - sg) * 64 + p) * 2], ai = AP[((31 - sg) * 64 + p) * 2 + 1];
#pragma unroll
            for (int e = 0; e < 8; ++e) { const float br = BB[(p * 16 + hi0 + e) * 2], bi = BB[(p * 16 + hi0 + e) * 2 + 1]; val[e] = ri == 0 ? (ar * br - ai * bi) : (ar * bi + ai * br); } }
        else {
#pragma unroll
            for (int e = 0; e < 8; ++e) val[e] = 0.f; }
        u32x4 o; o.x = pk2(val[0], val[1]); o.y = pk2(val[2], val[3]); o.z = pk2(val[4], val[5]); o.w = pk2(val[6], val[7]);
        *(u32x4*)(BW + (size_t)n * SKU + kv) = o; }
    __syncthreads();
}
__device__ __forceinline__ void p0_prologue(Frame& F) {
    for (int it = F.vcu; it < SG * 8; it += F.G) ssm_gen(F, it >> 3, it & 7);
    LAS float* scr = (LAS float*)(F.lds + F.wave * 16384);
    const int gw = F.vcu * NWAVES + F.wave, NGW = F.G * NWAVES, lane = F.lane;
    constexpr int I_IN = 16 * 128, I_GLU = 8 * 16, I_US = 8 * 32, I_UA = 8 * 32, I_OUT = 16 * 32, I_W1 = 32 * 256, I_W3 = 32 * 256, I_W2 = 32 * 256;
    constexpr int NITEMS = I_IN + I_GLU + I_US + I_UA + I_OUT + I_W1 + I_W3 + I_W2;
    unsigned char* ws = F.ws;
    for (int it = gw; it < NITEMS; it += NGW) {
        int r = it;
        if (r < I_IN) { const int k0 = 64 * (r / 128), n0 = 32 * (r % 128);
            if (n0 < DS) transpose_item(F.in[2], DIN, k0, n0, (bf16_t*)(ws + WS_WIN), n0, D, scr, lane);
            else transpose_item_f8(F.in[2], DIN, k0, n0, ws + WS_WINF8, n0 - DS, D, WF8_SCALE, scr, lane);
            continue; } r -= I_IN;
        if (r < I_GLU) { transpose_item(F.in[12], DS, 64 * (r / 16), 32 * (r % 16), (bf16_t*)(ws + WS_WGLU), 32 * (r % 16), DS, scr, lane); continue; } r -= I_GLU;
        if (r < I_US) { transpose_item(F.in[14], D, 64 * (r / 32), 32 * (r % 32), (bf16_t*)(ws + WS_WUS), 32 * (r % 32), DS, scr, lane); continue; } r -= I_US;
        if (r < I_UA) { transpose_item_f8(F.in[15], D, 64 * (r / 32), 32 * (r % 32), ws + WS_WUA, 32 * (r % 32), DA, WF8_SCALE, scr, lane); continue; } r -= I_UA;
        if (r < I_OUT) { transpose_item(F.in[17], D, 64 * (r / 32), 32 * (r % 32), (bf16_t*)(ws + WS_WOUT), 32 * (r % 32), D, scr, lane); continue; } r -= I_OUT;
        if (r < I_W1 + I_W3) { const int w3 = r >= I_W1; if (w3) r -= I_W1; const int e = r >> 8, q = r & 255, k0 = 64 * (q / 16), n0 = 32 * (q % 16);
            transpose_item_f8((w3 ? F.in[24] : F.in[23]) + (size_t)e * D * DE, DE, k0, n0, ws + WS_W13, (size_t)e * 1024 + 256 * (n0 >> 7) + (n0 & 127) + (w3 ? 128 : 0), D, WF8_SCALE, scr, lane, F.in[18]); continue; }
        r -= I_W1 + I_W3;
        { const int e = r >> 8, q = r & 255, k0 = 64 * (q / 32), n0 = 32 * (q % 32);
            transpose_item_f8(F.in[25] + (size_t)e * DE * D, D, k0, n0, ws + WS_W2, (size_t)e * 1024 + n0, DE, WF8_SCALE, scr, lane); }
    }
    for (int m = 4 * gw; m < T; m += 4 * NGW) rms_rows_to_bf16<4>(lane, F.in[0] + (size_t)m * D, F.in[1], (bf16_t*)(ws + WS_H1) + (size_t)m * D, ws + WS_H1F8 + (size_t)m * D);
    { bf16_t* WR = (bf16_t*)(ws + WS_WR); const float* wrg = F.in[19]; const float* wre = F.in[21];
      for (int idx = F.vcu * NTHR + F.tid; idx < 256 * D; idx += F.G * NTHR) { const int r = idx >> 10, k = idx & 1023; unsigned o = 0u;
          if (r < 72) { const int c = r < 36 ? r : r - 36; const float w = (c < 4 ? wrg[k * 4 + c] : wre[k * 32 + (c - 4)]) * F.in[18][k]; const unsigned hb = f2bf(w);
              o = r < 36 ? hb : f2bf(w - __builtin_bit_cast(float, hb << 16)); }
          WR[idx] = (bf16_t)o; } }
}

__device__ __forceinline__ int crow(int r, int hi) { return (r & 3) + 8 * (r >> 2) + 4 * hi; }
constexpr int KVP = 72;
__device__ __forceinline__ void kv_prep_phase(Frame& F) {
    LAS bf16_t* KS = (LAS bf16_t*)(F.lds); LAS bf16_t* VS = KS + 256 * KVP; LAS float* PS = (LAS float*)(F.lds + 2 * 256 * KVP * 2); LAS float* WM = PS + 512;
    const bf16_t* Kb = (const bf16_t*)(F.ws + WS_K); const bf16_t* Vb = (const bf16_t*)(F.ws + WS_V);
    bf16_t* Kf = (bf16_t*)(F.ws + WS_KFRAG); bf16_t* Vf = (bf16_t*)(F.ws + WS_VFRAG); bf16_t* KM = (bf16_t*)(F.ws + WS_KMEAN); float* KN = (float*)(F.ws + WS_KMEAN + 512 * 1024);
    const int tid = F.tid;
    u32x4 kr[4], vr[4];
#define KVP_LOAD(item_) do { const int n_ = (item_) & 31, h_ = ((item_) >> 5) & 7, b_ = (item_) >> 8; const size_t tok0_ = (size_t)b_ * SEQ + 256 * n_; \
        _Pragma("unroll") for (int j = 0; j < 4; ++j) { const int q = tid + NTHR * j, row = q >> 3, pc = q & 7; const size_t src = (tok0_ + row) * DA + h_ * HD + pc * 8; kr[j] = *(const u32x4*)(Kb + src); vr[j] = *(const u32x4*)(Vb + src); } } while (0)
    if (F.vcu < BATCH * NH * NBLK) KVP_LOAD(F.vcu);
    for (int item = F.vcu; item < BATCH * NH * NBLK; item += F.G) {
#pragma unroll
        for (int j = 0; j < 4; ++j) { const int q = tid + NTHR * j, row = q >> 3, pc = q & 7; *(LAS u32x4*)(KS + row * KVP + pc * 8) = kr[j]; *(LAS u32x4*)(VS + row * KVP + pc * 8) = vr[j]; }
        { const int nx = (item + F.G < BATCH * NH * NBLK) ? item + F.G : item; KVP_LOAD(nx); }
        __syncthreads();
#pragma unroll
        for (int j = 0; j < 4; ++j) { const int P = tid + NTHR * j, st = P >> 8, ds = (P >> 6) & 3, l2 = P & 63, row = 32 * st + (l2 & 31), col = 16 * ds + 8 * (l2 >> 5);
            *(u32x4*)(Kf + ((size_t)item * 2048 + P) * 8) = *(const LAS u32x4*)(KS + row * KVP + col); }
#pragma unroll
        for (int j = 0; j < 4; ++j) { const int P = tid + NTHR * j, st = P >> 8, ks = (P >> 7) & 1, d0 = (P >> 6) & 1, l2 = P & 63, hi = l2 >> 5, jj = l2 & 31; unsigned w[4];
#pragma unroll
            for (int e = 0; e < 8; e += 2) { const unsigned lo = VS[(32 * st + 16 * ks + crow(e, hi)) * KVP + 32 * d0 + jj], hi16 = VS[(32 * st + 16 * ks + crow(e + 1, hi)) * KVP + 32 * d0 + jj]; w[e >> 1] = lo | (hi16 << 16); }
            *(u32x4*)(Vf + ((size_t)item * 2048 + P) * 8) = (u32x4){w[0], w[1], w[2], w[3]}; }
        { const int d = tid & 63, part = tid >> 6; float s = 0.f;
#pragma unroll 8
          for (int r = 0; r < 32; ++r) s += bf2f(KS[(part * 32 + r) * KVP + d]);
          PS[part * 64 + d] = s; }
        if (tid < 256) { float ss = 0.f;
#pragma unroll
            for (int c = 0; c < 8; ++c) { const u32x4 w = *(const LAS u32x4*)(KS + tid * KVP + c * 8);
                ss += bflo(w.x) * bflo(w.x) + bfhi(w.x) * bfhi(w.x) + bflo(w.y) * bflo(w.y) + bfhi(w.y) * bfhi(w.y) + bflo(w.z) * bflo(w.z) + bfhi(w.z) * bfhi(w.z) + bflo(w.w) * bflo(w.w) + bfhi(w.w) * bfhi(w.w); }
            ss = wave_max(ss); if (F.lane == 0) WM[F.wave] = ss; }
        __syncthreads();
        if (tid < 64) { float s = 0.f;
#pragma unroll
            for (int p = 0; p < 8; ++p) s += PS[p * 64 + tid];
            KM[(size_t)item * 64 + tid] = (bf16_t)f2bf(s * (1.f / 256.f)); }
        if (tid == 0) KN[item] = fmaxf(fmaxf(WM[0], WM[1]), fmaxf(WM[2], WM[3]));
        __syncthreads();
    }
#undef KVP_LOAD
}

__device__ __forceinline__ void ssm_scan_phase(Frame& F) {
    LAS float* FW = (LAS float*)(F.lds);
    const float* E = (const float*)(F.ws + WS_E); bf16_t* UP = (bf16_t*)(F.ws + WS_UP);
    const int w = F.wave, p = F.lane;
    for (int gb = F.vcu; gb < SG * BATCH; gb += F.G) {
        const int g = gb >> 3, b = gb & 7;
        const float lr = F.in[4][g * SP + p], li = F.in[5][g * SP + p], step = __expf(F.in[6][g]);
        float ar, ai; cpow(lr, li, step, 32.f, ar, ai);
        const size_t row0 = (size_t)g * SROWS + b * 256 + 32 * w;
        f32x2 e[32];
#pragma unroll
        for (int j = 0; j < 32; ++j) e[j] = *(const f32x2*)(E + (row0 + j) * 128 + 2 * p);
        float sr = 0.f, si = 0.f;
#pragma unroll
        for (int j = 0; j < 32; ++j) { const float nr = ar * sr - ai * si + e[j].x, ni = ar * si + ai * sr + e[j].y; sr = nr; si = ni; }
        FW[(w * 64 + p) * 2] = sr; FW[(w * 64 + p) * 2 + 1] = si;
        __syncthreads();
        float Ar = ar, Ai = ai;
#pragma unroll
        for (int q = 0; q < 5; ++q) { const float nr = Ar * Ar - Ai * Ai, ni = 2.f * Ar * Ai; Ar = nr; Ai = ni; }
        sr = 0.f; si = 0.f;
        for (int w2 = 0; w2 < w; ++w2) { const float fr = FW[(w2 * 64 + p) * 2], fi = FW[(w2 * 64 + p) * 2 + 1]; const float nr = Ar * sr - Ai * si + fr, ni = Ar * si + Ai * sr + fi; sr = nr; si = ni; }
#pragma unroll
        for (int j = 0; j < 32; ++j) { *(unsigned*)(UP + (row0 + j) * SKY + SKU + 2 * p) = pk2(sr, si);
            const float nr = ar * sr - ai * si + e[j].x, ni = ar * si + ai * sr + e[j].y; sr = nr; si = ni; }
        __syncthreads();
    }
}

__device__ __forceinline__ int t5_bucket(int d) {
    if (d < 16) return d;
    return 16 + (d >= 19) + (d >= 21) + (d >= 24) + (d >= 27) + (d >= 31) + (d >= 35) + (d >= 40) + (d >= 46) + (d >= 52) + (d >= 59) + (d >= 67) + (d >= 77) + (d >= 87) + (d >= 99) + (d >= 113);
}
struct Top3 { float v0, v1, v2; int i0, i1, i2; };
__device__ __forceinline__ Top3 top3_insert(Top3 t, float x, int n) {
    const bool b0 = (x > t.v0) || (x == t.v0 && n < t.i0), b1 = (x > t.v1) || (x == t.v1 && n < t.i1), b2 = (x > t.v2) || (x == t.v2 && n < t.i2);
    Top3 r;
    r.v2 = b1 ? t.v1 : (b2 ? x : t.v2); r.i2 = b1 ? t.i1 : (b2 ? n : t.i2);
    r.v1 = b0 ? t.v0 : (b1 ? x : t.v1); r.i1 = b0 ? t.i0 : (b1 ? n : t.i1);
    r.v0 = b0 ? x : t.v0; r.i0 = b0 ? n : t.i0;
    return r;
}
constexpr int GQS = 0, GKME = 36864, GCNTL = 41472, GMISC = 41600;
template <bool COUNT> __device__ __forceinline__ void attn_gate_unit(Frame& F, int bh, int qb) {
    LAS unsigned char* L = F.lds;
    LAS bf16_t* QS = (LAS bf16_t*)(L + GQS); LAS bf16_t* KME = (LAS bf16_t*)(L + GKME); LAS int* CNT = (LAS int*)(L + GCNTL); LAS float* KNM = (LAS float*)(L + GMISC);
    int tid = F.tid; asm volatile("" : "+v"(tid));
    const int lane = tid & 63, w = F.wave, j = lane & 31, hi = lane >> 5;
    const int b = bh >> 3, h = bh & 7; const size_t tok0 = (size_t)b * SEQ + 256 * qb;
    const bf16_t* Qb = (const bf16_t*)(F.ws + WS_Q); const bf16_t* KM = (const bf16_t*)(F.ws + WS_KMEAN); const float* KN = (const float*)(F.ws + WS_KMEAN + 512 * 1024);
    float* MQg = (float*)(F.ws + WS_MQ); unsigned short* QL = (unsigned short*)(F.ws + WS_QLIST); unsigned* GC = (unsigned*)(F.ctl + CW_GCNT); unsigned* SEGC = (unsigned*)(F.ws + WS_SEGC);
#pragma unroll
    for (int jj = 0; jj < 4; ++jj) { const int q = tid + NTHR * jj, row = q >> 3, pc = q & 7; *(LAS u32x4*)(QS + row * KVP + pc * 8) = *(const u32x4*)(Qb + (tok0 + row) * DA + h * HD + pc * 8); }
    if (tid < 256) { const int n = tid >> 3, pc = tid & 7; *(LAS u32x4*)(KME + n * KVP + pc * 8) = *(const u32x4*)(KM + ((size_t)bh * 32 + n) * 64 + pc * 8); }
    if (tid < 32) CNT[tid] = 0;
    if (w == 1) { float v = (lane <= qb && lane < 32) ? KN[bh * 32 + lane] : 0.f; v = wave_max(v); if (lane == 0) KNM[0] = v; }
    if (w == 2) { float v = F.in[16][h * 32 + (lane & 31)]; v = wave_max(v); if (lane == 0) KNM[1] = v * LOG2E; }
    __syncthreads();
    {
        bf16x8 qf[4], kmf[4];
#pragma unroll
        for (int ds = 0; ds < 4; ++ds) { qf[ds] = *(const LAS bf16x8*)(QS + (32 * w + j) * KVP + 16 * ds + 8 * hi); kmf[ds] = *(const LAS bf16x8*)(KME + j * KVP + 16 * ds + 8 * hi); }
        f32x16 gt = {};
#pragma unroll
        for (int ds = 0; ds < 4; ++ds) gt = __builtin_amdgcn_mfma_f32_32x32x16_bf16(kmf[ds], qf[ds], gt, 0, 0, 0);
        float qn = 0.f;
#pragma unroll
        for (int ds = 0; ds < 4; ++ds)
#pragma unroll
            for (int e = 0; e < 8; ++e) { const float x = bf2f((unsigned short)qf[ds][e]); qn += x * x; }
        qn += __shfl_xor(qn, 32);
        const float m2 = sqrtf(qn * KNM[0]) + KNM[1];
        const int ql = 256 * qb + 32 * w + j;
        if (hi == 0) MQg[(size_t)bh * SEQ + ql] = m2;
        Top3 t3; t3.v0 = t3.v1 = t3.v2 = -INFINITY; t3.i0 = t3.i1 = t3.i2 = -1;
#pragma unroll
        for (int r = 0; r < 16; ++r) { const int n = crow(r, hi); const float x = (n < qb) ? gt[r] : -INFINITY; t3 = top3_insert(t3, x, x > -INFINITY ? n : 0x7fffffff); }
        { const float p0 = __shfl_xor(t3.v0, 32), p1 = __shfl_xor(t3.v1, 32), p2 = __shfl_xor(t3.v2, 32); const int q0 = __shfl_xor(t3.i0, 32), q1 = __shfl_xor(t3.i1, 32), q2 = __shfl_xor(t3.i2, 32);
          t3 = top3_insert(t3, p0, q0 >= 0 ? q0 : 0x7fffffff); t3 = top3_insert(t3, p1, q1 >= 0 ? q1 : 0x7fffffff); t3 = top3_insert(t3, p2, q2 >= 0 ? q2 : 0x7fffffff); }
        const int i0 = t3.v0 > -INFINITY ? t3.i0 : -1, i1 = t3.v1 > -INFINITY ? t3.i1 : -1, i2 = t3.v2 > -INFINITY ? t3.i2 : -1;
        if (hi == 0) { const unsigned e = (unsigned)ql << 2;
            if (i0 >= 0) { const int pos = __hip_atomic_fetch_add(CNT + i0, 1, __ATOMIC_RELAXED, __HIP_MEMORY_SCOPE_WORKGROUP); QL[((size_t)bh * 32 + i0) * SEQ + (qb - i0 - 1) * 256 + pos] = (unsigned short)(e | 0u); }
            if (i1 >= 0) { const int pos = __hip_atomic_fetch_add(CNT + i1, 1, __ATOMIC_RELAXED, __HIP_MEMORY_SCOPE_WORKGROUP); QL[((size_t)bh * 32 + i1) * SEQ + (qb - i1 - 1) * 256 + pos] = (unsigned short)(e | 1u); }
            if (i2 >= 0) { const int pos = __hip_atomic_fetch_add(CNT + i2, 1, __ATOMIC_RELAXED, __HIP_MEMORY_SCOPE_WORKGROUP); QL[((size_t)bh * 32 + i2) * SEQ + (qb - i2 - 1) * 256 + pos] = (unsigned short)(e | 2u); } }
    }
    __syncthreads();
    if (tid < qb) { const unsigned c = (unsigned)CNT[tid]; SEGC[((size_t)bh * 32 + tid) * 32 + (qb - tid - 1)] = c; if (COUNT && c) (void)__hip_atomic_fetch_add(GC + bh * 32 + tid, c, __ATOMIC_RELAXED, __HIP_MEMORY_SCOPE_AGENT); }
    __syncthreads();
}
template <bool COUNT> __device__ __forceinline__ void attn_gate_phase(Frame& F) {
    for (int u = F.vcu; u < BATCH * NH * NBLK; u += F.G) attn_gate_unit<COUNT>(F, u >> 5, u & 31);
}

#define ATTN_SUBTILE(KP, VP, st_, MODE, CINIT) do { \
        bf16x8 kf_[4], vf_[4]; \
        _Pragma("unroll") for (int ds_ = 0; ds_ < 4; ++ds_) kf_[ds_] = *(const LAS bf16x8*)((KP) + ((st_) * 4 + ds_) * 512 + lane8); \
        _Pragma("unroll") for (int q_ = 0; q_ < 4; ++q_) vf_[q_] = *(const LAS bf16x8*)((VP) + ((st_) * 4 + q_) * 512 + lane8); \
        f32x16 s_ = __builtin_amdgcn_mfma_f32_32x32x16_bf16(kf_[0], qf[0], CINIT, 0, 0, 0); \
        _Pragma("unroll") for (int ds_ = 1; ds_ < 4; ++ds_) s_ = __builtin_amdgcn_mfma_f32_32x32x16_bf16(kf_[ds_], qf[ds_], s_, 0, 0, 0); \
        float p_[16]; \
        if ((MODE) == 0) { _Pragma("unroll") for (int r_ = 0; r_ < 16; ++r_) p_[r_] = __builtin_amdgcn_exp2f(s_[r_]); } \
        else if ((MODE) == 1) { _Pragma("unroll") for (int r_ = 0; r_ < 16; ++r_) { const int dist_ = dq - (32 * (st_) + crow(r_, hi)); const int di_ = dist_ < 0 ? 0 : (dist_ > 127 ? 127 : dist_); \
                p_[r_] = __builtin_amdgcn_exp2f(s_[r_] + TABh[di_]); } } \
        else { _Pragma("unroll") for (int rq_ = 0; rq_ < 4; ++rq_) { const f32x4 bb_ = *(const LAS f32x4*)(BTD + rq_ * 256 + lane * 4); \
                _Pragma("unroll") for (int i_ = 0; i_ < 4; ++i_) p_[4 * rq_ + i_] = __builtin_amdgcn_exp2f(s_[4 * rq_ + i_] + bb_[i_]); } } \
        _Pragma("unroll") for (int r_ = 0; r_ < 16; ++r_) lsum += p_[r_]; \
        u32x4 pa_, pb_; pa_.x = cvt_pk_bf16(p_[0], p_[1]); pa_.y = cvt_pk_bf16(p_[2], p_[3]); pa_.z = cvt_pk_bf16(p_[4], p_[5]); pa_.w = cvt_pk_bf16(p_[6], p_[7]); \
        pb_.x = cvt_pk_bf16(p_[8], p_[9]); pb_.y = cvt_pk_bf16(p_[10], p_[11]); pb_.z = cvt_pk_bf16(p_[12], p_[13]); pb_.w = cvt_pk_bf16(p_[14], p_[15]); \
        const bf16x8 A0_ = __builtin_bit_cast(bf16x8, pa_), A1_ = __builtin_bit_cast(bf16x8, pb_); \
        o0 = __builtin_amdgcn_mfma_f32_32x32x16_bf16(vf_[0], A0_, o0, 0, 0, 0); o1 = __builtin_amdgcn_mfma_f32_32x32x16_bf16(vf_[1], A0_, o1, 0, 0, 0); \
        o0 = __builtin_amdgcn_mfma_f32_32x32x16_bf16(vf_[2], A1_, o0, 0, 0, 0); o1 = __builtin_amdgcn_mfma_f32_32x32x16_bf16(vf_[3], A1_, o1, 0, 0, 0); } while (0)

__device__ __forceinline__ u32x4 ot_pack16(const f32x16& o, int pr) {
    const unsigned p0 = cvt_pk_bf16(o[8 * pr], o[8 * pr + 1]), p1 = cvt_pk_bf16(o[8 * pr + 2], o[8 * pr + 3]), q0 = cvt_pk_bf16(o[8 * pr + 4], o[8 * pr + 5]), q1 = cvt_pk_bf16(o[8 * pr + 6], o[8 * pr + 7]);
    const auto r0 = __builtin_amdgcn_permlane32_swap(p0, q0, false, false); const auto r1 = __builtin_amdgcn_permlane32_swap(p1, q1, false, false);
    return (u32x4){r0[0], r1[0], r0[1], r1[1]};
}
__device__ __forceinline__ u32x2 ot_pack8_f8(const f32x16& o, int pr) {
    const unsigned p = pk4_fp8(o[8 * pr], o[8 * pr + 1], o[8 * pr + 2], o[8 * pr + 3]), q = pk4_fp8(o[8 * pr + 4], o[8 * pr + 5], o[8 * pr + 6], o[8 * pr + 7]);
    const auto r0 = __builtin_amdgcn_permlane32_swap(p, q, false, false);
    return (u32x2){r0[0], r0[1]};
}
__device__ __forceinline__ void ot_add16(f32x16& o, int pr, u32x4 v, bool use) {
    const auto r0 = __builtin_amdgcn_permlane32_swap(v.x, v.z, false, false); const auto r1 = __builtin_amdgcn_permlane32_swap(v.y, v.w, false, false);
    const unsigned p0 = r0[0], p1 = r1[0], q0 = r0[1], q1 = r1[1];
    o[8 * pr] += use ? bflo(p0) : 0.f; o[8 * pr + 1] += use ? bfhi(p0) : 0.f; o[8 * pr + 2] += use ? bflo(p1) : 0.f; o[8 * pr + 3] += use ? bfhi(p1) : 0.f;
    o[8 * pr + 4] += use ? bflo(q0) : 0.f; o[8 * pr + 5] += use ? bfhi(q0) : 0.f; o[8 * pr + 6] += use ? bflo(q1) : 0.f; o[8 * pr + 7] += use ? bfhi(q1) : 0.f;
}
__device__ __forceinline__ void ot_add8_f8(f32x16& o, int pr, u32x2 v, bool use, float sc) {
    const auto r0 = __builtin_amdgcn_permlane32_swap(v.x, v.y, false, false); const int p = (int)r0[0], q = (int)r0[1];
    o[8 * pr] += use ? __builtin_amdgcn_cvt_f32_fp8(p, 0) * sc : 0.f; o[8 * pr + 1] += use ? __builtin_amdgcn_cvt_f32_fp8(p, 1) * sc : 0.f; o[8 * pr + 2] += use ? __builtin_amdgcn_cvt_f32_fp8(p, 2) * sc : 0.f; o[8 * pr + 3] += use ? __builtin_amdgcn_cvt_f32_fp8(p, 3) * sc : 0.f;
    o[8 * pr + 4] += use ? __builtin_amdgcn_cvt_f32_fp8(q, 0) * sc : 0.f; o[8 * pr + 5] += use ? __builtin_amdgcn_cvt_f32_fp8(q, 1) * sc : 0.f; o[8 * pr + 6] += use ? __builtin_amdgcn_cvt_f32_fp8(q, 2) * sc : 0.f; o[8 * pr + 7] += use ? __builtin_amdgcn_cvt_f32_fp8(q, 3) * sc : 0.f;
}
__device__ __forceinline__ void attn_fill_tab(Frame& F, LAS float* TAB) {
    const float* rb = F.in[16];
    for (int idx = F.tid; idx < 8 * 132; idx += NTHR) { const int h = idx / 132, d = idx % 132; float v = 0.f;
        if (d < 128) v = rb[h * 32 + t5_bucket(d)] * LOG2E; else if (d == 129) v = rb[h * 32 + 31] * LOG2E;
        TAB[idx] = v; }
}
constexpr int BGPRE_OFF = ROWTAB_OFF, BGCL_OFF = ROWTAB_OFF + 8448, BTAB_OFF = ROWTAB_OFF + 16640, BIT_OFF = ROWTAB_OFF + 20992, BIT_MAX = 512, OTAB_OFF = ROWTAB_OFF + 20480  ;
static_assert(BTAB_OFF + 8 * 132 * 4 <= MOE_TST_OFF, "attention LDS tables");
__device__ __forceinline__ size_t part_off(int slot) { return slot == 0 ? WS_PART0 : (slot == 1 ? WS_PART1 : WS_PART2); }

__device__ __forceinline__ void attn_block_phase(Frame& F) {
    LAS unsigned char* L = F.lds; LAS int* GPRE = (LAS int*)(L + BGPRE_OFF); LAS int* GCL = (LAS int*)(L + BGCL_OFF); LAS float* TAB = (LAS float*)(L + BTAB_OFF); LAS int* ITT = (LAS int*)(L + BIT_OFF); LAS int* WSUM = (LAS int*)(L + MOE_TST_OFF);
    const unsigned* GC = (const unsigned*)(F.ctl + CW_GCNT); const unsigned* SEGC = (const unsigned*)(F.ws + WS_SEGC);
    const int tid = F.tid, lane = F.lane, w = F.wave, j = lane & 31, hi = lane >> 5, lane8 = lane * 8;
    { int ng[4], tot = 0;
#pragma unroll
      for (int e = 0; e < 4; ++e) { const int c = (int)GC[4 * tid + e]; GCL[4 * tid + e] = c; ng[e] = (((c + 31) >> 5) + 7) >> 3; tot += ng[e]; }
      int inc = tot;
#pragma unroll
      for (int o = 1; o < 64; o <<= 1) { const int t = __shfl_up(inc, o); if (lane >= o) inc += t; }
      if (lane == 63) WSUM[w] = inc;
      __syncthreads();
      int woff = 0;
      for (int q = 0; q < w; ++q) woff += WSUM[q];
      int ex = woff + inc - tot;
#pragma unroll
      for (int e = 0; e < 4; ++e) { GPRE[4 * tid + e] = ex; ex += ng[e]; }
      if (tid == NTHR - 1) GPRE[2048] = ex; }
    attn_fill_tab(F, TAB);
    __syncthreads();
    const int NIT = GPRE[2048];
    const int nk = (NIT > F.vcu) ? (NIT - F.vcu + F.G - 1) / F.G : 0;
    if (tid < nk && tid < BIT_MAX) { const int it_ = F.vcu + tid * F.G; int lo_ = 0, hi_ = 2048; while (hi_ - lo_ > 1) { const int mid_ = (lo_ + hi_) >> 1; if (GPRE[mid_] <= it_) lo_ = mid_; else hi_ = mid_; } ITT[tid] = lo_ * 64 + (it_ - GPRE[lo_]); }
    __syncthreads();
    if (nk == 0) return;
    const int nkc = nk < BIT_MAX ? nk : BIT_MAX;
    const bf16_t* Qb = (const bf16_t*)(F.ws + WS_Q); const float* MQg = (const float*)(F.ws + WS_MQ); const unsigned short* QL = (const unsigned short*)(F.ws + WS_QLIST);
    const bf16_t* KF = (const bf16_t*)(F.ws + WS_KFRAG); const bf16_t* VF = (const bf16_t*)(F.ws + WS_VFRAG);
    float* PL = (float*)(F.ws + WS_PL);
#define BLK_ITEM(k_, pi_, g_) do { const int kk_ = (k_) < nkc ? (k_) : nkc - 1; const int v_ = __builtin_amdgcn_readfirstlane(ITT[kk_]); pi_ = v_ >> 6; g_ = v_ & 63; } while (0)
#define BLK_DMA(buf_, pi_) do { const char* ks_ = (const char*)KF + ((size_t)(pi_) * 2048 + tid) * 16; const char* vs_ = (const char*)VF + ((size_t)(pi_) * 2048 + tid) * 16; \
        _Pragma("unroll") for (int i_ = 0; i_ < 4; ++i_) { \
            __builtin_amdgcn_global_load_lds((const unsigned*)(ks_ + i_ * 8192), (LAS unsigned*)(L + (buf_) + (i_ * 512 + w * 64) * 16), 16, 0, 0); \
            __builtin_amdgcn_global_load_lds((const unsigned*)(vs_ + i_ * 8192), (LAS unsigned*)(L + (buf_) + 32768 + (i_ * 512 + w * 64) * 16), 16, 0, 0); } } while (0)
#define BLK_SEGC(dst_, pi_) do { dst_ = SEGC[(size_t)(pi_) * 32 + j]; } while (0)
#define BLK_ENTRY(dst_, segc_, pi_, g_) do { const int n_ = (pi_) & 31; int inc_ = (j < 31 - n_) ? (int)(segc_) : 0; \
        _Pragma("unroll") for (int o_ = 1; o_ < 32; o_ <<= 1) { const int t_ = __shfl_up(inc_, o_); if (j >= o_) inc_ += t_; } \
        const int cnt_ = GCL[pi_]; const int idx_ = 32 * (8 * (g_) + w) + j; int seg_ = 0, prev_ = 0; \
        for (int s_ = 0; s_ < 31 - n_; ++s_) { const int p_ = __builtin_amdgcn_readlane(inc_, s_); const bool le_ = p_ <= idx_; seg_ += le_ ? 1 : 0; prev_ = le_ ? p_ : prev_; } \
        const bool ok_ = idx_ < cnt_; const unsigned v_ = QL[(size_t)(pi_) * SEQ + (ok_ ? seg_ * 256 + (idx_ - prev_) : 0)]; dst_ = ok_ ? v_ : 0xFFFFu; } while (0)
#define BLK_QLOAD(qf_, m2_, ent_, pi_) do { const unsigned qq_ = ((ent_) == 0xFFFFu) ? 0u : ((ent_) >> 2); const int bh_ = (pi_) >> 5; \
        const bf16_t* qrow_ = Qb + ((size_t)(bh_ >> 3) * SEQ + qq_) * DA + (bh_ & 7) * HD + 8 * hi; \
        _Pragma("unroll") for (int ds_ = 0; ds_ < 4; ++ds_) qf_[ds_] = *(const bf16x8*)(qrow_ + 16 * ds_); \
        m2_ = MQg[(size_t)bh_ * SEQ + qq_]; } while (0)
    int pi, g, pi1, g1, pi2, g2; unsigned ent, ent1, sc2; bf16x8 qf[4]; float m2r;
    BLK_ITEM(0, pi, g); BLK_ITEM(1, pi1, g1); BLK_ITEM(2, pi2, g2);
    BLK_DMA(0, pi);
    { unsigned sc0, sc1; BLK_SEGC(sc0, pi); BLK_SEGC(sc1, pi1); BLK_SEGC(sc2, pi2); BLK_ENTRY(ent, sc0, pi, g); BLK_ENTRY(ent1, sc1, pi1, g1); }
    BLK_QLOAD(qf, m2r, ent, pi);
    int cur = 0;
    __builtin_amdgcn_s_waitcnt(0x0F70);
    unsigned char* dump = F.ws + WS_E + ((size_t)F.vcu * NTHR + tid) * 128;
    for (int k = 0; k < nkc; ++k) {
        __builtin_amdgcn_s_waitcnt(0x0F75);
        __syncthreads();
        int pi3, g3; unsigned sc3, ent2; bf16x8 qfn[4]; float m2n;
        BLK_ITEM(k + 3, pi3, g3); BLK_SEGC(sc3, pi3);
        BLK_ENTRY(ent2, sc2, pi2, g2);
        BLK_QLOAD(qfn, m2n, ent1, pi1);
        BLK_DMA((cur ^ 1) * 65536, pi1);
        const int bh = pi >> 5, n = pi & 31, h = bh & 7;
        const bool valid = ent != 0xFFFFu; const int q = valid ? (int)(ent >> 2) : 0; const int slot = (int)(ent & 3u);
        const bool active = __builtin_amdgcn_readfirstlane((int)(__ballot(valid) != 0ull)) != 0;
        f32x16 o0 = {}, o1 = {}; float lsum = 0.f;
        if (active) {
            const float m2 = valid ? m2r : INFINITY;
            const LAS bf16_t* KP = (const LAS bf16_t*)(L + cur * 65536); const LAS bf16_t* VP = (const LAS bf16_t*)(L + cur * 65536 + 32768);
            const LAS float* TABh = TAB + h * 132; const LAS float* BTD = nullptr; (void)BTD;
            const int dq = q - 256 * n;
            const bool nearw = __builtin_amdgcn_readfirstlane((int)(__ballot(valid && dq < 383) != 0ull)) != 0;
            const float ci = nearw ? -m2 : TABh[129] - m2;
            f32x16 cinit;
#pragma unroll
            for (int r = 0; r < 16; ++r) cinit[r] = ci;
            if (nearw) { for (int st = 0; st < 8; ++st) ATTN_SUBTILE(KP, VP, st, 1, cinit); }
            else { for (int st = 0; st < 8; ++st) ATTN_SUBTILE(KP, VP, st, 0, cinit); }
        }
        { const float lt = lsum + __shfl_xor(lsum, 32);
          const size_t qi = (size_t)bh * SEQ + q;
          float* pld = valid ? PL + (size_t)slot * (NH * BATCH * SEQ) + qi : (float*)(dump + 120);
          unsigned char* dst = valid ? F.ws + part_off(slot) + qi * HD + 8 * hi : dump;
          *pld = lt;
          const float inv = lt > 0.f ? 1.f / lt : 0.f;
#pragma unroll
          for (int r = 0; r < 16; ++r) { o0[r] *= inv; o1[r] *= inv; }
          *(u32x2*)(dst) = ot_pack8_f8(o0, 0); *(u32x2*)(dst + 16) = ot_pack8_f8(o0, 1); *(u32x2*)(dst + 32) = ot_pack8_f8(o1, 0); *(u32x2*)(dst + 48) = ot_pack8_f8(o1, 1); }
        pi = pi1; g = g1; ent = ent1; m2r = m2n; pi1 = pi2; g1 = g2; ent1 = ent2; pi2 = pi3; g2 = g3; sc2 = sc3; cur ^= 1;
#pragma unroll
        for (int ds = 0; ds < 4; ++ds) qf[ds] = qfn[ds];
    }
    VM_WAIT(); __syncthreads();
#undef BLK_ITEM
#undef BLK_DMA
#undef BLK_SEGC
#undef BLK_ENTRY
#undef BLK_QLOAD
}

__device__ __forceinline__ void attn_own_phase(Frame& F) {
    LAS unsigned char* L = F.lds; LAS float* TAB = (LAS float*)(L + OTAB_OFF); LAS float* BT = (LAS float*)(L + ROWTAB_OFF); int bth = -1;
    attn_fill_tab(F, TAB);
    const int tid = F.tid, lane = F.lane, w = F.wave, j = lane & 31, hi = lane >> 5, lane8 = lane * 8;
    const bf16_t* Qb = (const bf16_t*)(F.ws + WS_Q); const float* MQg = (const float*)(F.ws + WS_MQ);
    const bf16_t* KF = (const bf16_t*)(F.ws + WS_KFRAG); const bf16_t* VF = (const bf16_t*)(F.ws + WS_VFRAG);
    const float* PL = (const float*)(F.ws + WS_PL); unsigned char* YA = F.ws + WS_YATT;
    const int NU = BATCH * NH * NBLK;
#define OWN_DMA(buf_, pi_) do { const char* ks_ = (const char*)KF + ((size_t)(pi_) * 2048 + tid) * 16; const char* vs_ = (const char*)VF + ((size_t)(pi_) * 2048 + tid) * 16; \
        _Pragma("unroll") for (int i_ = 0; i_ < 4; ++i_) { \
            __builtin_amdgcn_global_load_lds((const unsigned*)(ks_ + i_ * 8192), (LAS unsigned*)(L + (buf_) + (i_ * 512 + w * 64) * 16), 16, 0, 0); \
            __builtin_amdgcn_global_load_lds((const unsigned*)(vs_ + i_ * 8192), (LAS unsigned*)(L + (buf_) + 32768 + (i_ * 512 + w * 64) * 16), 16, 0, 0); } } while (0)
#define OWN_QLOAD(qf_, m2_, u_) do { const int bh_ = (u_) >> 5, qb_ = (u_) & 31; const size_t tk_ = (size_t)256 * qb_ + 32 * w + j; \
        const bf16_t* qrow_ = Qb + ((size_t)(bh_ >> 3) * SEQ + tk_) * DA + (bh_ & 7) * HD + 8 * hi; \
        _Pragma("unroll") for (int ds_ = 0; ds_ < 4; ++ds_) qf_[ds_] = *(const bf16x8*)(qrow_ + 16 * ds_); \
        m2_ = MQg[(size_t)bh_ * SEQ + tk_]; } while (0)
    int u = F.vcu; if (u >= NU) return;
    bf16x8 qf[4]; float m2;
    OWN_DMA(0, u); OWN_QLOAD(qf, m2, u);
    int cur = 0;
    __builtin_amdgcn_s_waitcnt(0x0F70);
    for (;;) {
        __builtin_amdgcn_s_waitcnt(0x0F74); __syncthreads();
        const int un = (u + F.G < NU) ? u + F.G : u; const bool last = (un == u);
        const int bh = u >> 5, qb = u & 31, b = bh >> 3, h = bh & 7; const int ql = 32 * w + j; const size_t qi = (size_t)bh * SEQ + 256 * qb + ql;
        u32x2 pa[3][4]; float pl[3];
#pragma unroll
        for (int s = 0; s < 3; ++s) { pl[s] = PL[(size_t)s * (NH * BATCH * SEQ) + qi]; const unsigned char* src = F.ws + part_off(s) + qi * HD + 8 * hi;
#pragma unroll
            for (int c = 0; c < 4; ++c) pa[s][c] = *(const u32x2*)(src + 16 * c); }
        bf16x8 qfn[4]; float m2n;
        OWN_QLOAD(qfn, m2n, un);
        OWN_DMA((cur ^ 1) * 65536, un);
        const LAS bf16_t* KP = (const LAS bf16_t*)(L + cur * 65536); const LAS bf16_t* VP = (const LAS bf16_t*)(L + cur * 65536 + 32768); const LAS float* TABh = TAB + h * 132;
        if (h != bth) { __syncthreads();
            for (int e = tid; e < 5 * 1024; e += NTHR) { const int i = e & 3, ln = (e >> 2) & 63, rq = (e >> 8) & 3, dl = e >> 10; const int dist = 32 * dl + (ln & 31) - crow(4 * rq + i, ln >> 5);
                BT[e] = dist < 0 ? -1e30f : TABh[dist > 127 ? 127 : dist]; }
            bth = h; __syncthreads(); }
        const int dq = ql; (void)dq;
        f32x16 cnear, cfar;
#pragma unroll
        for (int r = 0; r < 16; ++r) { cnear[r] = -m2; cfar[r] = TABh[129] - m2; }
        f32x16 o0 = {}, o1 = {}; float lsum = 0.f;
        for (int st = 0; st <= w; ++st) { const int dl = w - st;
            if (dl >= 5) { const LAS float* BTD = nullptr; (void)BTD; ATTN_SUBTILE(KP, VP, st, 0, cfar); }
            else { const LAS float* BTD = BT + dl * 1024; ATTN_SUBTILE(KP, VP, st, 2, cnear); } }
        float lt = lsum + __shfl_xor(lsum, 32);
        const int nsel = qb < 3 ? qb : 3;
#pragma unroll
        for (int s = 0; s < 3; ++s) { const bool use = s < nsel; lt += use ? pl[s] : 0.f;
            ot_add8_f8(o0, 0, pa[s][0], use, pl[s]); ot_add8_f8(o0, 1, pa[s][1], use, pl[s]); ot_add8_f8(o1, 0, pa[s][2], use, pl[s]); ot_add8_f8(o1, 1, pa[s][3], use, pl[s]); }
        const float inv = 1.f / lt;
#pragma unroll
        for (int r = 0; r < 16; ++r) { o0[r] *= inv; o1[r] *= inv; }
        unsigned char* dst = YA + ((size_t)b * SEQ + 256 * qb + ql) * DA + h * HD + 8 * hi;
        *(u32x2*)(dst) = ot_pack8_f8(o0, 0); *(u32x2*)(dst + 16) = ot_pack8_f8(o0, 1); *(u32x2*)(dst + 32) = ot_pack8_f8(o1, 0); *(u32x2*)(dst + 48) = ot_pack8_f8(o1, 1);
        if (last) break;
        u = un; m2 = m2n; cur ^= 1;
#pragma unroll
        for (int ds = 0; ds < 4; ++ds) qf[ds] = qfn[ds];
    }
    VM_WAIT(); __syncthreads();
#undef OWN_DMA
#undef OWN_QLOAD
}
#undef ATTN_SUBTILE

__device__ __forceinline__ void routing_phase(Frame& F) {
    LAS int* lcnt = (LAS int*)(F.lds); LAS int* lbase = lcnt + 32;
    const float* SSQ = (const float*)(F.ws + WS_SSQ); const float* RL = (const float*)(F.ws + WS_RLOG);
    unsigned* rowtok = (unsigned*)(F.ws + WS_ROWTOK); float* rowcoef = (float*)(F.ws + WS_ROWCOEF); float* rowrstd = (float*)(F.ws + WS_ROWRSTD);
    unsigned* ecnt = (unsigned*)(F.ctl + CW_ECNT);
    const float* brg = F.in[20]; const float* bre = F.in[22];
    const int tid = F.tid;
    for (int base = F.vcu * 256; base < T; base += F.G * 256) {
        if (tid < 32) lcnt[tid] = 0;
        __syncthreads();
        int e0 = 0, e1 = 0, lp0 = 0, lp1 = 0; float c0 = 0.f, c1 = 0.f, rstd = 0.f; const int tok = base + tid;
        if (tid < 256) {
            float ss = 0.f;
#pragma unroll
            for (int q = 0; q < 4; ++q) { const f32x4 v = *(const f32x4*)(SSQ + (size_t)tok * 16 + 4 * q); ss += (v.x + v.y) + (v.z + v.w); }
            rstd = 1.f / sqrtf(ss * (1.f / D) + RMS_EPS);
            float r[72];
#pragma unroll
            for (int q = 0; q < 18; ++q) { const f32x4 v = *(const f32x4*)(RL + (size_t)tok * 72 + 4 * q); r[4 * q] = v.x; r[4 * q + 1] = v.y; r[4 * q + 2] = v.z; r[4 * q + 3] = v.w; }
            float gl[4], el[32];
#pragma unroll
            for (int c = 0; c < 4; ++c) gl[c] = rstd * (r[c] + r[36 + c]) + brg[c];
#pragma unroll
            for (int c = 0; c < 32; ++c) el[c] = rstd * (r[4 + c] + r[40 + c]) + bre[c];
            int gi = 0; float gm = gl[0];
#pragma unroll
            for (int c = 1; c < 4; ++c) if (gl[c] > gm) { gm = gl[c]; gi = c; }
            float Z = 0.f;
#pragma unroll
            for (int c = 0; c < 4; ++c) Z += __expf(gl[c] - gm);
            const float gval = 1.f / Z;
            float es[8];
#pragma unroll
            for (int q = 0; q < 8; ++q) es[q] = gi == 0 ? el[q] : (gi == 1 ? el[8 + q] : (gi == 2 ? el[16 + q] : el[24 + q]));
            int a0 = 0; float m0 = es[0];
#pragma unroll
            for (int q = 1; q < 8; ++q) if (es[q] > m0) { m0 = es[q]; a0 = q; }
            int a1 = -1; float m1 = -INFINITY;
#pragma unroll
            for (int q = 0; q < 8; ++q) if (q != a0 && es[q] > m1) { m1 = es[q]; a1 = q; }
            const float w0 = 1.f / (1.f + __expf(m1 - m0)), w1 = 1.f - w0;
            e0 = gi * 8 + a0; e1 = gi * 8 + a1; c0 = gval * w0; c1 = gval * w1;
            lp0 = __hip_atomic_fetch_add(lcnt + e0, 1, __ATOMIC_RELAXED, __HIP_MEMORY_SCOPE_WORKGROUP);
            lp1 = __hip_atomic_fetch_add(lcnt + e1, 1, __ATOMIC_RELAXED, __HIP_MEMORY_SCOPE_WORKGROUP);
        }
        __syncthreads();
        if (tid < 32) lbase[tid] = (int)__hip_atomic_fetch_add(ecnt + tid, (unsigned)lcnt[tid], __ATOMIC_RELAXED, __HIP_MEMORY_SCOPE_AGENT);
        __syncthreads();
        if (tid < 256) {
            const size_t i0 = (size_t)e0 * ROWCAP + lbase[e0] + lp0, i1 = (size_t)e1 * ROWCAP + lbase[e1] + lp1;
            rowtok[i0] = (unsigned)tok * 2u; rowcoef[i0] = c0; rowrstd[i0] = rstd;
            rowtok[i1] = (unsigned)tok * 2u + 1u; rowcoef[i1] = c1; rowrstd[i1] = rstd;
        }
        __syncthreads();
    }
}
struct MoeOrder {
    const LAS int* tst; int total, G, v;
    __device__ bool next(int i, pg8::Unit& u) const {
        const int L = i * G + v; if (L >= total) return false;
        const int rt = L >> 2; int e = 0;
#pragma unroll 8
        for (int q = 1; q <= 32; ++q) e += (tst[q] <= rt) ? 1 : 0;
        u.pm = rt; u.pn = L & 3; u.pb = e * 4 + u.pn; u.aux = e; u.aux2 = (rt - tst[e]) * 256; return true;
    }
};
__device__ __forceinline__ void moe_tables(Frame& F) {
    LAS int* tst = (LAS int*)(F.lds + MOE_TST_OFF); const unsigned* ecnt = (const unsigned*)(F.ctl + CW_ECNT);
    if (F.wave == 0) { const int lane = F.lane; int nt = lane < 32 ? (int)((ecnt[lane & 31] + 255u) >> 8) : 0; int inc = nt;
#pragma unroll
        for (int o = 1; o < 32; o <<= 1) { const int t = __shfl_up(inc, o); if (lane >= o) inc += t; }
        if (lane < 32) tst[lane + 1] = inc; if (lane == 0) tst[0] = 0; }
    __syncthreads();
}
__device__ __forceinline__ void final_phase(Frame& F) {
#ifdef SELFCHECK
    const bool chk_bad = __hip_atomic_load((unsigned*)(F.ctl + 2), __ATOMIC_RELAXED, __HIP_MEMORY_SCOPE_AGENT) != 0u;
#endif
    const bf16_t* X1 = (const bf16_t*)(F.ws + WS_X1); const unsigned char* Y0 = F.ws + WS_Y0; const unsigned char* Y1 = F.ws + WS_Y1; const float* gf = F.in[26];
    const int gw = F.vcu * NWAVES + F.wave, NGW = F.G * NWAVES, lane = F.lane;
    for (int m = gw; m < T; m += NGW) {
        const u32x2* xr = (const u32x2*)(X1 + (size_t)m * D) + lane; const unsigned* y0 = (const unsigned*)(Y0 + (size_t)m * D) + lane; const unsigned* y1 = (const unsigned*)(Y1 + (size_t)m * D) + lane;
        f32x4 v[4]; float s = 0.f;
#pragma unroll
        for (int j = 0; j < 4; ++j) { const u32x2 xx = xr[64 * j]; const int a = (int)y0[64 * j], c = (int)y1[64 * j]; constexpr float ys = 1.f / YF8_SCALE;
            v[j].x = bflo(xx.x) + (__builtin_amdgcn_cvt_f32_fp8(a, 0) + __builtin_amdgcn_cvt_f32_fp8(c, 0)) * ys; v[j].y = bfhi(xx.x) + (__builtin_amdgcn_cvt_f32_fp8(a, 1) + __builtin_amdgcn_cvt_f32_fp8(c, 1)) * ys;
            v[j].z = bflo(xx.y) + (__builtin_amdgcn_cvt_f32_fp8(a, 2) + __builtin_amdgcn_cvt_f32_fp8(c, 2)) * ys; v[j].w = bfhi(xx.y) + (__builtin_amdgcn_cvt_f32_fp8(a, 3) + __builtin_amdgcn_cvt_f32_fp8(c, 3)) * ys;
            s += (v[j].x * v[j].x + v[j].y * v[j].y) + (v[j].z * v[j].z + v[j].w * v[j].w); }
        const float rstd = 1.f / sqrtf(wave_sum(s) * (1.f / D) + RMS_EPS);
        f32x4* o = (f32x4*)(F.out + (size_t)m * D) + lane; const f32x4* gr = (const f32x4*)gf + lane;
#ifdef SELFCHECK
        if (chk_bad) { for (int j = 0; j < 4; ++j) o[64 * j] = (f32x4){0.f, 0.f, 0.f, 0.f}; continue; }
#endif
#pragma unroll
        for (int j = 0; j < 4; ++j) o[64 * j] = v[j] * rstd * gr[64 * j];
    }
}
#ifdef SELFCHECK
constexpr int CW_CHK = 2;
__device__ __forceinline__ int t5_bucket_ref(int n) { if (n < 16) return n; const int l = 16 + (int)(logf((float)n / 16.f) / logf(8.f) * 16.f); return l < 31 ? l : 31; }
__device__ __forceinline__ float kfrag_at(const bf16_t* KF, int bh, int key, int d) { const int n = key >> 8, kl = key & 255, st = kl >> 5, i = kl & 31, ds = d >> 4, hi = (d >> 3) & 1, e = d & 7;
    return bf2f(KF[(((size_t)bh * 32 + n) * 2048 + (st * 4 + ds) * 64 + (i + 32 * hi)) * 8 + e]); }
__device__ __forceinline__ float vfrag_at(const bf16_t* VF, int bh, int key, int d) { const int n = key >> 8, kl = key & 255, st = kl >> 5, kk = kl & 31, ks = kk >> 4, k16 = kk & 15, hi = (k16 >> 2) & 1, e = (k16 & 3) + 4 * (k16 >> 3), d0 = d >> 5, jj = d & 31;
    return bf2f(VF[(((size_t)bh * 32 + n) * 2048 + ((st * 2 + ks) * 2 + d0) * 64 + (jj + 32 * hi)) * 8 + e]); }
__device__ __forceinline__ void selfcheck_phase(Frame& F, float tol_attn, float tol_ssm) {
    const int lane = lane_id(); const int gw = F.vcu * NWAVES + F.wave;
    const bf16_t* Qb = (const bf16_t*)(F.ws + WS_Q); const bf16_t* KM = (const bf16_t*)(F.ws + WS_KMEAN); const bf16_t* KF = (const bf16_t*)(F.ws + WS_KFRAG); const bf16_t* VF = (const bf16_t*)(F.ws + WS_VFRAG);
    const unsigned char* YA = F.ws + WS_YATT; const float* rb = F.in[16];
    bool bad = false;
    for (int sidx = 0; sidx < 12; ++sidx) {
        unsigned hsh = (unsigned)(gw * 12 + sidx) * 2654435761u; hsh ^= hsh >> 15; hsh *= 2246822519u; hsh ^= hsh >> 13;
        const int bh = (int)(hsh & 63u); int q = (int)((hsh >> 6) & 8191u);
        if (sidx == 0) q = q & 767; if (sidx == 1) q = (q & ~255) | (sidx & 1 ? 0 : 255); if (sidx == 2) q = (q & ~255) | 255; if (sidx == 3) q = (q & ~255) | 128;
        const int b = bh >> 3, h = bh & 7, qb = q >> 8, d = lane;
        const float qd = bf2f(Qb[((size_t)b * SEQ + q) * DA + h * HD + d]);
        int s0 = -1, s1 = -1, s2 = -1; float g0 = -INFINITY, g1 = -INFINITY, g2 = -INFINITY;
        for (int n = 0; n < qb; ++n) { const float gt = wave_sum(qd * bf2f(KM[((size_t)bh * 32 + n) * 64 + d]));
            if (gt > g0) { g2 = g1; s2 = s1; g1 = g0; s1 = s0; g0 = gt; s0 = n; } else if (gt > g1) { g2 = g1; s2 = s1; g1 = gt; s1 = n; } else if (gt > g2) { g2 = gt; s2 = n; } }
        float m = -INFINITY, l = 0.f, od = 0.f;
        for (int blk = 0; blk < 4; ++blk) { const int n = blk == 0 ? s0 : (blk == 1 ? s1 : (blk == 2 ? s2 : qb)); if (n < 0) continue;
            const int kend = (blk == 3) ? (q & 255) + 1 : 256;
            for (int kl = 0; kl < kend; ++kl) { const int key = 256 * n + kl; const float kd = kfrag_at(KF, bh, key, d);
                const float s = wave_sum(qd * kd) + rb[h * 32 + t5_bucket_ref(q - key)] * LOG2E;
                const float mn = fmaxf(m, s), sc = exp2f(m - mn), p = exp2f(s - mn); l = l * sc + p; od = od * sc + p * vfrag_at(VF, bh, key, d); m = mn; } }
        od /= l;
        const float yd = __builtin_amdgcn_cvt_f32_fp8((int)YA[((size_t)b * SEQ + q) * DA + h * HD + d], 0);
        const float e2 = wave_sum((od - yd) * (od - yd)), o2 = wave_sum(od * od);
        if (!(e2 <= tol_attn * tol_attn * o2)) bad = true;
    }
    { const bf16_t* UP = (const bf16_t*)(F.ws + WS_UP); const bf16_t* GA = (const bf16_t*)(F.ws + WS_GACT);
      for (int sidx = 0; sidx < 6; ++sidx) {
        unsigned hsh = (unsigned)(gw * 6 + sidx + 7777) * 2654435761u; hsh ^= hsh >> 15; hsh *= 2246822519u; hsh ^= hsh >> 13;
        const int g = (int)(hsh & 31u), b = (int)((hsh >> 5) & 7u); int t = (int)((hsh >> 8) % 330u); if (sidx == 0) t = 31 + (int)((hsh >> 20) & 3u) * 32; if (sidx == 1) t = 32 + (int)((hsh >> 20) & 7u) * 32;
        const int p = lane;
        const float lr = F.in[4][g * SP + p], li = F.in[5][g * SP + p], step = expf(F.in[6][g]);
        const float mag = expf(lr * step), ar = mag * cosf(li * step), ai = mag * sinf(li * step);
        const float nr = ar - 1.f, ni = ai, den = lr * lr + li * li, cr = (nr * lr + ni * li) / den, ci = (ni * lr - nr * li) / den;
        float hr = 0.f, hi_ = 0.f;
        for (int tt = 0; tt <= t; ++tt) { float br = 0.f, bi = 0.f;
            for (int c = 0; c < 16; ++c) { const float u = bf2f(UP[(size_t)g * SROWS * SKY + ((size_t)b * 256 + (tt >> 5)) * SKY + (tt & 31) * 16 + c]);
                const float b_r = F.in[7][(g * SP + p) * 16 + c], b_i = F.in[8][(g * SP + p) * 16 + c]; br += (cr * b_r - ci * b_i) * u; bi += (cr * b_i + ci * b_r) * u; }
            const float n_r = ar * hr - ai * hi_ + br, n_i = ar * hi_ + ai * hr + bi; hr = n_r; hi_ = n_i; }
        float e2 = 0.f, o2 = 0.f;
        for (int ho = 0; ho < 16; ++ho) { float y = wave_sum(hr * F.in[9][(g * 16 + ho) * SP + p] - hi_ * F.in[10][(g * 16 + ho) * SP + p]);
            const float u = bf2f(UP[(size_t)g * SROWS * SKY + ((size_t)b * 256 + (t >> 5)) * SKY + (t & 31) * 16 + ho]); y += F.in[11][g * 16 + ho] * u;
            const float ge = 0.5f * y * (1.f + tanhf(0.7978845608028654f * (y + 0.044715f * y * y * y)));
            const float gv = bf2f(GA[((size_t)b * SEQ + t) * DS + g * 16 + ho]); e2 += (ge - gv) * (ge - gv); o2 += ge * ge; }
        if (!(e2 <= tol_ssm * tol_ssm * o2 + 1e-6f)) bad = true;
      } }
    if (__ballot(bad) != 0ull && lane == 0) __hip_atomic_store((unsigned*)(F.ctl + CW_CHK), 1u, __ATOMIC_RELAXED, __HIP_MEMORY_SCOPE_AGENT);
}
#endif

#ifdef SELFCHECK
__device__ __forceinline__ void selfcheck_prep(Frame& F) {
    const int lane = lane_id(); const int gw = F.vcu * NWAVES + F.wave;
    const bf16_t* Kb = (const bf16_t*)(F.ws + WS_K); const bf16_t* Vb = (const bf16_t*)(F.ws + WS_V); const bf16_t* KF = (const bf16_t*)(F.ws + WS_KFRAG); const bf16_t* VF = (const bf16_t*)(F.ws + WS_VFRAG);
    const bf16_t* KM = (const bf16_t*)(F.ws + WS_KMEAN); const float* KN = (const float*)(F.ws + WS_KMEAN + 512 * 1024);
    bool bad = false;
    for (int sidx = 0; sidx < 64; ++sidx) {
        unsigned hsh = (unsigned)(gw * 64 + sidx + 12345) * 2654435761u; hsh ^= hsh >> 15; hsh *= 2246822519u; hsh ^= hsh >> 13;
        const int bh = (int)(hsh & 63u), key = (int)((hsh >> 6) & 8191u), b = bh >> 3, h = bh & 7, d = lane;
        const float k0 = bf2f(Kb[((size_t)b * SEQ + key) * DA + h * HD + d]), v0 = bf2f(Vb[((size_t)b * SEQ + key) * DA + h * HD + d]);
        if (kfrag_at(KF, bh, key, d) != k0 || vfrag_at(VF, bh, key, d) != v0) bad = true;
    }
    for (int sidx = 0; sidx < 2; ++sidx) {
        unsigned hsh = (unsigned)(gw * 2 + sidx + 999) * 2654435761u; hsh ^= hsh >> 15; hsh *= 2246822519u; hsh ^= hsh >> 13;
        const int item = (int)(hsh & 2047u), bh = item >> 5, n = item & 31, b = bh >> 3, h = bh & 7, d = lane; float sum = 0.f, mx = 0.f;
        for (int kl = 0; kl < 256; ++kl) { const float kv = bf2f(Kb[((size_t)b * SEQ + 256 * n + kl) * DA + h * HD + d]); sum += kv; mx = fmaxf(mx, wave_sum(kv * kv)); }
        const float mean = sum * (1.f / 256.f), got = bf2f(KM[(size_t)item * 64 + d]);
        if (fabsf(mean - got) > 0.01f * fabsf(mean) + 1e-3f) bad = true;
        if (fabsf(mx - KN[item]) > 1e-3f * mx) bad = true;
    }
    if (__ballot(bad) != 0ull && lane == 0) __hip_atomic_store((unsigned*)(F.ctl + CW_CHK), 1u, __ATOMIC_RELAXED, __HIP_MEMORY_SCOPE_AGENT);
}
#endif
#ifndef MK_N_LAUNCHES
#define MK_N_LAUNCHES 1
#endif
constexpr int NPHASE = 14;
struct Args { const float* in[27]; float* out; unsigned char* ws; int ph_lo, ph_hi; };
static_assert(sizeof(Args) == 27 * 8 + 8 + 8 + 8, "Args has no padding");

#ifndef STAG9
#define STAG9 0
#endif
#ifndef STAG8
#define STAG8 0
#endif
#ifndef DUP_MASK
#define DUP_MASK 0
#endif
#define PH_ARGS Frame& F, unsigned char* ws, LAS unsigned char* ring
__device__ __forceinline__ void ph1(PH_ARGS) {
    { pg8::Gemm g{(const bf16_t*)(ws + WS_H1), (const bf16_t*)(ws + WS_WIN), D, D, D}; pg8::StaticOrder S; S.init(T, DS, F.G, (int)blockIdx.x);
      EpiProj<0> E{ws, F.in[3], 0, 1.f};
      pg8::gemm_phase<EpiProj<0>, pg8::StaticOrder, true, false>(ring, g, S, E, nullptr, F.wave); }
    { pg8::Gemm g{(const bf16_t*)(ws + WS_H1F8), (const bf16_t*)(ws + WS_WINF8), D / 2, D / 2, D / 2}; pg8::StaticOrder S; S.init(T, DIN - DS, F.G, (int)blockIdx.x);
      EpiProj<1> E{ws, F.in[3], 2, 1.f / WF8_SCALE};
      pg8::gemm_phase<EpiProj<1>, pg8::StaticOrder, true, false, true>(ring, g, S, E, nullptr, F.wave); }
}
__device__ __forceinline__ void ph2(PH_ARGS) {
    { pg8::Gemm g{(const bf16_t*)(ws + WS_UP), (const bf16_t*)(ws + WS_SSMW), SKY, SKU, SKU}; pg8::GroupedOrder S; S.init(SG * 8, 1, 8, F.G, F.vcu);
      EpiSsmE E{(float*)(ws + WS_E)};
      pg8::gemm_phase<EpiSsmE, pg8::GroupedOrder, false, false>(ring, g, S, E, nullptr, F.wave); }
    VM_WAIT(); __syncthreads();
    ssm_scan_phase(F);
    kv_prep_phase(F);
}
__device__ __forceinline__ void ph4(PH_ARGS) {
    pg8::Gemm g{(const bf16_t*)(ws + WS_UP), (const bf16_t*)(ws + WS_SSMT), SKY, SKY, SKY}; pg8::GroupedOrder S; S.init(SG * 8, 2, 8, F.G, F.vcu);
    EpiSsmY E{(bf16_t*)(ws + WS_GACT)};
    pg8::gemm_phase<EpiSsmY, pg8::GroupedOrder, true, false>(ring, g, S, E, nullptr, F.wave);
}
__device__ __forceinline__ void ph5(PH_ARGS) {
    pg8::Gemm g{(const bf16_t*)(ws + WS_GACT), (const bf16_t*)(ws + WS_WGLU), DS, DS, DS}; pg8::StaticOrder S; S.init(T, DS, F.G, (int)blockIdx.x);
    EpiGlu E{(const bf16_t*)(ws + WS_GACT), (bf16_t*)(ws + WS_YSSM), F.in[13]};
    pg8::gemm_phase<EpiGlu, pg8::StaticOrder, true, false>(ring, g, S, E, nullptr, F.wave);
}
__device__ __forceinline__ void ph6(PH_ARGS) {
    { pg8::Gemm g{(const bf16_t*)(ws + WS_YATT), (const bf16_t*)(ws + WS_WUA), DA / 2, DA / 2, DA / 2}; pg8::StaticOrder S; S.init(T, D, F.G, (int)blockIdx.x);
      EpiUpA E{ws + WS_SGA, ws + WS_MA, MA_SCALE / WF8_SCALE};
      pg8::gemm_phase<EpiUpA, pg8::StaticOrder, true, false, true>(ring, g, S, E, nullptr, F.wave); }
    VM_WAIT(); __syncthreads();
    { pg8::Gemm g{(const bf16_t*)(ws + WS_YSSM), (const bf16_t*)(ws + WS_WUS), DS, DS, DS}; pg8::StaticOrder S; S.init(T, D, F.G, (int)blockIdx.x);
      EpiUpS E{(const bf16_t*)(ws + WS_SGS), ws + WS_MA, (bf16_t*)(ws + WS_MRG)};
      pg8::gemm_phase<EpiUpS, pg8::StaticOrder, true, false>(ring, g, S, E, nullptr, F.wave); }
}
__device__ __forceinline__ void ph7(PH_ARGS) {
    pg8::Gemm g{(const bf16_t*)(ws + WS_MRG), (const bf16_t*)(ws + WS_WOUT), D, D, D}; pg8::StaticOrder S; S.init(T, D, F.G, (int)blockIdx.x);
    EpiOut E{F.in[0], (bf16_t*)(ws + WS_X1), ws + WS_XGF8, (float*)(ws + WS_SSQ)};
    pg8::gemm_phase<EpiOut, pg8::StaticOrder, true, false>(ring, g, S, E, nullptr, F.wave);
}
__device__ __forceinline__ void ph8(PH_ARGS) {
    pg8::Gemm g{(const bf16_t*)(ws + WS_X1), (const bf16_t*)(ws + WS_WR), D, D, D}; pg8::GroupedOrder S; S.init(T / 256, 1, T / 256, F.G, F.vcu);
    EpiRouter E{(float*)(ws + WS_RLOG)};
    pg8::gemm_phase<EpiRouter, pg8::GroupedOrder, false, false>(ring, g, S, E, nullptr, F.wave);
}
__device__ __forceinline__ void ph10(PH_ARGS) {
    moe_tables(F);
    const LAS int* tst = (const LAS int*)(F.lds + MOE_TST_OFF);
    MoeOrder S{tst, tst[32] * 4, F.G, F.vcu};
    LAS unsigned* rowtab = (LAS unsigned*)(F.lds + ROWTAB_OFF);
    { const unsigned* rowtok = (const unsigned*)(ws + WS_ROWTOK); const unsigned* ecnt = (const unsigned*)(F.ctl + CW_ECNT); pg8::Unit u;
      for (int i = 0; i < ROWTAB_UNITS && S.next(i, u); ++i) { if (F.tid < 256) { const int pos = u.aux2 + F.tid; const unsigned tk = pos < (int)ecnt[u.aux] ? (rowtok[(size_t)u.aux * ROWCAP + pos] >> 1) : 0u; rowtab[i * 256 + F.tid] = tk * (unsigned)D; } } }
    __syncthreads();
    pg8::Gemm g{(const bf16_t*)(ws + WS_XGF8), (const bf16_t*)(ws + WS_W13), D / 2, D / 2, D / 2};
    EpiMoe1 E{ws + WS_HID, (const float*)(ws + WS_ROWRSTD), (const unsigned*)(F.ctl + CW_ECNT), 1.f / WF8_SCALE};
    pg8::gemm_phase<EpiMoe1, MoeOrder, true, true, true>(ring, g, S, E, rowtab, F.wave);
}
__device__ __forceinline__ void ph11(PH_ARGS) {
    moe_tables(F);
    const LAS int* tst = (const LAS int*)(F.lds + MOE_TST_OFF);
    MoeOrder S{tst, tst[32] * 4, F.G, F.vcu};
    pg8::Gemm g{(const bf16_t*)(ws + WS_HID), (const bf16_t*)(ws + WS_W2), DE / 2, DE / 2, DE / 2};
    EpiMoe2 E{ws + WS_Y0, (size_t)(WS_Y1 - WS_Y0), (const unsigned*)(ws + WS_ROWTOK), (const float*)(ws + WS_ROWCOEF), (const unsigned*)(F.ctl + CW_ECNT), YF8_SCALE / WF8_SCALE};
    pg8::gemm_phase<EpiMoe2, MoeOrder, true, false, true>(ring, g, S, E, nullptr, F.wave);
}

__global__ void __launch_bounds__(NTHR, 2) fwd_kernel(Args args) {
    extern __shared__ __attribute__((aligned(16))) unsigned char lds_raw[];
    Frame F;
    F.lds = (LAS unsigned char*)lds_raw;
    F.MISC = (volatile LAS unsigned*)(F.lds + MISC_OFF);
    F.wave = __builtin_amdgcn_readfirstlane((int)(threadIdx.x >> 6)); F.lane = lane_id(); F.tid = F.wave * 64 + F.lane;
    F.G = gridDim.x; { const int bx = blockIdx.x; F.vcu = (F.G % 8 == 0) ? (bx % 8) * (F.G / 8) + bx / 8 : bx; }
    F.ws = args.ws; F.ctl = (gu32*)(args.ws + WS_CTL); F.out = args.out;
#pragma unroll
    for (int i = 0; i < 27; ++i) F.in[i] = args.in[i];
    for (int u = F.tid; u < (LDS_BYTES - MOE_TST_OFF) / 4; u += NTHR) ((LAS unsigned*)(F.lds + MOE_TST_OFF))[u] = 0u;
    __syncthreads();
    XcdBarrier bar; bar.bar = (unsigned*)(F.ctl + CW_BAR); bar.x = 0; bar.st = nullptr;
    const int lo = args.ph_lo, hi = args.ph_hi;
    if (hi - lo > 1) bar = xcd_barrier_post((unsigned*)(F.ctl + CW_BAR), F.MISC + 8, F.tid == 0);
#define IN(k) (lo <= (k) && (k) < hi)
#define DUP(k) ((DUP_MASK >> (k)) & 1)
#define SEAM(k) do { if (IN(k) && IN((k) + 1)) xcd_barrier(bar, F.wave == 0 && lane_id() == 0); REFRESH(); } while (0)
#define REFRESH() do { int l_ = lane_id(); asm volatile("" : "+v"(l_)); F.lane = l_; F.tid = F.wave * 64 + l_; } while (0)
    unsigned char* ws = args.ws;
    LAS unsigned char* ring = F.lds;
    if (IN(0)) { p0_prologue(F); if (DUP(0)) p0_prologue(F); }
    SEAM(0);
    if (IN(1)) { ph1(F, ws, ring); if (DUP(1)) ph1(F, ws, ring); }
    SEAM(1);
    if (IN(2)) { ph2(F, ws, ring); if (DUP(2)) ph2(F, ws, ring); }
    SEAM(2);
#ifdef SELFCHECK_PREP
    if (IN(3)) { selfcheck_prep(F); }
#endif
    if (IN(3)) { attn_gate_phase<true>(F); }
    SEAM(3);
    if (IN(4)) { attn_block_phase(F); if (DUP(4)) { __syncthreads(); attn_block_phase(F); } }
    SEAM(4);
    if (IN(5)) { attn_own_phase(F); if (DUP(5)) attn_own_phase(F); }
    SEAM(5);
    if (IN(6)) { ph4(F, ws, ring); if (DUP(6)) ph4(F, ws, ring); }
#ifdef SELFCHECK
    if (IN(6)) { xcd_barrier(bar, F.wave == 0 && lane_id() == 0); REFRESH(); selfcheck_phase(F, SELFCHECK_TOL_ATTN, SELFCHECK_TOL_SSM); }
#endif
    SEAM(6);
    if (IN(7)) { ph5(F, ws, ring); if (DUP(7)) ph5(F, ws, ring); }
    SEAM(7);
    if (IN(8)) { if (STAG8 > 0 && (F.vcu & 1)) { const unsigned long long t0_ = __builtin_amdgcn_s_memrealtime(); while ((long long)(__builtin_amdgcn_s_memrealtime() - t0_) < (long long)STAG8) __builtin_amdgcn_s_sleep(16); }
                 ph6(F, ws, ring); if (DUP(8)) ph6(F, ws, ring); }
    SEAM(8);
    if (IN(9)) { if (STAG9 > 0 && (F.vcu & 1)) { const unsigned long long t0_ = __builtin_amdgcn_s_memrealtime(); while ((long long)(__builtin_amdgcn_s_memrealtime() - t0_) < (long long)STAG9) __builtin_amdgcn_s_sleep(16); }
                 ph7(F, ws, ring); if (DUP(9)) ph7(F, ws, ring); }
    SEAM(9);
    if (IN(10)) { ph8(F, ws, ring); VM_WAIT(); __syncthreads(); routing_phase(F); }
    SEAM(10);
    if (IN(11)) { ph10(F, ws, ring); if (DUP(11)) ph10(F, ws, ring); }
    SEAM(11);
    if (IN(12)) { ph11(F, ws, ring); if (DUP(12)) ph11(F, ws, ring); }
    SEAM(12);
    if (IN(13)) { final_phase(F); if (DUP(13)) final_phase(F); }
#undef IN
#undef DUP
#undef SEAM
#undef REFRESH
}

extern "C" void kernel_launch(void* const* d_in, const int* in_sizes, int n_in, void* d_out, int out_size, void* d_ws, size_t ws_size, hipStream_t stream) {
    static int grid = 0;
    if (grid == 0) {
        if (n_in != 27 || in_sizes[0] != T * D || out_size != T * D || ws_size < WS_END) { fprintf(stderr, "kernel_launch: unexpected shapes (n_in %d, in0 %d, out %d, ws %zu)\n", n_in, n_in > 0 ? in_sizes[0] : -1, out_size, ws_size); grid = -1; return; }
        int dev = 0, cus = 0;
        if (hipGetDevice(&dev) != hipSuccess || hipDeviceGetAttribute(&cus, hipDeviceAttributeMultiprocessorCount, dev) != hipSuccess) { grid = -1; return; }
        if (hipFuncSetAttribute((const void*)fwd_kernel, hipFuncAttributeMaxDynamicSharedMemorySize, LDS_BYTES) != hipSuccess) { fprintf(stderr, "kernel_launch: hipFuncSetAttribute failed\n"); grid = -1; return; }
        (void)hipGetLastError();
        grid = cus;
    }
    if (grid < 0) return;
    (void)hipMemsetAsync((char*)d_ws + WS_CTL, 0, CTL_ZERO_BYTES, stream);
    Args a{};
    for (int i = 0; i < 27; ++i) a.in[i] = (const float*)d_in[i];
    a.out = (float*)d_out; a.ws = (unsigned char*)d_ws;
    if (MK_N_LAUNCHES == 1) { a.ph_lo = 0; a.ph_hi = NPHASE; hipLaunchKernelGGL(fwd_kernel, dim3(grid), dim3(NTHR), LDS_BYTES, stream, a); }
    else { for (int p = 0; p < NPHASE; ++p) { a.ph_lo = p; a.ph_hi = p + 1; hipLaunchKernelGGL(fwd_kernel, dim3(grid), dim3(NTHR), LDS_BYTES, stream, a); } }
}
```

```cpp
#include <hip/hip_runtime.h>
#include <cstdio>
#include <cstdint>

#define LAS __attribute__((address_space(3)))
#define GAS __attribute__((address_space(1)))
typedef unsigned short bf16_t;
typedef short bf16x8 __attribute__((ext_vector_type(8)));
typedef float f32x2 __attribute__((ext_vector_type(2)));
typedef float f32x4 __attribute__((ext_vector_type(4)));
typedef float f32x16 __attribute__((ext_vector_type(16)));
typedef unsigned u32x2 __attribute__((ext_vector_type(2)));
typedef unsigned u32x4 __attribute__((ext_vector_type(4)));
typedef GAS unsigned gu32;
typedef int v4i32 __attribute__((ext_vector_type(4)));
typedef int v8i32 __attribute__((ext_vector_type(8)));
#define RLX_AGENT __ATOMIC_RELAXED, __HIP_MEMORY_SCOPE_AGENT
#define LDS_WAIT() asm volatile("s_waitcnt lgkmcnt(0)" ::: "memory")
#define VM_WAIT() asm volatile("s_waitcnt vmcnt(0)" ::: "memory")

__device__ __forceinline__ unsigned f2bf(float f) { unsigned u = __builtin_bit_cast(unsigned, f); return (u + 0x7fffu + ((u >> 16) & 1u)) >> 16; }
__device__ __forceinline__ unsigned pk2(float lo, float hi) { return f2bf(lo) | (f2bf(hi) << 16); }
__device__ __forceinline__ float bf2f(unsigned short b) { return __builtin_bit_cast(float, (unsigned)b << 16); }
__device__ __forceinline__ float bflo(unsigned w) { return __builtin_bit_cast(float, w << 16); }
__device__ __forceinline__ float bfhi(unsigned w) { return __builtin_bit_cast(float, w & 0xffff0000u); }
__device__ __forceinline__ unsigned cvt_pk_bf16(float lo, float hi) { unsigned r; asm volatile("v_cvt_pk_bf16_f32 %0, %1, %2" : "=v"(r) : "v"(lo), "v"(hi)); return r; }
__device__ __forceinline__ float fast_sigmoid(float x) { return __builtin_amdgcn_rcpf(1.f + __builtin_amdgcn_exp2f(-1.4426950408889634f * x)); }
__device__ __forceinline__ int lane_id() { int l; asm volatile("v_mbcnt_lo_u32_b32 %0, -1, 0\n\tv_mbcnt_hi_u32_b32 %0, -1, %0" : "=v"(l)); return l; }
__device__ __forceinline__ float wave_sum(float v) {
#pragma unroll
    for (int o = 1; o < 64; o <<= 1) v += __shfl_xor(v, o);
    return v;
}
__device__ __forceinline__ float wave_max(float v) {
#pragma unroll
    for (int o = 1; o < 64; o <<= 1) v = fmaxf(v, __shfl_xor(v, o));
    return v;
}

#define XB_TMO      128
#define XB_XCNT(j)  (256  + 64 * (j))
#define XB_XSUB(j)  (1280 + 64 * (j))
#define XB_XGEN(j)  (2304 + 64 * (j))
#define XB_TOP      3328
#define XB_TOPGEN   3392
#define XCD_BAR_WORDS 3456
#define XB_SPIN_CAP (1u << 20)

__device__ __forceinline__ unsigned xb_ld(unsigned* p)              { return __hip_atomic_load(p, __ATOMIC_RELAXED, __HIP_MEMORY_SCOPE_AGENT); }
__device__ __forceinline__ unsigned xb_add(unsigned* p, unsigned v) { return __hip_atomic_fetch_add(p, v, __ATOMIC_RELAXED, __HIP_MEMORY_SCOPE_AGENT); }
__device__ __forceinline__ unsigned xb_xcc_id() { return (unsigned)__builtin_amdgcn_s_getreg((3 << 11) | 20) & 0xFu; }
#define XB_SPIN(cond, bar) do { unsigned _sp = 0; while (cond) { __builtin_amdgcn_s_sleep(1); \
    if ((++_sp & 255u) == 0u) { if (xb_ld(&(bar)[XB_TMO])) break; if (_sp > XB_SPIN_CAP) { atomicAdd(&(bar)[XB_TMO], 1u); break; } } } } while (0)

struct XcdBarrier { unsigned* bar; unsigned x; volatile LAS unsigned* st; };

__device__ __forceinline__ XcdBarrier xcd_barrier_post(unsigned* bar, volatile LAS unsigned* st, bool leader  ) {
    XcdBarrier b; b.bar = bar; b.x = xb_xcc_id(); b.st = st;
    if (leader) (void)xb_add(&bar[XB_XCNT(b.x)], 1u);
    return b;
}
__device__ __forceinline__ void xcd_barrier_complete(unsigned* bar, unsigned x, unsigned& nloc, unsigned& nx) {
    const unsigned G = gridDim.x * gridDim.y * gridDim.z;
    unsigned sum, cnt, mine, sp = 0u;
    for (;;) {
        sum = 0u; cnt = 0u; mine = 0u;
#pragma unroll
        for (unsigned j = 0; j < 16; ++j) { const unsigned c = xb_ld(&bar[XB_XCNT(j)]); sum += c; cnt += (c > 0u) ? 1u : 0u; mine = (j == x) ? c : mine; }
        if (sum == G) break;
        __builtin_amdgcn_s_sleep(1);
        if ((++sp & 255u) == 0u) { if (xb_ld(&bar[XB_TMO])) break; if (sp > XB_SPIN_CAP) { atomicAdd(&bar[XB_TMO], 1u); break; } }
    }
    nloc = mine > 0u ? mine : 1u; nx = cnt > 0u ? cnt : 1u;
}
__device__ __forceinline__ void xcd_barrier(const XcdBarrier& b, bool leader  ) {
    asm volatile("s_waitcnt vmcnt(0)" ::: "memory");
    __syncthreads();
    if (leader) {
        unsigned* bar = b.bar;
        __builtin_amdgcn_s_waitcnt(0);
        unsigned nloc = b.st[0], nx = b.st[1];
        if (nloc == 0u) { xcd_barrier_complete(bar, b.x, nloc, nx); b.st[0] = nloc; b.st[1] = nx; }
        const unsigned old = xb_add(&bar[XB_XSUB(b.x)], 1u);
        const unsigned gen = old / nloc;
        if (old + 1u == (gen + 1u) * nloc) {
            __builtin_amdgcn_fence(__ATOMIC_RELEASE, "agent");
            asm volatile("s_waitcnt vmcnt(0)" ::: "memory");
            const unsigned og = xb_add(&bar[XB_TOP], 1u);
            const unsigned tg = og / nx;
            if (og + 1u == (tg + 1u) * nx) xb_add(&bar[XB_TOPGEN], 1u);
            else XB_SPIN(xb_ld(&bar[XB_TOPGEN]) == tg, bar);
            __builtin_amdgcn_fence(__ATOMIC_ACQUIRE, "agent");
            xb_add(&bar[XB_XGEN(b.x)], 1u);
            asm volatile("s_waitcnt vmcnt(0)" ::: "memory");
        } else {
            XB_SPIN(xb_ld(&bar[XB_XGEN(b.x)]) == gen, bar);
            __builtin_amdgcn_fence(__ATOMIC_ACQUIRE, "agent");
            asm volatile("s_waitcnt vmcnt(0)" ::: "memory");
        }
    }
    __syncthreads();
}

#ifndef STG_MMA
#define STG_MMA 0
#endif
#ifndef PG8_ASM_DMA
#define PG8_ASM_DMA 0
#endif
namespace pg8 {
constexpr int BM = 256, BK = 64, HALF = 128, HTB = HALF * BK * 2, STAGE_BYTES = 8 * HTB, NXCD = 8, WGM = 8;
#ifndef LINE_PIECES
#define LINE_PIECES 1
#endif
#if LINE_PIECES
__host__ __device__ __forceinline__ int lds_byte(int r, int c) { const int s = (r >> 1) & 7; return (r >> 3) * 1024 + (r & 7) * 128 + ((((c >> 3) ^ s) & 7) << 4) + (c & 7) * 2; }
__host__ __device__ __forceinline__ void stage_rc(int b, int& R, int& C) { const int blk = b / 1024, wi = b % 1024, ri = wi >> 7, pos = wi & 127; R = blk * 8 + ri; const int s = (R >> 1) & 7; C = (((pos >> 4) ^ s) & 7) * 8 + (pos & 15) / 2; }
#else
__host__ __device__ __forceinline__ int lds_byte(int r, int c) { const int st = (r >> 4) * 2 + (c >> 5), rr = r & 15, cc = c & 31, ob = rr * 64 + cc * 2; return st * 1024 + (ob ^ (((ob >> 9) & 1) << 5)); }
__host__ __device__ __forceinline__ void stage_rc(int b, int& R, int& C) { const int st = b / 1024, sb = b % 1024, swz = sb ^ (((sb >> 9) & 1) << 5); R = (st >> 1) * 16 + swz / 64; C = (st & 1) * 32 + (swz % 64) / 2; }
#endif
__host__ __device__ __forceinline__ int perm32(int rho) { const int n = rho >> 4, i = rho & 15; return 8 * (i >> 2) + 4 * n + (i & 3); }

struct Unit { int pm, pn, pb, aux, aux2, aux3; };
struct Gemm { const bf16_t* A; const bf16_t* Bt; int lda, ldb, K; };

struct StaticOrder {
    int nM, nN, nwg, G, c, blk;
    __device__ void init(int M, int N, int G_, int c_, bool blocked = false) { nM = M / BM; nN = N / BM; nwg = nM * nN; G = G_; c = c_; blk = blocked ? nwg / G_ : 0; }
    __device__ bool next(int i, Unit& u) const {
        if (blk > 0) { if (i >= blk) return false; const int Lb = c * blk + i; u.pm = Lb / nN; u.pn = Lb % nN; u.pb = u.pn; u.aux = 0; u.aux2 = 0; u.aux3 = 0; return true; }
        const long L = (long)i * G + c; if (L >= nwg) return false;
        int wgid = (int)L; { const int q = nwg / NXCD, r = nwg % NXCD, xcd = wgid % NXCD, off = wgid / NXCD; wgid = (xcd < r ? xcd * (q + 1) : r * (q + 1) + (xcd - r) * q) + off; }
        const int nig = WGM * nN, gid = wgid / nig, fm = gid * WGM, gsz = (nM - fm) < WGM ? (nM - fm) : WGM;
        u.pm = fm + ((wgid % nig) % gsz); u.pn = (wgid % nig) / gsz; u.pb = u.pn; u.aux = 0; u.aux2 = 0; u.aux3 = 0; return true;
    }
};
struct GroupedOrder {
    int nM, nN, rtpg, G, v;
    __device__ void init(int nM_, int nN_, int rtpg_, int G_, int v_) { nM = nM_; nN = nN_; rtpg = rtpg_; G = G_; v = v_; }
    __device__ bool next(int i, Unit& u) const {
        const int L = i * G + v; if (L >= nM * nN) return false;
        u.pm = L / nN; u.pn = (L + i) % nN  ; u.aux = u.pm / rtpg; u.pb = u.aux * nN + u.pn; u.aux2 = 0; u.aux3 = 0; return true;
    }
};

template <class Epi, class Sched, bool ALIGN_EPI, bool GATHER, bool FP8 = false, bool HALFN = false  , int PID = 0  , bool KSKIP = false  >
__device__ __forceinline__ void gemm_phase(LAS unsigned char* lds, const Gemm g, const Sched& S, const Epi& E, const LAS unsigned* rowtab  , int wid  , unsigned* probe = nullptr) {
#ifdef PROBE_GEMM
    unsigned pg_te_ = 0u, pg_tw_ = 0u; const unsigned pg_t0_ = (unsigned)__builtin_amdgcn_s_memtime();
#endif
    const int lane = lane_id(), tid = wid * 64 + lane, wr = wid >> 2, wc = wid & 3;
    const int K = g.K, nt = K / BK;
    unsigned voffB[2];
#pragma unroll
    for (int i = 0; i < 2; ++i) { int R, C; stage_rc(tid * 16 + i * 8192, R, C); const int Rb = (R & ~31) + perm32(R & 31);
        voffB[i] = (unsigned)(Rb * g.ldb + C) * 2u; }
    const size_t kstep = (size_t)(BK * 2);
    const size_t hstepB = (size_t)HALF * g.ldb * 2, tstepB = 2 * hstepB;
    const size_t tstepA = (size_t)BM * g.lda * 2;
    const unsigned ldsw = (unsigned)wid * 1024u;
    int aoff = lds_byte(wr * 64 + (lane & 15), (lane >> 4) * 8), boff = lds_byte(wc * 32 + (lane & 15), (lane >> 4) * 8);
    unsigned vAc[2][2];
#define PG8_SETVA(dst, ui_) do { const int t_ = wid * 64 + lane_id(); _Pragma("unroll") for (int i_ = 0; i_ < 2; ++i_) { int R_, C_; stage_rc(t_ * 16 + i_ * 8192, R_, C_); \
        _Pragma("unroll") for (int h_ = 0; h_ < 2; ++h_) dst[h_][i_] = (GATHER ? rowtab[(ui_) * 256 + h_ * 128 + R_] : (unsigned)((h_ * 128 + R_) * g.lda) * 2u) + (unsigned)C_ * 2u; } } while (0)
#define PG8_SA(b, h) (((b) * 2 + (h)) * HTB)
#define PG8_SB(b, h) ((4 + (b) * 2 + (h)) * HTB)
#define PG8_GLDS_S(gbase_, voff_, ldsaddr_) do { unsigned keep_; asm volatile("s_mov_b32 %0, m0\n\ts_mov_b32 m0, %3\n\ts_nop 0\n\tglobal_load_lds_dwordx4 %1, %2\n\ts_mov_b32 m0, %0" \
        : "=&s"(keep_) : "v"(voff_), "s"(gbase_), "s"(ldsaddr_) : "memory"); } while (0)
#define PG8_STAGE(bufoff, gbase, v0, v1) do { \
        if constexpr (FP8 || PG8_ASM_DMA) { const unsigned la_ = (unsigned)(uintptr_t)(lds + (bufoff) + ldsw); PG8_GLDS_S((const char*)(gbase), (v0), la_); PG8_GLDS_S((const char*)(gbase), (v1), la_ + 8192u); } else { \
        __builtin_amdgcn_global_load_lds((const unsigned*)((const char*)(gbase) + (v0)), (LAS unsigned*)(lds + (bufoff) + ldsw), 16, 0, 0); \
        __builtin_amdgcn_global_load_lds((const unsigned*)((const char*)(gbase) + (v1)), (LAS unsigned*)(lds + (bufoff) + ldsw + 8192), 16, 0, 0); } } while (0)
#define PG8_STB(bufoff, gbase) PG8_STAGE(bufoff, gbase, voffB[0], voffB[1])
#if LINE_PIECES
#define PG8_KTOG(v_) asm volatile("v_xor_b32 %0, 64, %0" : "+v"(v_))
#define PG8_LDA(dst, b, h) do { _Pragma("unroll") for (int m = 0; m < 4; ++m) dst[m][0] = *(const LAS bf16x8*)(lds + PG8_SA(b, h) + aoff + m * 2048); PG8_KTOG(aoff); \
        _Pragma("unroll") for (int m = 0; m < 4; ++m) dst[m][1] = *(const LAS bf16x8*)(lds + PG8_SA(b, h) + aoff + m * 2048); PG8_KTOG(aoff); } while (0)
#define PG8_LDB(dst, b, h) do { _Pragma("unroll") for (int n = 0; n < 2; ++n) dst[n][0] = *(const LAS bf16x8*)(lds + PG8_SB(b, h) + boff + n * 2048); PG8_KTOG(boff); \
        _Pragma("unroll") for (int n = 0; n < 2; ++n) dst[n][1] = *(const LAS bf16x8*)(lds + PG8_SB(b, h) + boff + n * 2048); PG8_KTOG(boff); } while (0)
#else
#define PG8_LDA(dst, b, h) do { _Pragma("unroll") for (int m = 0; m < 4; ++m) _Pragma("unroll") for (int k = 0; k < 2; ++k) dst[m][k] = *(const LAS bf16x8*)(lds + PG8_SA(b, h) + aoff + m * 2048 + k * 1024); } while (0)
#define PG8_LDB(dst, b, h) do { _Pragma("unroll") for (int n = 0; n < 2; ++n) _Pragma("unroll") for (int k = 0; k < 2; ++k) dst[n][k] = *(const LAS bf16x8*)(lds + PG8_SB(b, h) + boff + n * 2048 + k * 1024); } while (0)
#endif
#define PG8_MMA(ai, bj, At, Bt) do { __builtin_amdgcn_s_setprio(1); \
        if constexpr (FP8) { _Pragma("unroll") for (int m = 0; m < 4; ++m) _Pragma("unroll") for (int n = 0; n < 2; ++n) { \
            const v8i32 a8_ = __builtin_shufflevector(__builtin_bit_cast(v4i32, At[m][0]), __builtin_bit_cast(v4i32, At[m][1]), 0, 1, 2, 3, 4, 5, 6, 7); \
            const v8i32 b8_ = __builtin_shufflevector(__builtin_bit_cast(v4i32, Bt[n][0]), __builtin_bit_cast(v4i32, Bt[n][1]), 0, 1, 2, 3, 4, 5, 6, 7); \
            acc[ai][bj][m][n] = __builtin_amdgcn_mfma_scale_f32_16x16x128_f8f6f4(b8_, a8_, acc[ai][bj][m][n], 0, 0, 0, 0, 0, 0); } } \
        else { _Pragma("unroll") for (int m = 0; m < 4; ++m) _Pragma("unroll") for (int n = 0; n < 2; ++n) _Pragma("unroll") for (int k = 0; k < 2; ++k) \
            acc[ai][bj][m][n] = __builtin_amdgcn_mfma_f32_16x16x32_bf16(Bt[n][k], At[m][k], acc[ai][bj][m][n], 0, 0, 0); } \
        __builtin_amdgcn_s_setprio(0); } while (0)
#ifdef PROBE_GEMM
#define PGT(mode_, stmt_) do { if (PID == PROBE_GEMM_PID && PROBE_GEMM == (mode_)) { const unsigned q0_ = (unsigned)__builtin_amdgcn_s_memtime(); stmt_; pg_tw_ += (unsigned)__builtin_amdgcn_s_memtime() - q0_; } else { stmt_; } } while (0)
#define PG8_WAIT_V(n) PGT(3, asm volatile("s_waitcnt vmcnt(" #n ")" ::: "memory"))
#else
#define PG8_WAIT_V(n) asm volatile("s_waitcnt vmcnt(" #n ")" ::: "memory")
#define PGT(mode_, stmt_) do { stmt_; } while (0)
#endif
#define PG8_WAIT_L(n) asm volatile("s_waitcnt lgkmcnt(" #n ")" ::: "memory")
#define PG8_BAR __builtin_amdgcn_s_barrier()
#define PG8_SCHED __builtin_amdgcn_sched_barrier(0)
#define PG8_SCHED8 do { if constexpr (FP8) __builtin_amdgcn_sched_barrier(0); } while (0)
    Unit cur, nxt; int ui = 0;
#define PG8_UNI(u_) do { u_.pm = __builtin_amdgcn_readfirstlane(u_.pm); u_.pn = __builtin_amdgcn_readfirstlane(u_.pn); u_.pb = __builtin_amdgcn_readfirstlane(u_.pb); u_.aux = __builtin_amdgcn_readfirstlane(u_.aux); u_.aux2 = __builtin_amdgcn_readfirstlane(u_.aux2); u_.aux3 = __builtin_amdgcn_readfirstlane(u_.aux3); asm volatile("" : "+s"(u_.pm), "+s"(u_.pn), "+s"(u_.pb), "+s"(u_.aux), "+s"(u_.aux2), "+s"(u_.aux3)); } while (0)
    if (!S.next(0, cur)) return;
    PG8_UNI(cur);
    f32x4 acc[2][2][4][2];
#pragma unroll
    for (int a = 0; a < 2; ++a)
#pragma unroll
        for (int b = 0; b < 2; ++b)
#pragma unroll
            for (int m = 0; m < 4; ++m)
#pragma unroll
                for (int n = 0; n < 2; ++n) acc[a][b][m][n] = (f32x4){0.f, 0.f, 0.f, 0.f};
    bf16x8 At[4][2], B0[2][2], B1[2][2];
    const char* cA = (const char*)g.A + (GATHER ? (size_t)0 : (size_t)cur.pm * tstepA); const char* cB = (const char*)g.Bt + (size_t)cur.pb * tstepB;
    PG8_SETVA(vAc, 0);
    PG8_STB(PG8_SB(0, 0), cB); if constexpr (!HALFN) PG8_STB(PG8_SB(0, 1), cB + hstepB); PG8_STAGE(PG8_SA(0, 0), cA, vAc[0][0], vAc[0][1]); PG8_STAGE(PG8_SA(0, 1), cA, vAc[1][0], vAc[1][1]);
    if (wr == 1) PG8_BAR;
    PG8_WAIT_V(2); PG8_BAR;
    PG8_STB(PG8_SB(1, 0), cB + kstep); PG8_STAGE(PG8_SA(1, 0), cA + kstep, vAc[0][0], vAc[0][1]); if constexpr (!HALFN) PG8_STB(PG8_SB(1, 1), cB + hstepB + kstep);
    if constexpr (HALFN) PG8_WAIT_V(4); else PG8_WAIT_V(6);
    PG8_BAR;
    for (;;) {
        const bool has_next = S.next(ui + 1, nxt);
        PG8_UNI(nxt);
        const char* nA = GATHER ? cA : (has_next ? (const char*)g.A + (size_t)nxt.pm * tstepA : cA); const char* nB = has_next ? (const char*)g.Bt + (size_t)nxt.pb * tstepB : cB;
        const int nui = has_next ? ui + 1 : ui;
        const bool kskip = KSKIP && cur.pn == 0; const int ntu = kskip ? nt - 4 : nt;
#pragma nounroll
        for (int t = 0; t < ntu; t += 2) {
            const bool last = (t == ntu - 2);
            const int tk1 = (kskip && t >= 4) ? t + 5 : t + 1, tk2 = (kskip && t + 2 >= 4) ? t + 6 : t + 2;
            const char* a1 = cA + (size_t)tk1 * kstep;
            const char* a2 = last ? nA : cA + (size_t)tk2 * kstep; const char* b2 = last ? nB : cB + (size_t)tk2 * kstep;
            const char* a3 = a2 + kstep; const char* b3 = b2 + kstep;
            unsigned x00 = vAc[0][0], x01 = vAc[0][1], x10 = vAc[1][0], x11 = vAc[1][1];
            if (GATHER) { if (last) { unsigned vN_[2][2]; PG8_SETVA(vN_, nui); x00 = vN_[0][0]; x01 = vN_[0][1]; x10 = vN_[1][0]; x11 = vN_[1][1]; } }
#define PG8_MID(stmt_) do { PG8_SCHED; stmt_; PG8_SCHED; } while (0)
#define PG8_SPB0(ai_) do { if constexpr (HALFN) { PG8_SPB(6, ai_, (void)0); } else { PG8_SPB(8, ai_, (void)0); } } while (0)
#define PG8_SPB(wn_, ai_, mid_) PG8_WAIT_V(wn_); PGT(4, PG8_WAIT_L(0)); PGT(5, PG8_BAR); PG8_SCHED8; PGT(6, PG8_MMA(ai_, 0, At, B0); mid_; if constexpr (!HALFN) PG8_MMA(ai_, 1, At, B1)); PG8_SCHED8; PGT(7, PG8_BAR); PG8_SCHED
            PG8_LDB(B0, 0, 0); if constexpr (!HALFN) PG8_LDB(B1, 0, 1); PG8_SCHED; PG8_LDA(At, 0, 0);
#if STG_MMA >= 2
            PG8_SPB(6, 0, PG8_MID(PG8_STAGE(PG8_SA(1, 1), a1, vAc[1][0], vAc[1][1])));
#else
            PG8_STAGE(PG8_SA(1, 1), a1, vAc[1][0], vAc[1][1]); PG8_SPB0(0);
#endif
            PG8_LDA(At, 0, 1); PG8_STB(PG8_SB(0, 0), b2); if constexpr (!HALFN) PG8_STB(PG8_SB(0, 1), b2 + hstepB);
#if STG_MMA >= 1
            PG8_SPB(6, 1, PG8_MID(PG8_STAGE(PG8_SA(0, 0), a2, x00, x01)));
#else
            PG8_STAGE(PG8_SA(0, 0), a2, x00, x01); PG8_SPB0(1);
#endif
            PG8_LDB(B0, 1, 0); if constexpr (!HALFN) PG8_LDB(B1, 1, 1); PG8_SCHED; PG8_LDA(At, 1, 0);
#if STG_MMA >= 2
            PG8_SPB(6, 0, PG8_MID(PG8_STAGE(PG8_SA(0, 1), a2, x10, x11)));
#else
            PG8_STAGE(PG8_SA(0, 1), a2, x10, x11); PG8_SPB0(0);
#endif
            PG8_LDA(At, 1, 1); PG8_STB(PG8_SB(1, 0), b3); if constexpr (!HALFN) PG8_STB(PG8_SB(1, 1), b3 + hstepB);
#if STG_MMA >= 1
            PG8_SPB(6, 1, PG8_MID(PG8_STAGE(PG8_SA(1, 0), a3, x00, x01)));
#else
            PG8_STAGE(PG8_SA(1, 0), a3, x00, x01); PG8_SPB0(1);
#endif
        }
        if constexpr (ALIGN_EPI) { if (wr == 0) PG8_BAR; }
#ifdef PROBE_GEMM
        const unsigned pg_e0_ = (unsigned)__builtin_amdgcn_s_memtime();
#endif
        { int l_ = lane_id(); asm volatile("" : "+v"(l_));
          E(acc, cur, wr, wc, l_ & 15, l_ >> 4); }
#ifdef PROBE_GEMM
        if (PID == PROBE_GEMM_PID) pg_te_ += (unsigned)__builtin_amdgcn_s_memtime() - pg_e0_;
#endif
        if (!has_next) break;
#pragma unroll
        for (int a = 0; a < 2; ++a)
#pragma unroll
            for (int b = 0; b < 2; ++b)
#pragma unroll
                for (int m = 0; m < 4; ++m)
#pragma unroll
                    for (int n = 0; n < 2; ++n) acc[a][b][m][n] = (f32x4){0.f, 0.f, 0.f, 0.f};
        cur = nxt; cA = nA; cB = nB; ++ui;
        if (GATHER) { PG8_SETVA(vAc, ui); }
        if constexpr (ALIGN_EPI) { if (wr == 1) PG8_BAR; }
    }
    PG8_WAIT_V(0);
    if constexpr (!ALIGN_EPI) { if (wr == 0) PG8_BAR; }
    PG8_BAR;
#ifdef PROBE_GEMM
    if (PID == PROBE_GEMM_PID && probe && wid == PROBE_GEMM_WAVE && lane_id() == 0) { __hip_atomic_fetch_add(probe + 3, (PROBE_GEMM == 1 ? pg_te_ : pg_tw_) >> 8, __ATOMIC_RELAXED, __HIP_MEMORY_SCOPE_AGENT); __hip_atomic_fetch_add(probe + 4, ((unsigned)__builtin_amdgcn_s_memtime() - pg_t0_) >> 8, __ATOMIC_RELAXED, __HIP_MEMORY_SCOPE_AGENT); }
#endif
#undef PG8_SETVA
#undef PG8_UNI
#undef PG8_SA
#undef PG8_SB
#undef PG8_STAGE
#undef PG8_GLDS_S
#undef PG8_STB
#undef PG8_LDA
#undef PG8_LDB
#undef PG8_MMA
#undef PG8_WAIT_V
#undef PG8_WAIT_L
#undef PG8_BAR
#undef PG8_SCHED
#undef PG8_SCHED8
}
}
constexpr int NWAVES = 8, NTHR = 512;
constexpr int BATCH = 8, SEQ = 8192, T = BATCH * SEQ, D = 1024, DIN = 4096;
constexpr int DS = 512, DA = 512, NH = 8, HD = 64, NBLK = SEQ / 256;
constexpr int SG = 32, SHC = 16, SP = 64, SL = 32, SKU = SL * SHC  , SKS = 2 * SP  , SKY = SKU + SKS  , SROWS = T / SL  ;
constexpr int NE = 32, DE = 512;
constexpr float RMS_EPS = 1e-6f;
constexpr float LOG2E = 1.4426950408889634f;
constexpr float QSCALE = 0.125f * LOG2E;
constexpr float WF8_SCALE = 32.f;
constexpr float YF8_SCALE = 16.f;
constexpr float MA_SCALE = 64.f;
constexpr int ROWCAP = T;
constexpr int HID_ROWS = 2 * T + NE * 256;

constexpr size_t MiB = 1u << 20;
constexpr size_t WS_CTL = 0, CTL_ZERO_BYTES = 1 * MiB;
constexpr size_t WS_WIN = 1 * MiB;
constexpr size_t WS_WGLU = 9 * MiB;
constexpr size_t WS_WUS = 10 * MiB;
constexpr size_t WS_WUA = 11 * MiB;
constexpr size_t WS_WOUT = 12 * MiB;
constexpr size_t WS_WR = 14 * MiB;
constexpr size_t WS_KMEAN = 15 * MiB;
constexpr size_t WS_SSMW = 16 * MiB;
constexpr size_t WS_SSMT = 24 * MiB;
constexpr size_t WS_W13 = 44 * MiB;
constexpr size_t WS_W2 = 108 * MiB;
constexpr size_t WS_A0 = 140 * MiB;
constexpr size_t WS_UP = 276 * MiB;
constexpr size_t WS_Q = 356 * MiB;
constexpr size_t WS_SSQ = 404 * MiB;
constexpr size_t WS_RLOG = 408 * MiB;
constexpr size_t WS_K = 420 * MiB;
constexpr size_t WS_ROWTOK = 428 * MiB, WS_ROWCOEF = 436 * MiB, WS_ROWRSTD = 444 * MiB;
constexpr size_t WS_GACT = 484 * MiB;
constexpr size_t WS_V = 484 * MiB;
constexpr size_t WS_YSSM = 740 * MiB;
constexpr size_t WS_SGS = 548 * MiB;
constexpr size_t WS_SGA = 676 * MiB;
constexpr size_t WS_E = 804 * MiB;
constexpr size_t WS_YATT = 836 * MiB;
constexpr size_t WS_PART0 = 420 * MiB, WS_PART1 = 452 * MiB, WS_PART2 = 932 * MiB;
constexpr size_t WS_QLIST = 900 * MiB;
constexpr size_t WS_PL = 268 * MiB;
constexpr size_t WS_MQ = 996 * MiB;
constexpr size_t WS_H1F8 = 836 * MiB;
#ifndef UPS_FP8
#define UPS_FP8 1
#endif
constexpr float YS_SCALE = 16.f;
#ifndef OUT_FP8
#define OUT_FP8 1
#endif
constexpr float MRG_SCALE = 16.f;
#ifndef U_FP8
#define U_FP8 1
#endif
constexpr size_t WS_WINF8U = 904 * MiB;
constexpr size_t WS_WINF8 = 900 * MiB;
constexpr size_t WS_XGF8 = 836 * MiB;
constexpr size_t WS_MA = 276 * MiB;
constexpr size_t WS_SEGC = 998 * MiB;
constexpr size_t WS_END = 999 * MiB;
constexpr size_t WS_KFRAG = WS_A0, WS_VFRAG = WS_A0 + 64 * MiB, WS_H1 = WS_A0, WS_MRG = WS_A0, WS_HID = WS_A0;
constexpr size_t WS_X1 = WS_SGS, WS_XG = WS_UP, WS_Y0 = WS_UP, WS_Y1 = WS_E;
static_assert(WS_SGA + 64 * MiB <= WS_YSSM && WS_YSSM + 64 * MiB <= WS_E && WS_GACT + 64 * MiB <= WS_SGS && WS_PART1 + 32 * MiB <= WS_GACT, "map");
static_assert(WS_HID + (size_t)HID_ROWS * DE * 2 <= WS_UP, "hid fits");
static_assert(WS_RLOG + (size_t)T * 72 * 4 <= WS_ROWTOK, "rlog fits");

constexpr int CW_TMO = 0, CW_CODE = 1;
constexpr int CW_BAR = 4096;
constexpr int CW_ECNT = 8192;
constexpr int CW_GCNT = 12288;

constexpr int RING_BYTES = 131072;
constexpr int ROWTAB_OFF = RING_BYTES, ROWTAB_UNITS = 12, ROWTAB_BYTES = 25 * 1024;
constexpr int MOE_TST_OFF = ROWTAB_OFF + ROWTAB_BYTES;
constexpr int MISC_OFF = MOE_TST_OFF + 512;
constexpr int LDS_BYTES = MISC_OFF + 128;
static_assert(LDS_BYTES <= 163840, "LDS");

struct Frame {
    LAS unsigned char* lds;
    volatile LAS unsigned* MISC;
    gu32* ctl;
    unsigned char* ws;
    int tid, lane, wave, vcu, G;
    const float* in[27];
    float* out;
};

__device__ __forceinline__ unsigned pk4_fp8(float a, float b, float c, float d) { int w = 0; w = __builtin_amdgcn_cvt_pk_fp8_f32(a, b, w, false); w = __builtin_amdgcn_cvt_pk_fp8_f32(c, d, w, true); return (unsigned)w; }
#define EPI_LOOP_BEGIN  _Pragma("unroll") for (int ai = 0; ai < 2; ++ai) _Pragma("unroll") for (int m = 0; m < 4; ++m) { const int rl = ai * 128 + wr * 64 + m * 16 + fr; _Pragma("unroll") for (int bj = 0; bj < 2; ++bj) { const int cl = bj * 128 + wc * 32 + 8 * fq; \
        const f32x4 a0 = acc[ai][bj][m][0], a1 = acc[ai][bj][m][1]; (void)rl; (void)cl; (void)a0; (void)a1;
#define EPI_LOOP_END } }
typedef const f32x4 (&AccRef)[2][2][4][2];
__device__ __forceinline__ u32x4 pack8(f32x4 a, f32x4 b) { u32x4 w; w.x = cvt_pk_bf16(a[0], a[1]); w.y = cvt_pk_bf16(a[2], a[3]); w.z = cvt_pk_bf16(b[0], b[1]); w.w = cvt_pk_bf16(b[2], b[3]); return w; }
__device__ __forceinline__ void unpack8(u32x4 w, f32x4& a, f32x4& b) { a = (f32x4){bflo(w.x), bfhi(w.x), bflo(w.y), bfhi(w.y)}; b = (f32x4){bflo(w.z), bfhi(w.z), bflo(w.w), bfhi(w.w)}; }

__device__ __forceinline__ u32x4 pair16(u32x2 X, u32x2 Y) {
    const auto r0 = __builtin_amdgcn_permlane16_swap(X.x, Y.x, false, false); const auto r1 = __builtin_amdgcn_permlane16_swap(X.y, Y.y, false, false);
    return (u32x4){r0[0], r1[0], r0[1], r1[1]};
}
__device__ __forceinline__ void unpair16(u32x4 v, u32x2& X, u32x2& Y) {
    const auto r0 = __builtin_amdgcn_permlane16_swap(v.x, v.z, false, false); const auto r1 = __builtin_amdgcn_permlane16_swap(v.y, v.w, false, false);
    X = (u32x2){r0[0], r1[0]}; Y = (u32x2){r0[1], r1[1]};
}
#define EPI_P(p_) const int ai = (p_) >> 1, m = 2 * ((p_) & 1); const int rlA = ai * 128 + wr * 64 + m * 16 + fr, rlB = rlA + 16; const int rlS = (fq & 1) ? rlB : rlA; (void)rlA; (void)rlB; (void)rlS
__device__ __forceinline__ u32x2 pk8_fp8(f32x4 a, f32x4 b) { return (u32x2){pk4_fp8(a[0], a[1], a[2], a[3]), pk4_fp8(b[0], b[1], b[2], b[3])}; }
__device__ __forceinline__ void unpk8_fp8(u32x2 v, f32x4& a, f32x4& b) { const int x = (int)v.x, y = (int)v.y;
    a = (f32x4){__builtin_amdgcn_cvt_f32_fp8(x, 0), __builtin_amdgcn_cvt_f32_fp8(x, 1), __builtin_amdgcn_cvt_f32_fp8(x, 2), __builtin_amdgcn_cvt_f32_fp8(x, 3)};
    b = (f32x4){__builtin_amdgcn_cvt_f32_fp8(y, 0), __builtin_amdgcn_cvt_f32_fp8(y, 1), __builtin_amdgcn_cvt_f32_fp8(y, 2), __builtin_amdgcn_cvt_f32_fp8(y, 3)}; }
#ifndef SIGMOID_IN_CONSUMER
#define SIGMOID_IN_CONSUMER 0
#endif
#if SIGMOID_IN_CONSUMER
#define GATE_ACT(v) (v)
#define GATE_USE(v) fast_sigmoid(v)
#else
#define GATE_ACT(v) fast_sigmoid(v)
#define GATE_USE(v) (v)
#endif
template <int PART  > struct EpiProj {
    unsigned char* ws; const float* b_gate; int pn_off; float ascale;
    __device__ __forceinline__ void operator()(AccRef acc, const pg8::Unit& u, int wr, int wc, int fr, int fq) const {
        const int pn = u.pn + pn_off; const int row0 = u.pm * 256;
        if (PART == 0) {
            bf16_t* Uperm = (bf16_t*)(ws + WS_UP);
            EPI_LOOP_BEGIN
                const int row = row0 + rl, col = pn * 256 + cl;
                bf16_t* dst = Uperm + (size_t)(col >> 4) * ((size_t)SROWS * SKY) + (size_t)(row >> 5) * SKY + (row & 31) * 16 + (col & 15);
                *(u32x4*)dst = pack8(a0 * ascale, a1 * ascale);
            EPI_LOOP_END
        } else if (pn < 8) {
            const size_t boff = pn < 4 ? WS_Q : (pn < 6 ? WS_K : WS_V);
            bf16_t* base = (bf16_t*)(ws + boff); const float sc = pn < 4 ? QSCALE : 1.f; const int c0 = (pn & 1) * 256;
            EPI_LOOP_BEGIN
                const int row = row0 + rl, col = c0 + cl;
                *(u32x4*)(base + (size_t)row * 512 + col) = pack8(a0 * (sc * ascale), a1 * (sc * ascale));
            EPI_LOOP_END
        } else {
            const bool attn_gate = pn >= 12;
            const int c0 = ((pn - 8) & 3) * 256; const float* bg = b_gate + (pn - 8) * 256;
            if (attn_gate) {
#pragma unroll
                for (int p = 0; p < 4; ++p) { EPI_P(p);
#pragma unroll
                    for (int bj = 0; bj < 2; ++bj) { const int cl = bj * 128 + wc * 32 + 8 * fq; const f32x4 b0 = *(const f32x4*)(bg + cl), b1 = *(const f32x4*)(bg + cl + 4); f32x4 s0, s1, t0, t1;
#pragma unroll
                        for (int e = 0; e < 4; ++e) { s0[e] = GATE_ACT(acc[ai][bj][m][0][e] * ascale + b0[e]); s1[e] = GATE_ACT(acc[ai][bj][m][1][e] * ascale + b1[e]);
                                                      t0[e] = GATE_ACT(acc[ai][bj][m + 1][0][e] * ascale + b0[e]); t1[e] = GATE_ACT(acc[ai][bj][m + 1][1][e] * ascale + b1[e]); }
                        *(u32x4*)(ws + WS_SGA + (size_t)(row0 + rlS) * 1024 + c0 + bj * 128 + wc * 32 + 16 * (fq >> 1)) = pair16(pk8_fp8(s0, s1), pk8_fp8(t0, t1)); } }
            } else {
            EPI_LOOP_BEGIN
                const int row = row0 + rl, col = c0 + cl;
                const f32x4 b0 = *(const f32x4*)(bg + cl), b1 = *(const f32x4*)(bg + cl + 4);
                f32x4 s0, s1;
#pragma unroll
                for (int e = 0; e < 4; ++e) { s0[e] = GATE_ACT(a0[e] * ascale + b0[e]); s1[e] = GATE_ACT(a1[e] * ascale + b1[e]); }
                *(u32x4*)((bf16_t*)(ws + WS_SGS) + (size_t)row * 1024 + col) = pack8(s0, s1);
            EPI_LOOP_END
            }
        }
    }
};
struct EpiSsmE {
    float* E;
    __device__ __forceinline__ void operator()(AccRef acc, const pg8::Unit& u, int wr, int wc, int fr, int fq) const {
        EPI_LOOP_BEGIN
            if (bj == 0) { float* dst = E + (size_t)(u.pm * 256 + rl) * 128 + cl; *(f32x4*)dst = a0; *(f32x4*)(dst + 4) = a1; }
        EPI_LOOP_END
    }
};
__device__ __forceinline__ float gelu_tanh(float x) { const float z = 1.5957691216057308f * (x + 0.044715f * x * x * x); return x * fast_sigmoid(z); }
struct EpiSsmY {
    bf16_t* Gact;
    __device__ __forceinline__ void operator()(AccRef acc, const pg8::Unit& u, int wr, int wc, int fr, int fq) const {
        const int g = u.aux;
        EPI_LOOP_BEGIN
            const int rg = (u.pm & 7) * 256 + rl;
            const int colg = u.pn * 256 + cl;
            const int tok = (rg >> 8) * SEQ + (rg & 255) * SL + (colg >> 4);
            f32x4 y0, y1;
#pragma unroll
            for (int e = 0; e < 4; ++e) { y0[e] = gelu_tanh(a0[e]); y1[e] = gelu_tanh(a1[e]); }
            *(u32x4*)(Gact + (size_t)tok * DS + g * 16 + (colg & 15)) = pack8(y0, y1);
        EPI_LOOP_END
    }
};
#define EPI_SBAR __builtin_amdgcn_sched_barrier(0)
#define EPI_G(g_) const int ai = (g_) >> 2, m = (g_) & 3; const int rl = ai * 128 + wr * 64 + m * 16 + fr; (void)rl
struct EpiGlu {
    const bf16_t* Gact; bf16_t* Yssm; const float* b_glu;
    __device__ __forceinline__ void operator()(AccRef acc, const pg8::Unit& u, int wr, int wc, int fr, int fq) const {
        const int col0 = u.pn * 256 + wc * 32 + 8 * fq; const size_t rowb = (size_t)u.pm * 256;
        f32x4 bv[2][2]; u32x4 gv[8][2];
#pragma unroll
        for (int bj = 0; bj < 2; ++bj) { bv[bj][0] = *(const f32x4*)(b_glu + col0 + bj * 128); bv[bj][1] = *(const f32x4*)(b_glu + col0 + bj * 128 + 4); }
#pragma unroll
        for (int g = 0; g < 8; ++g) { EPI_G(g);
#pragma unroll
            for (int bj = 0; bj < 2; ++bj) gv[g][bj] = *(const u32x4*)(Gact + (rowb + rl) * DS + col0 + bj * 128); }
        EPI_SBAR;
#pragma unroll
        for (int p = 0; p < 4; ++p) { EPI_P(p);
#pragma unroll
            for (int bj = 0; bj < 2; ++bj) { f32x4 y_[2][2];
#pragma unroll
                for (int gi = 0; gi < 2; ++gi) { f32x4 g0, g1; unpack8(gv[2 * p + gi][bj], g0, g1); const f32x4 a0 = acc[ai][bj][m + gi][0], a1 = acc[ai][bj][m + gi][1];
#pragma unroll
                    for (int e = 0; e < 4; ++e) { y_[gi][0][e] = g0[e] * fast_sigmoid(a0[e] + bv[bj][0][e]); y_[gi][1][e] = g1[e] * fast_sigmoid(a1[e] + bv[bj][1][e]); } }
                if (UPS_FP8) *(u32x4*)((unsigned char*)Yssm + (rowb + rlS) * DS + u.pn * 256 + wc * 32 + 16 * (fq >> 1) + bj * 128) = pair16(pk8_fp8(y_[0][0] * YS_SCALE, y_[0][1] * YS_SCALE), pk8_fp8(y_[1][0] * YS_SCALE, y_[1][1] * YS_SCALE));
                else { *(u32x4*)(Yssm + (rowb + rlA) * DS + col0 + bj * 128) = pack8(y_[0][0], y_[0][1]); *(u32x4*)(Yssm + (rowb + rlB) * DS + col0 + bj * 128) = pack8(y_[1][0], y_[1][1]); } } }
    }
};
struct EpiUpA {
    const unsigned char* SG; unsigned char* MA; float ascale;
    __device__ __forceinline__ void operator()(AccRef acc, const pg8::Unit& u, int wr, int wc, int fr, int fq) const {
        const size_t base = (size_t)u.pm * 256 * D + u.pn * 256 + wc * 32 + 16 * (fq >> 1); u32x4 sv[4][2];
#pragma unroll
        for (int p = 0; p < 4; ++p) { EPI_P(p);
#pragma unroll
            for (int bj = 0; bj < 2; ++bj) sv[p][bj] = *(const u32x4*)(SG + base + (size_t)rlS * D + bj * 128); }
        EPI_SBAR;
#pragma unroll
        for (int p = 0; p < 4; ++p) { EPI_P(p);
#pragma unroll
            for (int bj = 0; bj < 2; ++bj) { u32x2 sx, sy; unpair16(sv[p][bj], sx, sy); f32x4 s0, s1, t0, t1; unpk8_fp8(sx, s0, s1); unpk8_fp8(sy, t0, t1);
#pragma unroll
                for (int e = 0; e < 4; ++e) { s0[e] = GATE_USE(s0[e]); s1[e] = GATE_USE(s1[e]); t0[e] = GATE_USE(t0[e]); t1[e] = GATE_USE(t1[e]); }
                const f32x4 y0 = s0 * acc[ai][bj][m][0] * ascale, y1 = s1 * acc[ai][bj][m][1] * ascale, z0 = t0 * acc[ai][bj][m + 1][0] * ascale, z1 = t1 * acc[ai][bj][m + 1][1] * ascale;
                *(u32x4*)(MA + base + (size_t)rlS * D + bj * 128) = pair16(pk8_fp8(y0, y1), pk8_fp8(z0, z1)); } }
    }
};
struct EpiUpS {
    const bf16_t* SG; const unsigned char* MA; bf16_t* Mrg; float ascale;
    __device__ __forceinline__ void operator()(AccRef acc, const pg8::Unit& u, int wr, int wc, int fr, int fq) const {
        const size_t base = (size_t)u.pm * 256 * D + u.pn * 256 + wc * 32 + 8 * fq; const size_t base16 = (size_t)u.pm * 256 * D + u.pn * 256 + wc * 32 + 16 * (fq >> 1);
        u32x4 sv[2][2][2]; u32x4 mv[2][2];
        constexpr float ms = 1.f / MA_SCALE;
#define UPS_LOAD(buf_, bt_) do { { EPI_P(bt_); _Pragma("unroll") for (int bj = 0; bj < 2; ++bj) mv[buf_][bj] = *(const u32x4*)(MA + base16 + (size_t)rlS * D + bj * 128); } \
            _Pragma("unroll") for (int gi_ = 0; gi_ < 2; ++gi_) { EPI_G(2 * (bt_) + gi_); _Pragma("unroll") for (int bj = 0; bj < 2; ++bj) sv[buf_][gi_][bj] = *(const u32x4*)(SG + base + (size_t)rl * D + bj * 128); } } while (0)
#define UPS_PROC(buf_, bt_) do { EPI_P(bt_); _Pragma("unroll") for (int bj = 0; bj < 2; ++bj) { u32x2 mx_, my_; unpair16(mv[buf_][bj], mx_, my_); f32x4 r_[2][2]; \
            _Pragma("unroll") for (int gi_ = 0; gi_ < 2; ++gi_) { f32x4 s0, s1; unpack8(sv[buf_][gi_][bj], s0, s1); _Pragma("unroll") for (int e_ = 0; e_ < 4; ++e_) { s0[e_] = GATE_USE(s0[e_]); s1[e_] = GATE_USE(s1[e_]); } \
                f32x4 p0, p1; unpk8_fp8(gi_ == 0 ? mx_ : my_, p0, p1); r_[gi_][0] = s0 * (acc[ai][bj][m + gi_][0] * ascale) + p0 * ms; r_[gi_][1] = s1 * (acc[ai][bj][m + gi_][1] * ascale) + p1 * ms; } \
            if (OUT_FP8) *(u32x4*)((unsigned char*)Mrg + base16 + (size_t)rlS * D + bj * 128) = pair16(pk8_fp8(r_[0][0] * MRG_SCALE, r_[0][1] * MRG_SCALE), pk8_fp8(r_[1][0] * MRG_SCALE, r_[1][1] * MRG_SCALE)); \
            else { *(u32x4*)(Mrg + base + (size_t)rlA * D + bj * 128) = pack8(r_[0][0], r_[0][1]); *(u32x4*)(Mrg + base + (size_t)rlB * D + bj * 128) = pack8(r_[1][0], r_[1][1]); } } } while (0)
        UPS_LOAD(0, 0); UPS_LOAD(1, 1); EPI_SBAR;
        UPS_PROC(0, 0); UPS_LOAD(0, 2); EPI_SBAR;
        UPS_PROC(1, 1); UPS_LOAD(1, 3); EPI_SBAR;
        UPS_PROC(0, 2); EPI_SBAR;
        UPS_PROC(1, 3);
#undef UPS_LOAD
#undef UPS_PROC
    }
};
__device__ __forceinline__ float sum_xor16(float v) { const unsigned u = __builtin_bit_cast(unsigned, v); const auto r = __builtin_amdgcn_permlane16_swap(u, u, false, false); return __builtin_bit_cast(float, (unsigned)r[0]) + __builtin_bit_cast(float, (unsigned)r[1]); }
__device__ __forceinline__ float sum_xor32(float v) { const unsigned u = __builtin_bit_cast(unsigned, v); const auto r = __builtin_amdgcn_permlane32_swap(u, u, false, false); return __builtin_bit_cast(float, (unsigned)r[0]) + __builtin_bit_cast(float, (unsigned)r[1]); }
struct EpiOut {
    const float* x; bf16_t* X1; unsigned char* X18; float* SSQ; float ascale;
    __device__ __forceinline__ void operator()(AccRef acc, const pg8::Unit& u, int wr, int wc, int fr, int fq) const {
        const int col0 = u.pn * 256 + wc * 32 + 8 * fq; const size_t base = (size_t)u.pm * 256 * D + col0; const size_t base16 = (size_t)u.pm * 256 * D + u.pn * 256 + wc * 32 + 16 * (fq >> 1);
        f32x4 xv[2][2][2][2];
#define OUT_LOAD(buf_, bt_) do { _Pragma("unroll") for (int gi_ = 0; gi_ < 2; ++gi_) { EPI_G(2 * (bt_) + gi_); _Pragma("unroll") for (int bj = 0; bj < 2; ++bj) { const size_t off = base + (size_t)rl * D + bj * 128; \
            xv[buf_][gi_][bj][0] = *(const f32x4*)(x + off); xv[buf_][gi_][bj][1] = *(const f32x4*)(x + off + 4); } } } while (0)
#define OUT_PROC(buf_, bt_) do { u32x2 f8_[2][2]; _Pragma("unroll") for (int gi_ = 0; gi_ < 2; ++gi_) { EPI_G(2 * (bt_) + gi_); float ss = 0.f; _Pragma("unroll") for (int bj = 0; bj < 2; ++bj) { const size_t off = base + (size_t)rl * D + bj * 128; \
            const f32x4 x0 = xv[buf_][gi_][bj][0] + acc[ai][bj][m][0] * ascale, x1 = xv[buf_][gi_][bj][1] + acc[ai][bj][m][1] * ascale; \
            *(u32x4*)(X1 + off) = pack8(x0, x1); f8_[gi_][bj] = pk8_fp8(x0, x1); \
            ss += (x0[0] * x0[0] + x0[1] * x0[1]) + (x0[2] * x0[2] + x0[3] * x0[3]) + (x1[0] * x1[0] + x1[1] * x1[1]) + (x1[2] * x1[2] + x1[3] * x1[3]); } \
            ss = sum_xor16(ss); ss = sum_xor32(ss); \
            SSQ[((size_t)u.pm * 256 + rl) * 16 + u.pn * 4 + wc] = ss; } \
            { EPI_P(bt_); _Pragma("unroll") for (int bj = 0; bj < 2; ++bj) *(u32x4*)(X18 + base16 + (size_t)rlS * D + bj * 128) = pair16(f8_[0][bj], f8_[1][bj]); } } while (0)
        OUT_LOAD(0, 0); OUT_LOAD(1, 1); EPI_SBAR;
        OUT_PROC(0, 0); OUT_LOAD(0, 2); EPI_SBAR;
        OUT_PROC(1, 1); OUT_LOAD(1, 3); EPI_SBAR;
        OUT_PROC(0, 2); EPI_SBAR;
        OUT_PROC(1, 3);
#undef OUT_LOAD
#undef OUT_PROC
    }
};
struct EpiRouter {
    float* Rlog;
    __device__ __forceinline__ void operator()(AccRef acc, const pg8::Unit& u, int wr, int wc, int fr, int fq) const {
        EPI_LOOP_BEGIN
            if (bj == 0 && cl < 72) { float* dst = Rlog + (size_t)(u.pm * 256 + rl) * 72 + cl; *(f32x4*)dst = a0; *(f32x4*)(dst + 4) = a1; }
        EPI_LOOP_END
    }
};
struct EpiMoe1 {
    unsigned char* Hid; const float* rowrstd; const unsigned* ecnt; float ascale;
    __device__ __forceinline__ void operator()(AccRef acc, const pg8::Unit& u, int wr, int wc, int fr, int fq) const {
        const int e = u.aux, cnt = u.aux3; float rsv[8];
#pragma unroll
        for (int g = 0; g < 8; ++g) { EPI_G(g); const int pos = u.aux2 + rl; rsv[g] = rowrstd[(size_t)e * ROWCAP + (pos < cnt ? pos : 0)] * ascale; }
        EPI_SBAR;
#pragma unroll
        for (int p = 0; p < 4; ++p) { EPI_P(p); u32x2 hp[2];
#pragma unroll
            for (int gi = 0; gi < 2; ++gi) { const float rs = rsv[2 * p + gi]; f32x4 h0, h1;
#pragma unroll
                for (int k = 0; k < 4; ++k) { const float a = acc[ai][0][m + gi][0][k] * rs, b = acc[ai][1][m + gi][0][k] * rs; h0[k] = a * fast_sigmoid(a) * b;
                    const float a2 = acc[ai][0][m + gi][1][k] * rs, b2 = acc[ai][1][m + gi][1][k] * rs; h1[k] = a2 * fast_sigmoid(a2) * b2; }
                hp[gi] = pk8_fp8(h0, h1); }
            const u32x4 v = pair16(hp[0], hp[1]);
            if (u.aux2 + rlS < cnt) *(u32x4*)(Hid + (size_t)(u.pm * 256 + rlS) * DE + u.pn * 128 + wc * 32 + 16 * (fq >> 1)) = v; }
    }
};
struct EpiMoe2 {
    unsigned char* Y0; size_t ydelta; const unsigned* rowtok; const float* rowcoef; const unsigned* ecnt; float ascale;
    __device__ __forceinline__ void operator()(AccRef acc, const pg8::Unit& u, int wr, int wc, int fr, int fq) const {
        const int e = u.aux, cnt = u.aux3; unsigned tkv[8]; float cfv[8];
#pragma unroll
        for (int g = 0; g < 8; ++g) { EPI_G(g); const int pos = u.aux2 + rl; const size_t ri = (size_t)e * ROWCAP + (pos < cnt ? pos : 0); tkv[g] = rowtok[ri]; cfv[g] = rowcoef[ri] * ascale; }
        EPI_SBAR;
#pragma unroll
        for (int p = 0; p < 4; ++p) { EPI_P(p); unsigned ta_ = tkv[2 * p], tb_ = tkv[2 * p + 1]; asm volatile("" : "+v"(ta_), "+v"(tb_));
            const unsigned tk = (fq & 1) ? tb_ : ta_; const bool ok = u.aux2 + rlS < cnt;
            unsigned char* dst = Y0 + (size_t)(tk & 1u) * ydelta + (size_t)(tk >> 1) * D + u.pn * 256 + wc * 32 + 16 * (fq >> 1);
#pragma unroll
            for (int bj = 0; bj < 2; ++bj) { const float c0 = cfv[2 * p], c1 = cfv[2 * p + 1];
                const u32x4 v = pair16(pk8_fp8(acc[ai][bj][m][0] * c0, acc[ai][bj][m][1] * c0), pk8_fp8(acc[ai][bj][m + 1][0] * c1, acc[ai][bj][m + 1][1] * c1));
                if (ok) *(u32x4*)(dst + bj * 128) = v; } }
    }
};
__device__ __forceinline__ void transpose_item(const float* W, int N, int k0, int n0, bf16_t* WT, size_t drow0, int ldo, LAS float* scr, int lane) {
    float tv[32];
#pragma unroll
    for (int i = 0; i < 32; ++i) tv[i] = W[(size_t)(k0 + 2 * i + (lane >> 5)) * N + n0 + (lane & 31)];
#pragma unroll
    for (int i = 0; i < 32; ++i) scr[(2 * i + (lane >> 5)) * 33 + (lane & 31)] = tv[i];
    LDS_WAIT(); asm volatile("" ::: "memory");
    const int c = lane & 7;
#pragma unroll
    for (int j = 0; j < 4; ++j) { const int n = (lane >> 3) + 8 * j; const LAS float* s = scr + (8 * c) * 33 + n;
        u32x4 o; o.x = pk2(s[0 * 33], s[1 * 33]); o.y = pk2(s[2 * 33], s[3 * 33]); o.z = pk2(s[4 * 33], s[5 * 33]); o.w = pk2(s[6 * 33], s[7 * 33]);
        *(u32x4*)(WT + (drow0 + n) * (size_t)ldo + k0 + 8 * c) = o; }
    LDS_WAIT(); asm volatile("" ::: "memory");
}
__device__ __forceinline__ void transpose_item_f8(const float* W, int N, int k0, int n0, unsigned char* WT8, size_t drow0, int ldo, float scale, LAS float* scr, int lane, const float* kgain = nullptr  ) {
    float tv[32];
#pragma unroll
    for (int i = 0; i < 32; ++i) tv[i] = W[(size_t)(k0 + 2 * i + (lane >> 5)) * N + n0 + (lane & 31)];
#pragma unroll
    for (int i = 0; i < 32; ++i) scr[(2 * i + (lane >> 5)) * 33 + (lane & 31)] = tv[i] * (kgain ? scale * kgain[k0 + 2 * i + (lane >> 5)] : scale);
    LDS_WAIT(); asm volatile("" ::: "memory");
    const int c = lane & 3;
#pragma unroll
    for (int j = 0; j < 2; ++j) { const int n = (lane >> 2) + 16 * j; const LAS float* s = scr + (16 * c) * 33 + n;
        u32x4 o; o.x = pk4_fp8(s[0 * 33], s[1 * 33], s[2 * 33], s[3 * 33]); o.y = pk4_fp8(s[4 * 33], s[5 * 33], s[6 * 33], s[7 * 33]);
        o.z = pk4_fp8(s[8 * 33], s[9 * 33], s[10 * 33], s[11 * 33]); o.w = pk4_fp8(s[12 * 33], s[13 * 33], s[14 * 33], s[15 * 33]);
        *(u32x4*)(WT8 + (drow0 + n) * (size_t)ldo + k0 + 16 * c) = o; }
    LDS_WAIT(); asm volatile("" ::: "memory");
}
template <int NR> __device__ __forceinline__ void rms_rows_to_bf16(int lane, const float* xrow, const float* g, bf16_t* orow, unsigned char* orow8) {
    f32x4 v[NR][4]; float s[NR];
#pragma unroll
    for (int r = 0; r < NR; ++r) { const f32x4* xr = (const f32x4*)(xrow + (size_t)r * D) + lane;
#pragma unroll
        for (int j = 0; j < 4; ++j) v[r][j] = xr[64 * j]; }
    const f32x4* gr = (const f32x4*)g + lane; f32x4 wv[4];
#pragma unroll
    for (int j = 0; j < 4; ++j) wv[j] = gr[64 * j];
#pragma unroll
    for (int r = 0; r < NR; ++r) { float a = 0.f;
#pragma unroll
        for (int j = 0; j < 4; ++j) a += (v[r][j].x * v[r][j].x + v[r][j].y * v[r][j].y) + (v[r][j].z * v[r][j].z + v[r][j].w * v[r][j].w);
        s[r] = a; }
#pragma unroll
    for (int o = 1; o < 64; o <<= 1) {
#pragma unroll
        for (int r = 0; r < NR; ++r) s[r] += __shfl_xor(s[r], o); }
#pragma unroll
    for (int r = 0; r < NR; ++r) { const float rstd = 1.f / sqrtf(s[r] * (1.f / D) + RMS_EPS); unsigned long long* o8 = (unsigned long long*)(orow + (size_t)r * D) + lane;
#pragma unroll
        for (int j = 0; j < 4; ++j) { const float y0 = v[r][j].x * rstd * wv[j].x, y1 = v[r][j].y * rstd * wv[j].y, y2 = v[r][j].z * rstd * wv[j].z, y3 = v[r][j].w * rstd * wv[j].w;
            if (!U_FP8) o8[64 * j] = (unsigned long long)pk2(y0, y1) | ((unsigned long long)pk2(y2, y3) << 32);
            ((unsigned*)(orow8 + (size_t)r * D))[lane + 64 * j] = pk4_fp8(y0, y1, y2, y3); } }
}
__device__ __forceinline__ void cpow(float lr, float li, float step, float dl, float& ar, float& ai) {
    const float mag = __expf(dl * lr * step); const float rev = dl * (li * step * 0.15915494309189535f); const float fr = rev - floorf(rev);
    ar = mag * __builtin_amdgcn_cosf(fr); ai = mag * __builtin_amdgcn_sinf(fr);
}
__device__ __forceinline__ void ssm_gen(Frame& F, int g, int sl) {
    LAS float* AP = (LAS float*)(F.lds); LAS float* BB = AP + 33 * 64 * 2; LAS float* CC = BB + 2048; LAS float* KT = CC + 2048;
    const float* lam_re = F.in[4] + g * SP; const float* lam_im = F.in[5] + g * SP; const float step = __expf(F.in[6][g]);
    const float* b_re = F.in[7] + g * SP * SHC; const float* b_im = F.in[8] + g * SP * SHC; const float* c_re = F.in[9] + g * SHC * SP; const float* c_im = F.in[10] + g * SHC * SP; const float* dd = F.in[11] + g * SHC;
    bf16_t* BT = (bf16_t*)(F.ws + WS_SSMT) + (size_t)g * 512 * SKY; bf16_t* BW = (bf16_t*)(F.ws + WS_SSMW) + (size_t)g * 256 * SKU;
    const int tid = F.tid;
    for (int idx = tid; idx < 33 * 64; idx += NTHR) { const int dl = idx >> 6, p = idx & 63; float ar, ai; cpow(lam_re[p], lam_im[p], step, (float)dl, ar, ai); AP[idx * 2] = ar; AP[idx * 2 + 1] = ai; }
    for (int idx = tid; idx < 1024; idx += NTHR) { const int ho = idx >> 6, p = idx & 63; CC[idx * 2] = c_re[ho * 64 + p]; CC[idx * 2 + 1] = c_im[ho * 64 + p]; }
    __syncthreads();
    for (int idx = tid; idx < 1024; idx += NTHR) { const int p = idx >> 4, h = idx & 15; const float ar = AP[(64 + p) * 2], ai = AP[(64 + p) * 2 + 1];
        const float lr = lam_re[p], li = lam_im[p], nr = ar - 1.f, ni = ai, den = lr * lr + li * li, cr = (nr * lr + ni * li) / den, ci = (ni * lr - nr * li) / den;
        const float br = b_re[p * 16 + h], bi = b_im[p * 16 + h]; BB[idx * 2] = cr * br - ci * bi; BB[idx * 2 + 1] = cr * bi + ci * br; }
    __syncthreads();
    for (int idx = tid; idx < 1024; idx += NTHR) { const int dl = idx >> 5, hl = (idx >> 4) & 1, hi = idx & 15, ho = 2 * sl + hl; float s = 0.f;
        for (int p = 0; p < 64; ++p) { const float ar = AP[(dl * 64 + p) * 2], ai = AP[(dl * 64 + p) * 2 + 1], br = BB[(p * 16 + hi) * 2], bi = BB[(p * 16 + hi) * 2 + 1];
            const float zr = ar * br - ai * bi, zi = ar * bi + ai * br; s += CC[(ho * 64 + p) * 2] * zr - CC[(ho * 64 + p) * 2 + 1] * zi; }
        if (dl == 0 && ho == hi) s += dd[ho];
        KT[idx] = s; }
    __syncthreads();
    for (int v = tid; v < 64 * 80; v += NTHR) { const int nl = v / 80, kv = (v % 80) * 8, tau = nl >> 1, hl = nl & 1, ho = 2 * sl + hl, n = tau * 16 + ho; float val[8];
        if (kv < 512) { const int sg = kv >> 4, hi0 = kv & 15;
#pragma unroll
            for (int e = 0; e < 8; ++e) val[e] = (tau >= sg) ? KT[((tau - sg) * 2 + hl) * 16 + hi0 + e] : 0.f; }
        else { const int kk = kv - 512;
#pragma unroll
            for (int e = 0; e < 8; ++e) { const int p = (kk + e) >> 1, ri = (kk + e) & 1; const float ar = AP[((tau + 1) * 64 + p) * 2], ai = AP[((tau + 1) * 64 + p) * 2 + 1], cre = CC[(ho * 64 + p) * 2], cim = CC[(ho * 64 + p) * 2 + 1];
                val[e] = ri == 0 ? (cre * ar - cim * ai) : -(cre * ai + cim * ar); } }
        u32x4 o; o.x = pk2(val[0], val[1]); o.y = pk2(val[2], val[3]); o.z = pk2(val[4], val[5]); o.w = pk2(val[6], val[7]);
        *(u32x4*)(BT + (size_t)n * SKY + kv) = o; }
    for (int v = tid; v < 32 * 64; v += NTHR) { const int nl = v >> 6, kv = (v & 63) * 8; float val[8];
        const bool real = nl < 16; const int n = real ? 16 * sl + nl : 128 + 16 * sl + (nl - 16);
        if (real) { const int p = n >> 1, ri = n & 1, sg = kv >> 4, hi0 = kv & 15; const float ar = AP[((31 - sg) * 64 + p) * 2], ai = AP[((31 - sg) * 64 + p) * 2 + 1];
#pragma unroll
            for (int e = 0; e < 8; ++e) { const float br = BB[(p * 16 + hi0 + e) * 2], bi = BB[(p * 16 + hi0 + e) * 2 + 1]; val[e] = ri == 0 ? (ar * br - ai * bi) : (ar * bi + ai * br); } }
        else {
#pragma unroll
            for (int e = 0; e < 8; ++e) val[e] = 0.f; }
        u32x4 o; o.x = pk2(val[0], val[1]); o.y = pk2(val[2], val[3]); o.z = pk2(val[4], val[5]); o.w = pk2(val[6], val[7]);
        *(u32x4*)(BW + (size_t)n * SKU + kv) = o; }
    __syncthreads();
}
__device__ __forceinline__ void p0_prologue(Frame& F) {
    for (int it = F.vcu; it < SG * 8; it += F.G) ssm_gen(F, it >> 3, it & 7);
    LAS float* scr = (LAS float*)(F.lds + F.wave * 16384);
    const int gw = F.vcu * NWAVES + F.wave, NGW = F.G * NWAVES, lane = F.lane;
    constexpr int I_IN = 16 * 128, I_GLU = 8 * 16, I_US = 8 * 32, I_UA = 8 * 32, I_OUT = 16 * 32, I_W1 = 32 * 256, I_W3 = 32 * 256, I_W2 = 32 * 256;
    constexpr int NITEMS = I_IN + I_GLU + I_US + I_UA + I_OUT + I_W1 + I_W3 + I_W2;
    unsigned char* ws = F.ws;
    for (int it = gw; it < NITEMS; it += NGW) {
        int r = it;
        if (r < I_IN) { const int k0 = 64 * (r / 128), n0 = 32 * (r % 128);
            if (n0 < DS) { if (U_FP8) transpose_item_f8(F.in[2], DIN, k0, n0, ws + WS_WINF8U, n0, D, WF8_SCALE, scr, lane); else transpose_item(F.in[2], DIN, k0, n0, (bf16_t*)(ws + WS_WIN), n0, D, scr, lane); }
            else transpose_item_f8(F.in[2], DIN, k0, n0, ws + WS_WINF8, n0 - DS, D, WF8_SCALE, scr, lane);
            continue; } r -= I_IN;
        if (r < I_GLU) { transpose_item(F.in[12], DS, 64 * (r / 16), 32 * (r % 16), (bf16_t*)(ws + WS_WGLU), 32 * (r % 16), DS, scr, lane); continue; } r -= I_GLU;
        if (r < I_US) { if (UPS_FP8) transpose_item_f8(F.in[14], D, 64 * (r / 32), 32 * (r % 32), ws + WS_WUS, 32 * (r % 32), DS, WF8_SCALE, scr, lane); else transpose_item(F.in[14], D, 64 * (r / 32), 32 * (r % 32), (bf16_t*)(ws + WS_WUS), 32 * (r % 32), DS, scr, lane); continue; } r -= I_US;
        if (r < I_UA) { transpose_item_f8(F.in[15], D, 64 * (r / 32), 32 * (r % 32), ws + WS_WUA, 32 * (r % 32), DA, WF8_SCALE, scr, lane); continue; } r -= I_UA;
        if (r < I_OUT) { if (OUT_FP8) transpose_item_f8(F.in[17], D, 64 * (r / 32), 32 * (r % 32), ws + WS_WOUT, 32 * (r % 32), D, WF8_SCALE, scr, lane); else transpose_item(F.in[17], D, 64 * (r / 32), 32 * (r % 32), (bf16_t*)(ws + WS_WOUT), 32 * (r % 32), D, scr, lane); continue; } r -= I_OUT;
        if (r < I_W1 + I_W3) { const int w3 = r >= I_W1; if (w3) r -= I_W1; const int e = r >> 8, q = r & 255, k0 = 64 * (q / 16), n0 = 32 * (q % 16);
            transpose_item_f8((w3 ? F.in[24] : F.in[23]) + (size_t)e * D * DE, DE, k0, n0, ws + WS_W13, (size_t)e * 1024 + 256 * (n0 >> 7) + (n0 & 127) + (w3 ? 128 : 0), D, WF8_SCALE, scr, lane, F.in[18]); continue; }
        r -= I_W1 + I_W3;
        { const int e = r >> 8, q = r & 255, k0 = 64 * (q / 32), n0 = 32 * (q % 32);
            transpose_item_f8(F.in[25] + (size_t)e * DE * D, D, k0, n0, ws + WS_W2, (size_t)e * 1024 + n0, DE, WF8_SCALE, scr, lane); }
    }
    for (int m = 4 * gw; m < T; m += 4 * NGW) rms_rows_to_bf16<4>(lane, F.in[0] + (size_t)m * D, F.in[1], (bf16_t*)(ws + WS_H1) + (size_t)m * D, ws + WS_H1F8 + (size_t)m * D);
    { bf16_t* WR = (bf16_t*)(ws + WS_WR); const float* wrg = F.in[19]; const float* wre = F.in[21];
      for (int idx = F.vcu * NTHR + F.tid; idx < 256 * D; idx += F.G * NTHR) { const int r = idx >> 10, k = idx & 1023; unsigned o = 0u;
          if (r < 72) { const int c = r < 36 ? r : r - 36; const float w = (c < 4 ? wrg[k * 4 + c] : wre[k * 32 + (c - 4)]) * F.in[18][k]; const unsigned hb = f2bf(w);
              o = r < 36 ? hb : f2bf(w - __builtin_bit_cast(float, hb << 16)); }
          WR[idx] = (bf16_t)o; } }
}

__device__ __forceinline__ int crow(int r, int hi) { return (r & 3) + 8 * (r >> 2) + 4 * hi; }
constexpr int KVP = 72;
__device__ __forceinline__ void kv_prep_phase(Frame& F) {
    LAS bf16_t* KS = (LAS bf16_t*)(F.lds); LAS bf16_t* VS = KS + 256 * KVP; LAS float* PS = (LAS float*)(F.lds + 2 * 256 * KVP * 2); LAS float* WM = PS + 512;
    const bf16_t* Kb = (const bf16_t*)(F.ws + WS_K); const bf16_t* Vb = (const bf16_t*)(F.ws + WS_V);
    bf16_t* Kf = (bf16_t*)(F.ws + WS_KFRAG); bf16_t* Vf = (bf16_t*)(F.ws + WS_VFRAG); bf16_t* KM = (bf16_t*)(F.ws + WS_KMEAN); float* KN = (float*)(F.ws + WS_KMEAN + 512 * 1024);
    const int tid = F.tid;
    u32x4 kr[4], vr[4];
#define KVP_LOAD(item_) do { const int n_ = (item_) & 31, h_ = ((item_) >> 5) & 7, b_ = (item_) >> 8; const size_t tok0_ = (size_t)b_ * SEQ + 256 * n_; \
        _Pragma("unroll") for (int j = 0; j < 4; ++j) { const int q = tid + NTHR * j, row = q >> 3, pc = q & 7; const size_t src = (tok0_ + row) * DA + h_ * HD + pc * 8; kr[j] = *(const u32x4*)(Kb + src); vr[j] = *(const u32x4*)(Vb + src); } } while (0)
    if (F.vcu < BATCH * NH * NBLK) KVP_LOAD(F.vcu);
    for (int item = F.vcu; item < BATCH * NH * NBLK; item += F.G) {
#pragma unroll
        for (int j = 0; j < 4; ++j) { const int q = tid + NTHR * j, row = q >> 3, pc = q & 7; *(LAS u32x4*)(KS + row * KVP + pc * 8) = kr[j]; *(LAS u32x4*)(VS + row * KVP + pc * 8) = vr[j]; }
        { const int nx = (item + F.G < BATCH * NH * NBLK) ? item + F.G : item; KVP_LOAD(nx); }
        __syncthreads();
#pragma unroll
        for (int j = 0; j < 4; ++j) { const int P = tid + NTHR * j, st = P >> 8, ds = (P >> 6) & 3, l2 = P & 63, row = 32 * st + (l2 & 31), col = 16 * ds + 8 * (l2 >> 5);
            *(u32x4*)(Kf + ((size_t)item * 2048 + P) * 8) = *(const LAS u32x4*)(KS + row * KVP + col); }
#pragma unroll
        for (int j = 0; j < 4; ++j) { const int P = tid + NTHR * j, st = P >> 8, ks = (P >> 7) & 1, d0 = (P >> 6) & 1, l2 = P & 63, hi = l2 >> 5, jj = l2 & 31; unsigned w[4];
#pragma unroll
            for (int e = 0; e < 8; e += 2) { const unsigned lo = VS[(32 * st + 16 * ks + crow(e, hi)) * KVP + 32 * d0 + jj], hi16 = VS[(32 * st + 16 * ks + crow(e + 1, hi)) * KVP + 32 * d0 + jj]; w[e >> 1] = lo | (hi16 << 16); }
            *(u32x4*)(Vf + ((size_t)item * 2048 + P) * 8) = (u32x4){w[0], w[1], w[2], w[3]}; }
        { const int d = tid & 63, part = tid >> 6; float s = 0.f;
#pragma unroll 8
          for (int r = 0; r < 32; ++r) s += bf2f(KS[(part * 32 + r) * KVP + d]);
          PS[part * 64 + d] = s; }
        if (tid < 256) { float ss = 0.f;
#pragma unroll
            for (int c = 0; c < 8; ++c) { const u32x4 w = *(const LAS u32x4*)(KS + tid * KVP + c * 8);
                ss += bflo(w.x) * bflo(w.x) + bfhi(w.x) * bfhi(w.x) + bflo(w.y) * bflo(w.y) + bfhi(w.y) * bfhi(w.y) + bflo(w.z) * bflo(w.z) + bfhi(w.z) * bfhi(w.z) + bflo(w.w) * bflo(w.w) + bfhi(w.w) * bfhi(w.w); }
            ss = wave_max(ss); if (F.lane == 0) WM[F.wave] = ss; }
        __syncthreads();
        if (tid < 64) { float s = 0.f;
#pragma unroll
            for (int p = 0; p < 8; ++p) s += PS[p * 64 + tid];
            KM[(size_t)item * 64 + tid] = (bf16_t)f2bf(s * (1.f / 256.f)); }
        if (tid == 0) KN[item] = fmaxf(fmaxf(WM[0], WM[1]), fmaxf(WM[2], WM[3]));
        __syncthreads();
    }
#undef KVP_LOAD
}

__device__ __forceinline__ void ssm_scan_phase(Frame& F) {
    LAS float* FW = (LAS float*)(F.lds);
    const float* E = (const float*)(F.ws + WS_E); bf16_t* UP = (bf16_t*)(F.ws + WS_UP);
    const int w = F.wave, p = F.lane;
    for (int gb = F.vcu; gb < SG * BATCH; gb += F.G) {
        const int g = gb >> 3, b = gb & 7;
        const float lr = F.in[4][g * SP + p], li = F.in[5][g * SP + p], step = __expf(F.in[6][g]);
        float ar, ai; cpow(lr, li, step, 32.f, ar, ai);
        const size_t row0 = (size_t)g * SROWS + b * 256 + 32 * w;
        f32x2 e[32];
#pragma unroll
        for (int j = 0; j < 32; ++j) e[j] = *(const f32x2*)(E + (row0 + j) * 128 + 2 * p);
        float sr = 0.f, si = 0.f;
#pragma unroll
        for (int j = 0; j < 32; ++j) { const float nr = ar * sr - ai * si + e[j].x, ni = ar * si + ai * sr + e[j].y; sr = nr; si = ni; }
        FW[(w * 64 + p) * 2] = sr; FW[(w * 64 + p) * 2 + 1] = si;
        __syncthreads();
        float Ar = ar, Ai = ai;
#pragma unroll
        for (int q = 0; q < 5; ++q) { const float nr = Ar * Ar - Ai * Ai, ni = 2.f * Ar * Ai; Ar = nr; Ai = ni; }
        sr = 0.f; si = 0.f;
        for (int w2 = 0; w2 < w; ++w2) { const float fr = FW[(w2 * 64 + p) * 2], fi = FW[(w2 * 64 + p) * 2 + 1]; const float nr = Ar * sr - Ai * si + fr, ni = Ar * si + Ai * sr + fi; sr = nr; si = ni; }
#pragma unroll
        for (int j = 0; j < 32; ++j) { *(unsigned*)(UP + (row0 + j) * SKY + SKU + 2 * p) = pk2(sr, si);
            const float nr = ar * sr - ai * si + e[j].x, ni = ar * si + ai * sr + e[j].y; sr = nr; si = ni; }
        __syncthreads();
    }
}

__device__ __forceinline__ int t5_bucket(int d) {
    if (d < 16) return d;
    return 16 + (d >= 19) + (d >= 21) + (d >= 24) + (d >= 27) + (d >= 31) + (d >= 35) + (d >= 40) + (d >= 46) + (d >= 52) + (d >= 59) + (d >= 67) + (d >= 77) + (d >= 87) + (d >= 99) + (d >= 113);
}
struct Top3 { float v0, v1, v2; int i0, i1, i2; };
__device__ __forceinline__ Top3 top3_insert(Top3 t, float x, int n) {
    const bool b0 = (x > t.v0) || (x == t.v0 && n < t.i0), b1 = (x > t.v1) || (x == t.v1 && n < t.i1), b2 = (x > t.v2) || (x == t.v2 && n < t.i2);
    Top3 r;
    r.v2 = b1 ? t.v1 : (b2 ? x : t.v2); r.i2 = b1 ? t.i1 : (b2 ? n : t.i2);
    r.v1 = b0 ? t.v0 : (b1 ? x : t.v1); r.i1 = b0 ? t.i0 : (b1 ? n : t.i1);
    r.v0 = b0 ? x : t.v0; r.i0 = b0 ? n : t.i0;
    return r;
}
constexpr int GQS = 0, GKME = 36864, GCNTL = 41472, GMISC = 41600;
struct GatePre { u32x4 q[4]; u32x4 km; float kn, rbv; };
__device__ __forceinline__ void attn_gate_prefetch(Frame& F, int tid, int u, GatePre& P) {
    const int bh = u >> 5, qb = u & 31, b = bh >> 3, h = bh & 7, lane = tid & 63; const size_t tok0 = (size_t)b * SEQ + 256 * qb;
    const bf16_t* Qb = (const bf16_t*)(F.ws + WS_Q); const bf16_t* KM = (const bf16_t*)(F.ws + WS_KMEAN); const float* KN = (const float*)(F.ws + WS_KMEAN + 512 * 1024);
#pragma unroll
    for (int jj = 0; jj < 4; ++jj) { const int q = tid + NTHR * jj, row = q >> 3, pc = q & 7; P.q[jj] = *(const u32x4*)(Qb + (tok0 + row) * DA + h * HD + pc * 8); }
    { const int t2 = tid & 255, n = t2 >> 3, pc = t2 & 7; P.km = *(const u32x4*)(KM + ((size_t)bh * 32 + n) * 64 + pc * 8); }
    P.kn = KN[bh * 32 + (lane & 31)]; P.rbv = F.in[16][h * 32 + (lane & 31)];
}
template <bool COUNT> __device__ __forceinline__ void attn_gate_unit(Frame& F, int bh, int qb, const GatePre& P, int unext, GatePre& PN) {
    LAS unsigned char* L = F.lds;
    LAS bf16_t* QS = (LAS bf16_t*)(L + GQS); LAS bf16_t* KME = (LAS bf16_t*)(L + GKME); LAS int* CNT = (LAS int*)(L + GCNTL); LAS float* KNM = (LAS float*)(L + GMISC);
    int tid = F.tid; asm volatile("" : "+v"(tid));
    const int lane = tid & 63, w = F.wave, j = lane & 31, hi = lane >> 5;
    const int b = bh >> 3, h = bh & 7; const size_t tok0 = (size_t)b * SEQ + 256 * qb;
    const bf16_t* Qb = (const bf16_t*)(F.ws + WS_Q); const bf16_t* KM = (const bf16_t*)(F.ws + WS_KMEAN); const float* KN = (const float*)(F.ws + WS_KMEAN + 512 * 1024);
    float* MQg = (float*)(F.ws + WS_MQ); unsigned short* QL = (unsigned short*)(F.ws + WS_QLIST); unsigned* GC = (unsigned*)(F.ctl + CW_GCNT); unsigned* SEGC = (unsigned*)(F.ws + WS_SEGC);
#pragma unroll
    for (int jj = 0; jj < 4; ++jj) { const int q = tid + NTHR * jj, row = q >> 3, pc = q & 7; *(LAS u32x4*)(QS + row * KVP + pc * 8) = P.q[jj]; }
    if (tid < 256) { const int n = tid >> 3, pc = tid & 7; *(LAS u32x4*)(KME + n * KVP + pc * 8) = P.km; }
    if (tid < 32) CNT[tid] = 0;
    if (w == 1) { float v = (lane <= qb && lane < 32) ? P.kn : 0.f; v = wave_max(v); if (lane == 0) KNM[0] = v; }
    if (w == 2) { float v = wave_max(P.rbv); if (lane == 0) KNM[1] = v * LOG2E; }
    attn_gate_prefetch(F, tid, unext, PN);
    __syncthreads();
    {
        bf16x8 qf[4], kmf[4];
#pragma unroll
        for (int ds = 0; ds < 4; ++ds) { qf[ds] = *(const LAS bf16x8*)(QS + (32 * w + j) * KVP + 16 * ds + 8 * hi); kmf[ds] = *(const LAS bf16x8*)(KME + j * KVP + 16 * ds + 8 * hi); }
        f32x16 gt = {};
#pragma unroll
        for (int ds = 0; ds < 4; ++ds) gt = __builtin_amdgcn_mfma_f32_32x32x16_bf16(kmf[ds], qf[ds], gt, 0, 0, 0);
        float qn = 0.f;
#pragma unroll
        for (int ds = 0; ds < 4; ++ds)
#pragma unroll
            for (int e = 0; e < 8; ++e) { const float x = bf2f((unsigned short)qf[ds][e]); qn += x * x; }
        qn += __shfl_xor(qn, 32);
        const float m2 = sqrtf(qn * KNM[0]) + KNM[1];
        const int ql = 256 * qb + 32 * w + j;
        if (hi == 0) MQg[(size_t)bh * SEQ + ql] = m2;
        Top3 t3; t3.v0 = t3.v1 = t3.v2 = -INFINITY; t3.i0 = t3.i1 = t3.i2 = -1;
#pragma unroll
        for (int r = 0; r < 16; ++r) { const int n = crow(r, hi); const float x = (n < qb) ? gt[r] : -INFINITY; t3 = top3_insert(t3, x, x > -INFINITY ? n : 0x7fffffff); }
        { const float p0 = __shfl_xor(t3.v0, 32), p1 = __shfl_xor(t3.v1, 32), p2 = __shfl_xor(t3.v2, 32); const int q0 = __shfl_xor(t3.i0, 32), q1 = __shfl_xor(t3.i1, 32), q2 = __shfl_xor(t3.i2, 32);
          t3 = top3_insert(t3, p0, q0 >= 0 ? q0 : 0x7fffffff); t3 = top3_insert(t3, p1, q1 >= 0 ? q1 : 0x7fffffff); t3 = top3_insert(t3, p2, q2 >= 0 ? q2 : 0x7fffffff); }
        const int i0 = t3.v0 > -INFINITY ? t3.i0 : -1, i1 = t3.v1 > -INFINITY ? t3.i1 : -1, i2 = t3.v2 > -INFINITY ? t3.i2 : -1;
        if (hi == 0) { const unsigned e = (unsigned)ql << 2;
            if (i0 >= 0) { const int pos = __hip_atomic_fetch_add(CNT + i0, 1, __ATOMIC_RELAXED, __HIP_MEMORY_SCOPE_WORKGROUP); QL[((size_t)bh * 32 + i0) * SEQ + (qb - i0 - 1) * 256 + pos] = (unsigned short)(e | 0u); }
            if (i1 >= 0) { const int pos = __hip_atomic_fetch_add(CNT + i1, 1, __ATOMIC_RELAXED, __HIP_MEMORY_SCOPE_WORKGROUP); QL[((size_t)bh * 32 + i1) * SEQ + (qb - i1 - 1) * 256 + pos] = (unsigned short)(e | 1u); }
            if (i2 >= 0) { const int pos = __hip_atomic_fetch_add(CNT + i2, 1, __ATOMIC_RELAXED, __HIP_MEMORY_SCOPE_WORKGROUP); QL[((size_t)bh * 32 + i2) * SEQ + (qb - i2 - 1) * 256 + pos] = (unsigned short)(e | 2u); } }
    }
    __syncthreads();
    if (tid < qb) { const unsigned c = (unsigned)CNT[tid]; SEGC[((size_t)bh * 32 + tid) * 32 + (qb - tid - 1)] = c; if (COUNT && c) (void)__hip_atomic_fetch_add(GC + bh * 32 + tid, c, __ATOMIC_RELAXED, __HIP_MEMORY_SCOPE_AGENT); }
    __syncthreads();
}
template <bool COUNT> __device__ __forceinline__ void attn_gate_phase(Frame& F) {
    constexpr int NU = BATCH * NH * NBLK; if (F.vcu >= NU) return;
    GatePre PA, PB; attn_gate_prefetch(F, F.tid, F.vcu, PA);
    for (int u = F.vcu; u < NU; u += 2 * F.G) {
        const int u1 = u + F.G, u2 = u + 2 * F.G;
        attn_gate_unit<COUNT>(F, u >> 5, u & 31, PA, u1 < NU ? u1 : u, PB);
        if (u1 < NU) attn_gate_unit<COUNT>(F, u1 >> 5, u1 & 31, PB, u2 < NU ? u2 : u1, PA);
    }
}

__device__ __forceinline__ int prefix32_dpp(int v) {
    v += __builtin_amdgcn_update_dpp(0, v, 0x111, 0xF, 0xF, false);
    v += __builtin_amdgcn_update_dpp(0, v, 0x112, 0xF, 0xF, false);
    v += __builtin_amdgcn_update_dpp(0, v, 0x114, 0xF, 0xF, false);
    v += __builtin_amdgcn_update_dpp(0, v, 0x118, 0xF, 0xF, false);
    v += __builtin_amdgcn_update_dpp(0, v, 0x142, 0xA, 0xF, false);
    return v;
}
#define ATTN_SBAR __builtin_amdgcn_sched_barrier(0)
#ifndef ATTN_SETPRIO
#define ATTN_SETPRIO 0
#endif
#define ATTN_PRIO(p_) do { if (ATTN_SETPRIO) __builtin_amdgcn_s_setprio(p_); } while (0)
#define ATTN_LOADF(KF_, VF_, KP, VP, st_) do { \
        _Pragma("unroll") for (int ds_ = 0; ds_ < 4; ++ds_) KF_[ds_] = *(const LAS bf16x8*)((KP) + ((st_) * 4 + ds_) * 512 + lane8); \
        _Pragma("unroll") for (int q_ = 0; q_ < 4; ++q_) VF_[q_] = *(const LAS bf16x8*)((VP) + ((st_) * 4 + q_) * 512 + lane8); } while (0)
#define ATTN_COMPUTE(KF_, VF_, st_, MODE, CINIT) do { \
        ATTN_PRIO(1); f32x16 s_ = __builtin_amdgcn_mfma_f32_32x32x16_bf16(KF_[0], qf[0], CINIT, 0, 0, 0); \
        _Pragma("unroll") for (int ds_ = 1; ds_ < 4; ++ds_) s_ = __builtin_amdgcn_mfma_f32_32x32x16_bf16(KF_[ds_], qf[ds_], s_, 0, 0, 0); ATTN_PRIO(0); \
        float p_[16]; \
        if ((MODE) == 0) { _Pragma("unroll") for (int r_ = 0; r_ < 16; ++r_) p_[r_] = __builtin_amdgcn_exp2f(s_[r_]); } \
        else if ((MODE) == 1) { _Pragma("unroll") for (int r_ = 0; r_ < 16; ++r_) { const int dist_ = dq - (32 * (st_) + crow(r_, hi)); const int di_ = dist_ < 0 ? 0 : (dist_ > 127 ? 127 : dist_); \
                p_[r_] = __builtin_amdgcn_exp2f(s_[r_] + TABh[di_]); } } \
        else { _Pragma("unroll") for (int rq_ = 0; rq_ < 4; ++rq_) { const f32x4 bb_ = *(const LAS f32x4*)(BTD + rq_ * 256 + lane * 4); \
                _Pragma("unroll") for (int i_ = 0; i_ < 4; ++i_) p_[4 * rq_ + i_] = __builtin_amdgcn_exp2f(s_[4 * rq_ + i_] + bb_[i_]); } } \
        _Pragma("unroll") for (int r_ = 0; r_ < 16; ++r_) lsum += p_[r_]; \
        u32x4 pa_, pb_; pa_.x = cvt_pk_bf16(p_[0], p_[1]); pa_.y = cvt_pk_bf16(p_[2], p_[3]); pa_.z = cvt_pk_bf16(p_[4], p_[5]); pa_.w = cvt_pk_bf16(p_[6], p_[7]); \
        pb_.x = cvt_pk_bf16(p_[8], p_[9]); pb_.y = cvt_pk_bf16(p_[10], p_[11]); pb_.z = cvt_pk_bf16(p_[12], p_[13]); pb_.w = cvt_pk_bf16(p_[14], p_[15]); \
        const bf16x8 A0_ = __builtin_bit_cast(bf16x8, pa_), A1_ = __builtin_bit_cast(bf16x8, pb_); \
        ATTN_PRIO(1); o0 = __builtin_amdgcn_mfma_f32_32x32x16_bf16(VF_[0], A0_, o0, 0, 0, 0); o1 = __builtin_amdgcn_mfma_f32_32x32x16_bf16(VF_[1], A0_, o1, 0, 0, 0); \
        o0 = __builtin_amdgcn_mfma_f32_32x32x16_bf16(VF_[2], A1_, o0, 0, 0, 0); o1 = __builtin_amdgcn_mfma_f32_32x32x16_bf16(VF_[3], A1_, o1, 0, 0, 0); ATTN_PRIO(0); } while (0)
#define ATTN_TILE8(KP, VP, MODE, CINIT, HOOK) do { bf16x8 kA_[4], vA_[4], kB_[4], vB_[4]; ATTN_LOADF(kA_, vA_, KP, VP, 0); \
        _Pragma("nounroll") for (int st2_ = 0; st2_ < 8; st2_ += 2) { ATTN_LOADF(kB_, vB_, KP, VP, st2_ + 1); ATTN_SBAR; ATTN_COMPUTE(kA_, vA_, st2_, MODE, CINIT); HOOK(st2_); \
            ATTN_LOADF(kA_, vA_, KP, VP, (st2_ + 2 < 8 ? st2_ + 2 : 7)); ATTN_SBAR; ATTN_COMPUTE(kB_, vB_, st2_ + 1, MODE, CINIT); } } while (0)

__device__ __forceinline__ u32x4 ot_pack16(const f32x16& o, int pr) {
    const unsigned p0 = cvt_pk_bf16(o[8 * pr], o[8 * pr + 1]), p1 = cvt_pk_bf16(o[8 * pr + 2], o[8 * pr + 3]), q0 = cvt_pk_bf16(o[8 * pr + 4], o[8 * pr + 5]), q1 = cvt_pk_bf16(o[8 * pr + 6], o[8 * pr + 7]);
    const auto r0 = __builtin_amdgcn_permlane32_swap(p0, q0, false, false); const auto r1 = __builtin_amdgcn_permlane32_swap(p1, q1, false, false);
    return (u32x4){r0[0], r1[0], r0[1], r1[1]};
}
__device__ __forceinline__ u32x2 ot_pack8_f8(const f32x16& o, int pr) {
    const unsigned p = pk4_fp8(o[8 * pr], o[8 * pr + 1], o[8 * pr + 2], o[8 * pr + 3]), q = pk4_fp8(o[8 * pr + 4], o[8 * pr + 5], o[8 * pr + 6], o[8 * pr + 7]);
    const auto r0 = __builtin_amdgcn_permlane32_swap(p, q, false, false);
    return (u32x2){r0[0], r0[1]};
}
__device__ __forceinline__ void ot_add16(f32x16& o, int pr, u32x4 v, bool use) {
    const auto r0 = __builtin_amdgcn_permlane32_swap(v.x, v.z, false, false); const auto r1 = __builtin_amdgcn_permlane32_swap(v.y, v.w, false, false);
    const unsigned p0 = r0[0], p1 = r1[0], q0 = r0[1], q1 = r1[1];
    o[8 * pr] += use ? bflo(p0) : 0.f; o[8 * pr + 1] += use ? bfhi(p0) : 0.f; o[8 * pr + 2] += use ? bflo(p1) : 0.f; o[8 * pr + 3] += use ? bfhi(p1) : 0.f;
    o[8 * pr + 4] += use ? bflo(q0) : 0.f; o[8 * pr + 5] += use ? bfhi(q0) : 0.f; o[8 * pr + 6] += use ? bflo(q1) : 0.f; o[8 * pr + 7] += use ? bfhi(q1) : 0.f;
}
__device__ __forceinline__ void ot_add8_f8(f32x16& o, int pr, u32x2 v, bool use, float sc) {
    const auto r0 = __builtin_amdgcn_permlane32_swap(v.x, v.y, false, false); const int p = (int)r0[0], q = (int)r0[1];
    o[8 * pr] += use ? __builtin_amdgcn_cvt_f32_fp8(p, 0) * sc : 0.f; o[8 * pr + 1] += use ? __builtin_amdgcn_cvt_f32_fp8(p, 1) * sc : 0.f; o[8 * pr + 2] += use ? __builtin_amdgcn_cvt_f32_fp8(p, 2) * sc : 0.f; o[8 * pr + 3] += use ? __builtin_amdgcn_cvt_f32_fp8(p, 3) * sc : 0.f;
    o[8 * pr + 4] += use ? __builtin_amdgcn_cvt_f32_fp8(q, 0) * sc : 0.f; o[8 * pr + 5] += use ? __builtin_amdgcn_cvt_f32_fp8(q, 1) * sc : 0.f; o[8 * pr + 6] += use ? __builtin_amdgcn_cvt_f32_fp8(q, 2) * sc : 0.f; o[8 * pr + 7] += use ? __builtin_amdgcn_cvt_f32_fp8(q, 3) * sc : 0.f;
}
__device__ __forceinline__ u32x4 ot_pack16_f8(const f32x16& o) {
    const unsigned a = pk4_fp8(o[0], o[1], o[2], o[3]), b = pk4_fp8(o[4], o[5], o[6], o[7]), c = pk4_fp8(o[8], o[9], o[10], o[11]), d = pk4_fp8(o[12], o[13], o[14], o[15]);
    const auto r0 = __builtin_amdgcn_permlane32_swap(a, c, false, false); const auto r1 = __builtin_amdgcn_permlane32_swap(b, d, false, false);
    return (u32x4){r0[0], r0[1], r1[0], r1[1]};
}
__device__ __forceinline__ void ot_add16_f8(f32x16& o, u32x4 v, bool use, float sc) {
    const auto r0 = __builtin_amdgcn_permlane32_swap(v.x, v.y, false, false); const auto r1 = __builtin_amdgcn_permlane32_swap(v.z, v.w, false, false);
    const int a = (int)r0[0], c = (int)r0[1], b = (int)r1[0], d = (int)r1[1];
#pragma unroll
    for (int e = 0; e < 4; ++e) { float fa, fb, fc, fd;
        switch (e) { case 0: fa = __builtin_amdgcn_cvt_f32_fp8(a, 0); fb = __builtin_amdgcn_cvt_f32_fp8(b, 0); fc = __builtin_amdgcn_cvt_f32_fp8(c, 0); fd = __builtin_amdgcn_cvt_f32_fp8(d, 0); break;
                     case 1: fa = __builtin_amdgcn_cvt_f32_fp8(a, 1); fb = __builtin_amdgcn_cvt_f32_fp8(b, 1); fc = __builtin_amdgcn_cvt_f32_fp8(c, 1); fd = __builtin_amdgcn_cvt_f32_fp8(d, 1); break;
                     case 2: fa = __builtin_amdgcn_cvt_f32_fp8(a, 2); fb = __builtin_amdgcn_cvt_f32_fp8(b, 2); fc = __builtin_amdgcn_cvt_f32_fp8(c, 2); fd = __builtin_amdgcn_cvt_f32_fp8(d, 2); break;
                     default: fa = __builtin_amdgcn_cvt_f32_fp8(a, 3); fb = __builtin_amdgcn_cvt_f32_fp8(b, 3); fc = __builtin_amdgcn_cvt_f32_fp8(c, 3); fd = __builtin_amdgcn_cvt_f32_fp8(d, 3); break; }
        o[e] += use ? fa * sc : 0.f; o[4 + e] += use ? fb * sc : 0.f; o[8 + e] += use ? fc * sc : 0.f; o[12 + e] += use ? fd * sc : 0.f; }
}
__device__ __forceinline__ void attn_fill_tab(Frame& F, LAS float* TAB) {
    const float* rb = F.in[16];
    for (int idx = F.tid; idx < 8 * 132; idx += NTHR) { const int h = idx / 132, d = idx % 132; float v = 0.f;
        if (d < 128) v = rb[h * 32 + t5_bucket(d)] * LOG2E; else if (d == 129) v = rb[h * 32 + 31] * LOG2E;
        TAB[idx] = v; }
}
constexpr int BGPRE_OFF = ROWTAB_OFF, BGCL_OFF = ROWTAB_OFF + 8448, BTAB_OFF = ROWTAB_OFF + 16640, BIT_OFF = ROWTAB_OFF + 20992, BIT_MAX = 512, OTAB_OFF = ROWTAB_OFF + 20480  ;
static_assert(BTAB_OFF + 8 * 132 * 4 <= MOE_TST_OFF, "attention LDS tables");
__device__ __forceinline__ size_t part_off(int slot) { return slot == 0 ? WS_PART0 : (slot == 1 ? WS_PART1 : WS_PART2); }

__device__ __forceinline__ void attn_block_phase(Frame& F) {
    LAS unsigned char* L = F.lds; LAS int* GPRE = (LAS int*)(L + BGPRE_OFF); LAS int* GCL = (LAS int*)(L + BGCL_OFF); LAS float* TAB = (LAS float*)(L + BTAB_OFF); LAS int* ITT = (LAS int*)(L + BIT_OFF); LAS int* WSUM = (LAS int*)(L + MOE_TST_OFF);
    const unsigned* GC = (const unsigned*)(F.ctl + CW_GCNT); const unsigned* SEGC = (const unsigned*)(F.ws + WS_SEGC);
    const int tid = F.tid, lane = F.lane, w = F.wave, j = lane & 31, hi = lane >> 5, lane8 = lane * 8;
    { int ng[4], tot = 0;
#pragma unroll
      for (int e = 0; e < 4; ++e) { const int c = (int)GC[4 * tid + e]; GCL[4 * tid + e] = c; ng[e] = (((c + 31) >> 5) + 7) >> 3; tot += ng[e]; }
      int inc = tot;
#pragma unroll
      for (int o = 1; o < 64; o <<= 1) { const int t = __shfl_up(inc, o); if (lane >= o) inc += t; }
      if (lane == 63) WSUM[w] = inc;
      __syncthreads();
      int woff = 0;
      for (int q = 0; q < w; ++q) woff += WSUM[q];
      int ex = woff + inc - tot;
#pragma unroll
      for (int e = 0; e < 4; ++e) { GPRE[4 * tid + e] = ex; ex += ng[e]; }
      if (tid == NTHR - 1) GPRE[2048] = ex; }
    attn_fill_tab(F, TAB);
    __syncthreads();
    const int NIT = GPRE[2048];
    const int nk = (NIT > F.vcu) ? (NIT - F.vcu + F.G - 1) / F.G : 0;
    if (tid < nk && tid < BIT_MAX) { const int it_ = F.vcu + tid * F.G; int lo_ = 0, hi_ = 2048; while (hi_ - lo_ > 1) { const int mid_ = (lo_ + hi_) >> 1; if (GPRE[mid_] <= it_) lo_ = mid_; else hi_ = mid_; } ITT[tid] = lo_ * 64 + (it_ - GPRE[lo_]); }
    __syncthreads();
    if (nk == 0) return;
    const int nkc = nk < BIT_MAX ? nk : BIT_MAX;
    const bf16_t* Qb = (const bf16_t*)(F.ws + WS_Q); const float* MQg = (const float*)(F.ws + WS_MQ); const unsigned short* QL = (const unsigned short*)(F.ws + WS_QLIST);
    const bf16_t* KF = (const bf16_t*)(F.ws + WS_KFRAG); const bf16_t* VF = (const bf16_t*)(F.ws + WS_VFRAG);
    float* PL = (float*)(F.ws + WS_PL);
#define BLK_ITEM(k_, pi_, g_) do { const int kk_ = (k_) < nkc ? (k_) : nkc - 1; const int v_ = __builtin_amdgcn_readfirstlane(ITT[kk_]); pi_ = v_ >> 6; g_ = v_ & 63; } while (0)
#define BLK_DMA2(buf_, pi_, i0_) do { const char* ks_ = (const char*)KF + ((size_t)(pi_) * 2048 + tid) * 16; const char* vs_ = (const char*)VF + ((size_t)(pi_) * 2048 + tid) * 16; \
        _Pragma("unroll") for (int i_ = (i0_); i_ < (i0_) + 2; ++i_) { \
            __builtin_amdgcn_global_load_lds((const unsigned*)(ks_ + i_ * 8192), (LAS unsigned*)(L + (buf_) + (i_ * 512 + w * 64) * 16), 16, 0, 0); \
            __builtin_amdgcn_global_load_lds((const unsigned*)(vs_ + i_ * 8192), (LAS unsigned*)(L + (buf_) + 32768 + (i_ * 512 + w * 64) * 16), 16, 0, 0); } } while (0)
#define BLK_DMA(buf_, pi_) do { const char* ks_ = (const char*)KF + ((size_t)(pi_) * 2048 + tid) * 16; const char* vs_ = (const char*)VF + ((size_t)(pi_) * 2048 + tid) * 16; \
        _Pragma("unroll") for (int i_ = 0; i_ < 4; ++i_) { \
            __builtin_amdgcn_global_load_lds((const unsigned*)(ks_ + i_ * 8192), (LAS unsigned*)(L + (buf_) + (i_ * 512 + w * 64) * 16), 16, 0, 0); \
            __builtin_amdgcn_global_load_lds((const unsigned*)(vs_ + i_ * 8192), (LAS unsigned*)(L + (buf_) + 32768 + (i_ * 512 + w * 64) * 16), 16, 0, 0); } } while (0)
#define BLK_SEGC(dst_, pi_) do { dst_ = SEGC[(size_t)(pi_) * 32 + j]; } while (0)
#define BLK_ENTRY(dst_, segc_, pi_, g_) do { const int n_ = (pi_) & 31; int inc_ = (j < 31 - n_) ? (int)(segc_) : 0; \
        inc_ = prefix32_dpp(inc_); \
        const int cnt_ = GCL[pi_]; const int base_ = 32 * (8 * (g_) + w); const int idx_ = base_ + j; const bool vs_ = j < 31 - n_; \
          \
        const unsigned lb_ = (unsigned)__ballot(vs_ && inc_ <= base_); const int seg0_ = __builtin_popcount(lb_); \
        int seg_ = seg0_, prev_ = seg0_ > 0 ? __builtin_amdgcn_readlane(inc_, seg0_ - 1) : 0; \
        unsigned wm_ = (unsigned)__ballot(vs_ && inc_ > base_ && inc_ <= base_ + 31); \
        while (wm_ != 0u) { const int s_ = __builtin_ctz(wm_); wm_ &= wm_ - 1u; const int p_ = __builtin_amdgcn_readlane(inc_, s_); const bool le_ = p_ <= idx_; seg_ += le_ ? 1 : 0; prev_ = le_ ? p_ : prev_; } \
        const bool ok_ = idx_ < cnt_; const unsigned v_ = QL[(size_t)(pi_) * SEQ + (ok_ ? seg_ * 256 + (idx_ - prev_) : 0)]; dst_ = ok_ ? v_ : 0xFFFFu; } while (0)
#define BLK_QLOAD(qf_, m2_, ent_, pi_) do { const unsigned qq_ = ((ent_) == 0xFFFFu) ? 0u : ((ent_) >> 2); const int bh_ = (pi_) >> 5; \
        const bf16_t* qrow_ = Qb + ((size_t)(bh_ >> 3) * SEQ + qq_) * DA + (bh_ & 7) * HD + 8 * hi; \
        _Pragma("unroll") for (int ds_ = 0; ds_ < 4; ++ds_) qf_[ds_] = *(const bf16x8*)(qrow_ + 16 * ds_); \
        m2_ = MQg[(size_t)bh_ * SEQ + qq_]; } while (0)
    int pi, g, pi1, g1, pi2, g2; unsigned ent, ent1, sc2; bf16x8 qf[4]; float m2r;
    BLK_ITEM(0, pi, g); BLK_ITEM(1, pi1, g1); BLK_ITEM(2, pi2, g2);
    BLK_DMA(0, pi);
    { unsigned sc0, sc1; BLK_SEGC(sc0, pi); BLK_SEGC(sc1, pi1); BLK_SEGC(sc2, pi2); BLK_ENTRY(ent, sc0, pi, g); BLK_ENTRY(ent1, sc1, pi1, g1); }
    BLK_QLOAD(qf, m2r, ent, pi);
    int cur = 0;
#ifdef PROBE_TW
    unsigned tw_acc_ = 0u; const unsigned long long tt0_ = __builtin_amdgcn_s_memrealtime();
#endif
    __builtin_amdgcn_s_waitcnt(0x0F70);
    unsigned char* dump = F.ws + WS_E + ((size_t)F.vcu * NTHR + tid) * 128;
    for (int k = 0; k < nkc; ++k) {
#ifdef PROBE_TW
        const unsigned long long tw0_ = __builtin_amdgcn_s_memrealtime();
#endif
        __builtin_amdgcn_s_waitcnt(0x0F73);
        __syncthreads();
#ifdef PROBE_TW
        tw_acc_ += (unsigned)(__builtin_amdgcn_s_memrealtime() - tw0_);
#endif
        int pi3, g3; unsigned sc3, ent2; bf16x8 qfn[4]; float m2n;
        BLK_ITEM(k + 3, pi3, g3);
#define BLK_HOOK(st_) do { if ((st_) == 0) { BLK_DMA2((cur ^ 1) * 65536, pi1, 0); } else if ((st_) == 2) { BLK_DMA2((cur ^ 1) * 65536, pi1, 2); } } while (0)
        BLK_SEGC(sc3, pi3);
        BLK_ENTRY(ent2, sc2, pi2, g2);
        BLK_QLOAD(qfn, m2n, ent1, pi1);
        const int bh = pi >> 5, n = pi & 31, h = bh & 7;
        const bool valid = ent != 0xFFFFu; const int q = valid ? (int)(ent >> 2) : 0; const int slot = (int)(ent & 3u);
        const bool active = __builtin_amdgcn_readfirstlane((int)(__ballot(valid) != 0ull)) != 0;
        f32x16 o0 = {}, o1 = {}; float lsum = 0.f;
        if (active) {
            const float m2 = valid ? m2r : INFINITY;
            const LAS bf16_t* KP = (const LAS bf16_t*)(L + cur * 65536); const LAS bf16_t* VP = (const LAS bf16_t*)(L + cur * 65536 + 32768);
            const LAS float* TABh = TAB + h * 132; const LAS float* BTD = nullptr; (void)BTD;
            const int dq = q - 256 * n;
            const bool nearw = __builtin_amdgcn_readfirstlane((int)(__ballot(valid && dq < 383) != 0ull)) != 0;
            const float ci = nearw ? -m2 : TABh[129] - m2;
            f32x16 cinit;
#pragma unroll
            for (int r = 0; r < 16; ++r) cinit[r] = ci;
            if (nearw) { ATTN_TILE8(KP, VP, 1, cinit, BLK_HOOK); }
            else { ATTN_TILE8(KP, VP, 0, cinit, BLK_HOOK); }
        } else { BLK_HOOK(0); BLK_HOOK(2); }
#undef BLK_HOOK
        { const float lt = sum_xor32(lsum);
          const size_t qi = (size_t)bh * SEQ + q;
          float* pld = valid ? PL + (size_t)slot * (NH * BATCH * SEQ) + qi : (float*)(dump + 120);
          unsigned char* dst = valid ? F.ws + part_off(slot) + qi * HD + 16 * hi : dump;
          *pld = lt;
          const float inv = lt > 0.f ? 1.f / lt : 0.f;
#pragma unroll
          for (int r = 0; r < 16; ++r) { o0[r] *= inv; o1[r] *= inv; }
          *(u32x4*)(dst) = ot_pack16_f8(o0); *(u32x4*)(dst + 32) = ot_pack16_f8(o1); }
        pi = pi1; g = g1; ent = ent1; m2r = m2n; pi1 = pi2; g1 = g2; ent1 = ent2; pi2 = pi3; g2 = g3; sc2 = sc3; cur ^= 1;
#pragma unroll
        for (int ds = 0; ds < 4; ++ds) qf[ds] = qfn[ds];
    }
#ifdef PROBE_TW
    if (F.wave == PROBE_TW_WAVE && lane == 0) { __hip_atomic_fetch_add((unsigned*)(F.ctl + 3), tw_acc_, __ATOMIC_RELAXED, __HIP_MEMORY_SCOPE_AGENT); __hip_atomic_fetch_add((unsigned*)(F.ctl + 4), (unsigned)(__builtin_amdgcn_s_memrealtime() - tt0_), __ATOMIC_RELAXED, __HIP_MEMORY_SCOPE_AGENT); }
#endif
    VM_WAIT(); __syncthreads();
#undef BLK_ITEM
#undef BLK_DMA
#undef BLK_DMA2
#undef BLK_SEGC
#undef BLK_ENTRY
#undef BLK_QLOAD
}

__device__ __forceinline__ void attn_own_phase(Frame& F) {
    LAS unsigned char* L = F.lds; LAS float* TAB = (LAS float*)(L + OTAB_OFF); LAS float* BT = (LAS float*)(L + ROWTAB_OFF); int bth = -1;
    attn_fill_tab(F, TAB);
    const int tid = F.tid, lane = F.lane, wv = F.wave, j = lane & 31, hi = lane >> 5, lane8 = lane * 8;
    const int w = (wv < 4) ? wv : 11 - wv;
    const bf16_t* Qb = (const bf16_t*)(F.ws + WS_Q); const float* MQg = (const float*)(F.ws + WS_MQ);
    const bf16_t* KF = (const bf16_t*)(F.ws + WS_KFRAG); const bf16_t* VF = (const bf16_t*)(F.ws + WS_VFRAG);
    const float* PL = (const float*)(F.ws + WS_PL); unsigned char* YA = F.ws + WS_YATT;
    const int NU = BATCH * NH * NBLK;
#define OWN_DMA(buf_, pi_) do { const char* ks_ = (const char*)KF + ((size_t)(pi_) * 2048 + tid) * 16; const char* vs_ = (const char*)VF + ((size_t)(pi_) * 2048 + tid) * 16; \
        _Pragma("unroll") for (int i_ = 0; i_ < 4; ++i_) { \
            __builtin_amdgcn_global_load_lds((const unsigned*)(ks_ + i_ * 8192), (LAS unsigned*)(L + (buf_) + (i_ * 512 + wv * 64) * 16), 16, 0, 0); \
            __builtin_amdgcn_global_load_lds((const unsigned*)(vs_ + i_ * 8192), (LAS unsigned*)(L + (buf_) + 32768 + (i_ * 512 + wv * 64) * 16), 16, 0, 0); } } while (0)
#define OWN_DMA_LIGHT(buf_, pi_) do { const char* ks_ = (const char*)KF + ((size_t)(pi_) * 2048 + tid) * 16; const char* vs_ = (const char*)VF + ((size_t)(pi_) * 2048 + tid) * 16; \
        _Pragma("unroll") for (int i_ = 0; i_ < 8; ++i_) { \
            __builtin_amdgcn_global_load_lds((const unsigned*)(ks_ + i_ * 4096), (LAS unsigned*)(L + (buf_) + (i_ * 256 + wv * 64) * 16), 16, 0, 0); \
            __builtin_amdgcn_global_load_lds((const unsigned*)(vs_ + i_ * 4096), (LAS unsigned*)(L + (buf_) + 32768 + (i_ * 256 + wv * 64) * 16), 16, 0, 0); } } while (0)
#define OWN_QLOAD(qf_, m2_, u_) do { const int bh_ = (u_) >> 5, qb_ = (u_) & 31; const size_t tk_ = (size_t)256 * qb_ + 32 * w + j; \
        const bf16_t* qrow_ = Qb + ((size_t)(bh_ >> 3) * SEQ + tk_) * DA + (bh_ & 7) * HD + 8 * hi; \
        _Pragma("unroll") for (int ds_ = 0; ds_ < 4; ++ds_) qf_[ds_] = *(const bf16x8*)(qrow_ + 16 * ds_); \
        m2_ = MQg[(size_t)bh_ * SEQ + tk_]; } while (0)
    int u = F.vcu; if (u >= NU) return;
    bf16x8 qf[4]; float m2;
    OWN_DMA(0, u); OWN_QLOAD(qf, m2, u);
    int cur = 0;
    __builtin_amdgcn_s_waitcnt(0x0F70);
    for (;;) {
        __builtin_amdgcn_s_waitcnt(0x0F72); __syncthreads();
        const int un = (u + F.G < NU) ? u + F.G : u; const bool last = (un == u);
        const int bh = u >> 5, qb = u & 31, b = bh >> 3, h = bh & 7; const int ql = 32 * w + j; const size_t qi = (size_t)bh * SEQ + 256 * qb + ql;
        u32x4 pa[3][2]; float pl[3]; bf16x8 qfn[4]; float m2n;
#define OWN_PA() do { _Pragma("unroll") for (int s = 0; s < 3; ++s) { const unsigned char* src = F.ws + part_off(s) + qi * HD + 16 * hi; \
            _Pragma("unroll") for (int c = 0; c < 2; ++c) pa[s][c] = *(const u32x4*)(src + 32 * c); } } while (0)
#define OWN_PL() do { _Pragma("unroll") for (int s = 0; s < 3; ++s) pl[s] = PL[(size_t)s * (NH * BATCH * SEQ) + qi]; } while (0)
        const LAS bf16_t* KP = (const LAS bf16_t*)(L + cur * 65536); const LAS bf16_t* VP = (const LAS bf16_t*)(L + cur * 65536 + 32768); const LAS float* TABh = TAB + h * 132;
        if (h != bth) { __syncthreads();
            for (int e = tid; e < 5 * 1024; e += NTHR) { const int i = e & 3, ln = (e >> 2) & 63, rq = (e >> 8) & 3, dl = e >> 10; const int dist = 32 * dl + (ln & 31) - crow(4 * rq + i, ln >> 5);
                BT[e] = dist < 0 ? -1e30f : TABh[dist > 127 ? 127 : dist]; }
            bth = h; __syncthreads(); }
        const int dq = ql; (void)dq;
        f32x16 cnear; float cf_ = TABh[129] - m2;
#pragma unroll
        for (int r = 0; r < 16; ++r) cnear[r] = -m2;
#define OWN_SPLATF() ({ float t_ = cf_; asm volatile("" : "+v"(t_)); f32x16 c_; _Pragma("unroll") for (int r_ = 0; r_ < 16; ++r_) c_[r_] = t_; c_; })
        f32x16 o0 = {}, o1 = {}; float lsum = 0.f;
        { bf16x8 kA_[4], vA_[4], kB_[4], vB_[4]; ATTN_LOADF(kA_, vA_, KP, VP, 0);
          for (int st = 0; st <= w; st += 2) { const int s1 = st + 1 <= w ? st + 1 : w, s2 = st + 2 <= w ? st + 2 : w;
              ATTN_LOADF(kB_, vB_, KP, VP, s1); ATTN_SBAR;
              { const int dl = w - st; if (dl >= 5) { const LAS float* BTD = nullptr; (void)BTD; ATTN_COMPUTE(kA_, vA_, st, 0, OWN_SPLATF()); } else { const LAS float* BTD = BT + dl * 1024; ATTN_COMPUTE(kA_, vA_, st, 2, cnear); } }
              if (w >= 4 && st == 0) OWN_PA();
              ATTN_LOADF(kA_, vA_, KP, VP, s2); ATTN_SBAR;
              if (st + 1 <= w) { const int dl = w - st - 1; if (dl >= 5) { const LAS float* BTD = nullptr; (void)BTD; ATTN_COMPUTE(kB_, vB_, st + 1, 0, OWN_SPLATF()); } else { const LAS float* BTD = BT + dl * 1024; ATTN_COMPUTE(kB_, vB_, st + 1, 2, cnear); } }
              if (w >= 4 && st == 2) { OWN_PL(); OWN_QLOAD(qfn, m2n, un); } } }
        if (w < 4) { OWN_PA(); OWN_PL(); OWN_DMA_LIGHT((cur ^ 1) * 65536, un); OWN_QLOAD(qfn, m2n, un); }
        float lt = sum_xor32(lsum);
        const int nsel = qb < 3 ? qb : 3;
#pragma unroll
        for (int s = 0; s < 3; ++s) { const bool use = s < nsel; lt += use ? pl[s] : 0.f;
            ot_add16_f8(o0, pa[s][0], use, pl[s]); ot_add16_f8(o1, pa[s][1], use, pl[s]); }
        const float inv = 1.f / lt;
#pragma unroll
        for (int r = 0; r < 16; ++r) { o0[r] *= inv; o1[r] *= inv; }
        unsigned char* dst = YA + ((size_t)b * SEQ + 256 * qb + ql) * DA + h * HD + 16 * hi;
        *(u32x4*)(dst) = ot_pack16_f8(o0); *(u32x4*)(dst + 32) = ot_pack16_f8(o1);
        if (last) break;
        u = un; m2 = m2n; cur ^= 1;
#pragma unroll
        for (int ds = 0; ds < 4; ++ds) qf[ds] = qfn[ds];
    }
    VM_WAIT(); __syncthreads();
#undef OWN_DMA
#undef OWN_SPLATF
#undef OWN_DMA_LIGHT
#undef OWN_PA
#undef OWN_PL
#undef OWN_QLOAD
}
#undef ATTN_LOADF
#undef ATTN_COMPUTE
#undef ATTN_TILE8
#undef ATTN_SBAR

__device__ __forceinline__ void routing_phase(Frame& F) {
    LAS int* lcnt = (LAS int*)(F.lds); LAS int* lbase = lcnt + 32;
    const float* SSQ = (const float*)(F.ws + WS_SSQ); const float* RL = (const float*)(F.ws + WS_RLOG);
    unsigned* rowtok = (unsigned*)(F.ws + WS_ROWTOK); float* rowcoef = (float*)(F.ws + WS_ROWCOEF); float* rowrstd = (float*)(F.ws + WS_ROWRSTD);
    unsigned* ecnt = (unsigned*)(F.ctl + CW_ECNT);
    const float* brg = F.in[20]; const float* bre = F.in[22];
    const int tid = F.tid;
    for (int base = F.vcu * 256; base < T; base += F.G * 256) {
        if (tid < 32) lcnt[tid] = 0;
        __syncthreads();
        int e0 = 0, e1 = 0, lp0 = 0, lp1 = 0; float c0 = 0.f, c1 = 0.f, rstd = 0.f; const int tok = base + tid;
        if (tid < 256) {
            float ss = 0.f;
#pragma unroll
            for (int q = 0; q < 4; ++q) { const f32x4 v = *(const f32x4*)(SSQ + (size_t)tok * 16 + 4 * q); ss += (v.x + v.y) + (v.z + v.w); }
            rstd = 1.f / sqrtf(ss * (1.f / D) + RMS_EPS);
            float r[72];
#pragma unroll
            for (int q = 0; q < 18; ++q) { const f32x4 v = *(const f32x4*)(RL + (size_t)tok * 72 + 4 * q); r[4 * q] = v.x; r[4 * q + 1] = v.y; r[4 * q + 2] = v.z; r[4 * q + 3] = v.w; }
            float gl[4], el[32];
#pragma unroll
            for (int c = 0; c < 4; ++c) gl[c] = rstd * (r[c] + r[36 + c]) + brg[c];
#pragma unroll
            for (int c = 0; c < 32; ++c) el[c] = rstd * (r[4 + c] + r[40 + c]) + bre[c];
            int gi = 0; float gm = gl[0];
#pragma unroll
            for (int c = 1; c < 4; ++c) if (gl[c] > gm) { gm = gl[c]; gi = c; }
            float Z = 0.f;
#pragma unroll
            for (int c = 0; c < 4; ++c) Z += __expf(gl[c] - gm);
            const float gval = 1.f / Z;
            float es[8];
#pragma unroll
            for (int q = 0; q < 8; ++q) es[q] = gi == 0 ? el[q] : (gi == 1 ? el[8 + q] : (gi == 2 ? el[16 + q] : el[24 + q]));
            int a0 = 0; float m0 = es[0];
#pragma unroll
            for (int q = 1; q < 8; ++q) if (es[q] > m0) { m0 = es[q]; a0 = q; }
            int a1 = -1; float m1 = -INFINITY;
#pragma unroll
            for (int q = 0; q < 8; ++q) if (q != a0 && es[q] > m1) { m1 = es[q]; a1 = q; }
            const float w0 = 1.f / (1.f + __expf(m1 - m0)), w1 = 1.f - w0;
            e0 = gi * 8 + a0; e1 = gi * 8 + a1; c0 = gval * w0; c1 = gval * w1;
            lp0 = __hip_atomic_fetch_add(lcnt + e0, 1, __ATOMIC_RELAXED, __HIP_MEMORY_SCOPE_WORKGROUP);
            lp1 = __hip_atomic_fetch_add(lcnt + e1, 1, __ATOMIC_RELAXED, __HIP_MEMORY_SCOPE_WORKGROUP);
        }
        __syncthreads();
        if (tid < 32) lbase[tid] = (int)__hip_atomic_fetch_add(ecnt + tid, (unsigned)lcnt[tid], __ATOMIC_RELAXED, __HIP_MEMORY_SCOPE_AGENT);
        __syncthreads();
        if (tid < 256) {
            const size_t i0 = (size_t)e0 * ROWCAP + lbase[e0] + lp0, i1 = (size_t)e1 * ROWCAP + lbase[e1] + lp1;
            rowtok[i0] = (unsigned)tok * 2u; rowcoef[i0] = c0; rowrstd[i0] = rstd;
            rowtok[i1] = (unsigned)tok * 2u + 1u; rowcoef[i1] = c1; rowrstd[i1] = rstd;
        }
        __syncthreads();
    }
}
struct MoeOrder {
    const LAS int* tst; int total, G, v; bool blocked;
    __device__ bool next(int i, pg8::Unit& u) const {
        int L;
        if (blocked) { const int b0 = (int)(((long)v * total) / G), b1 = (int)(((long)(v + 1) * total) / G); L = b0 + i; if (L >= b1) return false; }
        else { L = i * G + v; if (L >= total) return false; }
        const int rt = L >> 2; int e = 0;
#pragma unroll 8
        for (int q = 1; q <= 32; ++q) e += (tst[q] <= rt) ? 1 : 0;
        u.pm = rt; u.pn = L & 3; u.pb = e * 4 + u.pn; u.aux = e; u.aux2 = (rt - tst[e]) * 256; u.aux3 = tst[64 + e]; return true;
    }
};
__device__ __forceinline__ void moe_tables(Frame& F) {
    LAS int* tst = (LAS int*)(F.lds + MOE_TST_OFF); const unsigned* ecnt = (const unsigned*)(F.ctl + CW_ECNT);
    if (F.wave == 0) { const int lane = F.lane; int nt = lane < 32 ? (int)((ecnt[lane & 31] + 255u) >> 8) : 0; int inc = nt;
#pragma unroll
        for (int o = 1; o < 32; o <<= 1) { const int t = __shfl_up(inc, o); if (lane >= o) inc += t; }
        if (lane < 32) { tst[lane + 1] = inc; tst[64 + lane] = (int)ecnt[lane]; } if (lane == 0) tst[0] = 0; }
    __syncthreads();
}
#if defined(PROBE_TW) || defined(PROBE_BAR) || defined(PROBE_GEMM)
#define PROBE_SCALE * probe_sc_
#else
#define PROBE_SCALE
#endif
__device__ __forceinline__ void final_phase(Frame& F) {
#if defined(PROBE_TW) || defined(PROBE_BAR) || defined(PROBE_GEMM)
    #ifndef PROBE_Q
#define PROBE_Q 0
#endif
#ifndef PROBE_GAIN
#define PROBE_GAIN 0.25f
#endif
    float probe_f_ = (float)__hip_atomic_load((unsigned*)(F.ctl + 3), __ATOMIC_RELAXED, __HIP_MEMORY_SCOPE_AGENT) / (float)__hip_atomic_load((unsigned*)(F.ctl + 4), __ATOMIC_RELAXED, __HIP_MEMORY_SCOPE_AGENT);
    if (PROBE_Q > 0) probe_f_ = floorf(probe_f_ * (float)PROBE_Q + 0.5f) / (float)PROBE_Q;
    const float probe_sc_ = 1.f + PROBE_GAIN * probe_f_;
#endif
#ifdef SELFCHECK
    const bool chk_bad = __hip_atomic_load((unsigned*)(F.ctl + 2), __ATOMIC_RELAXED, __HIP_MEMORY_SCOPE_AGENT) != 0u;
#endif
    const bf16_t* X1 = (const bf16_t*)(F.ws + WS_X1); const unsigned char* Y0 = F.ws + WS_Y0; const unsigned char* Y1 = F.ws + WS_Y1; const float* gf = F.in[26];
    const int gw = F.vcu * NWAVES + F.wave, NGW = F.G * NWAVES, lane = F.lane;
    f32x4 gv[4];
#pragma unroll
    for (int j = 0; j < 4; ++j) gv[j] = ((const f32x4*)gf)[lane + 64 * j];
    constexpr int FR = 4;
    for (int m0 = gw; m0 < T; m0 += NGW * FR) {
        u32x2 xx[FR][4]; unsigned ya[FR][4], yb[FR][4];
#pragma unroll
        for (int r = 0; r < FR; ++r) { const size_t m = (size_t)m0 + (size_t)r * NGW; const u32x2* xr = (const u32x2*)(X1 + m * D) + lane; const unsigned* y0 = (const unsigned*)(Y0 + m * D) + lane; const unsigned* y1 = (const unsigned*)(Y1 + m * D) + lane;
#pragma unroll
            for (int j = 0; j < 4; ++j) { xx[r][j] = xr[64 * j]; ya[r][j] = y0[64 * j]; yb[r][j] = y1[64 * j]; } }
        f32x4 v[FR][4]; float s[FR];
#pragma unroll
        for (int r = 0; r < FR; ++r) { float acc_ = 0.f;
#pragma unroll
            for (int j = 0; j < 4; ++j) { const int a = (int)ya[r][j], c = (int)yb[r][j]; constexpr float ys = 1.f / YF8_SCALE;
                v[r][j].x = bflo(xx[r][j].x) + (__builtin_amdgcn_cvt_f32_fp8(a, 0) + __builtin_amdgcn_cvt_f32_fp8(c, 0)) * ys; v[r][j].y = bfhi(xx[r][j].x) + (__builtin_amdgcn_cvt_f32_fp8(a, 1) + __builtin_amdgcn_cvt_f32_fp8(c, 1)) * ys;
                v[r][j].z = bflo(xx[r][j].y) + (__builtin_amdgcn_cvt_f32_fp8(a, 2) + __builtin_amdgcn_cvt_f32_fp8(c, 2)) * ys; v[r][j].w = bfhi(xx[r][j].y) + (__builtin_amdgcn_cvt_f32_fp8(a, 3) + __builtin_amdgcn_cvt_f32_fp8(c, 3)) * ys;
                acc_ += (v[r][j].x * v[r][j].x + v[r][j].y * v[r][j].y) + (v[r][j].z * v[r][j].z + v[r][j].w * v[r][j].w); }
            s[r] = acc_; }
#pragma unroll
        for (int r = 0; r < FR; ++r) { const float rstd = 1.f / sqrtf(wave_sum(s[r]) * (1.f / D) + RMS_EPS); f32x4* o = (f32x4*)(F.out + ((size_t)m0 + (size_t)r * NGW) * D) + lane;
#ifdef SELFCHECK
            if (chk_bad) { for (int j = 0; j < 4; ++j) o[64 * j] = (f32x4){0.f, 0.f, 0.f, 0.f}; continue; }
#endif
#pragma unroll
            for (int j = 0; j < 4; ++j) o[64 * j] = v[r][j] * rstd * gv[j] PROBE_SCALE; }
    }
}
#ifdef SELFCHECK
constexpr int CW_CHK = 2;
__device__ __forceinline__ int t5_bucket_ref(int n) { if (n < 16) return n; const int l = 16 + (int)(logf((float)n / 16.f) / logf(8.f) * 16.f); return l < 31 ? l : 31; }
__device__ __forceinline__ float kfrag_at(const bf16_t* KF, int bh, int key, int d) { const int n = key >> 8, kl = key & 255, st = kl >> 5, i = kl & 31, ds = d >> 4, hi = (d >> 3) & 1, e = d & 7;
    return bf2f(KF[(((size_t)bh * 32 + n) * 2048 + (st * 4 + ds) * 64 + (i + 32 * hi)) * 8 + e]); }
__device__ __forceinline__ float vfrag_at(const bf16_t* VF, int bh, int key, int d) { const int n = key >> 8, kl = key & 255, st = kl >> 5, kk = kl & 31, ks = kk >> 4, k16 = kk & 15, hi = (k16 >> 2) & 1, e = (k16 & 3) + 4 * (k16 >> 3), d0 = d >> 5, jj = d & 31;
    return bf2f(VF[(((size_t)bh * 32 + n) * 2048 + ((st * 2 + ks) * 2 + d0) * 64 + (jj + 32 * hi)) * 8 + e]); }
__device__ __forceinline__ void selfcheck_phase(Frame& F, float tol_attn, float tol_ssm) {
    const int lane = lane_id(); const int gw = F.vcu * NWAVES + F.wave;
    const bf16_t* Qb = (const bf16_t*)(F.ws + WS_Q); const bf16_t* KM = (const bf16_t*)(F.ws + WS_KMEAN); const bf16_t* KF = (const bf16_t*)(F.ws + WS_KFRAG); const bf16_t* VF = (const bf16_t*)(F.ws + WS_VFRAG);
    const unsigned char* YA = F.ws + WS_YATT; const float* rb = F.in[16];
    bool bad = false;
    for (int sidx = 0; sidx < 12; ++sidx) {
        unsigned hsh = (unsigned)(gw * 12 + sidx) * 2654435761u; hsh ^= hsh >> 15; hsh *= 2246822519u; hsh ^= hsh >> 13;
        const int bh = (int)(hsh & 63u); int q = (int)((hsh >> 6) & 8191u);
        if (sidx == 0) q = q & 767; if (sidx == 1) q = (q & ~255) | (sidx & 1 ? 0 : 255); if (sidx == 2) q = (q & ~255) | 255; if (sidx == 3) q = (q & ~255) | 128;
        const int b = bh >> 3, h = bh & 7, qb = q >> 8, d = lane;
        const float qd = bf2f(Qb[((size_t)b * SEQ + q) * DA + h * HD + d]);
        int s0 = -1, s1 = -1, s2 = -1; float g0 = -INFINITY, g1 = -INFINITY, g2 = -INFINITY;
        for (int n = 0; n < qb; ++n) { const float gt = wave_sum(qd * bf2f(KM[((size_t)bh * 32 + n) * 64 + d]));
            if (gt > g0) { g2 = g1; s2 = s1; g1 = g0; s1 = s0; g0 = gt; s0 = n; } else if (gt > g1) { g2 = g1; s2 = s1; g1 = gt; s1 = n; } else if (gt > g2) { g2 = gt; s2 = n; } }
        float m = -INFINITY, l = 0.f, od = 0.f;
        for (int blk = 0; blk < 4; ++blk) { const int n = blk == 0 ? s0 : (blk == 1 ? s1 : (blk == 2 ? s2 : qb)); if (n < 0) continue;
            const int kend = (blk == 3) ? (q & 255) + 1 : 256;
            for (int kl = 0; kl < kend; ++kl) { const int key = 256 * n + kl; const float kd = kfrag_at(KF, bh, key, d);
                const float s = wave_sum(qd * kd) + rb[h * 32 + t5_bucket_ref(q - key)] * LOG2E;
                const float mn = fmaxf(m, s), sc = exp2f(m - mn), p = exp2f(s - mn); l = l * sc + p; od = od * sc + p * vfrag_at(VF, bh, key, d); m = mn; } }
        od /= l;
        const float yd = __builtin_amdgcn_cvt_f32_fp8((int)YA[((size_t)b * SEQ + q) * DA + h * HD + d], 0);
        const float e2 = wave_sum((od - yd) * (od - yd)), o2 = wave_sum(od * od);
        if (!(e2 <= tol_attn * tol_attn * o2)) bad = true;
    }
    { const bf16_t* UP = (const bf16_t*)(F.ws + WS_UP); const bf16_t* GA = (const bf16_t*)(F.ws + WS_GACT);
      for (int sidx = 0; sidx < 6; ++sidx) {
        unsigned hsh = (unsigned)(gw * 6 + sidx + 7777) * 2654435761u; hsh ^= hsh >> 15; hsh *= 2246822519u; hsh ^= hsh >> 13;
        const int g = (int)(hsh & 31u), b = (int)((hsh >> 5) & 7u); int t = (int)((hsh >> 8) % 330u); if (sidx == 0) t = 31 + (int)((hsh >> 20) & 3u) * 32; if (sidx == 1) t = 32 + (int)((hsh >> 20) & 7u) * 32;
        const int p = lane;
        const float lr = F.in[4][g * SP + p], li = F.in[5][g * SP + p], step = expf(F.in[6][g]);
        const float mag = expf(lr * step), ar = mag * cosf(li * step), ai = mag * sinf(li * step);
        const float nr = ar - 1.f, ni = ai, den = lr * lr + li * li, cr = (nr * lr + ni * li) / den, ci = (ni * lr - nr * li) / den;
        float hr = 0.f, hi_ = 0.f;
        for (int tt = 0; tt <= t; ++tt) { float br = 0.f, bi = 0.f;
            for (int c = 0; c < 16; ++c) { const float u = bf2f(UP[(size_t)g * SROWS * SKY + ((size_t)b * 256 + (tt >> 5)) * SKY + (tt & 31) * 16 + c]);
                const float b_r = F.in[7][(g * SP + p) * 16 + c], b_i = F.in[8][(g * SP + p) * 16 + c]; br += (cr * b_r - ci * b_i) * u; bi += (cr * b_i + ci * b_r) * u; }
            const float n_r = ar * hr - ai * hi_ + br, n_i = ar * hi_ + ai * hr + bi; hr = n_r; hi_ = n_i; }
        float e2 = 0.f, o2 = 0.f;
        for (int ho = 0; ho < 16; ++ho) { float y = wave_sum(hr * F.in[9][(g * 16 + ho) * SP + p] - hi_ * F.in[10][(g * 16 + ho) * SP + p]);
            const float u = bf2f(UP[(size_t)g * SROWS * SKY + ((size_t)b * 256 + (t >> 5)) * SKY + (t & 31) * 16 + ho]); y += F.in[11][g * 16 + ho] * u;
            const float ge = 0.5f * y * (1.f + tanhf(0.7978845608028654f * (y + 0.044715f * y * y * y)));
            const float gv = bf2f(GA[((size_t)b * SEQ + t) * DS + g * 16 + ho]); e2 += (ge - gv) * (ge - gv); o2 += ge * ge; }
        if (!(e2 <= tol_ssm * tol_ssm * o2 + 1e-6f)) bad = true;
      } }
    if (__ballot(bad) != 0ull && lane == 0) __hip_atomic_store((unsigned*)(F.ctl + CW_CHK), 1u, __ATOMIC_RELAXED, __HIP_MEMORY_SCOPE_AGENT);
}
#endif

#ifdef SELFCHECK
__device__ __forceinline__ void selfcheck_prep(Frame& F) {
    const int lane = lane_id(); const int gw = F.vcu * NWAVES + F.wave;
    const bf16_t* Kb = (const bf16_t*)(F.ws + WS_K); const bf16_t* Vb = (const bf16_t*)(F.ws + WS_V); const bf16_t* KF = (const bf16_t*)(F.ws + WS_KFRAG); const bf16_t* VF = (const bf16_t*)(F.ws + WS_VFRAG);
    const bf16_t* KM = (const bf16_t*)(F.ws + WS_KMEAN); const float* KN = (const float*)(F.ws + WS_KMEAN + 512 * 1024);
    bool bad = false;
    for (int sidx = 0; sidx < 64; ++sidx) {
        unsigned hsh = (unsigned)(gw * 64 + sidx + 12345) * 2654435761u; hsh ^= hsh >> 15; hsh *= 2246822519u; hsh ^= hsh >> 13;
        const int bh = (int)(hsh & 63u), key = (int)((hsh >> 6) & 8191u), b = bh >> 3, h = bh & 7, d = lane;
        const float k0 = bf2f(Kb[((size_t)b * SEQ + key) * DA + h * HD + d]), v0 = bf2f(Vb[((size_t)b * SEQ + key) * DA + h * HD + d]);
        if (kfrag_at(KF, bh, key, d) != k0 || vfrag_at(VF, bh, key, d) != v0) bad = true;
    }
    for (int sidx = 0; sidx < 2; ++sidx) {
        unsigned hsh = (unsigned)(gw * 2 + sidx + 999) * 2654435761u; hsh ^= hsh >> 15; hsh *= 2246822519u; hsh ^= hsh >> 13;
        const int item = (int)(hsh & 2047u), bh = item >> 5, n = item & 31, b = bh >> 3, h = bh & 7, d = lane; float sum = 0.f, mx = 0.f;
        for (int kl = 0; kl < 256; ++kl) { const float kv = bf2f(Kb[((size_t)b * SEQ + 256 * n + kl) * DA + h * HD + d]); sum += kv; mx = fmaxf(mx, wave_sum(kv * kv)); }
        const float mean = sum * (1.f / 256.f), got = bf2f(KM[(size_t)item * 64 + d]);
        if (fabsf(mean - got) > 0.01f * fabsf(mean) + 1e-3f) bad = true;
        if (fabsf(mx - KN[item]) > 1e-3f * mx) bad = true;
    }
    if (__ballot(bad) != 0ull && lane == 0) __hip_atomic_store((unsigned*)(F.ctl + CW_CHK), 1u, __ATOMIC_RELAXED, __HIP_MEMORY_SCOPE_AGENT);
}
#endif
#ifndef MK_N_LAUNCHES
#define MK_N_LAUNCHES 1
#endif
constexpr int NPHASE = 13;
struct Args { const float* in[27]; float* out; unsigned char* ws; int ph_lo, ph_hi; };
static_assert(sizeof(Args) == 27 * 8 + 8 + 8 + 8, "Args has no padding");

#ifndef PAIR_PHASES
#define PAIR_PHASES 1
#endif
#ifndef BLK_ORDER
#define BLK_ORDER 0
#endif
#ifndef STAG9
#define STAG9 0
#endif
#ifndef STAG8
#define STAG8 0
#endif
#ifndef DUP_MASK
#define DUP_MASK 0
#endif
#define PH_ARGS Frame& F, unsigned char* ws, LAS unsigned char* ring
__device__ __forceinline__ void ph1(PH_ARGS) {
#if U_FP8
    { pg8::Gemm g{(const bf16_t*)(ws + WS_H1F8), (const bf16_t*)(ws + WS_WINF8U), D / 2, D / 2, D / 2}; pg8::StaticOrder S; S.init(T, DS, F.G, (int)blockIdx.x);
      EpiProj<0> E{ws, F.in[3], 0, 1.f / WF8_SCALE};
      pg8::gemm_phase<EpiProj<0>, pg8::StaticOrder, true, false, true>(ring, g, S, E, nullptr, F.wave); }
#else
    { pg8::Gemm g{(const bf16_t*)(ws + WS_H1), (const bf16_t*)(ws + WS_WIN), D, D, D}; pg8::StaticOrder S; S.init(T, DS, F.G, (int)blockIdx.x);
      EpiProj<0> E{ws, F.in[3], 0, 1.f};
      pg8::gemm_phase<EpiProj<0>, pg8::StaticOrder, true, false>(ring, g, S, E, nullptr, F.wave); }
#endif
    { pg8::Gemm g{(const bf16_t*)(ws + WS_H1F8), (const bf16_t*)(ws + WS_WINF8), D / 2, D / 2, D / 2}; pg8::StaticOrder S; S.init(T, DIN - DS, F.G, (int)blockIdx.x);
      EpiProj<1> E{ws, F.in[3], 2, 1.f / WF8_SCALE};
      pg8::gemm_phase<EpiProj<1>, pg8::StaticOrder, true, false, true, false, 1>(ring, g, S, E, nullptr, F.wave, (unsigned*)F.ctl); }
}
__device__ __forceinline__ void ph2(PH_ARGS) {
    { pg8::Gemm g{(const bf16_t*)(ws + WS_UP), (const bf16_t*)(ws + WS_SSMW), SKY, SKU, SKU}; pg8::GroupedOrder S; S.init(SG * 8, 1, 8, F.G, F.vcu);
      EpiSsmE E{(float*)(ws + WS_E)};
      pg8::gemm_phase<EpiSsmE, pg8::GroupedOrder, false, false, false, true  >(ring, g, S, E, nullptr, F.wave); }
    VM_WAIT(); __syncthreads();
    ssm_scan_phase(F);
    kv_prep_phase(F);
}
__device__ __forceinline__ void ph4(PH_ARGS) {
    pg8::Gemm g{(const bf16_t*)(ws + WS_UP), (const bf16_t*)(ws + WS_SSMT), SKY, SKY, SKY}; pg8::GroupedOrder S; S.init(SG * 8, 2, 8, F.G, F.vcu);
    EpiSsmY E{(bf16_t*)(ws + WS_GACT)};
    pg8::gemm_phase<EpiSsmY, pg8::GroupedOrder, true, false, false, false, 0, true  >(ring, g, S, E, nullptr, F.wave);
}
__device__ __forceinline__ void ph5(PH_ARGS) {
    pg8::Gemm g{(const bf16_t*)(ws + WS_GACT), (const bf16_t*)(ws + WS_WGLU), DS, DS, DS}; pg8::StaticOrder S; S.init(T, DS, F.G, (int)blockIdx.x, (BLK_ORDER & 1) != 0);
    EpiGlu E{(const bf16_t*)(ws + WS_GACT), (bf16_t*)(ws + WS_YSSM), F.in[13]};
    pg8::gemm_phase<EpiGlu, pg8::StaticOrder, true, false>(ring, g, S, E, nullptr, F.wave);
}
__device__ __forceinline__ void ph6(PH_ARGS) {
    { pg8::Gemm g{(const bf16_t*)(ws + WS_YATT), (const bf16_t*)(ws + WS_WUA), DA / 2, DA / 2, DA / 2}; pg8::StaticOrder S; S.init(T, D, F.G, (int)blockIdx.x, (BLK_ORDER & 2) != 0);
      EpiUpA E{ws + WS_SGA, ws + WS_MA, MA_SCALE / WF8_SCALE};
      pg8::gemm_phase<EpiUpA, pg8::StaticOrder, true, false, true>(ring, g, S, E, nullptr, F.wave); }
    VM_WAIT(); __syncthreads();
    { constexpr int KS = UPS_FP8 ? DS / 2 : DS;
      pg8::Gemm g{(const bf16_t*)(ws + WS_YSSM), (const bf16_t*)(ws + WS_WUS), KS, KS, KS}; pg8::StaticOrder S; S.init(T, D, F.G, (int)blockIdx.x, (BLK_ORDER & 2) != 0);
      EpiUpS E{(const bf16_t*)(ws + WS_SGS), ws + WS_MA, (bf16_t*)(ws + WS_MRG), UPS_FP8 ? 1.f / (WF8_SCALE * YS_SCALE) : 1.f};
      pg8::gemm_phase<EpiUpS, pg8::StaticOrder, true, false, UPS_FP8 != 0>(ring, g, S, E, nullptr, F.wave); }
}
__device__ __forceinline__ void ph7(PH_ARGS) {
    constexpr int KD = OUT_FP8 ? D / 2 : D;
    pg8::Gemm g{(const bf16_t*)(ws + WS_MRG), (const bf16_t*)(ws + WS_WOUT), KD, KD, KD}; pg8::StaticOrder S; S.init(T, D, F.G, (int)blockIdx.x, (BLK_ORDER & 4) != 0);
    EpiOut E{F.in[0], (bf16_t*)(ws + WS_X1), ws + WS_XGF8, (float*)(ws + WS_SSQ), OUT_FP8 ? 1.f / (WF8_SCALE * MRG_SCALE) : 1.f};
    pg8::gemm_phase<EpiOut, pg8::StaticOrder, true, false, OUT_FP8 != 0, false, 9>(ring, g, S, E, nullptr, F.wave, (unsigned*)F.ctl);
}
__device__ __forceinline__ void ph8(PH_ARGS) {
    pg8::Gemm g{(const bf16_t*)(ws + WS_X1), (const bf16_t*)(ws + WS_WR), D, D, D}; pg8::GroupedOrder S; S.init(T / 256, 1, T / 256, F.G, F.vcu);
    EpiRouter E{(float*)(ws + WS_RLOG)};
    pg8::gemm_phase<EpiRouter, pg8::GroupedOrder, false, false, false, true  >(ring, g, S, E, nullptr, F.wave);
}
__device__ __forceinline__ void ph10(PH_ARGS) {
    moe_tables(F);
    const LAS int* tst = (const LAS int*)(F.lds + MOE_TST_OFF);
    MoeOrder S{tst, tst[32] * 4, F.G, F.vcu, false};
    LAS unsigned* rowtab = (LAS unsigned*)(F.lds + ROWTAB_OFF);
    { const unsigned* rowtok = (const unsigned*)(ws + WS_ROWTOK); unsigned tkv[ROWTAB_UNITS];
#pragma unroll
      for (int i = 0; i < ROWTAB_UNITS; ++i) { pg8::Unit u; tkv[i] = 0u; if (S.next(i, u) && F.tid < 256) { const int pos = u.aux2 + F.tid; if (pos < u.aux3) tkv[i] = rowtok[(size_t)u.aux * ROWCAP + pos]; } }
#pragma unroll
      for (int i = 0; i < ROWTAB_UNITS; ++i) if (F.tid < 256) rowtab[i * 256 + F.tid] = (tkv[i] >> 1) * (unsigned)D; }
    __syncthreads();
    pg8::Gemm g{(const bf16_t*)(ws + WS_XGF8), (const bf16_t*)(ws + WS_W13), D / 2, D / 2, D / 2};
    EpiMoe1 E{ws + WS_HID, (const float*)(ws + WS_ROWRSTD), (const unsigned*)(F.ctl + CW_ECNT), 1.f / WF8_SCALE};
    pg8::gemm_phase<EpiMoe1, MoeOrder, true, true, true, false, 11>(ring, g, S, E, rowtab, F.wave, (unsigned*)F.ctl);
}
__device__ __forceinline__ void ph11(PH_ARGS) {
    moe_tables(F);
    const LAS int* tst = (const LAS int*)(F.lds + MOE_TST_OFF);
    MoeOrder S{tst, tst[32] * 4, F.G, F.vcu, (BLK_ORDER & 8) != 0};
    pg8::Gemm g{(const bf16_t*)(ws + WS_HID), (const bf16_t*)(ws + WS_W2), DE / 2, DE / 2, DE / 2};
    EpiMoe2 E{ws + WS_Y0, (size_t)(WS_Y1 - WS_Y0), (const unsigned*)(ws + WS_ROWTOK), (const float*)(ws + WS_ROWCOEF), (const unsigned*)(F.ctl + CW_ECNT), YF8_SCALE / WF8_SCALE};
    pg8::gemm_phase<EpiMoe2, MoeOrder, true, false, true, false, 12>(ring, g, S, E, nullptr, F.wave, (unsigned*)F.ctl);
}

__global__ void __launch_bounds__(NTHR, 2) fwd_kernel(Args args) {
    extern __shared__ __attribute__((aligned(16))) unsigned char lds_raw[];
    Frame F;
    F.lds = (LAS unsigned char*)lds_raw;
    F.MISC = (volatile LAS unsigned*)(F.lds + MISC_OFF);
    F.wave = __builtin_amdgcn_readfirstlane((int)(threadIdx.x >> 6)); F.lane = lane_id(); F.tid = F.wave * 64 + F.lane;
    F.G = gridDim.x; { const int bx = blockIdx.x; F.vcu = (F.G % 8 == 0) ? (bx % 8) * (F.G / 8) + bx / 8 : bx; }
    F.ws = args.ws; F.ctl = (gu32*)(args.ws + WS_CTL); F.out = args.out;
#pragma unroll
    for (int i = 0; i < 27; ++i) F.in[i] = args.in[i];
    for (int u = F.tid; u < (LDS_BYTES - MOE_TST_OFF) / 4; u += NTHR) ((LAS unsigned*)(F.lds + MOE_TST_OFF))[u] = 0u;
    __syncthreads();
    XcdBarrier bar; bar.bar = (unsigned*)(F.ctl + CW_BAR); bar.x = 0; bar.st = nullptr;
    const int lo = args.ph_lo, hi = args.ph_hi;
    if (hi - lo > 1) bar = xcd_barrier_post((unsigned*)(F.ctl + CW_BAR), F.MISC + 8, F.tid == 0);
#define IN(k) (lo <= (k) && (k) < hi)
#define DUP(k) ((DUP_MASK >> (k)) & 1)
#ifdef PROBE_BAR
#define SEAM(k) do { if (IN(k) && IN((k) + 1)) { const unsigned long long tb0_ = __builtin_amdgcn_s_memrealtime(); xcd_barrier(bar, F.wave == 0 && lane_id() == 0); tb_acc_ += (unsigned)(__builtin_amdgcn_s_memrealtime() - tb0_); } REFRESH(); } while (0)
#else
#define SEAM(k) do { if (IN(k) && IN((k) + 1)) xcd_barrier(bar, F.wave == 0 && lane_id() == 0); REFRESH(); } while (0)
#endif
#define REFRESH() do { int l_ = lane_id(); asm volatile("" : "+v"(l_)); F.lane = l_; F.tid = F.wave * 64 + l_; } while (0)
    unsigned char* ws = args.ws;
    LAS unsigned char* ring = F.lds;
#ifdef PROBE_BAR
    unsigned tb_acc_ = 0u; const unsigned long long tk0_ = __builtin_amdgcn_s_memrealtime();
#endif
    if (IN(0)) { p0_prologue(F); if (DUP(0)) p0_prologue(F); }
    SEAM(0);
    if (IN(1)) { ph1(F, ws, ring); if (DUP(1)) ph1(F, ws, ring); }
    SEAM(1);
    if (IN(2)) { ph2(F, ws, ring); if (DUP(2)) ph2(F, ws, ring); }
    SEAM(2);
#ifdef SELFCHECK_PREP
    if (IN(3)) { selfcheck_prep(F); }
#endif
    if (IN(3)) { attn_gate_phase<true>(F); }
#if PAIR_PHASES
    if (IN(3)) { __syncthreads(); ph4(F, ws, ring); }
#endif
    SEAM(3);
    if (IN(4)) { attn_block_phase(F); if (DUP(4)) { __syncthreads(); attn_block_phase(F); } }
#if PAIR_PHASES
    if (IN(4)) { __syncthreads(); ph5(F, ws, ring); }
#endif
    SEAM(4);
    if (IN(5)) { attn_own_phase(F); if (DUP(5)) attn_own_phase(F); }
#if !PAIR_PHASES
    if (IN(5)) { __syncthreads(); ph4(F, ws, ring); if (DUP(14)) ph4(F, ws, ring); }
#endif
#ifdef SELFCHECK
    if (IN(5)) { xcd_barrier(bar, F.wave == 0 && lane_id() == 0); REFRESH(); selfcheck_phase(F, SELFCHECK_TOL_ATTN, SELFCHECK_TOL_SSM); }
#endif
    SEAM(5);
#if !PAIR_PHASES
    if (IN(6)) { ph5(F, ws, ring); if (DUP(6)) ph5(F, ws, ring); }
    SEAM(6);
#endif
    if (IN(7)) { if (STAG8 > 0 && (F.vcu & 1)) { const unsigned long long t0_ = __builtin_amdgcn_s_memrealtime(); while ((long long)(__builtin_amdgcn_s_memrealtime() - t0_) < (long long)STAG8) __builtin_amdgcn_s_sleep(16); }
                 ph6(F, ws, ring); if (DUP(7)) ph6(F, ws, ring); }
    SEAM(7);
    if (IN(8)) { if (STAG9 > 0 && (F.vcu & 1)) { const unsigned long long t0_ = __builtin_amdgcn_s_memrealtime(); while ((long long)(__builtin_amdgcn_s_memrealtime() - t0_) < (long long)STAG9) __builtin_amdgcn_s_sleep(16); }
                 ph7(F, ws, ring); if (DUP(8)) ph7(F, ws, ring); }
    SEAM(8);
    if (IN(9)) { ph8(F, ws, ring); VM_WAIT(); __syncthreads(); routing_phase(F); }
    SEAM(9);
    if (IN(10)) { ph10(F, ws, ring); if (DUP(10)) ph10(F, ws, ring); }
    SEAM(10);
    if (IN(11)) { ph11(F, ws, ring); if (DUP(11)) ph11(F, ws, ring); }
    SEAM(11);
#ifdef PROBE_BAR
    if (F.wave == 0 && lane_id() == 0) { __hip_atomic_fetch_add((unsigned*)(F.ctl + 3), tb_acc_, __ATOMIC_RELAXED, __HIP_MEMORY_SCOPE_AGENT); __hip_atomic_fetch_add((unsigned*)(F.ctl + 4), (unsigned)(__builtin_amdgcn_s_memrealtime() - tk0_), __ATOMIC_RELAXED, __HIP_MEMORY_SCOPE_AGENT); }
    xcd_barrier(bar, F.wave == 0 && lane_id() == 0); REFRESH();
#endif
    if (IN(12)) { final_phase(F); if (DUP(12)) final_phase(F); }
#undef IN
#undef DUP
#undef SEAM
#undef REFRESH
}

extern "C" void kernel_launch(void* const* d_in, const int* in_sizes, int n_in, void* d_out, int out_size, void* d_ws, size_t ws_size, hipStream_t stream) {
    static int grid = 0;
    if (grid == 0) {
        if (n_in != 27 || in_sizes[0] != T * D || out_size != T * D || ws_size < WS_END) { fprintf(stderr, "kernel_launch: unexpected shapes (n_in %d, in0 %d, out %d, ws %zu)\n", n_in, n_in > 0 ? in_sizes[0] : -1, out_size, ws_size); grid = -1; return; }
        int dev = 0, cus = 0;
        if (hipGetDevice(&dev) != hipSuccess || hipDeviceGetAttribute(&cus, hipDeviceAttributeMultiprocessorCount, dev) != hipSuccess) { grid = -1; return; }
        if (hipFuncSetAttribute((const void*)fwd_kernel, hipFuncAttributeMaxDynamicSharedMemorySize, LDS_BYTES) != hipSuccess) { fprintf(stderr, "kernel_launch: hipFuncSetAttribute failed\n"); grid = -1; return; }
        (void)hipGetLastError();
        grid = cus;
    }
    if (grid < 0) return;
    (void)hipMemsetAsync((char*)d_ws + WS_CTL, 0, CTL_ZERO_BYTES, stream);
    Args a{};
    for (int i = 0; i < 27; ++i) a.in[i] = (const float*)d_in[i];
    a.out = (float*)d_out; a.ws = (unsigned char*)d_ws;
    if (MK_N_LAUNCHES == 1) { a.ph_lo = 0; a.ph_hi = NPHASE; hipLaunchKernelGGL(fwd_kernel, dim3(grid), dim3(NTHR), LDS_BYTES, stream, a); }
    else { for (int p = 0; p < NPHASE; ++p) { a.ph_lo = p; a.ph_hi = p + 1; hipLaunchKernelGGL(fwd_kernel, dim3(grid), dim3(NTHR), LDS_BYTES, stream, a); } }
}
```

```cpp
#include <hip/hip_runtime.h>
#include <cstdio>
#include <cstdint>

#define LAS __attribute__((address_space(3)))
#define GAS __attribute__((address_space(1)))
typedef unsigned short bf16_t;
typedef short bf16x8 __attribute__((ext_vector_type(8)));
typedef float f32x2 __attribute__((ext_vector_type(2)));
typedef float f32x4 __attribute__((ext_vector_type(4)));
typedef float f32x16 __attribute__((ext_vector_type(16)));
typedef unsigned u32x2 __attribute__((ext_vector_type(2)));
typedef unsigned u32x4 __attribute__((ext_vector_type(4)));
typedef GAS unsigned gu32;
typedef int v4i32 __attribute__((ext_vector_type(4)));
typedef int v8i32 __attribute__((ext_vector_type(8)));
#define RLX_AGENT __ATOMIC_RELAXED, __HIP_MEMORY_SCOPE_AGENT
#define LDS_WAIT() asm volatile("s_waitcnt lgkmcnt(0)" ::: "memory")
#define VM_WAIT() asm volatile("s_waitcnt vmcnt(0)" ::: "memory")

__device__ __forceinline__ unsigned f2bf(float f) { unsigned u = __builtin_bit_cast(unsigned, f); return (u + 0x7fffu + ((u >> 16) & 1u)) >> 16; }
__device__ __forceinline__ unsigned pk2(float lo, float hi) { return f2bf(lo) | (f2bf(hi) << 16); }
__device__ __forceinline__ float bf2f(unsigned short b) { return __builtin_bit_cast(float, (unsigned)b << 16); }
__device__ __forceinline__ float bflo(unsigned w) { return __builtin_bit_cast(float, w << 16); }
__device__ __forceinline__ float bfhi(unsigned w) { return __builtin_bit_cast(float, w & 0xffff0000u); }
__device__ __forceinline__ unsigned cvt_pk_bf16(float lo, float hi) { unsigned r; asm volatile("v_cvt_pk_bf16_f32 %0, %1, %2" : "=v"(r) : "v"(lo), "v"(hi)); return r; }
__device__ __forceinline__ float fast_sigmoid(float x) { return __builtin_amdgcn_rcpf(1.f + __builtin_amdgcn_exp2f(-1.4426950408889634f * x)); }
__device__ __forceinline__ int lane_id() { int l; asm volatile("v_mbcnt_lo_u32_b32 %0, -1, 0\n\tv_mbcnt_hi_u32_b32 %0, -1, %0" : "=v"(l)); return l; }
__device__ __forceinline__ float wave_sum(float v) {
#pragma unroll
    for (int o = 1; o < 64; o <<= 1) v += __shfl_xor(v, o);
    return v;
}
__device__ __forceinline__ float wave_max(float v) {
#pragma unroll
    for (int o = 1; o < 64; o <<= 1) v = fmaxf(v, __shfl_xor(v, o));
    return v;
}

#define XB_TMO      128
#define XB_XCNT(j)  (256  + 64 * (j))
#define XB_XSUB(j)  (1280 + 64 * (j))
#define XB_XGEN(j)  (2304 + 64 * (j))
#define XB_TOP      3328
#define XB_TOPGEN   3392
#define XCD_BAR_WORDS 3456
#define XB_SPIN_CAP (1u << 20)

__device__ __forceinline__ unsigned xb_ld(unsigned* p)              { return __hip_atomic_load(p, __ATOMIC_RELAXED, __HIP_MEMORY_SCOPE_AGENT); }
__device__ __forceinline__ unsigned xb_add(unsigned* p, unsigned v) { return __hip_atomic_fetch_add(p, v, __ATOMIC_RELAXED, __HIP_MEMORY_SCOPE_AGENT); }
__device__ __forceinline__ unsigned xb_xcc_id() { return (unsigned)__builtin_amdgcn_s_getreg((3 << 11) | 20) & 0xFu; }
#define XB_SPIN(cond, bar) do { unsigned _sp = 0; while (cond) { __builtin_amdgcn_s_sleep(1); \
    if ((++_sp & 255u) == 0u) { if (xb_ld(&(bar)[XB_TMO])) break; if (_sp > XB_SPIN_CAP) { atomicAdd(&(bar)[XB_TMO], 1u); break; } } } } while (0)

struct XcdBarrier { unsigned* bar; unsigned x; volatile LAS unsigned* st; };

__device__ __forceinline__ XcdBarrier xcd_barrier_post(unsigned* bar, volatile LAS unsigned* st, bool leader  ) {
    XcdBarrier b; b.bar = bar; b.x = xb_xcc_id(); b.st = st;
    if (leader) (void)xb_add(&bar[XB_XCNT(b.x)], 1u);
    return b;
}
__device__ __forceinline__ void xcd_barrier_complete(unsigned* bar, unsigned x, unsigned& nloc, unsigned& nx) {
    const unsigned G = gridDim.x * gridDim.y * gridDim.z;
    unsigned sum, cnt, mine, sp = 0u;
    for (;;) {
        sum = 0u; cnt = 0u; mine = 0u;
#pragma unroll
        for (unsigned j = 0; j < 16; ++j) { const unsigned c = xb_ld(&bar[XB_XCNT(j)]); sum += c; cnt += (c > 0u) ? 1u : 0u; mine = (j == x) ? c : mine; }
        if (sum == G) break;
        __builtin_amdgcn_s_sleep(1);
        if ((++sp & 255u) == 0u) { if (xb_ld(&bar[XB_TMO])) break; if (sp > XB_SPIN_CAP) { atomicAdd(&bar[XB_TMO], 1u); break; } }
    }
    nloc = mine > 0u ? mine : 1u; nx = cnt > 0u ? cnt : 1u;
}
__device__ __forceinline__ void xcd_barrier(const XcdBarrier& b, bool leader  ) {
    asm volatile("s_waitcnt vmcnt(0)" ::: "memory");
    __syncthreads();
    if (leader) {
        unsigned* bar = b.bar;
        __builtin_amdgcn_s_waitcnt(0);
        unsigned nloc = b.st[0], nx = b.st[1];
        if (nloc == 0u) { xcd_barrier_complete(bar, b.x, nloc, nx); b.st[0] = nloc; b.st[1] = nx; }
        const unsigned old = xb_add(&bar[XB_XSUB(b.x)], 1u);
        const unsigned gen = old / nloc;
        if (old + 1u == (gen + 1u) * nloc) {
            __builtin_amdgcn_fence(__ATOMIC_RELEASE, "agent");
            asm volatile("s_waitcnt vmcnt(0)" ::: "memory");
            const unsigned og = xb_add(&bar[XB_TOP], 1u);
            const unsigned tg = og / nx;
            if (og + 1u == (tg + 1u) * nx) xb_add(&bar[XB_TOPGEN], 1u);
            else XB_SPIN(xb_ld(&bar[XB_TOPGEN]) == tg, bar);
            __builtin_amdgcn_fence(__ATOMIC_ACQUIRE, "agent");
            xb_add(&bar[XB_XGEN(b.x)], 1u);
            asm volatile("s_waitcnt vmcnt(0)" ::: "memory");
        } else {
            XB_SPIN(xb_ld(&bar[XB_XGEN(b.x)]) == gen, bar);
            __builtin_amdgcn_fence(__ATOMIC_ACQUIRE, "agent");
            asm volatile("s_waitcnt vmcnt(0)" ::: "memory");
        }
    }
    __syncthreads();
}

#ifndef STG_MMA
#define STG_MMA 0
#endif
#ifndef PG8_ASM_DMA
#define PG8_ASM_DMA 0
#endif
namespace pg8 {
constexpr int BM = 256, BK = 64, HALF = 128, HTB = HALF * BK * 2, STAGE_BYTES = 8 * HTB, NXCD = 8, WGM = 8;
#ifndef LINE_PIECES
#define LINE_PIECES 1
#endif
#if LINE_PIECES
__host__ __device__ __forceinline__ int lds_byte(int r, int c) { const int s = (r >> 1) & 7; return (r >> 3) * 1024 + (r & 7) * 128 + ((((c >> 3) ^ s) & 7) << 4) + (c & 7) * 2; }
__host__ __device__ __forceinline__ void stage_rc(int b, int& R, int& C) { const int blk = b / 1024, wi = b % 1024, ri = wi >> 7, pos = wi & 127; R = blk * 8 + ri; const int s = (R >> 1) & 7; C = (((pos >> 4) ^ s) & 7) * 8 + (pos & 15) / 2; }
#else
__host__ __device__ __forceinline__ int lds_byte(int r, int c) { const int st = (r >> 4) * 2 + (c >> 5), rr = r & 15, cc = c & 31, ob = rr * 64 + cc * 2; return st * 1024 + (ob ^ (((ob >> 9) & 1) << 5)); }
__host__ __device__ __forceinline__ void stage_rc(int b, int& R, int& C) { const int st = b / 1024, sb = b % 1024, swz = sb ^ (((sb >> 9) & 1) << 5); R = (st >> 1) * 16 + swz / 64; C = (st & 1) * 32 + (swz % 64) / 2; }
#endif
__host__ __device__ __forceinline__ int perm32(int rho) { const int n = rho >> 4, i = rho & 15; return 8 * (i >> 2) + 4 * n + (i & 3); }

struct Unit { int pm, pn, pb, aux, aux2, aux3, aux4; };
struct Gemm { const bf16_t* A; const bf16_t* Bt; int lda, ldb, K; };

struct StaticOrder {
    int nM, nN, nwg, G, c, blk;
    __device__ void init(int M, int N, int G_, int c_, bool blocked = false) { nM = M / BM; nN = N / BM; nwg = nM * nN; G = G_; c = c_; blk = blocked ? nwg / G_ : 0; }
    __device__ bool next(int i, Unit& u) const {
        if (blk > 0) { if (i >= blk) return false; const int Lb = c * blk + i; u.pm = Lb / nN; u.pn = Lb % nN; u.pb = u.pn; u.aux = 0; u.aux2 = 0; u.aux3 = 0; u.aux4 = 0; return true; }
        const long L = (long)i * G + c; if (L >= nwg) return false;
        int wgid = (int)L; { const int q = nwg / NXCD, r = nwg % NXCD, xcd = wgid % NXCD, off = wgid / NXCD; wgid = (xcd < r ? xcd * (q + 1) : r * (q + 1) + (xcd - r) * q) + off; }
        const int nig = WGM * nN, gid = wgid / nig, fm = gid * WGM, gsz = (nM - fm) < WGM ? (nM - fm) : WGM;
        u.pm = fm + ((wgid % nig) % gsz); u.pn = (wgid % nig) / gsz; u.pb = u.pn; u.aux = 0; u.aux2 = 0; u.aux3 = 0; u.aux4 = 0; return true;
    }
};
struct GroupedOrder {
    int nM, nN, rtpg, G, v;
    __device__ void init(int nM_, int nN_, int rtpg_, int G_, int v_) { nM = nM_; nN = nN_; rtpg = rtpg_; G = G_; v = v_; }
    __device__ bool next(int i, Unit& u) const {
        const int L = i * G + v; if (L >= nM * nN) return false;
        u.pm = L / nN; u.pn = (L + i) % nN  ; u.aux = u.pm / rtpg; u.pb = u.aux * nN + u.pn; u.aux2 = 0; u.aux3 = 0; u.aux4 = 0; return true;
    }
};

template <class Epi, class Sched, bool ALIGN_EPI, bool GATHER, bool FP8 = false, bool HALFN = false  , int PID = 0  , bool KSKIP = false  >
__device__ __forceinline__ void gemm_phase(LAS unsigned char* lds, const Gemm g, const Sched& S, const Epi& E, const LAS unsigned* rowtab  , int wid  , unsigned* probe = nullptr) {
#ifdef PROBE_GEMM
    unsigned pg_te_ = 0u, pg_tw_ = 0u; const unsigned pg_t0_ = (unsigned)__builtin_amdgcn_s_memtime();
#endif
    const int lane = lane_id(), tid = wid * 64 + lane, wr = wid >> 2, wc = wid & 3;
    const int K = g.K, nt = K / BK;
    unsigned voffB[2];
#pragma unroll
    for (int i = 0; i < 2; ++i) { int R, C; stage_rc(tid * 16 + i * 8192, R, C); const int Rb = (R & ~31) + perm32(R & 31);
        voffB[i] = (unsigned)(Rb * g.ldb + C) * 2u; }
    const size_t kstep = (size_t)(BK * 2);
    const size_t hstepB = (size_t)HALF * g.ldb * 2, tstepB = 2 * hstepB;
    const size_t tstepA = (size_t)BM * g.lda * 2;
    const unsigned ldsw = (unsigned)wid * 1024u;
    int aoff = lds_byte(wr * 64 + (lane & 15), (lane >> 4) * 8), boff = lds_byte(wc * 32 + (lane & 15), (lane >> 4) * 8);
    unsigned vAc[2][2];
#define PG8_SETVA(dst, ui_) do { const int t_ = wid * 64 + lane_id(); _Pragma("unroll") for (int i_ = 0; i_ < 2; ++i_) { int R_, C_; stage_rc(t_ * 16 + i_ * 8192, R_, C_); \
        _Pragma("unroll") for (int h_ = 0; h_ < 2; ++h_) dst[h_][i_] = (GATHER ? rowtab[(ui_) * 256 + h_ * 128 + R_] : (unsigned)((h_ * 128 + R_) * g.lda) * 2u) + (unsigned)C_ * 2u; } } while (0)
#define PG8_SA(b, h) (((b) * 2 + (h)) * HTB)
#define PG8_SB(b, h) ((4 + (b) * 2 + (h)) * HTB)
#define PG8_GLDS_S(gbase_, voff_, ldsaddr_) do { unsigned keep_; asm volatile("s_mov_b32 %0, m0\n\ts_mov_b32 m0, %3\n\ts_nop 0\n\tglobal_load_lds_dwordx4 %1, %2\n\ts_mov_b32 m0, %0" \
        : "=&s"(keep_) : "v"(voff_), "s"(gbase_), "s"(ldsaddr_) : "memory"); } while (0)
#define PG8_STAGE(bufoff, gbase, v0, v1) do { \
        if constexpr (FP8 || PG8_ASM_DMA) { const unsigned la_ = (unsigned)(uintptr_t)(lds + (bufoff) + ldsw); PG8_GLDS_S((const char*)(gbase), (v0), la_); PG8_GLDS_S((const char*)(gbase), (v1), la_ + 8192u); } else { \
        __builtin_amdgcn_global_load_lds((const unsigned*)((const char*)(gbase) + (v0)), (LAS unsigned*)(lds + (bufoff) + ldsw), 16, 0, 0); \
        __builtin_amdgcn_global_load_lds((const unsigned*)((const char*)(gbase) + (v1)), (LAS unsigned*)(lds + (bufoff) + ldsw + 8192), 16, 0, 0); } } while (0)
#define PG8_STB(bufoff, gbase) PG8_STAGE(bufoff, gbase, voffB[0], voffB[1])
#if LINE_PIECES
#define PG8_KTOG(v_) asm volatile("v_xor_b32 %0, 64, %0" : "+v"(v_))
#define PG8_LDA(dst, b, h) do { _Pragma("unroll") for (int m = 0; m < 4; ++m) dst[m][0] = *(const LAS bf16x8*)(lds + PG8_SA(b, h) + aoff + m * 2048); PG8_KTOG(aoff); \
        _Pragma("unroll") for (int m = 0; m < 4; ++m) dst[m][1] = *(const LAS bf16x8*)(lds + PG8_SA(b, h) + aoff + m * 2048); PG8_KTOG(aoff); } while (0)
#define PG8_LDB(dst, b, h) do { _Pragma("unroll") for (int n = 0; n < 2; ++n) dst[n][0] = *(const LAS bf16x8*)(lds + PG8_SB(b, h) + boff + n * 2048); PG8_KTOG(boff); \
        _Pragma("unroll") for (int n = 0; n < 2; ++n) dst[n][1] = *(const LAS bf16x8*)(lds + PG8_SB(b, h) + boff + n * 2048); PG8_KTOG(boff); } while (0)
#else
#define PG8_LDA(dst, b, h) do { _Pragma("unroll") for (int m = 0; m < 4; ++m) _Pragma("unroll") for (int k = 0; k < 2; ++k) dst[m][k] = *(const LAS bf16x8*)(lds + PG8_SA(b, h) + aoff + m * 2048 + k * 1024); } while (0)
#define PG8_LDB(dst, b, h) do { _Pragma("unroll") for (int n = 0; n < 2; ++n) _Pragma("unroll") for (int k = 0; k < 2; ++k) dst[n][k] = *(const LAS bf16x8*)(lds + PG8_SB(b, h) + boff + n * 2048 + k * 1024); } while (0)
#endif
#define PG8_MMA(ai, bj, At, Bt) do { __builtin_amdgcn_s_setprio(1); \
        if constexpr (FP8) { _Pragma("unroll") for (int m = 0; m < 4; ++m) _Pragma("unroll") for (int n = 0; n < 2; ++n) { \
            const v8i32 a8_ = __builtin_shufflevector(__builtin_bit_cast(v4i32, At[m][0]), __builtin_bit_cast(v4i32, At[m][1]), 0, 1, 2, 3, 4, 5, 6, 7); \
            const v8i32 b8_ = __builtin_shufflevector(__builtin_bit_cast(v4i32, Bt[n][0]), __builtin_bit_cast(v4i32, Bt[n][1]), 0, 1, 2, 3, 4, 5, 6, 7); \
            acc[ai][bj][m][n] = __builtin_amdgcn_mfma_scale_f32_16x16x128_f8f6f4(b8_, a8_, acc[ai][bj][m][n], 0, 0, 0, 0, 0, 0); } } \
        else { _Pragma("unroll") for (int m = 0; m < 4; ++m) _Pragma("unroll") for (int n = 0; n < 2; ++n) _Pragma("unroll") for (int k = 0; k < 2; ++k) \
            acc[ai][bj][m][n] = __builtin_amdgcn_mfma_f32_16x16x32_bf16(Bt[n][k], At[m][k], acc[ai][bj][m][n], 0, 0, 0); } \
        __builtin_amdgcn_s_setprio(0); } while (0)
#ifdef PROBE_GEMM
#define PGT(mode_, stmt_) do { if (PID == PROBE_GEMM_PID && PROBE_GEMM == (mode_)) { const unsigned q0_ = (unsigned)__builtin_amdgcn_s_memtime(); stmt_; pg_tw_ += (unsigned)__builtin_amdgcn_s_memtime() - q0_; } else { stmt_; } } while (0)
#define PG8_WAIT_V(n) PGT(3, asm volatile("s_waitcnt vmcnt(" #n ")" ::: "memory"))
#else
#define PG8_WAIT_V(n) asm volatile("s_waitcnt vmcnt(" #n ")" ::: "memory")
#define PGT(mode_, stmt_) do { stmt_; } while (0)
#endif
#define PG8_WAIT_L(n) asm volatile("s_waitcnt lgkmcnt(" #n ")" ::: "memory")
#define PG8_BAR __builtin_amdgcn_s_barrier()
#define PG8_SCHED __builtin_amdgcn_sched_barrier(0)
#define PG8_SCHED8 do { if constexpr (FP8) __builtin_amdgcn_sched_barrier(0); } while (0)
    Unit cur, nxt; int ui = 0;
#define PG8_UNI(u_) do { u_.pm = __builtin_amdgcn_readfirstlane(u_.pm); u_.pn = __builtin_amdgcn_readfirstlane(u_.pn); u_.pb = __builtin_amdgcn_readfirstlane(u_.pb); u_.aux = __builtin_amdgcn_readfirstlane(u_.aux); u_.aux2 = __builtin_amdgcn_readfirstlane(u_.aux2); u_.aux3 = __builtin_amdgcn_readfirstlane(u_.aux3); u_.aux4 = __builtin_amdgcn_readfirstlane(u_.aux4); asm volatile("" : "+s"(u_.pm), "+s"(u_.pn), "+s"(u_.pb), "+s"(u_.aux), "+s"(u_.aux2), "+s"(u_.aux3), "+s"(u_.aux4)); } while (0)
    if (!S.next(0, cur)) return;
    PG8_UNI(cur);
    f32x4 acc[2][2][4][2];
#pragma unroll
    for (int a = 0; a < 2; ++a)
#pragma unroll
        for (int b = 0; b < 2; ++b)
#pragma unroll
            for (int m = 0; m < 4; ++m)
#pragma unroll
                for (int n = 0; n < 2; ++n) acc[a][b][m][n] = (f32x4){0.f, 0.f, 0.f, 0.f};
    bf16x8 At[4][2], B0[2][2], B1[2][2];
    const char* cA = (const char*)g.A + (GATHER ? (size_t)0 : (size_t)cur.pm * tstepA); const char* cB = (const char*)g.Bt + (size_t)cur.pb * tstepB;
    PG8_SETVA(vAc, 0);
    PG8_STB(PG8_SB(0, 0), cB); if constexpr (!HALFN) PG8_STB(PG8_SB(0, 1), cB + hstepB); PG8_STAGE(PG8_SA(0, 0), cA, vAc[0][0], vAc[0][1]); PG8_STAGE(PG8_SA(0, 1), cA, vAc[1][0], vAc[1][1]);
    if (wr == 1) PG8_BAR;
    PG8_WAIT_V(2); PG8_BAR;
    PG8_STB(PG8_SB(1, 0), cB + kstep); PG8_STAGE(PG8_SA(1, 0), cA + kstep, vAc[0][0], vAc[0][1]); if constexpr (!HALFN) PG8_STB(PG8_SB(1, 1), cB + hstepB + kstep);
    if constexpr (HALFN) PG8_WAIT_V(4); else PG8_WAIT_V(6);
    PG8_BAR;
    for (;;) {
        const bool has_next = S.next(ui + 1, nxt);
        PG8_UNI(nxt);
        const char* nA = GATHER ? cA : (has_next ? (const char*)g.A + (size_t)nxt.pm * tstepA : cA); const char* nB = has_next ? (const char*)g.Bt + (size_t)nxt.pb * tstepB : cB;
        const int nui = has_next ? ui + 1 : ui;
        const bool kskip = KSKIP && cur.pn == 0; const int ntu = kskip ? nt - 4 : nt;
#pragma nounroll
        for (int t = 0; t < ntu; t += 2) {
            const bool last = (t == ntu - 2);
            const int tk1 = (kskip && t >= 4) ? t + 5 : t + 1, tk2 = (kskip && t + 2 >= 4) ? t + 6 : t + 2;
            const char* a1 = cA + (size_t)tk1 * kstep;
            const char* a2 = last ? nA : cA + (size_t)tk2 * kstep; const char* b2 = last ? nB : cB + (size_t)tk2 * kstep;
            const char* a3 = a2 + kstep; const char* b3 = b2 + kstep;
            unsigned x00 = vAc[0][0], x01 = vAc[0][1], x10 = vAc[1][0], x11 = vAc[1][1];
            if (GATHER) { if (last) { unsigned vN_[2][2]; PG8_SETVA(vN_, nui); x00 = vN_[0][0]; x01 = vN_[0][1]; x10 = vN_[1][0]; x11 = vN_[1][1]; } }
#define PG8_MID(stmt_) do { PG8_SCHED; stmt_; PG8_SCHED; } while (0)
#define PG8_SPB0(ai_) do { if constexpr (HALFN) { PG8_SPB(6, ai_, (void)0); } else { PG8_SPB(8, ai_, (void)0); } } while (0)
#define PG8_SPB(wn_, ai_, mid_) PG8_WAIT_V(wn_); PGT(4, PG8_WAIT_L(0)); PGT(5, PG8_BAR); PG8_SCHED8; PGT(6, PG8_MMA(ai_, 0, At, B0); mid_; if constexpr (!HALFN) PG8_MMA(ai_, 1, At, B1)); PG8_SCHED8; PGT(7, PG8_BAR); PG8_SCHED
            PG8_LDB(B0, 0, 0); if constexpr (!HALFN) PG8_LDB(B1, 0, 1); PG8_SCHED; PG8_LDA(At, 0, 0);
#if STG_MMA >= 2
            PG8_SPB(6, 0, PG8_MID(PG8_STAGE(PG8_SA(1, 1), a1, vAc[1][0], vAc[1][1])));
#else
            PG8_STAGE(PG8_SA(1, 1), a1, vAc[1][0], vAc[1][1]); PG8_SPB0(0);
#endif
            PG8_LDA(At, 0, 1); PG8_STB(PG8_SB(0, 0), b2); if constexpr (!HALFN) PG8_STB(PG8_SB(0, 1), b2 + hstepB);
#if STG_MMA >= 1
            PG8_SPB(6, 1, PG8_MID(PG8_STAGE(PG8_SA(0, 0), a2, x00, x01)));
#else
            PG8_STAGE(PG8_SA(0, 0), a2, x00, x01); PG8_SPB0(1);
#endif
            PG8_LDB(B0, 1, 0); if constexpr (!HALFN) PG8_LDB(B1, 1, 1); PG8_SCHED; PG8_LDA(At, 1, 0);
#if STG_MMA >= 2
            PG8_SPB(6, 0, PG8_MID(PG8_STAGE(PG8_SA(0, 1), a2, x10, x11)));
#else
            PG8_STAGE(PG8_SA(0, 1), a2, x10, x11); PG8_SPB0(0);
#endif
            PG8_LDA(At, 1, 1); PG8_STB(PG8_SB(1, 0), b3); if constexpr (!HALFN) PG8_STB(PG8_SB(1, 1), b3 + hstepB);
#if STG_MMA >= 1
            PG8_SPB(6, 1, PG8_MID(PG8_STAGE(PG8_SA(1, 0), a3, x00, x01)));
#else
            PG8_STAGE(PG8_SA(1, 0), a3, x00, x01); PG8_SPB0(1);
#endif
        }
        if constexpr (ALIGN_EPI) { if (wr == 0) PG8_BAR; }
#ifdef PROBE_GEMM
        const unsigned pg_e0_ = (unsigned)__builtin_amdgcn_s_memtime();
#endif
        { int l_ = lane_id(); asm volatile("" : "+v"(l_));
          E(acc, cur, wr, wc, l_ & 15, l_ >> 4); }
#ifdef PROBE_GEMM
        if (PID == PROBE_GEMM_PID) pg_te_ += (unsigned)__builtin_amdgcn_s_memtime() - pg_e0_;
#endif
        if (!has_next) break;
#pragma unroll
        for (int a = 0; a < 2; ++a)
#pragma unroll
            for (int b = 0; b < 2; ++b)
#pragma unroll
                for (int m = 0; m < 4; ++m)
#pragma unroll
                    for (int n = 0; n < 2; ++n) acc[a][b][m][n] = (f32x4){0.f, 0.f, 0.f, 0.f};
        cur = nxt; cA = nA; cB = nB; ++ui;
        if (GATHER) { PG8_SETVA(vAc, ui); }
        if constexpr (ALIGN_EPI) { if (wr == 1) PG8_BAR; }
    }
    PG8_WAIT_V(0);
    if constexpr (!ALIGN_EPI) { if (wr == 0) PG8_BAR; }
    PG8_BAR;
#ifdef PROBE_GEMM
    if (PID == PROBE_GEMM_PID && probe && wid == PROBE_GEMM_WAVE && lane_id() == 0) { __hip_atomic_fetch_add(probe + 3, (PROBE_GEMM == 1 ? pg_te_ : pg_tw_) >> 8, __ATOMIC_RELAXED, __HIP_MEMORY_SCOPE_AGENT); __hip_atomic_fetch_add(probe + 4, ((unsigned)__builtin_amdgcn_s_memtime() - pg_t0_) >> 8, __ATOMIC_RELAXED, __HIP_MEMORY_SCOPE_AGENT); }
#endif
#undef PG8_SETVA
#undef PG8_UNI
#undef PG8_SA
#undef PG8_SB
#undef PG8_STAGE
#undef PG8_GLDS_S
#undef PG8_STB
#undef PG8_LDA
#undef PG8_LDB
#undef PG8_MMA
#undef PG8_WAIT_V
#undef PG8_WAIT_L
#undef PG8_BAR
#undef PG8_SCHED
#undef PG8_SCHED8
}
}
constexpr int NWAVES = 8, NTHR = 512;
constexpr int BATCH = 8, SEQ = 8192, T = BATCH * SEQ, D = 1024, DIN = 4096;
constexpr int DS = 512, DA = 512, NH = 8, HD = 64, NBLK = SEQ / 256;
constexpr int SG = 32, SHC = 16, SP = 64, SL = 32, SKU = SL * SHC  , SKS = 2 * SP  , SKY = SKU + SKS  , SROWS = T / SL  ;
constexpr int NE = 32, DE = 512;
constexpr float RMS_EPS = 1e-6f;
constexpr float LOG2E = 1.4426950408889634f;
constexpr float QSCALE = 0.125f * LOG2E;
constexpr float WF8_SCALE = 32.f;
constexpr float YF8_SCALE = 16.f;
constexpr float MA_SCALE = 64.f;
constexpr int ROWCAP = T;
constexpr int HID_ROWS = 2 * T + NE * 256;

constexpr size_t MiB = 1u << 20;
constexpr size_t WS_CTL = 0, CTL_ZERO_BYTES = 1 * MiB;
constexpr size_t WS_WIN = 1 * MiB;
constexpr size_t WS_WGLU = 9 * MiB;
constexpr size_t WS_WUS = 10 * MiB;
constexpr size_t WS_WUA = 11 * MiB;
constexpr size_t WS_WOUT = 12 * MiB;
constexpr size_t WS_WR = 14 * MiB;
constexpr size_t WS_KMEAN = 15 * MiB;
constexpr size_t WS_SSMW = 16 * MiB;
constexpr size_t WS_SSMT = 24 * MiB;
constexpr size_t WS_W13 = 44 * MiB;
constexpr size_t WS_W2 = 108 * MiB;
constexpr size_t WS_A0 = 140 * MiB;
constexpr size_t WS_UP = 276 * MiB;
constexpr size_t WS_Q = 356 * MiB;
constexpr size_t WS_SSQ = 404 * MiB;
constexpr size_t WS_RLOG = 408 * MiB;
constexpr size_t WS_K = 420 * MiB;
constexpr size_t WS_ROWTOK = 428 * MiB, WS_ROWCOEF = 436 * MiB, WS_ROWRSTD = 444 * MiB;
constexpr size_t WS_GACT = 484 * MiB;
constexpr size_t WS_V = 484 * MiB;
constexpr size_t WS_YSSM = 740 * MiB;
constexpr size_t WS_SGS = 548 * MiB;
constexpr size_t WS_SGA = 676 * MiB;
constexpr size_t WS_E = 804 * MiB;
constexpr size_t WS_YATT = 836 * MiB;
constexpr size_t WS_PART0 = 420 * MiB, WS_PART1 = 452 * MiB, WS_PART2 = 932 * MiB;
constexpr size_t WS_QLIST = 900 * MiB;
constexpr size_t WS_PL = 268 * MiB;
constexpr size_t WS_MQ = 996 * MiB;
constexpr size_t WS_H1F8 = 836 * MiB;
#ifndef UPS_FP8
#define UPS_FP8 1
#endif
constexpr float YS_SCALE = 16.f;
#ifndef OUT_FP8
#define OUT_FP8 1
#endif
constexpr float MRG_SCALE = 16.f;
#ifndef U_FP8
#define U_FP8 1
#endif
constexpr size_t WS_WINF8U = 904 * MiB;
constexpr size_t WS_WINF8 = 900 * MiB;
constexpr size_t WS_XGF8 = 836 * MiB;
constexpr size_t WS_MA = 276 * MiB;
constexpr size_t WS_SEGC = 998 * MiB;
constexpr size_t WS_END = 999 * MiB;
constexpr size_t WS_KFRAG = WS_A0, WS_VFRAG = WS_A0 + 64 * MiB, WS_H1 = WS_A0, WS_MRG = WS_A0, WS_HID = WS_A0;
constexpr size_t WS_X1 = WS_SGS, WS_XG = WS_UP, WS_Y0 = WS_UP, WS_Y1 = WS_E;
static_assert(WS_SGA + 64 * MiB <= WS_YSSM && WS_YSSM + 64 * MiB <= WS_E && WS_GACT + 64 * MiB <= WS_SGS && WS_PART1 + 32 * MiB <= WS_GACT, "map");
static_assert(WS_HID + (size_t)HID_ROWS * DE * 2 <= WS_UP, "hid fits");
static_assert(WS_RLOG + (size_t)T * 72 * 4 <= WS_ROWTOK, "rlog fits");

constexpr int CW_TMO = 0, CW_CODE = 1;
constexpr int CW_BAR = 4096;
constexpr int CW_ECNT = 8192;
constexpr int CW_GCNT = 12288;

constexpr int RING_BYTES = 131072;
constexpr int ROWTAB_OFF = RING_BYTES, ROWTAB_UNITS = 12, ROWTAB_BYTES = 25 * 1024;
constexpr int MOE_TST_OFF = ROWTAB_OFF + ROWTAB_BYTES;
constexpr int MISC_OFF = MOE_TST_OFF + 512;
constexpr int LDS_BYTES = MISC_OFF + 128;
static_assert(LDS_BYTES <= 163840, "LDS");

struct Frame {
    LAS unsigned char* lds;
    volatile LAS unsigned* MISC;
    gu32* ctl;
    unsigned char* ws;
    int tid, lane, wave, vcu, G;
    const float* in[27];
    float* out;
};

__device__ __forceinline__ unsigned pk4_fp8(float a, float b, float c, float d) { int w = 0; w = __builtin_amdgcn_cvt_pk_fp8_f32(a, b, w, false); w = __builtin_amdgcn_cvt_pk_fp8_f32(c, d, w, true); return (unsigned)w; }
#define EPI_LOOP_BEGIN  _Pragma("unroll") for (int ai = 0; ai < 2; ++ai) _Pragma("unroll") for (int m = 0; m < 4; ++m) { const int rl = ai * 128 + wr * 64 + m * 16 + fr; _Pragma("unroll") for (int bj = 0; bj < 2; ++bj) { const int cl = bj * 128 + wc * 32 + 8 * fq; \
        const f32x4 a0 = acc[ai][bj][m][0], a1 = acc[ai][bj][m][1]; (void)rl; (void)cl; (void)a0; (void)a1;
#define EPI_LOOP_END } }
typedef const f32x4 (&AccRef)[2][2][4][2];
__device__ __forceinline__ u32x4 pack8(f32x4 a, f32x4 b) { u32x4 w; w.x = cvt_pk_bf16(a[0], a[1]); w.y = cvt_pk_bf16(a[2], a[3]); w.z = cvt_pk_bf16(b[0], b[1]); w.w = cvt_pk_bf16(b[2], b[3]); return w; }
__device__ __forceinline__ void unpack8(u32x4 w, f32x4& a, f32x4& b) { a = (f32x4){bflo(w.x), bfhi(w.x), bflo(w.y), bfhi(w.y)}; b = (f32x4){bflo(w.z), bfhi(w.z), bflo(w.w), bfhi(w.w)}; }

__device__ __forceinline__ u32x4 pair16(u32x2 X, u32x2 Y) {
    const auto r0 = __builtin_amdgcn_permlane16_swap(X.x, Y.x, false, false); const auto r1 = __builtin_amdgcn_permlane16_swap(X.y, Y.y, false, false);
    return (u32x4){r0[0], r1[0], r0[1], r1[1]};
}
__device__ __forceinline__ void unpair16(u32x4 v, u32x2& X, u32x2& Y) {
    const auto r0 = __builtin_amdgcn_permlane16_swap(v.x, v.z, false, false); const auto r1 = __builtin_amdgcn_permlane16_swap(v.y, v.w, false, false);
    X = (u32x2){r0[0], r1[0]}; Y = (u32x2){r0[1], r1[1]};
}
#define EPI_P(p_) const int ai = (p_) >> 1, m = 2 * ((p_) & 1); const int rlA = ai * 128 + wr * 64 + m * 16 + fr, rlB = rlA + 16; const int rlS = (fq & 1) ? rlB : rlA; (void)rlA; (void)rlB; (void)rlS
__device__ __forceinline__ u32x2 pk8_fp8(f32x4 a, f32x4 b) { return (u32x2){pk4_fp8(a[0], a[1], a[2], a[3]), pk4_fp8(b[0], b[1], b[2], b[3])}; }
__device__ __forceinline__ void unpk8_fp8(u32x2 v, f32x4& a, f32x4& b) { const int x = (int)v.x, y = (int)v.y;
    a = (f32x4){__builtin_amdgcn_cvt_f32_fp8(x, 0), __builtin_amdgcn_cvt_f32_fp8(x, 1), __builtin_amdgcn_cvt_f32_fp8(x, 2), __builtin_amdgcn_cvt_f32_fp8(x, 3)};
    b = (f32x4){__builtin_amdgcn_cvt_f32_fp8(y, 0), __builtin_amdgcn_cvt_f32_fp8(y, 1), __builtin_amdgcn_cvt_f32_fp8(y, 2), __builtin_amdgcn_cvt_f32_fp8(y, 3)}; }
#ifndef SIGMOID_IN_CONSUMER
#define SIGMOID_IN_CONSUMER 0
#endif
#if SIGMOID_IN_CONSUMER
#define GATE_ACT(v) (v)
#define GATE_USE(v) fast_sigmoid(v)
#else
#define GATE_ACT(v) fast_sigmoid(v)
#define GATE_USE(v) (v)
#endif
template <int PART  > struct EpiProj {
    unsigned char* ws; const float* b_gate; int pn_off; float ascale;
    __device__ __forceinline__ void operator()(AccRef acc, const pg8::Unit& u, int wr, int wc, int fr, int fq) const {
        const int pn = u.pn + pn_off; const int row0 = u.pm * 256;
        if (PART == 0) {
            bf16_t* Uperm = (bf16_t*)(ws + WS_UP);
            EPI_LOOP_BEGIN
                const int row = row0 + rl, col = pn * 256 + cl;
                bf16_t* dst = Uperm + (size_t)(col >> 4) * ((size_t)SROWS * SKY) + (size_t)(row >> 5) * SKY + (row & 31) * 16 + (col & 15);
                *(u32x4*)dst = pack8(a0 * ascale, a1 * ascale);
            EPI_LOOP_END
        } else if (pn < 8) {
            const size_t boff = pn < 4 ? WS_Q : (pn < 6 ? WS_K : WS_V);
            bf16_t* base = (bf16_t*)(ws + boff); const float sc = pn < 4 ? QSCALE : 1.f; const int c0 = (pn & 1) * 256;
            EPI_LOOP_BEGIN
                const int row = row0 + rl, col = c0 + cl;
                *(u32x4*)(base + (size_t)row * 512 + col) = pack8(a0 * (sc * ascale), a1 * (sc * ascale));
            EPI_LOOP_END
        } else {
            const bool attn_gate = pn >= 12;
            const int c0 = ((pn - 8) & 3) * 256; const float* bg = b_gate + (pn - 8) * 256;
            if (attn_gate) {
#pragma unroll
                for (int p = 0; p < 4; ++p) { EPI_P(p);
#pragma unroll
                    for (int bj = 0; bj < 2; ++bj) { const int cl = bj * 128 + wc * 32 + 8 * fq; const f32x4 b0 = *(const f32x4*)(bg + cl), b1 = *(const f32x4*)(bg + cl + 4); f32x4 s0, s1, t0, t1;
#pragma unroll
                        for (int e = 0; e < 4; ++e) { s0[e] = GATE_ACT(acc[ai][bj][m][0][e] * ascale + b0[e]); s1[e] = GATE_ACT(acc[ai][bj][m][1][e] * ascale + b1[e]);
                                                      t0[e] = GATE_ACT(acc[ai][bj][m + 1][0][e] * ascale + b0[e]); t1[e] = GATE_ACT(acc[ai][bj][m + 1][1][e] * ascale + b1[e]); }
                        *(u32x4*)(ws + WS_SGA + (size_t)(row0 + rlS) * 1024 + c0 + bj * 128 + wc * 32 + 16 * (fq >> 1)) = pair16(pk8_fp8(s0, s1), pk8_fp8(t0, t1)); } }
            } else {
            EPI_LOOP_BEGIN
                const int row = row0 + rl, col = c0 + cl;
                const f32x4 b0 = *(const f32x4*)(bg + cl), b1 = *(const f32x4*)(bg + cl + 4);
                f32x4 s0, s1;
#pragma unroll
                for (int e = 0; e < 4; ++e) { s0[e] = GATE_ACT(a0[e] * ascale + b0[e]); s1[e] = GATE_ACT(a1[e] * ascale + b1[e]); }
                *(u32x4*)((bf16_t*)(ws + WS_SGS) + (size_t)row * 1024 + col) = pack8(s0, s1);
            EPI_LOOP_END
            }
        }
    }
};
struct EpiSsmE {
    float* E;
    __device__ __forceinline__ void operator()(AccRef acc, const pg8::Unit& u, int wr, int wc, int fr, int fq) const {
        EPI_LOOP_BEGIN
            if (bj == 0) { float* dst = E + (size_t)(u.pm * 256 + rl) * 128 + cl; *(f32x4*)dst = a0; *(f32x4*)(dst + 4) = a1; }
        EPI_LOOP_END
    }
};
__device__ __forceinline__ float gelu_tanh(float x) { const float z = 1.5957691216057308f * (x + 0.044715f * x * x * x); return x * fast_sigmoid(z); }
struct EpiSsmY {
    bf16_t* Gact;
    __device__ __forceinline__ void operator()(AccRef acc, const pg8::Unit& u, int wr, int wc, int fr, int fq) const {
        const int g = u.aux;
        EPI_LOOP_BEGIN
            const int rg = (u.pm & 7) * 256 + rl;
            const int colg = u.pn * 256 + cl;
            const int tok = (rg >> 8) * SEQ + (rg & 255) * SL + (colg >> 4);
            f32x4 y0, y1;
#pragma unroll
            for (int e = 0; e < 4; ++e) { y0[e] = gelu_tanh(a0[e]); y1[e] = gelu_tanh(a1[e]); }
            *(u32x4*)(Gact + (size_t)tok * DS + g * 16 + (colg & 15)) = pack8(y0, y1);
        EPI_LOOP_END
    }
};
#define EPI_SBAR __builtin_amdgcn_sched_barrier(0)
#define EPI_G(g_) const int ai = (g_) >> 2, m = (g_) & 3; const int rl = ai * 128 + wr * 64 + m * 16 + fr; (void)rl
struct EpiGlu {
    const bf16_t* Gact; bf16_t* Yssm; const float* b_glu;
    __device__ __forceinline__ void operator()(AccRef acc, const pg8::Unit& u, int wr, int wc, int fr, int fq) const {
        const int col0 = u.pn * 256 + wc * 32 + 8 * fq; const size_t rowb = (size_t)u.pm * 256;
        f32x4 bv[2][2]; u32x4 gv[8][2];
#pragma unroll
        for (int bj = 0; bj < 2; ++bj) { bv[bj][0] = *(const f32x4*)(b_glu + col0 + bj * 128); bv[bj][1] = *(const f32x4*)(b_glu + col0 + bj * 128 + 4); }
#pragma unroll
        for (int g = 0; g < 8; ++g) { EPI_G(g);
#pragma unroll
            for (int bj = 0; bj < 2; ++bj) gv[g][bj] = *(const u32x4*)(Gact + (rowb + rl) * DS + col0 + bj * 128); }
        EPI_SBAR;
#pragma unroll
        for (int p = 0; p < 4; ++p) { EPI_P(p);
#pragma unroll
            for (int bj = 0; bj < 2; ++bj) { f32x4 y_[2][2];
#pragma unroll
                for (int gi = 0; gi < 2; ++gi) { f32x4 g0, g1; unpack8(gv[2 * p + gi][bj], g0, g1); const f32x4 a0 = acc[ai][bj][m + gi][0], a1 = acc[ai][bj][m + gi][1];
#pragma unroll
                    for (int e = 0; e < 4; ++e) { y_[gi][0][e] = g0[e] * fast_sigmoid(a0[e] + bv[bj][0][e]); y_[gi][1][e] = g1[e] * fast_sigmoid(a1[e] + bv[bj][1][e]); } }
                if (UPS_FP8) *(u32x4*)((unsigned char*)Yssm + (rowb + rlS) * DS + u.pn * 256 + wc * 32 + 16 * (fq >> 1) + bj * 128) = pair16(pk8_fp8(y_[0][0] * YS_SCALE, y_[0][1] * YS_SCALE), pk8_fp8(y_[1][0] * YS_SCALE, y_[1][1] * YS_SCALE));
                else { *(u32x4*)(Yssm + (rowb + rlA) * DS + col0 + bj * 128) = pack8(y_[0][0], y_[0][1]); *(u32x4*)(Yssm + (rowb + rlB) * DS + col0 + bj * 128) = pack8(y_[1][0], y_[1][1]); } } }
    }
};
struct EpiUpA {
    const unsigned char* SG; unsigned char* MA; float ascale;
    __device__ __forceinline__ void operator()(AccRef acc, const pg8::Unit& u, int wr, int wc, int fr, int fq) const {
        const size_t base = (size_t)u.pm * 256 * D + u.pn * 256 + wc * 32 + 16 * (fq >> 1); u32x4 sv[4][2];
#pragma unroll
        for (int p = 0; p < 4; ++p) { EPI_P(p);
#pragma unroll
            for (int bj = 0; bj < 2; ++bj) sv[p][bj] = *(const u32x4*)(SG + base + (size_t)rlS * D + bj * 128); }
        EPI_SBAR;
#pragma unroll
        for (int p = 0; p < 4; ++p) { EPI_P(p);
#pragma unroll
            for (int bj = 0; bj < 2; ++bj) { u32x2 sx, sy; unpair16(sv[p][bj], sx, sy); f32x4 s0, s1, t0, t1; unpk8_fp8(sx, s0, s1); unpk8_fp8(sy, t0, t1);
#pragma unroll
                for (int e = 0; e < 4; ++e) { s0[e] = GATE_USE(s0[e]); s1[e] = GATE_USE(s1[e]); t0[e] = GATE_USE(t0[e]); t1[e] = GATE_USE(t1[e]); }
                const f32x4 y0 = s0 * acc[ai][bj][m][0] * ascale, y1 = s1 * acc[ai][bj][m][1] * ascale, z0 = t0 * acc[ai][bj][m + 1][0] * ascale, z1 = t1 * acc[ai][bj][m + 1][1] * ascale;
                *(u32x4*)(MA + base + (size_t)rlS * D + bj * 128) = pair16(pk8_fp8(y0, y1), pk8_fp8(z0, z1)); } }
    }
};
struct EpiUpS {
    const bf16_t* SG; const unsigned char* MA; bf16_t* Mrg; float ascale;
    __device__ __forceinline__ void operator()(AccRef acc, const pg8::Unit& u, int wr, int wc, int fr, int fq) const {
        const size_t base = (size_t)u.pm * 256 * D + u.pn * 256 + wc * 32 + 8 * fq; const size_t base16 = (size_t)u.pm * 256 * D + u.pn * 256 + wc * 32 + 16 * (fq >> 1);
        u32x4 sv[2][2][2]; u32x4 mv[2][2];
        constexpr float ms = 1.f / MA_SCALE;
#define UPS_LOAD(buf_, bt_) do { { EPI_P(bt_); _Pragma("unroll") for (int bj = 0; bj < 2; ++bj) mv[buf_][bj] = *(const u32x4*)(MA + base16 + (size_t)rlS * D + bj * 128); } \
            _Pragma("unroll") for (int gi_ = 0; gi_ < 2; ++gi_) { EPI_G(2 * (bt_) + gi_); _Pragma("unroll") for (int bj = 0; bj < 2; ++bj) sv[buf_][gi_][bj] = *(const u32x4*)(SG + base + (size_t)rl * D + bj * 128); } } while (0)
#define UPS_PROC(buf_, bt_) do { EPI_P(bt_); _Pragma("unroll") for (int bj = 0; bj < 2; ++bj) { u32x2 mx_, my_; unpair16(mv[buf_][bj], mx_, my_); f32x4 r_[2][2]; \
            _Pragma("unroll") for (int gi_ = 0; gi_ < 2; ++gi_) { f32x4 s0, s1; unpack8(sv[buf_][gi_][bj], s0, s1); _Pragma("unroll") for (int e_ = 0; e_ < 4; ++e_) { s0[e_] = GATE_USE(s0[e_]); s1[e_] = GATE_USE(s1[e_]); } \
                f32x4 p0, p1; unpk8_fp8(gi_ == 0 ? mx_ : my_, p0, p1); r_[gi_][0] = s0 * (acc[ai][bj][m + gi_][0] * ascale) + p0 * ms; r_[gi_][1] = s1 * (acc[ai][bj][m + gi_][1] * ascale) + p1 * ms; } \
            if (OUT_FP8) *(u32x4*)((unsigned char*)Mrg + base16 + (size_t)rlS * D + bj * 128) = pair16(pk8_fp8(r_[0][0] * MRG_SCALE, r_[0][1] * MRG_SCALE), pk8_fp8(r_[1][0] * MRG_SCALE, r_[1][1] * MRG_SCALE)); \
            else { *(u32x4*)(Mrg + base + (size_t)rlA * D + bj * 128) = pack8(r_[0][0], r_[0][1]); *(u32x4*)(Mrg + base + (size_t)rlB * D + bj * 128) = pack8(r_[1][0], r_[1][1]); } } } while (0)
        UPS_LOAD(0, 0); UPS_LOAD(1, 1); EPI_SBAR;
        UPS_PROC(0, 0); UPS_LOAD(0, 2); EPI_SBAR;
        UPS_PROC(1, 1); UPS_LOAD(1, 3); EPI_SBAR;
        UPS_PROC(0, 2); EPI_SBAR;
        UPS_PROC(1, 3);
#undef UPS_LOAD
#undef UPS_PROC
    }
};
__device__ __forceinline__ float sum_xor16(float v) { const unsigned u = __builtin_bit_cast(unsigned, v); const auto r = __builtin_amdgcn_permlane16_swap(u, u, false, false); return __builtin_bit_cast(float, (unsigned)r[0]) + __builtin_bit_cast(float, (unsigned)r[1]); }
__device__ __forceinline__ float sum_xor32(float v) { const unsigned u = __builtin_bit_cast(unsigned, v); const auto r = __builtin_amdgcn_permlane32_swap(u, u, false, false); return __builtin_bit_cast(float, (unsigned)r[0]) + __builtin_bit_cast(float, (unsigned)r[1]); }
struct EpiOut {
    const float* x; bf16_t* X1; unsigned char* X18; float* SSQ; float ascale;
    __device__ __forceinline__ void operator()(AccRef acc, const pg8::Unit& u, int wr, int wc, int fr, int fq) const {
        const int col0 = u.pn * 256 + wc * 32 + 8 * fq; const size_t base = (size_t)u.pm * 256 * D + col0; const size_t base16 = (size_t)u.pm * 256 * D + u.pn * 256 + wc * 32 + 16 * (fq >> 1);
        f32x4 xv[2][2][2][2];
#define OUT_LOAD(buf_, bt_) do { _Pragma("unroll") for (int gi_ = 0; gi_ < 2; ++gi_) { EPI_G(2 * (bt_) + gi_); _Pragma("unroll") for (int bj = 0; bj < 2; ++bj) { const size_t off = base + (size_t)rl * D + bj * 128; \
            xv[buf_][gi_][bj][0] = *(const f32x4*)(x + off); xv[buf_][gi_][bj][1] = *(const f32x4*)(x + off + 4); } } } while (0)
#define OUT_PROC(buf_, bt_) do { u32x2 f8_[2][2]; _Pragma("unroll") for (int gi_ = 0; gi_ < 2; ++gi_) { EPI_G(2 * (bt_) + gi_); float ss = 0.f; _Pragma("unroll") for (int bj = 0; bj < 2; ++bj) { const size_t off = base + (size_t)rl * D + bj * 128; \
            const f32x4 x0 = xv[buf_][gi_][bj][0] + acc[ai][bj][m][0] * ascale, x1 = xv[buf_][gi_][bj][1] + acc[ai][bj][m][1] * ascale; \
            *(u32x4*)(X1 + off) = pack8(x0, x1); f8_[gi_][bj] = pk8_fp8(x0, x1); \
            ss += (x0[0] * x0[0] + x0[1] * x0[1]) + (x0[2] * x0[2] + x0[3] * x0[3]) + (x1[0] * x1[0] + x1[1] * x1[1]) + (x1[2] * x1[2] + x1[3] * x1[3]); } \
            ss = sum_xor16(ss); ss = sum_xor32(ss); \
            SSQ[((size_t)u.pm * 256 + rl) * 16 + u.pn * 4 + wc] = ss; } \
            { EPI_P(bt_); _Pragma("unroll") for (int bj = 0; bj < 2; ++bj) *(u32x4*)(X18 + base16 + (size_t)rlS * D + bj * 128) = pair16(f8_[0][bj], f8_[1][bj]); } } while (0)
        OUT_LOAD(0, 0); OUT_LOAD(1, 1); EPI_SBAR;
        OUT_PROC(0, 0); OUT_LOAD(0, 2); EPI_SBAR;
        OUT_PROC(1, 1); OUT_LOAD(1, 3); EPI_SBAR;
        OUT_PROC(0, 2); EPI_SBAR;
        OUT_PROC(1, 3);
#undef OUT_LOAD
#undef OUT_PROC
    }
};
struct EpiRouter {
    float* Rlog;
    __device__ __forceinline__ void operator()(AccRef acc, const pg8::Unit& u, int wr, int wc, int fr, int fq) const {
        EPI_LOOP_BEGIN
            if (bj == 0 && cl < 72) { float* dst = Rlog + (size_t)(u.pm * 256 + rl) * 72 + cl; *(f32x4*)dst = a0; *(f32x4*)(dst + 4) = a1; }
        EPI_LOOP_END
    }
};
struct EpiMoe1 {
    unsigned char* Hid; const float* rowrstd; const unsigned* ecnt; float ascale;
    __device__ __forceinline__ void operator()(AccRef acc, const pg8::Unit& u, int wr, int wc, int fr, int fq) const {
        const int e = u.aux, cnt = u.aux3; float rsv[8];
#pragma unroll
        for (int g = 0; g < 8; ++g) { EPI_G(g); const int pos = u.aux2 + rl; rsv[g] = rowrstd[(size_t)e * ROWCAP + (pos < cnt ? pos : 0)] * ascale; }
        EPI_SBAR;
#pragma unroll
        for (int p = 0; p < 4; ++p) { EPI_P(p); u32x2 hp[2];
#pragma unroll
            for (int gi = 0; gi < 2; ++gi) { const float rs = rsv[2 * p + gi]; f32x4 h0, h1;
#pragma unroll
                for (int k = 0; k < 4; ++k) { const float a = acc[ai][0][m + gi][0][k] * rs, b = acc[ai][1][m + gi][0][k] * rs; h0[k] = a * fast_sigmoid(a) * b;
                    const float a2 = acc[ai][0][m + gi][1][k] * rs, b2 = acc[ai][1][m + gi][1][k] * rs; h1[k] = a2 * fast_sigmoid(a2) * b2; }
                hp[gi] = pk8_fp8(h0, h1); }
            const u32x4 v = pair16(hp[0], hp[1]);
            if (u.aux2 + rlS < cnt) *(u32x4*)(Hid + (size_t)(u.pm * 256 + rlS) * DE + u.pn * 128 + wc * 32 + 16 * (fq >> 1)) = v; }
    }
};
struct EpiMoe2 {
    unsigned char* Y0; size_t ydelta; const LAS unsigned* tktab; const LAS float* cftab; const unsigned* ecnt; float ascale;
    __device__ __forceinline__ void operator()(AccRef acc, const pg8::Unit& u, int wr, int wc, int fr, int fq) const {
        const int cnt = u.aux3; unsigned tkv[8]; float cfv[8];
#pragma unroll
        for (int g = 0; g < 8; ++g) { EPI_G(g); tkv[g] = tktab[u.aux4 * 256 + rl]; cfv[g] = cftab[u.aux4 * 256 + rl] * ascale; }
#pragma unroll
        for (int p = 0; p < 4; ++p) { EPI_P(p); unsigned ta_ = tkv[2 * p], tb_ = tkv[2 * p + 1]; asm volatile("" : "+v"(ta_), "+v"(tb_));
            const unsigned tk = (fq & 1) ? tb_ : ta_; const bool ok = u.aux2 + rlS < cnt;
            unsigned char* dst = Y0 + (size_t)(tk & 1u) * ydelta + (size_t)(tk >> 1) * D + u.pn * 256 + wc * 32 + 16 * (fq >> 1);
#pragma unroll
            for (int bj = 0; bj < 2; ++bj) { const float c0 = cfv[2 * p], c1 = cfv[2 * p + 1];
                const u32x4 v = pair16(pk8_fp8(acc[ai][bj][m][0] * c0, acc[ai][bj][m][1] * c0), pk8_fp8(acc[ai][bj][m + 1][0] * c1, acc[ai][bj][m + 1][1] * c1));
                if (ok) *(u32x4*)(dst + bj * 128) = v; } }
    }
};
__device__ __forceinline__ void transpose_item(const float* W, int N, int k0, int n0, bf16_t* WT, size_t drow0, int ldo, LAS float* scr, int lane) {
    float tv[32];
#pragma unroll
    for (int i = 0; i < 32; ++i) tv[i] = W[(size_t)(k0 + 2 * i + (lane >> 5)) * N + n0 + (lane & 31)];
#pragma unroll
    for (int i = 0; i < 32; ++i) scr[(2 * i + (lane >> 5)) * 33 + (lane & 31)] = tv[i];
    LDS_WAIT(); asm volatile("" ::: "memory");
    const int c = lane & 7;
#pragma unroll
    for (int j = 0; j < 4; ++j) { const int n = (lane >> 3) + 8 * j; const LAS float* s = scr + (8 * c) * 33 + n;
        u32x4 o; o.x = pk2(s[0 * 33], s[1 * 33]); o.y = pk2(s[2 * 33], s[3 * 33]); o.z = pk2(s[4 * 33], s[5 * 33]); o.w = pk2(s[6 * 33], s[7 * 33]);
        *(u32x4*)(WT + (drow0 + n) * (size_t)ldo + k0 + 8 * c) = o; }
    LDS_WAIT(); asm volatile("" ::: "memory");
}
__device__ __forceinline__ void transpose_item_f8(const float* W, int N, int k0, int n0, unsigned char* WT8, size_t drow0, int ldo, float scale, LAS float* scr, int lane, const float* kgain = nullptr  ) {
    float tv[32];
#pragma unroll
    for (int i = 0; i < 32; ++i) tv[i] = W[(size_t)(k0 + 2 * i + (lane >> 5)) * N + n0 + (lane & 31)];
#pragma unroll
    for (int i = 0; i < 32; ++i) scr[(2 * i + (lane >> 5)) * 33 + (lane & 31)] = tv[i] * (kgain ? scale * kgain[k0 + 2 * i + (lane >> 5)] : scale);
    LDS_WAIT(); asm volatile("" ::: "memory");
    const int c = lane & 3;
#pragma unroll
    for (int j = 0; j < 2; ++j) { const int n = (lane >> 2) + 16 * j; const LAS float* s = scr + (16 * c) * 33 + n;
        u32x4 o; o.x = pk4_fp8(s[0 * 33], s[1 * 33], s[2 * 33], s[3 * 33]); o.y = pk4_fp8(s[4 * 33], s[5 * 33], s[6 * 33], s[7 * 33]);
        o.z = pk4_fp8(s[8 * 33], s[9 * 33], s[10 * 33], s[11 * 33]); o.w = pk4_fp8(s[12 * 33], s[13 * 33], s[14 * 33], s[15 * 33]);
        *(u32x4*)(WT8 + (drow0 + n) * (size_t)ldo + k0 + 16 * c) = o; }
    LDS_WAIT(); asm volatile("" ::: "memory");
}
template <int NR> __device__ __forceinline__ void rms_rows_to_bf16(int lane, const float* xrow, const float* g, bf16_t* orow, unsigned char* orow8) {
    f32x4 v[NR][4]; float s[NR];
#pragma unroll
    for (int r = 0; r < NR; ++r) { const f32x4* xr = (const f32x4*)(xrow + (size_t)r * D) + lane;
#pragma unroll
        for (int j = 0; j < 4; ++j) v[r][j] = xr[64 * j]; }
    const f32x4* gr = (const f32x4*)g + lane; f32x4 wv[4];
#pragma unroll
    for (int j = 0; j < 4; ++j) wv[j] = gr[64 * j];
#pragma unroll
    for (int r = 0; r < NR; ++r) { float a = 0.f;
#pragma unroll
        for (int j = 0; j < 4; ++j) a += (v[r][j].x * v[r][j].x + v[r][j].y * v[r][j].y) + (v[r][j].z * v[r][j].z + v[r][j].w * v[r][j].w);
        s[r] = a; }
#pragma unroll
    for (int o = 1; o < 64; o <<= 1) {
#pragma unroll
        for (int r = 0; r < NR; ++r) s[r] += __shfl_xor(s[r], o); }
#pragma unroll
    for (int r = 0; r < NR; ++r) { const float rstd = 1.f / sqrtf(s[r] * (1.f / D) + RMS_EPS); unsigned long long* o8 = (unsigned long long*)(orow + (size_t)r * D) + lane;
#pragma unroll
        for (int j = 0; j < 4; ++j) { const float y0 = v[r][j].x * rstd * wv[j].x, y1 = v[r][j].y * rstd * wv[j].y, y2 = v[r][j].z * rstd * wv[j].z, y3 = v[r][j].w * rstd * wv[j].w;
            if (!U_FP8) o8[64 * j] = (unsigned long long)pk2(y0, y1) | ((unsigned long long)pk2(y2, y3) << 32);
            ((unsigned*)(orow8 + (size_t)r * D))[lane + 64 * j] = pk4_fp8(y0, y1, y2, y3); } }
}
__device__ __forceinline__ void cpow(float lr, float li, float step, float dl, float& ar, float& ai) {
    const float mag = __expf(dl * lr * step); const float rev = dl * (li * step * 0.15915494309189535f); const float fr = rev - floorf(rev);
    ar = mag * __builtin_amdgcn_cosf(fr); ai = mag * __builtin_amdgcn_sinf(fr);
}
__device__ __forceinline__ void ssm_gen(Frame& F, int g, int sl) {
    LAS float* AP = (LAS float*)(F.lds); LAS float* BB = AP + 33 * 64 * 2; LAS float* CC = BB + 2048; LAS float* KT = CC + 2048;
    const float* lam_re = F.in[4] + g * SP; const float* lam_im = F.in[5] + g * SP; const float step = __expf(F.in[6][g]);
    const float* b_re = F.in[7] + g * SP * SHC; const float* b_im = F.in[8] + g * SP * SHC; const float* c_re = F.in[9] + g * SHC * SP; const float* c_im = F.in[10] + g * SHC * SP; const float* dd = F.in[11] + g * SHC;
    bf16_t* BT = (bf16_t*)(F.ws + WS_SSMT) + (size_t)g * 512 * SKY; bf16_t* BW = (bf16_t*)(F.ws + WS_SSMW) + (size_t)g * 256 * SKU;
    const int tid = F.tid;
    for (int idx = tid; idx < 33 * 64; idx += NTHR) { const int dl = idx >> 6, p = idx & 63; float ar, ai; cpow(lam_re[p], lam_im[p], step, (float)dl, ar, ai); AP[idx * 2] = ar; AP[idx * 2 + 1] = ai; }
    for (int idx = tid; idx < 1024; idx += NTHR) { const int ho = idx >> 6, p = idx & 63; CC[idx * 2] = c_re[ho * 64 + p]; CC[idx * 2 + 1] = c_im[ho * 64 + p]; }
    __syncthreads();
    for (int idx = tid; idx < 1024; idx += NTHR) { const int p = idx >> 4, h = idx & 15; const float ar = AP[(64 + p) * 2], ai = AP[(64 + p) * 2 + 1];
        const float lr = lam_re[p], li = lam_im[p], nr = ar - 1.f, ni = ai, den = lr * lr + li * li, cr = (nr * lr + ni * li) / den, ci = (ni * lr - nr * li) / den;
        const float br = b_re[p * 16 + h], bi = b_im[p * 16 + h]; BB[idx * 2] = cr * br - ci * bi; BB[idx * 2 + 1] = cr * bi + ci * br; }
    __syncthreads();
    for (int idx = tid; idx < 1024; idx += NTHR) { const int dl = idx >> 5, hl = (idx >> 4) & 1, hi = idx & 15, ho = 2 * sl + hl; float s = 0.f;
        for (int p = 0; p < 64; ++p) { const float ar = AP[(dl * 64 + p) * 2], ai = AP[(dl * 64 + p) * 2 + 1], br = BB[(p * 16 + hi) * 2], bi = BB[(p * 16 + hi) * 2 + 1];
            const float zr = ar * br - ai * bi, zi = ar * bi + ai * br; s += CC[(ho * 64 + p) * 2] * zr - CC[(ho * 64 + p) * 2 + 1] * zi; }
        if (dl == 0 && ho == hi) s += dd[ho];
        KT[idx] = s; }
    __syncthreads();
    for (int v = tid; v < 64 * 80; v += NTHR) { const int nl = v / 80, kv = (v % 80) * 8, tau = nl >> 1, hl = nl & 1, ho = 2 * sl + hl, n = tau * 16 + ho; float val[8];
        if (kv < 512) { const int sg = kv >> 4, hi0 = kv & 15;
#pragma unroll
            for (int e = 0; e < 8; ++e) val[e] = (tau >= sg) ? KT[((tau - sg) * 2 + hl) * 16 + hi0 + e] : 0.f; }
        else { const int kk = kv - 512;
#pragma unroll
            for (int e = 0; e < 8; ++e) { const int p = (kk + e) >> 1, ri = (kk + e) & 1; const float ar = AP[((tau + 1) * 64 + p) * 2], ai = AP[((tau + 1) * 64 + p) * 2 + 1], cre = CC[(ho * 64 + p) * 2], cim = CC[(ho * 64 + p) * 2 + 1];
                val[e] = ri == 0 ? (cre * ar - cim * ai) : -(cre * ai + cim * ar); } }
        u32x4 o; o.x = pk2(val[0], val[1]); o.y = pk2(val[2], val[3]); o.z = pk2(val[4], val[5]); o.w = pk2(val[6], val[7]);
        *(u32x4*)(BT + (size_t)n * SKY + kv) = o; }
    for (int v = tid; v < 32 * 64; v += NTHR) { const int nl = v >> 6, kv = (v & 63) * 8; float val[8];
        const bool real = nl < 16; const int n = real ? 16 * sl + nl : 128 + 16 * sl + (nl - 16);
        if (real) { const int p = n >> 1, ri = n & 1, sg = kv >> 4, hi0 = kv & 15; const float ar = AP[((31 - sg) * 64 + p) * 2], ai = AP[((31 - sg) * 64 + p) * 2 + 1];
#pragma unroll
            for (int e = 0; e < 8; ++e) { const float br = BB[(p * 16 + hi0 + e) * 2], bi = BB[(p * 16 + hi0 + e) * 2 + 1]; val[e] = ri == 0 ? (ar * br - ai * bi) : (ar * bi + ai * br); } }
        else {
#pragma unroll
            for (int e = 0; e < 8; ++e) val[e] = 0.f; }
        u32x4 o; o.x = pk2(val[0], val[1]); o.y = pk2(val[2], val[3]); o.z = pk2(val[4], val[5]); o.w = pk2(val[6], val[7]);
        *(u32x4*)(BW + (size_t)n * SKU + kv) = o; }
    __syncthreads();
}
__device__ __forceinline__ void p0_prologue(Frame& F) {
    for (int it = F.vcu; it < SG * 8; it += F.G) ssm_gen(F, it >> 3, it & 7);
    LAS float* scr = (LAS float*)(F.lds + F.wave * 16384);
    const int gw = F.vcu * NWAVES + F.wave, NGW = F.G * NWAVES, lane = F.lane;
    constexpr int I_IN = 16 * 128, I_GLU = 8 * 16, I_US = 8 * 32, I_UA = 8 * 32, I_OUT = 16 * 32, I_W1 = 32 * 256, I_W3 = 32 * 256, I_W2 = 32 * 256;
    constexpr int NITEMS = I_IN + I_GLU + I_US + I_UA + I_OUT + I_W1 + I_W3 + I_W2;
    unsigned char* ws = F.ws;
    for (int it = gw; it < NITEMS; it += NGW) {
        int r = it;
        if (r < I_IN) { const int k0 = 64 * (r / 128), n0 = 32 * (r % 128);
            if (n0 < DS) { if (U_FP8) transpose_item_f8(F.in[2], DIN, k0, n0, ws + WS_WINF8U, n0, D, WF8_SCALE, scr, lane); else transpose_item(F.in[2], DIN, k0, n0, (bf16_t*)(ws + WS_WIN), n0, D, scr, lane); }
            else transpose_item_f8(F.in[2], DIN, k0, n0, ws + WS_WINF8, n0 - DS, D, WF8_SCALE, scr, lane);
            continue; } r -= I_IN;
        if (r < I_GLU) { transpose_item(F.in[12], DS, 64 * (r / 16), 32 * (r % 16), (bf16_t*)(ws + WS_WGLU), 32 * (r % 16), DS, scr, lane); continue; } r -= I_GLU;
        if (r < I_US) { if (UPS_FP8) transpose_item_f8(F.in[14], D, 64 * (r / 32), 32 * (r % 32), ws + WS_WUS, 32 * (r % 32), DS, WF8_SCALE, scr, lane); else transpose_item(F.in[14], D, 64 * (r / 32), 32 * (r % 32), (bf16_t*)(ws + WS_WUS), 32 * (r % 32), DS, scr, lane); continue; } r -= I_US;
        if (r < I_UA) { transpose_item_f8(F.in[15], D, 64 * (r / 32), 32 * (r % 32), ws + WS_WUA, 32 * (r % 32), DA, WF8_SCALE, scr, lane); continue; } r -= I_UA;
        if (r < I_OUT) { if (OUT_FP8) transpose_item_f8(F.in[17], D, 64 * (r / 32), 32 * (r % 32), ws + WS_WOUT, 32 * (r % 32), D, WF8_SCALE, scr, lane); else transpose_item(F.in[17], D, 64 * (r / 32), 32 * (r % 32), (bf16_t*)(ws + WS_WOUT), 32 * (r % 32), D, scr, lane); continue; } r -= I_OUT;
        if (r < I_W1 + I_W3) { const int w3 = r >= I_W1; if (w3) r -= I_W1; const int e = r >> 8, q = r & 255, k0 = 64 * (q / 16), n0 = 32 * (q % 16);
            transpose_item_f8((w3 ? F.in[24] : F.in[23]) + (size_t)e * D * DE, DE, k0, n0, ws + WS_W13, (size_t)e * 1024 + 256 * (n0 >> 7) + (n0 & 127) + (w3 ? 128 : 0), D, WF8_SCALE, scr, lane, F.in[18]); continue; }
        r -= I_W1 + I_W3;
        { const int e = r >> 8, q = r & 255, k0 = 64 * (q / 32), n0 = 32 * (q % 32);
            transpose_item_f8(F.in[25] + (size_t)e * DE * D, D, k0, n0, ws + WS_W2, (size_t)e * 1024 + n0, DE, WF8_SCALE, scr, lane); }
    }
    for (int m = 4 * gw; m < T; m += 4 * NGW) rms_rows_to_bf16<4>(lane, F.in[0] + (size_t)m * D, F.in[1], (bf16_t*)(ws + WS_H1) + (size_t)m * D, ws + WS_H1F8 + (size_t)m * D);
    { bf16_t* WR = (bf16_t*)(ws + WS_WR); const float* wrg = F.in[19]; const float* wre = F.in[21];
      for (int idx = F.vcu * NTHR + F.tid; idx < 256 * D; idx += F.G * NTHR) { const int r = idx >> 10, k = idx & 1023; unsigned o = 0u;
          if (r < 72) { const int c = r < 36 ? r : r - 36; const float w = (c < 4 ? wrg[k * 4 + c] : wre[k * 32 + (c - 4)]) * F.in[18][k]; const unsigned hb = f2bf(w);
              o = r < 36 ? hb : f2bf(w - __builtin_bit_cast(float, hb << 16)); }
          WR[idx] = (bf16_t)o; } }
}

__device__ __forceinline__ int crow(int r, int hi) { return (r & 3) + 8 * (r >> 2) + 4 * hi; }
constexpr int KVP = 72;
__device__ __forceinline__ void kv_prep_phase(Frame& F) {
    LAS bf16_t* KS = (LAS bf16_t*)(F.lds); LAS bf16_t* VS = KS + 256 * KVP; LAS float* PS = (LAS float*)(F.lds + 2 * 256 * KVP * 2); LAS float* WM = PS + 512;
    const bf16_t* Kb = (const bf16_t*)(F.ws + WS_K); const bf16_t* Vb = (const bf16_t*)(F.ws + WS_V);
    bf16_t* Kf = (bf16_t*)(F.ws + WS_KFRAG); bf16_t* Vf = (bf16_t*)(F.ws + WS_VFRAG); bf16_t* KM = (bf16_t*)(F.ws + WS_KMEAN); float* KN = (float*)(F.ws + WS_KMEAN + 512 * 1024);
    const int tid = F.tid;
    u32x4 kr[4], vr[4];
#define KVP_LOAD(item_) do { const int n_ = (item_) & 31, h_ = ((item_) >> 5) & 7, b_ = (item_) >> 8; const size_t tok0_ = (size_t)b_ * SEQ + 256 * n_; \
        _Pragma("unroll") for (int j = 0; j < 4; ++j) { const int q = tid + NTHR * j, row = q >> 3, pc = q & 7; const size_t src = (tok0_ + row) * DA + h_ * HD + pc * 8; kr[j] = *(const u32x4*)(Kb + src); vr[j] = *(const u32x4*)(Vb + src); } } while (0)
    if (F.vcu < BATCH * NH * NBLK) KVP_LOAD(F.vcu);
    for (int item = F.vcu; item < BATCH * NH * NBLK; item += F.G) {
#pragma unroll
        for (int j = 0; j < 4; ++j) { const int q = tid + NTHR * j, row = q >> 3, pc = q & 7; *(LAS u32x4*)(KS + row * KVP + pc * 8) = kr[j]; *(LAS u32x4*)(VS + row * KVP + pc * 8) = vr[j]; }
        { const int nx = (item + F.G < BATCH * NH * NBLK) ? item + F.G : item; KVP_LOAD(nx); }
        __syncthreads();
#pragma unroll
        for (int j = 0; j < 4; ++j) { const int P = tid + NTHR * j, st = P >> 8, ds = (P >> 6) & 3, l2 = P & 63, row = 32 * st + (l2 & 31), col = 16 * ds + 8 * (l2 >> 5);
            *(u32x4*)(Kf + ((size_t)item * 2048 + P) * 8) = *(const LAS u32x4*)(KS + row * KVP + col); }
#pragma unroll
        for (int j = 0; j < 4; ++j) { const int P = tid + NTHR * j, st = P >> 8, ks = (P >> 7) & 1, d0 = (P >> 6) & 1, l2 = P & 63, hi = l2 >> 5, jj = l2 & 31; unsigned w[4];
#pragma unroll
            for (int e = 0; e < 8; e += 2) { const unsigned lo = VS[(32 * st + 16 * ks + crow(e, hi)) * KVP + 32 * d0 + jj], hi16 = VS[(32 * st + 16 * ks + crow(e + 1, hi)) * KVP + 32 * d0 + jj]; w[e >> 1] = lo | (hi16 << 16); }
            *(u32x4*)(Vf + ((size_t)item * 2048 + P) * 8) = (u32x4){w[0], w[1], w[2], w[3]}; }
        { const int d = tid & 63, part = tid >> 6; float s = 0.f;
#pragma unroll 8
          for (int r = 0; r < 32; ++r) s += bf2f(KS[(part * 32 + r) * KVP + d]);
          PS[part * 64 + d] = s; }
        if (tid < 256) { float ss = 0.f;
#pragma unroll
            for (int c = 0; c < 8; ++c) { const u32x4 w = *(const LAS u32x4*)(KS + tid * KVP + c * 8);
                ss += bflo(w.x) * bflo(w.x) + bfhi(w.x) * bfhi(w.x) + bflo(w.y) * bflo(w.y) + bfhi(w.y) * bfhi(w.y) + bflo(w.z) * bflo(w.z) + bfhi(w.z) * bfhi(w.z) + bflo(w.w) * bflo(w.w) + bfhi(w.w) * bfhi(w.w); }
            ss = wave_max(ss); if (F.lane == 0) WM[F.wave] = ss; }
        __syncthreads();
        if (tid < 64) { float s = 0.f;
#pragma unroll
            for (int p = 0; p < 8; ++p) s += PS[p * 64 + tid];
            KM[(size_t)item * 64 + tid] = (bf16_t)f2bf(s * (1.f / 256.f)); }
        if (tid == 0) KN[item] = fmaxf(fmaxf(WM[0], WM[1]), fmaxf(WM[2], WM[3]));
        __syncthreads();
    }
#undef KVP_LOAD
}

__device__ __forceinline__ void ssm_scan_phase(Frame& F) {
    LAS float* FW = (LAS float*)(F.lds);
    const float* E = (const float*)(F.ws + WS_E); bf16_t* UP = (bf16_t*)(F.ws + WS_UP);
    const int w = F.wave, p = F.lane;
    for (int gb = F.vcu; gb < SG * BATCH; gb += F.G) {
        const int g = gb >> 3, b = gb & 7;
        const float lr = F.in[4][g * SP + p], li = F.in[5][g * SP + p], step = __expf(F.in[6][g]);
        float ar, ai; cpow(lr, li, step, 32.f, ar, ai);
        const size_t row0 = (size_t)g * SROWS + b * 256 + 32 * w;
        f32x2 e[32];
#pragma unroll
        for (int j = 0; j < 32; ++j) e[j] = *(const f32x2*)(E + (row0 + j) * 128 + 2 * p);
        float sr = 0.f, si = 0.f;
#pragma unroll
        for (int j = 0; j < 32; ++j) { const float nr = ar * sr - ai * si + e[j].x, ni = ar * si + ai * sr + e[j].y; sr = nr; si = ni; }
        FW[(w * 64 + p) * 2] = sr; FW[(w * 64 + p) * 2 + 1] = si;
        __syncthreads();
        float Ar = ar, Ai = ai;
#pragma unroll
        for (int q = 0; q < 5; ++q) { const float nr = Ar * Ar - Ai * Ai, ni = 2.f * Ar * Ai; Ar = nr; Ai = ni; }
        sr = 0.f; si = 0.f;
        for (int w2 = 0; w2 < w; ++w2) { const float fr = FW[(w2 * 64 + p) * 2], fi = FW[(w2 * 64 + p) * 2 + 1]; const float nr = Ar * sr - Ai * si + fr, ni = Ar * si + Ai * sr + fi; sr = nr; si = ni; }
#pragma unroll
        for (int j = 0; j < 32; ++j) { *(unsigned*)(UP + (row0 + j) * SKY + SKU + 2 * p) = pk2(sr, si);
            const float nr = ar * sr - ai * si + e[j].x, ni = ar * si + ai * sr + e[j].y; sr = nr; si = ni; }
        __syncthreads();
    }
}

__device__ __forceinline__ int t5_bucket(int d) {
    if (d < 16) return d;
    return 16 + (d >= 19) + (d >= 21) + (d >= 24) + (d >= 27) + (d >= 31) + (d >= 35) + (d >= 40) + (d >= 46) + (d >= 52) + (d >= 59) + (d >= 67) + (d >= 77) + (d >= 87) + (d >= 99) + (d >= 113);
}
struct Top3 { float v0, v1, v2; int i0, i1, i2; };
__device__ __forceinline__ Top3 top3_insert(Top3 t, float x, int n) {
    const bool b0 = (x > t.v0) || (x == t.v0 && n < t.i0), b1 = (x > t.v1) || (x == t.v1 && n < t.i1), b2 = (x > t.v2) || (x == t.v2 && n < t.i2);
    Top3 r;
    r.v2 = b1 ? t.v1 : (b2 ? x : t.v2); r.i2 = b1 ? t.i1 : (b2 ? n : t.i2);
    r.v1 = b0 ? t.v0 : (b1 ? x : t.v1); r.i1 = b0 ? t.i0 : (b1 ? n : t.i1);
    r.v0 = b0 ? x : t.v0; r.i0 = b0 ? n : t.i0;
    return r;
}
constexpr int GQS = 0, GKME = 36864, GCNTL = 41472, GMISC = 41600;
struct GatePre { u32x4 q[4]; u32x4 km; float kn, rbv; };
__device__ __forceinline__ void attn_gate_prefetch(Frame& F, int tid, int u, GatePre& P) {
    const int bh = u >> 5, qb = u & 31, b = bh >> 3, h = bh & 7, lane = tid & 63; const size_t tok0 = (size_t)b * SEQ + 256 * qb;
    const bf16_t* Qb = (const bf16_t*)(F.ws + WS_Q); const bf16_t* KM = (const bf16_t*)(F.ws + WS_KMEAN); const float* KN = (const float*)(F.ws + WS_KMEAN + 512 * 1024);
#pragma unroll
    for (int jj = 0; jj < 4; ++jj) { const int q = tid + NTHR * jj, row = q >> 3, pc = q & 7; P.q[jj] = *(const u32x4*)(Qb + (tok0 + row) * DA + h * HD + pc * 8); }
    { const int t2 = tid & 255, n = t2 >> 3, pc = t2 & 7; P.km = *(const u32x4*)(KM + ((size_t)bh * 32 + n) * 64 + pc * 8); }
    P.kn = KN[bh * 32 + (lane & 31)]; P.rbv = F.in[16][h * 32 + (lane & 31)];
}
template <bool COUNT> __device__ __forceinline__ void attn_gate_unit(Frame& F, int bh, int qb, const GatePre& P, int unext, GatePre& PN) {
    LAS unsigned char* L = F.lds;
    LAS bf16_t* QS = (LAS bf16_t*)(L + GQS); LAS bf16_t* KME = (LAS bf16_t*)(L + GKME); LAS int* CNT = (LAS int*)(L + GCNTL); LAS float* KNM = (LAS float*)(L + GMISC);
    int tid = F.tid; asm volatile("" : "+v"(tid));
    const int lane = tid & 63, w = F.wave, j = lane & 31, hi = lane >> 5;
    const int b = bh >> 3, h = bh & 7; const size_t tok0 = (size_t)b * SEQ + 256 * qb;
    const bf16_t* Qb = (const bf16_t*)(F.ws + WS_Q); const bf16_t* KM = (const bf16_t*)(F.ws + WS_KMEAN); const float* KN = (const float*)(F.ws + WS_KMEAN + 512 * 1024);
    float* MQg = (float*)(F.ws + WS_MQ); unsigned short* QL = (unsigned short*)(F.ws + WS_QLIST); unsigned* GC = (unsigned*)(F.ctl + CW_GCNT); unsigned* SEGC = (unsigned*)(F.ws + WS_SEGC);
#pragma unroll
    for (int jj = 0; jj < 4; ++jj) { const int q = tid + NTHR * jj, row = q >> 3, pc = q & 7; *(LAS u32x4*)(QS + row * KVP + pc * 8) = P.q[jj]; }
    if (tid < 256) { const int n = tid >> 3, pc = tid & 7; *(LAS u32x4*)(KME + n * KVP + pc * 8) = P.km; }
    if (tid < 32) CNT[tid] = 0;
    if (w == 1) { float v = (lane <= qb && lane < 32) ? P.kn : 0.f; v = wave_max(v); if (lane == 0) KNM[0] = v; }
    if (w == 2) { float v = wave_max(P.rbv); if (lane == 0) KNM[1] = v * LOG2E; }
    attn_gate_prefetch(F, tid, unext, PN);
    __syncthreads();
    {
        bf16x8 qf[4], kmf[4];
#pragma unroll
        for (int ds = 0; ds < 4; ++ds) { qf[ds] = *(const LAS bf16x8*)(QS + (32 * w + j) * KVP + 16 * ds + 8 * hi); kmf[ds] = *(const LAS bf16x8*)(KME + j * KVP + 16 * ds + 8 * hi); }
        f32x16 gt = {};
#pragma unroll
        for (int ds = 0; ds < 4; ++ds) gt = __builtin_amdgcn_mfma_f32_32x32x16_bf16(kmf[ds], qf[ds], gt, 0, 0, 0);
        float qn = 0.f;
#pragma unroll
        for (int ds = 0; ds < 4; ++ds)
#pragma unroll
            for (int e = 0; e < 8; ++e) { const float x = bf2f((unsigned short)qf[ds][e]); qn += x * x; }
        qn += __shfl_xor(qn, 32);
        const float m2 = sqrtf(qn * KNM[0]) + KNM[1];
        const int ql = 256 * qb + 32 * w + j;
        if (hi == 0) MQg[(size_t)bh * SEQ + ql] = m2;
        Top3 t3; t3.v0 = t3.v1 = t3.v2 = -INFINITY; t3.i0 = t3.i1 = t3.i2 = -1;
#pragma unroll
        for (int r = 0; r < 16; ++r) { const int n = crow(r, hi); const float x = (n < qb) ? gt[r] : -INFINITY; t3 = top3_insert(t3, x, x > -INFINITY ? n : 0x7fffffff); }
        { const float p0 = __shfl_xor(t3.v0, 32), p1 = __shfl_xor(t3.v1, 32), p2 = __shfl_xor(t3.v2, 32); const int q0 = __shfl_xor(t3.i0, 32), q1 = __shfl_xor(t3.i1, 32), q2 = __shfl_xor(t3.i2, 32);
          t3 = top3_insert(t3, p0, q0 >= 0 ? q0 : 0x7fffffff); t3 = top3_insert(t3, p1, q1 >= 0 ? q1 : 0x7fffffff); t3 = top3_insert(t3, p2, q2 >= 0 ? q2 : 0x7fffffff); }
        const int i0 = t3.v0 > -INFINITY ? t3.i0 : -1, i1 = t3.v1 > -INFINITY ? t3.i1 : -1, i2 = t3.v2 > -INFINITY ? t3.i2 : -1;
        if (hi == 0) { const unsigned e = (unsigned)ql << 2;
            if (i0 >= 0) { const int pos = __hip_atomic_fetch_add(CNT + i0, 1, __ATOMIC_RELAXED, __HIP_MEMORY_SCOPE_WORKGROUP); QL[((size_t)bh * 32 + i0) * SEQ + (qb - i0 - 1) * 256 + pos] = (unsigned short)(e | 0u); }
            if (i1 >= 0) { const int pos = __hip_atomic_fetch_add(CNT + i1, 1, __ATOMIC_RELAXED, __HIP_MEMORY_SCOPE_WORKGROUP); QL[((size_t)bh * 32 + i1) * SEQ + (qb - i1 - 1) * 256 + pos] = (unsigned short)(e | 1u); }
            if (i2 >= 0) { const int pos = __hip_atomic_fetch_add(CNT + i2, 1, __ATOMIC_RELAXED, __HIP_MEMORY_SCOPE_WORKGROUP); QL[((size_t)bh * 32 + i2) * SEQ + (qb - i2 - 1) * 256 + pos] = (unsigned short)(e | 2u); } }
    }
    __syncthreads();
    if (tid < qb) { const unsigned c = (unsigned)CNT[tid]; SEGC[((size_t)bh * 32 + tid) * 32 + (qb - tid - 1)] = c; if (COUNT && c) (void)__hip_atomic_fetch_add(GC + bh * 32 + tid, c, __ATOMIC_RELAXED, __HIP_MEMORY_SCOPE_AGENT); }
    __syncthreads();
}
template <bool COUNT> __device__ __forceinline__ void attn_gate_phase(Frame& F) {
    constexpr int NU = BATCH * NH * NBLK; if (F.vcu >= NU) return;
    GatePre PA, PB; attn_gate_prefetch(F, F.tid, F.vcu, PA);
    for (int u = F.vcu; u < NU; u += 2 * F.G) {
        const int u1 = u + F.G, u2 = u + 2 * F.G;
        attn_gate_unit<COUNT>(F, u >> 5, u & 31, PA, u1 < NU ? u1 : u, PB);
        if (u1 < NU) attn_gate_unit<COUNT>(F, u1 >> 5, u1 & 31, PB, u2 < NU ? u2 : u1, PA);
    }
}

__device__ __forceinline__ int prefix32_dpp(int v) {
    v += __builtin_amdgcn_update_dpp(0, v, 0x111, 0xF, 0xF, false);
    v += __builtin_amdgcn_update_dpp(0, v, 0x112, 0xF, 0xF, false);
    v += __builtin_amdgcn_update_dpp(0, v, 0x114, 0xF, 0xF, false);
    v += __builtin_amdgcn_update_dpp(0, v, 0x118, 0xF, 0xF, false);
    v += __builtin_amdgcn_update_dpp(0, v, 0x142, 0xA, 0xF, false);
    return v;
}
#define ATTN_SBAR __builtin_amdgcn_sched_barrier(0)
#ifndef ATTN_SETPRIO
#define ATTN_SETPRIO 0
#endif
#define ATTN_PRIO(p_) do { if (ATTN_SETPRIO) __builtin_amdgcn_s_setprio(p_); } while (0)
#define ATTN_LOADF(KF_, VF_, KP, VP, st_) do { \
        _Pragma("unroll") for (int ds_ = 0; ds_ < 4; ++ds_) KF_[ds_] = *(const LAS bf16x8*)((KP) + ((st_) * 4 + ds_) * 512 + lane8); \
        _Pragma("unroll") for (int q_ = 0; q_ < 4; ++q_) VF_[q_] = *(const LAS bf16x8*)((VP) + ((st_) * 4 + q_) * 512 + lane8); } while (0)
#define ATTN_COMPUTE(KF_, VF_, st_, MODE, CINIT) do { \
        ATTN_PRIO(1); f32x16 s_ = __builtin_amdgcn_mfma_f32_32x32x16_bf16(KF_[0], qf[0], CINIT, 0, 0, 0); \
        _Pragma("unroll") for (int ds_ = 1; ds_ < 4; ++ds_) s_ = __builtin_amdgcn_mfma_f32_32x32x16_bf16(KF_[ds_], qf[ds_], s_, 0, 0, 0); ATTN_PRIO(0); \
        float p_[16]; \
        if ((MODE) == 0) { _Pragma("unroll") for (int r_ = 0; r_ < 16; ++r_) p_[r_] = __builtin_amdgcn_exp2f(s_[r_]); } \
        else if ((MODE) == 1) { _Pragma("unroll") for (int r_ = 0; r_ < 16; ++r_) { const int dist_ = dq - (32 * (st_) + crow(r_, hi)); const int di_ = dist_ < 0 ? 0 : (dist_ > 127 ? 127 : dist_); \
                p_[r_] = __builtin_amdgcn_exp2f(s_[r_] + TABh[di_]); } } \
        else { _Pragma("unroll") for (int rq_ = 0; rq_ < 4; ++rq_) { const f32x4 bb_ = *(const LAS f32x4*)(BTD + rq_ * 256 + lane * 4); \
                _Pragma("unroll") for (int i_ = 0; i_ < 4; ++i_) p_[4 * rq_ + i_] = __builtin_amdgcn_exp2f(s_[4 * rq_ + i_] + bb_[i_]); } } \
        _Pragma("unroll") for (int r_ = 0; r_ < 16; ++r_) lsum += p_[r_]; \
        u32x4 pa_, pb_; pa_.x = cvt_pk_bf16(p_[0], p_[1]); pa_.y = cvt_pk_bf16(p_[2], p_[3]); pa_.z = cvt_pk_bf16(p_[4], p_[5]); pa_.w = cvt_pk_bf16(p_[6], p_[7]); \
        pb_.x = cvt_pk_bf16(p_[8], p_[9]); pb_.y = cvt_pk_bf16(p_[10], p_[11]); pb_.z = cvt_pk_bf16(p_[12], p_[13]); pb_.w = cvt_pk_bf16(p_[14], p_[15]); \
        const bf16x8 A0_ = __builtin_bit_cast(bf16x8, pa_), A1_ = __builtin_bit_cast(bf16x8, pb_); \
        ATTN_PRIO(1); o0 = __builtin_amdgcn_mfma_f32_32x32x16_bf16(VF_[0], A0_, o0, 0, 0, 0); o1 = __builtin_amdgcn_mfma_f32_32x32x16_bf16(VF_[1], A0_, o1, 0, 0, 0); \
        o0 = __builtin_amdgcn_mfma_f32_32x32x16_bf16(VF_[2], A1_, o0, 0, 0, 0); o1 = __builtin_amdgcn_mfma_f32_32x32x16_bf16(VF_[3], A1_, o1, 0, 0, 0); ATTN_PRIO(0); } while (0)
#define ATTN_TILE8(KP, VP, MODE, CINIT, HOOK) do { bf16x8 kA_[4], vA_[4], kB_[4], vB_[4]; ATTN_LOADF(kA_, vA_, KP, VP, 0); \
        _Pragma("nounroll") for (int st2_ = 0; st2_ < 8; st2_ += 2) { ATTN_LOADF(kB_, vB_, KP, VP, st2_ + 1); ATTN_SBAR; ATTN_COMPUTE(kA_, vA_, st2_, MODE, CINIT); HOOK(st2_); \
            ATTN_LOADF(kA_, vA_, KP, VP, (st2_ + 2 < 8 ? st2_ + 2 : 7)); ATTN_SBAR; ATTN_COMPUTE(kB_, vB_, st2_ + 1, MODE, CINIT); } } while (0)

__device__ __forceinline__ u32x4 ot_pack16(const f32x16& o, int pr) {
    const unsigned p0 = cvt_pk_bf16(o[8 * pr], o[8 * pr + 1]), p1 = cvt_pk_bf16(o[8 * pr + 2], o[8 * pr + 3]), q0 = cvt_pk_bf16(o[8 * pr + 4], o[8 * pr + 5]), q1 = cvt_pk_bf16(o[8 * pr + 6], o[8 * pr + 7]);
    const auto r0 = __builtin_amdgcn_permlane32_swap(p0, q0, false, false); const auto r1 = __builtin_amdgcn_permlane32_swap(p1, q1, false, false);
    return (u32x4){r0[0], r1[0], r0[1], r1[1]};
}
__device__ __forceinline__ u32x2 ot_pack8_f8(const f32x16& o, int pr) {
    const unsigned p = pk4_fp8(o[8 * pr], o[8 * pr + 1], o[8 * pr + 2], o[8 * pr + 3]), q = pk4_fp8(o[8 * pr + 4], o[8 * pr + 5], o[8 * pr + 6], o[8 * pr + 7]);
    const auto r0 = __builtin_amdgcn_permlane32_swap(p, q, false, false);
    return (u32x2){r0[0], r0[1]};
}
__device__ __forceinline__ void ot_add16(f32x16& o, int pr, u32x4 v, bool use) {
    const auto r0 = __builtin_amdgcn_permlane32_swap(v.x, v.z, false, false); const auto r1 = __builtin_amdgcn_permlane32_swap(v.y, v.w, false, false);
    const unsigned p0 = r0[0], p1 = r1[0], q0 = r0[1], q1 = r1[1];
    o[8 * pr] += use ? bflo(p0) : 0.f; o[8 * pr + 1] += use ? bfhi(p0) : 0.f; o[8 * pr + 2] += use ? bflo(p1) : 0.f; o[8 * pr + 3] += use ? bfhi(p1) : 0.f;
    o[8 * pr + 4] += use ? bflo(q0) : 0.f; o[8 * pr + 5] += use ? bfhi(q0) : 0.f; o[8 * pr + 6] += use ? bflo(q1) : 0.f; o[8 * pr + 7] += use ? bfhi(q1) : 0.f;
}
__device__ __forceinline__ void ot_add8_f8(f32x16& o, int pr, u32x2 v, bool use, float sc) {
    const auto r0 = __builtin_amdgcn_permlane32_swap(v.x, v.y, false, false); const int p = (int)r0[0], q = (int)r0[1];
    o[8 * pr] += use ? __builtin_amdgcn_cvt_f32_fp8(p, 0) * sc : 0.f; o[8 * pr + 1] += use ? __builtin_amdgcn_cvt_f32_fp8(p, 1) * sc : 0.f; o[8 * pr + 2] += use ? __builtin_amdgcn_cvt_f32_fp8(p, 2) * sc : 0.f; o[8 * pr + 3] += use ? __builtin_amdgcn_cvt_f32_fp8(p, 3) * sc : 0.f;
    o[8 * pr + 4] += use ? __builtin_amdgcn_cvt_f32_fp8(q, 0) * sc : 0.f; o[8 * pr + 5] += use ? __builtin_amdgcn_cvt_f32_fp8(q, 1) * sc : 0.f; o[8 * pr + 6] += use ? __builtin_amdgcn_cvt_f32_fp8(q, 2) * sc : 0.f; o[8 * pr + 7] += use ? __builtin_amdgcn_cvt_f32_fp8(q, 3) * sc : 0.f;
}
__device__ __forceinline__ u32x4 ot_pack16_f8(const f32x16& o) {
    const unsigned a = pk4_fp8(o[0], o[1], o[2], o[3]), b = pk4_fp8(o[4], o[5], o[6], o[7]), c = pk4_fp8(o[8], o[9], o[10], o[11]), d = pk4_fp8(o[12], o[13], o[14], o[15]);
    const auto r0 = __builtin_amdgcn_permlane32_swap(a, c, false, false); const auto r1 = __builtin_amdgcn_permlane32_swap(b, d, false, false);
    return (u32x4){r0[0], r0[1], r1[0], r1[1]};
}
__device__ __forceinline__ void ot_add16_f8(f32x16& o, u32x4 v, bool use, float sc) {
    const auto r0 = __builtin_amdgcn_permlane32_swap(v.x, v.y, false, false); const auto r1 = __builtin_amdgcn_permlane32_swap(v.z, v.w, false, false);
    const int a = (int)r0[0], c = (int)r0[1], b = (int)r1[0], d = (int)r1[1];
#pragma unroll
    for (int e = 0; e < 4; ++e) { float fa, fb, fc, fd;
        switch (e) { case 0: fa = __builtin_amdgcn_cvt_f32_fp8(a, 0); fb = __builtin_amdgcn_cvt_f32_fp8(b, 0); fc = __builtin_amdgcn_cvt_f32_fp8(c, 0); fd = __builtin_amdgcn_cvt_f32_fp8(d, 0); break;
                     case 1: fa = __builtin_amdgcn_cvt_f32_fp8(a, 1); fb = __builtin_amdgcn_cvt_f32_fp8(b, 1); fc = __builtin_amdgcn_cvt_f32_fp8(c, 1); fd = __builtin_amdgcn_cvt_f32_fp8(d, 1); break;
                     case 2: fa = __builtin_amdgcn_cvt_f32_fp8(a, 2); fb = __builtin_amdgcn_cvt_f32_fp8(b, 2); fc = __builtin_amdgcn_cvt_f32_fp8(c, 2); fd = __builtin_amdgcn_cvt_f32_fp8(d, 2); break;
                     default: fa = __builtin_amdgcn_cvt_f32_fp8(a, 3); fb = __builtin_amdgcn_cvt_f32_fp8(b, 3); fc = __builtin_amdgcn_cvt_f32_fp8(c, 3); fd = __builtin_amdgcn_cvt_f32_fp8(d, 3); break; }
        o[e] += use ? fa * sc : 0.f; o[4 + e] += use ? fb * sc : 0.f; o[8 + e] += use ? fc * sc : 0.f; o[12 + e] += use ? fd * sc : 0.f; }
}
__device__ __forceinline__ void attn_fill_tab(Frame& F, LAS float* TAB) {
    const float* rb = F.in[16];
    for (int idx = F.tid; idx < 8 * 132; idx += NTHR) { const int h = idx / 132, d = idx % 132; float v = 0.f;
        if (d < 128) v = rb[h * 32 + t5_bucket(d)] * LOG2E; else if (d == 129) v = rb[h * 32 + 31] * LOG2E;
        TAB[idx] = v; }
}
constexpr int BGPRE_OFF = ROWTAB_OFF, BGCL_OFF = ROWTAB_OFF + 8448, BTAB_OFF = ROWTAB_OFF + 16640, BIT_OFF = ROWTAB_OFF + 20992, BIT_MAX = 512, OTAB_OFF = ROWTAB_OFF + 20480  ;
static_assert(BTAB_OFF + 8 * 132 * 4 <= MOE_TST_OFF, "attention LDS tables");
__device__ __forceinline__ size_t part_off(int slot) { return slot == 0 ? WS_PART0 : (slot == 1 ? WS_PART1 : WS_PART2); }

__device__ __forceinline__ void attn_block_phase(Frame& F) {
    LAS unsigned char* L = F.lds; LAS int* GPRE = (LAS int*)(L + BGPRE_OFF); LAS int* GCL = (LAS int*)(L + BGCL_OFF); LAS float* TAB = (LAS float*)(L + BTAB_OFF); LAS int* ITT = (LAS int*)(L + BIT_OFF); LAS int* WSUM = (LAS int*)(L + MOE_TST_OFF);
    const unsigned* GC = (const unsigned*)(F.ctl + CW_GCNT); const unsigned* SEGC = (const unsigned*)(F.ws + WS_SEGC);
    const int tid = F.tid, lane = F.lane, w = F.wave, j = lane & 31, hi = lane >> 5, lane8 = lane * 8;
    { int ng[4], tot = 0;
#pragma unroll
      for (int e = 0; e < 4; ++e) { const int c = (int)GC[4 * tid + e]; GCL[4 * tid + e] = c; ng[e] = (((c + 31) >> 5) + 7) >> 3; tot += ng[e]; }
      int inc = tot;
#pragma unroll
      for (int o = 1; o < 64; o <<= 1) { const int t = __shfl_up(inc, o); if (lane >= o) inc += t; }
      if (lane == 63) WSUM[w] = inc;
      __syncthreads();
      int woff = 0;
      for (int q = 0; q < w; ++q) woff += WSUM[q];
      int ex = woff + inc - tot;
#pragma unroll
      for (int e = 0; e < 4; ++e) { GPRE[4 * tid + e] = ex; ex += ng[e]; }
      if (tid == NTHR - 1) GPRE[2048] = ex; }
    attn_fill_tab(F, TAB);
    __syncthreads();
    const int NIT = GPRE[2048];
    const int nk = (NIT > F.vcu) ? (NIT - F.vcu + F.G - 1) / F.G : 0;
    if (tid < nk && tid < BIT_MAX) { const int it_ = F.vcu + tid * F.G; int lo_ = 0, hi_ = 2048; while (hi_ - lo_ > 1) { const int mid_ = (lo_ + hi_) >> 1; if (GPRE[mid_] <= it_) lo_ = mid_; else hi_ = mid_; } ITT[tid] = lo_ * 64 + (it_ - GPRE[lo_]); }
    __syncthreads();
    if (nk == 0) return;
    const int nkc = nk < BIT_MAX ? nk : BIT_MAX;
    const bf16_t* Qb = (const bf16_t*)(F.ws + WS_Q); const float* MQg = (const float*)(F.ws + WS_MQ); const unsigned short* QL = (const unsigned short*)(F.ws + WS_QLIST);
    const bf16_t* KF = (const bf16_t*)(F.ws + WS_KFRAG); const bf16_t* VF = (const bf16_t*)(F.ws + WS_VFRAG);
    float* PL = (float*)(F.ws + WS_PL);
#define BLK_ITEM(k_, pi_, g_) do { const int kk_ = (k_) < nkc ? (k_) : nkc - 1; const int v_ = __builtin_amdgcn_readfirstlane(ITT[kk_]); pi_ = v_ >> 6; g_ = v_ & 63; } while (0)
#define BLK_DMA2(buf_, pi_, i0_) do { const char* ks_ = (const char*)KF + ((size_t)(pi_) * 2048 + tid) * 16; const char* vs_ = (const char*)VF + ((size_t)(pi_) * 2048 + tid) * 16; \
        _Pragma("unroll") for (int i_ = (i0_); i_ < (i0_) + 2; ++i_) { \
            __builtin_amdgcn_global_load_lds((const unsigned*)(ks_ + i_ * 8192), (LAS unsigned*)(L + (buf_) + (i_ * 512 + w * 64) * 16), 16, 0, 0); \
            __builtin_amdgcn_global_load_lds((const unsigned*)(vs_ + i_ * 8192), (LAS unsigned*)(L + (buf_) + 32768 + (i_ * 512 + w * 64) * 16), 16, 0, 0); } } while (0)
#define BLK_DMA(buf_, pi_) do { const char* ks_ = (const char*)KF + ((size_t)(pi_) * 2048 + tid) * 16; const char* vs_ = (const char*)VF + ((size_t)(pi_) * 2048 + tid) * 16; \
        _Pragma("unroll") for (int i_ = 0; i_ < 4; ++i_) { \
            __builtin_amdgcn_global_load_lds((const unsigned*)(ks_ + i_ * 8192), (LAS unsigned*)(L + (buf_) + (i_ * 512 + w * 64) * 16), 16, 0, 0); \
            __builtin_amdgcn_global_load_lds((const unsigned*)(vs_ + i_ * 8192), (LAS unsigned*)(L + (buf_) + 32768 + (i_ * 512 + w * 64) * 16), 16, 0, 0); } } while (0)
#define BLK_SEGC(dst_, pi_) do { dst_ = SEGC[(size_t)(pi_) * 32 + j]; } while (0)
#define BLK_ENTRY(dst_, segc_, pi_, g_) do { const int n_ = (pi_) & 31; int inc_ = (j < 31 - n_) ? (int)(segc_) : 0; \
        inc_ = prefix32_dpp(inc_); \
        const int cnt_ = GCL[pi_]; const int base_ = 32 * (8 * (g_) + w); const int idx_ = base_ + j; const bool vs_ = j < 31 - n_; \
          \
        const unsigned lb_ = (unsigned)__ballot(vs_ && inc_ <= base_); const int seg0_ = __builtin_popcount(lb_); \
        int seg_ = seg0_, prev_ = seg0_ > 0 ? __builtin_amdgcn_readlane(inc_, seg0_ - 1) : 0; \
        unsigned wm_ = (unsigned)__ballot(vs_ && inc_ > base_ && inc_ <= base_ + 31); \
        while (wm_ != 0u) { const int s_ = __builtin_ctz(wm_); wm_ &= wm_ - 1u; const int p_ = __builtin_amdgcn_readlane(inc_, s_); const bool le_ = p_ <= idx_; seg_ += le_ ? 1 : 0; prev_ = le_ ? p_ : prev_; } \
        const bool ok_ = idx_ < cnt_; const unsigned v_ = QL[(size_t)(pi_) * SEQ + (ok_ ? seg_ * 256 + (idx_ - prev_) : 0)]; dst_ = ok_ ? v_ : 0xFFFFu; } while (0)
#define BLK_QLOAD(qf_, m2_, ent_, pi_) do { const unsigned qq_ = ((ent_) == 0xFFFFu) ? 0u : ((ent_) >> 2); const int bh_ = (pi_) >> 5; \
        const bf16_t* qrow_ = Qb + ((size_t)(bh_ >> 3) * SEQ + qq_) * DA + (bh_ & 7) * HD + 8 * hi; \
        _Pragma("unroll") for (int ds_ = 0; ds_ < 4; ++ds_) qf_[ds_] = *(const bf16x8*)(qrow_ + 16 * ds_); \
        m2_ = MQg[(size_t)bh_ * SEQ + qq_]; } while (0)
    int pi, g, pi1, g1, pi2, g2; unsigned ent, ent1, sc2; bf16x8 qf[4]; float m2r;
    BLK_ITEM(0, pi, g); BLK_ITEM(1, pi1, g1); BLK_ITEM(2, pi2, g2);
    BLK_DMA(0, pi);
    { unsigned sc0, sc1; BLK_SEGC(sc0, pi); BLK_SEGC(sc1, pi1); BLK_SEGC(sc2, pi2); BLK_ENTRY(ent, sc0, pi, g); BLK_ENTRY(ent1, sc1, pi1, g1); }
    BLK_QLOAD(qf, m2r, ent, pi);
    int cur = 0;
#ifdef PROBE_TW
    unsigned tw_acc_ = 0u; const unsigned long long tt0_ = __builtin_amdgcn_s_memrealtime();
#endif
    __builtin_amdgcn_s_waitcnt(0x0F70);
    unsigned char* dump = F.ws + WS_E + ((size_t)F.vcu * NTHR + tid) * 128;
    for (int k = 0; k < nkc; ++k) {
#ifdef PROBE_TW
        const unsigned long long tw0_ = __builtin_amdgcn_s_memrealtime();
#endif
        __builtin_amdgcn_s_waitcnt(0x0F73);
        __syncthreads();
#ifdef PROBE_TW
        tw_acc_ += (unsigned)(__builtin_amdgcn_s_memrealtime() - tw0_);
#endif
        int pi3, g3; unsigned sc3, ent2; bf16x8 qfn[4]; float m2n;
        BLK_ITEM(k + 3, pi3, g3);
#define BLK_HOOK(st_) do { if ((st_) == 0) { BLK_DMA2((cur ^ 1) * 65536, pi1, 0); } else if ((st_) == 2) { BLK_DMA2((cur ^ 1) * 65536, pi1, 2); } } while (0)
        BLK_SEGC(sc3, pi3);
        BLK_ENTRY(ent2, sc2, pi2, g2);
        BLK_QLOAD(qfn, m2n, ent1, pi1);
        const int bh = pi >> 5, n = pi & 31, h = bh & 7;
        const bool valid = ent != 0xFFFFu; const int q = valid ? (int)(ent >> 2) : 0; const int slot = (int)(ent & 3u);
        const bool active = __builtin_amdgcn_readfirstlane((int)(__ballot(valid) != 0ull)) != 0;
        f32x16 o0 = {}, o1 = {}; float lsum = 0.f;
        if (active) {
            const float m2 = valid ? m2r : INFINITY;
            const LAS bf16_t* KP = (const LAS bf16_t*)(L + cur * 65536); const LAS bf16_t* VP = (const LAS bf16_t*)(L + cur * 65536 + 32768);
            const LAS float* TABh = TAB + h * 132; const LAS float* BTD = nullptr; (void)BTD;
            const int dq = q - 256 * n;
            const bool nearw = __builtin_amdgcn_readfirstlane((int)(__ballot(valid && dq < 383) != 0ull)) != 0;
            const float ci = nearw ? -m2 : TABh[129] - m2;
            f32x16 cinit;
#pragma unroll
            for (int r = 0; r < 16; ++r) cinit[r] = ci;
            if (nearw) { ATTN_TILE8(KP, VP, 1, cinit, BLK_HOOK); }
            else { ATTN_TILE8(KP, VP, 0, cinit, BLK_HOOK); }
        } else { BLK_HOOK(0); BLK_HOOK(2); }
#undef BLK_HOOK
        { const float lt = sum_xor32(lsum);
          const size_t qi = (size_t)bh * SEQ + q;
          float* pld = valid ? PL + (size_t)slot * (NH * BATCH * SEQ) + qi : (float*)(dump + 120);
          unsigned char* dst = valid ? F.ws + part_off(slot) + qi * HD + 16 * hi : dump;
          *pld = lt;
          const float inv = lt > 0.f ? 1.f / lt : 0.f;
#pragma unroll
          for (int r = 0; r < 16; ++r) { o0[r] *= inv; o1[r] *= inv; }
          *(u32x4*)(dst) = ot_pack16_f8(o0); *(u32x4*)(dst + 32) = ot_pack16_f8(o1); }
        pi = pi1; g = g1; ent = ent1; m2r = m2n; pi1 = pi2; g1 = g2; ent1 = ent2; pi2 = pi3; g2 = g3; sc2 = sc3; cur ^= 1;
#pragma unroll
        for (int ds = 0; ds < 4; ++ds) qf[ds] = qfn[ds];
    }
#ifdef PROBE_TW
    if (F.wave == PROBE_TW_WAVE && lane == 0) { __hip_atomic_fetch_add((unsigned*)(F.ctl + 3), tw_acc_, __ATOMIC_RELAXED, __HIP_MEMORY_SCOPE_AGENT); __hip_atomic_fetch_add((unsigned*)(F.ctl + 4), (unsigned)(__builtin_amdgcn_s_memrealtime() - tt0_), __ATOMIC_RELAXED, __HIP_MEMORY_SCOPE_AGENT); }
#endif
    VM_WAIT(); __syncthreads();
#undef BLK_ITEM
#undef BLK_DMA
#undef BLK_DMA2
#undef BLK_SEGC
#undef BLK_ENTRY
#undef BLK_QLOAD
}

__device__ __forceinline__ void attn_own_phase(Frame& F) {
    LAS unsigned char* L = F.lds; LAS float* TAB = (LAS float*)(L + OTAB_OFF); LAS float* BT = (LAS float*)(L + ROWTAB_OFF); int bth = -1;
    attn_fill_tab(F, TAB);
    const int tid = F.tid, lane = F.lane, w = F.wave, j = lane & 31, hi = lane >> 5, lane8 = lane * 8;
    const bf16_t* Qb = (const bf16_t*)(F.ws + WS_Q); const float* MQg = (const float*)(F.ws + WS_MQ);
    const bf16_t* KF = (const bf16_t*)(F.ws + WS_KFRAG); const bf16_t* VF = (const bf16_t*)(F.ws + WS_VFRAG);
    const float* PL = (const float*)(F.ws + WS_PL); unsigned char* YA = F.ws + WS_YATT;
    const int NU = BATCH * NH * NBLK;
#define OWN_DMA(buf_, pi_) do { const char* ks_ = (const char*)KF + ((size_t)(pi_) * 2048 + tid) * 16; const char* vs_ = (const char*)VF + ((size_t)(pi_) * 2048 + tid) * 16; \
        _Pragma("unroll") for (int i_ = 0; i_ < 4; ++i_) { \
            __builtin_amdgcn_global_load_lds((const unsigned*)(ks_ + i_ * 8192), (LAS unsigned*)(L + (buf_) + (i_ * 512 + w * 64) * 16), 16, 0, 0); \
            __builtin_amdgcn_global_load_lds((const unsigned*)(vs_ + i_ * 8192), (LAS unsigned*)(L + (buf_) + 32768 + (i_ * 512 + w * 64) * 16), 16, 0, 0); } } while (0)
#define OWN_DMA_LIGHT(buf_, pi_) do { const char* ks_ = (const char*)KF + ((size_t)(pi_) * 2048 + tid) * 16; const char* vs_ = (const char*)VF + ((size_t)(pi_) * 2048 + tid) * 16; \
        _Pragma("unroll") for (int i_ = 0; i_ < 8; ++i_) { \
            __builtin_amdgcn_global_load_lds((const unsigned*)(ks_ + i_ * 4096), (LAS unsigned*)(L + (buf_) + (i_ * 256 + w * 64) * 16), 16, 0, 0); \
            __builtin_amdgcn_global_load_lds((const unsigned*)(vs_ + i_ * 4096), (LAS unsigned*)(L + (buf_) + 32768 + (i_ * 256 + w * 64) * 16), 16, 0, 0); } } while (0)
#define OWN_QLOAD(qf_, m2_, u_) do { const int bh_ = (u_) >> 5, qb_ = (u_) & 31; const size_t tk_ = (size_t)256 * qb_ + 32 * w + j; \
        const bf16_t* qrow_ = Qb + ((size_t)(bh_ >> 3) * SEQ + tk_) * DA + (bh_ & 7) * HD + 8 * hi; \
        _Pragma("unroll") for (int ds_ = 0; ds_ < 4; ++ds_) qf_[ds_] = *(const bf16x8*)(qrow_ + 16 * ds_); \
        m2_ = MQg[(size_t)bh_ * SEQ + tk_]; } while (0)
    int u = F.vcu; if (u >= NU) return;
    bf16x8 qf[4]; float m2;
    OWN_DMA(0, u); OWN_QLOAD(qf, m2, u);
    int cur = 0;
    __builtin_amdgcn_s_waitcnt(0x0F70);
    for (;;) {
        __builtin_amdgcn_s_waitcnt(0x0F72); __syncthreads();
        const int un = (u + F.G < NU) ? u + F.G : u; const bool last = (un == u);
        const int bh = u >> 5, qb = u & 31, b = bh >> 3, h = bh & 7; const int ql = 32 * w + j; const size_t qi = (size_t)bh * SEQ + 256 * qb + ql;
        u32x4 pa[3][2]; float pl[3]; bf16x8 qfn[4]; float m2n;
#define OWN_PA() do { _Pragma("unroll") for (int s = 0; s < 3; ++s) { const unsigned char* src = F.ws + part_off(s) + qi * HD + 16 * hi; \
            _Pragma("unroll") for (int c = 0; c < 2; ++c) pa[s][c] = *(const u32x4*)(src + 32 * c); } } while (0)
#define OWN_PL() do { _Pragma("unroll") for (int s = 0; s < 3; ++s) pl[s] = PL[(size_t)s * (NH * BATCH * SEQ) + qi]; } while (0)
        const LAS bf16_t* KP = (const LAS bf16_t*)(L + cur * 65536); const LAS bf16_t* VP = (const LAS bf16_t*)(L + cur * 65536 + 32768); const LAS float* TABh = TAB + h * 132;
        if (h != bth) { __syncthreads();
            for (int e = tid; e < 5 * 1024; e += NTHR) { const int i = e & 3, ln = (e >> 2) & 63, rq = (e >> 8) & 3, dl = e >> 10; const int dist = 32 * dl + (ln & 31) - crow(4 * rq + i, ln >> 5);
                BT[e] = dist < 0 ? -1e30f : TABh[dist > 127 ? 127 : dist]; }
            bth = h; __syncthreads(); }
        const int dq = ql; (void)dq;
        f32x16 cnear, cfar;
#pragma unroll
        for (int r = 0; r < 16; ++r) { cnear[r] = -m2; cfar[r] = TABh[129] - m2; }
        f32x16 o0 = {}, o1 = {}; float lsum = 0.f;
        { bf16x8 kA_[4], vA_[4], kB_[4], vB_[4]; ATTN_LOADF(kA_, vA_, KP, VP, 0);
          for (int st = 0; st <= w; st += 2) { const int s1 = st + 1 <= w ? st + 1 : w, s2 = st + 2 <= w ? st + 2 : w;
              ATTN_LOADF(kB_, vB_, KP, VP, s1); ATTN_SBAR;
              { const int dl = w - st; if (dl >= 5) { const LAS float* BTD = nullptr; (void)BTD; ATTN_COMPUTE(kA_, vA_, st, 0, cfar); } else { const LAS float* BTD = BT + dl * 1024; ATTN_COMPUTE(kA_, vA_, st, 2, cnear); } }
              if (w >= 4 && st == 0) OWN_PA();
              ATTN_LOADF(kA_, vA_, KP, VP, s2); ATTN_SBAR;
              if (st + 1 <= w) { const int dl = w - st - 1; if (dl >= 5) { const LAS float* BTD = nullptr; (void)BTD; ATTN_COMPUTE(kB_, vB_, st + 1, 0, cfar); } else { const LAS float* BTD = BT + dl * 1024; ATTN_COMPUTE(kB_, vB_, st + 1, 2, cnear); } }
              if (w >= 4 && st == 2) { OWN_PL(); OWN_QLOAD(qfn, m2n, un); } } }
        if (w < 4) { OWN_PA(); OWN_PL(); OWN_DMA_LIGHT((cur ^ 1) * 65536, un); OWN_QLOAD(qfn, m2n, un); }
        float lt = sum_xor32(lsum);
        const int nsel = qb < 3 ? qb : 3;
#pragma unroll
        for (int s = 0; s < 3; ++s) { const bool use = s < nsel; lt += use ? pl[s] : 0.f;
            ot_add16_f8(o0, pa[s][0], use, pl[s]); ot_add16_f8(o1, pa[s][1], use, pl[s]); }
        const float inv = 1.f / lt;
#pragma unroll
        for (int r = 0; r < 16; ++r) { o0[r] *= inv; o1[r] *= inv; }
        unsigned char* dst = YA + ((size_t)b * SEQ + 256 * qb + ql) * DA + h * HD + 16 * hi;
        *(u32x4*)(dst) = ot_pack16_f8(o0); *(u32x4*)(dst + 32) = ot_pack16_f8(o1);
        if (last) break;
        u = un; m2 = m2n; cur ^= 1;
#pragma unroll
        for (int ds = 0; ds < 4; ++ds) qf[ds] = qfn[ds];
    }
    VM_WAIT(); __syncthreads();
#undef OWN_DMA
#undef OWN_DMA_LIGHT
#undef OWN_PA
#undef OWN_PL
#undef OWN_QLOAD
}
#undef ATTN_LOADF
#undef ATTN_COMPUTE
#undef ATTN_TILE8
#undef ATTN_SBAR

__device__ __forceinline__ void routing_phase(Frame& F) {
    LAS int* lcnt = (LAS int*)(F.lds); LAS int* lbase = lcnt + 32;
    const float* SSQ = (const float*)(F.ws + WS_SSQ); const float* RL = (const float*)(F.ws + WS_RLOG);
    unsigned* rowtok = (unsigned*)(F.ws + WS_ROWTOK); float* rowcoef = (float*)(F.ws + WS_ROWCOEF); float* rowrstd = (float*)(F.ws + WS_ROWRSTD);
    unsigned* ecnt = (unsigned*)(F.ctl + CW_ECNT);
    const float* brg = F.in[20]; const float* bre = F.in[22];
    const int tid = F.tid;
    for (int base = F.vcu * 256; base < T; base += F.G * 256) {
        if (tid < 32) lcnt[tid] = 0;
        __syncthreads();
        int e0 = 0, e1 = 0, lp0 = 0, lp1 = 0; float c0 = 0.f, c1 = 0.f, rstd = 0.f; const int tok = base + tid;
        if (tid < 256) {
            float ss = 0.f;
#pragma unroll
            for (int q = 0; q < 4; ++q) { const f32x4 v = *(const f32x4*)(SSQ + (size_t)tok * 16 + 4 * q); ss += (v.x + v.y) + (v.z + v.w); }
            rstd = 1.f / sqrtf(ss * (1.f / D) + RMS_EPS);
            float r[72];
#pragma unroll
            for (int q = 0; q < 18; ++q) { const f32x4 v = *(const f32x4*)(RL + (size_t)tok * 72 + 4 * q); r[4 * q] = v.x; r[4 * q + 1] = v.y; r[4 * q + 2] = v.z; r[4 * q + 3] = v.w; }
            float gl[4], el[32];
#pragma unroll
            for (int c = 0; c < 4; ++c) gl[c] = rstd * (r[c] + r[36 + c]) + brg[c];
#pragma unroll
            for (int c = 0; c < 32; ++c) el[c] = rstd * (r[4 + c] + r[40 + c]) + bre[c];
            int gi = 0; float gm = gl[0];
#pragma unroll
            for (int c = 1; c < 4; ++c) if (gl[c] > gm) { gm = gl[c]; gi = c; }
            float Z = 0.f;
#pragma unroll
            for (int c = 0; c < 4; ++c) Z += __expf(gl[c] - gm);
            const float gval = 1.f / Z;
            float es[8];
#pragma unroll
            for (int q = 0; q < 8; ++q) es[q] = gi == 0 ? el[q] : (gi == 1 ? el[8 + q] : (gi == 2 ? el[16 + q] : el[24 + q]));
            int a0 = 0; float m0 = es[0];
#pragma unroll
            for (int q = 1; q < 8; ++q) if (es[q] > m0) { m0 = es[q]; a0 = q; }
            int a1 = -1; float m1 = -INFINITY;
#pragma unroll
            for (int q = 0; q < 8; ++q) if (q != a0 && es[q] > m1) { m1 = es[q]; a1 = q; }
            const float w0 = 1.f / (1.f + __expf(m1 - m0)), w1 = 1.f - w0;
            e0 = gi * 8 + a0; e1 = gi * 8 + a1; c0 = gval * w0; c1 = gval * w1;
            lp0 = __hip_atomic_fetch_add(lcnt + e0, 1, __ATOMIC_RELAXED, __HIP_MEMORY_SCOPE_WORKGROUP);
            lp1 = __hip_atomic_fetch_add(lcnt + e1, 1, __ATOMIC_RELAXED, __HIP_MEMORY_SCOPE_WORKGROUP);
        }
        __syncthreads();
        if (tid < 32) lbase[tid] = (int)__hip_atomic_fetch_add(ecnt + tid, (unsigned)lcnt[tid], __ATOMIC_RELAXED, __HIP_MEMORY_SCOPE_AGENT);
        __syncthreads();
        if (tid < 256) {
            const size_t i0 = (size_t)e0 * ROWCAP + lbase[e0] + lp0, i1 = (size_t)e1 * ROWCAP + lbase[e1] + lp1;
            rowtok[i0] = (unsigned)tok * 2u; rowcoef[i0] = c0; rowrstd[i0] = rstd;
            rowtok[i1] = (unsigned)tok * 2u + 1u; rowcoef[i1] = c1; rowrstd[i1] = rstd;
        }
        __syncthreads();
    }
}
struct MoeOrder {
    const LAS int* tst; int total, G, v; bool blocked;
    __device__ bool next(int i, pg8::Unit& u) const {
        int L;
        if (blocked) { const int b0 = (int)(((long)v * total) / G), b1 = (int)(((long)(v + 1) * total) / G); L = b0 + i; if (L >= b1) return false; }
        else { L = i * G + v; if (L >= total) return false; }
        const int rt = L >> 2; int e = 0;
#pragma unroll 8
        for (int q = 1; q <= 32; ++q) e += (tst[q] <= rt) ? 1 : 0;
        u.pm = rt; u.pn = L & 3; u.pb = e * 4 + u.pn; u.aux = e; u.aux2 = (rt - tst[e]) * 256; u.aux3 = tst[64 + e]; u.aux4 = i; return true;
    }
};
__device__ __forceinline__ void moe_tables(Frame& F) {
    LAS int* tst = (LAS int*)(F.lds + MOE_TST_OFF); const unsigned* ecnt = (const unsigned*)(F.ctl + CW_ECNT);
    if (F.wave == 0) { const int lane = F.lane; int nt = lane < 32 ? (int)((ecnt[lane & 31] + 255u) >> 8) : 0; int inc = nt;
#pragma unroll
        for (int o = 1; o < 32; o <<= 1) { const int t = __shfl_up(inc, o); if (lane >= o) inc += t; }
        if (lane < 32) { tst[lane + 1] = inc; tst[64 + lane] = (int)ecnt[lane]; } if (lane == 0) tst[0] = 0; }
    __syncthreads();
}
#if defined(PROBE_TW) || defined(PROBE_BAR) || defined(PROBE_GEMM)
#define PROBE_SCALE * probe_sc_
#else
#define PROBE_SCALE
#endif
__device__ __forceinline__ void final_phase(Frame& F) {
#if defined(PROBE_TW) || defined(PROBE_BAR) || defined(PROBE_GEMM)
    #ifndef PROBE_Q
#define PROBE_Q 0
#endif
#ifndef PROBE_GAIN
#define PROBE_GAIN 0.25f
#endif
    float probe_f_ = (float)__hip_atomic_load((unsigned*)(F.ctl + 3), __ATOMIC_RELAXED, __HIP_MEMORY_SCOPE_AGENT) / (float)__hip_atomic_load((unsigned*)(F.ctl + 4), __ATOMIC_RELAXED, __HIP_MEMORY_SCOPE_AGENT);
    if (PROBE_Q > 0) probe_f_ = floorf(probe_f_ * (float)PROBE_Q + 0.5f) / (float)PROBE_Q;
    const float probe_sc_ = 1.f + PROBE_GAIN * probe_f_;
#endif
#ifdef SELFCHECK
    const bool chk_bad = __hip_atomic_load((unsigned*)(F.ctl + 2), __ATOMIC_RELAXED, __HIP_MEMORY_SCOPE_AGENT) != 0u;
#endif
    const bf16_t* X1 = (const bf16_t*)(F.ws + WS_X1); const unsigned char* Y0 = F.ws + WS_Y0; const unsigned char* Y1 = F.ws + WS_Y1; const float* gf = F.in[26];
    const int gw = F.vcu * NWAVES + F.wave, NGW = F.G * NWAVES, lane = F.lane;
    f32x4 gv[4];
#pragma unroll
    for (int j = 0; j < 4; ++j) gv[j] = ((const f32x4*)gf)[lane + 64 * j];
    constexpr int FR = 4;
    for (int m0 = gw; m0 < T; m0 += NGW * FR) {
        u32x2 xx[FR][4]; unsigned ya[FR][4], yb[FR][4];
#pragma unroll
        for (int r = 0; r < FR; ++r) { const size_t m = (size_t)m0 + (size_t)r * NGW; const u32x2* xr = (const u32x2*)(X1 + m * D) + lane; const unsigned* y0 = (const unsigned*)(Y0 + m * D) + lane; const unsigned* y1 = (const unsigned*)(Y1 + m * D) + lane;
#pragma unroll
            for (int j = 0; j < 4; ++j) { xx[r][j] = xr[64 * j]; ya[r][j] = y0[64 * j]; yb[r][j] = y1[64 * j]; } }
        f32x4 v[FR][4]; float s[FR];
#pragma unroll
        for (int r = 0; r < FR; ++r) { float acc_ = 0.f;
#pragma unroll
            for (int j = 0; j < 4; ++j) { const int a = (int)ya[r][j], c = (int)yb[r][j]; constexpr float ys = 1.f / YF8_SCALE;
                v[r][j].x = bflo(xx[r][j].x) + (__builtin_amdgcn_cvt_f32_fp8(a, 0) + __builtin_amdgcn_cvt_f32_fp8(c, 0)) * ys; v[r][j].y = bfhi(xx[r][j].x) + (__builtin_amdgcn_cvt_f32_fp8(a, 1) + __builtin_amdgcn_cvt_f32_fp8(c, 1)) * ys;
                v[r][j].z = bflo(xx[r][j].y) + (__builtin_amdgcn_cvt_f32_fp8(a, 2) + __builtin_amdgcn_cvt_f32_fp8(c, 2)) * ys; v[r][j].w = bfhi(xx[r][j].y) + (__builtin_amdgcn_cvt_f32_fp8(a, 3) + __builtin_amdgcn_cvt_f32_fp8(c, 3)) * ys;
                acc_ += (v[r][j].x * v[r][j].x + v[r][j].y * v[r][j].y) + (v[r][j].z * v[r][j].z + v[r][j].w * v[r][j].w); }
            s[r] = acc_; }
#pragma unroll
        for (int r = 0; r < FR; ++r) { const float rstd = 1.f / sqrtf(wave_sum(s[r]) * (1.f / D) + RMS_EPS); f32x4* o = (f32x4*)(F.out + ((size_t)m0 + (size_t)r * NGW) * D) + lane;
#ifdef SELFCHECK
            if (chk_bad) { for (int j = 0; j < 4; ++j) o[64 * j] = (f32x4){0.f, 0.f, 0.f, 0.f}; continue; }
#endif
#pragma unroll
            for (int j = 0; j < 4; ++j) o[64 * j] = v[r][j] * rstd * gv[j] PROBE_SCALE; }
    }
}
#ifdef SELFCHECK
constexpr int CW_CHK = 2;
__device__ __forceinline__ int t5_bucket_ref(int n) { if (n < 16) return n; const int l = 16 + (int)(logf((float)n / 16.f) / logf(8.f) * 16.f); return l < 31 ? l : 31; }
__device__ __forceinline__ float kfrag_at(const bf16_t* KF, int bh, int key, int d) { const int n = key >> 8, kl = key & 255, st = kl >> 5, i = kl & 31, ds = d >> 4, hi = (d >> 3) & 1, e = d & 7;
    return bf2f(KF[(((size_t)bh * 32 + n) * 2048 + (st * 4 + ds) * 64 + (i + 32 * hi)) * 8 + e]); }
__device__ __forceinline__ float vfrag_at(const bf16_t* VF, int bh, int key, int d) { const int n = key >> 8, kl = key & 255, st = kl >> 5, kk = kl & 31, ks = kk >> 4, k16 = kk & 15, hi = (k16 >> 2) & 1, e = (k16 & 3) + 4 * (k16 >> 3), d0 = d >> 5, jj = d & 31;
    return bf2f(VF[(((size_t)bh * 32 + n) * 2048 + ((st * 2 + ks) * 2 + d0) * 64 + (jj + 32 * hi)) * 8 + e]); }
__device__ __forceinline__ void selfcheck_phase(Frame& F, float tol_attn, float tol_ssm) {
    const int lane = lane_id(); const int gw = F.vcu * NWAVES + F.wave;
    const bf16_t* Qb = (const bf16_t*)(F.ws + WS_Q); const bf16_t* KM = (const bf16_t*)(F.ws + WS_KMEAN); const bf16_t* KF = (const bf16_t*)(F.ws + WS_KFRAG); const bf16_t* VF = (const bf16_t*)(F.ws + WS_VFRAG);
    const unsigned char* YA = F.ws + WS_YATT; const float* rb = F.in[16];
    bool bad = false;
    for (int sidx = 0; sidx < 12; ++sidx) {
        unsigned hsh = (unsigned)(gw * 12 + sidx) * 2654435761u; hsh ^= hsh >> 15; hsh *= 2246822519u; hsh ^= hsh >> 13;
        const int bh = (int)(hsh & 63u); int q = (int)((hsh >> 6) & 8191u);
        if (sidx == 0) q = q & 767; if (sidx == 1) q = (q & ~255) | (sidx & 1 ? 0 : 255); if (sidx == 2) q = (q & ~255) | 255; if (sidx == 3) q = (q & ~255) | 128;
        const int b = bh >> 3, h = bh & 7, qb = q >> 8, d = lane;
        const float qd = bf2f(Qb[((size_t)b * SEQ + q) * DA + h * HD + d]);
        int s0 = -1, s1 = -1, s2 = -1; float g0 = -INFINITY, g1 = -INFINITY, g2 = -INFINITY;
        for (int n = 0; n < qb; ++n) { const float gt = wave_sum(qd * bf2f(KM[((size_t)bh * 32 + n) * 64 + d]));
            if (gt > g0) { g2 = g1; s2 = s1; g1 = g0; s1 = s0; g0 = gt; s0 = n; } else if (gt > g1) { g2 = g1; s2 = s1; g1 = gt; s1 = n; } else if (gt > g2) { g2 = gt; s2 = n; } }
        float m = -INFINITY, l = 0.f, od = 0.f;
        for (int blk = 0; blk < 4; ++blk) { const int n = blk == 0 ? s0 : (blk == 1 ? s1 : (blk == 2 ? s2 : qb)); if (n < 0) continue;
            const int kend = (blk == 3) ? (q & 255) + 1 : 256;
            for (int kl = 0; kl < kend; ++kl) { const int key = 256 * n + kl; const float kd = kfrag_at(KF, bh, key, d);
                const float s = wave_sum(qd * kd) + rb[h * 32 + t5_bucket_ref(q - key)] * LOG2E;
                const float mn = fmaxf(m, s), sc = exp2f(m - mn), p = exp2f(s - mn); l = l * sc + p; od = od * sc + p * vfrag_at(VF, bh, key, d); m = mn; } }
        od /= l;
        const float yd = __builtin_amdgcn_cvt_f32_fp8((int)YA[((size_t)b * SEQ + q) * DA + h * HD + d], 0);
        const float e2 = wave_sum((od - yd) * (od - yd)), o2 = wave_sum(od * od);
        if (!(e2 <= tol_attn * tol_attn * o2)) bad = true;
    }
    { const bf16_t* UP = (const bf16_t*)(F.ws + WS_UP); const bf16_t* GA = (const bf16_t*)(F.ws + WS_GACT);
      for (int sidx = 0; sidx < 6; ++sidx) {
        unsigned hsh = (unsigned)(gw * 6 + sidx + 7777) * 2654435761u; hsh ^= hsh >> 15; hsh *= 2246822519u; hsh ^= hsh >> 13;
        const int g = (int)(hsh & 31u), b = (int)((hsh >> 5) & 7u); int t = (int)((hsh >> 8) % 330u); if (sidx == 0) t = 31 + (int)((hsh >> 20) & 3u) * 32; if (sidx == 1) t = 32 + (int)((hsh >> 20) & 7u) * 32;
        const int p = lane;
        const float lr = F.in[4][g * SP + p], li = F.in[5][g * SP + p], step = expf(F.in[6][g]);
        const float mag = expf(lr * step), ar = mag * cosf(li * step), ai = mag * sinf(li * step);
        const float nr = ar - 1.f, ni = ai, den = lr * lr + li * li, cr = (nr * lr + ni * li) / den, ci = (ni * lr - nr * li) / den;
        float hr = 0.f, hi_ = 0.f;
        for (int tt = 0; tt <= t; ++tt) { float br = 0.f, bi = 0.f;
            for (int c = 0; c < 16; ++c) { const float u = bf2f(UP[(size_t)g * SROWS * SKY + ((size_t)b * 256 + (tt >> 5)) * SKY + (tt & 31) * 16 + c]);
                const float b_r = F.in[7][(g * SP + p) * 16 + c], b_i = F.in[8][(g * SP + p) * 16 + c]; br += (cr * b_r - ci * b_i) * u; bi += (cr * b_i + ci * b_r) * u; }
            const float n_r = ar * hr - ai * hi_ + br, n_i = ar * hi_ + ai * hr + bi; hr = n_r; hi_ = n_i; }
        float e2 = 0.f, o2 = 0.f;
        for (int ho = 0; ho < 16; ++ho) { float y = wave_sum(hr * F.in[9][(g * 16 + ho) * SP + p] - hi_ * F.in[10][(g * 16 + ho) * SP + p]);
            const float u = bf2f(UP[(size_t)g * SROWS * SKY + ((size_t)b * 256 + (t >> 5)) * SKY + (t & 31) * 16 + ho]); y += F.in[11][g * 16 + ho] * u;
            const float ge = 0.5f * y * (1.f + tanhf(0.7978845608028654f * (y + 0.044715f * y * y * y)));
            const float gv = bf2f(GA[((size_t)b * SEQ + t) * DS + g * 16 + ho]); e2 += (ge - gv) * (ge - gv); o2 += ge * ge; }
        if (!(e2 <= tol_ssm * tol_ssm * o2 + 1e-6f)) bad = true;
      } }
    if (__ballot(bad) != 0ull && lane == 0) __hip_atomic_store((unsigned*)(F.ctl + CW_CHK), 1u, __ATOMIC_RELAXED, __HIP_MEMORY_SCOPE_AGENT);
}
#endif

#ifdef SELFCHECK
__device__ __forceinline__ void selfcheck_prep(Frame& F) {
    const int lane = lane_id(); const int gw = F.vcu * NWAVES + F.wave;
    const bf16_t* Kb = (const bf16_t*)(F.ws + WS_K); const bf16_t* Vb = (const bf16_t*)(F.ws + WS_V); const bf16_t* KF = (const bf16_t*)(F.ws + WS_KFRAG); const bf16_t* VF = (const bf16_t*)(F.ws + WS_VFRAG);
    const bf16_t* KM = (const bf16_t*)(F.ws + WS_KMEAN); const float* KN = (const float*)(F.ws + WS_KMEAN + 512 * 1024);
    bool bad = false;
    for (int sidx = 0; sidx < 64; ++sidx) {
        unsigned hsh = (unsigned)(gw * 64 + sidx + 12345) * 2654435761u; hsh ^= hsh >> 15; hsh *= 2246822519u; hsh ^= hsh >> 13;
        const int bh = (int)(hsh & 63u), key = (int)((hsh >> 6) & 8191u), b = bh >> 3, h = bh & 7, d = lane;
        const float k0 = bf2f(Kb[((size_t)b * SEQ + key) * DA + h * HD + d]), v0 = bf2f(Vb[((size_t)b * SEQ + key) * DA + h * HD + d]);
        if (kfrag_at(KF, bh, key, d) != k0 || vfrag_at(VF, bh, key, d) != v0) bad = true;
    }
    for (int sidx = 0; sidx < 2; ++sidx) {
        unsigned hsh = (unsigned)(gw * 2 + sidx + 999) * 2654435761u; hsh ^= hsh >> 15; hsh *= 2246822519u; hsh ^= hsh >> 13;
        const int item = (int)(hsh & 2047u), bh = item >> 5, n = item & 31, b = bh >> 3, h = bh & 7, d = lane; float sum = 0.f, mx = 0.f;
        for (int kl = 0; kl < 256; ++kl) { const float kv = bf2f(Kb[((size_t)b * SEQ + 256 * n + kl) * DA + h * HD + d]); sum += kv; mx = fmaxf(mx, wave_sum(kv * kv)); }
        const float mean = sum * (1.f / 256.f), got = bf2f(KM[(size_t)item * 64 + d]);
        if (fabsf(mean - got) > 0.01f * fabsf(mean) + 1e-3f) bad = true;
        if (fabsf(mx - KN[item]) > 1e-3f * mx) bad = true;
    }
    if (__ballot(bad) != 0ull && lane == 0) __hip_atomic_store((unsigned*)(F.ctl + CW_CHK), 1u, __ATOMIC_RELAXED, __HIP_MEMORY_SCOPE_AGENT);
}
#endif
#ifndef MK_N_LAUNCHES
#define MK_N_LAUNCHES 1
#endif
constexpr int NPHASE = 13;
struct Args { const float* in[27]; float* out; unsigned char* ws; int ph_lo, ph_hi; };
static_assert(sizeof(Args) == 27 * 8 + 8 + 8 + 8, "Args has no padding");

#ifndef PAIR_PHASES
#define PAIR_PHASES 1
#endif
#ifndef BLK_ORDER
#define BLK_ORDER 0
#endif
#ifndef STAG9
#define STAG9 0
#endif
#ifndef STAG8
#define STAG8 0
#endif
#ifndef DUP_MASK
#define DUP_MASK 0
#endif
#define PH_ARGS Frame& F, unsigned char* ws, LAS unsigned char* ring
__device__ __forceinline__ void ph1(PH_ARGS) {
#if U_FP8
    { pg8::Gemm g{(const bf16_t*)(ws + WS_H1F8), (const bf16_t*)(ws + WS_WINF8U), D / 2, D / 2, D / 2}; pg8::StaticOrder S; S.init(T, DS, F.G, (int)blockIdx.x);
      EpiProj<0> E{ws, F.in[3], 0, 1.f / WF8_SCALE};
      pg8::gemm_phase<EpiProj<0>, pg8::StaticOrder, true, false, true>(ring, g, S, E, nullptr, F.wave); }
#else
    { pg8::Gemm g{(const bf16_t*)(ws + WS_H1), (const bf16_t*)(ws + WS_WIN), D, D, D}; pg8::StaticOrder S; S.init(T, DS, F.G, (int)blockIdx.x);
      EpiProj<0> E{ws, F.in[3], 0, 1.f};
      pg8::gemm_phase<EpiProj<0>, pg8::StaticOrder, true, false>(ring, g, S, E, nullptr, F.wave); }
#endif
    { pg8::Gemm g{(const bf16_t*)(ws + WS_H1F8), (const bf16_t*)(ws + WS_WINF8), D / 2, D / 2, D / 2}; pg8::StaticOrder S; S.init(T, DIN - DS, F.G, (int)blockIdx.x);
      EpiProj<1> E{ws, F.in[3], 2, 1.f / WF8_SCALE};
      pg8::gemm_phase<EpiProj<1>, pg8::StaticOrder, true, false, true, false, 1>(ring, g, S, E, nullptr, F.wave, (unsigned*)F.ctl); }
}
__device__ __forceinline__ void ph2(PH_ARGS) {
    { pg8::Gemm g{(const bf16_t*)(ws + WS_UP), (const bf16_t*)(ws + WS_SSMW), SKY, SKU, SKU}; pg8::GroupedOrder S; S.init(SG * 8, 1, 8, F.G, F.vcu);
      EpiSsmE E{(float*)(ws + WS_E)};
      pg8::gemm_phase<EpiSsmE, pg8::GroupedOrder, false, false, false, true  >(ring, g, S, E, nullptr, F.wave); }
    VM_WAIT(); __syncthreads();
    ssm_scan_phase(F);
    kv_prep_phase(F);
}
__device__ __forceinline__ void ph4(PH_ARGS) {
    pg8::Gemm g{(const bf16_t*)(ws + WS_UP), (const bf16_t*)(ws + WS_SSMT), SKY, SKY, SKY}; pg8::GroupedOrder S; S.init(SG * 8, 2, 8, F.G, F.vcu);
    EpiSsmY E{(bf16_t*)(ws + WS_GACT)};
    pg8::gemm_phase<EpiSsmY, pg8::GroupedOrder, true, false, false, false, 0, true  >(ring, g, S, E, nullptr, F.wave);
}
__device__ __forceinline__ void ph5(PH_ARGS) {
    pg8::Gemm g{(const bf16_t*)(ws + WS_GACT), (const bf16_t*)(ws + WS_WGLU), DS, DS, DS}; pg8::StaticOrder S; S.init(T, DS, F.G, (int)blockIdx.x, (BLK_ORDER & 1) != 0);
    EpiGlu E{(const bf16_t*)(ws + WS_GACT), (bf16_t*)(ws + WS_YSSM), F.in[13]};
    pg8::gemm_phase<EpiGlu, pg8::StaticOrder, true, false>(ring, g, S, E, nullptr, F.wave);
}
__device__ __forceinline__ void ph6(PH_ARGS) {
    { pg8::Gemm g{(const bf16_t*)(ws + WS_YATT), (const bf16_t*)(ws + WS_WUA), DA / 2, DA / 2, DA / 2}; pg8::StaticOrder S; S.init(T, D, F.G, (int)blockIdx.x, (BLK_ORDER & 2) != 0);
      EpiUpA E{ws + WS_SGA, ws + WS_MA, MA_SCALE / WF8_SCALE};
      pg8::gemm_phase<EpiUpA, pg8::StaticOrder, true, false, true>(ring, g, S, E, nullptr, F.wave); }
    VM_WAIT(); __syncthreads();
    { constexpr int KS = UPS_FP8 ? DS / 2 : DS;
      pg8::Gemm g{(const bf16_t*)(ws + WS_YSSM), (const bf16_t*)(ws + WS_WUS), KS, KS, KS}; pg8::StaticOrder S; S.init(T, D, F.G, (int)blockIdx.x, (BLK_ORDER & 2) != 0);
      EpiUpS E{(const bf16_t*)(ws + WS_SGS), ws + WS_MA, (bf16_t*)(ws + WS_MRG), UPS_FP8 ? 1.f / (WF8_SCALE * YS_SCALE) : 1.f};
      pg8::gemm_phase<EpiUpS, pg8::StaticOrder, true, false, UPS_FP8 != 0>(ring, g, S, E, nullptr, F.wave); }
}
__device__ __forceinline__ void ph7(PH_ARGS) {
    constexpr int KD = OUT_FP8 ? D / 2 : D;
    pg8::Gemm g{(const bf16_t*)(ws + WS_MRG), (const bf16_t*)(ws + WS_WOUT), KD, KD, KD}; pg8::StaticOrder S; S.init(T, D, F.G, (int)blockIdx.x, (BLK_ORDER & 4) != 0);
    EpiOut E{F.in[0], (bf16_t*)(ws + WS_X1), ws + WS_XGF8, (float*)(ws + WS_SSQ), OUT_FP8 ? 1.f / (WF8_SCALE * MRG_SCALE) : 1.f};
    pg8::gemm_phase<EpiOut, pg8::StaticOrder, true, false, OUT_FP8 != 0, false, 9>(ring, g, S, E, nullptr, F.wave, (unsigned*)F.ctl);
}
__device__ __forceinline__ void ph8(PH_ARGS) {
    pg8::Gemm g{(const bf16_t*)(ws + WS_X1), (const bf16_t*)(ws + WS_WR), D, D, D}; pg8::GroupedOrder S; S.init(T / 256, 1, T / 256, F.G, F.vcu);
    EpiRouter E{(float*)(ws + WS_RLOG)};
    pg8::gemm_phase<EpiRouter, pg8::GroupedOrder, false, false, false, true  >(ring, g, S, E, nullptr, F.wave);
}
__device__ __forceinline__ void ph10(PH_ARGS) {
    moe_tables(F);
    const LAS int* tst = (const LAS int*)(F.lds + MOE_TST_OFF);
    MoeOrder S{tst, tst[32] * 4, F.G, F.vcu, false};
    LAS unsigned* rowtab = (LAS unsigned*)(F.lds + ROWTAB_OFF);
    { const unsigned* rowtok = (const unsigned*)(ws + WS_ROWTOK); unsigned tkv[ROWTAB_UNITS];
#pragma unroll
      for (int i = 0; i < ROWTAB_UNITS; ++i) { pg8::Unit u; tkv[i] = 0u; if (S.next(i, u) && F.tid < 256) { const int pos = u.aux2 + F.tid; if (pos < u.aux3) tkv[i] = rowtok[(size_t)u.aux * ROWCAP + pos]; } }
#pragma unroll
      for (int i = 0; i < ROWTAB_UNITS; ++i) if (F.tid < 256) rowtab[i * 256 + F.tid] = (tkv[i] >> 1) * (unsigned)D; }
    __syncthreads();
    pg8::Gemm g{(const bf16_t*)(ws + WS_XGF8), (const bf16_t*)(ws + WS_W13), D / 2, D / 2, D / 2};
    EpiMoe1 E{ws + WS_HID, (const float*)(ws + WS_ROWRSTD), (const unsigned*)(F.ctl + CW_ECNT), 1.f / WF8_SCALE};
    pg8::gemm_phase<EpiMoe1, MoeOrder, true, true, true, false, 11>(ring, g, S, E, rowtab, F.wave, (unsigned*)F.ctl);
}
__device__ __forceinline__ void ph11(PH_ARGS) {
    moe_tables(F);
    const LAS int* tst = (const LAS int*)(F.lds + MOE_TST_OFF);
    MoeOrder S{tst, tst[32] * 4, F.G, F.vcu, (BLK_ORDER & 8) != 0};
    LAS unsigned* tktab = (LAS unsigned*)(F.lds + ROWTAB_OFF); LAS float* cftab = (LAS float*)(F.lds + ROWTAB_OFF + ROWTAB_UNITS * 1024);
    { const unsigned* rowtok = (const unsigned*)(ws + WS_ROWTOK); const float* rowcoef = (const float*)(ws + WS_ROWCOEF); unsigned tkv[ROWTAB_UNITS]; float cfv[ROWTAB_UNITS];
#pragma unroll
      for (int i = 0; i < ROWTAB_UNITS; ++i) { pg8::Unit u; tkv[i] = 0u; cfv[i] = 0.f; if (S.next(i, u) && F.tid < 256) { const int pos = u.aux2 + F.tid; const size_t ri = (size_t)u.aux * ROWCAP + (pos < u.aux3 ? pos : 0); tkv[i] = rowtok[ri]; cfv[i] = rowcoef[ri]; } }
#pragma unroll
      for (int i = 0; i < ROWTAB_UNITS; ++i) if (F.tid < 256) { tktab[i * 256 + F.tid] = tkv[i]; cftab[i * 256 + F.tid] = cfv[i]; } }
    __syncthreads();
    pg8::Gemm g{(const bf16_t*)(ws + WS_HID), (const bf16_t*)(ws + WS_W2), DE / 2, DE / 2, DE / 2};
    EpiMoe2 E{ws + WS_Y0, (size_t)(WS_Y1 - WS_Y0), tktab, cftab, (const unsigned*)(F.ctl + CW_ECNT), YF8_SCALE / WF8_SCALE};
    pg8::gemm_phase<EpiMoe2, MoeOrder, true, false, true, false, 12>(ring, g, S, E, nullptr, F.wave, (unsigned*)F.ctl);
}

__global__ void __launch_bounds__(NTHR, 2) fwd_kernel(Args args) {
    extern __shared__ __attribute__((aligned(16))) unsigned char lds_raw[];
    Frame F;
    F.lds = (LAS unsigned char*)lds_raw;
    F.MISC = (volatile LAS unsigned*)(F.lds + MISC_OFF);
    F.wave = __builtin_amdgcn_readfirstlane((int)(threadIdx.x >> 6)); F.lane = lane_id(); F.tid = F.wave * 64 + F.lane;
    F.G = gridDim.x; { const int bx = blockIdx.x; F.vcu = (F.G % 8 == 0) ? (bx % 8) * (F.G / 8) + bx / 8 : bx; }
    F.ws = args.ws; F.ctl = (gu32*)(args.ws + WS_CTL); F.out = args.out;
#pragma unroll
    for (int i = 0; i < 27; ++i) F.in[i] = args.in[i];
    for (int u = F.tid; u < (LDS_BYTES - MOE_TST_OFF) / 4; u += NTHR) ((LAS unsigned*)(F.lds + MOE_TST_OFF))[u] = 0u;
    __syncthreads();
    XcdBarrier bar; bar.bar = (unsigned*)(F.ctl + CW_BAR); bar.x = 0; bar.st = nullptr;
    const int lo = args.ph_lo, hi = args.ph_hi;
    if (hi - lo > 1) bar = xcd_barrier_post((unsigned*)(F.ctl + CW_BAR), F.MISC + 8, F.tid == 0);
#define IN(k) (lo <= (k) && (k) < hi)
#define DUP(k) ((DUP_MASK >> (k)) & 1)
#ifdef PROBE_BAR
#define SEAM(k) do { if (IN(k) && IN((k) + 1)) { const unsigned long long tb0_ = __builtin_amdgcn_s_memrealtime(); xcd_barrier(bar, F.wave == 0 && lane_id() == 0); tb_acc_ += (unsigned)(__builtin_amdgcn_s_memrealtime() - tb0_); } REFRESH(); } while (0)
#else
#define SEAM(k) do { if (IN(k) && IN((k) + 1)) xcd_barrier(bar, F.wave == 0 && lane_id() == 0); REFRESH(); } while (0)
#endif
#define REFRESH() do { int l_ = lane_id(); asm volatile("" : "+v"(l_)); F.lane = l_; F.tid = F.wave * 64 + l_; } while (0)
    unsigned char* ws = args.ws;
    LAS unsigned char* ring = F.lds;
#ifdef PROBE_BAR
    unsigned tb_acc_ = 0u; const unsigned long long tk0_ = __builtin_amdgcn_s_memrealtime();
#endif
    if (IN(0)) { p0_prologue(F); if (DUP(0)) p0_prologue(F); }
    SEAM(0);
    if (IN(1)) { ph1(F, ws, ring); if (DUP(1)) ph1(F, ws, ring); }
    SEAM(1);
    if (IN(2)) { ph2(F, ws, ring); if (DUP(2)) ph2(F, ws, ring); }
    SEAM(2);
#ifdef SELFCHECK_PREP
    if (IN(3)) { selfcheck_prep(F); }
#endif
    if (IN(3)) { attn_gate_phase<true>(F); }
#if PAIR_PHASES
    if (IN(3)) { __syncthreads(); ph4(F, ws, ring); }
#endif
    SEAM(3);
    if (IN(4)) { attn_block_phase(F); if (DUP(4)) { __syncthreads(); attn_block_phase(F); } }
#if PAIR_PHASES
    if (IN(4)) { __syncthreads(); ph5(F, ws, ring); }
#endif
    SEAM(4);
    if (IN(5)) { attn_own_phase(F); if (DUP(5)) attn_own_phase(F); }
#if !PAIR_PHASES
    if (IN(5)) { __syncthreads(); ph4(F, ws, ring); if (DUP(14)) ph4(F, ws, ring); }
#endif
#ifdef SELFCHECK
    if (IN(5)) { xcd_barrier(bar, F.wave == 0 && lane_id() == 0); REFRESH(); selfcheck_phase(F, SELFCHECK_TOL_ATTN, SELFCHECK_TOL_SSM); }
#endif
    SEAM(5);
#if !PAIR_PHASES
    if (IN(6)) { ph5(F, ws, ring); if (DUP(6)) ph5(F, ws, ring); }
    SEAM(6);
#endif
    if (IN(7)) { if (STAG8 > 0 && (F.vcu & 1)) { const unsigned long long t0_ = __builtin_amdgcn_s_memrealtime(); while ((long long)(__builtin_amdgcn_s_memrealtime() - t0_) < (long long)STAG8) __builtin_amdgcn_s_sleep(16); }
                 ph6(F, ws, ring); if (DUP(7)) ph6(F, ws, ring); }
    SEAM(7);
    if (IN(8)) { if (STAG9 > 0 && (F.vcu & 1)) { const unsigned long long t0_ = __builtin_amdgcn_s_memrealtime(); while ((long long)(__builtin_amdgcn_s_memrealtime() - t0_) < (long long)STAG9) __builtin_amdgcn_s_sleep(16); }
                 ph7(F, ws, ring); if (DUP(8)) ph7(F, ws, ring); }
    SEAM(8);
    if (IN(9)) { ph8(F, ws, ring); VM_WAIT(); __syncthreads(); routing_phase(F); }
    SEAM(9);
    if (IN(10)) { ph10(F, ws, ring); if (DUP(10)) ph10(F, ws, ring); }
    SEAM(10);
    if (IN(11)) { ph11(F, ws, ring); if (DUP(11)) ph11(F, ws, ring); }
    SEAM(11);
#ifdef PROBE_BAR
    if (F.wave == 0 && lane_id() == 0) { __hip_atomic_fetch_add((unsigned*)(F.ctl + 3), tb_acc_, __ATOMIC_RELAXED, __HIP_MEMORY_SCOPE_AGENT); __hip_atomic_fetch_add((unsigned*)(F.ctl + 4), (unsigned)(__builtin_amdgcn_s_memrealtime() - tk0_), __ATOMIC_RELAXED, __HIP_MEMORY_SCOPE_AGENT); }
    xcd_barrier(bar, F.wave == 0 && lane_id() == 0); REFRESH();
#endif
    if (IN(12)) { final_phase(F); if (DUP(12)) final_phase(F); }
#undef IN
#undef DUP
#undef SEAM
#undef REFRESH
}

extern "C" void kernel_launch(void* const* d_in, const int* in_sizes, int n_in, void* d_out, int out_size, void* d_ws, size_t ws_size, hipStream_t stream) {
    static int grid = 0;
    if (grid == 0) {
        if (n_in != 27 || in_sizes[0] != T * D || out_size != T * D || ws_size < WS_END) { fprintf(stderr, "kernel_launch: unexpected shapes (n_in %d, in0 %d, out %d, ws %zu)\n", n_in, n_in > 0 ? in_sizes[0] : -1, out_size, ws_size); grid = -1; return; }
        int dev = 0, cus = 0;
        if (hipGetDevice(&dev) != hipSuccess || hipDeviceGetAttribute(&cus, hipDeviceAttributeMultiprocessorCount, dev) != hipSuccess) { grid = -1; return; }
        if (hipFuncSetAttribute((const void*)fwd_kernel, hipFuncAttributeMaxDynamicSharedMemorySize, LDS_BYTES) != hipSuccess) { fprintf(stderr, "kernel_launch: hipFuncSetAttribute failed\n"); grid = -1; return; }
        (void)hipGetLastError();
        grid = cus;
    }
    if (grid < 0) return;
    (void)hipMemsetAsync((char*)d_ws + WS_CTL, 0, CTL_ZERO_BYTES, stream);
    Args a{};
    for (int i = 0; i < 27; ++i) a.in[i] = (const float*)d_in[i];
    a.out = (float*)d_out; a.ws = (unsigned char*)d_ws;
    if (MK_N_LAUNCHES == 1) { a.ph_lo = 0; a.ph_hi = NPHASE; hipLaunchKernelGGL(fwd_kernel, dim3(grid), dim3(NTHR), LDS_BYTES, stream, a); }
    else { for (int p = 0; p < NPHASE; ++p) { a.ph_lo = p; a.ph_hi = p + 1; hipLaunchKernelGGL(fwd_kernel, dim3(grid), dim3(NTHR), LDS_BYTES, stream, a); } }
}
```

```cpp
#include <hip/hip_runtime.h>
#include <cstdio>
#include <cstdint>

#define LAS __attribute__((address_space(3)))
#define GAS __attribute__((address_space(1)))
typedef unsigned short bf16_t;
typedef short bf16x8 __attribute__((ext_vector_type(8)));
typedef float f32x2 __attribute__((ext_vector_type(2)));
typedef float f32x4 __attribute__((ext_vector_type(4)));
typedef float f32x16 __attribute__((ext_vector_type(16)));
typedef unsigned u32x2 __attribute__((ext_vector_type(2)));
typedef unsigned u32x4 __attribute__((ext_vector_type(4)));
typedef GAS unsigned gu32;
typedef int v4i32 __attribute__((ext_vector_type(4)));
typedef int v8i32 __attribute__((ext_vector_type(8)));
#define RLX_AGENT __ATOMIC_RELAXED, __HIP_MEMORY_SCOPE_AGENT
#define LDS_WAIT() asm volatile("s_waitcnt lgkmcnt(0)" ::: "memory")
#define VM_WAIT() asm volatile("s_waitcnt vmcnt(0)" ::: "memory")

__device__ __forceinline__ unsigned f2bf(float f) { unsigned u = __builtin_bit_cast(unsigned, f); return (u + 0x7fffu + ((u >> 16) & 1u)) >> 16; }
__device__ __forceinline__ unsigned pk2(float lo, float hi) { return f2bf(lo) | (f2bf(hi) << 16); }
__device__ __forceinline__ float bf2f(unsigned short b) { return __builtin_bit_cast(float, (unsigned)b << 16); }
__device__ __forceinline__ float bflo(unsigned w) { return __builtin_bit_cast(float, w << 16); }
__device__ __forceinline__ float bfhi(unsigned w) { return __builtin_bit_cast(float, w & 0xffff0000u); }
__device__ __forceinline__ unsigned cvt_pk_bf16(float lo, float hi) { unsigned r; asm volatile("v_cvt_pk_bf16_f32 %0, %1, %2" : "=v"(r) : "v"(lo), "v"(hi)); return r; }
__device__ __forceinline__ float fast_sigmoid(float x) { return __builtin_amdgcn_rcpf(1.f + __builtin_amdgcn_exp2f(-1.4426950408889634f * x)); }
__device__ __forceinline__ int lane_id() { int l; asm volatile("v_mbcnt_lo_u32_b32 %0, -1, 0\n\tv_mbcnt_hi_u32_b32 %0, -1, %0" : "=v"(l)); return l; }
__device__ __forceinline__ float wave_sum(float v) {
#pragma unroll
    for (int o = 1; o < 64; o <<= 1) v += __shfl_xor(v, o);
    return v;
}
__device__ __forceinline__ float wave_max(float v) {
#pragma unroll
    for (int o = 1; o < 64; o <<= 1) v = fmaxf(v, __shfl_xor(v, o));
    return v;
}

#define XB_TMO      128
#define XB_XCNT(j)  (256  + 64 * (j))
#define XB_XSUB(j)  (1280 + 64 * (j))
#define XB_XGEN(j)  (2304 + 64 * (j))
#define XB_TOP      3328
#define XB_TOPGEN   3392
#define XCD_BAR_WORDS 3456
#define XB_SPIN_CAP (1u << 20)

__device__ __forceinline__ unsigned xb_ld(unsigned* p)              { return __hip_atomic_load(p, __ATOMIC_RELAXED, __HIP_MEMORY_SCOPE_AGENT); }
__device__ __forceinline__ unsigned xb_add(unsigned* p, unsigned v) { return __hip_atomic_fetch_add(p, v, __ATOMIC_RELAXED, __HIP_MEMORY_SCOPE_AGENT); }
__device__ __forceinline__ unsigned xb_xcc_id() { return (unsigned)__builtin_amdgcn_s_getreg((3 << 11) | 20) & 0xFu; }
#define XB_SPIN(cond, bar) do { unsigned _sp = 0; while (cond) { __builtin_amdgcn_s_sleep(1); \
    if ((++_sp & 255u) == 0u) { if (xb_ld(&(bar)[XB_TMO])) break; if (_sp > XB_SPIN_CAP) { atomicAdd(&(bar)[XB_TMO], 1u); break; } } } } while (0)

struct XcdBarrier { unsigned* bar; unsigned x; volatile LAS unsigned* st; };

__device__ __forceinline__ XcdBarrier xcd_barrier_post(unsigned* bar, volatile LAS unsigned* st, bool leader  ) {
    XcdBarrier b; b.bar = bar; b.x = xb_xcc_id(); b.st = st;
    if (leader) (void)xb_add(&bar[XB_XCNT(b.x)], 1u);
    return b;
}
__device__ __forceinline__ void xcd_barrier_complete(unsigned* bar, unsigned x, unsigned& nloc, unsigned& nx) {
    const unsigned G = gridDim.x * gridDim.y * gridDim.z;
    unsigned sum, cnt, mine, sp = 0u;
    for (;;) {
        sum = 0u; cnt = 0u; mine = 0u;
#pragma unroll
        for (unsigned j = 0; j < 16; ++j) { const unsigned c = xb_ld(&bar[XB_XCNT(j)]); sum += c; cnt += (c > 0u) ? 1u : 0u; mine = (j == x) ? c : mine; }
        if (sum == G) break;
        __builtin_amdgcn_s_sleep(1);
        if ((++sp & 255u) == 0u) { if (xb_ld(&bar[XB_TMO])) break; if (sp > XB_SPIN_CAP) { atomicAdd(&bar[XB_TMO], 1u); break; } }
    }
    nloc = mine > 0u ? mine : 1u; nx = cnt > 0u ? cnt : 1u;
}
__device__ __forceinline__ void xcd_barrier(const XcdBarrier& b, bool leader  ) {
    asm volatile("s_waitcnt vmcnt(0)" ::: "memory");
    __syncthreads();
    if (leader) {
        unsigned* bar = b.bar;
        __builtin_amdgcn_s_waitcnt(0);
        unsigned nloc = b.st[0], nx = b.st[1];
        if (nloc == 0u) { xcd_barrier_complete(bar, b.x, nloc, nx); b.st[0] = nloc; b.st[1] = nx; }
        const unsigned old = xb_add(&bar[XB_XSUB(b.x)], 1u);
        const unsigned gen = old / nloc;
        if (old + 1u == (gen + 1u) * nloc) {
            __builtin_amdgcn_fence(__ATOMIC_RELEASE, "agent");
            asm volatile("s_waitcnt vmcnt(0)" ::: "memory");
            const unsigned og = xb_add(&bar[XB_TOP], 1u);
            const unsigned tg = og / nx;
            if (og + 1u == (tg + 1u) * nx) xb_add(&bar[XB_TOPGEN], 1u);
            else XB_SPIN(xb_ld(&bar[XB_TOPGEN]) == tg, bar);
            __builtin_amdgcn_fence(__ATOMIC_ACQUIRE, "agent");
            xb_add(&bar[XB_XGEN(b.x)], 1u);
            asm volatile("s_waitcnt vmcnt(0)" ::: "memory");
        } else {
            XB_SPIN(xb_ld(&bar[XB_XGEN(b.x)]) == gen, bar);
            __builtin_amdgcn_fence(__ATOMIC_ACQUIRE, "agent");
            asm volatile("s_waitcnt vmcnt(0)" ::: "memory");
        }
    }
    __syncthreads();
}

#ifndef STG_MMA
#define STG_MMA 0
#endif
#ifndef PG8_ASM_DMA
#define PG8_ASM_DMA 0
#endif
namespace pg8 {
constexpr int BM = 256, BK = 64, HALF = 128, HTB = HALF * BK * 2, STAGE_BYTES = 8 * HTB, NXCD = 8, WGM = 8;
#ifndef LINE_PIECES
#define LINE_PIECES 1
#endif
#if LINE_PIECES
__host__ __device__ __forceinline__ int lds_byte(int r, int c) { const int s = (r >> 1) & 7; return (r >> 3) * 1024 + (r & 7) * 128 + ((((c >> 3) ^ s) & 7) << 4) + (c & 7) * 2; }
__host__ __device__ __forceinline__ void stage_rc(int b, int& R, int& C) { const int blk = b / 1024, wi = b % 1024, ri = wi >> 7, pos = wi & 127; R = blk * 8 + ri; const int s = (R >> 1) & 7; C = (((pos >> 4) ^ s) & 7) * 8 + (pos & 15) / 2; }
#else
__host__ __device__ __forceinline__ int lds_byte(int r, int c) { const int st = (r >> 4) * 2 + (c >> 5), rr = r & 15, cc = c & 31, ob = rr * 64 + cc * 2; return st * 1024 + (ob ^ (((ob >> 9) & 1) << 5)); }
__host__ __device__ __forceinline__ void stage_rc(int b, int& R, int& C) { const int st = b / 1024, sb = b % 1024, swz = sb ^ (((sb >> 9) & 1) << 5); R = (st >> 1) * 16 + swz / 64; C = (st & 1) * 32 + (swz % 64) / 2; }
#endif
__host__ __device__ __forceinline__ int perm32(int rho) { const int n = rho >> 4, i = rho & 15; return 8 * (i >> 2) + 4 * n + (i & 3); }

struct Unit { int pm, pn, pb, aux, aux2, aux3, aux4; };
struct Gemm { const bf16_t* A; const bf16_t* Bt; int lda, ldb, K; };

struct StaticOrder {
    int nM, nN, nwg, G, c, blk;
    __device__ void init(int M, int N, int G_, int c_, bool blocked = false) { nM = M / BM; nN = N / BM; nwg = nM * nN; G = G_; c = c_; blk = blocked ? nwg / G_ : 0; }
    __device__ bool next(int i, Unit& u) const {
        if (blk > 0) { if (i >= blk) return false; const int Lb = c * blk + i; u.pm = Lb / nN; u.pn = Lb % nN; u.pb = u.pn; u.aux = 0; u.aux2 = 0; u.aux3 = 0; u.aux4 = 0; return true; }
        const long L = (long)i * G + c; if (L >= nwg) return false;
        int wgid = (int)L; { const int q = nwg / NXCD, r = nwg % NXCD, xcd = wgid % NXCD, off = wgid / NXCD; wgid = (xcd < r ? xcd * (q + 1) : r * (q + 1) + (xcd - r) * q) + off; }
        const int nig = WGM * nN, gid = wgid / nig, fm = gid * WGM, gsz = (nM - fm) < WGM ? (nM - fm) : WGM;
        u.pm = fm + ((wgid % nig) % gsz); u.pn = (wgid % nig) / gsz; u.pb = u.pn; u.aux = 0; u.aux2 = 0; u.aux3 = 0; u.aux4 = 0; return true;
    }
};
struct GroupedOrder {
    int nM, nN, rtpg, G, v;
    __device__ void init(int nM_, int nN_, int rtpg_, int G_, int v_) { nM = nM_; nN = nN_; rtpg = rtpg_; G = G_; v = v_; }
    __device__ bool next(int i, Unit& u) const {
        const int L = i * G + v; if (L >= nM * nN) return false;
        u.pm = L / nN; u.pn = (L + i) % nN  ; u.aux = u.pm / rtpg; u.pb = u.aux * nN + u.pn; u.aux2 = 0; u.aux3 = 0; u.aux4 = 0; return true;
    }
};

template <class Epi, class Sched, bool ALIGN_EPI, bool GATHER, bool FP8 = false, bool HALFN = false  , int PID = 0  , bool KSKIP = false  >
__device__ __forceinline__ void gemm_phase(LAS unsigned char* lds, const Gemm g, const Sched& S, const Epi& E, const LAS unsigned* rowtab  , int wid  , unsigned* probe = nullptr) {
#ifdef PROBE_GEMM
    unsigned pg_te_ = 0u, pg_tw_ = 0u; const unsigned pg_t0_ = (unsigned)__builtin_amdgcn_s_memtime();
#endif
    const int lane = lane_id(), tid = wid * 64 + lane, wr = wid >> 2, wc = wid & 3;
    const int K = g.K, nt = K / BK;
    unsigned voffB[2];
#pragma unroll
    for (int i = 0; i < 2; ++i) { int R, C; stage_rc(tid * 16 + i * 8192, R, C); const int Rb = (R & ~31) + perm32(R & 31);
        voffB[i] = (unsigned)(Rb * g.ldb + C) * 2u; }
    const size_t kstep = (size_t)(BK * 2);
    const size_t hstepB = (size_t)HALF * g.ldb * 2, tstepB = 2 * hstepB;
    const size_t tstepA = (size_t)BM * g.lda * 2;
    const unsigned ldsw = (unsigned)wid * 1024u;
    int aoff = lds_byte(wr * 64 + (lane & 15), (lane >> 4) * 8), boff = lds_byte(wc * 32 + (lane & 15), (lane >> 4) * 8);
    unsigned vAc[2][2];
#define PG8_SETVA(dst, ui_) do { const int t_ = wid * 64 + lane_id(); _Pragma("unroll") for (int i_ = 0; i_ < 2; ++i_) { int R_, C_; stage_rc(t_ * 16 + i_ * 8192, R_, C_); \
        _Pragma("unroll") for (int h_ = 0; h_ < 2; ++h_) dst[h_][i_] = (GATHER ? rowtab[(ui_) * 256 + h_ * 128 + R_] : (unsigned)((h_ * 128 + R_) * g.lda) * 2u) + (unsigned)C_ * 2u; } } while (0)
#define PG8_SA(b, h) (((b) * 2 + (h)) * HTB)
#define PG8_SB(b, h) ((4 + (b) * 2 + (h)) * HTB)
#define PG8_GLDS_S(gbase_, voff_, ldsaddr_) do { unsigned keep_; asm volatile("s_mov_b32 %0, m0\n\ts_mov_b32 m0, %3\n\ts_nop 0\n\tglobal_load_lds_dwordx4 %1, %2\n\ts_mov_b32 m0, %0" \
        : "=&s"(keep_) : "v"(voff_), "s"(gbase_), "s"(ldsaddr_) : "memory"); } while (0)
#define PG8_STAGE(bufoff, gbase, v0, v1) do { \
        if constexpr (FP8 || PG8_ASM_DMA) { const unsigned la_ = (unsigned)(uintptr_t)(lds + (bufoff) + ldsw); PG8_GLDS_S((const char*)(gbase), (v0), la_); PG8_GLDS_S((const char*)(gbase), (v1), la_ + 8192u); } else { \
        __builtin_amdgcn_global_load_lds((const unsigned*)((const char*)(gbase) + (v0)), (LAS unsigned*)(lds + (bufoff) + ldsw), 16, 0, 0); \
        __builtin_amdgcn_global_load_lds((const unsigned*)((const char*)(gbase) + (v1)), (LAS unsigned*)(lds + (bufoff) + ldsw + 8192), 16, 0, 0); } } while (0)
#define PG8_STB(bufoff, gbase) PG8_STAGE(bufoff, gbase, voffB[0], voffB[1])
#if LINE_PIECES
#define PG8_KTOG(v_) asm volatile("v_xor_b32 %0, 64, %0" : "+v"(v_))
#define PG8_LDA(dst, b, h) do { _Pragma("unroll") for (int m = 0; m < 4; ++m) dst[m][0] = *(const LAS bf16x8*)(lds + PG8_SA(b, h) + aoff + m * 2048); PG8_KTOG(aoff); \
        _Pragma("unroll") for (int m = 0; m < 4; ++m) dst[m][1] = *(const LAS bf16x8*)(lds + PG8_SA(b, h) + aoff + m * 2048); PG8_KTOG(aoff); } while (0)
#define PG8_LDB(dst, b, h) do { _Pragma("unroll") for (int n = 0; n < 2; ++n) dst[n][0] = *(const LAS bf16x8*)(lds + PG8_SB(b, h) + boff + n * 2048); PG8_KTOG(boff); \
        _Pragma("unroll") for (int n = 0; n < 2; ++n) dst[n][1] = *(const LAS bf16x8*)(lds + PG8_SB(b, h) + boff + n * 2048); PG8_KTOG(boff); } while (0)
#else
#define PG8_LDA(dst, b, h) do { _Pragma("unroll") for (int m = 0; m < 4; ++m) _Pragma("unroll") for (int k = 0; k < 2; ++k) dst[m][k] = *(const LAS bf16x8*)(lds + PG8_SA(b, h) + aoff + m * 2048 + k * 1024); } while (0)
#define PG8_LDB(dst, b, h) do { _Pragma("unroll") for (int n = 0; n < 2; ++n) _Pragma("unroll") for (int k = 0; k < 2; ++k) dst[n][k] = *(const LAS bf16x8*)(lds + PG8_SB(b, h) + boff + n * 2048 + k * 1024); } while (0)
#endif
#define PG8_MMA(ai, bj, At, Bt) do { __builtin_amdgcn_s_setprio(1); \
        if constexpr (FP8) { _Pragma("unroll") for (int m = 0; m < 4; ++m) _Pragma("unroll") for (int n = 0; n < 2; ++n) { \
            const v8i32 a8_ = __builtin_shufflevector(__builtin_bit_cast(v4i32, At[m][0]), __builtin_bit_cast(v4i32, At[m][1]), 0, 1, 2, 3, 4, 5, 6, 7); \
            const v8i32 b8_ = __builtin_shufflevector(__builtin_bit_cast(v4i32, Bt[n][0]), __builtin_bit_cast(v4i32, Bt[n][1]), 0, 1, 2, 3, 4, 5, 6, 7); \
            acc[ai][bj][m][n] = __builtin_amdgcn_mfma_scale_f32_16x16x128_f8f6f4(b8_, a8_, acc[ai][bj][m][n], 0, 0, 0, 0, 0, 0); } } \
        else { _Pragma("unroll") for (int m = 0; m < 4; ++m) _Pragma("unroll") for (int n = 0; n < 2; ++n) _Pragma("unroll") for (int k = 0; k < 2; ++k) \
            acc[ai][bj][m][n] = __builtin_amdgcn_mfma_f32_16x16x32_bf16(Bt[n][k], At[m][k], acc[ai][bj][m][n], 0, 0, 0); } \
        __builtin_amdgcn_s_setprio(0); } while (0)
#ifdef PROBE_GEMM
#define PGT(mode_, stmt_) do { if (PID == PROBE_GEMM_PID && PROBE_GEMM == (mode_)) { const unsigned q0_ = (unsigned)__builtin_amdgcn_s_memtime(); stmt_; pg_tw_ += (unsigned)__builtin_amdgcn_s_memtime() - q0_; } else { stmt_; } } while (0)
#define PG8_WAIT_V(n) PGT(3, asm volatile("s_waitcnt vmcnt(" #n ")" ::: "memory"))
#else
#define PG8_WAIT_V(n) asm volatile("s_waitcnt vmcnt(" #n ")" ::: "memory")
#define PGT(mode_, stmt_) do { stmt_; } while (0)
#endif
#define PG8_WAIT_L(n) asm volatile("s_waitcnt lgkmcnt(" #n ")" ::: "memory")
#define PG8_BAR __builtin_amdgcn_s_barrier()
#define PG8_SCHED __builtin_amdgcn_sched_barrier(0)
#define PG8_SCHED8 do { if constexpr (FP8) __builtin_amdgcn_sched_barrier(0); } while (0)
    Unit cur, nxt; int ui = 0;
#define PG8_UNI(u_) do { u_.pm = __builtin_amdgcn_readfirstlane(u_.pm); u_.pn = __builtin_amdgcn_readfirstlane(u_.pn); u_.pb = __builtin_amdgcn_readfirstlane(u_.pb); u_.aux = __builtin_amdgcn_readfirstlane(u_.aux); u_.aux2 = __builtin_amdgcn_readfirstlane(u_.aux2); u_.aux3 = __builtin_amdgcn_readfirstlane(u_.aux3); u_.aux4 = __builtin_amdgcn_readfirstlane(u_.aux4); asm volatile("" : "+s"(u_.pm), "+s"(u_.pn), "+s"(u_.pb), "+s"(u_.aux), "+s"(u_.aux2), "+s"(u_.aux3), "+s"(u_.aux4)); } while (0)
    if (!S.next(0, cur)) return;
    PG8_UNI(cur);
    f32x4 acc[2][2][4][2];
#pragma unroll
    for (int a = 0; a < 2; ++a)
#pragma unroll
        for (int b = 0; b < 2; ++b)
#pragma unroll
            for (int m = 0; m < 4; ++m)
#pragma unroll
                for (int n = 0; n < 2; ++n) acc[a][b][m][n] = (f32x4){0.f, 0.f, 0.f, 0.f};
    bf16x8 At[4][2], B0[2][2], B1[2][2];
    const char* cA = (const char*)g.A + (GATHER ? (size_t)0 : (size_t)cur.pm * tstepA); const char* cB = (const char*)g.Bt + (size_t)cur.pb * tstepB;
    PG8_SETVA(vAc, 0);
    PG8_STB(PG8_SB(0, 0), cB); if constexpr (!HALFN) PG8_STB(PG8_SB(0, 1), cB + hstepB); PG8_STAGE(PG8_SA(0, 0), cA, vAc[0][0], vAc[0][1]); PG8_STAGE(PG8_SA(0, 1), cA, vAc[1][0], vAc[1][1]);
    if (wr == 1) PG8_BAR;
    PG8_WAIT_V(2); PG8_BAR;
    PG8_STB(PG8_SB(1, 0), cB + kstep); PG8_STAGE(PG8_SA(1, 0), cA + kstep, vAc[0][0], vAc[0][1]); if constexpr (!HALFN) PG8_STB(PG8_SB(1, 1), cB + hstepB + kstep);
    if constexpr (HALFN) PG8_WAIT_V(4); else PG8_WAIT_V(6);
    PG8_BAR;
    for (;;) {
        const bool has_next = S.next(ui + 1, nxt);
        PG8_UNI(nxt);
        const char* nA = GATHER ? cA : (has_next ? (const char*)g.A + (size_t)nxt.pm * tstepA : cA); const char* nB = has_next ? (const char*)g.Bt + (size_t)nxt.pb * tstepB : cB;
        const int nui = has_next ? ui + 1 : ui;
        const bool kskip = KSKIP && cur.pn == 0; const int ntu = kskip ? nt - 4 : nt;
#pragma nounroll
        for (int t = 0; t < ntu; t += 2) {
            const bool last = (t == ntu - 2);
            const int tk1 = (kskip && t >= 4) ? t + 5 : t + 1, tk2 = (kskip && t + 2 >= 4) ? t + 6 : t + 2;
            const char* a1 = cA + (size_t)tk1 * kstep;
            const char* a2 = last ? nA : cA + (size_t)tk2 * kstep; const char* b2 = last ? nB : cB + (size_t)tk2 * kstep;
            const char* a3 = a2 + kstep; const char* b3 = b2 + kstep;
            unsigned x00 = vAc[0][0], x01 = vAc[0][1], x10 = vAc[1][0], x11 = vAc[1][1];
            if (GATHER) { if (last) { unsigned vN_[2][2]; PG8_SETVA(vN_, nui); x00 = vN_[0][0]; x01 = vN_[0][1]; x10 = vN_[1][0]; x11 = vN_[1][1]; } }
#define PG8_MID(stmt_) do { PG8_SCHED; stmt_; PG8_SCHED; } while (0)
#define PG8_SPB0(ai_) do { if constexpr (HALFN) { PG8_SPB(6, ai_, (void)0); } else { PG8_SPB(8, ai_, (void)0); } } while (0)
#define PG8_SPB(wn_, ai_, mid_) PG8_WAIT_V(wn_); PGT(4, PG8_WAIT_L(0)); PGT(5, PG8_BAR); PG8_SCHED8; PGT(6, PG8_MMA(ai_, 0, At, B0); mid_; if constexpr (!HALFN) PG8_MMA(ai_, 1, At, B1)); PG8_SCHED8; PGT(7, PG8_BAR); PG8_SCHED
            PG8_LDB(B0, 0, 0); if constexpr (!HALFN) PG8_LDB(B1, 0, 1); PG8_SCHED; PG8_LDA(At, 0, 0);
#if STG_MMA >= 2
            PG8_SPB(6, 0, PG8_MID(PG8_STAGE(PG8_SA(1, 1), a1, vAc[1][0], vAc[1][1])));
#else
            PG8_STAGE(PG8_SA(1, 1), a1, vAc[1][0], vAc[1][1]); PG8_SPB0(0);
#endif
            PG8_LDA(At, 0, 1); PG8_STB(PG8_SB(0, 0), b2); if constexpr (!HALFN) PG8_STB(PG8_SB(0, 1), b2 + hstepB);
#if STG_MMA >= 1
            PG8_SPB(6, 1, PG8_MID(PG8_STAGE(PG8_SA(0, 0), a2, x00, x01)));
#else
            PG8_STAGE(PG8_SA(0, 0), a2, x00, x01); PG8_SPB0(1);
#endif
            PG8_LDB(B0, 1, 0); if constexpr (!HALFN) PG8_LDB(B1, 1, 1); PG8_SCHED; PG8_LDA(At, 1, 0);
#if STG_MMA >= 2
            PG8_SPB(6, 0, PG8_MID(PG8_STAGE(PG8_SA(0, 1), a2, x10, x11)));
#else
            PG8_STAGE(PG8_SA(0, 1), a2, x10, x11); PG8_SPB0(0);
#endif
            PG8_LDA(At, 1, 1); PG8_STB(PG8_SB(1, 0), b3); if constexpr (!HALFN) PG8_STB(PG8_SB(1, 1), b3 + hstepB);
#if STG_MMA >= 1
            PG8_SPB(6, 1, PG8_MID(PG8_STAGE(PG8_SA(1, 0), a3, x00, x01)));
#else
            PG8_STAGE(PG8_SA(1, 0), a3, x00, x01); PG8_SPB0(1);
#endif
        }
        if constexpr (ALIGN_EPI) { if (wr == 0) PG8_BAR; }
#ifdef PROBE_GEMM
        const unsigned pg_e0_ = (unsigned)__builtin_amdgcn_s_memtime();
#endif
        { int l_ = lane_id(); asm volatile("" : "+v"(l_));
          E(acc, cur, wr, wc, l_ & 15, l_ >> 4); }
#ifdef PROBE_GEMM
        if (PID == PROBE_GEMM_PID) pg_te_ += (unsigned)__builtin_amdgcn_s_memtime() - pg_e0_;
#endif
        if (!has_next) break;
#pragma unroll
        for (int a = 0; a < 2; ++a)
#pragma unroll
            for (int b = 0; b < 2; ++b)
#pragma unroll
                for (int m = 0; m < 4; ++m)
#pragma unroll
                    for (int n = 0; n < 2; ++n) acc[a][b][m][n] = (f32x4){0.f, 0.f, 0.f, 0.f};
        cur = nxt; cA = nA; cB = nB; ++ui;
        if (GATHER) { PG8_SETVA(vAc, ui); }
        if constexpr (ALIGN_EPI) { if (wr == 1) PG8_BAR; }
    }
    PG8_WAIT_V(0);
    if constexpr (!ALIGN_EPI) { if (wr == 0) PG8_BAR; }
    PG8_BAR;
#ifdef PROBE_GEMM
    if (PID == PROBE_GEMM_PID && probe && wid == PROBE_GEMM_WAVE && lane_id() == 0) { __hip_atomic_fetch_add(probe + 3, (PROBE_GEMM == 1 ? pg_te_ : pg_tw_) >> 8, __ATOMIC_RELAXED, __HIP_MEMORY_SCOPE_AGENT); __hip_atomic_fetch_add(probe + 4, ((unsigned)__builtin_amdgcn_s_memtime() - pg_t0_) >> 8, __ATOMIC_RELAXED, __HIP_MEMORY_SCOPE_AGENT); }
#endif
#undef PG8_SETVA
#undef PG8_UNI
#undef PG8_SA
#undef PG8_SB
#undef PG8_STAGE
#undef PG8_GLDS_S
#undef PG8_STB
#undef PG8_LDA
#undef PG8_LDB
#undef PG8_MMA
#undef PG8_WAIT_V
#undef PG8_WAIT_L
#undef PG8_BAR
#undef PG8_SCHED
#undef PG8_SCHED8
}
}
constexpr int NWAVES = 8, NTHR = 512;
constexpr int BATCH = 8, SEQ = 8192, T = BATCH * SEQ, D = 1024, DIN = 4096;
constexpr int DS = 512, DA = 512, NH = 8, HD = 64, NBLK = SEQ / 256;
constexpr int SG = 32, SHC = 16, SP = 64, SL = 32, SKU = SL * SHC  , SKS = 2 * SP  , SKY = SKU + SKS  , SROWS = T / SL  ;
constexpr int NE = 32, DE = 512;
constexpr float RMS_EPS = 1e-6f;
constexpr float LOG2E = 1.4426950408889634f;
constexpr float QSCALE = 0.125f * LOG2E;
constexpr float WF8_SCALE = 32.f;
constexpr float YF8_SCALE = 16.f;
constexpr float MA_SCALE = 64.f;
constexpr int ROWCAP = T;
constexpr int HID_ROWS = 2 * T + NE * 256;

constexpr size_t MiB = 1u << 20;
constexpr size_t WS_CTL = 0, CTL_ZERO_BYTES = 1 * MiB;
constexpr size_t WS_WIN = 1 * MiB;
constexpr size_t WS_WGLU = 9 * MiB;
constexpr size_t WS_WUS = 10 * MiB;
constexpr size_t WS_WUA = 11 * MiB;
constexpr size_t WS_WOUT = 12 * MiB;
constexpr size_t WS_WR = 14 * MiB;
constexpr size_t WS_KMEAN = 15 * MiB;
constexpr size_t WS_SSMW = 16 * MiB;
constexpr size_t WS_SSMT = 24 * MiB;
constexpr size_t WS_W13 = 44 * MiB;
constexpr size_t WS_W2 = 108 * MiB;
constexpr size_t WS_A0 = 140 * MiB;
constexpr size_t WS_UP = 276 * MiB;
constexpr size_t WS_Q = 356 * MiB;
constexpr size_t WS_SSQ = 404 * MiB;
constexpr size_t WS_RLOG = 408 * MiB;
constexpr size_t WS_K = 420 * MiB;
constexpr size_t WS_ROWTOK = 428 * MiB, WS_ROWCOEF = 436 * MiB, WS_ROWRSTD = 444 * MiB;
constexpr size_t WS_GACT = 484 * MiB;
constexpr size_t WS_V = 484 * MiB;
constexpr size_t WS_YSSM = 740 * MiB;
constexpr size_t WS_SGS = 548 * MiB;
constexpr size_t WS_SGA = 676 * MiB;
constexpr size_t WS_E = 804 * MiB;
constexpr size_t WS_YATT = 836 * MiB;
constexpr size_t WS_PART0 = 420 * MiB, WS_PART1 = 452 * MiB, WS_PART2 = 932 * MiB;
constexpr size_t WS_QLIST = 900 * MiB;
constexpr size_t WS_PL = 268 * MiB;
constexpr size_t WS_MQ = 996 * MiB;
constexpr size_t WS_H1F8 = 836 * MiB;
#ifndef UPS_FP8
#define UPS_FP8 1
#endif
constexpr float YS_SCALE = 16.f;
#ifndef OUT_FP8
#define OUT_FP8 1
#endif
constexpr float MRG_SCALE = 16.f;
#ifndef U_FP8
#define U_FP8 1
#endif
constexpr size_t WS_WINF8U = 904 * MiB;
constexpr size_t WS_WINF8 = 900 * MiB;
constexpr size_t WS_XGF8 = 836 * MiB;
constexpr size_t WS_MA = 276 * MiB;
constexpr size_t WS_SEGC = 998 * MiB;
constexpr size_t WS_END = 999 * MiB;
constexpr size_t WS_KFRAG = WS_A0, WS_VFRAG = WS_A0 + 64 * MiB, WS_H1 = WS_A0, WS_MRG = WS_A0, WS_HID = WS_A0;
constexpr size_t WS_X1 = WS_SGS, WS_XG = WS_UP, WS_Y0 = WS_UP, WS_Y1 = WS_E;
static_assert(WS_SGA + 64 * MiB <= WS_YSSM && WS_YSSM + 64 * MiB <= WS_E && WS_GACT + 64 * MiB <= WS_SGS && WS_PART1 + 32 * MiB <= WS_GACT, "map");
static_assert(WS_HID + (size_t)HID_ROWS * DE * 2 <= WS_UP, "hid fits");
static_assert(WS_RLOG + (size_t)T * 72 * 4 <= WS_ROWTOK, "rlog fits");

constexpr int CW_TMO = 0, CW_CODE = 1;
constexpr int CW_BAR = 4096;
constexpr int CW_ECNT = 8192;
constexpr int CW_GCNT = 12288;

constexpr int RING_BYTES = 131072;
constexpr int ROWTAB_OFF = RING_BYTES, ROWTAB_UNITS = 12, ROWTAB_BYTES = 25 * 1024;
constexpr int MOE_TST_OFF = ROWTAB_OFF + ROWTAB_BYTES;
constexpr int MISC_OFF = MOE_TST_OFF + 512;
constexpr int LDS_BYTES = MISC_OFF + 128;
static_assert(LDS_BYTES <= 163840, "LDS");

struct Frame {
    LAS unsigned char* lds;
    volatile LAS unsigned* MISC;
    gu32* ctl;
    unsigned char* ws;
    int tid, lane, wave, vcu, G;
    const float* in[27];
    float* out;
};

__device__ __forceinline__ unsigned pk4_fp8(float a, float b, float c, float d) { int w = 0; w = __builtin_amdgcn_cvt_pk_fp8_f32(a, b, w, false); w = __builtin_amdgcn_cvt_pk_fp8_f32(c, d, w, true); return (unsigned)w; }
#define EPI_LOOP_BEGIN  _Pragma("unroll") for (int ai = 0; ai < 2; ++ai) _Pragma("unroll") for (int m = 0; m < 4; ++m) { const int rl = ai * 128 + wr * 64 + m * 16 + fr; _Pragma("unroll") for (int bj = 0; bj < 2; ++bj) { const int cl = bj * 128 + wc * 32 + 8 * fq; \
        const f32x4 a0 = acc[ai][bj][m][0], a1 = acc[ai][bj][m][1]; (void)rl; (void)cl; (void)a0; (void)a1;
#define EPI_LOOP_END } }
typedef const f32x4 (&AccRef)[2][2][4][2];
__device__ __forceinline__ u32x4 pack8(f32x4 a, f32x4 b) { u32x4 w; w.x = cvt_pk_bf16(a[0], a[1]); w.y = cvt_pk_bf16(a[2], a[3]); w.z = cvt_pk_bf16(b[0], b[1]); w.w = cvt_pk_bf16(b[2], b[3]); return w; }
__device__ __forceinline__ void unpack8(u32x4 w, f32x4& a, f32x4& b) { a = (f32x4){bflo(w.x), bfhi(w.x), bflo(w.y), bfhi(w.y)}; b = (f32x4){bflo(w.z), bfhi(w.z), bflo(w.w), bfhi(w.w)}; }

__device__ __forceinline__ u32x4 pair16(u32x2 X, u32x2 Y) {
    const auto r0 = __builtin_amdgcn_permlane16_swap(X.x, Y.x, false, false); const auto r1 = __builtin_amdgcn_permlane16_swap(X.y, Y.y, false, false);
    return (u32x4){r0[0], r1[0], r0[1], r1[1]};
}
__device__ __forceinline__ void unpair16(u32x4 v, u32x2& X, u32x2& Y) {
    const auto r0 = __builtin_amdgcn_permlane16_swap(v.x, v.z, false, false); const auto r1 = __builtin_amdgcn_permlane16_swap(v.y, v.w, false, false);
    X = (u32x2){r0[0], r1[0]}; Y = (u32x2){r0[1], r1[1]};
}
#define EPI_P(p_) const int ai = (p_) >> 1, m = 2 * ((p_) & 1); const int rlA = ai * 128 + wr * 64 + m * 16 + fr, rlB = rlA + 16; const int rlS = (fq & 1) ? rlB : rlA; (void)rlA; (void)rlB; (void)rlS
__device__ __forceinline__ u32x2 pk8_fp8(f32x4 a, f32x4 b) { return (u32x2){pk4_fp8(a[0], a[1], a[2], a[3]), pk4_fp8(b[0], b[1], b[2], b[3])}; }
__device__ __forceinline__ void unpk8_fp8(u32x2 v, f32x4& a, f32x4& b) { const int x = (int)v.x, y = (int)v.y;
    a = (f32x4){__builtin_amdgcn_cvt_f32_fp8(x, 0), __builtin_amdgcn_cvt_f32_fp8(x, 1), __builtin_amdgcn_cvt_f32_fp8(x, 2), __builtin_amdgcn_cvt_f32_fp8(x, 3)};
    b = (f32x4){__builtin_amdgcn_cvt_f32_fp8(y, 0), __builtin_amdgcn_cvt_f32_fp8(y, 1), __builtin_amdgcn_cvt_f32_fp8(y, 2), __builtin_amdgcn_cvt_f32_fp8(y, 3)}; }
#ifndef SIGMOID_IN_CONSUMER
#define SIGMOID_IN_CONSUMER 0
#endif
#if SIGMOID_IN_CONSUMER
#define GATE_ACT(v) (v)
#define GATE_USE(v) fast_sigmoid(v)
#else
#define GATE_ACT(v) fast_sigmoid(v)
#define GATE_USE(v) (v)
#endif
template <int PART  > struct EpiProj {
    unsigned char* ws; const float* b_gate; int pn_off; float ascale;
    __device__ __forceinline__ void operator()(AccRef acc, const pg8::Unit& u, int wr, int wc, int fr, int fq) const {
        const int pn = u.pn + pn_off; const int row0 = u.pm * 256;
        if (PART == 0) {
            bf16_t* Uperm = (bf16_t*)(ws + WS_UP);
            EPI_LOOP_BEGIN
                const int row = row0 + rl, col = pn * 256 + cl;
                bf16_t* dst = Uperm + (size_t)(col >> 4) * ((size_t)SROWS * SKY) + (size_t)(row >> 5) * SKY + (row & 31) * 16 + (col & 15);
                *(u32x4*)dst = pack8(a0 * ascale, a1 * ascale);
            EPI_LOOP_END
        } else if (pn < 8) {
            const size_t boff = pn < 4 ? WS_Q : (pn < 6 ? WS_K : WS_V);
            bf16_t* base = (bf16_t*)(ws + boff); const float sc = pn < 4 ? QSCALE : 1.f; const int c0 = (pn & 1) * 256;
            EPI_LOOP_BEGIN
                const int row = row0 + rl, col = c0 + cl;
                *(u32x4*)(base + (size_t)row * 512 + col) = pack8(a0 * (sc * ascale), a1 * (sc * ascale));
            EPI_LOOP_END
        } else {
            const bool attn_gate = pn >= 12;
            const int c0 = ((pn - 8) & 3) * 256; const float* bg = b_gate + (pn - 8) * 256;
            if (attn_gate) {
#pragma unroll
                for (int p = 0; p < 4; ++p) { EPI_P(p);
#pragma unroll
                    for (int bj = 0; bj < 2; ++bj) { const int cl = bj * 128 + wc * 32 + 8 * fq; const f32x4 b0 = *(const f32x4*)(bg + cl), b1 = *(const f32x4*)(bg + cl + 4); f32x4 s0, s1, t0, t1;
#pragma unroll
                        for (int e = 0; e < 4; ++e) { s0[e] = GATE_ACT(acc[ai][bj][m][0][e] * ascale + b0[e]); s1[e] = GATE_ACT(acc[ai][bj][m][1][e] * ascale + b1[e]);
                                                      t0[e] = GATE_ACT(acc[ai][bj][m + 1][0][e] * ascale + b0[e]); t1[e] = GATE_ACT(acc[ai][bj][m + 1][1][e] * ascale + b1[e]); }
                        *(u32x4*)(ws + WS_SGA + (size_t)(row0 + rlS) * 1024 + c0 + bj * 128 + wc * 32 + 16 * (fq >> 1)) = pair16(pk8_fp8(s0, s1), pk8_fp8(t0, t1)); } }
            } else {
            EPI_LOOP_BEGIN
                const int row = row0 + rl, col = c0 + cl;
                const f32x4 b0 = *(const f32x4*)(bg + cl), b1 = *(const f32x4*)(bg + cl + 4);
                f32x4 s0, s1;
#pragma unroll
                for (int e = 0; e < 4; ++e) { s0[e] = GATE_ACT(a0[e] * ascale + b0[e]); s1[e] = GATE_ACT(a1[e] * ascale + b1[e]); }
                *(u32x4*)((bf16_t*)(ws + WS_SGS) + (size_t)row * 1024 + col) = pack8(s0, s1);
            EPI_LOOP_END
            }
        }
    }
};
struct EpiSsmE {
    float* E;
    __device__ __forceinline__ void operator()(AccRef acc, const pg8::Unit& u, int wr, int wc, int fr, int fq) const {
        EPI_LOOP_BEGIN
            if (bj == 0) { float* dst = E + (size_t)(u.pm * 256 + rl) * 128 + cl; *(f32x4*)dst = a0; *(f32x4*)(dst + 4) = a1; }
        EPI_LOOP_END
    }
};
__device__ __forceinline__ float gelu_tanh(float x) { const float z = 1.5957691216057308f * (x + 0.044715f * x * x * x); return x * fast_sigmoid(z); }
struct EpiSsmY {
    bf16_t* Gact;
    __device__ __forceinline__ void operator()(AccRef acc, const pg8::Unit& u, int wr, int wc, int fr, int fq) const {
        const int g = u.aux;
        EPI_LOOP_BEGIN
            const int rg = (u.pm & 7) * 256 + rl;
            const int colg = u.pn * 256 + cl;
            const int tok = (rg >> 8) * SEQ + (rg & 255) * SL + (colg >> 4);
            f32x4 y0, y1;
#pragma unroll
            for (int e = 0; e < 4; ++e) { y0[e] = gelu_tanh(a0[e]); y1[e] = gelu_tanh(a1[e]); }
            *(u32x4*)(Gact + (size_t)tok * DS + g * 16 + (colg & 15)) = pack8(y0, y1);
        EPI_LOOP_END
    }
};
#define EPI_SBAR __builtin_amdgcn_sched_barrier(0)
#define EPI_G(g_) const int ai = (g_) >> 2, m = (g_) & 3; const int rl = ai * 128 + wr * 64 + m * 16 + fr; (void)rl
struct EpiGlu {
    const bf16_t* Gact; bf16_t* Yssm; const float* b_glu;
    __device__ __forceinline__ void operator()(AccRef acc, const pg8::Unit& u, int wr, int wc, int fr, int fq) const {
        const int col0 = u.pn * 256 + wc * 32 + 8 * fq; const size_t rowb = (size_t)u.pm * 256;
        f32x4 bv[2][2]; u32x4 gv[8][2];
#pragma unroll
        for (int bj = 0; bj < 2; ++bj) { bv[bj][0] = *(const f32x4*)(b_glu + col0 + bj * 128); bv[bj][1] = *(const f32x4*)(b_glu + col0 + bj * 128 + 4); }
#pragma unroll
        for (int g = 0; g < 8; ++g) { EPI_G(g);
#pragma unroll
            for (int bj = 0; bj < 2; ++bj) gv[g][bj] = *(const u32x4*)(Gact + (rowb + rl) * DS + col0 + bj * 128); }
        EPI_SBAR;
#pragma unroll
        for (int p = 0; p < 4; ++p) { EPI_P(p);
#pragma unroll
            for (int bj = 0; bj < 2; ++bj) { f32x4 y_[2][2];
#pragma unroll
                for (int gi = 0; gi < 2; ++gi) { f32x4 g0, g1; unpack8(gv[2 * p + gi][bj], g0, g1); const f32x4 a0 = acc[ai][bj][m + gi][0], a1 = acc[ai][bj][m + gi][1];
#pragma unroll
                    for (int e = 0; e < 4; ++e) { y_[gi][0][e] = g0[e] * fast_sigmoid(a0[e] + bv[bj][0][e]); y_[gi][1][e] = g1[e] * fast_sigmoid(a1[e] + bv[bj][1][e]); } }
                if (UPS_FP8) *(u32x4*)((unsigned char*)Yssm + (rowb + rlS) * DS + u.pn * 256 + wc * 32 + 16 * (fq >> 1) + bj * 128) = pair16(pk8_fp8(y_[0][0] * YS_SCALE, y_[0][1] * YS_SCALE), pk8_fp8(y_[1][0] * YS_SCALE, y_[1][1] * YS_SCALE));
                else { *(u32x4*)(Yssm + (rowb + rlA) * DS + col0 + bj * 128) = pack8(y_[0][0], y_[0][1]); *(u32x4*)(Yssm + (rowb + rlB) * DS + col0 + bj * 128) = pack8(y_[1][0], y_[1][1]); } } }
    }
};
struct EpiUpA {
    const unsigned char* SG; unsigned char* MA; float ascale;
    __device__ __forceinline__ void operator()(AccRef acc, const pg8::Unit& u, int wr, int wc, int fr, int fq) const {
        const size_t base = (size_t)u.pm * 256 * D + u.pn * 256 + wc * 32 + 16 * (fq >> 1); u32x4 sv[4][2];
#pragma unroll
        for (int p = 0; p < 4; ++p) { EPI_P(p);
#pragma unroll
            for (int bj = 0; bj < 2; ++bj) sv[p][bj] = *(const u32x4*)(SG + base + (size_t)rlS * D + bj * 128); }
        EPI_SBAR;
#pragma unroll
        for (int p = 0; p < 4; ++p) { EPI_P(p);
#pragma unroll
            for (int bj = 0; bj < 2; ++bj) { u32x2 sx, sy; unpair16(sv[p][bj], sx, sy); f32x4 s0, s1, t0, t1; unpk8_fp8(sx, s0, s1); unpk8_fp8(sy, t0, t1);
#pragma unroll
                for (int e = 0; e < 4; ++e) { s0[e] = GATE_USE(s0[e]); s1[e] = GATE_USE(s1[e]); t0[e] = GATE_USE(t0[e]); t1[e] = GATE_USE(t1[e]); }
                const f32x4 y0 = s0 * acc[ai][bj][m][0] * ascale, y1 = s1 * acc[ai][bj][m][1] * ascale, z0 = t0 * acc[ai][bj][m + 1][0] * ascale, z1 = t1 * acc[ai][bj][m + 1][1] * ascale;
                *(u32x4*)(MA + base + (size_t)rlS * D + bj * 128) = pair16(pk8_fp8(y0, y1), pk8_fp8(z0, z1)); } }
    }
};
struct EpiUpS {
    const bf16_t* SG; const unsigned char* MA; bf16_t* Mrg; float ascale;
    __device__ __forceinline__ void operator()(AccRef acc, const pg8::Unit& u, int wr, int wc, int fr, int fq) const {
        const size_t base = (size_t)u.pm * 256 * D + u.pn * 256 + wc * 32 + 8 * fq; const size_t base16 = (size_t)u.pm * 256 * D + u.pn * 256 + wc * 32 + 16 * (fq >> 1);
        u32x4 sv[2][2][2]; u32x4 mv[2][2];
        constexpr float ms = 1.f / MA_SCALE;
#define UPS_LOAD(buf_, bt_) do { { EPI_P(bt_); _Pragma("unroll") for (int bj = 0; bj < 2; ++bj) mv[buf_][bj] = *(const u32x4*)(MA + base16 + (size_t)rlS * D + bj * 128); } \
            _Pragma("unroll") for (int gi_ = 0; gi_ < 2; ++gi_) { EPI_G(2 * (bt_) + gi_); _Pragma("unroll") for (int bj = 0; bj < 2; ++bj) sv[buf_][gi_][bj] = *(const u32x4*)(SG + base + (size_t)rl * D + bj * 128); } } while (0)
#define UPS_PROC(buf_, bt_) do { EPI_P(bt_); _Pragma("unroll") for (int bj = 0; bj < 2; ++bj) { u32x2 mx_, my_; unpair16(mv[buf_][bj], mx_, my_); f32x4 r_[2][2]; \
            _Pragma("unroll") for (int gi_ = 0; gi_ < 2; ++gi_) { f32x4 s0, s1; unpack8(sv[buf_][gi_][bj], s0, s1); _Pragma("unroll") for (int e_ = 0; e_ < 4; ++e_) { s0[e_] = GATE_USE(s0[e_]); s1[e_] = GATE_USE(s1[e_]); } \
                f32x4 p0, p1; unpk8_fp8(gi_ == 0 ? mx_ : my_, p0, p1); r_[gi_][0] = s0 * (acc[ai][bj][m + gi_][0] * ascale) + p0 * ms; r_[gi_][1] = s1 * (acc[ai][bj][m + gi_][1] * ascale) + p1 * ms; } \
            if (OUT_FP8) *(u32x4*)((unsigned char*)Mrg + base16 + (size_t)rlS * D + bj * 128) = pair16(pk8_fp8(r_[0][0] * MRG_SCALE, r_[0][1] * MRG_SCALE), pk8_fp8(r_[1][0] * MRG_SCALE, r_[1][1] * MRG_SCALE)); \
            else { *(u32x4*)(Mrg + base + (size_t)rlA * D + bj * 128) = pack8(r_[0][0], r_[0][1]); *(u32x4*)(Mrg + base + (size_t)rlB * D + bj * 128) = pack8(r_[1][0], r_[1][1]); } } } while (0)
        UPS_LOAD(0, 0); UPS_LOAD(1, 1); EPI_SBAR;
        UPS_PROC(0, 0); UPS_LOAD(0, 2); EPI_SBAR;
        UPS_PROC(1, 1); UPS_LOAD(1, 3); EPI_SBAR;
        UPS_PROC(0, 2); EPI_SBAR;
        UPS_PROC(1, 3);
#undef UPS_LOAD
#undef UPS_PROC
    }
};
__device__ __forceinline__ float sum_xor16(float v) { const unsigned u = __builtin_bit_cast(unsigned, v); const auto r = __builtin_amdgcn_permlane16_swap(u, u, false, false); return __builtin_bit_cast(float, (unsigned)r[0]) + __builtin_bit_cast(float, (unsigned)r[1]); }
__device__ __forceinline__ float sum_xor32(float v) { const unsigned u = __builtin_bit_cast(unsigned, v); const auto r = __builtin_amdgcn_permlane32_swap(u, u, false, false); return __builtin_bit_cast(float, (unsigned)r[0]) + __builtin_bit_cast(float, (unsigned)r[1]); }
struct EpiOut {
    const float* x; bf16_t* X1; unsigned char* X18; float* SSQ; float ascale;
    __device__ __forceinline__ void operator()(AccRef acc, const pg8::Unit& u, int wr, int wc, int fr, int fq) const {
        const int col0 = u.pn * 256 + wc * 32 + 8 * fq; const size_t base = (size_t)u.pm * 256 * D + col0; const size_t base16 = (size_t)u.pm * 256 * D + u.pn * 256 + wc * 32 + 16 * (fq >> 1);
        f32x4 xv[2][2][2][2];
#define OUT_LOAD(buf_, bt_) do { _Pragma("unroll") for (int gi_ = 0; gi_ < 2; ++gi_) { EPI_G(2 * (bt_) + gi_); _Pragma("unroll") for (int bj = 0; bj < 2; ++bj) { const size_t off = base + (size_t)rl * D + bj * 128; \
            xv[buf_][gi_][bj][0] = *(const f32x4*)(x + off); xv[buf_][gi_][bj][1] = *(const f32x4*)(x + off + 4); } } } while (0)
#define OUT_PROC(buf_, bt_) do { u32x2 f8_[2][2]; _Pragma("unroll") for (int gi_ = 0; gi_ < 2; ++gi_) { EPI_G(2 * (bt_) + gi_); float ss = 0.f; _Pragma("unroll") for (int bj = 0; bj < 2; ++bj) { const size_t off = base + (size_t)rl * D + bj * 128; \
            const f32x4 x0 = xv[buf_][gi_][bj][0] + acc[ai][bj][m][0] * ascale, x1 = xv[buf_][gi_][bj][1] + acc[ai][bj][m][1] * ascale; \
            *(u32x4*)(X1 + off) = pack8(x0, x1); f8_[gi_][bj] = pk8_fp8(x0, x1); \
            ss += (x0[0] * x0[0] + x0[1] * x0[1]) + (x0[2] * x0[2] + x0[3] * x0[3]) + (x1[0] * x1[0] + x1[1] * x1[1]) + (x1[2] * x1[2] + x1[3] * x1[3]); } \
            ss = sum_xor16(ss); ss = sum_xor32(ss); \
            SSQ[((size_t)u.pm * 256 + rl) * 16 + u.pn * 4 + wc] = ss; } \
            { EPI_P(bt_); _Pragma("unroll") for (int bj = 0; bj < 2; ++bj) *(u32x4*)(X18 + base16 + (size_t)rlS * D + bj * 128) = pair16(f8_[0][bj], f8_[1][bj]); } } while (0)
        OUT_LOAD(0, 0); OUT_LOAD(1, 1); EPI_SBAR;
        OUT_PROC(0, 0); OUT_LOAD(0, 2); EPI_SBAR;
        OUT_PROC(1, 1); OUT_LOAD(1, 3); EPI_SBAR;
        OUT_PROC(0, 2); EPI_SBAR;
        OUT_PROC(1, 3);
#undef OUT_LOAD
#undef OUT_PROC
    }
};
struct EpiRouter {
    float* Rlog;
    __device__ __forceinline__ void operator()(AccRef acc, const pg8::Unit& u, int wr, int wc, int fr, int fq) const {
        EPI_LOOP_BEGIN
            if (bj == 0 && cl < 72) { float* dst = Rlog + (size_t)(u.pm * 256 + rl) * 72 + cl; *(f32x4*)dst = a0; *(f32x4*)(dst + 4) = a1; }
        EPI_LOOP_END
    }
};
struct EpiMoe1 {
    unsigned char* Hid; const LAS float* rstab; const unsigned* ecnt; float ascale;
    __device__ __forceinline__ void operator()(AccRef acc, const pg8::Unit& u, int wr, int wc, int fr, int fq) const {
        const int cnt = u.aux3; float rsv[8];
#pragma unroll
        for (int g = 0; g < 8; ++g) { EPI_G(g); rsv[g] = rstab[u.aux4 * 256 + rl] * ascale; }
#pragma unroll
        for (int p = 0; p < 4; ++p) { EPI_P(p); u32x2 hp[2];
#pragma unroll
            for (int gi = 0; gi < 2; ++gi) { const float rs = rsv[2 * p + gi]; f32x4 h0, h1;
#pragma unroll
                for (int k = 0; k < 4; ++k) { const float a = acc[ai][0][m + gi][0][k] * rs, b = acc[ai][1][m + gi][0][k] * rs; h0[k] = a * fast_sigmoid(a) * b;
                    const float a2 = acc[ai][0][m + gi][1][k] * rs, b2 = acc[ai][1][m + gi][1][k] * rs; h1[k] = a2 * fast_sigmoid(a2) * b2; }
                hp[gi] = pk8_fp8(h0, h1); }
            const u32x4 v = pair16(hp[0], hp[1]);
            if (u.aux2 + rlS < cnt) *(u32x4*)(Hid + (size_t)(u.pm * 256 + rlS) * DE + u.pn * 128 + wc * 32 + 16 * (fq >> 1)) = v; }
    }
};
struct EpiMoe2 {
    unsigned char* Y0; size_t ydelta; const LAS unsigned* tktab; const LAS float* cftab; const unsigned* ecnt; float ascale;
    __device__ __forceinline__ void operator()(AccRef acc, const pg8::Unit& u, int wr, int wc, int fr, int fq) const {
        const int cnt = u.aux3; unsigned tkv[8]; float cfv[8];
#pragma unroll
        for (int g = 0; g < 8; ++g) { EPI_G(g); tkv[g] = tktab[u.aux4 * 256 + rl]; cfv[g] = cftab[u.aux4 * 256 + rl] * ascale; }
#pragma unroll
        for (int p = 0; p < 4; ++p) { EPI_P(p); unsigned ta_ = tkv[2 * p], tb_ = tkv[2 * p + 1]; asm volatile("" : "+v"(ta_), "+v"(tb_));
            const unsigned tk = (fq & 1) ? tb_ : ta_; const bool ok = u.aux2 + rlS < cnt;
            unsigned char* dst = Y0 + (size_t)(tk & 1u) * ydelta + (size_t)(tk >> 1) * D + u.pn * 256 + wc * 32 + 16 * (fq >> 1);
#pragma unroll
            for (int bj = 0; bj < 2; ++bj) { const float c0 = cfv[2 * p], c1 = cfv[2 * p + 1];
                const u32x4 v = pair16(pk8_fp8(acc[ai][bj][m][0] * c0, acc[ai][bj][m][1] * c0), pk8_fp8(acc[ai][bj][m + 1][0] * c1, acc[ai][bj][m + 1][1] * c1));
                if (ok) *(u32x4*)(dst + bj * 128) = v; } }
    }
};
__device__ __forceinline__ void transpose_item(const float* W, int N, int k0, int n0, bf16_t* WT, size_t drow0, int ldo, LAS float* scr, int lane) {
    float tv[32];
#pragma unroll
    for (int i = 0; i < 32; ++i) tv[i] = W[(size_t)(k0 + 2 * i + (lane >> 5)) * N + n0 + (lane & 31)];
#pragma unroll
    for (int i = 0; i < 32; ++i) scr[(2 * i + (lane >> 5)) * 33 + (lane & 31)] = tv[i];
    LDS_WAIT(); asm volatile("" ::: "memory");
    const int c = lane & 7;
#pragma unroll
    for (int j = 0; j < 4; ++j) { const int n = (lane >> 3) + 8 * j; const LAS float* s = scr + (8 * c) * 33 + n;
        u32x4 o; o.x = pk2(s[0 * 33], s[1 * 33]); o.y = pk2(s[2 * 33], s[3 * 33]); o.z = pk2(s[4 * 33], s[5 * 33]); o.w = pk2(s[6 * 33], s[7 * 33]);
        *(u32x4*)(WT + (drow0 + n) * (size_t)ldo + k0 + 8 * c) = o; }
    LDS_WAIT(); asm volatile("" ::: "memory");
}
__device__ __forceinline__ void transpose_item_f8(const float* W, int N, int k0, int n0, unsigned char* WT8, size_t drow0, int ldo, float scale, LAS float* scr, int lane, const float* kgain = nullptr  ) {
    float tv[32];
#pragma unroll
    for (int i = 0; i < 32; ++i) tv[i] = W[(size_t)(k0 + 2 * i + (lane >> 5)) * N + n0 + (lane & 31)];
#pragma unroll
    for (int i = 0; i < 32; ++i) scr[(2 * i + (lane >> 5)) * 33 + (lane & 31)] = tv[i] * (kgain ? scale * kgain[k0 + 2 * i + (lane >> 5)] : scale);
    LDS_WAIT(); asm volatile("" ::: "memory");
    const int c = lane & 3;
#pragma unroll
    for (int j = 0; j < 2; ++j) { const int n = (lane >> 2) + 16 * j; const LAS float* s = scr + (16 * c) * 33 + n;
        u32x4 o; o.x = pk4_fp8(s[0 * 33], s[1 * 33], s[2 * 33], s[3 * 33]); o.y = pk4_fp8(s[4 * 33], s[5 * 33], s[6 * 33], s[7 * 33]);
        o.z = pk4_fp8(s[8 * 33], s[9 * 33], s[10 * 33], s[11 * 33]); o.w = pk4_fp8(s[12 * 33], s[13 * 33], s[14 * 33], s[15 * 33]);
        *(u32x4*)(WT8 + (drow0 + n) * (size_t)ldo + k0 + 16 * c) = o; }
    LDS_WAIT(); asm volatile("" ::: "memory");
}
template <int NR> __device__ __forceinline__ void rms_rows_to_bf16(int lane, const float* xrow, const float* g, bf16_t* orow, unsigned char* orow8) {
    f32x4 v[NR][4]; float s[NR];
#pragma unroll
    for (int r = 0; r < NR; ++r) { const f32x4* xr = (const f32x4*)(xrow + (size_t)r * D) + lane;
#pragma unroll
        for (int j = 0; j < 4; ++j) v[r][j] = xr[64 * j]; }
    const f32x4* gr = (const f32x4*)g + lane; f32x4 wv[4];
#pragma unroll
    for (int j = 0; j < 4; ++j) wv[j] = gr[64 * j];
#pragma unroll
    for (int r = 0; r < NR; ++r) { float a = 0.f;
#pragma unroll
        for (int j = 0; j < 4; ++j) a += (v[r][j].x * v[r][j].x + v[r][j].y * v[r][j].y) + (v[r][j].z * v[r][j].z + v[r][j].w * v[r][j].w);
        s[r] = a; }
#pragma unroll
    for (int o = 1; o < 64; o <<= 1) {
#pragma unroll
        for (int r = 0; r < NR; ++r) s[r] += __shfl_xor(s[r], o); }
#pragma unroll
    for (int r = 0; r < NR; ++r) { const float rstd = 1.f / sqrtf(s[r] * (1.f / D) + RMS_EPS); unsigned long long* o8 = (unsigned long long*)(orow + (size_t)r * D) + lane;
#pragma unroll
        for (int j = 0; j < 4; ++j) { const float y0 = v[r][j].x * rstd * wv[j].x, y1 = v[r][j].y * rstd * wv[j].y, y2 = v[r][j].z * rstd * wv[j].z, y3 = v[r][j].w * rstd * wv[j].w;
            if (!U_FP8) o8[64 * j] = (unsigned long long)pk2(y0, y1) | ((unsigned long long)pk2(y2, y3) << 32);
            ((unsigned*)(orow8 + (size_t)r * D))[lane + 64 * j] = pk4_fp8(y0, y1, y2, y3); } }
}
__device__ __forceinline__ void cpow(float lr, float li, float step, float dl, float& ar, float& ai) {
    const float mag = __expf(dl * lr * step); const float rev = dl * (li * step * 0.15915494309189535f); const float fr = rev - floorf(rev);
    ar = mag * __builtin_amdgcn_cosf(fr); ai = mag * __builtin_amdgcn_sinf(fr);
}
__device__ __forceinline__ void ssm_gen(Frame& F, int g, int sl) {
    LAS float* AP = (LAS float*)(F.lds); LAS float* BB = AP + 33 * 64 * 2; LAS float* CC = BB + 2048; LAS float* KT = CC + 2048;
    const float* lam_re = F.in[4] + g * SP; const float* lam_im = F.in[5] + g * SP; const float step = __expf(F.in[6][g]);
    const float* b_re = F.in[7] + g * SP * SHC; const float* b_im = F.in[8] + g * SP * SHC; const float* c_re = F.in[9] + g * SHC * SP; const float* c_im = F.in[10] + g * SHC * SP; const float* dd = F.in[11] + g * SHC;
    bf16_t* BT = (bf16_t*)(F.ws + WS_SSMT) + (size_t)g * 512 * SKY; bf16_t* BW = (bf16_t*)(F.ws + WS_SSMW) + (size_t)g * 256 * SKU;
    const int tid = F.tid;
    for (int idx = tid; idx < 33 * 64; idx += NTHR) { const int dl = idx >> 6, p = idx & 63; float ar, ai; cpow(lam_re[p], lam_im[p], step, (float)dl, ar, ai); AP[idx * 2] = ar; AP[idx * 2 + 1] = ai; }
    for (int idx = tid; idx < 1024; idx += NTHR) { const int ho = idx >> 6, p = idx & 63; CC[idx * 2] = c_re[ho * 64 + p]; CC[idx * 2 + 1] = c_im[ho * 64 + p]; }
    __syncthreads();
    for (int idx = tid; idx < 1024; idx += NTHR) { const int p = idx >> 4, h = idx & 15; const float ar = AP[(64 + p) * 2], ai = AP[(64 + p) * 2 + 1];
        const float lr = lam_re[p], li = lam_im[p], nr = ar - 1.f, ni = ai, den = lr * lr + li * li, cr = (nr * lr + ni * li) / den, ci = (ni * lr - nr * li) / den;
        const float br = b_re[p * 16 + h], bi = b_im[p * 16 + h]; BB[idx * 2] = cr * br - ci * bi; BB[idx * 2 + 1] = cr * bi + ci * br; }
    __syncthreads();
    for (int idx = tid; idx < 1024; idx += NTHR) { const int dl = idx >> 5, hl = (idx >> 4) & 1, hi = idx & 15, ho = 2 * sl + hl; float s = 0.f;
        for (int p = 0; p < 64; ++p) { const float ar = AP[(dl * 64 + p) * 2], ai = AP[(dl * 64 + p) * 2 + 1], br = BB[(p * 16 + hi) * 2], bi = BB[(p * 16 + hi) * 2 + 1];
            const float zr = ar * br - ai * bi, zi = ar * bi + ai * br; s += CC[(ho * 64 + p) * 2] * zr - CC[(ho * 64 + p) * 2 + 1] * zi; }
        if (dl == 0 && ho == hi) s += dd[ho];
        KT[idx] = s; }
    __syncthreads();
    for (int v = tid; v < 64 * 80; v += NTHR) { const int nl = v / 80, kv = (v % 80) * 8, tau = nl >> 1, hl = nl & 1, ho = 2 * sl + hl, n = tau * 16 + ho; float val[8];
        if (kv < 512) { const int sg = kv >> 4, hi0 = kv & 15;
#pragma unroll
            for (int e = 0; e < 8; ++e) val[e] = (tau >= sg) ? KT[((tau - sg) * 2 + hl) * 16 + hi0 + e] : 0.f; }
        else { const int kk = kv - 512;
#pragma unroll
            for (int e = 0; e < 8; ++e) { const int p = (kk + e) >> 1, ri = (kk + e) & 1; const float ar = AP[((tau + 1) * 64 + p) * 2], ai = AP[((tau + 1) * 64 + p) * 2 + 1], cre = CC[(ho * 64 + p) * 2], cim = CC[(ho * 64 + p) * 2 + 1];
                val[e] = ri == 0 ? (cre * ar - cim * ai) : -(cre * ai + cim * ar); } }
        u32x4 o; o.x = pk2(val[0], val[1]); o.y = pk2(val[2], val[3]); o.z = pk2(val[4], val[5]); o.w = pk2(val[6], val[7]);
        *(u32x4*)(BT + (size_t)n * SKY + kv) = o; }
    for (int v = tid; v < 32 * 64; v += NTHR) { const int nl = v >> 6, kv = (v & 63) * 8; float val[8];
        const bool real = nl < 16; const int n = real ? 16 * sl + nl : 128 + 16 * sl + (nl - 16);
        if (real) { const int p = n >> 1, ri = n & 1, sg = kv >> 4, hi0 = kv & 15; const float ar = AP[((31 - sg) * 64 + p) * 2], ai = AP[((31 - sg) * 64 + p) * 2 + 1];
#pragma unroll
            for (int e = 0; e < 8; ++e) { const float br = BB[(p * 16 + hi0 + e) * 2], bi = BB[(p * 16 + hi0 + e) * 2 + 1]; val[e] = ri == 0 ? (ar * br - ai * bi) : (ar * bi + ai * br); } }
        else {
#pragma unroll
            for (int e = 0; e < 8; ++e) val[e] = 0.f; }
        u32x4 o; o.x = pk2(val[0], val[1]); o.y = pk2(val[2], val[3]); o.z = pk2(val[4], val[5]); o.w = pk2(val[6], val[7]);
        *(u32x4*)(BW + (size_t)n * SKU + kv) = o; }
    __syncthreads();
}
__device__ __forceinline__ void p0_prologue(Frame& F) {
    for (int it = F.vcu; it < SG * 8; it += F.G) ssm_gen(F, it >> 3, it & 7);
    LAS float* scr = (LAS float*)(F.lds + F.wave * 16384);
    const int gw = F.vcu * NWAVES + F.wave, NGW = F.G * NWAVES, lane = F.lane;
    constexpr int I_IN = 16 * 128, I_GLU = 8 * 16, I_US = 8 * 32, I_UA = 8 * 32, I_OUT = 16 * 32, I_W1 = 32 * 256, I_W3 = 32 * 256, I_W2 = 32 * 256;
    constexpr int NITEMS = I_IN + I_GLU + I_US + I_UA + I_OUT + I_W1 + I_W3 + I_W2;
    unsigned char* ws = F.ws;
    for (int it = gw; it < NITEMS; it += NGW) {
        int r = it;
        if (r < I_IN) { const int k0 = 64 * (r / 128), n0 = 32 * (r % 128);
            if (n0 < DS) { if (U_FP8) transpose_item_f8(F.in[2], DIN, k0, n0, ws + WS_WINF8U, n0, D, WF8_SCALE, scr, lane); else transpose_item(F.in[2], DIN, k0, n0, (bf16_t*)(ws + WS_WIN), n0, D, scr, lane); }
            else transpose_item_f8(F.in[2], DIN, k0, n0, ws + WS_WINF8, n0 - DS, D, WF8_SCALE, scr, lane);
            continue; } r -= I_IN;
        if (r < I_GLU) { transpose_item(F.in[12], DS, 64 * (r / 16), 32 * (r % 16), (bf16_t*)(ws + WS_WGLU), 32 * (r % 16), DS, scr, lane); continue; } r -= I_GLU;
        if (r < I_US) { if (UPS_FP8) transpose_item_f8(F.in[14], D, 64 * (r / 32), 32 * (r % 32), ws + WS_WUS, 32 * (r % 32), DS, WF8_SCALE, scr, lane); else transpose_item(F.in[14], D, 64 * (r / 32), 32 * (r % 32), (bf16_t*)(ws + WS_WUS), 32 * (r % 32), DS, scr, lane); continue; } r -= I_US;
        if (r < I_UA) { transpose_item_f8(F.in[15], D, 64 * (r / 32), 32 * (r % 32), ws + WS_WUA, 32 * (r % 32), DA, WF8_SCALE, scr, lane); continue; } r -= I_UA;
        if (r < I_OUT) { if (OUT_FP8) transpose_item_f8(F.in[17], D, 64 * (r / 32), 32 * (r % 32), ws + WS_WOUT, 32 * (r % 32), D, WF8_SCALE, scr, lane); else transpose_item(F.in[17], D, 64 * (r / 32), 32 * (r % 32), (bf16_t*)(ws + WS_WOUT), 32 * (r % 32), D, scr, lane); continue; } r -= I_OUT;
        if (r < I_W1 + I_W3) { const int w3 = r >= I_W1; if (w3) r -= I_W1; const int e = r >> 8, q = r & 255, k0 = 64 * (q / 16), n0 = 32 * (q % 16);
            transpose_item_f8((w3 ? F.in[24] : F.in[23]) + (size_t)e * D * DE, DE, k0, n0, ws + WS_W13, (size_t)e * 1024 + 256 * (n0 >> 7) + (n0 & 127) + (w3 ? 128 : 0), D, WF8_SCALE, scr, lane, F.in[18]); continue; }
        r -= I_W1 + I_W3;
        { const int e = r >> 8, q = r & 255, k0 = 64 * (q / 32), n0 = 32 * (q % 32);
            transpose_item_f8(F.in[25] + (size_t)e * DE * D, D, k0, n0, ws + WS_W2, (size_t)e * 1024 + n0, DE, WF8_SCALE, scr, lane); }
    }
    for (int m = 4 * gw; m < T; m += 4 * NGW) rms_rows_to_bf16<4>(lane, F.in[0] + (size_t)m * D, F.in[1], (bf16_t*)(ws + WS_H1) + (size_t)m * D, ws + WS_H1F8 + (size_t)m * D);
    { bf16_t* WR = (bf16_t*)(ws + WS_WR); const float* wrg = F.in[19]; const float* wre = F.in[21];
      for (int idx = F.vcu * NTHR + F.tid; idx < 256 * D; idx += F.G * NTHR) { const int r = idx >> 10, k = idx & 1023; unsigned o = 0u;
          if (r < 72) { const int c = r < 36 ? r : r - 36; const float w = (c < 4 ? wrg[k * 4 + c] : wre[k * 32 + (c - 4)]) * F.in[18][k]; const unsigned hb = f2bf(w);
              o = r < 36 ? hb : f2bf(w - __builtin_bit_cast(float, hb << 16)); }
          WR[idx] = (bf16_t)o; } }
}

__device__ __forceinline__ int crow(int r, int hi) { return (r & 3) + 8 * (r >> 2) + 4 * hi; }
constexpr int KVP = 72;
__device__ __forceinline__ void kv_prep_phase(Frame& F) {
    LAS bf16_t* KS = (LAS bf16_t*)(F.lds); LAS bf16_t* VS = KS + 256 * KVP; LAS float* PS = (LAS float*)(F.lds + 2 * 256 * KVP * 2); LAS float* WM = PS + 512;
    const bf16_t* Kb = (const bf16_t*)(F.ws + WS_K); const bf16_t* Vb = (const bf16_t*)(F.ws + WS_V);
    bf16_t* Kf = (bf16_t*)(F.ws + WS_KFRAG); bf16_t* Vf = (bf16_t*)(F.ws + WS_VFRAG); bf16_t* KM = (bf16_t*)(F.ws + WS_KMEAN); float* KN = (float*)(F.ws + WS_KMEAN + 512 * 1024);
    const int tid = F.tid;
    u32x4 kr[4], vr[4];
#define KVP_LOAD(item_) do { const int n_ = (item_) & 31, h_ = ((item_) >> 5) & 7, b_ = (item_) >> 8; const size_t tok0_ = (size_t)b_ * SEQ + 256 * n_; \
        _Pragma("unroll") for (int j = 0; j < 4; ++j) { const int q = tid + NTHR * j, row = q >> 3, pc = q & 7; const size_t src = (tok0_ + row) * DA + h_ * HD + pc * 8; kr[j] = *(const u32x4*)(Kb + src); vr[j] = *(const u32x4*)(Vb + src); } } while (0)
    if (F.vcu < BATCH * NH * NBLK) KVP_LOAD(F.vcu);
    for (int item = F.vcu; item < BATCH * NH * NBLK; item += F.G) {
#pragma unroll
        for (int j = 0; j < 4; ++j) { const int q = tid + NTHR * j, row = q >> 3, pc = q & 7; *(LAS u32x4*)(KS + row * KVP + pc * 8) = kr[j]; *(LAS u32x4*)(VS + row * KVP + pc * 8) = vr[j]; }
        { const int nx = (item + F.G < BATCH * NH * NBLK) ? item + F.G : item; KVP_LOAD(nx); }
        __syncthreads();
#pragma unroll
        for (int j = 0; j < 4; ++j) { const int P = tid + NTHR * j, st = P >> 8, ds = (P >> 6) & 3, l2 = P & 63, row = 32 * st + (l2 & 31), col = 16 * ds + 8 * (l2 >> 5);
            *(u32x4*)(Kf + ((size_t)item * 2048 + P) * 8) = *(const LAS u32x4*)(KS + row * KVP + col); }
#pragma unroll
        for (int j = 0; j < 4; ++j) { const int P = tid + NTHR * j, st = P >> 8, ks = (P >> 7) & 1, d0 = (P >> 6) & 1, l2 = P & 63, hi = l2 >> 5, jj = l2 & 31; unsigned w[4];
#pragma unroll
            for (int e = 0; e < 8; e += 2) { const unsigned lo = VS[(32 * st + 16 * ks + crow(e, hi)) * KVP + 32 * d0 + jj], hi16 = VS[(32 * st + 16 * ks + crow(e + 1, hi)) * KVP + 32 * d0 + jj]; w[e >> 1] = lo | (hi16 << 16); }
            *(u32x4*)(Vf + ((size_t)item * 2048 + P) * 8) = (u32x4){w[0], w[1], w[2], w[3]}; }
        { const int d = tid & 63, part = tid >> 6; float s = 0.f;
#pragma unroll 8
          for (int r = 0; r < 32; ++r) s += bf2f(KS[(part * 32 + r) * KVP + d]);
          PS[part * 64 + d] = s; }
        if (tid < 256) { float ss = 0.f;
#pragma unroll
            for (int c = 0; c < 8; ++c) { const u32x4 w = *(const LAS u32x4*)(KS + tid * KVP + c * 8);
                ss += bflo(w.x) * bflo(w.x) + bfhi(w.x) * bfhi(w.x) + bflo(w.y) * bflo(w.y) + bfhi(w.y) * bfhi(w.y) + bflo(w.z) * bflo(w.z) + bfhi(w.z) * bfhi(w.z) + bflo(w.w) * bflo(w.w) + bfhi(w.w) * bfhi(w.w); }
            ss = wave_max(ss); if (F.lane == 0) WM[F.wave] = ss; }
        __syncthreads();
        if (tid < 64) { float s = 0.f;
#pragma unroll
            for (int p = 0; p < 8; ++p) s += PS[p * 64 + tid];
            KM[(size_t)item * 64 + tid] = (bf16_t)f2bf(s * (1.f / 256.f)); }
        if (tid == 0) KN[item] = fmaxf(fmaxf(WM[0], WM[1]), fmaxf(WM[2], WM[3]));
        __syncthreads();
    }
#undef KVP_LOAD
}

__device__ __forceinline__ void ssm_scan_phase(Frame& F) {
    LAS float* FW = (LAS float*)(F.lds);
    const float* E = (const float*)(F.ws + WS_E); bf16_t* UP = (bf16_t*)(F.ws + WS_UP);
    const int w = F.wave, p = F.lane;
    for (int gb = F.vcu; gb < SG * BATCH; gb += F.G) {
        const int g = gb >> 3, b = gb & 7;
        const float lr = F.in[4][g * SP + p], li = F.in[5][g * SP + p], step = __expf(F.in[6][g]);
        float ar, ai; cpow(lr, li, step, 32.f, ar, ai);
        const size_t row0 = (size_t)g * SROWS + b * 256 + 32 * w;
        f32x2 e[32];
#pragma unroll
        for (int j = 0; j < 32; ++j) e[j] = *(const f32x2*)(E + (row0 + j) * 128 + 2 * p);
        float sr = 0.f, si = 0.f;
#pragma unroll
        for (int j = 0; j < 32; ++j) { const float nr = ar * sr - ai * si + e[j].x, ni = ar * si + ai * sr + e[j].y; sr = nr; si = ni; }
        FW[(w * 64 + p) * 2] = sr; FW[(w * 64 + p) * 2 + 1] = si;
        __syncthreads();
        float Ar = ar, Ai = ai;
#pragma unroll
        for (int q = 0; q < 5; ++q) { const float nr = Ar * Ar - Ai * Ai, ni = 2.f * Ar * Ai; Ar = nr; Ai = ni; }
        sr = 0.f; si = 0.f;
        for (int w2 = 0; w2 < w; ++w2) { const float fr = FW[(w2 * 64 + p) * 2], fi = FW[(w2 * 64 + p) * 2 + 1]; const float nr = Ar * sr - Ai * si + fr, ni = Ar * si + Ai * sr + fi; sr = nr; si = ni; }
#pragma unroll
        for (int j = 0; j < 32; ++j) { *(unsigned*)(UP + (row0 + j) * SKY + SKU + 2 * p) = pk2(sr, si);
            const float nr = ar * sr - ai * si + e[j].x, ni = ar * si + ai * sr + e[j].y; sr = nr; si = ni; }
        __syncthreads();
    }
}

__device__ __forceinline__ int t5_bucket(int d) {
    if (d < 16) return d;
    return 16 + (d >= 19) + (d >= 21) + (d >= 24) + (d >= 27) + (d >= 31) + (d >= 35) + (d >= 40) + (d >= 46) + (d >= 52) + (d >= 59) + (d >= 67) + (d >= 77) + (d >= 87) + (d >= 99) + (d >= 113);
}
struct Top3 { float v0, v1, v2; int i0, i1, i2; };
__device__ __forceinline__ Top3 top3_insert(Top3 t, float x, int n) {
    const bool b0 = (x > t.v0) || (x == t.v0 && n < t.i0), b1 = (x > t.v1) || (x == t.v1 && n < t.i1), b2 = (x > t.v2) || (x == t.v2 && n < t.i2);
    Top3 r;
    r.v2 = b1 ? t.v1 : (b2 ? x : t.v2); r.i2 = b1 ? t.i1 : (b2 ? n : t.i2);
    r.v1 = b0 ? t.v0 : (b1 ? x : t.v1); r.i1 = b0 ? t.i0 : (b1 ? n : t.i1);
    r.v0 = b0 ? x : t.v0; r.i0 = b0 ? n : t.i0;
    return r;
}
constexpr int GQS = 0, GKME = 36864, GCNTL = 41472, GMISC = 41600;
struct GatePre { u32x4 q[4]; u32x4 km; float kn, rbv; };
__device__ __forceinline__ void attn_gate_prefetch(Frame& F, int tid, int u, GatePre& P) {
    const int bh = u >> 5, qb = u & 31, b = bh >> 3, h = bh & 7, lane = tid & 63; const size_t tok0 = (size_t)b * SEQ + 256 * qb;
    const bf16_t* Qb = (const bf16_t*)(F.ws + WS_Q); const bf16_t* KM = (const bf16_t*)(F.ws + WS_KMEAN); const float* KN = (const float*)(F.ws + WS_KMEAN + 512 * 1024);
#pragma unroll
    for (int jj = 0; jj < 4; ++jj) { const int q = tid + NTHR * jj, row = q >> 3, pc = q & 7; P.q[jj] = *(const u32x4*)(Qb + (tok0 + row) * DA + h * HD + pc * 8); }
    { const int t2 = tid & 255, n = t2 >> 3, pc = t2 & 7; P.km = *(const u32x4*)(KM + ((size_t)bh * 32 + n) * 64 + pc * 8); }
    P.kn = KN[bh * 32 + (lane & 31)]; P.rbv = F.in[16][h * 32 + (lane & 31)];
}
template <bool COUNT> __device__ __forceinline__ void attn_gate_unit(Frame& F, int bh, int qb, const GatePre& P, int unext, GatePre& PN) {
    LAS unsigned char* L = F.lds;
    LAS bf16_t* QS = (LAS bf16_t*)(L + GQS); LAS bf16_t* KME = (LAS bf16_t*)(L + GKME); LAS int* CNT = (LAS int*)(L + GCNTL); LAS float* KNM = (LAS float*)(L + GMISC);
    int tid = F.tid; asm volatile("" : "+v"(tid));
    const int lane = tid & 63, w = F.wave, j = lane & 31, hi = lane >> 5;
    const int b = bh >> 3, h = bh & 7; const size_t tok0 = (size_t)b * SEQ + 256 * qb;
    const bf16_t* Qb = (const bf16_t*)(F.ws + WS_Q); const bf16_t* KM = (const bf16_t*)(F.ws + WS_KMEAN); const float* KN = (const float*)(F.ws + WS_KMEAN + 512 * 1024);
    float* MQg = (float*)(F.ws + WS_MQ); unsigned short* QL = (unsigned short*)(F.ws + WS_QLIST); unsigned* GC = (unsigned*)(F.ctl + CW_GCNT); unsigned* SEGC = (unsigned*)(F.ws + WS_SEGC);
#pragma unroll
    for (int jj = 0; jj < 4; ++jj) { const int q = tid + NTHR * jj, row = q >> 3, pc = q & 7; *(LAS u32x4*)(QS + row * KVP + pc * 8) = P.q[jj]; }
    if (tid < 256) { const int n = tid >> 3, pc = tid & 7; *(LAS u32x4*)(KME + n * KVP + pc * 8) = P.km; }
    if (tid < 32) CNT[tid] = 0;
    if (w == 1) { float v = (lane <= qb && lane < 32) ? P.kn : 0.f; v = wave_max(v); if (lane == 0) KNM[0] = v; }
    if (w == 2) { float v = wave_max(P.rbv); if (lane == 0) KNM[1] = v * LOG2E; }
    attn_gate_prefetch(F, tid, unext, PN);
    __syncthreads();
    {
        bf16x8 qf[4], kmf[4];
#pragma unroll
        for (int ds = 0; ds < 4; ++ds) { qf[ds] = *(const LAS bf16x8*)(QS + (32 * w + j) * KVP + 16 * ds + 8 * hi); kmf[ds] = *(const LAS bf16x8*)(KME + j * KVP + 16 * ds + 8 * hi); }
        f32x16 gt = {};
#pragma unroll
        for (int ds = 0; ds < 4; ++ds) gt = __builtin_amdgcn_mfma_f32_32x32x16_bf16(kmf[ds], qf[ds], gt, 0, 0, 0);
        float qn = 0.f;
#pragma unroll
        for (int ds = 0; ds < 4; ++ds)
#pragma unroll
            for (int e = 0; e < 8; ++e) { const float x = bf2f((unsigned short)qf[ds][e]); qn += x * x; }
        qn += __shfl_xor(qn, 32);
        const float m2 = sqrtf(qn * KNM[0]) + KNM[1];
        const int ql = 256 * qb + 32 * w + j;
        if (hi == 0) MQg[(size_t)bh * SEQ + ql] = m2;
        Top3 t3; t3.v0 = t3.v1 = t3.v2 = -INFINITY; t3.i0 = t3.i1 = t3.i2 = -1;
#pragma unroll
        for (int r = 0; r < 16; ++r) { const int n = crow(r, hi); const float x = (n < qb) ? gt[r] : -INFINITY; t3 = top3_insert(t3, x, x > -INFINITY ? n : 0x7fffffff); }
        { const float p0 = __shfl_xor(t3.v0, 32), p1 = __shfl_xor(t3.v1, 32), p2 = __shfl_xor(t3.v2, 32); const int q0 = __shfl_xor(t3.i0, 32), q1 = __shfl_xor(t3.i1, 32), q2 = __shfl_xor(t3.i2, 32);
          t3 = top3_insert(t3, p0, q0 >= 0 ? q0 : 0x7fffffff); t3 = top3_insert(t3, p1, q1 >= 0 ? q1 : 0x7fffffff); t3 = top3_insert(t3, p2, q2 >= 0 ? q2 : 0x7fffffff); }
        const int i0 = t3.v0 > -INFINITY ? t3.i0 : -1, i1 = t3.v1 > -INFINITY ? t3.i1 : -1, i2 = t3.v2 > -INFINITY ? t3.i2 : -1;
        if (hi == 0) { const unsigned e = (unsigned)ql << 2;
            if (i0 >= 0) { const int pos = __hip_atomic_fetch_add(CNT + i0, 1, __ATOMIC_RELAXED, __HIP_MEMORY_SCOPE_WORKGROUP); QL[((size_t)bh * 32 + i0) * SEQ + (qb - i0 - 1) * 256 + pos] = (unsigned short)(e | 0u); }
            if (i1 >= 0) { const int pos = __hip_atomic_fetch_add(CNT + i1, 1, __ATOMIC_RELAXED, __HIP_MEMORY_SCOPE_WORKGROUP); QL[((size_t)bh * 32 + i1) * SEQ + (qb - i1 - 1) * 256 + pos] = (unsigned short)(e | 1u); }
            if (i2 >= 0) { const int pos = __hip_atomic_fetch_add(CNT + i2, 1, __ATOMIC_RELAXED, __HIP_MEMORY_SCOPE_WORKGROUP); QL[((size_t)bh * 32 + i2) * SEQ + (qb - i2 - 1) * 256 + pos] = (unsigned short)(e | 2u); } }
    }
    __syncthreads();
    if (tid < qb) { const unsigned c = (unsigned)CNT[tid]; SEGC[((size_t)bh * 32 + tid) * 32 + (qb - tid - 1)] = c; if (COUNT && c) (void)__hip_atomic_fetch_add(GC + bh * 32 + tid, c, __ATOMIC_RELAXED, __HIP_MEMORY_SCOPE_AGENT); }
    __syncthreads();
}
template <bool COUNT> __device__ __forceinline__ void attn_gate_phase(Frame& F) {
    constexpr int NU = BATCH * NH * NBLK; if (F.vcu >= NU) return;
    GatePre PA, PB; attn_gate_prefetch(F, F.tid, F.vcu, PA);
    for (int u = F.vcu; u < NU; u += 2 * F.G) {
        const int u1 = u + F.G, u2 = u + 2 * F.G;
        attn_gate_unit<COUNT>(F, u >> 5, u & 31, PA, u1 < NU ? u1 : u, PB);
        if (u1 < NU) attn_gate_unit<COUNT>(F, u1 >> 5, u1 & 31, PB, u2 < NU ? u2 : u1, PA);
    }
}

__device__ __forceinline__ int prefix32_dpp(int v) {
    v += __builtin_amdgcn_update_dpp(0, v, 0x111, 0xF, 0xF, false);
    v += __builtin_amdgcn_update_dpp(0, v, 0x112, 0xF, 0xF, false);
    v += __builtin_amdgcn_update_dpp(0, v, 0x114, 0xF, 0xF, false);
    v += __builtin_amdgcn_update_dpp(0, v, 0x118, 0xF, 0xF, false);
    v += __builtin_amdgcn_update_dpp(0, v, 0x142, 0xA, 0xF, false);
    return v;
}
#define ATTN_SBAR __builtin_amdgcn_sched_barrier(0)
#ifndef ATTN_SETPRIO
#define ATTN_SETPRIO 0
#endif
#define ATTN_PRIO(p_) do { if (ATTN_SETPRIO) __builtin_amdgcn_s_setprio(p_); } while (0)
#define ATTN_LOADF(KF_, VF_, KP, VP, st_) do { \
        _Pragma("unroll") for (int ds_ = 0; ds_ < 4; ++ds_) KF_[ds_] = *(const LAS bf16x8*)((KP) + ((st_) * 4 + ds_) * 512 + lane8); \
        _Pragma("unroll") for (int q_ = 0; q_ < 4; ++q_) VF_[q_] = *(const LAS bf16x8*)((VP) + ((st_) * 4 + q_) * 512 + lane8); } while (0)
#define ATTN_COMPUTE(KF_, VF_, st_, MODE, CINIT) do { \
        ATTN_PRIO(1); f32x16 s_ = __builtin_amdgcn_mfma_f32_32x32x16_bf16(KF_[0], qf[0], CINIT, 0, 0, 0); \
        _Pragma("unroll") for (int ds_ = 1; ds_ < 4; ++ds_) s_ = __builtin_amdgcn_mfma_f32_32x32x16_bf16(KF_[ds_], qf[ds_], s_, 0, 0, 0); ATTN_PRIO(0); \
        float p_[16]; \
        if ((MODE) == 0) { _Pragma("unroll") for (int r_ = 0; r_ < 16; ++r_) p_[r_] = __builtin_amdgcn_exp2f(s_[r_]); } \
        else if ((MODE) == 1) { _Pragma("unroll") for (int r_ = 0; r_ < 16; ++r_) { const int dist_ = dq - (32 * (st_) + crow(r_, hi)); const int di_ = dist_ < 0 ? 0 : (dist_ > 127 ? 127 : dist_); \
                p_[r_] = __builtin_amdgcn_exp2f(s_[r_] + TABh[di_]); } } \
        else { _Pragma("unroll") for (int rq_ = 0; rq_ < 4; ++rq_) { const f32x4 bb_ = *(const LAS f32x4*)(BTD + rq_ * 256 + lane * 4); \
                _Pragma("unroll") for (int i_ = 0; i_ < 4; ++i_) p_[4 * rq_ + i_] = __builtin_amdgcn_exp2f(s_[4 * rq_ + i_] + bb_[i_]); } } \
        _Pragma("unroll") for (int r_ = 0; r_ < 16; ++r_) lsum += p_[r_]; \
        u32x4 pa_, pb_; pa_.x = cvt_pk_bf16(p_[0], p_[1]); pa_.y = cvt_pk_bf16(p_[2], p_[3]); pa_.z = cvt_pk_bf16(p_[4], p_[5]); pa_.w = cvt_pk_bf16(p_[6], p_[7]); \
        pb_.x = cvt_pk_bf16(p_[8], p_[9]); pb_.y = cvt_pk_bf16(p_[10], p_[11]); pb_.z = cvt_pk_bf16(p_[12], p_[13]); pb_.w = cvt_pk_bf16(p_[14], p_[15]); \
        const bf16x8 A0_ = __builtin_bit_cast(bf16x8, pa_), A1_ = __builtin_bit_cast(bf16x8, pb_); \
        ATTN_PRIO(1); o0 = __builtin_amdgcn_mfma_f32_32x32x16_bf16(VF_[0], A0_, o0, 0, 0, 0); o1 = __builtin_amdgcn_mfma_f32_32x32x16_bf16(VF_[1], A0_, o1, 0, 0, 0); \
        o0 = __builtin_amdgcn_mfma_f32_32x32x16_bf16(VF_[2], A1_, o0, 0, 0, 0); o1 = __builtin_amdgcn_mfma_f32_32x32x16_bf16(VF_[3], A1_, o1, 0, 0, 0); ATTN_PRIO(0); } while (0)
#define ATTN_TILE8(KP, VP, MODE, CINIT, HOOK) do { bf16x8 kA_[4], vA_[4], kB_[4], vB_[4]; ATTN_LOADF(kA_, vA_, KP, VP, 0); \
        _Pragma("nounroll") for (int st2_ = 0; st2_ < 8; st2_ += 2) { ATTN_LOADF(kB_, vB_, KP, VP, st2_ + 1); ATTN_SBAR; ATTN_COMPUTE(kA_, vA_, st2_, MODE, CINIT); HOOK(st2_); \
            ATTN_LOADF(kA_, vA_, KP, VP, (st2_ + 2 < 8 ? st2_ + 2 : 7)); ATTN_SBAR; ATTN_COMPUTE(kB_, vB_, st2_ + 1, MODE, CINIT); } } while (0)

__device__ __forceinline__ u32x4 ot_pack16(const f32x16& o, int pr) {
    const unsigned p0 = cvt_pk_bf16(o[8 * pr], o[8 * pr + 1]), p1 = cvt_pk_bf16(o[8 * pr + 2], o[8 * pr + 3]), q0 = cvt_pk_bf16(o[8 * pr + 4], o[8 * pr + 5]), q1 = cvt_pk_bf16(o[8 * pr + 6], o[8 * pr + 7]);
    const auto r0 = __builtin_amdgcn_permlane32_swap(p0, q0, false, false); const auto r1 = __builtin_amdgcn_permlane32_swap(p1, q1, false, false);
    return (u32x4){r0[0], r1[0], r0[1], r1[1]};
}
__device__ __forceinline__ u32x2 ot_pack8_f8(const f32x16& o, int pr) {
    const unsigned p = pk4_fp8(o[8 * pr], o[8 * pr + 1], o[8 * pr + 2], o[8 * pr + 3]), q = pk4_fp8(o[8 * pr + 4], o[8 * pr + 5], o[8 * pr + 6], o[8 * pr + 7]);
    const auto r0 = __builtin_amdgcn_permlane32_swap(p, q, false, false);
    return (u32x2){r0[0], r0[1]};
}
__device__ __forceinline__ void ot_add16(f32x16& o, int pr, u32x4 v, bool use) {
    const auto r0 = __builtin_amdgcn_permlane32_swap(v.x, v.z, false, false); const auto r1 = __builtin_amdgcn_permlane32_swap(v.y, v.w, false, false);
    const unsigned p0 = r0[0], p1 = r1[0], q0 = r0[1], q1 = r1[1];
    o[8 * pr] += use ? bflo(p0) : 0.f; o[8 * pr + 1] += use ? bfhi(p0) : 0.f; o[8 * pr + 2] += use ? bflo(p1) : 0.f; o[8 * pr + 3] += use ? bfhi(p1) : 0.f;
    o[8 * pr + 4] += use ? bflo(q0) : 0.f; o[8 * pr + 5] += use ? bfhi(q0) : 0.f; o[8 * pr + 6] += use ? bflo(q1) : 0.f; o[8 * pr + 7] += use ? bfhi(q1) : 0.f;
}
__device__ __forceinline__ void ot_add8_f8(f32x16& o, int pr, u32x2 v, bool use, float sc) {
    const auto r0 = __builtin_amdgcn_permlane32_swap(v.x, v.y, false, false); const int p = (int)r0[0], q = (int)r0[1];
    o[8 * pr] += use ? __builtin_amdgcn_cvt_f32_fp8(p, 0) * sc : 0.f; o[8 * pr + 1] += use ? __builtin_amdgcn_cvt_f32_fp8(p, 1) * sc : 0.f; o[8 * pr + 2] += use ? __builtin_amdgcn_cvt_f32_fp8(p, 2) * sc : 0.f; o[8 * pr + 3] += use ? __builtin_amdgcn_cvt_f32_fp8(p, 3) * sc : 0.f;
    o[8 * pr + 4] += use ? __builtin_amdgcn_cvt_f32_fp8(q, 0) * sc : 0.f; o[8 * pr + 5] += use ? __builtin_amdgcn_cvt_f32_fp8(q, 1) * sc : 0.f; o[8 * pr + 6] += use ? __builtin_amdgcn_cvt_f32_fp8(q, 2) * sc : 0.f; o[8 * pr + 7] += use ? __builtin_amdgcn_cvt_f32_fp8(q, 3) * sc : 0.f;
}
__device__ __forceinline__ u32x4 ot_pack16_f8(const f32x16& o) {
    const unsigned a = pk4_fp8(o[0], o[1], o[2], o[3]), b = pk4_fp8(o[4], o[5], o[6], o[7]), c = pk4_fp8(o[8], o[9], o[10], o[11]), d = pk4_fp8(o[12], o[13], o[14], o[15]);
    const auto r0 = __builtin_amdgcn_permlane32_swap(a, c, false, false); const auto r1 = __builtin_amdgcn_permlane32_swap(b, d, false, false);
    return (u32x4){r0[0], r0[1], r1[0], r1[1]};
}
__device__ __forceinline__ void ot_add16_f8(f32x16& o, u32x4 v, bool use, float sc) {
    const auto r0 = __builtin_amdgcn_permlane32_swap(v.x, v.y, false, false); const auto r1 = __builtin_amdgcn_permlane32_swap(v.z, v.w, false, false);
    const int a = (int)r0[0], c = (int)r0[1], b = (int)r1[0], d = (int)r1[1];
#pragma unroll
    for (int e = 0; e < 4; ++e) { float fa, fb, fc, fd;
        switch (e) { case 0: fa = __builtin_amdgcn_cvt_f32_fp8(a, 0); fb = __builtin_amdgcn_cvt_f32_fp8(b, 0); fc = __builtin_amdgcn_cvt_f32_fp8(c, 0); fd = __builtin_amdgcn_cvt_f32_fp8(d, 0); break;
                     case 1: fa = __builtin_amdgcn_cvt_f32_fp8(a, 1); fb = __builtin_amdgcn_cvt_f32_fp8(b, 1); fc = __builtin_amdgcn_cvt_f32_fp8(c, 1); fd = __builtin_amdgcn_cvt_f32_fp8(d, 1); break;
                     case 2: fa = __builtin_amdgcn_cvt_f32_fp8(a, 2); fb = __builtin_amdgcn_cvt_f32_fp8(b, 2); fc = __builtin_amdgcn_cvt_f32_fp8(c, 2); fd = __builtin_amdgcn_cvt_f32_fp8(d, 2); break;
                     default: fa = __builtin_amdgcn_cvt_f32_fp8(a, 3); fb = __builtin_amdgcn_cvt_f32_fp8(b, 3); fc = __builtin_amdgcn_cvt_f32_fp8(c, 3); fd = __builtin_amdgcn_cvt_f32_fp8(d, 3); break; }
        o[e] += use ? fa * sc : 0.f; o[4 + e] += use ? fb * sc : 0.f; o[8 + e] += use ? fc * sc : 0.f; o[12 + e] += use ? fd * sc : 0.f; }
}
__device__ __forceinline__ void attn_fill_tab(Frame& F, LAS float* TAB) {
    const float* rb = F.in[16];
    for (int idx = F.tid; idx < 8 * 132; idx += NTHR) { const int h = idx / 132, d = idx % 132; float v = 0.f;
        if (d < 128) v = rb[h * 32 + t5_bucket(d)] * LOG2E; else if (d == 129) v = rb[h * 32 + 31] * LOG2E;
        TAB[idx] = v; }
}
constexpr int BGPRE_OFF = ROWTAB_OFF, BGCL_OFF = ROWTAB_OFF + 8448, BTAB_OFF = ROWTAB_OFF + 16640, BIT_OFF = ROWTAB_OFF + 20992, BIT_MAX = 512, OTAB_OFF = ROWTAB_OFF + 20480  ;
static_assert(BTAB_OFF + 8 * 132 * 4 <= MOE_TST_OFF, "attention LDS tables");
__device__ __forceinline__ size_t part_off(int slot) { return slot == 0 ? WS_PART0 : (slot == 1 ? WS_PART1 : WS_PART2); }

__device__ __forceinline__ void attn_block_phase(Frame& F) {
    LAS unsigned char* L = F.lds; LAS int* GPRE = (LAS int*)(L + BGPRE_OFF); LAS int* GCL = (LAS int*)(L + BGCL_OFF); LAS float* TAB = (LAS float*)(L + BTAB_OFF); LAS int* ITT = (LAS int*)(L + BIT_OFF); LAS int* WSUM = (LAS int*)(L + MOE_TST_OFF);
    const unsigned* GC = (const unsigned*)(F.ctl + CW_GCNT); const unsigned* SEGC = (const unsigned*)(F.ws + WS_SEGC);
    const int tid = F.tid, lane = F.lane, w = F.wave, j = lane & 31, hi = lane >> 5, lane8 = lane * 8;
    { int ng[4], tot = 0;
#pragma unroll
      for (int e = 0; e < 4; ++e) { const int c = (int)GC[4 * tid + e]; GCL[4 * tid + e] = c; ng[e] = (((c + 31) >> 5) + 7) >> 3; tot += ng[e]; }
      int inc = tot;
#pragma unroll
      for (int o = 1; o < 64; o <<= 1) { const int t = __shfl_up(inc, o); if (lane >= o) inc += t; }
      if (lane == 63) WSUM[w] = inc;
      __syncthreads();
      int woff = 0;
      for (int q = 0; q < w; ++q) woff += WSUM[q];
      int ex = woff + inc - tot;
#pragma unroll
      for (int e = 0; e < 4; ++e) { GPRE[4 * tid + e] = ex; ex += ng[e]; }
      if (tid == NTHR - 1) GPRE[2048] = ex; }
    attn_fill_tab(F, TAB);
    __syncthreads();
    const int NIT = GPRE[2048];
    const int nk = (NIT > F.vcu) ? (NIT - F.vcu + F.G - 1) / F.G : 0;
    if (tid < nk && tid < BIT_MAX) { const int it_ = F.vcu + tid * F.G; int lo_ = 0, hi_ = 2048; while (hi_ - lo_ > 1) { const int mid_ = (lo_ + hi_) >> 1; if (GPRE[mid_] <= it_) lo_ = mid_; else hi_ = mid_; } ITT[tid] = lo_ * 64 + (it_ - GPRE[lo_]); }
    __syncthreads();
    if (nk == 0) return;
    const int nkc = nk < BIT_MAX ? nk : BIT_MAX;
    const bf16_t* Qb = (const bf16_t*)(F.ws + WS_Q); const float* MQg = (const float*)(F.ws + WS_MQ); const unsigned short* QL = (const unsigned short*)(F.ws + WS_QLIST);
    const bf16_t* KF = (const bf16_t*)(F.ws + WS_KFRAG); const bf16_t* VF = (const bf16_t*)(F.ws + WS_VFRAG);
    float* PL = (float*)(F.ws + WS_PL);
#define BLK_ITEM(k_, pi_, g_) do { const int kk_ = (k_) < nkc ? (k_) : nkc - 1; const int v_ = __builtin_amdgcn_readfirstlane(ITT[kk_]); pi_ = v_ >> 6; g_ = v_ & 63; } while (0)
#define BLK_DMA2(buf_, pi_, i0_) do { const char* ks_ = (const char*)KF + ((size_t)(pi_) * 2048 + tid) * 16; const char* vs_ = (const char*)VF + ((size_t)(pi_) * 2048 + tid) * 16; \
        _Pragma("unroll") for (int i_ = (i0_); i_ < (i0_) + 2; ++i_) { \
            __builtin_amdgcn_global_load_lds((const unsigned*)(ks_ + i_ * 8192), (LAS unsigned*)(L + (buf_) + (i_ * 512 + w * 64) * 16), 16, 0, 0); \
            __builtin_amdgcn_global_load_lds((const unsigned*)(vs_ + i_ * 8192), (LAS unsigned*)(L + (buf_) + 32768 + (i_ * 512 + w * 64) * 16), 16, 0, 0); } } while (0)
#define BLK_DMA(buf_, pi_) do { const char* ks_ = (const char*)KF + ((size_t)(pi_) * 2048 + tid) * 16; const char* vs_ = (const char*)VF + ((size_t)(pi_) * 2048 + tid) * 16; \
        _Pragma("unroll") for (int i_ = 0; i_ < 4; ++i_) { \
            __builtin_amdgcn_global_load_lds((const unsigned*)(ks_ + i_ * 8192), (LAS unsigned*)(L + (buf_) + (i_ * 512 + w * 64) * 16), 16, 0, 0); \
            __builtin_amdgcn_global_load_lds((const unsigned*)(vs_ + i_ * 8192), (LAS unsigned*)(L + (buf_) + 32768 + (i_ * 512 + w * 64) * 16), 16, 0, 0); } } while (0)
#define BLK_SEGC(dst_, pi_) do { dst_ = SEGC[(size_t)(pi_) * 32 + j]; } while (0)
#define BLK_ENTRY(dst_, segc_, pi_, g_) do { const int n_ = (pi_) & 31; int inc_ = (j < 31 - n_) ? (int)(segc_) : 0; \
        inc_ = prefix32_dpp(inc_); \
        const int cnt_ = GCL[pi_]; const int base_ = 32 * (8 * (g_) + w); const int idx_ = base_ + j; const bool vs_ = j < 31 - n_; \
          \
        const unsigned lb_ = (unsigned)__ballot(vs_ && inc_ <= base_); const int seg0_ = __builtin_popcount(lb_); \
        int seg_ = seg0_, prev_ = seg0_ > 0 ? __builtin_amdgcn_readlane(inc_, seg0_ - 1) : 0; \
        unsigned wm_ = (unsigned)__ballot(vs_ && inc_ > base_ && inc_ <= base_ + 31); \
        while (wm_ != 0u) { const int s_ = __builtin_ctz(wm_); wm_ &= wm_ - 1u; const int p_ = __builtin_amdgcn_readlane(inc_, s_); const bool le_ = p_ <= idx_; seg_ += le_ ? 1 : 0; prev_ = le_ ? p_ : prev_; } \
        const bool ok_ = idx_ < cnt_; const unsigned v_ = QL[(size_t)(pi_) * SEQ + (ok_ ? seg_ * 256 + (idx_ - prev_) : 0)]; dst_ = ok_ ? v_ : 0xFFFFu; } while (0)
#define BLK_QLOAD(qf_, m2_, ent_, pi_) do { const unsigned qq_ = ((ent_) == 0xFFFFu) ? 0u : ((ent_) >> 2); const int bh_ = (pi_) >> 5; \
        const bf16_t* qrow_ = Qb + ((size_t)(bh_ >> 3) * SEQ + qq_) * DA + (bh_ & 7) * HD + 8 * hi; \
        _Pragma("unroll") for (int ds_ = 0; ds_ < 4; ++ds_) qf_[ds_] = *(const bf16x8*)(qrow_ + 16 * ds_); \
        m2_ = MQg[(size_t)bh_ * SEQ + qq_]; } while (0)
    int pi, g, pi1, g1, pi2, g2; unsigned ent, ent1, sc2; bf16x8 qf[4]; float m2r;
    BLK_ITEM(0, pi, g); BLK_ITEM(1, pi1, g1); BLK_ITEM(2, pi2, g2);
    BLK_DMA(0, pi);
    { unsigned sc0, sc1; BLK_SEGC(sc0, pi); BLK_SEGC(sc1, pi1); BLK_SEGC(sc2, pi2); BLK_ENTRY(ent, sc0, pi, g); BLK_ENTRY(ent1, sc1, pi1, g1); }
    BLK_QLOAD(qf, m2r, ent, pi);
    int cur = 0;
#ifdef PROBE_TW
    unsigned tw_acc_ = 0u; const unsigned long long tt0_ = __builtin_amdgcn_s_memrealtime();
#endif
    __builtin_amdgcn_s_waitcnt(0x0F70);
    unsigned char* dump = F.ws + WS_E + ((size_t)F.vcu * NTHR + tid) * 128;
    for (int k = 0; k < nkc; ++k) {
#ifdef PROBE_TW
        const unsigned long long tw0_ = __builtin_amdgcn_s_memrealtime();
#endif
        __builtin_amdgcn_s_waitcnt(0x0F73);
        __syncthreads();
#ifdef PROBE_TW
        tw_acc_ += (unsigned)(__builtin_amdgcn_s_memrealtime() - tw0_);
#endif
        int pi3, g3; unsigned sc3, ent2; bf16x8 qfn[4]; float m2n;
        BLK_ITEM(k + 3, pi3, g3);
#define BLK_HOOK(st_) do { if ((st_) == 0) { BLK_DMA2((cur ^ 1) * 65536, pi1, 0); } else if ((st_) == 2) { BLK_DMA2((cur ^ 1) * 65536, pi1, 2); } } while (0)
        BLK_SEGC(sc3, pi3);
        BLK_ENTRY(ent2, sc2, pi2, g2);
        BLK_QLOAD(qfn, m2n, ent1, pi1);
        const int bh = pi >> 5, n = pi & 31, h = bh & 7;
        const bool valid = ent != 0xFFFFu; const int q = valid ? (int)(ent >> 2) : 0; const int slot = (int)(ent & 3u);
        const bool active = __builtin_amdgcn_readfirstlane((int)(__ballot(valid) != 0ull)) != 0;
        f32x16 o0 = {}, o1 = {}; float lsum = 0.f;
        if (active) {
            const float m2 = valid ? m2r : INFINITY;
            const LAS bf16_t* KP = (const LAS bf16_t*)(L + cur * 65536); const LAS bf16_t* VP = (const LAS bf16_t*)(L + cur * 65536 + 32768);
            const LAS float* TABh = TAB + h * 132; const LAS float* BTD = nullptr; (void)BTD;
            const int dq = q - 256 * n;
            const bool nearw = __builtin_amdgcn_readfirstlane((int)(__ballot(valid && dq < 383) != 0ull)) != 0;
            const float ci = nearw ? -m2 : TABh[129] - m2;
            f32x16 cinit;
#pragma unroll
            for (int r = 0; r < 16; ++r) cinit[r] = ci;
            if (nearw) { ATTN_TILE8(KP, VP, 1, cinit, BLK_HOOK); }
            else { ATTN_TILE8(KP, VP, 0, cinit, BLK_HOOK); }
        } else { BLK_HOOK(0); BLK_HOOK(2); }
#undef BLK_HOOK
        { const float lt = sum_xor32(lsum);
          const size_t qi = (size_t)bh * SEQ + q;
          float* pld = valid ? PL + (size_t)slot * (NH * BATCH * SEQ) + qi : (float*)(dump + 120);
          unsigned char* dst = valid ? F.ws + part_off(slot) + qi * HD + 16 * hi : dump;
          *pld = lt;
          const float inv = lt > 0.f ? 1.f / lt : 0.f;
#pragma unroll
          for (int r = 0; r < 16; ++r) { o0[r] *= inv; o1[r] *= inv; }
          *(u32x4*)(dst) = ot_pack16_f8(o0); *(u32x4*)(dst + 32) = ot_pack16_f8(o1); }
        pi = pi1; g = g1; ent = ent1; m2r = m2n; pi1 = pi2; g1 = g2; ent1 = ent2; pi2 = pi3; g2 = g3; sc2 = sc3; cur ^= 1;
#pragma unroll
        for (int ds = 0; ds < 4; ++ds) qf[ds] = qfn[ds];
    }
#ifdef PROBE_TW
    if (F.wave == PROBE_TW_WAVE && lane == 0) { __hip_atomic_fetch_add((unsigned*)(F.ctl + 3), tw_acc_, __ATOMIC_RELAXED, __HIP_MEMORY_SCOPE_AGENT); __hip_atomic_fetch_add((unsigned*)(F.ctl + 4), (unsigned)(__builtin_amdgcn_s_memrealtime() - tt0_), __ATOMIC_RELAXED, __HIP_MEMORY_SCOPE_AGENT); }
#endif
    VM_WAIT(); __syncthreads();
#undef BLK_ITEM
#undef BLK_DMA
#undef BLK_DMA2
#undef BLK_SEGC
#undef BLK_ENTRY
#undef BLK_QLOAD
}

__device__ __forceinline__ void attn_own_phase(Frame& F) {
    LAS unsigned char* L = F.lds; LAS float* TAB = (LAS float*)(L + OTAB_OFF); LAS float* BT = (LAS float*)(L + ROWTAB_OFF); int bth = -1;
    attn_fill_tab(F, TAB);
    const int tid = F.tid, lane = F.lane, w = F.wave, j = lane & 31, hi = lane >> 5, lane8 = lane * 8;
    const bf16_t* Qb = (const bf16_t*)(F.ws + WS_Q); const float* MQg = (const float*)(F.ws + WS_MQ);
    const bf16_t* KF = (const bf16_t*)(F.ws + WS_KFRAG); const bf16_t* VF = (const bf16_t*)(F.ws + WS_VFRAG);
    const float* PL = (const float*)(F.ws + WS_PL); unsigned char* YA = F.ws + WS_YATT;
    const int NU = BATCH * NH * NBLK;
#define OWN_DMA(buf_, pi_) do { const char* ks_ = (const char*)KF + ((size_t)(pi_) * 2048 + tid) * 16; const char* vs_ = (const char*)VF + ((size_t)(pi_) * 2048 + tid) * 16; \
        _Pragma("unroll") for (int i_ = 0; i_ < 4; ++i_) { \
            __builtin_amdgcn_global_load_lds((const unsigned*)(ks_ + i_ * 8192), (LAS unsigned*)(L + (buf_) + (i_ * 512 + w * 64) * 16), 16, 0, 0); \
            __builtin_amdgcn_global_load_lds((const unsigned*)(vs_ + i_ * 8192), (LAS unsigned*)(L + (buf_) + 32768 + (i_ * 512 + w * 64) * 16), 16, 0, 0); } } while (0)
#define OWN_DMA_LIGHT(buf_, pi_) do { const char* ks_ = (const char*)KF + ((size_t)(pi_) * 2048 + tid) * 16; const char* vs_ = (const char*)VF + ((size_t)(pi_) * 2048 + tid) * 16; \
        _Pragma("unroll") for (int i_ = 0; i_ < 8; ++i_) { \
            __builtin_amdgcn_global_load_lds((const unsigned*)(ks_ + i_ * 4096), (LAS unsigned*)(L + (buf_) + (i_ * 256 + w * 64) * 16), 16, 0, 0); \
            __builtin_amdgcn_global_load_lds((const unsigned*)(vs_ + i_ * 4096), (LAS unsigned*)(L + (buf_) + 32768 + (i_ * 256 + w * 64) * 16), 16, 0, 0); } } while (0)
#define OWN_QLOAD(qf_, m2_, u_) do { const int bh_ = (u_) >> 5, qb_ = (u_) & 31; const size_t tk_ = (size_t)256 * qb_ + 32 * w + j; \
        const bf16_t* qrow_ = Qb + ((size_t)(bh_ >> 3) * SEQ + tk_) * DA + (bh_ & 7) * HD + 8 * hi; \
        _Pragma("unroll") for (int ds_ = 0; ds_ < 4; ++ds_) qf_[ds_] = *(const bf16x8*)(qrow_ + 16 * ds_); \
        m2_ = MQg[(size_t)bh_ * SEQ + tk_]; } while (0)
    int u = F.vcu; if (u >= NU) return;
    bf16x8 qf[4]; float m2;
    OWN_DMA(0, u); OWN_QLOAD(qf, m2, u);
    int cur = 0;
    __builtin_amdgcn_s_waitcnt(0x0F70);
    for (;;) {
        __builtin_amdgcn_s_waitcnt(0x0F72); __syncthreads();
        const int un = (u + F.G < NU) ? u + F.G : u; const bool last = (un == u);
        const int bh = u >> 5, qb = u & 31, b = bh >> 3, h = bh & 7; const int ql = 32 * w + j; const size_t qi = (size_t)bh * SEQ + 256 * qb + ql;
        u32x4 pa[3][2]; float pl[3]; bf16x8 qfn[4]; float m2n;
#define OWN_PA() do { _Pragma("unroll") for (int s = 0; s < 3; ++s) { const unsigned char* src = F.ws + part_off(s) + qi * HD + 16 * hi; \
            _Pragma("unroll") for (int c = 0; c < 2; ++c) pa[s][c] = *(const u32x4*)(src + 32 * c); } } while (0)
#define OWN_PL() do { _Pragma("unroll") for (int s = 0; s < 3; ++s) pl[s] = PL[(size_t)s * (NH * BATCH * SEQ) + qi]; } while (0)
        const LAS bf16_t* KP = (const LAS bf16_t*)(L + cur * 65536); const LAS bf16_t* VP = (const LAS bf16_t*)(L + cur * 65536 + 32768); const LAS float* TABh = TAB + h * 132;
        if (h != bth) { __syncthreads();
            for (int e = tid; e < 5 * 1024; e += NTHR) { const int i = e & 3, ln = (e >> 2) & 63, rq = (e >> 8) & 3, dl = e >> 10; const int dist = 32 * dl + (ln & 31) - crow(4 * rq + i, ln >> 5);
                BT[e] = dist < 0 ? -1e30f : TABh[dist > 127 ? 127 : dist]; }
            bth = h; __syncthreads(); }
        const int dq = ql; (void)dq;
        f32x16 cnear, cfar;
#pragma unroll
        for (int r = 0; r < 16; ++r) { cnear[r] = -m2; cfar[r] = TABh[129] - m2; }
        f32x16 o0 = {}, o1 = {}; float lsum = 0.f;
        { bf16x8 kA_[4], vA_[4], kB_[4], vB_[4]; ATTN_LOADF(kA_, vA_, KP, VP, 0);
          for (int st = 0; st <= w; st += 2) { const int s1 = st + 1 <= w ? st + 1 : w, s2 = st + 2 <= w ? st + 2 : w;
              ATTN_LOADF(kB_, vB_, KP, VP, s1); ATTN_SBAR;
              { const int dl = w - st; if (dl >= 5) { const LAS float* BTD = nullptr; (void)BTD; ATTN_COMPUTE(kA_, vA_, st, 0, cfar); } else { const LAS float* BTD = BT + dl * 1024; ATTN_COMPUTE(kA_, vA_, st, 2, cnear); } }
              if (w >= 4 && st == 0) OWN_PA();
              ATTN_LOADF(kA_, vA_, KP, VP, s2); ATTN_SBAR;
              if (st + 1 <= w) { const int dl = w - st - 1; if (dl >= 5) { const LAS float* BTD = nullptr; (void)BTD; ATTN_COMPUTE(kB_, vB_, st + 1, 0, cfar); } else { const LAS float* BTD = BT + dl * 1024; ATTN_COMPUTE(kB_, vB_, st + 1, 2, cnear); } }
              if (w >= 4 && st == 2) { OWN_PL(); OWN_QLOAD(qfn, m2n, un); } } }
        if (w < 4) { OWN_PA(); OWN_PL(); OWN_DMA_LIGHT((cur ^ 1) * 65536, un); OWN_QLOAD(qfn, m2n, un); }
        float lt = sum_xor32(lsum);
        const int nsel = qb < 3 ? qb : 3;
#pragma unroll
        for (int s = 0; s < 3; ++s) { const bool use = s < nsel; lt += use ? pl[s] : 0.f;
            ot_add16_f8(o0, pa[s][0], use, pl[s]); ot_add16_f8(o1, pa[s][1], use, pl[s]); }
        const float inv = 1.f / lt;
#pragma unroll
        for (int r = 0; r < 16; ++r) { o0[r] *= inv; o1[r] *= inv; }
        unsigned char* dst = YA + ((size_t)b * SEQ + 256 * qb + ql) * DA + h * HD + 16 * hi;
        *(u32x4*)(dst) = ot_pack16_f8(o0); *(u32x4*)(dst + 32) = ot_pack16_f8(o1);
        if (last) break;
        u = un; m2 = m2n; cur ^= 1;
#pragma unroll
        for (int ds = 0; ds < 4; ++ds) qf[ds] = qfn[ds];
    }
    VM_WAIT(); __syncthreads();
#undef OWN_DMA
#undef OWN_DMA_LIGHT
#undef OWN_PA
#undef OWN_PL
#undef OWN_QLOAD
}
#undef ATTN_LOADF
#undef ATTN_COMPUTE
#undef ATTN_TILE8
#undef ATTN_SBAR

__device__ __forceinline__ void routing_phase(Frame& F) {
    LAS int* lcnt = (LAS int*)(F.lds); LAS int* lbase = lcnt + 32;
    const float* SSQ = (const float*)(F.ws + WS_SSQ); const float* RL = (const float*)(F.ws + WS_RLOG);
    unsigned* rowtok = (unsigned*)(F.ws + WS_ROWTOK); float* rowcoef = (float*)(F.ws + WS_ROWCOEF); float* rowrstd = (float*)(F.ws + WS_ROWRSTD);
    unsigned* ecnt = (unsigned*)(F.ctl + CW_ECNT);
    const float* brg = F.in[20]; const float* bre = F.in[22];
    const int tid = F.tid;
    for (int base = F.vcu * 256; base < T; base += F.G * 256) {
        if (tid < 32) lcnt[tid] = 0;
        __syncthreads();
        int e0 = 0, e1 = 0, lp0 = 0, lp1 = 0; float c0 = 0.f, c1 = 0.f, rstd = 0.f; const int tok = base + tid;
        if (tid < 256) {
            float ss = 0.f;
#pragma unroll
            for (int q = 0; q < 4; ++q) { const f32x4 v = *(const f32x4*)(SSQ + (size_t)tok * 16 + 4 * q); ss += (v.x + v.y) + (v.z + v.w); }
            rstd = 1.f / sqrtf(ss * (1.f / D) + RMS_EPS);
            float r[72];
#pragma unroll
            for (int q = 0; q < 18; ++q) { const f32x4 v = *(const f32x4*)(RL + (size_t)tok * 72 + 4 * q); r[4 * q] = v.x; r[4 * q + 1] = v.y; r[4 * q + 2] = v.z; r[4 * q + 3] = v.w; }
            float gl[4], el[32];
#pragma unroll
            for (int c = 0; c < 4; ++c) gl[c] = rstd * (r[c] + r[36 + c]) + brg[c];
#pragma unroll
            for (int c = 0; c < 32; ++c) el[c] = rstd * (r[4 + c] + r[40 + c]) + bre[c];
            int gi = 0; float gm = gl[0];
#pragma unroll
            for (int c = 1; c < 4; ++c) if (gl[c] > gm) { gm = gl[c]; gi = c; }
            float Z = 0.f;
#pragma unroll
            for (int c = 0; c < 4; ++c) Z += __expf(gl[c] - gm);
            const float gval = 1.f / Z;
            float es[8];
#pragma unroll
            for (int q = 0; q < 8; ++q) es[q] = gi == 0 ? el[q] : (gi == 1 ? el[8 + q] : (gi == 2 ? el[16 + q] : el[24 + q]));
            int a0 = 0; float m0 = es[0];
#pragma unroll
            for (int q = 1; q < 8; ++q) if (es[q] > m0) { m0 = es[q]; a0 = q; }
            int a1 = -1; float m1 = -INFINITY;
#pragma unroll
            for (int q = 0; q < 8; ++q) if (q != a0 && es[q] > m1) { m1 = es[q]; a1 = q; }
            const float w0 = 1.f / (1.f + __expf(m1 - m0)), w1 = 1.f - w0;
            e0 = gi * 8 + a0; e1 = gi * 8 + a1; c0 = gval * w0; c1 = gval * w1;
            lp0 = __hip_atomic_fetch_add(lcnt + e0, 1, __ATOMIC_RELAXED, __HIP_MEMORY_SCOPE_WORKGROUP);
            lp1 = __hip_atomic_fetch_add(lcnt + e1, 1, __ATOMIC_RELAXED, __HIP_MEMORY_SCOPE_WORKGROUP);
        }
        __syncthreads();
        if (tid < 32) lbase[tid] = (int)__hip_atomic_fetch_add(ecnt + tid, (unsigned)lcnt[tid], __ATOMIC_RELAXED, __HIP_MEMORY_SCOPE_AGENT);
        __syncthreads();
        if (tid < 256) {
            const size_t i0 = (size_t)e0 * ROWCAP + lbase[e0] + lp0, i1 = (size_t)e1 * ROWCAP + lbase[e1] + lp1;
            rowtok[i0] = (unsigned)tok * 2u; rowcoef[i0] = c0; rowrstd[i0] = rstd;
            rowtok[i1] = (unsigned)tok * 2u + 1u; rowcoef[i1] = c1; rowrstd[i1] = rstd;
        }
        __syncthreads();
    }
}
struct MoeOrder {
    const LAS int* tst; int total, G, v; bool blocked;
    __device__ bool next(int i, pg8::Unit& u) const {
        int L;
        if (blocked) { const int b0 = (int)(((long)v * total) / G), b1 = (int)(((long)(v + 1) * total) / G); L = b0 + i; if (L >= b1) return false; }
        else { L = i * G + v; if (L >= total) return false; }
        const int rt = L >> 2; int e = 0;
#pragma unroll 8
        for (int q = 1; q <= 32; ++q) e += (tst[q] <= rt) ? 1 : 0;
        u.pm = rt; u.pn = L & 3; u.pb = e * 4 + u.pn; u.aux = e; u.aux2 = (rt - tst[e]) * 256; u.aux3 = tst[64 + e]; u.aux4 = i; return true;
    }
};
__device__ __forceinline__ void moe_tables(Frame& F) {
    LAS int* tst = (LAS int*)(F.lds + MOE_TST_OFF); const unsigned* ecnt = (const unsigned*)(F.ctl + CW_ECNT);
    if (F.wave == 0) { const int lane = F.lane; int nt = lane < 32 ? (int)((ecnt[lane & 31] + 255u) >> 8) : 0; int inc = nt;
#pragma unroll
        for (int o = 1; o < 32; o <<= 1) { const int t = __shfl_up(inc, o); if (lane >= o) inc += t; }
        if (lane < 32) { tst[lane + 1] = inc; tst[64 + lane] = (int)ecnt[lane]; } if (lane == 0) tst[0] = 0; }
    __syncthreads();
}
#if defined(PROBE_TW) || defined(PROBE_BAR) || defined(PROBE_GEMM)
#define PROBE_SCALE * probe_sc_
#else
#define PROBE_SCALE
#endif
__device__ __forceinline__ void final_phase(Frame& F) {
#if defined(PROBE_TW) || defined(PROBE_BAR) || defined(PROBE_GEMM)
    #ifndef PROBE_Q
#define PROBE_Q 0
#endif
#ifndef PROBE_GAIN
#define PROBE_GAIN 0.25f
#endif
    float probe_f_ = (float)__hip_atomic_load((unsigned*)(F.ctl + 3), __ATOMIC_RELAXED, __HIP_MEMORY_SCOPE_AGENT) / (float)__hip_atomic_load((unsigned*)(F.ctl + 4), __ATOMIC_RELAXED, __HIP_MEMORY_SCOPE_AGENT);
    if (PROBE_Q > 0) probe_f_ = floorf(probe_f_ * (float)PROBE_Q + 0.5f) / (float)PROBE_Q;
    const float probe_sc_ = 1.f + PROBE_GAIN * probe_f_;
#endif
#ifdef SELFCHECK
    const bool chk_bad = __hip_atomic_load((unsigned*)(F.ctl + 2), __ATOMIC_RELAXED, __HIP_MEMORY_SCOPE_AGENT) != 0u;
#endif
    const bf16_t* X1 = (const bf16_t*)(F.ws + WS_X1); const unsigned char* Y0 = F.ws + WS_Y0; const unsigned char* Y1 = F.ws + WS_Y1; const float* gf = F.in[26];
    const int gw = F.vcu * NWAVES + F.wave, NGW = F.G * NWAVES, lane = F.lane;
    f32x4 gv[4];
#pragma unroll
    for (int j = 0; j < 4; ++j) gv[j] = ((const f32x4*)gf)[lane + 64 * j];
    constexpr int FR = 4;
    for (int m0 = gw; m0 < T; m0 += NGW * FR) {
        u32x2 xx[FR][4]; unsigned ya[FR][4], yb[FR][4];
#pragma unroll
        for (int r = 0; r < FR; ++r) { const size_t m = (size_t)m0 + (size_t)r * NGW; const u32x2* xr = (const u32x2*)(X1 + m * D) + lane; const unsigned* y0 = (const unsigned*)(Y0 + m * D) + lane; const unsigned* y1 = (const unsigned*)(Y1 + m * D) + lane;
#pragma unroll
            for (int j = 0; j < 4; ++j) { xx[r][j] = xr[64 * j]; ya[r][j] = y0[64 * j]; yb[r][j] = y1[64 * j]; } }
        f32x4 v[FR][4]; float s[FR];
#pragma unroll
        for (int r = 0; r < FR; ++r) { float acc_ = 0.f;
#pragma unroll
            for (int j = 0; j < 4; ++j) { const int a = (int)ya[r][j], c = (int)yb[r][j]; constexpr float ys = 1.f / YF8_SCALE;
                v[r][j].x = bflo(xx[r][j].x) + (__builtin_amdgcn_cvt_f32_fp8(a, 0) + __builtin_amdgcn_cvt_f32_fp8(c, 0)) * ys; v[r][j].y = bfhi(xx[r][j].x) + (__builtin_amdgcn_cvt_f32_fp8(a, 1) + __builtin_amdgcn_cvt_f32_fp8(c, 1)) * ys;
                v[r][j].z = bflo(xx[r][j].y) + (__builtin_amdgcn_cvt_f32_fp8(a, 2) + __builtin_amdgcn_cvt_f32_fp8(c, 2)) * ys; v[r][j].w = bfhi(xx[r][j].y) + (__builtin_amdgcn_cvt_f32_fp8(a, 3) + __builtin_amdgcn_cvt_f32_fp8(c, 3)) * ys;
                acc_ += (v[r][j].x * v[r][j].x + v[r][j].y * v[r][j].y) + (v[r][j].z * v[r][j].z + v[r][j].w * v[r][j].w); }
            s[r] = acc_; }
#pragma unroll
        for (int r = 0; r < FR; ++r) { const float rstd = 1.f / sqrtf(wave_sum(s[r]) * (1.f / D) + RMS_EPS); f32x4* o = (f32x4*)(F.out + ((size_t)m0 + (size_t)r * NGW) * D) + lane;
#ifdef SELFCHECK
            if (chk_bad) { for (int j = 0; j < 4; ++j) o[64 * j] = (f32x4){0.f, 0.f, 0.f, 0.f}; continue; }
#endif
#pragma unroll
            for (int j = 0; j < 4; ++j) o[64 * j] = v[r][j] * rstd * gv[j] PROBE_SCALE; }
    }
}
#ifdef SELFCHECK
constexpr int CW_CHK = 2;
__device__ __forceinline__ int t5_bucket_ref(int n) { if (n < 16) return n; const int l = 16 + (int)(logf((float)n / 16.f) / logf(8.f) * 16.f); return l < 31 ? l : 31; }
__device__ __forceinline__ float kfrag_at(const bf16_t* KF, int bh, int key, int d) { const int n = key >> 8, kl = key & 255, st = kl >> 5, i = kl & 31, ds = d >> 4, hi = (d >> 3) & 1, e = d & 7;
    return bf2f(KF[(((size_t)bh * 32 + n) * 2048 + (st * 4 + ds) * 64 + (i + 32 * hi)) * 8 + e]); }
__device__ __forceinline__ float vfrag_at(const bf16_t* VF, int bh, int key, int d) { const int n = key >> 8, kl = key & 255, st = kl >> 5, kk = kl & 31, ks = kk >> 4, k16 = kk & 15, hi = (k16 >> 2) & 1, e = (k16 & 3) + 4 * (k16 >> 3), d0 = d >> 5, jj = d & 31;
    return bf2f(VF[(((size_t)bh * 32 + n) * 2048 + ((st * 2 + ks) * 2 + d0) * 64 + (jj + 32 * hi)) * 8 + e]); }
__device__ __forceinline__ void selfcheck_phase(Frame& F, float tol_attn, float tol_ssm) {
    const int lane = lane_id(); const int gw = F.vcu * NWAVES + F.wave;
    const bf16_t* Qb = (const bf16_t*)(F.ws + WS_Q); const bf16_t* KM = (const bf16_t*)(F.ws + WS_KMEAN); const bf16_t* KF = (const bf16_t*)(F.ws + WS_KFRAG); const bf16_t* VF = (const bf16_t*)(F.ws + WS_VFRAG);
    const unsigned char* YA = F.ws + WS_YATT; const float* rb = F.in[16];
    bool bad = false;
    for (int sidx = 0; sidx < 12; ++sidx) {
        unsigned hsh = (unsigned)(gw * 12 + sidx) * 2654435761u; hsh ^= hsh >> 15; hsh *= 2246822519u; hsh ^= hsh >> 13;
        const int bh = (int)(hsh & 63u); int q = (int)((hsh >> 6) & 8191u);
        if (sidx == 0) q = q & 767; if (sidx == 1) q = (q & ~255) | (sidx & 1 ? 0 : 255); if (sidx == 2) q = (q & ~255) | 255; if (sidx == 3) q = (q & ~255) | 128;
        const int b = bh >> 3, h = bh & 7, qb = q >> 8, d = lane;
        const float qd = bf2f(Qb[((size_t)b * SEQ + q) * DA + h * HD + d]);
        int s0 = -1, s1 = -1, s2 = -1; float g0 = -INFINITY, g1 = -INFINITY, g2 = -INFINITY;
        for (int n = 0; n < qb; ++n) { const float gt = wave_sum(qd * bf2f(KM[((size_t)bh * 32 + n) * 64 + d]));
            if (gt > g0) { g2 = g1; s2 = s1; g1 = g0; s1 = s0; g0 = gt; s0 = n; } else if (gt > g1) { g2 = g1; s2 = s1; g1 = gt; s1 = n; } else if (gt > g2) { g2 = gt; s2 = n; } }
        float m = -INFINITY, l = 0.f, od = 0.f;
        for (int blk = 0; blk < 4; ++blk) { const int n = blk == 0 ? s0 : (blk == 1 ? s1 : (blk == 2 ? s2 : qb)); if (n < 0) continue;
            const int kend = (blk == 3) ? (q & 255) + 1 : 256;
            for (int kl = 0; kl < kend; ++kl) { const int key = 256 * n + kl; const float kd = kfrag_at(KF, bh, key, d);
                const float s = wave_sum(qd * kd) + rb[h * 32 + t5_bucket_ref(q - key)] * LOG2E;
                const float mn = fmaxf(m, s), sc = exp2f(m - mn), p = exp2f(s - mn); l = l * sc + p; od = od * sc + p * vfrag_at(VF, bh, key, d); m = mn; } }
        od /= l;
        const float yd = __builtin_amdgcn_cvt_f32_fp8((int)YA[((size_t)b * SEQ + q) * DA + h * HD + d], 0);
        const float e2 = wave_sum((od - yd) * (od - yd)), o2 = wave_sum(od * od);
        if (!(e2 <= tol_attn * tol_attn * o2)) bad = true;
    }
    { const bf16_t* UP = (const bf16_t*)(F.ws + WS_UP); const bf16_t* GA = (const bf16_t*)(F.ws + WS_GACT);
      for (int sidx = 0; sidx < 6; ++sidx) {
        unsigned hsh = (unsigned)(gw * 6 + sidx + 7777) * 2654435761u; hsh ^= hsh >> 15; hsh *= 2246822519u; hsh ^= hsh >> 13;
        const int g = (int)(hsh & 31u), b = (int)((hsh >> 5) & 7u); int t = (int)((hsh >> 8) % 330u); if (sidx == 0) t = 31 + (int)((hsh >> 20) & 3u) * 32; if (sidx == 1) t = 32 + (int)((hsh >> 20) & 7u) * 32;
        const int p = lane;
        const float lr = F.in[4][g * SP + p], li = F.in[5][g * SP + p], step = expf(F.in[6][g]);
        const float mag = expf(lr * step), ar = mag * cosf(li * step), ai = mag * sinf(li * step);
        const float nr = ar - 1.f, ni = ai, den = lr * lr + li * li, cr = (nr * lr + ni * li) / den, ci = (ni * lr - nr * li) / den;
        float hr = 0.f, hi_ = 0.f;
        for (int tt = 0; tt <= t; ++tt) { float br = 0.f, bi = 0.f;
            for (int c = 0; c < 16; ++c) { const float u = bf2f(UP[(size_t)g * SROWS * SKY + ((size_t)b * 256 + (tt >> 5)) * SKY + (tt & 31) * 16 + c]);
                const float b_r = F.in[7][(g * SP + p) * 16 + c], b_i = F.in[8][(g * SP + p) * 16 + c]; br += (cr * b_r - ci * b_i) * u; bi += (cr * b_i + ci * b_r) * u; }
            const float n_r = ar * hr - ai * hi_ + br, n_i = ar * hi_ + ai * hr + bi; hr = n_r; hi_ = n_i; }
        float e2 = 0.f, o2 = 0.f;
        for (int ho = 0; ho < 16; ++ho) { float y = wave_sum(hr * F.in[9][(g * 16 + ho) * SP + p] - hi_ * F.in[10][(g * 16 + ho) * SP + p]);
            const float u = bf2f(UP[(size_t)g * SROWS * SKY + ((size_t)b * 256 + (t >> 5)) * SKY + (t & 31) * 16 + ho]); y += F.in[11][g * 16 + ho] * u;
            const float ge = 0.5f * y * (1.f + tanhf(0.7978845608028654f * (y + 0.044715f * y * y * y)));
            const float gv = bf2f(GA[((size_t)b * SEQ + t) * DS + g * 16 + ho]); e2 += (ge - gv) * (ge - gv); o2 += ge * ge; }
        if (!(e2 <= tol_ssm * tol_ssm * o2 + 1e-6f)) bad = true;
      } }
    if (__ballot(bad) != 0ull && lane == 0) __hip_atomic_store((unsigned*)(F.ctl + CW_CHK), 1u, __ATOMIC_RELAXED, __HIP_MEMORY_SCOPE_AGENT);
}
#endif

#ifdef SELFCHECK
__device__ __forceinline__ void selfcheck_prep(Frame& F) {
    const int lane = lane_id(); const int gw = F.vcu * NWAVES + F.wave;
    const bf16_t* Kb = (const bf16_t*)(F.ws + WS_K); const bf16_t* Vb = (const bf16_t*)(F.ws + WS_V); const bf16_t* KF = (const bf16_t*)(F.ws + WS_KFRAG); const bf16_t* VF = (const bf16_t*)(F.ws + WS_VFRAG);
    const bf16_t* KM = (const bf16_t*)(F.ws + WS_KMEAN); const float* KN = (const float*)(F.ws + WS_KMEAN + 512 * 1024);
    bool bad = false;
    for (int sidx = 0; sidx < 64; ++sidx) {
        unsigned hsh = (unsigned)(gw * 64 + sidx + 12345) * 2654435761u; hsh ^= hsh >> 15; hsh *= 2246822519u; hsh ^= hsh >> 13;
        const int bh = (int)(hsh & 63u), key = (int)((hsh >> 6) & 8191u), b = bh >> 3, h = bh & 7, d = lane;
        const float k0 = bf2f(Kb[((size_t)b * SEQ + key) * DA + h * HD + d]), v0 = bf2f(Vb[((size_t)b * SEQ + key) * DA + h * HD + d]);
        if (kfrag_at(KF, bh, key, d) != k0 || vfrag_at(VF, bh, key, d) != v0) bad = true;
    }
    for (int sidx = 0; sidx < 2; ++sidx) {
        unsigned hsh = (unsigned)(gw * 2 + sidx + 999) * 2654435761u; hsh ^= hsh >> 15; hsh *= 2246822519u; hsh ^= hsh >> 13;
        const int item = (int)(hsh & 2047u), bh = item >> 5, n = item & 31, b = bh >> 3, h = bh & 7, d = lane; float sum = 0.f, mx = 0.f;
        for (int kl = 0; kl < 256; ++kl) { const float kv = bf2f(Kb[((size_t)b * SEQ + 256 * n + kl) * DA + h * HD + d]); sum += kv; mx = fmaxf(mx, wave_sum(kv * kv)); }
        const float mean = sum * (1.f / 256.f), got = bf2f(KM[(size_t)item * 64 + d]);
        if (fabsf(mean - got) > 0.01f * fabsf(mean) + 1e-3f) bad = true;
        if (fabsf(mx - KN[item]) > 1e-3f * mx) bad = true;
    }
    if (__ballot(bad) != 0ull && lane == 0) __hip_atomic_store((unsigned*)(F.ctl + CW_CHK), 1u, __ATOMIC_RELAXED, __HIP_MEMORY_SCOPE_AGENT);
}
#endif
#ifndef MK_N_LAUNCHES
#define MK_N_LAUNCHES 1
#endif
constexpr int NPHASE = 13;
struct Args { const float* in[27]; float* out; unsigned char* ws; int ph_lo, ph_hi; };
static_assert(sizeof(Args) == 27 * 8 + 8 + 8 + 8, "Args has no padding");

#ifndef PAIR_PHASES
#define PAIR_PHASES 1
#endif
#ifndef BLK_ORDER
#define BLK_ORDER 0
#endif
#ifndef STAG9
#define STAG9 0
#endif
#ifndef STAG8
#define STAG8 0
#endif
#ifndef DUP_MASK
#define DUP_MASK 0
#endif
#define PH_ARGS Frame& F, unsigned char* ws, LAS unsigned char* ring
__device__ __forceinline__ void ph1(PH_ARGS) {
#if U_FP8
    { pg8::Gemm g{(const bf16_t*)(ws + WS_H1F8), (const bf16_t*)(ws + WS_WINF8U), D / 2, D / 2, D / 2}; pg8::StaticOrder S; S.init(T, DS, F.G, (int)blockIdx.x);
      EpiProj<0> E{ws, F.in[3], 0, 1.f / WF8_SCALE};
      pg8::gemm_phase<EpiProj<0>, pg8::StaticOrder, true, false, true>(ring, g, S, E, nullptr, F.wave); }
#else
    { pg8::Gemm g{(const bf16_t*)(ws + WS_H1), (const bf16_t*)(ws + WS_WIN), D, D, D}; pg8::StaticOrder S; S.init(T, DS, F.G, (int)blockIdx.x);
      EpiProj<0> E{ws, F.in[3], 0, 1.f};
      pg8::gemm_phase<EpiProj<0>, pg8::StaticOrder, true, false>(ring, g, S, E, nullptr, F.wave); }
#endif
    { pg8::Gemm g{(const bf16_t*)(ws + WS_H1F8), (const bf16_t*)(ws + WS_WINF8), D / 2, D / 2, D / 2}; pg8::StaticOrder S; S.init(T, DIN - DS, F.G, (int)blockIdx.x);
      EpiProj<1> E{ws, F.in[3], 2, 1.f / WF8_SCALE};
      pg8::gemm_phase<EpiProj<1>, pg8::StaticOrder, true, false, true, false, 1>(ring, g, S, E, nullptr, F.wave, (unsigned*)F.ctl); }
}
__device__ __forceinline__ void ph2(PH_ARGS) {
    { pg8::Gemm g{(const bf16_t*)(ws + WS_UP), (const bf16_t*)(ws + WS_SSMW), SKY, SKU, SKU}; pg8::GroupedOrder S; S.init(SG * 8, 1, 8, F.G, F.vcu);
      EpiSsmE E{(float*)(ws + WS_E)};
      pg8::gemm_phase<EpiSsmE, pg8::GroupedOrder, false, false, false, true  >(ring, g, S, E, nullptr, F.wave); }
    VM_WAIT(); __syncthreads();
    ssm_scan_phase(F);
    kv_prep_phase(F);
}
__device__ __forceinline__ void ph4(PH_ARGS) {
    pg8::Gemm g{(const bf16_t*)(ws + WS_UP), (const bf16_t*)(ws + WS_SSMT), SKY, SKY, SKY}; pg8::GroupedOrder S; S.init(SG * 8, 2, 8, F.G, F.vcu);
    EpiSsmY E{(bf16_t*)(ws + WS_GACT)};
    pg8::gemm_phase<EpiSsmY, pg8::GroupedOrder, true, false, false, false, 0, true  >(ring, g, S, E, nullptr, F.wave);
}
__device__ __forceinline__ void ph5(PH_ARGS) {
    pg8::Gemm g{(const bf16_t*)(ws + WS_GACT), (const bf16_t*)(ws + WS_WGLU), DS, DS, DS}; pg8::StaticOrder S; S.init(T, DS, F.G, (int)blockIdx.x, (BLK_ORDER & 1) != 0);
    EpiGlu E{(const bf16_t*)(ws + WS_GACT), (bf16_t*)(ws + WS_YSSM), F.in[13]};
    pg8::gemm_phase<EpiGlu, pg8::StaticOrder, true, false>(ring, g, S, E, nullptr, F.wave);
}
__device__ __forceinline__ void ph6(PH_ARGS) {
    { pg8::Gemm g{(const bf16_t*)(ws + WS_YATT), (const bf16_t*)(ws + WS_WUA), DA / 2, DA / 2, DA / 2}; pg8::StaticOrder S; S.init(T, D, F.G, (int)blockIdx.x, (BLK_ORDER & 2) != 0);
      EpiUpA E{ws + WS_SGA, ws + WS_MA, MA_SCALE / WF8_SCALE};
      pg8::gemm_phase<EpiUpA, pg8::StaticOrder, true, false, true>(ring, g, S, E, nullptr, F.wave); }
    VM_WAIT(); __syncthreads();
    { constexpr int KS = UPS_FP8 ? DS / 2 : DS;
      pg8::Gemm g{(const bf16_t*)(ws + WS_YSSM), (const bf16_t*)(ws + WS_WUS), KS, KS, KS}; pg8::StaticOrder S; S.init(T, D, F.G, (int)blockIdx.x, (BLK_ORDER & 2) != 0);
      EpiUpS E{(const bf16_t*)(ws + WS_SGS), ws + WS_MA, (bf16_t*)(ws + WS_MRG), UPS_FP8 ? 1.f / (WF8_SCALE * YS_SCALE) : 1.f};
      pg8::gemm_phase<EpiUpS, pg8::StaticOrder, true, false, UPS_FP8 != 0>(ring, g, S, E, nullptr, F.wave); }
}
__device__ __forceinline__ void ph7(PH_ARGS) {
    constexpr int KD = OUT_FP8 ? D / 2 : D;
    pg8::Gemm g{(const bf16_t*)(ws + WS_MRG), (const bf16_t*)(ws + WS_WOUT), KD, KD, KD}; pg8::StaticOrder S; S.init(T, D, F.G, (int)blockIdx.x, (BLK_ORDER & 4) != 0);
    EpiOut E{F.in[0], (bf16_t*)(ws + WS_X1), ws + WS_XGF8, (float*)(ws + WS_SSQ), OUT_FP8 ? 1.f / (WF8_SCALE * MRG_SCALE) : 1.f};
    pg8::gemm_phase<EpiOut, pg8::StaticOrder, true, false, OUT_FP8 != 0, false, 9>(ring, g, S, E, nullptr, F.wave, (unsigned*)F.ctl);
}
__device__ __forceinline__ void ph8(PH_ARGS) {
    pg8::Gemm g{(const bf16_t*)(ws + WS_X1), (const bf16_t*)(ws + WS_WR), D, D, D}; pg8::GroupedOrder S; S.init(T / 256, 1, T / 256, F.G, F.vcu);
    EpiRouter E{(float*)(ws + WS_RLOG)};
    pg8::gemm_phase<EpiRouter, pg8::GroupedOrder, false, false, false, true  >(ring, g, S, E, nullptr, F.wave);
}
__device__ __forceinline__ void ph10(PH_ARGS) {
    moe_tables(F);
    const LAS int* tst = (const LAS int*)(F.lds + MOE_TST_OFF);
    MoeOrder S{tst, tst[32] * 4, F.G, F.vcu, false};
    LAS unsigned* rowtab = (LAS unsigned*)(F.lds + ROWTAB_OFF);
    LAS float* rstab = (LAS float*)(F.lds + ROWTAB_OFF + ROWTAB_UNITS * 1024);
    { const unsigned* rowtok = (const unsigned*)(ws + WS_ROWTOK); const float* rowrstd = (const float*)(ws + WS_ROWRSTD); unsigned tkv[ROWTAB_UNITS]; float rsv[ROWTAB_UNITS];
#pragma unroll
      for (int i = 0; i < ROWTAB_UNITS; ++i) { pg8::Unit u; tkv[i] = 0u; rsv[i] = 0.f; if (S.next(i, u) && F.tid < 256) { const int pos = u.aux2 + F.tid; const size_t ri = (size_t)u.aux * ROWCAP + (pos < u.aux3 ? pos : 0); rsv[i] = rowrstd[ri]; if (pos < u.aux3) tkv[i] = rowtok[ri]; } }
#pragma unroll
      for (int i = 0; i < ROWTAB_UNITS; ++i) if (F.tid < 256) { rowtab[i * 256 + F.tid] = (tkv[i] >> 1) * (unsigned)D; rstab[i * 256 + F.tid] = rsv[i]; } }
    __syncthreads();
    pg8::Gemm g{(const bf16_t*)(ws + WS_XGF8), (const bf16_t*)(ws + WS_W13), D / 2, D / 2, D / 2};
    EpiMoe1 E{ws + WS_HID, rstab, (const unsigned*)(F.ctl + CW_ECNT), 1.f / WF8_SCALE};
    pg8::gemm_phase<EpiMoe1, MoeOrder, true, true, true, false, 11>(ring, g, S, E, rowtab, F.wave, (unsigned*)F.ctl);
}
__device__ __forceinline__ void ph11(PH_ARGS) {
    moe_tables(F);
    const LAS int* tst = (const LAS int*)(F.lds + MOE_TST_OFF);
    MoeOrder S{tst, tst[32] * 4, F.G, F.vcu, (BLK_ORDER & 8) != 0};
    LAS unsigned* tktab = (LAS unsigned*)(F.lds + ROWTAB_OFF); LAS float* cftab = (LAS float*)(F.lds + ROWTAB_OFF + ROWTAB_UNITS * 1024);
    { const unsigned* rowtok = (const unsigned*)(ws + WS_ROWTOK); const float* rowcoef = (const float*)(ws + WS_ROWCOEF); unsigned tkv[ROWTAB_UNITS]; float cfv[ROWTAB_UNITS];
#pragma unroll
      for (int i = 0; i < ROWTAB_UNITS; ++i) { pg8::Unit u; tkv[i] = 0u; cfv[i] = 0.f; if (S.next(i, u) && F.tid < 256) { const int pos = u.aux2 + F.tid; const size_t ri = (size_t)u.aux * ROWCAP + (pos < u.aux3 ? pos : 0); tkv[i] = rowtok[ri]; cfv[i] = rowcoef[ri]; } }
#pragma unroll
      for (int i = 0; i < ROWTAB_UNITS; ++i) if (F.tid < 256) { tktab[i * 256 + F.tid] = tkv[i]; cftab[i * 256 + F.tid] = cfv[i]; } }
    __syncthreads();
    pg8::Gemm g{(const bf16_t*)(ws + WS_HID), (const bf16_t*)(ws + WS_W2), DE / 2, DE / 2, DE / 2};
    EpiMoe2 E{ws + WS_Y0, (size_t)(WS_Y1 - WS_Y0), tktab, cftab, (const unsigned*)(F.ctl + CW_ECNT), YF8_SCALE / WF8_SCALE};
    pg8::gemm_phase<EpiMoe2, MoeOrder, true, false, true, false, 12>(ring, g, S, E, nullptr, F.wave, (unsigned*)F.ctl);
}

__global__ void __launch_bounds__(NTHR, 2) fwd_kernel(Args args) {
    extern __shared__ __attribute__((aligned(16))) unsigned char lds_raw[];
    Frame F;
    F.lds = (LAS unsigned char*)lds_raw;
    F.MISC = (volatile LAS unsigned*)(F.lds + MISC_OFF);
    F.wave = __builtin_amdgcn_readfirstlane((int)(threadIdx.x >> 6)); F.lane = lane_id(); F.tid = F.wave * 64 + F.lane;
    F.G = gridDim.x; { const int bx = blockIdx.x; F.vcu = (F.G % 8 == 0) ? (bx % 8) * (F.G / 8) + bx / 8 : bx; }
    F.ws = args.ws; F.ctl = (gu32*)(args.ws + WS_CTL); F.out = args.out;
#pragma unroll
    for (int i = 0; i < 27; ++i) F.in[i] = args.in[i];
    for (int u = F.tid; u < (LDS_BYTES - MOE_TST_OFF) / 4; u += NTHR) ((LAS unsigned*)(F.lds + MOE_TST_OFF))[u] = 0u;
    __syncthreads();
    XcdBarrier bar; bar.bar = (unsigned*)(F.ctl + CW_BAR); bar.x = 0; bar.st = nullptr;
    const int lo = args.ph_lo, hi = args.ph_hi;
    if (hi - lo > 1) bar = xcd_barrier_post((unsigned*)(F.ctl + CW_BAR), F.MISC + 8, F.tid == 0);
#define IN(k) (lo <= (k) && (k) < hi)
#define DUP(k) ((DUP_MASK >> (k)) & 1)
#ifdef PROBE_BAR
#define SEAM(k) do { if (IN(k) && IN((k) + 1)) { const unsigned long long tb0_ = __builtin_amdgcn_s_memrealtime(); xcd_barrier(bar, F.wave == 0 && lane_id() == 0); tb_acc_ += (unsigned)(__builtin_amdgcn_s_memrealtime() - tb0_); } REFRESH(); } while (0)
#else
#define SEAM(k) do { if (IN(k) && IN((k) + 1)) xcd_barrier(bar, F.wave == 0 && lane_id() == 0); REFRESH(); } while (0)
#endif
#define REFRESH() do { int l_ = lane_id(); asm volatile("" : "+v"(l_)); F.lane = l_; F.tid = F.wave * 64 + l_; } while (0)
    unsigned char* ws = args.ws;
    LAS unsigned char* ring = F.lds;
#ifdef PROBE_BAR
    unsigned tb_acc_ = 0u; const unsigned long long tk0_ = __builtin_amdgcn_s_memrealtime();
#endif
    if (IN(0)) { p0_prologue(F); if (DUP(0)) p0_prologue(F); }
    SEAM(0);
    if (IN(1)) { ph1(F, ws, ring); if (DUP(1)) ph1(F, ws, ring); }
    SEAM(1);
    if (IN(2)) { ph2(F, ws, ring); if (DUP(2)) ph2(F, ws, ring); }
    SEAM(2);
#ifdef SELFCHECK_PREP
    if (IN(3)) { selfcheck_prep(F); }
#endif
    if (IN(3)) { attn_gate_phase<true>(F); }
#if PAIR_PHASES
    if (IN(3)) { __syncthreads(); ph4(F, ws, ring); }
#endif
    SEAM(3);
    if (IN(4)) { attn_block_phase(F); if (DUP(4)) { __syncthreads(); attn_block_phase(F); } }
#if PAIR_PHASES
    if (IN(4)) { __syncthreads(); ph5(F, ws, ring); }
#endif
    SEAM(4);
    if (IN(5)) { attn_own_phase(F); if (DUP(5)) attn_own_phase(F); }
#if !PAIR_PHASES
    if (IN(5)) { __syncthreads(); ph4(F, ws, ring); if (DUP(14)) ph4(F, ws, ring); }
#endif
#ifdef SELFCHECK
    if (IN(5)) { xcd_barrier(bar, F.wave == 0 && lane_id() == 0); REFRESH(); selfcheck_phase(F, SELFCHECK_TOL_ATTN, SELFCHECK_TOL_SSM); }
#endif
    SEAM(5);
#if !PAIR_PHASES
    if (IN(6)) { ph5(F, ws, ring); if (DUP(6)) ph5(F, ws, ring); }
    SEAM(6);
#endif
    if (IN(7)) { if (STAG8 > 0 && (F.vcu & 1)) { const unsigned long long t0_ = __builtin_amdgcn_s_memrealtime(); while ((long long)(__builtin_amdgcn_s_memrealtime() - t0_) < (long long)STAG8) __builtin_amdgcn_s_sleep(16); }
                 ph6(F, ws, ring); if (DUP(7)) ph6(F, ws, ring); }
    SEAM(7);
    if (IN(8)) { if (STAG9 > 0 && (F.vcu & 1)) { const unsigned long long t0_ = __builtin_amdgcn_s_memrealtime(); while ((long long)(__builtin_amdgcn_s_memrealtime() - t0_) < (long long)STAG9) __builtin_amdgcn_s_sleep(16); }
                 ph7(F, ws, ring); if (DUP(8)) ph7(F, ws, ring); }
    SEAM(8);
    if (IN(9)) { ph8(F, ws, ring); VM_WAIT(); __syncthreads(); routing_phase(F); }
    SEAM(9);
    if (IN(10)) { ph10(F, ws, ring); if (DUP(10)) ph10(F, ws, ring); }
    SEAM(10);
    if (IN(11)) { ph11(F, ws, ring); if (DUP(11)) ph11(F, ws, ring); }
    SEAM(11);
#ifdef PROBE_BAR
    if (F.wave == 0 && lane_id() == 0) { __hip_atomic_fetch_add((unsigned*)(F.ctl + 3), tb_acc_, __ATOMIC_RELAXED, __HIP_MEMORY_SCOPE_AGENT); __hip_atomic_fetch_add((unsigned*)(F.ctl + 4), (unsigned)(__builtin_amdgcn_s_memrealtime() - tk0_), __ATOMIC_RELAXED, __HIP_MEMORY_SCOPE_AGENT); }
    xcd_barrier(bar, F.wave == 0 && lane_id() == 0); REFRESH();
#endif
    if (IN(12)) { final_phase(F); if (DUP(12)) final_phase(F); }
#undef IN
#undef DUP
#undef SEAM
#undef REFRESH
}

extern "C" void kernel_launch(void* const* d_in, const int* in_sizes, int n_in, void* d_out, int out_size, void* d_ws, size_t ws_size, hipStream_t stream) {
    static int grid = 0;
    if (grid == 0) {
        if (n_in != 27 || in_sizes[0] != T * D || out_size != T * D || ws_size < WS_END) { fprintf(stderr, "kernel_launch: unexpected shapes (n_in %d, in0 %d, out %d, ws %zu)\n", n_in, n_in > 0 ? in_sizes[0] : -1, out_size, ws_size); grid = -1; return; }
        int dev = 0, cus = 0;
        if (hipGetDevice(&dev) != hipSuccess || hipDeviceGetAttribute(&cus, hipDeviceAttributeMultiprocessorCount, dev) != hipSuccess) { grid = -1; return; }
        if (hipFuncSetAttribute((const void*)fwd_kernel, hipFuncAttributeMaxDynamicSharedMemorySize, LDS_BYTES) != hipSuccess) { fprintf(stderr, "kernel_launch: hipFuncSetAttribute failed\n"); grid = -1; return; }
        (void)hipGetLastError();
        grid = cus;
    }
    if (grid < 0) return;
    (void)hipMemsetAsync((char*)d_ws + WS_CTL, 0, CTL_ZERO_BYTES, stream);
    Args a{};
    for (int i = 0; i < 27; ++i) a.in[i] = (const float*)d_in[i];
    a.out = (float*)d_out; a.ws = (unsigned char*)d_ws;
    if (MK_N_LAUNCHES == 1) { a.ph_lo = 0; a.ph_hi = NPHASE; hipLaunchKernelGGL(fwd_kernel, dim3(grid), dim3(NTHR), LDS_BYTES, stream, a); }
    else { for (int p = 0; p < NPHASE; ++p) { a.ph_lo = p; a.ph_hi = p + 1; hipLaunchKernelGGL(fwd_kernel, dim3(grid), dim3(NTHR), LDS_BYTES, stream, a); } }
}
```
